# Optimizing an MI355X kernel written in HIP

```python
import jax, jax.numpy as jnp
from jax import lax
import numpy as np

D_MODEL = 1024
BATCH = 2
SEQ = 8192
DEPTH = 1

D_MIX = D_MODEL
RET_HEADS = 4
RET_DK = 128
RET_DV = 128
RET_CHUNK = 128
NSA_HEADS = 8
NSA_KV_GROUPS = 2
NSA_HPG = NSA_HEADS // NSA_KV_GROUPS
NSA_DH = 64
CMP_LEN = 32
CMP_STRIDE = 16
CMP_HID = 256
SEL_BLOCK = 64
SEL_TOPN = 16
WINDOW = 512
Q_BLOCK = 128
FORCED_SCORE = 1e9
ROPE_THETA = 10000.0
PEER_HEADS = 8
PEER_NKEYS = 128
PEER_EXPERTS = PEER_NKEYS * PEER_NKEYS
PEER_TOPK = 16
PEER_DQ = 256
PEER_DHALF = PEER_DQ // 2
PEER_TOK_BLOCK = 128
NORM_EPS = 1e-6
KV_COLS = NSA_KV_GROUPS * NSA_DH
IN_SPLITS = (RET_HEADS * RET_DK, RET_HEADS * RET_DK, RET_HEADS * RET_DV, RET_HEADS * RET_DV,
             NSA_HEADS * NSA_DH, KV_COLS, KV_COLS, KV_COLS, KV_COLS, KV_COLS, KV_COLS,
             NSA_HEADS * 3)
IN_COLS = sum(IN_SPLITS)

kernel_name = "hymba_retention_nsa_peer_block"


def _rms_norm(x, g):
    xf = x.astype(jnp.float32)
    y = xf * lax.rsqrt(jnp.mean(xf * xf, axis=-1, keepdims=True) + NORM_EPS)
    return (y * g.astype(jnp.float32)).astype(x.dtype)


def _modulate(h, shift, scale):
    return h * (1.0 + scale[:, None, :]) + shift[:, None, :]


def _rope(x, pos):
    d = x.shape[-1]
    inv = ROPE_THETA ** (-jnp.arange(0, d, 2, dtype=jnp.float32) / d)
    ang = pos.astype(jnp.float32)[:, None] * inv[None, :]
    cos = jnp.cos(ang)[None, :, None, :].astype(x.dtype)
    sin = jnp.sin(ang)[None, :, None, :].astype(x.dtype)
    x1, x2 = jnp.split(x, 2, axis=-1)
    return jnp.concatenate([x1 * cos - x2 * sin, x2 * cos + x1 * sin], axis=-1)


def _masked_softmax(s, mask):
    s = jnp.where(mask, s, -jnp.inf)
    m = jnp.max(s, axis=-1, keepdims=True)
    m = jnp.where(jnp.isfinite(m), m, 0.0)
    e = jnp.where(mask, jnp.exp(s - m), 0.0)
    return e / jnp.maximum(jnp.sum(e, axis=-1, keepdims=True), jnp.finfo(jnp.float32).tiny)


def _retention(q, k, v, g):
    B, S, H, DK = q.shape
    DV = v.shape[-1]
    C = RET_CHUNK
    nc = S // C
    f32 = jnp.float32
    log_g = jnp.log1p(-jnp.exp2(-5.0 - jnp.arange(H, dtype=f32)))
    n = jnp.arange(C, dtype=f32)
    diff = n[:, None] - n[None, :]
    causal = diff >= 0
    dmat = jnp.where(causal[None], jnp.exp(jnp.where(causal, diff, 0.0)[None] * log_g[:, None, None]), 0.0)
    qc = q.astype(f32).reshape(B, nc, C, H, DK)
    kc = (k.astype(f32) * DK ** -0.5).reshape(B, nc, C, H, DK)
    vc = v.astype(f32).reshape(B, nc, C, H, DV)
    scores = jnp.einsum('bcnhk,bcmhk->bchnm', qc, kc) * dmat[None, None]
    inner = jnp.einsum('bchnm,bcmhv->bcnhv', scores, vc)
    zeta = jnp.exp((C - 1 - n)[None, :] * log_g[:, None])
    kv = jnp.einsum('bcmhk,bcmhv,hm->cbhkv', kc, vc, zeta)
    cdecay = jnp.exp(C * log_g)[None, :, None, None]

    def step(state, kv_c):
        return cdecay * state + kv_c, state

    _, s_prev = lax.scan(step, jnp.zeros((B, H, DK, DV), f32), kv)
    xi = jnp.exp((n + 1.0)[None, :] * log_g[:, None])
    cross = jnp.einsum('bcnhk,cbhkv,hn->bcnhv', qc, s_prev, xi)
    y = (inner + cross).reshape(B, S, H, DV)
    mu = jnp.mean(y, axis=-1, keepdims=True)
    var = jnp.mean((y - mu) ** 2, axis=-1, keepdims=True)
    y = (y - mu) * lax.rsqrt(var + NORM_EPS)
    y = jax.nn.silu(g.astype(f32)) * y
    return y.reshape(B, S, H * DV).astype(q.dtype)


def _compress(kraw, pe, w1, b1, w2):
    B, S, G, DH = kraw.shape
    ncb = (S - CMP_LEN) // CMP_STRIDE + 1
    idx = jnp.arange(ncb)[:, None] * CMP_STRIDE + jnp.arange(CMP_LEN)[None, :]
    blk = kraw[:, idx] + pe[None, None, :, None, :]
    blk = blk.transpose(0, 1, 3, 2, 4).reshape(B, ncb, G, CMP_LEN * DH)
    return jax.nn.gelu(blk @ w1 + b1) @ w2


def _nsa(q, k_c, v_c, k_s, v_s, k_w, v_w, gate_logits, pe_k, pe_v, wk1, bk1, wk2, wv1, bv1, wv2):
    B, S = q.shape[:2]
    G, HPG, DH = NSA_KV_GROUPS, NSA_HPG, NSA_DH
    f32 = jnp.float32
    kc = _compress(k_c, pe_k, wk1, bk1, wk2)
    vc = _compress(v_c, pe_v, wv1, bv1, wv2)
    ncb = kc.shape[1]
    nsel = S // SEL_BLOCK
    n_top = min(SEL_TOPN, nsel)
    nqb = S // Q_BLOCK
    cmp_start = jnp.arange(ncb) * CMP_STRIDE
    cmp_end = cmp_start + CMP_LEN - 1
    sel_start = jnp.arange(nsel) * SEL_BLOCK
    overlap = jnp.clip(jnp.minimum(cmp_start[:, None] + CMP_LEN, sel_start[None, :] + SEL_BLOCK)
                       - jnp.maximum(cmp_start[:, None], sel_start[None, :]), 0).astype(f32) / CMP_STRIDE
    ks_g = k_s.reshape(B, nsel, SEL_BLOCK, G, DH).transpose(0, 3, 1, 2, 4)
    vs_g = v_s.reshape(B, nsel, SEL_BLOCK, G, DH).transpose(0, 3, 1, 2, 4)
    kw_pad = jnp.pad(k_w, ((0, 0), (WINDOW, 0), (0, 0), (0, 0)))
    vw_pad = jnp.pad(v_w, ((0, 0), (WINDOW, 0), (0, 0), (0, 0)))
    qg = q.reshape(B, nqb, Q_BLOCK, G, HPG, DH).swapaxes(0, 1)
    gg = gate_logits.reshape(B, nqb, Q_BLOCK, G, HPG, 3).swapaxes(0, 1)
    scale = DH ** -0.5
    gather = jax.vmap(jax.vmap(lambda tbl, ix: tbl[ix]))
    blk_ids = jnp.arange(nsel)

    def body(args):
        qb, qblk, gblk = args
        t = qb * Q_BLOCK + jnp.arange(Q_BLOCK)
        s_c = jnp.einsum('bqghd,bngd->bghqn', qblk, kc).astype(f32) * scale
        p_c = _masked_softmax(s_c, cmp_end[None, :] <= t[:, None])
        o_c = jnp.einsum('bghqn,bngd->bqghd', p_c.astype(vc.dtype), vc)
        imp = jnp.einsum('bghqn,nj->bgqj', p_c, overlap)
        cur = t // SEL_BLOCK
        forced = (blk_ids[None, :] == 0) | (blk_ids[None, :] == cur[:, None]) | (blk_ids[None, :] == cur[:, None] - 1)
        imp = jnp.where(forced, FORCED_SCORE, imp)
        imp = jnp.where(blk_ids[None, :] <= cur[:, None], imp, -jnp.inf)
        top_v, top_i = lax.top_k(imp, n_top)
        ksel = gather(ks_g, top_i)
        vsel = gather(vs_g, top_i)
        pos = top_i[..., None] * SEL_BLOCK + jnp.arange(SEL_BLOCK)
        m_s = jnp.isfinite(top_v)[..., None] & (pos <= t[None, None, :, None, None])
        s_s = jnp.einsum('bqghd,bgqnkd->bghqnk', qblk, ksel).astype(f32) * scale
        p_s = _masked_softmax(s_s.reshape(B, G, HPG, Q_BLOCK, n_top * SEL_BLOCK),
                              m_s.reshape(B, G, 1, Q_BLOCK, n_top * SEL_BLOCK))
        o_s = jnp.einsum('bghqm,bgqmd->bqghd', p_s.astype(vsel.dtype),
                         vsel.reshape(B, G, Q_BLOCK, n_top * SEL_BLOCK, DH))
        kwb = lax.dynamic_slice_in_dim(kw_pad, qb * Q_BLOCK, Q_BLOCK + WINDOW, axis=1)
        vwb = lax.dynamic_slice_in_dim(vw_pad, qb * Q_BLOCK, Q_BLOCK + WINDOW, axis=1)
        sp = qb * Q_BLOCK - WINDOW + jnp.arange(Q_BLOCK + WINDOW)
        m_w = (sp[None, :] >= 0) & (sp[None, :] <= t[:, None]) & (sp[None, :] > t[:, None] - WINDOW)
        s_w = jnp.einsum('bqghd,bkgd->bghqk', qblk, kwb).astype(f32) * scale
        p_w = _masked_softmax(s_w, m_w)
        o_w = jnp.einsum('bghqk,bkgd->bqghd', p_w.astype(vwb.dtype), vwb)
        gate = jax.nn.sigmoid(gblk.astype(f32))
        out = gate[..., 0:1] * o_c + gate[..., 1:2] * o_s + gate[..., 2:3] * o_w
        return out.astype(qblk.dtype)

    out = lax.map(body, (jnp.arange(nqb), qg, gg))
    return out.swapaxes(0, 1).reshape(B, S, NSA_HEADS * DH)


def _peer(h, w_q, subkeys, w_down, w_up):
    B, S, D = h.shape
    TB = PEER_TOK_BLOCK
    nb = S // TB
    hb = h.reshape(B, nb, TB, D).swapaxes(0, 1)

    def body(hblk):
        q = (hblk @ w_q).reshape(B, TB, PEER_HEADS, 2, PEER_DHALF)
        s = jnp.einsum('btphd,phnd->btphn', q, subkeys).astype(jnp.float32)
        v, i = lax.top_k(s, PEER_TOPK)
        cand = (v[..., 0, :, None] + v[..., 1, None, :]).reshape(B, TB, PEER_HEADS, PEER_TOPK * PEER_TOPK)
        cidx = (i[..., 0, :, None] * PEER_NKEYS + i[..., 1, None, :]).reshape(B, TB, PEER_HEADS, PEER_TOPK * PEER_TOPK)
        tv, tj = lax.top_k(cand, PEER_TOPK)
        eidx = jnp.take_along_axis(cidx, tj, axis=-1)
        w = jax.nn.softmax(tv, axis=-1)
        u = w_down[eidx]
        a = jax.nn.gelu(jnp.einsum('btd,btpkd->btpk', hblk, u).astype(jnp.float32))
        vv = w_up[eidx]
        return jnp.einsum('btpk,btpkd->btd', (w * a).astype(hblk.dtype), vv)

    out = lax.map(body, hb)
    return out.swapaxes(0, 1).reshape(B, S, D)


def setup_inputs(seed: int = 0) -> dict:
    key = jax.random.key(seed)
    ks = jax.random.split(key, 24)
    L = DEPTH

    def nrm(k, shape, s):
        return jax.random.normal(k, shape, jnp.float32) * s

    return {
        "x": nrm(ks[0], (BATCH, SEQ, D_MODEL), 1.0),
        "c": nrm(ks[1], (BATCH, D_MODEL), 1.0),
        "w_ada": nrm(ks[2], (L, D_MODEL, 6 * D_MODEL), 0.5 * D_MODEL ** -0.5),
        "b_ada": nrm(ks[3], (L, 6 * D_MODEL), 0.02),
        "g_norm_mix": 1.0 + nrm(ks[4], (L, D_MODEL), 0.02),
        "w_in": nrm(ks[5], (L, D_MODEL, IN_COLS), D_MODEL ** -0.5),
        "pe_cmp_k": nrm(ks[6], (L, CMP_LEN, NSA_DH), 0.1),
        "pe_cmp_v": nrm(ks[7], (L, CMP_LEN, NSA_DH), 0.1),
        "w_cmp_k1": nrm(ks[8], (L, CMP_LEN * NSA_DH, CMP_HID), (CMP_LEN * NSA_DH) ** -0.5),
        "b_cmp_k1": nrm(ks[9], (L, CMP_HID), 0.02),
        "w_cmp_k2": nrm(ks[10], (L, CMP_HID, NSA_DH), CMP_HID ** -0.5),
        "w_cmp_v1": nrm(ks[11], (L, CMP_LEN * NSA_DH, CMP_HID), (CMP_LEN * NSA_DH) ** -0.5),
        "b_cmp_v1": nrm(ks[12], (L, CMP_HID), 0.02),
        "w_cmp_v2": nrm(ks[13], (L, CMP_HID, NSA_DH), CMP_HID ** -0.5),
        "w_out": nrm(ks[14], (L, D_MIX, D_MODEL), D_MIX ** -0.5),
        "g_norm_ffn": 1.0 + nrm(ks[15], (L, D_MODEL), 0.02),
        "w_peer_q": nrm(ks[16], (L, D_MODEL, PEER_HEADS * PEER_DQ), D_MODEL ** -0.5),
        "peer_subkeys": nrm(ks[17], (L, PEER_HEADS, 2, PEER_NKEYS, PEER_DHALF), PEER_DHALF ** -0.5),
        "peer_down": nrm(ks[18], (L, PEER_EXPERTS, D_MODEL), D_MODEL ** -0.5),
        "peer_up": nrm(ks[19], (L, PEER_EXPERTS, D_MODEL), PEER_HEADS ** -0.5),
        "g_norm_final": 1.0 + nrm(ks[20], (D_MODEL,), 0.02),
    }


def reference(x, c, w_ada, b_ada, g_norm_mix, w_in, pe_cmp_k, pe_cmp_v, w_cmp_k1, b_cmp_k1, w_cmp_k2,
              w_cmp_v1, b_cmp_v1, w_cmp_v2, w_out, g_norm_ffn, w_peer_q, peer_subkeys, peer_down, peer_up,
              g_norm_final):
    B, S, D = x.shape
    pos = jnp.arange(S)
    split_points = [int(v) for v in np.cumsum(IN_SPLITS)[:-1]]
    for l in range(DEPTH):
        mod = jax.nn.silu(c) @ w_ada[l] + b_ada[l]
        sh1, sc1, ga1, sh2, sc2, ga2 = jnp.split(mod, 6, axis=-1)
        h = _modulate(_rms_norm(x, g_norm_mix[l]), sh1, sc1)
        proj = h @ w_in[l]
        (r_q, r_k, r_v, r_g, n_q, n_kc, n_vc, n_ks, n_vs, n_kw, n_vw, n_gate) = jnp.split(proj, split_points, axis=-1)
        r_q = _rope(r_q.reshape(B, S, RET_HEADS, RET_DK), pos)
        r_k = _rope(r_k.reshape(B, S, RET_HEADS, RET_DK), pos)
        ret_out = _retention(r_q, r_k, r_v.reshape(B, S, RET_HEADS, RET_DV), r_g.reshape(B, S, RET_HEADS, RET_DV))
        kvshape = (B, S, NSA_KV_GROUPS, NSA_DH)
        nsa_out = _nsa(_rope(n_q.reshape(B, S, NSA_HEADS, NSA_DH), pos),
                       _rope(n_kc.reshape(kvshape), pos), n_vc.reshape(kvshape),
                       _rope(n_ks.reshape(kvshape), pos), n_vs.reshape(kvshape),
                       _rope(n_kw.reshape(kvshape), pos), n_vw.reshape(kvshape),
                       n_gate, pe_cmp_k[l], pe_cmp_v[l], w_cmp_k1[l], b_cmp_k1[l], w_cmp_k2[l],
                       w_cmp_v1[l], b_cmp_v1[l], w_cmp_v2[l])
        mix = jnp.concatenate([ret_out, nsa_out], axis=-1) @ w_out[l]
        x = x + ga1[:, None, :] * mix
        h = _modulate(_rms_norm(x, g_norm_ffn[l]), sh2, sc2)
        x = x + ga2[:, None, :] * _peer(h, w_peer_q[l], peer_subkeys[l], peer_down[l], peer_up[l])
    return _rms_norm(x, g_norm_final)
```

```cpp
#include <hip/hip_runtime.h>
#include <hip/hip_bf16.h>
#include <stdint.h>

typedef unsigned short bf16_t;
#define DI __device__ __forceinline__

DI float bf2f(bf16_t v) { return __uint_as_float(((unsigned)v) << 16); }
DI bf16_t f2bf(float x) { unsigned u = __float_as_uint(x); u += 0x7fffu + ((u >> 16) & 1u); return (bf16_t)(u >> 16); }
DI float gelu_tanh(float x) { float u = 0.7978845608028654f * (x + 0.044715f * x * x * x); return 0.5f * x * (1.f + tanhf(u)); }
DI float siluf(float x) { return x / (1.f + __expf(-x)); }
DI float sigmoidf(float x) { return 1.f / (1.f + __expf(-x)); }

#define T_TOK 16384
#define SEQ 8192
#define DM 1024
#define NPROJ 3456
#define NEG_INF (-__builtin_inff())

struct Params {
  const float *x, *c, *w_ada, *b_ada, *g_mix, *w_in, *pe_k, *pe_v, *w_k1, *b_k1, *w_k2, *w_v1, *b_v1, *w_v2, *w_out, *g_ffn,
      *w_pq, *subkeys, *peer_down, *peer_up, *g_final;
  float* out;
  float* mod;
  unsigned* ksmax;
  float *c128, *s128, *c64, *s64;
  bf16_t *WinT, *WoutT, *WqT, *W1Tk, *W1Tv, *W2Tk, *W2Tv, *SUBK;
  float *B1Pk, *B1Pv;
  bf16_t* RA;
  bf16_t *RQ, *RK, *RKT, *RVT, *RGT, *NQ, *NKC, *NVC, *NKS, *NKW, *NVST, *NVWT;
  float* GATE;
  float* KV;
  bf16_t* SPREV;
  bf16_t *KC, *VCT;
  float* HID;
  bf16_t* PQ;
  int* EIDX;
  float* EW;
};

DI float logg_h(int h) { return log1pf(-exp2f(-5.f - (float)h)); }

__global__ void k_mod(Params p) {
  int j = blockIdx.x * blockDim.x + threadIdx.x;
  if (j >= 6144) return;
  float a0 = 0.f, a1 = 0.f;
  for (int k = 0; k < DM; ++k) {
    float w = p.w_ada[(size_t)k * 6144 + j];
    a0 += siluf(p.c[k]) * w;
    a1 += siluf(p.c[DM + k]) * w;
  }
  p.mod[j] = a0 + p.b_ada[j];
  p.mod[6144 + j] = a1 + p.b_ada[j];
}

DI int win_logical_col(int np) {
  int g = np >> 6, c = np & 63;
  if (g < 16) {
    int sec = g >> 3, hh = (g & 7) >> 1, j = g & 1, i = 32 * j + (c & 31);
    return sec * 512 + hh * 128 + ((c < 32) ? i : 64 + i);
  } else if (g < 52) return 1024 + (g - 16) * 64 + c;
  else if (g == 52) return (c < 24) ? 3328 + c : -1;
  return -1;
}

__global__ void k_transpose(const float* in, bf16_t* out, int K, int N_in, int N_out, int mode) {
  size_t idx = (size_t)blockIdx.x * blockDim.x + threadIdx.x;
  if (idx >= (size_t)K * N_out) return;
  int n = (int)(idx / K), k = (int)(idx % K);
  int col = mode ? win_logical_col(n) : n;
  float v = (col >= 0) ? in[(size_t)k * N_in + col] : 0.f;
  out[idx] = f2bf(v);
}
__global__ void k_convert(const float* in, bf16_t* out, size_t n) {
  size_t idx = (size_t)blockIdx.x * blockDim.x + threadIdx.x;
  if (idx < n) out[idx] = f2bf(in[idx]);
}
__global__ void k_rope_tables(Params p) {
  int idx = blockIdx.x * blockDim.x + threadIdx.x;
  if (idx < SEQ * 64) {
    int s = idx >> 6, i = idx & 63;
    float inv = powf(10000.f, -(float)(2 * i) / 128.f);
    float ang = (float)s * inv;
    p.c128[idx] = cosf(ang); p.s128[idx] = sinf(ang);
  }
  if (idx < SEQ * 32) {
    int s = idx >> 5, i = idx & 31;
    float inv = powf(10000.f, -(float)(2 * i) / 64.f);
    float ang = (float)s * inv;
    p.c64[idx] = cosf(ang); p.s64[idx] = sinf(ang);
  }
}
__global__ void k_b1p(Params p) {
  int idx = blockIdx.x * blockDim.x + threadIdx.x;
  if (idx >= 512) return;
  int kv = idx >> 8, j = idx & 255;
  const float* w1 = kv ? p.w_v1 : p.w_k1; const float* pe = kv ? p.pe_v : p.pe_k; const float* b1 = kv ? p.b_v1 : p.b_k1;
  float a = b1[j];
  for (int f = 0; f < 2048; ++f) a += pe[f] * w1[(size_t)f * 256 + j];
  (kv ? p.B1Pv : p.B1Pk)[j] = a;
}

__global__ void k_rownorm(const float* src, const float* g, const float* mod, int sh_off, int sc_off, bf16_t* dst) {
  int row = blockIdx.x * 4 + (threadIdx.x >> 6), lane = threadIdx.x & 63;
  int b = row >> 13;
  const float* xr = src + (size_t)row * DM;
  float v[16]; float ss = 0.f;
#pragma unroll
  for (int i = 0; i < 4; ++i) {
    float4 t = *(const float4*)(xr + i * 256 + lane * 4);
    v[i * 4 + 0] = t.x; v[i * 4 + 1] = t.y; v[i * 4 + 2] = t.z; v[i * 4 + 3] = t.w;
    ss += t.x * t.x + t.y * t.y + t.z * t.z + t.w * t.w;
  }
  for (int o = 32; o; o >>= 1) ss += __shfl_xor(ss, o);
  float rstd = rsqrtf(ss * (1.f / DM) + 1e-6f);
  const float* sh = mod + b * 6144 + sh_off; const float* sc = mod + b * 6144 + sc_off;
#pragma unroll
  for (int i = 0; i < 4; ++i)
#pragma unroll
    for (int e = 0; e < 4; ++e) {
      int col = i * 256 + lane * 4 + e;
      float y = v[i * 4 + e] * rstd * g[col];
      y = y * (1.f + sc[col]) + sh[col];
      dst[(size_t)row * DM + col] = f2bf(y);
    }
}

template <class Epi>
__global__ void __launch_bounds__(256) k_gemm_naive(const bf16_t* A, const bf16_t* Bt, int K, Epi epi) {
  __shared__ float As[32][65];
  __shared__ float Bs[32][65];
  int m0 = blockIdx.y * 64, n0 = blockIdx.x * 64;
  int tid = threadIdx.x, ty = tid >> 4, tx = tid & 15;
  float acc[4][4] = {};
  int lr = tid >> 2, lk = (tid & 3) * 8;
  for (int k0 = 0; k0 < K; k0 += 32) {
    uint4 av = *(const uint4*)(A + (size_t)(m0 + lr) * K + k0 + lk);
    uint4 bv = *(const uint4*)(Bt + (size_t)(n0 + lr) * K + k0 + lk);
    const bf16_t* ap = (const bf16_t*)&av; const bf16_t* bp = (const bf16_t*)&bv;
#pragma unroll
    for (int e = 0; e < 8; ++e) { As[lk + e][lr] = bf2f(ap[e]); Bs[lk + e][lr] = bf2f(bp[e]); }
    __syncthreads();
#pragma unroll 8
    for (int k = 0; k < 32; ++k) {
      float a[4], b[4];
#pragma unroll
      for (int i = 0; i < 4; ++i) { a[i] = As[k][ty + 16 * i]; b[i] = Bs[k][tx + 16 * i]; }
#pragma unroll
      for (int i = 0; i < 4; ++i)
#pragma unroll
        for (int j = 0; j < 4; ++j) acc[i][j] += a[i] * b[j];
    }
    __syncthreads();
  }
  int G = blockIdx.x;
#pragma unroll
  for (int i = 0; i < 4; ++i) {
    int row = m0 + ty + 16 * i;
    epi(row, G, tx, acc[i][0], acc[i][2]);
    epi(row, G, tx + 16, acc[i][1], acc[i][3]);
  }
}

struct EpiProj {
  Params p;
  DI void operator()(int t, int G, int c, float vlo, float vhi) const {
    int b = t >> 13, s = t & 8191;
    if (G < 16) {
      int sec = G >> 3, hh = (G & 7) >> 1, j = G & 1, i = 32 * j + c;
      float cs = p.c128[s * 64 + i], sn = p.s128[s * 64 + i];
      float o1 = vlo * cs - vhi * sn, o2 = vhi * cs + vlo * sn;
      if (sec == 0) {
        p.RQ[(size_t)t * 512 + hh * 128 + i] = f2bf(o1);
        p.RQ[(size_t)t * 512 + hh * 128 + 64 + i] = f2bf(o2);
      } else {
        const float sc = 0.08838834764831845f;
        o1 *= sc; o2 *= sc;
        p.RK[(size_t)t * 512 + hh * 128 + i] = f2bf(o1);
        p.RK[(size_t)t * 512 + hh * 128 + 64 + i] = f2bf(o2);
        float zeta = __expf((float)(127 - (s & 127)) * logg_h(hh));
        p.RKT[((size_t)(b * 4 + hh) * 128 + i) * SEQ + s] = f2bf(o1 * zeta);
        p.RKT[((size_t)(b * 4 + hh) * 128 + 64 + i) * SEQ + s] = f2bf(o2 * zeta);
      }
    } else if (G < 24) {
      int hh = (G - 16) >> 1, d = ((G - 16) & 1) * 64 + c;
      p.RVT[((size_t)(b * 4 + hh) * 128 + d) * SEQ + s] = f2bf(vlo);
      p.RVT[((size_t)(b * 4 + hh) * 128 + d + 32) * SEQ + s] = f2bf(vhi);
    } else if (G < 32) {
      int hh = (G - 24) >> 1, d = ((G - 24) & 1) * 64 + c;
      p.RGT[((size_t)(b * 4 + hh) * 128 + d) * SEQ + s] = f2bf(siluf(vlo));
      p.RGT[((size_t)(b * 4 + hh) * 128 + d + 32) * SEQ + s] = f2bf(siluf(vhi));
    } else if (G < 40) {
      int head = G - 32;
      float cs = p.c64[s * 32 + c], sn = p.s64[s * 32 + c];
      float o1 = (vlo * cs - vhi * sn) * 0.125f, o2 = (vhi * cs + vlo * sn) * 0.125f;
      p.NQ[(size_t)t * 512 + head * 64 + c] = f2bf(o1);
      p.NQ[(size_t)t * 512 + head * 64 + 32 + c] = f2bf(o2);
    } else if (G < 52) {
      int k = G - 40, kind = k >> 1, gg = k & 1;
      float o1 = vlo, o2 = vhi;
      if ((kind & 1) == 0) {
        float cs = p.c64[s * 32 + c], sn = p.s64[s * 32 + c];
        o1 = vlo * cs - vhi * sn; o2 = vhi * cs + vlo * sn;
      }
      bf16_t b1 = f2bf(o1), b2 = f2bf(o2);
      size_t ro = (size_t)t * 128 + gg * 64 + c;
      size_t to = ((size_t)(b * 2 + gg) * 64 + c) * SEQ + s;
      switch (kind) {
        case 0: p.NKC[ro] = b1; p.NKC[ro + 32] = b2; break;
        case 1: p.NVC[ro] = b1; p.NVC[ro + 32] = b2; break;
        case 2: p.NKS[ro] = b1; p.NKS[ro + 32] = b2; break;
        case 3: p.NVST[to] = b1; p.NVST[to + (size_t)32 * SEQ] = b2; break;
        case 4: p.NKW[ro] = b1; p.NKW[ro + 32] = b2; break;
        default: p.NVWT[to] = b1; p.NVWT[to + (size_t)32 * SEQ] = b2; break;
      }
    } else if (G == 52) {
      if (c < 24) p.GATE[(size_t)t * 24 + c] = sigmoidf(vlo);
    }
  }
};

struct EpiOut {
  Params p;
  DI void operator()(int t, int G, int c, float vlo, float vhi) const {
    int b = t >> 13;
    int c0 = G * 64 + c, c1 = c0 + 32;
    const float* ga1 = p.mod + b * 6144 + 2048;
    p.out[(size_t)t * DM + c0] = p.x[(size_t)t * DM + c0] + ga1[c0] * vlo;
    p.out[(size_t)t * DM + c1] = p.x[(size_t)t * DM + c1] + ga1[c1] * vhi;
  }
};
struct EpiPQ {
  Params p;
  DI void operator()(int t, int G, int c, float vlo, float vhi) const {
    p.PQ[(size_t)t * 2048 + G * 64 + c] = f2bf(vlo);
    p.PQ[(size_t)t * 2048 + G * 64 + 32 + c] = f2bf(vhi);
  }
};

__global__ void k_retkv(Params p) {
  size_t idx = (size_t)blockIdx.x * blockDim.x + threadIdx.x;
  int item = (int)(idx >> 14), v = (int)((idx >> 7) & 127), k = (int)(idx & 127);
  int h = item & 3, c = (item >> 2) & 63, b = item >> 8;
  const bf16_t* vp = p.RVT + ((size_t)(b * 4 + h) * 128 + v) * SEQ + c * 128;
  const bf16_t* kp = p.RKT + ((size_t)(b * 4 + h) * 128 + k) * SEQ + c * 128;
  float a = 0.f;
  for (int m = 0; m < 128; ++m) a += bf2f(vp[m]) * bf2f(kp[m]);
  p.KV[idx] = a;
}
__global__ void k_scan(Params p) {
  int idx = blockIdx.x * blockDim.x + threadIdx.x;
  int e = idx & 16383, bh = idx >> 14, b = bh >> 2, h = bh & 3;
  float cd = __expf(128.f * logg_h(h));
  float S = 0.f;
  for (int c = 0; c < 64; ++c) {
    size_t o = (size_t)((b * 64 + c) * 4 + h) * 16384 + e;
    p.SPREV[o] = f2bf(S);
    S = cd * S + p.KV[o];
  }
}
__global__ void __launch_bounds__(256) k_retout(Params p) {
  extern __shared__ float sm[];
  float* Ssc = sm;
  float* Y = sm + 128 * 129;
  int item = blockIdx.x, h = item & 3, c = (item >> 2) & 63, b = item >> 8;
  int t0 = b * SEQ + c * 128, s0 = c * 128;
  float lg = logg_h(h);
  for (int idx = threadIdx.x; idx < 16384; idx += 256) {
    int n = idx >> 7, m = idx & 127;
    float a = 0.f;
    if (m <= n) {
      const bf16_t* q = p.RQ + (size_t)(t0 + n) * 512 + h * 128;
      const bf16_t* k = p.RK + (size_t)(t0 + m) * 512 + h * 128;
      for (int kk = 0; kk < 128; ++kk) a += bf2f(q[kk]) * bf2f(k[kk]);
      a *= __expf((float)(n - m) * lg);
    }
    Ssc[n * 129 + m] = a;
  }
  __syncthreads();
  for (int idx = threadIdx.x; idx < 16384; idx += 256) {
    int n = idx >> 7, v = idx & 127;
    const bf16_t* vp = p.RVT + ((size_t)(b * 4 + h) * 128 + v) * SEQ + s0;
    float inner = 0.f;
    for (int m = 0; m <= n; ++m) inner += Ssc[n * 129 + m] * bf2f(vp[m]);
    const bf16_t* q = p.RQ + (size_t)(t0 + n) * 512 + h * 128;
    const bf16_t* sp = p.SPREV + (size_t)item * 16384 + v * 128;
    float cr = 0.f;
    for (int kk = 0; kk < 128; ++kk) cr += bf2f(q[kk]) * bf2f(sp[kk]);
    Y[n * 129 + v] = inner + __expf((float)(n + 1) * lg) * cr;
  }
  __syncthreads();
  if (threadIdx.x < 128) {
    int n = threadIdx.x;
    float mu = 0.f;
    for (int v = 0; v < 128; ++v) mu += Y[n * 129 + v];
    mu *= (1.f / 128.f);
    float var = 0.f;
    for (int v = 0; v < 128; ++v) { float d = Y[n * 129 + v] - mu; var += d * d; }
    var *= (1.f / 128.f);
    float rs = rsqrtf(var + 1e-6f);
    for (int v = 0; v < 128; ++v) {
      float g = bf2f(p.RGT[((size_t)(b * 4 + h) * 128 + v) * SEQ + s0 + n]);
      p.RA[(size_t)(t0 + n) * DM + h * 128 + v] = f2bf((Y[n * 129 + v] - mu) * rs * g);
    }
  }
}

__global__ void k_cmp1(Params p) {
  int idx = blockIdx.x * blockDim.x + threadIdx.x;
  int j = idx & 255, r = (idx >> 8) & 2047, kv = idx >> 19;
  if (r >= 2044) return;
  int g = r & 1, n = (r >> 1) % 511, b = (r >> 1) / 511;
  const bf16_t* src = (kv ? p.NVC : p.NKC) + ((size_t)(b * SEQ + 16 * n)) * 128 + g * 64;
  const bf16_t* w = (kv ? p.W1Tv : p.W1Tk) + (size_t)j * 2048;
  float a = 0.f;
  for (int l = 0; l < 32; ++l)
    for (int d = 0; d < 64; ++d) a += bf2f(src[l * 128 + d]) * bf2f(w[l * 64 + d]);
  a += (kv ? p.B1Pv : p.B1Pk)[j];
  p.HID[((size_t)kv * 2048 + r) * 256 + j] = gelu_tanh(a);
}
__global__ void k_cmp2(Params p) {
  int idx = blockIdx.x * blockDim.x + threadIdx.x;
  int e = idx & 63, r = (idx >> 6) & 2047, kv = idx >> 17;
  if (r >= 2044) {
    int bg = r - 2044;
    if (kv == 0) p.KC[((size_t)bg * 512 + 511) * 64 + e] = 0;
    else p.VCT[((size_t)bg * 64 + e) * 512 + 511] = 0;
    return;
  }
  int g = r & 1, n = (r >> 1) % 511, b = (r >> 1) / 511;
  const float* hid = p.HID + ((size_t)kv * 2048 + r) * 256;
  const bf16_t* w = (kv ? p.W2Tv : p.W2Tk) + e * 256;
  float a = 0.f;
  for (int j = 0; j < 256; ++j) a += hid[j] * bf2f(w[j]);
  if (kv == 0) p.KC[((size_t)(b * 2 + g) * 512 + n) * 64 + e] = f2bf(a);
  else p.VCT[((size_t)(b * 2 + g) * 64 + e) * 512 + n] = f2bf(a);
}
__global__ void k_ksmax(Params p) {
  int idx = blockIdx.x * blockDim.x + threadIdx.x;
  int g = idx & 1, t = idx >> 1, b = t >> 13;
  const bf16_t* k = p.NKS + (size_t)t * 128 + g * 64;
  float ss = 0.f;
  for (int d = 0; d < 64; ++d) { float v = bf2f(k[d]); ss += v * v; }
  atomicMax(&p.ksmax[b * 2 + g], __float_as_uint(sqrtf(ss)));
}

__global__ void __launch_bounds__(256) k_nsa_naive(Params p) {
  extern __shared__ float sm[];
  float* qs = sm;
  float* P = sm + 1024;
  float* IMP = P + 16 * 1024;
  int* SEL = (int*)(IMP + 512);
  int* NSEL = SEL + 64;
  int blk = blockIdx.x;
  int g = blk & 1, tq = blk >> 1;
  int tok0 = tq * 4, b = tok0 >> 13, s0 = tok0 & 8191;
  int bg = b * 2 + g;
  int tid = threadIdx.x, th = tid >> 4, sub = tid & 15, token = th >> 2, hh = th & 3;
  int t = s0 + token;
  for (int i = tid; i < 1024; i += 256) {
    int r = i >> 6, d = i & 63;
    qs[i] = bf2f(p.NQ[(size_t)(tok0 + (r >> 2)) * 512 + (g * 4 + (r & 3)) * 64 + d]);
  }
  __syncthreads();
  const float* q = qs + th * 64;
  float* Pr = P + th * 1024;
  int nvalid = (t >= 31) ? ((t - 31) / 16 + 1) : 0;
  if (nvalid > 511) nvalid = 511;
  float mx = NEG_INF;
  for (int n = sub; n < 512; n += 16) {
    float sc = NEG_INF;
    if (n < nvalid) {
      const bf16_t* k = p.KC + ((size_t)bg * 512 + n) * 64;
      float a = 0.f;
      for (int d = 0; d < 64; ++d) a += q[d] * bf2f(k[d]);
      sc = a;
    }
    Pr[n] = sc; mx = fmaxf(mx, sc);
  }
  for (int o = 8; o; o >>= 1) mx = fmaxf(mx, __shfl_xor(mx, o));
  float mm = (mx == NEG_INF) ? 0.f : mx;
  float l = 0.f;
  for (int n = sub; n < 512; n += 16) { float e = (n < nvalid) ? __expf(Pr[n] - mm) : 0.f; Pr[n] = e; l += e; }
  for (int o = 8; o; o >>= 1) l += __shfl_xor(l, o);
  float inv = 1.f / fmaxf(l, 1.17549435e-38f);
  for (int n = sub; n < 512; n += 16) Pr[n] *= inv;
  __syncthreads();
  float oc[4] = {0, 0, 0, 0};
#pragma unroll
  for (int e = 0; e < 4; ++e) {
    int d = sub * 4 + e;
    const bf16_t* v = p.VCT + ((size_t)bg * 64 + d) * 512;
    float a = 0.f;
    for (int n = 0; n < nvalid; ++n) a += Pr[n] * bf2f(v[n]);
    oc[e] = a;
  }
  for (int i = tid; i < 512; i += 256) {
    int tk = i >> 7, j = i & 127;
    int tt = s0 + tk, cur = tt >> 6;
    float a = 0.f;
    for (int h2 = 0; h2 < 4; ++h2) {
      const float* pp = P + (tk * 4 + h2) * 1024;
      a += 2.f * (pp[4 * j] + pp[4 * j + 1] + pp[4 * j + 2]) + pp[4 * j + 3] + (j > 0 ? pp[4 * j - 1] : 0.f);
    }
    if (j == 0 || j == cur || j == cur - 1) a = 1e9f;
    if (j > cur) a = NEG_INF;
    IMP[i] = a;
  }
  __syncthreads();
  if (tid < 4) {
    int cnt = 0;
    for (int k = 0; k < 16; ++k) {
      float best = NEG_INF; int bj = -1;
      for (int j = 0; j < 128; ++j) { float v = IMP[tid * 128 + j]; if (v > best) { best = v; bj = j; } }
      if (bj < 0) break;
      SEL[tid * 16 + cnt] = bj; ++cnt; IMP[tid * 128 + bj] = NEG_INF;
    }
    NSEL[tid] = cnt;
  }
  __syncthreads();
  float os[4] = {0, 0, 0, 0};
  {
    int nk = NSEL[token] * 64;
    mx = NEG_INF;
    for (int ki = sub; ki < nk; ki += 16) {
      int pos = SEL[token * 16 + (ki >> 6)] * 64 + (ki & 63);
      float sc = NEG_INF;
      if (pos <= t) {
        const bf16_t* k = p.NKS + ((size_t)(b * SEQ + pos)) * 128 + g * 64;
        float a = 0.f;
        for (int d = 0; d < 64; ++d) a += q[d] * bf2f(k[d]);
        sc = a;
      }
      Pr[ki] = sc; mx = fmaxf(mx, sc);
    }
    for (int o = 8; o; o >>= 1) mx = fmaxf(mx, __shfl_xor(mx, o));
    mm = (mx == NEG_INF) ? 0.f : mx;
    l = 0.f;
    for (int ki = sub; ki < nk; ki += 16) { float sc = Pr[ki]; float e = (sc == NEG_INF) ? 0.f : __expf(sc - mm); Pr[ki] = e; l += e; }
    for (int o = 8; o; o >>= 1) l += __shfl_xor(l, o);
    inv = 1.f / fmaxf(l, 1.17549435e-38f);
    __syncthreads();
#pragma unroll
    for (int e = 0; e < 4; ++e) {
      int d = sub * 4 + e;
      const bf16_t* v = p.NVST + ((size_t)bg * 64 + d) * SEQ;
      float a = 0.f;
      for (int ki = 0; ki < nk; ++ki) {
        int pos = SEL[token * 16 + (ki >> 6)] * 64 + (ki & 63);
        a += Pr[ki] * bf2f(v[pos]);
      }
      os[e] = a * inv;
    }
    __syncthreads();
  }
  float ow[4] = {0, 0, 0, 0};
  {
    int lo = t - 511; if (lo < 0) lo = 0;
    int nk = t - lo + 1;
    mx = NEG_INF;
    for (int ki = sub; ki < nk; ki += 16) {
      int pos = lo + ki;
      const bf16_t* k = p.NKW + ((size_t)(b * SEQ + pos)) * 128 + g * 64;
      float a = 0.f;
      for (int d = 0; d < 64; ++d) a += q[d] * bf2f(k[d]);
      Pr[ki] = a; mx = fmaxf(mx, a);
    }
    for (int o = 8; o; o >>= 1) mx = fmaxf(mx, __shfl_xor(mx, o));
    l = 0.f;
    for (int ki = sub; ki < nk; ki += 16) { float e = __expf(Pr[ki] - mx); Pr[ki] = e; l += e; }
    for (int o = 8; o; o >>= 1) l += __shfl_xor(l, o);
    inv = 1.f / l;
    __syncthreads();
#pragma unroll
    for (int e = 0; e < 4; ++e) {
      int d = sub * 4 + e;
      const bf16_t* v = p.NVWT + ((size_t)bg * 64 + d) * SEQ + lo;
      float a = 0.f;
      for (int ki = 0; ki < nk; ++ki) a += Pr[ki] * bf2f(v[ki]);
      ow[e] = a * inv;
    }
  }
  const float* gt = p.GATE + (size_t)(tok0 + token) * 24 + (g * 4 + hh) * 3;
  float g0 = gt[0], g1 = gt[1], g2 = gt[2];
#pragma unroll
  for (int e = 0; e < 4; ++e) {
    int d = sub * 4 + e;
    p.RA[(size_t)(tok0 + token) * DM + 512 + (g * 4 + hh) * 64 + d] = f2bf(g0 * oc[e] + g1 * os[e] + g2 * ow[e]);
  }
}

__global__ void __launch_bounds__(256) k_peer_topk(Params p) {
  __shared__ float qrow[2048];
  __shared__ float sc[16 * 128];
  __shared__ float tv[16 * 16];
  __shared__ int ti[16 * 16];
  __shared__ float cand[8 * 256];
  __shared__ float tv2[8 * 16];
  __shared__ int te2[8 * 16];
  int t = blockIdx.x, tid = threadIdx.x;
  for (int i = tid; i < 2048; i += 256) qrow[i] = bf2f(p.PQ[(size_t)t * 2048 + i]);
  __syncthreads();
  for (int i = tid; i < 2048; i += 256) {
    int ph = i >> 7;
    const bf16_t* k = p.SUBK + (size_t)i * 128;
    const float* q = qrow + ph * 128;
    float a = 0.f;
    for (int d = 0; d < 128; ++d) a += q[d] * bf2f(k[d]);
    sc[i] = a;
  }
  __syncthreads();
  if (tid < 16) {
    for (int k = 0; k < 16; ++k) {
      float best = NEG_INF; int bj = 0;
      for (int j = 0; j < 128; ++j) { float v = sc[tid * 128 + j]; if (v > best) { best = v; bj = j; } }
      tv[tid * 16 + k] = best; ti[tid * 16 + k] = bj; sc[tid * 128 + bj] = NEG_INF;
    }
  }
  __syncthreads();
  for (int i = tid; i < 2048; i += 256) {
    int pp = i >> 8, ii = (i >> 4) & 15, jj = i & 15;
    cand[i] = tv[(2 * pp) * 16 + ii] + tv[(2 * pp + 1) * 16 + jj];
  }
  __syncthreads();
  if (tid < 8) {
    for (int k = 0; k < 16; ++k) {
      float best = NEG_INF; int bj = 0;
      for (int j = 0; j < 256; ++j) { float v = cand[tid * 256 + j]; if (v > best) { best = v; bj = j; } }
      cand[tid * 256 + bj] = NEG_INF;
      tv2[tid * 16 + k] = best; te2[tid * 16 + k] = ti[(2 * tid) * 16 + (bj >> 4)] * 128 + ti[(2 * tid + 1) * 16 + (bj & 15)];
    }
    float m = tv2[tid * 16], l = 0.f;
    for (int k = 0; k < 16; ++k) { float e = __expf(tv2[tid * 16 + k] - m); tv2[tid * 16 + k] = e; l += e; }
    for (int k = 0; k < 16; ++k) { p.EIDX[(size_t)t * 128 + tid * 16 + k] = te2[tid * 16 + k]; p.EW[(size_t)t * 128 + tid * 16 + k] = tv2[tid * 16 + k] / l; }
  }
}
__global__ void __launch_bounds__(256) k_peer_gather(Params p) {
  __shared__ float red[4];
  __shared__ float hrow[1024];
  int t = blockIdx.x, tid = threadIdx.x, b = t >> 13;
  for (int i = tid; i < 1024; i += 256) hrow[i] = bf2f(p.RA[(size_t)t * DM + i]);
  __syncthreads();
  float4 hv = *(float4*)(hrow + tid * 4);
  float acc[4] = {0, 0, 0, 0};
  for (int e = 0; e < 128; ++e) {
    int idx = p.EIDX[(size_t)t * 128 + e];
    float w = p.EW[(size_t)t * 128 + e];
    float4 u = *(const float4*)(p.peer_down + (size_t)idx * DM + tid * 4);
    float d = hv.x * u.x + hv.y * u.y + hv.z * u.z + hv.w * u.w;
    for (int o = 32; o; o >>= 1) d += __shfl_xor(d, o);
    if ((tid & 63) == 0) red[tid >> 6] = d;
    __syncthreads();
    float dot = red[0] + red[1] + red[2] + red[3];
    __syncthreads();
    float cf = w * gelu_tanh(dot);
    float4 v = *(const float4*)(p.peer_up + (size_t)idx * DM + tid * 4);
    acc[0] += cf * v.x; acc[1] += cf * v.y; acc[2] += cf * v.z; acc[3] += cf * v.w;
  }
  const float* ga2 = p.mod + b * 6144 + 5120;
  float4 x1 = *(float4*)(p.out + (size_t)t * DM + tid * 4);
  float y[4];
  y[0] = x1.x + ga2[tid * 4 + 0] * acc[0]; y[1] = x1.y + ga2[tid * 4 + 1] * acc[1];
  y[2] = x1.z + ga2[tid * 4 + 2] * acc[2]; y[3] = x1.w + ga2[tid * 4 + 3] * acc[3];
  float ss = y[0] * y[0] + y[1] * y[1] + y[2] * y[2] + y[3] * y[3];
  for (int o = 32; o; o >>= 1) ss += __shfl_xor(ss, o);
  __syncthreads();
  if ((tid & 63) == 0) red[tid >> 6] = ss;
  __syncthreads();
  float tot = red[0] + red[1] + red[2] + red[3];
  float rstd = rsqrtf(tot * (1.f / DM) + 1e-6f);
  float4 o4;
  o4.x = y[0] * rstd * p.g_final[tid * 4 + 0]; o4.y = y[1] * rstd * p.g_final[tid * 4 + 1];
  o4.z = y[2] * rstd * p.g_final[tid * 4 + 2]; o4.w = y[3] * rstd * p.g_final[tid * 4 + 3];
  *(float4*)(p.out + (size_t)t * DM + tid * 4) = o4;
}

static size_t carve(size_t& off, size_t bytes) { size_t o = off; off += (bytes + 255) & ~(size_t)255; return o; }

extern "C" void kernel_launch(void* const* d_in, const int* in_sizes, int n_in, void* d_out, int out_size, void* d_ws, size_t ws_size,
                              hipStream_t stream) {
  Params p{};
  p.x = (const float*)d_in[0]; p.c = (const float*)d_in[1]; p.w_ada = (const float*)d_in[2]; p.b_ada = (const float*)d_in[3];
  p.g_mix = (const float*)d_in[4]; p.w_in = (const float*)d_in[5]; p.pe_k = (const float*)d_in[6]; p.pe_v = (const float*)d_in[7];
  p.w_k1 = (const float*)d_in[8]; p.b_k1 = (const float*)d_in[9]; p.w_k2 = (const float*)d_in[10]; p.w_v1 = (const float*)d_in[11];
  p.b_v1 = (const float*)d_in[12]; p.w_v2 = (const float*)d_in[13]; p.w_out = (const float*)d_in[14]; p.g_ffn = (const float*)d_in[15];
  p.w_pq = (const float*)d_in[16]; p.subkeys = (const float*)d_in[17]; p.peer_down = (const float*)d_in[18]; p.peer_up = (const float*)d_in[19];
  p.g_final = (const float*)d_in[20];
  p.out = (float*)d_out;
  char* ws = (char*)d_ws;
  size_t off = 0;
  p.mod = (float*)(ws + carve(off, 2 * 6144 * 4));
  p.ksmax = (unsigned*)(ws + carve(off, 256));
  p.c128 = (float*)(ws + carve(off, (size_t)SEQ * 64 * 4)); p.s128 = (float*)(ws + carve(off, (size_t)SEQ * 64 * 4));
  p.c64 = (float*)(ws + carve(off, (size_t)SEQ * 32 * 4)); p.s64 = (float*)(ws + carve(off, (size_t)SEQ * 32 * 4));
  p.WinT = (bf16_t*)(ws + carve(off, (size_t)NPROJ * 1024 * 2));
  p.WoutT = (bf16_t*)(ws + carve(off, (size_t)1024 * 1024 * 2));
  p.WqT = (bf16_t*)(ws + carve(off, (size_t)2048 * 1024 * 2));
  p.W1Tk = (bf16_t*)(ws + carve(off, (size_t)256 * 2048 * 2)); p.W1Tv = (bf16_t*)(ws + carve(off, (size_t)256 * 2048 * 2));
  p.W2Tk = (bf16_t*)(ws + carve(off, 64 * 256 * 2)); p.W2Tv = (bf16_t*)(ws + carve(off, 64 * 256 * 2));
  p.SUBK = (bf16_t*)(ws + carve(off, (size_t)16 * 128 * 128 * 2));
  p.B1Pk = (float*)(ws + carve(off, 1024)); p.B1Pv = (float*)(ws + carve(off, 1024));
  p.RA = (bf16_t*)(ws + carve(off, (size_t)T_TOK * 1024 * 2));
  size_t rb = off;
  p.RQ = (bf16_t*)(ws + carve(off, (size_t)T_TOK * 512 * 2)); p.RK = (bf16_t*)(ws + carve(off, (size_t)T_TOK * 512 * 2));
  p.RKT = (bf16_t*)(ws + carve(off, (size_t)T_TOK * 512 * 2)); p.RVT = (bf16_t*)(ws + carve(off, (size_t)T_TOK * 512 * 2));
  p.RGT = (bf16_t*)(ws + carve(off, (size_t)T_TOK * 512 * 2)); p.NQ = (bf16_t*)(ws + carve(off, (size_t)T_TOK * 512 * 2));
  p.NKC = (bf16_t*)(ws + carve(off, (size_t)T_TOK * 128 * 2)); p.NVC = (bf16_t*)(ws + carve(off, (size_t)T_TOK * 128 * 2));
  p.NKS = (bf16_t*)(ws + carve(off, (size_t)T_TOK * 128 * 2)); p.NKW = (bf16_t*)(ws + carve(off, (size_t)T_TOK * 128 * 2));
  p.NVST = (bf16_t*)(ws + carve(off, (size_t)T_TOK * 128 * 2)); p.NVWT = (bf16_t*)(ws + carve(off, (size_t)T_TOK * 128 * 2));
  p.GATE = (float*)(ws + carve(off, (size_t)T_TOK * 24 * 4));
  p.KV = (float*)(ws + carve(off, (size_t)512 * 16384 * 4));
  p.SPREV = (bf16_t*)(ws + carve(off, (size_t)512 * 16384 * 2));
  p.KC = (bf16_t*)(ws + carve(off, (size_t)4 * 512 * 64 * 2)); p.VCT = (bf16_t*)(ws + carve(off, (size_t)4 * 512 * 64 * 2));
  p.HID = (float*)(ws + carve(off, (size_t)2 * 2048 * 256 * 4));
  size_t off2 = rb;
  p.PQ = (bf16_t*)(ws + carve(off2, (size_t)T_TOK * 2048 * 2));
  p.EIDX = (int*)(ws + carve(off2, (size_t)T_TOK * 128 * 4));
  p.EW = (float*)(ws + carve(off2, (size_t)T_TOK * 128 * 4));
  (void)ws_size; (void)in_sizes; (void)n_in; (void)out_size;

  hipMemsetAsync(p.ksmax, 0, 256, stream);
  k_mod<<<24, 256, 0, stream>>>(p);
  k_transpose<<<(NPROJ * 1024 + 255) / 256, 256, 0, stream>>>(p.w_in, p.WinT, 1024, 3352, NPROJ, 1);
  k_transpose<<<(1024 * 1024) / 256, 256, 0, stream>>>(p.w_out, p.WoutT, 1024, 1024, 1024, 0);
  k_transpose<<<(2048 * 1024) / 256, 256, 0, stream>>>(p.w_pq, p.WqT, 1024, 2048, 2048, 0);
  k_transpose<<<(256 * 2048) / 256, 256, 0, stream>>>(p.w_k1, p.W1Tk, 2048, 256, 256, 0);
  k_transpose<<<(256 * 2048) / 256, 256, 0, stream>>>(p.w_v1, p.W1Tv, 2048, 256, 256, 0);
  k_transpose<<<(64 * 256) / 256, 256, 0, stream>>>(p.w_k2, p.W2Tk, 256, 64, 64, 0);
  k_transpose<<<(64 * 256) / 256, 256, 0, stream>>>(p.w_v2, p.W2Tv, 256, 64, 64, 0);
  k_convert<<<(16 * 128 * 128) / 256, 256, 0, stream>>>(p.subkeys, p.SUBK, (size_t)16 * 128 * 128);
  k_rope_tables<<<(SEQ * 64) / 256, 256, 0, stream>>>(p);
  k_b1p<<<2, 256, 0, stream>>>(p);
  k_rownorm<<<T_TOK / 4, 256, 0, stream>>>(p.x, p.g_mix, p.mod, 0, 1024, p.RA);
  { EpiProj e{p}; k_gemm_naive<<<dim3(NPROJ / 64, T_TOK / 64), 256, 0, stream>>>(p.RA, p.WinT, 1024, e); }
  k_retkv<<<(512 * 16384) / 256, 256, 0, stream>>>(p);
  k_cmp1<<<(2 * 2048 * 256) / 256, 256, 0, stream>>>(p);
  k_cmp2<<<(2 * 2048 * 64) / 256, 256, 0, stream>>>(p);
  k_ksmax<<<(T_TOK * 2) / 256, 256, 0, stream>>>(p);
  k_scan<<<(8 * 16384) / 256, 256, 0, stream>>>(p);
  hipFuncSetAttribute((const void*)k_retout, hipFuncAttributeMaxDynamicSharedMemorySize, 2 * 128 * 129 * 4);
  k_retout<<<512, 256, 2 * 128 * 129 * 4, stream>>>(p);
  hipFuncSetAttribute((const void*)k_nsa_naive, hipFuncAttributeMaxDynamicSharedMemorySize, (1024 + 16 * 1024 + 512 + 64 + 16) * 4);
  k_nsa_naive<<<8192, 256, (1024 + 16 * 1024 + 512 + 64 + 16) * 4, stream>>>(p);
  { EpiOut e{p}; k_gemm_naive<<<dim3(1024 / 64, T_TOK / 64), 256, 0, stream>>>(p.RA, p.WoutT, 1024, e); }
  k_rownorm<<<T_TOK / 4, 256, 0, stream>>>(p.out, p.g_ffn, p.mod, 3072, 4096, p.RA);
  { EpiPQ e{p}; k_gemm_naive<<<dim3(2048 / 64, T_TOK / 64), 256, 0, stream>>>(p.RA, p.WqT, 1024, e); }
  k_peer_topk<<<T_TOK, 256, 0, stream>>>(p);
  k_peer_gather<<<T_TOK, 256, 0, stream>>>(p);
}
```

```cpp
#include <hip/hip_runtime.h>
#include <hip/hip_bf16.h>
#include <hip/hip_cooperative_groups.h>
#include <stdint.h>
#include <stdio.h>
namespace cg = cooperative_groups;

typedef unsigned short bf16_t;
#define DI __device__ __forceinline__

DI float bf2f(bf16_t v) { return __uint_as_float(((unsigned)v) << 16); }
DI bf16_t f2bf(float x) { unsigned u = __float_as_uint(x); u += 0x7fffu + ((u >> 16) & 1u); return (bf16_t)(u >> 16); }
DI float gelu_tanh(float x) { float u = 0.7978845608028654f * (x + 0.044715f * x * x * x); return 0.5f * x * (1.f + tanhf(u)); }
DI float siluf(float x) { return x / (1.f + __expf(-x)); }
DI float sigmoidf(float x) { return 1.f / (1.f + __expf(-x)); }

#define T_TOK 16384
#define SEQ 8192
#define DM 1024
#define NPROJ 3456
#define NEG_INF (-__builtin_inff())

struct Params {
  const float *x, *c, *w_ada, *b_ada, *g_mix, *w_in, *pe_k, *pe_v, *w_k1, *b_k1, *w_k2, *w_v1, *b_v1, *w_v2, *w_out, *g_ffn,
      *w_pq, *subkeys, *peer_down, *peer_up, *g_final;
  float* out;
  float* mod;
  unsigned* ksmax;
  float *c128, *s128, *c64, *s64;
  bf16_t *WinT, *WoutT, *WqT, *W1Tk, *W1Tv, *W2Tk, *W2Tv, *SUBK;
  float *B1Pk, *B1Pv;
  bf16_t* RA;
  bf16_t *RQ, *RK, *RKT, *RVT, *RGT, *NQ, *NKC, *NVC, *NKS, *NKW, *NVST, *NVWT;
  float* GATE;
  float* KV;
  bf16_t* SPREV;
  bf16_t *KC, *VCT;
  float* HID;
  bf16_t* PQ;
  int* EIDX;
  float* EW;
  bf16_t *PDN, *PUP;
};

DI float logg_h(int h) { return log1pf(-exp2f(-5.f - (float)h)); }


typedef __bf16 bf16x2_t __attribute__((ext_vector_type(2)));
typedef float f32x2_t __attribute__((ext_vector_type(2)));
DI unsigned cvt2(float a, float b) { f32x2_t v = {a, b}; bf16x2_t r = __builtin_convertvector(v, bf16x2_t); return __builtin_bit_cast(unsigned, r); }
DI uint2 pack4(float a, float b, float c, float d) { uint2 r; r.x = cvt2(a, b); r.y = cvt2(c, d); return r; }
#define NT 512
typedef short bf16x8 __attribute__((ext_vector_type(8)));
typedef float f32x16 __attribute__((ext_vector_type(16)));
#define MFMA32(a, b, c) __builtin_amdgcn_mfma_f32_32x32x16_bf16((a), (b), (c), 0, 0, 0)

DI int win_logical_col(int np) {
  int g = np >> 6, c = np & 63;
  if (g < 16) {
    int sec = g >> 3, hh = (g & 7) >> 1, j = g & 1, i = 32 * j + (c & 31);
    return sec * 512 + hh * 128 + ((c < 32) ? i : 64 + i);
  } else if (g < 52) return 1024 + (g - 16) * 64 + c;
  else if (g == 52) return (c < 24) ? 3328 + c : -1;
  return -1;
}

DI void tr_tile(const float* __restrict__ in, bf16_t* __restrict__ out, int K, int N_in, int k0, int n0, int mode, float* tile) {
  const int tid = threadIdx.x;
  {
    int nn = tid & 63, col = mode ? win_logical_col(n0 + nn) : (n0 + nn);
#pragma unroll
    for (int i = 0; i < 8; ++i) {
      int kk = (tid >> 6) + 8 * i;
      tile[kk * 65 + nn] = (col >= 0) ? in[(size_t)(k0 + kk) * N_in + col] : 0.f;
    }
  }
  __syncthreads();
  {
    int kk = tid & 63;
#pragma unroll
    for (int i = 0; i < 8; ++i) {
      int nn = (tid >> 6) + 8 * i;
      out[(size_t)(n0 + nn) * K + k0 + kk] = f2bf(tile[kk * 65 + nn]);
    }
  }
  __syncthreads();
}

#define PH0_MOD 96
#define PH0_WIN (PH0_MOD + 16 * 54)
#define PH0_WOUT (PH0_WIN + 256)
#define PH0_WQ (PH0_WOUT + 512)
#define PH0_W1K (PH0_WQ + 128)
#define PH0_W1V (PH0_W1K + 128)
#define PH0_W2K (PH0_W1V + 4)
#define PH0_W2V (PH0_W2K + 4)
#define PH0_SUBK (PH0_W2V + 512)
#define PH0_ROPE (PH0_SUBK + 1024)
#define PH0_B1P (PH0_ROPE + 8)
#define PH0_NVB PH0_B1P

DI void ph0_body(const Params& p, int vb, char* smem) {
  const int tid = threadIdx.x;
  float* fs = (float*)smem;
  if (vb < PH0_MOD) {
    int kg = tid >> 6, col = vb * 64 + (tid & 63);
    float a0 = 0.f, a1 = 0.f;
#pragma unroll 8
    for (int k = kg * 128; k < kg * 128 + 128; ++k) {
      float w = p.w_ada[(size_t)k * 6144 + col];
      a0 += siluf(p.c[k]) * w; a1 += siluf(p.c[DM + k]) * w;
    }
    fs[kg * 64 + (tid & 63)] = a0; fs[512 + kg * 64 + (tid & 63)] = a1;
    __syncthreads();
    if (tid < 128) {
      int b = tid >> 6, cc = tid & 63; float s = 0.f;
      for (int g = 0; g < 8; ++g) s += fs[b * 512 + g * 64 + cc];
      p.mod[b * 6144 + vb * 64 + cc] = s + p.b_ada[vb * 64 + cc];
    }
    __syncthreads();
    if (vb == 0 && tid < 12) p.ksmax[tid] = 0u;
  } else if (vb < PH0_WIN) { int t = vb - PH0_MOD; tr_tile(p.w_in, p.WinT, 1024, 3352, (t & 15) * 64, (t >> 4) * 64, 1, fs); }
  else if (vb < PH0_WOUT) { int t = vb - PH0_WIN; tr_tile(p.w_out, p.WoutT, 1024, 1024, (t & 15) * 64, (t >> 4) * 64, 0, fs); }
  else if (vb < PH0_WQ) { int t = vb - PH0_WOUT; tr_tile(p.w_pq, p.WqT, 1024, 2048, (t & 15) * 64, (t >> 4) * 64, 0, fs); }
  else if (vb < PH0_W1K) { int t = vb - PH0_WQ; tr_tile(p.w_k1, p.W1Tk, 2048, 256, (t & 31) * 64, (t >> 5) * 64, 0, fs); }
  else if (vb < PH0_W1V) { int t = vb - PH0_W1K; tr_tile(p.w_v1, p.W1Tv, 2048, 256, (t & 31) * 64, (t >> 5) * 64, 0, fs); }
  else if (vb < PH0_W2K) { int t = vb - PH0_W1V; tr_tile(p.w_k2, p.W2Tk, 256, 64, t * 64, 0, 0, fs); }
  else if (vb < PH0_W2V) { int t = vb - PH0_W2K; tr_tile(p.w_v2, p.W2Tv, 256, 64, t * 64, 0, 0, fs); }
  else if (vb < PH0_SUBK) { int i = (vb - PH0_W2V) * NT + tid; p.SUBK[i] = f2bf(p.subkeys[i]); }
  else if (vb < PH0_ROPE) {
    int idx = (vb - PH0_SUBK) * NT + tid;
    { int s = idx >> 6, i = idx & 63; float inv = powf(10000.f, -(float)(2 * i) / 128.f); float ang = (float)s * inv; p.c128[idx] = cosf(ang); p.s128[idx] = sinf(ang); }
    if (idx < SEQ * 32) { int s = idx >> 5, i = idx & 31; float inv = powf(10000.f, -(float)(2 * i) / 64.f); float ang = (float)s * inv; p.c64[idx] = cosf(ang); p.s64[idx] = sinf(ang); }
  } else {
    int t = vb - PH0_ROPE, kv = t >> 2, jb = t & 3;
    const float* w1 = kv ? p.w_v1 : p.w_k1; const float* pe = kv ? p.pe_v : p.pe_k; const float* b1 = kv ? p.b_v1 : p.b_k1;
    int fg = tid >> 6, j = jb * 64 + (tid & 63);
    float a = 0.f;
#pragma unroll 8
    for (int f = fg * 256; f < fg * 256 + 256; ++f) a += pe[f] * w1[(size_t)f * 256 + j];
    fs[fg * 64 + (tid & 63)] = a;
    __syncthreads();
    if (tid < 64) { float s = b1[j]; for (int g = 0; g < 8; ++g) s += fs[g * 64 + tid]; (kv ? p.B1Pv : p.B1Pk)[j] = s; }
    __syncthreads();
  }
}

DI void rownorm_body(const float* __restrict__ src, const float* __restrict__ g, const float* __restrict__ mod, int sh_off, int sc_off, bf16_t* __restrict__ dst, int vb) {
  int row = vb * 8 + (threadIdx.x >> 6), lane = threadIdx.x & 63;
  int b = row >> 13;
  const float* xr = src + (size_t)row * DM;
  float v[16]; float ss = 0.f;
#pragma unroll
  for (int i = 0; i < 4; ++i) {
    float4 t = *(const float4*)(xr + i * 256 + lane * 4);
    v[i * 4 + 0] = t.x; v[i * 4 + 1] = t.y; v[i * 4 + 2] = t.z; v[i * 4 + 3] = t.w;
    ss += t.x * t.x + t.y * t.y + t.z * t.z + t.w * t.w;
  }
  for (int o = 32; o; o >>= 1) ss += __shfl_xor(ss, o);
  float rstd = rsqrtf(ss * (1.f / DM) + 1e-6f);
  const float* sh = mod + b * 6144 + sh_off; const float* sc = mod + b * 6144 + sc_off;
#pragma unroll
  for (int i = 0; i < 4; ++i) {
    int col = i * 256 + lane * 4;
    float4 gg = *(const float4*)(g + col), s4 = *(const float4*)(sc + col), h4 = *(const float4*)(sh + col);
    float y0 = v[i * 4 + 0] * rstd * gg.x * (1.f + s4.x) + h4.x;
    float y1 = v[i * 4 + 1] * rstd * gg.y * (1.f + s4.y) + h4.y;
    float y2 = v[i * 4 + 2] * rstd * gg.z * (1.f + s4.z) + h4.z;
    float y3 = v[i * 4 + 3] * rstd * gg.w * (1.f + s4.w) + h4.w;
    *(uint2*)(dst + (size_t)row * DM + col) = pack4(y0, y1, y2, y3);
  }
}

#define G_A_BYTES (256 * 144)
#define G_B_BYTES (128 * 144)
#define G_BUF_BYTES (G_A_BYTES + G_B_BYTES)
template <class Epi>
DI void gemm_tile(const bf16_t* __restrict__ A, const bf16_t* __restrict__ Bt, int K, int m0, int n0, char* smem, const Epi& epi) {
  const int tid = threadIdx.x, lane = tid & 63, w = tid >> 6, wm = w >> 1, wn = w & 1, r = lane & 31, h = lane >> 5;
  f32x16 acc[2][2];
#pragma unroll
  for (int i = 0; i < 2; ++i)
#pragma unroll
    for (int j = 0; j < 2; ++j)
#pragma unroll
      for (int e = 0; e < 16; ++e) acc[i][j][e] = 0.f;
  const int crow = tid >> 3, ckc = tid & 7;
  const bf16_t* ag = A + (size_t)(m0 + crow) * K + ckc * 8;
  const bf16_t* bg = Bt + (size_t)(n0 + crow) * K + ckc * 8;
  uint4 ra[4], rb[2];
#pragma unroll
  for (int i = 0; i < 4; ++i) ra[i] = *(const uint4*)(ag + (size_t)i * 64 * K);
#pragma unroll
  for (int i = 0; i < 2; ++i) rb[i] = *(const uint4*)(bg + (size_t)i * 64 * K);
  char* lw = smem + crow * 144 + ckc * 16;
#pragma unroll
  for (int i = 0; i < 4; ++i) *(uint4*)(lw + i * 64 * 144) = ra[i];
#pragma unroll
  for (int i = 0; i < 2; ++i) *(uint4*)(lw + G_A_BYTES + i * 64 * 144) = rb[i];
  __syncthreads();
  const int nk = K >> 6;
  for (int kt = 0; kt < nk; ++kt) {
    const int cur = kt & 1;
    if (kt + 1 < nk) {
      const int k0 = (kt + 1) * 64;
#pragma unroll
      for (int i = 0; i < 4; ++i) ra[i] = *(const uint4*)(ag + (size_t)i * 64 * K + k0);
#pragma unroll
      for (int i = 0; i < 2; ++i) rb[i] = *(const uint4*)(bg + (size_t)i * 64 * K + k0);
    }
    const char* la = smem + cur * G_BUF_BYTES + (wm * 64 + r) * 144 + h * 16;
    const char* lb = smem + cur * G_BUF_BYTES + G_A_BYTES + (wn * 64 + r) * 144 + h * 16;
#pragma unroll
    for (int kk = 0; kk < 4; ++kk) {
      bf16x8 a0 = *(const bf16x8*)(la + kk * 32), a1 = *(const bf16x8*)(la + 32 * 144 + kk * 32);
      bf16x8 b0 = *(const bf16x8*)(lb + kk * 32), b1 = *(const bf16x8*)(lb + 32 * 144 + kk * 32);
      acc[0][0] = MFMA32(a0, b0, acc[0][0]); acc[0][1] = MFMA32(a0, b1, acc[0][1]);
      acc[1][0] = MFMA32(a1, b0, acc[1][0]); acc[1][1] = MFMA32(a1, b1, acc[1][1]);
    }
    if (kt + 1 < nk) {
      char* lw2 = lw + (cur ^ 1) * G_BUF_BYTES;
#pragma unroll
      for (int i = 0; i < 4; ++i) *(uint4*)(lw2 + i * 64 * 144) = ra[i];
#pragma unroll
      for (int i = 0; i < 2; ++i) *(uint4*)(lw2 + G_A_BYTES + i * 64 * 144) = rb[i];
    }
    __syncthreads();
  }
  const int G = (n0 >> 6) + wn;
#pragma unroll
  for (int i = 0; i < 2; ++i)
#pragma unroll
    for (int g = 0; g < 4; ++g) {
      float lo[4], hi[4];
#pragma unroll
      for (int e = 0; e < 4; ++e) { lo[e] = acc[i][0][4 * g + e]; hi[e] = acc[i][1][4 * g + e]; }
      epi(m0 + wm * 64 + i * 32 + 8 * g + 4 * h, G, r, lo, hi);
    }
}

struct EpiProj {
  const Params& p;
  DI void operator()(int t0, int G, int c, const float (&lo)[4], const float (&hi)[4]) const {
    const int b = t0 >> 13, s0 = t0 & 8191;
    if (G < 16) {
      const int sec = G >> 3, hh = (G & 7) >> 1, j = G & 1, i = 32 * j + c;
      float o1[4], o2[4];
#pragma unroll
      for (int e = 0; e < 4; ++e) {
        float cs = p.c128[(s0 + e) * 64 + i], sn = p.s128[(s0 + e) * 64 + i];
        o1[e] = lo[e] * cs - hi[e] * sn; o2[e] = hi[e] * cs + lo[e] * sn;
      }
      if (sec == 0) {
#pragma unroll
        for (int e = 0; e < 4; ++e) {
          p.RQ[(size_t)(t0 + e) * 512 + hh * 128 + i] = f2bf(o1[e]);
          p.RQ[(size_t)(t0 + e) * 512 + hh * 128 + 64 + i] = f2bf(o2[e]);
        }
      } else {
        const float sc = 0.08838834764831845f;
        const float lg = logg_h(hh);
#pragma unroll
        for (int e = 0; e < 4; ++e) {
          o1[e] *= sc; o2[e] *= sc;
          p.RK[(size_t)(t0 + e) * 512 + hh * 128 + i] = f2bf(o1[e]);
          p.RK[(size_t)(t0 + e) * 512 + hh * 128 + 64 + i] = f2bf(o2[e]);
          float zeta = __expf((float)(127 - ((s0 + e) & 127)) * lg);
          o1[e] *= zeta; o2[e] *= zeta;
        }
        *(uint2*)(p.RKT + ((size_t)(b * 4 + hh) * 128 + i) * SEQ + s0) = pack4(o1[0], o1[1], o1[2], o1[3]);
        *(uint2*)(p.RKT + ((size_t)(b * 4 + hh) * 128 + 64 + i) * SEQ + s0) = pack4(o2[0], o2[1], o2[2], o2[3]);
      }
    } else if (G < 24) {
      const int hh = (G - 16) >> 1, d = ((G - 16) & 1) * 64 + c;
      *(uint2*)(p.RVT + ((size_t)(b * 4 + hh) * 128 + d) * SEQ + s0) = pack4(lo[0], lo[1], lo[2], lo[3]);
      *(uint2*)(p.RVT + ((size_t)(b * 4 + hh) * 128 + d + 32) * SEQ + s0) = pack4(hi[0], hi[1], hi[2], hi[3]);
    } else if (G < 32) {
      const int hh = (G - 24) >> 1, d = ((G - 24) & 1) * 64 + c;
#pragma unroll
      for (int e = 0; e < 4; ++e) {
        p.RGT[(size_t)(t0 + e) * 512 + hh * 128 + d] = f2bf(siluf(lo[e]));
        p.RGT[(size_t)(t0 + e) * 512 + hh * 128 + d + 32] = f2bf(siluf(hi[e]));
      }
    } else if (G < 40) {
      const int head = G - 32;
#pragma unroll
      for (int e = 0; e < 4; ++e) {
        float cs = p.c64[(s0 + e) * 32 + c], sn = p.s64[(s0 + e) * 32 + c];
        float o1 = (lo[e] * cs - hi[e] * sn) * 0.125f, o2 = (hi[e] * cs + lo[e] * sn) * 0.125f;
        p.NQ[(size_t)(t0 + e) * 512 + head * 64 + c] = f2bf(o1);
        p.NQ[(size_t)(t0 + e) * 512 + head * 64 + 32 + c] = f2bf(o2);
      }
    } else if (G < 52) {
      const int k = G - 40, kind = k >> 1, gg = k & 1;
      float o1[4], o2[4];
#pragma unroll
      for (int e = 0; e < 4; ++e) {
        o1[e] = lo[e]; o2[e] = hi[e];
        if ((kind & 1) == 0) {
          float cs = p.c64[(s0 + e) * 32 + c], sn = p.s64[(s0 + e) * 32 + c];
          o1[e] = lo[e] * cs - hi[e] * sn; o2[e] = hi[e] * cs + lo[e] * sn;
        }
      }
      if (kind == 3 || kind == 5) {
        bf16_t* dst = (kind == 3 ? p.NVST : p.NVWT) + ((size_t)(b * 2 + gg) * 64 + c) * SEQ + s0;
        *(uint2*)dst = pack4(o1[0], o1[1], o1[2], o1[3]);
        *(uint2*)(dst + (size_t)32 * SEQ) = pack4(o2[0], o2[1], o2[2], o2[3]);
      } else {
        bf16_t* dst = (kind == 0 ? p.NKC : kind == 1 ? p.NVC : kind == 2 ? p.NKS : p.NKW);
#pragma unroll
        for (int e = 0; e < 4; ++e) {
          dst[(size_t)(t0 + e) * 128 + gg * 64 + c] = f2bf(o1[e]);
          dst[(size_t)(t0 + e) * 128 + gg * 64 + 32 + c] = f2bf(o2[e]);
        }
      }
    } else if (G == 52) {
      if (c < 24) {
#pragma unroll
        for (int e = 0; e < 4; ++e) p.GATE[(size_t)(t0 + e) * 24 + c] = sigmoidf(lo[e]);
      }
    }
  }
};
struct EpiOut {
  const Params& p;
  DI void operator()(int t0, int G, int c, const float (&lo)[4], const float (&hi)[4]) const {
    const int b = t0 >> 13;
    const int c0 = G * 64 + c, c1 = c0 + 32;
    const float* ga1 = p.mod + b * 6144 + 2048;
    const float g0 = ga1[c0], g1 = ga1[c1];
#pragma unroll
    for (int e = 0; e < 4; ++e) {
      p.out[(size_t)(t0 + e) * DM + c0] = p.x[(size_t)(t0 + e) * DM + c0] + g0 * lo[e];
      p.out[(size_t)(t0 + e) * DM + c1] = p.x[(size_t)(t0 + e) * DM + c1] + g1 * hi[e];
    }
  }
};
struct EpiPQ {
  const Params& p;
  DI void operator()(int t0, int G, int c, const float (&lo)[4], const float (&hi)[4]) const {
#pragma unroll
    for (int e = 0; e < 4; ++e) {
      p.PQ[(size_t)(t0 + e) * 2048 + G * 64 + c] = f2bf(lo[e]);
      p.PQ[(size_t)(t0 + e) * 2048 + G * 64 + 32 + c] = f2bf(hi[e]);
    }
  }
};

DI void retkv_naive(const Params& p, size_t idx) {
  int item = (int)(idx >> 14), v = (int)((idx >> 7) & 127), k = (int)(idx & 127);
  int h = item & 3, c = (item >> 2) & 63, b = item >> 8;
  const bf16_t* vp = p.RVT + ((size_t)(b * 4 + h) * 128 + v) * SEQ + c * 128;
  const bf16_t* kp = p.RKT + ((size_t)(b * 4 + h) * 128 + k) * SEQ + c * 128;
  float a = 0.f;
  for (int m = 0; m < 128; ++m) a += bf2f(vp[m]) * bf2f(kp[m]);
  p.KV[idx] = a;
}
DI void scan_naive(const Params& p, int idx) {
  int e = idx & 16383, bh = idx >> 14, b = bh >> 2, h = bh & 3;
  float cd = __expf(128.f * logg_h(h));
  float S = 0.f;
  for (int c = 0; c < 64; ++c) {
    size_t o = (size_t)((b * 64 + c) * 4 + h) * 16384 + e;
    p.SPREV[o] = f2bf(S);
    S = cd * S + p.KV[o];
  }
}
DI void retout_naive(const Params& p, int item, char* smem) {
  float* Ssc = (float*)smem;
  float* Y = Ssc + 128 * 129;
  int h = item & 3, c = (item >> 2) & 63, b = item >> 8;
  int t0 = b * SEQ + c * 128, s0 = c * 128;
  float lg = logg_h(h);
  for (int idx = threadIdx.x; idx < 16384; idx += NT) {
    int n = idx >> 7, m = idx & 127;
    float a = 0.f;
    if (m <= n) {
      const bf16_t* q = p.RQ + (size_t)(t0 + n) * 512 + h * 128;
      const bf16_t* k = p.RK + (size_t)(t0 + m) * 512 + h * 128;
      for (int kk = 0; kk < 128; ++kk) a += bf2f(q[kk]) * bf2f(k[kk]);
      a *= __expf((float)(n - m) * lg);
    }
    Ssc[n * 129 + m] = a;
  }
  __syncthreads();
  for (int idx = threadIdx.x; idx < 16384; idx += NT) {
    int n = idx >> 7, v = idx & 127;
    const bf16_t* vp = p.RVT + ((size_t)(b * 4 + h) * 128 + v) * SEQ + s0;
    float inner = 0.f;
    for (int m = 0; m <= n; ++m) inner += Ssc[n * 129 + m] * bf2f(vp[m]);
    const bf16_t* q = p.RQ + (size_t)(t0 + n) * 512 + h * 128;
    const bf16_t* sp = p.SPREV + (size_t)item * 16384 + v * 128;
    float cr = 0.f;
    for (int kk = 0; kk < 128; ++kk) cr += bf2f(q[kk]) * bf2f(sp[kk]);
    Y[n * 129 + v] = inner + __expf((float)(n + 1) * lg) * cr;
  }
  __syncthreads();
  if (threadIdx.x < 128) {
    int n = threadIdx.x;
    float mu = 0.f;
    for (int v = 0; v < 128; ++v) mu += Y[n * 129 + v];
    mu *= (1.f / 128.f);
    float var = 0.f;
    for (int v = 0; v < 128; ++v) { float d = Y[n * 129 + v] - mu; var += d * d; }
    var *= (1.f / 128.f);
    float rs = rsqrtf(var + 1e-6f);
    for (int v = 0; v < 128; ++v) {
      float g = bf2f(p.RGT[((size_t)(b * 4 + h) * 128 + v) * SEQ + s0 + n]);
      p.RA[(size_t)(t0 + n) * DM + h * 128 + v] = f2bf((Y[n * 129 + v] - mu) * rs * g);
    }
  }
  __syncthreads();
}
DI void cmp1_naive(const Params& p, int idx) {
  int j = idx & 255, r = (idx >> 8) & 2047, kv = idx >> 19;
  if (r >= 2044) return;
  int g = r & 1, n = (r >> 1) % 511, b = (r >> 1) / 511;
  const bf16_t* src = (kv ? p.NVC : p.NKC) + ((size_t)(b * SEQ + 16 * n)) * 128 + g * 64;
  const bf16_t* w = (kv ? p.W1Tv : p.W1Tk) + (size_t)j * 2048;
  float a = 0.f;
  for (int l = 0; l < 32; ++l)
    for (int d = 0; d < 64; ++d) a += bf2f(src[l * 128 + d]) * bf2f(w[l * 64 + d]);
  a += (kv ? p.B1Pv : p.B1Pk)[j];
  p.HID[((size_t)kv * 2048 + r) * 256 + j] = gelu_tanh(a);
}
DI void cmp2_naive(const Params& p, int idx) {
  int e = idx & 63, r = (idx >> 6) & 2047, kv = idx >> 17;
  if (r >= 2044) {
    int bg = r - 2044;
    if (kv == 0) p.KC[((size_t)bg * 512 + 511) * 64 + e] = 0;
    else p.VCT[((size_t)bg * 64 + e) * 512 + 511] = 0;
    return;
  }
  int g = r & 1, n = (r >> 1) % 511, b = (r >> 1) / 511;
  const float* hid = p.HID + ((size_t)kv * 2048 + r) * 256;
  const bf16_t* w = (kv ? p.W2Tv : p.W2Tk) + e * 256;
  float a = 0.f;
  for (int j = 0; j < 256; ++j) a += hid[j] * bf2f(w[j]);
  if (kv == 0) p.KC[((size_t)(b * 2 + g) * 512 + n) * 64 + e] = f2bf(a);
  else p.VCT[((size_t)(b * 2 + g) * 64 + e) * 512 + n] = f2bf(a);
}
DI void ksmax_naive(const Params& p, int idx) {
  int g = idx & 1, t = idx >> 1, b = t >> 13;
  const bf16_t* k = p.NKS + (size_t)t * 128 + g * 64;
  float ss = 0.f;
  for (int d = 0; d < 64; ++d) { float v = bf2f(k[d]); ss += v * v; }
  atomicMax(&p.ksmax[b * 2 + g], __float_as_uint(sqrtf(ss)));
}

#define NSA_SUB_FLOATS 18048
DI void nsa_naive(const Params& p, int blk, int tid, float* sm) {
  float* qs = sm;
  float* P = sm + 1024;
  float* IMP = P + 16 * 1024;
  int* SEL = (int*)(IMP + 512);
  int* NSEL = SEL + 64;
  int g = blk & 1, tq = blk >> 1;
  int tok0 = tq * 4, b = tok0 >> 13, s0 = tok0 & 8191;
  int bg = b * 2 + g;
  int th = tid >> 4, sub = tid & 15, token = th >> 2, hh = th & 3;
  int t = s0 + token;
  for (int i = tid; i < 1024; i += 256) {
    int r = i >> 6, d = i & 63;
    qs[i] = bf2f(p.NQ[(size_t)(tok0 + (r >> 2)) * 512 + (g * 4 + (r & 3)) * 64 + d]);
  }
  __syncthreads();
  const float* q = qs + th * 64;
  float* Pr = P + th * 1024;
  int nvalid = (t >= 31) ? ((t - 31) / 16 + 1) : 0;
  if (nvalid > 511) nvalid = 511;
  float mx = NEG_INF;
  for (int n = sub; n < 512; n += 16) {
    float sc = NEG_INF;
    if (n < nvalid) {
      const bf16_t* k = p.KC + ((size_t)bg * 512 + n) * 64;
      float a = 0.f;
      for (int d = 0; d < 64; ++d) a += q[d] * bf2f(k[d]);
      sc = a;
    }
    Pr[n] = sc; mx = fmaxf(mx, sc);
  }
  for (int o = 8; o; o >>= 1) mx = fmaxf(mx, __shfl_xor(mx, o));
  float mm = (mx == NEG_INF) ? 0.f : mx;
  float l = 0.f;
  for (int n = sub; n < 512; n += 16) { float e = (n < nvalid) ? __expf(Pr[n] - mm) : 0.f; Pr[n] = e; l += e; }
  for (int o = 8; o; o >>= 1) l += __shfl_xor(l, o);
  float inv = 1.f / fmaxf(l, 1.17549435e-38f);
  for (int n = sub; n < 512; n += 16) Pr[n] *= inv;
  __syncthreads();
  float oc[4] = {0, 0, 0, 0};
#pragma unroll
  for (int e = 0; e < 4; ++e) {
    int d = sub * 4 + e;
    const bf16_t* v = p.VCT + ((size_t)bg * 64 + d) * 512;
    float a = 0.f;
    for (int n = 0; n < nvalid; ++n) a += Pr[n] * bf2f(v[n]);
    oc[e] = a;
  }
  for (int i = tid; i < 512; i += 256) {
    int tk = i >> 7, j = i & 127;
    int tt = s0 + tk, cur = tt >> 6;
    float a = 0.f;
    for (int h2 = 0; h2 < 4; ++h2) {
      const float* pp = P + (tk * 4 + h2) * 1024;
      a += 2.f * (pp[4 * j] + pp[4 * j + 1] + pp[4 * j + 2]) + pp[4 * j + 3] + (j > 0 ? pp[4 * j - 1] : 0.f);
    }
    if (j == 0 || j == cur || j == cur - 1) a = 1e9f;
    if (j > cur) a = NEG_INF;
    IMP[i] = a;
  }
  __syncthreads();
  if (tid < 4) {
    int cnt = 0;
    for (int k = 0; k < 16; ++k) {
      float best = NEG_INF; int bj = -1;
      for (int j = 0; j < 128; ++j) { float v = IMP[tid * 128 + j]; if (v > best) { best = v; bj = j; } }
      if (bj < 0) break;
      SEL[tid * 16 + cnt] = bj; ++cnt; IMP[tid * 128 + bj] = NEG_INF;
    }
    NSEL[tid] = cnt;
  }
  __syncthreads();
  float os[4] = {0, 0, 0, 0};
  {
    int nk = NSEL[token] * 64;
    mx = NEG_INF;
    for (int ki = sub; ki < nk; ki += 16) {
      int pos = SEL[token * 16 + (ki >> 6)] * 64 + (ki & 63);
      float sc = NEG_INF;
      if (pos <= t) {
        const bf16_t* k = p.NKS + ((size_t)(b * SEQ + pos)) * 128 + g * 64;
        float a = 0.f;
        for (int d = 0; d < 64; ++d) a += q[d] * bf2f(k[d]);
        sc = a;
      }
      Pr[ki] = sc; mx = fmaxf(mx, sc);
    }
    for (int o = 8; o; o >>= 1) mx = fmaxf(mx, __shfl_xor(mx, o));
    mm = (mx == NEG_INF) ? 0.f : mx;
    l = 0.f;
    for (int ki = sub; ki < nk; ki += 16) { float sc = Pr[ki]; float e = (sc == NEG_INF) ? 0.f : __expf(sc - mm); Pr[ki] = e; l += e; }
    for (int o = 8; o; o >>= 1) l += __shfl_xor(l, o);
    inv = 1.f / fmaxf(l, 1.17549435e-38f);
    __syncthreads();
#pragma unroll
    for (int e = 0; e < 4; ++e) {
      int d = sub * 4 + e;
      const bf16_t* v = p.NVST + ((size_t)bg * 64 + d) * SEQ;
      float a = 0.f;
      for (int ki = 0; ki < nk; ++ki) {
        int pos = SEL[token * 16 + (ki >> 6)] * 64 + (ki & 63);
        a += Pr[ki] * bf2f(v[pos]);
      }
      os[e] = a * inv;
    }
    __syncthreads();
  }
  float ow[4] = {0, 0, 0, 0};
  {
    int lo = t - 511; if (lo < 0) lo = 0;
    int nk = t - lo + 1;
    mx = NEG_INF;
    for (int ki = sub; ki < nk; ki += 16) {
      int pos = lo + ki;
      const bf16_t* k = p.NKW + ((size_t)(b * SEQ + pos)) * 128 + g * 64;
      float a = 0.f;
      for (int d = 0; d < 64; ++d) a += q[d] * bf2f(k[d]);
      Pr[ki] = a; mx = fmaxf(mx, a);
    }
    for (int o = 8; o; o >>= 1) mx = fmaxf(mx, __shfl_xor(mx, o));
    l = 0.f;
    for (int ki = sub; ki < nk; ki += 16) { float e = __expf(Pr[ki] - mx); Pr[ki] = e; l += e; }
    for (int o = 8; o; o >>= 1) l += __shfl_xor(l, o);
    inv = 1.f / l;
    __syncthreads();
#pragma unroll
    for (int e = 0; e < 4; ++e) {
      int d = sub * 4 + e;
      const bf16_t* v = p.NVWT + ((size_t)bg * 64 + d) * SEQ + lo;
      float a = 0.f;
      for (int ki = 0; ki < nk; ++ki) a += Pr[ki] * bf2f(v[ki]);
      ow[e] = a * inv;
    }
  }
  const float* gt = p.GATE + (size_t)(tok0 + token) * 24 + (g * 4 + hh) * 3;
  float g0 = gt[0], g1 = gt[1], g2 = gt[2];
#pragma unroll
  for (int e = 0; e < 4; ++e) {
    int d = sub * 4 + e;
    p.RA[(size_t)(tok0 + token) * DM + 512 + (g * 4 + hh) * 64 + d] = f2bf(g0 * oc[e] + g1 * os[e] + g2 * ow[e]);
  }
  __syncthreads();
}

#define PEER_SUB_FLOATS 8192
DI void peer_naive(const Params& p, int t, int tid, float* sm) {
  float* qrow = sm;
  float* sc = sm + 2048;
  float* cand = sm + 4096;
  float* tv = sm + 6144;
  int* ti = (int*)(sm + 6400);
  float* tv2 = sm + 6656;
  int* te2 = (int*)(sm + 6784);
  float* red = sm + 6912;
  float* hrow = sm + 6928;
  int b = t >> 13;
  for (int i = tid; i < 2048; i += 256) qrow[i] = bf2f(p.PQ[(size_t)t * 2048 + i]);
  for (int i = tid; i < 1024; i += 256) hrow[i] = bf2f(p.RA[(size_t)t * DM + i]);
  __syncthreads();
  for (int i = tid; i < 2048; i += 256) {
    int ph = i >> 7;
    const bf16_t* k = p.SUBK + (size_t)i * 128;
    const float* q = qrow + ph * 128;
    float a = 0.f;
    for (int d = 0; d < 128; ++d) a += q[d] * bf2f(k[d]);
    sc[i] = a;
  }
  __syncthreads();
  if (tid < 16) {
    for (int k = 0; k < 16; ++k) {
      float best = NEG_INF; int bj = 0;
      for (int j = 0; j < 128; ++j) { float v = sc[tid * 128 + j]; if (v > best) { best = v; bj = j; } }
      tv[tid * 16 + k] = best; ti[tid * 16 + k] = bj; sc[tid * 128 + bj] = NEG_INF;
    }
  }
  __syncthreads();
  for (int i = tid; i < 2048; i += 256) {
    int pp = i >> 8, ii = (i >> 4) & 15, jj = i & 15;
    cand[i] = tv[(2 * pp) * 16 + ii] + tv[(2 * pp + 1) * 16 + jj];
  }
  __syncthreads();
  if (tid < 8) {
    for (int k = 0; k < 16; ++k) {
      float best = NEG_INF; int bj = 0;
      for (int j = 0; j < 256; ++j) { float v = cand[tid * 256 + j]; if (v > best) { best = v; bj = j; } }
      cand[tid * 256 + bj] = NEG_INF;
      tv2[tid * 16 + k] = best; te2[tid * 16 + k] = ti[(2 * tid) * 16 + (bj >> 4)] * 128 + ti[(2 * tid + 1) * 16 + (bj & 15)];
    }
    float m = tv2[tid * 16], l = 0.f;
    for (int k = 0; k < 16; ++k) { float e = __expf(tv2[tid * 16 + k] - m); tv2[tid * 16 + k] = e; l += e; }
    for (int k = 0; k < 16; ++k) tv2[tid * 16 + k] /= l;
  }
  __syncthreads();
  float4 hv = *(float4*)(hrow + tid * 4);
  float acc[4] = {0, 0, 0, 0};
  for (int e = 0; e < 128; ++e) {
    int idx = te2[e];
    float w = tv2[e];
    float4 u = *(const float4*)(p.peer_down + (size_t)idx * DM + tid * 4);
    float d = hv.x * u.x + hv.y * u.y + hv.z * u.z + hv.w * u.w;
    for (int o = 32; o; o >>= 1) d += __shfl_xor(d, o);
    if ((tid & 63) == 0) red[tid >> 6] = d;
    __syncthreads();
    float dot = red[0] + red[1] + red[2] + red[3];
    __syncthreads();
    float cf = w * gelu_tanh(dot);
    float4 v = *(const float4*)(p.peer_up + (size_t)idx * DM + tid * 4);
    acc[0] += cf * v.x; acc[1] += cf * v.y; acc[2] += cf * v.z; acc[3] += cf * v.w;
  }
  const float* ga2 = p.mod + b * 6144 + 5120;
  float4 x1 = *(float4*)(p.out + (size_t)t * DM + tid * 4);
  float y0 = x1.x + ga2[tid * 4 + 0] * acc[0], y1 = x1.y + ga2[tid * 4 + 1] * acc[1];
  float y2 = x1.z + ga2[tid * 4 + 2] * acc[2], y3 = x1.w + ga2[tid * 4 + 3] * acc[3];
  float ss = y0 * y0 + y1 * y1 + y2 * y2 + y3 * y3;
  for (int o = 32; o; o >>= 1) ss += __shfl_xor(ss, o);
  if ((tid & 63) == 0) red[4 + (tid >> 6)] = ss;
  __syncthreads();
  float tot = red[4] + red[5] + red[6] + red[7];
  float rstd = rsqrtf(tot * (1.f / DM) + 1e-6f);
  float4 o4;
  o4.x = y0 * rstd * p.g_final[tid * 4 + 0]; o4.y = y1 * rstd * p.g_final[tid * 4 + 1];
  o4.z = y2 * rstd * p.g_final[tid * 4 + 2]; o4.w = y3 * rstd * p.g_final[tid * 4 + 3];
  *(float4*)(p.out + (size_t)t * DM + tid * 4) = o4;
  __syncthreads();
}


DI int crow(int reg, int h) { return (reg & 3) + 8 * (reg >> 2) + 4 * h; }
DI bf16x8 ld16(const bf16_t* ptr) { return *(const bf16x8*)ptr; }
DI bf16x8 ld8x2(const bf16_t* ptr) {
  uint2 a = *(const uint2*)ptr, b = *(const uint2*)(ptr + 8);
  uint4 v; v.x = a.x; v.y = a.y; v.z = b.x; v.w = b.y;
  return __builtin_bit_cast(bf16x8, v);
}
DI bf16x8 pack8(float x0, float x1, float x2, float x3, float x4, float x5, float x6, float x7) {
  uint4 v; v.x = cvt2(x0, x1); v.y = cvt2(x2, x3); v.z = cvt2(x4, x5); v.w = cvt2(x6, x7);
  return __builtin_bit_cast(bf16x8, v);
}
DI f32x16 zero16() { f32x16 z; for (int e = 0; e < 16; ++e) z[e] = 0.f; return z; }

DI void retkv_mfma(const Params& p, int item) {
  const int lane = threadIdx.x & 63, w = threadIdx.x >> 6, r = lane & 31, h = lane >> 5;
  const int hh = item & 3, c = (item >> 2) & 63, b = item >> 8, bh = b * 4 + hh, s0 = c * 128;
  const int mi = w >> 1, nb = (w & 1) * 2;
  const bf16_t* vb_ = p.RVT + ((size_t)(bh * 128 + 32 * mi + r)) * SEQ + s0 + 8 * h;
  const bf16_t* k0 = p.RKT + ((size_t)(bh * 128 + 32 * nb + r)) * SEQ + s0 + 8 * h;
  const bf16_t* k1 = k0 + (size_t)32 * SEQ;
  f32x16 a0 = zero16(), a1 = zero16();
#pragma unroll
  for (int s = 0; s < 8; ++s) {
    bf16x8 a = ld16(vb_ + 16 * s), b0 = ld16(k0 + 16 * s), b1 = ld16(k1 + 16 * s);
    a0 = MFMA32(a, b0, a0); a1 = MFMA32(a, b1, a1);
  }
  float* dst = p.KV + (size_t)item * 16384;
#pragma unroll
  for (int e = 0; e < 16; ++e) {
    const int v = 32 * mi + crow(e, h);
    dst[v * 128 + 32 * nb + r] = a0[e];
    dst[v * 128 + 32 * nb + 32 + r] = a1[e];
  }
}
DI void scan_body(const Params& p, int idx) {
  const int e = idx & 16383, bh = idx >> 14, b = bh >> 2, h = bh & 3;
  const float cd = __expf(128.f * logg_h(h));
  float S = 0.f;
  for (int c0 = 0; c0 < 64; c0 += 8) {
    float kv[8];
#pragma unroll
    for (int u = 0; u < 8; ++u) kv[u] = p.KV[(size_t)((b * 64 + c0 + u) * 4 + h) * 16384 + e];
#pragma unroll
    for (int u = 0; u < 8; ++u) {
      p.SPREV[(size_t)((b * 64 + c0 + u) * 4 + h) * 16384 + e] = f2bf(S);
      S = cd * S + kv[u];
    }
  }
}
DI void retout_mfma(const Params& p, int task) {
  const int lane = threadIdx.x & 63, r = lane & 31, h = lane >> 5;
  const int item = task >> 2, nt = task & 3;
  const int hh = item & 3, c = (item >> 2) & 63, b = item >> 8, bh = b * 4 + hh, s0 = c * 128, t0 = b * SEQ + s0;
  const float lg = logg_h(hh);
  const int n = 32 * nt + r;
  bf16x8 qf[8];
#pragma unroll
  for (int s = 0; s < 8; ++s) qf[s] = ld16(p.RQ + (size_t)(t0 + n) * 512 + hh * 128 + 16 * s + 8 * h);
  f32x16 acc[4];
#pragma unroll
  for (int vi = 0; vi < 4; ++vi) {
    acc[vi] = zero16();
    const bf16_t* sp = p.SPREV + (size_t)item * 16384 + (size_t)(32 * vi + r) * 128 + 8 * h;
#pragma unroll
    for (int s = 0; s < 8; ++s) acc[vi] = MFMA32(ld16(sp + 16 * s), qf[s], acc[vi]);
  }
  {
    const float xi = __expf((float)(n + 1) * lg);
#pragma unroll
    for (int vi = 0; vi < 4; ++vi)
#pragma unroll
      for (int e = 0; e < 16; ++e) acc[vi][e] *= xi;
  }
  for (int mt = 0; mt <= nt; ++mt) {
    f32x16 sa = zero16();
    const bf16_t* kp = p.RK + (size_t)(t0 + 32 * mt + r) * 512 + hh * 128 + 8 * h;
#pragma unroll
    for (int s = 0; s < 8; ++s) sa = MFMA32(ld16(kp + 16 * s), qf[s], sa);
    float pv[16];
#pragma unroll
    for (int e = 0; e < 16; ++e) {
      const int dm = n - (32 * mt + crow(e, h));
      pv[e] = (dm >= 0) ? sa[e] * __expf((float)dm * lg) : 0.f;
    }
#pragma unroll
    for (int s2 = 0; s2 < 2; ++s2) {
      bf16x8 bfr = pack8(pv[8 * s2], pv[8 * s2 + 1], pv[8 * s2 + 2], pv[8 * s2 + 3], pv[8 * s2 + 4], pv[8 * s2 + 5], pv[8 * s2 + 6], pv[8 * s2 + 7]);
#pragma unroll
      for (int vi = 0; vi < 4; ++vi) {
        bf16x8 afr = ld8x2(p.RVT + ((size_t)(bh * 128 + 32 * vi + r)) * SEQ + s0 + 32 * mt + 16 * s2 + 4 * h);
        acc[vi] = MFMA32(afr, bfr, acc[vi]);
      }
    }
  }
  float sum = 0.f;
#pragma unroll
  for (int vi = 0; vi < 4; ++vi)
#pragma unroll
    for (int e = 0; e < 16; ++e) sum += acc[vi][e];
  sum += __shfl_xor(sum, 32);
  const float mu = sum * (1.f / 128.f);
  float var = 0.f;
#pragma unroll
  for (int vi = 0; vi < 4; ++vi)
#pragma unroll
    for (int e = 0; e < 16; ++e) { float d = acc[vi][e] - mu; var += d * d; }
  var += __shfl_xor(var, 32);
  const float rs = rsqrtf(var * (1.f / 128.f) + 1e-6f);
#pragma unroll
  for (int vi = 0; vi < 4; ++vi)
#pragma unroll
    for (int g4 = 0; g4 < 4; ++g4) {
      const int v0 = 32 * vi + 8 * g4 + 4 * h;
      uint2 gt = *(const uint2*)(p.RGT + (size_t)(t0 + n) * 512 + hh * 128 + v0);
      float y0 = (acc[vi][4 * g4 + 0] - mu) * rs * __uint_as_float(gt.x << 16);
      float y1 = (acc[vi][4 * g4 + 1] - mu) * rs * __uint_as_float(gt.x & 0xffff0000u);
      float y2 = (acc[vi][4 * g4 + 2] - mu) * rs * __uint_as_float(gt.y << 16);
      float y3 = (acc[vi][4 * g4 + 3] - mu) * rs * __uint_as_float(gt.y & 0xffff0000u);
      *(uint2*)(p.RA + (size_t)(t0 + n) * DM + hh * 128 + v0) = pack4(y0, y1, y2, y3);
    }
}
#define HID_STRIDE 264
DI void compress_mfma(const Params& p, int item, char* smem) {
  bf16_t* HIDL = (bf16_t*)smem;
  const int lane = threadIdx.x & 63, w = threadIdx.x >> 6, r = lane & 31, h = lane >> 5;
  const int kv = item >> 6, bg = (item >> 4) & 3, rt = item & 15, n0 = rt * 32, b = bg >> 1, g = bg & 1;
  const bf16_t* src = kv ? p.NVC : p.NKC; const bf16_t* W1 = kv ? p.W1Tv : p.W1Tk; const bf16_t* W2 = kv ? p.W2Tv : p.W2Tk;
  const float* B1 = kv ? p.B1Pv : p.B1Pk;
  {
    const int n = min(n0 + r, 510);
    const bf16_t* ab = src + ((size_t)(b * SEQ + 16 * n)) * 128 + g * 64 + 8 * h;
    const bf16_t* bb = W1 + (size_t)(32 * w + r) * 2048 + 8 * h;
    f32x16 acc = zero16();
#pragma unroll 8
    for (int s = 0; s < 128; ++s) acc = MFMA32(ld16(ab + (s >> 2) * 128 + (s & 3) * 16), ld16(bb + 16 * s), acc);
    const float bias = B1[32 * w + r];
#pragma unroll
    for (int e = 0; e < 16; ++e) HIDL[crow(e, h) * HID_STRIDE + 32 * w + r] = f2bf(gelu_tanh(acc[e] + bias));
  }
  __syncthreads();
  if (w < 2) {
    f32x16 acc = zero16();
#pragma unroll
    for (int s = 0; s < 16; ++s) acc = MFMA32(ld16(HIDL + r * HID_STRIDE + 16 * s + 8 * h), ld16(W2 + (size_t)(32 * w + r) * 256 + 16 * s + 8 * h), acc);
    const int e_ = 32 * w + r;
    if (kv == 0) {
#pragma unroll
      for (int e = 0; e < 16; ++e) { const int n = n0 + crow(e, h); p.KC[((size_t)bg * 512 + n) * 64 + e_] = (n < 511) ? f2bf(acc[e]) : (bf16_t)0; }
    } else {
#pragma unroll
      for (int g4 = 0; g4 < 4; ++g4) {
        const int n = n0 + 8 * g4 + 4 * h;
        float v3 = (n + 3 < 511) ? acc[4 * g4 + 3] : 0.f;
        *(uint2*)(p.VCT + ((size_t)bg * 64 + e_) * 512 + n) = pack4(acc[4 * g4], acc[4 * g4 + 1], acc[4 * g4 + 2], v3);
      }
    }
  }
  __syncthreads();
}
DI void kmax_body(const Params& p, int idx) {
  const int g = idx & 1, t = idx >> 1, b = t >> 13;
  const bf16_t* k = p.NKS + (size_t)t * 128 + g * 64; const bf16_t* kw = p.NKW + (size_t)t * 128 + g * 64;
  float ss = 0.f, sw = 0.f;
  for (int d = 0; d < 64; ++d) { float v = bf2f(k[d]); ss += v * v; float u = bf2f(kw[d]); sw += u * u; }
  float m1 = sqrtf(ss), m2 = sqrtf(sw);
  for (int o = 32; o; o >>= 1) { m1 = fmaxf(m1, __shfl_xor(m1, o)); m2 = fmaxf(m2, __shfl_xor(m2, o)); }
}
DI void kmax_body2(const Params& p, int vb) {
  const int tid = threadIdx.x, g = tid & 1, t = vb * 256 + (tid >> 1), b = t >> 13;
  const bf16_t* k = p.NKS + (size_t)t * 128 + g * 64; const bf16_t* kw = p.NKW + (size_t)t * 128 + g * 64;
  float ss = 0.f, sw = 0.f;
  for (int d = 0; d < 64; d += 8) {
    uint4 a = *(const uint4*)(k + d), c = *(const uint4*)(kw + d);
    const unsigned aa[4] = {a.x, a.y, a.z, a.w}, cc[4] = {c.x, c.y, c.z, c.w};
#pragma unroll
    for (int q = 0; q < 4; ++q) {
      float x0 = __uint_as_float(aa[q] << 16), x1 = __uint_as_float(aa[q] & 0xffff0000u);
      float y0 = __uint_as_float(cc[q] << 16), y1 = __uint_as_float(cc[q] & 0xffff0000u);
      ss += x0 * x0 + x1 * x1; sw += y0 * y0 + y1 * y1;
    }
  }
  float m1 = sqrtf(ss), m2 = sqrtf(sw);
  for (int o = 2; o < 64; o <<= 1) { m1 = fmaxf(m1, __shfl_xor(m1, o)); m2 = fmaxf(m2, __shfl_xor(m2, o)); }
  if ((tid & 63) < 2) { atomicMax(&p.ksmax[b * 2 + g], __float_as_uint(m1)); atomicMax(&p.ksmax[4 + b * 2 + g], __float_as_uint(m2)); }
}
DI void kcmax_body(const Params& p, int idx) {
  const bf16_t* k = p.KC + (size_t)idx * 64;
  float ss = 0.f;
  for (int d = 0; d < 64; ++d) { float v = bf2f(k[d]); ss += v * v; }
  atomicMax(&p.ksmax[8 + (idx >> 9)], __float_as_uint(sqrtf(ss)));
}

#define QL_STRIDE 144
#define NSA_OS 36864
#define OS_STRIDE 260
#define NSA_LS (NSA_OS + 64 * OS_STRIDE * 4)
#define NSA_MB (NSA_LS + 1024)
#define NSA_SELM (NSA_MB + 1024)
#define NSA_LIST (NSA_SELM + 1024)
template <int CTRL> DI float dpp_f2(float x) { return __builtin_bit_cast(float, __builtin_amdgcn_mov_dpp(__builtin_bit_cast(int, x), CTRL, 0xf, 0xf, true)); }
DI float quad_sum(float v) { v += dpp_f2<0xB1>(v); v += dpp_f2<0x4E>(v); return v; }

DI void nsa_item(const Params& p, int item, char* smem) {
  const int tid = threadIdx.x, lane = tid & 63, w = tid >> 6, r = lane & 31, h = lane >> 5;
  const int ti = item >> 2, bg = item & 3, b = bg >> 1, g = bg & 1;
  const int ts = ti * 64, tokg0 = b * SEQ + ts;
  const int tkl = 8 * w + (r >> 2), hl = r & 3, hd = g * 4 + hl, tpos = ts + tkl, row = tkl * 4 + hl;
  char* QL = smem;
  float* OS = (float*)(smem + NSA_OS);
  float* IMPA = OS; float* IMPB = OS + 64 * 128;
  float* LS = (float*)(smem + NSA_LS);
  float* MB = (float*)(smem + NSA_MB);
  unsigned* SELM = (unsigned*)(smem + NSA_SELM);
  int* LIST = (int*)(smem + NSA_LIST);
  const float ksm = __uint_as_float(p.ksmax[bg]), kwm = __uint_as_float(p.ksmax[4 + bg]), kcm = __uint_as_float(p.ksmax[8 + bg]);

  bf16x8 qf[4];
#pragma unroll
  for (int s = 0; s < 4; ++s) qf[s] = ld16(p.NQ + (size_t)(tokg0 + tkl) * 512 + hd * 64 + 16 * s + 8 * h);
  float qq = 0.f;
#pragma unroll
  for (int s = 0; s < 4; ++s) {
    uint4 u = __builtin_bit_cast(uint4, qf[s]);
    const unsigned uu[4] = {u.x, u.y, u.z, u.w};
#pragma unroll
    for (int q = 0; q < 4; ++q) { float x0 = __uint_as_float(uu[q] << 16), x1 = __uint_as_float(uu[q] & 0xffff0000u); qq += x0 * x0 + x1 * x1; }
    *(bf16x8*)(QL + row * QL_STRIDE + (16 * s + 8 * h) * 2) = qf[s];
  }
  qq += __shfl_xor(qq, 32);
  const float qn = sqrtf(qq);
  if (h == 0) MB[row] = qn * ksm;
  for (int q = tid; q < 64 * 128 * 2 / 4; q += NT) ((float4*)IMPA)[q] = make_float4(0.f, 0.f, 0.f, 0.f);
  __syncthreads();

  const float mbc = qn * kcm;
  int nvalid = (tpos >= 31) ? ((tpos - 31) >> 4) + 1 : 0;
  if (nvalid > 511) nvalid = 511;
  int nvw = (ts + 8 * w + 7 >= 31) ? ((ts + 8 * w + 7 - 31) >> 4) + 1 : 0;
  if (nvw > 511) nvw = 511;
  const int nkt = (nvw + 31) >> 5;
  const bf16_t* kcb = p.KC + ((size_t)bg * 512 + r) * 64 + 8 * h;
  float lsum = 0.f;
  for (int kt = 0; kt < nkt; ++kt) {
    f32x16 sa = zero16();
#pragma unroll
    for (int s = 0; s < 4; ++s) sa = MFMA32(ld16(kcb + (size_t)kt * 32 * 64 + 16 * s), qf[s], sa);
#pragma unroll
    for (int e = 0; e < 16; ++e) { const int n = 32 * kt + crow(e, h); lsum += (n < nvalid) ? __expf(sa[e] - mbc) : 0.f; }
  }
  lsum += __shfl_xor(lsum, 32);
  const float invl = (lsum > 0.f) ? 1.f / lsum : 0.f;
  for (int kt = 0; kt < nkt; ++kt) {
    f32x16 sa = zero16();
#pragma unroll
    for (int s = 0; s < 4; ++s) sa = MFMA32(ld16(kcb + (size_t)kt * 32 * 64 + 16 * s), qf[s], sa);
    float pv[16];
#pragma unroll
    for (int e = 0; e < 16; ++e) { const int n = 32 * kt + crow(e, h); pv[e] = (n < nvalid) ? __expf(sa[e] - mbc) * invl : 0.f; }
#pragma unroll
    for (int q = 0; q < 4; ++q) {
      float A = 2.f * (pv[4 * q] + pv[4 * q + 1] + pv[4 * q + 2]) + pv[4 * q + 3], Bv = pv[4 * q + 3];
      A = quad_sum(A); Bv = quad_sum(Bv);
      if (hl == 0) { const int j = 8 * kt + 2 * q + h; IMPA[tkl * 128 + j] = A; IMPB[tkl * 128 + j] = Bv; }
    }
  }
  for (int tk = 0; tk < 8; ++tk) {
    const int tl = 8 * w + tk;
    unsigned long long key[2];
#pragma unroll
    for (int c2 = 0; c2 < 2; ++c2) {
      const int j = lane + 64 * c2;
      float imp = IMPA[tl * 128 + j] + ((j > 0) ? IMPB[tl * 128 + j - 1] : 0.f);
      if (j == 0 || j == ti || j == ti - 1) imp = 1e9f;
      key[c2] = (j <= ti) ? ((((unsigned long long)__float_as_uint(imp)) << 8) | (unsigned long long)(127 - j)) + 1ull : 0ull;
    }
    unsigned m0 = 0, m1 = 0, m2 = 0, m3 = 0;
    for (int it = 0; it < 16; ++it) {
      unsigned long long k = key[0] > key[1] ? key[0] : key[1];
#pragma unroll
      for (int o = 32; o; o >>= 1) {
        unsigned lo = (unsigned)k, hi = (unsigned)(k >> 32);
        unsigned lo2 = __shfl_xor(lo, o), hi2 = __shfl_xor(hi, o);
        unsigned long long k2 = ((unsigned long long)hi2 << 32) | lo2;
        k = k2 > k ? k2 : k;
      }
      if (k == 0ull) break;
      const int js = 127 - (int)((k - 1ull) & 255ull);
      const unsigned bit = 1u << (js & 31);
      if ((js >> 5) == 0) m0 |= bit; else if ((js >> 5) == 1) m1 |= bit; else if ((js >> 5) == 2) m2 |= bit; else m3 |= bit;
      if (key[0] == k) key[0] = 0ull;
      if (key[1] == k) key[1] = 0ull;
    }
    if (lane == 0) { SELM[tl * 4 + 0] = m0; SELM[tl * 4 + 1] = m1; SELM[tl * 4 + 2] = m2; SELM[tl * 4 + 3] = m3; }
  }
  __syncthreads();
  for (int q = tid; q < (64 * OS_STRIDE + 256) / 4; q += NT) ((float4*)OS)[q] = make_float4(0.f, 0.f, 0.f, 0.f);
  __syncthreads();
  for (int j = w; j <= ti; j += 8) {
    const unsigned bit = (SELM[lane * 4 + (j >> 5)] >> (j & 31)) & 1u;
    const unsigned long long M = __ballot(bit);
    const int cnt = __popcll(M);
    if (cnt == 0) continue;
    if (bit) LIST[w * 64 + __popcll(M & ((1ull << lane) - 1ull))] = lane;
    bf16x8 kf[2][4], vf[2][2][2];
#pragma unroll
    for (int kh = 0; kh < 2; ++kh)
#pragma unroll
      for (int s = 0; s < 4; ++s) kf[kh][s] = ld16(p.NKS + ((size_t)(b * SEQ + 64 * j + 32 * kh + r)) * 128 + g * 64 + 16 * s + 8 * h);
#pragma unroll
    for (int di = 0; di < 2; ++di)
#pragma unroll
      for (int kh = 0; kh < 2; ++kh)
#pragma unroll
        for (int s2 = 0; s2 < 2; ++s2) vf[di][kh][s2] = ld8x2(p.NVST + ((size_t)bg * 64 + 32 * di + r) * SEQ + 64 * j + 32 * kh + 16 * s2 + 4 * h);
    const int nch = (cnt + 7) >> 3;
    for (int q = 0; q < nch; ++q) {
      const int slot = 8 * q + (r >> 2);
      const bool valid = slot < cnt;
      const int tk = LIST[w * 64 + (valid ? slot : 0)];
      const int rw = tk * 4 + hl;
      bf16x8 qg[4];
#pragma unroll
      for (int s = 0; s < 4; ++s) qg[s] = *(const bf16x8*)(QL + rw * QL_STRIDE + (16 * s + 8 * h) * 2);
      const float mb = MB[rw];
      bf16x8 pk[2][2];
      float lp = 0.f;
#pragma unroll
      for (int kh = 0; kh < 2; ++kh) {
        f32x16 sa = zero16();
#pragma unroll
        for (int s = 0; s < 4; ++s) sa = MFMA32(kf[kh][s], qg[s], sa);
        float pv[16];
#pragma unroll
        for (int e = 0; e < 16; ++e) {
          const int key = 32 * kh + crow(e, h);
          const bool ok = valid && ((j < ti) || (key <= tk));
          pv[e] = ok ? __expf(sa[e] - mb) : 0.f; lp += pv[e];
        }
        pk[kh][0] = pack8(pv[0], pv[1], pv[2], pv[3], pv[4], pv[5], pv[6], pv[7]);
        pk[kh][1] = pack8(pv[8], pv[9], pv[10], pv[11], pv[12], pv[13], pv[14], pv[15]);
      }
      f32x16 o2[2]; o2[0] = zero16(); o2[1] = zero16();
#pragma unroll
      for (int di = 0; di < 2; ++di)
#pragma unroll
        for (int kh = 0; kh < 2; ++kh)
#pragma unroll
          for (int s2 = 0; s2 < 2; ++s2) o2[di] = MFMA32(vf[di][kh][s2], pk[kh][s2], o2[di]);
      if (valid) {
        atomicAdd(&LS[rw], lp);
#pragma unroll
        for (int di = 0; di < 2; ++di)
#pragma unroll
          for (int e = 0; e < 16; ++e) atomicAdd(&OS[(32 * di + crow(e, h)) * OS_STRIDE + rw], o2[di][e]);
      }
    }
  }
#pragma unroll
  for (int s = 0; s < 4; ++s) qf[s] = *(const bf16x8*)(QL + row * QL_STRIDE + (16 * s + 8 * h) * 2);
  f32x16 oc[2]; oc[0] = zero16(); oc[1] = zero16();
  for (int kt = 0; kt < nkt; ++kt) {
    f32x16 sa = zero16();
#pragma unroll
    for (int s = 0; s < 4; ++s) sa = MFMA32(ld16(kcb + (size_t)kt * 32 * 64 + 16 * s), qf[s], sa);
    float pv[16];
#pragma unroll
    for (int e = 0; e < 16; ++e) { const int n = 32 * kt + crow(e, h); pv[e] = (n < nvalid) ? __expf(sa[e] - mbc) * invl : 0.f; }
#pragma unroll
    for (int s2 = 0; s2 < 2; ++s2) {
      bf16x8 bfr = pack8(pv[8 * s2], pv[8 * s2 + 1], pv[8 * s2 + 2], pv[8 * s2 + 3], pv[8 * s2 + 4], pv[8 * s2 + 5], pv[8 * s2 + 6], pv[8 * s2 + 7]);
#pragma unroll
      for (int di = 0; di < 2; ++di) oc[di] = MFMA32(ld8x2(p.VCT + ((size_t)bg * 64 + 32 * di + r) * 512 + 32 * kt + 16 * s2 + 4 * h), bfr, oc[di]);
    }
  }
  const float mbw = qn * kwm;
  f32x16 ow[2]; ow[0] = zero16(); ow[1] = zero16();
  float lw = 0.f;
  {
    int lo = ts + 8 * w - 511; if (lo < 0) lo = 0;
    const int kt0 = lo >> 5, kt1 = (ts + 8 * w + 7) >> 5;
    for (int kt = kt0; kt <= kt1; ++kt) {
      f32x16 sa = zero16();
      const bf16_t* kp = p.NKW + ((size_t)(b * SEQ + 32 * kt + r)) * 128 + g * 64 + 8 * h;
#pragma unroll
      for (int s = 0; s < 4; ++s) sa = MFMA32(ld16(kp + 16 * s), qf[s], sa);
      float pv[16];
#pragma unroll
      for (int e = 0; e < 16; ++e) {
        const int pos = 32 * kt + crow(e, h);
        const bool ok = (pos <= tpos) && (pos > tpos - 512);
        pv[e] = ok ? __expf(sa[e] - mbw) : 0.f; lw += pv[e];
      }
#pragma unroll
      for (int s2 = 0; s2 < 2; ++s2) {
        bf16x8 bfr = pack8(pv[8 * s2], pv[8 * s2 + 1], pv[8 * s2 + 2], pv[8 * s2 + 3], pv[8 * s2 + 4], pv[8 * s2 + 5], pv[8 * s2 + 6], pv[8 * s2 + 7]);
#pragma unroll
        for (int di = 0; di < 2; ++di) ow[di] = MFMA32(ld8x2(p.NVWT + ((size_t)bg * 64 + 32 * di + r) * SEQ + 32 * kt + 16 * s2 + 4 * h), bfr, ow[di]);
      }
    }
    lw += __shfl_xor(lw, 32);
  }
  __syncthreads();
  {
    const float ls = LS[row];
    const float invs = 1.f / ls, invw = 1.f / lw;
    const float* gt = p.GATE + (size_t)(tokg0 + tkl) * 24 + hd * 3;
    const float g0 = gt[0], g1 = gt[1] * invs, g2 = gt[2] * invw;
#pragma unroll
    for (int di = 0; di < 2; ++di)
#pragma unroll
      for (int g4 = 0; g4 < 4; ++g4) {
        const int d0 = 32 * di + 8 * g4 + 4 * h;
        float y[4];
#pragma unroll
        for (int e = 0; e < 4; ++e) y[e] = g0 * oc[di][4 * g4 + e] + g1 * OS[(d0 + e) * OS_STRIDE + row] + g2 * ow[di][4 * g4 + e];
        *(uint2*)(p.RA + (size_t)(tokg0 + tkl) * DM + 512 + hd * 64 + d0) = pack4(y[0], y[1], y[2], y[3]);
      }
  }
  __syncthreads();
}

typedef float f32x4 __attribute__((ext_vector_type(4)));
#define MFMA16(a, b, c) __builtin_amdgcn_mfma_f32_16x16x32_bf16((a), (b), (c), 0, 0, 0)
constexpr int pk_clen(int i) { return 16 / (i + 1); }
constexpr int pk_coff(int i) { int s = 0; for (int q = 0; q < i; ++q) s += pk_clen(q); return s; }
#define SC_STRIDE 132

DI void peer_topk_tile(const Params& p, int vb, char* smem) {
  float* SC = (float*)smem;
  unsigned* ELK = (unsigned*)(smem + 256 * SC_STRIDE * 4);
  float* ELW = (float*)(ELK + 16 * 128);
  const int tid = threadIdx.x, lane = tid & 63, w = tid >> 6;
  const int t0 = vb * 16;
  {
    const int tq = lane & 15, kq = lane >> 4;
#pragma unroll
    for (int pi = 0; pi < 2; ++pi) {
      const int ph = 2 * w + pi;
      bf16x8 bfr[4];
#pragma unroll
      for (int s = 0; s < 4; ++s) bfr[s] = *(const bf16x8*)(p.PQ + (size_t)(t0 + tq) * 2048 + ph * 128 + 32 * s + 8 * kq);
#pragma unroll
      for (int j = 0; j < 8; ++j) {
        f32x4 acc = {0.f, 0.f, 0.f, 0.f};
#pragma unroll
        for (int s = 0; s < 4; ++s) {
          bf16x8 afr = *(const bf16x8*)(p.SUBK + ((size_t)(ph * 128 + 16 * j + tq)) * 128 + 32 * s + 8 * kq);
          acc = MFMA16(afr, bfr[s], acc);
        }
        *(f32x4*)(SC + (ph * 16 + tq) * SC_STRIDE + 16 * j + 4 * kq) = acc;
      }
    }
  }
  __syncthreads();
  if (tid < 256) {
    float* row = SC + tid * SC_STRIDE;
    float gmax[16];
#pragma unroll
    for (int g = 0; g < 16; ++g) {
      float4 a = *(float4*)(row + g * 8), b = *(float4*)(row + g * 8 + 4);
      gmax[g] = fmaxf(fmaxf(fmaxf(a.x, a.y), fmaxf(a.z, a.w)), fmaxf(fmaxf(b.x, b.y), fmaxf(b.z, b.w)));
    }
    float outv[16]; int outi[16];
#pragma unroll
    for (int k = 0; k < 16; ++k) {
      float gm = gmax[0]; int gi = 0;
#pragma unroll
      for (int g = 1; g < 16; ++g) { bool c = gmax[g] > gm; gm = c ? gmax[g] : gm; gi = c ? g : gi; }
      float* gp = row + gi * 8;
      float4 a = *(float4*)gp, b = *(float4*)(gp + 4);
      float v[8] = {a.x, a.y, a.z, a.w, b.x, b.y, b.z, b.w};
      int ei = 7;
#pragma unroll
      for (int e = 6; e >= 0; --e) ei = (v[e] == gm) ? e : ei;
      float nm = NEG_INF;
#pragma unroll
      for (int e = 0; e < 8; ++e) { float x = (e == ei) ? NEG_INF : v[e]; nm = fmaxf(nm, x); }
      gp[ei] = NEG_INF;
#pragma unroll
      for (int g = 0; g < 16; ++g) gmax[g] = (g == gi) ? nm : gmax[g];
      outv[k] = gm; outi[k] = gi * 8 + ei;
    }
#pragma unroll
    for (int k = 0; k < 16; ++k) { row[k] = outv[k]; row[16 + k] = __int_as_float(outi[k]); }
  }
  __syncthreads();
  if (tid < 128) {
    const int t = tid >> 3, pp = tid & 7;
    const float* ra = SC + ((2 * pp) * 16 + t) * SC_STRIDE;
    const float* rb = SC + ((2 * pp + 1) * 16 + t) * SC_STRIDE;
    float a[16], b[16]; int ia[16], ib[16];
#pragma unroll
    for (int q = 0; q < 4; ++q) {
      float4 x = *(const float4*)(ra + 4 * q), y = *(const float4*)(rb + 4 * q);
      float4 xi = *(const float4*)(ra + 16 + 4 * q), yi = *(const float4*)(rb + 16 + 4 * q);
      a[4 * q] = x.x; a[4 * q + 1] = x.y; a[4 * q + 2] = x.z; a[4 * q + 3] = x.w;
      b[4 * q] = y.x; b[4 * q + 1] = y.y; b[4 * q + 2] = y.z; b[4 * q + 3] = y.w;
      ia[4 * q] = __float_as_int(xi.x); ia[4 * q + 1] = __float_as_int(xi.y); ia[4 * q + 2] = __float_as_int(xi.z); ia[4 * q + 3] = __float_as_int(xi.w);
      ib[4 * q] = __float_as_int(yi.x); ib[4 * q + 1] = __float_as_int(yi.y); ib[4 * q + 2] = __float_as_int(yi.z); ib[4 * q + 3] = __float_as_int(yi.w);
    }
    float cs[50]; int cc[50];
#pragma unroll
    for (int i = 0; i < 16; ++i)
#pragma unroll
      for (int j = 0; j < pk_clen(i); ++j) { cs[pk_coff(i) + j] = a[i] + b[j]; cc[pk_coff(i) + j] = ia[i] * 128 + ib[j]; }
    float v16[16]; int c16[16];
#pragma unroll
    for (int k = 0; k < 16; ++k) {
      float best = cs[0]; int bi = 0, bc = cc[0];
#pragma unroll
      for (int q = 1; q < 50; ++q) { bool c = cs[q] > best; best = c ? cs[q] : best; bi = c ? q : bi; bc = c ? cc[q] : bc; }
#pragma unroll
      for (int q = 0; q < 50; ++q) cs[q] = (q == bi) ? NEG_INF : cs[q];
      v16[k] = best; c16[k] = bc;
    }
    float l = 0.f; const float vmax = v16[0];
#pragma unroll
    for (int k = 0; k < 16; ++k) { v16[k] = __expf(v16[k] - vmax); l += v16[k]; }
    float inv = 1.f / l;
#pragma unroll
    for (int k = 0; k < 16; ++k) {
      ELK[t * 128 + pp * 16 + k] = ((unsigned)c16[k] << 7) | (unsigned)(pp * 16 + k);
      ELW[t * 128 + pp * 16 + k] = v16[k] * inv;
    }
  }
  __syncthreads();
#pragma unroll
  for (int tt = 0; tt < 2; ++tt) {
    const int t = 2 * w + tt;
    unsigned e0 = ELK[t * 128 + 2 * lane], e1 = ELK[t * 128 + 2 * lane + 1];
#pragma unroll
    for (int k = 2; k <= 128; k <<= 1) {
#pragma unroll
      for (int j = k >> 1; j > 0; j >>= 1) {
        if (j == 1) {
          bool up = ((2 * lane) & k) == 0;
          unsigned lo = min(e0, e1), hi = max(e0, e1);
          e0 = up ? lo : hi; e1 = up ? hi : lo;
        } else {
          unsigned o0 = __shfl_xor(e0, j >> 1), o1 = __shfl_xor(e1, j >> 1);
          bool up = ((2 * lane) & k) == 0;
          bool lower = ((2 * lane) & j) == 0;
          bool keepmin = (up == lower);
          e0 = keepmin ? min(e0, o0) : max(e0, o0);
          e1 = keepmin ? min(e1, o1) : max(e1, o1);
        }
      }
    }
    const size_t gb = (size_t)(t0 + t) * 128 + 2 * lane;
    p.EIDX[gb] = (int)(e0 >> 7); p.EIDX[gb + 1] = (int)(e1 >> 7);
    p.EW[gb] = ELW[t * 128 + (e0 & 127)]; p.EW[gb + 1] = ELW[t * 128 + (e1 & 127)];
  }
  __syncthreads();
}

DI float dot2bf(unsigned a, unsigned b, float acc) { return __builtin_amdgcn_fdot2_f32_bf16(__builtin_bit_cast(bf16x2_t, a), __builtin_bit_cast(bf16x2_t, b), acc, false); }
template <int CTRL> DI float dpp_f(float x) { return __builtin_bit_cast(float, __builtin_amdgcn_mov_dpp(__builtin_bit_cast(int, x), CTRL, 0xf, 0xf, true)); }
DI float row16_sum(float v) { v += dpp_f<0x128>(v); v += dpp_f<0x124>(v); v += dpp_f<0x122>(v); v += dpp_f<0x121>(v); return v; }
DI float dot_row(const uint4 (&u)[8], const uint4 (&h)[8]) {
  float d = 0.f;
#pragma unroll
  for (int j = 0; j < 8; ++j) { d = dot2bf(u[j].x, h[j].x, d); d = dot2bf(u[j].y, h[j].y, d); d = dot2bf(u[j].z, h[j].z, d); d = dot2bf(u[j].w, h[j].w, d); }
  return row16_sum(d);
}
DI void axpy_row(float (&acc)[64], const uint4 (&v)[8], float c) {
#pragma unroll
  for (int j = 0; j < 8; ++j) {
    const unsigned ww[4] = {v[j].x, v[j].y, v[j].z, v[j].w};
#pragma unroll
    for (int q = 0; q < 4; ++q) {
      acc[j * 8 + 2 * q] += c * __uint_as_float(ww[q] << 16);
      acc[j * 8 + 2 * q + 1] += c * __uint_as_float(ww[q] & 0xffff0000u);
    }
  }
}
#define PEER_TILE_SHIFT 8
DI void peer_gather_block(const Params& p, int vb, char* smem) {
  unsigned* ELK = (unsigned*)smem;
  float* ELC = (float*)(smem + 32768);
  const int tid = threadIdx.x, lane = tid & 63, w = tid >> 6, grp = lane >> 4, i = lane & 15;
  const int tokbase = vb * 64;
  for (int q = tid; q < 64 * 128 / 4; q += NT) {
    ((uint4*)ELK)[q] = ((const uint4*)(p.EIDX + (size_t)tokbase * 128))[q];
    ((float4*)ELC)[q] = ((const float4*)(p.EW + (size_t)tokbase * 128))[q];
  }
  __syncthreads();
  const int tl0 = w * 8 + grp * 2;
  const unsigned* k0 = ELK + tl0 * 128; const unsigned* k1 = k0 + 128;
  float* c0 = ELC + tl0 * 128; float* c1 = c0 + 128;
  {
    uint4 h0[8], h1[8];
#pragma unroll
    for (int j = 0; j < 8; ++j) {
      h0[j] = *(const uint4*)(p.RA + (size_t)(tokbase + tl0) * DM + j * 128 + i * 8);
      h1[j] = *(const uint4*)(p.RA + (size_t)(tokbase + tl0 + 1) * DM + j * 128 + i * 8);
    }
    int ptr0 = 0, ptr1 = 0;
    for (int tile = 0; tile < (16384 >> PEER_TILE_SHIFT); ++tile) {
      for (;;) {
        const unsigned ea = k0[min(ptr0, 127)], eb = k1[min(ptr1, 127)];
        const bool hasA = (ptr0 < 128) && ((int)(ea >> PEER_TILE_SHIFT) == tile);
        const bool hasB = (ptr1 < 128) && ((int)(eb >> PEER_TILE_SHIFT) == tile);
        if (!__any(hasA || hasB)) break;
        uint4 ua[8], ub[8];
        if (hasA) {
#pragma unroll
          for (int j = 0; j < 8; ++j) ua[j] = *(const uint4*)(p.PDN + (size_t)ea * DM + j * 128 + i * 8);
        }
        if (hasB) {
#pragma unroll
          for (int j = 0; j < 8; ++j) ub[j] = *(const uint4*)(p.PDN + (size_t)eb * DM + j * 128 + i * 8);
        }
        if (hasA) {
          float d = dot_row(ua, h0);
          float cf = c0[ptr0] * gelu_tanh(d);
          if (i == 0) c0[ptr0] = cf;
          ++ptr0;
        }
        if (hasB) {
          float d = dot_row(ub, h1);
          float cf = c1[ptr1] * gelu_tanh(d);
          if (i == 0) c1[ptr1] = cf;
          ++ptr1;
        }
      }
    }
  }
  float acc0[64], acc1[64];
#pragma unroll
  for (int e = 0; e < 64; ++e) { acc0[e] = 0.f; acc1[e] = 0.f; }
  {
    int ptr0 = 0, ptr1 = 0;
    for (int tile = 0; tile < (16384 >> PEER_TILE_SHIFT); ++tile) {
      for (;;) {
        const unsigned ea = k0[min(ptr0, 127)], eb = k1[min(ptr1, 127)];
        const bool hasA = (ptr0 < 128) && ((int)(ea >> PEER_TILE_SHIFT) == tile);
        const bool hasB = (ptr1 < 128) && ((int)(eb >> PEER_TILE_SHIFT) == tile);
        if (!__any(hasA || hasB)) break;
        uint4 ua[8], ub[8];
        if (hasA) {
#pragma unroll
          for (int j = 0; j < 8; ++j) ua[j] = *(const uint4*)(p.PUP + (size_t)ea * DM + j * 128 + i * 8);
        }
        if (hasB) {
#pragma unroll
          for (int j = 0; j < 8; ++j) ub[j] = *(const uint4*)(p.PUP + (size_t)eb * DM + j * 128 + i * 8);
        }
        if (hasA) { axpy_row(acc0, ua, c0[ptr0]); ++ptr0; }
        if (hasB) { axpy_row(acc1, ub, c1[ptr1]); ++ptr1; }
      }
    }
  }
#pragma unroll
  for (int tt = 0; tt < 2; ++tt) {
    const int tok = tokbase + tl0 + tt, b = tok >> 13;
    const float* ga2 = p.mod + b * 6144 + 5120;
    float* orow = p.out + (size_t)tok * DM;
    float ss = 0.f;
#pragma unroll
    for (int j = 0; j < 8; ++j)
#pragma unroll
      for (int hf = 0; hf < 2; ++hf) {
        const int col = j * 128 + i * 8 + hf * 4;
        float4 x1 = *(const float4*)(orow + col), gg = *(const float4*)(ga2 + col);
        float* a = (tt == 0 ? acc0 : acc1) + j * 8 + hf * 4;
        a[0] = x1.x + gg.x * a[0]; a[1] = x1.y + gg.y * a[1]; a[2] = x1.z + gg.z * a[2]; a[3] = x1.w + gg.w * a[3];
        ss += a[0] * a[0] + a[1] * a[1] + a[2] * a[2] + a[3] * a[3];
      }
    ss = row16_sum(ss);
    const float rstd = rsqrtf(ss * (1.f / DM) + 1e-6f);
#pragma unroll
    for (int j = 0; j < 8; ++j)
#pragma unroll
      for (int hf = 0; hf < 2; ++hf) {
        const int col = j * 128 + i * 8 + hf * 4;
        float4 gf = *(const float4*)(p.g_final + col);
        const float* a = (tt == 0 ? acc0 : acc1) + j * 8 + hf * 4;
        float4 o4; o4.x = a[0] * rstd * gf.x; o4.y = a[1] * rstd * gf.y; o4.z = a[2] * rstd * gf.z; o4.w = a[3] * rstd * gf.w;
        *(float4*)(orow + col) = o4;
      }
  }
  __syncthreads();
}
DI void convert_tables(const Params& p, int v) {
  const int tb = v >> 12; const size_t base = (size_t)(v & 4095) * 4096 + threadIdx.x * 8;
  const float* src = (tb ? p.peer_up : p.peer_down) + base;
  float4 a = *(const float4*)src, b = *(const float4*)(src + 4);
  uint2 lo = pack4(a.x, a.y, a.z, a.w), hi = pack4(b.x, b.y, b.z, b.w);
  uint4 o; o.x = lo.x; o.y = lo.y; o.z = hi.x; o.w = hi.y;
  *(uint4*)((tb ? p.PUP : p.PDN) + base) = o;
}

#define N_PHASES 11
template <int PH>
DI void run_phase(const Params& p, char* smem) {
  const int nb = gridDim.x, bid = blockIdx.x, tid = threadIdx.x;
  if (PH == 0) {
    for (int vb = bid; vb < PH0_NVB; vb += nb) ph0_body(p, vb, smem);
  } else if (PH == 1) {
    for (int vb = bid; vb < T_TOK / 8; vb += nb) rownorm_body(p.x, p.g_mix, p.mod, 0, 1024, p.RA, vb);
  } else if (PH == 2) {
    EpiProj e{p};
    for (int vb = bid; vb < 64 * 27; vb += nb) gemm_tile(p.RA, p.WinT, 1024, (vb & 63) * 256, (vb >> 6) * 128, smem, e);
  } else if (PH == 3) {
    for (int vb = bid; vb < 512 + 128 + 64; vb += nb) {
      if (vb < 512) retkv_mfma(p, vb);
      else if (vb < 512 + 128) compress_mfma(p, vb - 512, smem);
      else kmax_body2(p, vb - 640);
    }
  } else if (PH == 4) {
    for (int vb = bid; vb < 256 + 4; vb += nb) {
      if (vb < 256) scan_body(p, vb * NT + tid);
      else kcmax_body(p, (vb - 256) * NT + tid);
    }
  } else if (PH == 5) {
    for (int vb = bid; vb < 768; vb += nb) {
      if (vb >= 256 && vb < 512) retout_mfma(p, (vb - 256) * 8 + (tid >> 6));
      else nsa_item(p, (vb < 256) ? vb : 1023 - vb, smem);
    }
  } else if (PH == 6) {
    EpiOut e{p};
    for (int vb = bid; vb < 64 * 8; vb += nb) gemm_tile(p.RA, p.WoutT, 1024, (vb & 63) * 256, (vb >> 6) * 128, smem, e);
  } else if (PH == 7) {
    for (int vb = bid; vb < T_TOK / 8 + 8192; vb += nb) {
      if (vb < T_TOK / 8) rownorm_body(p.out, p.g_ffn, p.mod, 3072, 4096, p.RA, vb);
      else convert_tables(p, vb - T_TOK / 8);
    }
  } else if (PH == 8) {
    EpiPQ e{p};
    for (int vb = bid; vb < 64 * 16; vb += nb) gemm_tile(p.RA, p.WqT, 1024, (vb & 63) * 256, (vb >> 6) * 128, smem, e);
  } else if (PH == 9) {
    for (int vb = bid; vb < T_TOK / 16; vb += nb) peer_topk_tile(p, vb, smem);
  } else if (PH == 10) {
    for (int vb = bid; vb < T_TOK / 64; vb += nb) peer_gather_block(p, vb, smem);
  }
}

#define SMEM_BYTES 155648

__global__ void __launch_bounds__(NT) k_mega(Params p) {
  extern __shared__ __attribute__((aligned(16))) char smem[];
  cg::grid_group grid = cg::this_grid();
  run_phase<0>(p, smem); grid.sync();
  run_phase<1>(p, smem); grid.sync();
  run_phase<2>(p, smem); grid.sync();
  run_phase<3>(p, smem); grid.sync();
  run_phase<4>(p, smem); grid.sync();
  run_phase<5>(p, smem); grid.sync();
  run_phase<6>(p, smem); grid.sync();
  run_phase<7>(p, smem); grid.sync();
  run_phase<8>(p, smem); grid.sync();
  run_phase<9>(p, smem); grid.sync();
  run_phase<10>(p, smem);
}
#ifdef MK_MULTI
template <int PH>
__global__ void __launch_bounds__(NT) k_single(Params p) {
  extern __shared__ __attribute__((aligned(16))) char smem[];
  run_phase<PH>(p, smem);
}
#endif

static size_t carve(size_t& off, size_t bytes) { size_t o = off; off += (bytes + 255) & ~(size_t)255; return o; }

extern "C" void kernel_launch(void* const* d_in, const int* in_sizes, int n_in, void* d_out, int out_size, void* d_ws, size_t ws_size,
                              hipStream_t stream) {
  Params p{};
  p.x = (const float*)d_in[0]; p.c = (const float*)d_in[1]; p.w_ada = (const float*)d_in[2]; p.b_ada = (const float*)d_in[3];
  p.g_mix = (const float*)d_in[4]; p.w_in = (const float*)d_in[5]; p.pe_k = (const float*)d_in[6]; p.pe_v = (const float*)d_in[7];
  p.w_k1 = (const float*)d_in[8]; p.b_k1 = (const float*)d_in[9]; p.w_k2 = (const float*)d_in[10]; p.w_v1 = (const float*)d_in[11];
  p.b_v1 = (const float*)d_in[12]; p.w_v2 = (const float*)d_in[13]; p.w_out = (const float*)d_in[14]; p.g_ffn = (const float*)d_in[15];
  p.w_pq = (const float*)d_in[16]; p.subkeys = (const float*)d_in[17]; p.peer_down = (const float*)d_in[18]; p.peer_up = (const float*)d_in[19];
  p.g_final = (const float*)d_in[20];
  p.out = (float*)d_out;
  char* ws = (char*)d_ws;
  size_t off = 0;
  p.mod = (float*)(ws + carve(off, 2 * 6144 * 4));
  p.ksmax = (unsigned*)(ws + carve(off, 256));
  p.c128 = (float*)(ws + carve(off, (size_t)SEQ * 64 * 4)); p.s128 = (float*)(ws + carve(off, (size_t)SEQ * 64 * 4));
  p.c64 = (float*)(ws + carve(off, (size_t)SEQ * 32 * 4)); p.s64 = (float*)(ws + carve(off, (size_t)SEQ * 32 * 4));
  p.WinT = (bf16_t*)(ws + carve(off, (size_t)NPROJ * 1024 * 2));
  p.WoutT = (bf16_t*)(ws + carve(off, (size_t)1024 * 1024 * 2));
  p.WqT = (bf16_t*)(ws + carve(off, (size_t)2048 * 1024 * 2));
  p.W1Tk = (bf16_t*)(ws + carve(off, (size_t)256 * 2048 * 2)); p.W1Tv = (bf16_t*)(ws + carve(off, (size_t)256 * 2048 * 2));
  p.W2Tk = (bf16_t*)(ws + carve(off, 64 * 256 * 2)); p.W2Tv = (bf16_t*)(ws + carve(off, 64 * 256 * 2));
  p.SUBK = (bf16_t*)(ws + carve(off, (size_t)16 * 128 * 128 * 2));
  p.B1Pk = (float*)(ws + carve(off, 1024)); p.B1Pv = (float*)(ws + carve(off, 1024));
  p.RA = (bf16_t*)(ws + carve(off, (size_t)T_TOK * 1024 * 2));
  size_t rb = off;
  p.RQ = (bf16_t*)(ws + carve(off, (size_t)T_TOK * 512 * 2)); p.RK = (bf16_t*)(ws + carve(off, (size_t)T_TOK * 512 * 2));
  p.RKT = (bf16_t*)(ws + carve(off, (size_t)T_TOK * 512 * 2)); p.RVT = (bf16_t*)(ws + carve(off, (size_t)T_TOK * 512 * 2));
  p.RGT = (bf16_t*)(ws + carve(off, (size_t)T_TOK * 512 * 2)); p.NQ = (bf16_t*)(ws + carve(off, (size_t)T_TOK * 512 * 2));
  p.NKC = (bf16_t*)(ws + carve(off, (size_t)T_TOK * 128 * 2)); p.NVC = (bf16_t*)(ws + carve(off, (size_t)T_TOK * 128 * 2));
  p.NKS = (bf16_t*)(ws + carve(off, (size_t)T_TOK * 128 * 2)); p.NKW = (bf16_t*)(ws + carve(off, (size_t)T_TOK * 128 * 2));
  p.NVST = (bf16_t*)(ws + carve(off, (size_t)T_TOK * 128 * 2)); p.NVWT = (bf16_t*)(ws + carve(off, (size_t)T_TOK * 128 * 2));
  p.GATE = (float*)(ws + carve(off, (size_t)T_TOK * 24 * 4));
  p.KV = (float*)(ws + carve(off, (size_t)512 * 16384 * 4));
  p.SPREV = (bf16_t*)(ws + carve(off, (size_t)512 * 16384 * 2));
  p.KC = (bf16_t*)(ws + carve(off, (size_t)4 * 512 * 64 * 2)); p.VCT = (bf16_t*)(ws + carve(off, (size_t)4 * 512 * 64 * 2));
  p.HID = (float*)(ws + carve(off, (size_t)2 * 2048 * 256 * 4));
  size_t off2 = rb;
  p.PQ = (bf16_t*)(ws + carve(off2, (size_t)T_TOK * 2048 * 2));
  p.EIDX = (int*)(ws + carve(off2, (size_t)T_TOK * 128 * 4));
  p.EW = (float*)(ws + carve(off2, (size_t)T_TOK * 128 * 4));
  p.PDN = (bf16_t*)(ws + carve(off2, (size_t)16384 * 1024 * 2));
  p.PUP = (bf16_t*)(ws + carve(off2, (size_t)16384 * 1024 * 2));
  (void)ws_size; (void)in_sizes; (void)n_in; (void)out_size;

#ifdef MK_MULTI
#define LAUNCH1(PH) { hipFuncSetAttribute((const void*)k_single<PH>, hipFuncAttributeMaxDynamicSharedMemorySize, SMEM_BYTES); k_single<PH><<<256, NT, SMEM_BYTES, stream>>>(p); }
  LAUNCH1(0) LAUNCH1(1) LAUNCH1(2) LAUNCH1(3) LAUNCH1(4) LAUNCH1(5) LAUNCH1(6) LAUNCH1(7) LAUNCH1(8) LAUNCH1(9) LAUNCH1(10)
#else
  static int grid_blocks = 0;
  if (!grid_blocks) {
    int dev = 0, cus = 0, per_cu = 0;
    (void)hipGetDevice(&dev);
    (void)hipDeviceGetAttribute(&cus, hipDeviceAttributeMultiprocessorCount, dev);
    (void)hipFuncSetAttribute((const void*)k_mega, hipFuncAttributeMaxDynamicSharedMemorySize, SMEM_BYTES);
    (void)hipOccupancyMaxActiveBlocksPerMultiprocessor(&per_cu, k_mega, NT, SMEM_BYTES);
    if (per_cu < 1) per_cu = 1;
    if (per_cu > 1) per_cu = 1;
    grid_blocks = cus * per_cu;
  }
  void* args[] = {&p};
  hipError_t e = hipLaunchCooperativeKernel((void*)k_mega, dim3(grid_blocks), dim3(NT), args, SMEM_BYTES, stream);
  if (e != hipSuccess) fprintf(stderr, "cooperative launch failed: %s (grid %d)\n", hipGetErrorString(e), grid_blocks);
#endif
}
```

```cpp
#include <hip/hip_runtime.h>
#include <hip/hip_bf16.h>
#include <hip/hip_cooperative_groups.h>
#include <stdint.h>
#include <stdio.h>
namespace cg = cooperative_groups;

typedef unsigned short bf16_t;
#define DI __device__ __forceinline__

DI int mytid() { int t = threadIdx.x; asm volatile("" : "+v"(t)); return t; }
DI float bf2f(bf16_t v) { return __uint_as_float(((unsigned)v) << 16); }
DI bf16_t f2bf(float x) { unsigned u = __float_as_uint(x); u += 0x7fffu + ((u >> 16) & 1u); return (bf16_t)(u >> 16); }
DI float gelu_tanh(float x) { float u = 0.7978845608028654f * (x + 0.044715f * x * x * x); return 0.5f * x * (1.f + tanhf(u)); }
DI float siluf(float x) { return x / (1.f + __expf(-x)); }
DI float sigmoidf(float x) { return 1.f / (1.f + __expf(-x)); }

#define T_TOK 16384
#define SEQ 8192
#define DM 1024
#define NPROJ 3456
#define NEG_INF (-__builtin_inff())

struct Params {
  const float *x, *c, *w_ada, *b_ada, *g_mix, *w_in, *pe_k, *pe_v, *w_k1, *b_k1, *w_k2, *w_v1, *b_v1, *w_v2, *w_out, *g_ffn,
      *w_pq, *subkeys, *peer_down, *peer_up, *g_final;
  float* out;
  float* gout;
  float* mod;
  unsigned* ksmax;
  float *c128, *s128, *c64, *s64;
  bf16_t *WinT, *WoutT, *WqT, *W1Tk, *W1Tv, *W2Tk, *W2Tv, *SUBK;
  float *B1Pk, *B1Pv;
  bf16_t* RA;
  bf16_t *RQ, *RK, *RKT, *RVT, *RGT, *NQ, *NKC, *NVC, *NKS, *NKW, *NVST, *NVWT;
  float* GATE;
  float* KV;
  bf16_t* SPREV;
  bf16_t *KC, *VCT;
  float* HID;
  bf16_t* PQ;
  int* EIDX;
  float* EW;
  bf16_t *PDN, *PUP;
};

DI float logg_h(int h) { return log1pf(-exp2f(-5.f - (float)h)); }


typedef __bf16 bf16x2_t __attribute__((ext_vector_type(2)));
typedef float f32x2_t __attribute__((ext_vector_type(2)));
DI unsigned cvt2(float a, float b) { f32x2_t v = {a, b}; bf16x2_t r = __builtin_convertvector(v, bf16x2_t); return __builtin_bit_cast(unsigned, r); }
DI uint2 pack4(float a, float b, float c, float d) { uint2 r; r.x = cvt2(a, b); r.y = cvt2(c, d); return r; }
#define NT 512
typedef short bf16x8 __attribute__((ext_vector_type(8)));
typedef float f32x16 __attribute__((ext_vector_type(16)));
#define MFMA32(a, b, c) __builtin_amdgcn_mfma_f32_32x32x16_bf16((a), (b), (c), 0, 0, 0)

DI int win_logical_col(int np) {
  int g = np >> 6, c = np & 63;
  if (g < 16) {
    int sec = g >> 3, hh = (g & 7) >> 1, j = g & 1, i = 32 * j + (c & 31);
    return sec * 512 + hh * 128 + ((c < 32) ? i : 64 + i);
  } else if (g < 52) return 1024 + (g - 16) * 64 + c;
  else if (g == 52) return (c < 24) ? 3328 + c : -1;
  return -1;
}

DI void tr_tile(const float* __restrict__ in, bf16_t* __restrict__ out, int K, int N_in, int k0, int n0, int mode, float* tile) {
  const int tid = mytid();
  {
    int nn = tid & 63, col = mode ? win_logical_col(n0 + nn) : (n0 + nn);
#pragma unroll
    for (int i = 0; i < 8; ++i) {
      int kk = (tid >> 6) + 8 * i;
      tile[kk * 65 + nn] = (col >= 0) ? in[(size_t)(k0 + kk) * N_in + col] : 0.f;
    }
  }
  __syncthreads();
  {
    int kk = tid & 63;
#pragma unroll
    for (int i = 0; i < 8; ++i) {
      int nn = (tid >> 6) + 8 * i;
      out[(size_t)(n0 + nn) * K + k0 + kk] = f2bf(tile[kk * 65 + nn]);
    }
  }
  __syncthreads();
}

#define PH0_MOD 96
#define PH0_WIN (PH0_MOD + 16 * 54)
#define PH0_WOUT (PH0_WIN + 256)
#define PH0_WQ (PH0_WOUT + 512)
#define PH0_W1K (PH0_WQ + 128)
#define PH0_W1V (PH0_W1K + 128)
#define PH0_W2K (PH0_W1V + 4)
#define PH0_W2V (PH0_W2K + 4)
#define PH0_SUBK (PH0_W2V + 512)
#define PH0_ROPE (PH0_SUBK + 1024)
#define PH0_B1P (PH0_ROPE + 8)
#define PH0_NVB PH0_B1P

DI void ph0_body(const Params& p, int vb, char* smem) {
  const int tid = mytid();
  float* fs = (float*)smem;
  if (vb < PH0_MOD) {
    int kg = tid >> 6, col = vb * 64 + (tid & 63);
    float a0 = 0.f, a1 = 0.f;
#pragma unroll 8
    for (int k = kg * 128; k < kg * 128 + 128; ++k) {
      float w = p.w_ada[(size_t)k * 6144 + col];
      a0 += siluf(p.c[k]) * w; a1 += siluf(p.c[DM + k]) * w;
    }
    fs[kg * 64 + (tid & 63)] = a0; fs[512 + kg * 64 + (tid & 63)] = a1;
    __syncthreads();
    if (tid < 128) {
      int b = tid >> 6, cc = tid & 63; float s = 0.f;
      for (int g = 0; g < 8; ++g) s += fs[b * 512 + g * 64 + cc];
      p.mod[b * 6144 + vb * 64 + cc] = s + p.b_ada[vb * 64 + cc];
    }
    __syncthreads();
    if (vb == 0 && tid < 12) p.ksmax[tid] = 0u;
  } else if (vb < PH0_WIN) { int t = vb - PH0_MOD; tr_tile(p.w_in, p.WinT, 1024, 3352, (t & 15) * 64, (t >> 4) * 64, 1, fs); }
  else if (vb < PH0_WOUT) { int t = vb - PH0_WIN; tr_tile(p.w_out, p.WoutT, 1024, 1024, (t & 15) * 64, (t >> 4) * 64, 0, fs); }
  else if (vb < PH0_WQ) { int t = vb - PH0_WOUT; tr_tile(p.w_pq, p.WqT, 1024, 2048, (t & 15) * 64, (t >> 4) * 64, 0, fs); }
  else if (vb < PH0_W1K) { int t = vb - PH0_WQ; tr_tile(p.w_k1, p.W1Tk, 2048, 256, (t & 31) * 64, (t >> 5) * 64, 0, fs); }
  else if (vb < PH0_W1V) { int t = vb - PH0_W1K; tr_tile(p.w_v1, p.W1Tv, 2048, 256, (t & 31) * 64, (t >> 5) * 64, 0, fs); }
  else if (vb < PH0_W2K) { int t = vb - PH0_W1V; tr_tile(p.w_k2, p.W2Tk, 256, 64, t * 64, 0, 0, fs); }
  else if (vb < PH0_W2V) { int t = vb - PH0_W2K; tr_tile(p.w_v2, p.W2Tv, 256, 64, t * 64, 0, 0, fs); }
  else if (vb < PH0_SUBK) { int i = (vb - PH0_W2V) * NT + tid; p.SUBK[i] = f2bf(p.subkeys[i]); }
  else if (vb < PH0_ROPE) {
    int idx = (vb - PH0_SUBK) * NT + tid;
    { int s = idx >> 6, i = idx & 63; float inv = powf(10000.f, -(float)(2 * i) / 128.f); float ang = (float)s * inv; p.c128[idx] = cosf(ang); p.s128[idx] = sinf(ang); }
    if (idx < SEQ * 32) { int s = idx >> 5, i = idx & 31; float inv = powf(10000.f, -(float)(2 * i) / 64.f); float ang = (float)s * inv; p.c64[idx] = cosf(ang); p.s64[idx] = sinf(ang); }
  } else {
    int t = vb - PH0_ROPE, kv = t >> 2, jb = t & 3;
    const float* w1 = kv ? p.w_v1 : p.w_k1; const float* pe = kv ? p.pe_v : p.pe_k; const float* b1 = kv ? p.b_v1 : p.b_k1;
    int fg = tid >> 6, j = jb * 64 + (tid & 63);
    float a = 0.f;
#pragma unroll 8
    for (int f = fg * 256; f < fg * 256 + 256; ++f) a += pe[f] * w1[(size_t)f * 256 + j];
    fs[fg * 64 + (tid & 63)] = a;
    __syncthreads();
    if (tid < 64) { float s = b1[j]; for (int g = 0; g < 8; ++g) s += fs[g * 64 + tid]; (kv ? p.B1Pv : p.B1Pk)[j] = s; }
    __syncthreads();
  }
}

DI void rownorm_body(const float* __restrict__ src, const float* __restrict__ g, const float* __restrict__ mod, int sh_off, int sc_off, bf16_t* __restrict__ dst, int vb) {
  int row = vb * 8 + (mytid() >> 6), lane = mytid() & 63;
  int b = row >> 13;
  const float* xr = src + (size_t)row * DM;
  float v[16]; float ss = 0.f;
#pragma unroll
  for (int i = 0; i < 4; ++i) {
    float4 t = *(const float4*)(xr + i * 256 + lane * 4);
    v[i * 4 + 0] = t.x; v[i * 4 + 1] = t.y; v[i * 4 + 2] = t.z; v[i * 4 + 3] = t.w;
    ss += t.x * t.x + t.y * t.y + t.z * t.z + t.w * t.w;
  }
  for (int o = 32; o; o >>= 1) ss += __shfl_xor(ss, o);
  float rstd = rsqrtf(ss * (1.f / DM) + 1e-6f);
  const float* sh = mod + b * 6144 + sh_off; const float* sc = mod + b * 6144 + sc_off;
#pragma unroll
  for (int i = 0; i < 4; ++i) {
    int col = i * 256 + lane * 4;
    float4 gg = *(const float4*)(g + col), s4 = *(const float4*)(sc + col), h4 = *(const float4*)(sh + col);
    float y0 = v[i * 4 + 0] * rstd * gg.x * (1.f + s4.x) + h4.x;
    float y1 = v[i * 4 + 1] * rstd * gg.y * (1.f + s4.y) + h4.y;
    float y2 = v[i * 4 + 2] * rstd * gg.z * (1.f + s4.z) + h4.z;
    float y3 = v[i * 4 + 3] * rstd * gg.w * (1.f + s4.w) + h4.w;
    *(uint2*)(dst + (size_t)row * DM + col) = pack4(y0, y1, y2, y3);
  }
}

#define G_A_BYTES (256 * 144)
#define G_B_BYTES (128 * 144)
#define G_BUF_BYTES (G_A_BYTES + G_B_BYTES)
template <class Epi>
DI void gemm_tile(const bf16_t* __restrict__ A, const bf16_t* __restrict__ Bt, int K, int m0, int n0, char* smem, const Epi& epi) {
  const int tid = mytid(), lane = tid & 63, w = tid >> 6, wm = w >> 1, wn = w & 1, r = lane & 31, h = lane >> 5;
  f32x16 acc[2][2];
#pragma unroll
  for (int i = 0; i < 2; ++i)
#pragma unroll
    for (int j = 0; j < 2; ++j)
#pragma unroll
      for (int e = 0; e < 16; ++e) acc[i][j][e] = 0.f;
  const int crow = tid >> 3, ckc = tid & 7;
  const bf16_t* ag = A + (size_t)(m0 + crow) * K + ckc * 8;
  const bf16_t* bg = Bt + (size_t)(n0 + crow) * K + ckc * 8;
  uint4 ra[4], rb[2];
#pragma unroll
  for (int i = 0; i < 4; ++i) ra[i] = *(const uint4*)(ag + (size_t)i * 64 * K);
#pragma unroll
  for (int i = 0; i < 2; ++i) rb[i] = *(const uint4*)(bg + (size_t)i * 64 * K);
  char* lw = smem + crow * 144 + ckc * 16;
#pragma unroll
  for (int i = 0; i < 4; ++i) *(uint4*)(lw + i * 64 * 144) = ra[i];
#pragma unroll
  for (int i = 0; i < 2; ++i) *(uint4*)(lw + G_A_BYTES + i * 64 * 144) = rb[i];
  __syncthreads();
  const int nk = K >> 6;
  for (int kt = 0; kt < nk; ++kt) {
    const int cur = kt & 1;
    if (kt + 1 < nk) {
      const int k0 = (kt + 1) * 64;
#pragma unroll
      for (int i = 0; i < 4; ++i) ra[i] = *(const uint4*)(ag + (size_t)i * 64 * K + k0);
#pragma unroll
      for (int i = 0; i < 2; ++i) rb[i] = *(const uint4*)(bg + (size_t)i * 64 * K + k0);
    }
    const char* la = smem + cur * G_BUF_BYTES + (wm * 64 + r) * 144 + h * 16;
    const char* lb = smem + cur * G_BUF_BYTES + G_A_BYTES + (wn * 64 + r) * 144 + h * 16;
#pragma unroll
    for (int kk = 0; kk < 4; ++kk) {
      bf16x8 a0 = *(const bf16x8*)(la + kk * 32), a1 = *(const bf16x8*)(la + 32 * 144 + kk * 32);
      bf16x8 b0 = *(const bf16x8*)(lb + kk * 32), b1 = *(const bf16x8*)(lb + 32 * 144 + kk * 32);
      acc[0][0] = MFMA32(a0, b0, acc[0][0]); acc[0][1] = MFMA32(a0, b1, acc[0][1]);
      acc[1][0] = MFMA32(a1, b0, acc[1][0]); acc[1][1] = MFMA32(a1, b1, acc[1][1]);
    }
    if (kt + 1 < nk) {
      char* lw2 = lw + (cur ^ 1) * G_BUF_BYTES;
#pragma unroll
      for (int i = 0; i < 4; ++i) *(uint4*)(lw2 + i * 64 * 144) = ra[i];
#pragma unroll
      for (int i = 0; i < 2; ++i) *(uint4*)(lw2 + G_A_BYTES + i * 64 * 144) = rb[i];
    }
    __syncthreads();
  }
  const int G = (n0 >> 6) + wn;
#pragma unroll
  for (int i = 0; i < 2; ++i)
#pragma unroll
    for (int g = 0; g < 4; ++g) {
      float lo[4], hi[4];
#pragma unroll
      for (int e = 0; e < 4; ++e) { lo[e] = acc[i][0][4 * g + e]; hi[e] = acc[i][1][4 * g + e]; }
      epi(m0 + wm * 64 + i * 32 + 8 * g + 4 * h, G, r, lo, hi);
    }
}

struct EpiProj {
  const Params& p;
  DI void operator()(int t0, int G, int c, const float (&lo)[4], const float (&hi)[4]) const {
    const int b = t0 >> 13, s0 = t0 & 8191;
    if (G < 16) {
      const int sec = G >> 3, hh = (G & 7) >> 1, j = G & 1, i = 32 * j + c;
      float o1[4], o2[4];
#pragma unroll
      for (int e = 0; e < 4; ++e) {
        float cs = p.c128[(s0 + e) * 64 + i], sn = p.s128[(s0 + e) * 64 + i];
        o1[e] = lo[e] * cs - hi[e] * sn; o2[e] = hi[e] * cs + lo[e] * sn;
      }
      if (sec == 0) {
#pragma unroll
        for (int e = 0; e < 4; ++e) {
          p.RQ[(size_t)(t0 + e) * 512 + hh * 128 + i] = f2bf(o1[e]);
          p.RQ[(size_t)(t0 + e) * 512 + hh * 128 + 64 + i] = f2bf(o2[e]);
        }
      } else {
        const float sc = 0.08838834764831845f;
        const float lg = logg_h(hh);
#pragma unroll
        for (int e = 0; e < 4; ++e) {
          o1[e] *= sc; o2[e] *= sc;
          p.RK[(size_t)(t0 + e) * 512 + hh * 128 + i] = f2bf(o1[e]);
          p.RK[(size_t)(t0 + e) * 512 + hh * 128 + 64 + i] = f2bf(o2[e]);
          float zeta = __expf((float)(127 - ((s0 + e) & 127)) * lg);
          o1[e] *= zeta; o2[e] *= zeta;
        }
        *(uint2*)(p.RKT + ((size_t)(b * 4 + hh) * 128 + i) * SEQ + s0) = pack4(o1[0], o1[1], o1[2], o1[3]);
        *(uint2*)(p.RKT + ((size_t)(b * 4 + hh) * 128 + 64 + i) * SEQ + s0) = pack4(o2[0], o2[1], o2[2], o2[3]);
      }
    } else if (G < 24) {
      const int hh = (G - 16) >> 1, d = ((G - 16) & 1) * 64 + c;
      *(uint2*)(p.RVT + ((size_t)(b * 4 + hh) * 128 + d) * SEQ + s0) = pack4(lo[0], lo[1], lo[2], lo[3]);
      *(uint2*)(p.RVT + ((size_t)(b * 4 + hh) * 128 + d + 32) * SEQ + s0) = pack4(hi[0], hi[1], hi[2], hi[3]);
    } else if (G < 32) {
      const int hh = (G - 24) >> 1, d = ((G - 24) & 1) * 64 + c;
#pragma unroll
      for (int e = 0; e < 4; ++e) {
        p.RGT[(size_t)(t0 + e) * 512 + hh * 128 + d] = f2bf(siluf(lo[e]));
        p.RGT[(size_t)(t0 + e) * 512 + hh * 128 + d + 32] = f2bf(siluf(hi[e]));
      }
    } else if (G < 40) {
      const int head = G - 32;
#pragma unroll
      for (int e = 0; e < 4; ++e) {
        float cs = p.c64[(s0 + e) * 32 + c], sn = p.s64[(s0 + e) * 32 + c];
        float o1 = (lo[e] * cs - hi[e] * sn) * 0.125f, o2 = (hi[e] * cs + lo[e] * sn) * 0.125f;
        p.NQ[(size_t)(t0 + e) * 512 + head * 64 + c] = f2bf(o1);
        p.NQ[(size_t)(t0 + e) * 512 + head * 64 + 32 + c] = f2bf(o2);
      }
    } else if (G < 52) {
      const int k = G - 40, kind = k >> 1, gg = k & 1;
      float o1[4], o2[4];
#pragma unroll
      for (int e = 0; e < 4; ++e) {
        o1[e] = lo[e]; o2[e] = hi[e];
        if ((kind & 1) == 0) {
          float cs = p.c64[(s0 + e) * 32 + c], sn = p.s64[(s0 + e) * 32 + c];
          o1[e] = lo[e] * cs - hi[e] * sn; o2[e] = hi[e] * cs + lo[e] * sn;
        }
      }
      if (kind == 3 || kind == 5) {
        bf16_t* dst = (kind == 3 ? p.NVST : p.NVWT) + ((size_t)(b * 2 + gg) * 64 + c) * SEQ + s0;
        *(uint2*)dst = pack4(o1[0], o1[1], o1[2], o1[3]);
        *(uint2*)(dst + (size_t)32 * SEQ) = pack4(o2[0], o2[1], o2[2], o2[3]);
      } else {
        bf16_t* dst = (kind == 0 ? p.NKC : kind == 1 ? p.NVC : kind == 2 ? p.NKS : p.NKW);
#pragma unroll
        for (int e = 0; e < 4; ++e) {
          dst[(size_t)(t0 + e) * 128 + gg * 64 + c] = f2bf(o1[e]);
          dst[(size_t)(t0 + e) * 128 + gg * 64 + 32 + c] = f2bf(o2[e]);
        }
      }
    } else if (G == 52) {
      if (c < 24) {
#pragma unroll
        for (int e = 0; e < 4; ++e) p.GATE[(size_t)(t0 + e) * 24 + c] = sigmoidf(lo[e]);
      }
    }
  }
};
struct EpiOut {
  const Params& p;
  DI void operator()(int t0, int G, int c, const float (&lo)[4], const float (&hi)[4]) const {
    const int b = t0 >> 13;
    const int c0 = G * 64 + c, c1 = c0 + 32;
    const float* ga1 = p.mod + b * 6144 + 2048;
    const float g0 = ga1[c0], g1 = ga1[c1];
#pragma unroll
    for (int e = 0; e < 4; ++e) {
      p.out[(size_t)(t0 + e) * DM + c0] = p.x[(size_t)(t0 + e) * DM + c0] + g0 * lo[e];
      p.out[(size_t)(t0 + e) * DM + c1] = p.x[(size_t)(t0 + e) * DM + c1] + g1 * hi[e];
    }
  }
};
struct EpiPQ {
  const Params& p;
  DI void operator()(int t0, int G, int c, const float (&lo)[4], const float (&hi)[4]) const {
#pragma unroll
    for (int e = 0; e < 4; ++e) {
      p.PQ[(size_t)(t0 + e) * 2048 + G * 64 + c] = f2bf(lo[e]);
      p.PQ[(size_t)(t0 + e) * 2048 + G * 64 + 32 + c] = f2bf(hi[e]);
    }
  }
};

DI void retkv_naive(const Params& p, size_t idx) {
  int item = (int)(idx >> 14), v = (int)((idx >> 7) & 127), k = (int)(idx & 127);
  int h = item & 3, c = (item >> 2) & 63, b = item >> 8;
  const bf16_t* vp = p.RVT + ((size_t)(b * 4 + h) * 128 + v) * SEQ + c * 128;
  const bf16_t* kp = p.RKT + ((size_t)(b * 4 + h) * 128 + k) * SEQ + c * 128;
  float a = 0.f;
  for (int m = 0; m < 128; ++m) a += bf2f(vp[m]) * bf2f(kp[m]);
  p.KV[idx] = a;
}
DI void scan_naive(const Params& p, int idx) {
  int e = idx & 16383, bh = idx >> 14, b = bh >> 2, h = bh & 3;
  float cd = __expf(128.f * logg_h(h));
  float S = 0.f;
  for (int c = 0; c < 64; ++c) {
    size_t o = (size_t)((b * 64 + c) * 4 + h) * 16384 + e;
    p.SPREV[o] = f2bf(S);
    S = cd * S + p.KV[o];
  }
}
DI void retout_naive(const Params& p, int item, char* smem) {
  float* Ssc = (float*)smem;
  float* Y = Ssc + 128 * 129;
  int h = item & 3, c = (item >> 2) & 63, b = item >> 8;
  int t0 = b * SEQ + c * 128, s0 = c * 128;
  float lg = logg_h(h);
  for (int idx = mytid(); idx < 16384; idx += NT) {
    int n = idx >> 7, m = idx & 127;
    float a = 0.f;
    if (m <= n) {
      const bf16_t* q = p.RQ + (size_t)(t0 + n) * 512 + h * 128;
      const bf16_t* k = p.RK + (size_t)(t0 + m) * 512 + h * 128;
      for (int kk = 0; kk < 128; ++kk) a += bf2f(q[kk]) * bf2f(k[kk]);
      a *= __expf((float)(n - m) * lg);
    }
    Ssc[n * 129 + m] = a;
  }
  __syncthreads();
  for (int idx = mytid(); idx < 16384; idx += NT) {
    int n = idx >> 7, v = idx & 127;
    const bf16_t* vp = p.RVT + ((size_t)(b * 4 + h) * 128 + v) * SEQ + s0;
    float inner = 0.f;
    for (int m = 0; m <= n; ++m) inner += Ssc[n * 129 + m] * bf2f(vp[m]);
    const bf16_t* q = p.RQ + (size_t)(t0 + n) * 512 + h * 128;
    const bf16_t* sp = p.SPREV + (size_t)item * 16384 + v * 128;
    float cr = 0.f;
    for (int kk = 0; kk < 128; ++kk) cr += bf2f(q[kk]) * bf2f(sp[kk]);
    Y[n * 129 + v] = inner + __expf((float)(n + 1) * lg) * cr;
  }
  __syncthreads();
  if (mytid() < 128) {
    int n = mytid();
    float mu = 0.f;
    for (int v = 0; v < 128; ++v) mu += Y[n * 129 + v];
    mu *= (1.f / 128.f);
    float var = 0.f;
    for (int v = 0; v < 128; ++v) { float d = Y[n * 129 + v] - mu; var += d * d; }
    var *= (1.f / 128.f);
    float rs = rsqrtf(var + 1e-6f);
    for (int v = 0; v < 128; ++v) {
      float g = bf2f(p.RGT[((size_t)(b * 4 + h) * 128 + v) * SEQ + s0 + n]);
      p.RA[(size_t)(t0 + n) * DM + h * 128 + v] = f2bf((Y[n * 129 + v] - mu) * rs * g);
    }
  }
  __syncthreads();
}
DI void cmp1_naive(const Params& p, int idx) {
  int j = idx & 255, r = (idx >> 8) & 2047, kv = idx >> 19;
  if (r >= 2044) return;
  int g = r & 1, n = (r >> 1) % 511, b = (r >> 1) / 511;
  const bf16_t* src = (kv ? p.NVC : p.NKC) + ((size_t)(b * SEQ + 16 * n)) * 128 + g * 64;
  const bf16_t* w = (kv ? p.W1Tv : p.W1Tk) + (size_t)j * 2048;
  float a = 0.f;
  for (int l = 0; l < 32; ++l)
    for (int d = 0; d < 64; ++d) a += bf2f(src[l * 128 + d]) * bf2f(w[l * 64 + d]);
  a += (kv ? p.B1Pv : p.B1Pk)[j];
  p.HID[((size_t)kv * 2048 + r) * 256 + j] = gelu_tanh(a);
}
DI void cmp2_naive(const Params& p, int idx) {
  int e = idx & 63, r = (idx >> 6) & 2047, kv = idx >> 17;
  if (r >= 2044) {
    int bg = r - 2044;
    if (kv == 0) p.KC[((size_t)bg * 512 + 511) * 64 + e] = 0;
    else p.VCT[((size_t)bg * 64 + e) * 512 + 511] = 0;
    return;
  }
  int g = r & 1, n = (r >> 1) % 511, b = (r >> 1) / 511;
  const float* hid = p.HID + ((size_t)kv * 2048 + r) * 256;
  const bf16_t* w = (kv ? p.W2Tv : p.W2Tk) + e * 256;
  float a = 0.f;
  for (int j = 0; j < 256; ++j) a += hid[j] * bf2f(w[j]);
  if (kv == 0) p.KC[((size_t)(b * 2 + g) * 512 + n) * 64 + e] = f2bf(a);
  else p.VCT[((size_t)(b * 2 + g) * 64 + e) * 512 + n] = f2bf(a);
}
DI void ksmax_naive(const Params& p, int idx) {
  int g = idx & 1, t = idx >> 1, b = t >> 13;
  const bf16_t* k = p.NKS + (size_t)t * 128 + g * 64;
  float ss = 0.f;
  for (int d = 0; d < 64; ++d) { float v = bf2f(k[d]); ss += v * v; }
  atomicMax(&p.ksmax[b * 2 + g], __float_as_uint(sqrtf(ss)));
}

#define NSA_SUB_FLOATS 18048
DI void nsa_naive(const Params& p, int blk, int tid, float* sm) {
  float* qs = sm;
  float* P = sm + 1024;
  float* IMP = P + 16 * 1024;
  int* SEL = (int*)(IMP + 512);
  int* NSEL = SEL + 64;
  int g = blk & 1, tq = blk >> 1;
  int tok0 = tq * 4, b = tok0 >> 13, s0 = tok0 & 8191;
  int bg = b * 2 + g;
  int th = tid >> 4, sub = tid & 15, token = th >> 2, hh = th & 3;
  int t = s0 + token;
  for (int i = tid; i < 1024; i += 256) {
    int r = i >> 6, d = i & 63;
    qs[i] = bf2f(p.NQ[(size_t)(tok0 + (r >> 2)) * 512 + (g * 4 + (r & 3)) * 64 + d]);
  }
  __syncthreads();
  const float* q = qs + th * 64;
  float* Pr = P + th * 1024;
  int nvalid = (t >= 31) ? ((t - 31) / 16 + 1) : 0;
  if (nvalid > 511) nvalid = 511;
  float mx = NEG_INF;
  for (int n = sub; n < 512; n += 16) {
    float sc = NEG_INF;
    if (n < nvalid) {
      const bf16_t* k = p.KC + ((size_t)bg * 512 + n) * 64;
      float a = 0.f;
      for (int d = 0; d < 64; ++d) a += q[d] * bf2f(k[d]);
      sc = a;
    }
    Pr[n] = sc; mx = fmaxf(mx, sc);
  }
  for (int o = 8; o; o >>= 1) mx = fmaxf(mx, __shfl_xor(mx, o));
  float mm = (mx == NEG_INF) ? 0.f : mx;
  float l = 0.f;
  for (int n = sub; n < 512; n += 16) { float e = (n < nvalid) ? __expf(Pr[n] - mm) : 0.f; Pr[n] = e; l += e; }
  for (int o = 8; o; o >>= 1) l += __shfl_xor(l, o);
  float inv = 1.f / fmaxf(l, 1.17549435e-38f);
  for (int n = sub; n < 512; n += 16) Pr[n] *= inv;
  __syncthreads();
  float oc[4] = {0, 0, 0, 0};
#pragma unroll
  for (int e = 0; e < 4; ++e) {
    int d = sub * 4 + e;
    const bf16_t* v = p.VCT + ((size_t)bg * 64 + d) * 512;
    float a = 0.f;
    for (int n = 0; n < nvalid; ++n) a += Pr[n] * bf2f(v[n]);
    oc[e] = a;
  }
  for (int i = tid; i < 512; i += 256) {
    int tk = i >> 7, j = i & 127;
    int tt = s0 + tk, cur = tt >> 6;
    float a = 0.f;
    for (int h2 = 0; h2 < 4; ++h2) {
      const float* pp = P + (tk * 4 + h2) * 1024;
      a += 2.f * (pp[4 * j] + pp[4 * j + 1] + pp[4 * j + 2]) + pp[4 * j + 3] + (j > 0 ? pp[4 * j - 1] : 0.f);
    }
    if (j == 0 || j == cur || j == cur - 1) a = 1e9f;
    if (j > cur) a = NEG_INF;
    IMP[i] = a;
  }
  __syncthreads();
  if (tid < 4) {
    int cnt = 0;
    for (int k = 0; k < 16; ++k) {
      float best = NEG_INF; int bj = -1;
      for (int j = 0; j < 128; ++j) { float v = IMP[tid * 128 + j]; if (v > best) { best = v; bj = j; } }
      if (bj < 0) break;
      SEL[tid * 16 + cnt] = bj; ++cnt; IMP[tid * 128 + bj] = NEG_INF;
    }
    NSEL[tid] = cnt;
  }
  __syncthreads();
  float os[4] = {0, 0, 0, 0};
  {
    int nk = NSEL[token] * 64;
    mx = NEG_INF;
    for (int ki = sub; ki < nk; ki += 16) {
      int pos = SEL[token * 16 + (ki >> 6)] * 64 + (ki & 63);
      float sc = NEG_INF;
      if (pos <= t) {
        const bf16_t* k = p.NKS + ((size_t)(b * SEQ + pos)) * 128 + g * 64;
        float a = 0.f;
        for (int d = 0; d < 64; ++d) a += q[d] * bf2f(k[d]);
        sc = a;
      }
      Pr[ki] = sc; mx = fmaxf(mx, sc);
    }
    for (int o = 8; o; o >>= 1) mx = fmaxf(mx, __shfl_xor(mx, o));
    mm = (mx == NEG_INF) ? 0.f : mx;
    l = 0.f;
    for (int ki = sub; ki < nk; ki += 16) { float sc = Pr[ki]; float e = (sc == NEG_INF) ? 0.f : __expf(sc - mm); Pr[ki] = e; l += e; }
    for (int o = 8; o; o >>= 1) l += __shfl_xor(l, o);
    inv = 1.f / fmaxf(l, 1.17549435e-38f);
    __syncthreads();
#pragma unroll
    for (int e = 0; e < 4; ++e) {
      int d = sub * 4 + e;
      const bf16_t* v = p.NVST + ((size_t)bg * 64 + d) * SEQ;
      float a = 0.f;
      for (int ki = 0; ki < nk; ++ki) {
        int pos = SEL[token * 16 + (ki >> 6)] * 64 + (ki & 63);
        a += Pr[ki] * bf2f(v[pos]);
      }
      os[e] = a * inv;
    }
    __syncthreads();
  }
  float ow[4] = {0, 0, 0, 0};
  {
    int lo = t - 511; if (lo < 0) lo = 0;
    int nk = t - lo + 1;
    mx = NEG_INF;
    for (int ki = sub; ki < nk; ki += 16) {
      int pos = lo + ki;
      const bf16_t* k = p.NKW + ((size_t)(b * SEQ + pos)) * 128 + g * 64;
      float a = 0.f;
      for (int d = 0; d < 64; ++d) a += q[d] * bf2f(k[d]);
      Pr[ki] = a; mx = fmaxf(mx, a);
    }
    for (int o = 8; o; o >>= 1) mx = fmaxf(mx, __shfl_xor(mx, o));
    l = 0.f;
    for (int ki = sub; ki < nk; ki += 16) { float e = __expf(Pr[ki] - mx); Pr[ki] = e; l += e; }
    for (int o = 8; o; o >>= 1) l += __shfl_xor(l, o);
    inv = 1.f / l;
    __syncthreads();
#pragma unroll
    for (int e = 0; e < 4; ++e) {
      int d = sub * 4 + e;
      const bf16_t* v = p.NVWT + ((size_t)bg * 64 + d) * SEQ + lo;
      float a = 0.f;
      for (int ki = 0; ki < nk; ++ki) a += Pr[ki] * bf2f(v[ki]);
      ow[e] = a * inv;
    }
  }
  const float* gt = p.GATE + (size_t)(tok0 + token) * 24 + (g * 4 + hh) * 3;
  float g0 = gt[0], g1 = gt[1], g2 = gt[2];
#pragma unroll
  for (int e = 0; e < 4; ++e) {
    int d = sub * 4 + e;
    p.RA[(size_t)(tok0 + token) * DM + 512 + (g * 4 + hh) * 64 + d] = f2bf(g0 * oc[e] + g1 * os[e] + g2 * ow[e]);
  }
  __syncthreads();
}

#define PEER_SUB_FLOATS 8192
DI void peer_naive(const Params& p, int t, int tid, float* sm) {
  float* qrow = sm;
  float* sc = sm + 2048;
  float* cand = sm + 4096;
  float* tv = sm + 6144;
  int* ti = (int*)(sm + 6400);
  float* tv2 = sm + 6656;
  int* te2 = (int*)(sm + 6784);
  float* red = sm + 6912;
  float* hrow = sm + 6928;
  int b = t >> 13;
  for (int i = tid; i < 2048; i += 256) qrow[i] = bf2f(p.PQ[(size_t)t * 2048 + i]);
  for (int i = tid; i < 1024; i += 256) hrow[i] = bf2f(p.RA[(size_t)t * DM + i]);
  __syncthreads();
  for (int i = tid; i < 2048; i += 256) {
    int ph = i >> 7;
    const bf16_t* k = p.SUBK + (size_t)i * 128;
    const float* q = qrow + ph * 128;
    float a = 0.f;
    for (int d = 0; d < 128; ++d) a += q[d] * bf2f(k[d]);
    sc[i] = a;
  }
  __syncthreads();
  if (tid < 16) {
    for (int k = 0; k < 16; ++k) {
      float best = NEG_INF; int bj = 0;
      for (int j = 0; j < 128; ++j) { float v = sc[tid * 128 + j]; if (v > best) { best = v; bj = j; } }
      tv[tid * 16 + k] = best; ti[tid * 16 + k] = bj; sc[tid * 128 + bj] = NEG_INF;
    }
  }
  __syncthreads();
  for (int i = tid; i < 2048; i += 256) {
    int pp = i >> 8, ii = (i >> 4) & 15, jj = i & 15;
    cand[i] = tv[(2 * pp) * 16 + ii] + tv[(2 * pp + 1) * 16 + jj];
  }
  __syncthreads();
  if (tid < 8) {
    for (int k = 0; k < 16; ++k) {
      float best = NEG_INF; int bj = 0;
      for (int j = 0; j < 256; ++j) { float v = cand[tid * 256 + j]; if (v > best) { best = v; bj = j; } }
      cand[tid * 256 + bj] = NEG_INF;
      tv2[tid * 16 + k] = best; te2[tid * 16 + k] = ti[(2 * tid) * 16 + (bj >> 4)] * 128 + ti[(2 * tid + 1) * 16 + (bj & 15)];
    }
    float m = tv2[tid * 16], l = 0.f;
    for (int k = 0; k < 16; ++k) { float e = __expf(tv2[tid * 16 + k] - m); tv2[tid * 16 + k] = e; l += e; }
    for (int k = 0; k < 16; ++k) tv2[tid * 16 + k] /= l;
  }
  __syncthreads();
  float4 hv = *(float4*)(hrow + tid * 4);
  float acc[4] = {0, 0, 0, 0};
  for (int e = 0; e < 128; ++e) {
    int idx = te2[e];
    float w = tv2[e];
    float4 u = *(const float4*)(p.peer_down + (size_t)idx * DM + tid * 4);
    float d = hv.x * u.x + hv.y * u.y + hv.z * u.z + hv.w * u.w;
    for (int o = 32; o; o >>= 1) d += __shfl_xor(d, o);
    if ((tid & 63) == 0) red[tid >> 6] = d;
    __syncthreads();
    float dot = red[0] + red[1] + red[2] + red[3];
    __syncthreads();
    float cf = w * gelu_tanh(dot);
    float4 v = *(const float4*)(p.peer_up + (size_t)idx * DM + tid * 4);
    acc[0] += cf * v.x; acc[1] += cf * v.y; acc[2] += cf * v.z; acc[3] += cf * v.w;
  }
  const float* ga2 = p.mod + b * 6144 + 5120;
  float4 x1 = *(float4*)(p.out + (size_t)t * DM + tid * 4);
  float y0 = x1.x + ga2[tid * 4 + 0] * acc[0], y1 = x1.y + ga2[tid * 4 + 1] * acc[1];
  float y2 = x1.z + ga2[tid * 4 + 2] * acc[2], y3 = x1.w + ga2[tid * 4 + 3] * acc[3];
  float ss = y0 * y0 + y1 * y1 + y2 * y2 + y3 * y3;
  for (int o = 32; o; o >>= 1) ss += __shfl_xor(ss, o);
  if ((tid & 63) == 0) red[4 + (tid >> 6)] = ss;
  __syncthreads();
  float tot = red[4] + red[5] + red[6] + red[7];
  float rstd = rsqrtf(tot * (1.f / DM) + 1e-6f);
  float4 o4;
  o4.x = y0 * rstd * p.g_final[tid * 4 + 0]; o4.y = y1 * rstd * p.g_final[tid * 4 + 1];
  o4.z = y2 * rstd * p.g_final[tid * 4 + 2]; o4.w = y3 * rstd * p.g_final[tid * 4 + 3];
  *(float4*)(p.out + (size_t)t * DM + tid * 4) = o4;
  __syncthreads();
}


DI int crow(int reg, int h) { return (reg & 3) + 8 * (reg >> 2) + 4 * h; }
DI bf16x8 ld16(const bf16_t* ptr) { return *(const bf16x8*)ptr; }
DI bf16x8 ld8x2(const bf16_t* ptr) {
  uint2 a = *(const uint2*)ptr, b = *(const uint2*)(ptr + 8);
  uint4 v; v.x = a.x; v.y = a.y; v.z = b.x; v.w = b.y;
  return __builtin_bit_cast(bf16x8, v);
}
DI bf16x8 pack8(float x0, float x1, float x2, float x3, float x4, float x5, float x6, float x7) {
  uint4 v; v.x = cvt2(x0, x1); v.y = cvt2(x2, x3); v.z = cvt2(x4, x5); v.w = cvt2(x6, x7);
  return __builtin_bit_cast(bf16x8, v);
}
DI f32x16 zero16() { f32x16 z; for (int e = 0; e < 16; ++e) z[e] = 0.f; return z; }

DI void retkv_mfma(const Params& p, int item) {
  const int lane = mytid() & 63, w = mytid() >> 6, r = lane & 31, h = lane >> 5;
  const int hh = item & 3, c = (item >> 2) & 63, b = item >> 8, bh = b * 4 + hh, s0 = c * 128;
  const int mi = w >> 1, nb = (w & 1) * 2;
  const bf16_t* vb_ = p.RVT + ((size_t)(bh * 128 + 32 * mi + r)) * SEQ + s0 + 8 * h;
  const bf16_t* k0 = p.RKT + ((size_t)(bh * 128 + 32 * nb + r)) * SEQ + s0 + 8 * h;
  const bf16_t* k1 = k0 + (size_t)32 * SEQ;
  f32x16 a0 = zero16(), a1 = zero16();
#pragma unroll
  for (int s = 0; s < 8; ++s) {
    bf16x8 a = ld16(vb_ + 16 * s), b0 = ld16(k0 + 16 * s), b1 = ld16(k1 + 16 * s);
    a0 = MFMA32(a, b0, a0); a1 = MFMA32(a, b1, a1);
  }
  float* dst = p.KV + (size_t)item * 16384;
#pragma unroll
  for (int e = 0; e < 16; ++e) {
    const int v = 32 * mi + crow(e, h);
    dst[v * 128 + 32 * nb + r] = a0[e];
    dst[v * 128 + 32 * nb + 32 + r] = a1[e];
  }
}
DI void scan_body(const Params& p, int idx) {
  const int e = idx & 16383, bh = idx >> 14, b = bh >> 2, h = bh & 3;
  const float cd = __expf(128.f * logg_h(h));
  float S = 0.f;
  for (int c0 = 0; c0 < 64; c0 += 8) {
    float kv[8];
#pragma unroll
    for (int u = 0; u < 8; ++u) kv[u] = p.KV[(size_t)((b * 64 + c0 + u) * 4 + h) * 16384 + e];
#pragma unroll
    for (int u = 0; u < 8; ++u) {
      p.SPREV[(size_t)((b * 64 + c0 + u) * 4 + h) * 16384 + e] = f2bf(S);
      S = cd * S + kv[u];
    }
  }
}
DI void retout_mfma(const Params& p, int task) {
  const int lane = mytid() & 63, r = lane & 31, h = lane >> 5;
  const int item = task >> 2, nt = task & 3;
  const int hh = item & 3, c = (item >> 2) & 63, b = item >> 8, bh = b * 4 + hh, s0 = c * 128, t0 = b * SEQ + s0;
  const float lg = logg_h(hh);
  const int n = 32 * nt + r;
  bf16x8 qf[8];
#pragma unroll
  for (int s = 0; s < 8; ++s) qf[s] = ld16(p.RQ + (size_t)(t0 + n) * 512 + hh * 128 + 16 * s + 8 * h);
  f32x16 acc[4];
#pragma unroll
  for (int vi = 0; vi < 4; ++vi) {
    acc[vi] = zero16();
    const bf16_t* sp = p.SPREV + (size_t)item * 16384 + (size_t)(32 * vi + r) * 128 + 8 * h;
#pragma unroll
    for (int s = 0; s < 8; ++s) acc[vi] = MFMA32(ld16(sp + 16 * s), qf[s], acc[vi]);
    __builtin_amdgcn_sched_barrier(0);
  }
  {
    const float xi = __expf((float)(n + 1) * lg);
#pragma unroll
    for (int vi = 0; vi < 4; ++vi)
#pragma unroll
      for (int e = 0; e < 16; ++e) acc[vi][e] *= xi;
  }
  for (int mt = 0; mt <= nt; ++mt) {
    f32x16 sa = zero16();
    const bf16_t* kp = p.RK + (size_t)(t0 + 32 * mt + r) * 512 + hh * 128 + 8 * h;
#pragma unroll
    for (int s = 0; s < 8; ++s) sa = MFMA32(ld16(kp + 16 * s), qf[s], sa);
    float pv[16];
#pragma unroll
    for (int e = 0; e < 16; ++e) {
      const int dm = n - (32 * mt + crow(e, h));
      pv[e] = (dm >= 0) ? sa[e] * __expf((float)dm * lg) : 0.f;
    }
#pragma unroll
    for (int s2 = 0; s2 < 2; ++s2) {
      bf16x8 bfr = pack8(pv[8 * s2], pv[8 * s2 + 1], pv[8 * s2 + 2], pv[8 * s2 + 3], pv[8 * s2 + 4], pv[8 * s2 + 5], pv[8 * s2 + 6], pv[8 * s2 + 7]);
#pragma unroll
      for (int vi = 0; vi < 4; ++vi) {
        bf16x8 afr = ld8x2(p.RVT + ((size_t)(bh * 128 + 32 * vi + r)) * SEQ + s0 + 32 * mt + 16 * s2 + 4 * h);
        acc[vi] = MFMA32(afr, bfr, acc[vi]);
      }
      __builtin_amdgcn_sched_barrier(0);
    }
  }
  float sum = 0.f;
#pragma unroll
  for (int vi = 0; vi < 4; ++vi)
#pragma unroll
    for (int e = 0; e < 16; ++e) sum += acc[vi][e];
  sum += __shfl_xor(sum, 32);
  const float mu = sum * (1.f / 128.f);
  float var = 0.f;
#pragma unroll
  for (int vi = 0; vi < 4; ++vi)
#pragma unroll
    for (int e = 0; e < 16; ++e) { float d = acc[vi][e] - mu; var += d * d; }
  var += __shfl_xor(var, 32);
  const float rs = rsqrtf(var * (1.f / 128.f) + 1e-6f);
#pragma unroll
  for (int vi = 0; vi < 4; ++vi)
#pragma unroll
    for (int g4 = 0; g4 < 4; ++g4) {
      const int v0 = 32 * vi + 8 * g4 + 4 * h;
      uint2 gt = *(const uint2*)(p.RGT + (size_t)(t0 + n) * 512 + hh * 128 + v0);
      float y0 = (acc[vi][4 * g4 + 0] - mu) * rs * __uint_as_float(gt.x << 16);
      float y1 = (acc[vi][4 * g4 + 1] - mu) * rs * __uint_as_float(gt.x & 0xffff0000u);
      float y2 = (acc[vi][4 * g4 + 2] - mu) * rs * __uint_as_float(gt.y << 16);
      float y3 = (acc[vi][4 * g4 + 3] - mu) * rs * __uint_as_float(gt.y & 0xffff0000u);
      *(uint2*)(p.RA + (size_t)(t0 + n) * DM + hh * 128 + v0) = pack4(y0, y1, y2, y3);
    }
}
#define HID_STRIDE 264
DI void compress_mfma(const Params& p, int item, char* smem) {
  bf16_t* HIDL = (bf16_t*)smem;
  const int lane = mytid() & 63, w = mytid() >> 6, r = lane & 31, h = lane >> 5;
  const int kv = item >> 6, bg = (item >> 4) & 3, rt = item & 15, n0 = rt * 32, b = bg >> 1, g = bg & 1;
  const bf16_t* src = kv ? p.NVC : p.NKC; const bf16_t* W1 = kv ? p.W1Tv : p.W1Tk; const bf16_t* W2 = kv ? p.W2Tv : p.W2Tk;
  const float* B1 = kv ? p.B1Pv : p.B1Pk;
  {
    const int n = min(n0 + r, 510);
    const bf16_t* ab = src + ((size_t)(b * SEQ + 16 * n)) * 128 + g * 64 + 8 * h;
    const bf16_t* bb = W1 + (size_t)(32 * w + r) * 2048 + 8 * h;
    f32x16 acc = zero16();
#pragma unroll 8
    for (int s = 0; s < 128; ++s) acc = MFMA32(ld16(ab + (s >> 2) * 128 + (s & 3) * 16), ld16(bb + 16 * s), acc);
    const float bias = B1[32 * w + r];
#pragma unroll
    for (int e = 0; e < 16; ++e) HIDL[crow(e, h) * HID_STRIDE + 32 * w + r] = f2bf(gelu_tanh(acc[e] + bias));
  }
  __syncthreads();
  if (w < 2) {
    f32x16 acc = zero16();
#pragma unroll
    for (int s = 0; s < 16; ++s) acc = MFMA32(ld16(HIDL + r * HID_STRIDE + 16 * s + 8 * h), ld16(W2 + (size_t)(32 * w + r) * 256 + 16 * s + 8 * h), acc);
    const int e_ = 32 * w + r;
    if (kv == 0) {
#pragma unroll
      for (int e = 0; e < 16; ++e) { const int n = n0 + crow(e, h); p.KC[((size_t)bg * 512 + n) * 64 + e_] = (n < 511) ? f2bf(acc[e]) : (bf16_t)0; }
    } else {
#pragma unroll
      for (int g4 = 0; g4 < 4; ++g4) {
        const int n = n0 + 8 * g4 + 4 * h;
        float v3 = (n + 3 < 511) ? acc[4 * g4 + 3] : 0.f;
        *(uint2*)(p.VCT + ((size_t)bg * 64 + e_) * 512 + n) = pack4(acc[4 * g4], acc[4 * g4 + 1], acc[4 * g4 + 2], v3);
      }
    }
  }
  __syncthreads();
}
DI void kmax_body(const Params& p, int idx) {
  const int g = idx & 1, t = idx >> 1, b = t >> 13;
  const bf16_t* k = p.NKS + (size_t)t * 128 + g * 64; const bf16_t* kw = p.NKW + (size_t)t * 128 + g * 64;
  float ss = 0.f, sw = 0.f;
  for (int d = 0; d < 64; ++d) { float v = bf2f(k[d]); ss += v * v; float u = bf2f(kw[d]); sw += u * u; }
  float m1 = sqrtf(ss), m2 = sqrtf(sw);
  for (int o = 32; o; o >>= 1) { m1 = fmaxf(m1, __shfl_xor(m1, o)); m2 = fmaxf(m2, __shfl_xor(m2, o)); }
}
DI void kmax_body2(const Params& p, int vb) {
  const int tid = mytid(), g = tid & 1, t = vb * 256 + (tid >> 1), b = t >> 13;
  const bf16_t* k = p.NKS + (size_t)t * 128 + g * 64; const bf16_t* kw = p.NKW + (size_t)t * 128 + g * 64;
  float ss = 0.f, sw = 0.f;
  for (int d = 0; d < 64; d += 8) {
    uint4 a = *(const uint4*)(k + d), c = *(const uint4*)(kw + d);
    const unsigned aa[4] = {a.x, a.y, a.z, a.w}, cc[4] = {c.x, c.y, c.z, c.w};
#pragma unroll
    for (int q = 0; q < 4; ++q) {
      float x0 = __uint_as_float(aa[q] << 16), x1 = __uint_as_float(aa[q] & 0xffff0000u);
      float y0 = __uint_as_float(cc[q] << 16), y1 = __uint_as_float(cc[q] & 0xffff0000u);
      ss += x0 * x0 + x1 * x1; sw += y0 * y0 + y1 * y1;
    }
  }
  float m1 = sqrtf(ss), m2 = sqrtf(sw);
  for (int o = 2; o < 64; o <<= 1) { m1 = fmaxf(m1, __shfl_xor(m1, o)); m2 = fmaxf(m2, __shfl_xor(m2, o)); }
  if ((tid & 63) < 2) { atomicMax(&p.ksmax[b * 2 + g], __float_as_uint(m1)); atomicMax(&p.ksmax[4 + b * 2 + g], __float_as_uint(m2)); }
}
DI void kcmax_body(const Params& p, int idx) {
  const bf16_t* k = p.KC + (size_t)idx * 64;
  float ss = 0.f;
  for (int d = 0; d < 64; ++d) { float v = bf2f(k[d]); ss += v * v; }
  atomicMax(&p.ksmax[8 + (idx >> 9)], __float_as_uint(sqrtf(ss)));
}

#define QL_STRIDE 144
#define NSA_OS 36864
#define OS_STRIDE 260
#define NSA_LS (NSA_OS + 64 * OS_STRIDE * 4)
#define NSA_MB (NSA_LS + 1024)
#define NSA_SELM (NSA_MB + 1024)
#define NSA_LIST (NSA_SELM + 1024)
template <int CTRL> DI float dpp_f2(float x) { return __builtin_bit_cast(float, __builtin_amdgcn_mov_dpp(__builtin_bit_cast(int, x), CTRL, 0xf, 0xf, true)); }
DI float quad_sum(float v) { v += dpp_f2<0xB1>(v); v += dpp_f2<0x4E>(v); return v; }

DI void nsa_item(const Params& p, int item, char* smem) {
  const int tid = mytid(), lane = tid & 63, w = tid >> 6, r = lane & 31, h = lane >> 5;
  const int ti = item >> 2, bg = item & 3, b = bg >> 1, g = bg & 1;
  const int ts = ti * 64, tokg0 = b * SEQ + ts;
  const int tkl = 8 * w + (r >> 2), hl = r & 3, hd = g * 4 + hl, tpos = ts + tkl, row = tkl * 4 + hl;
  char* QL = smem;
  float* OS = (float*)(smem + NSA_OS);
  float* IMPA = OS; float* IMPB = OS + 64 * 128;
  float* LS = (float*)(smem + NSA_LS);
  float* MB = (float*)(smem + NSA_MB);
  unsigned* SELM = (unsigned*)(smem + NSA_SELM);
  int* LIST = (int*)(smem + NSA_LIST);
  const float ksm = __uint_as_float(p.ksmax[bg]), kwm = __uint_as_float(p.ksmax[4 + bg]), kcm = __uint_as_float(p.ksmax[8 + bg]);

  bf16x8 qf[4];
#pragma unroll
  for (int s = 0; s < 4; ++s) qf[s] = ld16(p.NQ + (size_t)(tokg0 + tkl) * 512 + hd * 64 + 16 * s + 8 * h);
  float qq = 0.f;
#pragma unroll
  for (int s = 0; s < 4; ++s) {
    uint4 u = __builtin_bit_cast(uint4, qf[s]);
    const unsigned uu[4] = {u.x, u.y, u.z, u.w};
#pragma unroll
    for (int q = 0; q < 4; ++q) { float x0 = __uint_as_float(uu[q] << 16), x1 = __uint_as_float(uu[q] & 0xffff0000u); qq += x0 * x0 + x1 * x1; }
    *(bf16x8*)(QL + row * QL_STRIDE + (16 * s + 8 * h) * 2) = qf[s];
  }
  qq += __shfl_xor(qq, 32);
  const float qn = sqrtf(qq);
  if (h == 0) MB[row] = qn * ksm;
  for (int q = tid; q < 64 * 128 * 2 / 4; q += NT) ((float4*)IMPA)[q] = make_float4(0.f, 0.f, 0.f, 0.f);
  __syncthreads();

  const float mbc = qn * kcm;
  int nvalid = (tpos >= 31) ? ((tpos - 31) >> 4) + 1 : 0;
  if (nvalid > 511) nvalid = 511;
  int nvw = (ts + 8 * w + 7 >= 31) ? ((ts + 8 * w + 7 - 31) >> 4) + 1 : 0;
  if (nvw > 511) nvw = 511;
  const int nkt = (nvw + 31) >> 5;
  const bf16_t* kcb = p.KC + ((size_t)bg * 512 + r) * 64 + 8 * h;
  float lsum = 0.f;
  for (int kt = 0; kt < nkt; ++kt) {
    f32x16 sa = zero16();
#pragma unroll
    for (int s = 0; s < 4; ++s) sa = MFMA32(ld16(kcb + (size_t)kt * 32 * 64 + 16 * s), qf[s], sa);
#pragma unroll
    for (int e = 0; e < 16; ++e) { const int n = 32 * kt + crow(e, h); lsum += (n < nvalid) ? __expf(sa[e] - mbc) : 0.f; }
  }
  lsum += __shfl_xor(lsum, 32);
  const float invl = (lsum > 0.f) ? 1.f / lsum : 0.f;
  for (int kt = 0; kt < nkt; ++kt) {
    f32x16 sa = zero16();
#pragma unroll
    for (int s = 0; s < 4; ++s) sa = MFMA32(ld16(kcb + (size_t)kt * 32 * 64 + 16 * s), qf[s], sa);
    float pv[16];
#pragma unroll
    for (int e = 0; e < 16; ++e) { const int n = 32 * kt + crow(e, h); pv[e] = (n < nvalid) ? __expf(sa[e] - mbc) * invl : 0.f; }
#pragma unroll
    for (int q = 0; q < 4; ++q) {
      float A = 2.f * (pv[4 * q] + pv[4 * q + 1] + pv[4 * q + 2]) + pv[4 * q + 3], Bv = pv[4 * q + 3];
      A = quad_sum(A); Bv = quad_sum(Bv);
      if (hl == 0) { const int j = 8 * kt + 2 * q + h; IMPA[tkl * 128 + j] = A; IMPB[tkl * 128 + j] = Bv; }
    }
  }
  for (int tk = 0; tk < 8; ++tk) {
    const int tl = 8 * w + tk;
    unsigned long long key[2];
#pragma unroll
    for (int c2 = 0; c2 < 2; ++c2) {
      const int j = lane + 64 * c2;
      float imp = IMPA[tl * 128 + j] + ((j > 0) ? IMPB[tl * 128 + j - 1] : 0.f);
      if (j == 0 || j == ti || j == ti - 1) imp = 1e9f;
      key[c2] = (j <= ti) ? ((((unsigned long long)__float_as_uint(imp)) << 8) | (unsigned long long)(127 - j)) + 1ull : 0ull;
    }
    unsigned m0 = 0, m1 = 0, m2 = 0, m3 = 0;
    for (int it = 0; it < 16; ++it) {
      unsigned long long k = key[0] > key[1] ? key[0] : key[1];
#pragma unroll
      for (int o = 32; o; o >>= 1) {
        unsigned lo = (unsigned)k, hi = (unsigned)(k >> 32);
        unsigned lo2 = __shfl_xor(lo, o), hi2 = __shfl_xor(hi, o);
        unsigned long long k2 = ((unsigned long long)hi2 << 32) | lo2;
        k = k2 > k ? k2 : k;
      }
      if (k == 0ull) break;
      const int js = 127 - (int)((k - 1ull) & 255ull);
      const unsigned bit = 1u << (js & 31);
      if ((js >> 5) == 0) m0 |= bit; else if ((js >> 5) == 1) m1 |= bit; else if ((js >> 5) == 2) m2 |= bit; else m3 |= bit;
      if (key[0] == k) key[0] = 0ull;
      if (key[1] == k) key[1] = 0ull;
    }
    if (lane == 0) { SELM[tl * 4 + 0] = m0; SELM[tl * 4 + 1] = m1; SELM[tl * 4 + 2] = m2; SELM[tl * 4 + 3] = m3; }
  }
  __syncthreads();
  for (int q = tid; q < (64 * OS_STRIDE + 256) / 4; q += NT) ((float4*)OS)[q] = make_float4(0.f, 0.f, 0.f, 0.f);
  __syncthreads();
  for (int j = w; j <= ti; j += 8) {
    const unsigned bit = (SELM[lane * 4 + (j >> 5)] >> (j & 31)) & 1u;
    const unsigned long long M = __ballot(bit);
    const int cnt = __popcll(M);
    if (cnt == 0) continue;
    if (bit) LIST[w * 64 + __popcll(M & ((1ull << lane) - 1ull))] = lane;
    bf16x8 kf[2][4], vf[2][2][2];
#pragma unroll
    for (int kh = 0; kh < 2; ++kh)
#pragma unroll
      for (int s = 0; s < 4; ++s) kf[kh][s] = ld16(p.NKS + ((size_t)(b * SEQ + 64 * j + 32 * kh + r)) * 128 + g * 64 + 16 * s + 8 * h);
#pragma unroll
    for (int di = 0; di < 2; ++di)
#pragma unroll
      for (int kh = 0; kh < 2; ++kh)
#pragma unroll
        for (int s2 = 0; s2 < 2; ++s2) vf[di][kh][s2] = ld8x2(p.NVST + ((size_t)bg * 64 + 32 * di + r) * SEQ + 64 * j + 32 * kh + 16 * s2 + 4 * h);
    const int nch = (cnt + 7) >> 3;
    for (int q = 0; q < nch; ++q) {
      const int slot = 8 * q + (r >> 2);
      const bool valid = slot < cnt;
      const int tk = LIST[w * 64 + (valid ? slot : 0)];
      const int rw = tk * 4 + hl;
      bf16x8 qg[4];
#pragma unroll
      for (int s = 0; s < 4; ++s) qg[s] = *(const bf16x8*)(QL + rw * QL_STRIDE + (16 * s + 8 * h) * 2);
      const float mb = MB[rw];
      bf16x8 pk[2][2];
      float lp = 0.f;
#pragma unroll
      for (int kh = 0; kh < 2; ++kh) {
        f32x16 sa = zero16();
#pragma unroll
        for (int s = 0; s < 4; ++s) sa = MFMA32(kf[kh][s], qg[s], sa);
        float pv[16];
#pragma unroll
        for (int e = 0; e < 16; ++e) {
          const int key = 32 * kh + crow(e, h);
          const bool ok = valid && ((j < ti) || (key <= tk));
          pv[e] = ok ? __expf(sa[e] - mb) : 0.f; lp += pv[e];
        }
        pk[kh][0] = pack8(pv[0], pv[1], pv[2], pv[3], pv[4], pv[5], pv[6], pv[7]);
        pk[kh][1] = pack8(pv[8], pv[9], pv[10], pv[11], pv[12], pv[13], pv[14], pv[15]);
      }
      if (valid) atomicAdd(&LS[rw], lp);
#pragma unroll
      for (int di = 0; di < 2; ++di) {
        f32x16 o2 = zero16();
#pragma unroll
        for (int kh = 0; kh < 2; ++kh)
#pragma unroll
          for (int s2 = 0; s2 < 2; ++s2) o2 = MFMA32(vf[di][kh][s2], pk[kh][s2], o2);
        if (valid) {
#pragma unroll
          for (int e = 0; e < 16; ++e) atomicAdd(&OS[(32 * di + crow(e, h)) * OS_STRIDE + rw], o2[e]);
        }
      }
    }
  }
#pragma unroll
  for (int s = 0; s < 4; ++s) qf[s] = *(const bf16x8*)(QL + row * QL_STRIDE + (16 * s + 8 * h) * 2);
  f32x16 oc[2]; oc[0] = zero16(); oc[1] = zero16();
  for (int kt = 0; kt < nkt; ++kt) {
    f32x16 sa = zero16();
#pragma unroll
    for (int s = 0; s < 4; ++s) sa = MFMA32(ld16(kcb + (size_t)kt * 32 * 64 + 16 * s), qf[s], sa);
    float pv[16];
#pragma unroll
    for (int e = 0; e < 16; ++e) { const int n = 32 * kt + crow(e, h); pv[e] = (n < nvalid) ? __expf(sa[e] - mbc) * invl : 0.f; }
#pragma unroll
    for (int s2 = 0; s2 < 2; ++s2) {
      bf16x8 bfr = pack8(pv[8 * s2], pv[8 * s2 + 1], pv[8 * s2 + 2], pv[8 * s2 + 3], pv[8 * s2 + 4], pv[8 * s2 + 5], pv[8 * s2 + 6], pv[8 * s2 + 7]);
#pragma unroll
      for (int di = 0; di < 2; ++di) oc[di] = MFMA32(ld8x2(p.VCT + ((size_t)bg * 64 + 32 * di + r) * 512 + 32 * kt + 16 * s2 + 4 * h), bfr, oc[di]);
    }
  }
  const float mbw = qn * kwm;
  f32x16 ow[2]; ow[0] = zero16(); ow[1] = zero16();
  float lw = 0.f;
  {
    int lo = ts + 8 * w - 511; if (lo < 0) lo = 0;
    const int kt0 = lo >> 5, kt1 = (ts + 8 * w + 7) >> 5;
    for (int kt = kt0; kt <= kt1; ++kt) {
      f32x16 sa = zero16();
      const bf16_t* kp = p.NKW + ((size_t)(b * SEQ + 32 * kt + r)) * 128 + g * 64 + 8 * h;
#pragma unroll
      for (int s = 0; s < 4; ++s) sa = MFMA32(ld16(kp + 16 * s), qf[s], sa);
      float pv[16];
#pragma unroll
      for (int e = 0; e < 16; ++e) {
        const int pos = 32 * kt + crow(e, h);
        const bool ok = (pos <= tpos) && (pos > tpos - 512);
        pv[e] = ok ? __expf(sa[e] - mbw) : 0.f; lw += pv[e];
      }
#pragma unroll
      for (int s2 = 0; s2 < 2; ++s2) {
        bf16x8 bfr = pack8(pv[8 * s2], pv[8 * s2 + 1], pv[8 * s2 + 2], pv[8 * s2 + 3], pv[8 * s2 + 4], pv[8 * s2 + 5], pv[8 * s2 + 6], pv[8 * s2 + 7]);
#pragma unroll
        for (int di = 0; di < 2; ++di) ow[di] = MFMA32(ld8x2(p.NVWT + ((size_t)bg * 64 + 32 * di + r) * SEQ + 32 * kt + 16 * s2 + 4 * h), bfr, ow[di]);
      }
    }
    lw += __shfl_xor(lw, 32);
  }
  __syncthreads();
  {
    const float ls = LS[row];
    const float invs = 1.f / ls, invw = 1.f / lw;
    const float* gt = p.GATE + (size_t)(tokg0 + tkl) * 24 + hd * 3;
    const float g0 = gt[0], g1 = gt[1] * invs, g2 = gt[2] * invw;
#pragma unroll
    for (int di = 0; di < 2; ++di)
#pragma unroll
      for (int g4 = 0; g4 < 4; ++g4) {
        const int d0 = 32 * di + 8 * g4 + 4 * h;
        float y[4];
#pragma unroll
        for (int e = 0; e < 4; ++e) y[e] = g0 * oc[di][4 * g4 + e] + g1 * OS[(d0 + e) * OS_STRIDE + row] + g2 * ow[di][4 * g4 + e];
        *(uint2*)(p.RA + (size_t)(tokg0 + tkl) * DM + 512 + hd * 64 + d0) = pack4(y[0], y[1], y[2], y[3]);
      }
  }
  __syncthreads();
}

typedef float f32x4 __attribute__((ext_vector_type(4)));
#define MFMA16(a, b, c) __builtin_amdgcn_mfma_f32_16x16x32_bf16((a), (b), (c), 0, 0, 0)
constexpr int pk_clen(int i) { return 16 / (i + 1); }
constexpr int pk_coff(int i) { int s = 0; for (int q = 0; q < i; ++q) s += pk_clen(q); return s; }
#define SC_STRIDE 132

DI void peer_topk_tile(const Params& p, int vb, char* smem) {
  float* SC = (float*)smem;
  unsigned* ELK = (unsigned*)(smem + 256 * SC_STRIDE * 4);
  float* ELW = (float*)(ELK + 16 * 128);
  const int tid = mytid(), lane = tid & 63, w = tid >> 6;
  const int t0 = vb * 16;
  {
    const int tq = lane & 15, kq = lane >> 4;
#pragma unroll
    for (int pi = 0; pi < 2; ++pi) {
      const int ph = 2 * w + pi;
      bf16x8 bfr[4];
#pragma unroll
      for (int s = 0; s < 4; ++s) bfr[s] = *(const bf16x8*)(p.PQ + (size_t)(t0 + tq) * 2048 + ph * 128 + 32 * s + 8 * kq);
#pragma unroll
      for (int j = 0; j < 8; ++j) {
        f32x4 acc = {0.f, 0.f, 0.f, 0.f};
#pragma unroll
        for (int s = 0; s < 4; ++s) {
          bf16x8 afr = *(const bf16x8*)(p.SUBK + ((size_t)(ph * 128 + 16 * j + tq)) * 128 + 32 * s + 8 * kq);
          acc = MFMA16(afr, bfr[s], acc);
        }
        *(f32x4*)(SC + (ph * 16 + tq) * SC_STRIDE + 16 * j + 4 * kq) = acc;
      }
    }
  }
  __syncthreads();
  if (tid < 256) {
    float* row = SC + tid * SC_STRIDE;
    float gmax[16];
#pragma unroll
    for (int g = 0; g < 16; ++g) {
      float4 a = *(float4*)(row + g * 8), b = *(float4*)(row + g * 8 + 4);
      gmax[g] = fmaxf(fmaxf(fmaxf(a.x, a.y), fmaxf(a.z, a.w)), fmaxf(fmaxf(b.x, b.y), fmaxf(b.z, b.w)));
    }
    float outv[16]; int outi[16];
#pragma unroll
    for (int k = 0; k < 16; ++k) {
      float gm = gmax[0]; int gi = 0;
#pragma unroll
      for (int g = 1; g < 16; ++g) { bool c = gmax[g] > gm; gm = c ? gmax[g] : gm; gi = c ? g : gi; }
      float* gp = row + gi * 8;
      float4 a = *(float4*)gp, b = *(float4*)(gp + 4);
      float v[8] = {a.x, a.y, a.z, a.w, b.x, b.y, b.z, b.w};
      int ei = 7;
#pragma unroll
      for (int e = 6; e >= 0; --e) ei = (v[e] == gm) ? e : ei;
      float nm = NEG_INF;
#pragma unroll
      for (int e = 0; e < 8; ++e) { float x = (e == ei) ? NEG_INF : v[e]; nm = fmaxf(nm, x); }
      gp[ei] = NEG_INF;
#pragma unroll
      for (int g = 0; g < 16; ++g) gmax[g] = (g == gi) ? nm : gmax[g];
      outv[k] = gm; outi[k] = gi * 8 + ei;
    }
#pragma unroll
    for (int k = 0; k < 16; ++k) { row[k] = outv[k]; row[16 + k] = __int_as_float(outi[k]); }
  }
  __syncthreads();
  if (tid < 128) {
    const int t = tid >> 3, pp = tid & 7;
    const float* ra = SC + ((2 * pp) * 16 + t) * SC_STRIDE;
    const float* rb = SC + ((2 * pp + 1) * 16 + t) * SC_STRIDE;
    float a[16], b[16]; int ia[16], ib[16];
#pragma unroll
    for (int q = 0; q < 4; ++q) {
      float4 x = *(const float4*)(ra + 4 * q), y = *(const float4*)(rb + 4 * q);
      float4 xi = *(const float4*)(ra + 16 + 4 * q), yi = *(const float4*)(rb + 16 + 4 * q);
      a[4 * q] = x.x; a[4 * q + 1] = x.y; a[4 * q + 2] = x.z; a[4 * q + 3] = x.w;
      b[4 * q] = y.x; b[4 * q + 1] = y.y; b[4 * q + 2] = y.z; b[4 * q + 3] = y.w;
      ia[4 * q] = __float_as_int(xi.x); ia[4 * q + 1] = __float_as_int(xi.y); ia[4 * q + 2] = __float_as_int(xi.z); ia[4 * q + 3] = __float_as_int(xi.w);
      ib[4 * q] = __float_as_int(yi.x); ib[4 * q + 1] = __float_as_int(yi.y); ib[4 * q + 2] = __float_as_int(yi.z); ib[4 * q + 3] = __float_as_int(yi.w);
    }
    float cs[50]; int cc[50];
#pragma unroll
    for (int i = 0; i < 16; ++i)
#pragma unroll
      for (int j = 0; j < pk_clen(i); ++j) { cs[pk_coff(i) + j] = a[i] + b[j]; cc[pk_coff(i) + j] = ia[i] * 128 + ib[j]; }
    float v16[16]; int c16[16];
#pragma unroll
    for (int k = 0; k < 16; ++k) {
      float best = cs[0]; int bi = 0, bc = cc[0];
#pragma unroll
      for (int q = 1; q < 50; ++q) { bool c = cs[q] > best; best = c ? cs[q] : best; bi = c ? q : bi; bc = c ? cc[q] : bc; }
#pragma unroll
      for (int q = 0; q < 50; ++q) cs[q] = (q == bi) ? NEG_INF : cs[q];
      v16[k] = best; c16[k] = bc;
    }
    float l = 0.f; const float vmax = v16[0];
#pragma unroll
    for (int k = 0; k < 16; ++k) { v16[k] = __expf(v16[k] - vmax); l += v16[k]; }
    float inv = 1.f / l;
#pragma unroll
    for (int k = 0; k < 16; ++k) {
      ELK[t * 128 + pp * 16 + k] = ((unsigned)c16[k] << 7) | (unsigned)(pp * 16 + k);
      ELW[t * 128 + pp * 16 + k] = v16[k] * inv;
    }
  }
  __syncthreads();
#pragma unroll
  for (int tt = 0; tt < 2; ++tt) {
    const int t = 2 * w + tt;
    unsigned e0 = ELK[t * 128 + 2 * lane], e1 = ELK[t * 128 + 2 * lane + 1];
#pragma unroll
    for (int k = 2; k <= 128; k <<= 1) {
#pragma unroll
      for (int j = k >> 1; j > 0; j >>= 1) {
        if (j == 1) {
          bool up = ((2 * lane) & k) == 0;
          unsigned lo = min(e0, e1), hi = max(e0, e1);
          e0 = up ? lo : hi; e1 = up ? hi : lo;
        } else {
          unsigned o0 = __shfl_xor(e0, j >> 1), o1 = __shfl_xor(e1, j >> 1);
          bool up = ((2 * lane) & k) == 0;
          bool lower = ((2 * lane) & j) == 0;
          bool keepmin = (up == lower);
          e0 = keepmin ? min(e0, o0) : max(e0, o0);
          e1 = keepmin ? min(e1, o1) : max(e1, o1);
        }
      }
    }
    const size_t gb = (size_t)(t0 + t) * 128 + 2 * lane;
    p.EIDX[gb] = (int)(e0 >> 7); p.EIDX[gb + 1] = (int)(e1 >> 7);
    p.EW[gb] = ELW[t * 128 + (e0 & 127)]; p.EW[gb + 1] = ELW[t * 128 + (e1 & 127)];
  }
  __syncthreads();
}

DI float dot2bf(unsigned a, unsigned b, float acc) { return __builtin_amdgcn_fdot2_f32_bf16(__builtin_bit_cast(bf16x2_t, a), __builtin_bit_cast(bf16x2_t, b), acc, false); }
template <int CTRL> DI float dpp_f(float x) { return __builtin_bit_cast(float, __builtin_amdgcn_mov_dpp(__builtin_bit_cast(int, x), CTRL, 0xf, 0xf, true)); }
DI float row16_sum(float v) { v += dpp_f<0x128>(v); v += dpp_f<0x124>(v); v += dpp_f<0x122>(v); v += dpp_f<0x121>(v); return v; }
DI float dot_row(const uint4 (&u)[8], const uint4 (&h)[8]) {
  float d = 0.f;
#pragma unroll
  for (int j = 0; j < 8; ++j) { d = dot2bf(u[j].x, h[j].x, d); d = dot2bf(u[j].y, h[j].y, d); d = dot2bf(u[j].z, h[j].z, d); d = dot2bf(u[j].w, h[j].w, d); }
  return row16_sum(d);
}
DI void axpy_row(float (&acc)[64], const uint4 (&v)[8], float c) {
#pragma unroll
  for (int j = 0; j < 8; ++j) {
    const unsigned ww[4] = {v[j].x, v[j].y, v[j].z, v[j].w};
#pragma unroll
    for (int q = 0; q < 4; ++q) {
      acc[j * 8 + 2 * q] += c * __uint_as_float(ww[q] << 16);
      acc[j * 8 + 2 * q + 1] += c * __uint_as_float(ww[q] & 0xffff0000u);
    }
  }
}
DI void axpy_half(float (&acc)[32], const uint4 (&v)[4], float c) {
#pragma unroll
  for (int j = 0; j < 4; ++j) {
    const unsigned ww[4] = {v[j].x, v[j].y, v[j].z, v[j].w};
#pragma unroll
    for (int q = 0; q < 4; ++q) {
      acc[j * 8 + 2 * q] += c * __uint_as_float(ww[q] << 16);
      acc[j * 8 + 2 * q + 1] += c * __uint_as_float(ww[q] & 0xffff0000u);
    }
  }
}
#ifndef PEER_TILE_SHIFT
#define PEER_TILE_SHIFT 8
#endif
DI void peer_gather_block(const Params& p, int vb, char* smem) {
  unsigned* ELK = (unsigned*)smem;
  float* ELC = (float*)(smem + 32768);
  const int tid = mytid(), lane = tid & 63, w = tid >> 6, grp = lane >> 4, i = lane & 15;
  const int tokbase = vb * 64;
  for (int q = tid; q < 64 * 128 / 4; q += NT) {
    ((uint4*)ELK)[q] = ((const uint4*)(p.EIDX + (size_t)tokbase * 128))[q];
    ((float4*)ELC)[q] = ((const float4*)(p.EW + (size_t)tokbase * 128))[q];
  }
  __syncthreads();
  const int tl0 = w * 8 + grp * 2;
  const unsigned* k0 = ELK + tl0 * 128; const unsigned* k1 = k0 + 128;
  float* c0 = ELC + tl0 * 128; float* c1 = c0 + 128;
  {
    uint4 h0[8], h1[8];
#pragma unroll
    for (int j = 0; j < 8; ++j) {
      h0[j] = *(const uint4*)(p.RA + (size_t)(tokbase + tl0) * DM + j * 128 + i * 8);
      h1[j] = *(const uint4*)(p.RA + (size_t)(tokbase + tl0 + 1) * DM + j * 128 + i * 8);
    }
    const bf16_t* ub_ = p.PDN + i * 8;
    uint4 xa[8], xb[8], ya[8], yb[8];
#define DN_LOAD(A, B, E) { const unsigned ea_ = k0[E], eb_ = k1[E]; _Pragma("unroll") for (int j = 0; j < 8; ++j) { A[j] = *(const uint4*)(ub_ + (size_t)ea_ * DM + j * 128); B[j] = *(const uint4*)(ub_ + (size_t)eb_ * DM + j * 128); } }
#define DN_COMP(A, B, E) { float da = dot_row(A, h0), db = dot_row(B, h1); float ca = c0[E] * gelu_tanh(da), cb = c1[E] * gelu_tanh(db); if (i == 0) { c0[E] = ca; c1[E] = cb; } }
    DN_LOAD(xa, xb, 0)
    for (int e = 0; e < 128; e += 2) {
      DN_LOAD(ya, yb, e + 1)
      DN_COMP(xa, xb, e)
      if (e + 2 < 128) DN_LOAD(xa, xb, e + 2)
      DN_COMP(ya, yb, e + 1)
    }
#undef DN_LOAD
#undef DN_COMP
  }
  float ssq0 = 0.f, ssq1 = 0.f;
#pragma unroll 1
  for (int half = 0; half < 2; ++half) {
    float acc0[32], acc1[32];
#pragma unroll
    for (int e = 0; e < 32; ++e) { acc0[e] = 0.f; acc1[e] = 0.f; }
    const bf16_t* vbase = p.PUP + half * 512 + i * 8;
    uint4 xa[4], xb[4], ya[4], yb[4];
#define UP_LOAD(A, B, E) { const unsigned ea_ = k0[E], eb_ = k1[E]; _Pragma("unroll") for (int j = 0; j < 4; ++j) { A[j] = *(const uint4*)(vbase + (size_t)ea_ * DM + j * 128); B[j] = *(const uint4*)(vbase + (size_t)eb_ * DM + j * 128); } }
#define UP_COMP(A, B, E) { axpy_half(acc0, A, c0[E]); axpy_half(acc1, B, c1[E]); }
    UP_LOAD(xa, xb, 0)
    for (int e = 0; e < 128; e += 2) {
      UP_LOAD(ya, yb, e + 1)
      UP_COMP(xa, xb, e)
      if (e + 2 < 128) UP_LOAD(xa, xb, e + 2)
      UP_COMP(ya, yb, e + 1)
    }
#undef UP_LOAD
#undef UP_COMP
#pragma unroll
    for (int tt = 0; tt < 2; ++tt) {
      const int tok = tokbase + tl0 + tt, b = tok >> 13;
      const float* ga2 = p.mod + b * 6144 + 5120;
      const float* orow = p.out + (size_t)tok * DM; float* grow = p.gout + (size_t)tok * DM;
      float* a = (tt == 0) ? acc0 : acc1;
      float ss = 0.f;
#pragma unroll
      for (int j = 0; j < 4; ++j)
#pragma unroll
        for (int hf = 0; hf < 2; ++hf) {
          const int col = half * 512 + j * 128 + i * 8 + hf * 4;
          float4 x1 = *(const float4*)(orow + col), gg = *(const float4*)(ga2 + col);
          float* q = a + j * 8 + hf * 4;
          q[0] = x1.x + gg.x * q[0]; q[1] = x1.y + gg.y * q[1]; q[2] = x1.z + gg.z * q[2]; q[3] = x1.w + gg.w * q[3];
          ss += q[0] * q[0] + q[1] * q[1] + q[2] * q[2] + q[3] * q[3];
        }
      ss = row16_sum(ss);
      if (half == 0) {
        if (tt == 0) ssq0 = ss; else ssq1 = ss;
#pragma unroll
        for (int j = 0; j < 4; ++j)
#pragma unroll
          for (int hf = 0; hf < 2; ++hf) {
            const int col = j * 128 + i * 8 + hf * 4;
            const float* q = a + j * 8 + hf * 4;
            *(float4*)(grow + col) = make_float4(q[0], q[1], q[2], q[3]);
          }
      } else {
        const float tot = ss + (tt == 0 ? ssq0 : ssq1);
        const float rstd = rsqrtf(tot * (1.f / DM) + 1e-6f);
#pragma unroll
        for (int j = 0; j < 4; ++j)
#pragma unroll
          for (int hf = 0; hf < 2; ++hf) {
            const int col = 512 + j * 128 + i * 8 + hf * 4;
            float4 gf = *(const float4*)(p.g_final + col);
            const float* q = a + j * 8 + hf * 4;
            *(float4*)(grow + col) = make_float4(q[0] * rstd * gf.x, q[1] * rstd * gf.y, q[2] * rstd * gf.z, q[3] * rstd * gf.w);
          }
#pragma unroll
        for (int j = 0; j < 4; ++j)
#pragma unroll
          for (int hf = 0; hf < 2; ++hf) {
            const int col = j * 128 + i * 8 + hf * 4;
            float4 gf = *(const float4*)(p.g_final + col), y = *(const float4*)(grow + col);
            *(float4*)(grow + col) = make_float4(y.x * rstd * gf.x, y.y * rstd * gf.y, y.z * rstd * gf.z, y.w * rstd * gf.w);
          }
      }
    }
  }
  __syncthreads();
}
DI void convert_tables(const Params& p, int v) {
  const int tb = v >> 12; const size_t base = (size_t)(v & 4095) * 4096 + mytid() * 8;
  const float* src = (tb ? p.peer_up : p.peer_down) + base;
  float4 a = *(const float4*)src, b = *(const float4*)(src + 4);
  uint2 lo = pack4(a.x, a.y, a.z, a.w), hi = pack4(b.x, b.y, b.z, b.w);
  uint4 o; o.x = lo.x; o.y = lo.y; o.z = hi.x; o.w = hi.y;
  *(uint4*)((tb ? p.PUP : p.PDN) + base) = o;
}

#define N_PHASES 11
template <int PH>
DI void run_phase(const Params& p, char* smem) {
  const int nb = gridDim.x, bid = blockIdx.x, tid = mytid();
  if (PH == 0) {
    for (int vb = bid; vb < PH0_NVB; vb += nb) ph0_body(p, vb, smem);
  } else if (PH == 1) {
    for (int vb = bid; vb < T_TOK / 8; vb += nb) rownorm_body(p.x, p.g_mix, p.mod, 0, 1024, p.RA, vb);
  } else if (PH == 2) {
    EpiProj e{p};
    for (int vb = bid; vb < 64 * 27; vb += nb) gemm_tile(p.RA, p.WinT, 1024, (vb & 63) * 256, (vb >> 6) * 128, smem, e);
  } else if (PH == 3) {
    for (int vb = bid; vb < 512 + 128 + 64; vb += nb) {
      if (vb < 512) retkv_mfma(p, vb);
      else if (vb < 512 + 128) compress_mfma(p, vb - 512, smem);
      else kmax_body2(p, vb - 640);
    }
  } else if (PH == 4) {
    for (int vb = bid; vb < 256 + 4; vb += nb) {
      if (vb < 256) scan_body(p, vb * NT + tid);
      else kcmax_body(p, (vb - 256) * NT + tid);
    }
  } else if (PH == 5) {
    for (int vb = bid; vb < 256; vb += nb) retout_mfma(p, vb * 8 + (tid >> 6));
    for (int vb = bid; vb < 512; vb += nb) nsa_item(p, (vb < 256) ? vb : 767 - vb, smem);
  } else if (PH == 6) {
    EpiOut e{p};
    for (int vb = bid; vb < 64 * 8; vb += nb) gemm_tile(p.RA, p.WoutT, 1024, (vb & 63) * 256, (vb >> 6) * 128, smem, e);
  } else if (PH == 7) {
    for (int vb = bid; vb < T_TOK / 8 + 8192; vb += nb) {
      if (vb < T_TOK / 8) rownorm_body(p.out, p.g_ffn, p.mod, 3072, 4096, p.RA, vb);
      else convert_tables(p, vb - T_TOK / 8);
    }
  } else if (PH == 8) {
    EpiPQ e{p};
    for (int vb = bid; vb < 64 * 16; vb += nb) gemm_tile(p.RA, p.WqT, 1024, (vb & 63) * 256, (vb >> 6) * 128, smem, e);
  } else if (PH == 9) {
    for (int vb = bid; vb < T_TOK / 16; vb += nb) peer_topk_tile(p, vb, smem);
  } else if (PH == 10) {
    for (int vb = bid; vb < T_TOK / 64; vb += nb) peer_gather_block(p, vb, smem);
  }
}

#define SMEM_BYTES 155648

#ifndef PROBE_DUP
#define PROBE_DUP -1
#endif
template <int PH>
DI void phase_and_probe(const Params& p, char* smem, cg::grid_group& grid) {
  const int reps = (PROBE_DUP == PH) ? 2 : 1;
  for (int rep = 0; rep < reps; ++rep) {
    if (PH == 10 && rep + 1 < reps) { Params q = p; q.gout = (float*)p.PQ; run_phase<PH>(q, smem); }
    else run_phase<PH>(p, smem);
    if (rep + 1 < reps) grid.sync();
  }
}
__global__ void __launch_bounds__(NT) k_mega(Params p) {
  extern __shared__ __attribute__((aligned(16))) char smem[];
  cg::grid_group grid = cg::this_grid();
  phase_and_probe<0>(p, smem, grid); grid.sync();
  phase_and_probe<1>(p, smem, grid); grid.sync();
  phase_and_probe<2>(p, smem, grid); grid.sync();
  phase_and_probe<3>(p, smem, grid); grid.sync();
  phase_and_probe<4>(p, smem, grid); grid.sync();
  phase_and_probe<5>(p, smem, grid); grid.sync();
  phase_and_probe<6>(p, smem, grid); grid.sync();
  phase_and_probe<7>(p, smem, grid); grid.sync();
  phase_and_probe<8>(p, smem, grid); grid.sync();
  phase_and_probe<9>(p, smem, grid); grid.sync();
  phase_and_probe<10>(p, smem, grid);
}
#ifdef MK_MULTI
template <int PH>
__global__ void __launch_bounds__(NT) k_single(Params p) {
  extern __shared__ __attribute__((aligned(16))) char smem[];
  run_phase<PH>(p, smem);
}
#endif

static size_t carve(size_t& off, size_t bytes) { size_t o = off; off += (bytes + 255) & ~(size_t)255; return o; }

extern "C" void kernel_launch(void* const* d_in, const int* in_sizes, int n_in, void* d_out, int out_size, void* d_ws, size_t ws_size,
                              hipStream_t stream) {
  Params p{};
  p.x = (const float*)d_in[0]; p.c = (const float*)d_in[1]; p.w_ada = (const float*)d_in[2]; p.b_ada = (const float*)d_in[3];
  p.g_mix = (const float*)d_in[4]; p.w_in = (const float*)d_in[5]; p.pe_k = (const float*)d_in[6]; p.pe_v = (const float*)d_in[7];
  p.w_k1 = (const float*)d_in[8]; p.b_k1 = (const float*)d_in[9]; p.w_k2 = (const float*)d_in[10]; p.w_v1 = (const float*)d_in[11];
  p.b_v1 = (const float*)d_in[12]; p.w_v2 = (const float*)d_in[13]; p.w_out = (const float*)d_in[14]; p.g_ffn = (const float*)d_in[15];
  p.w_pq = (const float*)d_in[16]; p.subkeys = (const float*)d_in[17]; p.peer_down = (const float*)d_in[18]; p.peer_up = (const float*)d_in[19];
  p.g_final = (const float*)d_in[20];
  p.out = (float*)d_out; p.gout = p.out;
  char* ws = (char*)d_ws;
  size_t off = 0;
  p.mod = (float*)(ws + carve(off, 2 * 6144 * 4));
  p.ksmax = (unsigned*)(ws + carve(off, 256));
  p.c128 = (float*)(ws + carve(off, (size_t)SEQ * 64 * 4)); p.s128 = (float*)(ws + carve(off, (size_t)SEQ * 64 * 4));
  p.c64 = (float*)(ws + carve(off, (size_t)SEQ * 32 * 4)); p.s64 = (float*)(ws + carve(off, (size_t)SEQ * 32 * 4));
  p.WinT = (bf16_t*)(ws + carve(off, (size_t)NPROJ * 1024 * 2));
  p.WoutT = (bf16_t*)(ws + carve(off, (size_t)1024 * 1024 * 2));
  p.WqT = (bf16_t*)(ws + carve(off, (size_t)2048 * 1024 * 2));
  p.W1Tk = (bf16_t*)(ws + carve(off, (size_t)256 * 2048 * 2)); p.W1Tv = (bf16_t*)(ws + carve(off, (size_t)256 * 2048 * 2));
  p.W2Tk = (bf16_t*)(ws + carve(off, 64 * 256 * 2)); p.W2Tv = (bf16_t*)(ws + carve(off, 64 * 256 * 2));
  p.SUBK = (bf16_t*)(ws + carve(off, (size_t)16 * 128 * 128 * 2));
  p.B1Pk = (float*)(ws + carve(off, 1024)); p.B1Pv = (float*)(ws + carve(off, 1024));
  p.RA = (bf16_t*)(ws + carve(off, (size_t)T_TOK * 1024 * 2));
  size_t rb = off;
  p.RQ = (bf16_t*)(ws + carve(off, (size_t)T_TOK * 512 * 2)); p.RK = (bf16_t*)(ws + carve(off, (size_t)T_TOK * 512 * 2));
  p.RKT = (bf16_t*)(ws + carve(off, (size_t)T_TOK * 512 * 2)); p.RVT = (bf16_t*)(ws + carve(off, (size_t)T_TOK * 512 * 2));
  p.RGT = (bf16_t*)(ws + carve(off, (size_t)T_TOK * 512 * 2)); p.NQ = (bf16_t*)(ws + carve(off, (size_t)T_TOK * 512 * 2));
  p.NKC = (bf16_t*)(ws + carve(off, (size_t)T_TOK * 128 * 2)); p.NVC = (bf16_t*)(ws + carve(off, (size_t)T_TOK * 128 * 2));
  p.NKS = (bf16_t*)(ws + carve(off, (size_t)T_TOK * 128 * 2)); p.NKW = (bf16_t*)(ws + carve(off, (size_t)T_TOK * 128 * 2));
  p.NVST = (bf16_t*)(ws + carve(off, (size_t)T_TOK * 128 * 2)); p.NVWT = (bf16_t*)(ws + carve(off, (size_t)T_TOK * 128 * 2));
  p.GATE = (float*)(ws + carve(off, (size_t)T_TOK * 24 * 4));
  p.KV = (float*)(ws + carve(off, (size_t)512 * 16384 * 4));
  p.SPREV = (bf16_t*)(ws + carve(off, (size_t)512 * 16384 * 2));
  p.KC = (bf16_t*)(ws + carve(off, (size_t)4 * 512 * 64 * 2)); p.VCT = (bf16_t*)(ws + carve(off, (size_t)4 * 512 * 64 * 2));
  p.HID = (float*)(ws + carve(off, (size_t)2 * 2048 * 256 * 4));
  size_t off2 = rb;
  p.PQ = (bf16_t*)(ws + carve(off2, (size_t)T_TOK * 2048 * 2));
  p.EIDX = (int*)(ws + carve(off2, (size_t)T_TOK * 128 * 4));
  p.EW = (float*)(ws + carve(off2, (size_t)T_TOK * 128 * 4));
  p.PDN = (bf16_t*)(ws + carve(off2, (size_t)16384 * 1024 * 2));
  p.PUP = (bf16_t*)(ws + carve(off2, (size_t)16384 * 1024 * 2));
  (void)ws_size; (void)in_sizes; (void)n_in; (void)out_size;

#ifdef MK_MULTI
#define LAUNCH1(PH) { hipFuncSetAttribute((const void*)k_single<PH>, hipFuncAttributeMaxDynamicSharedMemorySize, SMEM_BYTES); k_single<PH><<<256, NT, SMEM_BYTES, stream>>>(p); }
  LAUNCH1(0) LAUNCH1(1) LAUNCH1(2) LAUNCH1(3) LAUNCH1(4) LAUNCH1(5) LAUNCH1(6) LAUNCH1(7) LAUNCH1(8) LAUNCH1(9) LAUNCH1(10)
#else
  static int grid_blocks = 0;
  if (!grid_blocks) {
    int dev = 0, cus = 0, per_cu = 0;
    (void)hipGetDevice(&dev);
    (void)hipDeviceGetAttribute(&cus, hipDeviceAttributeMultiprocessorCount, dev);
    (void)hipFuncSetAttribute((const void*)k_mega, hipFuncAttributeMaxDynamicSharedMemorySize, SMEM_BYTES);
    (void)hipOccupancyMaxActiveBlocksPerMultiprocessor(&per_cu, k_mega, NT, SMEM_BYTES);
    if (per_cu < 1) per_cu = 1;
    if (per_cu > 1) per_cu = 1;
    grid_blocks = cus * per_cu;
  }
  void* args[] = {&p};
  hipError_t e = hipLaunchCooperativeKernel((void*)k_mega, dim3(grid_blocks), dim3(NT), args, SMEM_BYTES, stream);
  if (e != hipSuccess) fprintf(stderr, "cooperative launch failed: %s (grid %d)\n", hipGetErrorString(e), grid_blocks);
#endif
}
```

```cpp
#include <hip/hip_runtime.h>
#include <hip/hip_bf16.h>
#include <hip/hip_cooperative_groups.h>
#include <stdint.h>
#include <stdio.h>
namespace cg = cooperative_groups;

typedef unsigned short bf16_t;
#define DI __device__ __forceinline__

DI int mytid() { int t = threadIdx.x; asm volatile("" : "+v"(t)); return t; }
DI float bf2f(bf16_t v) { return __uint_as_float(((unsigned)v) << 16); }
DI bf16_t f2bf(float x) { unsigned u = __float_as_uint(x); u += 0x7fffu + ((u >> 16) & 1u); return (bf16_t)(u >> 16); }
DI float gelu_tanh(float x) { float u = 0.7978845608028654f * (x + 0.044715f * x * x * x); return 0.5f * x * (1.f + tanhf(u)); }
DI float siluf(float x) { return x / (1.f + __expf(-x)); }
DI float sigmoidf(float x) { return 1.f / (1.f + __expf(-x)); }

#define T_TOK 16384
#define SEQ 8192
#define DM 1024
#define NPROJ 3456
#define NEG_INF (-__builtin_inff())

struct Params {
  const float *x, *c, *w_ada, *b_ada, *g_mix, *w_in, *pe_k, *pe_v, *w_k1, *b_k1, *w_k2, *w_v1, *b_v1, *w_v2, *w_out, *g_ffn,
      *w_pq, *subkeys, *peer_down, *peer_up, *g_final;
  float* out;
  float* gout;
  float* mod;
  unsigned* ksmax;
  unsigned* xbar;
  float *c128, *s128, *c64, *s64;
  bf16_t *WinT, *WoutT, *WqT, *W1Tk, *W1Tv, *W2Tk, *W2Tv, *SUBK;
  float *B1Pk, *B1Pv;
  bf16_t* RA;
  bf16_t *RQ, *RK, *RKT, *RVT, *RGT, *NQ, *NKC, *NVC, *NKS, *NKW, *NVST, *NVWT;
  float* GATE;
  float* KV;
  bf16_t* SPREV;
  bf16_t *KC, *VCT;
  float* HID;
  bf16_t* PQ;
  int* EIDX;
  float* EW;
  bf16_t *PDN, *PUP;
};

DI float logg_h(int h) { return log1pf(-exp2f(-5.f - (float)h)); }


typedef __bf16 bf16x2_t __attribute__((ext_vector_type(2)));
typedef float f32x2_t __attribute__((ext_vector_type(2)));
DI unsigned cvt2(float a, float b) { f32x2_t v = {a, b}; bf16x2_t r = __builtin_convertvector(v, bf16x2_t); return __builtin_bit_cast(unsigned, r); }
DI uint2 pack4(float a, float b, float c, float d) { uint2 r; r.x = cvt2(a, b); r.y = cvt2(c, d); return r; }
#define NT 512
#ifndef PROBE_DUP
#define PROBE_DUP -1
#endif
typedef short bf16x8 __attribute__((ext_vector_type(8)));
typedef float f32x16 __attribute__((ext_vector_type(16)));
#define MFMA32(a, b, c) __builtin_amdgcn_mfma_f32_32x32x16_bf16((a), (b), (c), 0, 0, 0)

DI int win_logical_col(int np) {
  int g = np >> 6, c = np & 63;
  if (g < 16) {
    int sec = g >> 3, hh = (g & 7) >> 1, j = g & 1, i = 32 * j + (c & 31);
    return sec * 512 + hh * 128 + ((c < 32) ? i : 64 + i);
  } else if (g < 52) return 1024 + (g - 16) * 64 + c;
  else if (g == 52) return (c < 24) ? 3328 + c : -1;
  return -1;
}

DI void tr_tile(const float* __restrict__ in, bf16_t* __restrict__ out, int K, int N_in, int k0, int n0, int mode, float* tile) {
  const int tid = mytid();
  {
    int nn = tid & 63, col = mode ? win_logical_col(n0 + nn) : (n0 + nn);
#pragma unroll
    for (int i = 0; i < 8; ++i) {
      int kk = (tid >> 6) + 8 * i;
      tile[kk * 65 + nn] = (col >= 0) ? in[(size_t)(k0 + kk) * N_in + col] : 0.f;
    }
  }
  __syncthreads();
  {
    int kk = tid & 63;
#pragma unroll
    for (int i = 0; i < 8; ++i) {
      int nn = (tid >> 6) + 8 * i;
      out[(size_t)(n0 + nn) * K + k0 + kk] = f2bf(tile[kk * 65 + nn]);
    }
  }
  __syncthreads();
}

#define PH0_MOD 96
#define PH0_WIN (PH0_MOD + 16 * 54)
#define PH0_WOUT (PH0_WIN + 256)
#define PH0_WQ (PH0_WOUT + 512)
#define PH0_W1K (PH0_WQ + 128)
#define PH0_W1V (PH0_W1K + 128)
#define PH0_W2K (PH0_W1V + 4)
#define PH0_W2V (PH0_W2K + 4)
#define PH0_SUBK (PH0_W2V + 512)
#define PH0_ROPE (PH0_SUBK + 1024)
#define PH0_B1P (PH0_ROPE + 8)
#define PH0_NVB PH0_B1P

DI void ph0_body(const Params& p, int vb, char* smem) {
  const int tid = mytid();
  float* fs = (float*)smem;
  if (vb < PH0_MOD) {
    int kg = tid >> 6, col = vb * 64 + (tid & 63);
    float a0 = 0.f, a1 = 0.f;
#pragma unroll 8
    for (int k = kg * 128; k < kg * 128 + 128; ++k) {
      float w = p.w_ada[(size_t)k * 6144 + col];
      a0 += siluf(p.c[k]) * w; a1 += siluf(p.c[DM + k]) * w;
    }
    fs[kg * 64 + (tid & 63)] = a0; fs[512 + kg * 64 + (tid & 63)] = a1;
    __syncthreads();
    if (tid < 128) {
      int b = tid >> 6, cc = tid & 63; float s = 0.f;
      for (int g = 0; g < 8; ++g) s += fs[b * 512 + g * 64 + cc];
      p.mod[b * 6144 + vb * 64 + cc] = s + p.b_ada[vb * 64 + cc];
    }
    __syncthreads();
    if (vb == 0 && tid < 12) p.ksmax[tid] = 0u;
  } else if (vb < PH0_WIN) { int t = vb - PH0_MOD; tr_tile(p.w_in, p.WinT, 1024, 3352, (t & 15) * 64, (t >> 4) * 64, 1, fs); }
  else if (vb < PH0_WOUT) { int t = vb - PH0_WIN; tr_tile(p.w_out, p.WoutT, 1024, 1024, (t & 15) * 64, (t >> 4) * 64, 0, fs); }
  else if (vb < PH0_WQ) { int t = vb - PH0_WOUT; tr_tile(p.w_pq, p.WqT, 1024, 2048, (t & 15) * 64, (t >> 4) * 64, 0, fs); }
  else if (vb < PH0_W1K) { int t = vb - PH0_WQ; tr_tile(p.w_k1, p.W1Tk, 2048, 256, (t & 31) * 64, (t >> 5) * 64, 0, fs); }
  else if (vb < PH0_W1V) { int t = vb - PH0_W1K; tr_tile(p.w_v1, p.W1Tv, 2048, 256, (t & 31) * 64, (t >> 5) * 64, 0, fs); }
  else if (vb < PH0_W2K) { int t = vb - PH0_W1V; tr_tile(p.w_k2, p.W2Tk, 256, 64, t * 64, 0, 0, fs); }
  else if (vb < PH0_W2V) { int t = vb - PH0_W2K; tr_tile(p.w_v2, p.W2Tv, 256, 64, t * 64, 0, 0, fs); }
  else if (vb < PH0_SUBK) { int i = (vb - PH0_W2V) * NT + tid; p.SUBK[i] = f2bf(p.subkeys[i]); }
  else if (vb < PH0_ROPE) {
    int idx = (vb - PH0_SUBK) * NT + tid;
    { int s = idx >> 6, i = idx & 63; float inv = powf(10000.f, -(float)(2 * i) / 128.f); float ang = (float)s * inv; p.c128[idx] = cosf(ang); p.s128[idx] = sinf(ang); }
    if (idx < SEQ * 32) { int s = idx >> 5, i = idx & 31; float inv = powf(10000.f, -(float)(2 * i) / 64.f); float ang = (float)s * inv; p.c64[idx] = cosf(ang); p.s64[idx] = sinf(ang); }
  } else {
    int t = vb - PH0_ROPE, kv = t >> 2, jb = t & 3;
    const float* w1 = kv ? p.w_v1 : p.w_k1; const float* pe = kv ? p.pe_v : p.pe_k; const float* b1 = kv ? p.b_v1 : p.b_k1;
    int fg = tid >> 6, j = jb * 64 + (tid & 63);
    float a = 0.f;
#pragma unroll 8
    for (int f = fg * 256; f < fg * 256 + 256; ++f) a += pe[f] * w1[(size_t)f * 256 + j];
    fs[fg * 64 + (tid & 63)] = a;
    __syncthreads();
    if (tid < 64) { float s = b1[j]; for (int g = 0; g < 8; ++g) s += fs[g * 64 + tid]; (kv ? p.B1Pv : p.B1Pk)[j] = s; }
    __syncthreads();
  }
}

DI void rownorm_body(const float* __restrict__ src, const float* __restrict__ g, const float* __restrict__ mod, int sh_off, int sc_off, bf16_t* __restrict__ dst, int vb) {
  int row = vb * 8 + (mytid() >> 6), lane = mytid() & 63;
  int b = row >> 13;
  const float* xr = src + (size_t)row * DM;
  float v[16]; float ss = 0.f;
#pragma unroll
  for (int i = 0; i < 4; ++i) {
    float4 t = *(const float4*)(xr + i * 256 + lane * 4);
    v[i * 4 + 0] = t.x; v[i * 4 + 1] = t.y; v[i * 4 + 2] = t.z; v[i * 4 + 3] = t.w;
    ss += t.x * t.x + t.y * t.y + t.z * t.z + t.w * t.w;
  }
  for (int o = 32; o; o >>= 1) ss += __shfl_xor(ss, o);
  float rstd = rsqrtf(ss * (1.f / DM) + 1e-6f);
  const float* sh = mod + b * 6144 + sh_off; const float* sc = mod + b * 6144 + sc_off;
#pragma unroll
  for (int i = 0; i < 4; ++i) {
    int col = i * 256 + lane * 4;
    float4 gg = *(const float4*)(g + col), s4 = *(const float4*)(sc + col), h4 = *(const float4*)(sh + col);
    float y0 = v[i * 4 + 0] * rstd * gg.x * (1.f + s4.x) + h4.x;
    float y1 = v[i * 4 + 1] * rstd * gg.y * (1.f + s4.y) + h4.y;
    float y2 = v[i * 4 + 2] * rstd * gg.z * (1.f + s4.z) + h4.z;
    float y3 = v[i * 4 + 3] * rstd * gg.w * (1.f + s4.w) + h4.w;
    *(uint2*)(dst + (size_t)row * DM + col) = pack4(y0, y1, y2, y3);
  }
}

#define G_A_BYTES (256 * 144)
#define G_B_BYTES (128 * 144)
#define G_BUF_BYTES (G_A_BYTES + G_B_BYTES)
template <class Epi>
DI void gemm_tile(const bf16_t* __restrict__ A, const bf16_t* __restrict__ Bt, int K, int m0, int n0, char* smem, const Epi& epi) {
  const int tid = mytid(), lane = tid & 63, w = tid >> 6, wm = w >> 1, wn = w & 1, r = lane & 31, h = lane >> 5;
  f32x16 acc[2][2];
#pragma unroll
  for (int i = 0; i < 2; ++i)
#pragma unroll
    for (int j = 0; j < 2; ++j)
#pragma unroll
      for (int e = 0; e < 16; ++e) acc[i][j][e] = 0.f;
  const int crow = tid >> 3, ckc = tid & 7;
  const bf16_t* ag = A + (size_t)(m0 + crow) * K + ckc * 8;
  const bf16_t* bg = Bt + (size_t)(n0 + crow) * K + ckc * 8;
  uint4 ra[4], rb[2];
#pragma unroll
  for (int i = 0; i < 4; ++i) ra[i] = *(const uint4*)(ag + (size_t)i * 64 * K);
#pragma unroll
  for (int i = 0; i < 2; ++i) rb[i] = *(const uint4*)(bg + (size_t)i * 64 * K);
  char* lw = smem + crow * 144 + ckc * 16;
#pragma unroll
  for (int i = 0; i < 4; ++i) *(uint4*)(lw + i * 64 * 144) = ra[i];
#pragma unroll
  for (int i = 0; i < 2; ++i) *(uint4*)(lw + G_A_BYTES + i * 64 * 144) = rb[i];
  __syncthreads();
  const int nk = K >> 6;
  for (int kt = 0; kt < nk; ++kt) {
    const int cur = kt & 1;
    if (kt + 1 < nk) {
      const int k0 = (kt + 1) * 64;
#pragma unroll
      for (int i = 0; i < 4; ++i) ra[i] = *(const uint4*)(ag + (size_t)i * 64 * K + k0);
#pragma unroll
      for (int i = 0; i < 2; ++i) rb[i] = *(const uint4*)(bg + (size_t)i * 64 * K + k0);
    }
    const char* la = smem + cur * G_BUF_BYTES + (wm * 64 + r) * 144 + h * 16;
    const char* lb = smem + cur * G_BUF_BYTES + G_A_BYTES + (wn * 64 + r) * 144 + h * 16;
#pragma unroll
    for (int kk = 0; kk < 4; ++kk) {
      bf16x8 a0 = *(const bf16x8*)(la + kk * 32), a1 = *(const bf16x8*)(la + 32 * 144 + kk * 32);
      bf16x8 b0 = *(const bf16x8*)(lb + kk * 32), b1 = *(const bf16x8*)(lb + 32 * 144 + kk * 32);
      acc[0][0] = MFMA32(a0, b0, acc[0][0]); acc[0][1] = MFMA32(a0, b1, acc[0][1]);
      acc[1][0] = MFMA32(a1, b0, acc[1][0]); acc[1][1] = MFMA32(a1, b1, acc[1][1]);
    }
    if (kt + 1 < nk) {
      char* lw2 = lw + (cur ^ 1) * G_BUF_BYTES;
#pragma unroll
      for (int i = 0; i < 4; ++i) *(uint4*)(lw2 + i * 64 * 144) = ra[i];
#pragma unroll
      for (int i = 0; i < 2; ++i) *(uint4*)(lw2 + G_A_BYTES + i * 64 * 144) = rb[i];
    }
    __syncthreads();
  }
  const int G = (n0 >> 6) + wn;
#pragma unroll
  for (int i = 0; i < 2; ++i)
#pragma unroll
    for (int g = 0; g < 4; ++g) {
      float lo[4], hi[4];
#pragma unroll
      for (int e = 0; e < 4; ++e) { lo[e] = acc[i][0][4 * g + e]; hi[e] = acc[i][1][4 * g + e]; }
      epi(m0 + wm * 64 + i * 32 + 8 * g + 4 * h, G, r, lo, hi);
    }
}

struct EpiProj {
  const Params& p;
  DI void operator()(int t0, int G, int c, const float (&lo)[4], const float (&hi)[4]) const {
    const int b = t0 >> 13, s0 = t0 & 8191;
    if (G < 16) {
      const int sec = G >> 3, hh = (G & 7) >> 1, j = G & 1, i = 32 * j + c;
      float o1[4], o2[4];
#pragma unroll
      for (int e = 0; e < 4; ++e) {
        float cs = p.c128[(s0 + e) * 64 + i], sn = p.s128[(s0 + e) * 64 + i];
        o1[e] = lo[e] * cs - hi[e] * sn; o2[e] = hi[e] * cs + lo[e] * sn;
      }
      if (sec == 0) {
#pragma unroll
        for (int e = 0; e < 4; ++e) {
          p.RQ[(size_t)(t0 + e) * 512 + hh * 128 + i] = f2bf(o1[e]);
          p.RQ[(size_t)(t0 + e) * 512 + hh * 128 + 64 + i] = f2bf(o2[e]);
        }
      } else {
        const float sc = 0.08838834764831845f;
        const float lg = logg_h(hh);
#pragma unroll
        for (int e = 0; e < 4; ++e) {
          o1[e] *= sc; o2[e] *= sc;
          p.RK[(size_t)(t0 + e) * 512 + hh * 128 + i] = f2bf(o1[e]);
          p.RK[(size_t)(t0 + e) * 512 + hh * 128 + 64 + i] = f2bf(o2[e]);
          float zeta = __expf((float)(127 - ((s0 + e) & 127)) * lg);
          o1[e] *= zeta; o2[e] *= zeta;
        }
        *(uint2*)(p.RKT + ((size_t)(b * 4 + hh) * 128 + i) * SEQ + s0) = pack4(o1[0], o1[1], o1[2], o1[3]);
        *(uint2*)(p.RKT + ((size_t)(b * 4 + hh) * 128 + 64 + i) * SEQ + s0) = pack4(o2[0], o2[1], o2[2], o2[3]);
      }
    } else if (G < 24) {
      const int hh = (G - 16) >> 1, d = ((G - 16) & 1) * 64 + c;
      *(uint2*)(p.RVT + ((size_t)(b * 4 + hh) * 128 + d) * SEQ + s0) = pack4(lo[0], lo[1], lo[2], lo[3]);
      *(uint2*)(p.RVT + ((size_t)(b * 4 + hh) * 128 + d + 32) * SEQ + s0) = pack4(hi[0], hi[1], hi[2], hi[3]);
    } else if (G < 32) {
      const int hh = (G - 24) >> 1, d = ((G - 24) & 1) * 64 + c;
#pragma unroll
      for (int e = 0; e < 4; ++e) {
        p.RGT[(size_t)(t0 + e) * 512 + hh * 128 + d] = f2bf(siluf(lo[e]));
        p.RGT[(size_t)(t0 + e) * 512 + hh * 128 + d + 32] = f2bf(siluf(hi[e]));
      }
    } else if (G < 40) {
      const int head = G - 32;
#pragma unroll
      for (int e = 0; e < 4; ++e) {
        float cs = p.c64[(s0 + e) * 32 + c], sn = p.s64[(s0 + e) * 32 + c];
        float o1 = (lo[e] * cs - hi[e] * sn) * 0.125f, o2 = (hi[e] * cs + lo[e] * sn) * 0.125f;
        p.NQ[(size_t)(t0 + e) * 512 + head * 64 + c] = f2bf(o1);
        p.NQ[(size_t)(t0 + e) * 512 + head * 64 + 32 + c] = f2bf(o2);
      }
    } else if (G < 52) {
      const int k = G - 40, kind = k >> 1, gg = k & 1;
      float o1[4], o2[4];
#pragma unroll
      for (int e = 0; e < 4; ++e) {
        o1[e] = lo[e]; o2[e] = hi[e];
        if ((kind & 1) == 0) {
          float cs = p.c64[(s0 + e) * 32 + c], sn = p.s64[(s0 + e) * 32 + c];
          o1[e] = lo[e] * cs - hi[e] * sn; o2[e] = hi[e] * cs + lo[e] * sn;
        }
      }
      if (kind == 3 || kind == 5) {
        bf16_t* dst = (kind == 3 ? p.NVST : p.NVWT) + ((size_t)(b * 2 + gg) * 64 + c) * SEQ + s0;
        *(uint2*)dst = pack4(o1[0], o1[1], o1[2], o1[3]);
        *(uint2*)(dst + (size_t)32 * SEQ) = pack4(o2[0], o2[1], o2[2], o2[3]);
      } else {
        bf16_t* dst = (kind == 0 ? p.NKC : kind == 1 ? p.NVC : kind == 2 ? p.NKS : p.NKW);
#pragma unroll
        for (int e = 0; e < 4; ++e) {
          dst[(size_t)(t0 + e) * 128 + gg * 64 + c] = f2bf(o1[e]);
          dst[(size_t)(t0 + e) * 128 + gg * 64 + 32 + c] = f2bf(o2[e]);
        }
      }
    } else if (G == 52) {
      if (c < 24) {
#pragma unroll
        for (int e = 0; e < 4; ++e) p.GATE[(size_t)(t0 + e) * 24 + c] = sigmoidf(lo[e]);
      }
    }
  }
};
struct EpiOut {
  const Params& p;
  DI void operator()(int t0, int G, int c, const float (&lo)[4], const float (&hi)[4]) const {
    const int b = t0 >> 13;
    const int c0 = G * 64 + c, c1 = c0 + 32;
    const float* ga1 = p.mod + b * 6144 + 2048;
    const float g0 = ga1[c0], g1 = ga1[c1];
#pragma unroll
    for (int e = 0; e < 4; ++e) {
      p.out[(size_t)(t0 + e) * DM + c0] = p.x[(size_t)(t0 + e) * DM + c0] + g0 * lo[e];
      p.out[(size_t)(t0 + e) * DM + c1] = p.x[(size_t)(t0 + e) * DM + c1] + g1 * hi[e];
    }
  }
};
struct EpiPQ {
  const Params& p;
  DI void operator()(int t0, int G, int c, const float (&lo)[4], const float (&hi)[4]) const {
#pragma unroll
    for (int e = 0; e < 4; ++e) {
      p.PQ[(size_t)(t0 + e) * 2048 + G * 64 + c] = f2bf(lo[e]);
      p.PQ[(size_t)(t0 + e) * 2048 + G * 64 + 32 + c] = f2bf(hi[e]);
    }
  }
};

DI void retkv_naive(const Params& p, size_t idx) {
  int item = (int)(idx >> 14), v = (int)((idx >> 7) & 127), k = (int)(idx & 127);
  int h = item & 3, c = (item >> 2) & 63, b = item >> 8;
  const bf16_t* vp = p.RVT + ((size_t)(b * 4 + h) * 128 + v) * SEQ + c * 128;
  const bf16_t* kp = p.RKT + ((size_t)(b * 4 + h) * 128 + k) * SEQ + c * 128;
  float a = 0.f;
  for (int m = 0; m < 128; ++m) a += bf2f(vp[m]) * bf2f(kp[m]);
  p.KV[idx] = a;
}
DI void scan_naive(const Params& p, int idx) {
  int e = idx & 16383, bh = idx >> 14, b = bh >> 2, h = bh & 3;
  float cd = __expf(128.f * logg_h(h));
  float S = 0.f;
  for (int c = 0; c < 64; ++c) {
    size_t o = (size_t)((b * 64 + c) * 4 + h) * 16384 + e;
    p.SPREV[o] = f2bf(S);
    S = cd * S + p.KV[o];
  }
}
DI void retout_naive(const Params& p, int item, char* smem) {
  float* Ssc = (float*)smem;
  float* Y = Ssc + 128 * 129;
  int h = item & 3, c = (item >> 2) & 63, b = item >> 8;
  int t0 = b * SEQ + c * 128, s0 = c * 128;
  float lg = logg_h(h);
  for (int idx = mytid(); idx < 16384; idx += NT) {
    int n = idx >> 7, m = idx & 127;
    float a = 0.f;
    if (m <= n) {
      const bf16_t* q = p.RQ + (size_t)(t0 + n) * 512 + h * 128;
      const bf16_t* k = p.RK + (size_t)(t0 + m) * 512 + h * 128;
      for (int kk = 0; kk < 128; ++kk) a += bf2f(q[kk]) * bf2f(k[kk]);
      a *= __expf((float)(n - m) * lg);
    }
    Ssc[n * 129 + m] = a;
  }
  __syncthreads();
  for (int idx = mytid(); idx < 16384; idx += NT) {
    int n = idx >> 7, v = idx & 127;
    const bf16_t* vp = p.RVT + ((size_t)(b * 4 + h) * 128 + v) * SEQ + s0;
    float inner = 0.f;
    for (int m = 0; m <= n; ++m) inner += Ssc[n * 129 + m] * bf2f(vp[m]);
    const bf16_t* q = p.RQ + (size_t)(t0 + n) * 512 + h * 128;
    const bf16_t* sp = p.SPREV + (size_t)item * 16384 + v * 128;
    float cr = 0.f;
    for (int kk = 0; kk < 128; ++kk) cr += bf2f(q[kk]) * bf2f(sp[kk]);
    Y[n * 129 + v] = inner + __expf((float)(n + 1) * lg) * cr;
  }
  __syncthreads();
  if (mytid() < 128) {
    int n = mytid();
    float mu = 0.f;
    for (int v = 0; v < 128; ++v) mu += Y[n * 129 + v];
    mu *= (1.f / 128.f);
    float var = 0.f;
    for (int v = 0; v < 128; ++v) { float d = Y[n * 129 + v] - mu; var += d * d; }
    var *= (1.f / 128.f);
    float rs = rsqrtf(var + 1e-6f);
    for (int v = 0; v < 128; ++v) {
      float g = bf2f(p.RGT[((size_t)(b * 4 + h) * 128 + v) * SEQ + s0 + n]);
      p.RA[(size_t)(t0 + n) * DM + h * 128 + v] = f2bf((Y[n * 129 + v] - mu) * rs * g);
    }
  }
  __syncthreads();
}
DI void cmp1_naive(const Params& p, int idx) {
  int j = idx & 255, r = (idx >> 8) & 2047, kv = idx >> 19;
  if (r >= 2044) return;
  int g = r & 1, n = (r >> 1) % 511, b = (r >> 1) / 511;
  const bf16_t* src = (kv ? p.NVC : p.NKC) + ((size_t)(b * SEQ + 16 * n)) * 128 + g * 64;
  const bf16_t* w = (kv ? p.W1Tv : p.W1Tk) + (size_t)j * 2048;
  float a = 0.f;
  for (int l = 0; l < 32; ++l)
    for (int d = 0; d < 64; ++d) a += bf2f(src[l * 128 + d]) * bf2f(w[l * 64 + d]);
  a += (kv ? p.B1Pv : p.B1Pk)[j];
  p.HID[((size_t)kv * 2048 + r) * 256 + j] = gelu_tanh(a);
}
DI void cmp2_naive(const Params& p, int idx) {
  int e = idx & 63, r = (idx >> 6) & 2047, kv = idx >> 17;
  if (r >= 2044) {
    int bg = r - 2044;
    if (kv == 0) p.KC[((size_t)bg * 512 + 511) * 64 + e] = 0;
    else p.VCT[((size_t)bg * 64 + e) * 512 + 511] = 0;
    return;
  }
  int g = r & 1, n = (r >> 1) % 511, b = (r >> 1) / 511;
  const float* hid = p.HID + ((size_t)kv * 2048 + r) * 256;
  const bf16_t* w = (kv ? p.W2Tv : p.W2Tk) + e * 256;
  float a = 0.f;
  for (int j = 0; j < 256; ++j) a += hid[j] * bf2f(w[j]);
  if (kv == 0) p.KC[((size_t)(b * 2 + g) * 512 + n) * 64 + e] = f2bf(a);
  else p.VCT[((size_t)(b * 2 + g) * 64 + e) * 512 + n] = f2bf(a);
}
DI void ksmax_naive(const Params& p, int idx) {
  int g = idx & 1, t = idx >> 1, b = t >> 13;
  const bf16_t* k = p.NKS + (size_t)t * 128 + g * 64;
  float ss = 0.f;
  for (int d = 0; d < 64; ++d) { float v = bf2f(k[d]); ss += v * v; }
  atomicMax(&p.ksmax[b * 2 + g], __float_as_uint(sqrtf(ss)));
}

#define NSA_SUB_FLOATS 18048
DI void nsa_naive(const Params& p, int blk, int tid, float* sm) {
  float* qs = sm;
  float* P = sm + 1024;
  float* IMP = P + 16 * 1024;
  int* SEL = (int*)(IMP + 512);
  int* NSEL = SEL + 64;
  int g = blk & 1, tq = blk >> 1;
  int tok0 = tq * 4, b = tok0 >> 13, s0 = tok0 & 8191;
  int bg = b * 2 + g;
  int th = tid >> 4, sub = tid & 15, token = th >> 2, hh = th & 3;
  int t = s0 + token;
  for (int i = tid; i < 1024; i += 256) {
    int r = i >> 6, d = i & 63;
    qs[i] = bf2f(p.NQ[(size_t)(tok0 + (r >> 2)) * 512 + (g * 4 + (r & 3)) * 64 + d]);
  }
  __syncthreads();
  const float* q = qs + th * 64;
  float* Pr = P + th * 1024;
  int nvalid = (t >= 31) ? ((t - 31) / 16 + 1) : 0;
  if (nvalid > 511) nvalid = 511;
  float mx = NEG_INF;
  for (int n = sub; n < 512; n += 16) {
    float sc = NEG_INF;
    if (n < nvalid) {
      const bf16_t* k = p.KC + ((size_t)bg * 512 + n) * 64;
      float a = 0.f;
      for (int d = 0; d < 64; ++d) a += q[d] * bf2f(k[d]);
      sc = a;
    }
    Pr[n] = sc; mx = fmaxf(mx, sc);
  }
  for (int o = 8; o; o >>= 1) mx = fmaxf(mx, __shfl_xor(mx, o));
  float mm = (mx == NEG_INF) ? 0.f : mx;
  float l = 0.f;
  for (int n = sub; n < 512; n += 16) { float e = (n < nvalid) ? __expf(Pr[n] - mm) : 0.f; Pr[n] = e; l += e; }
  for (int o = 8; o; o >>= 1) l += __shfl_xor(l, o);
  float inv = 1.f / fmaxf(l, 1.17549435e-38f);
  for (int n = sub; n < 512; n += 16) Pr[n] *= inv;
  __syncthreads();
  float oc[4] = {0, 0, 0, 0};
#pragma unroll
  for (int e = 0; e < 4; ++e) {
    int d = sub * 4 + e;
    const bf16_t* v = p.VCT + ((size_t)bg * 64 + d) * 512;
    float a = 0.f;
    for (int n = 0; n < nvalid; ++n) a += Pr[n] * bf2f(v[n]);
    oc[e] = a;
  }
  for (int i = tid; i < 512; i += 256) {
    int tk = i >> 7, j = i & 127;
    int tt = s0 + tk, cur = tt >> 6;
    float a = 0.f;
    for (int h2 = 0; h2 < 4; ++h2) {
      const float* pp = P + (tk * 4 + h2) * 1024;
      a += 2.f * (pp[4 * j] + pp[4 * j + 1] + pp[4 * j + 2]) + pp[4 * j + 3] + (j > 0 ? pp[4 * j - 1] : 0.f);
    }
    if (j == 0 || j == cur || j == cur - 1) a = 1e9f;
    if (j > cur) a = NEG_INF;
    IMP[i] = a;
  }
  __syncthreads();
  if (tid < 4) {
    int cnt = 0;
    for (int k = 0; k < 16; ++k) {
      float best = NEG_INF; int bj = -1;
      for (int j = 0; j < 128; ++j) { float v = IMP[tid * 128 + j]; if (v > best) { best = v; bj = j; } }
      if (bj < 0) break;
      SEL[tid * 16 + cnt] = bj; ++cnt; IMP[tid * 128 + bj] = NEG_INF;
    }
    NSEL[tid] = cnt;
  }
  __syncthreads();
  float os[4] = {0, 0, 0, 0};
  {
    int nk = NSEL[token] * 64;
    mx = NEG_INF;
    for (int ki = sub; ki < nk; ki += 16) {
      int pos = SEL[token * 16 + (ki >> 6)] * 64 + (ki & 63);
      float sc = NEG_INF;
      if (pos <= t) {
        const bf16_t* k = p.NKS + ((size_t)(b * SEQ + pos)) * 128 + g * 64;
        float a = 0.f;
        for (int d = 0; d < 64; ++d) a += q[d] * bf2f(k[d]);
        sc = a;
      }
      Pr[ki] = sc; mx = fmaxf(mx, sc);
    }
    for (int o = 8; o; o >>= 1) mx = fmaxf(mx, __shfl_xor(mx, o));
    mm = (mx == NEG_INF) ? 0.f : mx;
    l = 0.f;
    for (int ki = sub; ki < nk; ki += 16) { float sc = Pr[ki]; float e = (sc == NEG_INF) ? 0.f : __expf(sc - mm); Pr[ki] = e; l += e; }
    for (int o = 8; o; o >>= 1) l += __shfl_xor(l, o);
    inv = 1.f / fmaxf(l, 1.17549435e-38f);
    __syncthreads();
#pragma unroll
    for (int e = 0; e < 4; ++e) {
      int d = sub * 4 + e;
      const bf16_t* v = p.NVST + ((size_t)bg * 64 + d) * SEQ;
      float a = 0.f;
      for (int ki = 0; ki < nk; ++ki) {
        int pos = SEL[token * 16 + (ki >> 6)] * 64 + (ki & 63);
        a += Pr[ki] * bf2f(v[pos]);
      }
      os[e] = a * inv;
    }
    __syncthreads();
  }
  float ow[4] = {0, 0, 0, 0};
  {
    int lo = t - 511; if (lo < 0) lo = 0;
    int nk = t - lo + 1;
    mx = NEG_INF;
    for (int ki = sub; ki < nk; ki += 16) {
      int pos = lo + ki;
      const bf16_t* k = p.NKW + ((size_t)(b * SEQ + pos)) * 128 + g * 64;
      float a = 0.f;
      for (int d = 0; d < 64; ++d) a += q[d] * bf2f(k[d]);
      Pr[ki] = a; mx = fmaxf(mx, a);
    }
    for (int o = 8; o; o >>= 1) mx = fmaxf(mx, __shfl_xor(mx, o));
    l = 0.f;
    for (int ki = sub; ki < nk; ki += 16) { float e = __expf(Pr[ki] - mx); Pr[ki] = e; l += e; }
    for (int o = 8; o; o >>= 1) l += __shfl_xor(l, o);
    inv = 1.f / l;
    __syncthreads();
#pragma unroll
    for (int e = 0; e < 4; ++e) {
      int d = sub * 4 + e;
      const bf16_t* v = p.NVWT + ((size_t)bg * 64 + d) * SEQ + lo;
      float a = 0.f;
      for (int ki = 0; ki < nk; ++ki) a += Pr[ki] * bf2f(v[ki]);
      ow[e] = a * inv;
    }
  }
  const float* gt = p.GATE + (size_t)(tok0 + token) * 24 + (g * 4 + hh) * 3;
  float g0 = gt[0], g1 = gt[1], g2 = gt[2];
#pragma unroll
  for (int e = 0; e < 4; ++e) {
    int d = sub * 4 + e;
    p.RA[(size_t)(tok0 + token) * DM + 512 + (g * 4 + hh) * 64 + d] = f2bf(g0 * oc[e] + g1 * os[e] + g2 * ow[e]);
  }
  __syncthreads();
}

#define PEER_SUB_FLOATS 8192
DI void peer_naive(const Params& p, int t, int tid, float* sm) {
  float* qrow = sm;
  float* sc = sm + 2048;
  float* cand = sm + 4096;
  float* tv = sm + 6144;
  int* ti = (int*)(sm + 6400);
  float* tv2 = sm + 6656;
  int* te2 = (int*)(sm + 6784);
  float* red = sm + 6912;
  float* hrow = sm + 6928;
  int b = t >> 13;
  for (int i = tid; i < 2048; i += 256) qrow[i] = bf2f(p.PQ[(size_t)t * 2048 + i]);
  for (int i = tid; i < 1024; i += 256) hrow[i] = bf2f(p.RA[(size_t)t * DM + i]);
  __syncthreads();
  for (int i = tid; i < 2048; i += 256) {
    int ph = i >> 7;
    const bf16_t* k = p.SUBK + (size_t)i * 128;
    const float* q = qrow + ph * 128;
    float a = 0.f;
    for (int d = 0; d < 128; ++d) a += q[d] * bf2f(k[d]);
    sc[i] = a;
  }
  __syncthreads();
  if (tid < 16) {
    for (int k = 0; k < 16; ++k) {
      float best = NEG_INF; int bj = 0;
      for (int j = 0; j < 128; ++j) { float v = sc[tid * 128 + j]; if (v > best) { best = v; bj = j; } }
      tv[tid * 16 + k] = best; ti[tid * 16 + k] = bj; sc[tid * 128 + bj] = NEG_INF;
    }
  }
  __syncthreads();
  for (int i = tid; i < 2048; i += 256) {
    int pp = i >> 8, ii = (i >> 4) & 15, jj = i & 15;
    cand[i] = tv[(2 * pp) * 16 + ii] + tv[(2 * pp + 1) * 16 + jj];
  }
  __syncthreads();
  if (tid < 8) {
    for (int k = 0; k < 16; ++k) {
      float best = NEG_INF; int bj = 0;
      for (int j = 0; j < 256; ++j) { float v = cand[tid * 256 + j]; if (v > best) { best = v; bj = j; } }
      cand[tid * 256 + bj] = NEG_INF;
      tv2[tid * 16 + k] = best; te2[tid * 16 + k] = ti[(2 * tid) * 16 + (bj >> 4)] * 128 + ti[(2 * tid + 1) * 16 + (bj & 15)];
    }
    float m = tv2[tid * 16], l = 0.f;
    for (int k = 0; k < 16; ++k) { float e = __expf(tv2[tid * 16 + k] - m); tv2[tid * 16 + k] = e; l += e; }
    for (int k = 0; k < 16; ++k) tv2[tid * 16 + k] /= l;
  }
  __syncthreads();
  float4 hv = *(float4*)(hrow + tid * 4);
  float acc[4] = {0, 0, 0, 0};
  for (int e = 0; e < 128; ++e) {
    int idx = te2[e];
    float w = tv2[e];
    float4 u = *(const float4*)(p.peer_down + (size_t)idx * DM + tid * 4);
    float d = hv.x * u.x + hv.y * u.y + hv.z * u.z + hv.w * u.w;
    for (int o = 32; o; o >>= 1) d += __shfl_xor(d, o);
    if ((tid & 63) == 0) red[tid >> 6] = d;
    __syncthreads();
    float dot = red[0] + red[1] + red[2] + red[3];
    __syncthreads();
    float cf = w * gelu_tanh(dot);
    float4 v = *(const float4*)(p.peer_up + (size_t)idx * DM + tid * 4);
    acc[0] += cf * v.x; acc[1] += cf * v.y; acc[2] += cf * v.z; acc[3] += cf * v.w;
  }
  const float* ga2 = p.mod + b * 6144 + 5120;
  float4 x1 = *(float4*)(p.out + (size_t)t * DM + tid * 4);
  float y0 = x1.x + ga2[tid * 4 + 0] * acc[0], y1 = x1.y + ga2[tid * 4 + 1] * acc[1];
  float y2 = x1.z + ga2[tid * 4 + 2] * acc[2], y3 = x1.w + ga2[tid * 4 + 3] * acc[3];
  float ss = y0 * y0 + y1 * y1 + y2 * y2 + y3 * y3;
  for (int o = 32; o; o >>= 1) ss += __shfl_xor(ss, o);
  if ((tid & 63) == 0) red[4 + (tid >> 6)] = ss;
  __syncthreads();
  float tot = red[4] + red[5] + red[6] + red[7];
  float rstd = rsqrtf(tot * (1.f / DM) + 1e-6f);
  float4 o4;
  o4.x = y0 * rstd * p.g_final[tid * 4 + 0]; o4.y = y1 * rstd * p.g_final[tid * 4 + 1];
  o4.z = y2 * rstd * p.g_final[tid * 4 + 2]; o4.w = y3 * rstd * p.g_final[tid * 4 + 3];
  *(float4*)(p.out + (size_t)t * DM + tid * 4) = o4;
  __syncthreads();
}


DI int crow(int reg, int h) { return (reg & 3) + 8 * (reg >> 2) + 4 * h; }
DI bf16x8 ld16(const bf16_t* ptr) { return *(const bf16x8*)ptr; }
DI bf16x8 ld8x2(const bf16_t* ptr) {
  uint2 a = *(const uint2*)ptr, b = *(const uint2*)(ptr + 8);
  uint4 v; v.x = a.x; v.y = a.y; v.z = b.x; v.w = b.y;
  return __builtin_bit_cast(bf16x8, v);
}
DI bf16x8 pack8(float x0, float x1, float x2, float x3, float x4, float x5, float x6, float x7) {
  uint4 v; v.x = cvt2(x0, x1); v.y = cvt2(x2, x3); v.z = cvt2(x4, x5); v.w = cvt2(x6, x7);
  return __builtin_bit_cast(bf16x8, v);
}
DI f32x16 zero16() { f32x16 z; for (int e = 0; e < 16; ++e) z[e] = 0.f; return z; }

DI void retkv_mfma(const Params& p, int item) {
  const int lane = mytid() & 63, w = mytid() >> 6, r = lane & 31, h = lane >> 5;
  const int hh = item & 3, c = (item >> 2) & 63, b = item >> 8, bh = b * 4 + hh, s0 = c * 128;
  const int mi = w >> 1, nb = (w & 1) * 2;
  const bf16_t* vb_ = p.RVT + ((size_t)(bh * 128 + 32 * mi + r)) * SEQ + s0 + 8 * h;
  const bf16_t* k0 = p.RKT + ((size_t)(bh * 128 + 32 * nb + r)) * SEQ + s0 + 8 * h;
  const bf16_t* k1 = k0 + (size_t)32 * SEQ;
  f32x16 a0 = zero16(), a1 = zero16();
#pragma unroll
  for (int s = 0; s < 8; ++s) {
    bf16x8 a = ld16(vb_ + 16 * s), b0 = ld16(k0 + 16 * s), b1 = ld16(k1 + 16 * s);
    a0 = MFMA32(a, b0, a0); a1 = MFMA32(a, b1, a1);
  }
  float* dst = p.KV + (size_t)item * 16384;
#pragma unroll
  for (int e = 0; e < 16; ++e) {
    const int v = 32 * mi + crow(e, h);
    dst[v * 128 + 32 * nb + r] = a0[e];
    dst[v * 128 + 32 * nb + 32 + r] = a1[e];
  }
}
DI void scan_body(const Params& p, int idx) {
  const int e = idx & 16383, bh = idx >> 14, b = bh >> 2, h = bh & 3;
  const float cd = __expf(128.f * logg_h(h));
  float S = 0.f;
  for (int c0 = 0; c0 < 64; c0 += 8) {
    float kv[8];
#pragma unroll
    for (int u = 0; u < 8; ++u) kv[u] = p.KV[(size_t)((b * 64 + c0 + u) * 4 + h) * 16384 + e];
#pragma unroll
    for (int u = 0; u < 8; ++u) {
      p.SPREV[(size_t)((b * 64 + c0 + u) * 4 + h) * 16384 + e] = f2bf(S);
      S = cd * S + kv[u];
    }
  }
}
DI void retout_mfma(const Params& p, int task) {
  const int lane = mytid() & 63, r = lane & 31, h = lane >> 5;
  const int item = task >> 2, nt = task & 3;
  const int hh = item & 3, c = (item >> 2) & 63, b = item >> 8, bh = b * 4 + hh, s0 = c * 128, t0 = b * SEQ + s0;
  const float lg = logg_h(hh);
  const int n = 32 * nt + r;
  bf16x8 qf[8];
#pragma unroll
  for (int s = 0; s < 8; ++s) qf[s] = ld16(p.RQ + (size_t)(t0 + n) * 512 + hh * 128 + 16 * s + 8 * h);
  f32x16 acc[4];
#pragma unroll
  for (int vi = 0; vi < 4; ++vi) {
    acc[vi] = zero16();
    const bf16_t* sp = p.SPREV + (size_t)item * 16384 + (size_t)(32 * vi + r) * 128 + 8 * h;
#pragma unroll
    for (int s = 0; s < 8; ++s) acc[vi] = MFMA32(ld16(sp + 16 * s), qf[s], acc[vi]);
    __builtin_amdgcn_sched_barrier(0);
  }
  {
    const float xi = __expf((float)(n + 1) * lg);
#pragma unroll
    for (int vi = 0; vi < 4; ++vi)
#pragma unroll
      for (int e = 0; e < 16; ++e) acc[vi][e] *= xi;
  }
  for (int mt = 0; mt <= nt; ++mt) {
    f32x16 sa = zero16();
    const bf16_t* kp = p.RK + (size_t)(t0 + 32 * mt + r) * 512 + hh * 128 + 8 * h;
#pragma unroll
    for (int s = 0; s < 8; ++s) sa = MFMA32(ld16(kp + 16 * s), qf[s], sa);
    float pv[16];
#pragma unroll
    for (int e = 0; e < 16; ++e) {
      const int dm = n - (32 * mt + crow(e, h));
      pv[e] = (dm >= 0) ? sa[e] * __expf((float)dm * lg) : 0.f;
    }
#pragma unroll
    for (int s2 = 0; s2 < 2; ++s2) {
      bf16x8 bfr = pack8(pv[8 * s2], pv[8 * s2 + 1], pv[8 * s2 + 2], pv[8 * s2 + 3], pv[8 * s2 + 4], pv[8 * s2 + 5], pv[8 * s2 + 6], pv[8 * s2 + 7]);
#pragma unroll
      for (int vi = 0; vi < 4; ++vi) {
        bf16x8 afr = ld8x2(p.RVT + ((size_t)(bh * 128 + 32 * vi + r)) * SEQ + s0 + 32 * mt + 16 * s2 + 4 * h);
        acc[vi] = MFMA32(afr, bfr, acc[vi]);
      }
      __builtin_amdgcn_sched_barrier(0);
    }
  }
  float sum = 0.f;
#pragma unroll
  for (int vi = 0; vi < 4; ++vi)
#pragma unroll
    for (int e = 0; e < 16; ++e) sum += acc[vi][e];
  sum += __shfl_xor(sum, 32);
  const float mu = sum * (1.f / 128.f);
  float var = 0.f;
#pragma unroll
  for (int vi = 0; vi < 4; ++vi)
#pragma unroll
    for (int e = 0; e < 16; ++e) { float d = acc[vi][e] - mu; var += d * d; }
  var += __shfl_xor(var, 32);
  const float rs = rsqrtf(var * (1.f / 128.f) + 1e-6f);
#pragma unroll
  for (int vi = 0; vi < 4; ++vi)
#pragma unroll
    for (int g4 = 0; g4 < 4; ++g4) {
      const int v0 = 32 * vi + 8 * g4 + 4 * h;
      uint2 gt = *(const uint2*)(p.RGT + (size_t)(t0 + n) * 512 + hh * 128 + v0);
      float y0 = (acc[vi][4 * g4 + 0] - mu) * rs * __uint_as_float(gt.x << 16);
      float y1 = (acc[vi][4 * g4 + 1] - mu) * rs * __uint_as_float(gt.x & 0xffff0000u);
      float y2 = (acc[vi][4 * g4 + 2] - mu) * rs * __uint_as_float(gt.y << 16);
      float y3 = (acc[vi][4 * g4 + 3] - mu) * rs * __uint_as_float(gt.y & 0xffff0000u);
      *(uint2*)(p.RA + (size_t)(t0 + n) * DM + hh * 128 + v0) = pack4(y0, y1, y2, y3);
    }
}
#define HID_STRIDE 264
DI void compress_mfma(const Params& p, int item, char* smem) {
  bf16_t* HIDL = (bf16_t*)smem;
  const int lane = mytid() & 63, w = mytid() >> 6, r = lane & 31, h = lane >> 5;
  const int kv = item >> 6, bg = (item >> 4) & 3, rt = item & 15, n0 = rt * 32, b = bg >> 1, g = bg & 1;
  const bf16_t* src = kv ? p.NVC : p.NKC; const bf16_t* W1 = kv ? p.W1Tv : p.W1Tk; const bf16_t* W2 = kv ? p.W2Tv : p.W2Tk;
  const float* B1 = kv ? p.B1Pv : p.B1Pk;
  {
    const int n = min(n0 + r, 510);
    const bf16_t* ab = src + ((size_t)(b * SEQ + 16 * n)) * 128 + g * 64 + 8 * h;
    const bf16_t* bb = W1 + (size_t)(32 * w + r) * 2048 + 8 * h;
    f32x16 acc = zero16();
#pragma unroll 8
    for (int s = 0; s < 128; ++s) acc = MFMA32(ld16(ab + (s >> 2) * 128 + (s & 3) * 16), ld16(bb + 16 * s), acc);
    const float bias = B1[32 * w + r];
#pragma unroll
    for (int e = 0; e < 16; ++e) HIDL[crow(e, h) * HID_STRIDE + 32 * w + r] = f2bf(gelu_tanh(acc[e] + bias));
  }
  __syncthreads();
  if (w < 2) {
    f32x16 acc = zero16();
#pragma unroll
    for (int s = 0; s < 16; ++s) acc = MFMA32(ld16(HIDL + r * HID_STRIDE + 16 * s + 8 * h), ld16(W2 + (size_t)(32 * w + r) * 256 + 16 * s + 8 * h), acc);
    const int e_ = 32 * w + r;
    if (kv == 0) {
#pragma unroll
      for (int e = 0; e < 16; ++e) { const int n = n0 + crow(e, h); p.KC[((size_t)bg * 512 + n) * 64 + e_] = (n < 511) ? f2bf(acc[e]) : (bf16_t)0; }
    } else {
#pragma unroll
      for (int g4 = 0; g4 < 4; ++g4) {
        const int n = n0 + 8 * g4 + 4 * h;
        float v3 = (n + 3 < 511) ? acc[4 * g4 + 3] : 0.f;
        *(uint2*)(p.VCT + ((size_t)bg * 64 + e_) * 512 + n) = pack4(acc[4 * g4], acc[4 * g4 + 1], acc[4 * g4 + 2], v3);
      }
    }
  }
  __syncthreads();
}
DI void kmax_body(const Params& p, int idx) {
  const int g = idx & 1, t = idx >> 1, b = t >> 13;
  const bf16_t* k = p.NKS + (size_t)t * 128 + g * 64; const bf16_t* kw = p.NKW + (size_t)t * 128 + g * 64;
  float ss = 0.f, sw = 0.f;
  for (int d = 0; d < 64; ++d) { float v = bf2f(k[d]); ss += v * v; float u = bf2f(kw[d]); sw += u * u; }
  float m1 = sqrtf(ss), m2 = sqrtf(sw);
  for (int o = 32; o; o >>= 1) { m1 = fmaxf(m1, __shfl_xor(m1, o)); m2 = fmaxf(m2, __shfl_xor(m2, o)); }
}
DI void kmax_body2(const Params& p, int vb) {
  const int tid = mytid(), g = tid & 1, t = vb * 256 + (tid >> 1), b = t >> 13;
  const bf16_t* k = p.NKS + (size_t)t * 128 + g * 64; const bf16_t* kw = p.NKW + (size_t)t * 128 + g * 64;
  float ss = 0.f, sw = 0.f;
  for (int d = 0; d < 64; d += 8) {
    uint4 a = *(const uint4*)(k + d), c = *(const uint4*)(kw + d);
    const unsigned aa[4] = {a.x, a.y, a.z, a.w}, cc[4] = {c.x, c.y, c.z, c.w};
#pragma unroll
    for (int q = 0; q < 4; ++q) {
      float x0 = __uint_as_float(aa[q] << 16), x1 = __uint_as_float(aa[q] & 0xffff0000u);
      float y0 = __uint_as_float(cc[q] << 16), y1 = __uint_as_float(cc[q] & 0xffff0000u);
      ss += x0 * x0 + x1 * x1; sw += y0 * y0 + y1 * y1;
    }
  }
  float m1 = sqrtf(ss), m2 = sqrtf(sw);
  for (int o = 2; o < 64; o <<= 1) { m1 = fmaxf(m1, __shfl_xor(m1, o)); m2 = fmaxf(m2, __shfl_xor(m2, o)); }
  if ((tid & 63) < 2) { atomicMax(&p.ksmax[b * 2 + g], __float_as_uint(m1)); atomicMax(&p.ksmax[4 + b * 2 + g], __float_as_uint(m2)); }
}
DI void kcmax_body(const Params& p, int idx) {
  const bf16_t* k = p.KC + (size_t)idx * 64;
  float ss = 0.f;
  for (int d = 0; d < 64; ++d) { float v = bf2f(k[d]); ss += v * v; }
  atomicMax(&p.ksmax[8 + (idx >> 9)], __float_as_uint(sqrtf(ss)));
}

#define NSA_IMP 0
#define NSA_SELM 65536
#define NSA_KV 66560
#define KV_ROW 144
#define KV_TILE (64 * KV_ROW)
template <int CTRL> DI float dpp_f2(float x) { return __builtin_bit_cast(float, __builtin_amdgcn_mov_dpp(__builtin_bit_cast(int, x), CTRL, 0xf, 0xf, true)); }
DI float quad_sum(float v) { v += dpp_f2<0xB1>(v); v += dpp_f2<0x4E>(v); return v; }
DI bf16x8 lds8x2(const char* ptr) {
  uint2 a = *(const uint2*)ptr, b = *(const uint2*)(ptr + 16);
  uint4 v; v.x = a.x; v.y = a.y; v.z = b.x; v.w = b.y;
  return __builtin_bit_cast(bf16x8, v);
}

DI void nsa_item(const Params& p, int item, char* smem) {
  const int tid = mytid(), lane = tid & 63, w = tid >> 6, r = lane & 31, h = lane >> 5;
  const int ti = item >> 2, bg = item & 3, b = bg >> 1, g = bg & 1;
  const int ts = ti * 64, tokg0 = b * SEQ + ts;
  const int tkl = 8 * w + (r >> 2), hl = r & 3, hd = g * 4 + hl, tpos = ts + tkl;
  float* IMPA = (float*)(smem + NSA_IMP); float* IMPB = IMPA + 64 * 128;
  unsigned* SELM = (unsigned*)(smem + NSA_SELM);
  char* KVB = smem + NSA_KV;
  const float ksm = __uint_as_float(p.ksmax[bg]), kwm = __uint_as_float(p.ksmax[4 + bg]), kcm = __uint_as_float(p.ksmax[8 + bg]);

  bf16x8 qf[4];
#pragma unroll
  for (int s = 0; s < 4; ++s) qf[s] = ld16(p.NQ + (size_t)(tokg0 + tkl) * 512 + hd * 64 + 16 * s + 8 * h);
  float qq = 0.f;
#pragma unroll
  for (int s = 0; s < 4; ++s) {
    uint4 u = __builtin_bit_cast(uint4, qf[s]);
    const unsigned uu[4] = {u.x, u.y, u.z, u.w};
#pragma unroll
    for (int q = 0; q < 4; ++q) { float x0 = __uint_as_float(uu[q] << 16), x1 = __uint_as_float(uu[q] & 0xffff0000u); qq += x0 * x0 + x1 * x1; }
  }
  qq += __shfl_xor(qq, 32);
  const float qn = sqrtf(qq);
  const int srow = tid >> 3, sch = tid & 7;
  const bf16_t* ksrc = p.NKS + ((size_t)(b * SEQ) + srow) * 128 + g * 64 + sch * 8;
  const bf16_t* vsrc = p.NVST + ((size_t)bg * 64 + srow) * SEQ + sch * 8;
  char* sdst = KVB + srow * KV_ROW + sch * 16;
  {
    uint4 k0 = *(const uint4*)ksrc, v0 = *(const uint4*)vsrc;
    *(uint4*)sdst = k0; *(uint4*)(sdst + KV_TILE) = v0;
  }
  for (int q = tid; q < 64 * 128 * 2 / 4; q += NT) ((float4*)IMPA)[q] = make_float4(0.f, 0.f, 0.f, 0.f);
  __syncthreads();

  const float mbc = qn * kcm;
  int nvalid = (tpos >= 31) ? ((tpos - 31) >> 4) + 1 : 0;
  if (nvalid > 511) nvalid = 511;
  int nvw = (ts + 8 * w + 7 >= 31) ? ((ts + 8 * w + 7 - 31) >> 4) + 1 : 0;
  if (nvw > 511) nvw = 511;
  const int nkt = (nvw + 31) >> 5;
  const bf16_t* kcb = p.KC + ((size_t)bg * 512 + r) * 64 + 8 * h;
  float lsum = 0.f, invl = 0.f;
  for (int rep521 = 0; rep521 < (PROBE_DUP == 521 ? 2 : 1); ++rep521) {
  lsum = 0.f;
  for (int kt = 0; kt < nkt; ++kt) {
    f32x16 sa = zero16();
#pragma unroll
    for (int s = 0; s < 4; ++s) sa = MFMA32(ld16(kcb + (size_t)kt * 32 * 64 + 16 * s), qf[s], sa);
#pragma unroll
    for (int e = 0; e < 16; ++e) { const int n = 32 * kt + crow(e, h); lsum += (n < nvalid) ? __expf(sa[e] - mbc) : 0.f; }
  }
  lsum += __shfl_xor(lsum, 32);
  invl = (lsum > 0.f) ? 1.f / lsum : 0.f;
  for (int kt = 0; kt < nkt; ++kt) {
    f32x16 sa = zero16();
#pragma unroll
    for (int s = 0; s < 4; ++s) sa = MFMA32(ld16(kcb + (size_t)kt * 32 * 64 + 16 * s), qf[s], sa);
    float pv[16];
#pragma unroll
    for (int e = 0; e < 16; ++e) { const int n = 32 * kt + crow(e, h); pv[e] = (n < nvalid) ? __expf(sa[e] - mbc) * invl : 0.f; }
#pragma unroll
    for (int q = 0; q < 4; ++q) {
      float A = 2.f * (pv[4 * q] + pv[4 * q + 1] + pv[4 * q + 2]) + pv[4 * q + 3], Bv = pv[4 * q + 3];
      A = quad_sum(A); Bv = quad_sum(Bv);
      if (hl == 0) { const int j = 8 * kt + 2 * q + h; IMPA[tkl * 128 + j] = A; IMPB[tkl * 128 + j] = Bv; }
    }
  }
  }
  for (int rep522 = 0; rep522 < (PROBE_DUP == 522 ? 2 : 1); ++rep522)
  for (int tk = 0; tk < 8; ++tk) {
    const int tl = 8 * w + tk;
    unsigned long long key[2];
#pragma unroll
    for (int c2 = 0; c2 < 2; ++c2) {
      const int j = lane + 64 * c2;
      float imp = IMPA[tl * 128 + j] + ((j > 0) ? IMPB[tl * 128 + j - 1] : 0.f);
      if (j == 0 || j == ti || j == ti - 1) imp = 1e9f;
      key[c2] = (j <= ti) ? ((((unsigned long long)__float_as_uint(imp)) << 8) | (unsigned long long)(127 - j)) + 1ull : 0ull;
    }
    unsigned m0 = 0, m1 = 0, m2 = 0, m3 = 0;
    for (int it = 0; it < 16; ++it) {
      unsigned long long k = key[0] > key[1] ? key[0] : key[1];
#pragma unroll
      for (int o = 32; o; o >>= 1) {
        unsigned lo = (unsigned)k, hi = (unsigned)(k >> 32);
        unsigned lo2 = __shfl_xor(lo, o), hi2 = __shfl_xor(hi, o);
        unsigned long long k2 = ((unsigned long long)hi2 << 32) | lo2;
        k = k2 > k ? k2 : k;
      }
      if (k == 0ull) break;
      const int js = 127 - (int)((k - 1ull) & 255ull);
      const unsigned bit = 1u << (js & 31);
      if ((js >> 5) == 0) m0 |= bit; else if ((js >> 5) == 1) m1 |= bit; else if ((js >> 5) == 2) m2 |= bit; else m3 |= bit;
      if (key[0] == k) key[0] = 0ull;
      if (key[1] == k) key[1] = 0ull;
    }
    if (lane == 0) { SELM[tl * 4 + 0] = m0; SELM[tl * 4 + 1] = m1; SELM[tl * 4 + 2] = m2; SELM[tl * 4 + 3] = m3; }
  }
  unsigned mm[4], wv[4];
#pragma unroll
  for (int q = 0; q < 4; ++q) {
    mm[q] = SELM[tkl * 4 + q];
    unsigned u = 0;
#pragma unroll
    for (int t8 = 0; t8 < 8; ++t8) u |= SELM[(8 * w + t8) * 4 + q];
    wv[q] = u;
  }
  const float mbs = qn * ksm;
  f32x16 osl[2]; osl[0] = zero16(); osl[1] = zero16();
  float lsel = 0.f;
  {
    uint4 kn0, kn1, kn2, kn3, vn0, vn1, vn2, vn3;
    kn0 = kn1 = kn2 = kn3 = vn0 = vn1 = vn2 = vn3 = make_uint4(0u, 0u, 0u, 0u);
    if (1 <= ti) { kn1 = *(const uint4*)(ksrc + (size_t)1 * 64 * 128); vn1 = *(const uint4*)(vsrc + 1 * 64); }
    if (2 <= ti) { kn2 = *(const uint4*)(ksrc + (size_t)2 * 64 * 128); vn2 = *(const uint4*)(vsrc + 2 * 64); }
    if (3 <= ti) { kn3 = *(const uint4*)(ksrc + (size_t)3 * 64 * 128); vn3 = *(const uint4*)(vsrc + 3 * 64); }
#define SEL_STEP(U, KCUR, VCUR, KNXT, VNXT)                                                                                                 \
    {                                                                                                                                       \
      const int j = j0 + U;                                                                                                                 \
      if (j <= ti) {                                                                                                                        \
        if (j + 4 <= ti) { KCUR = *(const uint4*)(ksrc + (size_t)(j + 4) * 64 * 128); VCUR = *(const uint4*)(vsrc + (j + 4) * 64); }          \
        const unsigned wsel = (j < 32) ? wv[0] : (j < 64) ? wv[1] : (j < 96) ? wv[2] : wv[3];                                               \
        if ((wsel >> (j & 31)) & 1u) {                                                                                                      \
          const char* kb = KVB + (j & 1) * 2 * KV_TILE;                                                                                     \
          const char* vbuf = kb + KV_TILE;                                                                                                  \
          const unsigned msel = (j < 32) ? mm[0] : (j < 64) ? mm[1] : (j < 96) ? mm[2] : mm[3];                                             \
          const unsigned csel = (msel >> (j & 31)) & 1u;                                                                                    \
          bf16x8 pk[2][2];                                                                                                                  \
          _Pragma("unroll") for (int kh = 0; kh < 2; ++kh) {                                                                                \
            f32x16 sa = zero16();                                                                                                           \
            _Pragma("unroll") for (int s = 0; s < 4; ++s) sa = MFMA32(*(const bf16x8*)(kb + (32 * kh + r) * KV_ROW + (16 * s + 8 * h) * 2), qf[s], sa); \
            float pv[16];                                                                                                                   \
            _Pragma("unroll") for (int e = 0; e < 16; ++e) {                                                                                \
              const int key = 32 * kh + crow(e, h);                                                                                         \
              const bool ok = csel && ((j < ti) || (key <= tkl));                                                                           \
              pv[e] = ok ? __expf(sa[e] - mbs) : 0.f; lsel += pv[e];                                                                        \
            }                                                                                                                               \
            pk[kh][0] = pack8(pv[0], pv[1], pv[2], pv[3], pv[4], pv[5], pv[6], pv[7]);                                                      \
            pk[kh][1] = pack8(pv[8], pv[9], pv[10], pv[11], pv[12], pv[13], pv[14], pv[15]);                                                \
          }                                                                                                                                 \
          _Pragma("unroll") for (int di = 0; di < 2; ++di)                                                                                  \
            _Pragma("unroll") for (int kh = 0; kh < 2; ++kh)                                                                                \
              _Pragma("unroll") for (int s2 = 0; s2 < 2; ++s2)                                                                              \
                osl[di] = MFMA32(lds8x2(vbuf + (32 * di + r) * KV_ROW + (32 * kh + 16 * s2 + 4 * h) * 2), pk[kh][s2], osl[di]);             \
        }                                                                                                                                   \
        if (j < ti) { char* d2 = sdst + ((j + 1) & 1) * 2 * KV_TILE; *(uint4*)d2 = KNXT; *(uint4*)(d2 + KV_TILE) = VNXT; }                  \
        __syncthreads();                                                                                                                    \
      }                                                                                                                                     \
    }
    for (int j0 = 0; j0 <= ti; j0 += 4) {
      SEL_STEP(0, kn0, vn0, kn1, vn1)
      SEL_STEP(1, kn1, vn1, kn2, vn2)
      SEL_STEP(2, kn2, vn2, kn3, vn3)
      SEL_STEP(3, kn3, vn3, kn0, vn0)
    }
#undef SEL_STEP
  }
  lsel += __shfl_xor(lsel, 32);
  f32x16 oc[2]; oc[0] = zero16(); oc[1] = zero16();
  f32x16 ow[2]; ow[0] = zero16(); ow[1] = zero16();
  float lw = 0.f;
  const float mbw = qn * kwm;
  for (int rep524 = 0; rep524 < (PROBE_DUP == 524 ? 2 : 1); ++rep524) {
  for (int kt = 0; kt < nkt; ++kt) {
    f32x16 sa = zero16();
#pragma unroll
    for (int s = 0; s < 4; ++s) sa = MFMA32(ld16(kcb + (size_t)kt * 32 * 64 + 16 * s), qf[s], sa);
    float pv[16];
#pragma unroll
    for (int e = 0; e < 16; ++e) { const int n = 32 * kt + crow(e, h); pv[e] = (n < nvalid) ? __expf(sa[e] - mbc) * invl : 0.f; }
#pragma unroll
    for (int s2 = 0; s2 < 2; ++s2) {
      bf16x8 bfr = pack8(pv[8 * s2], pv[8 * s2 + 1], pv[8 * s2 + 2], pv[8 * s2 + 3], pv[8 * s2 + 4], pv[8 * s2 + 5], pv[8 * s2 + 6], pv[8 * s2 + 7]);
#pragma unroll
      for (int di = 0; di < 2; ++di) oc[di] = MFMA32(ld8x2(p.VCT + ((size_t)bg * 64 + 32 * di + r) * 512 + 32 * kt + 16 * s2 + 4 * h), bfr, oc[di]);
    }
  }
  {
    int lo = ts + 8 * w - 511; if (lo < 0) lo = 0;
    const int kt0 = lo >> 5, kt1 = (ts + 8 * w + 7) >> 5;
    for (int kt = kt0; kt <= kt1; ++kt) {
      f32x16 sa = zero16();
      const bf16_t* kp = p.NKW + ((size_t)(b * SEQ + 32 * kt + r)) * 128 + g * 64 + 8 * h;
#pragma unroll
      for (int s = 0; s < 4; ++s) sa = MFMA32(ld16(kp + 16 * s), qf[s], sa);
      float pv[16];
#pragma unroll
      for (int e = 0; e < 16; ++e) {
        const int pos = 32 * kt + crow(e, h);
        const bool ok = (pos <= tpos) && (pos > tpos - 512);
        pv[e] = ok ? __expf(sa[e] - mbw) : 0.f; lw += pv[e];
      }
#pragma unroll
      for (int s2 = 0; s2 < 2; ++s2) {
        bf16x8 bfr = pack8(pv[8 * s2], pv[8 * s2 + 1], pv[8 * s2 + 2], pv[8 * s2 + 3], pv[8 * s2 + 4], pv[8 * s2 + 5], pv[8 * s2 + 6], pv[8 * s2 + 7]);
#pragma unroll
        for (int di = 0; di < 2; ++di) ow[di] = MFMA32(ld8x2(p.NVWT + ((size_t)bg * 64 + 32 * di + r) * SEQ + 32 * kt + 16 * s2 + 4 * h), bfr, ow[di]);
      }
    }
  }
  }
  lw += __shfl_xor(lw, 32);
  if (PROBE_DUP == 524) { for (int e = 0; e < 16; ++e) { oc[0][e] *= 0.5f; oc[1][e] *= 0.5f; } }
  {
    const float invs = 1.f / lsel, invw = 1.f / lw;
    const float* gt = p.GATE + (size_t)(tokg0 + tkl) * 24 + hd * 3;
    const float g0 = gt[0], g1 = gt[1] * invs, g2 = gt[2] * invw;
#pragma unroll
    for (int di = 0; di < 2; ++di)
#pragma unroll
      for (int g4 = 0; g4 < 4; ++g4) {
        const int d0 = 32 * di + 8 * g4 + 4 * h;
        float y[4];
#pragma unroll
        for (int e = 0; e < 4; ++e) y[e] = g0 * oc[di][4 * g4 + e] + g1 * osl[di][4 * g4 + e] + g2 * ow[di][4 * g4 + e];
        *(uint2*)(p.RA + (size_t)(tokg0 + tkl) * DM + 512 + hd * 64 + d0) = pack4(y[0], y[1], y[2], y[3]);
      }
  }
}

typedef float f32x4 __attribute__((ext_vector_type(4)));
#define MFMA16(a, b, c) __builtin_amdgcn_mfma_f32_16x16x32_bf16((a), (b), (c), 0, 0, 0)
constexpr int pk_clen(int i) { return 16 / (i + 1); }
constexpr int pk_coff(int i) { int s = 0; for (int q = 0; q < i; ++q) s += pk_clen(q); return s; }
#define SC_STRIDE 132

DI void peer_topk_tile(const Params& p, int vb, char* smem) {
  float* SC = (float*)smem;
  unsigned* ELK = (unsigned*)(smem + 256 * SC_STRIDE * 4);
  float* ELW = (float*)(ELK + 16 * 128);
  const int tid = mytid(), lane = tid & 63, w = tid >> 6;
  const int t0 = vb * 16;
  {
    const int tq = lane & 15, kq = lane >> 4;
#pragma unroll
    for (int pi = 0; pi < 2; ++pi) {
      const int ph = 2 * w + pi;
      bf16x8 bfr[4];
#pragma unroll
      for (int s = 0; s < 4; ++s) bfr[s] = *(const bf16x8*)(p.PQ + (size_t)(t0 + tq) * 2048 + ph * 128 + 32 * s + 8 * kq);
#pragma unroll
      for (int j = 0; j < 8; ++j) {
        f32x4 acc = {0.f, 0.f, 0.f, 0.f};
#pragma unroll
        for (int s = 0; s < 4; ++s) {
          bf16x8 afr = *(const bf16x8*)(p.SUBK + ((size_t)(ph * 128 + 16 * j + tq)) * 128 + 32 * s + 8 * kq);
          acc = MFMA16(afr, bfr[s], acc);
        }
        *(f32x4*)(SC + (ph * 16 + tq) * SC_STRIDE + 16 * j + 4 * kq) = acc;
      }
    }
  }
  __syncthreads();
  if (tid < 256) {
    float* row = SC + tid * SC_STRIDE;
    float gmax[16];
#pragma unroll
    for (int g = 0; g < 16; ++g) {
      float4 a = *(float4*)(row + g * 8), b = *(float4*)(row + g * 8 + 4);
      gmax[g] = fmaxf(fmaxf(fmaxf(a.x, a.y), fmaxf(a.z, a.w)), fmaxf(fmaxf(b.x, b.y), fmaxf(b.z, b.w)));
    }
    float outv[16]; int outi[16];
#pragma unroll
    for (int k = 0; k < 16; ++k) {
      float gm = gmax[0]; int gi = 0;
#pragma unroll
      for (int g = 1; g < 16; ++g) { bool c = gmax[g] > gm; gm = c ? gmax[g] : gm; gi = c ? g : gi; }
      float* gp = row + gi * 8;
      float4 a = *(float4*)gp, b = *(float4*)(gp + 4);
      float v[8] = {a.x, a.y, a.z, a.w, b.x, b.y, b.z, b.w};
      int ei = 7;
#pragma unroll
      for (int e = 6; e >= 0; --e) ei = (v[e] == gm) ? e : ei;
      float nm = NEG_INF;
#pragma unroll
      for (int e = 0; e < 8; ++e) { float x = (e == ei) ? NEG_INF : v[e]; nm = fmaxf(nm, x); }
      gp[ei] = NEG_INF;
#pragma unroll
      for (int g = 0; g < 16; ++g) gmax[g] = (g == gi) ? nm : gmax[g];
      outv[k] = gm; outi[k] = gi * 8 + ei;
    }
#pragma unroll
    for (int k = 0; k < 16; ++k) { row[k] = outv[k]; row[16 + k] = __int_as_float(outi[k]); }
  }
  __syncthreads();
  if (tid < 128) {
    const int t = tid >> 3, pp = tid & 7;
    const float* ra = SC + ((2 * pp) * 16 + t) * SC_STRIDE;
    const float* rb = SC + ((2 * pp + 1) * 16 + t) * SC_STRIDE;
    float a[16], b[16]; int ia[16], ib[16];
#pragma unroll
    for (int q = 0; q < 4; ++q) {
      float4 x = *(const float4*)(ra + 4 * q), y = *(const float4*)(rb + 4 * q);
      float4 xi = *(const float4*)(ra + 16 + 4 * q), yi = *(const float4*)(rb + 16 + 4 * q);
      a[4 * q] = x.x; a[4 * q + 1] = x.y; a[4 * q + 2] = x.z; a[4 * q + 3] = x.w;
      b[4 * q] = y.x; b[4 * q + 1] = y.y; b[4 * q + 2] = y.z; b[4 * q + 3] = y.w;
      ia[4 * q] = __float_as_int(xi.x); ia[4 * q + 1] = __float_as_int(xi.y); ia[4 * q + 2] = __float_as_int(xi.z); ia[4 * q + 3] = __float_as_int(xi.w);
      ib[4 * q] = __float_as_int(yi.x); ib[4 * q + 1] = __float_as_int(yi.y); ib[4 * q + 2] = __float_as_int(yi.z); ib[4 * q + 3] = __float_as_int(yi.w);
    }
    float cs[50]; int cc[50];
#pragma unroll
    for (int i = 0; i < 16; ++i)
#pragma unroll
      for (int j = 0; j < pk_clen(i); ++j) { cs[pk_coff(i) + j] = a[i] + b[j]; cc[pk_coff(i) + j] = ia[i] * 128 + ib[j]; }
    float v16[16]; int c16[16];
#pragma unroll
    for (int k = 0; k < 16; ++k) {
      float best = cs[0]; int bi = 0, bc = cc[0];
#pragma unroll
      for (int q = 1; q < 50; ++q) { bool c = cs[q] > best; best = c ? cs[q] : best; bi = c ? q : bi; bc = c ? cc[q] : bc; }
#pragma unroll
      for (int q = 0; q < 50; ++q) cs[q] = (q == bi) ? NEG_INF : cs[q];
      v16[k] = best; c16[k] = bc;
    }
    float l = 0.f; const float vmax = v16[0];
#pragma unroll
    for (int k = 0; k < 16; ++k) { v16[k] = __expf(v16[k] - vmax); l += v16[k]; }
    float inv = 1.f / l;
#pragma unroll
    for (int k = 0; k < 16; ++k) {
      ELK[t * 128 + pp * 16 + k] = ((unsigned)c16[k] << 7) | (unsigned)(pp * 16 + k);
      ELW[t * 128 + pp * 16 + k] = v16[k] * inv;
    }
  }
  __syncthreads();
#pragma unroll
  for (int tt = 0; tt < 2; ++tt) {
    const int t = 2 * w + tt;
    unsigned e0 = ELK[t * 128 + 2 * lane], e1 = ELK[t * 128 + 2 * lane + 1];
#pragma unroll
    for (int k = 2; k <= 128; k <<= 1) {
#pragma unroll
      for (int j = k >> 1; j > 0; j >>= 1) {
        if (j == 1) {
          bool up = ((2 * lane) & k) == 0;
          unsigned lo = min(e0, e1), hi = max(e0, e1);
          e0 = up ? lo : hi; e1 = up ? hi : lo;
        } else {
          unsigned o0 = __shfl_xor(e0, j >> 1), o1 = __shfl_xor(e1, j >> 1);
          bool up = ((2 * lane) & k) == 0;
          bool lower = ((2 * lane) & j) == 0;
          bool keepmin = (up == lower);
          e0 = keepmin ? min(e0, o0) : max(e0, o0);
          e1 = keepmin ? min(e1, o1) : max(e1, o1);
        }
      }
    }
    const size_t gb = (size_t)(t0 + t) * 128 + 2 * lane;
    p.EIDX[gb] = (int)(e0 >> 7); p.EIDX[gb + 1] = (int)(e1 >> 7);
    p.EW[gb] = ELW[t * 128 + (e0 & 127)]; p.EW[gb + 1] = ELW[t * 128 + (e1 & 127)];
  }
  __syncthreads();
}

DI float dot2bf(unsigned a, unsigned b, float acc) { return __builtin_amdgcn_fdot2_f32_bf16(__builtin_bit_cast(bf16x2_t, a), __builtin_bit_cast(bf16x2_t, b), acc, false); }
template <int CTRL> DI float dpp_f(float x) { return __builtin_bit_cast(float, __builtin_amdgcn_mov_dpp(__builtin_bit_cast(int, x), CTRL, 0xf, 0xf, true)); }
DI float row16_sum(float v) { v += dpp_f<0x128>(v); v += dpp_f<0x124>(v); v += dpp_f<0x122>(v); v += dpp_f<0x121>(v); return v; }
DI float dot_row(const uint4 (&u)[8], const uint4 (&h)[8]) {
  float d = 0.f;
#pragma unroll
  for (int j = 0; j < 8; ++j) { d = dot2bf(u[j].x, h[j].x, d); d = dot2bf(u[j].y, h[j].y, d); d = dot2bf(u[j].z, h[j].z, d); d = dot2bf(u[j].w, h[j].w, d); }
  return row16_sum(d);
}
DI void axpy_row(float (&acc)[64], const uint4 (&v)[8], float c) {
#pragma unroll
  for (int j = 0; j < 8; ++j) {
    const unsigned ww[4] = {v[j].x, v[j].y, v[j].z, v[j].w};
#pragma unroll
    for (int q = 0; q < 4; ++q) {
      acc[j * 8 + 2 * q] += c * __uint_as_float(ww[q] << 16);
      acc[j * 8 + 2 * q + 1] += c * __uint_as_float(ww[q] & 0xffff0000u);
    }
  }
}
DI void axpy_half(float (&acc)[32], const uint4 (&v)[4], float c) {
#pragma unroll
  for (int j = 0; j < 4; ++j) {
    const unsigned ww[4] = {v[j].x, v[j].y, v[j].z, v[j].w};
#pragma unroll
    for (int q = 0; q < 4; ++q) {
      acc[j * 8 + 2 * q] += c * __uint_as_float(ww[q] << 16);
      acc[j * 8 + 2 * q + 1] += c * __uint_as_float(ww[q] & 0xffff0000u);
    }
  }
}
#ifndef PEER_TILE_SHIFT
#define PEER_TILE_SHIFT 8
#endif
DI void peer_gather_block(const Params& p, int vb, char* smem) {
  unsigned* ELK = (unsigned*)smem;
  float* ELC = (float*)(smem + 32768);
  const int tid = mytid(), lane = tid & 63, w = tid >> 6, grp = lane >> 4, i = lane & 15;
  const int tokbase = vb * 64;
  for (int q = tid; q < 64 * 128 / 4; q += NT) {
    ((uint4*)ELK)[q] = ((const uint4*)(p.EIDX + (size_t)tokbase * 128))[q];
    ((float4*)ELC)[q] = ((const float4*)(p.EW + (size_t)tokbase * 128))[q];
  }
  __syncthreads();
  const int tl0 = w * 8 + grp * 2;
  const unsigned* k0 = ELK + tl0 * 128; const unsigned* k1 = k0 + 128;
  float* c0 = ELC + tl0 * 128; float* c1 = c0 + 128;
  {
    uint4 h0[8], h1[8];
#pragma unroll
    for (int j = 0; j < 8; ++j) {
      h0[j] = *(const uint4*)(p.RA + (size_t)(tokbase + tl0) * DM + j * 128 + i * 8);
      h1[j] = *(const uint4*)(p.RA + (size_t)(tokbase + tl0 + 1) * DM + j * 128 + i * 8);
    }
    const bf16_t* ub_ = p.PDN + i * 8;
    uint4 xa[8], xb[8], ya[8], yb[8];
#define DN_LOAD(A, B, E) { const unsigned ea_ = k0[E], eb_ = k1[E]; _Pragma("unroll") for (int j = 0; j < 8; ++j) { A[j] = *(const uint4*)(ub_ + (size_t)ea_ * DM + j * 128); B[j] = *(const uint4*)(ub_ + (size_t)eb_ * DM + j * 128); } }
#define DN_COMP(A, B, E) { float da = dot_row(A, h0), db = dot_row(B, h1); float ca = c0[E] * gelu_tanh(da), cb = c1[E] * gelu_tanh(db); if (i == 0) { c0[E] = ca; c1[E] = cb; } }
    DN_LOAD(xa, xb, 0)
    for (int e = 0; e < 128; e += 2) {
      DN_LOAD(ya, yb, e + 1)
      DN_COMP(xa, xb, e)
      if (e + 2 < 128) DN_LOAD(xa, xb, e + 2)
      DN_COMP(ya, yb, e + 1)
    }
#undef DN_LOAD
#undef DN_COMP
  }
  float ssq0 = 0.f, ssq1 = 0.f;
#pragma unroll 1
  for (int half = 0; half < 2; ++half) {
    float acc0[32], acc1[32];
#pragma unroll
    for (int e = 0; e < 32; ++e) { acc0[e] = 0.f; acc1[e] = 0.f; }
    const bf16_t* vbase = p.PUP + half * 512 + i * 8;
    uint4 xa[4], xb[4], ya[4], yb[4];
#define UP_LOAD(A, B, E) { const unsigned ea_ = k0[E], eb_ = k1[E]; _Pragma("unroll") for (int j = 0; j < 4; ++j) { A[j] = *(const uint4*)(vbase + (size_t)ea_ * DM + j * 128); B[j] = *(const uint4*)(vbase + (size_t)eb_ * DM + j * 128); } }
#define UP_COMP(A, B, E) { axpy_half(acc0, A, c0[E]); axpy_half(acc1, B, c1[E]); }
    UP_LOAD(xa, xb, 0)
    for (int e = 0; e < 128; e += 2) {
      UP_LOAD(ya, yb, e + 1)
      UP_COMP(xa, xb, e)
      if (e + 2 < 128) UP_LOAD(xa, xb, e + 2)
      UP_COMP(ya, yb, e + 1)
    }
#undef UP_LOAD
#undef UP_COMP
#pragma unroll
    for (int tt = 0; tt < 2; ++tt) {
      const int tok = tokbase + tl0 + tt, b = tok >> 13;
      const float* ga2 = p.mod + b * 6144 + 5120;
      const float* orow = p.out + (size_t)tok * DM; float* grow = p.gout + (size_t)tok * DM;
      float* a = (tt == 0) ? acc0 : acc1;
      float ss = 0.f;
#pragma unroll
      for (int j = 0; j < 4; ++j)
#pragma unroll
        for (int hf = 0; hf < 2; ++hf) {
          const int col = half * 512 + j * 128 + i * 8 + hf * 4;
          float4 x1 = *(const float4*)(orow + col), gg = *(const float4*)(ga2 + col);
          float* q = a + j * 8 + hf * 4;
          q[0] = x1.x + gg.x * q[0]; q[1] = x1.y + gg.y * q[1]; q[2] = x1.z + gg.z * q[2]; q[3] = x1.w + gg.w * q[3];
          ss += q[0] * q[0] + q[1] * q[1] + q[2] * q[2] + q[3] * q[3];
        }
      ss = row16_sum(ss);
      if (half == 0) {
        if (tt == 0) ssq0 = ss; else ssq1 = ss;
#pragma unroll
        for (int j = 0; j < 4; ++j)
#pragma unroll
          for (int hf = 0; hf < 2; ++hf) {
            const int col = j * 128 + i * 8 + hf * 4;
            const float* q = a + j * 8 + hf * 4;
            *(float4*)(grow + col) = make_float4(q[0], q[1], q[2], q[3]);
          }
      } else {
        const float tot = ss + (tt == 0 ? ssq0 : ssq1);
        const float rstd = rsqrtf(tot * (1.f / DM) + 1e-6f);
#pragma unroll
        for (int j = 0; j < 4; ++j)
#pragma unroll
          for (int hf = 0; hf < 2; ++hf) {
            const int col = 512 + j * 128 + i * 8 + hf * 4;
            float4 gf = *(const float4*)(p.g_final + col);
            const float* q = a + j * 8 + hf * 4;
            *(float4*)(grow + col) = make_float4(q[0] * rstd * gf.x, q[1] * rstd * gf.y, q[2] * rstd * gf.z, q[3] * rstd * gf.w);
          }
#pragma unroll
        for (int j = 0; j < 4; ++j)
#pragma unroll
          for (int hf = 0; hf < 2; ++hf) {
            const int col = j * 128 + i * 8 + hf * 4;
            float4 gf = *(const float4*)(p.g_final + col), y = *(const float4*)(grow + col);
            *(float4*)(grow + col) = make_float4(y.x * rstd * gf.x, y.y * rstd * gf.y, y.z * rstd * gf.z, y.w * rstd * gf.w);
          }
      }
    }
  }
  __syncthreads();
}
DI void convert_tables(const Params& p, int v) {
  const int tb = v >> 12; const size_t base = (size_t)(v & 4095) * 4096 + mytid() * 8;
  const float* src = (tb ? p.peer_up : p.peer_down) + base;
  float4 a = *(const float4*)src, b = *(const float4*)(src + 4);
  uint2 lo = pack4(a.x, a.y, a.z, a.w), hi = pack4(b.x, b.y, b.z, b.w);
  uint4 o; o.x = lo.x; o.y = lo.y; o.z = hi.x; o.w = hi.y;
  *(uint4*)((tb ? p.PUP : p.PDN) + base) = o;
}

#define N_PHASES 11
template <int PH>
DI void run_phase(const Params& p, char* smem) {
  const int nb = gridDim.x, bid = blockIdx.x, tid = mytid();
  if (PH == 0) {
    for (int vb = bid; vb < PH0_NVB; vb += nb) ph0_body(p, vb, smem);
  } else if (PH == 1) {
    for (int vb = bid; vb < T_TOK / 8; vb += nb) rownorm_body(p.x, p.g_mix, p.mod, 0, 1024, p.RA, vb);
  } else if (PH == 2) {
    EpiProj e{p};
    for (int vb = bid; vb < 64 * 27; vb += nb) gemm_tile(p.RA, p.WinT, 1024, (vb & 63) * 256, (vb >> 6) * 128, smem, e);
  } else if (PH == 3) {
    for (int vb = bid; vb < 512 + 128 + 64; vb += nb) {
      if (vb < 512) retkv_mfma(p, vb);
      else if (vb < 512 + 128) compress_mfma(p, vb - 512, smem);
      else kmax_body2(p, vb - 640);
    }
  } else if (PH == 4) {
    for (int vb = bid; vb < 256 + 4; vb += nb) {
      if (vb < 256) scan_body(p, vb * NT + tid);
      else kcmax_body(p, (vb - 256) * NT + tid);
    }
  } else if (PH == 5) {
    for (int rep = 0; rep < (PROBE_DUP == 51 ? 2 : 1); ++rep)
      for (int vb = bid; vb < 256; vb += nb) retout_mfma(p, vb * 8 + (tid >> 6));
    for (int rep = 0; rep < (PROBE_DUP == 52 ? 2 : 1); ++rep)
      for (int vb = bid; vb < 512; vb += nb) nsa_item(p, (vb < 256) ? vb : 767 - vb, smem);
  } else if (PH == 6) {
    EpiOut e{p};
    for (int vb = bid; vb < 64 * 8; vb += nb) gemm_tile(p.RA, p.WoutT, 1024, (vb & 63) * 256, (vb >> 6) * 128, smem, e);
  } else if (PH == 7) {
    for (int vb = bid; vb < T_TOK / 8 + 8192; vb += nb) {
      if (vb < T_TOK / 8) rownorm_body(p.out, p.g_ffn, p.mod, 3072, 4096, p.RA, vb);
      else convert_tables(p, vb - T_TOK / 8);
    }
  } else if (PH == 8) {
    EpiPQ e{p};
    for (int vb = bid; vb < 64 * 16; vb += nb) gemm_tile(p.RA, p.WqT, 1024, (vb & 63) * 256, (vb >> 6) * 128, smem, e);
  } else if (PH == 9) {
    for (int vb = bid; vb < T_TOK / 16; vb += nb) peer_topk_tile(p, vb, smem);
  } else if (PH == 10) {
    for (int vb = bid; vb < T_TOK / 64; vb += nb) peer_gather_block(p, vb, smem);
  }
}


#define XB_TMO      128
#define XB_XCNT(j)  (256  + 64 * (j))
#define XB_XSUB(j)  (1280 + 64 * (j))
#define XB_XGEN(j)  (2304 + 64 * (j))
#define XB_TOP      3328
#define XB_TOPGEN   3392
#define XCD_BAR_WORDS 3456
#define XB_SPIN_CAP (1u << 22)
#define LAS __attribute__((address_space(3)))
DI unsigned xb_ld(unsigned* p) { return __hip_atomic_load(p, __ATOMIC_RELAXED, __HIP_MEMORY_SCOPE_AGENT); }
DI unsigned xb_add(unsigned* p, unsigned v) { return __hip_atomic_fetch_add(p, v, __ATOMIC_RELAXED, __HIP_MEMORY_SCOPE_AGENT); }
DI unsigned xb_xcc_id() { return (unsigned)__builtin_amdgcn_s_getreg((3 << 11) | 20) & 0xFu; }
#define XB_SPIN(cond, bar) do { unsigned _sp = 0; while (cond) { __builtin_amdgcn_s_sleep(1); \
    if ((++_sp & 255u) == 0u) { if (xb_ld(&(bar)[XB_TMO])) break; if (_sp > XB_SPIN_CAP) { atomicAdd(&(bar)[XB_TMO], 1u); break; } } } } while (0)
struct XcdBarrier { unsigned* bar; unsigned x; volatile LAS unsigned* st; };
DI XcdBarrier xcd_barrier_post(unsigned* bar, volatile LAS unsigned* st) {
  XcdBarrier b; b.bar = bar; b.x = xb_xcc_id(); b.st = st;
  if (threadIdx.x == 0) (void)xb_add(&bar[XB_XCNT(b.x)], 1u);
  return b;
}
DI void xcd_barrier_complete(unsigned* bar, unsigned x, unsigned& nloc, unsigned& nx) {
  const unsigned G = gridDim.x * gridDim.y * gridDim.z;
  unsigned sum, cnt, mine, sp = 0u;
  for (;;) {
    sum = 0u; cnt = 0u; mine = 0u;
#pragma unroll
    for (unsigned j = 0; j < 16; ++j) { const unsigned c = xb_ld(&bar[XB_XCNT(j)]); sum += c; cnt += (c > 0u) ? 1u : 0u; mine = (j == x) ? c : mine; }
    if (sum == G) break;
    __builtin_amdgcn_s_sleep(1);
    if ((++sp & 255u) == 0u) { if (xb_ld(&bar[XB_TMO])) break; if (sp > XB_SPIN_CAP) { atomicAdd(&bar[XB_TMO], 1u); break; } }
  }
  nloc = mine > 0u ? mine : 1u; nx = cnt > 0u ? cnt : 1u;
}
DI void xcd_barrier(const XcdBarrier& b) {
  asm volatile("s_waitcnt vmcnt(0)" ::: "memory");
  __syncthreads();
  if (threadIdx.x == 0) {
    unsigned* bar = b.bar;
    __builtin_amdgcn_s_waitcnt(0);
    unsigned nloc = b.st[0], nx = b.st[1];
    if (nloc == 0u) { xcd_barrier_complete(bar, b.x, nloc, nx); b.st[0] = nloc; b.st[1] = nx; }
    const unsigned old = xb_add(&bar[XB_XSUB(b.x)], 1u);
    const unsigned gen = old / nloc;
    if (old + 1u == (gen + 1u) * nloc) {
      __builtin_amdgcn_fence(__ATOMIC_RELEASE, "agent");
      asm volatile("s_waitcnt vmcnt(0)" ::: "memory");
      const unsigned og = xb_add(&bar[XB_TOP], 1u);
      const unsigned tg = og / nx;
      if (og + 1u == (tg + 1u) * nx) xb_add(&bar[XB_TOPGEN], 1u);
      else XB_SPIN(xb_ld(&bar[XB_TOPGEN]) == tg, bar);
      __builtin_amdgcn_fence(__ATOMIC_ACQUIRE, "agent");
      xb_add(&bar[XB_XGEN(b.x)], 1u);
      asm volatile("s_waitcnt vmcnt(0)" ::: "memory");
    } else {
      XB_SPIN(xb_ld(&bar[XB_XGEN(b.x)]) == gen, bar);
      __builtin_amdgcn_fence(__ATOMIC_ACQUIRE, "agent");
      asm volatile("s_waitcnt vmcnt(0)" ::: "memory");
    }
  }
  __syncthreads();
}

#define SMEM_BYTES 155648

template <int PH>
DI void phase_and_probe(const Params& p, char* smem, cg::grid_group& grid) {
  const int reps = (PROBE_DUP == PH) ? 2 : 1;
  for (int rep = 0; rep < reps; ++rep) {
    if (PH == 10 && rep + 1 < reps) { Params q = p; q.gout = (float*)p.PQ; run_phase<PH>(q, smem); }
    else run_phase<PH>(p, smem);
    if (rep + 1 < reps) grid.sync();
  }
}
__global__ void __launch_bounds__(NT) k_mega(Params p) {
  extern __shared__ __attribute__((aligned(16))) char smem[];
  __shared__ uint4 xb_words;
  cg::grid_group grid = cg::this_grid();
  if (threadIdx.x == 0) xb_words = make_uint4(0u, 0u, 0u, 0u);
  __syncthreads();
  XcdBarrier xb = xcd_barrier_post(p.xbar, (volatile LAS unsigned*)&xb_words);
  phase_and_probe<0>(p, smem, grid); grid.sync();
  phase_and_probe<1>(p, smem, grid); xcd_barrier(xb);
  phase_and_probe<2>(p, smem, grid); xcd_barrier(xb);
  phase_and_probe<3>(p, smem, grid); xcd_barrier(xb);
  phase_and_probe<4>(p, smem, grid); xcd_barrier(xb);
  phase_and_probe<5>(p, smem, grid); xcd_barrier(xb);
  phase_and_probe<6>(p, smem, grid); xcd_barrier(xb);
  phase_and_probe<7>(p, smem, grid); xcd_barrier(xb);
  phase_and_probe<8>(p, smem, grid); xcd_barrier(xb);
  phase_and_probe<9>(p, smem, grid); xcd_barrier(xb);
  phase_and_probe<10>(p, smem, grid);
}
#ifdef MK_MULTI
template <int PH>
__global__ void __launch_bounds__(NT) k_single(Params p) {
  extern __shared__ __attribute__((aligned(16))) char smem[];
  run_phase<PH>(p, smem);
}
#endif

static size_t carve(size_t& off, size_t bytes) { size_t o = off; off += (bytes + 255) & ~(size_t)255; return o; }

extern "C" void kernel_launch(void* const* d_in, const int* in_sizes, int n_in, void* d_out, int out_size, void* d_ws, size_t ws_size,
                              hipStream_t stream) {
  Params p{};
  p.x = (const float*)d_in[0]; p.c = (const float*)d_in[1]; p.w_ada = (const float*)d_in[2]; p.b_ada = (const float*)d_in[3];
  p.g_mix = (const float*)d_in[4]; p.w_in = (const float*)d_in[5]; p.pe_k = (const float*)d_in[6]; p.pe_v = (const float*)d_in[7];
  p.w_k1 = (const float*)d_in[8]; p.b_k1 = (const float*)d_in[9]; p.w_k2 = (const float*)d_in[10]; p.w_v1 = (const float*)d_in[11];
  p.b_v1 = (const float*)d_in[12]; p.w_v2 = (const float*)d_in[13]; p.w_out = (const float*)d_in[14]; p.g_ffn = (const float*)d_in[15];
  p.w_pq = (const float*)d_in[16]; p.subkeys = (const float*)d_in[17]; p.peer_down = (const float*)d_in[18]; p.peer_up = (const float*)d_in[19];
  p.g_final = (const float*)d_in[20];
  p.out = (float*)d_out; p.gout = p.out;
  char* ws = (char*)d_ws;
  size_t off = 0;
  p.mod = (float*)(ws + carve(off, 2 * 6144 * 4));
  p.ksmax = (unsigned*)(ws + carve(off, 256));
  p.xbar = (unsigned*)(ws + carve(off, XCD_BAR_WORDS * 4));
  p.c128 = (float*)(ws + carve(off, (size_t)SEQ * 64 * 4)); p.s128 = (float*)(ws + carve(off, (size_t)SEQ * 64 * 4));
  p.c64 = (float*)(ws + carve(off, (size_t)SEQ * 32 * 4)); p.s64 = (float*)(ws + carve(off, (size_t)SEQ * 32 * 4));
  p.WinT = (bf16_t*)(ws + carve(off, (size_t)NPROJ * 1024 * 2));
  p.WoutT = (bf16_t*)(ws + carve(off, (size_t)1024 * 1024 * 2));
  p.WqT = (bf16_t*)(ws + carve(off, (size_t)2048 * 1024 * 2));
  p.W1Tk = (bf16_t*)(ws + carve(off, (size_t)256 * 2048 * 2)); p.W1Tv = (bf16_t*)(ws + carve(off, (size_t)256 * 2048 * 2));
  p.W2Tk = (bf16_t*)(ws + carve(off, 64 * 256 * 2)); p.W2Tv = (bf16_t*)(ws + carve(off, 64 * 256 * 2));
  p.SUBK = (bf16_t*)(ws + carve(off, (size_t)16 * 128 * 128 * 2));
  p.B1Pk = (float*)(ws + carve(off, 1024)); p.B1Pv = (float*)(ws + carve(off, 1024));
  p.RA = (bf16_t*)(ws + carve(off, (size_t)T_TOK * 1024 * 2));
  size_t rb = off;
  p.RQ = (bf16_t*)(ws + carve(off, (size_t)T_TOK * 512 * 2)); p.RK = (bf16_t*)(ws + carve(off, (size_t)T_TOK * 512 * 2));
  p.RKT = (bf16_t*)(ws + carve(off, (size_t)T_TOK * 512 * 2)); p.RVT = (bf16_t*)(ws + carve(off, (size_t)T_TOK * 512 * 2));
  p.RGT = (bf16_t*)(ws + carve(off, (size_t)T_TOK * 512 * 2)); p.NQ = (bf16_t*)(ws + carve(off, (size_t)T_TOK * 512 * 2));
  p.NKC = (bf16_t*)(ws + carve(off, (size_t)T_TOK * 128 * 2)); p.NVC = (bf16_t*)(ws + carve(off, (size_t)T_TOK * 128 * 2));
  p.NKS = (bf16_t*)(ws + carve(off, (size_t)T_TOK * 128 * 2)); p.NKW = (bf16_t*)(ws + carve(off, (size_t)T_TOK * 128 * 2));
  p.NVST = (bf16_t*)(ws + carve(off, (size_t)T_TOK * 128 * 2)); p.NVWT = (bf16_t*)(ws + carve(off, (size_t)T_TOK * 128 * 2));
  p.GATE = (float*)(ws + carve(off, (size_t)T_TOK * 24 * 4));
  p.KV = (float*)(ws + carve(off, (size_t)512 * 16384 * 4));
  p.SPREV = (bf16_t*)(ws + carve(off, (size_t)512 * 16384 * 2));
  p.KC = (bf16_t*)(ws + carve(off, (size_t)4 * 512 * 64 * 2)); p.VCT = (bf16_t*)(ws + carve(off, (size_t)4 * 512 * 64 * 2));
  p.HID = (float*)(ws + carve(off, (size_t)2 * 2048 * 256 * 4));
  size_t off2 = rb;
  p.PQ = (bf16_t*)(ws + carve(off2, (size_t)T_TOK * 2048 * 2));
  p.EIDX = (int*)(ws + carve(off2, (size_t)T_TOK * 128 * 4));
  p.EW = (float*)(ws + carve(off2, (size_t)T_TOK * 128 * 4));
  p.PDN = (bf16_t*)(ws + carve(off2, (size_t)16384 * 1024 * 2));
  p.PUP = (bf16_t*)(ws + carve(off2, (size_t)16384 * 1024 * 2));
  (void)ws_size; (void)in_sizes; (void)n_in; (void)out_size;

#ifdef MK_MULTI
#define LAUNCH1(PH) { hipFuncSetAttribute((const void*)k_single<PH>, hipFuncAttributeMaxDynamicSharedMemorySize, SMEM_BYTES); k_single<PH><<<256, NT, SMEM_BYTES, stream>>>(p); }
  LAUNCH1(0) LAUNCH1(1) LAUNCH1(2) LAUNCH1(3) LAUNCH1(4) LAUNCH1(5) LAUNCH1(6) LAUNCH1(7) LAUNCH1(8) LAUNCH1(9) LAUNCH1(10)
#else
  static int grid_blocks = 0;
  if (!grid_blocks) {
    int dev = 0, cus = 0, per_cu = 0;
    (void)hipGetDevice(&dev);
    (void)hipDeviceGetAttribute(&cus, hipDeviceAttributeMultiprocessorCount, dev);
    (void)hipFuncSetAttribute((const void*)k_mega, hipFuncAttributeMaxDynamicSharedMemorySize, SMEM_BYTES);
    (void)hipOccupancyMaxActiveBlocksPerMultiprocessor(&per_cu, k_mega, NT, SMEM_BYTES);
    if (per_cu < 1) per_cu = 1;
    if (per_cu > 1) per_cu = 1;
    grid_blocks = cus * per_cu;
  }
  (void)hipMemsetAsync(p.xbar, 0, XCD_BAR_WORDS * 4, stream);
  void* args[] = {&p};
  hipError_t e = hipLaunchCooperativeKernel((void*)k_mega, dim3(grid_blocks), dim3(NT), args, SMEM_BYTES, stream);
  if (e != hipSuccess) fprintf(stderr, "cooperative launch failed: %s (grid %d)\n", hipGetErrorString(e), grid_blocks);
#endif
}
```

```cpp
#include <hip/hip_runtime.h>
#include <hip/hip_bf16.h>
#include <hip/hip_cooperative_groups.h>
#include <stdint.h>
#include <stdio.h>
namespace cg = cooperative_groups;

typedef unsigned short bf16_t;
#define DI __device__ __forceinline__

DI int mytid() { int t = threadIdx.x; asm volatile("" : "+v"(t)); return t; }
DI float bf2f(bf16_t v) { return __uint_as_float(((unsigned)v) << 16); }
DI bf16_t f2bf(float x) { unsigned u = __float_as_uint(x); u += 0x7fffu + ((u >> 16) & 1u); return (bf16_t)(u >> 16); }
DI float gelu_tanh(float x) { float u = 0.7978845608028654f * (x + 0.044715f * x * x * x); return 0.5f * x * (1.f + tanhf(u)); }
DI float siluf(float x) { return x / (1.f + __expf(-x)); }
DI float sigmoidf(float x) { return 1.f / (1.f + __expf(-x)); }

#define T_TOK 16384
#define SEQ 8192
#define DM 1024
#define NPROJ 3456
#define NEG_INF (-__builtin_inff())

struct Params {
  const float *x, *c, *w_ada, *b_ada, *g_mix, *w_in, *pe_k, *pe_v, *w_k1, *b_k1, *w_k2, *w_v1, *b_v1, *w_v2, *w_out, *g_ffn,
      *w_pq, *subkeys, *peer_down, *peer_up, *g_final;
  float* out;
  float* gout;
  float* mod;
  unsigned* ksmax;
  unsigned* xbar;
  float *c128, *s128, *c64, *s64;
  bf16_t *WinT, *WoutT, *WqT, *W1Tk, *W1Tv, *W2Tk, *W2Tv, *SUBK;
  float *B1Pk, *B1Pv;
  bf16_t* RA;
  bf16_t *RQ, *RK, *RKT, *RVT, *RGT, *NQ, *NKC, *NVC, *NKS, *NKW, *NVST, *NVWT;
  float* GATE;
  float* KV;
  bf16_t* SPREV;
  bf16_t *KC, *VCT;
  float* HID;
  bf16_t* PQ;
  int* EIDX;
  float* EW;
  unsigned char *PDN8, *PUP8;
  float *SDN, *SUP;
};

DI float logg_h(int h) { return log1pf(-exp2f(-5.f - (float)h)); }


typedef __bf16 bf16x2_t __attribute__((ext_vector_type(2)));
typedef float f32x2_t __attribute__((ext_vector_type(2)));
DI unsigned cvt2(float a, float b) { f32x2_t v = {a, b}; bf16x2_t r = __builtin_convertvector(v, bf16x2_t); return __builtin_bit_cast(unsigned, r); }
DI uint2 pack4(float a, float b, float c, float d) { uint2 r; r.x = cvt2(a, b); r.y = cvt2(c, d); return r; }
#define NT 512
#ifndef PROBE_DUP
#define PROBE_DUP -1
#endif
typedef short bf16x8 __attribute__((ext_vector_type(8)));
typedef float f32x16 __attribute__((ext_vector_type(16)));
#define MFMA32(a, b, c) __builtin_amdgcn_mfma_f32_32x32x16_bf16((a), (b), (c), 0, 0, 0)

DI int win_logical_col(int np) {
  int g = np >> 6, c = np & 63;
  if (g < 16) {
    int sec = g >> 3, hh = (g & 7) >> 1, j = g & 1, i = 32 * j + (c & 31);
    return sec * 512 + hh * 128 + ((c < 32) ? i : 64 + i);
  } else if (g < 52) return 1024 + (g - 16) * 64 + c;
  else if (g == 52) return (c < 24) ? 3328 + c : -1;
  return -1;
}

DI void tr_tile(const float* __restrict__ in, bf16_t* __restrict__ out, int K, int N_in, int k0, int n0, int mode, float* tile) {
  const int tid = mytid();
  {
    int nn = tid & 63, col = mode ? win_logical_col(n0 + nn) : (n0 + nn);
#pragma unroll
    for (int i = 0; i < 8; ++i) {
      int kk = (tid >> 6) + 8 * i;
      tile[kk * 65 + nn] = (col >= 0) ? in[(size_t)(k0 + kk) * N_in + col] : 0.f;
    }
  }
  __syncthreads();
  {
    int kk = tid & 63;
#pragma unroll
    for (int i = 0; i < 8; ++i) {
      int nn = (tid >> 6) + 8 * i;
      out[(size_t)(n0 + nn) * K + k0 + kk] = f2bf(tile[kk * 65 + nn]);
    }
  }
  __syncthreads();
}

#define PH0_MOD 96
#define PH0_WIN (PH0_MOD + 16 * 54)
#define PH0_WOUT (PH0_WIN + 256)
#define PH0_WQ (PH0_WOUT + 512)
#define PH0_W1K (PH0_WQ + 128)
#define PH0_W1V (PH0_W1K + 128)
#define PH0_W2K (PH0_W1V + 4)
#define PH0_W2V (PH0_W2K + 4)
#define PH0_SUBK (PH0_W2V + 512)
#define PH0_ROPE (PH0_SUBK + 1024)
#define PH0_B1P (PH0_ROPE + 8)
#define PH0_NVB PH0_B1P

DI void ph0_body(const Params& p, int vb, char* smem) {
  const int tid = mytid();
  float* fs = (float*)smem;
  if (vb < PH0_MOD) {
    int kg = tid >> 6, col = vb * 64 + (tid & 63);
    float a0 = 0.f, a1 = 0.f;
#pragma unroll 8
    for (int k = kg * 128; k < kg * 128 + 128; ++k) {
      float w = p.w_ada[(size_t)k * 6144 + col];
      a0 += siluf(p.c[k]) * w; a1 += siluf(p.c[DM + k]) * w;
    }
    fs[kg * 64 + (tid & 63)] = a0; fs[512 + kg * 64 + (tid & 63)] = a1;
    __syncthreads();
    if (tid < 128) {
      int b = tid >> 6, cc = tid & 63; float s = 0.f;
      for (int g = 0; g < 8; ++g) s += fs[b * 512 + g * 64 + cc];
      p.mod[b * 6144 + vb * 64 + cc] = s + p.b_ada[vb * 64 + cc];
    }
    __syncthreads();
    if (vb == 0 && tid < 12) p.ksmax[tid] = 0u;
  } else if (vb < PH0_WIN) { int t = vb - PH0_MOD; tr_tile(p.w_in, p.WinT, 1024, 3352, (t & 15) * 64, (t >> 4) * 64, 1, fs); }
  else if (vb < PH0_WOUT) { int t = vb - PH0_WIN; tr_tile(p.w_out, p.WoutT, 1024, 1024, (t & 15) * 64, (t >> 4) * 64, 0, fs); }
  else if (vb < PH0_WQ) { int t = vb - PH0_WOUT; tr_tile(p.w_pq, p.WqT, 1024, 2048, (t & 15) * 64, (t >> 4) * 64, 0, fs); }
  else if (vb < PH0_W1K) { int t = vb - PH0_WQ; tr_tile(p.w_k1, p.W1Tk, 2048, 256, (t & 31) * 64, (t >> 5) * 64, 0, fs); }
  else if (vb < PH0_W1V) { int t = vb - PH0_W1K; tr_tile(p.w_v1, p.W1Tv, 2048, 256, (t & 31) * 64, (t >> 5) * 64, 0, fs); }
  else if (vb < PH0_W2K) { int t = vb - PH0_W1V; tr_tile(p.w_k2, p.W2Tk, 256, 64, t * 64, 0, 0, fs); }
  else if (vb < PH0_W2V) { int t = vb - PH0_W2K; tr_tile(p.w_v2, p.W2Tv, 256, 64, t * 64, 0, 0, fs); }
  else if (vb < PH0_SUBK) { int i = (vb - PH0_W2V) * NT + tid; p.SUBK[i] = f2bf(p.subkeys[i]); }
  else if (vb < PH0_ROPE) {
    int idx = (vb - PH0_SUBK) * NT + tid;
    { int s = idx >> 6, i = idx & 63; float inv = powf(10000.f, -(float)(2 * i) / 128.f); float ang = (float)s * inv; p.c128[idx] = cosf(ang); p.s128[idx] = sinf(ang); }
    if (idx < SEQ * 32) { int s = idx >> 5, i = idx & 31; float inv = powf(10000.f, -(float)(2 * i) / 64.f); float ang = (float)s * inv; p.c64[idx] = cosf(ang); p.s64[idx] = sinf(ang); }
  } else {
    int t = vb - PH0_ROPE, kv = t >> 2, jb = t & 3;
    const float* w1 = kv ? p.w_v1 : p.w_k1; const float* pe = kv ? p.pe_v : p.pe_k; const float* b1 = kv ? p.b_v1 : p.b_k1;
    int fg = tid >> 6, j = jb * 64 + (tid & 63);
    float a = 0.f;
#pragma unroll 8
    for (int f = fg * 256; f < fg * 256 + 256; ++f) a += pe[f] * w1[(size_t)f * 256 + j];
    fs[fg * 64 + (tid & 63)] = a;
    __syncthreads();
    if (tid < 64) { float s = b1[j]; for (int g = 0; g < 8; ++g) s += fs[g * 64 + tid]; (kv ? p.B1Pv : p.B1Pk)[j] = s; }
    __syncthreads();
  }
}

DI void rownorm_body(const float* __restrict__ src, const float* __restrict__ g, const float* __restrict__ mod, int sh_off, int sc_off, bf16_t* __restrict__ dst, int vb) {
  int row = vb * 8 + (mytid() >> 6), lane = mytid() & 63;
  int b = row >> 13;
  const float* xr = src + (size_t)row * DM;
  float v[16]; float ss = 0.f;
#pragma unroll
  for (int i = 0; i < 4; ++i) {
    float4 t = *(const float4*)(xr + i * 256 + lane * 4);
    v[i * 4 + 0] = t.x; v[i * 4 + 1] = t.y; v[i * 4 + 2] = t.z; v[i * 4 + 3] = t.w;
    ss += t.x * t.x + t.y * t.y + t.z * t.z + t.w * t.w;
  }
  for (int o = 32; o; o >>= 1) ss += __shfl_xor(ss, o);
  float rstd = rsqrtf(ss * (1.f / DM) + 1e-6f);
  const float* sh = mod + b * 6144 + sh_off; const float* sc = mod + b * 6144 + sc_off;
#pragma unroll
  for (int i = 0; i < 4; ++i) {
    int col = i * 256 + lane * 4;
    float4 gg = *(const float4*)(g + col), s4 = *(const float4*)(sc + col), h4 = *(const float4*)(sh + col);
    float y0 = v[i * 4 + 0] * rstd * gg.x * (1.f + s4.x) + h4.x;
    float y1 = v[i * 4 + 1] * rstd * gg.y * (1.f + s4.y) + h4.y;
    float y2 = v[i * 4 + 2] * rstd * gg.z * (1.f + s4.z) + h4.z;
    float y3 = v[i * 4 + 3] * rstd * gg.w * (1.f + s4.w) + h4.w;
    *(uint2*)(dst + (size_t)row * DM + col) = pack4(y0, y1, y2, y3);
  }
}

#define G_A_BYTES (256 * 144)
#define G_B_BYTES (128 * 144)
#define G_BUF_BYTES (G_A_BYTES + G_B_BYTES)
template <class Epi>
DI void gemm_tile(const bf16_t* __restrict__ A, const bf16_t* __restrict__ Bt, int K, int m0, int n0, char* smem, const Epi& epi) {
  const int tid = mytid(), lane = tid & 63, w = tid >> 6, wm = w >> 1, wn = w & 1, r = lane & 31, h = lane >> 5;
  f32x16 acc[2][2];
#pragma unroll
  for (int i = 0; i < 2; ++i)
#pragma unroll
    for (int j = 0; j < 2; ++j)
#pragma unroll
      for (int e = 0; e < 16; ++e) acc[i][j][e] = 0.f;
  const int crow = tid >> 3, ckc = tid & 7;
  const bf16_t* ag = A + (size_t)(m0 + crow) * K + ckc * 8;
  const bf16_t* bg = Bt + (size_t)(n0 + crow) * K + ckc * 8;
  uint4 ra[4], rb[2];
#pragma unroll
  for (int i = 0; i < 4; ++i) ra[i] = *(const uint4*)(ag + (size_t)i * 64 * K);
#pragma unroll
  for (int i = 0; i < 2; ++i) rb[i] = *(const uint4*)(bg + (size_t)i * 64 * K);
  char* lw = smem + crow * 144 + ckc * 16;
#pragma unroll
  for (int i = 0; i < 4; ++i) *(uint4*)(lw + i * 64 * 144) = ra[i];
#pragma unroll
  for (int i = 0; i < 2; ++i) *(uint4*)(lw + G_A_BYTES + i * 64 * 144) = rb[i];
  __syncthreads();
  const int nk = K >> 6;
  for (int kt = 0; kt < nk; ++kt) {
    const int cur = kt & 1;
    if (kt + 1 < nk) {
      const int k0 = (kt + 1) * 64;
#pragma unroll
      for (int i = 0; i < 4; ++i) ra[i] = *(const uint4*)(ag + (size_t)i * 64 * K + k0);
#pragma unroll
      for (int i = 0; i < 2; ++i) rb[i] = *(const uint4*)(bg + (size_t)i * 64 * K + k0);
    }
    const char* la = smem + cur * G_BUF_BYTES + (wm * 64 + r) * 144 + h * 16;
    const char* lb = smem + cur * G_BUF_BYTES + G_A_BYTES + (wn * 64 + r) * 144 + h * 16;
#pragma unroll
    for (int kk = 0; kk < 4; ++kk) {
      bf16x8 a0 = *(const bf16x8*)(la + kk * 32), a1 = *(const bf16x8*)(la + 32 * 144 + kk * 32);
      bf16x8 b0 = *(const bf16x8*)(lb + kk * 32), b1 = *(const bf16x8*)(lb + 32 * 144 + kk * 32);
      acc[0][0] = MFMA32(a0, b0, acc[0][0]); acc[0][1] = MFMA32(a0, b1, acc[0][1]);
      acc[1][0] = MFMA32(a1, b0, acc[1][0]); acc[1][1] = MFMA32(a1, b1, acc[1][1]);
    }
    if (kt + 1 < nk) {
      char* lw2 = lw + (cur ^ 1) * G_BUF_BYTES;
#pragma unroll
      for (int i = 0; i < 4; ++i) *(uint4*)(lw2 + i * 64 * 144) = ra[i];
#pragma unroll
      for (int i = 0; i < 2; ++i) *(uint4*)(lw2 + G_A_BYTES + i * 64 * 144) = rb[i];
    }
    __syncthreads();
  }
  const int G = (n0 >> 6) + wn;
  float pre[2][4][8];
#pragma unroll
  for (int i = 0; i < 2; ++i)
#pragma unroll
    for (int g = 0; g < 4; ++g) epi.prefetch(m0 + wm * 64 + i * 32 + 8 * g + 4 * h, G, r, pre[i][g]);
  for (int rep21 = 0; rep21 < ((PROBE_DUP == 21 && Epi::kProbe) ? 2 : 1); ++rep21) {
#pragma unroll
  for (int i = 0; i < 2; ++i)
#pragma unroll
    for (int g = 0; g < 4; ++g) {
      float lo[4], hi[4];
#pragma unroll
      for (int e = 0; e < 4; ++e) { lo[e] = acc[i][0][4 * g + e]; hi[e] = acc[i][1][4 * g + e]; }
      epi(m0 + wm * 64 + i * 32 + 8 * g + 4 * h, G, r, lo, hi, pre[i][g]);
    }
  }
}

struct EpiProj {
  static constexpr bool kProbe = true;
  const Params& p;
  DI void prefetch(int t0, int G, int c, float (&pre)[8]) const {
    const int s0 = t0 & 8191;
    const bool r128 = G < 16, r64 = (G >= 32 && G < 40) || (G >= 40 && G < 52 && (((G - 40) >> 1) & 1) == 0);
    if (r128) {
      const int i = 32 * (G & 1) + c;
#pragma unroll
      for (int e = 0; e < 4; ++e) { pre[e] = p.c128[(s0 + e) * 64 + i]; pre[4 + e] = p.s128[(s0 + e) * 64 + i]; }
    } else if (r64) {
#pragma unroll
      for (int e = 0; e < 4; ++e) { pre[e] = p.c64[(s0 + e) * 32 + c]; pre[4 + e] = p.s64[(s0 + e) * 32 + c]; }
    } else {
#pragma unroll
      for (int e = 0; e < 8; ++e) pre[e] = 0.f;
    }
  }
  DI void operator()(int t0, int G, int c, const float (&lo)[4], const float (&hi)[4], const float (&pre)[8]) const {
    const int b = t0 >> 13, s0 = t0 & 8191;
    if (G < 16) {
      const int sec = G >> 3, hh = (G & 7) >> 1, j = G & 1, i = 32 * j + c;
      float o1[4], o2[4];
#pragma unroll
      for (int e = 0; e < 4; ++e) {
        float cs = pre[e], sn = pre[4 + e];
        o1[e] = lo[e] * cs - hi[e] * sn; o2[e] = hi[e] * cs + lo[e] * sn;
      }
      if (sec == 0) {
#pragma unroll
        for (int e = 0; e < 4; ++e) {
          p.RQ[(size_t)(t0 + e) * 512 + hh * 128 + i] = f2bf(o1[e]);
          p.RQ[(size_t)(t0 + e) * 512 + hh * 128 + 64 + i] = f2bf(o2[e]);
        }
      } else {
        const float sc = 0.08838834764831845f;
        const float lg = logg_h(hh);
#pragma unroll
        for (int e = 0; e < 4; ++e) {
          o1[e] *= sc; o2[e] *= sc;
          p.RK[(size_t)(t0 + e) * 512 + hh * 128 + i] = f2bf(o1[e]);
          p.RK[(size_t)(t0 + e) * 512 + hh * 128 + 64 + i] = f2bf(o2[e]);
          float zeta = __expf((float)(127 - ((s0 + e) & 127)) * lg);
          o1[e] *= zeta; o2[e] *= zeta;
        }
        *(uint2*)(p.RKT + ((size_t)(b * 4 + hh) * 128 + i) * SEQ + s0) = pack4(o1[0], o1[1], o1[2], o1[3]);
        *(uint2*)(p.RKT + ((size_t)(b * 4 + hh) * 128 + 64 + i) * SEQ + s0) = pack4(o2[0], o2[1], o2[2], o2[3]);
      }
    } else if (G < 24) {
      const int hh = (G - 16) >> 1, d = ((G - 16) & 1) * 64 + c;
      *(uint2*)(p.RVT + ((size_t)(b * 4 + hh) * 128 + d) * SEQ + s0) = pack4(lo[0], lo[1], lo[2], lo[3]);
      *(uint2*)(p.RVT + ((size_t)(b * 4 + hh) * 128 + d + 32) * SEQ + s0) = pack4(hi[0], hi[1], hi[2], hi[3]);
    } else if (G < 32) {
      const int hh = (G - 24) >> 1, d = ((G - 24) & 1) * 64 + c;
#pragma unroll
      for (int e = 0; e < 4; ++e) {
        p.RGT[(size_t)(t0 + e) * 512 + hh * 128 + d] = f2bf(siluf(lo[e]));
        p.RGT[(size_t)(t0 + e) * 512 + hh * 128 + d + 32] = f2bf(siluf(hi[e]));
      }
    } else if (G < 40) {
      const int head = G - 32;
#pragma unroll
      for (int e = 0; e < 4; ++e) {
        float cs = pre[e], sn = pre[4 + e];
        float o1 = (lo[e] * cs - hi[e] * sn) * 0.125f, o2 = (hi[e] * cs + lo[e] * sn) * 0.125f;
        p.NQ[(size_t)(t0 + e) * 512 + head * 64 + c] = f2bf(o1);
        p.NQ[(size_t)(t0 + e) * 512 + head * 64 + 32 + c] = f2bf(o2);
      }
    } else if (G < 52) {
      const int k = G - 40, kind = k >> 1, gg = k & 1;
      float o1[4], o2[4];
#pragma unroll
      for (int e = 0; e < 4; ++e) {
        o1[e] = lo[e]; o2[e] = hi[e];
        if ((kind & 1) == 0) {
          float cs = pre[e], sn = pre[4 + e];
          o1[e] = lo[e] * cs - hi[e] * sn; o2[e] = hi[e] * cs + lo[e] * sn;
        }
      }
      if (kind == 3 || kind == 5) {
        bf16_t* dst = (kind == 3 ? p.NVST : p.NVWT) + ((size_t)(b * 2 + gg) * 64 + c) * SEQ + s0;
        *(uint2*)dst = pack4(o1[0], o1[1], o1[2], o1[3]);
        *(uint2*)(dst + (size_t)32 * SEQ) = pack4(o2[0], o2[1], o2[2], o2[3]);
      } else {
        bf16_t* dst = (kind == 0 ? p.NKC : kind == 1 ? p.NVC : kind == 2 ? p.NKS : p.NKW);
#pragma unroll
        for (int e = 0; e < 4; ++e) {
          dst[(size_t)(t0 + e) * 128 + gg * 64 + c] = f2bf(o1[e]);
          dst[(size_t)(t0 + e) * 128 + gg * 64 + 32 + c] = f2bf(o2[e]);
        }
      }
    } else if (G == 52) {
      if (c < 24) {
#pragma unroll
        for (int e = 0; e < 4; ++e) p.GATE[(size_t)(t0 + e) * 24 + c] = sigmoidf(lo[e]);
      }
    }
  }
};
struct EpiOut {
  static constexpr bool kProbe = false;
  const Params& p;
  DI void prefetch(int t0, int G, int c, float (&pre)[8]) const {
    const int c0 = G * 64 + c;
#pragma unroll
    for (int e = 0; e < 4; ++e) { pre[e] = p.x[(size_t)(t0 + e) * DM + c0]; pre[4 + e] = p.x[(size_t)(t0 + e) * DM + c0 + 32]; }
  }
  DI void operator()(int t0, int G, int c, const float (&lo)[4], const float (&hi)[4], const float (&pre)[8]) const {
    const int b = t0 >> 13;
    const int c0 = G * 64 + c, c1 = c0 + 32;
    const float* ga1 = p.mod + b * 6144 + 2048;
    const float g0 = ga1[c0], g1 = ga1[c1];
#pragma unroll
    for (int e = 0; e < 4; ++e) {
      p.out[(size_t)(t0 + e) * DM + c0] = pre[e] + g0 * lo[e];
      p.out[(size_t)(t0 + e) * DM + c1] = pre[4 + e] + g1 * hi[e];
    }
  }
};
struct EpiPQ {
  static constexpr bool kProbe = false;
  const Params& p;
  DI void prefetch(int, int, int, float (&)[8]) const {}
  DI void operator()(int t0, int G, int c, const float (&lo)[4], const float (&hi)[4], const float (&)[8]) const {
#pragma unroll
    for (int e = 0; e < 4; ++e) {
      p.PQ[(size_t)(t0 + e) * 2048 + G * 64 + c] = f2bf(lo[e]);
      p.PQ[(size_t)(t0 + e) * 2048 + G * 64 + 32 + c] = f2bf(hi[e]);
    }
  }
};

DI void retkv_naive(const Params& p, size_t idx) {
  int item = (int)(idx >> 14), v = (int)((idx >> 7) & 127), k = (int)(idx & 127);
  int h = item & 3, c = (item >> 2) & 63, b = item >> 8;
  const bf16_t* vp = p.RVT + ((size_t)(b * 4 + h) * 128 + v) * SEQ + c * 128;
  const bf16_t* kp = p.RKT + ((size_t)(b * 4 + h) * 128 + k) * SEQ + c * 128;
  float a = 0.f;
  for (int m = 0; m < 128; ++m) a += bf2f(vp[m]) * bf2f(kp[m]);
  p.KV[idx] = a;
}
DI void scan_naive(const Params& p, int idx) {
  int e = idx & 16383, bh = idx >> 14, b = bh >> 2, h = bh & 3;
  float cd = __expf(128.f * logg_h(h));
  float S = 0.f;
  for (int c = 0; c < 64; ++c) {
    size_t o = (size_t)((b * 64 + c) * 4 + h) * 16384 + e;
    p.SPREV[o] = f2bf(S);
    S = cd * S + p.KV[o];
  }
}
DI void retout_naive(const Params& p, int item, char* smem) {
  float* Ssc = (float*)smem;
  float* Y = Ssc + 128 * 129;
  int h = item & 3, c = (item >> 2) & 63, b = item >> 8;
  int t0 = b * SEQ + c * 128, s0 = c * 128;
  float lg = logg_h(h);
  for (int idx = mytid(); idx < 16384; idx += NT) {
    int n = idx >> 7, m = idx & 127;
    float a = 0.f;
    if (m <= n) {
      const bf16_t* q = p.RQ + (size_t)(t0 + n) * 512 + h * 128;
      const bf16_t* k = p.RK + (size_t)(t0 + m) * 512 + h * 128;
      for (int kk = 0; kk < 128; ++kk) a += bf2f(q[kk]) * bf2f(k[kk]);
      a *= __expf((float)(n - m) * lg);
    }
    Ssc[n * 129 + m] = a;
  }
  __syncthreads();
  for (int idx = mytid(); idx < 16384; idx += NT) {
    int n = idx >> 7, v = idx & 127;
    const bf16_t* vp = p.RVT + ((size_t)(b * 4 + h) * 128 + v) * SEQ + s0;
    float inner = 0.f;
    for (int m = 0; m <= n; ++m) inner += Ssc[n * 129 + m] * bf2f(vp[m]);
    const bf16_t* q = p.RQ + (size_t)(t0 + n) * 512 + h * 128;
    const bf16_t* sp = p.SPREV + (size_t)item * 16384 + v * 128;
    float cr = 0.f;
    for (int kk = 0; kk < 128; ++kk) cr += bf2f(q[kk]) * bf2f(sp[kk]);
    Y[n * 129 + v] = inner + __expf((float)(n + 1) * lg) * cr;
  }
  __syncthreads();
  if (mytid() < 128) {
    int n = mytid();
    float mu = 0.f;
    for (int v = 0; v < 128; ++v) mu += Y[n * 129 + v];
    mu *= (1.f / 128.f);
    float var = 0.f;
    for (int v = 0; v < 128; ++v) { float d = Y[n * 129 + v] - mu; var += d * d; }
    var *= (1.f / 128.f);
    float rs = rsqrtf(var + 1e-6f);
    for (int v = 0; v < 128; ++v) {
      float g = bf2f(p.RGT[((size_t)(b * 4 + h) * 128 + v) * SEQ + s0 + n]);
      p.RA[(size_t)(t0 + n) * DM + h * 128 + v] = f2bf((Y[n * 129 + v] - mu) * rs * g);
    }
  }
  __syncthreads();
}
DI void cmp1_naive(const Params& p, int idx) {
  int j = idx & 255, r = (idx >> 8) & 2047, kv = idx >> 19;
  if (r >= 2044) return;
  int g = r & 1, n = (r >> 1) % 511, b = (r >> 1) / 511;
  const bf16_t* src = (kv ? p.NVC : p.NKC) + ((size_t)(b * SEQ + 16 * n)) * 128 + g * 64;
  const bf16_t* w = (kv ? p.W1Tv : p.W1Tk) + (size_t)j * 2048;
  float a = 0.f;
  for (int l = 0; l < 32; ++l)
    for (int d = 0; d < 64; ++d) a += bf2f(src[l * 128 + d]) * bf2f(w[l * 64 + d]);
  a += (kv ? p.B1Pv : p.B1Pk)[j];
  p.HID[((size_t)kv * 2048 + r) * 256 + j] = gelu_tanh(a);
}
DI void cmp2_naive(const Params& p, int idx) {
  int e = idx & 63, r = (idx >> 6) & 2047, kv = idx >> 17;
  if (r >= 2044) {
    int bg = r - 2044;
    if (kv == 0) p.KC[((size_t)bg * 512 + 511) * 64 + e] = 0;
    else p.VCT[((size_t)bg * 64 + e) * 512 + 511] = 0;
    return;
  }
  int g = r & 1, n = (r >> 1) % 511, b = (r >> 1) / 511;
  const float* hid = p.HID + ((size_t)kv * 2048 + r) * 256;
  const bf16_t* w = (kv ? p.W2Tv : p.W2Tk) + e * 256;
  float a = 0.f;
  for (int j = 0; j < 256; ++j) a += hid[j] * bf2f(w[j]);
  if (kv == 0) p.KC[((size_t)(b * 2 + g) * 512 + n) * 64 + e] = f2bf(a);
  else p.VCT[((size_t)(b * 2 + g) * 64 + e) * 512 + n] = f2bf(a);
}
DI void ksmax_naive(const Params& p, int idx) {
  int g = idx & 1, t = idx >> 1, b = t >> 13;
  const bf16_t* k = p.NKS + (size_t)t * 128 + g * 64;
  float ss = 0.f;
  for (int d = 0; d < 64; ++d) { float v = bf2f(k[d]); ss += v * v; }
  atomicMax(&p.ksmax[b * 2 + g], __float_as_uint(sqrtf(ss)));
}

#define NSA_SUB_FLOATS 18048
DI void nsa_naive(const Params& p, int blk, int tid, float* sm) {
  float* qs = sm;
  float* P = sm + 1024;
  float* IMP = P + 16 * 1024;
  int* SEL = (int*)(IMP + 512);
  int* NSEL = SEL + 64;
  int g = blk & 1, tq = blk >> 1;
  int tok0 = tq * 4, b = tok0 >> 13, s0 = tok0 & 8191;
  int bg = b * 2 + g;
  int th = tid >> 4, sub = tid & 15, token = th >> 2, hh = th & 3;
  int t = s0 + token;
  for (int i = tid; i < 1024; i += 256) {
    int r = i >> 6, d = i & 63;
    qs[i] = bf2f(p.NQ[(size_t)(tok0 + (r >> 2)) * 512 + (g * 4 + (r & 3)) * 64 + d]);
  }
  __syncthreads();
  const float* q = qs + th * 64;
  float* Pr = P + th * 1024;
  int nvalid = (t >= 31) ? ((t - 31) / 16 + 1) : 0;
  if (nvalid > 511) nvalid = 511;
  float mx = NEG_INF;
  for (int n = sub; n < 512; n += 16) {
    float sc = NEG_INF;
    if (n < nvalid) {
      const bf16_t* k = p.KC + ((size_t)bg * 512 + n) * 64;
      float a = 0.f;
      for (int d = 0; d < 64; ++d) a += q[d] * bf2f(k[d]);
      sc = a;
    }
    Pr[n] = sc; mx = fmaxf(mx, sc);
  }
  for (int o = 8; o; o >>= 1) mx = fmaxf(mx, __shfl_xor(mx, o));
  float mm = (mx == NEG_INF) ? 0.f : mx;
  float l = 0.f;
  for (int n = sub; n < 512; n += 16) { float e = (n < nvalid) ? __expf(Pr[n] - mm) : 0.f; Pr[n] = e; l += e; }
  for (int o = 8; o; o >>= 1) l += __shfl_xor(l, o);
  float inv = 1.f / fmaxf(l, 1.17549435e-38f);
  for (int n = sub; n < 512; n += 16) Pr[n] *= inv;
  __syncthreads();
  float oc[4] = {0, 0, 0, 0};
#pragma unroll
  for (int e = 0; e < 4; ++e) {
    int d = sub * 4 + e;
    const bf16_t* v = p.VCT + ((size_t)bg * 64 + d) * 512;
    float a = 0.f;
    for (int n = 0; n < nvalid; ++n) a += Pr[n] * bf2f(v[n]);
    oc[e] = a;
  }
  for (int i = tid; i < 512; i += 256) {
    int tk = i >> 7, j = i & 127;
    int tt = s0 + tk, cur = tt >> 6;
    float a = 0.f;
    for (int h2 = 0; h2 < 4; ++h2) {
      const float* pp = P + (tk * 4 + h2) * 1024;
      a += 2.f * (pp[4 * j] + pp[4 * j + 1] + pp[4 * j + 2]) + pp[4 * j + 3] + (j > 0 ? pp[4 * j - 1] : 0.f);
    }
    if (j == 0 || j == cur || j == cur - 1) a = 1e9f;
    if (j > cur) a = NEG_INF;
    IMP[i] = a;
  }
  __syncthreads();
  if (tid < 4) {
    int cnt = 0;
    for (int k = 0; k < 16; ++k) {
      float best = NEG_INF; int bj = -1;
      for (int j = 0; j < 128; ++j) { float v = IMP[tid * 128 + j]; if (v > best) { best = v; bj = j; } }
      if (bj < 0) break;
      SEL[tid * 16 + cnt] = bj; ++cnt; IMP[tid * 128 + bj] = NEG_INF;
    }
    NSEL[tid] = cnt;
  }
  __syncthreads();
  float os[4] = {0, 0, 0, 0};
  {
    int nk = NSEL[token] * 64;
    mx = NEG_INF;
    for (int ki = sub; ki < nk; ki += 16) {
      int pos = SEL[token * 16 + (ki >> 6)] * 64 + (ki & 63);
      float sc = NEG_INF;
      if (pos <= t) {
        const bf16_t* k = p.NKS + ((size_t)(b * SEQ + pos)) * 128 + g * 64;
        float a = 0.f;
        for (int d = 0; d < 64; ++d) a += q[d] * bf2f(k[d]);
        sc = a;
      }
      Pr[ki] = sc; mx = fmaxf(mx, sc);
    }
    for (int o = 8; o; o >>= 1) mx = fmaxf(mx, __shfl_xor(mx, o));
    mm = (mx == NEG_INF) ? 0.f : mx;
    l = 0.f;
    for (int ki = sub; ki < nk; ki += 16) { float sc = Pr[ki]; float e = (sc == NEG_INF) ? 0.f : __expf(sc - mm); Pr[ki] = e; l += e; }
    for (int o = 8; o; o >>= 1) l += __shfl_xor(l, o);
    inv = 1.f / fmaxf(l, 1.17549435e-38f);
    __syncthreads();
#pragma unroll
    for (int e = 0; e < 4; ++e) {
      int d = sub * 4 + e;
      const bf16_t* v = p.NVST + ((size_t)bg * 64 + d) * SEQ;
      float a = 0.f;
      for (int ki = 0; ki < nk; ++ki) {
        int pos = SEL[token * 16 + (ki >> 6)] * 64 + (ki & 63);
        a += Pr[ki] * bf2f(v[pos]);
      }
      os[e] = a * inv;
    }
    __syncthreads();
  }
  float ow[4] = {0, 0, 0, 0};
  {
    int lo = t - 511; if (lo < 0) lo = 0;
    int nk = t - lo + 1;
    mx = NEG_INF;
    for (int ki = sub; ki < nk; ki += 16) {
      int pos = lo + ki;
      const bf16_t* k = p.NKW + ((size_t)(b * SEQ + pos)) * 128 + g * 64;
      float a = 0.f;
      for (int d = 0; d < 64; ++d) a += q[d] * bf2f(k[d]);
      Pr[ki] = a; mx = fmaxf(mx, a);
    }
    for (int o = 8; o; o >>= 1) mx = fmaxf(mx, __shfl_xor(mx, o));
    l = 0.f;
    for (int ki = sub; ki < nk; ki += 16) { float e = __expf(Pr[ki] - mx); Pr[ki] = e; l += e; }
    for (int o = 8; o; o >>= 1) l += __shfl_xor(l, o);
    inv = 1.f / l;
    __syncthreads();
#pragma unroll
    for (int e = 0; e < 4; ++e) {
      int d = sub * 4 + e;
      const bf16_t* v = p.NVWT + ((size_t)bg * 64 + d) * SEQ + lo;
      float a = 0.f;
      for (int ki = 0; ki < nk; ++ki) a += Pr[ki] * bf2f(v[ki]);
      ow[e] = a * inv;
    }
  }
  const float* gt = p.GATE + (size_t)(tok0 + token) * 24 + (g * 4 + hh) * 3;
  float g0 = gt[0], g1 = gt[1], g2 = gt[2];
#pragma unroll
  for (int e = 0; e < 4; ++e) {
    int d = sub * 4 + e;
    p.RA[(size_t)(tok0 + token) * DM + 512 + (g * 4 + hh) * 64 + d] = f2bf(g0 * oc[e] + g1 * os[e] + g2 * ow[e]);
  }
  __syncthreads();
}

#define PEER_SUB_FLOATS 8192
DI void peer_naive(const Params& p, int t, int tid, float* sm) {
  float* qrow = sm;
  float* sc = sm + 2048;
  float* cand = sm + 4096;
  float* tv = sm + 6144;
  int* ti = (int*)(sm + 6400);
  float* tv2 = sm + 6656;
  int* te2 = (int*)(sm + 6784);
  float* red = sm + 6912;
  float* hrow = sm + 6928;
  int b = t >> 13;
  for (int i = tid; i < 2048; i += 256) qrow[i] = bf2f(p.PQ[(size_t)t * 2048 + i]);
  for (int i = tid; i < 1024; i += 256) hrow[i] = bf2f(p.RA[(size_t)t * DM + i]);
  __syncthreads();
  for (int i = tid; i < 2048; i += 256) {
    int ph = i >> 7;
    const bf16_t* k = p.SUBK + (size_t)i * 128;
    const float* q = qrow + ph * 128;
    float a = 0.f;
    for (int d = 0; d < 128; ++d) a += q[d] * bf2f(k[d]);
    sc[i] = a;
  }
  __syncthreads();
  if (tid < 16) {
    for (int k = 0; k < 16; ++k) {
      float best = NEG_INF; int bj = 0;
      for (int j = 0; j < 128; ++j) { float v = sc[tid * 128 + j]; if (v > best) { best = v; bj = j; } }
      tv[tid * 16 + k] = best; ti[tid * 16 + k] = bj; sc[tid * 128 + bj] = NEG_INF;
    }
  }
  __syncthreads();
  for (int i = tid; i < 2048; i += 256) {
    int pp = i >> 8, ii = (i >> 4) & 15, jj = i & 15;
    cand[i] = tv[(2 * pp) * 16 + ii] + tv[(2 * pp + 1) * 16 + jj];
  }
  __syncthreads();
  if (tid < 8) {
    for (int k = 0; k < 16; ++k) {
      float best = NEG_INF; int bj = 0;
      for (int j = 0; j < 256; ++j) { float v = cand[tid * 256 + j]; if (v > best) { best = v; bj = j; } }
      cand[tid * 256 + bj] = NEG_INF;
      tv2[tid * 16 + k] = best; te2[tid * 16 + k] = ti[(2 * tid) * 16 + (bj >> 4)] * 128 + ti[(2 * tid + 1) * 16 + (bj & 15)];
    }
    float m = tv2[tid * 16], l = 0.f;
    for (int k = 0; k < 16; ++k) { float e = __expf(tv2[tid * 16 + k] - m); tv2[tid * 16 + k] = e; l += e; }
    for (int k = 0; k < 16; ++k) tv2[tid * 16 + k] /= l;
  }
  __syncthreads();
  float4 hv = *(float4*)(hrow + tid * 4);
  float acc[4] = {0, 0, 0, 0};
  for (int e = 0; e < 128; ++e) {
    int idx = te2[e];
    float w = tv2[e];
    float4 u = *(const float4*)(p.peer_down + (size_t)idx * DM + tid * 4);
    float d = hv.x * u.x + hv.y * u.y + hv.z * u.z + hv.w * u.w;
    for (int o = 32; o; o >>= 1) d += __shfl_xor(d, o);
    if ((tid & 63) == 0) red[tid >> 6] = d;
    __syncthreads();
    float dot = red[0] + red[1] + red[2] + red[3];
    __syncthreads();
    float cf = w * gelu_tanh(dot);
    float4 v = *(const float4*)(p.peer_up + (size_t)idx * DM + tid * 4);
    acc[0] += cf * v.x; acc[1] += cf * v.y; acc[2] += cf * v.z; acc[3] += cf * v.w;
  }
  const float* ga2 = p.mod + b * 6144 + 5120;
  float4 x1 = *(float4*)(p.out + (size_t)t * DM + tid * 4);
  float y0 = x1.x + ga2[tid * 4 + 0] * acc[0], y1 = x1.y + ga2[tid * 4 + 1] * acc[1];
  float y2 = x1.z + ga2[tid * 4 + 2] * acc[2], y3 = x1.w + ga2[tid * 4 + 3] * acc[3];
  float ss = y0 * y0 + y1 * y1 + y2 * y2 + y3 * y3;
  for (int o = 32; o; o >>= 1) ss += __shfl_xor(ss, o);
  if ((tid & 63) == 0) red[4 + (tid >> 6)] = ss;
  __syncthreads();
  float tot = red[4] + red[5] + red[6] + red[7];
  float rstd = rsqrtf(tot * (1.f / DM) + 1e-6f);
  float4 o4;
  o4.x = y0 * rstd * p.g_final[tid * 4 + 0]; o4.y = y1 * rstd * p.g_final[tid * 4 + 1];
  o4.z = y2 * rstd * p.g_final[tid * 4 + 2]; o4.w = y3 * rstd * p.g_final[tid * 4 + 3];
  *(float4*)(p.out + (size_t)t * DM + tid * 4) = o4;
  __syncthreads();
}


DI int crow(int reg, int h) { return (reg & 3) + 8 * (reg >> 2) + 4 * h; }
DI bf16x8 ld16(const bf16_t* ptr) { return *(const bf16x8*)ptr; }
DI bf16x8 ld8x2(const bf16_t* ptr) {
  uint2 a = *(const uint2*)ptr, b = *(const uint2*)(ptr + 8);
  uint4 v; v.x = a.x; v.y = a.y; v.z = b.x; v.w = b.y;
  return __builtin_bit_cast(bf16x8, v);
}
DI bf16x8 pack8(float x0, float x1, float x2, float x3, float x4, float x5, float x6, float x7) {
  uint4 v; v.x = cvt2(x0, x1); v.y = cvt2(x2, x3); v.z = cvt2(x4, x5); v.w = cvt2(x6, x7);
  return __builtin_bit_cast(bf16x8, v);
}
DI f32x16 zero16() { f32x16 z; for (int e = 0; e < 16; ++e) z[e] = 0.f; return z; }

DI void retkv_mfma(const Params& p, int item) {
  const int lane = mytid() & 63, w = mytid() >> 6, r = lane & 31, h = lane >> 5;
  const int hh = item & 3, c = (item >> 2) & 63, b = item >> 8, bh = b * 4 + hh, s0 = c * 128;
  const int mi = w >> 1, nb = (w & 1) * 2;
  const bf16_t* vb_ = p.RVT + ((size_t)(bh * 128 + 32 * mi + r)) * SEQ + s0 + 8 * h;
  const bf16_t* k0 = p.RKT + ((size_t)(bh * 128 + 32 * nb + r)) * SEQ + s0 + 8 * h;
  const bf16_t* k1 = k0 + (size_t)32 * SEQ;
  f32x16 a0 = zero16(), a1 = zero16();
#pragma unroll
  for (int s = 0; s < 8; ++s) {
    bf16x8 a = ld16(vb_ + 16 * s), b0 = ld16(k0 + 16 * s), b1 = ld16(k1 + 16 * s);
    a0 = MFMA32(a, b0, a0); a1 = MFMA32(a, b1, a1);
  }
  float* dst = p.KV + (size_t)item * 16384;
#pragma unroll
  for (int e = 0; e < 16; ++e) {
    const int v = 32 * mi + crow(e, h);
    dst[v * 128 + 32 * nb + r] = a0[e];
    dst[v * 128 + 32 * nb + 32 + r] = a1[e];
  }
}
DI void scan_body(const Params& p, int idx) {
  const int e = idx & 16383, bh = idx >> 14, b = bh >> 2, h = bh & 3;
  const float cd = __expf(128.f * logg_h(h));
  float S = 0.f;
  for (int c0 = 0; c0 < 64; c0 += 8) {
    float kv[8];
#pragma unroll
    for (int u = 0; u < 8; ++u) kv[u] = p.KV[(size_t)((b * 64 + c0 + u) * 4 + h) * 16384 + e];
#pragma unroll
    for (int u = 0; u < 8; ++u) {
      p.SPREV[(size_t)((b * 64 + c0 + u) * 4 + h) * 16384 + e] = f2bf(S);
      S = cd * S + kv[u];
    }
  }
}
DI void retout_mfma(const Params& p, int task) {
  const int lane = mytid() & 63, r = lane & 31, h = lane >> 5;
  const int item = task >> 2, nt = task & 3;
  const int hh = item & 3, c = (item >> 2) & 63, b = item >> 8, bh = b * 4 + hh, s0 = c * 128, t0 = b * SEQ + s0;
  const float lg = logg_h(hh);
  const int n = 32 * nt + r;
  bf16x8 qf[8];
#pragma unroll
  for (int s = 0; s < 8; ++s) qf[s] = ld16(p.RQ + (size_t)(t0 + n) * 512 + hh * 128 + 16 * s + 8 * h);
  f32x16 acc[4];
#pragma unroll
  for (int vi = 0; vi < 4; ++vi) {
    acc[vi] = zero16();
    const bf16_t* sp = p.SPREV + (size_t)item * 16384 + (size_t)(32 * vi + r) * 128 + 8 * h;
#pragma unroll
    for (int s = 0; s < 8; ++s) acc[vi] = MFMA32(ld16(sp + 16 * s), qf[s], acc[vi]);
    __builtin_amdgcn_sched_barrier(0);
  }
  {
    const float xi = __expf((float)(n + 1) * lg);
#pragma unroll
    for (int vi = 0; vi < 4; ++vi)
#pragma unroll
      for (int e = 0; e < 16; ++e) acc[vi][e] *= xi;
  }
  for (int mt = 0; mt <= nt; ++mt) {
    f32x16 sa = zero16();
    const bf16_t* kp = p.RK + (size_t)(t0 + 32 * mt + r) * 512 + hh * 128 + 8 * h;
#pragma unroll
    for (int s = 0; s < 8; ++s) sa = MFMA32(ld16(kp + 16 * s), qf[s], sa);
    float pv[16];
#pragma unroll
    for (int e = 0; e < 16; ++e) {
      const int dm = n - (32 * mt + crow(e, h));
      pv[e] = (dm >= 0) ? sa[e] * __expf((float)dm * lg) : 0.f;
    }
#pragma unroll
    for (int s2 = 0; s2 < 2; ++s2) {
      bf16x8 bfr = pack8(pv[8 * s2], pv[8 * s2 + 1], pv[8 * s2 + 2], pv[8 * s2 + 3], pv[8 * s2 + 4], pv[8 * s2 + 5], pv[8 * s2 + 6], pv[8 * s2 + 7]);
#pragma unroll
      for (int vi = 0; vi < 4; ++vi) {
        bf16x8 afr = ld8x2(p.RVT + ((size_t)(bh * 128 + 32 * vi + r)) * SEQ + s0 + 32 * mt + 16 * s2 + 4 * h);
        acc[vi] = MFMA32(afr, bfr, acc[vi]);
      }
      __builtin_amdgcn_sched_barrier(0);
    }
  }
  float sum = 0.f;
#pragma unroll
  for (int vi = 0; vi < 4; ++vi)
#pragma unroll
    for (int e = 0; e < 16; ++e) sum += acc[vi][e];
  sum += __shfl_xor(sum, 32);
  const float mu = sum * (1.f / 128.f);
  float var = 0.f;
#pragma unroll
  for (int vi = 0; vi < 4; ++vi)
#pragma unroll
    for (int e = 0; e < 16; ++e) { float d = acc[vi][e] - mu; var += d * d; }
  var += __shfl_xor(var, 32);
  const float rs = rsqrtf(var * (1.f / 128.f) + 1e-6f);
#pragma unroll
  for (int vi = 0; vi < 4; ++vi)
#pragma unroll
    for (int g4 = 0; g4 < 4; ++g4) {
      const int v0 = 32 * vi + 8 * g4 + 4 * h;
      uint2 gt = *(const uint2*)(p.RGT + (size_t)(t0 + n) * 512 + hh * 128 + v0);
      float y0 = (acc[vi][4 * g4 + 0] - mu) * rs * __uint_as_float(gt.x << 16);
      float y1 = (acc[vi][4 * g4 + 1] - mu) * rs * __uint_as_float(gt.x & 0xffff0000u);
      float y2 = (acc[vi][4 * g4 + 2] - mu) * rs * __uint_as_float(gt.y << 16);
      float y3 = (acc[vi][4 * g4 + 3] - mu) * rs * __uint_as_float(gt.y & 0xffff0000u);
      *(uint2*)(p.RA + (size_t)(t0 + n) * DM + hh * 128 + v0) = pack4(y0, y1, y2, y3);
    }
}
#define HID_STRIDE 264
DI void compress_mfma(const Params& p, int item, char* smem) {
  bf16_t* HIDL = (bf16_t*)smem;
  const int lane = mytid() & 63, w = mytid() >> 6, r = lane & 31, h = lane >> 5;
  const int kv = item >> 6, bg = (item >> 4) & 3, rt = item & 15, n0 = rt * 32, b = bg >> 1, g = bg & 1;
  const bf16_t* src = kv ? p.NVC : p.NKC; const bf16_t* W1 = kv ? p.W1Tv : p.W1Tk; const bf16_t* W2 = kv ? p.W2Tv : p.W2Tk;
  const float* B1 = kv ? p.B1Pv : p.B1Pk;
  {
    const int n = min(n0 + r, 510);
    const bf16_t* ab = src + ((size_t)(b * SEQ + 16 * n)) * 128 + g * 64 + 8 * h;
    const bf16_t* bb = W1 + (size_t)(32 * w + r) * 2048 + 8 * h;
    f32x16 acc = zero16();
#pragma unroll 8
    for (int s = 0; s < 128; ++s) acc = MFMA32(ld16(ab + (s >> 2) * 128 + (s & 3) * 16), ld16(bb + 16 * s), acc);
    const float bias = B1[32 * w + r];
#pragma unroll
    for (int e = 0; e < 16; ++e) HIDL[crow(e, h) * HID_STRIDE + 32 * w + r] = f2bf(gelu_tanh(acc[e] + bias));
  }
  __syncthreads();
  if (w < 2) {
    f32x16 acc = zero16();
#pragma unroll
    for (int s = 0; s < 16; ++s) acc = MFMA32(ld16(HIDL + r * HID_STRIDE + 16 * s + 8 * h), ld16(W2 + (size_t)(32 * w + r) * 256 + 16 * s + 8 * h), acc);
    const int e_ = 32 * w + r;
    if (kv == 0) {
#pragma unroll
      for (int e = 0; e < 16; ++e) { const int n = n0 + crow(e, h); p.KC[((size_t)bg * 512 + n) * 64 + e_] = (n < 511) ? f2bf(acc[e]) : (bf16_t)0; }
    } else {
#pragma unroll
      for (int g4 = 0; g4 < 4; ++g4) {
        const int n = n0 + 8 * g4 + 4 * h;
        float v3 = (n + 3 < 511) ? acc[4 * g4 + 3] : 0.f;
        *(uint2*)(p.VCT + ((size_t)bg * 64 + e_) * 512 + n) = pack4(acc[4 * g4], acc[4 * g4 + 1], acc[4 * g4 + 2], v3);
      }
    }
  }
  __syncthreads();
}
DI void kmax_body(const Params& p, int idx) {
  const int g = idx & 1, t = idx >> 1, b = t >> 13;
  const bf16_t* k = p.NKS + (size_t)t * 128 + g * 64; const bf16_t* kw = p.NKW + (size_t)t * 128 + g * 64;
  float ss = 0.f, sw = 0.f;
  for (int d = 0; d < 64; ++d) { float v = bf2f(k[d]); ss += v * v; float u = bf2f(kw[d]); sw += u * u; }
  float m1 = sqrtf(ss), m2 = sqrtf(sw);
  for (int o = 32; o; o >>= 1) { m1 = fmaxf(m1, __shfl_xor(m1, o)); m2 = fmaxf(m2, __shfl_xor(m2, o)); }
}
DI void kmax_body2(const Params& p, int vb) {
  const int tid = mytid(), g = tid & 1, t = vb * 256 + (tid >> 1), b = t >> 13;
  const bf16_t* k = p.NKS + (size_t)t * 128 + g * 64; const bf16_t* kw = p.NKW + (size_t)t * 128 + g * 64;
  float ss = 0.f, sw = 0.f;
  for (int d = 0; d < 64; d += 8) {
    uint4 a = *(const uint4*)(k + d), c = *(const uint4*)(kw + d);
    const unsigned aa[4] = {a.x, a.y, a.z, a.w}, cc[4] = {c.x, c.y, c.z, c.w};
#pragma unroll
    for (int q = 0; q < 4; ++q) {
      float x0 = __uint_as_float(aa[q] << 16), x1 = __uint_as_float(aa[q] & 0xffff0000u);
      float y0 = __uint_as_float(cc[q] << 16), y1 = __uint_as_float(cc[q] & 0xffff0000u);
      ss += x0 * x0 + x1 * x1; sw += y0 * y0 + y1 * y1;
    }
  }
  float m1 = sqrtf(ss), m2 = sqrtf(sw);
  for (int o = 2; o < 64; o <<= 1) { m1 = fmaxf(m1, __shfl_xor(m1, o)); m2 = fmaxf(m2, __shfl_xor(m2, o)); }
  if ((tid & 63) < 2) { atomicMax(&p.ksmax[b * 2 + g], __float_as_uint(m1)); atomicMax(&p.ksmax[4 + b * 2 + g], __float_as_uint(m2)); }
}
DI void kcmax_body(const Params& p, int idx) {
  const bf16_t* k = p.KC + (size_t)idx * 64;
  float ss = 0.f;
  for (int d = 0; d < 64; ++d) { float v = bf2f(k[d]); ss += v * v; }
  atomicMax(&p.ksmax[8 + (idx >> 9)], __float_as_uint(sqrtf(ss)));
}

#define NSA_IMP 0
#define NSA_SELM 65536
#define NSA_KV 66560
#define KV_ROW 144
#define KV_TILE (64 * KV_ROW)
template <int CTRL> DI float dpp_f2(float x) { return __builtin_bit_cast(float, __builtin_amdgcn_mov_dpp(__builtin_bit_cast(int, x), CTRL, 0xf, 0xf, true)); }
DI float quad_sum(float v) { v += dpp_f2<0xB1>(v); v += dpp_f2<0x4E>(v); return v; }
DI bf16x8 lds8x2(const char* ptr) {
  uint2 a = *(const uint2*)ptr, b = *(const uint2*)(ptr + 16);
  uint4 v; v.x = a.x; v.y = a.y; v.z = b.x; v.w = b.y;
  return __builtin_bit_cast(bf16x8, v);
}

DI void nsa_item(const Params& p, int item, char* smem) {
  const int tid = mytid(), lane = tid & 63, w = tid >> 6, r = lane & 31, h = lane >> 5;
  const int ti = item >> 2, bg = item & 3, b = bg >> 1, g = bg & 1;
  const int ts = ti * 64, tokg0 = b * SEQ + ts;
  const int tkl = 8 * w + (r >> 2), hl = r & 3, hd = g * 4 + hl, tpos = ts + tkl;
  float* IMPA = (float*)(smem + NSA_IMP); float* IMPB = IMPA + 64 * 128;
  unsigned* SELM = (unsigned*)(smem + NSA_SELM);
  char* KVB = smem + NSA_KV;
  const float ksm = __uint_as_float(p.ksmax[bg]), kwm = __uint_as_float(p.ksmax[4 + bg]), kcm = __uint_as_float(p.ksmax[8 + bg]);

  bf16x8 qf[4];
#pragma unroll
  for (int s = 0; s < 4; ++s) qf[s] = ld16(p.NQ + (size_t)(tokg0 + tkl) * 512 + hd * 64 + 16 * s + 8 * h);
  float qq = 0.f;
#pragma unroll
  for (int s = 0; s < 4; ++s) {
    uint4 u = __builtin_bit_cast(uint4, qf[s]);
    const unsigned uu[4] = {u.x, u.y, u.z, u.w};
#pragma unroll
    for (int q = 0; q < 4; ++q) { float x0 = __uint_as_float(uu[q] << 16), x1 = __uint_as_float(uu[q] & 0xffff0000u); qq += x0 * x0 + x1 * x1; }
  }
  qq += __shfl_xor(qq, 32);
  const float qn = sqrtf(qq);
  const int srow = tid >> 3, sch = tid & 7;
  const bf16_t* ksrc = p.NKS + ((size_t)(b * SEQ) + srow) * 128 + g * 64 + sch * 8;
  const bf16_t* vsrc = p.NVST + ((size_t)bg * 64 + srow) * SEQ + sch * 8;
  char* sdst = KVB + srow * KV_ROW + sch * 16;
  {
    uint4 k0 = *(const uint4*)ksrc, v0 = *(const uint4*)vsrc;
    *(uint4*)sdst = k0; *(uint4*)(sdst + KV_TILE) = v0;
  }
  for (int q = tid; q < 64 * 128 * 2 / 4; q += NT) ((float4*)IMPA)[q] = make_float4(0.f, 0.f, 0.f, 0.f);
  __syncthreads();

  const float mbc = qn * kcm;
  int nvalid = (tpos >= 31) ? ((tpos - 31) >> 4) + 1 : 0;
  if (nvalid > 511) nvalid = 511;
  int nvw = (ts + 8 * w + 7 >= 31) ? ((ts + 8 * w + 7 - 31) >> 4) + 1 : 0;
  if (nvw > 511) nvw = 511;
  const int nkt = (nvw + 31) >> 5;
  const bf16_t* kcb = p.KC + ((size_t)bg * 512 + r) * 64 + 8 * h;
  float lsum = 0.f, invl = 0.f;
  for (int rep521 = 0; rep521 < (PROBE_DUP == 521 ? 2 : 1); ++rep521) {
  lsum = 0.f;
  for (int kt = 0; kt < nkt; ++kt) {
    f32x16 sa = zero16();
#pragma unroll
    for (int s = 0; s < 4; ++s) sa = MFMA32(ld16(kcb + (size_t)kt * 32 * 64 + 16 * s), qf[s], sa);
#pragma unroll
    for (int e = 0; e < 16; ++e) { const int n = 32 * kt + crow(e, h); lsum += (n < nvalid) ? __expf(sa[e] - mbc) : 0.f; }
  }
  lsum += __shfl_xor(lsum, 32);
  invl = (lsum > 0.f) ? 1.f / lsum : 0.f;
  for (int kt = 0; kt < nkt; ++kt) {
    f32x16 sa = zero16();
#pragma unroll
    for (int s = 0; s < 4; ++s) sa = MFMA32(ld16(kcb + (size_t)kt * 32 * 64 + 16 * s), qf[s], sa);
    float pv[16];
#pragma unroll
    for (int e = 0; e < 16; ++e) { const int n = 32 * kt + crow(e, h); pv[e] = (n < nvalid) ? __expf(sa[e] - mbc) * invl : 0.f; }
#pragma unroll
    for (int q = 0; q < 4; ++q) {
      float A = 2.f * (pv[4 * q] + pv[4 * q + 1] + pv[4 * q + 2]) + pv[4 * q + 3], Bv = pv[4 * q + 3];
      A = quad_sum(A); Bv = quad_sum(Bv);
      if (hl == 0) { const int j = 8 * kt + 2 * q + h; IMPA[tkl * 128 + j] = A; IMPB[tkl * 128 + j] = Bv; }
    }
  }
  }
  for (int rep522 = 0; rep522 < (PROBE_DUP == 522 ? 2 : 1); ++rep522)
  for (int tk = 0; tk < 8; ++tk) {
    const int tl = 8 * w + tk;
    unsigned long long key[2];
#pragma unroll
    for (int c2 = 0; c2 < 2; ++c2) {
      const int j = lane + 64 * c2;
      float imp = IMPA[tl * 128 + j] + ((j > 0) ? IMPB[tl * 128 + j - 1] : 0.f);
      if (j == 0 || j == ti || j == ti - 1) imp = 1e9f;
      key[c2] = (j <= ti) ? ((((unsigned long long)__float_as_uint(imp)) << 8) | (unsigned long long)(127 - j)) + 1ull : 0ull;
    }
    unsigned m0 = 0, m1 = 0, m2 = 0, m3 = 0;
    for (int it = 0; it < 16; ++it) {
      unsigned long long k = key[0] > key[1] ? key[0] : key[1];
#pragma unroll
      for (int o = 32; o; o >>= 1) {
        unsigned lo = (unsigned)k, hi = (unsigned)(k >> 32);
        unsigned lo2 = __shfl_xor(lo, o), hi2 = __shfl_xor(hi, o);
        unsigned long long k2 = ((unsigned long long)hi2 << 32) | lo2;
        k = k2 > k ? k2 : k;
      }
      if (k == 0ull) break;
      const int js = 127 - (int)((k - 1ull) & 255ull);
      const unsigned bit = 1u << (js & 31);
      if ((js >> 5) == 0) m0 |= bit; else if ((js >> 5) == 1) m1 |= bit; else if ((js >> 5) == 2) m2 |= bit; else m3 |= bit;
      if (key[0] == k) key[0] = 0ull;
      if (key[1] == k) key[1] = 0ull;
    }
    if (lane == 0) { SELM[tl * 4 + 0] = m0; SELM[tl * 4 + 1] = m1; SELM[tl * 4 + 2] = m2; SELM[tl * 4 + 3] = m3; }
  }
  unsigned mm[4], wv[4];
#pragma unroll
  for (int q = 0; q < 4; ++q) {
    mm[q] = SELM[tkl * 4 + q];
    unsigned u = 0;
#pragma unroll
    for (int t8 = 0; t8 < 8; ++t8) u |= SELM[(8 * w + t8) * 4 + q];
    wv[q] = u;
  }
  const float mbs = qn * ksm;
  f32x16 osl[2]; osl[0] = zero16(); osl[1] = zero16();
  float lsel = 0.f;
  {
    uint4 kn0, kn1, kn2, kn3, vn0, vn1, vn2, vn3;
    kn0 = kn1 = kn2 = kn3 = vn0 = vn1 = vn2 = vn3 = make_uint4(0u, 0u, 0u, 0u);
    if (1 <= ti) { kn1 = *(const uint4*)(ksrc + (size_t)1 * 64 * 128); vn1 = *(const uint4*)(vsrc + 1 * 64); }
    if (2 <= ti) { kn2 = *(const uint4*)(ksrc + (size_t)2 * 64 * 128); vn2 = *(const uint4*)(vsrc + 2 * 64); }
    if (3 <= ti) { kn3 = *(const uint4*)(ksrc + (size_t)3 * 64 * 128); vn3 = *(const uint4*)(vsrc + 3 * 64); }
#define SEL_STEP(U, KCUR, VCUR, KNXT, VNXT)                                                                                                 \
    {                                                                                                                                       \
      const int j = j0 + U;                                                                                                                 \
      if (j <= ti) {                                                                                                                        \
        if (j + 4 <= ti) { KCUR = *(const uint4*)(ksrc + (size_t)(j + 4) * 64 * 128); VCUR = *(const uint4*)(vsrc + (j + 4) * 64); }          \
        const unsigned wsel = (j < 32) ? wv[0] : (j < 64) ? wv[1] : (j < 96) ? wv[2] : wv[3];                                               \
        if ((wsel >> (j & 31)) & 1u) {                                                                                                      \
          const char* kb = KVB + (j & 1) * 2 * KV_TILE;                                                                                     \
          const char* vbuf = kb + KV_TILE;                                                                                                  \
          const unsigned msel = (j < 32) ? mm[0] : (j < 64) ? mm[1] : (j < 96) ? mm[2] : mm[3];                                             \
          const unsigned csel = (msel >> (j & 31)) & 1u;                                                                                    \
          bf16x8 pk[2][2];                                                                                                                  \
          _Pragma("unroll") for (int kh = 0; kh < 2; ++kh) {                                                                                \
            f32x16 sa = zero16();                                                                                                           \
            _Pragma("unroll") for (int s = 0; s < 4; ++s) sa = MFMA32(*(const bf16x8*)(kb + (32 * kh + r) * KV_ROW + (16 * s + 8 * h) * 2), qf[s], sa); \
            float pv[16];                                                                                                                   \
            _Pragma("unroll") for (int e = 0; e < 16; ++e) {                                                                                \
              const int key = 32 * kh + crow(e, h);                                                                                         \
              const bool ok = csel && ((j < ti) || (key <= tkl));                                                                           \
              pv[e] = ok ? __expf(sa[e] - mbs) : 0.f; lsel += pv[e];                                                                        \
            }                                                                                                                               \
            pk[kh][0] = pack8(pv[0], pv[1], pv[2], pv[3], pv[4], pv[5], pv[6], pv[7]);                                                      \
            pk[kh][1] = pack8(pv[8], pv[9], pv[10], pv[11], pv[12], pv[13], pv[14], pv[15]);                                                \
          }                                                                                                                                 \
          _Pragma("unroll") for (int di = 0; di < 2; ++di)                                                                                  \
            _Pragma("unroll") for (int kh = 0; kh < 2; ++kh)                                                                                \
              _Pragma("unroll") for (int s2 = 0; s2 < 2; ++s2)                                                                              \
                osl[di] = MFMA32(lds8x2(vbuf + (32 * di + r) * KV_ROW + (32 * kh + 16 * s2 + 4 * h) * 2), pk[kh][s2], osl[di]);             \
        }                                                                                                                                   \
        if (j < ti) { char* d2 = sdst + ((j + 1) & 1) * 2 * KV_TILE; *(uint4*)d2 = KNXT; *(uint4*)(d2 + KV_TILE) = VNXT; }                  \
        __syncthreads();                                                                                                                    \
      }                                                                                                                                     \
    }
    for (int j0 = 0; j0 <= ti; j0 += 4) {
      SEL_STEP(0, kn0, vn0, kn1, vn1)
      SEL_STEP(1, kn1, vn1, kn2, vn2)
      SEL_STEP(2, kn2, vn2, kn3, vn3)
      SEL_STEP(3, kn3, vn3, kn0, vn0)
    }
#undef SEL_STEP
  }
  lsel += __shfl_xor(lsel, 32);
  f32x16 oc[2]; oc[0] = zero16(); oc[1] = zero16();
  f32x16 ow[2]; ow[0] = zero16(); ow[1] = zero16();
  float lw = 0.f;
  const float mbw = qn * kwm;
  for (int rep524 = 0; rep524 < (PROBE_DUP == 524 ? 2 : 1); ++rep524) {
  for (int kt = 0; kt < nkt; ++kt) {
    f32x16 sa = zero16();
#pragma unroll
    for (int s = 0; s < 4; ++s) sa = MFMA32(ld16(kcb + (size_t)kt * 32 * 64 + 16 * s), qf[s], sa);
    float pv[16];
#pragma unroll
    for (int e = 0; e < 16; ++e) { const int n = 32 * kt + crow(e, h); pv[e] = (n < nvalid) ? __expf(sa[e] - mbc) * invl : 0.f; }
#pragma unroll
    for (int s2 = 0; s2 < 2; ++s2) {
      bf16x8 bfr = pack8(pv[8 * s2], pv[8 * s2 + 1], pv[8 * s2 + 2], pv[8 * s2 + 3], pv[8 * s2 + 4], pv[8 * s2 + 5], pv[8 * s2 + 6], pv[8 * s2 + 7]);
#pragma unroll
      for (int di = 0; di < 2; ++di) oc[di] = MFMA32(ld8x2(p.VCT + ((size_t)bg * 64 + 32 * di + r) * 512 + 32 * kt + 16 * s2 + 4 * h), bfr, oc[di]);
    }
  }
  {
    int lo = ts + 8 * w - 511; if (lo < 0) lo = 0;
    const int kt0 = lo >> 5, kt1 = (ts + 8 * w + 7) >> 5;
    for (int kt = kt0; kt <= kt1; ++kt) {
      f32x16 sa = zero16();
      const bf16_t* kp = p.NKW + ((size_t)(b * SEQ + 32 * kt + r)) * 128 + g * 64 + 8 * h;
#pragma unroll
      for (int s = 0; s < 4; ++s) sa = MFMA32(ld16(kp + 16 * s), qf[s], sa);
      float pv[16];
#pragma unroll
      for (int e = 0; e < 16; ++e) {
        const int pos = 32 * kt + crow(e, h);
        const bool ok = (pos <= tpos) && (pos > tpos - 512);
        pv[e] = ok ? __expf(sa[e] - mbw) : 0.f; lw += pv[e];
      }
#pragma unroll
      for (int s2 = 0; s2 < 2; ++s2) {
        bf16x8 bfr = pack8(pv[8 * s2], pv[8 * s2 + 1], pv[8 * s2 + 2], pv[8 * s2 + 3], pv[8 * s2 + 4], pv[8 * s2 + 5], pv[8 * s2 + 6], pv[8 * s2 + 7]);
#pragma unroll
        for (int di = 0; di < 2; ++di) ow[di] = MFMA32(ld8x2(p.NVWT + ((size_t)bg * 64 + 32 * di + r) * SEQ + 32 * kt + 16 * s2 + 4 * h), bfr, ow[di]);
      }
    }
  }
  }
  lw += __shfl_xor(lw, 32);
  if (PROBE_DUP == 524) { for (int e = 0; e < 16; ++e) { oc[0][e] *= 0.5f; oc[1][e] *= 0.5f; } }
  {
    const float invs = 1.f / lsel, invw = 1.f / lw;
    const float* gt = p.GATE + (size_t)(tokg0 + tkl) * 24 + hd * 3;
    const float g0 = gt[0], g1 = gt[1] * invs, g2 = gt[2] * invw;
#pragma unroll
    for (int di = 0; di < 2; ++di)
#pragma unroll
      for (int g4 = 0; g4 < 4; ++g4) {
        const int d0 = 32 * di + 8 * g4 + 4 * h;
        float y[4];
#pragma unroll
        for (int e = 0; e < 4; ++e) y[e] = g0 * oc[di][4 * g4 + e] + g1 * osl[di][4 * g4 + e] + g2 * ow[di][4 * g4 + e];
        *(uint2*)(p.RA + (size_t)(tokg0 + tkl) * DM + 512 + hd * 64 + d0) = pack4(y[0], y[1], y[2], y[3]);
      }
  }
}

typedef float f32x4 __attribute__((ext_vector_type(4)));
#define MFMA16(a, b, c) __builtin_amdgcn_mfma_f32_16x16x32_bf16((a), (b), (c), 0, 0, 0)
constexpr int pk_clen(int i) { return 16 / (i + 1); }
constexpr int pk_coff(int i) { int s = 0; for (int q = 0; q < i; ++q) s += pk_clen(q); return s; }
#define SC_STRIDE 132

DI void peer_topk_tile(const Params& p, int vb, char* smem) {
  float* SC = (float*)smem;
  unsigned* ELK = (unsigned*)(smem + 256 * SC_STRIDE * 4);
  float* ELW = (float*)(ELK + 16 * 128);
  const int tid = mytid(), lane = tid & 63, w = tid >> 6;
  const int t0 = vb * 16;
  {
    const int tq = lane & 15, kq = lane >> 4;
#pragma unroll
    for (int pi = 0; pi < 2; ++pi) {
      const int ph = 2 * w + pi;
      bf16x8 bfr[4];
#pragma unroll
      for (int s = 0; s < 4; ++s) bfr[s] = *(const bf16x8*)(p.PQ + (size_t)(t0 + tq) * 2048 + ph * 128 + 32 * s + 8 * kq);
#pragma unroll
      for (int j = 0; j < 8; ++j) {
        f32x4 acc = {0.f, 0.f, 0.f, 0.f};
#pragma unroll
        for (int s = 0; s < 4; ++s) {
          bf16x8 afr = *(const bf16x8*)(p.SUBK + ((size_t)(ph * 128 + 16 * j + tq)) * 128 + 32 * s + 8 * kq);
          acc = MFMA16(afr, bfr[s], acc);
        }
        *(f32x4*)(SC + (ph * 16 + tq) * SC_STRIDE + 16 * j + 4 * kq) = acc;
      }
    }
  }
  __syncthreads();
  if (tid < 256) {
    float* row = SC + tid * SC_STRIDE;
    float gmax[16];
#pragma unroll
    for (int g = 0; g < 16; ++g) {
      float4 a = *(float4*)(row + g * 8), b = *(float4*)(row + g * 8 + 4);
      gmax[g] = fmaxf(fmaxf(fmaxf(a.x, a.y), fmaxf(a.z, a.w)), fmaxf(fmaxf(b.x, b.y), fmaxf(b.z, b.w)));
    }
    float outv[16]; int outi[16];
#pragma unroll
    for (int k = 0; k < 16; ++k) {
      float gm = gmax[0]; int gi = 0;
#pragma unroll
      for (int g = 1; g < 16; ++g) { bool c = gmax[g] > gm; gm = c ? gmax[g] : gm; gi = c ? g : gi; }
      float* gp = row + gi * 8;
      float4 a = *(float4*)gp, b = *(float4*)(gp + 4);
      float v[8] = {a.x, a.y, a.z, a.w, b.x, b.y, b.z, b.w};
      int ei = 7;
#pragma unroll
      for (int e = 6; e >= 0; --e) ei = (v[e] == gm) ? e : ei;
      float nm = NEG_INF;
#pragma unroll
      for (int e = 0; e < 8; ++e) { float x = (e == ei) ? NEG_INF : v[e]; nm = fmaxf(nm, x); }
      gp[ei] = NEG_INF;
#pragma unroll
      for (int g = 0; g < 16; ++g) gmax[g] = (g == gi) ? nm : gmax[g];
      outv[k] = gm; outi[k] = gi * 8 + ei;
    }
#pragma unroll
    for (int k = 0; k < 16; ++k) { row[k] = outv[k]; row[16 + k] = __int_as_float(outi[k]); }
  }
  __syncthreads();
  if (tid < 128) {
    const int t = tid >> 3, pp = tid & 7;
    const float* ra = SC + ((2 * pp) * 16 + t) * SC_STRIDE;
    const float* rb = SC + ((2 * pp + 1) * 16 + t) * SC_STRIDE;
    float a[16], b[16]; int ia[16], ib[16];
#pragma unroll
    for (int q = 0; q < 4; ++q) {
      float4 x = *(const float4*)(ra + 4 * q), y = *(const float4*)(rb + 4 * q);
      float4 xi = *(const float4*)(ra + 16 + 4 * q), yi = *(const float4*)(rb + 16 + 4 * q);
      a[4 * q] = x.x; a[4 * q + 1] = x.y; a[4 * q + 2] = x.z; a[4 * q + 3] = x.w;
      b[4 * q] = y.x; b[4 * q + 1] = y.y; b[4 * q + 2] = y.z; b[4 * q + 3] = y.w;
      ia[4 * q] = __float_as_int(xi.x); ia[4 * q + 1] = __float_as_int(xi.y); ia[4 * q + 2] = __float_as_int(xi.z); ia[4 * q + 3] = __float_as_int(xi.w);
      ib[4 * q] = __float_as_int(yi.x); ib[4 * q + 1] = __float_as_int(yi.y); ib[4 * q + 2] = __float_as_int(yi.z); ib[4 * q + 3] = __float_as_int(yi.w);
    }
    float cs[50]; int cc[50];
#pragma unroll
    for (int i = 0; i < 16; ++i)
#pragma unroll
      for (int j = 0; j < pk_clen(i); ++j) { cs[pk_coff(i) + j] = a[i] + b[j]; cc[pk_coff(i) + j] = ia[i] * 128 + ib[j]; }
    float v16[16]; int c16[16];
#pragma unroll
    for (int k = 0; k < 16; ++k) {
      float best = cs[0]; int bi = 0, bc = cc[0];
#pragma unroll
      for (int q = 1; q < 50; ++q) { bool c = cs[q] > best; best = c ? cs[q] : best; bi = c ? q : bi; bc = c ? cc[q] : bc; }
#pragma unroll
      for (int q = 0; q < 50; ++q) cs[q] = (q == bi) ? NEG_INF : cs[q];
      v16[k] = best; c16[k] = bc;
    }
    float l = 0.f; const float vmax = v16[0];
#pragma unroll
    for (int k = 0; k < 16; ++k) { v16[k] = __expf(v16[k] - vmax); l += v16[k]; }
    float inv = 1.f / l;
#pragma unroll
    for (int k = 0; k < 16; ++k) {
      ELK[t * 128 + pp * 16 + k] = ((unsigned)c16[k] << 7) | (unsigned)(pp * 16 + k);
      ELW[t * 128 + pp * 16 + k] = v16[k] * inv;
    }
  }
  __syncthreads();
#pragma unroll
  for (int tt = 0; tt < 2; ++tt) {
    const int t = 2 * w + tt;
    unsigned e0 = ELK[t * 128 + 2 * lane], e1 = ELK[t * 128 + 2 * lane + 1];
#pragma unroll
    for (int k = 2; k <= 128; k <<= 1) {
#pragma unroll
      for (int j = k >> 1; j > 0; j >>= 1) {
        if (j == 1) {
          bool up = ((2 * lane) & k) == 0;
          unsigned lo = min(e0, e1), hi = max(e0, e1);
          e0 = up ? lo : hi; e1 = up ? hi : lo;
        } else {
          unsigned o0 = __shfl_xor(e0, j >> 1), o1 = __shfl_xor(e1, j >> 1);
          bool up = ((2 * lane) & k) == 0;
          bool lower = ((2 * lane) & j) == 0;
          bool keepmin = (up == lower);
          e0 = keepmin ? min(e0, o0) : max(e0, o0);
          e1 = keepmin ? min(e1, o1) : max(e1, o1);
        }
      }
    }
    const size_t gb = (size_t)(t0 + t) * 128 + 2 * lane;
    p.EIDX[gb] = (int)(e0 >> 7); p.EIDX[gb + 1] = (int)(e1 >> 7);
    p.EW[gb] = ELW[t * 128 + (e0 & 127)]; p.EW[gb + 1] = ELW[t * 128 + (e1 & 127)];
  }
  __syncthreads();
}

DI float dot2bf(unsigned a, unsigned b, float acc) { return __builtin_amdgcn_fdot2_f32_bf16(__builtin_bit_cast(bf16x2_t, a), __builtin_bit_cast(bf16x2_t, b), acc, false); }
template <int CTRL> DI float dpp_f(float x) { return __builtin_bit_cast(float, __builtin_amdgcn_mov_dpp(__builtin_bit_cast(int, x), CTRL, 0xf, 0xf, true)); }
DI float row16_sum(float v) { v += dpp_f<0x128>(v); v += dpp_f<0x124>(v); v += dpp_f<0x122>(v); v += dpp_f<0x121>(v); return v; }
DI float dot_row(const uint4 (&u)[8], const uint4 (&h)[8]) {
  float d = 0.f;
#pragma unroll
  for (int j = 0; j < 8; ++j) { d = dot2bf(u[j].x, h[j].x, d); d = dot2bf(u[j].y, h[j].y, d); d = dot2bf(u[j].z, h[j].z, d); d = dot2bf(u[j].w, h[j].w, d); }
  return row16_sum(d);
}
DI void axpy_row(float (&acc)[64], const uint4 (&v)[8], float c) {
#pragma unroll
  for (int j = 0; j < 8; ++j) {
    const unsigned ww[4] = {v[j].x, v[j].y, v[j].z, v[j].w};
#pragma unroll
    for (int q = 0; q < 4; ++q) {
      acc[j * 8 + 2 * q] += c * __uint_as_float(ww[q] << 16);
      acc[j * 8 + 2 * q + 1] += c * __uint_as_float(ww[q] & 0xffff0000u);
    }
  }
}
DI void axpy_half(float (&acc)[32], const uint4 (&v)[4], float c) {
#pragma unroll
  for (int j = 0; j < 4; ++j) {
    const unsigned ww[4] = {v[j].x, v[j].y, v[j].z, v[j].w};
#pragma unroll
    for (int q = 0; q < 4; ++q) {
      acc[j * 8 + 2 * q] += c * __uint_as_float(ww[q] << 16);
      acc[j * 8 + 2 * q + 1] += c * __uint_as_float(ww[q] & 0xffff0000u);
    }
  }
}
#ifndef PEER_TILE_SHIFT
#define PEER_TILE_SHIFT 8
#endif
DI void fma16_fp8(float& d, const uint4& u, const float* hv) {
  const unsigned ww[4] = {u.x, u.y, u.z, u.w};
#pragma unroll
  for (int q = 0; q < 4; ++q) {
    f32x2_t a = __builtin_amdgcn_cvt_pk_f32_fp8((int)ww[q], false), b = __builtin_amdgcn_cvt_pk_f32_fp8((int)ww[q], true);
    d += a[0] * hv[4 * q] + a[1] * hv[4 * q + 1] + b[0] * hv[4 * q + 2] + b[1] * hv[4 * q + 3];
  }
}
DI float dot_row8(const uint4 (&u)[4], const float (&hv)[64]) {
  float d0 = 0.f, d1 = 0.f;
  fma16_fp8(d0, u[0], hv); fma16_fp8(d1, u[1], hv + 16); fma16_fp8(d0, u[2], hv + 32); fma16_fp8(d1, u[3], hv + 48);
  return row16_sum(d0 + d1);
}
DI void axpy_row8(float (&acc)[64], const uint4 (&v)[4], float c) {
#pragma unroll
  for (int j = 0; j < 4; ++j) {
    const unsigned ww[4] = {v[j].x, v[j].y, v[j].z, v[j].w};
#pragma unroll
    for (int q = 0; q < 4; ++q) {
      f32x2_t a = __builtin_amdgcn_cvt_pk_f32_fp8((int)ww[q], false), b = __builtin_amdgcn_cvt_pk_f32_fp8((int)ww[q], true);
      acc[j * 16 + 4 * q] += c * a[0]; acc[j * 16 + 4 * q + 1] += c * a[1]; acc[j * 16 + 4 * q + 2] += c * b[0]; acc[j * 16 + 4 * q + 3] += c * b[1];
    }
  }
}
DI void peer_gather_block(const Params& p, int vb, char* smem) {
  unsigned* ELK = (unsigned*)smem;
  float* ELC = (float*)(smem + 32768);
  const int tid = mytid(), lane = tid & 63, w = tid >> 6, grp = lane >> 4, i = lane & 15;
  const int tokbase = vb * 64;
  for (int q = tid; q < 64 * 128 / 4; q += NT) {
    ((uint4*)ELK)[q] = ((const uint4*)(p.EIDX + (size_t)tokbase * 128))[q];
    ((float4*)ELC)[q] = ((const float4*)(p.EW + (size_t)tokbase * 128))[q];
  }
  __syncthreads();
#pragma unroll 1
  for (int tt = 0; tt < 2; ++tt) {
    const int tl = w * 8 + grp * 2 + tt, tok = tokbase + tl;
    const unsigned* kk = ELK + tl * 128;
    float* cc = ELC + tl * 128;
    uint4 b0[4], b1[4], b2[4], b3[4];
#define ROW_LOAD(BUF, BASE, E) { const unsigned e_ = kk[E]; _Pragma("unroll") for (int j = 0; j < 4; ++j) BUF[j] = *(const uint4*)(BASE + (size_t)e_ * DM + j * 256); }
    {
      float hv[64];
#pragma unroll
      for (int j = 0; j < 4; ++j)
#pragma unroll
        for (int hf = 0; hf < 2; ++hf) {
          uint4 a = *(const uint4*)(p.RA + (size_t)tok * DM + j * 256 + i * 16 + hf * 8);
          const unsigned aa[4] = {a.x, a.y, a.z, a.w};
#pragma unroll
          for (int q = 0; q < 4; ++q) { hv[j * 16 + hf * 8 + 2 * q] = __uint_as_float(aa[q] << 16); hv[j * 16 + hf * 8 + 2 * q + 1] = __uint_as_float(aa[q] & 0xffff0000u); }
        }
      const unsigned char* ub_ = p.PDN8 + i * 16;
#define DN_COMP(BUF, E) { const unsigned e_ = kk[E]; float d_ = dot_row8(BUF, hv) * p.SDN[e_]; float c_ = cc[E] * gelu_tanh(d_) * p.SUP[e_]; if (i == 0) cc[E] = c_; }
      ROW_LOAD(b0, ub_, 0) ROW_LOAD(b1, ub_, 1) ROW_LOAD(b2, ub_, 2) ROW_LOAD(b3, ub_, 3)
      for (int e = 0; e < 128; e += 4) {
        DN_COMP(b0, e)     if (e + 4 < 128) ROW_LOAD(b0, ub_, e + 4)
        DN_COMP(b1, e + 1) if (e + 4 < 128) ROW_LOAD(b1, ub_, e + 5)
        DN_COMP(b2, e + 2) if (e + 4 < 128) ROW_LOAD(b2, ub_, e + 6)
        DN_COMP(b3, e + 3) if (e + 4 < 128) ROW_LOAD(b3, ub_, e + 7)
      }
#undef DN_COMP
    }
    {
      float acc[64];
#pragma unroll
      for (int e = 0; e < 64; ++e) acc[e] = 0.f;
      const unsigned char* vbase = p.PUP8 + i * 16;
      ROW_LOAD(b0, vbase, 0) ROW_LOAD(b1, vbase, 1) ROW_LOAD(b2, vbase, 2) ROW_LOAD(b3, vbase, 3)
      for (int e = 0; e < 128; e += 4) {
        axpy_row8(acc, b0, cc[e]);     if (e + 4 < 128) ROW_LOAD(b0, vbase, e + 4)
        axpy_row8(acc, b1, cc[e + 1]); if (e + 4 < 128) ROW_LOAD(b1, vbase, e + 5)
        axpy_row8(acc, b2, cc[e + 2]); if (e + 4 < 128) ROW_LOAD(b2, vbase, e + 6)
        axpy_row8(acc, b3, cc[e + 3]); if (e + 4 < 128) ROW_LOAD(b3, vbase, e + 7)
      }
      const int b = tok >> 13;
      const float* ga2 = p.mod + b * 6144 + 5120;
      const float* orow = p.out + (size_t)tok * DM; float* grow = p.gout + (size_t)tok * DM;
      float ss = 0.f;
#pragma unroll
      for (int j = 0; j < 4; ++j)
#pragma unroll
        for (int q4 = 0; q4 < 4; ++q4) {
          const int col = j * 256 + i * 16 + q4 * 4;
          float4 x1 = *(const float4*)(orow + col), gg = *(const float4*)(ga2 + col);
          float* q = acc + j * 16 + q4 * 4;
          q[0] = x1.x + gg.x * q[0]; q[1] = x1.y + gg.y * q[1]; q[2] = x1.z + gg.z * q[2]; q[3] = x1.w + gg.w * q[3];
          ss += q[0] * q[0] + q[1] * q[1] + q[2] * q[2] + q[3] * q[3];
        }
      ss = row16_sum(ss);
      const float rstd = rsqrtf(ss * (1.f / DM) + 1e-6f);
#pragma unroll
      for (int j = 0; j < 4; ++j)
#pragma unroll
        for (int q4 = 0; q4 < 4; ++q4) {
          const int col = j * 256 + i * 16 + q4 * 4;
          float4 gf = *(const float4*)(p.g_final + col);
          const float* q = acc + j * 16 + q4 * 4;
          *(float4*)(grow + col) = make_float4(q[0] * rstd * gf.x, q[1] * rstd * gf.y, q[2] * rstd * gf.z, q[3] * rstd * gf.w);
        }
    }
#undef ROW_LOAD
  }
  __syncthreads();
}
DI void convert_tables(const Params& p, int v) {
  const int lane = mytid() & 63, row = v * 8 + (mytid() >> 6);
  const int tb = row >> 14, rr = row & 16383;
  const float* src = (tb ? p.peer_up : p.peer_down) + (size_t)rr * DM;
  float4 x[4]; float am = 0.f;
#pragma unroll
  for (int q = 0; q < 4; ++q) {
    x[q] = *(const float4*)(src + q * 256 + lane * 4);
    am = fmaxf(am, fmaxf(fmaxf(fabsf(x[q].x), fabsf(x[q].y)), fmaxf(fabsf(x[q].z), fabsf(x[q].w))));
  }
  for (int o = 32; o; o >>= 1) am = fmaxf(am, __shfl_xor(am, o));
  const float sc = (am > 0.f) ? am * (1.f / 448.f) : 1.f, inv = (am > 0.f) ? 448.f / am : 1.f;
  unsigned* dst = (unsigned*)((tb ? p.PUP8 : p.PDN8) + (size_t)rr * DM);
#pragma unroll
  for (int q = 0; q < 4; ++q) {
    int wd = 0;
    wd = __builtin_amdgcn_cvt_pk_fp8_f32(x[q].x * inv, x[q].y * inv, wd, false);
    wd = __builtin_amdgcn_cvt_pk_fp8_f32(x[q].z * inv, x[q].w * inv, wd, true);
    dst[q * 64 + lane] = (unsigned)wd;
  }
  if (lane == 0) (tb ? p.SUP : p.SDN)[rr] = sc;
}

#define N_PHASES 11
template <int PH>
DI void run_phase(const Params& p, char* smem) {
  const int nb = gridDim.x, bid = blockIdx.x, tid = mytid();
  if (PH == 0) {
    for (int vb = bid; vb < PH0_NVB; vb += nb) ph0_body(p, vb, smem);
  } else if (PH == 1) {
    for (int vb = bid; vb < T_TOK / 8; vb += nb) rownorm_body(p.x, p.g_mix, p.mod, 0, 1024, p.RA, vb);
  } else if (PH == 2) {
    EpiProj e{p};
    for (int vb = bid; vb < 64 * 27; vb += nb) gemm_tile(p.RA, p.WinT, 1024, (vb & 63) * 256, (vb >> 6) * 128, smem, e);
  } else if (PH == 3) {
    for (int vb = bid; vb < 512 + 128 + 64; vb += nb) {
      if (vb < 512) retkv_mfma(p, vb);
      else if (vb < 512 + 128) compress_mfma(p, vb - 512, smem);
      else kmax_body2(p, vb - 640);
    }
  } else if (PH == 4) {
    for (int vb = bid; vb < 256 + 4; vb += nb) {
      if (vb < 256) scan_body(p, vb * NT + tid);
      else kcmax_body(p, (vb - 256) * NT + tid);
    }
  } else if (PH == 5) {
    for (int rep = 0; rep < (PROBE_DUP == 51 ? 2 : 1); ++rep)
      for (int vb = bid; vb < 256; vb += nb) retout_mfma(p, vb * 8 + (tid >> 6));
    for (int rep = 0; rep < (PROBE_DUP == 52 ? 2 : 1); ++rep)
      for (int vb = bid; vb < 512; vb += nb) nsa_item(p, (vb < 256) ? vb : 767 - vb, smem);
  } else if (PH == 6) {
    EpiOut e{p};
    for (int vb = bid; vb < 64 * 8; vb += nb) gemm_tile(p.RA, p.WoutT, 1024, (vb & 63) * 256, (vb >> 6) * 128, smem, e);
  } else if (PH == 7) {
    for (int vb = bid; vb < T_TOK / 8 + 4096; vb += nb) {
      if (vb < T_TOK / 8) rownorm_body(p.out, p.g_ffn, p.mod, 3072, 4096, p.RA, vb);
      else convert_tables(p, vb - T_TOK / 8);
    }
  } else if (PH == 8) {
    EpiPQ e{p};
    for (int vb = bid; vb < 64 * 16; vb += nb) gemm_tile(p.RA, p.WqT, 1024, (vb & 63) * 256, (vb >> 6) * 128, smem, e);
  } else if (PH == 9) {
    for (int vb = bid; vb < T_TOK / 16; vb += nb) peer_topk_tile(p, vb, smem);
  } else if (PH == 10) {
    for (int vb = bid; vb < T_TOK / 64; vb += nb) peer_gather_block(p, vb, smem);
  }
}


#define XB_TMO      128
#define XB_XCNT(j)  (256  + 64 * (j))
#define XB_XSUB(j)  (1280 + 64 * (j))
#define XB_XGEN(j)  (2304 + 64 * (j))
#define XB_TOP      3328
#define XB_TOPGEN   3392
#define XCD_BAR_WORDS 3456
#define XB_SPIN_CAP (1u << 22)
#define LAS __attribute__((address_space(3)))
DI unsigned xb_ld(unsigned* p) { return __hip_atomic_load(p, __ATOMIC_RELAXED, __HIP_MEMORY_SCOPE_AGENT); }
DI unsigned xb_add(unsigned* p, unsigned v) { return __hip_atomic_fetch_add(p, v, __ATOMIC_RELAXED, __HIP_MEMORY_SCOPE_AGENT); }
DI unsigned xb_xcc_id() { return (unsigned)__builtin_amdgcn_s_getreg((3 << 11) | 20) & 0xFu; }
#define XB_SPIN(cond, bar) do { unsigned _sp = 0; while (cond) { __builtin_amdgcn_s_sleep(1); \
    if ((++_sp & 255u) == 0u) { if (xb_ld(&(bar)[XB_TMO])) break; if (_sp > XB_SPIN_CAP) { atomicAdd(&(bar)[XB_TMO], 1u); break; } } } } while (0)
struct XcdBarrier { unsigned* bar; unsigned x; volatile LAS unsigned* st; };
DI XcdBarrier xcd_barrier_post(unsigned* bar, volatile LAS unsigned* st) {
  XcdBarrier b; b.bar = bar; b.x = xb_xcc_id(); b.st = st;
  if (threadIdx.x == 0) (void)xb_add(&bar[XB_XCNT(b.x)], 1u);
  return b;
}
DI void xcd_barrier_complete(unsigned* bar, unsigned x, unsigned& nloc, unsigned& nx) {
  const unsigned G = gridDim.x * gridDim.y * gridDim.z;
  unsigned sum, cnt, mine, sp = 0u;
  for (;;) {
    sum = 0u; cnt = 0u; mine = 0u;
#pragma unroll
    for (unsigned j = 0; j < 16; ++j) { const unsigned c = xb_ld(&bar[XB_XCNT(j)]); sum += c; cnt += (c > 0u) ? 1u : 0u; mine = (j == x) ? c : mine; }
    if (sum == G) break;
    __builtin_amdgcn_s_sleep(1);
    if ((++sp & 255u) == 0u) { if (xb_ld(&bar[XB_TMO])) break; if (sp > XB_SPIN_CAP) { atomicAdd(&bar[XB_TMO], 1u); break; } }
  }
  nloc = mine > 0u ? mine : 1u; nx = cnt > 0u ? cnt : 1u;
}
DI void xcd_barrier(const XcdBarrier& b) {
  asm volatile("s_waitcnt vmcnt(0)" ::: "memory");
  __syncthreads();
  if (threadIdx.x == 0) {
    unsigned* bar = b.bar;
    __builtin_amdgcn_s_waitcnt(0);
    unsigned nloc = b.st[0], nx = b.st[1];
    if (nloc == 0u) { xcd_barrier_complete(bar, b.x, nloc, nx); b.st[0] = nloc; b.st[1] = nx; }
    const unsigned old = xb_add(&bar[XB_XSUB(b.x)], 1u);
    const unsigned gen = old / nloc;
    if (old + 1u == (gen + 1u) * nloc) {
      __builtin_amdgcn_fence(__ATOMIC_RELEASE, "agent");
      asm volatile("s_waitcnt vmcnt(0)" ::: "memory");
      const unsigned og = xb_add(&bar[XB_TOP], 1u);
      const unsigned tg = og / nx;
      if (og + 1u == (tg + 1u) * nx) xb_add(&bar[XB_TOPGEN], 1u);
      else XB_SPIN(xb_ld(&bar[XB_TOPGEN]) == tg, bar);
      __builtin_amdgcn_fence(__ATOMIC_ACQUIRE, "agent");
      xb_add(&bar[XB_XGEN(b.x)], 1u);
      asm volatile("s_waitcnt vmcnt(0)" ::: "memory");
    } else {
      XB_SPIN(xb_ld(&bar[XB_XGEN(b.x)]) == gen, bar);
      __builtin_amdgcn_fence(__ATOMIC_ACQUIRE, "agent");
      asm volatile("s_waitcnt vmcnt(0)" ::: "memory");
    }
  }
  __syncthreads();
}

#define SMEM_BYTES 155648

template <int PH>
DI void phase_and_probe(const Params& p, char* smem, cg::grid_group& grid) {
  const int reps = (PROBE_DUP == PH) ? 2 : 1;
  for (int rep = 0; rep < reps; ++rep) {
    if (PH == 10 && rep + 1 < reps) { Params q = p; q.gout = (float*)p.PQ; run_phase<PH>(q, smem); }
    else run_phase<PH>(p, smem);
    if (rep + 1 < reps) grid.sync();
  }
}
__global__ void __launch_bounds__(NT) k_mega(Params p) {
  extern __shared__ __attribute__((aligned(16))) char smem[];
  __shared__ uint4 xb_words;
  cg::grid_group grid = cg::this_grid();
  if (threadIdx.x == 0) xb_words = make_uint4(0u, 0u, 0u, 0u);
  __syncthreads();
  XcdBarrier xb = xcd_barrier_post(p.xbar, (volatile LAS unsigned*)&xb_words);
  phase_and_probe<0>(p, smem, grid); grid.sync();
  phase_and_probe<1>(p, smem, grid); xcd_barrier(xb);
  phase_and_probe<2>(p, smem, grid); xcd_barrier(xb);
  phase_and_probe<3>(p, smem, grid); xcd_barrier(xb);
  phase_and_probe<4>(p, smem, grid); xcd_barrier(xb);
  phase_and_probe<5>(p, smem, grid); xcd_barrier(xb);
  phase_and_probe<6>(p, smem, grid); xcd_barrier(xb);
  phase_and_probe<7>(p, smem, grid); xcd_barrier(xb);
  phase_and_probe<8>(p, smem, grid); xcd_barrier(xb);
  phase_and_probe<9>(p, smem, grid); xcd_barrier(xb);
  phase_and_probe<10>(p, smem, grid);
}
#ifdef MK_MULTI
template <int PH>
__global__ void __launch_bounds__(NT) k_single(Params p) {
  extern __shared__ __attribute__((aligned(16))) char smem[];
  run_phase<PH>(p, smem);
}
#endif

static size_t carve(size_t& off, size_t bytes) { size_t o = off; off += (bytes + 255) & ~(size_t)255; return o; }

extern "C" void kernel_launch(void* const* d_in, const int* in_sizes, int n_in, void* d_out, int out_size, void* d_ws, size_t ws_size,
                              hipStream_t stream) {
  Params p{};
  p.x = (const float*)d_in[0]; p.c = (const float*)d_in[1]; p.w_ada = (const float*)d_in[2]; p.b_ada = (const float*)d_in[3];
  p.g_mix = (const float*)d_in[4]; p.w_in = (const float*)d_in[5]; p.pe_k = (const float*)d_in[6]; p.pe_v = (const float*)d_in[7];
  p.w_k1 = (const float*)d_in[8]; p.b_k1 = (const float*)d_in[9]; p.w_k2 = (const float*)d_in[10]; p.w_v1 = (const float*)d_in[11];
  p.b_v1 = (const float*)d_in[12]; p.w_v2 = (const float*)d_in[13]; p.w_out = (const float*)d_in[14]; p.g_ffn = (const float*)d_in[15];
  p.w_pq = (const float*)d_in[16]; p.subkeys = (const float*)d_in[17]; p.peer_down = (const float*)d_in[18]; p.peer_up = (const float*)d_in[19];
  p.g_final = (const float*)d_in[20];
  p.out = (float*)d_out; p.gout = p.out;
  char* ws = (char*)d_ws;
  size_t off = 0;
  p.mod = (float*)(ws + carve(off, 2 * 6144 * 4));
  p.ksmax = (unsigned*)(ws + carve(off, 256));
  p.xbar = (unsigned*)(ws + carve(off, XCD_BAR_WORDS * 4));
  p.c128 = (float*)(ws + carve(off, (size_t)SEQ * 64 * 4)); p.s128 = (float*)(ws + carve(off, (size_t)SEQ * 64 * 4));
  p.c64 = (float*)(ws + carve(off, (size_t)SEQ * 32 * 4)); p.s64 = (float*)(ws + carve(off, (size_t)SEQ * 32 * 4));
  p.WinT = (bf16_t*)(ws + carve(off, (size_t)NPROJ * 1024 * 2));
  p.WoutT = (bf16_t*)(ws + carve(off, (size_t)1024 * 1024 * 2));
  p.WqT = (bf16_t*)(ws + carve(off, (size_t)2048 * 1024 * 2));
  p.W1Tk = (bf16_t*)(ws + carve(off, (size_t)256 * 2048 * 2)); p.W1Tv = (bf16_t*)(ws + carve(off, (size_t)256 * 2048 * 2));
  p.W2Tk = (bf16_t*)(ws + carve(off, 64 * 256 * 2)); p.W2Tv = (bf16_t*)(ws + carve(off, 64 * 256 * 2));
  p.SUBK = (bf16_t*)(ws + carve(off, (size_t)16 * 128 * 128 * 2));
  p.B1Pk = (float*)(ws + carve(off, 1024)); p.B1Pv = (float*)(ws + carve(off, 1024));
  p.RA = (bf16_t*)(ws + carve(off, (size_t)T_TOK * 1024 * 2));
  size_t rb = off;
  p.RQ = (bf16_t*)(ws + carve(off, (size_t)T_TOK * 512 * 2)); p.RK = (bf16_t*)(ws + carve(off, (size_t)T_TOK * 512 * 2));
  p.RKT = (bf16_t*)(ws + carve(off, (size_t)T_TOK * 512 * 2)); p.RVT = (bf16_t*)(ws + carve(off, (size_t)T_TOK * 512 * 2));
  p.RGT = (bf16_t*)(ws + carve(off, (size_t)T_TOK * 512 * 2)); p.NQ = (bf16_t*)(ws + carve(off, (size_t)T_TOK * 512 * 2));
  p.NKC = (bf16_t*)(ws + carve(off, (size_t)T_TOK * 128 * 2)); p.NVC = (bf16_t*)(ws + carve(off, (size_t)T_TOK * 128 * 2));
  p.NKS = (bf16_t*)(ws + carve(off, (size_t)T_TOK * 128 * 2)); p.NKW = (bf16_t*)(ws + carve(off, (size_t)T_TOK * 128 * 2));
  p.NVST = (bf16_t*)(ws + carve(off, (size_t)T_TOK * 128 * 2)); p.NVWT = (bf16_t*)(ws + carve(off, (size_t)T_TOK * 128 * 2));
  p.GATE = (float*)(ws + carve(off, (size_t)T_TOK * 24 * 4));
  p.KV = (float*)(ws + carve(off, (size_t)512 * 16384 * 4));
  p.SPREV = (bf16_t*)(ws + carve(off, (size_t)512 * 16384 * 2));
  p.KC = (bf16_t*)(ws + carve(off, (size_t)4 * 512 * 64 * 2)); p.VCT = (bf16_t*)(ws + carve(off, (size_t)4 * 512 * 64 * 2));
  p.HID = (float*)(ws + carve(off, (size_t)2 * 2048 * 256 * 4));
  size_t off2 = rb;
  p.PQ = (bf16_t*)(ws + carve(off2, (size_t)T_TOK * 2048 * 2));
  p.EIDX = (int*)(ws + carve(off2, (size_t)T_TOK * 128 * 4));
  p.EW = (float*)(ws + carve(off2, (size_t)T_TOK * 128 * 4));
  p.PDN8 = (unsigned char*)(ws + carve(off2, (size_t)16384 * 1024));
  p.PUP8 = (unsigned char*)(ws + carve(off2, (size_t)16384 * 1024));
  p.SDN = (float*)(ws + carve(off2, 16384 * 4));
  p.SUP = (float*)(ws + carve(off2, 16384 * 4));
  (void)ws_size; (void)in_sizes; (void)n_in; (void)out_size;

#ifdef MK_MULTI
#define LAUNCH1(PH) { hipFuncSetAttribute((const void*)k_single<PH>, hipFuncAttributeMaxDynamicSharedMemorySize, SMEM_BYTES); k_single<PH><<<256, NT, SMEM_BYTES, stream>>>(p); }
  LAUNCH1(0) LAUNCH1(1) LAUNCH1(2) LAUNCH1(3) LAUNCH1(4) LAUNCH1(5) LAUNCH1(6) LAUNCH1(7) LAUNCH1(8) LAUNCH1(9) LAUNCH1(10)
#else
  static int grid_blocks = 0;
  if (!grid_blocks) {
    int dev = 0, cus = 0, per_cu = 0;
    (void)hipGetDevice(&dev);
    (void)hipDeviceGetAttribute(&cus, hipDeviceAttributeMultiprocessorCount, dev);
    (void)hipFuncSetAttribute((const void*)k_mega, hipFuncAttributeMaxDynamicSharedMemorySize, SMEM_BYTES);
    (void)hipOccupancyMaxActiveBlocksPerMultiprocessor(&per_cu, k_mega, NT, SMEM_BYTES);
    if (per_cu < 1) per_cu = 1;
    if (per_cu > 1) per_cu = 1;
    grid_blocks = cus * per_cu;
  }
  (void)hipMemsetAsync(p.xbar, 0, XCD_BAR_WORDS * 4, stream);
  void* args[] = {&p};
  hipError_t e = hipLaunchCooperativeKernel((void*)k_mega, dim3(grid_blocks), dim3(NT), args, SMEM_BYTES, stream);
  if (e != hipSuccess) fprintf(stderr, "cooperative launch failed: %s (grid %d)\n", hipGetErrorString(e), grid_blocks);
#endif
}
```

```cpp
#include <hip/hip_runtime.h>
#include <hip/hip_bf16.h>
#include <hip/hip_cooperative_groups.h>
#include <stdint.h>
#include <stdio.h>
namespace cg = cooperative_groups;

typedef unsigned short bf16_t;
#define DI __device__ __forceinline__

DI int mytid() { int t = threadIdx.x; asm volatile("" : "+v"(t)); return t; }
DI float bf2f(bf16_t v) { return __uint_as_float(((unsigned)v) << 16); }
DI bf16_t f2bf(float x) { unsigned u = __float_as_uint(x); u += 0x7fffu + ((u >> 16) & 1u); return (bf16_t)(u >> 16); }
DI float gelu_tanh(float x) { float u = 0.7978845608028654f * (x + 0.044715f * x * x * x); return 0.5f * x * (1.f + tanhf(u)); }
DI float siluf(float x) { return x / (1.f + __expf(-x)); }
DI float sigmoidf(float x) { return 1.f / (1.f + __expf(-x)); }

#define T_TOK 16384
#define SEQ 8192
#define DM 1024
#define NPROJ 3584
#define NEG_INF (-__builtin_inff())

struct Params {
  const float *x, *c, *w_ada, *b_ada, *g_mix, *w_in, *pe_k, *pe_v, *w_k1, *b_k1, *w_k2, *w_v1, *b_v1, *w_v2, *w_out, *g_ffn,
      *w_pq, *subkeys, *peer_down, *peer_up, *g_final;
  float* out;
  float* gout;
  float* mod;
  unsigned* ksmax;
  unsigned* xbar;
  float *c128, *s128, *c64, *s64;
  bf16_t *WinT, *WoutT, *WqT, *W1Tk, *W1Tv, *W2Tk, *W2Tv, *SUBK;
  float *B1Pk, *B1Pv;
  bf16_t* RA;
  bf16_t *RQ, *RK, *RKT, *RVT, *RGT, *NQ, *NKC, *NVC, *NKS, *NKW, *NVST, *NVWT;
  float* GATE;
  float* KV;
  bf16_t* SPREV;
  bf16_t *KC, *VCT;
  float* HID;
  bf16_t* PQ;
  int* EIDX;
  float* EW;
  unsigned char *PDN8, *PUP8;
  float *SDN, *SUP;
};

DI float logg_h(int h) { return log1pf(-exp2f(-5.f - (float)h)); }


typedef __bf16 bf16x2_t __attribute__((ext_vector_type(2)));
typedef float f32x2_t __attribute__((ext_vector_type(2)));
DI unsigned cvt2(float a, float b) { f32x2_t v = {a, b}; bf16x2_t r = __builtin_convertvector(v, bf16x2_t); return __builtin_bit_cast(unsigned, r); }
DI uint2 pack4(float a, float b, float c, float d) { uint2 r; r.x = cvt2(a, b); r.y = cvt2(c, d); return r; }
#define NT 512
#ifndef PROBE_DUP
#define PROBE_DUP -1
#endif
typedef short bf16x8 __attribute__((ext_vector_type(8)));
typedef float f32x16 __attribute__((ext_vector_type(16)));
#define MFMA32(a, b, c) __builtin_amdgcn_mfma_f32_32x32x16_bf16((a), (b), (c), 0, 0, 0)
DI f32x16 zero16() { f32x16 z; for (int e = 0; e < 16; ++e) z[e] = 0.f; return z; }
DI f32x16 fill16(float v) { f32x16 z; for (int e = 0; e < 16; ++e) z[e] = v; return z; }
DI float ex2(float x) { return __builtin_amdgcn_exp2f(x); }

DI int win_logical_col(int np) {
  int g = np >> 6, c = np & 63;
  if (g < 16) {
    int sec = g >> 3, hh = (g & 7) >> 1, j = g & 1, i = 32 * j + (c & 31);
    return sec * 512 + hh * 128 + ((c < 32) ? i : 64 + i);
  } else if (g < 52) return 1024 + (g - 16) * 64 + c;
  else if (g == 52) return (c < 24) ? 3328 + c : -1;
  return -1;
}

DI void tr_tile(const float* __restrict__ in, bf16_t* __restrict__ out, int K, int N_in, int k0, int n0, int mode, float* tile) {
  const int tid = mytid();
  {
    int nn = tid & 63, col = mode ? win_logical_col(n0 + nn) : (n0 + nn);
#pragma unroll
    for (int i = 0; i < 8; ++i) {
      int kk = (tid >> 6) + 8 * i;
      tile[kk * 65 + nn] = (col >= 0) ? in[(size_t)(k0 + kk) * N_in + col] : 0.f;
    }
  }
  __syncthreads();
  {
    int kk = tid & 63;
#pragma unroll
    for (int i = 0; i < 8; ++i) {
      int nn = (tid >> 6) + 8 * i;
      out[(size_t)(n0 + nn) * K + k0 + kk] = f2bf(tile[kk * 65 + nn]);
    }
  }
  __syncthreads();
}

#define PH0_MOD 96
#define PH0_WIN (PH0_MOD + 16 * 56)
#define PH0_WOUT (PH0_WIN + 256)
#define PH0_WQ (PH0_WOUT + 512)
#define PH0_W1K (PH0_WQ + 128)
#define PH0_W1V (PH0_W1K + 128)
#define PH0_W2K (PH0_W1V + 4)
#define PH0_W2V (PH0_W2K + 4)
#define PH0_SUBK (PH0_W2V + 512)
#define PH0_ROPE (PH0_SUBK + 1024)
#define PH0_B1P (PH0_ROPE + 8)
#define PH0_NVB PH0_B1P

DI void ph0_body(const Params& p, int vb, char* smem) {
  const int tid = mytid();
  float* fs = (float*)smem;
  if (vb < PH0_MOD) {
    int kg = tid >> 6, col = vb * 64 + (tid & 63);
    float a0 = 0.f, a1 = 0.f;
#pragma unroll 8
    for (int k = kg * 128; k < kg * 128 + 128; ++k) {
      float w = p.w_ada[(size_t)k * 6144 + col];
      a0 += siluf(p.c[k]) * w; a1 += siluf(p.c[DM + k]) * w;
    }
    fs[kg * 64 + (tid & 63)] = a0; fs[512 + kg * 64 + (tid & 63)] = a1;
    __syncthreads();
    if (tid < 128) {
      int b = tid >> 6, cc = tid & 63; float s = 0.f;
      for (int g = 0; g < 8; ++g) s += fs[b * 512 + g * 64 + cc];
      p.mod[b * 6144 + vb * 64 + cc] = s + p.b_ada[vb * 64 + cc];
    }
    __syncthreads();
    if (vb == 0 && tid < 12) p.ksmax[tid] = 0u;
  } else if (vb < PH0_WIN) { int t = vb - PH0_MOD; tr_tile(p.w_in, p.WinT, 1024, 3352, (t & 15) * 64, (t >> 4) * 64, 1, fs); }
  else if (vb < PH0_WOUT) { int t = vb - PH0_WIN; tr_tile(p.w_out, p.WoutT, 1024, 1024, (t & 15) * 64, (t >> 4) * 64, 0, fs); }
  else if (vb < PH0_WQ) { int t = vb - PH0_WOUT; tr_tile(p.w_pq, p.WqT, 1024, 2048, (t & 15) * 64, (t >> 4) * 64, 0, fs); }
  else if (vb < PH0_W1K) { int t = vb - PH0_WQ; tr_tile(p.w_k1, p.W1Tk, 2048, 256, (t & 31) * 64, (t >> 5) * 64, 0, fs); }
  else if (vb < PH0_W1V) { int t = vb - PH0_W1K; tr_tile(p.w_v1, p.W1Tv, 2048, 256, (t & 31) * 64, (t >> 5) * 64, 0, fs); }
  else if (vb < PH0_W2K) { int t = vb - PH0_W1V; tr_tile(p.w_k2, p.W2Tk, 256, 64, t * 64, 0, 0, fs); }
  else if (vb < PH0_W2V) { int t = vb - PH0_W2K; tr_tile(p.w_v2, p.W2Tv, 256, 64, t * 64, 0, 0, fs); }
  else if (vb < PH0_SUBK) { int i = (vb - PH0_W2V) * NT + tid; p.SUBK[i] = f2bf(p.subkeys[i]); }
  else if (vb < PH0_ROPE) {
    int idx = (vb - PH0_SUBK) * NT + tid;
    { int s = idx >> 6, i = idx & 63; float inv = powf(10000.f, -(float)(2 * i) / 128.f); float ang = (float)s * inv; p.c128[idx] = cosf(ang); p.s128[idx] = sinf(ang); }
    if (idx < SEQ * 32) { int s = idx >> 5, i = idx & 31; float inv = powf(10000.f, -(float)(2 * i) / 64.f); float ang = (float)s * inv; p.c64[idx] = cosf(ang); p.s64[idx] = sinf(ang); }
  } else {
    int t = vb - PH0_ROPE, kv = t >> 2, jb = t & 3;
    const float* w1 = kv ? p.w_v1 : p.w_k1; const float* pe = kv ? p.pe_v : p.pe_k; const float* b1 = kv ? p.b_v1 : p.b_k1;
    int fg = tid >> 6, j = jb * 64 + (tid & 63);
    float a = 0.f;
#pragma unroll 8
    for (int f = fg * 256; f < fg * 256 + 256; ++f) a += pe[f] * w1[(size_t)f * 256 + j];
    fs[fg * 64 + (tid & 63)] = a;
    __syncthreads();
    if (tid < 64) { float s = b1[j]; for (int g = 0; g < 8; ++g) s += fs[g * 64 + tid]; (kv ? p.B1Pv : p.B1Pk)[j] = s; }
    __syncthreads();
  }
}

DI void rownorm_body(const float* __restrict__ src, const float* __restrict__ g, const float* __restrict__ mod, int sh_off, int sc_off, bf16_t* __restrict__ dst, int vb) {
  int row = vb * 8 + (mytid() >> 6), lane = mytid() & 63;
  int b = row >> 13;
  const float* xr = src + (size_t)row * DM;
  float v[16]; float ss = 0.f;
#pragma unroll
  for (int i = 0; i < 4; ++i) {
    float4 t = *(const float4*)(xr + i * 256 + lane * 4);
    v[i * 4 + 0] = t.x; v[i * 4 + 1] = t.y; v[i * 4 + 2] = t.z; v[i * 4 + 3] = t.w;
    ss += t.x * t.x + t.y * t.y + t.z * t.z + t.w * t.w;
  }
  for (int o = 32; o; o >>= 1) ss += __shfl_xor(ss, o);
  float rstd = rsqrtf(ss * (1.f / DM) + 1e-6f);
  const float* sh = mod + b * 6144 + sh_off; const float* sc = mod + b * 6144 + sc_off;
#pragma unroll
  for (int i = 0; i < 4; ++i) {
    int col = i * 256 + lane * 4;
    float4 gg = *(const float4*)(g + col), s4 = *(const float4*)(sc + col), h4 = *(const float4*)(sh + col);
    float y0 = v[i * 4 + 0] * rstd * gg.x * (1.f + s4.x) + h4.x;
    float y1 = v[i * 4 + 1] * rstd * gg.y * (1.f + s4.y) + h4.y;
    float y2 = v[i * 4 + 2] * rstd * gg.z * (1.f + s4.z) + h4.z;
    float y3 = v[i * 4 + 3] * rstd * gg.w * (1.f + s4.w) + h4.w;
    *(uint2*)(dst + (size_t)row * DM + col) = pack4(y0, y1, y2, y3);
  }
}

#define G_A_BYTES (256 * 144)
#define G_B_BYTES (256 * 144)
#define G_BUF_BYTES (G_A_BYTES + G_B_BYTES)
template <class Epi>
DI void gemm_tile(const bf16_t* __restrict__ A, const bf16_t* __restrict__ Bt, int K, int m0, int n0, char* smem, const Epi& epi) {
  const int tid = mytid(), lane = tid & 63, w = tid >> 6, wm = w >> 2, wn = w & 3, r = lane & 31, h = lane >> 5;
  f32x16 acc[4][2];
#pragma unroll
  for (int i = 0; i < 4; ++i)
#pragma unroll
    for (int j = 0; j < 2; ++j) acc[i][j] = zero16();
  const int crow = tid >> 3, ckc = tid & 7;
  const bf16_t* ag = A + (size_t)(m0 + crow) * K + ckc * 8;
  const bf16_t* bg = Bt + (size_t)(n0 + crow) * K + ckc * 8;
  uint4 ra[4], rb[4];
#pragma unroll
  for (int i = 0; i < 4; ++i) { ra[i] = *(const uint4*)(ag + (size_t)i * 64 * K); rb[i] = *(const uint4*)(bg + (size_t)i * 64 * K); }
  char* lw = smem + crow * 144 + ckc * 16;
#pragma unroll
  for (int i = 0; i < 4; ++i) { *(uint4*)(lw + i * 64 * 144) = ra[i]; *(uint4*)(lw + G_A_BYTES + i * 64 * 144) = rb[i]; }
  __syncthreads();
  const int nk = K >> 6;
  for (int kt = 0; kt < nk; ++kt) {
    const int cur = kt & 1;
    if (kt + 1 < nk) {
      const int k0 = (kt + 1) * 64;
#pragma unroll
      for (int i = 0; i < 4; ++i) { ra[i] = *(const uint4*)(ag + (size_t)i * 64 * K + k0); rb[i] = *(const uint4*)(bg + (size_t)i * 64 * K + k0); }
    }
    const char* la = smem + cur * G_BUF_BYTES + (wm * 128 + r) * 144 + h * 16;
    const char* lb = smem + cur * G_BUF_BYTES + G_A_BYTES + (wn * 64 + r) * 144 + h * 16;
#pragma unroll
    for (int kk = 0; kk < 4; ++kk) {
      bf16x8 b0 = *(const bf16x8*)(lb + kk * 32), b1 = *(const bf16x8*)(lb + 32 * 144 + kk * 32);
#pragma unroll
      for (int i = 0; i < 4; ++i) {
        bf16x8 a = *(const bf16x8*)(la + i * 32 * 144 + kk * 32);
        acc[i][0] = MFMA32(a, b0, acc[i][0]); acc[i][1] = MFMA32(a, b1, acc[i][1]);
      }
    }
    if (kt + 1 < nk) {
      char* lw2 = lw + (cur ^ 1) * G_BUF_BYTES;
#pragma unroll
      for (int i = 0; i < 4; ++i) { *(uint4*)(lw2 + i * 64 * 144) = ra[i]; *(uint4*)(lw2 + G_A_BYTES + i * 64 * 144) = rb[i]; }
    }
    __syncthreads();
  }
  const int G = (n0 >> 6) + wn;
#pragma unroll
  for (int i = 0; i < 4; ++i) {
    float pre[4][8];
#pragma unroll
    for (int g = 0; g < 4; ++g) epi.prefetch(m0 + wm * 128 + i * 32 + 8 * g + 4 * h, G, r, pre[g]);
#pragma unroll
    for (int g = 0; g < 4; ++g) {
      float lo[4], hi[4];
#pragma unroll
      for (int e = 0; e < 4; ++e) { lo[e] = acc[i][0][4 * g + e]; hi[e] = acc[i][1][4 * g + e]; }
      epi(m0 + wm * 128 + i * 32 + 8 * g + 4 * h, G, r, lo, hi, pre[g]);
    }
  }
}

struct EpiProj {
  static constexpr bool kProbe = true;
  const Params& p;
  DI void prefetch(int t0, int G, int c, float (&pre)[8]) const {
    const int s0 = t0 & 8191;
    const bool r128 = G < 16, r64 = (G >= 32 && G < 40) || (G >= 40 && G < 52 && (((G - 40) >> 1) & 1) == 0);
    if (r128) {
      const int i = 32 * (G & 1) + c;
#pragma unroll
      for (int e = 0; e < 4; ++e) { pre[e] = p.c128[(s0 + e) * 64 + i]; pre[4 + e] = p.s128[(s0 + e) * 64 + i]; }
    } else if (r64) {
#pragma unroll
      for (int e = 0; e < 4; ++e) { pre[e] = p.c64[(s0 + e) * 32 + c]; pre[4 + e] = p.s64[(s0 + e) * 32 + c]; }
    } else {
#pragma unroll
      for (int e = 0; e < 8; ++e) pre[e] = 0.f;
    }
  }
  DI void operator()(int t0, int G, int c, const float (&lo)[4], const float (&hi)[4], const float (&pre)[8]) const {
    const int b = t0 >> 13, s0 = t0 & 8191;
    if (G < 16) {
      const int sec = G >> 3, hh = (G & 7) >> 1, j = G & 1, i = 32 * j + c;
      float o1[4], o2[4];
#pragma unroll
      for (int e = 0; e < 4; ++e) {
        float cs = pre[e], sn = pre[4 + e];
        o1[e] = lo[e] * cs - hi[e] * sn; o2[e] = hi[e] * cs + lo[e] * sn;
      }
      if (sec == 0) {
#pragma unroll
        for (int e = 0; e < 4; ++e) {
          p.RQ[(size_t)(t0 + e) * 512 + hh * 128 + i] = f2bf(o1[e]);
          p.RQ[(size_t)(t0 + e) * 512 + hh * 128 + 64 + i] = f2bf(o2[e]);
        }
      } else {
        const float sc = 0.08838834764831845f;
        const float lg = logg_h(hh);
#pragma unroll
        for (int e = 0; e < 4; ++e) {
          o1[e] *= sc; o2[e] *= sc;
          p.RK[(size_t)(t0 + e) * 512 + hh * 128 + i] = f2bf(o1[e]);
          p.RK[(size_t)(t0 + e) * 512 + hh * 128 + 64 + i] = f2bf(o2[e]);
          float zeta = __expf((float)(127 - ((s0 + e) & 127)) * lg);
          o1[e] *= zeta; o2[e] *= zeta;
        }
        *(uint2*)(p.RKT + ((size_t)(b * 4 + hh) * 128 + i) * SEQ + s0) = pack4(o1[0], o1[1], o1[2], o1[3]);
        *(uint2*)(p.RKT + ((size_t)(b * 4 + hh) * 128 + 64 + i) * SEQ + s0) = pack4(o2[0], o2[1], o2[2], o2[3]);
      }
    } else if (G < 24) {
      const int hh = (G - 16) >> 1, d = ((G - 16) & 1) * 64 + c;
      *(uint2*)(p.RVT + ((size_t)(b * 4 + hh) * 128 + d) * SEQ + s0) = pack4(lo[0], lo[1], lo[2], lo[3]);
      *(uint2*)(p.RVT + ((size_t)(b * 4 + hh) * 128 + d + 32) * SEQ + s0) = pack4(hi[0], hi[1], hi[2], hi[3]);
    } else if (G < 32) {
      const int hh = (G - 24) >> 1, d = ((G - 24) & 1) * 64 + c;
#pragma unroll
      for (int e = 0; e < 4; ++e) {
        p.RGT[(size_t)(t0 + e) * 512 + hh * 128 + d] = f2bf(siluf(lo[e]));
        p.RGT[(size_t)(t0 + e) * 512 + hh * 128 + d + 32] = f2bf(siluf(hi[e]));
      }
    } else if (G < 40) {
      const int head = G - 32;
#pragma unroll
      for (int e = 0; e < 4; ++e) {
        float cs = pre[e], sn = pre[4 + e];
        const float qs = 0.125f * 1.4426950408889634f;
        float o1 = (lo[e] * cs - hi[e] * sn) * qs, o2 = (hi[e] * cs + lo[e] * sn) * qs;
        p.NQ[(size_t)(t0 + e) * 512 + head * 64 + c] = f2bf(o1);
        p.NQ[(size_t)(t0 + e) * 512 + head * 64 + 32 + c] = f2bf(o2);
      }
    } else if (G < 52) {
      const int k = G - 40, kind = k >> 1, gg = k & 1;
      float o1[4], o2[4];
#pragma unroll
      for (int e = 0; e < 4; ++e) {
        o1[e] = lo[e]; o2[e] = hi[e];
        if ((kind & 1) == 0) {
          float cs = pre[e], sn = pre[4 + e];
          o1[e] = lo[e] * cs - hi[e] * sn; o2[e] = hi[e] * cs + lo[e] * sn;
        }
      }
      if (kind == 3 || kind == 5) {
        bf16_t* dst = (kind == 3 ? p.NVST : p.NVWT) + ((size_t)(b * 2 + gg) * 64 + c) * SEQ + s0;
        *(uint2*)dst = pack4(o1[0], o1[1], o1[2], o1[3]);
        *(uint2*)(dst + (size_t)32 * SEQ) = pack4(o2[0], o2[1], o2[2], o2[3]);
      } else {
        bf16_t* dst = (kind == 0 ? p.NKC : kind == 1 ? p.NVC : kind == 2 ? p.NKS : p.NKW);
#pragma unroll
        for (int e = 0; e < 4; ++e) {
          dst[(size_t)(t0 + e) * 128 + gg * 64 + c] = f2bf(o1[e]);
          dst[(size_t)(t0 + e) * 128 + gg * 64 + 32 + c] = f2bf(o2[e]);
        }
      }
    } else if (G == 52) {
      if (c < 24) {
#pragma unroll
        for (int e = 0; e < 4; ++e) p.GATE[(size_t)(t0 + e) * 24 + c] = sigmoidf(lo[e]);
      }
    }
  }
};
struct EpiOut {
  static constexpr bool kProbe = false;
  const Params& p;
  DI void prefetch(int t0, int G, int c, float (&pre)[8]) const {
    const int c0 = G * 64 + c;
#pragma unroll
    for (int e = 0; e < 4; ++e) { pre[e] = p.x[(size_t)(t0 + e) * DM + c0]; pre[4 + e] = p.x[(size_t)(t0 + e) * DM + c0 + 32]; }
  }
  DI void operator()(int t0, int G, int c, const float (&lo)[4], const float (&hi)[4], const float (&pre)[8]) const {
    const int b = t0 >> 13;
    const int c0 = G * 64 + c, c1 = c0 + 32;
    const float* ga1 = p.mod + b * 6144 + 2048;
    const float g0 = ga1[c0], g1 = ga1[c1];
#pragma unroll
    for (int e = 0; e < 4; ++e) {
      p.out[(size_t)(t0 + e) * DM + c0] = pre[e] + g0 * lo[e];
      p.out[(size_t)(t0 + e) * DM + c1] = pre[4 + e] + g1 * hi[e];
    }
  }
};
struct EpiPQ {
  static constexpr bool kProbe = false;
  const Params& p;
  DI void prefetch(int, int, int, float (&)[8]) const {}
  DI void operator()(int t0, int G, int c, const float (&lo)[4], const float (&hi)[4], const float (&)[8]) const {
#pragma unroll
    for (int e = 0; e < 4; ++e) {
      p.PQ[(size_t)(t0 + e) * 2048 + G * 64 + c] = f2bf(lo[e]);
      p.PQ[(size_t)(t0 + e) * 2048 + G * 64 + 32 + c] = f2bf(hi[e]);
    }
  }
};

DI int crow(int reg, int h) { return (reg & 3) + 8 * (reg >> 2) + 4 * h; }
DI bf16x8 ld16(const bf16_t* ptr) { return *(const bf16x8*)ptr; }
DI bf16x8 ld8x2(const bf16_t* ptr) {
  uint2 a = *(const uint2*)ptr, b = *(const uint2*)(ptr + 8);
  uint4 v; v.x = a.x; v.y = a.y; v.z = b.x; v.w = b.y;
  return __builtin_bit_cast(bf16x8, v);
}
DI bf16x8 pack8(float x0, float x1, float x2, float x3, float x4, float x5, float x6, float x7) {
  uint4 v; v.x = cvt2(x0, x1); v.y = cvt2(x2, x3); v.z = cvt2(x4, x5); v.w = cvt2(x6, x7);
  return __builtin_bit_cast(bf16x8, v);
}

DI void retkv_mfma(const Params& p, int item) {
  const int lane = mytid() & 63, w = mytid() >> 6, r = lane & 31, h = lane >> 5;
  const int hh = item & 3, c = (item >> 2) & 63, b = item >> 8, bh = b * 4 + hh, s0 = c * 128;
  const int mi = w >> 1, nb = (w & 1) * 2;
  const bf16_t* vb_ = p.RVT + ((size_t)(bh * 128 + 32 * mi + r)) * SEQ + s0 + 8 * h;
  const bf16_t* k0 = p.RKT + ((size_t)(bh * 128 + 32 * nb + r)) * SEQ + s0 + 8 * h;
  const bf16_t* k1 = k0 + (size_t)32 * SEQ;
  f32x16 a0 = zero16(), a1 = zero16();
#pragma unroll
  for (int s = 0; s < 8; ++s) {
    bf16x8 a = ld16(vb_ + 16 * s), b0 = ld16(k0 + 16 * s), b1 = ld16(k1 + 16 * s);
    a0 = MFMA32(a, b0, a0); a1 = MFMA32(a, b1, a1);
  }
  float* dst = p.KV + (size_t)item * 16384;
#pragma unroll
  for (int e = 0; e < 16; ++e) {
    const int v = 32 * mi + crow(e, h);
    dst[v * 128 + 32 * nb + r] = a0[e];
    dst[v * 128 + 32 * nb + 32 + r] = a1[e];
  }
}
DI void scan_body(const Params& p, int idx) {
  const int e = idx & 16383, bh = idx >> 14, b = bh >> 2, h = bh & 3;
  const float cd = __expf(128.f * logg_h(h));
  float S = 0.f;
  for (int c0 = 0; c0 < 64; c0 += 8) {
    float kv[8];
#pragma unroll
    for (int u = 0; u < 8; ++u) kv[u] = p.KV[(size_t)((b * 64 + c0 + u) * 4 + h) * 16384 + e];
#pragma unroll
    for (int u = 0; u < 8; ++u) {
      p.SPREV[(size_t)((b * 64 + c0 + u) * 4 + h) * 16384 + e] = f2bf(S);
      S = cd * S + kv[u];
    }
  }
}
DI void retout_mfma(const Params& p, int task) {
  const int lane = mytid() & 63, r = lane & 31, h = lane >> 5;
  const int item = task >> 2, nt = task & 3;
  const int hh = item & 3, c = (item >> 2) & 63, b = item >> 8, bh = b * 4 + hh, s0 = c * 128, t0 = b * SEQ + s0;
  const float lg = logg_h(hh);
  const int n = 32 * nt + r;
  bf16x8 qf[8];
#pragma unroll
  for (int s = 0; s < 8; ++s) qf[s] = ld16(p.RQ + (size_t)(t0 + n) * 512 + hh * 128 + 16 * s + 8 * h);
  f32x16 acc[4];
#pragma unroll
  for (int vi = 0; vi < 4; ++vi) {
    acc[vi] = zero16();
    const bf16_t* sp = p.SPREV + (size_t)item * 16384 + (size_t)(32 * vi + r) * 128 + 8 * h;
#pragma unroll
    for (int s = 0; s < 8; ++s) acc[vi] = MFMA32(ld16(sp + 16 * s), qf[s], acc[vi]);
    __builtin_amdgcn_sched_barrier(0);
  }
  {
    const float xi = __expf((float)(n + 1) * lg);
#pragma unroll
    for (int vi = 0; vi < 4; ++vi)
#pragma unroll
      for (int e = 0; e < 16; ++e) acc[vi][e] *= xi;
  }
  for (int mt = 0; mt <= nt; ++mt) {
    f32x16 sa = zero16();
    const bf16_t* kp = p.RK + (size_t)(t0 + 32 * mt + r) * 512 + hh * 128 + 8 * h;
#pragma unroll
    for (int s = 0; s < 8; ++s) sa = MFMA32(ld16(kp + 16 * s), qf[s], sa);
    float pv[16];
#pragma unroll
    for (int e = 0; e < 16; ++e) {
      const int dm = n - (32 * mt + crow(e, h));
      pv[e] = (dm >= 0) ? sa[e] * __expf((float)dm * lg) : 0.f;
    }
#pragma unroll
    for (int s2 = 0; s2 < 2; ++s2) {
      bf16x8 bfr = pack8(pv[8 * s2], pv[8 * s2 + 1], pv[8 * s2 + 2], pv[8 * s2 + 3], pv[8 * s2 + 4], pv[8 * s2 + 5], pv[8 * s2 + 6], pv[8 * s2 + 7]);
#pragma unroll
      for (int vi = 0; vi < 4; ++vi) {
        bf16x8 afr = ld8x2(p.RVT + ((size_t)(bh * 128 + 32 * vi + r)) * SEQ + s0 + 32 * mt + 16 * s2 + 4 * h);
        acc[vi] = MFMA32(afr, bfr, acc[vi]);
      }
      __builtin_amdgcn_sched_barrier(0);
    }
  }
  float sum = 0.f;
#pragma unroll
  for (int vi = 0; vi < 4; ++vi)
#pragma unroll
    for (int e = 0; e < 16; ++e) sum += acc[vi][e];
  sum += __shfl_xor(sum, 32);
  const float mu = sum * (1.f / 128.f);
  float var = 0.f;
#pragma unroll
  for (int vi = 0; vi < 4; ++vi)
#pragma unroll
    for (int e = 0; e < 16; ++e) { float d = acc[vi][e] - mu; var += d * d; }
  var += __shfl_xor(var, 32);
  const float rs = rsqrtf(var * (1.f / 128.f) + 1e-6f);
#pragma unroll
  for (int vi = 0; vi < 4; ++vi)
#pragma unroll
    for (int g4 = 0; g4 < 4; ++g4) {
      const int v0 = 32 * vi + 8 * g4 + 4 * h;
      uint2 gt = *(const uint2*)(p.RGT + (size_t)(t0 + n) * 512 + hh * 128 + v0);
      float y0 = (acc[vi][4 * g4 + 0] - mu) * rs * __uint_as_float(gt.x << 16);
      float y1 = (acc[vi][4 * g4 + 1] - mu) * rs * __uint_as_float(gt.x & 0xffff0000u);
      float y2 = (acc[vi][4 * g4 + 2] - mu) * rs * __uint_as_float(gt.y << 16);
      float y3 = (acc[vi][4 * g4 + 3] - mu) * rs * __uint_as_float(gt.y & 0xffff0000u);
      *(uint2*)(p.RA + (size_t)(t0 + n) * DM + hh * 128 + v0) = pack4(y0, y1, y2, y3);
    }
}
#define HID_STRIDE 264
DI void compress_mfma(const Params& p, int item, char* smem) {
  bf16_t* HIDL = (bf16_t*)smem;
  const int lane = mytid() & 63, w = mytid() >> 6, r = lane & 31, h = lane >> 5;
  const int kv = item >> 6, bg = (item >> 4) & 3, rt = item & 15, n0 = rt * 32, b = bg >> 1, g = bg & 1;
  const bf16_t* src = kv ? p.NVC : p.NKC; const bf16_t* W1 = kv ? p.W1Tv : p.W1Tk; const bf16_t* W2 = kv ? p.W2Tv : p.W2Tk;
  const float* B1 = kv ? p.B1Pv : p.B1Pk;
  {
    const int n = min(n0 + r, 510);
    const bf16_t* ab = src + ((size_t)(b * SEQ + 16 * n)) * 128 + g * 64 + 8 * h;
    const bf16_t* bb = W1 + (size_t)(32 * w + r) * 2048 + 8 * h;
    f32x16 acc = zero16();
#pragma unroll 8
    for (int s = 0; s < 128; ++s) acc = MFMA32(ld16(ab + (s >> 2) * 128 + (s & 3) * 16), ld16(bb + 16 * s), acc);
    const float bias = B1[32 * w + r];
#pragma unroll
    for (int e = 0; e < 16; ++e) HIDL[crow(e, h) * HID_STRIDE + 32 * w + r] = f2bf(gelu_tanh(acc[e] + bias));
  }
  __syncthreads();
  if (w < 2) {
    f32x16 acc = zero16();
#pragma unroll
    for (int s = 0; s < 16; ++s) acc = MFMA32(ld16(HIDL + r * HID_STRIDE + 16 * s + 8 * h), ld16(W2 + (size_t)(32 * w + r) * 256 + 16 * s + 8 * h), acc);
    const int e_ = 32 * w + r;
    if (kv == 0) {
#pragma unroll
      for (int e = 0; e < 16; ++e) { const int n = n0 + crow(e, h); p.KC[((size_t)bg * 512 + n) * 64 + e_] = (n < 511) ? f2bf(acc[e]) : (bf16_t)0; }
    } else {
#pragma unroll
      for (int g4 = 0; g4 < 4; ++g4) {
        const int n = n0 + 8 * g4 + 4 * h;
        float v3 = (n + 3 < 511) ? acc[4 * g4 + 3] : 0.f;
        *(uint2*)(p.VCT + ((size_t)bg * 64 + e_) * 512 + n) = pack4(acc[4 * g4], acc[4 * g4 + 1], acc[4 * g4 + 2], v3);
      }
    }
  }
  __syncthreads();
}
DI void kmax_body2(const Params& p, int vb) {
  const int tid = mytid(), g = tid & 1, t = vb * 256 + (tid >> 1), b = t >> 13;
  const bf16_t* k = p.NKS + (size_t)t * 128 + g * 64; const bf16_t* kw = p.NKW + (size_t)t * 128 + g * 64;
  float ss = 0.f, sw = 0.f;
  for (int d = 0; d < 64; d += 8) {
    uint4 a = *(const uint4*)(k + d), c = *(const uint4*)(kw + d);
    const unsigned aa[4] = {a.x, a.y, a.z, a.w}, cc[4] = {c.x, c.y, c.z, c.w};
#pragma unroll
    for (int q = 0; q < 4; ++q) {
      float x0 = __uint_as_float(aa[q] << 16), x1 = __uint_as_float(aa[q] & 0xffff0000u);
      float y0 = __uint_as_float(cc[q] << 16), y1 = __uint_as_float(cc[q] & 0xffff0000u);
      ss += x0 * x0 + x1 * x1; sw += y0 * y0 + y1 * y1;
    }
  }
  float m1 = sqrtf(ss), m2 = sqrtf(sw);
  for (int o = 2; o < 64; o <<= 1) { m1 = fmaxf(m1, __shfl_xor(m1, o)); m2 = fmaxf(m2, __shfl_xor(m2, o)); }
  if ((tid & 63) < 2) { atomicMax(&p.ksmax[b * 2 + g], __float_as_uint(m1)); atomicMax(&p.ksmax[4 + b * 2 + g], __float_as_uint(m2)); }
}
DI void kcmax_body(const Params& p, int idx) {
  const bf16_t* k = p.KC + (size_t)idx * 64;
  float ss = 0.f;
  for (int d = 0; d < 64; ++d) { float v = bf2f(k[d]); ss += v * v; }
  atomicMax(&p.ksmax[8 + (idx >> 9)], __float_as_uint(sqrtf(ss)));
}

#define NSA_IMP 0
#define NSA_SELM 65536
#define NSA_KV 66560
#define KV_ROW 144
#define KV_TILE (64 * KV_ROW)
template <int CTRL> DI float dpp_f2(float x) { return __builtin_bit_cast(float, __builtin_amdgcn_mov_dpp(__builtin_bit_cast(int, x), CTRL, 0xf, 0xf, true)); }
DI float quad_sum(float v) { v += dpp_f2<0xB1>(v); v += dpp_f2<0x4E>(v); return v; }
DI bf16x8 lds8x2(const char* ptr) {
  uint2 a = *(const uint2*)ptr, b = *(const uint2*)(ptr + 16);
  uint4 v; v.x = a.x; v.y = a.y; v.z = b.x; v.w = b.y;
  return __builtin_bit_cast(bf16x8, v);
}

DI void nsa_item(const Params& p, int item, char* smem) {
  const int tid = mytid(), lane = tid & 63, w = tid >> 6, r = lane & 31, h = lane >> 5;
  const int ti = item >> 2, bg = item & 3, b = bg >> 1, g = bg & 1;
  const int ts = ti * 64, tokg0 = b * SEQ + ts;
  const int tkl = 8 * w + (r >> 2), hl = r & 3, hd = g * 4 + hl, tpos = ts + tkl;
  float* IMPA = (float*)(smem + NSA_IMP); float* IMPB = IMPA + 64 * 128;
  unsigned* SELM = (unsigned*)(smem + NSA_SELM);
  char* KVB = smem + NSA_KV;
  const float ksm = __uint_as_float(p.ksmax[bg]), kwm = __uint_as_float(p.ksmax[4 + bg]), kcm = __uint_as_float(p.ksmax[8 + bg]);

  bf16x8 qf[4];
#pragma unroll
  for (int s = 0; s < 4; ++s) qf[s] = ld16(p.NQ + (size_t)(tokg0 + tkl) * 512 + hd * 64 + 16 * s + 8 * h);
  float qq = 0.f;
#pragma unroll
  for (int s = 0; s < 4; ++s) {
    uint4 u = __builtin_bit_cast(uint4, qf[s]);
    const unsigned uu[4] = {u.x, u.y, u.z, u.w};
#pragma unroll
    for (int q = 0; q < 4; ++q) { float x0 = __uint_as_float(uu[q] << 16), x1 = __uint_as_float(uu[q] & 0xffff0000u); qq += x0 * x0 + x1 * x1; }
  }
  qq += __shfl_xor(qq, 32);
  const float qn = sqrtf(qq);
  const int srow = tid >> 3, sch = tid & 7;
  const bf16_t* ksrc = p.NKS + ((size_t)(b * SEQ) + srow) * 128 + g * 64 + sch * 8;
  const bf16_t* vsrc = p.NVST + ((size_t)bg * 64 + srow) * SEQ + sch * 8;
  char* sdst = KVB + srow * KV_ROW + sch * 16;
  {
    uint4 k0 = *(const uint4*)ksrc, v0 = *(const uint4*)vsrc;
    *(uint4*)sdst = k0; *(uint4*)(sdst + KV_TILE) = v0;
  }
  for (int q = tid; q < 64 * 128 * 2 / 4; q += NT) ((float4*)IMPA)[q] = make_float4(0.f, 0.f, 0.f, 0.f);
  __syncthreads();

  const float mbc = qn * kcm;
  int nvalid = (tpos >= 31) ? ((tpos - 31) >> 4) + 1 : 0;
  if (nvalid > 511) nvalid = 511;
  int nvw = (ts + 8 * w + 7 >= 31) ? ((ts + 8 * w + 7 - 31) >> 4) + 1 : 0;
  if (nvw > 511) nvw = 511;
  const int nkt = (nvw + 31) >> 5;
  int nvmin = (ts + 8 * w >= 31) ? ((ts + 8 * w - 31) >> 4) + 1 : 0;
  if (nvmin > 511) nvmin = 511;
  const bf16_t* kcb = p.KC + ((size_t)bg * 512 + r) * 64 + 8 * h;
  float lsum = 0.f, invl = 0.f;
  for (int rep521 = 0; rep521 < (PROBE_DUP == 521 ? 2 : 1); ++rep521) {
  lsum = 0.f;
  for (int kt = 0; kt < nkt; ++kt) {
    f32x16 sa = fill16(-mbc);
#pragma unroll
    for (int s = 0; s < 4; ++s) sa = MFMA32(ld16(kcb + (size_t)kt * 32 * 64 + 16 * s), qf[s], sa);
    if (32 * kt + 32 <= nvmin) {
#pragma unroll
      for (int e = 0; e < 16; ++e) lsum += ex2(sa[e]);
    } else {
#pragma unroll
      for (int e = 0; e < 16; ++e) { const int n = 32 * kt + crow(e, h); lsum += (n < nvalid) ? ex2(sa[e]) : 0.f; }
    }
  }
  lsum += __shfl_xor(lsum, 32);
  invl = (lsum > 0.f) ? 1.f / lsum : 0.f;
  for (int kt = 0; kt < nkt; ++kt) {
    f32x16 sa = fill16(-mbc);
#pragma unroll
    for (int s = 0; s < 4; ++s) sa = MFMA32(ld16(kcb + (size_t)kt * 32 * 64 + 16 * s), qf[s], sa);
    float pv[16];
    if (32 * kt + 32 <= nvmin) {
#pragma unroll
      for (int e = 0; e < 16; ++e) pv[e] = ex2(sa[e]) * invl;
    } else {
#pragma unroll
      for (int e = 0; e < 16; ++e) { const int n = 32 * kt + crow(e, h); pv[e] = (n < nvalid) ? ex2(sa[e]) * invl : 0.f; }
    }
#pragma unroll
    for (int q = 0; q < 4; ++q) {
      float A = 2.f * (pv[4 * q] + pv[4 * q + 1] + pv[4 * q + 2]) + pv[4 * q + 3], Bv = pv[4 * q + 3];
      A = quad_sum(A); Bv = quad_sum(Bv);
      if (hl == 0) { const int j = 8 * kt + 2 * q + h; IMPA[tkl * 128 + j] = A; IMPB[tkl * 128 + j] = Bv; }
    }
  }
  }
  for (int rep522 = 0; rep522 < (PROBE_DUP == 522 ? 2 : 1); ++rep522)
  {
    const int tl = 8 * w + (lane >> 3), sub = lane & 7;
    unsigned kv_[16], ki_[16];
#pragma unroll
    for (int c = 0; c < 16; ++c) {
      const int j = sub + 8 * c;
      float imp = IMPA[tl * 128 + j] + ((j > 0) ? IMPB[tl * 128 + j - 1] : 0.f);
      if (j == 0 || j == ti || j == ti - 1) imp = 1e9f;
      kv_[c] = (j <= ti) ? __float_as_uint(imp) : 0u;
      ki_[c] = (j <= ti) ? (unsigned)(128 - j) : 0u;
    }
    unsigned m0 = 0, m1 = 0, m2 = 0, m3 = 0;
    for (int it = 0; it < 16; ++it) {
      unsigned bv = kv_[0], bi = ki_[0];
#pragma unroll
      for (int c = 1; c < 16; ++c) { const bool gt = (kv_[c] > bv) || (kv_[c] == bv && ki_[c] > bi); bv = gt ? kv_[c] : bv; bi = gt ? ki_[c] : bi; }
#define TOPK_STEP(CTRL) { const unsigned ov = (unsigned)__builtin_amdgcn_mov_dpp((int)bv, CTRL, 0xf, 0xf, true), oi = (unsigned)__builtin_amdgcn_mov_dpp((int)bi, CTRL, 0xf, 0xf, true); \
        const bool gt = (ov > bv) || (ov == bv && oi > bi); bv = gt ? ov : bv; bi = gt ? oi : bi; }
      TOPK_STEP(0xB1) TOPK_STEP(0x4E) TOPK_STEP(0x141)
#undef TOPK_STEP
      if (bi != 0u) {
        const int js = 128 - (int)bi;
        const unsigned bit = 1u << (js & 31);
        if ((js >> 5) == 0) m0 |= bit; else if ((js >> 5) == 1) m1 |= bit; else if ((js >> 5) == 2) m2 |= bit; else m3 |= bit;
#pragma unroll
        for (int c = 0; c < 16; ++c) { const bool hit = (ki_[c] == bi); kv_[c] = hit ? 0u : kv_[c]; ki_[c] = hit ? 0u : ki_[c]; }
      }
    }
    if (sub == 0) { SELM[tl * 4 + 0] = m0; SELM[tl * 4 + 1] = m1; SELM[tl * 4 + 2] = m2; SELM[tl * 4 + 3] = m3; }
  }
  unsigned mm[4], wv[4];
#pragma unroll
  for (int q = 0; q < 4; ++q) {
    mm[q] = SELM[tkl * 4 + q];
    unsigned u = 0;
#pragma unroll
    for (int t8 = 0; t8 < 8; ++t8) u |= SELM[(8 * w + t8) * 4 + q];
    wv[q] = u;
  }
  const float mbs = qn * ksm;
  f32x16 osl[2]; osl[0] = zero16(); osl[1] = zero16();
  float lsel = 0.f;
  {
    uint4 kn0, kn1, kn2, kn3, vn0, vn1, vn2, vn3;
    kn0 = kn1 = kn2 = kn3 = vn0 = vn1 = vn2 = vn3 = make_uint4(0u, 0u, 0u, 0u);
    if (1 <= ti) { kn1 = *(const uint4*)(ksrc + (size_t)1 * 64 * 128); vn1 = *(const uint4*)(vsrc + 1 * 64); }
    if (2 <= ti) { kn2 = *(const uint4*)(ksrc + (size_t)2 * 64 * 128); vn2 = *(const uint4*)(vsrc + 2 * 64); }
    if (3 <= ti) { kn3 = *(const uint4*)(ksrc + (size_t)3 * 64 * 128); vn3 = *(const uint4*)(vsrc + 3 * 64); }
#define SEL_STEP(U, KCUR, VCUR, KNXT, VNXT)                                                                                                 \
    {                                                                                                                                       \
      const int j = j0 + U;                                                                                                                 \
      if (j <= ti) {                                                                                                                        \
        if (j + 4 <= ti) { KCUR = *(const uint4*)(ksrc + (size_t)(j + 4) * 64 * 128); VCUR = *(const uint4*)(vsrc + (j + 4) * 64); }          \
        const unsigned wsel = (j < 32) ? wv[0] : (j < 64) ? wv[1] : (j < 96) ? wv[2] : wv[3];                                               \
        if ((wsel >> (j & 31)) & 1u) {                                                                                                      \
          const char* kb = KVB + (j & 1) * 2 * KV_TILE;                                                                                     \
          const char* vbuf = kb + KV_TILE;                                                                                                  \
          const unsigned msel = (j < 32) ? mm[0] : (j < 64) ? mm[1] : (j < 96) ? mm[2] : mm[3];                                             \
          const unsigned csel = (msel >> (j & 31)) & 1u;                                                                                    \
          bf16x8 pk[2][2];                                                                                                                  \
          _Pragma("unroll") for (int kh = 0; kh < 2; ++kh) {                                                                                \
            f32x16 sa = fill16(csel ? -mbs : NEG_INF);                                                                                      \
            _Pragma("unroll") for (int s = 0; s < 4; ++s) sa = MFMA32(*(const bf16x8*)(kb + (32 * kh + r) * KV_ROW + (16 * s + 8 * h) * 2), qf[s], sa); \
            float pv[16];                                                                                                                   \
            if (j < ti) {                                                                                                                   \
              _Pragma("unroll") for (int e = 0; e < 16; ++e) { pv[e] = ex2(sa[e]); lsel += pv[e]; }                                         \
            } else {                                                                                                                        \
              _Pragma("unroll") for (int e = 0; e < 16; ++e) { const int key = 32 * kh + crow(e, h); pv[e] = (key <= tkl) ? ex2(sa[e]) : 0.f; lsel += pv[e]; } \
            }                                                                                                                               \
            pk[kh][0] = pack8(pv[0], pv[1], pv[2], pv[3], pv[4], pv[5], pv[6], pv[7]);                                                      \
            pk[kh][1] = pack8(pv[8], pv[9], pv[10], pv[11], pv[12], pv[13], pv[14], pv[15]);                                                \
          }                                                                                                                                 \
          _Pragma("unroll") for (int di = 0; di < 2; ++di)                                                                                  \
            _Pragma("unroll") for (int kh = 0; kh < 2; ++kh)                                                                                \
              _Pragma("unroll") for (int s2 = 0; s2 < 2; ++s2)                                                                              \
                osl[di] = MFMA32(lds8x2(vbuf + (32 * di + r) * KV_ROW + (32 * kh + 16 * s2 + 4 * h) * 2), pk[kh][s2], osl[di]);             \
        }                                                                                                                                   \
        if (j < ti) { char* d2 = sdst + ((j + 1) & 1) * 2 * KV_TILE; *(uint4*)d2 = KNXT; *(uint4*)(d2 + KV_TILE) = VNXT; }                  \
        __syncthreads();                                                                                                                    \
      }                                                                                                                                     \
    }
    for (int j0 = 0; j0 <= ti; j0 += 4) {
      SEL_STEP(0, kn0, vn0, kn1, vn1)
      SEL_STEP(1, kn1, vn1, kn2, vn2)
      SEL_STEP(2, kn2, vn2, kn3, vn3)
      SEL_STEP(3, kn3, vn3, kn0, vn0)
    }
#undef SEL_STEP
  }
  lsel += __shfl_xor(lsel, 32);
  f32x16 oc[2]; oc[0] = zero16(); oc[1] = zero16();
  f32x16 ow[2]; ow[0] = zero16(); ow[1] = zero16();
  float lw = 0.f;
  const float mbw = qn * kwm;
  for (int rep524 = 0; rep524 < (PROBE_DUP == 524 ? 2 : 1); ++rep524) {
  for (int kt = 0; kt < nkt; ++kt) {
    f32x16 sa = fill16(-mbc);
#pragma unroll
    for (int s = 0; s < 4; ++s) sa = MFMA32(ld16(kcb + (size_t)kt * 32 * 64 + 16 * s), qf[s], sa);
    float pv[16];
    if (32 * kt + 32 <= nvmin) {
#pragma unroll
      for (int e = 0; e < 16; ++e) pv[e] = ex2(sa[e]) * invl;
    } else {
#pragma unroll
      for (int e = 0; e < 16; ++e) { const int n = 32 * kt + crow(e, h); pv[e] = (n < nvalid) ? ex2(sa[e]) * invl : 0.f; }
    }
#pragma unroll
    for (int s2 = 0; s2 < 2; ++s2) {
      bf16x8 bfr = pack8(pv[8 * s2], pv[8 * s2 + 1], pv[8 * s2 + 2], pv[8 * s2 + 3], pv[8 * s2 + 4], pv[8 * s2 + 5], pv[8 * s2 + 6], pv[8 * s2 + 7]);
#pragma unroll
      for (int di = 0; di < 2; ++di) oc[di] = MFMA32(ld8x2(p.VCT + ((size_t)bg * 64 + 32 * di + r) * 512 + 32 * kt + 16 * s2 + 4 * h), bfr, oc[di]);
    }
  }
  {
    int lo = ts + 8 * w - 511; if (lo < 0) lo = 0;
    const int kt0 = lo >> 5, kt1 = (ts + 8 * w + 7) >> 5;
    for (int kt = kt0; kt <= kt1; ++kt) {
      f32x16 sa = fill16(-mbw);
      const bf16_t* kp = p.NKW + ((size_t)(b * SEQ + 32 * kt + r)) * 128 + g * 64 + 8 * h;
#pragma unroll
      for (int s = 0; s < 4; ++s) sa = MFMA32(ld16(kp + 16 * s), qf[s], sa);
      float pv[16];
      if (32 * kt + 31 <= ts + 8 * w && 32 * kt > ts + 8 * w + 7 - 512) {
#pragma unroll
        for (int e = 0; e < 16; ++e) { pv[e] = ex2(sa[e]); lw += pv[e]; }
      } else {
#pragma unroll
        for (int e = 0; e < 16; ++e) {
          const int pos = 32 * kt + crow(e, h);
          const bool ok = (pos <= tpos) && (pos > tpos - 512);
          pv[e] = ok ? ex2(sa[e]) : 0.f; lw += pv[e];
        }
      }
#pragma unroll
      for (int s2 = 0; s2 < 2; ++s2) {
        bf16x8 bfr = pack8(pv[8 * s2], pv[8 * s2 + 1], pv[8 * s2 + 2], pv[8 * s2 + 3], pv[8 * s2 + 4], pv[8 * s2 + 5], pv[8 * s2 + 6], pv[8 * s2 + 7]);
#pragma unroll
        for (int di = 0; di < 2; ++di) ow[di] = MFMA32(ld8x2(p.NVWT + ((size_t)bg * 64 + 32 * di + r) * SEQ + 32 * kt + 16 * s2 + 4 * h), bfr, ow[di]);
      }
    }
  }
  }
  lw += __shfl_xor(lw, 32);
  if (PROBE_DUP == 524) { for (int e = 0; e < 16; ++e) { oc[0][e] *= 0.5f; oc[1][e] *= 0.5f; } }
  {
    const float invs = 1.f / lsel, invw = 1.f / lw;
    const float* gt = p.GATE + (size_t)(tokg0 + tkl) * 24 + hd * 3;
    const float g0 = gt[0], g1 = gt[1] * invs, g2 = gt[2] * invw;
#pragma unroll
    for (int di = 0; di < 2; ++di)
#pragma unroll
      for (int g4 = 0; g4 < 4; ++g4) {
        const int d0 = 32 * di + 8 * g4 + 4 * h;
        float y[4];
#pragma unroll
        for (int e = 0; e < 4; ++e) y[e] = g0 * oc[di][4 * g4 + e] + g1 * osl[di][4 * g4 + e] + g2 * ow[di][4 * g4 + e];
        *(uint2*)(p.RA + (size_t)(tokg0 + tkl) * DM + 512 + hd * 64 + d0) = pack4(y[0], y[1], y[2], y[3]);
      }
  }
}

typedef float f32x4 __attribute__((ext_vector_type(4)));
#define MFMA16(a, b, c) __builtin_amdgcn_mfma_f32_16x16x32_bf16((a), (b), (c), 0, 0, 0)
constexpr int pk_clen(int i) { return 16 / (i + 1); }
constexpr int pk_coff(int i) { int s = 0; for (int q = 0; q < i; ++q) s += pk_clen(q); return s; }
#define SC_STRIDE 132

DI void peer_topk_tile(const Params& p, int vb, char* smem) {
  float* SC = (float*)smem;
  unsigned* ELK = (unsigned*)(smem + 256 * SC_STRIDE * 4);
  float* ELW = (float*)(ELK + 16 * 128);
  const int tid = mytid(), lane = tid & 63, w = tid >> 6;
  const int t0 = vb * 16;
  {
    const int tq = lane & 15, kq = lane >> 4;
#pragma unroll
    for (int pi = 0; pi < 2; ++pi) {
      const int ph = 2 * w + pi;
      bf16x8 bfr[4];
#pragma unroll
      for (int s = 0; s < 4; ++s) bfr[s] = *(const bf16x8*)(p.PQ + (size_t)(t0 + tq) * 2048 + ph * 128 + 32 * s + 8 * kq);
#pragma unroll
      for (int j = 0; j < 8; ++j) {
        f32x4 acc = {0.f, 0.f, 0.f, 0.f};
#pragma unroll
        for (int s = 0; s < 4; ++s) {
          bf16x8 afr = *(const bf16x8*)(p.SUBK + ((size_t)(ph * 128 + 16 * j + tq)) * 128 + 32 * s + 8 * kq);
          acc = MFMA16(afr, bfr[s], acc);
        }
        *(f32x4*)(SC + (ph * 16 + tq) * SC_STRIDE + 16 * j + 4 * kq) = acc;
      }
    }
  }
  __syncthreads();
  if (tid < 256) {
    float* row = SC + tid * SC_STRIDE;
    float gmax[16];
#pragma unroll
    for (int g = 0; g < 16; ++g) {
      float4 a = *(float4*)(row + g * 8), b = *(float4*)(row + g * 8 + 4);
      gmax[g] = fmaxf(fmaxf(fmaxf(a.x, a.y), fmaxf(a.z, a.w)), fmaxf(fmaxf(b.x, b.y), fmaxf(b.z, b.w)));
    }
    float outv[16]; int outi[16];
#pragma unroll
    for (int k = 0; k < 16; ++k) {
      float gm = gmax[0]; int gi = 0;
#pragma unroll
      for (int g = 1; g < 16; ++g) { bool c = gmax[g] > gm; gm = c ? gmax[g] : gm; gi = c ? g : gi; }
      float* gp = row + gi * 8;
      float4 a = *(float4*)gp, b = *(float4*)(gp + 4);
      float v[8] = {a.x, a.y, a.z, a.w, b.x, b.y, b.z, b.w};
      int ei = 7;
#pragma unroll
      for (int e = 6; e >= 0; --e) ei = (v[e] == gm) ? e : ei;
      float nm = NEG_INF;
#pragma unroll
      for (int e = 0; e < 8; ++e) { float x = (e == ei) ? NEG_INF : v[e]; nm = fmaxf(nm, x); }
      gp[ei] = NEG_INF;
#pragma unroll
      for (int g = 0; g < 16; ++g) gmax[g] = (g == gi) ? nm : gmax[g];
      outv[k] = gm; outi[k] = gi * 8 + ei;
    }
#pragma unroll
    for (int k = 0; k < 16; ++k) { row[k] = outv[k]; row[16 + k] = __int_as_float(outi[k]); }
  }
  __syncthreads();
  if (tid < 128) {
    const int t = tid >> 3, pp = tid & 7;
    const float* ra = SC + ((2 * pp) * 16 + t) * SC_STRIDE;
    const float* rb = SC + ((2 * pp + 1) * 16 + t) * SC_STRIDE;
    float a[16], b[16]; int ia[16], ib[16];
#pragma unroll
    for (int q = 0; q < 4; ++q) {
      float4 x = *(const float4*)(ra + 4 * q), y = *(const float4*)(rb + 4 * q);
      float4 xi = *(const float4*)(ra + 16 + 4 * q), yi = *(const float4*)(rb + 16 + 4 * q);
      a[4 * q] = x.x; a[4 * q + 1] = x.y; a[4 * q + 2] = x.z; a[4 * q + 3] = x.w;
      b[4 * q] = y.x; b[4 * q + 1] = y.y; b[4 * q + 2] = y.z; b[4 * q + 3] = y.w;
      ia[4 * q] = __float_as_int(xi.x); ia[4 * q + 1] = __float_as_int(xi.y); ia[4 * q + 2] = __float_as_int(xi.z); ia[4 * q + 3] = __float_as_int(xi.w);
      ib[4 * q] = __float_as_int(yi.x); ib[4 * q + 1] = __float_as_int(yi.y); ib[4 * q + 2] = __float_as_int(yi.z); ib[4 * q + 3] = __float_as_int(yi.w);
    }
    float cs[50]; int cc[50];
#pragma unroll
    for (int i = 0; i < 16; ++i)
#pragma unroll
      for (int j = 0; j < pk_clen(i); ++j) { cs[pk_coff(i) + j] = a[i] + b[j]; cc[pk_coff(i) + j] = ia[i] * 128 + ib[j]; }
    float v16[16]; int c16[16];
#pragma unroll
    for (int k = 0; k < 16; ++k) {
      float best = cs[0]; int bi = 0, bc = cc[0];
#pragma unroll
      for (int q = 1; q < 50; ++q) { bool c = cs[q] > best; best = c ? cs[q] : best; bi = c ? q : bi; bc = c ? cc[q] : bc; }
#pragma unroll
      for (int q = 0; q < 50; ++q) cs[q] = (q == bi) ? NEG_INF : cs[q];
      v16[k] = best; c16[k] = bc;
    }
    float l = 0.f; const float vmax = v16[0];
#pragma unroll
    for (int k = 0; k < 16; ++k) { v16[k] = __expf(v16[k] - vmax); l += v16[k]; }
    float inv = 1.f / l;
#pragma unroll
    for (int k = 0; k < 16; ++k) {
      ELK[t * 128 + pp * 16 + k] = ((unsigned)c16[k] << 7) | (unsigned)(pp * 16 + k);
      ELW[t * 128 + pp * 16 + k] = v16[k] * inv;
    }
  }
  __syncthreads();
#pragma unroll
  for (int tt = 0; tt < 2; ++tt) {
    const int t = 2 * w + tt;
    unsigned e0 = ELK[t * 128 + 2 * lane], e1 = ELK[t * 128 + 2 * lane + 1];
#pragma unroll
    for (int k = 2; k <= 128; k <<= 1) {
#pragma unroll
      for (int j = k >> 1; j > 0; j >>= 1) {
        if (j == 1) {
          bool up = ((2 * lane) & k) == 0;
          unsigned lo = min(e0, e1), hi = max(e0, e1);
          e0 = up ? lo : hi; e1 = up ? hi : lo;
        } else {
          unsigned o0 = __shfl_xor(e0, j >> 1), o1 = __shfl_xor(e1, j >> 1);
          bool up = ((2 * lane) & k) == 0;
          bool lower = ((2 * lane) & j) == 0;
          bool keepmin = (up == lower);
          e0 = keepmin ? min(e0, o0) : max(e0, o0);
          e1 = keepmin ? min(e1, o1) : max(e1, o1);
        }
      }
    }
    const size_t gb = (size_t)(t0 + t) * 128 + 2 * lane;
    p.EIDX[gb] = (int)(e0 >> 7); p.EIDX[gb + 1] = (int)(e1 >> 7);
    p.EW[gb] = ELW[t * 128 + (e0 & 127)]; p.EW[gb + 1] = ELW[t * 128 + (e1 & 127)];
  }
  __syncthreads();
}

DI float dot2bf(unsigned a, unsigned b, float acc) { return __builtin_amdgcn_fdot2_f32_bf16(__builtin_bit_cast(bf16x2_t, a), __builtin_bit_cast(bf16x2_t, b), acc, false); }
template <int CTRL> DI float dpp_f(float x) { return __builtin_bit_cast(float, __builtin_amdgcn_mov_dpp(__builtin_bit_cast(int, x), CTRL, 0xf, 0xf, true)); }
DI float row16_sum(float v) { v += dpp_f<0x128>(v); v += dpp_f<0x124>(v); v += dpp_f<0x122>(v); v += dpp_f<0x121>(v); return v; }
DI float dot_row(const uint4 (&u)[8], const uint4 (&h)[8]) {
  float d = 0.f;
#pragma unroll
  for (int j = 0; j < 8; ++j) { d = dot2bf(u[j].x, h[j].x, d); d = dot2bf(u[j].y, h[j].y, d); d = dot2bf(u[j].z, h[j].z, d); d = dot2bf(u[j].w, h[j].w, d); }
  return row16_sum(d);
}
DI void axpy_row(float (&acc)[64], const uint4 (&v)[8], float c) {
#pragma unroll
  for (int j = 0; j < 8; ++j) {
    const unsigned ww[4] = {v[j].x, v[j].y, v[j].z, v[j].w};
#pragma unroll
    for (int q = 0; q < 4; ++q) {
      acc[j * 8 + 2 * q] += c * __uint_as_float(ww[q] << 16);
      acc[j * 8 + 2 * q + 1] += c * __uint_as_float(ww[q] & 0xffff0000u);
    }
  }
}
DI void axpy_half(float (&acc)[32], const uint4 (&v)[4], float c) {
#pragma unroll
  for (int j = 0; j < 4; ++j) {
    const unsigned ww[4] = {v[j].x, v[j].y, v[j].z, v[j].w};
#pragma unroll
    for (int q = 0; q < 4; ++q) {
      acc[j * 8 + 2 * q] += c * __uint_as_float(ww[q] << 16);
      acc[j * 8 + 2 * q + 1] += c * __uint_as_float(ww[q] & 0xffff0000u);
    }
  }
}
#ifndef PEER_TILE_SHIFT
#define PEER_TILE_SHIFT 8
#endif
DI void fma16_fp8(float& d, const uint4& u, const float* hv) {
  const unsigned ww[4] = {u.x, u.y, u.z, u.w};
#pragma unroll
  for (int q = 0; q < 4; ++q) {
    f32x2_t a = __builtin_amdgcn_cvt_pk_f32_fp8((int)ww[q], false), b = __builtin_amdgcn_cvt_pk_f32_fp8((int)ww[q], true);
    d += a[0] * hv[4 * q] + a[1] * hv[4 * q + 1] + b[0] * hv[4 * q + 2] + b[1] * hv[4 * q + 3];
  }
}
DI float dot_row8(const uint4 (&u)[4], const float (&hv)[64]) {
  float d0 = 0.f, d1 = 0.f;
  fma16_fp8(d0, u[0], hv); fma16_fp8(d1, u[1], hv + 16); fma16_fp8(d0, u[2], hv + 32); fma16_fp8(d1, u[3], hv + 48);
  return row16_sum(d0 + d1);
}
DI void axpy_row8(float (&acc)[64], const uint4 (&v)[4], float c) {
#pragma unroll
  for (int j = 0; j < 4; ++j) {
    const unsigned ww[4] = {v[j].x, v[j].y, v[j].z, v[j].w};
#pragma unroll
    for (int q = 0; q < 4; ++q) {
      f32x2_t a = __builtin_amdgcn_cvt_pk_f32_fp8((int)ww[q], false), b = __builtin_amdgcn_cvt_pk_f32_fp8((int)ww[q], true);
      acc[j * 16 + 4 * q] += c * a[0]; acc[j * 16 + 4 * q + 1] += c * a[1]; acc[j * 16 + 4 * q + 2] += c * b[0]; acc[j * 16 + 4 * q + 3] += c * b[1];
    }
  }
}
DI void peer_gather_block(const Params& p, int vb, char* smem) {
  unsigned* ELK = (unsigned*)smem;
  float* ELC = (float*)(smem + 32768);
  const int tid = mytid(), lane = tid & 63, w = tid >> 6, grp = lane >> 4, i = lane & 15;
  const int tokbase = vb * 64;
  for (int q = tid; q < 64 * 128 / 4; q += NT) {
    ((uint4*)ELK)[q] = ((const uint4*)(p.EIDX + (size_t)tokbase * 128))[q];
    ((float4*)ELC)[q] = ((const float4*)(p.EW + (size_t)tokbase * 128))[q];
  }
  __syncthreads();
#pragma unroll 1
  for (int tt = 0; tt < 2; ++tt) {
    const int tl = w * 8 + grp * 2 + tt, tok = tokbase + tl;
    const unsigned* kk = ELK + tl * 128;
    float* cc = ELC + tl * 128;
    uint4 b0[4], b1[4], b2[4], b3[4];
#define ROW_LOAD(BUF, BASE, E) { const unsigned e_ = kk[E]; _Pragma("unroll") for (int j = 0; j < 4; ++j) BUF[j] = *(const uint4*)(BASE + (size_t)e_ * DM + j * 256); }
    {
      float hv[64];
#pragma unroll
      for (int j = 0; j < 4; ++j)
#pragma unroll
        for (int hf = 0; hf < 2; ++hf) {
          uint4 a = *(const uint4*)(p.RA + (size_t)tok * DM + j * 256 + i * 16 + hf * 8);
          const unsigned aa[4] = {a.x, a.y, a.z, a.w};
#pragma unroll
          for (int q = 0; q < 4; ++q) { hv[j * 16 + hf * 8 + 2 * q] = __uint_as_float(aa[q] << 16); hv[j * 16 + hf * 8 + 2 * q + 1] = __uint_as_float(aa[q] & 0xffff0000u); }
        }
      const unsigned char* ub_ = p.PDN8 + i * 16;
#define DN_COMP(BUF, E) { const unsigned e_ = kk[E]; float d_ = dot_row8(BUF, hv) * p.SDN[e_]; float c_ = cc[E] * gelu_tanh(d_) * p.SUP[e_]; if (i == 0) cc[E] = c_; }
      ROW_LOAD(b0, ub_, 0) ROW_LOAD(b1, ub_, 1) ROW_LOAD(b2, ub_, 2) ROW_LOAD(b3, ub_, 3)
      for (int e = 0; e < 128; e += 4) {
        DN_COMP(b0, e)     if (e + 4 < 128) ROW_LOAD(b0, ub_, e + 4)
        DN_COMP(b1, e + 1) if (e + 4 < 128) ROW_LOAD(b1, ub_, e + 5)
        DN_COMP(b2, e + 2) if (e + 4 < 128) ROW_LOAD(b2, ub_, e + 6)
        DN_COMP(b3, e + 3) if (e + 4 < 128) ROW_LOAD(b3, ub_, e + 7)
      }
#undef DN_COMP
    }
    {
      float acc[64];
#pragma unroll
      for (int e = 0; e < 64; ++e) acc[e] = 0.f;
      const unsigned char* vbase = p.PUP8 + i * 16;
      ROW_LOAD(b0, vbase, 0) ROW_LOAD(b1, vbase, 1) ROW_LOAD(b2, vbase, 2) ROW_LOAD(b3, vbase, 3)
      for (int e = 0; e < 128; e += 4) {
        axpy_row8(acc, b0, cc[e]);     if (e + 4 < 128) ROW_LOAD(b0, vbase, e + 4)
        axpy_row8(acc, b1, cc[e + 1]); if (e + 4 < 128) ROW_LOAD(b1, vbase, e + 5)
        axpy_row8(acc, b2, cc[e + 2]); if (e + 4 < 128) ROW_LOAD(b2, vbase, e + 6)
        axpy_row8(acc, b3, cc[e + 3]); if (e + 4 < 128) ROW_LOAD(b3, vbase, e + 7)
      }
      const int b = tok >> 13;
      const float* ga2 = p.mod + b * 6144 + 5120;
      const float* orow = p.out + (size_t)tok * DM; float* grow = p.gout + (size_t)tok * DM;
      float ss = 0.f;
#pragma unroll
      for (int j = 0; j < 4; ++j)
#pragma unroll
        for (int q4 = 0; q4 < 4; ++q4) {
          const int col = j * 256 + i * 16 + q4 * 4;
          float4 x1 = *(const float4*)(orow + col), gg = *(const float4*)(ga2 + col);
          float* q = acc + j * 16 + q4 * 4;
          q[0] = x1.x + gg.x * q[0]; q[1] = x1.y + gg.y * q[1]; q[2] = x1.z + gg.z * q[2]; q[3] = x1.w + gg.w * q[3];
          ss += q[0] * q[0] + q[1] * q[1] + q[2] * q[2] + q[3] * q[3];
        }
      ss = row16_sum(ss);
      const float rstd = rsqrtf(ss * (1.f / DM) + 1e-6f);
#pragma unroll
      for (int j = 0; j < 4; ++j)
#pragma unroll
        for (int q4 = 0; q4 < 4; ++q4) {
          const int col = j * 256 + i * 16 + q4 * 4;
          float4 gf = *(const float4*)(p.g_final + col);
          const float* q = acc + j * 16 + q4 * 4;
          *(float4*)(grow + col) = make_float4(q[0] * rstd * gf.x, q[1] * rstd * gf.y, q[2] * rstd * gf.z, q[3] * rstd * gf.w);
        }
    }
#undef ROW_LOAD
  }
  __syncthreads();
}
DI void convert_tables(const Params& p, int v) {
  const int lane = mytid() & 63, row = v * 8 + (mytid() >> 6);
  const int tb = row >> 14, rr = row & 16383;
  const float* src = (tb ? p.peer_up : p.peer_down) + (size_t)rr * DM;
  float4 x[4]; float am = 0.f;
#pragma unroll
  for (int q = 0; q < 4; ++q) {
    x[q] = *(const float4*)(src + q * 256 + lane * 4);
    am = fmaxf(am, fmaxf(fmaxf(fabsf(x[q].x), fabsf(x[q].y)), fmaxf(fabsf(x[q].z), fabsf(x[q].w))));
  }
  for (int o = 32; o; o >>= 1) am = fmaxf(am, __shfl_xor(am, o));
  const float sc = (am > 0.f) ? am * (1.f / 448.f) : 1.f, inv = (am > 0.f) ? 448.f / am : 1.f;
  unsigned* dst = (unsigned*)((tb ? p.PUP8 : p.PDN8) + (size_t)rr * DM);
#pragma unroll
  for (int q = 0; q < 4; ++q) {
    int wd = 0;
    wd = __builtin_amdgcn_cvt_pk_fp8_f32(x[q].x * inv, x[q].y * inv, wd, false);
    wd = __builtin_amdgcn_cvt_pk_fp8_f32(x[q].z * inv, x[q].w * inv, wd, true);
    dst[q * 64 + lane] = (unsigned)wd;
  }
  if (lane == 0) (tb ? p.SUP : p.SDN)[rr] = sc;
}

#define N_PHASES 11
template <int PH>
DI void run_phase(const Params& p, char* smem) {
  const int nb = gridDim.x, bid = blockIdx.x, tid = mytid();
  if (PH == 0) {
    for (int vb = bid; vb < PH0_NVB; vb += nb) ph0_body(p, vb, smem);
  } else if (PH == 1) {
    for (int vb = bid; vb < T_TOK / 8; vb += nb) rownorm_body(p.x, p.g_mix, p.mod, 0, 1024, p.RA, vb);
  } else if (PH == 2) {
    EpiProj e{p};
    for (int vb = bid; vb < 64 * 14; vb += nb) gemm_tile(p.RA, p.WinT, 1024, (vb & 63) * 256, (vb >> 6) * 256, smem, e);
  } else if (PH == 3) {
    for (int vb = bid; vb < 512 + 128 + 64; vb += nb) {
      if (vb < 512) retkv_mfma(p, vb);
      else if (vb < 512 + 128) compress_mfma(p, vb - 512, smem);
      else kmax_body2(p, vb - 640);
    }
  } else if (PH == 4) {
    for (int vb = bid; vb < 256 + 4; vb += nb) {
      if (vb < 256) scan_body(p, vb * NT + tid);
      else kcmax_body(p, (vb - 256) * NT + tid);
    }
  } else if (PH == 5) {
    for (int rep = 0; rep < (PROBE_DUP == 51 ? 2 : 1); ++rep)
      for (int vb = bid; vb < 256; vb += nb) retout_mfma(p, vb * 8 + (tid >> 6));
    for (int rep = 0; rep < (PROBE_DUP == 52 ? 2 : 1); ++rep)
      for (int vb = bid; vb < 512; vb += nb) nsa_item(p, (vb < 256) ? vb : 767 - vb, smem);
  } else if (PH == 6) {
    EpiOut e{p};
    for (int vb = bid; vb < 64 * 4; vb += nb) gemm_tile(p.RA, p.WoutT, 1024, (vb & 63) * 256, (vb >> 6) * 256, smem, e);
  } else if (PH == 7) {
    for (int vb = bid; vb < T_TOK / 8 + 4096; vb += nb) {
      if (vb < T_TOK / 8) rownorm_body(p.out, p.g_ffn, p.mod, 3072, 4096, p.RA, vb);
      else convert_tables(p, vb - T_TOK / 8);
    }
  } else if (PH == 8) {
    EpiPQ e{p};
    for (int vb = bid; vb < 64 * 8; vb += nb) gemm_tile(p.RA, p.WqT, 1024, (vb & 63) * 256, (vb >> 6) * 256, smem, e);
  } else if (PH == 9) {
    for (int vb = bid; vb < T_TOK / 16; vb += nb) peer_topk_tile(p, vb, smem);
  } else if (PH == 10) {
    for (int vb = bid; vb < T_TOK / 64; vb += nb) peer_gather_block(p, vb, smem);
  }
}


#define XB_TMO      128
#define XB_XCNT(j)  (256  + 64 * (j))
#define XB_XSUB(j)  (1280 + 64 * (j))
#define XB_XGEN(j)  (2304 + 64 * (j))
#define XB_TOP      3328
#define XB_TOPGEN   3392
#define XCD_BAR_WORDS 3456
#define XB_SPIN_CAP (1u << 22)
#define LAS __attribute__((address_space(3)))
DI unsigned xb_ld(unsigned* p) { return __hip_atomic_load(p, __ATOMIC_RELAXED, __HIP_MEMORY_SCOPE_AGENT); }
DI unsigned xb_add(unsigned* p, unsigned v) { return __hip_atomic_fetch_add(p, v, __ATOMIC_RELAXED, __HIP_MEMORY_SCOPE_AGENT); }
DI unsigned xb_xcc_id() { return (unsigned)__builtin_amdgcn_s_getreg((3 << 11) | 20) & 0xFu; }
#define XB_SPIN(cond, bar) do { unsigned _sp = 0; while (cond) { __builtin_amdgcn_s_sleep(1); \
    if ((++_sp & 255u) == 0u) { if (xb_ld(&(bar)[XB_TMO])) break; if (_sp > XB_SPIN_CAP) { atomicAdd(&(bar)[XB_TMO], 1u); break; } } } } while (0)
struct XcdBarrier { unsigned* bar; unsigned x; volatile LAS unsigned* st; };
DI XcdBarrier xcd_barrier_post(unsigned* bar, volatile LAS unsigned* st) {
  XcdBarrier b; b.bar = bar; b.x = xb_xcc_id(); b.st = st;
  if (threadIdx.x == 0) (void)xb_add(&bar[XB_XCNT(b.x)], 1u);
  return b;
}
DI void xcd_barrier_complete(unsigned* bar, unsigned x, unsigned& nloc, unsigned& nx) {
  const unsigned G = gridDim.x * gridDim.y * gridDim.z;
  unsigned sum, cnt, mine, sp = 0u;
  for (;;) {
    sum = 0u; cnt = 0u; mine = 0u;
#pragma unroll
    for (unsigned j = 0; j < 16; ++j) { const unsigned c = xb_ld(&bar[XB_XCNT(j)]); sum += c; cnt += (c > 0u) ? 1u : 0u; mine = (j == x) ? c : mine; }
    if (sum == G) break;
    __builtin_amdgcn_s_sleep(1);
    if ((++sp & 255u) == 0u) { if (xb_ld(&bar[XB_TMO])) break; if (sp > XB_SPIN_CAP) { atomicAdd(&bar[XB_TMO], 1u); break; } }
  }
  nloc = mine > 0u ? mine : 1u; nx = cnt > 0u ? cnt : 1u;
}
DI void xcd_barrier(const XcdBarrier& b) {
  asm volatile("s_waitcnt vmcnt(0)" ::: "memory");
  __syncthreads();
  if (threadIdx.x == 0) {
    unsigned* bar = b.bar;
    __builtin_amdgcn_s_waitcnt(0);
    unsigned nloc = b.st[0], nx = b.st[1];
    if (nloc == 0u) { xcd_barrier_complete(bar, b.x, nloc, nx); b.st[0] = nloc; b.st[1] = nx; }
    const unsigned old = xb_add(&bar[XB_XSUB(b.x)], 1u);
    const unsigned gen = old / nloc;
    if (old + 1u == (gen + 1u) * nloc) {
      __builtin_amdgcn_fence(__ATOMIC_RELEASE, "agent");
      asm volatile("s_waitcnt vmcnt(0)" ::: "memory");
      const unsigned og = xb_add(&bar[XB_TOP], 1u);
      const unsigned tg = og / nx;
      if (og + 1u == (tg + 1u) * nx) xb_add(&bar[XB_TOPGEN], 1u);
      else XB_SPIN(xb_ld(&bar[XB_TOPGEN]) == tg, bar);
      __builtin_amdgcn_fence(__ATOMIC_ACQUIRE, "agent");
      xb_add(&bar[XB_XGEN(b.x)], 1u);
      asm volatile("s_waitcnt vmcnt(0)" ::: "memory");
    } else {
      XB_SPIN(xb_ld(&bar[XB_XGEN(b.x)]) == gen, bar);
      __builtin_amdgcn_fence(__ATOMIC_ACQUIRE, "agent");
      asm volatile("s_waitcnt vmcnt(0)" ::: "memory");
    }
  }
  __syncthreads();
}

#define SMEM_BYTES 155648

template <int PH>
DI void phase_and_probe(const Params& p, char* smem, cg::grid_group& grid) {
  const int reps = (PROBE_DUP == PH) ? 2 : 1;
  for (int rep = 0; rep < reps; ++rep) {
    if (PH == 10 && rep + 1 < reps) { Params q = p; q.gout = (float*)p.PQ; run_phase<PH>(q, smem); }
    else run_phase<PH>(p, smem);
    if (rep + 1 < reps) grid.sync();
  }
}
__global__ void __launch_bounds__(NT) k_mega(Params p) {
  extern __shared__ __attribute__((aligned(16))) char smem[];
  __shared__ uint4 xb_words;
  cg::grid_group grid = cg::this_grid();
  if (threadIdx.x == 0) xb_words = make_uint4(0u, 0u, 0u, 0u);
  __syncthreads();
  XcdBarrier xb = xcd_barrier_post(p.xbar, (volatile LAS unsigned*)&xb_words);
  phase_and_probe<0>(p, smem, grid); grid.sync();
  phase_and_probe<1>(p, smem, grid); xcd_barrier(xb);
  phase_and_probe<2>(p, smem, grid); xcd_barrier(xb);
  phase_and_probe<3>(p, smem, grid); xcd_barrier(xb);
  phase_and_probe<4>(p, smem, grid); xcd_barrier(xb);
  phase_and_probe<5>(p, smem, grid); xcd_barrier(xb);
  phase_and_probe<6>(p, smem, grid); xcd_barrier(xb);
  phase_and_probe<7>(p, smem, grid); xcd_barrier(xb);
  phase_and_probe<8>(p, smem, grid); xcd_barrier(xb);
  phase_and_probe<9>(p, smem, grid); xcd_barrier(xb);
  phase_and_probe<10>(p, smem, grid);
}
#ifdef MK_MULTI
template <int PH>
__global__ void __launch_bounds__(NT) k_single(Params p) {
  extern __shared__ __attribute__((aligned(16))) char smem[];
  run_phase<PH>(p, smem);
}
#endif

static size_t carve(size_t& off, size_t bytes) { size_t o = off; off += (bytes + 255) & ~(size_t)255; return o; }

extern "C" void kernel_launch(void* const* d_in, const int* in_sizes, int n_in, void* d_out, int out_size, void* d_ws, size_t ws_size,
                              hipStream_t stream) {
  Params p{};
  p.x = (const float*)d_in[0]; p.c = (const float*)d_in[1]; p.w_ada = (const float*)d_in[2]; p.b_ada = (const float*)d_in[3];
  p.g_mix = (const float*)d_in[4]; p.w_in = (const float*)d_in[5]; p.pe_k = (const float*)d_in[6]; p.pe_v = (const float*)d_in[7];
  p.w_k1 = (const float*)d_in[8]; p.b_k1 = (const float*)d_in[9]; p.w_k2 = (const float*)d_in[10]; p.w_v1 = (const float*)d_in[11];
  p.b_v1 = (const float*)d_in[12]; p.w_v2 = (const float*)d_in[13]; p.w_out = (const float*)d_in[14]; p.g_ffn = (const float*)d_in[15];
  p.w_pq = (const float*)d_in[16]; p.subkeys = (const float*)d_in[17]; p.peer_down = (const float*)d_in[18]; p.peer_up = (const float*)d_in[19];
  p.g_final = (const float*)d_in[20];
  p.out = (float*)d_out; p.gout = p.out;
  char* ws = (char*)d_ws;
  size_t off = 0;
  p.mod = (float*)(ws + carve(off, 2 * 6144 * 4));
  p.ksmax = (unsigned*)(ws + carve(off, 256));
  p.xbar = (unsigned*)(ws + carve(off, XCD_BAR_WORDS * 4));
  p.c128 = (float*)(ws + carve(off, (size_t)SEQ * 64 * 4)); p.s128 = (float*)(ws + carve(off, (size_t)SEQ * 64 * 4));
  p.c64 = (float*)(ws + carve(off, (size_t)SEQ * 32 * 4)); p.s64 = (float*)(ws + carve(off, (size_t)SEQ * 32 * 4));
  p.WinT = (bf16_t*)(ws + carve(off, (size_t)NPROJ * 1024 * 2));
  p.WoutT = (bf16_t*)(ws + carve(off, (size_t)1024 * 1024 * 2));
  p.WqT = (bf16_t*)(ws + carve(off, (size_t)2048 * 1024 * 2));
  p.W1Tk = (bf16_t*)(ws + carve(off, (size_t)256 * 2048 * 2)); p.W1Tv = (bf16_t*)(ws + carve(off, (size_t)256 * 2048 * 2));
  p.W2Tk = (bf16_t*)(ws + carve(off, 64 * 256 * 2)); p.W2Tv = (bf16_t*)(ws + carve(off, 64 * 256 * 2));
  p.SUBK = (bf16_t*)(ws + carve(off, (size_t)16 * 128 * 128 * 2));
  p.B1Pk = (float*)(ws + carve(off, 1024)); p.B1Pv = (float*)(ws + carve(off, 1024));
  p.RA = (bf16_t*)(ws + carve(off, (size_t)T_TOK * 1024 * 2));
  size_t rb = off;
  p.RQ = (bf16_t*)(ws + carve(off, (size_t)T_TOK * 512 * 2)); p.RK = (bf16_t*)(ws + carve(off, (size_t)T_TOK * 512 * 2));
  p.RKT = (bf16_t*)(ws + carve(off, (size_t)T_TOK * 512 * 2)); p.RVT = (bf16_t*)(ws + carve(off, (size_t)T_TOK * 512 * 2));
  p.RGT = (bf16_t*)(ws + carve(off, (size_t)T_TOK * 512 * 2)); p.NQ = (bf16_t*)(ws + carve(off, (size_t)T_TOK * 512 * 2));
  p.NKC = (bf16_t*)(ws + carve(off, (size_t)T_TOK * 128 * 2)); p.NVC = (bf16_t*)(ws + carve(off, (size_t)T_TOK * 128 * 2));
  p.NKS = (bf16_t*)(ws + carve(off, (size_t)T_TOK * 128 * 2)); p.NKW = (bf16_t*)(ws + carve(off, (size_t)T_TOK * 128 * 2));
  p.NVST = (bf16_t*)(ws + carve(off, (size_t)T_TOK * 128 * 2)); p.NVWT = (bf16_t*)(ws + carve(off, (size_t)T_TOK * 128 * 2));
  p.GATE = (float*)(ws + carve(off, (size_t)T_TOK * 24 * 4));
  p.KV = (float*)(ws + carve(off, (size_t)512 * 16384 * 4));
  p.SPREV = (bf16_t*)(ws + carve(off, (size_t)512 * 16384 * 2));
  p.KC = (bf16_t*)(ws + carve(off, (size_t)4 * 512 * 64 * 2)); p.VCT = (bf16_t*)(ws + carve(off, (size_t)4 * 512 * 64 * 2));
  p.HID = (float*)(ws + carve(off, (size_t)2 * 2048 * 256 * 4));
  size_t off2 = rb;
  p.PQ = (bf16_t*)(ws + carve(off2, (size_t)T_TOK * 2048 * 2));
  p.EIDX = (int*)(ws + carve(off2, (size_t)T_TOK * 128 * 4));
  p.EW = (float*)(ws + carve(off2, (size_t)T_TOK * 128 * 4));
  p.PDN8 = (unsigned char*)(ws + carve(off2, (size_t)16384 * 1024));
  p.PUP8 = (unsigned char*)(ws + carve(off2, (size_t)16384 * 1024));
  p.SDN = (float*)(ws + carve(off2, 16384 * 4));
  p.SUP = (float*)(ws + carve(off2, 16384 * 4));
  (void)ws_size; (void)in_sizes; (void)n_in; (void)out_size;

#ifdef MK_MULTI
#define LAUNCH1(PH) { hipFuncSetAttribute((const void*)k_single<PH>, hipFuncAttributeMaxDynamicSharedMemorySize, SMEM_BYTES); k_single<PH><<<256, NT, SMEM_BYTES, stream>>>(p); }
  LAUNCH1(0) LAUNCH1(1) LAUNCH1(2) LAUNCH1(3) LAUNCH1(4) LAUNCH1(5) LAUNCH1(6) LAUNCH1(7) LAUNCH1(8) LAUNCH1(9) LAUNCH1(10)
#else
  static int grid_blocks = 0;
  if (!grid_blocks) {
    int dev = 0, cus = 0, per_cu = 0;
    (void)hipGetDevice(&dev);
    (void)hipDeviceGetAttribute(&cus, hipDeviceAttributeMultiprocessorCount, dev);
    (void)hipFuncSetAttribute((const void*)k_mega, hipFuncAttributeMaxDynamicSharedMemorySize, SMEM_BYTES);
    (void)hipOccupancyMaxActiveBlocksPerMultiprocessor(&per_cu, k_mega, NT, SMEM_BYTES);
    if (per_cu < 1) per_cu = 1;
    if (per_cu > 1) per_cu = 1;
    grid_blocks = cus * per_cu;
  }
  (void)hipMemsetAsync(p.xbar, 0, XCD_BAR_WORDS * 4, stream);
  void* args[] = {&p};
  hipError_t e = hipLaunchCooperativeKernel((void*)k_mega, dim3(grid_blocks), dim3(NT), args, SMEM_BYTES, stream);
  if (e != hipSuccess) fprintf(stderr, "cooperative launch failed: %s (grid %d)\n", hipGetErrorString(e), grid_blocks);
#endif
}
```

```cpp
#include <hip/hip_runtime.h>
#include <hip/hip_bf16.h>
#include <hip/hip_cooperative_groups.h>
#include <stdint.h>
#include <stdio.h>
namespace cg = cooperative_groups;

typedef unsigned short bf16_t;
#define DI __device__ __forceinline__

DI int mytid() { int t = threadIdx.x; asm volatile("" : "+v"(t)); return t; }
DI float bf2f(bf16_t v) { return __uint_as_float(((unsigned)v) << 16); }
DI bf16_t f2bf(float x) { unsigned u = __float_as_uint(x); u += 0x7fffu + ((u >> 16) & 1u); return (bf16_t)(u >> 16); }
DI float gelu_tanh(float x) { float u = 0.7978845608028654f * (x + 0.044715f * x * x * x); return 0.5f * x * (1.f + tanhf(u)); }
DI float siluf(float x) { return x / (1.f + __expf(-x)); }
DI float sigmoidf(float x) { return 1.f / (1.f + __expf(-x)); }

#define T_TOK 16384
#define SEQ 8192
#define DM 1024
#define NPROJ 3584
#define NEG_INF (-__builtin_inff())

struct Params {
  const float *x, *c, *w_ada, *b_ada, *g_mix, *w_in, *pe_k, *pe_v, *w_k1, *b_k1, *w_k2, *w_v1, *b_v1, *w_v2, *w_out, *g_ffn,
      *w_pq, *subkeys, *peer_down, *peer_up, *g_final;
  float* out;
  float* gout;
  float* mod;
  unsigned* ksmax;
  unsigned* xbar;
  float *c128, *s128, *c64, *s64;
  bf16_t *WinT, *WoutT, *WqT, *W1Tk, *W1Tv, *W2Tk, *W2Tv, *SUBK;
  float *B1Pk, *B1Pv;
  bf16_t* RA;
  bf16_t *RQ, *RK, *RKT, *RVT, *RGT, *NQ, *NKC, *NVC, *NKS, *NKW, *NVST, *NVWT;
  float* GATE;
  float* KV;
  bf16_t* SPREV;
  bf16_t *KC, *VCT;
  float* HID;
  bf16_t* PQ;
  int* EIDX;
  float* EW;
  unsigned char *PDN8, *PUP8;
  float *SDN, *SUP;
};

DI float logg_h(int h) { return log1pf(-exp2f(-5.f - (float)h)); }


typedef __bf16 bf16x2_t __attribute__((ext_vector_type(2)));
typedef float f32x2_t __attribute__((ext_vector_type(2)));
DI unsigned cvt2(float a, float b) { f32x2_t v = {a, b}; bf16x2_t r = __builtin_convertvector(v, bf16x2_t); return __builtin_bit_cast(unsigned, r); }
DI uint2 pack4(float a, float b, float c, float d) { uint2 r; r.x = cvt2(a, b); r.y = cvt2(c, d); return r; }
#define NT 512
#ifndef PROBE_DUP
#define PROBE_DUP -1
#endif
typedef short bf16x8 __attribute__((ext_vector_type(8)));
typedef float f32x16 __attribute__((ext_vector_type(16)));
#define MFMA32(a, b, c) __builtin_amdgcn_mfma_f32_32x32x16_bf16((a), (b), (c), 0, 0, 0)
DI f32x16 zero16() { f32x16 z; for (int e = 0; e < 16; ++e) z[e] = 0.f; return z; }
DI f32x16 fill16(float v) { f32x16 z; for (int e = 0; e < 16; ++e) z[e] = v; return z; }
DI float ex2(float x) { return __builtin_amdgcn_exp2f(x); }

DI int win_logical_col(int np) {
  int g = np >> 6, c = np & 63;
  if (g < 16) {
    int sec = g >> 3, hh = (g & 7) >> 1, j = g & 1, i = 32 * j + (c & 31);
    return sec * 512 + hh * 128 + ((c < 32) ? i : 64 + i);
  } else if (g < 52) return 1024 + (g - 16) * 64 + c;
  else if (g == 52) return (c < 24) ? 3328 + c : -1;
  return -1;
}

DI void tr_tile(const float* __restrict__ in, bf16_t* __restrict__ out, int K, int N_in, int k0, int n0, int mode, float* tile) {
  const int tid = mytid();
  {
    int nn = tid & 63, col = mode ? win_logical_col(n0 + nn) : (n0 + nn);
#pragma unroll
    for (int i = 0; i < 8; ++i) {
      int kk = (tid >> 6) + 8 * i;
      tile[kk * 65 + nn] = (col >= 0) ? in[(size_t)(k0 + kk) * N_in + col] : 0.f;
    }
  }
  __syncthreads();
  {
    int kk = tid & 63;
#pragma unroll
    for (int i = 0; i < 8; ++i) {
      int nn = (tid >> 6) + 8 * i;
      out[(size_t)(n0 + nn) * K + k0 + kk] = f2bf(tile[kk * 65 + nn]);
    }
  }
  __syncthreads();
}

#define PH0_MOD 96
#define PH0_WIN (PH0_MOD + 16 * 56)
#define PH0_WOUT (PH0_WIN + 256)
#define PH0_WQ (PH0_WOUT + 512)
#define PH0_W1K (PH0_WQ + 128)
#define PH0_W1V (PH0_W1K + 128)
#define PH0_W2K (PH0_W1V + 4)
#define PH0_W2V (PH0_W2K + 4)
#define PH0_SUBK (PH0_W2V + 512)
#define PH0_ROPE (PH0_SUBK + 1024)
#define PH0_B1P (PH0_ROPE + 8)
#define PH0_NVB PH0_B1P

DI void ph0_body(const Params& p, int vb, char* smem) {
  const int tid = mytid();
  float* fs = (float*)smem;
  if (vb < PH0_MOD) {
    int kg = tid >> 6, col = vb * 64 + (tid & 63);
    float a0 = 0.f, a1 = 0.f;
#pragma unroll 8
    for (int k = kg * 128; k < kg * 128 + 128; ++k) {
      float w = p.w_ada[(size_t)k * 6144 + col];
      a0 += siluf(p.c[k]) * w; a1 += siluf(p.c[DM + k]) * w;
    }
    fs[kg * 64 + (tid & 63)] = a0; fs[512 + kg * 64 + (tid & 63)] = a1;
    __syncthreads();
    if (tid < 128) {
      int b = tid >> 6, cc = tid & 63; float s = 0.f;
      for (int g = 0; g < 8; ++g) s += fs[b * 512 + g * 64 + cc];
      p.mod[b * 6144 + vb * 64 + cc] = s + p.b_ada[vb * 64 + cc];
    }
    __syncthreads();
    if (vb == 0 && tid < 12) p.ksmax[tid] = 0u;
  } else if (vb < PH0_WIN) { int t = vb - PH0_MOD; tr_tile(p.w_in, p.WinT, 1024, 3352, (t & 15) * 64, (t >> 4) * 64, 1, fs); }
  else if (vb < PH0_WOUT) { int t = vb - PH0_WIN; tr_tile(p.w_out, p.WoutT, 1024, 1024, (t & 15) * 64, (t >> 4) * 64, 0, fs); }
  else if (vb < PH0_WQ) { int t = vb - PH0_WOUT; tr_tile(p.w_pq, p.WqT, 1024, 2048, (t & 15) * 64, (t >> 4) * 64, 0, fs); }
  else if (vb < PH0_W1K) { int t = vb - PH0_WQ; tr_tile(p.w_k1, p.W1Tk, 2048, 256, (t & 31) * 64, (t >> 5) * 64, 0, fs); }
  else if (vb < PH0_W1V) { int t = vb - PH0_W1K; tr_tile(p.w_v1, p.W1Tv, 2048, 256, (t & 31) * 64, (t >> 5) * 64, 0, fs); }
  else if (vb < PH0_W2K) { int t = vb - PH0_W1V; tr_tile(p.w_k2, p.W2Tk, 256, 64, t * 64, 0, 0, fs); }
  else if (vb < PH0_W2V) { int t = vb - PH0_W2K; tr_tile(p.w_v2, p.W2Tv, 256, 64, t * 64, 0, 0, fs); }
  else if (vb < PH0_SUBK) { int i = (vb - PH0_W2V) * NT + tid; p.SUBK[i] = f2bf(p.subkeys[i]); }
  else if (vb < PH0_ROPE) {
    int idx = (vb - PH0_SUBK) * NT + tid;
    { int s = idx >> 6, i = idx & 63; float inv = powf(10000.f, -(float)(2 * i) / 128.f); float ang = (float)s * inv; p.c128[idx] = cosf(ang); p.s128[idx] = sinf(ang); }
    if (idx < SEQ * 32) { int s = idx >> 5, i = idx & 31; float inv = powf(10000.f, -(float)(2 * i) / 64.f); float ang = (float)s * inv; p.c64[idx] = cosf(ang); p.s64[idx] = sinf(ang); }
  } else {
    int t = vb - PH0_ROPE, kv = t >> 2, jb = t & 3;
    const float* w1 = kv ? p.w_v1 : p.w_k1; const float* pe = kv ? p.pe_v : p.pe_k; const float* b1 = kv ? p.b_v1 : p.b_k1;
    int fg = tid >> 6, j = jb * 64 + (tid & 63);
    float a = 0.f;
#pragma unroll 8
    for (int f = fg * 256; f < fg * 256 + 256; ++f) a += pe[f] * w1[(size_t)f * 256 + j];
    fs[fg * 64 + (tid & 63)] = a;
    __syncthreads();
    if (tid < 64) { float s = b1[j]; for (int g = 0; g < 8; ++g) s += fs[g * 64 + tid]; (kv ? p.B1Pv : p.B1Pk)[j] = s; }
    __syncthreads();
  }
}

DI void rownorm_body(const float* __restrict__ src, const float* __restrict__ g, const float* __restrict__ mod, int sh_off, int sc_off, bf16_t* __restrict__ dst, int vb) {
  int row = vb * 8 + (mytid() >> 6), lane = mytid() & 63;
  int b = row >> 13;
  const float* xr = src + (size_t)row * DM;
  float v[16]; float ss = 0.f;
#pragma unroll
  for (int i = 0; i < 4; ++i) {
    float4 t = *(const float4*)(xr + i * 256 + lane * 4);
    v[i * 4 + 0] = t.x; v[i * 4 + 1] = t.y; v[i * 4 + 2] = t.z; v[i * 4 + 3] = t.w;
    ss += t.x * t.x + t.y * t.y + t.z * t.z + t.w * t.w;
  }
  for (int o = 32; o; o >>= 1) ss += __shfl_xor(ss, o);
  float rstd = rsqrtf(ss * (1.f / DM) + 1e-6f);
  const float* sh = mod + b * 6144 + sh_off; const float* sc = mod + b * 6144 + sc_off;
#pragma unroll
  for (int i = 0; i < 4; ++i) {
    int col = i * 256 + lane * 4;
    float4 gg = *(const float4*)(g + col), s4 = *(const float4*)(sc + col), h4 = *(const float4*)(sh + col);
    float y0 = v[i * 4 + 0] * rstd * gg.x * (1.f + s4.x) + h4.x;
    float y1 = v[i * 4 + 1] * rstd * gg.y * (1.f + s4.y) + h4.y;
    float y2 = v[i * 4 + 2] * rstd * gg.z * (1.f + s4.z) + h4.z;
    float y3 = v[i * 4 + 3] * rstd * gg.w * (1.f + s4.w) + h4.w;
    *(uint2*)(dst + (size_t)row * DM + col) = pack4(y0, y1, y2, y3);
  }
}

#define G_A_BYTES (256 * 144)
#define G_B_BYTES (256 * 144)
#define G_BUF_BYTES (G_A_BYTES + G_B_BYTES)
template <class Epi>
DI void gemm_tile(const bf16_t* __restrict__ A, const bf16_t* __restrict__ Bt, int K, int m0, int n0, char* smem, const Epi& epi) {
  const int tid = mytid(), lane = tid & 63, w = tid >> 6, wm = w >> 2, wn = w & 3, r = lane & 31, h = lane >> 5;
  f32x16 acc[4][2];
#pragma unroll
  for (int i = 0; i < 4; ++i)
#pragma unroll
    for (int j = 0; j < 2; ++j) acc[i][j] = zero16();
  const int crow = tid >> 3, ckc = tid & 7;
  const bf16_t* ag = A + (size_t)(m0 + crow) * K + ckc * 8;
  const bf16_t* bg = Bt + (size_t)(n0 + crow) * K + ckc * 8;
  uint4 ra[4], rb[4];
#pragma unroll
  for (int i = 0; i < 4; ++i) { ra[i] = *(const uint4*)(ag + (size_t)i * 64 * K); rb[i] = *(const uint4*)(bg + (size_t)i * 64 * K); }
  char* lw = smem + crow * 144 + ckc * 16;
#pragma unroll
  for (int i = 0; i < 4; ++i) { *(uint4*)(lw + i * 64 * 144) = ra[i]; *(uint4*)(lw + G_A_BYTES + i * 64 * 144) = rb[i]; }
  __syncthreads();
  const int nk = K >> 6;
  for (int kt = 0; kt < nk; ++kt) {
    const int cur = kt & 1;
    if (kt + 1 < nk) {
      const int k0 = (kt + 1) * 64;
#pragma unroll
      for (int i = 0; i < 4; ++i) { ra[i] = *(const uint4*)(ag + (size_t)i * 64 * K + k0); rb[i] = *(const uint4*)(bg + (size_t)i * 64 * K + k0); }
    }
    const char* la = smem + cur * G_BUF_BYTES + (wm * 128 + r) * 144 + h * 16;
    const char* lb = smem + cur * G_BUF_BYTES + G_A_BYTES + (wn * 64 + r) * 144 + h * 16;
#pragma unroll
    for (int kk = 0; kk < 4; ++kk) {
      bf16x8 b0 = *(const bf16x8*)(lb + kk * 32), b1 = *(const bf16x8*)(lb + 32 * 144 + kk * 32);
#pragma unroll
      for (int i = 0; i < 4; ++i) {
        bf16x8 a = *(const bf16x8*)(la + i * 32 * 144 + kk * 32);
        acc[i][0] = MFMA32(a, b0, acc[i][0]); acc[i][1] = MFMA32(a, b1, acc[i][1]);
      }
    }
    if (kt + 1 < nk) {
      char* lw2 = lw + (cur ^ 1) * G_BUF_BYTES;
#pragma unroll
      for (int i = 0; i < 4; ++i) { *(uint4*)(lw2 + i * 64 * 144) = ra[i]; *(uint4*)(lw2 + G_A_BYTES + i * 64 * 144) = rb[i]; }
    }
    __syncthreads();
  }
  const int G = (n0 >> 6) + wn;
#pragma unroll
  for (int i = 0; i < 4; ++i) {
    float pre[4][8];
#pragma unroll
    for (int g = 0; g < 4; ++g) epi.prefetch(m0 + wm * 128 + i * 32 + 8 * g + 4 * h, G, r, pre[g]);
#pragma unroll
    for (int g = 0; g < 4; ++g) {
      float lo[4], hi[4];
#pragma unroll
      for (int e = 0; e < 4; ++e) { lo[e] = acc[i][0][4 * g + e]; hi[e] = acc[i][1][4 * g + e]; }
      epi(m0 + wm * 128 + i * 32 + 8 * g + 4 * h, G, r, lo, hi, pre[g]);
    }
  }
}

struct EpiProj {
  static constexpr bool kProbe = true;
  const Params& p;
  DI void prefetch(int t0, int G, int c, float (&pre)[8]) const {
    const int s0 = t0 & 8191;
    const bool r128 = G < 16, r64 = (G >= 32 && G < 40) || (G >= 40 && G < 52 && (((G - 40) >> 1) & 1) == 0);
    if (r128) {
      const int i = 32 * (G & 1) + c;
#pragma unroll
      for (int e = 0; e < 4; ++e) { pre[e] = p.c128[(s0 + e) * 64 + i]; pre[4 + e] = p.s128[(s0 + e) * 64 + i]; }
    } else if (r64) {
#pragma unroll
      for (int e = 0; e < 4; ++e) { pre[e] = p.c64[(s0 + e) * 32 + c]; pre[4 + e] = p.s64[(s0 + e) * 32 + c]; }
    } else {
#pragma unroll
      for (int e = 0; e < 8; ++e) pre[e] = 0.f;
    }
  }
  DI void operator()(int t0, int G, int c, const float (&lo)[4], const float (&hi)[4], const float (&pre)[8]) const {
    const int b = t0 >> 13, s0 = t0 & 8191;
    if (G < 16) {
      const int sec = G >> 3, hh = (G & 7) >> 1, j = G & 1, i = 32 * j + c;
      float o1[4], o2[4];
#pragma unroll
      for (int e = 0; e < 4; ++e) {
        float cs = pre[e], sn = pre[4 + e];
        o1[e] = lo[e] * cs - hi[e] * sn; o2[e] = hi[e] * cs + lo[e] * sn;
      }
      if (sec == 0) {
#pragma unroll
        for (int e = 0; e < 4; ++e) {
          p.RQ[(size_t)(t0 + e) * 512 + hh * 128 + i] = f2bf(o1[e]);
          p.RQ[(size_t)(t0 + e) * 512 + hh * 128 + 64 + i] = f2bf(o2[e]);
        }
      } else {
        const float sc = 0.08838834764831845f;
        const float lg = logg_h(hh);
#pragma unroll
        for (int e = 0; e < 4; ++e) {
          o1[e] *= sc; o2[e] *= sc;
          p.RK[(size_t)(t0 + e) * 512 + hh * 128 + i] = f2bf(o1[e]);
          p.RK[(size_t)(t0 + e) * 512 + hh * 128 + 64 + i] = f2bf(o2[e]);
          float zeta = __expf((float)(127 - ((s0 + e) & 127)) * lg);
          o1[e] *= zeta; o2[e] *= zeta;
        }
        *(uint2*)(p.RKT + ((size_t)(b * 4 + hh) * 128 + i) * SEQ + s0) = pack4(o1[0], o1[1], o1[2], o1[3]);
        *(uint2*)(p.RKT + ((size_t)(b * 4 + hh) * 128 + 64 + i) * SEQ + s0) = pack4(o2[0], o2[1], o2[2], o2[3]);
      }
    } else if (G < 24) {
      const int hh = (G - 16) >> 1, d = ((G - 16) & 1) * 64 + c;
      *(uint2*)(p.RVT + ((size_t)(b * 4 + hh) * 128 + d) * SEQ + s0) = pack4(lo[0], lo[1], lo[2], lo[3]);
      *(uint2*)(p.RVT + ((size_t)(b * 4 + hh) * 128 + d + 32) * SEQ + s0) = pack4(hi[0], hi[1], hi[2], hi[3]);
    } else if (G < 32) {
      const int hh = (G - 24) >> 1, d = ((G - 24) & 1) * 64 + c;
#pragma unroll
      for (int e = 0; e < 4; ++e) {
        p.RGT[(size_t)(t0 + e) * 512 + hh * 128 + d] = f2bf(siluf(lo[e]));
        p.RGT[(size_t)(t0 + e) * 512 + hh * 128 + d + 32] = f2bf(siluf(hi[e]));
      }
    } else if (G < 40) {
      const int head = G - 32;
#pragma unroll
      for (int e = 0; e < 4; ++e) {
        float cs = pre[e], sn = pre[4 + e];
        const float qs = 0.125f * 1.4426950408889634f;
        float o1 = (lo[e] * cs - hi[e] * sn) * qs, o2 = (hi[e] * cs + lo[e] * sn) * qs;
        p.NQ[(size_t)(t0 + e) * 512 + head * 64 + c] = f2bf(o1);
        p.NQ[(size_t)(t0 + e) * 512 + head * 64 + 32 + c] = f2bf(o2);
      }
    } else if (G < 52) {
      const int k = G - 40, kind = k >> 1, gg = k & 1;
      float o1[4], o2[4];
#pragma unroll
      for (int e = 0; e < 4; ++e) {
        o1[e] = lo[e]; o2[e] = hi[e];
        if ((kind & 1) == 0) {
          float cs = pre[e], sn = pre[4 + e];
          o1[e] = lo[e] * cs - hi[e] * sn; o2[e] = hi[e] * cs + lo[e] * sn;
        }
      }
      if (kind == 3 || kind == 5) {
        bf16_t* dst = (kind == 3 ? p.NVST : p.NVWT) + ((size_t)(b * 2 + gg) * 64 + c) * SEQ + s0;
        *(uint2*)dst = pack4(o1[0], o1[1], o1[2], o1[3]);
        *(uint2*)(dst + (size_t)32 * SEQ) = pack4(o2[0], o2[1], o2[2], o2[3]);
      } else {
        bf16_t* dst = (kind == 0 ? p.NKC : kind == 1 ? p.NVC : kind == 2 ? p.NKS : p.NKW);
#pragma unroll
        for (int e = 0; e < 4; ++e) {
          dst[(size_t)(t0 + e) * 128 + gg * 64 + c] = f2bf(o1[e]);
          dst[(size_t)(t0 + e) * 128 + gg * 64 + 32 + c] = f2bf(o2[e]);
        }
      }
    } else if (G == 52) {
      if (c < 24) {
#pragma unroll
        for (int e = 0; e < 4; ++e) p.GATE[(size_t)(t0 + e) * 24 + c] = sigmoidf(lo[e]);
      }
    }
  }
};
struct EpiOut {
  static constexpr bool kProbe = false;
  const Params& p;
  DI void prefetch(int t0, int G, int c, float (&pre)[8]) const {
    const int c0 = G * 64 + c;
#pragma unroll
    for (int e = 0; e < 4; ++e) { pre[e] = p.x[(size_t)(t0 + e) * DM + c0]; pre[4 + e] = p.x[(size_t)(t0 + e) * DM + c0 + 32]; }
  }
  DI void operator()(int t0, int G, int c, const float (&lo)[4], const float (&hi)[4], const float (&pre)[8]) const {
    const int b = t0 >> 13;
    const int c0 = G * 64 + c, c1 = c0 + 32;
    const float* ga1 = p.mod + b * 6144 + 2048;
    const float g0 = ga1[c0], g1 = ga1[c1];
#pragma unroll
    for (int e = 0; e < 4; ++e) {
      p.out[(size_t)(t0 + e) * DM + c0] = pre[e] + g0 * lo[e];
      p.out[(size_t)(t0 + e) * DM + c1] = pre[4 + e] + g1 * hi[e];
    }
  }
};
struct EpiPQ {
  static constexpr bool kProbe = false;
  const Params& p;
  DI void prefetch(int, int, int, float (&)[8]) const {}
  DI void operator()(int t0, int G, int c, const float (&lo)[4], const float (&hi)[4], const float (&)[8]) const {
#pragma unroll
    for (int e = 0; e < 4; ++e) {
      p.PQ[(size_t)(t0 + e) * 2048 + G * 64 + c] = f2bf(lo[e]);
      p.PQ[(size_t)(t0 + e) * 2048 + G * 64 + 32 + c] = f2bf(hi[e]);
    }
  }
};

DI int crow(int reg, int h) { return (reg & 3) + 8 * (reg >> 2) + 4 * h; }
DI bf16x8 ld16(const bf16_t* ptr) { return *(const bf16x8*)ptr; }
DI bf16x8 ld8x2(const bf16_t* ptr) {
  uint2 a = *(const uint2*)ptr, b = *(const uint2*)(ptr + 8);
  uint4 v; v.x = a.x; v.y = a.y; v.z = b.x; v.w = b.y;
  return __builtin_bit_cast(bf16x8, v);
}
DI bf16x8 pack8(float x0, float x1, float x2, float x3, float x4, float x5, float x6, float x7) {
  uint4 v; v.x = cvt2(x0, x1); v.y = cvt2(x2, x3); v.z = cvt2(x4, x5); v.w = cvt2(x6, x7);
  return __builtin_bit_cast(bf16x8, v);
}

DI void retkv_mfma(const Params& p, int item) {
  const int lane = mytid() & 63, w = mytid() >> 6, r = lane & 31, h = lane >> 5;
  const int hh = item & 3, c = (item >> 2) & 63, b = item >> 8, bh = b * 4 + hh, s0 = c * 128;
  const int mi = w >> 1, nb = (w & 1) * 2;
  const bf16_t* vb_ = p.RVT + ((size_t)(bh * 128 + 32 * mi + r)) * SEQ + s0 + 8 * h;
  const bf16_t* k0 = p.RKT + ((size_t)(bh * 128 + 32 * nb + r)) * SEQ + s0 + 8 * h;
  const bf16_t* k1 = k0 + (size_t)32 * SEQ;
  f32x16 a0 = zero16(), a1 = zero16();
#pragma unroll
  for (int s = 0; s < 8; ++s) {
    bf16x8 a = ld16(vb_ + 16 * s), b0 = ld16(k0 + 16 * s), b1 = ld16(k1 + 16 * s);
    a0 = MFMA32(a, b0, a0); a1 = MFMA32(a, b1, a1);
  }
  float* dst = p.KV + (size_t)item * 16384;
#pragma unroll
  for (int e = 0; e < 16; ++e) {
    const int v = 32 * mi + crow(e, h);
    dst[v * 128 + 32 * nb + r] = a0[e];
    dst[v * 128 + 32 * nb + 32 + r] = a1[e];
  }
}
DI void scan_body(const Params& p, int idx) {
  const int e = idx & 16383, bh = idx >> 14, b = bh >> 2, h = bh & 3;
  const float cd = __expf(128.f * logg_h(h));
  float S = 0.f;
  for (int c0 = 0; c0 < 64; c0 += 8) {
    float kv[8];
#pragma unroll
    for (int u = 0; u < 8; ++u) kv[u] = p.KV[(size_t)((b * 64 + c0 + u) * 4 + h) * 16384 + e];
#pragma unroll
    for (int u = 0; u < 8; ++u) {
      p.SPREV[(size_t)((b * 64 + c0 + u) * 4 + h) * 16384 + e] = f2bf(S);
      S = cd * S + kv[u];
    }
  }
}
DI void retout_mfma(const Params& p, int task) {
  const int lane = mytid() & 63, r = lane & 31, h = lane >> 5;
  const int item = task >> 2, nt = task & 3;
  const int hh = item & 3, c = (item >> 2) & 63, b = item >> 8, bh = b * 4 + hh, s0 = c * 128, t0 = b * SEQ + s0;
  const float lg = logg_h(hh);
  const int n = 32 * nt + r;
  bf16x8 qf[8];
#pragma unroll
  for (int s = 0; s < 8; ++s) qf[s] = ld16(p.RQ + (size_t)(t0 + n) * 512 + hh * 128 + 16 * s + 8 * h);
  f32x16 acc[4];
#pragma unroll
  for (int vi = 0; vi < 4; ++vi) {
    acc[vi] = zero16();
    const bf16_t* sp = p.SPREV + (size_t)item * 16384 + (size_t)(32 * vi + r) * 128 + 8 * h;
#pragma unroll
    for (int s = 0; s < 8; ++s) acc[vi] = MFMA32(ld16(sp + 16 * s), qf[s], acc[vi]);
    __builtin_amdgcn_sched_barrier(0);
  }
  {
    const float xi = __expf((float)(n + 1) * lg);
#pragma unroll
    for (int vi = 0; vi < 4; ++vi)
#pragma unroll
      for (int e = 0; e < 16; ++e) acc[vi][e] *= xi;
  }
  for (int mt = 0; mt <= nt; ++mt) {
    f32x16 sa = zero16();
    const bf16_t* kp = p.RK + (size_t)(t0 + 32 * mt + r) * 512 + hh * 128 + 8 * h;
#pragma unroll
    for (int s = 0; s < 8; ++s) sa = MFMA32(ld16(kp + 16 * s), qf[s], sa);
    float pv[16];
#pragma unroll
    for (int e = 0; e < 16; ++e) {
      const int dm = n - (32 * mt + crow(e, h));
      pv[e] = (dm >= 0) ? sa[e] * __expf((float)dm * lg) : 0.f;
    }
#pragma unroll
    for (int s2 = 0; s2 < 2; ++s2) {
      bf16x8 bfr = pack8(pv[8 * s2], pv[8 * s2 + 1], pv[8 * s2 + 2], pv[8 * s2 + 3], pv[8 * s2 + 4], pv[8 * s2 + 5], pv[8 * s2 + 6], pv[8 * s2 + 7]);
#pragma unroll
      for (int vi = 0; vi < 4; ++vi) {
        bf16x8 afr = ld8x2(p.RVT + ((size_t)(bh * 128 + 32 * vi + r)) * SEQ + s0 + 32 * mt + 16 * s2 + 4 * h);
        acc[vi] = MFMA32(afr, bfr, acc[vi]);
      }
      __builtin_amdgcn_sched_barrier(0);
    }
  }
  float sum = 0.f;
#pragma unroll
  for (int vi = 0; vi < 4; ++vi)
#pragma unroll
    for (int e = 0; e < 16; ++e) sum += acc[vi][e];
  sum += __shfl_xor(sum, 32);
  const float mu = sum * (1.f / 128.f);
  float var = 0.f;
#pragma unroll
  for (int vi = 0; vi < 4; ++vi)
#pragma unroll
    for (int e = 0; e < 16; ++e) { float d = acc[vi][e] - mu; var += d * d; }
  var += __shfl_xor(var, 32);
  const float rs = rsqrtf(var * (1.f / 128.f) + 1e-6f);
#pragma unroll
  for (int vi = 0; vi < 4; ++vi)
#pragma unroll
    for (int g4 = 0; g4 < 4; ++g4) {
      const int v0 = 32 * vi + 8 * g4 + 4 * h;
      uint2 gt = *(const uint2*)(p.RGT + (size_t)(t0 + n) * 512 + hh * 128 + v0);
      float y0 = (acc[vi][4 * g4 + 0] - mu) * rs * __uint_as_float(gt.x << 16);
      float y1 = (acc[vi][4 * g4 + 1] - mu) * rs * __uint_as_float(gt.x & 0xffff0000u);
      float y2 = (acc[vi][4 * g4 + 2] - mu) * rs * __uint_as_float(gt.y << 16);
      float y3 = (acc[vi][4 * g4 + 3] - mu) * rs * __uint_as_float(gt.y & 0xffff0000u);
      *(uint2*)(p.RA + (size_t)(t0 + n) * DM + hh * 128 + v0) = pack4(y0, y1, y2, y3);
    }
}
#define HID_STRIDE 264
DI void compress_mfma(const Params& p, int item, char* smem) {
  bf16_t* HIDL = (bf16_t*)smem;
  const int lane = mytid() & 63, w = mytid() >> 6, r = lane & 31, h = lane >> 5;
  const int kv = item >> 6, bg = (item >> 4) & 3, rt = item & 15, n0 = rt * 32, b = bg >> 1, g = bg & 1;
  const bf16_t* src = kv ? p.NVC : p.NKC; const bf16_t* W1 = kv ? p.W1Tv : p.W1Tk; const bf16_t* W2 = kv ? p.W2Tv : p.W2Tk;
  const float* B1 = kv ? p.B1Pv : p.B1Pk;
  {
    const int n = min(n0 + r, 510);
    const bf16_t* ab = src + ((size_t)(b * SEQ + 16 * n)) * 128 + g * 64 + 8 * h;
    const bf16_t* bb = W1 + (size_t)(32 * w + r) * 2048 + 8 * h;
    f32x16 acc = zero16();
#pragma unroll 8
    for (int s = 0; s < 128; ++s) acc = MFMA32(ld16(ab + (s >> 2) * 128 + (s & 3) * 16), ld16(bb + 16 * s), acc);
    const float bias = B1[32 * w + r];
#pragma unroll
    for (int e = 0; e < 16; ++e) HIDL[crow(e, h) * HID_STRIDE + 32 * w + r] = f2bf(gelu_tanh(acc[e] + bias));
  }
  __syncthreads();
  if (w < 2) {
    f32x16 acc = zero16();
#pragma unroll
    for (int s = 0; s < 16; ++s) acc = MFMA32(ld16(HIDL + r * HID_STRIDE + 16 * s + 8 * h), ld16(W2 + (size_t)(32 * w + r) * 256 + 16 * s + 8 * h), acc);
    const int e_ = 32 * w + r;
    if (kv == 0) {
#pragma unroll
      for (int e = 0; e < 16; ++e) { const int n = n0 + crow(e, h); p.KC[((size_t)bg * 512 + n) * 64 + e_] = (n < 511) ? f2bf(acc[e]) : (bf16_t)0; }
    } else {
#pragma unroll
      for (int g4 = 0; g4 < 4; ++g4) {
        const int n = n0 + 8 * g4 + 4 * h;
        float v3 = (n + 3 < 511) ? acc[4 * g4 + 3] : 0.f;
        *(uint2*)(p.VCT + ((size_t)bg * 64 + e_) * 512 + n) = pack4(acc[4 * g4], acc[4 * g4 + 1], acc[4 * g4 + 2], v3);
      }
    }
  }
  __syncthreads();
}
DI void kmax_body2(const Params& p, int vb) {
  const int tid = mytid(), g = tid & 1, t = vb * 256 + (tid >> 1), b = t >> 13;
  const bf16_t* k = p.NKS + (size_t)t * 128 + g * 64; const bf16_t* kw = p.NKW + (size_t)t * 128 + g * 64;
  float ss = 0.f, sw = 0.f;
  for (int d = 0; d < 64; d += 8) {
    uint4 a = *(const uint4*)(k + d), c = *(const uint4*)(kw + d);
    const unsigned aa[4] = {a.x, a.y, a.z, a.w}, cc[4] = {c.x, c.y, c.z, c.w};
#pragma unroll
    for (int q = 0; q < 4; ++q) {
      float x0 = __uint_as_float(aa[q] << 16), x1 = __uint_as_float(aa[q] & 0xffff0000u);
      float y0 = __uint_as_float(cc[q] << 16), y1 = __uint_as_float(cc[q] & 0xffff0000u);
      ss += x0 * x0 + x1 * x1; sw += y0 * y0 + y1 * y1;
    }
  }
  float m1 = sqrtf(ss), m2 = sqrtf(sw);
  for (int o = 2; o < 64; o <<= 1) { m1 = fmaxf(m1, __shfl_xor(m1, o)); m2 = fmaxf(m2, __shfl_xor(m2, o)); }
  if ((tid & 63) < 2) { atomicMax(&p.ksmax[b * 2 + g], __float_as_uint(m1)); atomicMax(&p.ksmax[4 + b * 2 + g], __float_as_uint(m2)); }
}
DI void kcmax_body(const Params& p, int idx) {
  const bf16_t* k = p.KC + (size_t)idx * 64;
  float ss = 0.f;
  for (int d = 0; d < 64; ++d) { float v = bf2f(k[d]); ss += v * v; }
  atomicMax(&p.ksmax[8 + (idx >> 9)], __float_as_uint(sqrtf(ss)));
}

#define NSA_IMP 0
#define NSA_SELM 65536
#define NSA_KV 66816
#define KV_ROW 144
#define KV_TILE (64 * KV_ROW)
template <int CTRL> DI float dpp_f2(float x) { return __builtin_bit_cast(float, __builtin_amdgcn_mov_dpp(__builtin_bit_cast(int, x), CTRL, 0xf, 0xf, true)); }
DI float quad_sum(float v) { v += dpp_f2<0xB1>(v); v += dpp_f2<0x4E>(v); return v; }
DI bf16x8 lds8x2(const char* ptr) {
  uint2 a = *(const uint2*)ptr, b = *(const uint2*)(ptr + 16);
  uint4 v; v.x = a.x; v.y = a.y; v.z = b.x; v.w = b.y;
  return __builtin_bit_cast(bf16x8, v);
}

DI void nsa_item(const Params& p, int item, char* smem) {
  const int tid = mytid(), lane = tid & 63, w = tid >> 6, r = lane & 31, h = lane >> 5;
  const int ti = item >> 2, bg = item & 3, b = bg >> 1, g = bg & 1;
  const int ts = ti * 64, tokg0 = b * SEQ + ts;
  const int tkl = 8 * w + (r >> 2), hl = r & 3, hd = g * 4 + hl, tpos = ts + tkl;
  float* IMPA = (float*)(smem + NSA_IMP); float* IMPB = IMPA + 64 * 128;
  unsigned* SELM = (unsigned*)(smem + NSA_SELM);
  char* KVB = smem + NSA_KV;
  const float ksm = __uint_as_float(p.ksmax[bg]), kwm = __uint_as_float(p.ksmax[4 + bg]), kcm = __uint_as_float(p.ksmax[8 + bg]);

  bf16x8 qf[4];
#pragma unroll
  for (int s = 0; s < 4; ++s) qf[s] = ld16(p.NQ + (size_t)(tokg0 + tkl) * 512 + hd * 64 + 16 * s + 8 * h);
  float qq = 0.f;
#pragma unroll
  for (int s = 0; s < 4; ++s) {
    uint4 u = __builtin_bit_cast(uint4, qf[s]);
    const unsigned uu[4] = {u.x, u.y, u.z, u.w};
#pragma unroll
    for (int q = 0; q < 4; ++q) { float x0 = __uint_as_float(uu[q] << 16), x1 = __uint_as_float(uu[q] & 0xffff0000u); qq += x0 * x0 + x1 * x1; }
  }
  qq += __shfl_xor(qq, 32);
  const float qn = sqrtf(qq);
  const int srow = tid >> 3, sch = tid & 7;
  const bf16_t* ksrc = p.NKS + ((size_t)(b * SEQ) + srow) * 128 + g * 64 + sch * 8;
  const bf16_t* vsrc = p.NVST + ((size_t)bg * 64 + srow) * SEQ + sch * 8;
  char* sdst = KVB + srow * KV_ROW + sch * 16;
  {
    uint4 k0 = *(const uint4*)ksrc, v0 = *(const uint4*)vsrc;
    *(uint4*)sdst = k0; *(uint4*)(sdst + KV_TILE) = v0;
  }
  for (int q = tid; q < 64 * 128 * 2 / 4; q += NT) ((float4*)IMPA)[q] = make_float4(0.f, 0.f, 0.f, 0.f);
  __syncthreads();

  const float mbc = qn * kcm;
  int nvalid = (tpos >= 31) ? ((tpos - 31) >> 4) + 1 : 0;
  if (nvalid > 511) nvalid = 511;
  int nvw = (ts + 8 * w + 7 >= 31) ? ((ts + 8 * w + 7 - 31) >> 4) + 1 : 0;
  if (nvw > 511) nvw = 511;
  const int nkt = (nvw + 31) >> 5;
  int nvmin = (ts + 8 * w >= 31) ? ((ts + 8 * w - 31) >> 4) + 1 : 0;
  if (nvmin > 511) nvmin = 511;
  const bf16_t* kcb = p.KC + ((size_t)bg * 512 + r) * 64 + 8 * h;
  float lsum = 0.f, invl = 0.f;
  for (int rep521 = 0; rep521 < (PROBE_DUP == 521 ? 2 : 1); ++rep521) {
  lsum = 0.f;
  for (int kt = 0; kt < nkt; ++kt) {
    f32x16 sa = fill16(-mbc);
#pragma unroll
    for (int s = 0; s < 4; ++s) sa = MFMA32(ld16(kcb + (size_t)kt * 32 * 64 + 16 * s), qf[s], sa);
    if (32 * kt + 32 <= nvmin) {
#pragma unroll
      for (int e = 0; e < 16; ++e) lsum += ex2(sa[e]);
    } else {
#pragma unroll
      for (int e = 0; e < 16; ++e) { const int n = 32 * kt + crow(e, h); lsum += (n < nvalid) ? ex2(sa[e]) : 0.f; }
    }
  }
  lsum += __shfl_xor(lsum, 32);
  invl = (lsum > 0.f) ? 1.f / lsum : 0.f;
  for (int kt = 0; kt < nkt; ++kt) {
    f32x16 sa = fill16(-mbc);
#pragma unroll
    for (int s = 0; s < 4; ++s) sa = MFMA32(ld16(kcb + (size_t)kt * 32 * 64 + 16 * s), qf[s], sa);
    float pv[16];
    if (32 * kt + 32 <= nvmin) {
#pragma unroll
      for (int e = 0; e < 16; ++e) pv[e] = ex2(sa[e]) * invl;
    } else {
#pragma unroll
      for (int e = 0; e < 16; ++e) { const int n = 32 * kt + crow(e, h); pv[e] = (n < nvalid) ? ex2(sa[e]) * invl : 0.f; }
    }
#pragma unroll
    for (int q = 0; q < 4; ++q) {
      float A = 2.f * (pv[4 * q] + pv[4 * q + 1] + pv[4 * q + 2]) + pv[4 * q + 3], Bv = pv[4 * q + 3];
      A = quad_sum(A); Bv = quad_sum(Bv);
      if (hl == 0) { const int j = 8 * kt + 2 * q + h; IMPA[tkl * 128 + j] = A; IMPB[tkl * 128 + j] = Bv; }
    }
  }
  }
  for (int rep522 = 0; rep522 < (PROBE_DUP == 522 ? 2 : 1); ++rep522)
  {
    const int tl = 8 * w + (lane >> 3), sub = lane & 7;
    unsigned kv_[16], ki_[16];
#pragma unroll
    for (int c = 0; c < 16; ++c) {
      const int j = sub + 8 * c;
      float imp = IMPA[tl * 128 + j] + ((j > 0) ? IMPB[tl * 128 + j - 1] : 0.f);
      if (j == 0 || j == ti || j == ti - 1) imp = 1e9f;
      kv_[c] = (j <= ti) ? __float_as_uint(imp) : 0u;
      ki_[c] = (j <= ti) ? (unsigned)(128 - j) : 0u;
    }
    unsigned m0 = 0, m1 = 0, m2 = 0, m3 = 0;
    for (int it = 0; it < 16; ++it) {
      unsigned bv = kv_[0], bi = ki_[0];
#pragma unroll
      for (int c = 1; c < 16; ++c) { const bool gt = (kv_[c] > bv) || (kv_[c] == bv && ki_[c] > bi); bv = gt ? kv_[c] : bv; bi = gt ? ki_[c] : bi; }
#define TOPK_STEP(CTRL) { const unsigned ov = (unsigned)__builtin_amdgcn_mov_dpp((int)bv, CTRL, 0xf, 0xf, true), oi = (unsigned)__builtin_amdgcn_mov_dpp((int)bi, CTRL, 0xf, 0xf, true); \
        const bool gt = (ov > bv) || (ov == bv && oi > bi); bv = gt ? ov : bv; bi = gt ? oi : bi; }
      TOPK_STEP(0xB1) TOPK_STEP(0x4E) TOPK_STEP(0x141)
#undef TOPK_STEP
      if (bi != 0u) {
        const int js = 128 - (int)bi;
        const unsigned bit = 1u << (js & 31);
        if ((js >> 5) == 0) m0 |= bit; else if ((js >> 5) == 1) m1 |= bit; else if ((js >> 5) == 2) m2 |= bit; else m3 |= bit;
#pragma unroll
        for (int c = 0; c < 16; ++c) { const bool hit = (ki_[c] == bi); kv_[c] = hit ? 0u : kv_[c]; ki_[c] = hit ? 0u : ki_[c]; }
      }
    }
    if (sub == 0) { SELM[tl * 4 + 0] = m0; SELM[tl * 4 + 1] = m1; SELM[tl * 4 + 2] = m2; SELM[tl * 4 + 3] = m3; }
  }
  if (lane < 4) {
    unsigned u = 0;
#pragma unroll
    for (int t8 = 0; t8 < 8; ++t8) u |= SELM[(8 * w + t8) * 4 + lane];
    SELM[(64 + w) * 4 + lane] = u;
  }
  const float mbs = qn * ksm;
  f32x16 osl[2]; osl[0] = zero16(); osl[1] = zero16();
  float lsel = 0.f;
#define RING_STEP(U, KCUR, VCUR, KNXT, VNXT, KS, KSTEP, VS, VSTEP, NTILES, NEED, COMPUTE)                                                   \
    {                                                                                                                                       \
      const int jj = jj0 + U;                                                                                                               \
      if (jj < (NTILES)) {                                                                                                                  \
        if (jj + 2 < (NTILES)) { KCUR = *(const uint4*)((KS) + (size_t)(jj + 2) * (KSTEP)); VCUR = *(const uint4*)((VS) + (size_t)(jj + 2) * (VSTEP)); } \
        if (NEED(jj)) {                                                                                                                     \
          const char* kb = KVB + (jj & 1) * 2 * KV_TILE;                                                                                    \
          const char* vbuf = kb + KV_TILE;                                                                                                  \
          COMPUTE(jj, kb, vbuf)                                                                                                             \
        }                                                                                                                                   \
        if (jj + 1 < (NTILES)) { char* d2 = sdst + ((jj + 1) & 1) * 2 * KV_TILE; *(uint4*)d2 = KNXT; *(uint4*)(d2 + KV_TILE) = VNXT; }      \
        __syncthreads();                                                                                                                    \
      }                                                                                                                                     \
    }
#define RING_RUN(KS, KSTEP, VS, VSTEP, NTILES, NEED, COMPUTE)                                                                               \
  {                                                                                                                                         \
    uint4 kn0, kn1, vn0, vn1;       \
    kn0 = kn1 = vn0 = vn1 = make_uint4(0u, 0u, 0u, 0u);                                                                                     \
    if (1 < (NTILES)) { kn1 = *(const uint4*)((KS) + (size_t)1 * (KSTEP)); vn1 = *(const uint4*)((VS) + (size_t)1 * (VSTEP)); }             \
    for (int jj0 = 0; jj0 < (NTILES); jj0 += 2) {                                                                                           \
      RING_STEP(0, kn0, vn0, kn1, vn1, KS, KSTEP, VS, VSTEP, NTILES, NEED, COMPUTE)                                                         \
      RING_STEP(1, kn1, vn1, kn0, vn0, KS, KSTEP, VS, VSTEP, NTILES, NEED, COMPUTE)                                                         \
    }                                                                                                                                       \
  }
#define STAGE_TILE0(KS, VS) { uint4 k0_ = *(const uint4*)(KS), v0_ = *(const uint4*)(VS); *(uint4*)sdst = k0_; *(uint4*)(sdst + KV_TILE) = v0_; __syncthreads(); }
#define ATT_TILE(kb, vbuf, INIT, FULL, MASKEXPR, SCALE, ACC, LACC)                                                                          \
          {                                                                                                                                 \
            _Pragma("unroll") for (int kh = 0; kh < 2; ++kh) {                                                                              \
              f32x16 sa = fill16(INIT);                                                                                                     \
              _Pragma("unroll") for (int s = 0; s < 4; ++s) sa = MFMA32(*(const bf16x8*)(kb + (32 * kh + r) * KV_ROW + (16 * s + 8 * h) * 2), qf[s], sa); \
              float pv[16];                                                                                                                 \
              if (FULL) {                                                                                                                   \
                _Pragma("unroll") for (int e = 0; e < 16; ++e) { pv[e] = ex2(sa[e]) * (SCALE); LACC += pv[e]; }                             \
              } else {                                                                                                                      \
                _Pragma("unroll") for (int e = 0; e < 16; ++e) { const int key = 32 * kh + crow(e, h); pv[e] = (MASKEXPR) ? ex2(sa[e]) * (SCALE) : 0.f; LACC += pv[e]; } \
              }                                                                                                                             \
              const bf16x8 pk0 = pack8(pv[0], pv[1], pv[2], pv[3], pv[4], pv[5], pv[6], pv[7]);                                             \
              const bf16x8 pk1 = pack8(pv[8], pv[9], pv[10], pv[11], pv[12], pv[13], pv[14], pv[15]);                                       \
              _Pragma("unroll") for (int di = 0; di < 2; ++di) {                                                                            \
                ACC[di] = MFMA32(lds8x2(vbuf + (32 * di + r) * KV_ROW + (32 * kh + 4 * h) * 2), pk0, ACC[di]);                              \
                ACC[di] = MFMA32(lds8x2(vbuf + (32 * di + r) * KV_ROW + (32 * kh + 16 + 4 * h) * 2), pk1, ACC[di]);                         \
              }                                                                                                                             \
            }                                                                                                                               \
          }
#define SEL_NEED(jj) ((SELM[(64 + w) * 4 + ((jj) >> 5)] >> ((jj) & 31)) & 1u)
#define SEL_COMPUTE(jj, kb, vbuf) { const unsigned msel_ = SELM[tkl * 4 + ((jj) >> 5)]; \
      const float init_ = ((msel_ >> ((jj) & 31)) & 1u) ? -mbs : NEG_INF; ATT_TILE(kb, vbuf, init_, (jj) < ti, key <= tkl, 1.f, osl, lsel) }
  RING_RUN(ksrc, 64 * 128, vsrc, 64, ti + 1, SEL_NEED, SEL_COMPUTE)
  lsel += __shfl_xor(lsel, 32);
  const float* gt = p.GATE + (size_t)(tokg0 + tkl) * 24 + hd * 3;
  f32x16 outacc[2];
  {
    const float g1 = gt[1] / lsel;
#pragma unroll
    for (int e = 0; e < 16; ++e) { outacc[0][e] = g1 * osl[0][e]; outacc[1][e] = g1 * osl[1][e]; }
  }
  {
  f32x16 oc[2]; oc[0] = zero16(); oc[1] = zero16();
  {
    int nvall = (ts + 63 >= 31) ? ((ts + 63 - 31) >> 4) + 1 : 0;
    if (nvall > 511) nvall = 511;
    const int nct = (nvall + 63) >> 6;
    if (nct > 0) {
      const bf16_t* kcs = p.KC + ((size_t)bg * 512 + srow) * 64 + sch * 8;
      const bf16_t* vcs = p.VCT + ((size_t)bg * 64 + srow) * 512 + sch * 8;
      float ldummy = 0.f;
      STAGE_TILE0(kcs, vcs)
#define CMP_NEED(jj) (64 * (jj) < nvw)
#define CMP_COMPUTE(jj, kb, vbuf) ATT_TILE(kb, vbuf, -mbc, 64 * (jj) + 64 <= nvmin, 64 * (jj) + key < nvalid, invl, oc, ldummy)
      RING_RUN(kcs, 64 * 64, vcs, 64, nct, CMP_NEED, CMP_COMPUTE)
    }
  }
  {
    const float g0 = gt[0];
#pragma unroll
    for (int e = 0; e < 16; ++e) { outacc[0][e] += g0 * oc[0][e]; outacc[1][e] += g0 * oc[1][e]; }
  }
  }
  f32x16 ow[2]; ow[0] = zero16(); ow[1] = zero16();
  float lw = 0.f;
  const float mbw = qn * kwm;
  {
    const int j0w = (ti >= 8) ? ti - 8 : 0, nwt = ti - j0w + 1;
    const bf16_t* kws = p.NKW + ((size_t)(b * SEQ + 64 * j0w) + srow) * 128 + g * 64 + sch * 8;
    const bf16_t* vws = p.NVWT + ((size_t)bg * 64 + srow) * SEQ + 64 * j0w + sch * 8;
    STAGE_TILE0(kws, vws)
#define WIN_NEED(jj) true
#define WIN_COMPUTE(jj, kb, vbuf) { const int jw_ = j0w + (jj); const bool last_ = (jw_ == ti), first_ = (ti >= 8) && ((jj) == 0); \
      ATT_TILE(kb, vbuf, -mbw, !(last_ || first_), last_ ? (key <= tkl) : (key > tkl), 1.f, ow, lw) }
    RING_RUN(kws, 64 * 128, vws, 64, nwt, WIN_NEED, WIN_COMPUTE)
  }
  lw += __shfl_xor(lw, 32);
  {
    const float g2 = gt[2] / lw;
#pragma unroll
    for (int di = 0; di < 2; ++di)
#pragma unroll
      for (int g4 = 0; g4 < 4; ++g4) {
        const int d0 = 32 * di + 8 * g4 + 4 * h;
        float y[4];
#pragma unroll
        for (int e = 0; e < 4; ++e) y[e] = outacc[di][4 * g4 + e] + g2 * ow[di][4 * g4 + e];
        *(uint2*)(p.RA + (size_t)(tokg0 + tkl) * DM + 512 + hd * 64 + d0) = pack4(y[0], y[1], y[2], y[3]);
      }
  }
}

typedef float f32x4 __attribute__((ext_vector_type(4)));
#define MFMA16(a, b, c) __builtin_amdgcn_mfma_f32_16x16x32_bf16((a), (b), (c), 0, 0, 0)
constexpr int pk_clen(int i) { return 16 / (i + 1); }
constexpr int pk_coff(int i) { int s = 0; for (int q = 0; q < i; ++q) s += pk_clen(q); return s; }
#define SC_STRIDE 132

DI void peer_topk_tile(const Params& p, int vb, char* smem) {
  float* SC = (float*)smem;
  unsigned* ELK = (unsigned*)(smem + 256 * SC_STRIDE * 4);
  float* ELW = (float*)(ELK + 16 * 128);
  const int tid = mytid(), lane = tid & 63, w = tid >> 6;
  const int t0 = vb * 16;
  {
    const int tq = lane & 15, kq = lane >> 4;
#pragma unroll
    for (int pi = 0; pi < 2; ++pi) {
      const int ph = 2 * w + pi;
      bf16x8 bfr[4];
#pragma unroll
      for (int s = 0; s < 4; ++s) bfr[s] = *(const bf16x8*)(p.PQ + (size_t)(t0 + tq) * 2048 + ph * 128 + 32 * s + 8 * kq);
#pragma unroll
      for (int j = 0; j < 8; ++j) {
        f32x4 acc = {0.f, 0.f, 0.f, 0.f};
#pragma unroll
        for (int s = 0; s < 4; ++s) {
          bf16x8 afr = *(const bf16x8*)(p.SUBK + ((size_t)(ph * 128 + 16 * j + tq)) * 128 + 32 * s + 8 * kq);
          acc = MFMA16(afr, bfr[s], acc);
        }
        *(f32x4*)(SC + (ph * 16 + tq) * SC_STRIDE + 16 * j + 4 * kq) = acc;
      }
    }
  }
  __syncthreads();
  if (tid < 256) {
    float* row = SC + tid * SC_STRIDE;
    float gmax[16];
#pragma unroll
    for (int g = 0; g < 16; ++g) {
      float4 a = *(float4*)(row + g * 8), b = *(float4*)(row + g * 8 + 4);
      gmax[g] = fmaxf(fmaxf(fmaxf(a.x, a.y), fmaxf(a.z, a.w)), fmaxf(fmaxf(b.x, b.y), fmaxf(b.z, b.w)));
    }
    float outv[16]; int outi[16];
#pragma unroll
    for (int k = 0; k < 16; ++k) {
      float gm = gmax[0]; int gi = 0;
#pragma unroll
      for (int g = 1; g < 16; ++g) { bool c = gmax[g] > gm; gm = c ? gmax[g] : gm; gi = c ? g : gi; }
      float* gp = row + gi * 8;
      float4 a = *(float4*)gp, b = *(float4*)(gp + 4);
      float v[8] = {a.x, a.y, a.z, a.w, b.x, b.y, b.z, b.w};
      int ei = 7;
#pragma unroll
      for (int e = 6; e >= 0; --e) ei = (v[e] == gm) ? e : ei;
      float nm = NEG_INF;
#pragma unroll
      for (int e = 0; e < 8; ++e) { float x = (e == ei) ? NEG_INF : v[e]; nm = fmaxf(nm, x); }
      gp[ei] = NEG_INF;
#pragma unroll
      for (int g = 0; g < 16; ++g) gmax[g] = (g == gi) ? nm : gmax[g];
      outv[k] = gm; outi[k] = gi * 8 + ei;
    }
#pragma unroll
    for (int k = 0; k < 16; ++k) { row[k] = outv[k]; row[16 + k] = __int_as_float(outi[k]); }
  }
  __syncthreads();
  if (tid < 128) {
    const int t = tid >> 3, pp = tid & 7;
    const float* ra = SC + ((2 * pp) * 16 + t) * SC_STRIDE;
    const float* rb = SC + ((2 * pp + 1) * 16 + t) * SC_STRIDE;
    float a[16], b[16]; int ia[16], ib[16];
#pragma unroll
    for (int q = 0; q < 4; ++q) {
      float4 x = *(const float4*)(ra + 4 * q), y = *(const float4*)(rb + 4 * q);
      float4 xi = *(const float4*)(ra + 16 + 4 * q), yi = *(const float4*)(rb + 16 + 4 * q);
      a[4 * q] = x.x; a[4 * q + 1] = x.y; a[4 * q + 2] = x.z; a[4 * q + 3] = x.w;
      b[4 * q] = y.x; b[4 * q + 1] = y.y; b[4 * q + 2] = y.z; b[4 * q + 3] = y.w;
      ia[4 * q] = __float_as_int(xi.x); ia[4 * q + 1] = __float_as_int(xi.y); ia[4 * q + 2] = __float_as_int(xi.z); ia[4 * q + 3] = __float_as_int(xi.w);
      ib[4 * q] = __float_as_int(yi.x); ib[4 * q + 1] = __float_as_int(yi.y); ib[4 * q + 2] = __float_as_int(yi.z); ib[4 * q + 3] = __float_as_int(yi.w);
    }
    float cs[50]; int cc[50];
#pragma unroll
    for (int i = 0; i < 16; ++i)
#pragma unroll
      for (int j = 0; j < pk_clen(i); ++j) { cs[pk_coff(i) + j] = a[i] + b[j]; cc[pk_coff(i) + j] = ia[i] * 128 + ib[j]; }
    float v16[16]; int c16[16];
#pragma unroll
    for (int k = 0; k < 16; ++k) {
      float best = cs[0]; int bi = 0, bc = cc[0];
#pragma unroll
      for (int q = 1; q < 50; ++q) { bool c = cs[q] > best; best = c ? cs[q] : best; bi = c ? q : bi; bc = c ? cc[q] : bc; }
#pragma unroll
      for (int q = 0; q < 50; ++q) cs[q] = (q == bi) ? NEG_INF : cs[q];
      v16[k] = best; c16[k] = bc;
    }
    float l = 0.f; const float vmax = v16[0];
#pragma unroll
    for (int k = 0; k < 16; ++k) { v16[k] = __expf(v16[k] - vmax); l += v16[k]; }
    float inv = 1.f / l;
#pragma unroll
    for (int k = 0; k < 16; ++k) {
      ELK[t * 128 + pp * 16 + k] = ((unsigned)c16[k] << 7) | (unsigned)(pp * 16 + k);
      ELW[t * 128 + pp * 16 + k] = v16[k] * inv;
    }
  }
  __syncthreads();
#pragma unroll
  for (int tt = 0; tt < 2; ++tt) {
    const int t = 2 * w + tt;
    unsigned e0 = ELK[t * 128 + 2 * lane], e1 = ELK[t * 128 + 2 * lane + 1];
#pragma unroll
    for (int k = 2; k <= 128; k <<= 1) {
#pragma unroll
      for (int j = k >> 1; j > 0; j >>= 1) {
        if (j == 1) {
          bool up = ((2 * lane) & k) == 0;
          unsigned lo = min(e0, e1), hi = max(e0, e1);
          e0 = up ? lo : hi; e1 = up ? hi : lo;
        } else {
          unsigned o0 = __shfl_xor(e0, j >> 1), o1 = __shfl_xor(e1, j >> 1);
          bool up = ((2 * lane) & k) == 0;
          bool lower = ((2 * lane) & j) == 0;
          bool keepmin = (up == lower);
          e0 = keepmin ? min(e0, o0) : max(e0, o0);
          e1 = keepmin ? min(e1, o1) : max(e1, o1);
        }
      }
    }
    const size_t gb = (size_t)(t0 + t) * 128 + 2 * lane;
    p.EIDX[gb] = (int)(e0 >> 7); p.EIDX[gb + 1] = (int)(e1 >> 7);
    p.EW[gb] = ELW[t * 128 + (e0 & 127)]; p.EW[gb + 1] = ELW[t * 128 + (e1 & 127)];
  }
  __syncthreads();
}

DI float dot2bf(unsigned a, unsigned b, float acc) { return __builtin_amdgcn_fdot2_f32_bf16(__builtin_bit_cast(bf16x2_t, a), __builtin_bit_cast(bf16x2_t, b), acc, false); }
template <int CTRL> DI float dpp_f(float x) { return __builtin_bit_cast(float, __builtin_amdgcn_mov_dpp(__builtin_bit_cast(int, x), CTRL, 0xf, 0xf, true)); }
DI float row16_sum(float v) { v += dpp_f<0x128>(v); v += dpp_f<0x124>(v); v += dpp_f<0x122>(v); v += dpp_f<0x121>(v); return v; }
DI float dot_row(const uint4 (&u)[8], const uint4 (&h)[8]) {
  float d = 0.f;
#pragma unroll
  for (int j = 0; j < 8; ++j) { d = dot2bf(u[j].x, h[j].x, d); d = dot2bf(u[j].y, h[j].y, d); d = dot2bf(u[j].z, h[j].z, d); d = dot2bf(u[j].w, h[j].w, d); }
  return row16_sum(d);
}
DI void axpy_row(float (&acc)[64], const uint4 (&v)[8], float c) {
#pragma unroll
  for (int j = 0; j < 8; ++j) {
    const unsigned ww[4] = {v[j].x, v[j].y, v[j].z, v[j].w};
#pragma unroll
    for (int q = 0; q < 4; ++q) {
      acc[j * 8 + 2 * q] += c * __uint_as_float(ww[q] << 16);
      acc[j * 8 + 2 * q + 1] += c * __uint_as_float(ww[q] & 0xffff0000u);
    }
  }
}
DI void axpy_half(float (&acc)[32], const uint4 (&v)[4], float c) {
#pragma unroll
  for (int j = 0; j < 4; ++j) {
    const unsigned ww[4] = {v[j].x, v[j].y, v[j].z, v[j].w};
#pragma unroll
    for (int q = 0; q < 4; ++q) {
      acc[j * 8 + 2 * q] += c * __uint_as_float(ww[q] << 16);
      acc[j * 8 + 2 * q + 1] += c * __uint_as_float(ww[q] & 0xffff0000u);
    }
  }
}
#ifndef PEER_TILE_SHIFT
#define PEER_TILE_SHIFT 8
#endif
DI void fma16_fp8(float& d, const uint4& u, const float* hv) {
  const unsigned ww[4] = {u.x, u.y, u.z, u.w};
#pragma unroll
  for (int q = 0; q < 4; ++q) {
    f32x2_t a = __builtin_amdgcn_cvt_pk_f32_fp8((int)ww[q], false), b = __builtin_amdgcn_cvt_pk_f32_fp8((int)ww[q], true);
    d += a[0] * hv[4 * q] + a[1] * hv[4 * q + 1] + b[0] * hv[4 * q + 2] + b[1] * hv[4 * q + 3];
  }
}
DI float dot_row8(const uint4 (&u)[4], const float (&hv)[64]) {
  float d0 = 0.f, d1 = 0.f;
  fma16_fp8(d0, u[0], hv); fma16_fp8(d1, u[1], hv + 16); fma16_fp8(d0, u[2], hv + 32); fma16_fp8(d1, u[3], hv + 48);
  return row16_sum(d0 + d1);
}
DI void axpy_row8(float (&acc)[64], const uint4 (&v)[4], float c) {
#pragma unroll
  for (int j = 0; j < 4; ++j) {
    const unsigned ww[4] = {v[j].x, v[j].y, v[j].z, v[j].w};
#pragma unroll
    for (int q = 0; q < 4; ++q) {
      f32x2_t a = __builtin_amdgcn_cvt_pk_f32_fp8((int)ww[q], false), b = __builtin_amdgcn_cvt_pk_f32_fp8((int)ww[q], true);
      acc[j * 16 + 4 * q] += c * a[0]; acc[j * 16 + 4 * q + 1] += c * a[1]; acc[j * 16 + 4 * q + 2] += c * b[0]; acc[j * 16 + 4 * q + 3] += c * b[1];
    }
  }
}
DI void peer_gather_block(const Params& p, int vb, char* smem) {
  unsigned* ELK = (unsigned*)smem;
  float* ELC = (float*)(smem + 32768);
  const int tid = mytid(), lane = tid & 63, w = tid >> 6, grp = lane >> 4, i = lane & 15;
  const int tokbase = vb * 64;
  for (int q = tid; q < 64 * 128 / 4; q += NT) {
    ((uint4*)ELK)[q] = ((const uint4*)(p.EIDX + (size_t)tokbase * 128))[q];
    ((float4*)ELC)[q] = ((const float4*)(p.EW + (size_t)tokbase * 128))[q];
  }
  __syncthreads();
#pragma unroll 1
  for (int tt = 0; tt < 2; ++tt) {
    const int tl = w * 8 + grp * 2 + tt, tok = tokbase + tl;
    const unsigned* kk = ELK + tl * 128;
    float* cc = ELC + tl * 128;
    uint4 b0[4], b1[4], b2[4], b3[4];
#define ROW_LOAD(BUF, BASE, E) { const unsigned e_ = kk[E]; _Pragma("unroll") for (int j = 0; j < 4; ++j) BUF[j] = *(const uint4*)(BASE + (size_t)e_ * DM + j * 256); }
    {
      float hv[64];
#pragma unroll
      for (int j = 0; j < 4; ++j)
#pragma unroll
        for (int hf = 0; hf < 2; ++hf) {
          uint4 a = *(const uint4*)(p.RA + (size_t)tok * DM + j * 256 + i * 16 + hf * 8);
          const unsigned aa[4] = {a.x, a.y, a.z, a.w};
#pragma unroll
          for (int q = 0; q < 4; ++q) { hv[j * 16 + hf * 8 + 2 * q] = __uint_as_float(aa[q] << 16); hv[j * 16 + hf * 8 + 2 * q + 1] = __uint_as_float(aa[q] & 0xffff0000u); }
        }
      const unsigned char* ub_ = p.PDN8 + i * 16;
#define DN_COMP(BUF, E) { const unsigned e_ = kk[E]; float d_ = dot_row8(BUF, hv) * p.SDN[e_]; float c_ = cc[E] * gelu_tanh(d_) * p.SUP[e_]; if (i == 0) cc[E] = c_; }
      ROW_LOAD(b0, ub_, 0) ROW_LOAD(b1, ub_, 1) ROW_LOAD(b2, ub_, 2) ROW_LOAD(b3, ub_, 3)
      for (int e = 0; e < 128; e += 4) {
        DN_COMP(b0, e)     if (e + 4 < 128) ROW_LOAD(b0, ub_, e + 4)
        DN_COMP(b1, e + 1) if (e + 4 < 128) ROW_LOAD(b1, ub_, e + 5)
        DN_COMP(b2, e + 2) if (e + 4 < 128) ROW_LOAD(b2, ub_, e + 6)
        DN_COMP(b3, e + 3) if (e + 4 < 128) ROW_LOAD(b3, ub_, e + 7)
      }
#undef DN_COMP
    }
    {
      float acc[64];
#pragma unroll
      for (int e = 0; e < 64; ++e) acc[e] = 0.f;
      const unsigned char* vbase = p.PUP8 + i * 16;
      ROW_LOAD(b0, vbase, 0) ROW_LOAD(b1, vbase, 1) ROW_LOAD(b2, vbase, 2) ROW_LOAD(b3, vbase, 3)
      for (int e = 0; e < 128; e += 4) {
        axpy_row8(acc, b0, cc[e]);     if (e + 4 < 128) ROW_LOAD(b0, vbase, e + 4)
        axpy_row8(acc, b1, cc[e + 1]); if (e + 4 < 128) ROW_LOAD(b1, vbase, e + 5)
        axpy_row8(acc, b2, cc[e + 2]); if (e + 4 < 128) ROW_LOAD(b2, vbase, e + 6)
        axpy_row8(acc, b3, cc[e + 3]); if (e + 4 < 128) ROW_LOAD(b3, vbase, e + 7)
      }
      const int b = tok >> 13;
      const float* ga2 = p.mod + b * 6144 + 5120;
      const float* orow = p.out + (size_t)tok * DM; float* grow = p.gout + (size_t)tok * DM;
      float ss = 0.f;
#pragma unroll
      for (int j = 0; j < 4; ++j)
#pragma unroll
        for (int q4 = 0; q4 < 4; ++q4) {
          const int col = j * 256 + i * 16 + q4 * 4;
          float4 x1 = *(const float4*)(orow + col), gg = *(const float4*)(ga2 + col);
          float* q = acc + j * 16 + q4 * 4;
          q[0] = x1.x + gg.x * q[0]; q[1] = x1.y + gg.y * q[1]; q[2] = x1.z + gg.z * q[2]; q[3] = x1.w + gg.w * q[3];
          ss += q[0] * q[0] + q[1] * q[1] + q[2] * q[2] + q[3] * q[3];
        }
      ss = row16_sum(ss);
      const float rstd = rsqrtf(ss * (1.f / DM) + 1e-6f);
#pragma unroll
      for (int j = 0; j < 4; ++j)
#pragma unroll
        for (int q4 = 0; q4 < 4; ++q4) {
          const int col = j * 256 + i * 16 + q4 * 4;
          float4 gf = *(const float4*)(p.g_final + col);
          const float* q = acc + j * 16 + q4 * 4;
          *(float4*)(grow + col) = make_float4(q[0] * rstd * gf.x, q[1] * rstd * gf.y, q[2] * rstd * gf.z, q[3] * rstd * gf.w);
        }
    }
#undef ROW_LOAD
  }
  __syncthreads();
}
DI void convert_tables(const Params& p, int v) {
  const int lane = mytid() & 63, row = v * 8 + (mytid() >> 6);
  const int tb = row >> 14, rr = row & 16383;
  const float* src = (tb ? p.peer_up : p.peer_down) + (size_t)rr * DM;
  float4 x[4]; float am = 0.f;
#pragma unroll
  for (int q = 0; q < 4; ++q) {
    x[q] = *(const float4*)(src + q * 256 + lane * 4);
    am = fmaxf(am, fmaxf(fmaxf(fabsf(x[q].x), fabsf(x[q].y)), fmaxf(fabsf(x[q].z), fabsf(x[q].w))));
  }
  for (int o = 32; o; o >>= 1) am = fmaxf(am, __shfl_xor(am, o));
  const float sc = (am > 0.f) ? am * (1.f / 448.f) : 1.f, inv = (am > 0.f) ? 448.f / am : 1.f;
  unsigned* dst = (unsigned*)((tb ? p.PUP8 : p.PDN8) + (size_t)rr * DM);
#pragma unroll
  for (int q = 0; q < 4; ++q) {
    int wd = 0;
    wd = __builtin_amdgcn_cvt_pk_fp8_f32(x[q].x * inv, x[q].y * inv, wd, false);
    wd = __builtin_amdgcn_cvt_pk_fp8_f32(x[q].z * inv, x[q].w * inv, wd, true);
    dst[q * 64 + lane] = (unsigned)wd;
  }
  if (lane == 0) (tb ? p.SUP : p.SDN)[rr] = sc;
}

#define N_PHASES 11
template <int PH>
DI void run_phase(const Params& p, char* smem) {
  const int nb = gridDim.x, bid = blockIdx.x, tid = mytid();
  if (PH == 0) {
    for (int vb = bid; vb < PH0_NVB; vb += nb) ph0_body(p, vb, smem);
  } else if (PH == 1) {
    for (int vb = bid; vb < T_TOK / 8; vb += nb) rownorm_body(p.x, p.g_mix, p.mod, 0, 1024, p.RA, vb);
  } else if (PH == 2) {
    EpiProj e{p};
    for (int vb = bid; vb < 64 * 14; vb += nb) gemm_tile(p.RA, p.WinT, 1024, (vb & 63) * 256, (vb >> 6) * 256, smem, e);
  } else if (PH == 3) {
    for (int vb = bid; vb < 512 + 128 + 64; vb += nb) {
      if (vb < 512) retkv_mfma(p, vb);
      else if (vb < 512 + 128) compress_mfma(p, vb - 512, smem);
      else kmax_body2(p, vb - 640);
    }
  } else if (PH == 4) {
    for (int vb = bid; vb < 256 + 4; vb += nb) {
      if (vb < 256) scan_body(p, vb * NT + tid);
      else kcmax_body(p, (vb - 256) * NT + tid);
    }
  } else if (PH == 5) {
    for (int rep = 0; rep < (PROBE_DUP == 51 ? 2 : 1); ++rep)
      for (int vb = bid; vb < 256; vb += nb) retout_mfma(p, vb * 8 + (tid >> 6));
    for (int rep = 0; rep < (PROBE_DUP == 52 ? 2 : 1); ++rep)
      for (int vb = bid; vb < 512; vb += nb) nsa_item(p, (vb < 256) ? vb : 767 - vb, smem);
  } else if (PH == 6) {
    EpiOut e{p};
    for (int vb = bid; vb < 64 * 4; vb += nb) gemm_tile(p.RA, p.WoutT, 1024, (vb & 63) * 256, (vb >> 6) * 256, smem, e);
  } else if (PH == 7) {
    for (int vb = bid; vb < T_TOK / 8 + 4096; vb += nb) {
      if (vb < T_TOK / 8) rownorm_body(p.out, p.g_ffn, p.mod, 3072, 4096, p.RA, vb);
      else convert_tables(p, vb - T_TOK / 8);
    }
  } else if (PH == 8) {
    EpiPQ e{p};
    for (int vb = bid; vb < 64 * 8; vb += nb) gemm_tile(p.RA, p.WqT, 1024, (vb & 63) * 256, (vb >> 6) * 256, smem, e);
  } else if (PH == 9) {
    for (int vb = bid; vb < T_TOK / 16; vb += nb) peer_topk_tile(p, vb, smem);
  } else if (PH == 10) {
    for (int vb = bid; vb < T_TOK / 64; vb += nb) peer_gather_block(p, vb, smem);
  }
}


#define XB_TMO      128
#define XB_XCNT(j)  (256  + 64 * (j))
#define XB_XSUB(j)  (1280 + 64 * (j))
#define XB_XGEN(j)  (2304 + 64 * (j))
#define XB_TOP      3328
#define XB_TOPGEN   3392
#define XCD_BAR_WORDS 3456
#define XB_SPIN_CAP (1u << 22)
#define LAS __attribute__((address_space(3)))
DI unsigned xb_ld(unsigned* p) { return __hip_atomic_load(p, __ATOMIC_RELAXED, __HIP_MEMORY_SCOPE_AGENT); }
DI unsigned xb_add(unsigned* p, unsigned v) { return __hip_atomic_fetch_add(p, v, __ATOMIC_RELAXED, __HIP_MEMORY_SCOPE_AGENT); }
DI unsigned xb_xcc_id() { return (unsigned)__builtin_amdgcn_s_getreg((3 << 11) | 20) & 0xFu; }
#define XB_SPIN(cond, bar) do { unsigned _sp = 0; while (cond) { __builtin_amdgcn_s_sleep(1); \
    if ((++_sp & 255u) == 0u) { if (xb_ld(&(bar)[XB_TMO])) break; if (_sp > XB_SPIN_CAP) { atomicAdd(&(bar)[XB_TMO], 1u); break; } } } } while (0)
struct XcdBarrier { unsigned* bar; unsigned x; volatile LAS unsigned* st; };
DI XcdBarrier xcd_barrier_post(unsigned* bar, volatile LAS unsigned* st) {
  XcdBarrier b; b.bar = bar; b.x = xb_xcc_id(); b.st = st;
  if (threadIdx.x == 0) (void)xb_add(&bar[XB_XCNT(b.x)], 1u);
  return b;
}
DI void xcd_barrier_complete(unsigned* bar, unsigned x, unsigned& nloc, unsigned& nx) {
  const unsigned G = gridDim.x * gridDim.y * gridDim.z;
  unsigned sum, cnt, mine, sp = 0u;
  for (;;) {
    sum = 0u; cnt = 0u; mine = 0u;
#pragma unroll
    for (unsigned j = 0; j < 16; ++j) { const unsigned c = xb_ld(&bar[XB_XCNT(j)]); sum += c; cnt += (c > 0u) ? 1u : 0u; mine = (j == x) ? c : mine; }
    if (sum == G) break;
    __builtin_amdgcn_s_sleep(1);
    if ((++sp & 255u) == 0u) { if (xb_ld(&bar[XB_TMO])) break; if (sp > XB_SPIN_CAP) { atomicAdd(&bar[XB_TMO], 1u); break; } }
  }
  nloc = mine > 0u ? mine : 1u; nx = cnt > 0u ? cnt : 1u;
}
DI void xcd_barrier(const XcdBarrier& b) {
  asm volatile("s_waitcnt vmcnt(0)" ::: "memory");
  __syncthreads();
  if (threadIdx.x == 0) {
    unsigned* bar = b.bar;
    __builtin_amdgcn_s_waitcnt(0);
    unsigned nloc = b.st[0], nx = b.st[1];
    if (nloc == 0u) { xcd_barrier_complete(bar, b.x, nloc, nx); b.st[0] = nloc; b.st[1] = nx; }
    const unsigned old = xb_add(&bar[XB_XSUB(b.x)], 1u);
    const unsigned gen = old / nloc;
    if (old + 1u == (gen + 1u) * nloc) {
      __builtin_amdgcn_fence(__ATOMIC_RELEASE, "agent");
      asm volatile("s_waitcnt vmcnt(0)" ::: "memory");
      const unsigned og = xb_add(&bar[XB_TOP], 1u);
      const unsigned tg = og / nx;
      if (og + 1u == (tg + 1u) * nx) xb_add(&bar[XB_TOPGEN], 1u);
      else XB_SPIN(xb_ld(&bar[XB_TOPGEN]) == tg, bar);
      __builtin_amdgcn_fence(__ATOMIC_ACQUIRE, "agent");
      xb_add(&bar[XB_XGEN(b.x)], 1u);
      asm volatile("s_waitcnt vmcnt(0)" ::: "memory");
    } else {
      XB_SPIN(xb_ld(&bar[XB_XGEN(b.x)]) == gen, bar);
      __builtin_amdgcn_fence(__ATOMIC_ACQUIRE, "agent");
      asm volatile("s_waitcnt vmcnt(0)" ::: "memory");
    }
  }
  __syncthreads();
}

#define SMEM_BYTES 155648

template <int PH>
DI void phase_and_probe(const Params& p, char* smem, cg::grid_group& grid) {
  const int reps = (PROBE_DUP == PH) ? 2 : 1;
  for (int rep = 0; rep < reps; ++rep) {
    if (PH == 10 && rep + 1 < reps) { Params q = p; q.gout = (float*)p.PQ; run_phase<PH>(q, smem); }
    else run_phase<PH>(p, smem);
    if (rep + 1 < reps) grid.sync();
  }
}
__global__ void __launch_bounds__(NT) k_mega(Params p) {
  extern __shared__ __attribute__((aligned(16))) char smem[];
  __shared__ uint4 xb_words;
  cg::grid_group grid = cg::this_grid();
  if (threadIdx.x == 0) xb_words = make_uint4(0u, 0u, 0u, 0u);
  __syncthreads();
  XcdBarrier xb = xcd_barrier_post(p.xbar, (volatile LAS unsigned*)&xb_words);
  phase_and_probe<0>(p, smem, grid); grid.sync();
  phase_and_probe<1>(p, smem, grid); xcd_barrier(xb);
  phase_and_probe<2>(p, smem, grid); xcd_barrier(xb);
  phase_and_probe<3>(p, smem, grid); xcd_barrier(xb);
  phase_and_probe<4>(p, smem, grid); xcd_barrier(xb);
  phase_and_probe<5>(p, smem, grid); xcd_barrier(xb);
  phase_and_probe<6>(p, smem, grid); xcd_barrier(xb);
  phase_and_probe<7>(p, smem, grid); xcd_barrier(xb);
  phase_and_probe<8>(p, smem, grid); xcd_barrier(xb);
  phase_and_probe<9>(p, smem, grid); xcd_barrier(xb);
  phase_and_probe<10>(p, smem, grid);
}
#ifdef MK_MULTI
template <int PH>
__global__ void __launch_bounds__(NT) k_single(Params p) {
  extern __shared__ __attribute__((aligned(16))) char smem[];
  run_phase<PH>(p, smem);
}
#endif

static size_t carve(size_t& off, size_t bytes) { size_t o = off; off += (bytes + 255) & ~(size_t)255; return o; }

extern "C" void kernel_launch(void* const* d_in, const int* in_sizes, int n_in, void* d_out, int out_size, void* d_ws, size_t ws_size,
                              hipStream_t stream) {
  Params p{};
  p.x = (const float*)d_in[0]; p.c = (const float*)d_in[1]; p.w_ada = (const float*)d_in[2]; p.b_ada = (const float*)d_in[3];
  p.g_mix = (const float*)d_in[4]; p.w_in = (const float*)d_in[5]; p.pe_k = (const float*)d_in[6]; p.pe_v = (const float*)d_in[7];
  p.w_k1 = (const float*)d_in[8]; p.b_k1 = (const float*)d_in[9]; p.w_k2 = (const float*)d_in[10]; p.w_v1 = (const float*)d_in[11];
  p.b_v1 = (const float*)d_in[12]; p.w_v2 = (const float*)d_in[13]; p.w_out = (const float*)d_in[14]; p.g_ffn = (const float*)d_in[15];
  p.w_pq = (const float*)d_in[16]; p.subkeys = (const float*)d_in[17]; p.peer_down = (const float*)d_in[18]; p.peer_up = (const float*)d_in[19];
  p.g_final = (const float*)d_in[20];
  p.out = (float*)d_out; p.gout = p.out;
  char* ws = (char*)d_ws;
  size_t off = 0;
  p.mod = (float*)(ws + carve(off, 2 * 6144 * 4));
  p.ksmax = (unsigned*)(ws + carve(off, 256));
  p.xbar = (unsigned*)(ws + carve(off, XCD_BAR_WORDS * 4));
  p.c128 = (float*)(ws + carve(off, (size_t)SEQ * 64 * 4)); p.s128 = (float*)(ws + carve(off, (size_t)SEQ * 64 * 4));
  p.c64 = (float*)(ws + carve(off, (size_t)SEQ * 32 * 4)); p.s64 = (float*)(ws + carve(off, (size_t)SEQ * 32 * 4));
  p.WinT = (bf16_t*)(ws + carve(off, (size_t)NPROJ * 1024 * 2));
  p.WoutT = (bf16_t*)(ws + carve(off, (size_t)1024 * 1024 * 2));
  p.WqT = (bf16_t*)(ws + carve(off, (size_t)2048 * 1024 * 2));
  p.W1Tk = (bf16_t*)(ws + carve(off, (size_t)256 * 2048 * 2)); p.W1Tv = (bf16_t*)(ws + carve(off, (size_t)256 * 2048 * 2));
  p.W2Tk = (bf16_t*)(ws + carve(off, 64 * 256 * 2)); p.W2Tv = (bf16_t*)(ws + carve(off, 64 * 256 * 2));
  p.SUBK = (bf16_t*)(ws + carve(off, (size_t)16 * 128 * 128 * 2));
  p.B1Pk = (float*)(ws + carve(off, 1024)); p.B1Pv = (float*)(ws + carve(off, 1024));
  p.RA = (bf16_t*)(ws + carve(off, (size_t)T_TOK * 1024 * 2));
  size_t rb = off;
  p.RQ = (bf16_t*)(ws + carve(off, (size_t)T_TOK * 512 * 2)); p.RK = (bf16_t*)(ws + carve(off, (size_t)T_TOK * 512 * 2));
  p.RKT = (bf16_t*)(ws + carve(off, (size_t)T_TOK * 512 * 2)); p.RVT = (bf16_t*)(ws + carve(off, (size_t)T_TOK * 512 * 2));
  p.RGT = (bf16_t*)(ws + carve(off, (size_t)T_TOK * 512 * 2)); p.NQ = (bf16_t*)(ws + carve(off, (size_t)T_TOK * 512 * 2));
  p.NKC = (bf16_t*)(ws + carve(off, (size_t)T_TOK * 128 * 2)); p.NVC = (bf16_t*)(ws + carve(off, (size_t)T_TOK * 128 * 2));
  p.NKS = (bf16_t*)(ws + carve(off, (size_t)T_TOK * 128 * 2)); p.NKW = (bf16_t*)(ws + carve(off, (size_t)T_TOK * 128 * 2));
  p.NVST = (bf16_t*)(ws + carve(off, (size_t)T_TOK * 128 * 2)); p.NVWT = (bf16_t*)(ws + carve(off, (size_t)T_TOK * 128 * 2));
  p.GATE = (float*)(ws + carve(off, (size_t)T_TOK * 24 * 4));
  p.KV = (float*)(ws + carve(off, (size_t)512 * 16384 * 4));
  p.SPREV = (bf16_t*)(ws + carve(off, (size_t)512 * 16384 * 2));
  p.KC = (bf16_t*)(ws + carve(off, (size_t)4 * 512 * 64 * 2)); p.VCT = (bf16_t*)(ws + carve(off, (size_t)4 * 512 * 64 * 2));
  p.HID = (float*)(ws + carve(off, (size_t)2 * 2048 * 256 * 4));
  size_t off2 = rb;
  p.PQ = (bf16_t*)(ws + carve(off2, (size_t)T_TOK * 2048 * 2));
  p.EIDX = (int*)(ws + carve(off2, (size_t)T_TOK * 128 * 4));
  p.EW = (float*)(ws + carve(off2, (size_t)T_TOK * 128 * 4));
  p.PDN8 = (unsigned char*)(ws + carve(off2, (size_t)16384 * 1024));
  p.PUP8 = (unsigned char*)(ws + carve(off2, (size_t)16384 * 1024));
  p.SDN = (float*)(ws + carve(off2, 16384 * 4));
  p.SUP = (float*)(ws + carve(off2, 16384 * 4));
  (void)ws_size; (void)in_sizes; (void)n_in; (void)out_size;

#ifdef MK_MULTI
#define LAUNCH1(PH) { hipFuncSetAttribute((const void*)k_single<PH>, hipFuncAttributeMaxDynamicSharedMemorySize, SMEM_BYTES); k_single<PH><<<256, NT, SMEM_BYTES, stream>>>(p); }
  LAUNCH1(0) LAUNCH1(1) LAUNCH1(2) LAUNCH1(3) LAUNCH1(4) LAUNCH1(5) LAUNCH1(6) LAUNCH1(7) LAUNCH1(8) LAUNCH1(9) LAUNCH1(10)
#else
  static int grid_blocks = 0;
  if (!grid_blocks) {
    int dev = 0, cus = 0, per_cu = 0;
    (void)hipGetDevice(&dev);
    (void)hipDeviceGetAttribute(&cus, hipDeviceAttributeMultiprocessorCount, dev);
    (void)hipFuncSetAttribute((const void*)k_mega, hipFuncAttributeMaxDynamicSharedMemorySize, SMEM_BYTES);
    (void)hipOccupancyMaxActiveBlocksPerMultiprocessor(&per_cu, k_mega, NT, SMEM_BYTES);
    if (per_cu < 1) per_cu = 1;
    if (per_cu > 1) per_cu = 1;
    grid_blocks = cus * per_cu;
  }
  (void)hipMemsetAsync(p.xbar, 0, XCD_BAR_WORDS * 4, stream);
  void* args[] = {&p};
  hipError_t e = hipLaunchCooperativeKernel((void*)k_mega, dim3(grid_blocks), dim3(NT), args, SMEM_BYTES, stream);
  if (e != hipSuccess) fprintf(stderr, "cooperative launch failed: %s (grid %d)\n", hipGetErrorString(e), grid_blocks);
#endif
}
```

```cpp
#include <hip/hip_runtime.h>
#include <hip/hip_bf16.h>
#include <hip/hip_cooperative_groups.h>
#include <stdint.h>
#include <stdio.h>
namespace cg = cooperative_groups;

typedef unsigned short bf16_t;
#define DI __device__ __forceinline__

DI int mytid() { int t = threadIdx.x; asm volatile("" : "+v"(t)); return t; }
DI float bf2f(bf16_t v) { return __uint_as_float(((unsigned)v) << 16); }
DI bf16_t f2bf(float x) { unsigned u = __float_as_uint(x); u += 0x7fffu + ((u >> 16) & 1u); return (bf16_t)(u >> 16); }
DI float gelu_tanh(float x) { float u = 0.7978845608028654f * (x + 0.044715f * x * x * x); return 0.5f * x * (1.f + tanhf(u)); }
DI float siluf(float x) { return x / (1.f + __expf(-x)); }
DI float sigmoidf(float x) { return 1.f / (1.f + __expf(-x)); }

#define T_TOK 16384
#define SEQ 8192
#define DM 1024
#define NPROJ 3584
#define NEG_INF (-__builtin_inff())

struct Params {
  const float *x, *c, *w_ada, *b_ada, *g_mix, *w_in, *pe_k, *pe_v, *w_k1, *b_k1, *w_k2, *w_v1, *b_v1, *w_v2, *w_out, *g_ffn,
      *w_pq, *subkeys, *peer_down, *peer_up, *g_final;
  float* out;
  float* gout;
  float* mod;
  unsigned* ksmax;
  unsigned* xbar;
  float *c128, *s128, *c64, *s64;
  bf16_t *WinT, *WoutT, *WqT, *W1Tk, *W1Tv, *W2Tk, *W2Tv, *SUBK;
  float *B1Pk, *B1Pv;
  bf16_t* RA;
  bf16_t *RQ, *RK, *RKT, *RVT, *RGT, *NQ, *NKC, *NVC, *NKS, *NKW, *NVST, *NVWT;
  float* GATE;
  float* KV;
  bf16_t* SPREV;
  bf16_t *KC, *VCT;
  float* HID;
  bf16_t* PQ;
  int* EIDX;
  float* EW;
  unsigned char *PDN8, *PUP8;
  float *SDN, *SUP;
};

DI float logg_h(int h) { return log1pf(-exp2f(-5.f - (float)h)); }


typedef __bf16 bf16x2_t __attribute__((ext_vector_type(2)));
typedef float f32x2_t __attribute__((ext_vector_type(2)));
DI unsigned cvt2(float a, float b) { f32x2_t v = {a, b}; bf16x2_t r = __builtin_convertvector(v, bf16x2_t); return __builtin_bit_cast(unsigned, r); }
DI uint2 pack4(float a, float b, float c, float d) { uint2 r; r.x = cvt2(a, b); r.y = cvt2(c, d); return r; }
#define NT 512
#ifndef PROBE_DUP
#define PROBE_DUP -1
#endif
typedef short bf16x8 __attribute__((ext_vector_type(8)));
typedef float f32x16 __attribute__((ext_vector_type(16)));
#define MFMA32(a, b, c) __builtin_amdgcn_mfma_f32_32x32x16_bf16((a), (b), (c), 0, 0, 0)
DI f32x16 zero16() { f32x16 z; for (int e = 0; e < 16; ++e) z[e] = 0.f; return z; }
DI f32x16 fill16(float v) { f32x16 z; for (int e = 0; e < 16; ++e) z[e] = v; return z; }
DI float ex2(float x) { return __builtin_amdgcn_exp2f(x); }

DI int win_logical_col(int np) {
  int g = np >> 6, c = np & 63;
  if (g < 16) {
    int sec = g >> 3, hh = (g & 7) >> 1, j = g & 1, i = 32 * j + (c & 31);
    return sec * 512 + hh * 128 + ((c < 32) ? i : 64 + i);
  } else if (g < 52) return 1024 + (g - 16) * 64 + c;
  else if (g == 52) return (c < 24) ? 3328 + c : -1;
  return -1;
}

DI void tr_tile(const float* __restrict__ in, bf16_t* __restrict__ out, int K, int N_in, int k0, int n0, int mode, float* tile) {
  const int tid = mytid();
  {
    int nn = tid & 63, col = mode ? win_logical_col(n0 + nn) : (n0 + nn);
#pragma unroll
    for (int i = 0; i < 8; ++i) {
      int kk = (tid >> 6) + 8 * i;
      tile[kk * 65 + nn] = (col >= 0) ? in[(size_t)(k0 + kk) * N_in + col] : 0.f;
    }
  }
  __syncthreads();
  {
    int kk = tid & 63;
#pragma unroll
    for (int i = 0; i < 8; ++i) {
      int nn = (tid >> 6) + 8 * i;
      out[(size_t)(n0 + nn) * K + k0 + kk] = f2bf(tile[kk * 65 + nn]);
    }
  }
  __syncthreads();
}

#define PH0_MOD 96
#define PH0_WIN (PH0_MOD + 16 * 56)
#define PH0_WOUT (PH0_WIN + 256)
#define PH0_WQ (PH0_WOUT + 512)
#define PH0_W1K (PH0_WQ + 128)
#define PH0_W1V (PH0_W1K + 128)
#define PH0_W2K (PH0_W1V + 4)
#define PH0_W2V (PH0_W2K + 4)
#define PH0_SUBK (PH0_W2V + 512)
#define PH0_ROPE (PH0_SUBK + 1024)
#define PH0_B1P (PH0_ROPE + 8)
#define PH0_NVB PH0_B1P

DI void ph0_body(const Params& p, int vb, char* smem) {
  const int tid = mytid();
  float* fs = (float*)smem;
  if (vb < PH0_MOD) {
    int kg = tid >> 6, col = vb * 64 + (tid & 63);
    float a0 = 0.f, a1 = 0.f;
#pragma unroll 8
    for (int k = kg * 128; k < kg * 128 + 128; ++k) {
      float w = p.w_ada[(size_t)k * 6144 + col];
      a0 += siluf(p.c[k]) * w; a1 += siluf(p.c[DM + k]) * w;
    }
    fs[kg * 64 + (tid & 63)] = a0; fs[512 + kg * 64 + (tid & 63)] = a1;
    __syncthreads();
    if (tid < 128) {
      int b = tid >> 6, cc = tid & 63; float s = 0.f;
      for (int g = 0; g < 8; ++g) s += fs[b * 512 + g * 64 + cc];
      p.mod[b * 6144 + vb * 64 + cc] = s + p.b_ada[vb * 64 + cc];
    }
    __syncthreads();
    if (vb == 0 && tid < 12) p.ksmax[tid] = 0u;
  } else if (vb < PH0_WIN) { int t = vb - PH0_MOD; tr_tile(p.w_in, p.WinT, 1024, 3352, (t & 15) * 64, (t >> 4) * 64, 1, fs); }
  else if (vb < PH0_WOUT) { int t = vb - PH0_WIN; tr_tile(p.w_out, p.WoutT, 1024, 1024, (t & 15) * 64, (t >> 4) * 64, 0, fs); }
  else if (vb < PH0_WQ) { int t = vb - PH0_WOUT; tr_tile(p.w_pq, p.WqT, 1024, 2048, (t & 15) * 64, (t >> 4) * 64, 0, fs); }
  else if (vb < PH0_W1K) { int t = vb - PH0_WQ; tr_tile(p.w_k1, p.W1Tk, 2048, 256, (t & 31) * 64, (t >> 5) * 64, 0, fs); }
  else if (vb < PH0_W1V) { int t = vb - PH0_W1K; tr_tile(p.w_v1, p.W1Tv, 2048, 256, (t & 31) * 64, (t >> 5) * 64, 0, fs); }
  else if (vb < PH0_W2K) { int t = vb - PH0_W1V; tr_tile(p.w_k2, p.W2Tk, 256, 64, t * 64, 0, 0, fs); }
  else if (vb < PH0_W2V) { int t = vb - PH0_W2K; tr_tile(p.w_v2, p.W2Tv, 256, 64, t * 64, 0, 0, fs); }
  else if (vb < PH0_SUBK) { int i = (vb - PH0_W2V) * NT + tid; p.SUBK[i] = f2bf(p.subkeys[i]); }
  else if (vb < PH0_ROPE) {
    int idx = (vb - PH0_SUBK) * NT + tid;
    { int s = idx >> 6, i = idx & 63; float inv = powf(10000.f, -(float)(2 * i) / 128.f); float ang = (float)s * inv; p.c128[idx] = cosf(ang); p.s128[idx] = sinf(ang); }
    if (idx < SEQ * 32) { int s = idx >> 5, i = idx & 31; float inv = powf(10000.f, -(float)(2 * i) / 64.f); float ang = (float)s * inv; p.c64[idx] = cosf(ang); p.s64[idx] = sinf(ang); }
  } else {
    int t = vb - PH0_ROPE, kv = t >> 2, jb = t & 3;
    const float* w1 = kv ? p.w_v1 : p.w_k1; const float* pe = kv ? p.pe_v : p.pe_k; const float* b1 = kv ? p.b_v1 : p.b_k1;
    int fg = tid >> 6, j = jb * 64 + (tid & 63);
    float a = 0.f;
#pragma unroll 8
    for (int f = fg * 256; f < fg * 256 + 256; ++f) a += pe[f] * w1[(size_t)f * 256 + j];
    fs[fg * 64 + (tid & 63)] = a;
    __syncthreads();
    if (tid < 64) { float s = b1[j]; for (int g = 0; g < 8; ++g) s += fs[g * 64 + tid]; (kv ? p.B1Pv : p.B1Pk)[j] = s; }
    __syncthreads();
  }
}

DI void rownorm_body(const float* __restrict__ src, const float* __restrict__ g, const float* __restrict__ mod, int sh_off, int sc_off, bf16_t* __restrict__ dst, int vb) {
  int row = vb * 8 + (mytid() >> 6), lane = mytid() & 63;
  int b = row >> 13;
  const float* xr = src + (size_t)row * DM;
  float v[16]; float ss = 0.f;
#pragma unroll
  for (int i = 0; i < 4; ++i) {
    float4 t = *(const float4*)(xr + i * 256 + lane * 4);
    v[i * 4 + 0] = t.x; v[i * 4 + 1] = t.y; v[i * 4 + 2] = t.z; v[i * 4 + 3] = t.w;
    ss += t.x * t.x + t.y * t.y + t.z * t.z + t.w * t.w;
  }
  for (int o = 32; o; o >>= 1) ss += __shfl_xor(ss, o);
  float rstd = rsqrtf(ss * (1.f / DM) + 1e-6f);
  const float* sh = mod + b * 6144 + sh_off; const float* sc = mod + b * 6144 + sc_off;
#pragma unroll
  for (int i = 0; i < 4; ++i) {
    int col = i * 256 + lane * 4;
    float4 gg = *(const float4*)(g + col), s4 = *(const float4*)(sc + col), h4 = *(const float4*)(sh + col);
    float y0 = v[i * 4 + 0] * rstd * gg.x * (1.f + s4.x) + h4.x;
    float y1 = v[i * 4 + 1] * rstd * gg.y * (1.f + s4.y) + h4.y;
    float y2 = v[i * 4 + 2] * rstd * gg.z * (1.f + s4.z) + h4.z;
    float y3 = v[i * 4 + 3] * rstd * gg.w * (1.f + s4.w) + h4.w;
    *(uint2*)(dst + (size_t)row * DM + col) = pack4(y0, y1, y2, y3);
  }
}

#define G_A_BYTES (256 * 144)
#define G_B_BYTES (256 * 144)
#define G_BUF_BYTES (G_A_BYTES + G_B_BYTES)
template <class Epi>
DI void gemm_tile(const bf16_t* __restrict__ A, const bf16_t* __restrict__ Bt, int K, int m0, int n0, char* smem, const Epi& epi) {
  const int tid = mytid(), lane = tid & 63, w = tid >> 6, wm = w >> 2, wn = w & 3, r = lane & 31, h = lane >> 5;
  f32x16 acc[4][2];
#pragma unroll
  for (int i = 0; i < 4; ++i)
#pragma unroll
    for (int j = 0; j < 2; ++j) acc[i][j] = zero16();
  const int crow = tid >> 3, ckc = tid & 7;
  const bf16_t* ag = A + (size_t)(m0 + crow) * K + ckc * 8;
  const bf16_t* bg = Bt + (size_t)(n0 + crow) * K + ckc * 8;
  uint4 ra[4], rb[4];
#pragma unroll
  for (int i = 0; i < 4; ++i) { ra[i] = *(const uint4*)(ag + (size_t)i * 64 * K); rb[i] = *(const uint4*)(bg + (size_t)i * 64 * K); }
  char* lw = smem + crow * 144 + ckc * 16;
#pragma unroll
  for (int i = 0; i < 4; ++i) { *(uint4*)(lw + i * 64 * 144) = ra[i]; *(uint4*)(lw + G_A_BYTES + i * 64 * 144) = rb[i]; }
  __syncthreads();
  const int nk = K >> 6;
  for (int kt = 0; kt < nk; ++kt) {
    const int cur = kt & 1;
    if (kt + 1 < nk) {
      const int k0 = (kt + 1) * 64;
#pragma unroll
      for (int i = 0; i < 4; ++i) { ra[i] = *(const uint4*)(ag + (size_t)i * 64 * K + k0); rb[i] = *(const uint4*)(bg + (size_t)i * 64 * K + k0); }
    }
    const char* la = smem + cur * G_BUF_BYTES + (wm * 128 + r) * 144 + h * 16;
    const char* lb = smem + cur * G_BUF_BYTES + G_A_BYTES + (wn * 64 + r) * 144 + h * 16;
#pragma unroll
    for (int kk = 0; kk < 4; ++kk) {
      bf16x8 b0 = *(const bf16x8*)(lb + kk * 32), b1 = *(const bf16x8*)(lb + 32 * 144 + kk * 32);
#pragma unroll
      for (int i = 0; i < 4; ++i) {
        bf16x8 a = *(const bf16x8*)(la + i * 32 * 144 + kk * 32);
        acc[i][0] = MFMA32(a, b0, acc[i][0]); acc[i][1] = MFMA32(a, b1, acc[i][1]);
      }
    }
    if (kt + 1 < nk) {
      char* lw2 = lw + (cur ^ 1) * G_BUF_BYTES;
#pragma unroll
      for (int i = 0; i < 4; ++i) { *(uint4*)(lw2 + i * 64 * 144) = ra[i]; *(uint4*)(lw2 + G_A_BYTES + i * 64 * 144) = rb[i]; }
    }
    __syncthreads();
  }
  const int G = (n0 >> 6) + wn;
#pragma unroll
  for (int i = 0; i < 4; ++i) {
    float pre[4][8];
#pragma unroll
    for (int g = 0; g < 4; ++g) epi.prefetch(m0 + wm * 128 + i * 32 + 8 * g + 4 * h, G, r, pre[g]);
#pragma unroll
    for (int g = 0; g < 4; ++g) {
      float lo[4], hi[4];
#pragma unroll
      for (int e = 0; e < 4; ++e) { lo[e] = acc[i][0][4 * g + e]; hi[e] = acc[i][1][4 * g + e]; }
      epi(m0 + wm * 128 + i * 32 + 8 * g + 4 * h, G, r, lo, hi, pre[g]);
    }
  }
}

struct EpiProj {
  static constexpr bool kProbe = true;
  const Params& p;
  DI void prefetch(int t0, int G, int c, float (&pre)[8]) const {
    const int s0 = t0 & 8191;
    const bool r128 = G < 16, r64 = (G >= 32 && G < 40) || (G >= 40 && G < 52 && (((G - 40) >> 1) & 1) == 0);
    if (r128) {
      const int i = 32 * (G & 1) + c;
#pragma unroll
      for (int e = 0; e < 4; ++e) { pre[e] = p.c128[(s0 + e) * 64 + i]; pre[4 + e] = p.s128[(s0 + e) * 64 + i]; }
    } else if (r64) {
#pragma unroll
      for (int e = 0; e < 4; ++e) { pre[e] = p.c64[(s0 + e) * 32 + c]; pre[4 + e] = p.s64[(s0 + e) * 32 + c]; }
    } else {
#pragma unroll
      for (int e = 0; e < 8; ++e) pre[e] = 0.f;
    }
  }
  DI void operator()(int t0, int G, int c, const float (&lo)[4], const float (&hi)[4], const float (&pre)[8]) const {
    const int b = t0 >> 13, s0 = t0 & 8191;
    if (G < 16) {
      const int sec = G >> 3, hh = (G & 7) >> 1, j = G & 1, i = 32 * j + c;
      float o1[4], o2[4];
#pragma unroll
      for (int e = 0; e < 4; ++e) {
        float cs = pre[e], sn = pre[4 + e];
        o1[e] = lo[e] * cs - hi[e] * sn; o2[e] = hi[e] * cs + lo[e] * sn;
      }
      if (sec == 0) {
#pragma unroll
        for (int e = 0; e < 4; ++e) {
          p.RQ[(size_t)(t0 + e) * 512 + hh * 128 + i] = f2bf(o1[e]);
          p.RQ[(size_t)(t0 + e) * 512 + hh * 128 + 64 + i] = f2bf(o2[e]);
        }
      } else {
        const float sc = 0.08838834764831845f;
        const float lg = logg_h(hh);
#pragma unroll
        for (int e = 0; e < 4; ++e) {
          o1[e] *= sc; o2[e] *= sc;
          p.RK[(size_t)(t0 + e) * 512 + hh * 128 + i] = f2bf(o1[e]);
          p.RK[(size_t)(t0 + e) * 512 + hh * 128 + 64 + i] = f2bf(o2[e]);
          float zeta = __expf((float)(127 - ((s0 + e) & 127)) * lg);
          o1[e] *= zeta; o2[e] *= zeta;
        }
        *(uint2*)(p.RKT + ((size_t)(b * 4 + hh) * 128 + i) * SEQ + s0) = pack4(o1[0], o1[1], o1[2], o1[3]);
        *(uint2*)(p.RKT + ((size_t)(b * 4 + hh) * 128 + 64 + i) * SEQ + s0) = pack4(o2[0], o2[1], o2[2], o2[3]);
      }
    } else if (G < 24) {
      const int hh = (G - 16) >> 1, d = ((G - 16) & 1) * 64 + c;
      *(uint2*)(p.RVT + ((size_t)(b * 4 + hh) * 128 + d) * SEQ + s0) = pack4(lo[0], lo[1], lo[2], lo[3]);
      *(uint2*)(p.RVT + ((size_t)(b * 4 + hh) * 128 + d + 32) * SEQ + s0) = pack4(hi[0], hi[1], hi[2], hi[3]);
    } else if (G < 32) {
      const int hh = (G - 24) >> 1, d = ((G - 24) & 1) * 64 + c;
#pragma unroll
      for (int e = 0; e < 4; ++e) {
        p.RGT[(size_t)(t0 + e) * 512 + hh * 128 + d] = f2bf(siluf(lo[e]));
        p.RGT[(size_t)(t0 + e) * 512 + hh * 128 + d + 32] = f2bf(siluf(hi[e]));
      }
    } else if (G < 40) {
      const int head = G - 32;
#pragma unroll
      for (int e = 0; e < 4; ++e) {
        float cs = pre[e], sn = pre[4 + e];
        const float qs = 0.125f * 1.4426950408889634f;
        float o1 = (lo[e] * cs - hi[e] * sn) * qs, o2 = (hi[e] * cs + lo[e] * sn) * qs;
        p.NQ[(size_t)(t0 + e) * 512 + head * 64 + c] = f2bf(o1);
        p.NQ[(size_t)(t0 + e) * 512 + head * 64 + 32 + c] = f2bf(o2);
      }
    } else if (G < 52) {
      const int k = G - 40, kind = k >> 1, gg = k & 1;
      float o1[4], o2[4];
#pragma unroll
      for (int e = 0; e < 4; ++e) {
        o1[e] = lo[e]; o2[e] = hi[e];
        if ((kind & 1) == 0) {
          float cs = pre[e], sn = pre[4 + e];
          o1[e] = lo[e] * cs - hi[e] * sn; o2[e] = hi[e] * cs + lo[e] * sn;
        }
      }
      if (kind == 3 || kind == 5) {
        bf16_t* dst = (kind == 3 ? p.NVST : p.NVWT) + ((size_t)(b * 2 + gg) * 64 + c) * SEQ + s0;
        *(uint2*)dst = pack4(o1[0], o1[1], o1[2], o1[3]);
        *(uint2*)(dst + (size_t)32 * SEQ) = pack4(o2[0], o2[1], o2[2], o2[3]);
      } else {
        bf16_t* dst = (kind == 0 ? p.NKC : kind == 1 ? p.NVC : kind == 2 ? p.NKS : p.NKW);
#pragma unroll
        for (int e = 0; e < 4; ++e) {
          dst[(size_t)(t0 + e) * 128 + gg * 64 + c] = f2bf(o1[e]);
          dst[(size_t)(t0 + e) * 128 + gg * 64 + 32 + c] = f2bf(o2[e]);
        }
      }
    } else if (G == 52) {
      if (c < 24) {
#pragma unroll
        for (int e = 0; e < 4; ++e) p.GATE[(size_t)(t0 + e) * 24 + c] = sigmoidf(lo[e]);
      }
    }
  }
};
struct EpiOut {
  static constexpr bool kProbe = false;
  const Params& p;
  DI void prefetch(int t0, int G, int c, float (&pre)[8]) const {
    const int c0 = G * 64 + c;
#pragma unroll
    for (int e = 0; e < 4; ++e) { pre[e] = p.x[(size_t)(t0 + e) * DM + c0]; pre[4 + e] = p.x[(size_t)(t0 + e) * DM + c0 + 32]; }
  }
  DI void operator()(int t0, int G, int c, const float (&lo)[4], const float (&hi)[4], const float (&pre)[8]) const {
    const int b = t0 >> 13;
    const int c0 = G * 64 + c, c1 = c0 + 32;
    const float* ga1 = p.mod + b * 6144 + 2048;
    const float g0 = ga1[c0], g1 = ga1[c1];
#pragma unroll
    for (int e = 0; e < 4; ++e) {
      p.out[(size_t)(t0 + e) * DM + c0] = pre[e] + g0 * lo[e];
      p.out[(size_t)(t0 + e) * DM + c1] = pre[4 + e] + g1 * hi[e];
    }
  }
};
struct EpiPQ {
  static constexpr bool kProbe = false;
  const Params& p;
  DI void prefetch(int, int, int, float (&)[8]) const {}
  DI void operator()(int t0, int G, int c, const float (&lo)[4], const float (&hi)[4], const float (&)[8]) const {
#pragma unroll
    for (int e = 0; e < 4; ++e) {
      p.PQ[(size_t)(t0 + e) * 2048 + G * 64 + c] = f2bf(lo[e]);
      p.PQ[(size_t)(t0 + e) * 2048 + G * 64 + 32 + c] = f2bf(hi[e]);
    }
  }
};

DI int crow(int reg, int h) { return (reg & 3) + 8 * (reg >> 2) + 4 * h; }
DI bf16x8 ld16(const bf16_t* ptr) { return *(const bf16x8*)ptr; }
DI bf16x8 ld8x2(const bf16_t* ptr) {
  uint2 a = *(const uint2*)ptr, b = *(const uint2*)(ptr + 8);
  uint4 v; v.x = a.x; v.y = a.y; v.z = b.x; v.w = b.y;
  return __builtin_bit_cast(bf16x8, v);
}
DI bf16x8 pack8(float x0, float x1, float x2, float x3, float x4, float x5, float x6, float x7) {
  uint4 v; v.x = cvt2(x0, x1); v.y = cvt2(x2, x3); v.z = cvt2(x4, x5); v.w = cvt2(x6, x7);
  return __builtin_bit_cast(bf16x8, v);
}

DI void retkv_mfma(const Params& p, int item) {
  const int lane = mytid() & 63, w = mytid() >> 6, r = lane & 31, h = lane >> 5;
  const int hh = item & 3, c = (item >> 2) & 63, b = item >> 8, bh = b * 4 + hh, s0 = c * 128;
  const int mi = w >> 1, nb = (w & 1) * 2;
  const bf16_t* vb_ = p.RVT + ((size_t)(bh * 128 + 32 * mi + r)) * SEQ + s0 + 8 * h;
  const bf16_t* k0 = p.RKT + ((size_t)(bh * 128 + 32 * nb + r)) * SEQ + s0 + 8 * h;
  const bf16_t* k1 = k0 + (size_t)32 * SEQ;
  f32x16 a0 = zero16(), a1 = zero16();
#pragma unroll
  for (int s = 0; s < 8; ++s) {
    bf16x8 a = ld16(vb_ + 16 * s), b0 = ld16(k0 + 16 * s), b1 = ld16(k1 + 16 * s);
    a0 = MFMA32(a, b0, a0); a1 = MFMA32(a, b1, a1);
  }
  float* dst = p.KV + (size_t)item * 16384;
#pragma unroll
  for (int e = 0; e < 16; ++e) {
    const int v = 32 * mi + crow(e, h);
    dst[v * 128 + 32 * nb + r] = a0[e];
    dst[v * 128 + 32 * nb + 32 + r] = a1[e];
  }
}
DI void scan_body(const Params& p, int idx) {
  const int e = idx & 16383, bh = idx >> 14, b = bh >> 2, h = bh & 3;
  const float cd = __expf(128.f * logg_h(h));
  float S = 0.f;
  for (int c0 = 0; c0 < 64; c0 += 16) {
    float kv[16];
#pragma unroll
    for (int u = 0; u < 16; ++u) kv[u] = p.KV[(size_t)((b * 64 + c0 + u) * 4 + h) * 16384 + e];
#pragma unroll
    for (int u = 0; u < 16; ++u) {
      p.SPREV[(size_t)((b * 64 + c0 + u) * 4 + h) * 16384 + e] = f2bf(S);
      S = cd * S + kv[u];
    }
  }
}
DI void retout_mfma(const Params& p, int task) {
  const int lane = mytid() & 63, r = lane & 31, h = lane >> 5;
  const int item = task >> 2, nt = task & 3;
  const int hh = item & 3, c = (item >> 2) & 63, b = item >> 8, bh = b * 4 + hh, s0 = c * 128, t0 = b * SEQ + s0;
  const float lg = logg_h(hh);
  const int n = 32 * nt + r;
  bf16x8 qf[8];
#pragma unroll
  for (int s = 0; s < 8; ++s) qf[s] = ld16(p.RQ + (size_t)(t0 + n) * 512 + hh * 128 + 16 * s + 8 * h);
  f32x16 acc[4];
#pragma unroll
  for (int vi = 0; vi < 4; ++vi) {
    acc[vi] = zero16();
    const bf16_t* sp = p.SPREV + (size_t)item * 16384 + (size_t)(32 * vi + r) * 128 + 8 * h;
#pragma unroll
    for (int s = 0; s < 8; ++s) acc[vi] = MFMA32(ld16(sp + 16 * s), qf[s], acc[vi]);
    __builtin_amdgcn_sched_barrier(0);
  }
  {
    const float xi = __expf((float)(n + 1) * lg);
#pragma unroll
    for (int vi = 0; vi < 4; ++vi)
#pragma unroll
      for (int e = 0; e < 16; ++e) acc[vi][e] *= xi;
  }
  for (int mt = 0; mt <= nt; ++mt) {
    f32x16 sa = zero16();
    const bf16_t* kp = p.RK + (size_t)(t0 + 32 * mt + r) * 512 + hh * 128 + 8 * h;
#pragma unroll
    for (int s = 0; s < 8; ++s) sa = MFMA32(ld16(kp + 16 * s), qf[s], sa);
    float pv[16];
#pragma unroll
    for (int e = 0; e < 16; ++e) {
      const int dm = n - (32 * mt + crow(e, h));
      pv[e] = (dm >= 0) ? sa[e] * __expf((float)dm * lg) : 0.f;
    }
#pragma unroll
    for (int s2 = 0; s2 < 2; ++s2) {
      bf16x8 bfr = pack8(pv[8 * s2], pv[8 * s2 + 1], pv[8 * s2 + 2], pv[8 * s2 + 3], pv[8 * s2 + 4], pv[8 * s2 + 5], pv[8 * s2 + 6], pv[8 * s2 + 7]);
#pragma unroll
      for (int vi = 0; vi < 4; ++vi) {
        bf16x8 afr = ld8x2(p.RVT + ((size_t)(bh * 128 + 32 * vi + r)) * SEQ + s0 + 32 * mt + 16 * s2 + 4 * h);
        acc[vi] = MFMA32(afr, bfr, acc[vi]);
      }
      __builtin_amdgcn_sched_barrier(0);
    }
  }
  float sum = 0.f;
#pragma unroll
  for (int vi = 0; vi < 4; ++vi)
#pragma unroll
    for (int e = 0; e < 16; ++e) sum += acc[vi][e];
  sum += __shfl_xor(sum, 32);
  const float mu = sum * (1.f / 128.f);
  float var = 0.f;
#pragma unroll
  for (int vi = 0; vi < 4; ++vi)
#pragma unroll
    for (int e = 0; e < 16; ++e) { float d = acc[vi][e] - mu; var += d * d; }
  var += __shfl_xor(var, 32);
  const float rs = rsqrtf(var * (1.f / 128.f) + 1e-6f);
#pragma unroll
  for (int vi = 0; vi < 4; ++vi)
#pragma unroll
    for (int g4 = 0; g4 < 4; ++g4) {
      const int v0 = 32 * vi + 8 * g4 + 4 * h;
      uint2 gt = *(const uint2*)(p.RGT + (size_t)(t0 + n) * 512 + hh * 128 + v0);
      float y0 = (acc[vi][4 * g4 + 0] - mu) * rs * __uint_as_float(gt.x << 16);
      float y1 = (acc[vi][4 * g4 + 1] - mu) * rs * __uint_as_float(gt.x & 0xffff0000u);
      float y2 = (acc[vi][4 * g4 + 2] - mu) * rs * __uint_as_float(gt.y << 16);
      float y3 = (acc[vi][4 * g4 + 3] - mu) * rs * __uint_as_float(gt.y & 0xffff0000u);
      *(uint2*)(p.RA + (size_t)(t0 + n) * DM + hh * 128 + v0) = pack4(y0, y1, y2, y3);
    }
}
#define HID_STRIDE 264
DI void compress_mfma(const Params& p, int item, char* smem) {
  float* PART = (float*)smem;
  bf16_t* HIDL = (bf16_t*)(smem + 4 * 16 * 256 * 4);
  const int tid = mytid(), lane = tid & 63, w = tid >> 6, r = lane & 31, h = lane >> 5;
  const int kv = item >> 7, bg = (item >> 5) & 3, rt = item & 31, n0 = rt * 16, b = bg >> 1, g = bg & 1;
  const bf16_t* src = kv ? p.NVC : p.NKC; const bf16_t* W1 = kv ? p.W1Tv : p.W1Tk; const bf16_t* W2 = kv ? p.W2Tv : p.W2Tk;
  const float* B1 = kv ? p.B1Pv : p.B1Pk;
  {
    const int kq = w >> 1, ch = w & 1;
    const int n = min(n0 + (r & 15), 510);
    const bf16_t* ab = src + ((size_t)(b * SEQ + 16 * n)) * 128 + g * 64 + 8 * h;
    const bf16_t* bb = W1 + (size_t)(128 * ch + r) * 2048 + 8 * h;
    f32x16 acc[4];
#pragma unroll
    for (int ct = 0; ct < 4; ++ct) acc[ct] = zero16();
#pragma unroll 4
    for (int s = 32 * kq; s < 32 * kq + 32; ++s) {
      const bf16x8 a = ld16(ab + (s >> 2) * 128 + (s & 3) * 16);
#pragma unroll
      for (int ct = 0; ct < 4; ++ct) acc[ct] = MFMA32(a, ld16(bb + (size_t)ct * 32 * 2048 + 16 * s), acc[ct]);
    }
#pragma unroll
    for (int ct = 0; ct < 4; ++ct)
#pragma unroll
      for (int e = 0; e < 8; ++e) PART[(kq * 16 + crow(e, h)) * 256 + 128 * ch + 32 * ct + r] = acc[ct][e];
  }
  __syncthreads();
#pragma unroll
  for (int i = 0; i < 8; ++i) {
    const int idx = tid + 512 * i, row = idx >> 8, col = idx & 255;
    const float v = PART[row * 256 + col] + PART[(16 + row) * 256 + col] + PART[(32 + row) * 256 + col] + PART[(48 + row) * 256 + col] + B1[col];
    HIDL[row * HID_STRIDE + col] = f2bf(gelu_tanh(v));
  }
  __syncthreads();
  if (w < 2) {
    f32x16 acc = zero16();
#pragma unroll
    for (int s = 0; s < 16; ++s) acc = MFMA32(ld16(HIDL + (r & 15) * HID_STRIDE + 16 * s + 8 * h), ld16(W2 + (size_t)(32 * w + r) * 256 + 16 * s + 8 * h), acc);
    const int e_ = 32 * w + r;
    if (kv == 0) {
#pragma unroll
      for (int e = 0; e < 8; ++e) { const int n = n0 + crow(e, h); p.KC[((size_t)bg * 512 + n) * 64 + e_] = (n < 511) ? f2bf(acc[e]) : (bf16_t)0; }
    } else {
#pragma unroll
      for (int g4 = 0; g4 < 2; ++g4) {
        const int n = n0 + 8 * g4 + 4 * h;
        float v3 = (n + 3 < 511) ? acc[4 * g4 + 3] : 0.f;
        *(uint2*)(p.VCT + ((size_t)bg * 64 + e_) * 512 + n) = pack4(acc[4 * g4], acc[4 * g4 + 1], acc[4 * g4 + 2], v3);
      }
    }
  }
  __syncthreads();
}
DI void kmax_body2(const Params& p, int vb) {
  const int tid = mytid(), g = tid & 1, t = vb * 256 + (tid >> 1), b = t >> 13;
  const bf16_t* k = p.NKS + (size_t)t * 128 + g * 64; const bf16_t* kw = p.NKW + (size_t)t * 128 + g * 64;
  float ss = 0.f, sw = 0.f;
  for (int d = 0; d < 64; d += 8) {
    uint4 a = *(const uint4*)(k + d), c = *(const uint4*)(kw + d);
    const unsigned aa[4] = {a.x, a.y, a.z, a.w}, cc[4] = {c.x, c.y, c.z, c.w};
#pragma unroll
    for (int q = 0; q < 4; ++q) {
      float x0 = __uint_as_float(aa[q] << 16), x1 = __uint_as_float(aa[q] & 0xffff0000u);
      float y0 = __uint_as_float(cc[q] << 16), y1 = __uint_as_float(cc[q] & 0xffff0000u);
      ss += x0 * x0 + x1 * x1; sw += y0 * y0 + y1 * y1;
    }
  }
  float m1 = sqrtf(ss), m2 = sqrtf(sw);
  for (int o = 2; o < 64; o <<= 1) { m1 = fmaxf(m1, __shfl_xor(m1, o)); m2 = fmaxf(m2, __shfl_xor(m2, o)); }
  if ((tid & 63) < 2) { atomicMax(&p.ksmax[b * 2 + g], __float_as_uint(m1)); atomicMax(&p.ksmax[4 + b * 2 + g], __float_as_uint(m2)); }
}
DI void kcmax_body(const Params& p, int idx) {
  const bf16_t* k = p.KC + (size_t)idx * 64;
  float ss = 0.f;
  for (int d = 0; d < 64; ++d) { float v = bf2f(k[d]); ss += v * v; }
  atomicMax(&p.ksmax[8 + (idx >> 9)], __float_as_uint(sqrtf(ss)));
}

#define NSA_IMP 0
#define NSA_SELM 65536
#define NSA_KV 66816
#define KV_ROW 144
#define KV_TILE (64 * KV_ROW)
template <int CTRL> DI float dpp_f2(float x) { return __builtin_bit_cast(float, __builtin_amdgcn_mov_dpp(__builtin_bit_cast(int, x), CTRL, 0xf, 0xf, true)); }
DI float quad_sum(float v) { v += dpp_f2<0xB1>(v); v += dpp_f2<0x4E>(v); return v; }
DI bf16x8 lds8x2(const char* ptr) {
  uint2 a = *(const uint2*)ptr, b = *(const uint2*)(ptr + 16);
  uint4 v; v.x = a.x; v.y = a.y; v.z = b.x; v.w = b.y;
  return __builtin_bit_cast(bf16x8, v);
}

DI void nsa_item(const Params& p, int item, char* smem) {
  const int tid = mytid(), lane = tid & 63, w = tid >> 6, r = lane & 31, h = lane >> 5;
  const int ti = item >> 2, bg = item & 3, b = bg >> 1, g = bg & 1;
  const int ts = ti * 64, tokg0 = b * SEQ + ts;
  const int tkl = 8 * w + (r >> 2), hl = r & 3, hd = g * 4 + hl, tpos = ts + tkl;
  float* IMPA = (float*)(smem + NSA_IMP); float* IMPB = IMPA + 64 * 128;
  unsigned* SELM = (unsigned*)(smem + NSA_SELM);
  char* KVB = smem + NSA_KV;
  const float ksm = __uint_as_float(p.ksmax[bg]), kwm = __uint_as_float(p.ksmax[4 + bg]), kcm = __uint_as_float(p.ksmax[8 + bg]);

  bf16x8 qf[4];
#pragma unroll
  for (int s = 0; s < 4; ++s) qf[s] = ld16(p.NQ + (size_t)(tokg0 + tkl) * 512 + hd * 64 + 16 * s + 8 * h);
  float qq = 0.f;
#pragma unroll
  for (int s = 0; s < 4; ++s) {
    uint4 u = __builtin_bit_cast(uint4, qf[s]);
    const unsigned uu[4] = {u.x, u.y, u.z, u.w};
#pragma unroll
    for (int q = 0; q < 4; ++q) { float x0 = __uint_as_float(uu[q] << 16), x1 = __uint_as_float(uu[q] & 0xffff0000u); qq += x0 * x0 + x1 * x1; }
  }
  qq += __shfl_xor(qq, 32);
  const float qn = sqrtf(qq);
  const int srow = tid >> 3, sch = tid & 7;
  const bf16_t* ksrc = p.NKS + ((size_t)(b * SEQ) + srow) * 128 + g * 64 + sch * 8;
  const bf16_t* vsrc = p.NVST + ((size_t)bg * 64 + srow) * SEQ + sch * 8;
  char* sdst = KVB + srow * KV_ROW + sch * 16;
  {
    uint4 k0 = *(const uint4*)ksrc, v0 = *(const uint4*)vsrc;
    *(uint4*)sdst = k0; *(uint4*)(sdst + KV_TILE) = v0;
  }
  for (int q = tid; q < 64 * 128 * 2 / 4; q += NT) ((float4*)IMPA)[q] = make_float4(0.f, 0.f, 0.f, 0.f);
  __syncthreads();

  const float mbc = qn * kcm;
  int nvalid = (tpos >= 31) ? ((tpos - 31) >> 4) + 1 : 0;
  if (nvalid > 511) nvalid = 511;
  int nvw = (ts + 8 * w + 7 >= 31) ? ((ts + 8 * w + 7 - 31) >> 4) + 1 : 0;
  if (nvw > 511) nvw = 511;
  const int nkt = (nvw + 31) >> 5;
  int nvmin = (ts + 8 * w >= 31) ? ((ts + 8 * w - 31) >> 4) + 1 : 0;
  if (nvmin > 511) nvmin = 511;
  const bf16_t* kcb = p.KC + ((size_t)bg * 512 + r) * 64 + 8 * h;
  float lsum = 0.f, invl = 0.f;
  for (int rep521 = 0; rep521 < (PROBE_DUP == 521 ? 2 : 1); ++rep521) {
  lsum = 0.f;
  for (int kt = 0; kt < nkt; ++kt) {
    f32x16 sa = fill16(-mbc);
#pragma unroll
    for (int s = 0; s < 4; ++s) sa = MFMA32(ld16(kcb + (size_t)kt * 32 * 64 + 16 * s), qf[s], sa);
    if (32 * kt + 32 <= nvmin) {
#pragma unroll
      for (int e = 0; e < 16; ++e) lsum += ex2(sa[e]);
    } else {
#pragma unroll
      for (int e = 0; e < 16; ++e) { const int n = 32 * kt + crow(e, h); lsum += (n < nvalid) ? ex2(sa[e]) : 0.f; }
    }
  }
  lsum += __shfl_xor(lsum, 32);
  invl = (lsum > 0.f) ? 1.f / lsum : 0.f;
  for (int kt = 0; kt < nkt; ++kt) {
    f32x16 sa = fill16(-mbc);
#pragma unroll
    for (int s = 0; s < 4; ++s) sa = MFMA32(ld16(kcb + (size_t)kt * 32 * 64 + 16 * s), qf[s], sa);
    float pv[16];
    if (32 * kt + 32 <= nvmin) {
#pragma unroll
      for (int e = 0; e < 16; ++e) pv[e] = ex2(sa[e]) * invl;
    } else {
#pragma unroll
      for (int e = 0; e < 16; ++e) { const int n = 32 * kt + crow(e, h); pv[e] = (n < nvalid) ? ex2(sa[e]) * invl : 0.f; }
    }
#pragma unroll
    for (int q = 0; q < 4; ++q) {
      float A = 2.f * (pv[4 * q] + pv[4 * q + 1] + pv[4 * q + 2]) + pv[4 * q + 3], Bv = pv[4 * q + 3];
      A = quad_sum(A); Bv = quad_sum(Bv);
      if (hl == 0) { const int j = 8 * kt + 2 * q + h; IMPA[tkl * 128 + j] = A; IMPB[tkl * 128 + j] = Bv; }
    }
  }
  }
  for (int rep522 = 0; rep522 < (PROBE_DUP == 522 ? 2 : 1); ++rep522)
  {
    const int tl = 8 * w + (lane >> 3), sub = lane & 7;
    unsigned kv_[16], ki_[16];
#pragma unroll
    for (int c = 0; c < 16; ++c) {
      const int j = sub + 8 * c;
      float imp = IMPA[tl * 128 + j] + ((j > 0) ? IMPB[tl * 128 + j - 1] : 0.f);
      if (j == 0 || j == ti || j == ti - 1) imp = 1e9f;
      kv_[c] = (j <= ti) ? __float_as_uint(imp) : 0u;
      ki_[c] = (j <= ti) ? (unsigned)(128 - j) : 0u;
    }
    unsigned m0 = 0, m1 = 0, m2 = 0, m3 = 0;
    for (int it = 0; it < 16; ++it) {
      unsigned bv = kv_[0], bi = ki_[0];
#pragma unroll
      for (int c = 1; c < 16; ++c) { const bool gt = (kv_[c] > bv) || (kv_[c] == bv && ki_[c] > bi); bv = gt ? kv_[c] : bv; bi = gt ? ki_[c] : bi; }
#define TOPK_STEP(CTRL) { const unsigned ov = (unsigned)__builtin_amdgcn_mov_dpp((int)bv, CTRL, 0xf, 0xf, true), oi = (unsigned)__builtin_amdgcn_mov_dpp((int)bi, CTRL, 0xf, 0xf, true); \
        const bool gt = (ov > bv) || (ov == bv && oi > bi); bv = gt ? ov : bv; bi = gt ? oi : bi; }
      TOPK_STEP(0xB1) TOPK_STEP(0x4E) TOPK_STEP(0x141)
#undef TOPK_STEP
      if (bi != 0u) {
        const int js = 128 - (int)bi;
        const unsigned bit = 1u << (js & 31);
        if ((js >> 5) == 0) m0 |= bit; else if ((js >> 5) == 1) m1 |= bit; else if ((js >> 5) == 2) m2 |= bit; else m3 |= bit;
#pragma unroll
        for (int c = 0; c < 16; ++c) { const bool hit = (ki_[c] == bi); kv_[c] = hit ? 0u : kv_[c]; ki_[c] = hit ? 0u : ki_[c]; }
      }
    }
    if (sub == 0) { SELM[tl * 4 + 0] = m0; SELM[tl * 4 + 1] = m1; SELM[tl * 4 + 2] = m2; SELM[tl * 4 + 3] = m3; }
  }
  if (lane < 4) {
    unsigned u = 0;
#pragma unroll
    for (int t8 = 0; t8 < 8; ++t8) u |= SELM[(8 * w + t8) * 4 + lane];
    SELM[(64 + w) * 4 + lane] = u;
  }
  const float mbs = qn * ksm;
  f32x16 osl[2]; osl[0] = zero16(); osl[1] = zero16();
  float lsel = 0.f;
#define RING_RUN(KS, KSTEP, VS, VSTEP, NTILES, NEED, COMPUTE)                                                                               \
  {                                                                                                                                         \
      \
      \
    for (int jj = 0; jj < (NTILES); ++jj) {                                                                                                 \
      uint4 ka_, va_;                                                                                                                       \
      ka_ = va_ = make_uint4(0u, 0u, 0u, 0u);                                                                                               \
      if (jj + 1 < (NTILES)) { ka_ = *(const uint4*)((KS) + (size_t)(jj + 1) * (KSTEP)); va_ = *(const uint4*)((VS) + (size_t)(jj + 1) * (VSTEP)); } \
      if (NEED(jj)) { const char* kb = KVB + (jj & 1) * 2 * KV_TILE; const char* vbuf = kb + KV_TILE; COMPUTE(jj, kb, vbuf) }               \
      if (jj + 1 < (NTILES)) { char* d2 = sdst + ((jj + 1) & 1) * 2 * KV_TILE; *(uint4*)d2 = ka_; *(uint4*)(d2 + KV_TILE) = va_; }          \
      __syncthreads();                                                                                                                      \
    }                                                                                                                                       \
  }
#define STAGE_PAIR0(KS, KSTEP, VS, VSTEP, NTILES) { uint4 k0_ = *(const uint4*)(KS), v0_ = *(const uint4*)(VS); *(uint4*)sdst = k0_; *(uint4*)(sdst + KV_TILE) = v0_; }
#define ATT_TILE(kb, vbuf, INIT, FULL, MASKEXPR, SCALE, ACC, LACC)                                                                          \
          {                                                                                                                                 \
            bf16x8 kf_[2][4], vf_[2][2][2];       \
            _Pragma("unroll") for (int kh = 0; kh < 2; ++kh)                                                                                \
              _Pragma("unroll") for (int s = 0; s < 4; ++s) kf_[kh][s] = *(const bf16x8*)(kb + (32 * kh + r) * KV_ROW + (16 * s + 8 * h) * 2); \
            _Pragma("unroll") for (int kh = 0; kh < 2; ++kh)                                                                                \
              _Pragma("unroll") for (int di = 0; di < 2; ++di)                                                                              \
                _Pragma("unroll") for (int s2 = 0; s2 < 2; ++s2) vf_[kh][di][s2] = lds8x2(vbuf + (32 * di + r) * KV_ROW + (32 * kh + 16 * s2 + 4 * h) * 2); \
            const bool full_ = (FULL);                                                                                                      \
            _Pragma("unroll") for (int kh = 0; kh < 2; ++kh) {                                                                              \
              f32x16 sa = fill16(INIT);                                                                                                     \
              _Pragma("unroll") for (int s = 0; s < 4; ++s) sa = MFMA32(kf_[kh][s], qf[s], sa);                                             \
              float pv[16];                                                                                                                 \
              _Pragma("unroll") for (int e = 0; e < 16; ++e) { const int key = 32 * kh + crow(e, h); pv[e] = (full_ || (MASKEXPR)) ? ex2(sa[e]) * (SCALE) : 0.f; } \
              LACC += ((pv[0] + pv[1]) + (pv[2] + pv[3])) + ((pv[4] + pv[5]) + (pv[6] + pv[7])) + ((pv[8] + pv[9]) + (pv[10] + pv[11])) + ((pv[12] + pv[13]) + (pv[14] + pv[15])); \
              const bf16x8 pk0 = pack8(pv[0], pv[1], pv[2], pv[3], pv[4], pv[5], pv[6], pv[7]);                                             \
              const bf16x8 pk1 = pack8(pv[8], pv[9], pv[10], pv[11], pv[12], pv[13], pv[14], pv[15]);                                       \
              _Pragma("unroll") for (int di = 0; di < 2; ++di) {                                                                            \
                ACC[di] = MFMA32(vf_[kh][di][0], pk0, ACC[di]);                                                                             \
                ACC[di] = MFMA32(vf_[kh][di][1], pk1, ACC[di]);                                                                             \
              }                                                                                                                             \
            }                                                                                                                               \
          }
#define SEL_NEED(jj) ((SELM[(64 + w) * 4 + ((jj) >> 5)] >> ((jj) & 31)) & 1u)
#define SEL_COMPUTE(jj, kb, vbuf) { const unsigned msel_ = SELM[tkl * 4 + ((jj) >> 5)]; \
      const float init_ = ((msel_ >> ((jj) & 31)) & 1u) ? -mbs : NEG_INF; ATT_TILE(kb, vbuf, init_, (jj) < ti, key <= tkl, 1.f, osl, lsel) }
  RING_RUN(ksrc, 64 * 128, vsrc, 64, ti + 1, SEL_NEED, SEL_COMPUTE)
  if (PROBE_DUP == 523) { STAGE_PAIR0(ksrc, 64 * 128, vsrc, 64, ti + 1) __syncthreads(); RING_RUN(ksrc, 64 * 128, vsrc, 64, ti + 1, SEL_NEED, SEL_COMPUTE) }
  lsel += __shfl_xor(lsel, 32);
  const float* gt = p.GATE + (size_t)(tokg0 + tkl) * 24 + hd * 3;
  f32x16 outacc[2];
  {
    const float g1 = gt[1] / lsel;
#pragma unroll
    for (int e = 0; e < 16; ++e) { outacc[0][e] = g1 * osl[0][e]; outacc[1][e] = g1 * osl[1][e]; }
  }
  {
  f32x16 oc[2]; oc[0] = zero16(); oc[1] = zero16();
  {
    int nvall = (ts + 63 >= 31) ? ((ts + 63 - 31) >> 4) + 1 : 0;
    if (nvall > 511) nvall = 511;
    const int nct = (nvall + 63) >> 6;
    if (nct > 0) {
      const bf16_t* kcs = p.KC + ((size_t)bg * 512 + srow) * 64 + sch * 8;
      const bf16_t* vcs = p.VCT + ((size_t)bg * 64 + srow) * 512 + sch * 8;
      float ldummy = 0.f;
      STAGE_PAIR0(kcs, 64 * 64, vcs, 64, nct) __syncthreads();
#define CMP_NEED(jj) (64 * (jj) < nvw)
#define CMP_COMPUTE(jj, kb, vbuf) ATT_TILE(kb, vbuf, -mbc, 64 * (jj) + 64 <= nvmin, 64 * (jj) + key < nvalid, invl, oc, ldummy)
      RING_RUN(kcs, 64 * 64, vcs, 64, nct, CMP_NEED, CMP_COMPUTE)
    }
  }
  {
    const float g0 = gt[0];
#pragma unroll
    for (int e = 0; e < 16; ++e) { outacc[0][e] += g0 * oc[0][e]; outacc[1][e] += g0 * oc[1][e]; }
  }
  }
  f32x16 ow[2]; ow[0] = zero16(); ow[1] = zero16();
  float lw = 0.f;
  const float mbw = qn * kwm;
  {
    const int j0w = (ti >= 8) ? ti - 8 : 0, nwt = ti - j0w + 1;
    const bf16_t* kws = p.NKW + ((size_t)(b * SEQ + 64 * j0w) + srow) * 128 + g * 64 + sch * 8;
    const bf16_t* vws = p.NVWT + ((size_t)bg * 64 + srow) * SEQ + 64 * j0w + sch * 8;
    STAGE_PAIR0(kws, 64 * 128, vws, 64, nwt) __syncthreads();
#define WIN_NEED(jj) true
#define WIN_COMPUTE(jj, kb, vbuf) { const int jw_ = j0w + (jj); const bool last_ = (jw_ == ti), first_ = (ti >= 8) && ((jj) == 0); \
      ATT_TILE(kb, vbuf, -mbw, !(last_ || first_), last_ ? (key <= tkl) : (key > tkl), 1.f, ow, lw) }
    RING_RUN(kws, 64 * 128, vws, 64, nwt, WIN_NEED, WIN_COMPUTE)
    if (PROBE_DUP == 525) { STAGE_PAIR0(kws, 64 * 128, vws, 64, nwt) __syncthreads(); RING_RUN(kws, 64 * 128, vws, 64, nwt, WIN_NEED, WIN_COMPUTE) }
  }
  lw += __shfl_xor(lw, 32);
  {
    const float g2 = gt[2] / lw;
#pragma unroll
    for (int di = 0; di < 2; ++di)
#pragma unroll
      for (int g4 = 0; g4 < 4; ++g4) {
        const int d0 = 32 * di + 8 * g4 + 4 * h;
        float y[4];
#pragma unroll
        for (int e = 0; e < 4; ++e) y[e] = outacc[di][4 * g4 + e] + g2 * ow[di][4 * g4 + e];
        *(uint2*)(p.RA + (size_t)(tokg0 + tkl) * DM + 512 + hd * 64 + d0) = pack4(y[0], y[1], y[2], y[3]);
      }
  }
}

typedef float f32x4 __attribute__((ext_vector_type(4)));
#define MFMA16(a, b, c) __builtin_amdgcn_mfma_f32_16x16x32_bf16((a), (b), (c), 0, 0, 0)
constexpr int pk_clen(int i) { return 16 / (i + 1); }
constexpr int pk_coff(int i) { int s = 0; for (int q = 0; q < i; ++q) s += pk_clen(q); return s; }
constexpr int pk_cand(int c) {
  int i = 0; while (i < 16 && c >= pk_clen(i)) { c -= pk_clen(i); ++i; }
  return (i < 16) ? i * 16 + c : 256;
}
#define SC_STRIDE 132

DI void convert_row(const Params& p, int row, int lane);
DI void peer_topk_tile(const Params& p, int vb, char* smem) {
  float* SC = (float*)smem;
  unsigned* ELK = (unsigned*)(smem + 256 * SC_STRIDE * 4);
  float* ELW = (float*)(ELK + 16 * 128);
  const int tid = mytid(), lane = tid & 63, w = tid >> 6;
  const int t0 = vb * 16;
  for (int rep91 = 0; rep91 < (PROBE_DUP == 91 ? 2 : 1); ++rep91) {
    const int tq = lane & 15, kq = lane >> 4;
#pragma unroll
    for (int pi = 0; pi < 2; ++pi) {
      const int ph = 2 * w + pi;
      bf16x8 bfr[4];
#pragma unroll
      for (int s = 0; s < 4; ++s) bfr[s] = *(const bf16x8*)(p.PQ + (size_t)(t0 + tq) * 2048 + ph * 128 + 32 * s + 8 * kq);
#pragma unroll
      for (int j = 0; j < 8; ++j) {
        f32x4 acc = {0.f, 0.f, 0.f, 0.f};
#pragma unroll
        for (int s = 0; s < 4; ++s) {
          bf16x8 afr = *(const bf16x8*)(p.SUBK + ((size_t)(ph * 128 + 16 * j + tq)) * 128 + 32 * s + 8 * kq);
          acc = MFMA16(afr, bfr[s], acc);
        }
        *(f32x4*)(SC + (ph * 16 + tq) * SC_STRIDE + 16 * j + 4 * kq) = acc;
      }
    }
  }
  __syncthreads();
  if (tid < 256) {
    float* row = SC + tid * SC_STRIDE;
    float gmax[16];
#pragma unroll
    for (int g = 0; g < 16; ++g) {
      float4 a = *(float4*)(row + g * 8), b = *(float4*)(row + g * 8 + 4);
      gmax[g] = fmaxf(fmaxf(fmaxf(a.x, a.y), fmaxf(a.z, a.w)), fmaxf(fmaxf(b.x, b.y), fmaxf(b.z, b.w)));
    }
    float outv[16]; int outi[16];
#pragma unroll
    for (int k = 0; k < 16; ++k) {
      float gm = gmax[0]; int gi = 0;
#pragma unroll
      for (int g = 1; g < 16; ++g) { bool c = gmax[g] > gm; gm = c ? gmax[g] : gm; gi = c ? g : gi; }
      float* gp = row + gi * 8;
      float4 a = *(float4*)gp, b = *(float4*)(gp + 4);
      float v[8] = {a.x, a.y, a.z, a.w, b.x, b.y, b.z, b.w};
      int ei = 7;
#pragma unroll
      for (int e = 6; e >= 0; --e) ei = (v[e] == gm) ? e : ei;
      float nm = NEG_INF;
#pragma unroll
      for (int e = 0; e < 8; ++e) { float x = (e == ei) ? NEG_INF : v[e]; nm = fmaxf(nm, x); }
      gp[ei] = NEG_INF;
#pragma unroll
      for (int g = 0; g < 16; ++g) gmax[g] = (g == gi) ? nm : gmax[g];
      outv[k] = gm; outi[k] = gi * 8 + ei;
    }
#pragma unroll
    for (int k = 0; k < 16; ++k) { row[k] = outv[k]; row[16 + k] = __int_as_float(outi[k]); }
  } else {
#pragma unroll 1
    for (int i = 0; i < 8; ++i) convert_row(p, (vb * 4 + (w - 4)) * 8 + i, lane);
  }
  __syncthreads();
  for (int rep93 = 0; rep93 < (PROBE_DUP == 93 ? 2 : 1); ++rep93) {
    const int q = tid >> 2, sub = tid & 3, t = q >> 3, pp = q & 7;
    const float* ra = SC + ((2 * pp) * 16 + t) * SC_STRIDE;
    const float* rb = SC + ((2 * pp + 1) * 16 + t) * SC_STRIDE;
    float sv[13]; int sj[13];
#pragma unroll
    for (int k = 0; k < 13; ++k) {
      const int ij = (sub == 0) ? pk_cand(4 * k) : (sub == 1) ? pk_cand(4 * k + 1) : (sub == 2) ? pk_cand(4 * k + 2) : pk_cand(4 * k + 3);
      sj[k] = ij;
      sv[k] = (ij < 256) ? ra[ij >> 4] + rb[ij & 15] : NEG_INF;
    }
    float v16[16]; int j16[16];
#pragma unroll
    for (int k = 0; k < 16; ++k) {
      float bv = sv[0]; int bj = sj[0];
#pragma unroll
      for (int c = 1; c < 13; ++c) { const bool gt = (sv[c] > bv) || (sv[c] == bv && sj[c] < bj); bv = gt ? sv[c] : bv; bj = gt ? sj[c] : bj; }
#define PK_STEP(CTRL) { const float ov = __builtin_bit_cast(float, __builtin_amdgcn_mov_dpp(__builtin_bit_cast(int, bv), CTRL, 0xf, 0xf, true)); \
        const int oj = __builtin_amdgcn_mov_dpp(bj, CTRL, 0xf, 0xf, true); const bool gt = (ov > bv) || (ov == bv && oj < bj); bv = gt ? ov : bv; bj = gt ? oj : bj; }
      PK_STEP(0xB1) PK_STEP(0x4E)
#undef PK_STEP
#pragma unroll
      for (int c = 0; c < 13; ++c) sv[c] = (sj[c] == bj) ? NEG_INF : sv[c];
      v16[k] = bv; j16[k] = bj;
    }
    float l = 0.f; const float vmax = v16[0];
#pragma unroll
    for (int k = 0; k < 16; ++k) { v16[k] = __expf(v16[k] - vmax); l += v16[k]; }
    const float inv = 1.f / l;
#pragma unroll
    for (int k = 0; k < 16; ++k)
      if ((k & 3) == sub) {
        const int code = __float_as_int(ra[16 + (j16[k] >> 4)]) * 128 + __float_as_int(rb[16 + (j16[k] & 15)]);
        ELK[t * 128 + pp * 16 + k] = ((unsigned)code << 7) | (unsigned)(pp * 16 + k);
        ELW[t * 128 + pp * 16 + k] = v16[k] * inv;
      }
  }
  __syncthreads();
  for (int rep94 = 0; rep94 < (PROBE_DUP == 94 ? 2 : 1); ++rep94)
#pragma unroll
  for (int tt = 0; tt < 2; ++tt) {
    const int t = 2 * w + tt;
    const unsigned e0 = ELK[t * 128 + 2 * lane], e1 = ELK[t * 128 + 2 * lane + 1];
    int r0 = 0, r1 = 0;
#pragma unroll 8
    for (int c = 0; c < 32; ++c) {
      const uint4 kq = *(const uint4*)(ELK + t * 128 + 4 * c);
      r0 += (kq.x < e0) + (kq.y < e0) + (kq.z < e0) + (kq.w < e0);
      r1 += (kq.x < e1) + (kq.y < e1) + (kq.z < e1) + (kq.w < e1);
    }
    const size_t gb = (size_t)(t0 + t) * 128;
    p.EIDX[gb + r0] = (int)(e0 >> 7); p.EIDX[gb + r1] = (int)(e1 >> 7);
    p.EW[gb + r0] = ELW[t * 128 + (e0 & 127)]; p.EW[gb + r1] = ELW[t * 128 + (e1 & 127)];
  }
  __syncthreads();
}

DI float dot2bf(unsigned a, unsigned b, float acc) { return __builtin_amdgcn_fdot2_f32_bf16(__builtin_bit_cast(bf16x2_t, a), __builtin_bit_cast(bf16x2_t, b), acc, false); }
template <int CTRL> DI float dpp_f(float x) { return __builtin_bit_cast(float, __builtin_amdgcn_mov_dpp(__builtin_bit_cast(int, x), CTRL, 0xf, 0xf, true)); }
DI float row16_sum(float v) { v += dpp_f<0x128>(v); v += dpp_f<0x124>(v); v += dpp_f<0x122>(v); v += dpp_f<0x121>(v); return v; }
DI float dot_row(const uint4 (&u)[8], const uint4 (&h)[8]) {
  float d = 0.f;
#pragma unroll
  for (int j = 0; j < 8; ++j) { d = dot2bf(u[j].x, h[j].x, d); d = dot2bf(u[j].y, h[j].y, d); d = dot2bf(u[j].z, h[j].z, d); d = dot2bf(u[j].w, h[j].w, d); }
  return row16_sum(d);
}
DI void axpy_row(float (&acc)[64], const uint4 (&v)[8], float c) {
#pragma unroll
  for (int j = 0; j < 8; ++j) {
    const unsigned ww[4] = {v[j].x, v[j].y, v[j].z, v[j].w};
#pragma unroll
    for (int q = 0; q < 4; ++q) {
      acc[j * 8 + 2 * q] += c * __uint_as_float(ww[q] << 16);
      acc[j * 8 + 2 * q + 1] += c * __uint_as_float(ww[q] & 0xffff0000u);
    }
  }
}
DI void axpy_half(float (&acc)[32], const uint4 (&v)[4], float c) {
#pragma unroll
  for (int j = 0; j < 4; ++j) {
    const unsigned ww[4] = {v[j].x, v[j].y, v[j].z, v[j].w};
#pragma unroll
    for (int q = 0; q < 4; ++q) {
      acc[j * 8 + 2 * q] += c * __uint_as_float(ww[q] << 16);
      acc[j * 8 + 2 * q + 1] += c * __uint_as_float(ww[q] & 0xffff0000u);
    }
  }
}
#ifndef PEER_TILE_SHIFT
#define PEER_TILE_SHIFT 8
#endif
DI void fma16_fp8(float& d, const uint4& u, const float* hv) {
  const unsigned ww[4] = {u.x, u.y, u.z, u.w};
#pragma unroll
  for (int q = 0; q < 4; ++q) {
    f32x2_t a = __builtin_amdgcn_cvt_pk_f32_fp8((int)ww[q], false), b = __builtin_amdgcn_cvt_pk_f32_fp8((int)ww[q], true);
    d += a[0] * hv[4 * q] + a[1] * hv[4 * q + 1] + b[0] * hv[4 * q + 2] + b[1] * hv[4 * q + 3];
  }
}
DI float dot_row8(const uint4 (&u)[4], const float (&hv)[64]) {
  float d0 = 0.f, d1 = 0.f;
  fma16_fp8(d0, u[0], hv); fma16_fp8(d1, u[1], hv + 16); fma16_fp8(d0, u[2], hv + 32); fma16_fp8(d1, u[3], hv + 48);
  return row16_sum(d0 + d1);
}
DI void axpy_row8(float (&acc)[64], const uint4 (&v)[4], float c) {
#pragma unroll
  for (int j = 0; j < 4; ++j) {
    const unsigned ww[4] = {v[j].x, v[j].y, v[j].z, v[j].w};
#pragma unroll
    for (int q = 0; q < 4; ++q) {
      f32x2_t a = __builtin_amdgcn_cvt_pk_f32_fp8((int)ww[q], false), b = __builtin_amdgcn_cvt_pk_f32_fp8((int)ww[q], true);
      acc[j * 16 + 4 * q] += c * a[0]; acc[j * 16 + 4 * q + 1] += c * a[1]; acc[j * 16 + 4 * q + 2] += c * b[0]; acc[j * 16 + 4 * q + 3] += c * b[1];
    }
  }
}
DI void peer_gather_block(const Params& p, int vb, char* smem) {
  unsigned* ELK = (unsigned*)smem;
  float* ELC = (float*)(smem + 32768);
  const int tid = mytid(), lane = tid & 63, w = tid >> 6, grp = lane >> 4, i = lane & 15;
  const int tokbase = vb * 64;
  for (int q = tid; q < 64 * 128 / 4; q += NT) {
    ((uint4*)ELK)[q] = ((const uint4*)(p.EIDX + (size_t)tokbase * 128))[q];
    ((float4*)ELC)[q] = ((const float4*)(p.EW + (size_t)tokbase * 128))[q];
  }
  __syncthreads();
#pragma unroll 1
  for (int tt = 0; tt < 2; ++tt) {
    const int tl = w * 8 + grp * 2 + tt, tok = tokbase + tl;
    const unsigned* kk = ELK + tl * 128;
    float* cc = ELC + tl * 128;
    uint4 b0[4], b1[4], b2[4], b3[4];
#define ROW_LOAD(BUF, BASE, E) { const unsigned e_ = kk[E]; _Pragma("unroll") for (int j = 0; j < 4; ++j) BUF[j] = *(const uint4*)(BASE + (size_t)e_ * DM + j * 256); }
    {
      float hv[64];
#pragma unroll
      for (int j = 0; j < 4; ++j)
#pragma unroll
        for (int hf = 0; hf < 2; ++hf) {
          uint4 a = *(const uint4*)(p.RA + (size_t)tok * DM + j * 256 + i * 16 + hf * 8);
          const unsigned aa[4] = {a.x, a.y, a.z, a.w};
#pragma unroll
          for (int q = 0; q < 4; ++q) { hv[j * 16 + hf * 8 + 2 * q] = __uint_as_float(aa[q] << 16); hv[j * 16 + hf * 8 + 2 * q + 1] = __uint_as_float(aa[q] & 0xffff0000u); }
        }
      const unsigned char* ub_ = p.PDN8 + i * 16;
#define DN_COMP(BUF, E) { const unsigned e_ = kk[E]; float d_ = dot_row8(BUF, hv) * p.SDN[e_]; float c_ = cc[E] * gelu_tanh(d_) * p.SUP[e_]; if (i == 0) cc[E] = c_; }
      ROW_LOAD(b0, ub_, 0) ROW_LOAD(b1, ub_, 1) ROW_LOAD(b2, ub_, 2) ROW_LOAD(b3, ub_, 3)
      for (int e = 0; e < 128; e += 4) {
        DN_COMP(b0, e)     if (e + 4 < 128) ROW_LOAD(b0, ub_, e + 4)
        DN_COMP(b1, e + 1) if (e + 4 < 128) ROW_LOAD(b1, ub_, e + 5)
        DN_COMP(b2, e + 2) if (e + 4 < 128) ROW_LOAD(b2, ub_, e + 6)
        DN_COMP(b3, e + 3) if (e + 4 < 128) ROW_LOAD(b3, ub_, e + 7)
      }
#undef DN_COMP
    }
    {
      float acc[64];
#pragma unroll
      for (int e = 0; e < 64; ++e) acc[e] = 0.f;
      const unsigned char* vbase = p.PUP8 + i * 16;
      ROW_LOAD(b0, vbase, 0) ROW_LOAD(b1, vbase, 1) ROW_LOAD(b2, vbase, 2) ROW_LOAD(b3, vbase, 3)
      for (int e = 0; e < 128; e += 4) {
        axpy_row8(acc, b0, cc[e]);     if (e + 4 < 128) ROW_LOAD(b0, vbase, e + 4)
        axpy_row8(acc, b1, cc[e + 1]); if (e + 4 < 128) ROW_LOAD(b1, vbase, e + 5)
        axpy_row8(acc, b2, cc[e + 2]); if (e + 4 < 128) ROW_LOAD(b2, vbase, e + 6)
        axpy_row8(acc, b3, cc[e + 3]); if (e + 4 < 128) ROW_LOAD(b3, vbase, e + 7)
      }
      const int b = tok >> 13;
      const float* ga2 = p.mod + b * 6144 + 5120;
      const float* orow = p.out + (size_t)tok * DM; float* grow = p.gout + (size_t)tok * DM;
      float ss = 0.f;
#pragma unroll
      for (int j = 0; j < 4; ++j)
#pragma unroll
        for (int q4 = 0; q4 < 4; ++q4) {
          const int col = j * 256 + i * 16 + q4 * 4;
          float4 x1 = *(const float4*)(orow + col), gg = *(const float4*)(ga2 + col);
          float* q = acc + j * 16 + q4 * 4;
          q[0] = x1.x + gg.x * q[0]; q[1] = x1.y + gg.y * q[1]; q[2] = x1.z + gg.z * q[2]; q[3] = x1.w + gg.w * q[3];
          ss += q[0] * q[0] + q[1] * q[1] + q[2] * q[2] + q[3] * q[3];
        }
      ss = row16_sum(ss);
      const float rstd = rsqrtf(ss * (1.f / DM) + 1e-6f);
#pragma unroll
      for (int j = 0; j < 4; ++j)
#pragma unroll
        for (int q4 = 0; q4 < 4; ++q4) {
          const int col = j * 256 + i * 16 + q4 * 4;
          float4 gf = *(const float4*)(p.g_final + col);
          const float* q = acc + j * 16 + q4 * 4;
          *(float4*)(grow + col) = make_float4(q[0] * rstd * gf.x, q[1] * rstd * gf.y, q[2] * rstd * gf.z, q[3] * rstd * gf.w);
        }
    }
#undef ROW_LOAD
  }
  __syncthreads();
}
DI void convert_row(const Params& p, int row, int lane) {
  const int tb = row >> 14, rr = row & 16383;
  const float* src = (tb ? p.peer_up : p.peer_down) + (size_t)rr * DM;
  float4 x[4]; float am = 0.f;
#pragma unroll
  for (int q = 0; q < 4; ++q) {
    x[q] = *(const float4*)(src + q * 256 + lane * 4);
    am = fmaxf(am, fmaxf(fmaxf(fabsf(x[q].x), fabsf(x[q].y)), fmaxf(fabsf(x[q].z), fabsf(x[q].w))));
  }
  for (int o = 32; o; o >>= 1) am = fmaxf(am, __shfl_xor(am, o));
  const float sc = (am > 0.f) ? am * (1.f / 448.f) : 1.f, inv = (am > 0.f) ? 448.f / am : 1.f;
  unsigned* dst = (unsigned*)((tb ? p.PUP8 : p.PDN8) + (size_t)rr * DM);
#pragma unroll
  for (int q = 0; q < 4; ++q) {
    int wd = 0;
    wd = __builtin_amdgcn_cvt_pk_fp8_f32(x[q].x * inv, x[q].y * inv, wd, false);
    wd = __builtin_amdgcn_cvt_pk_fp8_f32(x[q].z * inv, x[q].w * inv, wd, true);
    dst[q * 64 + lane] = (unsigned)wd;
  }
  if (lane == 0) (tb ? p.SUP : p.SDN)[rr] = sc;
}

#define N_PHASES 11
template <int PH>
DI void run_phase(const Params& p, char* smem) {
  const int nb = gridDim.x, bid = blockIdx.x, tid = mytid();
  if (PH == 0) {
    for (int vb = bid; vb < PH0_MOD; vb += nb) ph0_body(p, vb, smem);
  } else if (PH == 1) {
    for (int vb = bid; vb < T_TOK / 8 + (PH0_NVB - PH0_MOD); vb += nb) {
      if (vb < T_TOK / 8) rownorm_body(p.x, p.g_mix, p.mod, 0, 1024, p.RA, vb);
      else ph0_body(p, vb - T_TOK / 8 + PH0_MOD, smem);
    }
  } else if (PH == 2) {
    EpiProj e{p};
    for (int vb = bid; vb < 64 * 14; vb += nb) gemm_tile(p.RA, p.WinT, 1024, (vb & 63) * 256, (vb >> 6) * 256, smem, e);
  } else if (PH == 3) {
    for (int vb = bid; vb < 256 + 512 + 64; vb += nb) {
      if (vb < 256) compress_mfma(p, vb, smem);
      else if (vb < 256 + 512) retkv_mfma(p, vb - 256);
      else kmax_body2(p, vb - 768);
    }
  } else if (PH == 4) {
    for (int vb = bid; vb < 256 + 4; vb += nb) {
      if (vb < 256) scan_body(p, vb * NT + tid);
      else kcmax_body(p, (vb - 256) * NT + tid);
    }
  } else if (PH == 5) {
    for (int rep = 0; rep < (PROBE_DUP == 51 ? 2 : 1); ++rep)
      for (int vb = bid; vb < 256; vb += nb) retout_mfma(p, vb * 8 + (tid >> 6));
    for (int rep = 0; rep < (PROBE_DUP == 52 ? 2 : 1); ++rep)
      for (int vb = bid; vb < 512; vb += nb) nsa_item(p, (vb < 256) ? vb : 767 - vb, smem);
  } else if (PH == 6) {
    EpiOut e{p};
    for (int vb = bid; vb < 64 * 4; vb += nb) gemm_tile(p.RA, p.WoutT, 1024, (vb & 63) * 256, (vb >> 6) * 256, smem, e);
  } else if (PH == 7) {
    for (int vb = bid; vb < T_TOK / 8; vb += nb) rownorm_body(p.out, p.g_ffn, p.mod, 3072, 4096, p.RA, vb);
  } else if (PH == 8) {
    EpiPQ e{p};
    for (int vb = bid; vb < 64 * 8; vb += nb) gemm_tile(p.RA, p.WqT, 1024, (vb & 63) * 256, (vb >> 6) * 256, smem, e);
  } else if (PH == 9) {
    for (int vb = bid; vb < T_TOK / 16; vb += nb) peer_topk_tile(p, vb, smem);
  } else if (PH == 10) {
    for (int vb = bid; vb < T_TOK / 64; vb += nb) peer_gather_block(p, vb, smem);
  }
}


#define XB_TMO      128
#define XB_XCNT(j)  (256  + 64 * (j))
#define XB_XSUB(j)  (1280 + 64 * (j))
#define XB_XGEN(j)  (2304 + 64 * (j))
#define XB_TOP      3328
#define XB_TOPGEN   3392
#define XCD_BAR_WORDS 3456
#define XB_SPIN_CAP (1u << 22)
#define LAS __attribute__((address_space(3)))
DI unsigned xb_ld(unsigned* p) { return __hip_atomic_load(p, __ATOMIC_RELAXED, __HIP_MEMORY_SCOPE_AGENT); }
DI unsigned xb_add(unsigned* p, unsigned v) { return __hip_atomic_fetch_add(p, v, __ATOMIC_RELAXED, __HIP_MEMORY_SCOPE_AGENT); }
DI unsigned xb_xcc_id() { return (unsigned)__builtin_amdgcn_s_getreg((3 << 11) | 20) & 0xFu; }
#define XB_SPIN(cond, bar) do { unsigned _sp = 0; while (cond) { __builtin_amdgcn_s_sleep(1); \
    if ((++_sp & 255u) == 0u) { if (xb_ld(&(bar)[XB_TMO])) break; if (_sp > XB_SPIN_CAP) { atomicAdd(&(bar)[XB_TMO], 1u); break; } } } } while (0)
struct XcdBarrier { unsigned* bar; unsigned x; volatile LAS unsigned* st; };
DI XcdBarrier xcd_barrier_post(unsigned* bar, volatile LAS unsigned* st) {
  XcdBarrier b; b.bar = bar; b.x = xb_xcc_id(); b.st = st;
  if (threadIdx.x == 0) (void)xb_add(&bar[XB_XCNT(b.x)], 1u);
  return b;
}
DI void xcd_barrier_complete(unsigned* bar, unsigned x, unsigned& nloc, unsigned& nx) {
  const unsigned G = gridDim.x * gridDim.y * gridDim.z;
  unsigned sum, cnt, mine, sp = 0u;
  for (;;) {
    sum = 0u; cnt = 0u; mine = 0u;
#pragma unroll
    for (unsigned j = 0; j < 16; ++j) { const unsigned c = xb_ld(&bar[XB_XCNT(j)]); sum += c; cnt += (c > 0u) ? 1u : 0u; mine = (j == x) ? c : mine; }
    if (sum == G) break;
    __builtin_amdgcn_s_sleep(1);
    if ((++sp & 255u) == 0u) { if (xb_ld(&bar[XB_TMO])) break; if (sp > XB_SPIN_CAP) { atomicAdd(&bar[XB_TMO], 1u); break; } }
  }
  nloc = mine > 0u ? mine : 1u; nx = cnt > 0u ? cnt : 1u;
}
DI void xcd_barrier(const XcdBarrier& b) {
  asm volatile("s_waitcnt vmcnt(0)" ::: "memory");
  __syncthreads();
  if (threadIdx.x == 0) {
    unsigned* bar = b.bar;
    __builtin_amdgcn_s_waitcnt(0);
    unsigned nloc = b.st[0], nx = b.st[1];
    if (nloc == 0u) { xcd_barrier_complete(bar, b.x, nloc, nx); b.st[0] = nloc; b.st[1] = nx; }
    const unsigned old = xb_add(&bar[XB_XSUB(b.x)], 1u);
    const unsigned gen = old / nloc;
    if (old + 1u == (gen + 1u) * nloc) {
      __builtin_amdgcn_fence(__ATOMIC_RELEASE, "agent");
      asm volatile("s_waitcnt vmcnt(0)" ::: "memory");
      const unsigned og = xb_add(&bar[XB_TOP], 1u);
      const unsigned tg = og / nx;
      if (og + 1u == (tg + 1u) * nx) xb_add(&bar[XB_TOPGEN], 1u);
      else XB_SPIN(xb_ld(&bar[XB_TOPGEN]) == tg, bar);
      __builtin_amdgcn_fence(__ATOMIC_ACQUIRE, "agent");
      xb_add(&bar[XB_XGEN(b.x)], 1u);
      asm volatile("s_waitcnt vmcnt(0)" ::: "memory");
    } else {
      XB_SPIN(xb_ld(&bar[XB_XGEN(b.x)]) == gen, bar);
      __builtin_amdgcn_fence(__ATOMIC_ACQUIRE, "agent");
      asm volatile("s_waitcnt vmcnt(0)" ::: "memory");
    }
  }
  __syncthreads();
}

#define SMEM_BYTES 155648

template <int PH>
DI void phase_and_probe(const Params& p, char* smem, cg::grid_group& grid) {
  const int reps = (PROBE_DUP == PH) ? 2 : 1;
  for (int rep = 0; rep < reps; ++rep) {
    if (PH == 10 && rep + 1 < reps) { Params q = p; q.gout = (float*)p.PQ; run_phase<PH>(q, smem); }
    else run_phase<PH>(p, smem);
    if (rep + 1 < reps) grid.sync();
  }
}
__global__ void __launch_bounds__(NT) k_mega(Params p) {
  extern __shared__ __attribute__((aligned(16))) char smem[];
  __shared__ uint4 xb_words;
  cg::grid_group grid = cg::this_grid();
  if (threadIdx.x == 0) xb_words = make_uint4(0u, 0u, 0u, 0u);
  __syncthreads();
  XcdBarrier xb = xcd_barrier_post(p.xbar, (volatile LAS unsigned*)&xb_words);
  phase_and_probe<0>(p, smem, grid); grid.sync();
  phase_and_probe<1>(p, smem, grid); xcd_barrier(xb);
  phase_and_probe<2>(p, smem, grid); xcd_barrier(xb);
  phase_and_probe<3>(p, smem, grid); xcd_barrier(xb);
  phase_and_probe<4>(p, smem, grid); xcd_barrier(xb);
  phase_and_probe<5>(p, smem, grid); xcd_barrier(xb);
  phase_and_probe<6>(p, smem, grid); xcd_barrier(xb);
  phase_and_probe<7>(p, smem, grid); xcd_barrier(xb);
  phase_and_probe<8>(p, smem, grid); xcd_barrier(xb);
  phase_and_probe<9>(p, smem, grid); xcd_barrier(xb);
  phase_and_probe<10>(p, smem, grid);
}
#ifdef MK_MULTI
template <int PH>
__global__ void __launch_bounds__(NT) k_single(Params p) {
  extern __shared__ __attribute__((aligned(16))) char smem[];
  run_phase<PH>(p, smem);
}
#endif

static size_t carve(size_t& off, size_t bytes) { size_t o = off; off += (bytes + 255) & ~(size_t)255; return o; }

extern "C" void kernel_launch(void* const* d_in, const int* in_sizes, int n_in, void* d_out, int out_size, void* d_ws, size_t ws_size,
                              hipStream_t stream) {
  Params p{};
  p.x = (const float*)d_in[0]; p.c = (const float*)d_in[1]; p.w_ada = (const float*)d_in[2]; p.b_ada = (const float*)d_in[3];
  p.g_mix = (const float*)d_in[4]; p.w_in = (const float*)d_in[5]; p.pe_k = (const float*)d_in[6]; p.pe_v = (const float*)d_in[7];
  p.w_k1 = (const float*)d_in[8]; p.b_k1 = (const float*)d_in[9]; p.w_k2 = (const float*)d_in[10]; p.w_v1 = (const float*)d_in[11];
  p.b_v1 = (const float*)d_in[12]; p.w_v2 = (const float*)d_in[13]; p.w_out = (const float*)d_in[14]; p.g_ffn = (const float*)d_in[15];
  p.w_pq = (const float*)d_in[16]; p.subkeys = (const float*)d_in[17]; p.peer_down = (const float*)d_in[18]; p.peer_up = (const float*)d_in[19];
  p.g_final = (const float*)d_in[20];
  p.out = (float*)d_out; p.gout = p.out;
  char* ws = (char*)d_ws;
  size_t off = 0;
  p.mod = (float*)(ws + carve(off, 2 * 6144 * 4));
  p.ksmax = (unsigned*)(ws + carve(off, 256));
  p.xbar = (unsigned*)(ws + carve(off, XCD_BAR_WORDS * 4));
  p.c128 = (float*)(ws + carve(off, (size_t)SEQ * 64 * 4)); p.s128 = (float*)(ws + carve(off, (size_t)SEQ * 64 * 4));
  p.c64 = (float*)(ws + carve(off, (size_t)SEQ * 32 * 4)); p.s64 = (float*)(ws + carve(off, (size_t)SEQ * 32 * 4));
  p.WinT = (bf16_t*)(ws + carve(off, (size_t)NPROJ * 1024 * 2));
  p.WoutT = (bf16_t*)(ws + carve(off, (size_t)1024 * 1024 * 2));
  p.WqT = (bf16_t*)(ws + carve(off, (size_t)2048 * 1024 * 2));
  p.W1Tk = (bf16_t*)(ws + carve(off, (size_t)256 * 2048 * 2)); p.W1Tv = (bf16_t*)(ws + carve(off, (size_t)256 * 2048 * 2));
  p.W2Tk = (bf16_t*)(ws + carve(off, 64 * 256 * 2)); p.W2Tv = (bf16_t*)(ws + carve(off, 64 * 256 * 2));
  p.SUBK = (bf16_t*)(ws + carve(off, (size_t)16 * 128 * 128 * 2));
  p.B1Pk = (float*)(ws + carve(off, 1024)); p.B1Pv = (float*)(ws + carve(off, 1024));
  p.RA = (bf16_t*)(ws + carve(off, (size_t)T_TOK * 1024 * 2));
  size_t rb = off;
  p.RQ = (bf16_t*)(ws + carve(off, (size_t)T_TOK * 512 * 2)); p.RK = (bf16_t*)(ws + carve(off, (size_t)T_TOK * 512 * 2));
  p.RKT = (bf16_t*)(ws + carve(off, (size_t)T_TOK * 512 * 2)); p.RVT = (bf16_t*)(ws + carve(off, (size_t)T_TOK * 512 * 2));
  p.RGT = (bf16_t*)(ws + carve(off, (size_t)T_TOK * 512 * 2)); p.NQ = (bf16_t*)(ws + carve(off, (size_t)T_TOK * 512 * 2));
  p.NKC = (bf16_t*)(ws + carve(off, (size_t)T_TOK * 128 * 2)); p.NVC = (bf16_t*)(ws + carve(off, (size_t)T_TOK * 128 * 2));
  p.NKS = (bf16_t*)(ws + carve(off, (size_t)T_TOK * 128 * 2)); p.NKW = (bf16_t*)(ws + carve(off, (size_t)T_TOK * 128 * 2));
  p.NVST = (bf16_t*)(ws + carve(off, (size_t)T_TOK * 128 * 2)); p.NVWT = (bf16_t*)(ws + carve(off, (size_t)T_TOK * 128 * 2));
  p.GATE = (float*)(ws + carve(off, (size_t)T_TOK * 24 * 4));
  p.KV = (float*)(ws + carve(off, (size_t)512 * 16384 * 4));
  p.SPREV = (bf16_t*)(ws + carve(off, (size_t)512 * 16384 * 2));
  p.KC = (bf16_t*)(ws + carve(off, (size_t)4 * 512 * 64 * 2)); p.VCT = (bf16_t*)(ws + carve(off, (size_t)4 * 512 * 64 * 2));
  p.HID = (float*)(ws + carve(off, (size_t)2 * 2048 * 256 * 4));
  size_t off2 = rb;
  p.PQ = (bf16_t*)(ws + carve(off2, (size_t)T_TOK * 2048 * 2));
  p.EIDX = (int*)(ws + carve(off2, (size_t)T_TOK * 128 * 4));
  p.EW = (float*)(ws + carve(off2, (size_t)T_TOK * 128 * 4));
  p.PDN8 = (unsigned char*)(ws + carve(off2, (size_t)16384 * 1024));
  p.PUP8 = (unsigned char*)(ws + carve(off2, (size_t)16384 * 1024));
  p.SDN = (float*)(ws + carve(off2, 16384 * 4));
  p.SUP = (float*)(ws + carve(off2, 16384 * 4));
  (void)ws_size; (void)in_sizes; (void)n_in; (void)out_size;

#ifdef MK_MULTI
#define LAUNCH1(PH) { hipFuncSetAttribute((const void*)k_single<PH>, hipFuncAttributeMaxDynamicSharedMemorySize, SMEM_BYTES); k_single<PH><<<256, NT, SMEM_BYTES, stream>>>(p); }
  LAUNCH1(0) LAUNCH1(1) LAUNCH1(2) LAUNCH1(3) LAUNCH1(4) LAUNCH1(5) LAUNCH1(6) LAUNCH1(7) LAUNCH1(8) LAUNCH1(9) LAUNCH1(10)
#else
  static int grid_blocks = 0;
  if (!grid_blocks) {
    int dev = 0, cus = 0, per_cu = 0;
    (void)hipGetDevice(&dev);
    (void)hipDeviceGetAttribute(&cus, hipDeviceAttributeMultiprocessorCount, dev);
    (void)hipFuncSetAttribute((const void*)k_mega, hipFuncAttributeMaxDynamicSharedMemorySize, SMEM_BYTES);
    (void)hipOccupancyMaxActiveBlocksPerMultiprocessor(&per_cu, k_mega, NT, SMEM_BYTES);
    if (per_cu < 1) per_cu = 1;
    if (per_cu > 1) per_cu = 1;
    grid_blocks = cus * per_cu;
  }
  (void)hipMemsetAsync(p.xbar, 0, XCD_BAR_WORDS * 4, stream);
  void* args[] = {&p};
  hipError_t e = hipLaunchCooperativeKernel((void*)k_mega, dim3(grid_blocks), dim3(NT), args, SMEM_BYTES, stream);
  if (e != hipSuccess) fprintf(stderr, "cooperative launch failed: %s (grid %d)\n", hipGetErrorString(e), grid_blocks);
#endif
}
```

```cpp
#include <hip/hip_runtime.h>
#include <hip/hip_bf16.h>
#include <hip/hip_cooperative_groups.h>
#include <stdint.h>
#include <stdio.h>
namespace cg = cooperative_groups;

typedef unsigned short bf16_t;
#define DI __device__ __forceinline__

DI int mytid() { int t = threadIdx.x; asm volatile("" : "+v"(t)); return t; }
DI float bf2f(bf16_t v) { return __uint_as_float(((unsigned)v) << 16); }
DI bf16_t f2bf(float x) { unsigned u = __float_as_uint(x); u += 0x7fffu + ((u >> 16) & 1u); return (bf16_t)(u >> 16); }
DI float gelu_tanh(float x) { float u = 0.7978845608028654f * (x + 0.044715f * x * x * x); return 0.5f * x * (1.f + tanhf(u)); }
DI float siluf(float x) { return x / (1.f + __expf(-x)); }
DI float sigmoidf(float x) { return 1.f / (1.f + __expf(-x)); }

#define T_TOK 16384
#define SEQ 8192
#define DM 1024
#define NPROJ 3584
#define NEG_INF (-__builtin_inff())

struct Params {
  const float *x, *c, *w_ada, *b_ada, *g_mix, *w_in, *pe_k, *pe_v, *w_k1, *b_k1, *w_k2, *w_v1, *b_v1, *w_v2, *w_out, *g_ffn,
      *w_pq, *subkeys, *peer_down, *peer_up, *g_final;
  float* out;
  float* gout;
  float* mod;
  unsigned* ksmax;
  unsigned* xbar;
  float *c128, *s128, *c64, *s64;
  bf16_t *WinT, *WoutT, *WqT, *W1Tk, *W1Tv, *W2Tk, *W2Tv, *SUBK;
  float *B1Pk, *B1Pv;
  bf16_t* RA;
  bf16_t *RQ, *RK, *RKT, *RVT, *RGT, *NQ, *NKC, *NVC, *NKS, *NKW, *NVST, *NVWT;
  float* GATE;
  float* KV;
  bf16_t* SPREV;
  bf16_t *KC, *VCT;
  float* HID;
  bf16_t* PQ;
  int* EIDX;
  float* EW;
  unsigned char *PDN8, *PUP8;
  float *SDN, *SUP;
};

DI float logg_h(int h) { return log1pf(-exp2f(-5.f - (float)h)); }


typedef __bf16 bf16x2_t __attribute__((ext_vector_type(2)));
typedef float f32x2_t __attribute__((ext_vector_type(2)));
DI unsigned cvt2(float a, float b) { f32x2_t v = {a, b}; bf16x2_t r = __builtin_convertvector(v, bf16x2_t); return __builtin_bit_cast(unsigned, r); }
DI uint2 pack4(float a, float b, float c, float d) { uint2 r; r.x = cvt2(a, b); r.y = cvt2(c, d); return r; }
#define NT 512
#ifndef PROBE_DUP
#define PROBE_DUP -1
#endif
typedef short bf16x8 __attribute__((ext_vector_type(8)));
typedef float f32x16 __attribute__((ext_vector_type(16)));
#define MFMA32(a, b, c) __builtin_amdgcn_mfma_f32_32x32x16_bf16((a), (b), (c), 0, 0, 0)
DI f32x16 zero16() { f32x16 z; for (int e = 0; e < 16; ++e) z[e] = 0.f; return z; }
DI f32x16 fill16(float v) { f32x16 z; for (int e = 0; e < 16; ++e) z[e] = v; return z; }
DI float ex2(float x) { return __builtin_amdgcn_exp2f(x); }

DI int win_logical_col(int np) {
  int g = np >> 6, c = np & 63;
  if (g < 16) {
    int sec = g >> 3, hh = (g & 7) >> 1, j = g & 1, i = 32 * j + (c & 31);
    return sec * 512 + hh * 128 + ((c < 32) ? i : 64 + i);
  } else if (g < 52) return 1024 + (g - 16) * 64 + c;
  else if (g == 52) return (c < 24) ? 3328 + c : -1;
  return -1;
}

DI void tr_tile(const float* __restrict__ in, bf16_t* __restrict__ out, int K, int N_in, int k0, int n0, int mode, float* tile) {
  const int tid = mytid();
  {
    int nn = tid & 63, col = mode ? win_logical_col(n0 + nn) : (n0 + nn);
#pragma unroll
    for (int i = 0; i < 8; ++i) {
      int kk = (tid >> 6) + 8 * i;
      tile[kk * 65 + nn] = (col >= 0) ? in[(size_t)(k0 + kk) * N_in + col] : 0.f;
    }
  }
  __syncthreads();
  {
    int kk = tid & 63;
#pragma unroll
    for (int i = 0; i < 8; ++i) {
      int nn = (tid >> 6) + 8 * i;
      out[(size_t)(n0 + nn) * K + k0 + kk] = f2bf(tile[kk * 65 + nn]);
    }
  }
  __syncthreads();
}

#define PH0_MOD 96
#define PH0_WIN (PH0_MOD + 16 * 56)
#define PH0_WOUT (PH0_WIN + 256)
#define PH0_WQ (PH0_WOUT + 512)
#define PH0_W1K (PH0_WQ + 128)
#define PH0_W1V (PH0_W1K + 128)
#define PH0_W2K (PH0_W1V + 4)
#define PH0_W2V (PH0_W2K + 4)
#define PH0_SUBK (PH0_W2V + 512)
#define PH0_ROPE (PH0_SUBK + 1024)
#define PH0_B1P (PH0_ROPE + 8)
#define PH0_NVB PH0_B1P

DI void ph0_body(const Params& p, int vb, char* smem) {
  const int tid = mytid();
  float* fs = (float*)smem;
  if (vb < PH0_MOD) {
    int kg = tid >> 6, col = vb * 64 + (tid & 63);
    float a0 = 0.f, a1 = 0.f;
#pragma unroll 8
    for (int k = kg * 128; k < kg * 128 + 128; ++k) {
      float w = p.w_ada[(size_t)k * 6144 + col];
      a0 += siluf(p.c[k]) * w; a1 += siluf(p.c[DM + k]) * w;
    }
    fs[kg * 64 + (tid & 63)] = a0; fs[512 + kg * 64 + (tid & 63)] = a1;
    __syncthreads();
    if (tid < 128) {
      int b = tid >> 6, cc = tid & 63; float s = 0.f;
      for (int g = 0; g < 8; ++g) s += fs[b * 512 + g * 64 + cc];
      p.mod[b * 6144 + vb * 64 + cc] = s + p.b_ada[vb * 64 + cc];
    }
    __syncthreads();
    if (vb == 0 && tid < 12) p.ksmax[tid] = 0u;
  } else if (vb < PH0_WIN) { int t = vb - PH0_MOD; tr_tile(p.w_in, p.WinT, 1024, 3352, (t & 15) * 64, (t >> 4) * 64, 1, fs); }
  else if (vb < PH0_WOUT) { int t = vb - PH0_WIN; tr_tile(p.w_out, p.WoutT, 1024, 1024, (t & 15) * 64, (t >> 4) * 64, 0, fs); }
  else if (vb < PH0_WQ) { int t = vb - PH0_WOUT; tr_tile(p.w_pq, p.WqT, 1024, 2048, (t & 15) * 64, (t >> 4) * 64, 0, fs); }
  else if (vb < PH0_W1K) { int t = vb - PH0_WQ; tr_tile(p.w_k1, p.W1Tk, 2048, 256, (t & 31) * 64, (t >> 5) * 64, 0, fs); }
  else if (vb < PH0_W1V) { int t = vb - PH0_W1K; tr_tile(p.w_v1, p.W1Tv, 2048, 256, (t & 31) * 64, (t >> 5) * 64, 0, fs); }
  else if (vb < PH0_W2K) { int t = vb - PH0_W1V; tr_tile(p.w_k2, p.W2Tk, 256, 64, t * 64, 0, 0, fs); }
  else if (vb < PH0_W2V) { int t = vb - PH0_W2K; tr_tile(p.w_v2, p.W2Tv, 256, 64, t * 64, 0, 0, fs); }
  else if (vb < PH0_SUBK) { int i = (vb - PH0_W2V) * NT + tid; p.SUBK[i] = f2bf(p.subkeys[i]); }
  else if (vb < PH0_ROPE) {
    int idx = (vb - PH0_SUBK) * NT + tid;
    { int s = idx >> 6, i = idx & 63; float inv = powf(10000.f, -(float)(2 * i) / 128.f); float ang = (float)s * inv; p.c128[idx] = cosf(ang); p.s128[idx] = sinf(ang); }
    if (idx < SEQ * 32) { int s = idx >> 5, i = idx & 31; float inv = powf(10000.f, -(float)(2 * i) / 64.f); float ang = (float)s * inv; p.c64[idx] = cosf(ang); p.s64[idx] = sinf(ang); }
  } else {
    int t = vb - PH0_ROPE, kv = t >> 2, jb = t & 3;
    const float* w1 = kv ? p.w_v1 : p.w_k1; const float* pe = kv ? p.pe_v : p.pe_k; const float* b1 = kv ? p.b_v1 : p.b_k1;
    int fg = tid >> 6, j = jb * 64 + (tid & 63);
    float a = 0.f;
#pragma unroll 8
    for (int f = fg * 256; f < fg * 256 + 256; ++f) a += pe[f] * w1[(size_t)f * 256 + j];
    fs[fg * 64 + (tid & 63)] = a;
    __syncthreads();
    if (tid < 64) { float s = b1[j]; for (int g = 0; g < 8; ++g) s += fs[g * 64 + tid]; (kv ? p.B1Pv : p.B1Pk)[j] = s; }
    __syncthreads();
  }
}

DI void rownorm_body(const float* __restrict__ src, const float* __restrict__ g, const float* __restrict__ mod, int sh_off, int sc_off, bf16_t* __restrict__ dst, int vb) {
  int row = vb * 8 + (mytid() >> 6), lane = mytid() & 63;
  int b = row >> 13;
  const float* xr = src + (size_t)row * DM;
  float v[16]; float ss = 0.f;
#pragma unroll
  for (int i = 0; i < 4; ++i) {
    float4 t = *(const float4*)(xr + i * 256 + lane * 4);
    v[i * 4 + 0] = t.x; v[i * 4 + 1] = t.y; v[i * 4 + 2] = t.z; v[i * 4 + 3] = t.w;
    ss += t.x * t.x + t.y * t.y + t.z * t.z + t.w * t.w;
  }
  for (int o = 32; o; o >>= 1) ss += __shfl_xor(ss, o);
  float rstd = rsqrtf(ss * (1.f / DM) + 1e-6f);
  const float* sh = mod + b * 6144 + sh_off; const float* sc = mod + b * 6144 + sc_off;
#pragma unroll
  for (int i = 0; i < 4; ++i) {
    int col = i * 256 + lane * 4;
    float4 gg = *(const float4*)(g + col), s4 = *(const float4*)(sc + col), h4 = *(const float4*)(sh + col);
    float y0 = v[i * 4 + 0] * rstd * gg.x * (1.f + s4.x) + h4.x;
    float y1 = v[i * 4 + 1] * rstd * gg.y * (1.f + s4.y) + h4.y;
    float y2 = v[i * 4 + 2] * rstd * gg.z * (1.f + s4.z) + h4.z;
    float y3 = v[i * 4 + 3] * rstd * gg.w * (1.f + s4.w) + h4.w;
    *(uint2*)(dst + (size_t)row * DM + col) = pack4(y0, y1, y2, y3);
  }
}

#define G_A_BYTES (256 * 144)
#define G_B_BYTES (256 * 144)
#define G_BUF_BYTES (G_A_BYTES + G_B_BYTES)
template <class Epi>
DI void gemm_tile(const bf16_t* __restrict__ A, const bf16_t* __restrict__ Bt, int K, int m0, int n0, char* smem, const Epi& epi) {
  const int tid = mytid(), lane = tid & 63, w = tid >> 6, wm = w >> 2, wn = w & 3, r = lane & 31, h = lane >> 5;
  f32x16 acc[4][2];
#pragma unroll
  for (int i = 0; i < 4; ++i)
#pragma unroll
    for (int j = 0; j < 2; ++j) acc[i][j] = zero16();
  const int crow = tid >> 3, ckc = tid & 7;
  const bf16_t* ag = A + (size_t)(m0 + crow) * K + ckc * 8;
  const bf16_t* bg = Bt + (size_t)(n0 + crow) * K + ckc * 8;
  uint4 ra[4], rb[4];
#pragma unroll
  for (int i = 0; i < 4; ++i) { ra[i] = *(const uint4*)(ag + (size_t)i * 64 * K); rb[i] = *(const uint4*)(bg + (size_t)i * 64 * K); }
  char* lw = smem + crow * 144 + ckc * 16;
#pragma unroll
  for (int i = 0; i < 4; ++i) { *(uint4*)(lw + i * 64 * 144) = ra[i]; *(uint4*)(lw + G_A_BYTES + i * 64 * 144) = rb[i]; }
  __syncthreads();
  const int nk = K >> 6;
  for (int kt = 0; kt < nk; ++kt) {
    const int cur = kt & 1;
    if (kt + 1 < nk) {
      const int k0 = (kt + 1) * 64;
#pragma unroll
      for (int i = 0; i < 4; ++i) { ra[i] = *(const uint4*)(ag + (size_t)i * 64 * K + k0); rb[i] = *(const uint4*)(bg + (size_t)i * 64 * K + k0); }
    }
    const char* la = smem + cur * G_BUF_BYTES + (wm * 128 + r) * 144 + h * 16;
    const char* lb = smem + cur * G_BUF_BYTES + G_A_BYTES + (wn * 64 + r) * 144 + h * 16;
#pragma unroll
    for (int kk = 0; kk < 4; ++kk) {
      bf16x8 b0 = *(const bf16x8*)(lb + kk * 32), b1 = *(const bf16x8*)(lb + 32 * 144 + kk * 32);
#pragma unroll
      for (int i = 0; i < 4; ++i) {
        bf16x8 a = *(const bf16x8*)(la + i * 32 * 144 + kk * 32);
        acc[i][0] = MFMA32(a, b0, acc[i][0]); acc[i][1] = MFMA32(a, b1, acc[i][1]);
      }
    }
    if (kt + 1 < nk) {
      char* lw2 = lw + (cur ^ 1) * G_BUF_BYTES;
#pragma unroll
      for (int i = 0; i < 4; ++i) { *(uint4*)(lw2 + i * 64 * 144) = ra[i]; *(uint4*)(lw2 + G_A_BYTES + i * 64 * 144) = rb[i]; }
    }
    __syncthreads();
  }
  const int G = (n0 >> 6) + wn;
#pragma unroll
  for (int i = 0; i < 4; ++i) {
    float pre[4][8];
#pragma unroll
    for (int g = 0; g < 4; ++g) epi.prefetch(m0 + wm * 128 + i * 32 + 8 * g + 4 * h, G, r, pre[g]);
#pragma unroll
    for (int g = 0; g < 4; ++g) {
      float lo[4], hi[4];
#pragma unroll
      for (int e = 0; e < 4; ++e) { lo[e] = acc[i][0][4 * g + e]; hi[e] = acc[i][1][4 * g + e]; }
      epi(m0 + wm * 128 + i * 32 + 8 * g + 4 * h, G, r, lo, hi, pre[g]);
    }
  }
}

struct EpiProj {
  static constexpr bool kProbe = true;
  const Params& p;
  DI void prefetch(int t0, int G, int c, float (&pre)[8]) const {
    const int s0 = t0 & 8191;
    const bool r128 = G < 16, r64 = (G >= 32 && G < 40) || (G >= 40 && G < 52 && (((G - 40) >> 1) & 1) == 0);
    if (r128) {
      const int i = 32 * (G & 1) + c;
#pragma unroll
      for (int e = 0; e < 4; ++e) { pre[e] = p.c128[(s0 + e) * 64 + i]; pre[4 + e] = p.s128[(s0 + e) * 64 + i]; }
    } else if (r64) {
#pragma unroll
      for (int e = 0; e < 4; ++e) { pre[e] = p.c64[(s0 + e) * 32 + c]; pre[4 + e] = p.s64[(s0 + e) * 32 + c]; }
    } else {
#pragma unroll
      for (int e = 0; e < 8; ++e) pre[e] = 0.f;
    }
  }
  DI void operator()(int t0, int G, int c, const float (&lo)[4], const float (&hi)[4], const float (&pre)[8]) const {
    const int b = t0 >> 13, s0 = t0 & 8191;
    if (G < 16) {
      const int sec = G >> 3, hh = (G & 7) >> 1, j = G & 1, i = 32 * j + c;
      float o1[4], o2[4];
#pragma unroll
      for (int e = 0; e < 4; ++e) {
        float cs = pre[e], sn = pre[4 + e];
        o1[e] = lo[e] * cs - hi[e] * sn; o2[e] = hi[e] * cs + lo[e] * sn;
      }
      if (sec == 0) {
#pragma unroll
        for (int e = 0; e < 4; ++e) {
          p.RQ[(size_t)(t0 + e) * 512 + hh * 128 + i] = f2bf(o1[e]);
          p.RQ[(size_t)(t0 + e) * 512 + hh * 128 + 64 + i] = f2bf(o2[e]);
        }
      } else {
        const float sc = 0.08838834764831845f;
        const float lg = logg_h(hh);
#pragma unroll
        for (int e = 0; e < 4; ++e) {
          o1[e] *= sc; o2[e] *= sc;
          p.RK[(size_t)(t0 + e) * 512 + hh * 128 + i] = f2bf(o1[e]);
          p.RK[(size_t)(t0 + e) * 512 + hh * 128 + 64 + i] = f2bf(o2[e]);
          float zeta = __expf((float)(127 - ((s0 + e) & 127)) * lg);
          o1[e] *= zeta; o2[e] *= zeta;
        }
        *(uint2*)(p.RKT + ((size_t)(b * 4 + hh) * 128 + i) * SEQ + s0) = pack4(o1[0], o1[1], o1[2], o1[3]);
        *(uint2*)(p.RKT + ((size_t)(b * 4 + hh) * 128 + 64 + i) * SEQ + s0) = pack4(o2[0], o2[1], o2[2], o2[3]);
      }
    } else if (G < 24) {
      const int hh = (G - 16) >> 1, d = ((G - 16) & 1) * 64 + c;
      *(uint2*)(p.RVT + ((size_t)(b * 4 + hh) * 128 + d) * SEQ + s0) = pack4(lo[0], lo[1], lo[2], lo[3]);
      *(uint2*)(p.RVT + ((size_t)(b * 4 + hh) * 128 + d + 32) * SEQ + s0) = pack4(hi[0], hi[1], hi[2], hi[3]);
    } else if (G < 32) {
      const int hh = (G - 24) >> 1, d = ((G - 24) & 1) * 64 + c;
#pragma unroll
      for (int e = 0; e < 4; ++e) {
        p.RGT[(size_t)(t0 + e) * 512 + hh * 128 + d] = f2bf(siluf(lo[e]));
        p.RGT[(size_t)(t0 + e) * 512 + hh * 128 + d + 32] = f2bf(siluf(hi[e]));
      }
    } else if (G < 40) {
      const int head = G - 32;
#pragma unroll
      for (int e = 0; e < 4; ++e) {
        float cs = pre[e], sn = pre[4 + e];
        const float qs = 0.125f * 1.4426950408889634f;
        float o1 = (lo[e] * cs - hi[e] * sn) * qs, o2 = (hi[e] * cs + lo[e] * sn) * qs;
        p.NQ[(size_t)(t0 + e) * 512 + head * 64 + c] = f2bf(o1);
        p.NQ[(size_t)(t0 + e) * 512 + head * 64 + 32 + c] = f2bf(o2);
      }
    } else if (G < 52) {
      const int k = G - 40, kind = k >> 1, gg = k & 1;
      float o1[4], o2[4];
#pragma unroll
      for (int e = 0; e < 4; ++e) {
        o1[e] = lo[e]; o2[e] = hi[e];
        if ((kind & 1) == 0) {
          float cs = pre[e], sn = pre[4 + e];
          o1[e] = lo[e] * cs - hi[e] * sn; o2[e] = hi[e] * cs + lo[e] * sn;
        }
      }
      if (kind == 3 || kind == 5) {
        bf16_t* dst = (kind == 3 ? p.NVST : p.NVWT) + ((size_t)(b * 2 + gg) * 64 + c) * SEQ + s0;
        *(uint2*)dst = pack4(o1[0], o1[1], o1[2], o1[3]);
        *(uint2*)(dst + (size_t)32 * SEQ) = pack4(o2[0], o2[1], o2[2], o2[3]);
      } else {
        bf16_t* dst = (kind == 0 ? p.NKC : kind == 1 ? p.NVC : kind == 2 ? p.NKS : p.NKW);
#pragma unroll
        for (int e = 0; e < 4; ++e) {
          dst[(size_t)(t0 + e) * 128 + gg * 64 + c] = f2bf(o1[e]);
          dst[(size_t)(t0 + e) * 128 + gg * 64 + 32 + c] = f2bf(o2[e]);
        }
      }
    } else if (G == 52) {
      if (c < 24) {
#pragma unroll
        for (int e = 0; e < 4; ++e) p.GATE[(size_t)(t0 + e) * 24 + c] = sigmoidf(lo[e]);
      }
    }
  }
};
struct EpiOut {
  static constexpr bool kProbe = false;
  const Params& p;
  DI void prefetch(int t0, int G, int c, float (&pre)[8]) const {
    const int c0 = G * 64 + c;
#pragma unroll
    for (int e = 0; e < 4; ++e) { pre[e] = p.x[(size_t)(t0 + e) * DM + c0]; pre[4 + e] = p.x[(size_t)(t0 + e) * DM + c0 + 32]; }
  }
  DI void operator()(int t0, int G, int c, const float (&lo)[4], const float (&hi)[4], const float (&pre)[8]) const {
    const int b = t0 >> 13;
    const int c0 = G * 64 + c, c1 = c0 + 32;
    const float* ga1 = p.mod + b * 6144 + 2048;
    const float g0 = ga1[c0], g1 = ga1[c1];
#pragma unroll
    for (int e = 0; e < 4; ++e) {
      p.out[(size_t)(t0 + e) * DM + c0] = pre[e] + g0 * lo[e];
      p.out[(size_t)(t0 + e) * DM + c1] = pre[4 + e] + g1 * hi[e];
    }
  }
};
struct EpiPQ {
  static constexpr bool kProbe = false;
  const Params& p;
  DI void prefetch(int, int, int, float (&)[8]) const {}
  DI void operator()(int t0, int G, int c, const float (&lo)[4], const float (&hi)[4], const float (&)[8]) const {
#pragma unroll
    for (int e = 0; e < 4; ++e) {
      p.PQ[(size_t)(t0 + e) * 2048 + G * 64 + c] = f2bf(lo[e]);
      p.PQ[(size_t)(t0 + e) * 2048 + G * 64 + 32 + c] = f2bf(hi[e]);
    }
  }
};

DI int crow(int reg, int h) { return (reg & 3) + 8 * (reg >> 2) + 4 * h; }
DI bf16x8 ld16(const bf16_t* ptr) { return *(const bf16x8*)ptr; }
DI bf16x8 ld8x2(const bf16_t* ptr) {
  uint2 a = *(const uint2*)ptr, b = *(const uint2*)(ptr + 8);
  uint4 v; v.x = a.x; v.y = a.y; v.z = b.x; v.w = b.y;
  return __builtin_bit_cast(bf16x8, v);
}
DI bf16x8 pack8(float x0, float x1, float x2, float x3, float x4, float x5, float x6, float x7) {
  uint4 v; v.x = cvt2(x0, x1); v.y = cvt2(x2, x3); v.z = cvt2(x4, x5); v.w = cvt2(x6, x7);
  return __builtin_bit_cast(bf16x8, v);
}

DI void retkv_mfma(const Params& p, int item) {
  const int lane = mytid() & 63, w = mytid() >> 6, r = lane & 31, h = lane >> 5;
  const int hh = item & 3, c = (item >> 2) & 63, b = item >> 8, bh = b * 4 + hh, s0 = c * 128;
  const int mi = w >> 1, nb = (w & 1) * 2;
  const bf16_t* vb_ = p.RVT + ((size_t)(bh * 128 + 32 * mi + r)) * SEQ + s0 + 8 * h;
  const bf16_t* k0 = p.RKT + ((size_t)(bh * 128 + 32 * nb + r)) * SEQ + s0 + 8 * h;
  const bf16_t* k1 = k0 + (size_t)32 * SEQ;
  f32x16 a0 = zero16(), a1 = zero16();
#pragma unroll
  for (int s = 0; s < 8; ++s) {
    bf16x8 a = ld16(vb_ + 16 * s), b0 = ld16(k0 + 16 * s), b1 = ld16(k1 + 16 * s);
    a0 = MFMA32(a, b0, a0); a1 = MFMA32(a, b1, a1);
  }
  float* dst = p.KV + (size_t)item * 16384;
#pragma unroll
  for (int e = 0; e < 16; ++e) {
    const int v = 32 * mi + crow(e, h);
    dst[v * 128 + 32 * nb + r] = a0[e];
    dst[v * 128 + 32 * nb + 32 + r] = a1[e];
  }
}
DI void scan_body(const Params& p, int idx) {
  const int e = idx & 16383, bh = idx >> 14, b = bh >> 2, h = bh & 3;
  const float cd = __expf(128.f * logg_h(h));
  float S = 0.f;
  for (int c0 = 0; c0 < 64; c0 += 16) {
    float kv[16];
#pragma unroll
    for (int u = 0; u < 16; ++u) kv[u] = p.KV[(size_t)((b * 64 + c0 + u) * 4 + h) * 16384 + e];
#pragma unroll
    for (int u = 0; u < 16; ++u) {
      p.SPREV[(size_t)((b * 64 + c0 + u) * 4 + h) * 16384 + e] = f2bf(S);
      S = cd * S + kv[u];
    }
  }
}
DI void retout_mfma(const Params& p, int task) {
  const int lane = mytid() & 63, r = lane & 31, h = lane >> 5;
  const int item = task >> 2, nt = task & 3;
  const int hh = item & 3, c = (item >> 2) & 63, b = item >> 8, bh = b * 4 + hh, s0 = c * 128, t0 = b * SEQ + s0;
  const float lg = logg_h(hh);
  const int n = 32 * nt + r;
  bf16x8 qf[8];
#pragma unroll
  for (int s = 0; s < 8; ++s) qf[s] = ld16(p.RQ + (size_t)(t0 + n) * 512 + hh * 128 + 16 * s + 8 * h);
  f32x16 acc[4];
#pragma unroll
  for (int vi = 0; vi < 4; ++vi) {
    acc[vi] = zero16();
    const bf16_t* sp = p.SPREV + (size_t)item * 16384 + (size_t)(32 * vi + r) * 128 + 8 * h;
#pragma unroll
    for (int s = 0; s < 8; ++s) acc[vi] = MFMA32(ld16(sp + 16 * s), qf[s], acc[vi]);
    __builtin_amdgcn_sched_barrier(0);
  }
  {
    const float xi = __expf((float)(n + 1) * lg);
#pragma unroll
    for (int vi = 0; vi < 4; ++vi)
#pragma unroll
      for (int e = 0; e < 16; ++e) acc[vi][e] *= xi;
  }
  for (int mt = 0; mt <= nt; ++mt) {
    f32x16 sa = zero16();
    const bf16_t* kp = p.RK + (size_t)(t0 + 32 * mt + r) * 512 + hh * 128 + 8 * h;
#pragma unroll
    for (int s = 0; s < 8; ++s) sa = MFMA32(ld16(kp + 16 * s), qf[s], sa);
    float pv[16];
#pragma unroll
    for (int e = 0; e < 16; ++e) {
      const int dm = n - (32 * mt + crow(e, h));
      pv[e] = (dm >= 0) ? sa[e] * __expf((float)dm * lg) : 0.f;
    }
#pragma unroll
    for (int s2 = 0; s2 < 2; ++s2) {
      bf16x8 bfr = pack8(pv[8 * s2], pv[8 * s2 + 1], pv[8 * s2 + 2], pv[8 * s2 + 3], pv[8 * s2 + 4], pv[8 * s2 + 5], pv[8 * s2 + 6], pv[8 * s2 + 7]);
#pragma unroll
      for (int vi = 0; vi < 4; ++vi) {
        bf16x8 afr = ld8x2(p.RVT + ((size_t)(bh * 128 + 32 * vi + r)) * SEQ + s0 + 32 * mt + 16 * s2 + 4 * h);
        acc[vi] = MFMA32(afr, bfr, acc[vi]);
      }
      __builtin_amdgcn_sched_barrier(0);
    }
  }
  float sum = 0.f;
#pragma unroll
  for (int vi = 0; vi < 4; ++vi)
#pragma unroll
    for (int e = 0; e < 16; ++e) sum += acc[vi][e];
  sum += __shfl_xor(sum, 32);
  const float mu = sum * (1.f / 128.f);
  float var = 0.f;
#pragma unroll
  for (int vi = 0; vi < 4; ++vi)
#pragma unroll
    for (int e = 0; e < 16; ++e) { float d = acc[vi][e] - mu; var += d * d; }
  var += __shfl_xor(var, 32);
  const float rs = rsqrtf(var * (1.f / 128.f) + 1e-6f);
#pragma unroll
  for (int vi = 0; vi < 4; ++vi)
#pragma unroll
    for (int g4 = 0; g4 < 4; ++g4) {
      const int v0 = 32 * vi + 8 * g4 + 4 * h;
      uint2 gt = *(const uint2*)(p.RGT + (size_t)(t0 + n) * 512 + hh * 128 + v0);
      float y0 = (acc[vi][4 * g4 + 0] - mu) * rs * __uint_as_float(gt.x << 16);
      float y1 = (acc[vi][4 * g4 + 1] - mu) * rs * __uint_as_float(gt.x & 0xffff0000u);
      float y2 = (acc[vi][4 * g4 + 2] - mu) * rs * __uint_as_float(gt.y << 16);
      float y3 = (acc[vi][4 * g4 + 3] - mu) * rs * __uint_as_float(gt.y & 0xffff0000u);
      *(uint2*)(p.RA + (size_t)(t0 + n) * DM + hh * 128 + v0) = pack4(y0, y1, y2, y3);
    }
}
#define HID_STRIDE 264
DI void compress_mfma(const Params& p, int item, char* smem) {
  float* PART = (float*)smem;
  bf16_t* HIDL = (bf16_t*)(smem + 4 * 16 * 256 * 4);
  const int tid = mytid(), lane = tid & 63, w = tid >> 6, r = lane & 31, h = lane >> 5;
  const int kv = item >> 7, bg = (item >> 5) & 3, rt = item & 31, n0 = rt * 16, b = bg >> 1, g = bg & 1;
  const bf16_t* src = kv ? p.NVC : p.NKC; const bf16_t* W1 = kv ? p.W1Tv : p.W1Tk; const bf16_t* W2 = kv ? p.W2Tv : p.W2Tk;
  const float* B1 = kv ? p.B1Pv : p.B1Pk;
  {
    const int kq = w >> 1, ch = w & 1;
    const int n = min(n0 + (r & 15), 510);
    const bf16_t* ab = src + ((size_t)(b * SEQ + 16 * n)) * 128 + g * 64 + 8 * h;
    const bf16_t* bb = W1 + (size_t)(128 * ch + r) * 2048 + 8 * h;
    f32x16 acc[4];
#pragma unroll
    for (int ct = 0; ct < 4; ++ct) acc[ct] = zero16();
#pragma unroll 4
    for (int s = 32 * kq; s < 32 * kq + 32; ++s) {
      const bf16x8 a = ld16(ab + (s >> 2) * 128 + (s & 3) * 16);
#pragma unroll
      for (int ct = 0; ct < 4; ++ct) acc[ct] = MFMA32(a, ld16(bb + (size_t)ct * 32 * 2048 + 16 * s), acc[ct]);
    }
#pragma unroll
    for (int ct = 0; ct < 4; ++ct)
#pragma unroll
      for (int e = 0; e < 8; ++e) PART[(kq * 16 + crow(e, h)) * 256 + 128 * ch + 32 * ct + r] = acc[ct][e];
  }
  __syncthreads();
#pragma unroll
  for (int i = 0; i < 8; ++i) {
    const int idx = tid + 512 * i, row = idx >> 8, col = idx & 255;
    const float v = PART[row * 256 + col] + PART[(16 + row) * 256 + col] + PART[(32 + row) * 256 + col] + PART[(48 + row) * 256 + col] + B1[col];
    HIDL[row * HID_STRIDE + col] = f2bf(gelu_tanh(v));
  }
  __syncthreads();
  if (w < 2) {
    f32x16 acc = zero16();
#pragma unroll
    for (int s = 0; s < 16; ++s) acc = MFMA32(ld16(HIDL + (r & 15) * HID_STRIDE + 16 * s + 8 * h), ld16(W2 + (size_t)(32 * w + r) * 256 + 16 * s + 8 * h), acc);
    const int e_ = 32 * w + r;
    if (kv == 0) {
#pragma unroll
      for (int e = 0; e < 8; ++e) { const int n = n0 + crow(e, h); p.KC[((size_t)bg * 512 + n) * 64 + e_] = (n < 511) ? f2bf(acc[e]) : (bf16_t)0; }
    } else {
#pragma unroll
      for (int g4 = 0; g4 < 2; ++g4) {
        const int n = n0 + 8 * g4 + 4 * h;
        float v3 = (n + 3 < 511) ? acc[4 * g4 + 3] : 0.f;
        *(uint2*)(p.VCT + ((size_t)bg * 64 + e_) * 512 + n) = pack4(acc[4 * g4], acc[4 * g4 + 1], acc[4 * g4 + 2], v3);
      }
    }
  }
  __syncthreads();
}
DI void kmax_body2(const Params& p, int vb) {
  const int tid = mytid(), g = tid & 1, t = vb * 256 + (tid >> 1), b = t >> 13;
  const bf16_t* k = p.NKS + (size_t)t * 128 + g * 64; const bf16_t* kw = p.NKW + (size_t)t * 128 + g * 64;
  float ss = 0.f, sw = 0.f;
  for (int d = 0; d < 64; d += 8) {
    uint4 a = *(const uint4*)(k + d), c = *(const uint4*)(kw + d);
    const unsigned aa[4] = {a.x, a.y, a.z, a.w}, cc[4] = {c.x, c.y, c.z, c.w};
#pragma unroll
    for (int q = 0; q < 4; ++q) {
      float x0 = __uint_as_float(aa[q] << 16), x1 = __uint_as_float(aa[q] & 0xffff0000u);
      float y0 = __uint_as_float(cc[q] << 16), y1 = __uint_as_float(cc[q] & 0xffff0000u);
      ss += x0 * x0 + x1 * x1; sw += y0 * y0 + y1 * y1;
    }
  }
  float m1 = sqrtf(ss), m2 = sqrtf(sw);
  for (int o = 2; o < 64; o <<= 1) { m1 = fmaxf(m1, __shfl_xor(m1, o)); m2 = fmaxf(m2, __shfl_xor(m2, o)); }
  if ((tid & 63) < 2) { atomicMax(&p.ksmax[b * 2 + g], __float_as_uint(m1)); atomicMax(&p.ksmax[4 + b * 2 + g], __float_as_uint(m2)); }
}
DI void kcmax_body(const Params& p, int idx) {
  const bf16_t* k = p.KC + (size_t)idx * 64;
  float ss = 0.f;
  for (int d = 0; d < 64; ++d) { float v = bf2f(k[d]); ss += v * v; }
  atomicMax(&p.ksmax[8 + (idx >> 9)], __float_as_uint(sqrtf(ss)));
}

#define NSA_IMP 0
#define NSA_SELM 65536
#define NSA_KV 66816
#define KV_ROW 144
#define KV_TILE (64 * KV_ROW)
template <int CTRL> DI float dpp_f2(float x) { return __builtin_bit_cast(float, __builtin_amdgcn_mov_dpp(__builtin_bit_cast(int, x), CTRL, 0xf, 0xf, true)); }
DI float quad_sum(float v) { v += dpp_f2<0xB1>(v); v += dpp_f2<0x4E>(v); return v; }
DI bf16x8 lds8x2(const char* ptr) {
  uint2 a = *(const uint2*)ptr, b = *(const uint2*)(ptr + 16);
  uint4 v; v.x = a.x; v.y = a.y; v.z = b.x; v.w = b.y;
  return __builtin_bit_cast(bf16x8, v);
}

DI void nsa_item(const Params& p, int item, char* smem) {
  const int tid = mytid(), lane = tid & 63, w = tid >> 6, r = lane & 31, h = lane >> 5;
  const int ti = item >> 2, bg = item & 3, b = bg >> 1, g = bg & 1;
  const int ts = ti * 64, tokg0 = b * SEQ + ts;
  const int tkl = 8 * w + (r >> 2), hl = r & 3, hd = g * 4 + hl, tpos = ts + tkl;
  float* IMPA = (float*)(smem + NSA_IMP); float* IMPB = IMPA + 64 * 128;
  unsigned* SELM = (unsigned*)(smem + NSA_SELM);
  char* KVB = smem + NSA_KV;
  const float ksm = __uint_as_float(p.ksmax[bg]), kwm = __uint_as_float(p.ksmax[4 + bg]), kcm = __uint_as_float(p.ksmax[8 + bg]);

  bf16x8 qf[4];
#pragma unroll
  for (int s = 0; s < 4; ++s) qf[s] = ld16(p.NQ + (size_t)(tokg0 + tkl) * 512 + hd * 64 + 16 * s + 8 * h);
  float qq = 0.f;
#pragma unroll
  for (int s = 0; s < 4; ++s) {
    uint4 u = __builtin_bit_cast(uint4, qf[s]);
    const unsigned uu[4] = {u.x, u.y, u.z, u.w};
#pragma unroll
    for (int q = 0; q < 4; ++q) { float x0 = __uint_as_float(uu[q] << 16), x1 = __uint_as_float(uu[q] & 0xffff0000u); qq += x0 * x0 + x1 * x1; }
  }
  qq += __shfl_xor(qq, 32);
  const float qn = sqrtf(qq);
  const int srow = tid >> 3, sch = tid & 7;
  const bf16_t* ksrc = p.NKS + ((size_t)(b * SEQ) + srow) * 128 + g * 64 + sch * 8;
  const bf16_t* vsrc = p.NVST + ((size_t)bg * 64 + srow) * SEQ + sch * 8;
  char* sdst = KVB + srow * KV_ROW + sch * 16;
  {
    uint4 k0 = *(const uint4*)ksrc, v0 = *(const uint4*)vsrc;
    *(uint4*)sdst = k0; *(uint4*)(sdst + KV_TILE) = v0;
  }
  for (int q = tid; q < 64 * 128 * 2 / 4; q += NT) ((float4*)IMPA)[q] = make_float4(0.f, 0.f, 0.f, 0.f);
  __syncthreads();

  const float mbc = qn * kcm;
  int nvalid = (tpos >= 31) ? ((tpos - 31) >> 4) + 1 : 0;
  if (nvalid > 511) nvalid = 511;
  int nvw = (ts + 8 * w + 7 >= 31) ? ((ts + 8 * w + 7 - 31) >> 4) + 1 : 0;
  if (nvw > 511) nvw = 511;
  const int nkt = (nvw + 31) >> 5;
  int nvmin = (ts + 8 * w >= 31) ? ((ts + 8 * w - 31) >> 4) + 1 : 0;
  if (nvmin > 511) nvmin = 511;
  const bf16_t* kcb = p.KC + ((size_t)bg * 512 + r) * 64 + 8 * h;
  float lsum = 0.f, invl = 0.f;
  for (int rep521 = 0; rep521 < (PROBE_DUP == 521 ? 2 : 1); ++rep521) {
  lsum = 0.f;
  for (int kt = 0; kt < nkt; ++kt) {
    f32x16 sa = fill16(-mbc);
#pragma unroll
    for (int s = 0; s < 4; ++s) sa = MFMA32(ld16(kcb + (size_t)kt * 32 * 64 + 16 * s), qf[s], sa);
    if (32 * kt + 32 <= nvmin) {
#pragma unroll
      for (int e = 0; e < 16; ++e) lsum += ex2(sa[e]);
    } else {
#pragma unroll
      for (int e = 0; e < 16; ++e) { const int n = 32 * kt + crow(e, h); lsum += (n < nvalid) ? ex2(sa[e]) : 0.f; }
    }
  }
  lsum += __shfl_xor(lsum, 32);
  invl = (lsum > 0.f) ? 1.f / lsum : 0.f;
  for (int kt = 0; kt < nkt; ++kt) {
    f32x16 sa = fill16(-mbc);
#pragma unroll
    for (int s = 0; s < 4; ++s) sa = MFMA32(ld16(kcb + (size_t)kt * 32 * 64 + 16 * s), qf[s], sa);
    float pv[16];
    if (32 * kt + 32 <= nvmin) {
#pragma unroll
      for (int e = 0; e < 16; ++e) pv[e] = ex2(sa[e]) * invl;
    } else {
#pragma unroll
      for (int e = 0; e < 16; ++e) { const int n = 32 * kt + crow(e, h); pv[e] = (n < nvalid) ? ex2(sa[e]) * invl : 0.f; }
    }
#pragma unroll
    for (int q = 0; q < 4; ++q) {
      float A = 2.f * (pv[4 * q] + pv[4 * q + 1] + pv[4 * q + 2]) + pv[4 * q + 3], Bv = pv[4 * q + 3];
      A = quad_sum(A); Bv = quad_sum(Bv);
      if (hl == 0) { const int j = 8 * kt + 2 * q + h; IMPA[tkl * 128 + j] = A; IMPB[tkl * 128 + j] = Bv; }
    }
  }
  }
  for (int rep522 = 0; rep522 < (PROBE_DUP == 522 ? 2 : 1); ++rep522)
  {
    const int tl = 8 * w + (lane >> 3), sub = lane & 7;
    unsigned kv_[16], ki_[16];
#pragma unroll
    for (int c = 0; c < 16; ++c) {
      const int j = sub + 8 * c;
      float imp = IMPA[tl * 128 + j] + ((j > 0) ? IMPB[tl * 128 + j - 1] : 0.f);
      if (j == 0 || j == ti || j == ti - 1) imp = 1e9f;
      kv_[c] = (j <= ti) ? __float_as_uint(imp) : 0u;
      ki_[c] = (j <= ti) ? (unsigned)(128 - j) : 0u;
    }
    unsigned m0 = 0, m1 = 0, m2 = 0, m3 = 0;
    for (int it = 0; it < 16; ++it) {
      unsigned bv = kv_[0], bi = ki_[0];
#pragma unroll
      for (int c = 1; c < 16; ++c) { const bool gt = (kv_[c] > bv) || (kv_[c] == bv && ki_[c] > bi); bv = gt ? kv_[c] : bv; bi = gt ? ki_[c] : bi; }
#define TOPK_STEP(CTRL) { const unsigned ov = (unsigned)__builtin_amdgcn_mov_dpp((int)bv, CTRL, 0xf, 0xf, true), oi = (unsigned)__builtin_amdgcn_mov_dpp((int)bi, CTRL, 0xf, 0xf, true); \
        const bool gt = (ov > bv) || (ov == bv && oi > bi); bv = gt ? ov : bv; bi = gt ? oi : bi; }
      TOPK_STEP(0xB1) TOPK_STEP(0x4E) TOPK_STEP(0x141)
#undef TOPK_STEP
      if (bi != 0u) {
        const int js = 128 - (int)bi;
        const unsigned bit = 1u << (js & 31);
        if ((js >> 5) == 0) m0 |= bit; else if ((js >> 5) == 1) m1 |= bit; else if ((js >> 5) == 2) m2 |= bit; else m3 |= bit;
#pragma unroll
        for (int c = 0; c < 16; ++c) { const bool hit = (ki_[c] == bi); kv_[c] = hit ? 0u : kv_[c]; ki_[c] = hit ? 0u : ki_[c]; }
      }
    }
    if (sub == 0) { SELM[tl * 4 + 0] = m0; SELM[tl * 4 + 1] = m1; SELM[tl * 4 + 2] = m2; SELM[tl * 4 + 3] = m3; }
  }
  if (lane < 4) {
    unsigned u = 0;
#pragma unroll
    for (int t8 = 0; t8 < 8; ++t8) u |= SELM[(8 * w + t8) * 4 + lane];
    SELM[(64 + w) * 4 + lane] = u;
  }
  const float mbs = qn * ksm;
  f32x16 osl[2]; osl[0] = zero16(); osl[1] = zero16();
  float lsel = 0.f;
#define RING_RUN(KS, KSTEP, VS, VSTEP, NTILES, NEED, COMPUTE)                                                                               \
  {                                                                                                                                         \
      \
      \
    for (int jj = 0; jj < (NTILES); ++jj) {                                                                                                 \
      uint4 ka_, va_;                                                                                                                       \
      ka_ = va_ = make_uint4(0u, 0u, 0u, 0u);                                                                                               \
      if (jj + 1 < (NTILES)) { ka_ = *(const uint4*)((KS) + (size_t)(jj + 1) * (KSTEP)); va_ = *(const uint4*)((VS) + (size_t)(jj + 1) * (VSTEP)); } \
      if (NEED(jj)) { const char* kb = KVB + (jj & 1) * 2 * KV_TILE; const char* vbuf = kb + KV_TILE; COMPUTE(jj, kb, vbuf) }               \
      if (jj + 1 < (NTILES)) { char* d2 = sdst + ((jj + 1) & 1) * 2 * KV_TILE; *(uint4*)d2 = ka_; *(uint4*)(d2 + KV_TILE) = va_; }          \
      __syncthreads();                                                                                                                      \
    }                                                                                                                                       \
  }
#define STAGE_PAIR0(KS, KSTEP, VS, VSTEP, NTILES) { uint4 k0_ = *(const uint4*)(KS), v0_ = *(const uint4*)(VS); *(uint4*)sdst = k0_; *(uint4*)(sdst + KV_TILE) = v0_; }
#define ATT_TILE(kb, vbuf, INIT, FULL, MASKEXPR, SCALE, ACC, LACC)                                                                          \
          {                                                                                                                                 \
            bf16x8 kf_[2][4], vf_[2][2][2];       \
            _Pragma("unroll") for (int kh = 0; kh < 2; ++kh)                                                                                \
              _Pragma("unroll") for (int s = 0; s < 4; ++s) kf_[kh][s] = *(const bf16x8*)(kb + (32 * kh + r) * KV_ROW + (16 * s + 8 * h) * 2); \
            _Pragma("unroll") for (int kh = 0; kh < 2; ++kh)                                                                                \
              _Pragma("unroll") for (int di = 0; di < 2; ++di)                                                                              \
                _Pragma("unroll") for (int s2 = 0; s2 < 2; ++s2) vf_[kh][di][s2] = lds8x2(vbuf + (32 * di + r) * KV_ROW + (32 * kh + 16 * s2 + 4 * h) * 2); \
            const bool full_ = (FULL);                                                                                                      \
            _Pragma("unroll") for (int kh = 0; kh < 2; ++kh) {                                                                              \
              f32x16 sa = fill16(INIT);                                                                                                     \
              _Pragma("unroll") for (int s = 0; s < 4; ++s) sa = MFMA32(kf_[kh][s], qf[s], sa);                                             \
              float pv[16];                                                                                                                 \
              _Pragma("unroll") for (int e = 0; e < 16; ++e) { const int key = 32 * kh + crow(e, h); pv[e] = (full_ || (MASKEXPR)) ? ex2(sa[e]) * (SCALE) : 0.f; } \
              LACC += ((pv[0] + pv[1]) + (pv[2] + pv[3])) + ((pv[4] + pv[5]) + (pv[6] + pv[7])) + ((pv[8] + pv[9]) + (pv[10] + pv[11])) + ((pv[12] + pv[13]) + (pv[14] + pv[15])); \
              const bf16x8 pk0 = pack8(pv[0], pv[1], pv[2], pv[3], pv[4], pv[5], pv[6], pv[7]);                                             \
              const bf16x8 pk1 = pack8(pv[8], pv[9], pv[10], pv[11], pv[12], pv[13], pv[14], pv[15]);                                       \
              _Pragma("unroll") for (int di = 0; di < 2; ++di) {                                                                            \
                ACC[di] = MFMA32(vf_[kh][di][0], pk0, ACC[di]);                                                                             \
                ACC[di] = MFMA32(vf_[kh][di][1], pk1, ACC[di]);                                                                             \
              }                                                                                                                             \
            }                                                                                                                               \
          }
#define SEL_NEED(jj) ((SELM[(64 + w) * 4 + ((jj) >> 5)] >> ((jj) & 31)) & 1u)
#define SEL_COMPUTE(jj, kb, vbuf) { const unsigned msel_ = SELM[tkl * 4 + ((jj) >> 5)]; \
      const float init_ = ((msel_ >> ((jj) & 31)) & 1u) ? -mbs : NEG_INF; ATT_TILE(kb, vbuf, init_, (jj) < ti, key <= tkl, 1.f, osl, lsel) }
  RING_RUN(ksrc, 64 * 128, vsrc, 64, ti + 1, SEL_NEED, SEL_COMPUTE)
  if (PROBE_DUP == 523) { STAGE_PAIR0(ksrc, 64 * 128, vsrc, 64, ti + 1) __syncthreads(); RING_RUN(ksrc, 64 * 128, vsrc, 64, ti + 1, SEL_NEED, SEL_COMPUTE) }
  lsel += __shfl_xor(lsel, 32);
  const float* gt = p.GATE + (size_t)(tokg0 + tkl) * 24 + hd * 3;
  f32x16 outacc[2];
  {
    const float g1 = gt[1] / lsel;
#pragma unroll
    for (int e = 0; e < 16; ++e) { outacc[0][e] = g1 * osl[0][e]; outacc[1][e] = g1 * osl[1][e]; }
  }
  {
  f32x16 oc[2]; oc[0] = zero16(); oc[1] = zero16();
  {
    int nvall = (ts + 63 >= 31) ? ((ts + 63 - 31) >> 4) + 1 : 0;
    if (nvall > 511) nvall = 511;
    const int nct = (nvall + 63) >> 6;
    if (nct > 0) {
      const bf16_t* kcs = p.KC + ((size_t)bg * 512 + srow) * 64 + sch * 8;
      const bf16_t* vcs = p.VCT + ((size_t)bg * 64 + srow) * 512 + sch * 8;
      float ldummy = 0.f;
      STAGE_PAIR0(kcs, 64 * 64, vcs, 64, nct) __syncthreads();
#define CMP_NEED(jj) (64 * (jj) < nvw)
#define CMP_COMPUTE(jj, kb, vbuf) ATT_TILE(kb, vbuf, -mbc, 64 * (jj) + 64 <= nvmin, 64 * (jj) + key < nvalid, invl, oc, ldummy)
      RING_RUN(kcs, 64 * 64, vcs, 64, nct, CMP_NEED, CMP_COMPUTE)
    }
  }
  {
    const float g0 = gt[0];
#pragma unroll
    for (int e = 0; e < 16; ++e) { outacc[0][e] += g0 * oc[0][e]; outacc[1][e] += g0 * oc[1][e]; }
  }
  }
  f32x16 ow[2]; ow[0] = zero16(); ow[1] = zero16();
  float lw = 0.f;
  const float mbw = qn * kwm;
  {
    const int j0w = (ti >= 8) ? ti - 8 : 0, nwt = ti - j0w + 1;
    const bf16_t* kws = p.NKW + ((size_t)(b * SEQ + 64 * j0w) + srow) * 128 + g * 64 + sch * 8;
    const bf16_t* vws = p.NVWT + ((size_t)bg * 64 + srow) * SEQ + 64 * j0w + sch * 8;
    STAGE_PAIR0(kws, 64 * 128, vws, 64, nwt) __syncthreads();
#define WIN_NEED(jj) true
#define WIN_COMPUTE(jj, kb, vbuf) { const int jw_ = j0w + (jj); const bool last_ = (jw_ == ti), first_ = (ti >= 8) && ((jj) == 0); \
      ATT_TILE(kb, vbuf, -mbw, !(last_ || first_), last_ ? (key <= tkl) : (key > tkl), 1.f, ow, lw) }
    RING_RUN(kws, 64 * 128, vws, 64, nwt, WIN_NEED, WIN_COMPUTE)
    if (PROBE_DUP == 525) { STAGE_PAIR0(kws, 64 * 128, vws, 64, nwt) __syncthreads(); RING_RUN(kws, 64 * 128, vws, 64, nwt, WIN_NEED, WIN_COMPUTE) }
  }
  lw += __shfl_xor(lw, 32);
  {
    const float g2 = gt[2] / lw;
#pragma unroll
    for (int di = 0; di < 2; ++di)
#pragma unroll
      for (int g4 = 0; g4 < 4; ++g4) {
        const int d0 = 32 * di + 8 * g4 + 4 * h;
        float y[4];
#pragma unroll
        for (int e = 0; e < 4; ++e) y[e] = outacc[di][4 * g4 + e] + g2 * ow[di][4 * g4 + e];
        *(uint2*)(p.RA + (size_t)(tokg0 + tkl) * DM + 512 + hd * 64 + d0) = pack4(y[0], y[1], y[2], y[3]);
      }
  }
}

typedef float f32x4 __attribute__((ext_vector_type(4)));
#define MFMA16(a, b, c) __builtin_amdgcn_mfma_f32_16x16x32_bf16((a), (b), (c), 0, 0, 0)
constexpr int pk_clen(int i) { return 16 / (i + 1); }
constexpr int pk_coff(int i) { int s = 0; for (int q = 0; q < i; ++q) s += pk_clen(q); return s; }
constexpr int pk_cand(int c) {
  int i = 0; while (i < 16 && c >= pk_clen(i)) { c -= pk_clen(i); ++i; }
  return (i < 16) ? i * 16 + c : 256;
}
#define SC_STRIDE 132

DI void convert_row(const Params& p, int row, int lane);
DI void peer_topk_tile(const Params& p, int vb, char* smem) {
  float* SC = (float*)smem;
  unsigned* ELK = (unsigned*)(smem + 256 * SC_STRIDE * 4);
  float* ELW = (float*)(ELK + 16 * 128);
  const int tid = mytid(), lane = tid & 63, w = tid >> 6;
  const int t0 = vb * 16;
  for (int rep91 = 0; rep91 < (PROBE_DUP == 91 ? 2 : 1); ++rep91) {
    const int tq = lane & 15, kq = lane >> 4;
#pragma unroll
    for (int pi = 0; pi < 2; ++pi) {
      const int ph = 2 * w + pi;
      bf16x8 bfr[4];
#pragma unroll
      for (int s = 0; s < 4; ++s) bfr[s] = *(const bf16x8*)(p.PQ + (size_t)(t0 + tq) * 2048 + ph * 128 + 32 * s + 8 * kq);
#pragma unroll
      for (int j = 0; j < 8; ++j) {
        f32x4 acc = {0.f, 0.f, 0.f, 0.f};
#pragma unroll
        for (int s = 0; s < 4; ++s) {
          bf16x8 afr = *(const bf16x8*)(p.SUBK + ((size_t)(ph * 128 + 16 * j + tq)) * 128 + 32 * s + 8 * kq);
          acc = MFMA16(afr, bfr[s], acc);
        }
        *(f32x4*)(SC + (ph * 16 + tq) * SC_STRIDE + 16 * j + 4 * kq) = acc;
      }
    }
  }
  __syncthreads();
  if (tid < 256) {
    float* row = SC + tid * SC_STRIDE;
    float gmax[16];
#pragma unroll
    for (int g = 0; g < 16; ++g) {
      float4 a = *(float4*)(row + g * 8), b = *(float4*)(row + g * 8 + 4);
      gmax[g] = fmaxf(fmaxf(fmaxf(a.x, a.y), fmaxf(a.z, a.w)), fmaxf(fmaxf(b.x, b.y), fmaxf(b.z, b.w)));
    }
    float outv[16]; int outi[16];
#pragma unroll
    for (int k = 0; k < 16; ++k) {
      float gm = gmax[0]; int gi = 0;
#pragma unroll
      for (int g = 1; g < 16; ++g) { bool c = gmax[g] > gm; gm = c ? gmax[g] : gm; gi = c ? g : gi; }
      float* gp = row + gi * 8;
      float4 a = *(float4*)gp, b = *(float4*)(gp + 4);
      float v[8] = {a.x, a.y, a.z, a.w, b.x, b.y, b.z, b.w};
      int ei = 7;
#pragma unroll
      for (int e = 6; e >= 0; --e) ei = (v[e] == gm) ? e : ei;
      float nm = NEG_INF;
#pragma unroll
      for (int e = 0; e < 8; ++e) { float x = (e == ei) ? NEG_INF : v[e]; nm = fmaxf(nm, x); }
      gp[ei] = NEG_INF;
#pragma unroll
      for (int g = 0; g < 16; ++g) gmax[g] = (g == gi) ? nm : gmax[g];
      outv[k] = gm; outi[k] = gi * 8 + ei;
    }
#pragma unroll
    for (int k = 0; k < 16; ++k) { row[k] = outv[k]; row[16 + k] = __int_as_float(outi[k]); }
  } else {
#pragma unroll 1
    for (int i = 0; i < 8; ++i) convert_row(p, (vb * 4 + (w - 4)) * 8 + i, lane);
  }
  __syncthreads();
  for (int rep93 = 0; rep93 < (PROBE_DUP == 93 ? 2 : 1); ++rep93) {
    const int q = tid >> 2, sub = tid & 3, t = q >> 3, pp = q & 7;
    const float* ra = SC + ((2 * pp) * 16 + t) * SC_STRIDE;
    const float* rb = SC + ((2 * pp + 1) * 16 + t) * SC_STRIDE;
    float sv[13]; int sj[13];
#pragma unroll
    for (int k = 0; k < 13; ++k) {
      const int ij = (sub == 0) ? pk_cand(4 * k) : (sub == 1) ? pk_cand(4 * k + 1) : (sub == 2) ? pk_cand(4 * k + 2) : pk_cand(4 * k + 3);
      sj[k] = ij;
      sv[k] = (ij < 256) ? ra[ij >> 4] + rb[ij & 15] : NEG_INF;
    }
    float v16[16]; int j16[16];
#pragma unroll
    for (int k = 0; k < 16; ++k) {
      float bv = sv[0]; int bj = sj[0];
#pragma unroll
      for (int c = 1; c < 13; ++c) { const bool gt = (sv[c] > bv) || (sv[c] == bv && sj[c] < bj); bv = gt ? sv[c] : bv; bj = gt ? sj[c] : bj; }
#define PK_STEP(CTRL) { const float ov = __builtin_bit_cast(float, __builtin_amdgcn_mov_dpp(__builtin_bit_cast(int, bv), CTRL, 0xf, 0xf, true)); \
        const int oj = __builtin_amdgcn_mov_dpp(bj, CTRL, 0xf, 0xf, true); const bool gt = (ov > bv) || (ov == bv && oj < bj); bv = gt ? ov : bv; bj = gt ? oj : bj; }
      PK_STEP(0xB1) PK_STEP(0x4E)
#undef PK_STEP
#pragma unroll
      for (int c = 0; c < 13; ++c) sv[c] = (sj[c] == bj) ? NEG_INF : sv[c];
      v16[k] = bv; j16[k] = bj;
    }
    float l = 0.f; const float vmax = v16[0];
#pragma unroll
    for (int k = 0; k < 16; ++k) { v16[k] = __expf(v16[k] - vmax); l += v16[k]; }
    const float inv = 1.f / l;
#pragma unroll
    for (int k = 0; k < 16; ++k)
      if ((k & 3) == sub) {
        const int code = __float_as_int(ra[16 + (j16[k] >> 4)]) * 128 + __float_as_int(rb[16 + (j16[k] & 15)]);
        ELK[t * 128 + pp * 16 + k] = ((unsigned)code << 7) | (unsigned)(pp * 16 + k);
        ELW[t * 128 + pp * 16 + k] = v16[k] * inv;
      }
  }
  __syncthreads();
  for (int rep94 = 0; rep94 < (PROBE_DUP == 94 ? 2 : 1); ++rep94)
#pragma unroll
  for (int tt = 0; tt < 2; ++tt) {
    const int t = 2 * w + tt;
    const unsigned e0 = ELK[t * 128 + 2 * lane], e1 = ELK[t * 128 + 2 * lane + 1];
    int r0 = 0, r1 = 0;
#pragma unroll 8
    for (int c = 0; c < 32; ++c) {
      const uint4 kq = *(const uint4*)(ELK + t * 128 + 4 * c);
      r0 += (kq.x < e0) + (kq.y < e0) + (kq.z < e0) + (kq.w < e0);
      r1 += (kq.x < e1) + (kq.y < e1) + (kq.z < e1) + (kq.w < e1);
    }
    const size_t gb = (size_t)(t0 + t) * 128;
    p.EIDX[gb + r0] = (int)(e0 >> 7); p.EIDX[gb + r1] = (int)(e1 >> 7);
    p.EW[gb + r0] = ELW[t * 128 + (e0 & 127)]; p.EW[gb + r1] = ELW[t * 128 + (e1 & 127)];
  }
  __syncthreads();
}

DI float dot2bf(unsigned a, unsigned b, float acc) { return __builtin_amdgcn_fdot2_f32_bf16(__builtin_bit_cast(bf16x2_t, a), __builtin_bit_cast(bf16x2_t, b), acc, false); }
template <int CTRL> DI float dpp_f(float x) { return __builtin_bit_cast(float, __builtin_amdgcn_mov_dpp(__builtin_bit_cast(int, x), CTRL, 0xf, 0xf, true)); }
DI float row16_sum(float v) { v += dpp_f<0x128>(v); v += dpp_f<0x124>(v); v += dpp_f<0x122>(v); v += dpp_f<0x121>(v); return v; }
DI float dot_row(const uint4 (&u)[8], const uint4 (&h)[8]) {
  float d = 0.f;
#pragma unroll
  for (int j = 0; j < 8; ++j) { d = dot2bf(u[j].x, h[j].x, d); d = dot2bf(u[j].y, h[j].y, d); d = dot2bf(u[j].z, h[j].z, d); d = dot2bf(u[j].w, h[j].w, d); }
  return row16_sum(d);
}
DI void axpy_row(float (&acc)[64], const uint4 (&v)[8], float c) {
#pragma unroll
  for (int j = 0; j < 8; ++j) {
    const unsigned ww[4] = {v[j].x, v[j].y, v[j].z, v[j].w};
#pragma unroll
    for (int q = 0; q < 4; ++q) {
      acc[j * 8 + 2 * q] += c * __uint_as_float(ww[q] << 16);
      acc[j * 8 + 2 * q + 1] += c * __uint_as_float(ww[q] & 0xffff0000u);
    }
  }
}
DI void axpy_half(float (&acc)[32], const uint4 (&v)[4], float c) {
#pragma unroll
  for (int j = 0; j < 4; ++j) {
    const unsigned ww[4] = {v[j].x, v[j].y, v[j].z, v[j].w};
#pragma unroll
    for (int q = 0; q < 4; ++q) {
      acc[j * 8 + 2 * q] += c * __uint_as_float(ww[q] << 16);
      acc[j * 8 + 2 * q + 1] += c * __uint_as_float(ww[q] & 0xffff0000u);
    }
  }
}
#ifndef PEER_TILE_SHIFT
#define PEER_TILE_SHIFT 8
#endif
DI void fma16_fp8(float& d, const uint4& u, const float* hv) {
  const unsigned ww[4] = {u.x, u.y, u.z, u.w};
#pragma unroll
  for (int q = 0; q < 4; ++q) {
    f32x2_t a = __builtin_amdgcn_cvt_pk_f32_fp8((int)ww[q], false), b = __builtin_amdgcn_cvt_pk_f32_fp8((int)ww[q], true);
    d += a[0] * hv[4 * q] + a[1] * hv[4 * q + 1] + b[0] * hv[4 * q + 2] + b[1] * hv[4 * q + 3];
  }
}
DI float dot_row8(const uint4 (&u)[4], const float (&hv)[64]) {
  float d0 = 0.f, d1 = 0.f;
  fma16_fp8(d0, u[0], hv); fma16_fp8(d1, u[1], hv + 16); fma16_fp8(d0, u[2], hv + 32); fma16_fp8(d1, u[3], hv + 48);
  return row16_sum(d0 + d1);
}
DI void axpy_row8(float (&acc)[64], const uint4 (&v)[4], float c) {
#pragma unroll
  for (int j = 0; j < 4; ++j) {
    const unsigned ww[4] = {v[j].x, v[j].y, v[j].z, v[j].w};
#pragma unroll
    for (int q = 0; q < 4; ++q) {
      f32x2_t a = __builtin_amdgcn_cvt_pk_f32_fp8((int)ww[q], false), b = __builtin_amdgcn_cvt_pk_f32_fp8((int)ww[q], true);
      acc[j * 16 + 4 * q] += c * a[0]; acc[j * 16 + 4 * q + 1] += c * a[1]; acc[j * 16 + 4 * q + 2] += c * b[0]; acc[j * 16 + 4 * q + 3] += c * b[1];
    }
  }
}
DI void peer_gather_block(const Params& p, int vb, char* smem) {
  unsigned* ELK = (unsigned*)smem;
  float* ELC = (float*)(smem + 32768);
  const int tid = mytid(), lane = tid & 63, w = tid >> 6, grp = lane >> 4, i = lane & 15;
  const int tokbase = vb * 64;
  for (int q = tid; q < 64 * 128 / 4; q += NT) {
    ((uint4*)ELK)[q] = ((const uint4*)(p.EIDX + (size_t)tokbase * 128))[q];
    ((float4*)ELC)[q] = ((const float4*)(p.EW + (size_t)tokbase * 128))[q];
  }
  __syncthreads();
#pragma unroll 1
  for (int tt = 0; tt < 2; ++tt) {
    const int tl = w * 8 + grp * 2 + tt, tok = tokbase + tl;
    const unsigned* kk = ELK + tl * 128;
    float* cc = ELC + tl * 128;
    uint4 b0[4], b1[4], b2[4], b3[4];
#define ROW_LOAD(BUF, BASE, E) { const unsigned e_ = kk[E]; _Pragma("unroll") for (int j = 0; j < 4; ++j) BUF[j] = *(const uint4*)(BASE + (size_t)e_ * DM + j * 256); }
    {
      float hv[64];
#pragma unroll
      for (int j = 0; j < 4; ++j)
#pragma unroll
        for (int hf = 0; hf < 2; ++hf) {
          uint4 a = *(const uint4*)(p.RA + (size_t)tok * DM + j * 256 + i * 16 + hf * 8);
          const unsigned aa[4] = {a.x, a.y, a.z, a.w};
#pragma unroll
          for (int q = 0; q < 4; ++q) { hv[j * 16 + hf * 8 + 2 * q] = __uint_as_float(aa[q] << 16); hv[j * 16 + hf * 8 + 2 * q + 1] = __uint_as_float(aa[q] & 0xffff0000u); }
        }
      const unsigned char* ub_ = p.PDN8 + i * 16;
#define DN_COMP(BUF, E) { const unsigned e_ = kk[E]; float d_ = dot_row8(BUF, hv) * p.SDN[e_]; float c_ = cc[E] * gelu_tanh(d_) * p.SUP[e_]; if (i == 0) cc[E] = c_; }
      ROW_LOAD(b0, ub_, 0) ROW_LOAD(b1, ub_, 1) ROW_LOAD(b2, ub_, 2) ROW_LOAD(b3, ub_, 3)
      for (int e = 0; e < 128; e += 4) {
        DN_COMP(b0, e)     if (e + 4 < 128) ROW_LOAD(b0, ub_, e + 4)
        DN_COMP(b1, e + 1) if (e + 4 < 128) ROW_LOAD(b1, ub_, e + 5)
        DN_COMP(b2, e + 2) if (e + 4 < 128) ROW_LOAD(b2, ub_, e + 6)
        DN_COMP(b3, e + 3) if (e + 4 < 128) ROW_LOAD(b3, ub_, e + 7)
      }
#undef DN_COMP
    }
    {
      float acc[64];
#pragma unroll
      for (int e = 0; e < 64; ++e) acc[e] = 0.f;
      const unsigned char* vbase = p.PUP8 + i * 16;
      ROW_LOAD(b0, vbase, 0) ROW_LOAD(b1, vbase, 1) ROW_LOAD(b2, vbase, 2) ROW_LOAD(b3, vbase, 3)
      for (int e = 0; e < 128; e += 4) {
        axpy_row8(acc, b0, cc[e]);     if (e + 4 < 128) ROW_LOAD(b0, vbase, e + 4)
        axpy_row8(acc, b1, cc[e + 1]); if (e + 4 < 128) ROW_LOAD(b1, vbase, e + 5)
        axpy_row8(acc, b2, cc[e + 2]); if (e + 4 < 128) ROW_LOAD(b2, vbase, e + 6)
        axpy_row8(acc, b3, cc[e + 3]); if (e + 4 < 128) ROW_LOAD(b3, vbase, e + 7)
      }
      const int b = tok >> 13;
      const float* ga2 = p.mod + b * 6144 + 5120;
      const float* orow = p.out + (size_t)tok * DM; float* grow = p.gout + (size_t)tok * DM;
      float ss = 0.f;
#pragma unroll
      for (int j = 0; j < 4; ++j)
#pragma unroll
        for (int q4 = 0; q4 < 4; ++q4) {
          const int col = j * 256 + i * 16 + q4 * 4;
          float4 x1 = *(const float4*)(orow + col), gg = *(const float4*)(ga2 + col);
          float* q = acc + j * 16 + q4 * 4;
          q[0] = x1.x + gg.x * q[0]; q[1] = x1.y + gg.y * q[1]; q[2] = x1.z + gg.z * q[2]; q[3] = x1.w + gg.w * q[3];
          ss += q[0] * q[0] + q[1] * q[1] + q[2] * q[2] + q[3] * q[3];
        }
      ss = row16_sum(ss);
      const float rstd = rsqrtf(ss * (1.f / DM) + 1e-6f);
#pragma unroll
      for (int j = 0; j < 4; ++j)
#pragma unroll
        for (int q4 = 0; q4 < 4; ++q4) {
          const int col = j * 256 + i * 16 + q4 * 4;
          float4 gf = *(const float4*)(p.g_final + col);
          const float* q = acc + j * 16 + q4 * 4;
          *(float4*)(grow + col) = make_float4(q[0] * rstd * gf.x, q[1] * rstd * gf.y, q[2] * rstd * gf.z, q[3] * rstd * gf.w);
        }
    }
#undef ROW_LOAD
  }
  __syncthreads();
}
DI void convert_row(const Params& p, int row, int lane) {
  const int tb = row >> 14, rr = row & 16383;
  const float* src = (tb ? p.peer_up : p.peer_down) + (size_t)rr * DM;
  float4 x[4]; float am = 0.f;
#pragma unroll
  for (int q = 0; q < 4; ++q) {
    x[q] = *(const float4*)(src + q * 256 + lane * 4);
    am = fmaxf(am, fmaxf(fmaxf(fabsf(x[q].x), fabsf(x[q].y)), fmaxf(fabsf(x[q].z), fabsf(x[q].w))));
  }
  for (int o = 32; o; o >>= 1) am = fmaxf(am, __shfl_xor(am, o));
  const float sc = (am > 0.f) ? am * (1.f / 448.f) : 1.f, inv = (am > 0.f) ? 448.f / am : 1.f;
  unsigned* dst = (unsigned*)((tb ? p.PUP8 : p.PDN8) + (size_t)rr * DM);
#pragma unroll
  for (int q = 0; q < 4; ++q) {
    int wd = 0;
    wd = __builtin_amdgcn_cvt_pk_fp8_f32(x[q].x * inv, x[q].y * inv, wd, false);
    wd = __builtin_amdgcn_cvt_pk_fp8_f32(x[q].z * inv, x[q].w * inv, wd, true);
    dst[q * 64 + lane] = (unsigned)wd;
  }
  if (lane == 0) (tb ? p.SUP : p.SDN)[rr] = sc;
}

#define N_PHASES 11
template <int PH>
DI void run_phase(const Params& p, char* smem) {
  const int nb = gridDim.x, bid = blockIdx.x, tid = mytid();
  if (PH == 0) {
    for (int vb = bid; vb < PH0_MOD; vb += nb) ph0_body(p, vb, smem);
  } else if (PH == 1) {
    constexpr int kPrepA = (PH0_WIN - PH0_MOD) + (PH0_ROPE - PH0_SUBK);
    for (int vb = bid; vb < T_TOK / 8 + kPrepA; vb += nb) {
      if (vb < T_TOK / 8) rownorm_body(p.x, p.g_mix, p.mod, 0, 1024, p.RA, vb);
      else { const int j = vb - T_TOK / 8; ph0_body(p, (j < PH0_WIN - PH0_MOD) ? PH0_MOD + j : PH0_SUBK + (j - (PH0_WIN - PH0_MOD)), smem); }
    }
  } else if (PH == 2) {
    EpiProj e{p};
    for (int vb = bid; vb < 64 * 14; vb += nb) gemm_tile(p.RA, p.WinT, 1024, (vb & 63) * 256, (vb >> 6) * 256, smem, e);
    {
      constexpr int kPrepB = (PH0_SUBK - PH0_WIN) + (PH0_B1P - PH0_ROPE);
      const int rem = (64 * 14) % nb;
      if (rem == 0 || bid >= rem) {
        for (int j = (rem == 0) ? bid : bid - rem; j < kPrepB; j += (rem == 0) ? nb : nb - rem)
          ph0_body(p, (j < PH0_SUBK - PH0_WIN) ? PH0_WIN + j : PH0_ROPE + (j - (PH0_SUBK - PH0_WIN)), smem);
      }
    }
  } else if (PH == 3) {
    for (int vb = bid; vb < 256 + 512 + 64; vb += nb) {
      if (vb < 256) compress_mfma(p, vb, smem);
      else if (vb < 256 + 512) retkv_mfma(p, vb - 256);
      else kmax_body2(p, vb - 768);
    }
  } else if (PH == 4) {
    for (int vb = bid; vb < 256 + 4; vb += nb) {
      if (vb < 256) scan_body(p, vb * NT + tid);
      else kcmax_body(p, (vb - 256) * NT + tid);
    }
  } else if (PH == 5) {
    for (int rep = 0; rep < (PROBE_DUP == 51 ? 2 : 1); ++rep)
      for (int vb = bid; vb < 256; vb += nb) retout_mfma(p, vb * 8 + (tid >> 6));
    for (int rep = 0; rep < (PROBE_DUP == 52 ? 2 : 1); ++rep)
      for (int vb = bid; vb < 512; vb += nb) nsa_item(p, (vb < 256) ? vb : 767 - vb, smem);
  } else if (PH == 6) {
    EpiOut e{p};
    for (int vb = bid; vb < 64 * 4; vb += nb) gemm_tile(p.RA, p.WoutT, 1024, (vb & 63) * 256, (vb >> 6) * 256, smem, e);
  } else if (PH == 7) {
    for (int vb = bid; vb < T_TOK / 8; vb += nb) rownorm_body(p.out, p.g_ffn, p.mod, 3072, 4096, p.RA, vb);
  } else if (PH == 8) {
    EpiPQ e{p};
    for (int vb = bid; vb < 64 * 8; vb += nb) gemm_tile(p.RA, p.WqT, 1024, (vb & 63) * 256, (vb >> 6) * 256, smem, e);
  } else if (PH == 9) {
    for (int vb = bid; vb < T_TOK / 16; vb += nb) peer_topk_tile(p, vb, smem);
  } else if (PH == 10) {
    for (int vb = bid; vb < T_TOK / 64; vb += nb) peer_gather_block(p, vb, smem);
  }
}


#define XB_TMO      128
#define XB_XCNT(j)  (256  + 64 * (j))
#define XB_XSUB(j)  (1280 + 64 * (j))
#define XB_XGEN(j)  (2304 + 64 * (j))
#define XB_TOP      3328
#define XB_TOPGEN   3392
#define XCD_BAR_WORDS 3456
#define XB_SPIN_CAP (1u << 22)
#define LAS __attribute__((address_space(3)))
DI unsigned xb_ld(unsigned* p) { return __hip_atomic_load(p, __ATOMIC_RELAXED, __HIP_MEMORY_SCOPE_AGENT); }
DI unsigned xb_add(unsigned* p, unsigned v) { return __hip_atomic_fetch_add(p, v, __ATOMIC_RELAXED, __HIP_MEMORY_SCOPE_AGENT); }
DI unsigned xb_xcc_id() { return (unsigned)__builtin_amdgcn_s_getreg((3 << 11) | 20) & 0xFu; }
#define XB_SPIN(cond, bar) do { unsigned _sp = 0; while (cond) { __builtin_amdgcn_s_sleep(1); \
    if ((++_sp & 255u) == 0u) { if (xb_ld(&(bar)[XB_TMO])) break; if (_sp > XB_SPIN_CAP) { atomicAdd(&(bar)[XB_TMO], 1u); break; } } } } while (0)
struct XcdBarrier { unsigned* bar; unsigned x; volatile LAS unsigned* st; };
DI XcdBarrier xcd_barrier_post(unsigned* bar, volatile LAS unsigned* st) {
  XcdBarrier b; b.bar = bar; b.x = xb_xcc_id(); b.st = st;
  if (threadIdx.x == 0) (void)xb_add(&bar[XB_XCNT(b.x)], 1u);
  return b;
}
DI void xcd_barrier_complete(unsigned* bar, unsigned x, unsigned& nloc, unsigned& nx) {
  const unsigned G = gridDim.x * gridDim.y * gridDim.z;
  unsigned sum, cnt, mine, sp = 0u;
  for (;;) {
    sum = 0u; cnt = 0u; mine = 0u;
#pragma unroll
    for (unsigned j = 0; j < 16; ++j) { const unsigned c = xb_ld(&bar[XB_XCNT(j)]); sum += c; cnt += (c > 0u) ? 1u : 0u; mine = (j == x) ? c : mine; }
    if (sum == G) break;
    __builtin_amdgcn_s_sleep(1);
    if ((++sp & 255u) == 0u) { if (xb_ld(&bar[XB_TMO])) break; if (sp > XB_SPIN_CAP) { atomicAdd(&bar[XB_TMO], 1u); break; } }
  }
  nloc = mine > 0u ? mine : 1u; nx = cnt > 0u ? cnt : 1u;
}
DI void xcd_barrier(const XcdBarrier& b) {
  asm volatile("s_waitcnt vmcnt(0)" ::: "memory");
  __syncthreads();
  if (threadIdx.x == 0) {
    unsigned* bar = b.bar;
    __builtin_amdgcn_s_waitcnt(0);
    unsigned nloc = b.st[0], nx = b.st[1];
    if (nloc == 0u) { xcd_barrier_complete(bar, b.x, nloc, nx); b.st[0] = nloc; b.st[1] = nx; }
    const unsigned old = xb_add(&bar[XB_XSUB(b.x)], 1u);
    const unsigned gen = old / nloc;
    if (old + 1u == (gen + 1u) * nloc) {
      __builtin_amdgcn_fence(__ATOMIC_RELEASE, "agent");
      asm volatile("s_waitcnt vmcnt(0)" ::: "memory");
      const unsigned og = xb_add(&bar[XB_TOP], 1u);
      const unsigned tg = og / nx;
      if (og + 1u == (tg + 1u) * nx) xb_add(&bar[XB_TOPGEN], 1u);
      else XB_SPIN(xb_ld(&bar[XB_TOPGEN]) == tg, bar);
      __builtin_amdgcn_fence(__ATOMIC_ACQUIRE, "agent");
      xb_add(&bar[XB_XGEN(b.x)], 1u);
      asm volatile("s_waitcnt vmcnt(0)" ::: "memory");
    } else {
      XB_SPIN(xb_ld(&bar[XB_XGEN(b.x)]) == gen, bar);
      __builtin_amdgcn_fence(__ATOMIC_ACQUIRE, "agent");
      asm volatile("s_waitcnt vmcnt(0)" ::: "memory");
    }
  }
  __syncthreads();
}

#define SMEM_BYTES 155648

template <int PH>
DI void phase_and_probe(const Params& p, char* smem, cg::grid_group& grid) {
  const int reps = (PROBE_DUP == PH) ? 2 : 1;
  for (int rep = 0; rep < reps; ++rep) {
    if (PH == 10 && rep + 1 < reps) { Params q = p; q.gout = (float*)p.PQ; run_phase<PH>(q, smem); }
    else run_phase<PH>(p, smem);
    if (rep + 1 < reps) grid.sync();
  }
}
__global__ void __launch_bounds__(NT) k_mega(Params p) {
  extern __shared__ __attribute__((aligned(16))) char smem[];
  __shared__ uint4 xb_words;
  cg::grid_group grid = cg::this_grid();
  if (threadIdx.x == 0) xb_words = make_uint4(0u, 0u, 0u, 0u);
  __syncthreads();
  XcdBarrier xb = xcd_barrier_post(p.xbar, (volatile LAS unsigned*)&xb_words);
  phase_and_probe<0>(p, smem, grid); grid.sync();
  phase_and_probe<1>(p, smem, grid); xcd_barrier(xb);
  phase_and_probe<2>(p, smem, grid); xcd_barrier(xb);
  phase_and_probe<3>(p, smem, grid); xcd_barrier(xb);
  phase_and_probe<4>(p, smem, grid); xcd_barrier(xb);
  phase_and_probe<5>(p, smem, grid); xcd_barrier(xb);
  phase_and_probe<6>(p, smem, grid); xcd_barrier(xb);
  phase_and_probe<7>(p, smem, grid); xcd_barrier(xb);
  phase_and_probe<8>(p, smem, grid); xcd_barrier(xb);
  phase_and_probe<9>(p, smem, grid); xcd_barrier(xb);
  phase_and_probe<10>(p, smem, grid);
}
#ifdef MK_MULTI
template <int PH>
__global__ void __launch_bounds__(NT) k_single(Params p) {
  extern __shared__ __attribute__((aligned(16))) char smem[];
  run_phase<PH>(p, smem);
}
#endif

static size_t carve(size_t& off, size_t bytes) { size_t o = off; off += (bytes + 255) & ~(size_t)255; return o; }

extern "C" void kernel_launch(void* const* d_in, const int* in_sizes, int n_in, void* d_out, int out_size, void* d_ws, size_t ws_size,
                              hipStream_t stream) {
  Params p{};
  p.x = (const float*)d_in[0]; p.c = (const float*)d_in[1]; p.w_ada = (const float*)d_in[2]; p.b_ada = (const float*)d_in[3];
  p.g_mix = (const float*)d_in[4]; p.w_in = (const float*)d_in[5]; p.pe_k = (const float*)d_in[6]; p.pe_v = (const float*)d_in[7];
  p.w_k1 = (const float*)d_in[8]; p.b_k1 = (const float*)d_in[9]; p.w_k2 = (const float*)d_in[10]; p.w_v1 = (const float*)d_in[11];
  p.b_v1 = (const float*)d_in[12]; p.w_v2 = (const float*)d_in[13]; p.w_out = (const float*)d_in[14]; p.g_ffn = (const float*)d_in[15];
  p.w_pq = (const float*)d_in[16]; p.subkeys = (const float*)d_in[17]; p.peer_down = (const float*)d_in[18]; p.peer_up = (const float*)d_in[19];
  p.g_final = (const float*)d_in[20];
  p.out = (float*)d_out; p.gout = p.out;
  char* ws = (char*)d_ws;
  size_t off = 0;
  p.mod = (float*)(ws + carve(off, 2 * 6144 * 4));
  p.ksmax = (unsigned*)(ws + carve(off, 256));
  p.xbar = (unsigned*)(ws + carve(off, XCD_BAR_WORDS * 4));
  p.c128 = (float*)(ws + carve(off, (size_t)SEQ * 64 * 4)); p.s128 = (float*)(ws + carve(off, (size_t)SEQ * 64 * 4));
  p.c64 = (float*)(ws + carve(off, (size_t)SEQ * 32 * 4)); p.s64 = (float*)(ws + carve(off, (size_t)SEQ * 32 * 4));
  p.WinT = (bf16_t*)(ws + carve(off, (size_t)NPROJ * 1024 * 2));
  p.WoutT = (bf16_t*)(ws + carve(off, (size_t)1024 * 1024 * 2));
  p.WqT = (bf16_t*)(ws + carve(off, (size_t)2048 * 1024 * 2));
  p.W1Tk = (bf16_t*)(ws + carve(off, (size_t)256 * 2048 * 2)); p.W1Tv = (bf16_t*)(ws + carve(off, (size_t)256 * 2048 * 2));
  p.W2Tk = (bf16_t*)(ws + carve(off, 64 * 256 * 2)); p.W2Tv = (bf16_t*)(ws + carve(off, 64 * 256 * 2));
  p.SUBK = (bf16_t*)(ws + carve(off, (size_t)16 * 128 * 128 * 2));
  p.B1Pk = (float*)(ws + carve(off, 1024)); p.B1Pv = (float*)(ws + carve(off, 1024));
  p.RA = (bf16_t*)(ws + carve(off, (size_t)T_TOK * 1024 * 2));
  size_t rb = off;
  p.RQ = (bf16_t*)(ws + carve(off, (size_t)T_TOK * 512 * 2)); p.RK = (bf16_t*)(ws + carve(off, (size_t)T_TOK * 512 * 2));
  p.RKT = (bf16_t*)(ws + carve(off, (size_t)T_TOK * 512 * 2)); p.RVT = (bf16_t*)(ws + carve(off, (size_t)T_TOK * 512 * 2));
  p.RGT = (bf16_t*)(ws + carve(off, (size_t)T_TOK * 512 * 2)); p.NQ = (bf16_t*)(ws + carve(off, (size_t)T_TOK * 512 * 2));
  p.NKC = (bf16_t*)(ws + carve(off, (size_t)T_TOK * 128 * 2)); p.NVC = (bf16_t*)(ws + carve(off, (size_t)T_TOK * 128 * 2));
  p.NKS = (bf16_t*)(ws + carve(off, (size_t)T_TOK * 128 * 2)); p.NKW = (bf16_t*)(ws + carve(off, (size_t)T_TOK * 128 * 2));
  p.NVST = (bf16_t*)(ws + carve(off, (size_t)T_TOK * 128 * 2)); p.NVWT = (bf16_t*)(ws + carve(off, (size_t)T_TOK * 128 * 2));
  p.GATE = (float*)(ws + carve(off, (size_t)T_TOK * 24 * 4));
  p.KV = (float*)(ws + carve(off, (size_t)512 * 16384 * 4));
  p.SPREV = (bf16_t*)(ws + carve(off, (size_t)512 * 16384 * 2));
  p.KC = (bf16_t*)(ws + carve(off, (size_t)4 * 512 * 64 * 2)); p.VCT = (bf16_t*)(ws + carve(off, (size_t)4 * 512 * 64 * 2));
  p.HID = (float*)(ws + carve(off, (size_t)2 * 2048 * 256 * 4));
  size_t off2 = rb;
  p.PQ = (bf16_t*)(ws + carve(off2, (size_t)T_TOK * 2048 * 2));
  p.EIDX = (int*)(ws + carve(off2, (size_t)T_TOK * 128 * 4));
  p.EW = (float*)(ws + carve(off2, (size_t)T_TOK * 128 * 4));
  p.PDN8 = (unsigned char*)(ws + carve(off2, (size_t)16384 * 1024));
  p.PUP8 = (unsigned char*)(ws + carve(off2, (size_t)16384 * 1024));
  p.SDN = (float*)(ws + carve(off2, 16384 * 4));
  p.SUP = (float*)(ws + carve(off2, 16384 * 4));
  (void)ws_size; (void)in_sizes; (void)n_in; (void)out_size;

#ifdef MK_MULTI
#define LAUNCH1(PH) { hipFuncSetAttribute((const void*)k_single<PH>, hipFuncAttributeMaxDynamicSharedMemorySize, SMEM_BYTES); k_single<PH><<<256, NT, SMEM_BYTES, stream>>>(p); }
  LAUNCH1(0) LAUNCH1(1) LAUNCH1(2) LAUNCH1(3) LAUNCH1(4) LAUNCH1(5) LAUNCH1(6) LAUNCH1(7) LAUNCH1(8) LAUNCH1(9) LAUNCH1(10)
#else
  static int grid_blocks = 0;
  if (!grid_blocks) {
    int dev = 0, cus = 0, per_cu = 0;
    (void)hipGetDevice(&dev);
    (void)hipDeviceGetAttribute(&cus, hipDeviceAttributeMultiprocessorCount, dev);
    (void)hipFuncSetAttribute((const void*)k_mega, hipFuncAttributeMaxDynamicSharedMemorySize, SMEM_BYTES);
    (void)hipOccupancyMaxActiveBlocksPerMultiprocessor(&per_cu, k_mega, NT, SMEM_BYTES);
    if (per_cu < 1) per_cu = 1;
    if (per_cu > 1) per_cu = 1;
    grid_blocks = cus * per_cu;
  }
  (void)hipMemsetAsync(p.xbar, 0, XCD_BAR_WORDS * 4, stream);
  void* args[] = {&p};
  hipError_t e = hipLaunchCooperativeKernel((void*)k_mega, dim3(grid_blocks), dim3(NT), args, SMEM_BYTES, stream);
  if (e != hipSuccess) fprintf(stderr, "cooperative launch failed: %s (grid %d)\n", hipGetErrorString(e), grid_blocks);
#endif
}
```

```cpp
#include <hip/hip_runtime.h>
#include <hip/hip_bf16.h>
#include <hip/hip_cooperative_groups.h>
#include <stdint.h>
#include <stdio.h>
namespace cg = cooperative_groups;

typedef unsigned short bf16_t;
#define DI __device__ __forceinline__

DI int mytid() { int t = threadIdx.x; asm volatile("" : "+v"(t)); return t; }
DI float bf2f(bf16_t v) { return __uint_as_float(((unsigned)v) << 16); }
DI bf16_t f2bf(float x) { unsigned u = __float_as_uint(x); u += 0x7fffu + ((u >> 16) & 1u); return (bf16_t)(u >> 16); }
DI float gelu_tanh(float x) { float u = 0.7978845608028654f * (x + 0.044715f * x * x * x); return 0.5f * x * (1.f + tanhf(u)); }
DI float siluf(float x) { return x / (1.f + __expf(-x)); }
DI float sigmoidf(float x) { return 1.f / (1.f + __expf(-x)); }

#define T_TOK 16384
#define SEQ 8192
#define DM 1024
#define NPROJ 3584
#define NEG_INF (-__builtin_inff())

struct Params {
  const float *x, *c, *w_ada, *b_ada, *g_mix, *w_in, *pe_k, *pe_v, *w_k1, *b_k1, *w_k2, *w_v1, *b_v1, *w_v2, *w_out, *g_ffn,
      *w_pq, *subkeys, *peer_down, *peer_up, *g_final;
  float* out;
  float* gout;
  float* mod;
  unsigned* ksmax;
  unsigned* xbar;
  float *c128, *s128, *c64, *s64;
  bf16_t *WinT, *WoutT, *WqT, *W1Tk, *W1Tv, *W2Tk, *W2Tv, *SUBK;
  float *B1Pk, *B1Pv;
  bf16_t* RA;
  bf16_t *RQ, *RK, *RKT, *RVT, *RGT, *NQ, *NKC, *NVC, *NKS, *NKW, *NVST, *NVWT;
  float* GATE;
  float* KV;
  bf16_t* SPREV;
  bf16_t *KC, *VCT;
  float* HID;
  bf16_t* PQ;
  int* EIDX;
  float* EW;
  unsigned char *PDN8, *PUP8;
  float *SDN, *SUP;
};

DI float logg_h(int h) { return log1pf(-exp2f(-5.f - (float)h)); }


typedef __bf16 bf16x2_t __attribute__((ext_vector_type(2)));
typedef float f32x2_t __attribute__((ext_vector_type(2)));
DI unsigned cvt2(float a, float b) { f32x2_t v = {a, b}; bf16x2_t r = __builtin_convertvector(v, bf16x2_t); return __builtin_bit_cast(unsigned, r); }
DI uint2 pack4(float a, float b, float c, float d) { uint2 r; r.x = cvt2(a, b); r.y = cvt2(c, d); return r; }
#define NT 512
#ifndef PROBE_DUP
#define PROBE_DUP -1
#endif
typedef short bf16x8 __attribute__((ext_vector_type(8)));
typedef float f32x16 __attribute__((ext_vector_type(16)));
#define MFMA32(a, b, c) __builtin_amdgcn_mfma_f32_32x32x16_bf16((a), (b), (c), 0, 0, 0)
DI f32x16 zero16() { f32x16 z; for (int e = 0; e < 16; ++e) z[e] = 0.f; return z; }
DI f32x16 fill16(float v) { f32x16 z; for (int e = 0; e < 16; ++e) z[e] = v; return z; }
DI float ex2(float x) { return __builtin_amdgcn_exp2f(x); }

DI int win_logical_col(int np) {
  int g = np >> 6, c = np & 63;
  if (g < 16) {
    int sec = g >> 3, hh = (g & 7) >> 1, j = g & 1, i = 32 * j + (c & 31);
    return sec * 512 + hh * 128 + ((c < 32) ? i : 64 + i);
  } else if (g < 52) return 1024 + (g - 16) * 64 + c;
  else if (g == 52) return (c < 24) ? 3328 + c : -1;
  return -1;
}

DI void tr_tile(const float* __restrict__ in, bf16_t* __restrict__ out, int K, int N_in, int k0, int n0, int mode, float* tile) {
  const int tid = mytid();
  {
    int nn = tid & 63, col = mode ? win_logical_col(n0 + nn) : (n0 + nn);
#pragma unroll
    for (int i = 0; i < 8; ++i) {
      int kk = (tid >> 6) + 8 * i;
      tile[kk * 65 + nn] = (col >= 0) ? in[(size_t)(k0 + kk) * N_in + col] : 0.f;
    }
  }
  __syncthreads();
  {
    int kk = tid & 63;
#pragma unroll
    for (int i = 0; i < 8; ++i) {
      int nn = (tid >> 6) + 8 * i;
      out[(size_t)(n0 + nn) * K + k0 + kk] = f2bf(tile[kk * 65 + nn]);
    }
  }
  __syncthreads();
}

#define PH0_MOD 96
#define PH0_WIN (PH0_MOD + 16 * 56)
#define PH0_WOUT (PH0_WIN + 256)
#define PH0_WQ (PH0_WOUT + 512)
#define PH0_W1K (PH0_WQ + 128)
#define PH0_W1V (PH0_W1K + 128)
#define PH0_W2K (PH0_W1V + 4)
#define PH0_W2V (PH0_W2K + 4)
#define PH0_SUBK (PH0_W2V + 512)
#define PH0_ROPE (PH0_SUBK + 1024)
#define PH0_B1P (PH0_ROPE + 8)
#define PH0_NVB PH0_B1P

DI void ph0_body(const Params& p, int vb, char* smem) {
  const int tid = mytid();
  float* fs = (float*)smem;
  if (vb < PH0_MOD) {
    int kg = tid >> 6, col = vb * 64 + (tid & 63);
    float a0 = 0.f, a1 = 0.f;
#pragma unroll 8
    for (int k = kg * 128; k < kg * 128 + 128; ++k) {
      float w = p.w_ada[(size_t)k * 6144 + col];
      a0 += siluf(p.c[k]) * w; a1 += siluf(p.c[DM + k]) * w;
    }
    fs[kg * 64 + (tid & 63)] = a0; fs[512 + kg * 64 + (tid & 63)] = a1;
    __syncthreads();
    if (tid < 128) {
      int b = tid >> 6, cc = tid & 63; float s = 0.f;
      for (int g = 0; g < 8; ++g) s += fs[b * 512 + g * 64 + cc];
      p.mod[b * 6144 + vb * 64 + cc] = s + p.b_ada[vb * 64 + cc];
    }
    __syncthreads();
    if (vb == 0 && tid < 12) p.ksmax[tid] = 0u;
  } else if (vb < PH0_WIN) { int t = vb - PH0_MOD; tr_tile(p.w_in, p.WinT, 1024, 3352, (t & 15) * 64, (t >> 4) * 64, 1, fs); }
  else if (vb < PH0_WOUT) { int t = vb - PH0_WIN; tr_tile(p.w_out, p.WoutT, 1024, 1024, (t & 15) * 64, (t >> 4) * 64, 0, fs); }
  else if (vb < PH0_WQ) { int t = vb - PH0_WOUT; tr_tile(p.w_pq, p.WqT, 1024, 2048, (t & 15) * 64, (t >> 4) * 64, 0, fs); }
  else if (vb < PH0_W1K) { int t = vb - PH0_WQ; tr_tile(p.w_k1, p.W1Tk, 2048, 256, (t & 31) * 64, (t >> 5) * 64, 0, fs); }
  else if (vb < PH0_W1V) { int t = vb - PH0_W1K; tr_tile(p.w_v1, p.W1Tv, 2048, 256, (t & 31) * 64, (t >> 5) * 64, 0, fs); }
  else if (vb < PH0_W2K) { int t = vb - PH0_W1V; tr_tile(p.w_k2, p.W2Tk, 256, 64, t * 64, 0, 0, fs); }
  else if (vb < PH0_W2V) { int t = vb - PH0_W2K; tr_tile(p.w_v2, p.W2Tv, 256, 64, t * 64, 0, 0, fs); }
  else if (vb < PH0_SUBK) { int i = (vb - PH0_W2V) * NT + tid; p.SUBK[i] = f2bf(p.subkeys[i]); }
  else if (vb < PH0_ROPE) {
    int idx = (vb - PH0_SUBK) * NT + tid;
    { int s = idx >> 6, i = idx & 63; float inv = powf(10000.f, -(float)(2 * i) / 128.f); float ang = (float)s * inv; p.c128[idx] = cosf(ang); p.s128[idx] = sinf(ang); }
    if (idx < SEQ * 32) { int s = idx >> 5, i = idx & 31; float inv = powf(10000.f, -(float)(2 * i) / 64.f); float ang = (float)s * inv; p.c64[idx] = cosf(ang); p.s64[idx] = sinf(ang); }
  } else {
    int t = vb - PH0_ROPE, kv = t >> 2, jb = t & 3;
    const float* w1 = kv ? p.w_v1 : p.w_k1; const float* pe = kv ? p.pe_v : p.pe_k; const float* b1 = kv ? p.b_v1 : p.b_k1;
    int fg = tid >> 6, j = jb * 64 + (tid & 63);
    float a = 0.f;
#pragma unroll 8
    for (int f = fg * 256; f < fg * 256 + 256; ++f) a += pe[f] * w1[(size_t)f * 256 + j];
    fs[fg * 64 + (tid & 63)] = a;
    __syncthreads();
    if (tid < 64) { float s = b1[j]; for (int g = 0; g < 8; ++g) s += fs[g * 64 + tid]; (kv ? p.B1Pv : p.B1Pk)[j] = s; }
    __syncthreads();
  }
}

DI void rownorm_body(const float* __restrict__ src, const float* __restrict__ g, const float* __restrict__ mod, int sh_off, int sc_off, bf16_t* __restrict__ dst, int vb) {
  int row = vb * 8 + (mytid() >> 6), lane = mytid() & 63;
  int b = row >> 13;
  const float* xr = src + (size_t)row * DM;
  float v[16]; float ss = 0.f;
#pragma unroll
  for (int i = 0; i < 4; ++i) {
    float4 t = *(const float4*)(xr + i * 256 + lane * 4);
    v[i * 4 + 0] = t.x; v[i * 4 + 1] = t.y; v[i * 4 + 2] = t.z; v[i * 4 + 3] = t.w;
    ss += t.x * t.x + t.y * t.y + t.z * t.z + t.w * t.w;
  }
  for (int o = 32; o; o >>= 1) ss += __shfl_xor(ss, o);
  float rstd = rsqrtf(ss * (1.f / DM) + 1e-6f);
  const float* sh = mod + b * 6144 + sh_off; const float* sc = mod + b * 6144 + sc_off;
#pragma unroll
  for (int i = 0; i < 4; ++i) {
    int col = i * 256 + lane * 4;
    float4 gg = *(const float4*)(g + col), s4 = *(const float4*)(sc + col), h4 = *(const float4*)(sh + col);
    float y0 = v[i * 4 + 0] * rstd * gg.x * (1.f + s4.x) + h4.x;
    float y1 = v[i * 4 + 1] * rstd * gg.y * (1.f + s4.y) + h4.y;
    float y2 = v[i * 4 + 2] * rstd * gg.z * (1.f + s4.z) + h4.z;
    float y3 = v[i * 4 + 3] * rstd * gg.w * (1.f + s4.w) + h4.w;
    *(uint2*)(dst + (size_t)row * DM + col) = pack4(y0, y1, y2, y3);
  }
}

#define G_A_BYTES (256 * 144)
#define G_B_BYTES (256 * 144)
#define G_BUF_BYTES (G_A_BYTES + G_B_BYTES)
template <class Epi>
DI void gemm_tile(const bf16_t* __restrict__ A, const bf16_t* __restrict__ Bt, int K, int m0, int n0, char* smem, const Epi& epi) {
  const int tid = mytid(), lane = tid & 63, w = tid >> 6, wm = w >> 2, wn = w & 3, r = lane & 31, h = lane >> 5;
  f32x16 acc[4][2];
#pragma unroll
  for (int i = 0; i < 4; ++i)
#pragma unroll
    for (int j = 0; j < 2; ++j) acc[i][j] = zero16();
  const int crow = tid >> 3, ckc = tid & 7;
  const bf16_t* ag = A + (size_t)(m0 + crow) * K + ckc * 8;
  const bf16_t* bg = Bt + (size_t)(n0 + crow) * K + ckc * 8;
  uint4 ra[4], rb[4];
#pragma unroll
  for (int i = 0; i < 4; ++i) { ra[i] = *(const uint4*)(ag + (size_t)i * 64 * K); rb[i] = *(const uint4*)(bg + (size_t)i * 64 * K); }
  char* lw = smem + crow * 144 + ckc * 16;
#pragma unroll
  for (int i = 0; i < 4; ++i) { *(uint4*)(lw + i * 64 * 144) = ra[i]; *(uint4*)(lw + G_A_BYTES + i * 64 * 144) = rb[i]; }
  __syncthreads();
  const int nk = K >> 6;
  for (int kt = 0; kt < nk; ++kt) {
    const int cur = kt & 1;
    if (kt + 1 < nk) {
      const int k0 = (kt + 1) * 64;
#pragma unroll
      for (int i = 0; i < 4; ++i) { ra[i] = *(const uint4*)(ag + (size_t)i * 64 * K + k0); rb[i] = *(const uint4*)(bg + (size_t)i * 64 * K + k0); }
    }
    const char* la = smem + cur * G_BUF_BYTES + (wm * 128 + r) * 144 + h * 16;
    const char* lb = smem + cur * G_BUF_BYTES + G_A_BYTES + (wn * 64 + r) * 144 + h * 16;
#pragma unroll
    for (int kk = 0; kk < 4; ++kk) {
      bf16x8 b0 = *(const bf16x8*)(lb + kk * 32), b1 = *(const bf16x8*)(lb + 32 * 144 + kk * 32);
#pragma unroll
      for (int i = 0; i < 4; ++i) {
        bf16x8 a = *(const bf16x8*)(la + i * 32 * 144 + kk * 32);
        acc[i][0] = MFMA32(a, b0, acc[i][0]); acc[i][1] = MFMA32(a, b1, acc[i][1]);
      }
    }
    if (kt + 1 < nk) {
      char* lw2 = lw + (cur ^ 1) * G_BUF_BYTES;
#pragma unroll
      for (int i = 0; i < 4; ++i) { *(uint4*)(lw2 + i * 64 * 144) = ra[i]; *(uint4*)(lw2 + G_A_BYTES + i * 64 * 144) = rb[i]; }
    }
    __syncthreads();
  }
  const int G = (n0 >> 6) + wn;
#pragma unroll
  for (int i = 0; i < 4; ++i) {
    float pre[4][8];
#pragma unroll
    for (int g = 0; g < 4; ++g) epi.prefetch(m0 + wm * 128 + i * 32 + 8 * g + 4 * h, G, r, pre[g]);
#pragma unroll
    for (int g = 0; g < 4; ++g) {
      float lo[4], hi[4];
#pragma unroll
      for (int e = 0; e < 4; ++e) { lo[e] = acc[i][0][4 * g + e]; hi[e] = acc[i][1][4 * g + e]; }
      epi(m0 + wm * 128 + i * 32 + 8 * g + 4 * h, G, r, lo, hi, pre[g]);
    }
  }
}

struct EpiProj {
  static constexpr bool kProbe = true;
  const Params& p;
  DI void prefetch(int t0, int G, int c, float (&pre)[8]) const {
    const int s0 = t0 & 8191;
    const bool r128 = G < 16, r64 = (G >= 32 && G < 40) || (G >= 40 && G < 52 && (((G - 40) >> 1) & 1) == 0);
    if (r128) {
      const int i = 32 * (G & 1) + c;
#pragma unroll
      for (int e = 0; e < 4; ++e) { pre[e] = p.c128[(s0 + e) * 64 + i]; pre[4 + e] = p.s128[(s0 + e) * 64 + i]; }
    } else if (r64) {
#pragma unroll
      for (int e = 0; e < 4; ++e) { pre[e] = p.c64[(s0 + e) * 32 + c]; pre[4 + e] = p.s64[(s0 + e) * 32 + c]; }
    } else {
#pragma unroll
      for (int e = 0; e < 8; ++e) pre[e] = 0.f;
    }
  }
  DI void operator()(int t0, int G, int c, const float (&lo)[4], const float (&hi)[4], const float (&pre)[8]) const {
    const int b = t0 >> 13, s0 = t0 & 8191;
    if (G < 16) {
      const int sec = G >> 3, hh = (G & 7) >> 1, j = G & 1, i = 32 * j + c;
      float o1[4], o2[4];
#pragma unroll
      for (int e = 0; e < 4; ++e) {
        float cs = pre[e], sn = pre[4 + e];
        o1[e] = lo[e] * cs - hi[e] * sn; o2[e] = hi[e] * cs + lo[e] * sn;
      }
      if (sec == 0) {
#pragma unroll
        for (int e = 0; e < 4; ++e) {
          p.RQ[(size_t)(t0 + e) * 512 + hh * 128 + i] = f2bf(o1[e]);
          p.RQ[(size_t)(t0 + e) * 512 + hh * 128 + 64 + i] = f2bf(o2[e]);
        }
      } else {
        const float sc = 0.08838834764831845f;
        const float lg = logg_h(hh);
#pragma unroll
        for (int e = 0; e < 4; ++e) {
          o1[e] *= sc; o2[e] *= sc;
          p.RK[(size_t)(t0 + e) * 512 + hh * 128 + i] = f2bf(o1[e]);
          p.RK[(size_t)(t0 + e) * 512 + hh * 128 + 64 + i] = f2bf(o2[e]);
          float zeta = __expf((float)(127 - ((s0 + e) & 127)) * lg);
          o1[e] *= zeta; o2[e] *= zeta;
        }
        *(uint2*)(p.RKT + ((size_t)(b * 4 + hh) * 128 + i) * SEQ + s0) = pack4(o1[0], o1[1], o1[2], o1[3]);
        *(uint2*)(p.RKT + ((size_t)(b * 4 + hh) * 128 + 64 + i) * SEQ + s0) = pack4(o2[0], o2[1], o2[2], o2[3]);
      }
    } else if (G < 24) {
      const int hh = (G - 16) >> 1, d = ((G - 16) & 1) * 64 + c;
      *(uint2*)(p.RVT + ((size_t)(b * 4 + hh) * 128 + d) * SEQ + s0) = pack4(lo[0], lo[1], lo[2], lo[3]);
      *(uint2*)(p.RVT + ((size_t)(b * 4 + hh) * 128 + d + 32) * SEQ + s0) = pack4(hi[0], hi[1], hi[2], hi[3]);
    } else if (G < 32) {
      const int hh = (G - 24) >> 1, d = ((G - 24) & 1) * 64 + c;
#pragma unroll
      for (int e = 0; e < 4; ++e) {
        p.RGT[(size_t)(t0 + e) * 512 + hh * 128 + d] = f2bf(siluf(lo[e]));
        p.RGT[(size_t)(t0 + e) * 512 + hh * 128 + d + 32] = f2bf(siluf(hi[e]));
      }
    } else if (G < 40) {
      const int head = G - 32;
#pragma unroll
      for (int e = 0; e < 4; ++e) {
        float cs = pre[e], sn = pre[4 + e];
        const float qs = 0.125f * 1.4426950408889634f;
        float o1 = (lo[e] * cs - hi[e] * sn) * qs, o2 = (hi[e] * cs + lo[e] * sn) * qs;
        p.NQ[(size_t)(t0 + e) * 512 + head * 64 + c] = f2bf(o1);
        p.NQ[(size_t)(t0 + e) * 512 + head * 64 + 32 + c] = f2bf(o2);
      }
    } else if (G < 52) {
      const int k = G - 40, kind = k >> 1, gg = k & 1;
      float o1[4], o2[4];
#pragma unroll
      for (int e = 0; e < 4; ++e) {
        o1[e] = lo[e]; o2[e] = hi[e];
        if ((kind & 1) == 0) {
          float cs = pre[e], sn = pre[4 + e];
          o1[e] = lo[e] * cs - hi[e] * sn; o2[e] = hi[e] * cs + lo[e] * sn;
        }
      }
      if (kind == 3 || kind == 5) {
        bf16_t* dst = (kind == 3 ? p.NVST : p.NVWT) + ((size_t)(b * 2 + gg) * 64 + c) * SEQ + s0;
        *(uint2*)dst = pack4(o1[0], o1[1], o1[2], o1[3]);
        *(uint2*)(dst + (size_t)32 * SEQ) = pack4(o2[0], o2[1], o2[2], o2[3]);
      } else {
        bf16_t* dst = (kind == 0 ? p.NKC : kind == 1 ? p.NVC : kind == 2 ? p.NKS : p.NKW);
#pragma unroll
        for (int e = 0; e < 4; ++e) {
          dst[(size_t)(t0 + e) * 128 + gg * 64 + c] = f2bf(o1[e]);
          dst[(size_t)(t0 + e) * 128 + gg * 64 + 32 + c] = f2bf(o2[e]);
        }
      }
    } else if (G == 52) {
      if (c < 24) {
#pragma unroll
        for (int e = 0; e < 4; ++e) p.GATE[(size_t)(t0 + e) * 24 + c] = sigmoidf(lo[e]);
      }
    }
  }
};
struct EpiOut {
  static constexpr bool kProbe = false;
  const Params& p;
  DI void prefetch(int t0, int G, int c, float (&pre)[8]) const {
    const int c0 = G * 64 + c;
#pragma unroll
    for (int e = 0; e < 4; ++e) { pre[e] = p.x[(size_t)(t0 + e) * DM + c0]; pre[4 + e] = p.x[(size_t)(t0 + e) * DM + c0 + 32]; }
  }
  DI void operator()(int t0, int G, int c, const float (&lo)[4], const float (&hi)[4], const float (&pre)[8]) const {
    const int b = t0 >> 13;
    const int c0 = G * 64 + c, c1 = c0 + 32;
    const float* ga1 = p.mod + b * 6144 + 2048;
    const float g0 = ga1[c0], g1 = ga1[c1];
#pragma unroll
    for (int e = 0; e < 4; ++e) {
      p.out[(size_t)(t0 + e) * DM + c0] = pre[e] + g0 * lo[e];
      p.out[(size_t)(t0 + e) * DM + c1] = pre[4 + e] + g1 * hi[e];
    }
  }
};
struct EpiPQ {
  static constexpr bool kProbe = false;
  const Params& p;
  DI void prefetch(int, int, int, float (&)[8]) const {}
  DI void operator()(int t0, int G, int c, const float (&lo)[4], const float (&hi)[4], const float (&)[8]) const {
#pragma unroll
    for (int e = 0; e < 4; ++e) {
      p.PQ[(size_t)(t0 + e) * 2048 + G * 64 + c] = f2bf(lo[e]);
      p.PQ[(size_t)(t0 + e) * 2048 + G * 64 + 32 + c] = f2bf(hi[e]);
    }
  }
};


namespace pg8 {
#define PG8_LAS __attribute__((address_space(3)))
typedef float f32x4 __attribute__((ext_vector_type(4)));
constexpr int BM = 256, BK = 64, HALF = 128, HTB = HALF * BK * 2, STAGE_BYTES = 8 * HTB, NXCD = 8, WGM = 8;
DI int lds_byte(int r, int c) { const int st = (r >> 4) * 2 + (c >> 5), rr = r & 15, cc = c & 31, ob = rr * 64 + cc * 2; return st * 1024 + (ob ^ (((ob >> 9) & 1) << 5)); }
DI void stage_rc(int b, int& R, int& C) { const int st = b / 1024, sb = b % 1024, swz = sb ^ (((sb >> 9) & 1) << 5); R = (st >> 1) * 16 + swz / 64; C = (st & 1) * 32 + (swz % 64) / 2; }
DI int perm32(int rho) { const int n = rho >> 4, i = rho & 15; return 8 * (i >> 2) + 4 * n + (i & 3); }
struct Unit { int pm, pn; };
struct Gemm { const bf16_t* A; const bf16_t* Bt; int M, N, K; };
struct StaticOrder {
  int nM, nN, nwg, G, c;
  DI void init(int M, int N, int G_, int c_) { nM = M / BM; nN = N / BM; nwg = nM * nN; G = G_; c = c_; }
  DI bool next(int i, Unit& u) const {
    const long L = (long)i * G + c; if (L >= nwg) return false;
    int wgid = (int)L; { const int q = nwg / NXCD, r = nwg % NXCD, xcd = wgid % NXCD, off = wgid / NXCD; wgid = (xcd < r ? xcd * (q + 1) : r * (q + 1) + (xcd - r) * q) + off; }
    const int nig = WGM * nN, gid = wgid / nig, fm = gid * WGM, gsz = (nM - fm) < WGM ? (nM - fm) : WGM;
    u.pm = fm + ((wgid % nig) % gsz); u.pn = (wgid % nig) / gsz; return true;
  }
  DI void a_ready(const Unit&) const {}
  DI void done(const Unit&) const {}
};
template <class Epi, class Sched>
__device__ __forceinline__ void gemm_phase(PG8_LAS unsigned char* lds, const Gemm g, const Sched& S, const Epi& E) {
    const int tid = mytid(), wid = __builtin_amdgcn_readfirstlane(tid >> 6), lane = tid & 63, wr = wid >> 2, wc = wid & 3, fr = lane & 15, fq = lane >> 4;
    const int K = g.K, nt = K / BK;
    unsigned voffA[2], voffB[2];
#pragma unroll
    for (int i = 0; i < 2; ++i) { int R, C; stage_rc(tid * 16 + i * 8192, R, C); const int Rb = Epi::PERM ? ((R & ~31) + perm32(R & 31)) : R;
        voffA[i] = (unsigned)(R * K + C) * 2u; voffB[i] = (unsigned)(Rb * K + C) * 2u; }
    const size_t kstep = (size_t)(BK * 2);
    const size_t hstep = (size_t)HALF * K * 2;
    const size_t tstep = 2 * hstep;
    const unsigned ldsw = (unsigned)wid * 1024u;
    const int aoff = lds_byte(wr * 64 + fr, fq * 8), boff = lds_byte(wc * 32 + fr, fq * 8);
#define PG8_SA(b, h) (((b) * 2 + (h)) * HTB)
#define PG8_SB(b, h) ((4 + (b) * 2 + (h)) * HTB)
#define PG8_STAGE(bufoff, gbase, voff) do { _Pragma("unroll") for (int _i = 0; _i < 2; ++_i) \
        __builtin_amdgcn_global_load_lds((const unsigned*)((const char*)(gbase) + (voff)[_i]), (PG8_LAS unsigned*)(lds + (bufoff) + ldsw + _i * 8192), 16, 0, 0); } while (0)
#define PG8_LDA(dst, b, h) do { _Pragma("unroll") for (int m = 0; m < 4; ++m) _Pragma("unroll") for (int k = 0; k < 2; ++k) dst[m][k] = *(const PG8_LAS bf16x8*)(lds + PG8_SA(b, h) + aoff + m * 2048 + k * 1024); } while (0)
#define PG8_LDB(dst, b, h) do { _Pragma("unroll") for (int n = 0; n < 2; ++n) _Pragma("unroll") for (int k = 0; k < 2; ++k) dst[n][k] = *(const PG8_LAS bf16x8*)(lds + PG8_SB(b, h) + boff + n * 2048 + k * 1024); } while (0)
#define PG8_MMA(ai, bj, At, Bt) do { __builtin_amdgcn_s_setprio(1); _Pragma("unroll") for (int m = 0; m < 4; ++m) _Pragma("unroll") for (int n = 0; n < 2; ++n) _Pragma("unroll") for (int k = 0; k < 2; ++k) \
        acc[ai][bj][m][n] = __builtin_amdgcn_mfma_f32_16x16x32_bf16(Bt[n][k], At[m][k], acc[ai][bj][m][n], 0, 0, 0); __builtin_amdgcn_s_setprio(0); } while (0)
#define PG8_WAIT_V(n) asm volatile("s_waitcnt vmcnt(" #n ")" ::: "memory")
#define PG8_WAIT_L(n) asm volatile("s_waitcnt lgkmcnt(" #n ")" ::: "memory")
#define PG8_BAR __builtin_amdgcn_s_barrier()
#define PG8_SCHED __builtin_amdgcn_sched_barrier(0)
    Unit cur, nxt; int ui = 0;
    if (!S.next(0, cur)) return;
    f32x4 acc[2][2][4][2];
#pragma unroll
    for (int a = 0; a < 2; ++a)
#pragma unroll
        for (int b = 0; b < 2; ++b)
#pragma unroll
            for (int m = 0; m < 4; ++m)
#pragma unroll
                for (int n = 0; n < 2; ++n) acc[a][b][m][n] = (f32x4){0.f, 0.f, 0.f, 0.f};
    bf16x8 At[4][2], B0[2][2], B1[2][2];
    const char* cA = (const char*)g.A + (size_t)cur.pm * tstep; const char* cB = (const char*)g.Bt + (size_t)cur.pn * tstep;
    S.a_ready(cur);
    PG8_STAGE(PG8_SB(0, 0), cB, voffB); PG8_STAGE(PG8_SA(0, 0), cA, voffA); PG8_STAGE(PG8_SB(0, 1), cB + hstep, voffB); PG8_STAGE(PG8_SA(0, 1), cA + hstep, voffA);
    if (wr == 1) PG8_BAR;
    PG8_WAIT_V(4); PG8_BAR;
    PG8_STAGE(PG8_SB(1, 0), cB + kstep, voffB); PG8_STAGE(PG8_SA(1, 0), cA + kstep, voffA); PG8_STAGE(PG8_SB(1, 1), cB + hstep + kstep, voffB);
    PG8_WAIT_V(6); PG8_BAR;
    for (;;) {
        const bool has_next = S.next(ui + 1, nxt);
        const char* nA = has_next ? (const char*)g.A + (size_t)nxt.pm * tstep : cA; const char* nB = has_next ? (const char*)g.Bt + (size_t)nxt.pn * tstep : cB;
        for (int t = 0; t < nt; t += 2) {
            const bool last = (t == nt - 2);
            const char* a1 = cA + (size_t)(t + 1) * kstep;
            const char* a2 = last ? nA : cA + (size_t)(t + 2) * kstep; const char* b2 = last ? nB : cB + (size_t)(t + 2) * kstep;
            const char* a3 = a2 + kstep; const char* b3 = b2 + kstep;
            if (last && has_next) S.a_ready(nxt);
            PG8_LDB(B0, 0, 0); PG8_SCHED; PG8_LDA(At, 0, 0); PG8_STAGE(PG8_SA(1, 1), a1 + hstep, voffA);
            PG8_WAIT_L(8); PG8_BAR; PG8_WAIT_L(0); PG8_MMA(0, 0, At, B0); PG8_BAR; PG8_SCHED;
            PG8_LDB(B1, 0, 1); PG8_STAGE(PG8_SB(0, 0), b2, voffB);
            PG8_BAR; PG8_WAIT_L(0); PG8_MMA(0, 1, At, B1); PG8_BAR;
            PG8_LDA(At, 0, 1); PG8_STAGE(PG8_SA(0, 0), a2, voffA);
            PG8_BAR; PG8_WAIT_L(0); PG8_MMA(1, 0, At, B0); PG8_BAR; PG8_SCHED;
            PG8_STAGE(PG8_SB(0, 1), b2 + hstep, voffB);
            PG8_WAIT_V(6); PG8_BAR; PG8_MMA(1, 1, At, B1); PG8_BAR;
            PG8_LDB(B0, 1, 0); PG8_SCHED; PG8_LDA(At, 1, 0); PG8_STAGE(PG8_SA(0, 1), a2 + hstep, voffA);
            PG8_WAIT_L(8); PG8_BAR; PG8_WAIT_L(0); PG8_MMA(0, 0, At, B0); PG8_BAR; PG8_SCHED;
            PG8_LDB(B1, 1, 1); PG8_STAGE(PG8_SB(1, 0), b3, voffB);
            PG8_BAR; PG8_WAIT_L(0); PG8_MMA(0, 1, At, B1); PG8_BAR;
            PG8_LDA(At, 1, 1); PG8_STAGE(PG8_SA(1, 0), a3, voffA);
            PG8_BAR; PG8_WAIT_L(0); PG8_MMA(1, 0, At, B0); PG8_BAR; PG8_SCHED;
            PG8_STAGE(PG8_SB(1, 1), b3 + hstep, voffB);
            PG8_WAIT_V(6); PG8_BAR; PG8_MMA(1, 1, At, B1); PG8_BAR;
        }
        if constexpr (!Epi::AFTER_DRAIN) { E(acc, cur, wr, wc, fr, fq); S.done(cur); }
        if (!has_next) break;
#pragma unroll
        for (int a = 0; a < 2; ++a)
#pragma unroll
            for (int b = 0; b < 2; ++b)
#pragma unroll
                for (int m = 0; m < 4; ++m)
#pragma unroll
                    for (int n = 0; n < 2; ++n) acc[a][b][m][n] = (f32x4){0.f, 0.f, 0.f, 0.f};
        cur = nxt; cA = nA; cB = nB; ++ui;
    }
    PG8_WAIT_V(0);
    if (wr == 0) PG8_BAR;
    PG8_BAR;
    if constexpr (Epi::AFTER_DRAIN) { E.fused(acc, cur, wr, wc, fr, fq, lds, wid, lane); S.done(cur); }
#undef PG8_SA
#undef PG8_SB
#undef PG8_STAGE
#undef PG8_LDA
#undef PG8_LDB
#undef PG8_MMA
#undef PG8_WAIT_V
#undef PG8_WAIT_L
#undef PG8_BAR
#undef PG8_SCHED
}
}

struct EpiOut8 {
  static constexpr bool PERM = false, AFTER_DRAIN = false;
  const float* x; float* out; const float* mod;
  DI void operator()(const pg8::f32x4 (&acc)[2][2][4][2], const pg8::Unit& u, int wr, int wc, int fr, int fq) const {
    const int col0 = u.pn * 256 + wc * 32 + 4 * fq;
    const float* ga1 = mod + ((u.pm * 256) >> 13) * 6144 + 2048;
    float4 gv[2][2];
#pragma unroll
    for (int bj = 0; bj < 2; ++bj)
#pragma unroll
      for (int n = 0; n < 2; ++n) gv[bj][n] = *(const float4*)(ga1 + col0 + bj * 128 + n * 16);
#pragma unroll
    for (int ai = 0; ai < 2; ++ai)
#pragma unroll
      for (int m = 0; m < 4; ++m) {
        const size_t ro = (size_t)(u.pm * 256 + wr * 64 + fr + ai * 128 + m * 16) * DM + col0;
        float4 xv[2][2];
#pragma unroll
        for (int bj = 0; bj < 2; ++bj)
#pragma unroll
          for (int n = 0; n < 2; ++n) xv[bj][n] = *(const float4*)(x + ro + bj * 128 + n * 16);
#pragma unroll
        for (int bj = 0; bj < 2; ++bj)
#pragma unroll
          for (int n = 0; n < 2; ++n) {
            const pg8::f32x4 v = acc[ai][bj][m][n]; const float4 g4 = gv[bj][n], x4 = xv[bj][n];
            *(float4*)(out + ro + bj * 128 + n * 16) = make_float4(x4.x + g4.x * v[0], x4.y + g4.y * v[1], x4.z + g4.z * v[2], x4.w + g4.w * v[3]);
          }
      }
  }
};
struct EpiPQ8 {
  static constexpr bool PERM = false, AFTER_DRAIN = false;
  bf16_t* O;
  DI void operator()(const pg8::f32x4 (&acc)[2][2][4][2], const pg8::Unit& u, int wr, int wc, int fr, int fq) const {
#pragma unroll
    for (int ai = 0; ai < 2; ++ai)
#pragma unroll
      for (int m = 0; m < 4; ++m) {
        bf16_t* rowp = O + (size_t)(u.pm * 256 + wr * 64 + fr + ai * 128 + m * 16) * 2048 + u.pn * 256 + wc * 32 + 4 * fq;
#pragma unroll
        for (int bj = 0; bj < 2; ++bj)
#pragma unroll
          for (int n = 0; n < 2; ++n) { const pg8::f32x4 v = acc[ai][bj][m][n]; *(uint2*)(rowp + bj * 128 + n * 16) = pack4(v[0], v[1], v[2], v[3]); }
      }
  }
};
DI int crow(int reg, int h) { return (reg & 3) + 8 * (reg >> 2) + 4 * h; }
DI bf16x8 ld16(const bf16_t* ptr) { return *(const bf16x8*)ptr; }
DI bf16x8 ld8x2(const bf16_t* ptr) {
  uint2 a = *(const uint2*)ptr, b = *(const uint2*)(ptr + 8);
  uint4 v; v.x = a.x; v.y = a.y; v.z = b.x; v.w = b.y;
  return __builtin_bit_cast(bf16x8, v);
}
DI bf16x8 pack8(float x0, float x1, float x2, float x3, float x4, float x5, float x6, float x7) {
  uint4 v; v.x = cvt2(x0, x1); v.y = cvt2(x2, x3); v.z = cvt2(x4, x5); v.w = cvt2(x6, x7);
  return __builtin_bit_cast(bf16x8, v);
}

DI void retkv_mfma(const Params& p, int item) {
  const int lane = mytid() & 63, w = mytid() >> 6, r = lane & 31, h = lane >> 5;
  const int hh = item & 3, c = (item >> 2) & 63, b = item >> 8, bh = b * 4 + hh, s0 = c * 128;
  const int mi = w >> 1, nb = (w & 1) * 2;
  const bf16_t* vb_ = p.RVT + ((size_t)(bh * 128 + 32 * mi + r)) * SEQ + s0 + 8 * h;
  const bf16_t* k0 = p.RKT + ((size_t)(bh * 128 + 32 * nb + r)) * SEQ + s0 + 8 * h;
  const bf16_t* k1 = k0 + (size_t)32 * SEQ;
  f32x16 a0 = zero16(), a1 = zero16();
#pragma unroll
  for (int s = 0; s < 8; ++s) {
    bf16x8 a = ld16(vb_ + 16 * s), b0 = ld16(k0 + 16 * s), b1 = ld16(k1 + 16 * s);
    a0 = MFMA32(a, b0, a0); a1 = MFMA32(a, b1, a1);
  }
  float* dst = p.KV + (size_t)item * 16384;
#pragma unroll
  for (int e = 0; e < 16; ++e) {
    const int v = 32 * mi + crow(e, h);
    dst[v * 128 + 32 * nb + r] = a0[e];
    dst[v * 128 + 32 * nb + 32 + r] = a1[e];
  }
}
DI void scan_body(const Params& p, int idx) {
  const int e = idx & 16383, bh = idx >> 14, b = bh >> 2, h = bh & 3;
  const float cd = __expf(128.f * logg_h(h));
  float S = 0.f;
  for (int c0 = 0; c0 < 64; c0 += 32) {
    float kv[32];
#pragma unroll
    for (int u = 0; u < 32; ++u) kv[u] = p.KV[(size_t)((b * 64 + c0 + u) * 4 + h) * 16384 + e];
#pragma unroll
    for (int u = 0; u < 32; ++u) {
      p.SPREV[(size_t)((b * 64 + c0 + u) * 4 + h) * 16384 + e] = f2bf(S);
      S = cd * S + kv[u];
    }
  }
}
DI void retout_mfma(const Params& p, int task) {
  const int lane = mytid() & 63, r = lane & 31, h = lane >> 5;
  const int item = task >> 2, nt = task & 3;
  const int hh = item & 3, c = (item >> 2) & 63, b = item >> 8, bh = b * 4 + hh, s0 = c * 128, t0 = b * SEQ + s0;
  const float lg = logg_h(hh);
  const int n = 32 * nt + r;
  bf16x8 qf[8];
#pragma unroll
  for (int s = 0; s < 8; ++s) qf[s] = ld16(p.RQ + (size_t)(t0 + n) * 512 + hh * 128 + 16 * s + 8 * h);
  f32x16 acc[4];
#pragma unroll
  for (int vi = 0; vi < 4; ++vi) {
    acc[vi] = zero16();
    const bf16_t* sp = p.SPREV + (size_t)item * 16384 + (size_t)(32 * vi + r) * 128 + 8 * h;
#pragma unroll
    for (int s = 0; s < 8; ++s) acc[vi] = MFMA32(ld16(sp + 16 * s), qf[s], acc[vi]);
    __builtin_amdgcn_sched_barrier(0);
  }
  {
    const float xi = __expf((float)(n + 1) * lg);
#pragma unroll
    for (int vi = 0; vi < 4; ++vi)
#pragma unroll
      for (int e = 0; e < 16; ++e) acc[vi][e] *= xi;
  }
  for (int mt = 0; mt <= nt; ++mt) {
    f32x16 sa = zero16();
    const bf16_t* kp = p.RK + (size_t)(t0 + 32 * mt + r) * 512 + hh * 128 + 8 * h;
#pragma unroll
    for (int s = 0; s < 8; ++s) sa = MFMA32(ld16(kp + 16 * s), qf[s], sa);
    float pv[16];
#pragma unroll
    for (int e = 0; e < 16; ++e) {
      const int dm = n - (32 * mt + crow(e, h));
      pv[e] = (dm >= 0) ? sa[e] * __expf((float)dm * lg) : 0.f;
    }
#pragma unroll
    for (int s2 = 0; s2 < 2; ++s2) {
      bf16x8 bfr = pack8(pv[8 * s2], pv[8 * s2 + 1], pv[8 * s2 + 2], pv[8 * s2 + 3], pv[8 * s2 + 4], pv[8 * s2 + 5], pv[8 * s2 + 6], pv[8 * s2 + 7]);
#pragma unroll
      for (int vi = 0; vi < 4; ++vi) {
        bf16x8 afr = ld8x2(p.RVT + ((size_t)(bh * 128 + 32 * vi + r)) * SEQ + s0 + 32 * mt + 16 * s2 + 4 * h);
        acc[vi] = MFMA32(afr, bfr, acc[vi]);
      }
      __builtin_amdgcn_sched_barrier(0);
    }
  }
  float sum = 0.f;
#pragma unroll
  for (int vi = 0; vi < 4; ++vi)
#pragma unroll
    for (int e = 0; e < 16; ++e) sum += acc[vi][e];
  sum += __shfl_xor(sum, 32);
  const float mu = sum * (1.f / 128.f);
  float var = 0.f;
#pragma unroll
  for (int vi = 0; vi < 4; ++vi)
#pragma unroll
    for (int e = 0; e < 16; ++e) { float d = acc[vi][e] - mu; var += d * d; }
  var += __shfl_xor(var, 32);
  const float rs = rsqrtf(var * (1.f / 128.f) + 1e-6f);
#pragma unroll
  for (int vi = 0; vi < 4; ++vi)
#pragma unroll
    for (int g4 = 0; g4 < 4; ++g4) {
      const int v0 = 32 * vi + 8 * g4 + 4 * h;
      uint2 gt = *(const uint2*)(p.RGT + (size_t)(t0 + n) * 512 + hh * 128 + v0);
      float y0 = (acc[vi][4 * g4 + 0] - mu) * rs * __uint_as_float(gt.x << 16);
      float y1 = (acc[vi][4 * g4 + 1] - mu) * rs * __uint_as_float(gt.x & 0xffff0000u);
      float y2 = (acc[vi][4 * g4 + 2] - mu) * rs * __uint_as_float(gt.y << 16);
      float y3 = (acc[vi][4 * g4 + 3] - mu) * rs * __uint_as_float(gt.y & 0xffff0000u);
      *(uint2*)(p.RA + (size_t)(t0 + n) * DM + hh * 128 + v0) = pack4(y0, y1, y2, y3);
    }
}
#define HID_STRIDE 264
DI void compress_mfma(const Params& p, int item, char* smem) {
  float* PART = (float*)smem;
  bf16_t* HIDL = (bf16_t*)(smem + 4 * 16 * 256 * 4);
  const int tid = mytid(), lane = tid & 63, w = tid >> 6, r = lane & 31, h = lane >> 5;
  const int kv = item >> 7, bg = (item >> 5) & 3, rt = item & 31, n0 = rt * 16, b = bg >> 1, g = bg & 1;
  const bf16_t* src = kv ? p.NVC : p.NKC; const bf16_t* W1 = kv ? p.W1Tv : p.W1Tk; const bf16_t* W2 = kv ? p.W2Tv : p.W2Tk;
  const float* B1 = kv ? p.B1Pv : p.B1Pk;
  {
    const int kq = w >> 1, ch = w & 1;
    const int n = min(n0 + (r & 15), 510);
    const bf16_t* ab = src + ((size_t)(b * SEQ + 16 * n)) * 128 + g * 64 + 8 * h;
    const bf16_t* bb = W1 + (size_t)(128 * ch + r) * 2048 + 8 * h;
    f32x16 acc[4];
#pragma unroll
    for (int ct = 0; ct < 4; ++ct) acc[ct] = zero16();
#pragma unroll 4
    for (int s = 32 * kq; s < 32 * kq + 32; ++s) {
      const bf16x8 a = ld16(ab + (s >> 2) * 128 + (s & 3) * 16);
#pragma unroll
      for (int ct = 0; ct < 4; ++ct) acc[ct] = MFMA32(a, ld16(bb + (size_t)ct * 32 * 2048 + 16 * s), acc[ct]);
    }
#pragma unroll
    for (int ct = 0; ct < 4; ++ct)
#pragma unroll
      for (int e = 0; e < 8; ++e) PART[(kq * 16 + crow(e, h)) * 256 + 128 * ch + 32 * ct + r] = acc[ct][e];
  }
  __syncthreads();
#pragma unroll
  for (int i = 0; i < 8; ++i) {
    const int idx = tid + 512 * i, row = idx >> 8, col = idx & 255;
    const float v = PART[row * 256 + col] + PART[(16 + row) * 256 + col] + PART[(32 + row) * 256 + col] + PART[(48 + row) * 256 + col] + B1[col];
    HIDL[row * HID_STRIDE + col] = f2bf(gelu_tanh(v));
  }
  __syncthreads();
  if (w < 2) {
    f32x16 acc = zero16();
#pragma unroll
    for (int s = 0; s < 16; ++s) acc = MFMA32(ld16(HIDL + (r & 15) * HID_STRIDE + 16 * s + 8 * h), ld16(W2 + (size_t)(32 * w + r) * 256 + 16 * s + 8 * h), acc);
    const int e_ = 32 * w + r;
    if (kv == 0) {
#pragma unroll
      for (int e = 0; e < 8; ++e) { const int n = n0 + crow(e, h); p.KC[((size_t)bg * 512 + n) * 64 + e_] = (n < 511) ? f2bf(acc[e]) : (bf16_t)0; }
    } else {
#pragma unroll
      for (int g4 = 0; g4 < 2; ++g4) {
        const int n = n0 + 8 * g4 + 4 * h;
        float v3 = (n + 3 < 511) ? acc[4 * g4 + 3] : 0.f;
        *(uint2*)(p.VCT + ((size_t)bg * 64 + e_) * 512 + n) = pack4(acc[4 * g4], acc[4 * g4 + 1], acc[4 * g4 + 2], v3);
      }
    }
  }
  __syncthreads();
}
DI void kmax_body2(const Params& p, int vb) {
  const int tid = mytid(), g = tid & 1, t = vb * 256 + (tid >> 1), b = t >> 13;
  const bf16_t* k = p.NKS + (size_t)t * 128 + g * 64; const bf16_t* kw = p.NKW + (size_t)t * 128 + g * 64;
  float ss = 0.f, sw = 0.f;
  for (int d = 0; d < 64; d += 8) {
    uint4 a = *(const uint4*)(k + d), c = *(const uint4*)(kw + d);
    const unsigned aa[4] = {a.x, a.y, a.z, a.w}, cc[4] = {c.x, c.y, c.z, c.w};
#pragma unroll
    for (int q = 0; q < 4; ++q) {
      float x0 = __uint_as_float(aa[q] << 16), x1 = __uint_as_float(aa[q] & 0xffff0000u);
      float y0 = __uint_as_float(cc[q] << 16), y1 = __uint_as_float(cc[q] & 0xffff0000u);
      ss += x0 * x0 + x1 * x1; sw += y0 * y0 + y1 * y1;
    }
  }
  float m1 = sqrtf(ss), m2 = sqrtf(sw);
  for (int o = 2; o < 64; o <<= 1) { m1 = fmaxf(m1, __shfl_xor(m1, o)); m2 = fmaxf(m2, __shfl_xor(m2, o)); }
  if ((tid & 63) < 2) { atomicMax(&p.ksmax[b * 2 + g], __float_as_uint(m1)); atomicMax(&p.ksmax[4 + b * 2 + g], __float_as_uint(m2)); }
}
DI void kcmax_body(const Params& p, int idx) {
  const bf16_t* k = p.KC + (size_t)idx * 64;
  float ss = 0.f;
  for (int d = 0; d < 64; ++d) { float v = bf2f(k[d]); ss += v * v; }
  atomicMax(&p.ksmax[8 + (idx >> 9)], __float_as_uint(sqrtf(ss)));
}

#define NSA_IMP 0
#define NSA_SELM 65536
#define NSA_KV 66816
#define KV_ROW 144
#define KV_TILE (64 * KV_ROW)
template <int CTRL> DI float dpp_f2(float x) { return __builtin_bit_cast(float, __builtin_amdgcn_mov_dpp(__builtin_bit_cast(int, x), CTRL, 0xf, 0xf, true)); }
DI float quad_sum(float v) { v += dpp_f2<0xB1>(v); v += dpp_f2<0x4E>(v); return v; }
DI bf16x8 lds8x2(const char* ptr) {
  uint2 a = *(const uint2*)ptr, b = *(const uint2*)(ptr + 16);
  uint4 v; v.x = a.x; v.y = a.y; v.z = b.x; v.w = b.y;
  return __builtin_bit_cast(bf16x8, v);
}

DI void nsa_item(const Params& p, int item, char* smem) {
  const int tid = mytid(), lane = tid & 63, w = tid >> 6, r = lane & 31, h = lane >> 5;
  const int ti = item >> 2, bg = item & 3, b = bg >> 1, g = bg & 1;
  const int ts = ti * 64, tokg0 = b * SEQ + ts;
  const int tkl = 8 * w + (r >> 2), hl = r & 3, hd = g * 4 + hl, tpos = ts + tkl;
  float* IMPA = (float*)(smem + NSA_IMP); float* IMPB = IMPA + 64 * 128;
  unsigned* SELM = (unsigned*)(smem + NSA_SELM);
  char* KVB = smem + NSA_KV;
  const float ksm = __uint_as_float(p.ksmax[bg]), kwm = __uint_as_float(p.ksmax[4 + bg]), kcm = __uint_as_float(p.ksmax[8 + bg]);

  bf16x8 qf[4];
#pragma unroll
  for (int s = 0; s < 4; ++s) qf[s] = ld16(p.NQ + (size_t)(tokg0 + tkl) * 512 + hd * 64 + 16 * s + 8 * h);
  float qq = 0.f;
#pragma unroll
  for (int s = 0; s < 4; ++s) {
    uint4 u = __builtin_bit_cast(uint4, qf[s]);
    const unsigned uu[4] = {u.x, u.y, u.z, u.w};
#pragma unroll
    for (int q = 0; q < 4; ++q) { float x0 = __uint_as_float(uu[q] << 16), x1 = __uint_as_float(uu[q] & 0xffff0000u); qq += x0 * x0 + x1 * x1; }
  }
  qq += __shfl_xor(qq, 32);
  const float qn = sqrtf(qq);
  const int srow = tid >> 3, sch = tid & 7;
  const bf16_t* ksrc = p.NKS + ((size_t)(b * SEQ) + srow) * 128 + g * 64 + sch * 8;
  const bf16_t* vsrc = p.NVST + ((size_t)bg * 64 + srow) * SEQ + sch * 8;
  const bf16_t* kcs = p.KC + ((size_t)bg * 512 + srow) * 64 + sch * 8;
  const bf16_t* vcs = p.VCT + ((size_t)bg * 64 + srow) * 512 + sch * 8;
  char* sdst = KVB + srow * KV_ROW + sch * 16;
  {
    uint4 k0 = *(const uint4*)kcs, v0 = *(const uint4*)vcs;
    *(uint4*)sdst = k0; *(uint4*)(sdst + KV_TILE) = v0;
  }
  for (int q = tid; q < 64 * 128 * 2 / 4; q += NT) ((float4*)IMPA)[q] = make_float4(0.f, 0.f, 0.f, 0.f);
  __syncthreads();

#define RING_RUN(KS, KSTEP, VS, VSTEP, NTILES, NEED, COMPUTE)                                                                               \
  {                                                                                                                                         \
    for (int jj = 0; jj < (NTILES); ++jj) {                                                                                                 \
      uint4 ka_, va_;                                                                                                                       \
      ka_ = va_ = make_uint4(0u, 0u, 0u, 0u);                                                                                               \
      if (jj + 1 < (NTILES)) { ka_ = *(const uint4*)((KS) + (size_t)(jj + 1) * (KSTEP)); va_ = *(const uint4*)((VS) + (size_t)(jj + 1) * (VSTEP)); } \
      if (NEED(jj)) { const char* kb = KVB + (jj & 1) * 2 * KV_TILE; const char* vbuf = kb + KV_TILE; COMPUTE(jj, kb, vbuf) }               \
      if (jj + 1 < (NTILES)) { char* d2 = sdst + ((jj + 1) & 1) * 2 * KV_TILE; *(uint4*)d2 = ka_; *(uint4*)(d2 + KV_TILE) = va_; }          \
      __syncthreads();                                                                                                                      \
    }                                                                                                                                       \
  }
#define STAGE_PAIR0(KS, KSTEP, VS, VSTEP, NTILES) { uint4 k0_ = *(const uint4*)(KS), v0_ = *(const uint4*)(VS); *(uint4*)sdst = k0_; *(uint4*)(sdst + KV_TILE) = v0_; }
#define IMP_NONE(JJ, kh, pv)
#define ATT_TILE(kb, vbuf, INIT, FULL, MASKEXPR, SCALE, ACC, LACC, IMPHOOK, JJ)                                                             \
          {                                                                                                                                 \
            bf16x8 kf_[2][4], vf_[2][2][2];       \
            _Pragma("unroll") for (int kh = 0; kh < 2; ++kh)                                                                                \
              _Pragma("unroll") for (int s = 0; s < 4; ++s) kf_[kh][s] = *(const bf16x8*)(kb + (32 * kh + r) * KV_ROW + (16 * s + 8 * h) * 2); \
            _Pragma("unroll") for (int kh = 0; kh < 2; ++kh)                                                                                \
              _Pragma("unroll") for (int di = 0; di < 2; ++di)                                                                              \
                _Pragma("unroll") for (int s2 = 0; s2 < 2; ++s2) vf_[kh][di][s2] = lds8x2(vbuf + (32 * di + r) * KV_ROW + (32 * kh + 16 * s2 + 4 * h) * 2); \
            const bool full_ = (FULL);                                                                                                      \
            _Pragma("unroll") for (int kh = 0; kh < 2; ++kh) {                                                                              \
              f32x16 sa = fill16(INIT);                                                                                                     \
              _Pragma("unroll") for (int s = 0; s < 4; ++s) sa = MFMA32(kf_[kh][s], qf[s], sa);                                             \
              float pv[16];                                                                                                                 \
              _Pragma("unroll") for (int e = 0; e < 16; ++e) { const int key = 32 * kh + crow(e, h); pv[e] = (full_ || (MASKEXPR)) ? ex2(sa[e]) * (SCALE) : 0.f; } \
              LACC += ((pv[0] + pv[1]) + (pv[2] + pv[3])) + ((pv[4] + pv[5]) + (pv[6] + pv[7])) + ((pv[8] + pv[9]) + (pv[10] + pv[11])) + ((pv[12] + pv[13]) + (pv[14] + pv[15])); \
              IMPHOOK(JJ, kh, pv)                                                                                                           \
              const bf16x8 pk0 = pack8(pv[0], pv[1], pv[2], pv[3], pv[4], pv[5], pv[6], pv[7]);                                             \
              const bf16x8 pk1 = pack8(pv[8], pv[9], pv[10], pv[11], pv[12], pv[13], pv[14], pv[15]);                                       \
              _Pragma("unroll") for (int di = 0; di < 2; ++di) {                                                                            \
                ACC[di] = MFMA32(vf_[kh][di][0], pk0, ACC[di]);                                                                             \
                ACC[di] = MFMA32(vf_[kh][di][1], pk1, ACC[di]);                                                                             \
              }                                                                                                                             \
            }                                                                                                                               \
          }
  const float mbc = qn * kcm;
  int nvalid = (tpos >= 31) ? ((tpos - 31) >> 4) + 1 : 0;
  if (nvalid > 511) nvalid = 511;
  int nvw = (ts + 8 * w + 7 >= 31) ? ((ts + 8 * w + 7 - 31) >> 4) + 1 : 0;
  if (nvw > 511) nvw = 511;
  int nvmin = (ts + 8 * w >= 31) ? ((ts + 8 * w - 31) >> 4) + 1 : 0;
  if (nvmin > 511) nvmin = 511;
  int nvall = ((ts + 63 - 31) >> 4) + 1;
  if (nvall > 511) nvall = 511;
  const int nct = (nvall + 63) >> 6;
  float lsum = 0.f;
#define CMP_NEED(jj) (64 * (jj) < nvw)
#define CMPA_COMPUTE(jj, kb, vbuf)                                                                                                          \
          { _Pragma("unroll") for (int kh = 0; kh < 2; ++kh) {                                                                              \
              f32x16 sa = fill16(-mbc);                                                                                                     \
              _Pragma("unroll") for (int s = 0; s < 4; ++s) sa = MFMA32(*(const bf16x8*)(kb + (32 * kh + r) * KV_ROW + (16 * s + 8 * h) * 2), qf[s], sa); \
              const bool full_ = 64 * (jj) + 64 <= nvmin;                                                                                   \
              _Pragma("unroll") for (int e = 0; e < 16; ++e) lsum += (full_ || (64 * (jj) + 32 * kh + crow(e, h) < nvalid)) ? ex2(sa[e]) : 0.f; \
            } }
  RING_RUN(kcs, 64 * 64, vcs, 64, nct, CMP_NEED, CMPA_COMPUTE)
  lsum += __shfl_xor(lsum, 32);
  const float invl = (lsum > 0.f) ? 1.f / lsum : 0.f;
  f32x16 oc[2]; oc[0] = zero16(); oc[1] = zero16();
  {
    float ldummy = 0.f;
    STAGE_PAIR0(kcs, 64 * 64, vcs, 64, nct) __syncthreads();
#define CMP_IMP(JJ, kh, pv)                                                                                                                 \
              _Pragma("unroll") for (int q = 0; q < 4; ++q) {                                                                               \
                float A_ = 2.f * (pv[4 * q] + pv[4 * q + 1] + pv[4 * q + 2]) + pv[4 * q + 3], B_ = pv[4 * q + 3];                           \
                A_ = quad_sum(A_); B_ = quad_sum(B_);                                                                                       \
                if (hl == 0) { const int j_ = 16 * (JJ) + 8 * kh + 2 * q + h; IMPA[tkl * 128 + j_] = A_; IMPB[tkl * 128 + j_] = B_; }        \
              }
#define CMPB_COMPUTE(jj, kb, vbuf) ATT_TILE(kb, vbuf, -mbc, 64 * (jj) + 64 <= nvmin, 64 * (jj) + key < nvalid, invl, oc, ldummy, CMP_IMP, jj)
    RING_RUN(kcs, 64 * 64, vcs, 64, nct, CMP_NEED, CMPB_COMPUTE)
  }
  for (int rep522 = 0; rep522 < (PROBE_DUP == 522 ? 2 : 1); ++rep522)
  {
    const int tl = 8 * w + (lane >> 3), sub = lane & 7;
    unsigned kv_[16], ki_[16];
#pragma unroll
    for (int c = 0; c < 16; ++c) {
      const int j = sub + 8 * c;
      float imp = IMPA[tl * 128 + j] + ((j > 0) ? IMPB[tl * 128 + j - 1] : 0.f);
      if (j == 0 || j == ti || j == ti - 1) imp = 1e9f;
      kv_[c] = (j <= ti) ? __float_as_uint(imp) : 0u;
      ki_[c] = (j <= ti) ? (unsigned)(128 - j) : 0u;
    }
    unsigned m0 = 0, m1 = 0, m2 = 0, m3 = 0;
    for (int it = 0; it < 16; ++it) {
      unsigned bv = kv_[0], bi = ki_[0];
#pragma unroll
      for (int c = 1; c < 16; ++c) { const bool gt = (kv_[c] > bv) || (kv_[c] == bv && ki_[c] > bi); bv = gt ? kv_[c] : bv; bi = gt ? ki_[c] : bi; }
#define TOPK_STEP(CTRL) { const unsigned ov = (unsigned)__builtin_amdgcn_mov_dpp((int)bv, CTRL, 0xf, 0xf, true), oi = (unsigned)__builtin_amdgcn_mov_dpp((int)bi, CTRL, 0xf, 0xf, true); \
        const bool gt = (ov > bv) || (ov == bv && oi > bi); bv = gt ? ov : bv; bi = gt ? oi : bi; }
      TOPK_STEP(0xB1) TOPK_STEP(0x4E) TOPK_STEP(0x141)
#undef TOPK_STEP
      if (bi != 0u) {
        const int js = 128 - (int)bi;
        const unsigned bit = 1u << (js & 31);
        if ((js >> 5) == 0) m0 |= bit; else if ((js >> 5) == 1) m1 |= bit; else if ((js >> 5) == 2) m2 |= bit; else m3 |= bit;
#pragma unroll
        for (int c = 0; c < 16; ++c) { const bool hit = (ki_[c] == bi); kv_[c] = hit ? 0u : kv_[c]; ki_[c] = hit ? 0u : ki_[c]; }
      }
    }
    if (sub == 0) { SELM[tl * 4 + 0] = m0; SELM[tl * 4 + 1] = m1; SELM[tl * 4 + 2] = m2; SELM[tl * 4 + 3] = m3; }
  }
  if (lane < 4) {
    unsigned u = 0;
#pragma unroll
    for (int t8 = 0; t8 < 8; ++t8) u |= SELM[(8 * w + t8) * 4 + lane];
    SELM[(64 + w) * 4 + lane] = u;
  }
  __syncthreads();
  const float* gt = p.GATE + (size_t)(tokg0 + tkl) * 24 + hd * 3;
  float* OUTL = IMPA;
  {
    const float g0 = gt[0];
#pragma unroll
    for (int e = 0; e < 16; ++e) { OUTL[e * 512 + tid] = g0 * oc[0][e]; OUTL[(16 + e) * 512 + tid] = g0 * oc[1][e]; }
  }
  STAGE_PAIR0(ksrc, 64 * 128, vsrc, 64, ti + 1) __syncthreads();
  const float mbs = qn * ksm;
  f32x16 osl[2]; osl[0] = zero16(); osl[1] = zero16();
  float lsel = 0.f;
#define SEL_NEED(jj) ((SELM[(64 + w) * 4 + ((jj) >> 5)] >> ((jj) & 31)) & 1u)
#define SEL_COMPUTE(jj, kb, vbuf) { const unsigned msel_ = SELM[tkl * 4 + ((jj) >> 5)]; \
      const float init_ = ((msel_ >> ((jj) & 31)) & 1u) ? -mbs : NEG_INF; ATT_TILE(kb, vbuf, init_, (jj) < ti, key <= tkl, 1.f, osl, lsel, IMP_NONE, jj) }
  RING_RUN(ksrc, 64 * 128, vsrc, 64, ti + 1, SEL_NEED, SEL_COMPUTE)
  lsel += __shfl_xor(lsel, 32);
  {
    const float g1 = gt[1] / lsel;
#pragma unroll
    for (int e = 0; e < 16; ++e) { OUTL[e * 512 + tid] += g1 * osl[0][e]; OUTL[(16 + e) * 512 + tid] += g1 * osl[1][e]; }
  }
  f32x16 ow[2]; ow[0] = zero16(); ow[1] = zero16();
  float lw = 0.f;
  const float mbw = qn * kwm;
  {
    const int j0w = (ti >= 8) ? ti - 8 : 0, nwt = ti - j0w + 1;
    const bf16_t* kws = p.NKW + ((size_t)(b * SEQ + 64 * j0w) + srow) * 128 + g * 64 + sch * 8;
    const bf16_t* vws = p.NVWT + ((size_t)bg * 64 + srow) * SEQ + 64 * j0w + sch * 8;
    STAGE_PAIR0(kws, 64 * 128, vws, 64, nwt) __syncthreads();
#define WIN_NEED(jj) true
#define WIN_COMPUTE(jj, kb, vbuf) { const int jw_ = j0w + (jj); const bool last_ = (jw_ == ti), first_ = (ti >= 8) && ((jj) == 0); \
      ATT_TILE(kb, vbuf, -mbw, !(last_ || first_), last_ ? (key <= tkl) : (key > tkl), 1.f, ow, lw, IMP_NONE, jj) }
    RING_RUN(kws, 64 * 128, vws, 64, nwt, WIN_NEED, WIN_COMPUTE)
  }
  lw += __shfl_xor(lw, 32);
  {
    const float g2 = gt[2] / lw;
#pragma unroll
    for (int di = 0; di < 2; ++di)
#pragma unroll
      for (int g4 = 0; g4 < 4; ++g4) {
        const int d0 = 32 * di + 8 * g4 + 4 * h;
        float y[4];
#pragma unroll
        for (int e = 0; e < 4; ++e) y[e] = OUTL[(16 * di + 4 * g4 + e) * 512 + tid] + g2 * ow[di][4 * g4 + e];
        *(uint2*)(p.RA + (size_t)(tokg0 + tkl) * DM + 512 + hd * 64 + d0) = pack4(y[0], y[1], y[2], y[3]);
      }
  }
  __syncthreads();
}

typedef float f32x4 __attribute__((ext_vector_type(4)));
#define MFMA16(a, b, c) __builtin_amdgcn_mfma_f32_16x16x32_bf16((a), (b), (c), 0, 0, 0)
constexpr int pk_clen(int i) { return 16 / (i + 1); }
constexpr int pk_coff(int i) { int s = 0; for (int q = 0; q < i; ++q) s += pk_clen(q); return s; }
constexpr int pk_cand(int c) {
  int i = 0; while (i < 16 && c >= pk_clen(i)) { c -= pk_clen(i); ++i; }
  return (i < 16) ? i * 16 + c : 256;
}
#define SC_STRIDE 132

DI void convert_row(const Params& p, int row, int lane);
DI unsigned f2key(float x, unsigned tag, unsigned tagmask) {
  const unsigned bits = __float_as_uint(x), m = (unsigned)((int)bits >> 31) | 0x80000000u;
  return ((bits ^ m) & ~tagmask) | tag;
}
DI float key2f(unsigned k, unsigned tagmask) {
  const unsigned u = k & ~tagmask;
  return __uint_as_float((u & 0x80000000u) ? (u ^ 0x80000000u) : ~u);
}
DI void peer_topk_tile(const Params& p, int vb, char* smem) {
  unsigned* SC = (unsigned*)smem;
  unsigned* ELK = (unsigned*)(smem + 256 * SC_STRIDE * 4);
  float* ELW = (float*)(ELK + 16 * 128);
  int* CT = (int*)(ELW + 16 * 128);
  const int tid = mytid(), lane = tid & 63, w = tid >> 6;
  const int t0 = vb * 16;
  if (tid < 64) { int i = 0, c = tid; while (i < 16 && c >= 16 / (i + 1)) { c -= 16 / (i + 1); ++i; } CT[tid] = (i < 16) ? i * 16 + c : 0; }
  for (int rep91 = 0; rep91 < (PROBE_DUP == 91 ? 2 : 1); ++rep91) {
    const int tq = lane & 15, kq = lane >> 4;
#pragma unroll
    for (int pi = 0; pi < 2; ++pi) {
      const int ph = 2 * w + pi;
      bf16x8 bfr[4];
#pragma unroll
      for (int s = 0; s < 4; ++s) bfr[s] = *(const bf16x8*)(p.PQ + (size_t)(t0 + tq) * 2048 + ph * 128 + 32 * s + 8 * kq);
#pragma unroll
      for (int j = 0; j < 8; ++j) {
        f32x4 acc = {0.f, 0.f, 0.f, 0.f};
#pragma unroll
        for (int s = 0; s < 4; ++s) {
          bf16x8 afr = *(const bf16x8*)(p.SUBK + ((size_t)(ph * 128 + 16 * j + tq)) * 128 + 32 * s + 8 * kq);
          acc = MFMA16(afr, bfr[s], acc);
        }
        const int n0 = 16 * j + 4 * kq;
        uint4 kv4;
        kv4.x = f2key(acc[0], 127u - n0, 127u); kv4.y = f2key(acc[1], 126u - n0, 127u); kv4.z = f2key(acc[2], 125u - n0, 127u); kv4.w = f2key(acc[3], 124u - n0, 127u);
        *(uint4*)(SC + (ph * 16 + tq) * SC_STRIDE + n0) = kv4;
      }
    }
  }
  __syncthreads();
  if (tid < 256) {
    unsigned* row = SC + tid * SC_STRIDE;
    unsigned gmax[16];
#pragma unroll
    for (int g = 0; g < 16; ++g) {
      uint4 a = *(uint4*)(row + g * 8), b = *(uint4*)(row + g * 8 + 4);
      gmax[g] = max(max(max(a.x, a.y), max(a.z, a.w)), max(max(b.x, b.y), max(b.z, b.w)));
    }
    unsigned outk[16];
#pragma unroll
    for (int k = 0; k < 16; ++k) {
      unsigned m = max(max(max(max(gmax[0], gmax[1]), max(gmax[2], gmax[3])), max(max(gmax[4], gmax[5]), max(gmax[6], gmax[7]))),
                       max(max(max(gmax[8], gmax[9]), max(gmax[10], gmax[11])), max(max(gmax[12], gmax[13]), max(gmax[14], gmax[15]))));
      const int n = 127 - (int)(m & 127u), gi = n >> 3;
      unsigned* gp = row + gi * 8;
      uint4 a = *(uint4*)gp, b = *(uint4*)(gp + 4);
      const unsigned v[8] = {a.x, a.y, a.z, a.w, b.x, b.y, b.z, b.w};
      unsigned nm = 0u;
#pragma unroll
      for (int e = 0; e < 8; ++e) nm = max(nm, (v[e] == m) ? 0u : v[e]);
      row[n] = 0u;
#pragma unroll
      for (int g = 0; g < 16; ++g) gmax[g] = (g == gi) ? nm : gmax[g];
      outk[k] = m;
    }
#pragma unroll
    for (int k = 0; k < 16; ++k) row[k] = outk[k];
  } else {
#pragma unroll 4
    for (int i = 0; i < 8; ++i) convert_row(p, (vb * 4 + (w - 4)) * 8 + i, lane);
  }
  __syncthreads();
  for (int rep93 = 0; rep93 < (PROBE_DUP == 93 ? 2 : 1); ++rep93) {
    const int q = tid >> 2, sub = tid & 3, t = q >> 3, pp = q & 7;
    const unsigned* ra = SC + ((2 * pp) * 16 + t) * SC_STRIDE;
    const unsigned* rb = SC + ((2 * pp + 1) * 16 + t) * SC_STRIDE;
    unsigned ck[13];
#pragma unroll
    for (int k = 0; k < 13; ++k) {
      const int ij = (sub == 0) ? pk_cand(4 * k) : (sub == 1) ? pk_cand(4 * k + 1) : (sub == 2) ? pk_cand(4 * k + 2) : pk_cand(4 * k + 3);
      const int ord = 4 * k + sub;
      ck[k] = (ij < 256) ? f2key(key2f(ra[ij >> 4], 127u) + key2f(rb[ij & 15], 127u), (unsigned)(63 - ord), 63u) : 0u;
    }
    unsigned w16[16];
#pragma unroll
    for (int k = 0; k < 16; ++k) {
      unsigned bm = max(max(max(max(ck[0], ck[1]), max(ck[2], ck[3])), max(max(ck[4], ck[5]), max(ck[6], ck[7]))), max(max(max(ck[8], ck[9]), max(ck[10], ck[11])), ck[12]));
      bm = max(bm, (unsigned)__builtin_amdgcn_mov_dpp((int)bm, 0xB1, 0xf, 0xf, true));
      bm = max(bm, (unsigned)__builtin_amdgcn_mov_dpp((int)bm, 0x4E, 0xf, 0xf, true));
#pragma unroll
      for (int c = 0; c < 13; ++c) ck[c] = (ck[c] == bm) ? 0u : ck[c];
      w16[k] = bm;
    }
    float l = 0.f; const float vmax = key2f(w16[0], 63u);
    float ev[16];
#pragma unroll
    for (int k = 0; k < 16; ++k) { ev[k] = __expf(key2f(w16[k], 63u) - vmax); l += ev[k]; }
    const float inv = 1.f / l;
#pragma unroll
    for (int k = 0; k < 16; ++k)
      if ((k & 3) == sub) {
        const int ij = CT[63 - (int)(w16[k] & 63u)];
        const int code = (127 - (int)(ra[ij >> 4] & 127u)) * 128 + (127 - (int)(rb[ij & 15] & 127u));
        ELK[t * 128 + pp * 16 + k] = ((unsigned)code << 7) | (unsigned)(pp * 16 + k);
        ELW[t * 128 + pp * 16 + k] = ev[k] * inv;
      }
  }
  __syncthreads();
  for (int rep94 = 0; rep94 < (PROBE_DUP == 94 ? 2 : 1); ++rep94)
#pragma unroll
  for (int tt = 0; tt < 2; ++tt) {
    const int t = 2 * w + tt;
    const unsigned e0 = ELK[t * 128 + 2 * lane], e1 = ELK[t * 128 + 2 * lane + 1];
    int r0 = 0, r1 = 0;
#pragma unroll 8
    for (int c = 0; c < 32; ++c) {
      const uint4 kq = *(const uint4*)(ELK + t * 128 + 4 * c);
      r0 += (kq.x < e0) + (kq.y < e0) + (kq.z < e0) + (kq.w < e0);
      r1 += (kq.x < e1) + (kq.y < e1) + (kq.z < e1) + (kq.w < e1);
    }
    const size_t gb = (size_t)(t0 + t) * 128;
    p.EIDX[gb + r0] = (int)(e0 >> 7); p.EIDX[gb + r1] = (int)(e1 >> 7);
    p.EW[gb + r0] = ELW[t * 128 + (e0 & 127)]; p.EW[gb + r1] = ELW[t * 128 + (e1 & 127)];
  }
  __syncthreads();
}

DI float dot2bf(unsigned a, unsigned b, float acc) { return __builtin_amdgcn_fdot2_f32_bf16(__builtin_bit_cast(bf16x2_t, a), __builtin_bit_cast(bf16x2_t, b), acc, false); }
template <int CTRL> DI float dpp_f(float x) { return __builtin_bit_cast(float, __builtin_amdgcn_mov_dpp(__builtin_bit_cast(int, x), CTRL, 0xf, 0xf, true)); }
DI float row16_sum(float v) { v += dpp_f<0x128>(v); v += dpp_f<0x124>(v); v += dpp_f<0x122>(v); v += dpp_f<0x121>(v); return v; }
DI float dot_row(const uint4 (&u)[8], const uint4 (&h)[8]) {
  float d = 0.f;
#pragma unroll
  for (int j = 0; j < 8; ++j) { d = dot2bf(u[j].x, h[j].x, d); d = dot2bf(u[j].y, h[j].y, d); d = dot2bf(u[j].z, h[j].z, d); d = dot2bf(u[j].w, h[j].w, d); }
  return row16_sum(d);
}
DI void axpy_row(float (&acc)[64], const uint4 (&v)[8], float c) {
#pragma unroll
  for (int j = 0; j < 8; ++j) {
    const unsigned ww[4] = {v[j].x, v[j].y, v[j].z, v[j].w};
#pragma unroll
    for (int q = 0; q < 4; ++q) {
      acc[j * 8 + 2 * q] += c * __uint_as_float(ww[q] << 16);
      acc[j * 8 + 2 * q + 1] += c * __uint_as_float(ww[q] & 0xffff0000u);
    }
  }
}
DI void axpy_half(float (&acc)[32], const uint4 (&v)[4], float c) {
#pragma unroll
  for (int j = 0; j < 4; ++j) {
    const unsigned ww[4] = {v[j].x, v[j].y, v[j].z, v[j].w};
#pragma unroll
    for (int q = 0; q < 4; ++q) {
      acc[j * 8 + 2 * q] += c * __uint_as_float(ww[q] << 16);
      acc[j * 8 + 2 * q + 1] += c * __uint_as_float(ww[q] & 0xffff0000u);
    }
  }
}
#ifndef PEER_TILE_SHIFT
#define PEER_TILE_SHIFT 8
#endif
DI void fma16_fp8(float& d, const uint4& u, const float* hv) {
  const unsigned ww[4] = {u.x, u.y, u.z, u.w};
#pragma unroll
  for (int q = 0; q < 4; ++q) {
    f32x2_t a = __builtin_amdgcn_cvt_pk_f32_fp8((int)ww[q], false), b = __builtin_amdgcn_cvt_pk_f32_fp8((int)ww[q], true);
    d += a[0] * hv[4 * q] + a[1] * hv[4 * q + 1] + b[0] * hv[4 * q + 2] + b[1] * hv[4 * q + 3];
  }
}
DI float dot_row8(const uint4 (&u)[4], const float (&hv)[64]) {
  float d0 = 0.f, d1 = 0.f;
  fma16_fp8(d0, u[0], hv); fma16_fp8(d1, u[1], hv + 16); fma16_fp8(d0, u[2], hv + 32); fma16_fp8(d1, u[3], hv + 48);
  return row16_sum(d0 + d1);
}
DI void axpy_row8(float (&acc)[64], const uint4 (&v)[4], float c) {
#pragma unroll
  for (int j = 0; j < 4; ++j) {
    const unsigned ww[4] = {v[j].x, v[j].y, v[j].z, v[j].w};
#pragma unroll
    for (int q = 0; q < 4; ++q) {
      f32x2_t a = __builtin_amdgcn_cvt_pk_f32_fp8((int)ww[q], false), b = __builtin_amdgcn_cvt_pk_f32_fp8((int)ww[q], true);
      acc[j * 16 + 4 * q] += c * a[0]; acc[j * 16 + 4 * q + 1] += c * a[1]; acc[j * 16 + 4 * q + 2] += c * b[0]; acc[j * 16 + 4 * q + 3] += c * b[1];
    }
  }
}
DI void peer_gather_block(const Params& p, int vb, char* smem) {
  unsigned* ELK = (unsigned*)smem;
  float* ELC = (float*)(smem + 32768);
  const int tid = mytid(), lane = tid & 63, w = tid >> 6, grp = lane >> 4, i = lane & 15;
  const int tokbase = vb * 64;
  for (int q = tid; q < 64 * 128 / 4; q += NT) {
    ((uint4*)ELK)[q] = ((const uint4*)(p.EIDX + (size_t)tokbase * 128))[q];
    ((float4*)ELC)[q] = ((const float4*)(p.EW + (size_t)tokbase * 128))[q];
  }
  __syncthreads();
#pragma unroll 1
  for (int tt = 0; tt < 2; ++tt) {
    const int tl = w * 8 + grp * 2 + tt, tok = tokbase + tl;
    const unsigned* kk = ELK + tl * 128;
    float* cc = ELC + tl * 128;
    uint4 b0[4], b1[4], b2[4], b3[4];
#define ROW_LOAD(BUF, BASE, E) { const unsigned e_ = kk[E]; _Pragma("unroll") for (int j = 0; j < 4; ++j) BUF[j] = *(const uint4*)(BASE + (size_t)e_ * DM + j * 256); }
    {
      float hv[64];
#pragma unroll
      for (int j = 0; j < 4; ++j)
#pragma unroll
        for (int hf = 0; hf < 2; ++hf) {
          uint4 a = *(const uint4*)(p.RA + (size_t)tok * DM + j * 256 + i * 16 + hf * 8);
          const unsigned aa[4] = {a.x, a.y, a.z, a.w};
#pragma unroll
          for (int q = 0; q < 4; ++q) { hv[j * 16 + hf * 8 + 2 * q] = __uint_as_float(aa[q] << 16); hv[j * 16 + hf * 8 + 2 * q + 1] = __uint_as_float(aa[q] & 0xffff0000u); }
        }
      const unsigned char* ub_ = p.PDN8 + i * 16;
#define DN_COMP(BUF, E) { const unsigned e_ = kk[E]; float d_ = dot_row8(BUF, hv) * p.SDN[e_]; float c_ = cc[E] * gelu_tanh(d_) * p.SUP[e_]; if (i == 0) cc[E] = c_; }
      ROW_LOAD(b0, ub_, 0) ROW_LOAD(b1, ub_, 1) ROW_LOAD(b2, ub_, 2) ROW_LOAD(b3, ub_, 3)
      for (int e = 0; e < 128; e += 4) {
        DN_COMP(b0, e)     if (e + 4 < 128) ROW_LOAD(b0, ub_, e + 4)
        DN_COMP(b1, e + 1) if (e + 4 < 128) ROW_LOAD(b1, ub_, e + 5)
        DN_COMP(b2, e + 2) if (e + 4 < 128) ROW_LOAD(b2, ub_, e + 6)
        DN_COMP(b3, e + 3) if (e + 4 < 128) ROW_LOAD(b3, ub_, e + 7)
      }
#undef DN_COMP
    }
    {
      float acc[64];
#pragma unroll
      for (int e = 0; e < 64; ++e) acc[e] = 0.f;
      const unsigned char* vbase = p.PUP8 + i * 16;
      ROW_LOAD(b0, vbase, 0) ROW_LOAD(b1, vbase, 1) ROW_LOAD(b2, vbase, 2) ROW_LOAD(b3, vbase, 3)
      for (int e = 0; e < 128; e += 4) {
        axpy_row8(acc, b0, cc[e]);     if (e + 4 < 128) ROW_LOAD(b0, vbase, e + 4)
        axpy_row8(acc, b1, cc[e + 1]); if (e + 4 < 128) ROW_LOAD(b1, vbase, e + 5)
        axpy_row8(acc, b2, cc[e + 2]); if (e + 4 < 128) ROW_LOAD(b2, vbase, e + 6)
        axpy_row8(acc, b3, cc[e + 3]); if (e + 4 < 128) ROW_LOAD(b3, vbase, e + 7)
      }
      const int b = tok >> 13;
      const float* ga2 = p.mod + b * 6144 + 5120;
      const float* orow = p.out + (size_t)tok * DM; float* grow = p.gout + (size_t)tok * DM;
      float ss = 0.f;
#pragma unroll
      for (int j = 0; j < 4; ++j)
#pragma unroll
        for (int q4 = 0; q4 < 4; ++q4) {
          const int col = j * 256 + i * 16 + q4 * 4;
          float4 x1 = *(const float4*)(orow + col), gg = *(const float4*)(ga2 + col);
          float* q = acc + j * 16 + q4 * 4;
          q[0] = x1.x + gg.x * q[0]; q[1] = x1.y + gg.y * q[1]; q[2] = x1.z + gg.z * q[2]; q[3] = x1.w + gg.w * q[3];
          ss += q[0] * q[0] + q[1] * q[1] + q[2] * q[2] + q[3] * q[3];
        }
      ss = row16_sum(ss);
      const float rstd = rsqrtf(ss * (1.f / DM) + 1e-6f);
#pragma unroll
      for (int j = 0; j < 4; ++j)
#pragma unroll
        for (int q4 = 0; q4 < 4; ++q4) {
          const int col = j * 256 + i * 16 + q4 * 4;
          float4 gf = *(const float4*)(p.g_final + col);
          const float* q = acc + j * 16 + q4 * 4;
          *(float4*)(grow + col) = make_float4(q[0] * rstd * gf.x, q[1] * rstd * gf.y, q[2] * rstd * gf.z, q[3] * rstd * gf.w);
        }
    }
#undef ROW_LOAD
  }
  __syncthreads();
}
DI void convert_row(const Params& p, int row, int lane) {
  const int tb = row >> 14, rr = row & 16383;
  const float* src = (tb ? p.peer_up : p.peer_down) + (size_t)rr * DM;
  float4 x[4]; float am = 0.f;
#pragma unroll
  for (int q = 0; q < 4; ++q) {
    x[q] = *(const float4*)(src + q * 256 + lane * 4);
    am = fmaxf(am, fmaxf(fmaxf(fabsf(x[q].x), fabsf(x[q].y)), fmaxf(fabsf(x[q].z), fabsf(x[q].w))));
  }
  for (int o = 32; o; o >>= 1) am = fmaxf(am, __shfl_xor(am, o));
  const float sc = (am > 0.f) ? am * (1.f / 448.f) : 1.f, inv = (am > 0.f) ? 448.f / am : 1.f;
  unsigned* dst = (unsigned*)((tb ? p.PUP8 : p.PDN8) + (size_t)rr * DM);
#pragma unroll
  for (int q = 0; q < 4; ++q) {
    int wd = 0;
    wd = __builtin_amdgcn_cvt_pk_fp8_f32(x[q].x * inv, x[q].y * inv, wd, false);
    wd = __builtin_amdgcn_cvt_pk_fp8_f32(x[q].z * inv, x[q].w * inv, wd, true);
    dst[q * 64 + lane] = (unsigned)wd;
  }
  if (lane == 0) (tb ? p.SUP : p.SDN)[rr] = sc;
}

#define N_PHASES 11
template <int PH>
DI void run_phase(const Params& p, char* smem) {
  const int nb = gridDim.x, bid = blockIdx.x, tid = mytid();
  if (PH == 0) {
    for (int vb = bid; vb < PH0_MOD; vb += nb) ph0_body(p, vb, smem);
  } else if (PH == 1) {
    constexpr int kPrepA = (PH0_WIN - PH0_MOD) + (PH0_ROPE - PH0_SUBK);
    for (int vb = bid; vb < T_TOK / 8 + kPrepA; vb += nb) {
      if (vb < T_TOK / 8) rownorm_body(p.x, p.g_mix, p.mod, 0, 1024, p.RA, vb);
      else { const int j = vb - T_TOK / 8; ph0_body(p, (j < PH0_WIN - PH0_MOD) ? PH0_MOD + j : PH0_SUBK + (j - (PH0_WIN - PH0_MOD)), smem); }
    }
  } else if (PH == 2) {
    EpiProj e{p};
    for (int vb = bid; vb < 64 * 14; vb += nb) gemm_tile(p.RA, p.WinT, 1024, (vb & 63) * 256, (vb >> 6) * 256, smem, e);
    {
      constexpr int kPrepB = (PH0_SUBK - PH0_WIN) + (PH0_B1P - PH0_ROPE);
      const int rem = (64 * 14) % nb;
      if (rem == 0 || bid >= rem) {
        for (int j = (rem == 0) ? bid : bid - rem; j < kPrepB; j += (rem == 0) ? nb : nb - rem)
          ph0_body(p, (j < PH0_SUBK - PH0_WIN) ? PH0_WIN + j : PH0_ROPE + (j - (PH0_SUBK - PH0_WIN)), smem);
      }
    }
  } else if (PH == 3) {
    for (int vb = bid; vb < 256 + 512 + 64; vb += nb) {
      if (vb < 256) compress_mfma(p, vb, smem);
      else if (vb < 256 + 512) retkv_mfma(p, vb - 256);
      else kmax_body2(p, vb - 768);
    }
  } else if (PH == 4) {
    for (int vb = bid; vb < 256 + 4; vb += nb) {
      if (vb < 256) scan_body(p, vb * NT + tid);
      else kcmax_body(p, (vb - 256) * NT + tid);
    }
  } else if (PH == 5) {
    for (int rep = 0; rep < (PROBE_DUP == 51 ? 2 : 1); ++rep)
      for (int vb = bid; vb < 256; vb += nb) retout_mfma(p, vb * 8 + (tid >> 6));
    for (int rep = 0; rep < (PROBE_DUP == 52 ? 2 : 1); ++rep)
      for (int vb = bid; vb < 512; vb += nb) nsa_item(p, (vb < 256) ? vb : 767 - vb, smem);
  } else if (PH == 6) {
    pg8::StaticOrder S; S.init(T_TOK, 1024, nb, bid);
    const pg8::Gemm g{p.RA, p.WoutT, T_TOK, 1024, 1024};
    pg8::gemm_phase((PG8_LAS unsigned char*)smem, g, S, EpiOut8{p.x, p.out, p.mod});
  } else if (PH == 7) {
    for (int vb = bid; vb < T_TOK / 8; vb += nb) rownorm_body(p.out, p.g_ffn, p.mod, 3072, 4096, p.RA, vb);
  } else if (PH == 8) {
    pg8::StaticOrder S; S.init(T_TOK, 2048, nb, bid);
    const pg8::Gemm g{p.RA, p.WqT, T_TOK, 2048, 1024};
    pg8::gemm_phase((PG8_LAS unsigned char*)smem, g, S, EpiPQ8{p.PQ});
  } else if (PH == 9) {
    for (int vb = bid; vb < T_TOK / 16; vb += nb) peer_topk_tile(p, vb, smem);
  } else if (PH == 10) {
    for (int vb = bid; vb < T_TOK / 64; vb += nb) peer_gather_block(p, vb, smem);
  }
}


#define XB_TMO      128
#define XB_XCNT(j)  (256  + 64 * (j))
#define XB_XSUB(j)  (1280 + 64 * (j))
#define XB_XGEN(j)  (2304 + 64 * (j))
#define XB_TOP      3328
#define XB_TOPGEN   3392
#define XCD_BAR_WORDS 3456
#define XB_SPIN_CAP (1u << 22)
#define LAS __attribute__((address_space(3)))
DI unsigned xb_ld(unsigned* p) { return __hip_atomic_load(p, __ATOMIC_RELAXED, __HIP_MEMORY_SCOPE_AGENT); }
DI unsigned xb_add(unsigned* p, unsigned v) { return __hip_atomic_fetch_add(p, v, __ATOMIC_RELAXED, __HIP_MEMORY_SCOPE_AGENT); }
DI unsigned xb_xcc_id() { return (unsigned)__builtin_amdgcn_s_getreg((3 << 11) | 20) & 0xFu; }
#define XB_SPIN(cond, bar) do { unsigned _sp = 0; while (cond) { __builtin_amdgcn_s_sleep(1); \
    if ((++_sp & 255u) == 0u) { if (xb_ld(&(bar)[XB_TMO])) break; if (_sp > XB_SPIN_CAP) { atomicAdd(&(bar)[XB_TMO], 1u); break; } } } } while (0)
struct XcdBarrier { unsigned* bar; unsigned x; volatile LAS unsigned* st; };
DI XcdBarrier xcd_barrier_post(unsigned* bar, volatile LAS unsigned* st) {
  XcdBarrier b; b.bar = bar; b.x = xb_xcc_id(); b.st = st;
  if (threadIdx.x == 0) (void)xb_add(&bar[XB_XCNT(b.x)], 1u);
  return b;
}
DI void xcd_barrier_complete(unsigned* bar, unsigned x, unsigned& nloc, unsigned& nx) {
  const unsigned G = gridDim.x * gridDim.y * gridDim.z;
  unsigned sum, cnt, mine, sp = 0u;
  for (;;) {
    sum = 0u; cnt = 0u; mine = 0u;
#pragma unroll
    for (unsigned j = 0; j < 16; ++j) { const unsigned c = xb_ld(&bar[XB_XCNT(j)]); sum += c; cnt += (c > 0u) ? 1u : 0u; mine = (j == x) ? c : mine; }
    if (sum == G) break;
    __builtin_amdgcn_s_sleep(1);
    if ((++sp & 255u) == 0u) { if (xb_ld(&bar[XB_TMO])) break; if (sp > XB_SPIN_CAP) { atomicAdd(&bar[XB_TMO], 1u); break; } }
  }
  nloc = mine > 0u ? mine : 1u; nx = cnt > 0u ? cnt : 1u;
}
DI void xcd_barrier(const XcdBarrier& b) {
  asm volatile("s_waitcnt vmcnt(0)" ::: "memory");
  __syncthreads();
  if (threadIdx.x == 0) {
    unsigned* bar = b.bar;
    __builtin_amdgcn_s_waitcnt(0);
    unsigned nloc = b.st[0], nx = b.st[1];
    if (nloc == 0u) { xcd_barrier_complete(bar, b.x, nloc, nx); b.st[0] = nloc; b.st[1] = nx; }
    const unsigned old = xb_add(&bar[XB_XSUB(b.x)], 1u);
    const unsigned gen = old / nloc;
    if (old + 1u == (gen + 1u) * nloc) {
      __builtin_amdgcn_fence(__ATOMIC_RELEASE, "agent");
      asm volatile("s_waitcnt vmcnt(0)" ::: "memory");
      const unsigned og = xb_add(&bar[XB_TOP], 1u);
      const unsigned tg = og / nx;
      if (og + 1u == (tg + 1u) * nx) xb_add(&bar[XB_TOPGEN], 1u);
      else XB_SPIN(xb_ld(&bar[XB_TOPGEN]) == tg, bar);
      __builtin_amdgcn_fence(__ATOMIC_ACQUIRE, "agent");
      xb_add(&bar[XB_XGEN(b.x)], 1u);
      asm volatile("s_waitcnt vmcnt(0)" ::: "memory");
    } else {
      XB_SPIN(xb_ld(&bar[XB_XGEN(b.x)]) == gen, bar);
      __builtin_amdgcn_fence(__ATOMIC_ACQUIRE, "agent");
      asm volatile("s_waitcnt vmcnt(0)" ::: "memory");
    }
  }
  __syncthreads();
}

#define SMEM_BYTES 155648

template <int PH>
DI void phase_and_probe(const Params& p, char* smem, cg::grid_group& grid) {
  const int reps = (PROBE_DUP == PH) ? 2 : 1;
  for (int rep = 0; rep < reps; ++rep) {
    if (PH == 10 && rep + 1 < reps) { Params q = p; q.gout = (float*)p.PQ; run_phase<PH>(q, smem); }
    else run_phase<PH>(p, smem);
    if (rep + 1 < reps) grid.sync();
  }
}
__global__ void __launch_bounds__(NT) k_mega(Params p) {
  extern __shared__ __attribute__((aligned(16))) char smem[];
  __shared__ uint4 xb_words;
  cg::grid_group grid = cg::this_grid();
  if (threadIdx.x == 0) xb_words = make_uint4(0u, 0u, 0u, 0u);
  __syncthreads();
  XcdBarrier xb = xcd_barrier_post(p.xbar, (volatile LAS unsigned*)&xb_words);
  phase_and_probe<0>(p, smem, grid); grid.sync();
  phase_and_probe<1>(p, smem, grid); xcd_barrier(xb);
  phase_and_probe<2>(p, smem, grid); xcd_barrier(xb);
  phase_and_probe<3>(p, smem, grid); xcd_barrier(xb);
  phase_and_probe<4>(p, smem, grid); xcd_barrier(xb);
  phase_and_probe<5>(p, smem, grid); xcd_barrier(xb);
  phase_and_probe<6>(p, smem, grid); xcd_barrier(xb);
  phase_and_probe<7>(p, smem, grid); xcd_barrier(xb);
  phase_and_probe<8>(p, smem, grid); xcd_barrier(xb);
  phase_and_probe<9>(p, smem, grid); xcd_barrier(xb);
  phase_and_probe<10>(p, smem, grid);
}
#ifdef MK_MULTI
template <int PH>
__global__ void __launch_bounds__(NT) k_single(Params p) {
  extern __shared__ __attribute__((aligned(16))) char smem[];
  run_phase<PH>(p, smem);
}
#endif

static size_t carve(size_t& off, size_t bytes) { size_t o = off; off += (bytes + 255) & ~(size_t)255; return o; }

extern "C" void kernel_launch(void* const* d_in, const int* in_sizes, int n_in, void* d_out, int out_size, void* d_ws, size_t ws_size,
                              hipStream_t stream) {
  Params p{};
  p.x = (const float*)d_in[0]; p.c = (const float*)d_in[1]; p.w_ada = (const float*)d_in[2]; p.b_ada = (const float*)d_in[3];
  p.g_mix = (const float*)d_in[4]; p.w_in = (const float*)d_in[5]; p.pe_k = (const float*)d_in[6]; p.pe_v = (const float*)d_in[7];
  p.w_k1 = (const float*)d_in[8]; p.b_k1 = (const float*)d_in[9]; p.w_k2 = (const float*)d_in[10]; p.w_v1 = (const float*)d_in[11];
  p.b_v1 = (const float*)d_in[12]; p.w_v2 = (const float*)d_in[13]; p.w_out = (const float*)d_in[14]; p.g_ffn = (const float*)d_in[15];
  p.w_pq = (const float*)d_in[16]; p.subkeys = (const float*)d_in[17]; p.peer_down = (const float*)d_in[18]; p.peer_up = (const float*)d_in[19];
  p.g_final = (const float*)d_in[20];
  p.out = (float*)d_out; p.gout = p.out;
  char* ws = (char*)d_ws;
  size_t off = 0;
  p.mod = (float*)(ws + carve(off, 2 * 6144 * 4));
  p.ksmax = (unsigned*)(ws + carve(off, 256));
  p.xbar = (unsigned*)(ws + carve(off, XCD_BAR_WORDS * 4));
  p.c128 = (float*)(ws + carve(off, (size_t)SEQ * 64 * 4)); p.s128 = (float*)(ws + carve(off, (size_t)SEQ * 64 * 4));
  p.c64 = (float*)(ws + carve(off, (size_t)SEQ * 32 * 4)); p.s64 = (float*)(ws + carve(off, (size_t)SEQ * 32 * 4));
  p.WinT = (bf16_t*)(ws + carve(off, (size_t)NPROJ * 1024 * 2));
  p.WoutT = (bf16_t*)(ws + carve(off, (size_t)1024 * 1024 * 2));
  p.WqT = (bf16_t*)(ws + carve(off, (size_t)2048 * 1024 * 2));
  p.W1Tk = (bf16_t*)(ws + carve(off, (size_t)256 * 2048 * 2)); p.W1Tv = (bf16_t*)(ws + carve(off, (size_t)256 * 2048 * 2));
  p.W2Tk = (bf16_t*)(ws + carve(off, 64 * 256 * 2)); p.W2Tv = (bf16_t*)(ws + carve(off, 64 * 256 * 2));
  p.SUBK = (bf16_t*)(ws + carve(off, (size_t)16 * 128 * 128 * 2));
  p.B1Pk = (float*)(ws + carve(off, 1024)); p.B1Pv = (float*)(ws + carve(off, 1024));
  p.RA = (bf16_t*)(ws + carve(off, (size_t)T_TOK * 1024 * 2));
  size_t rb = off;
  p.RQ = (bf16_t*)(ws + carve(off, (size_t)T_TOK * 512 * 2)); p.RK = (bf16_t*)(ws + carve(off, (size_t)T_TOK * 512 * 2));
  p.RKT = (bf16_t*)(ws + carve(off, (size_t)T_TOK * 512 * 2)); p.RVT = (bf16_t*)(ws + carve(off, (size_t)T_TOK * 512 * 2));
  p.RGT = (bf16_t*)(ws + carve(off, (size_t)T_TOK * 512 * 2)); p.NQ = (bf16_t*)(ws + carve(off, (size_t)T_TOK * 512 * 2));
  p.NKC = (bf16_t*)(ws + carve(off, (size_t)T_TOK * 128 * 2)); p.NVC = (bf16_t*)(ws + carve(off, (size_t)T_TOK * 128 * 2));
  p.NKS = (bf16_t*)(ws + carve(off, (size_t)T_TOK * 128 * 2)); p.NKW = (bf16_t*)(ws + carve(off, (size_t)T_TOK * 128 * 2));
  p.NVST = (bf16_t*)(ws + carve(off, (size_t)T_TOK * 128 * 2)); p.NVWT = (bf16_t*)(ws + carve(off, (size_t)T_TOK * 128 * 2));
  p.GATE = (float*)(ws + carve(off, (size_t)T_TOK * 24 * 4));
  p.KV = (float*)(ws + carve(off, (size_t)512 * 16384 * 4));
  p.SPREV = (bf16_t*)(ws + carve(off, (size_t)512 * 16384 * 2));
  p.KC = (bf16_t*)(ws + carve(off, (size_t)4 * 512 * 64 * 2)); p.VCT = (bf16_t*)(ws + carve(off, (size_t)4 * 512 * 64 * 2));
  p.HID = (float*)(ws + carve(off, (size_t)2 * 2048 * 256 * 4));
  size_t off2 = rb;
  p.PQ = (bf16_t*)(ws + carve(off2, (size_t)T_TOK * 2048 * 2));
  p.EIDX = (int*)(ws + carve(off2, (size_t)T_TOK * 128 * 4));
  p.EW = (float*)(ws + carve(off2, (size_t)T_TOK * 128 * 4));
  p.PDN8 = (unsigned char*)(ws + carve(off2, (size_t)16384 * 1024));
  p.PUP8 = (unsigned char*)(ws + carve(off2, (size_t)16384 * 1024));
  p.SDN = (float*)(ws + carve(off2, 16384 * 4));
  p.SUP = (float*)(ws + carve(off2, 16384 * 4));
  (void)ws_size; (void)in_sizes; (void)n_in; (void)out_size;

#ifdef MK_MULTI
#define LAUNCH1(PH) { hipFuncSetAttribute((const void*)k_single<PH>, hipFuncAttributeMaxDynamicSharedMemorySize, SMEM_BYTES); k_single<PH><<<256, NT, SMEM_BYTES, stream>>>(p); }
  LAUNCH1(0) LAUNCH1(1) LAUNCH1(2) LAUNCH1(3) LAUNCH1(4) LAUNCH1(5) LAUNCH1(6) LAUNCH1(7) LAUNCH1(8) LAUNCH1(9) LAUNCH1(10)
#else
  static int grid_blocks = 0;
  if (!grid_blocks) {
    int dev = 0, cus = 0, per_cu = 0;
    (void)hipGetDevice(&dev);
    (void)hipDeviceGetAttribute(&cus, hipDeviceAttributeMultiprocessorCount, dev);
    (void)hipFuncSetAttribute((const void*)k_mega, hipFuncAttributeMaxDynamicSharedMemorySize, SMEM_BYTES);
    (void)hipOccupancyMaxActiveBlocksPerMultiprocessor(&per_cu, k_mega, NT, SMEM_BYTES);
    if (per_cu < 1) per_cu = 1;
    if (per_cu > 1) per_cu = 1;
    grid_blocks = cus * per_cu;
  }
  (void)hipMemsetAsync(p.xbar, 0, XCD_BAR_WORDS * 4, stream);
  void* args[] = {&p};
  hipError_t e = hipLaunchCooperativeKernel((void*)k_mega, dim3(grid_blocks), dim3(NT), args, SMEM_BYTES, stream);
  if (e != hipSuccess) fprintf(stderr, "cooperative launch failed: %s (grid %d)\n", hipGetErrorString(e), grid_blocks);
#endif
}
```

```cpp
#include <hip/hip_runtime.h>
#include <hip/hip_bf16.h>
#include <hip/hip_cooperative_groups.h>
#include <stdint.h>
#include <stdio.h>
namespace cg = cooperative_groups;

typedef unsigned short bf16_t;
#define DI __device__ __forceinline__

DI int mytid() { int t = threadIdx.x; asm volatile("" : "+v"(t)); return t; }
DI float bf2f(bf16_t v) { return __uint_as_float(((unsigned)v) << 16); }
DI bf16_t f2bf(float x) { unsigned u = __float_as_uint(x); u += 0x7fffu + ((u >> 16) & 1u); return (bf16_t)(u >> 16); }
DI float gelu_tanh(float x) { float u = 0.7978845608028654f * (x + 0.044715f * x * x * x); return 0.5f * x * (1.f + tanhf(u)); }
DI float siluf(float x) { return x / (1.f + __expf(-x)); }
DI float sigmoidf(float x) { return 1.f / (1.f + __expf(-x)); }

#define T_TOK 16384
#define SEQ 8192
#define DM 1024
#define NPROJ 3584
#define NEG_INF (-__builtin_inff())

struct Params {
  const float *x, *c, *w_ada, *b_ada, *g_mix, *w_in, *pe_k, *pe_v, *w_k1, *b_k1, *w_k2, *w_v1, *b_v1, *w_v2, *w_out, *g_ffn,
      *w_pq, *subkeys, *peer_down, *peer_up, *g_final;
  float* out;
  float* gout;
  float* mod;
  unsigned* ksmax;
  unsigned* xbar;
  float *c128, *s128, *c64, *s64;
  bf16_t *WinT, *WoutT, *WqT, *W1Tk, *W1Tv, *W2Tk, *W2Tv, *SUBK;
  float *B1Pk, *B1Pv;
  bf16_t* RA;
  bf16_t *RQ, *RK, *RKT, *RVT, *RGT, *NQ, *NKC, *NVC, *NKS, *NKW, *NVST, *NVWT;
  float* GATE;
  float* KV;
  bf16_t* SPREV;
  bf16_t *KC, *VCT;
  float* HID;
  bf16_t* PQ;
  int* EIDX;
  float* EW;
  unsigned char *PDN8, *PUP8;
  float *SDN, *SUP;
};

DI float logg_h(int h) { return log1pf(-exp2f(-5.f - (float)h)); }


typedef __bf16 bf16x2_t __attribute__((ext_vector_type(2)));
typedef float f32x2_t __attribute__((ext_vector_type(2)));
DI unsigned cvt2(float a, float b) { f32x2_t v = {a, b}; bf16x2_t r = __builtin_convertvector(v, bf16x2_t); return __builtin_bit_cast(unsigned, r); }
DI uint2 pack4(float a, float b, float c, float d) { uint2 r; r.x = cvt2(a, b); r.y = cvt2(c, d); return r; }
#define NT 512
#ifndef PROBE_DUP
#define PROBE_DUP -1
#endif
typedef short bf16x8 __attribute__((ext_vector_type(8)));
typedef float f32x16 __attribute__((ext_vector_type(16)));
#define MFMA32(a, b, c) __builtin_amdgcn_mfma_f32_32x32x16_bf16((a), (b), (c), 0, 0, 0)
DI f32x16 zero16() { f32x16 z; for (int e = 0; e < 16; ++e) z[e] = 0.f; return z; }
DI f32x16 fill16(float v) { f32x16 z; for (int e = 0; e < 16; ++e) z[e] = v; return z; }
DI float ex2(float x) { return __builtin_amdgcn_exp2f(x); }

DI int win_logical_col(int np) {
  const int tile = np >> 8, p = np & 255, half = p >> 7, q = p & 127;
  if (tile < 4) { const int head = 2 * (tile & 1) + (q >> 6), i = q & 63; return (tile >> 1) * 512 + head * 128 + (half ? 64 + i : i); }
  if (tile < 8) return 1024 + (tile - 4) * 256 + p;
  if (tile < 10) { const int head = 4 * (tile - 8) + (q >> 5), i = q & 31; return 2048 + head * 64 + (half ? 32 + i : i); }
  if (tile == 10) { const int blk = q >> 5, i = q & 31; return (blk < 2 ? 2560 + blk * 64 : 2816 + (blk - 2) * 64) + (half ? 32 + i : i); }
  if (tile == 11) { const int blk = q >> 5, i = q & 31; return (blk < 2) ? 3072 + blk * 64 + (half ? 32 + i : i) : 2688 + (half ? 64 : 0) + 32 * (blk - 2) + i; }
  if (tile == 12) return (half ? 3200 : 2944) + q;
  if (tile == 13) return (half == 0 && q < 24) ? 3328 + q : -1;
  return -1;
}

DI void tr_tile(const float* __restrict__ in, bf16_t* __restrict__ out, int K, int N_in, int k0, int n0, int mode, float* tile) {
  const int tid = mytid();
  {
    int nn = tid & 63, col = mode ? win_logical_col(n0 + nn) : (n0 + nn);
#pragma unroll
    for (int i = 0; i < 8; ++i) {
      int kk = (tid >> 6) + 8 * i;
      tile[kk * 65 + nn] = (col >= 0) ? in[(size_t)(k0 + kk) * N_in + col] : 0.f;
    }
  }
  __syncthreads();
  {
    int kk = tid & 63;
#pragma unroll
    for (int i = 0; i < 8; ++i) {
      int nn = (tid >> 6) + 8 * i;
      out[(size_t)(n0 + nn) * K + k0 + kk] = f2bf(tile[kk * 65 + nn]);
    }
  }
  __syncthreads();
}

#define PH0_MOD 96
#define PH0_WIN (PH0_MOD + 16 * 56)
#define PH0_WOUT (PH0_WIN + 256)
#define PH0_WQ (PH0_WOUT + 512)
#define PH0_W1K (PH0_WQ + 128)
#define PH0_W1V (PH0_W1K + 128)
#define PH0_W2K (PH0_W1V + 4)
#define PH0_W2V (PH0_W2K + 4)
#define PH0_SUBK (PH0_W2V + 512)
#define PH0_ROPE (PH0_SUBK + 1024)
#define PH0_B1P (PH0_ROPE + 8)
#define PH0_NVB PH0_B1P

DI void ph0_body(const Params& p, int vb, char* smem) {
  const int tid = mytid();
  float* fs = (float*)smem;
  if (vb < PH0_MOD) {
    int kg = tid >> 6, col = vb * 64 + (tid & 63);
    float a0 = 0.f, a1 = 0.f;
#pragma unroll 8
    for (int k = kg * 128; k < kg * 128 + 128; ++k) {
      float w = p.w_ada[(size_t)k * 6144 + col];
      a0 += siluf(p.c[k]) * w; a1 += siluf(p.c[DM + k]) * w;
    }
    fs[kg * 64 + (tid & 63)] = a0; fs[512 + kg * 64 + (tid & 63)] = a1;
    __syncthreads();
    if (tid < 128) {
      int b = tid >> 6, cc = tid & 63; float s = 0.f;
      for (int g = 0; g < 8; ++g) s += fs[b * 512 + g * 64 + cc];
      p.mod[b * 6144 + vb * 64 + cc] = s + p.b_ada[vb * 64 + cc];
    }
    __syncthreads();
    if (vb == 0 && tid < 12) p.ksmax[tid] = 0u;
  } else if (vb < PH0_WIN) { int t = vb - PH0_MOD; tr_tile(p.w_in, p.WinT, 1024, 3352, (t & 15) * 64, (t >> 4) * 64, 1, fs); }
  else if (vb < PH0_WOUT) { int t = vb - PH0_WIN; tr_tile(p.w_out, p.WoutT, 1024, 1024, (t & 15) * 64, (t >> 4) * 64, 0, fs); }
  else if (vb < PH0_WQ) { int t = vb - PH0_WOUT; tr_tile(p.w_pq, p.WqT, 1024, 2048, (t & 15) * 64, (t >> 4) * 64, 0, fs); }
  else if (vb < PH0_W1K) { int t = vb - PH0_WQ; tr_tile(p.w_k1, p.W1Tk, 2048, 256, (t & 31) * 64, (t >> 5) * 64, 0, fs); }
  else if (vb < PH0_W1V) { int t = vb - PH0_W1K; tr_tile(p.w_v1, p.W1Tv, 2048, 256, (t & 31) * 64, (t >> 5) * 64, 0, fs); }
  else if (vb < PH0_W2K) { int t = vb - PH0_W1V; tr_tile(p.w_k2, p.W2Tk, 256, 64, t * 64, 0, 0, fs); }
  else if (vb < PH0_W2V) { int t = vb - PH0_W2K; tr_tile(p.w_v2, p.W2Tv, 256, 64, t * 64, 0, 0, fs); }
  else if (vb < PH0_SUBK) { int i = (vb - PH0_W2V) * NT + tid; p.SUBK[i] = f2bf(p.subkeys[i]); }
  else if (vb < PH0_ROPE) {
    int idx = (vb - PH0_SUBK) * NT + tid;
    { int s = idx >> 6, i = idx & 63; float inv = powf(10000.f, -(float)(2 * i) / 128.f); float ang = (float)s * inv; p.c128[idx] = cosf(ang); p.s128[idx] = sinf(ang); }
    if (idx < SEQ * 32) { int s = idx >> 5, i = idx & 31; float inv = powf(10000.f, -(float)(2 * i) / 64.f); float ang = (float)s * inv; p.c64[idx] = cosf(ang); p.s64[idx] = sinf(ang); }
  } else {
    int t = vb - PH0_ROPE, kv = t >> 2, jb = t & 3;
    const float* w1 = kv ? p.w_v1 : p.w_k1; const float* pe = kv ? p.pe_v : p.pe_k; const float* b1 = kv ? p.b_v1 : p.b_k1;
    int fg = tid >> 6, j = jb * 64 + (tid & 63);
    float a = 0.f;
#pragma unroll 8
    for (int f = fg * 256; f < fg * 256 + 256; ++f) a += pe[f] * w1[(size_t)f * 256 + j];
    fs[fg * 64 + (tid & 63)] = a;
    __syncthreads();
    if (tid < 64) { float s = b1[j]; for (int g = 0; g < 8; ++g) s += fs[g * 64 + tid]; (kv ? p.B1Pv : p.B1Pk)[j] = s; }
    __syncthreads();
  }
}

DI void rownorm_body(const float* __restrict__ src, const float* __restrict__ g, const float* __restrict__ mod, int sh_off, int sc_off, bf16_t* __restrict__ dst, int vb) {
  int row = vb * 8 + (mytid() >> 6), lane = mytid() & 63;
  int b = row >> 13;
  const float* xr = src + (size_t)row * DM;
  float v[16]; float ss = 0.f;
#pragma unroll
  for (int i = 0; i < 4; ++i) {
    float4 t = *(const float4*)(xr + i * 256 + lane * 4);
    v[i * 4 + 0] = t.x; v[i * 4 + 1] = t.y; v[i * 4 + 2] = t.z; v[i * 4 + 3] = t.w;
    ss += t.x * t.x + t.y * t.y + t.z * t.z + t.w * t.w;
  }
  for (int o = 32; o; o >>= 1) ss += __shfl_xor(ss, o);
  float rstd = rsqrtf(ss * (1.f / DM) + 1e-6f);
  const float* sh = mod + b * 6144 + sh_off; const float* sc = mod + b * 6144 + sc_off;
#pragma unroll
  for (int i = 0; i < 4; ++i) {
    int col = i * 256 + lane * 4;
    float4 gg = *(const float4*)(g + col), s4 = *(const float4*)(sc + col), h4 = *(const float4*)(sh + col);
    float y0 = v[i * 4 + 0] * rstd * gg.x * (1.f + s4.x) + h4.x;
    float y1 = v[i * 4 + 1] * rstd * gg.y * (1.f + s4.y) + h4.y;
    float y2 = v[i * 4 + 2] * rstd * gg.z * (1.f + s4.z) + h4.z;
    float y3 = v[i * 4 + 3] * rstd * gg.w * (1.f + s4.w) + h4.w;
    *(uint2*)(dst + (size_t)row * DM + col) = pack4(y0, y1, y2, y3);
  }
}

#define G_A_BYTES (256 * 144)
#define G_B_BYTES (256 * 144)
#define G_BUF_BYTES (G_A_BYTES + G_B_BYTES)
template <class Epi>
DI void gemm_tile(const bf16_t* __restrict__ A, const bf16_t* __restrict__ Bt, int K, int m0, int n0, char* smem, const Epi& epi) {
  const int tid = mytid(), lane = tid & 63, w = tid >> 6, wm = w >> 2, wn = w & 3, r = lane & 31, h = lane >> 5;
  f32x16 acc[4][2];
#pragma unroll
  for (int i = 0; i < 4; ++i)
#pragma unroll
    for (int j = 0; j < 2; ++j) acc[i][j] = zero16();
  const int crow = tid >> 3, ckc = tid & 7;
  const bf16_t* ag = A + (size_t)(m0 + crow) * K + ckc * 8;
  const bf16_t* bg = Bt + (size_t)(n0 + crow) * K + ckc * 8;
  uint4 ra[4], rb[4];
#pragma unroll
  for (int i = 0; i < 4; ++i) { ra[i] = *(const uint4*)(ag + (size_t)i * 64 * K); rb[i] = *(const uint4*)(bg + (size_t)i * 64 * K); }
  char* lw = smem + crow * 144 + ckc * 16;
#pragma unroll
  for (int i = 0; i < 4; ++i) { *(uint4*)(lw + i * 64 * 144) = ra[i]; *(uint4*)(lw + G_A_BYTES + i * 64 * 144) = rb[i]; }
  __syncthreads();
  const int nk = K >> 6;
  for (int kt = 0; kt < nk; ++kt) {
    const int cur = kt & 1;
    if (kt + 1 < nk) {
      const int k0 = (kt + 1) * 64;
#pragma unroll
      for (int i = 0; i < 4; ++i) { ra[i] = *(const uint4*)(ag + (size_t)i * 64 * K + k0); rb[i] = *(const uint4*)(bg + (size_t)i * 64 * K + k0); }
    }
    const char* la = smem + cur * G_BUF_BYTES + (wm * 128 + r) * 144 + h * 16;
    const char* lb = smem + cur * G_BUF_BYTES + G_A_BYTES + (wn * 64 + r) * 144 + h * 16;
#pragma unroll
    for (int kk = 0; kk < 4; ++kk) {
      bf16x8 b0 = *(const bf16x8*)(lb + kk * 32), b1 = *(const bf16x8*)(lb + 32 * 144 + kk * 32);
#pragma unroll
      for (int i = 0; i < 4; ++i) {
        bf16x8 a = *(const bf16x8*)(la + i * 32 * 144 + kk * 32);
        acc[i][0] = MFMA32(a, b0, acc[i][0]); acc[i][1] = MFMA32(a, b1, acc[i][1]);
      }
    }
    if (kt + 1 < nk) {
      char* lw2 = lw + (cur ^ 1) * G_BUF_BYTES;
#pragma unroll
      for (int i = 0; i < 4; ++i) { *(uint4*)(lw2 + i * 64 * 144) = ra[i]; *(uint4*)(lw2 + G_A_BYTES + i * 64 * 144) = rb[i]; }
    }
    __syncthreads();
  }
  const int G = (n0 >> 6) + wn;
#pragma unroll
  for (int i = 0; i < 4; ++i) {
    float pre[4][8];
#pragma unroll
    for (int g = 0; g < 4; ++g) epi.prefetch(m0 + wm * 128 + i * 32 + 8 * g + 4 * h, G, r, pre[g]);
#pragma unroll
    for (int g = 0; g < 4; ++g) {
      float lo[4], hi[4];
#pragma unroll
      for (int e = 0; e < 4; ++e) { lo[e] = acc[i][0][4 * g + e]; hi[e] = acc[i][1][4 * g + e]; }
      epi(m0 + wm * 128 + i * 32 + 8 * g + 4 * h, G, r, lo, hi, pre[g]);
    }
  }
}

struct EpiProj {
  static constexpr bool kProbe = true;
  const Params& p;
  DI void prefetch(int t0, int G, int c, float (&pre)[8]) const {
    const int s0 = t0 & 8191;
    const bool r128 = G < 16, r64 = (G >= 32 && G < 40) || (G >= 40 && G < 52 && (((G - 40) >> 1) & 1) == 0);
    if (r128) {
      const int i = 32 * (G & 1) + c;
#pragma unroll
      for (int e = 0; e < 4; ++e) { pre[e] = p.c128[(s0 + e) * 64 + i]; pre[4 + e] = p.s128[(s0 + e) * 64 + i]; }
    } else if (r64) {
#pragma unroll
      for (int e = 0; e < 4; ++e) { pre[e] = p.c64[(s0 + e) * 32 + c]; pre[4 + e] = p.s64[(s0 + e) * 32 + c]; }
    } else {
#pragma unroll
      for (int e = 0; e < 8; ++e) pre[e] = 0.f;
    }
  }
  DI void operator()(int t0, int G, int c, const float (&lo)[4], const float (&hi)[4], const float (&pre)[8]) const {
    const int b = t0 >> 13, s0 = t0 & 8191;
    if (G < 16) {
      const int sec = G >> 3, hh = (G & 7) >> 1, j = G & 1, i = 32 * j + c;
      float o1[4], o2[4];
#pragma unroll
      for (int e = 0; e < 4; ++e) {
        float cs = pre[e], sn = pre[4 + e];
        o1[e] = lo[e] * cs - hi[e] * sn; o2[e] = hi[e] * cs + lo[e] * sn;
      }
      if (sec == 0) {
#pragma unroll
        for (int e = 0; e < 4; ++e) {
          p.RQ[(size_t)(t0 + e) * 512 + hh * 128 + i] = f2bf(o1[e]);
          p.RQ[(size_t)(t0 + e) * 512 + hh * 128 + 64 + i] = f2bf(o2[e]);
        }
      } else {
        const float sc = 0.08838834764831845f;
        const float lg = logg_h(hh);
#pragma unroll
        for (int e = 0; e < 4; ++e) {
          o1[e] *= sc; o2[e] *= sc;
          p.RK[(size_t)(t0 + e) * 512 + hh * 128 + i] = f2bf(o1[e]);
          p.RK[(size_t)(t0 + e) * 512 + hh * 128 + 64 + i] = f2bf(o2[e]);
          float zeta = __expf((float)(127 - ((s0 + e) & 127)) * lg);
          o1[e] *= zeta; o2[e] *= zeta;
        }
        *(uint2*)(p.RKT + ((size_t)(b * 4 + hh) * 128 + i) * SEQ + s0) = pack4(o1[0], o1[1], o1[2], o1[3]);
        *(uint2*)(p.RKT + ((size_t)(b * 4 + hh) * 128 + 64 + i) * SEQ + s0) = pack4(o2[0], o2[1], o2[2], o2[3]);
      }
    } else if (G < 24) {
      const int hh = (G - 16) >> 1, d = ((G - 16) & 1) * 64 + c;
      *(uint2*)(p.RVT + ((size_t)(b * 4 + hh) * 128 + d) * SEQ + s0) = pack4(lo[0], lo[1], lo[2], lo[3]);
      *(uint2*)(p.RVT + ((size_t)(b * 4 + hh) * 128 + d + 32) * SEQ + s0) = pack4(hi[0], hi[1], hi[2], hi[3]);
    } else if (G < 32) {
      const int hh = (G - 24) >> 1, d = ((G - 24) & 1) * 64 + c;
#pragma unroll
      for (int e = 0; e < 4; ++e) {
        p.RGT[(size_t)(t0 + e) * 512 + hh * 128 + d] = f2bf(siluf(lo[e]));
        p.RGT[(size_t)(t0 + e) * 512 + hh * 128 + d + 32] = f2bf(siluf(hi[e]));
      }
    } else if (G < 40) {
      const int head = G - 32;
#pragma unroll
      for (int e = 0; e < 4; ++e) {
        float cs = pre[e], sn = pre[4 + e];
        const float qs = 0.125f * 1.4426950408889634f;
        float o1 = (lo[e] * cs - hi[e] * sn) * qs, o2 = (hi[e] * cs + lo[e] * sn) * qs;
        p.NQ[(size_t)(t0 + e) * 512 + head * 64 + c] = f2bf(o1);
        p.NQ[(size_t)(t0 + e) * 512 + head * 64 + 32 + c] = f2bf(o2);
      }
    } else if (G < 52) {
      const int k = G - 40, kind = k >> 1, gg = k & 1;
      float o1[4], o2[4];
#pragma unroll
      for (int e = 0; e < 4; ++e) {
        o1[e] = lo[e]; o2[e] = hi[e];
        if ((kind & 1) == 0) {
          float cs = pre[e], sn = pre[4 + e];
          o1[e] = lo[e] * cs - hi[e] * sn; o2[e] = hi[e] * cs + lo[e] * sn;
        }
      }
      if (kind == 3 || kind == 5) {
        bf16_t* dst = (kind == 3 ? p.NVST : p.NVWT) + ((size_t)(b * 2 + gg) * 64 + c) * SEQ + s0;
        *(uint2*)dst = pack4(o1[0], o1[1], o1[2], o1[3]);
        *(uint2*)(dst + (size_t)32 * SEQ) = pack4(o2[0], o2[1], o2[2], o2[3]);
      } else {
        bf16_t* dst = (kind == 0 ? p.NKC : kind == 1 ? p.NVC : kind == 2 ? p.NKS : p.NKW);
#pragma unroll
        for (int e = 0; e < 4; ++e) {
          dst[(size_t)(t0 + e) * 128 + gg * 64 + c] = f2bf(o1[e]);
          dst[(size_t)(t0 + e) * 128 + gg * 64 + 32 + c] = f2bf(o2[e]);
        }
      }
    } else if (G == 52) {
      if (c < 24) {
#pragma unroll
        for (int e = 0; e < 4; ++e) p.GATE[(size_t)(t0 + e) * 24 + c] = sigmoidf(lo[e]);
      }
    }
  }
};
struct EpiOut {
  static constexpr bool kProbe = false;
  const Params& p;
  DI void prefetch(int t0, int G, int c, float (&pre)[8]) const {
    const int c0 = G * 64 + c;
#pragma unroll
    for (int e = 0; e < 4; ++e) { pre[e] = p.x[(size_t)(t0 + e) * DM + c0]; pre[4 + e] = p.x[(size_t)(t0 + e) * DM + c0 + 32]; }
  }
  DI void operator()(int t0, int G, int c, const float (&lo)[4], const float (&hi)[4], const float (&pre)[8]) const {
    const int b = t0 >> 13;
    const int c0 = G * 64 + c, c1 = c0 + 32;
    const float* ga1 = p.mod + b * 6144 + 2048;
    const float g0 = ga1[c0], g1 = ga1[c1];
#pragma unroll
    for (int e = 0; e < 4; ++e) {
      p.out[(size_t)(t0 + e) * DM + c0] = pre[e] + g0 * lo[e];
      p.out[(size_t)(t0 + e) * DM + c1] = pre[4 + e] + g1 * hi[e];
    }
  }
};
struct EpiPQ {
  static constexpr bool kProbe = false;
  const Params& p;
  DI void prefetch(int, int, int, float (&)[8]) const {}
  DI void operator()(int t0, int G, int c, const float (&lo)[4], const float (&hi)[4], const float (&)[8]) const {
#pragma unroll
    for (int e = 0; e < 4; ++e) {
      p.PQ[(size_t)(t0 + e) * 2048 + G * 64 + c] = f2bf(lo[e]);
      p.PQ[(size_t)(t0 + e) * 2048 + G * 64 + 32 + c] = f2bf(hi[e]);
    }
  }
};


namespace pg8 {
#define PG8_LAS __attribute__((address_space(3)))
typedef float f32x4 __attribute__((ext_vector_type(4)));
constexpr int BM = 256, BK = 64, HALF = 128, HTB = HALF * BK * 2, STAGE_BYTES = 8 * HTB, NXCD = 8, WGM = 8;
DI int lds_byte(int r, int c) { const int st = (r >> 4) * 2 + (c >> 5), rr = r & 15, cc = c & 31, ob = rr * 64 + cc * 2; return st * 1024 + (ob ^ (((ob >> 9) & 1) << 5)); }
DI void stage_rc(int b, int& R, int& C) { const int st = b / 1024, sb = b % 1024, swz = sb ^ (((sb >> 9) & 1) << 5); R = (st >> 1) * 16 + swz / 64; C = (st & 1) * 32 + (swz % 64) / 2; }
DI int perm32(int rho) { const int n = rho >> 4, i = rho & 15; return 8 * (i >> 2) + 4 * n + (i & 3); }
struct Unit { int pm, pn; };
struct Gemm { const bf16_t* A; const bf16_t* Bt; int M, N, K; };
struct StaticOrder {
  int nM, nN, nwg, G, c;
  DI void init(int M, int N, int G_, int c_) { nM = M / BM; nN = N / BM; nwg = nM * nN; G = G_; c = c_; }
  DI bool next(int i, Unit& u) const {
    const long L = (long)i * G + c; if (L >= nwg) return false;
    int wgid = (int)L; { const int q = nwg / NXCD, r = nwg % NXCD, xcd = wgid % NXCD, off = wgid / NXCD; wgid = (xcd < r ? xcd * (q + 1) : r * (q + 1) + (xcd - r) * q) + off; }
    const int nig = WGM * nN, gid = wgid / nig, fm = gid * WGM, gsz = (nM - fm) < WGM ? (nM - fm) : WGM;
    u.pm = fm + ((wgid % nig) % gsz); u.pn = (wgid % nig) / gsz; return true;
  }
  DI void a_ready(const Unit&) const {}
  DI void done(const Unit&) const {}
};
template <class Epi, class Sched>
__device__ __forceinline__ void gemm_phase(PG8_LAS unsigned char* lds, const Gemm g, const Sched& S, const Epi& E) {
    const int tid = mytid(), wid = __builtin_amdgcn_readfirstlane(tid >> 6), lane = tid & 63, wr = wid >> 2, wc = wid & 3, fr = lane & 15, fq = lane >> 4;
    const int K = g.K, nt = K / BK;
    unsigned voffA[2], voffB[2];
#pragma unroll
    for (int i = 0; i < 2; ++i) { int R, C; stage_rc(tid * 16 + i * 8192, R, C); const int Rb = Epi::PERM ? ((R & ~31) + perm32(R & 31)) : R;
        voffA[i] = (unsigned)(R * K + C) * 2u; voffB[i] = (unsigned)(Rb * K + C) * 2u; }
    const size_t kstep = (size_t)(BK * 2);
    const size_t hstep = (size_t)HALF * K * 2;
    const size_t tstep = 2 * hstep;
    const unsigned ldsw = (unsigned)wid * 1024u;
    const int aoff = lds_byte(wr * 64 + fr, fq * 8), boff = lds_byte(wc * 32 + fr, fq * 8);
#define PG8_SA(b, h) (((b) * 2 + (h)) * HTB)
#define PG8_SB(b, h) ((4 + (b) * 2 + (h)) * HTB)
#define PG8_STAGE(bufoff, gbase, voff) do { _Pragma("unroll") for (int _i = 0; _i < 2; ++_i) \
        __builtin_amdgcn_global_load_lds((const unsigned*)((const char*)(gbase) + (voff)[_i]), (PG8_LAS unsigned*)(lds + (bufoff) + ldsw + _i * 8192), 16, 0, 0); } while (0)
#define PG8_LDA(dst, b, h) do { _Pragma("unroll") for (int m = 0; m < 4; ++m) _Pragma("unroll") for (int k = 0; k < 2; ++k) dst[m][k] = *(const PG8_LAS bf16x8*)(lds + PG8_SA(b, h) + aoff + m * 2048 + k * 1024); } while (0)
#define PG8_LDB(dst, b, h) do { _Pragma("unroll") for (int n = 0; n < 2; ++n) _Pragma("unroll") for (int k = 0; k < 2; ++k) dst[n][k] = *(const PG8_LAS bf16x8*)(lds + PG8_SB(b, h) + boff + n * 2048 + k * 1024); } while (0)
#define PG8_MMA(ai, bj, At, Bt) do { __builtin_amdgcn_s_setprio(1); _Pragma("unroll") for (int m = 0; m < 4; ++m) _Pragma("unroll") for (int n = 0; n < 2; ++n) _Pragma("unroll") for (int k = 0; k < 2; ++k) \
        acc[ai][bj][m][n] = __builtin_amdgcn_mfma_f32_16x16x32_bf16(Bt[n][k], At[m][k], acc[ai][bj][m][n], 0, 0, 0); __builtin_amdgcn_s_setprio(0); } while (0)
#define PG8_WAIT_V(n) asm volatile("s_waitcnt vmcnt(" #n ")" ::: "memory")
#define PG8_WAIT_L(n) asm volatile("s_waitcnt lgkmcnt(" #n ")" ::: "memory")
#define PG8_BAR __builtin_amdgcn_s_barrier()
#define PG8_SCHED __builtin_amdgcn_sched_barrier(0)
    Unit cur, nxt; int ui = 0;
    if (!S.next(0, cur)) return;
    f32x4 acc[2][2][4][2];
#pragma unroll
    for (int a = 0; a < 2; ++a)
#pragma unroll
        for (int b = 0; b < 2; ++b)
#pragma unroll
            for (int m = 0; m < 4; ++m)
#pragma unroll
                for (int n = 0; n < 2; ++n) acc[a][b][m][n] = (f32x4){0.f, 0.f, 0.f, 0.f};
    bf16x8 At[4][2], B0[2][2], B1[2][2];
    const char* cA = (const char*)g.A + (size_t)cur.pm * tstep; const char* cB = (const char*)g.Bt + (size_t)cur.pn * tstep;
    S.a_ready(cur);
    PG8_STAGE(PG8_SB(0, 0), cB, voffB); PG8_STAGE(PG8_SA(0, 0), cA, voffA); PG8_STAGE(PG8_SB(0, 1), cB + hstep, voffB); PG8_STAGE(PG8_SA(0, 1), cA + hstep, voffA);
    if (wr == 1) PG8_BAR;
    PG8_WAIT_V(4); PG8_BAR;
    PG8_STAGE(PG8_SB(1, 0), cB + kstep, voffB); PG8_STAGE(PG8_SA(1, 0), cA + kstep, voffA); PG8_STAGE(PG8_SB(1, 1), cB + hstep + kstep, voffB);
    PG8_WAIT_V(6); PG8_BAR;
    for (;;) {
        const bool has_next = S.next(ui + 1, nxt);
        const char* nA = has_next ? (const char*)g.A + (size_t)nxt.pm * tstep : cA; const char* nB = has_next ? (const char*)g.Bt + (size_t)nxt.pn * tstep : cB;
        for (int t = 0; t < nt; t += 2) {
            const bool last = (t == nt - 2);
            const char* a1 = cA + (size_t)(t + 1) * kstep;
            const char* a2 = last ? nA : cA + (size_t)(t + 2) * kstep; const char* b2 = last ? nB : cB + (size_t)(t + 2) * kstep;
            const char* a3 = a2 + kstep; const char* b3 = b2 + kstep;
            if (last && has_next) S.a_ready(nxt);
            PG8_LDB(B0, 0, 0); PG8_SCHED; PG8_LDA(At, 0, 0); PG8_STAGE(PG8_SA(1, 1), a1 + hstep, voffA);
            PG8_WAIT_L(8); PG8_BAR; PG8_WAIT_L(0); PG8_MMA(0, 0, At, B0); PG8_BAR; PG8_SCHED;
            PG8_LDB(B1, 0, 1); PG8_STAGE(PG8_SB(0, 0), b2, voffB);
            PG8_BAR; PG8_WAIT_L(0); PG8_MMA(0, 1, At, B1); PG8_BAR;
            PG8_LDA(At, 0, 1); PG8_STAGE(PG8_SA(0, 0), a2, voffA);
            PG8_BAR; PG8_WAIT_L(0); PG8_MMA(1, 0, At, B0); PG8_BAR; PG8_SCHED;
            PG8_STAGE(PG8_SB(0, 1), b2 + hstep, voffB);
            PG8_WAIT_V(6); PG8_BAR; PG8_MMA(1, 1, At, B1); PG8_BAR;
            PG8_LDB(B0, 1, 0); PG8_SCHED; PG8_LDA(At, 1, 0); PG8_STAGE(PG8_SA(0, 1), a2 + hstep, voffA);
            PG8_WAIT_L(8); PG8_BAR; PG8_WAIT_L(0); PG8_MMA(0, 0, At, B0); PG8_BAR; PG8_SCHED;
            PG8_LDB(B1, 1, 1); PG8_STAGE(PG8_SB(1, 0), b3, voffB);
            PG8_BAR; PG8_WAIT_L(0); PG8_MMA(0, 1, At, B1); PG8_BAR;
            PG8_LDA(At, 1, 1); PG8_STAGE(PG8_SA(1, 0), a3, voffA);
            PG8_BAR; PG8_WAIT_L(0); PG8_MMA(1, 0, At, B0); PG8_BAR; PG8_SCHED;
            PG8_STAGE(PG8_SB(1, 1), b3 + hstep, voffB);
            PG8_WAIT_V(6); PG8_BAR; PG8_MMA(1, 1, At, B1); PG8_BAR;
        }
        if constexpr (!Epi::AFTER_DRAIN) { E(acc, cur, wr, wc, fr, fq); S.done(cur); }
        if (!has_next) break;
#pragma unroll
        for (int a = 0; a < 2; ++a)
#pragma unroll
            for (int b = 0; b < 2; ++b)
#pragma unroll
                for (int m = 0; m < 4; ++m)
#pragma unroll
                    for (int n = 0; n < 2; ++n) acc[a][b][m][n] = (f32x4){0.f, 0.f, 0.f, 0.f};
        cur = nxt; cA = nA; cB = nB; ++ui;
    }
    PG8_WAIT_V(0);
    if (wr == 0) PG8_BAR;
    PG8_BAR;
    if constexpr (Epi::AFTER_DRAIN) { E.fused(acc, cur, wr, wc, fr, fq, lds, wid, lane); S.done(cur); }
#undef PG8_SA
#undef PG8_SB
#undef PG8_STAGE
#undef PG8_LDA
#undef PG8_LDB
#undef PG8_MMA
#undef PG8_WAIT_V
#undef PG8_WAIT_L
#undef PG8_BAR
#undef PG8_SCHED
}
}

template <int CTRL> DI float dpp_q(float x) { return __builtin_bit_cast(float, __builtin_amdgcn_mov_dpp(__builtin_bit_cast(int, x), CTRL, 0xf, 0xf, true)); }
DI void tstore4(bf16_t* dst, float v0, float v1, float v2, float v3, int q) {
  const bool o1_ = q & 1, o2_ = q & 2;
  const float sa = o1_ ? v0 : v1, sb = o1_ ? v2 : v3;
  const float ra = dpp_q<0xB1>(sa), rb = dpp_q<0xB1>(sb);
  const float w0 = o1_ ? ra : v0, w1 = o1_ ? v1 : ra, w2 = o1_ ? rb : v2, w3 = o1_ ? v3 : rb;
  const float sc = o2_ ? w0 : w2, sd = o2_ ? w1 : w3;
  const float rc = dpp_q<0x4E>(sc), rd = dpp_q<0x4E>(sd);
  const float x0 = o2_ ? rc : w0, x1 = o2_ ? rd : w1, x2 = o2_ ? w2 : rc, x3 = o2_ ? w3 : rd;
  *(uint2*)(dst + (size_t)q * SEQ - q) = pack4(x0, x1, x2, x3);
}
DI uint4 pack8u(const float (&a)[4], const float (&b)[4]) { uint4 v; v.x = cvt2(a[0], a[1]); v.y = cvt2(a[2], a[3]); v.z = cvt2(b[0], b[1]); v.w = cvt2(b[2], b[3]); return v; }
struct EpiProj8 {
  static constexpr bool PERM = true, AFTER_DRAIN = false;
  const Params& p;
  DI void operator()(const pg8::f32x4 (&acc)[2][2][4][2], const pg8::Unit& u, int wr, int wc, int fr, int fq) const {
    const int pn = u.pn, q4 = fr & 3;
    const bool rot128 = pn < 4, rot64 = (pn >= 8 && pn < 10) || pn == 10 || (pn == 11 && wc < 2), rot = rot128 || rot64;
    const int t00 = u.pm * 256 + wr * 64 + fr, s00 = t00 & 8191;
    const int cb0 = 8 * fq;
    const float* ct = rot128 ? p.c128 : p.c64; const float* st = rot128 ? p.s128 : p.s64;
    const int nrot = rot128 ? 64 : 32, ridx = (rot128 ? 32 * (wc & 1) : 0) + cb0;
    float cd_[2][4], sd_[2][4];
    if (rot) {
#pragma unroll
      for (int n = 0; n < 2; ++n) {
        const float4 c16 = *(const float4*)(ct + (size_t)16 * nrot + ridx + 4 * n), s16 = *(const float4*)(st + (size_t)16 * nrot + ridx + 4 * n);
        cd_[n][0] = c16.x; cd_[n][1] = c16.y; cd_[n][2] = c16.z; cd_[n][3] = c16.w; sd_[n][0] = s16.x; sd_[n][1] = s16.y; sd_[n][2] = s16.z; sd_[n][3] = s16.w;
      }
    }
#pragma unroll
    for (int ai = 0; ai < 2; ++ai) {
      float c_[2][4], s_[2][4];
      if (rot) {
#pragma unroll
        for (int n = 0; n < 2; ++n) {
          const float4 c4 = *(const float4*)(ct + (size_t)(s00 + 128 * ai) * nrot + ridx + 4 * n), s4 = *(const float4*)(st + (size_t)(s00 + 128 * ai) * nrot + ridx + 4 * n);
          c_[n][0] = c4.x; c_[n][1] = c4.y; c_[n][2] = c4.z; c_[n][3] = c4.w; s_[n][0] = s4.x; s_[n][1] = s4.y; s_[n][2] = s4.z; s_[n][3] = s4.w;
        }
      }
#pragma unroll
      for (int m = 0; m < 4; ++m) {
        const int t = t00 + ai * 128 + m * 16, b = t >> 13, s = t & 8191;
        float lo[2][4], hi[2][4];
#pragma unroll
        for (int n = 0; n < 2; ++n) {
          const pg8::f32x4 L = acc[ai][0][m][n], H = acc[ai][1][m][n];
#pragma unroll
          for (int i = 0; i < 4; ++i) {
            if (rot) {
              const float c = c_[n][i], sn = s_[n][i];
              lo[n][i] = L[i] * c - H[i] * sn; hi[n][i] = H[i] * c + L[i] * sn;
              c_[n][i] = c * cd_[n][i] - sn * sd_[n][i]; s_[n][i] = sn * cd_[n][i] + c * sd_[n][i];
            } else { lo[n][i] = L[i]; hi[n][i] = H[i]; }
          }
        }
        if (pn < 4) {
          const int hh = 2 * (pn & 1) + (wc >> 1), idx = 32 * (wc & 1) + cb0;
          if (pn < 2) {
            *(uint4*)(p.RQ + (size_t)t * 512 + hh * 128 + idx) = pack8u(lo[0], lo[1]);
            *(uint4*)(p.RQ + (size_t)t * 512 + hh * 128 + 64 + idx) = pack8u(hi[0], hi[1]);
          } else {
            const float sc = 0.08838834764831845f;
#pragma unroll
            for (int n = 0; n < 2; ++n)
#pragma unroll
              for (int i = 0; i < 4; ++i) { lo[n][i] *= sc; hi[n][i] *= sc; }
            *(uint4*)(p.RK + (size_t)t * 512 + hh * 128 + idx) = pack8u(lo[0], lo[1]);
            *(uint4*)(p.RK + (size_t)t * 512 + hh * 128 + 64 + idx) = pack8u(hi[0], hi[1]);
            const float zeta = __expf((float)(127 - (s & 127)) * logg_h(hh));
            bf16_t* kt = p.RKT + ((size_t)(b * 4 + hh) * 128 + idx) * SEQ + s;
#pragma unroll
            for (int n = 0; n < 2; ++n) {
              tstore4(kt + (size_t)(4 * n) * SEQ, lo[n][0] * zeta, lo[n][1] * zeta, lo[n][2] * zeta, lo[n][3] * zeta, q4);
              tstore4(kt + (size_t)(64 + 4 * n) * SEQ, hi[n][0] * zeta, hi[n][1] * zeta, hi[n][2] * zeta, hi[n][3] * zeta, q4);
            }
          }
        } else if (pn < 6) {
          bf16_t* v0 = p.RVT + ((size_t)(b * 4 + 2 * (pn - 4)) * 128 + 32 * wc + cb0) * SEQ + s;
#pragma unroll
          for (int n = 0; n < 2; ++n) {
            tstore4(v0 + (size_t)(4 * n) * SEQ, lo[n][0], lo[n][1], lo[n][2], lo[n][3], q4);
            tstore4(v0 + (size_t)(128 + 4 * n) * SEQ, hi[n][0], hi[n][1], hi[n][2], hi[n][3], q4);
          }
        } else if (pn < 8) {
          const int d = 32 * wc + cb0, h0 = 2 * (pn - 6);
#pragma unroll
          for (int n = 0; n < 2; ++n)
#pragma unroll
            for (int i = 0; i < 4; ++i) { lo[n][i] = siluf(lo[n][i]); hi[n][i] = siluf(hi[n][i]); }
          *(uint4*)(p.RGT + (size_t)t * 512 + h0 * 128 + d) = pack8u(lo[0], lo[1]);
          *(uint4*)(p.RGT + (size_t)t * 512 + (h0 + 1) * 128 + d) = pack8u(hi[0], hi[1]);
        } else if (pn < 10) {
          const int head = 4 * (pn - 8) + wc;
          const float qs = 0.125f * 1.4426950408889634f;
#pragma unroll
          for (int n = 0; n < 2; ++n)
#pragma unroll
            for (int i = 0; i < 4; ++i) { lo[n][i] *= qs; hi[n][i] *= qs; }
          *(uint4*)(p.NQ + (size_t)t * 512 + head * 64 + cb0) = pack8u(lo[0], lo[1]);
          *(uint4*)(p.NQ + (size_t)t * 512 + head * 64 + 32 + cb0) = pack8u(hi[0], hi[1]);
        } else if (pn == 10 || (pn == 11 && wc < 2)) {
          bf16_t* dst = (pn == 11) ? p.NKW : (wc < 2 ? p.NKC : p.NKS);
          const int g = wc & 1;
          *(uint4*)(dst + (size_t)t * 128 + g * 64 + cb0) = pack8u(lo[0], lo[1]);
          *(uint4*)(dst + (size_t)t * 128 + g * 64 + 32 + cb0) = pack8u(hi[0], hi[1]);
        } else if (pn == 11) {
          const int c0 = 32 * (wc - 2) + cb0;
          *(uint4*)(p.NVC + (size_t)t * 128 + c0) = pack8u(lo[0], lo[1]);
          *(uint4*)(p.NVC + (size_t)t * 128 + 64 + c0) = pack8u(hi[0], hi[1]);
        } else if (pn == 12) {
          const int col = 32 * wc + cb0, g = col >> 6, d = col & 63;
          bf16_t* v0 = p.NVST + ((size_t)(b * 2 + g) * 64 + d) * SEQ + s;
          bf16_t* v1 = p.NVWT + ((size_t)(b * 2 + g) * 64 + d) * SEQ + s;
#pragma unroll
          for (int n = 0; n < 2; ++n) {
            tstore4(v0 + (size_t)(4 * n) * SEQ, lo[n][0], lo[n][1], lo[n][2], lo[n][3], q4);
            tstore4(v1 + (size_t)(4 * n) * SEQ, hi[n][0], hi[n][1], hi[n][2], hi[n][3], q4);
          }
        } else {
          if (wc == 0) {
#pragma unroll
            for (int n = 0; n < 2; ++n)
#pragma unroll
              for (int i = 0; i < 4; ++i) if (cb0 + 4 * n + i < 24) p.GATE[(size_t)t * 24 + cb0 + 4 * n + i] = sigmoidf(lo[n][i]);
          }
        }
      }
    }
  }
};
struct EpiOut8 {
  static constexpr bool PERM = false, AFTER_DRAIN = false;
  const float* x; float* out; const float* mod;
  DI void operator()(const pg8::f32x4 (&acc)[2][2][4][2], const pg8::Unit& u, int wr, int wc, int fr, int fq) const {
    const int col0 = u.pn * 256 + wc * 32 + 4 * fq;
    const float* ga1 = mod + ((u.pm * 256) >> 13) * 6144 + 2048;
    float4 gv[2][2];
#pragma unroll
    for (int bj = 0; bj < 2; ++bj)
#pragma unroll
      for (int n = 0; n < 2; ++n) gv[bj][n] = *(const float4*)(ga1 + col0 + bj * 128 + n * 16);
#pragma unroll
    for (int ai = 0; ai < 2; ++ai)
#pragma unroll
      for (int m = 0; m < 4; ++m) {
        const size_t ro = (size_t)(u.pm * 256 + wr * 64 + fr + ai * 128 + m * 16) * DM + col0;
        float4 xv[2][2];
#pragma unroll
        for (int bj = 0; bj < 2; ++bj)
#pragma unroll
          for (int n = 0; n < 2; ++n) xv[bj][n] = *(const float4*)(x + ro + bj * 128 + n * 16);
#pragma unroll
        for (int bj = 0; bj < 2; ++bj)
#pragma unroll
          for (int n = 0; n < 2; ++n) {
            const pg8::f32x4 v = acc[ai][bj][m][n]; const float4 g4 = gv[bj][n], x4 = xv[bj][n];
            *(float4*)(out + ro + bj * 128 + n * 16) = make_float4(x4.x + g4.x * v[0], x4.y + g4.y * v[1], x4.z + g4.z * v[2], x4.w + g4.w * v[3]);
          }
      }
  }
};
struct EpiPQ8 {
  static constexpr bool PERM = true, AFTER_DRAIN = false;
  bf16_t* O;
  DI void operator()(const pg8::f32x4 (&acc)[2][2][4][2], const pg8::Unit& u, int wr, int wc, int fr, int fq) const {
#pragma unroll
    for (int ai = 0; ai < 2; ++ai)
#pragma unroll
      for (int m = 0; m < 4; ++m) {
        bf16_t* rowp = O + (size_t)(u.pm * 256 + wr * 64 + fr + ai * 128 + m * 16) * 2048 + u.pn * 256 + wc * 32 + 8 * fq;
#pragma unroll
        for (int bj = 0; bj < 2; ++bj) {
          const pg8::f32x4 v0 = acc[ai][bj][m][0], v1 = acc[ai][bj][m][1];
          uint4 o; o.x = cvt2(v0[0], v0[1]); o.y = cvt2(v0[2], v0[3]); o.z = cvt2(v1[0], v1[1]); o.w = cvt2(v1[2], v1[3]);
          *(uint4*)(rowp + bj * 128) = o;
        }
      }
  }
};
DI int crow(int reg, int h) { return (reg & 3) + 8 * (reg >> 2) + 4 * h; }
DI bf16x8 ld16(const bf16_t* ptr) { return *(const bf16x8*)ptr; }
DI bf16x8 ld8x2(const bf16_t* ptr) {
  uint2 a = *(const uint2*)ptr, b = *(const uint2*)(ptr + 8);
  uint4 v; v.x = a.x; v.y = a.y; v.z = b.x; v.w = b.y;
  return __builtin_bit_cast(bf16x8, v);
}
DI bf16x8 pack8(float x0, float x1, float x2, float x3, float x4, float x5, float x6, float x7) {
  uint4 v; v.x = cvt2(x0, x1); v.y = cvt2(x2, x3); v.z = cvt2(x4, x5); v.w = cvt2(x6, x7);
  return __builtin_bit_cast(bf16x8, v);
}

DI void retkv_mfma(const Params& p, int item) {
  const int lane = mytid() & 63, w = mytid() >> 6, r = lane & 31, h = lane >> 5;
  const int hh = item & 3, c = (item >> 2) & 63, b = item >> 8, bh = b * 4 + hh, s0 = c * 128;
  const int mi = w >> 1, nb = (w & 1) * 2;
  const bf16_t* vb_ = p.RVT + ((size_t)(bh * 128 + 32 * mi + r)) * SEQ + s0 + 8 * h;
  const bf16_t* k0 = p.RKT + ((size_t)(bh * 128 + 32 * nb + r)) * SEQ + s0 + 8 * h;
  const bf16_t* k1 = k0 + (size_t)32 * SEQ;
  f32x16 a0 = zero16(), a1 = zero16();
#pragma unroll
  for (int s = 0; s < 8; ++s) {
    bf16x8 a = ld16(vb_ + 16 * s), b0 = ld16(k0 + 16 * s), b1 = ld16(k1 + 16 * s);
    a0 = MFMA32(a, b0, a0); a1 = MFMA32(a, b1, a1);
  }
  float* dst = p.KV + (size_t)item * 16384;
#pragma unroll
  for (int e = 0; e < 16; ++e) {
    const int v = 32 * mi + crow(e, h);
    dst[v * 128 + 32 * nb + r] = a0[e];
    dst[v * 128 + 32 * nb + 32 + r] = a1[e];
  }
}
DI void scan_body(const Params& p, int idx) {
  const int e = idx & 16383, bh = idx >> 14, b = bh >> 2, h = bh & 3;
  const float cd = __expf(128.f * logg_h(h));
  float S = 0.f;
  for (int c0 = 0; c0 < 64; c0 += 32) {
    float kv[32];
#pragma unroll
    for (int u = 0; u < 32; ++u) kv[u] = p.KV[(size_t)((b * 64 + c0 + u) * 4 + h) * 16384 + e];
#pragma unroll
    for (int u = 0; u < 32; ++u) {
      p.SPREV[(size_t)((b * 64 + c0 + u) * 4 + h) * 16384 + e] = f2bf(S);
      S = cd * S + kv[u];
    }
  }
}
DI void retout_mfma(const Params& p, int task) {
  const int lane = mytid() & 63, r = lane & 31, h = lane >> 5;
  const int item = task >> 2, nt = task & 3;
  const int hh = item & 3, c = (item >> 2) & 63, b = item >> 8, bh = b * 4 + hh, s0 = c * 128, t0 = b * SEQ + s0;
  const float lg = logg_h(hh);
  const int n = 32 * nt + r;
  bf16x8 qf[8];
#pragma unroll
  for (int s = 0; s < 8; ++s) qf[s] = ld16(p.RQ + (size_t)(t0 + n) * 512 + hh * 128 + 16 * s + 8 * h);
  f32x16 acc[4];
#pragma unroll
  for (int vi = 0; vi < 4; ++vi) {
    acc[vi] = zero16();
    const bf16_t* sp = p.SPREV + (size_t)item * 16384 + (size_t)(32 * vi + r) * 128 + 8 * h;
#pragma unroll
    for (int s = 0; s < 8; ++s) acc[vi] = MFMA32(ld16(sp + 16 * s), qf[s], acc[vi]);
    __builtin_amdgcn_sched_barrier(0);
  }
  {
    const float xi = __expf((float)(n + 1) * lg);
#pragma unroll
    for (int vi = 0; vi < 4; ++vi)
#pragma unroll
      for (int e = 0; e < 16; ++e) acc[vi][e] *= xi;
  }
  for (int mt = 0; mt <= nt; ++mt) {
    f32x16 sa = zero16();
    const bf16_t* kp = p.RK + (size_t)(t0 + 32 * mt + r) * 512 + hh * 128 + 8 * h;
#pragma unroll
    for (int s = 0; s < 8; ++s) sa = MFMA32(ld16(kp + 16 * s), qf[s], sa);
    float pv[16];
#pragma unroll
    for (int e = 0; e < 16; ++e) {
      const int dm = n - (32 * mt + crow(e, h));
      pv[e] = (dm >= 0) ? sa[e] * __expf((float)dm * lg) : 0.f;
    }
#pragma unroll
    for (int s2 = 0; s2 < 2; ++s2) {
      bf16x8 bfr = pack8(pv[8 * s2], pv[8 * s2 + 1], pv[8 * s2 + 2], pv[8 * s2 + 3], pv[8 * s2 + 4], pv[8 * s2 + 5], pv[8 * s2 + 6], pv[8 * s2 + 7]);
#pragma unroll
      for (int vi = 0; vi < 4; ++vi) {
        bf16x8 afr = ld8x2(p.RVT + ((size_t)(bh * 128 + 32 * vi + r)) * SEQ + s0 + 32 * mt + 16 * s2 + 4 * h);
        acc[vi] = MFMA32(afr, bfr, acc[vi]);
      }
      __builtin_amdgcn_sched_barrier(0);
    }
  }
  float sum = 0.f;
#pragma unroll
  for (int vi = 0; vi < 4; ++vi)
#pragma unroll
    for (int e = 0; e < 16; ++e) sum += acc[vi][e];
  sum += __shfl_xor(sum, 32);
  const float mu = sum * (1.f / 128.f);
  float var = 0.f;
#pragma unroll
  for (int vi = 0; vi < 4; ++vi)
#pragma unroll
    for (int e = 0; e < 16; ++e) { float d = acc[vi][e] - mu; var += d * d; }
  var += __shfl_xor(var, 32);
  const float rs = rsqrtf(var * (1.f / 128.f) + 1e-6f);
#pragma unroll
  for (int vi = 0; vi < 4; ++vi)
#pragma unroll
    for (int g4 = 0; g4 < 4; ++g4) {
      const int v0 = 32 * vi + 8 * g4 + 4 * h;
      uint2 gt = *(const uint2*)(p.RGT + (size_t)(t0 + n) * 512 + hh * 128 + v0);
      float y0 = (acc[vi][4 * g4 + 0] - mu) * rs * __uint_as_float(gt.x << 16);
      float y1 = (acc[vi][4 * g4 + 1] - mu) * rs * __uint_as_float(gt.x & 0xffff0000u);
      float y2 = (acc[vi][4 * g4 + 2] - mu) * rs * __uint_as_float(gt.y << 16);
      float y3 = (acc[vi][4 * g4 + 3] - mu) * rs * __uint_as_float(gt.y & 0xffff0000u);
      *(uint2*)(p.RA + (size_t)(t0 + n) * DM + hh * 128 + v0) = pack4(y0, y1, y2, y3);
    }
}
#define HID_STRIDE 264
DI void compress_mfma(const Params& p, int item, char* smem) {
  float* PART = (float*)smem;
  bf16_t* HIDL = (bf16_t*)(smem + 4 * 16 * 256 * 4);
  const int tid = mytid(), lane = tid & 63, w = tid >> 6, r = lane & 31, h = lane >> 5;
  const int kv = item >> 7, bg = (item >> 5) & 3, rt = item & 31, n0 = rt * 16, b = bg >> 1, g = bg & 1;
  const bf16_t* src = kv ? p.NVC : p.NKC; const bf16_t* W1 = kv ? p.W1Tv : p.W1Tk; const bf16_t* W2 = kv ? p.W2Tv : p.W2Tk;
  const float* B1 = kv ? p.B1Pv : p.B1Pk;
  {
    const int kq = w >> 1, ch = w & 1;
    const int n = min(n0 + (r & 15), 510);
    const bf16_t* ab = src + ((size_t)(b * SEQ + 16 * n)) * 128 + g * 64 + 8 * h;
    const bf16_t* bb = W1 + (size_t)(128 * ch + r) * 2048 + 8 * h;
    f32x16 acc[4];
#pragma unroll
    for (int ct = 0; ct < 4; ++ct) acc[ct] = zero16();
#pragma unroll 4
    for (int s = 32 * kq; s < 32 * kq + 32; ++s) {
      const bf16x8 a = ld16(ab + (s >> 2) * 128 + (s & 3) * 16);
#pragma unroll
      for (int ct = 0; ct < 4; ++ct) acc[ct] = MFMA32(a, ld16(bb + (size_t)ct * 32 * 2048 + 16 * s), acc[ct]);
    }
#pragma unroll
    for (int ct = 0; ct < 4; ++ct)
#pragma unroll
      for (int e = 0; e < 8; ++e) PART[(kq * 16 + crow(e, h)) * 256 + 128 * ch + 32 * ct + r] = acc[ct][e];
  }
  __syncthreads();
#pragma unroll
  for (int i = 0; i < 8; ++i) {
    const int idx = tid + 512 * i, row = idx >> 8, col = idx & 255;
    const float v = PART[row * 256 + col] + PART[(16 + row) * 256 + col] + PART[(32 + row) * 256 + col] + PART[(48 + row) * 256 + col] + B1[col];
    HIDL[row * HID_STRIDE + col] = f2bf(gelu_tanh(v));
  }
  __syncthreads();
  if (w < 2) {
    f32x16 acc = zero16();
#pragma unroll
    for (int s = 0; s < 16; ++s) acc = MFMA32(ld16(HIDL + (r & 15) * HID_STRIDE + 16 * s + 8 * h), ld16(W2 + (size_t)(32 * w + r) * 256 + 16 * s + 8 * h), acc);
    const int e_ = 32 * w + r;
    if (kv == 0) {
#pragma unroll
      for (int e = 0; e < 8; ++e) { const int n = n0 + crow(e, h); p.KC[((size_t)bg * 512 + n) * 64 + e_] = (n < 511) ? f2bf(acc[e]) : (bf16_t)0; }
    } else {
#pragma unroll
      for (int g4 = 0; g4 < 2; ++g4) {
        const int n = n0 + 8 * g4 + 4 * h;
        float v3 = (n + 3 < 511) ? acc[4 * g4 + 3] : 0.f;
        *(uint2*)(p.VCT + ((size_t)bg * 64 + e_) * 512 + n) = pack4(acc[4 * g4], acc[4 * g4 + 1], acc[4 * g4 + 2], v3);
      }
    }
  }
  __syncthreads();
}
DI void kmax_body2(const Params& p, int vb) {
  const int tid = mytid(), g = tid & 1, t = vb * 256 + (tid >> 1), b = t >> 13;
  const bf16_t* k = p.NKS + (size_t)t * 128 + g * 64; const bf16_t* kw = p.NKW + (size_t)t * 128 + g * 64;
  float ss = 0.f, sw = 0.f;
  for (int d = 0; d < 64; d += 8) {
    uint4 a = *(const uint4*)(k + d), c = *(const uint4*)(kw + d);
    const unsigned aa[4] = {a.x, a.y, a.z, a.w}, cc[4] = {c.x, c.y, c.z, c.w};
#pragma unroll
    for (int q = 0; q < 4; ++q) {
      float x0 = __uint_as_float(aa[q] << 16), x1 = __uint_as_float(aa[q] & 0xffff0000u);
      float y0 = __uint_as_float(cc[q] << 16), y1 = __uint_as_float(cc[q] & 0xffff0000u);
      ss += x0 * x0 + x1 * x1; sw += y0 * y0 + y1 * y1;
    }
  }
  float m1 = sqrtf(ss), m2 = sqrtf(sw);
  for (int o = 2; o < 64; o <<= 1) { m1 = fmaxf(m1, __shfl_xor(m1, o)); m2 = fmaxf(m2, __shfl_xor(m2, o)); }
  if ((tid & 63) < 2) { atomicMax(&p.ksmax[b * 2 + g], __float_as_uint(m1)); atomicMax(&p.ksmax[4 + b * 2 + g], __float_as_uint(m2)); }
}
DI void kcmax_body(const Params& p, int idx) {
  const bf16_t* k = p.KC + (size_t)idx * 64;
  float ss = 0.f;
  for (int d = 0; d < 64; ++d) { float v = bf2f(k[d]); ss += v * v; }
  atomicMax(&p.ksmax[8 + (idx >> 9)], __float_as_uint(sqrtf(ss)));
}

#define NSA_IMP 0
#define NSA_SELM 65536
#define NSA_KV 66816
#define KV_ROW 144
#define KV_TILE (64 * KV_ROW)
template <int CTRL> DI float dpp_f2(float x) { return __builtin_bit_cast(float, __builtin_amdgcn_mov_dpp(__builtin_bit_cast(int, x), CTRL, 0xf, 0xf, true)); }
DI float quad_sum(float v) { v += dpp_f2<0xB1>(v); v += dpp_f2<0x4E>(v); return v; }
DI bf16x8 lds8x2(const char* ptr) {
  uint2 a = *(const uint2*)ptr, b = *(const uint2*)(ptr + 16);
  uint4 v; v.x = a.x; v.y = a.y; v.z = b.x; v.w = b.y;
  return __builtin_bit_cast(bf16x8, v);
}

DI void nsa_item(const Params& p, int item, char* smem) {
  const int tid = mytid(), lane = tid & 63, w = tid >> 6, r = lane & 31, h = lane >> 5;
  const int ti = item >> 2, bg = item & 3, b = bg >> 1, g = bg & 1;
  const int ts = ti * 64, tokg0 = b * SEQ + ts;
  const int tkl = 8 * w + (r >> 2), hl = r & 3, hd = g * 4 + hl, tpos = ts + tkl;
  float* IMPA = (float*)(smem + NSA_IMP); float* IMPB = IMPA + 64 * 128;
  unsigned* SELM = (unsigned*)(smem + NSA_SELM);
  char* KVB = smem + NSA_KV;
  const float ksm = __uint_as_float(p.ksmax[bg]), kwm = __uint_as_float(p.ksmax[4 + bg]), kcm = __uint_as_float(p.ksmax[8 + bg]);

  bf16x8 qf[4];
#pragma unroll
  for (int s = 0; s < 4; ++s) qf[s] = ld16(p.NQ + (size_t)(tokg0 + tkl) * 512 + hd * 64 + 16 * s + 8 * h);
  float qq = 0.f;
#pragma unroll
  for (int s = 0; s < 4; ++s) {
    uint4 u = __builtin_bit_cast(uint4, qf[s]);
    const unsigned uu[4] = {u.x, u.y, u.z, u.w};
#pragma unroll
    for (int q = 0; q < 4; ++q) { float x0 = __uint_as_float(uu[q] << 16), x1 = __uint_as_float(uu[q] & 0xffff0000u); qq += x0 * x0 + x1 * x1; }
  }
  qq += __shfl_xor(qq, 32);
  const float qn = sqrtf(qq);
  const int srow = tid >> 3, sch = tid & 7;
  const bf16_t* ksrc = p.NKS + ((size_t)(b * SEQ) + srow) * 128 + g * 64 + sch * 8;
  const bf16_t* vsrc = p.NVST + ((size_t)bg * 64 + srow) * SEQ + sch * 8;
  const bf16_t* kcs = p.KC + ((size_t)bg * 512 + srow) * 64 + sch * 8;
  const bf16_t* vcs = p.VCT + ((size_t)bg * 64 + srow) * 512 + sch * 8;
  char* sdst = KVB + srow * KV_ROW + sch * 16;
  {
    uint4 k0 = *(const uint4*)kcs, v0 = *(const uint4*)vcs;
    *(uint4*)sdst = k0; *(uint4*)(sdst + KV_TILE) = v0;
  }
  for (int q = tid; q < 64 * 128 * 2 / 4; q += NT) ((float4*)IMPA)[q] = make_float4(0.f, 0.f, 0.f, 0.f);
  __syncthreads();

#define RING_RUN(KS, KSTEP, VS, VSTEP, NTILES, NEED, COMPUTE)                                                                               \
  {                                                                                                                                         \
    for (int jj = 0; jj < (NTILES); ++jj) {                                                                                                 \
      uint4 ka_, va_;                                                                                                                       \
      ka_ = va_ = make_uint4(0u, 0u, 0u, 0u);                                                                                               \
      if (jj + 1 < (NTILES)) { ka_ = *(const uint4*)((KS) + (size_t)(jj + 1) * (KSTEP)); va_ = *(const uint4*)((VS) + (size_t)(jj + 1) * (VSTEP)); } \
      if (NEED(jj)) { const char* kb = KVB + (jj & 1) * 2 * KV_TILE; const char* vbuf = kb + KV_TILE; COMPUTE(jj, kb, vbuf) }               \
      if (jj + 1 < (NTILES)) { char* d2 = sdst + ((jj + 1) & 1) * 2 * KV_TILE; *(uint4*)d2 = ka_; *(uint4*)(d2 + KV_TILE) = va_; }          \
      __syncthreads();                                                                                                                      \
    }                                                                                                                                       \
  }
#define STAGE_PAIR0(KS, KSTEP, VS, VSTEP, NTILES) { uint4 k0_ = *(const uint4*)(KS), v0_ = *(const uint4*)(VS); *(uint4*)sdst = k0_; *(uint4*)(sdst + KV_TILE) = v0_; }
#define IMP_NONE(JJ, kh, pv)
#define ATT_TILE(kb, vbuf, INIT, FULL, MASKEXPR, SCALE, ACC, LACC, IMPHOOK, JJ)                                                             \
          {                                                                                                                                 \
            bf16x8 kf_[2][4], vf_[2][2][2];       \
            _Pragma("unroll") for (int kh = 0; kh < 2; ++kh)                                                                                \
              _Pragma("unroll") for (int s = 0; s < 4; ++s) kf_[kh][s] = *(const bf16x8*)(kb + (32 * kh + r) * KV_ROW + (16 * s + 8 * h) * 2); \
            _Pragma("unroll") for (int kh = 0; kh < 2; ++kh)                                                                                \
              _Pragma("unroll") for (int di = 0; di < 2; ++di)                                                                              \
                _Pragma("unroll") for (int s2 = 0; s2 < 2; ++s2) vf_[kh][di][s2] = lds8x2(vbuf + (32 * di + r) * KV_ROW + (32 * kh + 16 * s2 + 4 * h) * 2); \
            const bool full_ = (FULL);                                                                                                      \
            _Pragma("unroll") for (int kh = 0; kh < 2; ++kh) {                                                                              \
              f32x16 sa = fill16(INIT);                                                                                                     \
              _Pragma("unroll") for (int s = 0; s < 4; ++s) sa = MFMA32(kf_[kh][s], qf[s], sa);                                             \
              float pv[16];                                                                                                                 \
              _Pragma("unroll") for (int e = 0; e < 16; ++e) { const int key = 32 * kh + crow(e, h); pv[e] = (full_ || (MASKEXPR)) ? ex2(sa[e]) * (SCALE) : 0.f; } \
              LACC += ((pv[0] + pv[1]) + (pv[2] + pv[3])) + ((pv[4] + pv[5]) + (pv[6] + pv[7])) + ((pv[8] + pv[9]) + (pv[10] + pv[11])) + ((pv[12] + pv[13]) + (pv[14] + pv[15])); \
              IMPHOOK(JJ, kh, pv)                                                                                                           \
              const bf16x8 pk0 = pack8(pv[0], pv[1], pv[2], pv[3], pv[4], pv[5], pv[6], pv[7]);                                             \
              const bf16x8 pk1 = pack8(pv[8], pv[9], pv[10], pv[11], pv[12], pv[13], pv[14], pv[15]);                                       \
              _Pragma("unroll") for (int di = 0; di < 2; ++di) {                                                                            \
                ACC[di] = MFMA32(vf_[kh][di][0], pk0, ACC[di]);                                                                             \
                ACC[di] = MFMA32(vf_[kh][di][1], pk1, ACC[di]);                                                                             \
              }                                                                                                                             \
            }                                                                                                                               \
          }
  const float mbc = qn * kcm;
  int nvalid = (tpos >= 31) ? ((tpos - 31) >> 4) + 1 : 0;
  if (nvalid > 511) nvalid = 511;
  int nvw = (ts + 8 * w + 7 >= 31) ? ((ts + 8 * w + 7 - 31) >> 4) + 1 : 0;
  if (nvw > 511) nvw = 511;
  int nvmin = (ts + 8 * w >= 31) ? ((ts + 8 * w - 31) >> 4) + 1 : 0;
  if (nvmin > 511) nvmin = 511;
  int nvall = ((ts + 63 - 31) >> 4) + 1;
  if (nvall > 511) nvall = 511;
  const int nct = (nvall + 63) >> 6;
  float lsum = 0.f;
#define CMP_NEED(jj) (64 * (jj) < nvw)
#define CMPA_COMPUTE(jj, kb, vbuf)                                                                                                          \
          { _Pragma("unroll") for (int kh = 0; kh < 2; ++kh) {                                                                              \
              f32x16 sa = fill16(-mbc);                                                                                                     \
              _Pragma("unroll") for (int s = 0; s < 4; ++s) sa = MFMA32(*(const bf16x8*)(kb + (32 * kh + r) * KV_ROW + (16 * s + 8 * h) * 2), qf[s], sa); \
              const bool full_ = 64 * (jj) + 64 <= nvmin;                                                                                   \
              _Pragma("unroll") for (int e = 0; e < 16; ++e) lsum += (full_ || (64 * (jj) + 32 * kh + crow(e, h) < nvalid)) ? ex2(sa[e]) : 0.f; \
            } }
  RING_RUN(kcs, 64 * 64, vcs, 64, nct, CMP_NEED, CMPA_COMPUTE)
  lsum += __shfl_xor(lsum, 32);
  const float invl = (lsum > 0.f) ? 1.f / lsum : 0.f;
  f32x16 oc[2]; oc[0] = zero16(); oc[1] = zero16();
  {
    float ldummy = 0.f;
    STAGE_PAIR0(kcs, 64 * 64, vcs, 64, nct) __syncthreads();
#define CMP_IMP(JJ, kh, pv)                                                                                                                 \
              _Pragma("unroll") for (int q = 0; q < 4; ++q) {                                                                               \
                float A_ = 2.f * (pv[4 * q] + pv[4 * q + 1] + pv[4 * q + 2]) + pv[4 * q + 3], B_ = pv[4 * q + 3];                           \
                A_ = quad_sum(A_); B_ = quad_sum(B_);                                                                                       \
                if (hl == 0) { const int j_ = 16 * (JJ) + 8 * kh + 2 * q + h; IMPA[tkl * 128 + j_] = A_; IMPB[tkl * 128 + j_] = B_; }        \
              }
#define CMPB_COMPUTE(jj, kb, vbuf) ATT_TILE(kb, vbuf, -mbc, 64 * (jj) + 64 <= nvmin, 64 * (jj) + key < nvalid, invl, oc, ldummy, CMP_IMP, jj)
    RING_RUN(kcs, 64 * 64, vcs, 64, nct, CMP_NEED, CMPB_COMPUTE)
  }
  for (int rep522 = 0; rep522 < (PROBE_DUP == 522 ? 2 : 1); ++rep522)
  {
    const int tl = 8 * w + (lane >> 3), sub = lane & 7;
    unsigned kv_[16], ki_[16];
#pragma unroll
    for (int c = 0; c < 16; ++c) {
      const int j = sub + 8 * c;
      float imp = IMPA[tl * 128 + j] + ((j > 0) ? IMPB[tl * 128 + j - 1] : 0.f);
      if (j == 0 || j == ti || j == ti - 1) imp = 1e9f;
      kv_[c] = (j <= ti) ? __float_as_uint(imp) : 0u;
      ki_[c] = (j <= ti) ? (unsigned)(128 - j) : 0u;
    }
    unsigned m0 = 0, m1 = 0, m2 = 0, m3 = 0;
    for (int it = 0; it < 16; ++it) {
      unsigned bv = kv_[0], bi = ki_[0];
#pragma unroll
      for (int c = 1; c < 16; ++c) { const bool gt = (kv_[c] > bv) || (kv_[c] == bv && ki_[c] > bi); bv = gt ? kv_[c] : bv; bi = gt ? ki_[c] : bi; }
#define TOPK_STEP(CTRL) { const unsigned ov = (unsigned)__builtin_amdgcn_mov_dpp((int)bv, CTRL, 0xf, 0xf, true), oi = (unsigned)__builtin_amdgcn_mov_dpp((int)bi, CTRL, 0xf, 0xf, true); \
        const bool gt = (ov > bv) || (ov == bv && oi > bi); bv = gt ? ov : bv; bi = gt ? oi : bi; }
      TOPK_STEP(0xB1) TOPK_STEP(0x4E) TOPK_STEP(0x141)
#undef TOPK_STEP
      if (bi != 0u) {
        const int js = 128 - (int)bi;
        const unsigned bit = 1u << (js & 31);
        if ((js >> 5) == 0) m0 |= bit; else if ((js >> 5) == 1) m1 |= bit; else if ((js >> 5) == 2) m2 |= bit; else m3 |= bit;
#pragma unroll
        for (int c = 0; c < 16; ++c) { const bool hit = (ki_[c] == bi); kv_[c] = hit ? 0u : kv_[c]; ki_[c] = hit ? 0u : ki_[c]; }
      }
    }
    if (sub == 0) { SELM[tl * 4 + 0] = m0; SELM[tl * 4 + 1] = m1; SELM[tl * 4 + 2] = m2; SELM[tl * 4 + 3] = m3; }
  }
  if (lane < 4) {
    unsigned u = 0;
#pragma unroll
    for (int t8 = 0; t8 < 8; ++t8) u |= SELM[(8 * w + t8) * 4 + lane];
    SELM[(64 + w) * 4 + lane] = u;
  }
  __syncthreads();
  const float* gt = p.GATE + (size_t)(tokg0 + tkl) * 24 + hd * 3;
  float* OUTL = IMPA;
  {
    const float g0 = gt[0];
#pragma unroll
    for (int e = 0; e < 16; ++e) { OUTL[e * 512 + tid] = g0 * oc[0][e]; OUTL[(16 + e) * 512 + tid] = g0 * oc[1][e]; }
  }
  STAGE_PAIR0(ksrc, 64 * 128, vsrc, 64, ti + 1) __syncthreads();
  const float mbs = qn * ksm;
  f32x16 osl[2]; osl[0] = zero16(); osl[1] = zero16();
  float lsel = 0.f;
#define SEL_NEED(jj) ((SELM[(64 + w) * 4 + ((jj) >> 5)] >> ((jj) & 31)) & 1u)
#define SEL_COMPUTE(jj, kb, vbuf) { const unsigned msel_ = SELM[tkl * 4 + ((jj) >> 5)]; \
      const float init_ = ((msel_ >> ((jj) & 31)) & 1u) ? -mbs : NEG_INF; ATT_TILE(kb, vbuf, init_, (jj) < ti, key <= tkl, 1.f, osl, lsel, IMP_NONE, jj) }
  RING_RUN(ksrc, 64 * 128, vsrc, 64, ti + 1, SEL_NEED, SEL_COMPUTE)
  lsel += __shfl_xor(lsel, 32);
  {
    const float g1 = gt[1] / lsel;
#pragma unroll
    for (int e = 0; e < 16; ++e) { OUTL[e * 512 + tid] += g1 * osl[0][e]; OUTL[(16 + e) * 512 + tid] += g1 * osl[1][e]; }
  }
  f32x16 ow[2]; ow[0] = zero16(); ow[1] = zero16();
  float lw = 0.f;
  const float mbw = qn * kwm;
  {
    const int j0w = (ti >= 8) ? ti - 8 : 0, nwt = ti - j0w + 1;
    const bf16_t* kws = p.NKW + ((size_t)(b * SEQ + 64 * j0w) + srow) * 128 + g * 64 + sch * 8;
    const bf16_t* vws = p.NVWT + ((size_t)bg * 64 + srow) * SEQ + 64 * j0w + sch * 8;
    STAGE_PAIR0(kws, 64 * 128, vws, 64, nwt) __syncthreads();
#define WIN_NEED(jj) true
#define WIN_COMPUTE(jj, kb, vbuf) { const int jw_ = j0w + (jj); const bool last_ = (jw_ == ti), first_ = (ti >= 8) && ((jj) == 0); \
      ATT_TILE(kb, vbuf, -mbw, !(last_ || first_), last_ ? (key <= tkl) : (key > tkl), 1.f, ow, lw, IMP_NONE, jj) }
    RING_RUN(kws, 64 * 128, vws, 64, nwt, WIN_NEED, WIN_COMPUTE)
  }
  lw += __shfl_xor(lw, 32);
  {
    const float g2 = gt[2] / lw;
#pragma unroll
    for (int di = 0; di < 2; ++di)
#pragma unroll
      for (int g4 = 0; g4 < 4; ++g4) {
        const int d0 = 32 * di + 8 * g4 + 4 * h;
        float y[4];
#pragma unroll
        for (int e = 0; e < 4; ++e) y[e] = OUTL[(16 * di + 4 * g4 + e) * 512 + tid] + g2 * ow[di][4 * g4 + e];
        *(uint2*)(p.RA + (size_t)(tokg0 + tkl) * DM + 512 + hd * 64 + d0) = pack4(y[0], y[1], y[2], y[3]);
      }
  }
  __syncthreads();
}

typedef float f32x4 __attribute__((ext_vector_type(4)));
#define MFMA16(a, b, c) __builtin_amdgcn_mfma_f32_16x16x32_bf16((a), (b), (c), 0, 0, 0)
constexpr int pk_clen(int i) { return 16 / (i + 1); }
constexpr int pk_coff(int i) { int s = 0; for (int q = 0; q < i; ++q) s += pk_clen(q); return s; }
constexpr int pk_cand(int c) {
  int i = 0; while (i < 16 && c >= pk_clen(i)) { c -= pk_clen(i); ++i; }
  return (i < 16) ? i * 16 + c : 256;
}
#define SC_STRIDE 132

DI void convert_row(const Params& p, int row, int lane);
DI unsigned f2key(float x, unsigned tag, unsigned tagmask) {
  const unsigned bits = __float_as_uint(x), m = (unsigned)((int)bits >> 31) | 0x80000000u;
  return ((bits ^ m) & ~tagmask) | tag;
}
DI float key2f(unsigned k, unsigned tagmask) {
  const unsigned u = k & ~tagmask;
  return __uint_as_float((u & 0x80000000u) ? (u ^ 0x80000000u) : ~u);
}
DI void peer_topk_tile(const Params& p, int vb, char* smem) {
  unsigned* SC = (unsigned*)smem;
  unsigned* ELK = (unsigned*)(smem + 256 * SC_STRIDE * 4);
  float* ELW = (float*)(ELK + 16 * 128);
  int* CT = (int*)(ELW + 16 * 128);
  const int tid = mytid(), lane = tid & 63, w = tid >> 6;
  const int t0 = vb * 16;
  if (tid < 64) { int i = 0, c = tid; while (i < 16 && c >= 16 / (i + 1)) { c -= 16 / (i + 1); ++i; } CT[tid] = (i < 16) ? i * 16 + c : 0; }
  for (int rep91 = 0; rep91 < (PROBE_DUP == 91 ? 2 : 1); ++rep91) {
    const int tq = lane & 15, kq = lane >> 4;
#pragma unroll
    for (int pi = 0; pi < 2; ++pi) {
      const int ph = 2 * w + pi;
      bf16x8 bfr[4];
#pragma unroll
      for (int s = 0; s < 4; ++s) bfr[s] = *(const bf16x8*)(p.PQ + (size_t)(t0 + tq) * 2048 + ph * 128 + 32 * s + 8 * kq);
#pragma unroll
      for (int j = 0; j < 8; ++j) {
        f32x4 acc = {0.f, 0.f, 0.f, 0.f};
#pragma unroll
        for (int s = 0; s < 4; ++s) {
          bf16x8 afr = *(const bf16x8*)(p.SUBK + ((size_t)(ph * 128 + 16 * j + tq)) * 128 + 32 * s + 8 * kq);
          acc = MFMA16(afr, bfr[s], acc);
        }
        const int n0 = 16 * j + 4 * kq;
        uint4 kv4;
        kv4.x = f2key(acc[0], 127u - n0, 127u); kv4.y = f2key(acc[1], 126u - n0, 127u); kv4.z = f2key(acc[2], 125u - n0, 127u); kv4.w = f2key(acc[3], 124u - n0, 127u);
        *(uint4*)(SC + (ph * 16 + tq) * SC_STRIDE + n0) = kv4;
      }
    }
  }
  __syncthreads();
  if (tid < 256) {
    unsigned* row = SC + tid * SC_STRIDE;
    unsigned gmax[16];
#pragma unroll
    for (int g = 0; g < 16; ++g) {
      uint4 a = *(uint4*)(row + g * 8), b = *(uint4*)(row + g * 8 + 4);
      gmax[g] = max(max(max(a.x, a.y), max(a.z, a.w)), max(max(b.x, b.y), max(b.z, b.w)));
    }
    unsigned outk[16];
#pragma unroll
    for (int k = 0; k < 16; ++k) {
      unsigned m = max(max(max(max(gmax[0], gmax[1]), max(gmax[2], gmax[3])), max(max(gmax[4], gmax[5]), max(gmax[6], gmax[7]))),
                       max(max(max(gmax[8], gmax[9]), max(gmax[10], gmax[11])), max(max(gmax[12], gmax[13]), max(gmax[14], gmax[15]))));
      const int n = 127 - (int)(m & 127u), gi = n >> 3;
      unsigned* gp = row + gi * 8;
      uint4 a = *(uint4*)gp, b = *(uint4*)(gp + 4);
      const unsigned v[8] = {a.x, a.y, a.z, a.w, b.x, b.y, b.z, b.w};
      unsigned nm = 0u;
#pragma unroll
      for (int e = 0; e < 8; ++e) nm = max(nm, (v[e] == m) ? 0u : v[e]);
      row[n] = 0u;
#pragma unroll
      for (int g = 0; g < 16; ++g) gmax[g] = (g == gi) ? nm : gmax[g];
      outk[k] = m;
    }
#pragma unroll
    for (int k = 0; k < 16; ++k) row[k] = outk[k];
  } else {
#pragma unroll 4
    for (int i = 0; i < 8; ++i) convert_row(p, (vb * 4 + (w - 4)) * 8 + i, lane);
  }
  __syncthreads();
  for (int rep93 = 0; rep93 < (PROBE_DUP == 93 ? 2 : 1); ++rep93) {
    const int q = tid >> 2, sub = tid & 3, t = q >> 3, pp = q & 7;
    const unsigned* ra = SC + ((2 * pp) * 16 + t) * SC_STRIDE;
    const unsigned* rb = SC + ((2 * pp + 1) * 16 + t) * SC_STRIDE;
    unsigned ck[13];
#pragma unroll
    for (int k = 0; k < 13; ++k) {
      const int ij = (sub == 0) ? pk_cand(4 * k) : (sub == 1) ? pk_cand(4 * k + 1) : (sub == 2) ? pk_cand(4 * k + 2) : pk_cand(4 * k + 3);
      const int ord = 4 * k + sub;
      ck[k] = (ij < 256) ? f2key(key2f(ra[ij >> 4], 127u) + key2f(rb[ij & 15], 127u), (unsigned)(63 - ord), 63u) : 0u;
    }
    unsigned w16[16];
#pragma unroll
    for (int k = 0; k < 16; ++k) {
      unsigned bm = max(max(max(max(ck[0], ck[1]), max(ck[2], ck[3])), max(max(ck[4], ck[5]), max(ck[6], ck[7]))), max(max(max(ck[8], ck[9]), max(ck[10], ck[11])), ck[12]));
      bm = max(bm, (unsigned)__builtin_amdgcn_mov_dpp((int)bm, 0xB1, 0xf, 0xf, true));
      bm = max(bm, (unsigned)__builtin_amdgcn_mov_dpp((int)bm, 0x4E, 0xf, 0xf, true));
#pragma unroll
      for (int c = 0; c < 13; ++c) ck[c] = (ck[c] == bm) ? 0u : ck[c];
      w16[k] = bm;
    }
    float l = 0.f; const float vmax = key2f(w16[0], 63u);
    float ev[16];
#pragma unroll
    for (int k = 0; k < 16; ++k) { ev[k] = __expf(key2f(w16[k], 63u) - vmax); l += ev[k]; }
    const float inv = 1.f / l;
#pragma unroll
    for (int k = 0; k < 16; ++k)
      if ((k & 3) == sub) {
        const int ij = CT[63 - (int)(w16[k] & 63u)];
        const int code = (127 - (int)(ra[ij >> 4] & 127u)) * 128 + (127 - (int)(rb[ij & 15] & 127u));
        ELK[t * 128 + pp * 16 + k] = ((unsigned)code << 7) | (unsigned)(pp * 16 + k);
        ELW[t * 128 + pp * 16 + k] = ev[k] * inv;
      }
  }
  __syncthreads();
  for (int rep94 = 0; rep94 < (PROBE_DUP == 94 ? 2 : 1); ++rep94)
#pragma unroll
  for (int tt = 0; tt < 2; ++tt) {
    const int t = 2 * w + tt;
    const unsigned e0 = ELK[t * 128 + 2 * lane], e1 = ELK[t * 128 + 2 * lane + 1];
    int r0 = 0, r1 = 0;
#pragma unroll 8
    for (int c = 0; c < 32; ++c) {
      const uint4 kq = *(const uint4*)(ELK + t * 128 + 4 * c);
      r0 += (kq.x < e0) + (kq.y < e0) + (kq.z < e0) + (kq.w < e0);
      r1 += (kq.x < e1) + (kq.y < e1) + (kq.z < e1) + (kq.w < e1);
    }
    const size_t gb = (size_t)(t0 + t) * 128;
    p.EIDX[gb + r0] = (int)(e0 >> 7); p.EIDX[gb + r1] = (int)(e1 >> 7);
    p.EW[gb + r0] = ELW[t * 128 + (e0 & 127)]; p.EW[gb + r1] = ELW[t * 128 + (e1 & 127)];
  }
  __syncthreads();
}

DI float dot2bf(unsigned a, unsigned b, float acc) { return __builtin_amdgcn_fdot2_f32_bf16(__builtin_bit_cast(bf16x2_t, a), __builtin_bit_cast(bf16x2_t, b), acc, false); }
template <int CTRL> DI float dpp_f(float x) { return __builtin_bit_cast(float, __builtin_amdgcn_mov_dpp(__builtin_bit_cast(int, x), CTRL, 0xf, 0xf, true)); }
DI float row16_sum(float v) { v += dpp_f<0x128>(v); v += dpp_f<0x124>(v); v += dpp_f<0x122>(v); v += dpp_f<0x121>(v); return v; }
DI float dot_row(const uint4 (&u)[8], const uint4 (&h)[8]) {
  float d = 0.f;
#pragma unroll
  for (int j = 0; j < 8; ++j) { d = dot2bf(u[j].x, h[j].x, d); d = dot2bf(u[j].y, h[j].y, d); d = dot2bf(u[j].z, h[j].z, d); d = dot2bf(u[j].w, h[j].w, d); }
  return row16_sum(d);
}
DI void axpy_row(float (&acc)[64], const uint4 (&v)[8], float c) {
#pragma unroll
  for (int j = 0; j < 8; ++j) {
    const unsigned ww[4] = {v[j].x, v[j].y, v[j].z, v[j].w};
#pragma unroll
    for (int q = 0; q < 4; ++q) {
      acc[j * 8 + 2 * q] += c * __uint_as_float(ww[q] << 16);
      acc[j * 8 + 2 * q + 1] += c * __uint_as_float(ww[q] & 0xffff0000u);
    }
  }
}
DI void axpy_half(float (&acc)[32], const uint4 (&v)[4], float c) {
#pragma unroll
  for (int j = 0; j < 4; ++j) {
    const unsigned ww[4] = {v[j].x, v[j].y, v[j].z, v[j].w};
#pragma unroll
    for (int q = 0; q < 4; ++q) {
      acc[j * 8 + 2 * q] += c * __uint_as_float(ww[q] << 16);
      acc[j * 8 + 2 * q + 1] += c * __uint_as_float(ww[q] & 0xffff0000u);
    }
  }
}
#ifndef PEER_TILE_SHIFT
#define PEER_TILE_SHIFT 8
#endif
DI void fma16_fp8(float& d, const uint4& u, const float* hv) {
  const unsigned ww[4] = {u.x, u.y, u.z, u.w};
#pragma unroll
  for (int q = 0; q < 4; ++q) {
    f32x2_t a = __builtin_amdgcn_cvt_pk_f32_fp8((int)ww[q], false), b = __builtin_amdgcn_cvt_pk_f32_fp8((int)ww[q], true);
    d += a[0] * hv[4 * q] + a[1] * hv[4 * q + 1] + b[0] * hv[4 * q + 2] + b[1] * hv[4 * q + 3];
  }
}
DI float dot_row8(const uint4 (&u)[4], const float (&hv)[64]) {
  float d0 = 0.f, d1 = 0.f;
  fma16_fp8(d0, u[0], hv); fma16_fp8(d1, u[1], hv + 16); fma16_fp8(d0, u[2], hv + 32); fma16_fp8(d1, u[3], hv + 48);
  return row16_sum(d0 + d1);
}
DI void axpy_row8(float (&acc)[64], const uint4 (&v)[4], float c) {
#pragma unroll
  for (int j = 0; j < 4; ++j) {
    const unsigned ww[4] = {v[j].x, v[j].y, v[j].z, v[j].w};
#pragma unroll
    for (int q = 0; q < 4; ++q) {
      f32x2_t a = __builtin_amdgcn_cvt_pk_f32_fp8((int)ww[q], false), b = __builtin_amdgcn_cvt_pk_f32_fp8((int)ww[q], true);
      acc[j * 16 + 4 * q] += c * a[0]; acc[j * 16 + 4 * q + 1] += c * a[1]; acc[j * 16 + 4 * q + 2] += c * b[0]; acc[j * 16 + 4 * q + 3] += c * b[1];
    }
  }
}
DI void peer_gather_block(const Params& p, int vb, char* smem) {
  unsigned* ELK = (unsigned*)smem;
  float* ELC = (float*)(smem + 32768);
  const int tid = mytid(), lane = tid & 63, w = tid >> 6, grp = lane >> 4, i = lane & 15;
  const int tokbase = vb * 64;
  for (int q = tid; q < 64 * 128 / 4; q += NT) {
    ((uint4*)ELK)[q] = ((const uint4*)(p.EIDX + (size_t)tokbase * 128))[q];
    ((float4*)ELC)[q] = ((const float4*)(p.EW + (size_t)tokbase * 128))[q];
  }
  __syncthreads();
#pragma unroll 1
  for (int tt = 0; tt < 2; ++tt) {
    const int tl = w * 8 + grp * 2 + tt, tok = tokbase + tl;
    const unsigned* kk = ELK + tl * 128;
    float* cc = ELC + tl * 128;
    uint4 b0[4], b1[4], b2[4], b3[4];
#define ROW_LOAD(BUF, BASE, E) { const unsigned e_ = kk[E]; _Pragma("unroll") for (int j = 0; j < 4; ++j) BUF[j] = *(const uint4*)(BASE + (size_t)e_ * DM + j * 256); }
    {
      float hv[64];
#pragma unroll
      for (int j = 0; j < 4; ++j)
#pragma unroll
        for (int hf = 0; hf < 2; ++hf) {
          uint4 a = *(const uint4*)(p.RA + (size_t)tok * DM + j * 256 + i * 16 + hf * 8);
          const unsigned aa[4] = {a.x, a.y, a.z, a.w};
#pragma unroll
          for (int q = 0; q < 4; ++q) { hv[j * 16 + hf * 8 + 2 * q] = __uint_as_float(aa[q] << 16); hv[j * 16 + hf * 8 + 2 * q + 1] = __uint_as_float(aa[q] & 0xffff0000u); }
        }
      const unsigned char* ub_ = p.PDN8 + i * 16;
#define DN_COMP(BUF, E) { const unsigned e_ = kk[E]; float d_ = dot_row8(BUF, hv) * p.SDN[e_]; float c_ = cc[E] * gelu_tanh(d_) * p.SUP[e_]; if (i == 0) cc[E] = c_; }
      ROW_LOAD(b0, ub_, 0) ROW_LOAD(b1, ub_, 1) ROW_LOAD(b2, ub_, 2) ROW_LOAD(b3, ub_, 3)
      for (int e = 0; e < 128; e += 4) {
        DN_COMP(b0, e)     if (e + 4 < 128) ROW_LOAD(b0, ub_, e + 4)
        DN_COMP(b1, e + 1) if (e + 4 < 128) ROW_LOAD(b1, ub_, e + 5)
        DN_COMP(b2, e + 2) if (e + 4 < 128) ROW_LOAD(b2, ub_, e + 6)
        DN_COMP(b3, e + 3) if (e + 4 < 128) ROW_LOAD(b3, ub_, e + 7)
      }
#undef DN_COMP
    }
    {
      float acc[64];
#pragma unroll
      for (int e = 0; e < 64; ++e) acc[e] = 0.f;
      const unsigned char* vbase = p.PUP8 + i * 16;
      ROW_LOAD(b0, vbase, 0) ROW_LOAD(b1, vbase, 1) ROW_LOAD(b2, vbase, 2) ROW_LOAD(b3, vbase, 3)
      for (int e = 0; e < 128; e += 4) {
        axpy_row8(acc, b0, cc[e]);     if (e + 4 < 128) ROW_LOAD(b0, vbase, e + 4)
        axpy_row8(acc, b1, cc[e + 1]); if (e + 4 < 128) ROW_LOAD(b1, vbase, e + 5)
        axpy_row8(acc, b2, cc[e + 2]); if (e + 4 < 128) ROW_LOAD(b2, vbase, e + 6)
        axpy_row8(acc, b3, cc[e + 3]); if (e + 4 < 128) ROW_LOAD(b3, vbase, e + 7)
      }
      const int b = tok >> 13;
      const float* ga2 = p.mod + b * 6144 + 5120;
      const float* orow = p.out + (size_t)tok * DM; float* grow = p.gout + (size_t)tok * DM;
      float ss = 0.f;
#pragma unroll
      for (int j = 0; j < 4; ++j)
#pragma unroll
        for (int q4 = 0; q4 < 4; ++q4) {
          const int col = j * 256 + i * 16 + q4 * 4;
          float4 x1 = *(const float4*)(orow + col), gg = *(const float4*)(ga2 + col);
          float* q = acc + j * 16 + q4 * 4;
          q[0] = x1.x + gg.x * q[0]; q[1] = x1.y + gg.y * q[1]; q[2] = x1.z + gg.z * q[2]; q[3] = x1.w + gg.w * q[3];
          ss += q[0] * q[0] + q[1] * q[1] + q[2] * q[2] + q[3] * q[3];
        }
      ss = row16_sum(ss);
      const float rstd = rsqrtf(ss * (1.f / DM) + 1e-6f);
#pragma unroll
      for (int j = 0; j < 4; ++j)
#pragma unroll
        for (int q4 = 0; q4 < 4; ++q4) {
          const int col = j * 256 + i * 16 + q4 * 4;
          float4 gf = *(const float4*)(p.g_final + col);
          const float* q = acc + j * 16 + q4 * 4;
          *(float4*)(grow + col) = make_float4(q[0] * rstd * gf.x, q[1] * rstd * gf.y, q[2] * rstd * gf.z, q[3] * rstd * gf.w);
        }
    }
#undef ROW_LOAD
  }
  __syncthreads();
}
DI void convert_row(const Params& p, int row, int lane) {
  const int tb = row >> 14, rr = row & 16383;
  const float* src = (tb ? p.peer_up : p.peer_down) + (size_t)rr * DM;
  float4 x[4]; float am = 0.f;
#pragma unroll
  for (int q = 0; q < 4; ++q) {
    x[q] = *(const float4*)(src + q * 256 + lane * 4);
    am = fmaxf(am, fmaxf(fmaxf(fabsf(x[q].x), fabsf(x[q].y)), fmaxf(fabsf(x[q].z), fabsf(x[q].w))));
  }
  for (int o = 32; o; o >>= 1) am = fmaxf(am, __shfl_xor(am, o));
  const float sc = (am > 0.f) ? am * (1.f / 448.f) : 1.f, inv = (am > 0.f) ? 448.f / am : 1.f;
  unsigned* dst = (unsigned*)((tb ? p.PUP8 : p.PDN8) + (size_t)rr * DM);
#pragma unroll
  for (int q = 0; q < 4; ++q) {
    int wd = 0;
    wd = __builtin_amdgcn_cvt_pk_fp8_f32(x[q].x * inv, x[q].y * inv, wd, false);
    wd = __builtin_amdgcn_cvt_pk_fp8_f32(x[q].z * inv, x[q].w * inv, wd, true);
    dst[q * 64 + lane] = (unsigned)wd;
  }
  if (lane == 0) (tb ? p.SUP : p.SDN)[rr] = sc;
}

#define N_PHASES 11
template <int PH>
DI void run_phase(const Params& p, char* smem) {
  const int nb = gridDim.x, bid = blockIdx.x, tid = mytid();
  if (PH == 0) {
    for (int vb = bid; vb < PH0_MOD; vb += nb) ph0_body(p, vb, smem);
  } else if (PH == 1) {
    constexpr int kPrepA = (PH0_WIN - PH0_MOD) + (PH0_ROPE - PH0_SUBK);
    for (int vb = bid; vb < T_TOK / 8 + kPrepA; vb += nb) {
      if (vb < T_TOK / 8) rownorm_body(p.x, p.g_mix, p.mod, 0, 1024, p.RA, vb);
      else { const int j = vb - T_TOK / 8; ph0_body(p, (j < PH0_WIN - PH0_MOD) ? PH0_MOD + j : PH0_SUBK + (j - (PH0_WIN - PH0_MOD)), smem); }
    }
  } else if (PH == 2) {
    {
      pg8::StaticOrder S; S.init(T_TOK, NPROJ, nb, bid);
      const pg8::Gemm g{p.RA, p.WinT, T_TOK, NPROJ, 1024};
      pg8::gemm_phase((PG8_LAS unsigned char*)smem, g, S, EpiProj8{p});
    }
    {
      constexpr int kPrepB = (PH0_SUBK - PH0_WIN) + (PH0_B1P - PH0_ROPE);
      const int rem = (64 * 14) % nb;
      if (rem == 0 || bid >= rem) {
        for (int j = (rem == 0) ? bid : bid - rem; j < kPrepB; j += (rem == 0) ? nb : nb - rem)
          ph0_body(p, (j < PH0_SUBK - PH0_WIN) ? PH0_WIN + j : PH0_ROPE + (j - (PH0_SUBK - PH0_WIN)), smem);
      }
    }
  } else if (PH == 3) {
    for (int vb = bid; vb < 256 + 512 + 64; vb += nb) {
      if (vb < 256) compress_mfma(p, vb, smem);
      else if (vb < 256 + 512) retkv_mfma(p, vb - 256);
      else kmax_body2(p, vb - 768);
    }
  } else if (PH == 4) {
    for (int vb = bid; vb < 256 + 4; vb += nb) {
      if (vb < 256) scan_body(p, vb * NT + tid);
      else kcmax_body(p, (vb - 256) * NT + tid);
    }
  } else if (PH == 5) {
    for (int rep = 0; rep < (PROBE_DUP == 51 ? 2 : 1); ++rep)
      for (int vb = bid; vb < 256; vb += nb) retout_mfma(p, vb * 8 + (tid >> 6));
    for (int rep = 0; rep < (PROBE_DUP == 52 ? 2 : 1); ++rep)
      for (int vb = bid; vb < 512; vb += nb) nsa_item(p, (vb < 256) ? vb : 767 - vb, smem);
  } else if (PH == 6) {
    pg8::StaticOrder S; S.init(T_TOK, 1024, nb, bid);
    const pg8::Gemm g{p.RA, p.WoutT, T_TOK, 1024, 1024};
    pg8::gemm_phase((PG8_LAS unsigned char*)smem, g, S, EpiOut8{p.x, p.out, p.mod});
  } else if (PH == 7) {
    for (int vb = bid; vb < T_TOK / 8; vb += nb) rownorm_body(p.out, p.g_ffn, p.mod, 3072, 4096, p.RA, vb);
  } else if (PH == 8) {
    pg8::StaticOrder S; S.init(T_TOK, 2048, nb, bid);
    const pg8::Gemm g{p.RA, p.WqT, T_TOK, 2048, 1024};
    pg8::gemm_phase((PG8_LAS unsigned char*)smem, g, S, EpiPQ8{p.PQ});
  } else if (PH == 9) {
    for (int vb = bid; vb < T_TOK / 16; vb += nb) peer_topk_tile(p, vb, smem);
  } else if (PH == 10) {
    for (int vb = bid; vb < T_TOK / 64; vb += nb) peer_gather_block(p, vb, smem);
  }
}


#define XB_TMO      128
#define XB_XCNT(j)  (256  + 64 * (j))
#define XB_XSUB(j)  (1280 + 64 * (j))
#define XB_XGEN(j)  (2304 + 64 * (j))
#define XB_TOP      3328
#define XB_TOPGEN   3392
#define XCD_BAR_WORDS 3456
#define XB_SPIN_CAP (1u << 22)
#define LAS __attribute__((address_space(3)))
DI unsigned xb_ld(unsigned* p) { return __hip_atomic_load(p, __ATOMIC_RELAXED, __HIP_MEMORY_SCOPE_AGENT); }
DI unsigned xb_add(unsigned* p, unsigned v) { return __hip_atomic_fetch_add(p, v, __ATOMIC_RELAXED, __HIP_MEMORY_SCOPE_AGENT); }
DI unsigned xb_xcc_id() { return (unsigned)__builtin_amdgcn_s_getreg((3 << 11) | 20) & 0xFu; }
#define XB_SPIN(cond, bar) do { unsigned _sp = 0; while (cond) { __builtin_amdgcn_s_sleep(1); \
    if ((++_sp & 255u) == 0u) { if (xb_ld(&(bar)[XB_TMO])) break; if (_sp > XB_SPIN_CAP) { atomicAdd(&(bar)[XB_TMO], 1u); break; } } } } while (0)
struct XcdBarrier { unsigned* bar; unsigned x; volatile LAS unsigned* st; };
DI XcdBarrier xcd_barrier_post(unsigned* bar, volatile LAS unsigned* st) {
  XcdBarrier b; b.bar = bar; b.x = xb_xcc_id(); b.st = st;
  if (threadIdx.x == 0) (void)xb_add(&bar[XB_XCNT(b.x)], 1u);
  return b;
}
DI void xcd_barrier_complete(unsigned* bar, unsigned x, unsigned& nloc, unsigned& nx) {
  const unsigned G = gridDim.x * gridDim.y * gridDim.z;
  unsigned sum, cnt, mine, sp = 0u;
  for (;;) {
    sum = 0u; cnt = 0u; mine = 0u;
#pragma unroll
    for (unsigned j = 0; j < 16; ++j) { const unsigned c = xb_ld(&bar[XB_XCNT(j)]); sum += c; cnt += (c > 0u) ? 1u : 0u; mine = (j == x) ? c : mine; }
    if (sum == G) break;
    __builtin_amdgcn_s_sleep(1);
    if ((++sp & 255u) == 0u) { if (xb_ld(&bar[XB_TMO])) break; if (sp > XB_SPIN_CAP) { atomicAdd(&bar[XB_TMO], 1u); break; } }
  }
  nloc = mine > 0u ? mine : 1u; nx = cnt > 0u ? cnt : 1u;
}
DI void xcd_barrier(const XcdBarrier& b) {
  asm volatile("s_waitcnt vmcnt(0)" ::: "memory");
  __syncthreads();
  if (threadIdx.x == 0) {
    unsigned* bar = b.bar;
    __builtin_amdgcn_s_waitcnt(0);
    unsigned nloc = b.st[0], nx = b.st[1];
    if (nloc == 0u) { xcd_barrier_complete(bar, b.x, nloc, nx); b.st[0] = nloc; b.st[1] = nx; }
    const unsigned old = xb_add(&bar[XB_XSUB(b.x)], 1u);
    const unsigned gen = old / nloc;
    if (old + 1u == (gen + 1u) * nloc) {
      __builtin_amdgcn_fence(__ATOMIC_RELEASE, "agent");
      asm volatile("s_waitcnt vmcnt(0)" ::: "memory");
      const unsigned og = xb_add(&bar[XB_TOP], 1u);
      const unsigned tg = og / nx;
      if (og + 1u == (tg + 1u) * nx) xb_add(&bar[XB_TOPGEN], 1u);
      else XB_SPIN(xb_ld(&bar[XB_TOPGEN]) == tg, bar);
      __builtin_amdgcn_fence(__ATOMIC_ACQUIRE, "agent");
      xb_add(&bar[XB_XGEN(b.x)], 1u);
      asm volatile("s_waitcnt vmcnt(0)" ::: "memory");
    } else {
      XB_SPIN(xb_ld(&bar[XB_XGEN(b.x)]) == gen, bar);
      __builtin_amdgcn_fence(__ATOMIC_ACQUIRE, "agent");
      asm volatile("s_waitcnt vmcnt(0)" ::: "memory");
    }
  }
  __syncthreads();
}

#define SMEM_BYTES 155648

template <int PH>
DI void phase_and_probe(const Params& p, char* smem, cg::grid_group& grid) {
  const int reps = (PROBE_DUP == PH) ? 2 : 1;
  for (int rep = 0; rep < reps; ++rep) {
    if (PH == 10 && rep + 1 < reps) { Params q = p; q.gout = (float*)p.PQ; run_phase<PH>(q, smem); }
    else run_phase<PH>(p, smem);
    if (rep + 1 < reps) grid.sync();
  }
}
__global__ void __launch_bounds__(NT) k_mega(Params p) {
  extern __shared__ __attribute__((aligned(16))) char smem[];
  __shared__ uint4 xb_words;
  cg::grid_group grid = cg::this_grid();
  if (threadIdx.x == 0) xb_words = make_uint4(0u, 0u, 0u, 0u);
  __syncthreads();
  XcdBarrier xb = xcd_barrier_post(p.xbar, (volatile LAS unsigned*)&xb_words);
  phase_and_probe<0>(p, smem, grid); grid.sync();
  phase_and_probe<1>(p, smem, grid); xcd_barrier(xb);
  phase_and_probe<2>(p, smem, grid); xcd_barrier(xb);
  phase_and_probe<3>(p, smem, grid); xcd_barrier(xb);
  phase_and_probe<4>(p, smem, grid); xcd_barrier(xb);
  phase_and_probe<5>(p, smem, grid); xcd_barrier(xb);
  phase_and_probe<6>(p, smem, grid); xcd_barrier(xb);
  phase_and_probe<7>(p, smem, grid); xcd_barrier(xb);
  phase_and_probe<8>(p, smem, grid); xcd_barrier(xb);
  phase_and_probe<9>(p, smem, grid); xcd_barrier(xb);
  phase_and_probe<10>(p, smem, grid);
}
#ifdef MK_MULTI
template <int PH>
__global__ void __launch_bounds__(NT) k_single(Params p) {
  extern __shared__ __attribute__((aligned(16))) char smem[];
  run_phase<PH>(p, smem);
}
#endif

static size_t carve(size_t& off, size_t bytes) { size_t o = off; off += (bytes + 255) & ~(size_t)255; return o; }

extern "C" void kernel_launch(void* const* d_in, const int* in_sizes, int n_in, void* d_out, int out_size, void* d_ws, size_t ws_size,
                              hipStream_t stream) {
  Params p{};
  p.x = (const float*)d_in[0]; p.c = (const float*)d_in[1]; p.w_ada = (const float*)d_in[2]; p.b_ada = (const float*)d_in[3];
  p.g_mix = (const float*)d_in[4]; p.w_in = (const float*)d_in[5]; p.pe_k = (const float*)d_in[6]; p.pe_v = (const float*)d_in[7];
  p.w_k1 = (const float*)d_in[8]; p.b_k1 = (const float*)d_in[9]; p.w_k2 = (const float*)d_in[10]; p.w_v1 = (const float*)d_in[11];
  p.b_v1 = (const float*)d_in[12]; p.w_v2 = (const float*)d_in[13]; p.w_out = (const float*)d_in[14]; p.g_ffn = (const float*)d_in[15];
  p.w_pq = (const float*)d_in[16]; p.subkeys = (const float*)d_in[17]; p.peer_down = (const float*)d_in[18]; p.peer_up = (const float*)d_in[19];
  p.g_final = (const float*)d_in[20];
  p.out = (float*)d_out; p.gout = p.out;
  char* ws = (char*)d_ws;
  size_t off = 0;
  p.mod = (float*)(ws + carve(off, 2 * 6144 * 4));
  p.ksmax = (unsigned*)(ws + carve(off, 256));
  p.xbar = (unsigned*)(ws + carve(off, XCD_BAR_WORDS * 4));
  p.c128 = (float*)(ws + carve(off, (size_t)SEQ * 64 * 4)); p.s128 = (float*)(ws + carve(off, (size_t)SEQ * 64 * 4));
  p.c64 = (float*)(ws + carve(off, (size_t)SEQ * 32 * 4)); p.s64 = (float*)(ws + carve(off, (size_t)SEQ * 32 * 4));
  p.WinT = (bf16_t*)(ws + carve(off, (size_t)NPROJ * 1024 * 2));
  p.WoutT = (bf16_t*)(ws + carve(off, (size_t)1024 * 1024 * 2));
  p.WqT = (bf16_t*)(ws + carve(off, (size_t)2048 * 1024 * 2));
  p.W1Tk = (bf16_t*)(ws + carve(off, (size_t)256 * 2048 * 2)); p.W1Tv = (bf16_t*)(ws + carve(off, (size_t)256 * 2048 * 2));
  p.W2Tk = (bf16_t*)(ws + carve(off, 64 * 256 * 2)); p.W2Tv = (bf16_t*)(ws + carve(off, 64 * 256 * 2));
  p.SUBK = (bf16_t*)(ws + carve(off, (size_t)16 * 128 * 128 * 2));
  p.B1Pk = (float*)(ws + carve(off, 1024)); p.B1Pv = (float*)(ws + carve(off, 1024));
  p.RA = (bf16_t*)(ws + carve(off, (size_t)T_TOK * 1024 * 2));
  size_t rb = off;
  p.RQ = (bf16_t*)(ws + carve(off, (size_t)T_TOK * 512 * 2)); p.RK = (bf16_t*)(ws + carve(off, (size_t)T_TOK * 512 * 2));
  p.RKT = (bf16_t*)(ws + carve(off, (size_t)T_TOK * 512 * 2)); p.RVT = (bf16_t*)(ws + carve(off, (size_t)T_TOK * 512 * 2));
  p.RGT = (bf16_t*)(ws + carve(off, (size_t)T_TOK * 512 * 2)); p.NQ = (bf16_t*)(ws + carve(off, (size_t)T_TOK * 512 * 2));
  p.NKC = (bf16_t*)(ws + carve(off, (size_t)T_TOK * 128 * 2)); p.NVC = (bf16_t*)(ws + carve(off, (size_t)T_TOK * 128 * 2));
  p.NKS = (bf16_t*)(ws + carve(off, (size_t)T_TOK * 128 * 2)); p.NKW = (bf16_t*)(ws + carve(off, (size_t)T_TOK * 128 * 2));
  p.NVST = (bf16_t*)(ws + carve(off, (size_t)T_TOK * 128 * 2)); p.NVWT = (bf16_t*)(ws + carve(off, (size_t)T_TOK * 128 * 2));
  p.GATE = (float*)(ws + carve(off, (size_t)T_TOK * 24 * 4));
  p.KV = (float*)(ws + carve(off, (size_t)512 * 16384 * 4));
  p.SPREV = (bf16_t*)(ws + carve(off, (size_t)512 * 16384 * 2));
  p.KC = (bf16_t*)(ws + carve(off, (size_t)4 * 512 * 64 * 2)); p.VCT = (bf16_t*)(ws + carve(off, (size_t)4 * 512 * 64 * 2));
  p.HID = (float*)(ws + carve(off, (size_t)2 * 2048 * 256 * 4));
  size_t off2 = rb;
  p.PQ = (bf16_t*)(ws + carve(off2, (size_t)T_TOK * 2048 * 2));
  p.EIDX = (int*)(ws + carve(off2, (size_t)T_TOK * 128 * 4));
  p.EW = (float*)(ws + carve(off2, (size_t)T_TOK * 128 * 4));
  p.PDN8 = (unsigned char*)(ws + carve(off2, (size_t)16384 * 1024));
  p.PUP8 = (unsigned char*)(ws + carve(off2, (size_t)16384 * 1024));
  p.SDN = (float*)(ws + carve(off2, 16384 * 4));
  p.SUP = (float*)(ws + carve(off2, 16384 * 4));
  (void)ws_size; (void)in_sizes; (void)n_in; (void)out_size;

#ifdef MK_MULTI
#define LAUNCH1(PH) { hipFuncSetAttribute((const void*)k_single<PH>, hipFuncAttributeMaxDynamicSharedMemorySize, SMEM_BYTES); k_single<PH><<<256, NT, SMEM_BYTES, stream>>>(p); }
  LAUNCH1(0) LAUNCH1(1) LAUNCH1(2) LAUNCH1(3) LAUNCH1(4) LAUNCH1(5) LAUNCH1(6) LAUNCH1(7) LAUNCH1(8) LAUNCH1(9) LAUNCH1(10)
#else
  static int grid_blocks = 0;
  if (!grid_blocks) {
    int dev = 0, cus = 0, per_cu = 0;
    (void)hipGetDevice(&dev);
    (void)hipDeviceGetAttribute(&cus, hipDeviceAttributeMultiprocessorCount, dev);
    (void)hipFuncSetAttribute((const void*)k_mega, hipFuncAttributeMaxDynamicSharedMemorySize, SMEM_BYTES);
    (void)hipOccupancyMaxActiveBlocksPerMultiprocessor(&per_cu, k_mega, NT, SMEM_BYTES);
    if (per_cu < 1) per_cu = 1;
    if (per_cu > 1) per_cu = 1;
    grid_blocks = cus * per_cu;
  }
  (void)hipMemsetAsync(p.xbar, 0, XCD_BAR_WORDS * 4, stream);
  void* args[] = {&p};
  hipError_t e = hipLaunchCooperativeKernel((void*)k_mega, dim3(grid_blocks), dim3(NT), args, SMEM_BYTES, stream);
  if (e != hipSuccess) fprintf(stderr, "cooperative launch failed: %s (grid %d)\n", hipGetErrorString(e), grid_blocks);
#endif
}
```

```cpp
#include <hip/hip_runtime.h>
#include <hip/hip_bf16.h>
#include <hip/hip_cooperative_groups.h>
#include <stdint.h>
#include <stdio.h>
namespace cg = cooperative_groups;

typedef unsigned short bf16_t;
#define DI __device__ __forceinline__

DI int mytid() { int t = threadIdx.x; asm volatile("" : "+v"(t)); return t; }
DI float bf2f(bf16_t v) { return __uint_as_float(((unsigned)v) << 16); }
DI bf16_t f2bf(float x) { unsigned u = __float_as_uint(x); u += 0x7fffu + ((u >> 16) & 1u); return (bf16_t)(u >> 16); }
DI float gelu_tanh(float x) { float u = 0.7978845608028654f * (x + 0.044715f * x * x * x); return 0.5f * x * (1.f + tanhf(u)); }
DI float siluf(float x) { return x / (1.f + __expf(-x)); }
DI float sigmoidf(float x) { return 1.f / (1.f + __expf(-x)); }

#define T_TOK 16384
#define SEQ 8192
#define DM 1024
#define NPROJ 3584
#define NEG_INF (-__builtin_inff())

struct Params {
  const float *x, *c, *w_ada, *b_ada, *g_mix, *w_in, *pe_k, *pe_v, *w_k1, *b_k1, *w_k2, *w_v1, *b_v1, *w_v2, *w_out, *g_ffn,
      *w_pq, *subkeys, *peer_down, *peer_up, *g_final;
  float* out;
  float* gout;
  float* mod;
  unsigned* ksmax;
  unsigned* xbar;
  float *c128, *s128, *c64, *s64;
  bf16_t *WinT, *WoutT, *WqT, *W1Tk, *W1Tv, *W2Tk, *W2Tv, *SUBK;
  float *B1Pk, *B1Pv;
  bf16_t* RA;
  bf16_t *RQ, *RK, *RKT, *RVT, *RGT, *NQ, *NKC, *NVC, *NKS, *NKW, *NVST, *NVWT;
  float* GATE;
  float* KV;
  bf16_t* SPREV;
  bf16_t *KC, *VCT;
  float* HID;
  bf16_t* PQ;
  int* EIDX;
  float* EW;
  unsigned char *PDN8, *PUP8;
  float *SDN, *SUP;
};

DI float logg_h(int h) { return log1pf(-exp2f(-5.f - (float)h)); }


typedef __bf16 bf16x2_t __attribute__((ext_vector_type(2)));
typedef float f32x2_t __attribute__((ext_vector_type(2)));
DI unsigned cvt2(float a, float b) { f32x2_t v = {a, b}; bf16x2_t r = __builtin_convertvector(v, bf16x2_t); return __builtin_bit_cast(unsigned, r); }
DI uint2 pack4(float a, float b, float c, float d) { uint2 r; r.x = cvt2(a, b); r.y = cvt2(c, d); return r; }
#define NT 512
#ifndef PROBE_DUP
#define PROBE_DUP -1
#endif
typedef short bf16x8 __attribute__((ext_vector_type(8)));
typedef float f32x16 __attribute__((ext_vector_type(16)));
#define MFMA32(a, b, c) __builtin_amdgcn_mfma_f32_32x32x16_bf16((a), (b), (c), 0, 0, 0)
DI f32x16 zero16() { f32x16 z; for (int e = 0; e < 16; ++e) z[e] = 0.f; return z; }
DI f32x16 fill16(float v) { f32x16 z; for (int e = 0; e < 16; ++e) z[e] = v; return z; }
DI float ex2(float x) { return __builtin_amdgcn_exp2f(x); }

DI int win_logical_col(int np) {
  const int tile = np >> 8, p = np & 255, half = p >> 7, q = p & 127;
  if (tile < 4) { const int head = 2 * (tile & 1) + (q >> 6), i = q & 63; return (tile >> 1) * 512 + head * 128 + (half ? 64 + i : i); }
  if (tile < 8) return 1024 + (tile - 4) * 256 + p;
  if (tile < 10) { const int head = 4 * (tile - 8) + (q >> 5), i = q & 31; return 2048 + head * 64 + (half ? 32 + i : i); }
  if (tile == 10) { const int blk = q >> 5, i = q & 31; return (blk < 2 ? 2560 + blk * 64 : 2816 + (blk - 2) * 64) + (half ? 32 + i : i); }
  if (tile == 11) { const int blk = q >> 5, i = q & 31; return (blk < 2) ? 3072 + blk * 64 + (half ? 32 + i : i) : 2688 + (half ? 64 : 0) + 32 * (blk - 2) + i; }
  if (tile == 12) return (half ? 3200 : 2944) + q;
  if (tile == 13) return (half == 0 && q < 24) ? 3328 + q : -1;
  return -1;
}

DI void tr_tile(const float* __restrict__ in, bf16_t* __restrict__ out, int K, int N_in, int k0, int n0, int mode, float* tile) {
  const int tid = mytid();
  {
    int nn = tid & 63, col = mode ? win_logical_col(n0 + nn) : (n0 + nn);
#pragma unroll
    for (int i = 0; i < 8; ++i) {
      int kk = (tid >> 6) + 8 * i;
      tile[kk * 65 + nn] = (col >= 0) ? in[(size_t)(k0 + kk) * N_in + col] : 0.f;
    }
  }
  __syncthreads();
  {
    int kk = tid & 63;
#pragma unroll
    for (int i = 0; i < 8; ++i) {
      int nn = (tid >> 6) + 8 * i;
      out[(size_t)(n0 + nn) * K + k0 + kk] = f2bf(tile[kk * 65 + nn]);
    }
  }
  __syncthreads();
}

#define PH0_MOD 96
#define PH0_WIN (PH0_MOD + 16 * 56)
#define PH0_WOUT (PH0_WIN + 256)
#define PH0_WQ (PH0_WOUT + 512)
#define PH0_W1K (PH0_WQ + 128)
#define PH0_W1V (PH0_W1K + 128)
#define PH0_W2K (PH0_W1V + 4)
#define PH0_W2V (PH0_W2K + 4)
#define PH0_SUBK (PH0_W2V + 512)
#define PH0_ROPE (PH0_SUBK + 1024)
#define PH0_B1P (PH0_ROPE + 8)
#define PH0_NVB PH0_B1P

DI void ph0_body(const Params& p, int vb, char* smem) {
  const int tid = mytid();
  float* fs = (float*)smem;
  if (vb < PH0_MOD) {
    int kg = tid >> 6, col = vb * 64 + (tid & 63);
    float a0 = 0.f, a1 = 0.f;
#pragma unroll 8
    for (int k = kg * 128; k < kg * 128 + 128; ++k) {
      float w = p.w_ada[(size_t)k * 6144 + col];
      a0 += siluf(p.c[k]) * w; a1 += siluf(p.c[DM + k]) * w;
    }
    fs[kg * 64 + (tid & 63)] = a0; fs[512 + kg * 64 + (tid & 63)] = a1;
    __syncthreads();
    if (tid < 128) {
      int b = tid >> 6, cc = tid & 63; float s = 0.f;
      for (int g = 0; g < 8; ++g) s += fs[b * 512 + g * 64 + cc];
      p.mod[b * 6144 + vb * 64 + cc] = s + p.b_ada[vb * 64 + cc];
    }
    __syncthreads();
    if (vb == 0 && tid < 12) p.ksmax[tid] = 0u;
  } else if (vb < PH0_WIN) { int t = vb - PH0_MOD; tr_tile(p.w_in, p.WinT, 1024, 3352, (t & 15) * 64, (t >> 4) * 64, 1, fs); }
  else if (vb < PH0_WOUT) { int t = vb - PH0_WIN; tr_tile(p.w_out, p.WoutT, 1024, 1024, (t & 15) * 64, (t >> 4) * 64, 0, fs); }
  else if (vb < PH0_WQ) { int t = vb - PH0_WOUT; tr_tile(p.w_pq, p.WqT, 1024, 2048, (t & 15) * 64, (t >> 4) * 64, 0, fs); }
  else if (vb < PH0_W1K) { int t = vb - PH0_WQ; tr_tile(p.w_k1, p.W1Tk, 2048, 256, (t & 31) * 64, (t >> 5) * 64, 0, fs); }
  else if (vb < PH0_W1V) { int t = vb - PH0_W1K; tr_tile(p.w_v1, p.W1Tv, 2048, 256, (t & 31) * 64, (t >> 5) * 64, 0, fs); }
  else if (vb < PH0_W2K) { int t = vb - PH0_W1V; tr_tile(p.w_k2, p.W2Tk, 256, 64, t * 64, 0, 0, fs); }
  else if (vb < PH0_W2V) { int t = vb - PH0_W2K; tr_tile(p.w_v2, p.W2Tv, 256, 64, t * 64, 0, 0, fs); }
  else if (vb < PH0_SUBK) { int i = (vb - PH0_W2V) * NT + tid; p.SUBK[i] = f2bf(p.subkeys[i]); }
  else if (vb < PH0_ROPE) {
    int idx = (vb - PH0_SUBK) * NT + tid;
    { int s = idx >> 6, i = idx & 63; float inv = powf(10000.f, -(float)(2 * i) / 128.f); float ang = (float)s * inv; p.c128[idx] = cosf(ang); p.s128[idx] = sinf(ang); }
    if (idx < SEQ * 32) { int s = idx >> 5, i = idx & 31; float inv = powf(10000.f, -(float)(2 * i) / 64.f); float ang = (float)s * inv; p.c64[idx] = cosf(ang); p.s64[idx] = sinf(ang); }
  } else {
    int t = vb - PH0_ROPE, kv = t >> 2, jb = t & 3;
    const float* w1 = kv ? p.w_v1 : p.w_k1; const float* pe = kv ? p.pe_v : p.pe_k; const float* b1 = kv ? p.b_v1 : p.b_k1;
    int fg = tid >> 6, j = jb * 64 + (tid & 63);
    float a = 0.f;
#pragma unroll 8
    for (int f = fg * 256; f < fg * 256 + 256; ++f) a += pe[f] * w1[(size_t)f * 256 + j];
    fs[fg * 64 + (tid & 63)] = a;
    __syncthreads();
    if (tid < 64) { float s = b1[j]; for (int g = 0; g < 8; ++g) s += fs[g * 64 + tid]; (kv ? p.B1Pv : p.B1Pk)[j] = s; }
    __syncthreads();
  }
}

DI void rownorm_body(const float* __restrict__ src, const float* __restrict__ g, const float* __restrict__ mod, int sh_off, int sc_off, bf16_t* __restrict__ dst, int vb) {
  int row = vb * 8 + (mytid() >> 6), lane = mytid() & 63;
  int b = row >> 13;
  const float* xr = src + (size_t)row * DM;
  float v[16]; float ss = 0.f;
#pragma unroll
  for (int i = 0; i < 4; ++i) {
    float4 t = *(const float4*)(xr + i * 256 + lane * 4);
    v[i * 4 + 0] = t.x; v[i * 4 + 1] = t.y; v[i * 4 + 2] = t.z; v[i * 4 + 3] = t.w;
    ss += t.x * t.x + t.y * t.y + t.z * t.z + t.w * t.w;
  }
  for (int o = 32; o; o >>= 1) ss += __shfl_xor(ss, o);
  float rstd = rsqrtf(ss * (1.f / DM) + 1e-6f);
  const float* sh = mod + b * 6144 + sh_off; const float* sc = mod + b * 6144 + sc_off;
#pragma unroll
  for (int i = 0; i < 4; ++i) {
    int col = i * 256 + lane * 4;
    float4 gg = *(const float4*)(g + col), s4 = *(const float4*)(sc + col), h4 = *(const float4*)(sh + col);
    float y0 = v[i * 4 + 0] * rstd * gg.x * (1.f + s4.x) + h4.x;
    float y1 = v[i * 4 + 1] * rstd * gg.y * (1.f + s4.y) + h4.y;
    float y2 = v[i * 4 + 2] * rstd * gg.z * (1.f + s4.z) + h4.z;
    float y3 = v[i * 4 + 3] * rstd * gg.w * (1.f + s4.w) + h4.w;
    *(uint2*)(dst + (size_t)row * DM + col) = pack4(y0, y1, y2, y3);
  }
}

#define G_A_BYTES (256 * 144)
#define G_B_BYTES (256 * 144)
#define G_BUF_BYTES (G_A_BYTES + G_B_BYTES)
template <class Epi>
DI void gemm_tile(const bf16_t* __restrict__ A, const bf16_t* __restrict__ Bt, int K, int m0, int n0, char* smem, const Epi& epi) {
  const int tid = mytid(), lane = tid & 63, w = tid >> 6, wm = w >> 2, wn = w & 3, r = lane & 31, h = lane >> 5;
  f32x16 acc[4][2];
#pragma unroll
  for (int i = 0; i < 4; ++i)
#pragma unroll
    for (int j = 0; j < 2; ++j) acc[i][j] = zero16();
  const int crow = tid >> 3, ckc = tid & 7;
  const bf16_t* ag = A + (size_t)(m0 + crow) * K + ckc * 8;
  const bf16_t* bg = Bt + (size_t)(n0 + crow) * K + ckc * 8;
  uint4 ra[4], rb[4];
#pragma unroll
  for (int i = 0; i < 4; ++i) { ra[i] = *(const uint4*)(ag + (size_t)i * 64 * K); rb[i] = *(const uint4*)(bg + (size_t)i * 64 * K); }
  char* lw = smem + crow * 144 + ckc * 16;
#pragma unroll
  for (int i = 0; i < 4; ++i) { *(uint4*)(lw + i * 64 * 144) = ra[i]; *(uint4*)(lw + G_A_BYTES + i * 64 * 144) = rb[i]; }
  __syncthreads();
  const int nk = K >> 6;
  for (int kt = 0; kt < nk; ++kt) {
    const int cur = kt & 1;
    if (kt + 1 < nk) {
      const int k0 = (kt + 1) * 64;
#pragma unroll
      for (int i = 0; i < 4; ++i) { ra[i] = *(const uint4*)(ag + (size_t)i * 64 * K + k0); rb[i] = *(const uint4*)(bg + (size_t)i * 64 * K + k0); }
    }
    const char* la = smem + cur * G_BUF_BYTES + (wm * 128 + r) * 144 + h * 16;
    const char* lb = smem + cur * G_BUF_BYTES + G_A_BYTES + (wn * 64 + r) * 144 + h * 16;
#pragma unroll
    for (int kk = 0; kk < 4; ++kk) {
      bf16x8 b0 = *(const bf16x8*)(lb + kk * 32), b1 = *(const bf16x8*)(lb + 32 * 144 + kk * 32);
#pragma unroll
      for (int i = 0; i < 4; ++i) {
        bf16x8 a = *(const bf16x8*)(la + i * 32 * 144 + kk * 32);
        acc[i][0] = MFMA32(a, b0, acc[i][0]); acc[i][1] = MFMA32(a, b1, acc[i][1]);
      }
    }
    if (kt + 1 < nk) {
      char* lw2 = lw + (cur ^ 1) * G_BUF_BYTES;
#pragma unroll
      for (int i = 0; i < 4; ++i) { *(uint4*)(lw2 + i * 64 * 144) = ra[i]; *(uint4*)(lw2 + G_A_BYTES + i * 64 * 144) = rb[i]; }
    }
    __syncthreads();
  }
  const int G = (n0 >> 6) + wn;
#pragma unroll
  for (int i = 0; i < 4; ++i) {
    float pre[4][8];
#pragma unroll
    for (int g = 0; g < 4; ++g) epi.prefetch(m0 + wm * 128 + i * 32 + 8 * g + 4 * h, G, r, pre[g]);
#pragma unroll
    for (int g = 0; g < 4; ++g) {
      float lo[4], hi[4];
#pragma unroll
      for (int e = 0; e < 4; ++e) { lo[e] = acc[i][0][4 * g + e]; hi[e] = acc[i][1][4 * g + e]; }
      epi(m0 + wm * 128 + i * 32 + 8 * g + 4 * h, G, r, lo, hi, pre[g]);
    }
  }
}

struct EpiProj {
  static constexpr bool kProbe = true;
  const Params& p;
  DI void prefetch(int t0, int G, int c, float (&pre)[8]) const {
    const int s0 = t0 & 8191;
    const bool r128 = G < 16, r64 = (G >= 32 && G < 40) || (G >= 40 && G < 52 && (((G - 40) >> 1) & 1) == 0);
    if (r128) {
      const int i = 32 * (G & 1) + c;
#pragma unroll
      for (int e = 0; e < 4; ++e) { pre[e] = p.c128[(s0 + e) * 64 + i]; pre[4 + e] = p.s128[(s0 + e) * 64 + i]; }
    } else if (r64) {
#pragma unroll
      for (int e = 0; e < 4; ++e) { pre[e] = p.c64[(s0 + e) * 32 + c]; pre[4 + e] = p.s64[(s0 + e) * 32 + c]; }
    } else {
#pragma unroll
      for (int e = 0; e < 8; ++e) pre[e] = 0.f;
    }
  }
  DI void operator()(int t0, int G, int c, const float (&lo)[4], const float (&hi)[4], const float (&pre)[8]) const {
    const int b = t0 >> 13, s0 = t0 & 8191;
    if (G < 16) {
      const int sec = G >> 3, hh = (G & 7) >> 1, j = G & 1, i = 32 * j + c;
      float o1[4], o2[4];
#pragma unroll
      for (int e = 0; e < 4; ++e) {
        float cs = pre[e], sn = pre[4 + e];
        o1[e] = lo[e] * cs - hi[e] * sn; o2[e] = hi[e] * cs + lo[e] * sn;
      }
      if (sec == 0) {
#pragma unroll
        for (int e = 0; e < 4; ++e) {
          p.RQ[(size_t)(t0 + e) * 512 + hh * 128 + i] = f2bf(o1[e]);
          p.RQ[(size_t)(t0 + e) * 512 + hh * 128 + 64 + i] = f2bf(o2[e]);
        }
      } else {
        const float sc = 0.08838834764831845f;
        const float lg = logg_h(hh);
#pragma unroll
        for (int e = 0; e < 4; ++e) {
          o1[e] *= sc; o2[e] *= sc;
          p.RK[(size_t)(t0 + e) * 512 + hh * 128 + i] = f2bf(o1[e]);
          p.RK[(size_t)(t0 + e) * 512 + hh * 128 + 64 + i] = f2bf(o2[e]);
          float zeta = __expf((float)(127 - ((s0 + e) & 127)) * lg);
          o1[e] *= zeta; o2[e] *= zeta;
        }
        *(uint2*)(p.RKT + ((size_t)(b * 4 + hh) * 128 + i) * SEQ + s0) = pack4(o1[0], o1[1], o1[2], o1[3]);
        *(uint2*)(p.RKT + ((size_t)(b * 4 + hh) * 128 + 64 + i) * SEQ + s0) = pack4(o2[0], o2[1], o2[2], o2[3]);
      }
    } else if (G < 24) {
      const int hh = (G - 16) >> 1, d = ((G - 16) & 1) * 64 + c;
      *(uint2*)(p.RVT + ((size_t)(b * 4 + hh) * 128 + d) * SEQ + s0) = pack4(lo[0], lo[1], lo[2], lo[3]);
      *(uint2*)(p.RVT + ((size_t)(b * 4 + hh) * 128 + d + 32) * SEQ + s0) = pack4(hi[0], hi[1], hi[2], hi[3]);
    } else if (G < 32) {
      const int hh = (G - 24) >> 1, d = ((G - 24) & 1) * 64 + c;
#pragma unroll
      for (int e = 0; e < 4; ++e) {
        p.RGT[(size_t)(t0 + e) * 512 + hh * 128 + d] = f2bf(siluf(lo[e]));
        p.RGT[(size_t)(t0 + e) * 512 + hh * 128 + d + 32] = f2bf(siluf(hi[e]));
      }
    } else if (G < 40) {
      const int head = G - 32;
#pragma unroll
      for (int e = 0; e < 4; ++e) {
        float cs = pre[e], sn = pre[4 + e];
        const float qs = 0.125f * 1.4426950408889634f;
        float o1 = (lo[e] * cs - hi[e] * sn) * qs, o2 = (hi[e] * cs + lo[e] * sn) * qs;
        p.NQ[(size_t)(t0 + e) * 512 + head * 64 + c] = f2bf(o1);
        p.NQ[(size_t)(t0 + e) * 512 + head * 64 + 32 + c] = f2bf(o2);
      }
    } else if (G < 52) {
      const int k = G - 40, kind = k >> 1, gg = k & 1;
      float o1[4], o2[4];
#pragma unroll
      for (int e = 0; e < 4; ++e) {
        o1[e] = lo[e]; o2[e] = hi[e];
        if ((kind & 1) == 0) {
          float cs = pre[e], sn = pre[4 + e];
          o1[e] = lo[e] * cs - hi[e] * sn; o2[e] = hi[e] * cs + lo[e] * sn;
        }
      }
      if (kind == 3 || kind == 5) {
        bf16_t* dst = (kind == 3 ? p.NVST : p.NVWT) + ((size_t)(b * 2 + gg) * 64 + c) * SEQ + s0;
        *(uint2*)dst = pack4(o1[0], o1[1], o1[2], o1[3]);
        *(uint2*)(dst + (size_t)32 * SEQ) = pack4(o2[0], o2[1], o2[2], o2[3]);
      } else {
        bf16_t* dst = (kind == 0 ? p.NKC : kind == 1 ? p.NVC : kind == 2 ? p.NKS : p.NKW);
#pragma unroll
        for (int e = 0; e < 4; ++e) {
          dst[(size_t)(t0 + e) * 128 + gg * 64 + c] = f2bf(o1[e]);
          dst[(size_t)(t0 + e) * 128 + gg * 64 + 32 + c] = f2bf(o2[e]);
        }
      }
    } else if (G == 52) {
      if (c < 24) {
#pragma unroll
        for (int e = 0; e < 4; ++e) p.GATE[(size_t)(t0 + e) * 24 + c] = sigmoidf(lo[e]);
      }
    }
  }
};
struct EpiOut {
  static constexpr bool kProbe = false;
  const Params& p;
  DI void prefetch(int t0, int G, int c, float (&pre)[8]) const {
    const int c0 = G * 64 + c;
#pragma unroll
    for (int e = 0; e < 4; ++e) { pre[e] = p.x[(size_t)(t0 + e) * DM + c0]; pre[4 + e] = p.x[(size_t)(t0 + e) * DM + c0 + 32]; }
  }
  DI void operator()(int t0, int G, int c, const float (&lo)[4], const float (&hi)[4], const float (&pre)[8]) const {
    const int b = t0 >> 13;
    const int c0 = G * 64 + c, c1 = c0 + 32;
    const float* ga1 = p.mod + b * 6144 + 2048;
    const float g0 = ga1[c0], g1 = ga1[c1];
#pragma unroll
    for (int e = 0; e < 4; ++e) {
      p.out[(size_t)(t0 + e) * DM + c0] = pre[e] + g0 * lo[e];
      p.out[(size_t)(t0 + e) * DM + c1] = pre[4 + e] + g1 * hi[e];
    }
  }
};
struct EpiPQ {
  static constexpr bool kProbe = false;
  const Params& p;
  DI void prefetch(int, int, int, float (&)[8]) const {}
  DI void operator()(int t0, int G, int c, const float (&lo)[4], const float (&hi)[4], const float (&)[8]) const {
#pragma unroll
    for (int e = 0; e < 4; ++e) {
      p.PQ[(size_t)(t0 + e) * 2048 + G * 64 + c] = f2bf(lo[e]);
      p.PQ[(size_t)(t0 + e) * 2048 + G * 64 + 32 + c] = f2bf(hi[e]);
    }
  }
};


namespace pg8 {
#define PG8_LAS __attribute__((address_space(3)))
typedef float f32x4 __attribute__((ext_vector_type(4)));
constexpr int BM = 256, BK = 64, HALF = 128, HTB = HALF * BK * 2, STAGE_BYTES = 8 * HTB, NXCD = 8, WGM = 8;
DI int lds_byte(int r, int c) { const int st = (r >> 4) * 2 + (c >> 5), rr = r & 15, cc = c & 31, ob = rr * 64 + cc * 2; return st * 1024 + (ob ^ (((ob >> 9) & 1) << 5)); }
DI void stage_rc(int b, int& R, int& C) { const int st = b / 1024, sb = b % 1024, swz = sb ^ (((sb >> 9) & 1) << 5); R = (st >> 1) * 16 + swz / 64; C = (st & 1) * 32 + (swz % 64) / 2; }
DI int perm32(int rho) { const int n = rho >> 4, i = rho & 15; return 8 * (i >> 2) + 4 * n + (i & 3); }
struct Unit { int pm, pn; };
struct Gemm { const bf16_t* A; const bf16_t* Bt; int M, N, K; };
struct StaticOrder {
  int nM, nN, nwg, G, c;
  DI void init(int M, int N, int G_, int c_) { nM = M / BM; nN = N / BM; nwg = nM * nN; G = G_; c = c_; }
  DI bool next(int i, Unit& u) const {
    const long L = (long)i * G + c; if (L >= nwg) return false;
    int wgid = (int)L; { const int q = nwg / NXCD, r = nwg % NXCD, xcd = wgid % NXCD, off = wgid / NXCD; wgid = (xcd < r ? xcd * (q + 1) : r * (q + 1) + (xcd - r) * q) + off; }
    const int nig = WGM * nN, gid = wgid / nig, fm = gid * WGM, gsz = (nM - fm) < WGM ? (nM - fm) : WGM;
    u.pm = fm + ((wgid % nig) % gsz); u.pn = (wgid % nig) / gsz; return true;
  }
  DI void a_ready(const Unit&) const {}
  DI void done(const Unit&) const {}
};
template <class Epi, class Sched>
__device__ __forceinline__ void gemm_phase(PG8_LAS unsigned char* lds, const Gemm g, const Sched& S, const Epi& E) {
    const int tid = mytid(), wid = __builtin_amdgcn_readfirstlane(tid >> 6), lane = tid & 63, wr = wid >> 2, wc = wid & 3, fr = lane & 15, fq = lane >> 4;
    const int K = g.K, nt = K / BK;
    unsigned voffA[2], voffB[2];
#pragma unroll
    for (int i = 0; i < 2; ++i) { int R, C; stage_rc(tid * 16 + i * 8192, R, C); const int Rb = Epi::PERM ? ((R & ~31) + perm32(R & 31)) : R;
        voffA[i] = (unsigned)(R * K + C) * 2u; voffB[i] = (unsigned)(Rb * K + C) * 2u; }
    const size_t kstep = (size_t)(BK * 2);
    const size_t hstep = (size_t)HALF * K * 2;
    const size_t tstep = 2 * hstep;
    const unsigned ldsw = (unsigned)wid * 1024u;
    const int aoff = lds_byte(wr * 64 + fr, fq * 8), boff = lds_byte(wc * 32 + fr, fq * 8);
#define PG8_SA(b, h) (((b) * 2 + (h)) * HTB)
#define PG8_SB(b, h) ((4 + (b) * 2 + (h)) * HTB)
#define PG8_STAGE(bufoff, gbase, voff) do { _Pragma("unroll") for (int _i = 0; _i < 2; ++_i) \
        __builtin_amdgcn_global_load_lds((const unsigned*)((const char*)(gbase) + (voff)[_i]), (PG8_LAS unsigned*)(lds + (bufoff) + ldsw + _i * 8192), 16, 0, 0); } while (0)
#define PG8_LDA(dst, b, h) do { _Pragma("unroll") for (int m = 0; m < 4; ++m) _Pragma("unroll") for (int k = 0; k < 2; ++k) dst[m][k] = *(const PG8_LAS bf16x8*)(lds + PG8_SA(b, h) + aoff + m * 2048 + k * 1024); } while (0)
#define PG8_LDB(dst, b, h) do { _Pragma("unroll") for (int n = 0; n < 2; ++n) _Pragma("unroll") for (int k = 0; k < 2; ++k) dst[n][k] = *(const PG8_LAS bf16x8*)(lds + PG8_SB(b, h) + boff + n * 2048 + k * 1024); } while (0)
#define PG8_MMA(ai, bj, At, Bt) do { __builtin_amdgcn_s_setprio(1); _Pragma("unroll") for (int m = 0; m < 4; ++m) _Pragma("unroll") for (int n = 0; n < 2; ++n) _Pragma("unroll") for (int k = 0; k < 2; ++k) \
        acc[ai][bj][m][n] = __builtin_amdgcn_mfma_f32_16x16x32_bf16(Bt[n][k], At[m][k], acc[ai][bj][m][n], 0, 0, 0); __builtin_amdgcn_s_setprio(0); } while (0)
#define PG8_WAIT_V(n) asm volatile("s_waitcnt vmcnt(" #n ")" ::: "memory")
#define PG8_WAIT_L(n) asm volatile("s_waitcnt lgkmcnt(" #n ")" ::: "memory")
#define PG8_BAR __builtin_amdgcn_s_barrier()
#define PG8_SCHED __builtin_amdgcn_sched_barrier(0)
    Unit cur, nxt; int ui = 0;
    if (!S.next(0, cur)) return;
    f32x4 acc[2][2][4][2];
#pragma unroll
    for (int a = 0; a < 2; ++a)
#pragma unroll
        for (int b = 0; b < 2; ++b)
#pragma unroll
            for (int m = 0; m < 4; ++m)
#pragma unroll
                for (int n = 0; n < 2; ++n) acc[a][b][m][n] = (f32x4){0.f, 0.f, 0.f, 0.f};
    bf16x8 At[4][2], B0[2][2], B1[2][2];
    const char* cA = (const char*)g.A + (size_t)cur.pm * tstep; const char* cB = (const char*)g.Bt + (size_t)cur.pn * tstep;
    S.a_ready(cur);
    PG8_STAGE(PG8_SB(0, 0), cB, voffB); PG8_STAGE(PG8_SA(0, 0), cA, voffA); PG8_STAGE(PG8_SB(0, 1), cB + hstep, voffB); PG8_STAGE(PG8_SA(0, 1), cA + hstep, voffA);
    if (wr == 1) PG8_BAR;
    PG8_WAIT_V(4); PG8_BAR;
    PG8_STAGE(PG8_SB(1, 0), cB + kstep, voffB); PG8_STAGE(PG8_SA(1, 0), cA + kstep, voffA); PG8_STAGE(PG8_SB(1, 1), cB + hstep + kstep, voffB);
    PG8_WAIT_V(6); PG8_BAR;
    for (;;) {
        const bool has_next = S.next(ui + 1, nxt);
        const char* nA = has_next ? (const char*)g.A + (size_t)nxt.pm * tstep : cA; const char* nB = has_next ? (const char*)g.Bt + (size_t)nxt.pn * tstep : cB;
        for (int t = 0; t < nt; t += 2) {
            const bool last = (t == nt - 2);
            const char* a1 = cA + (size_t)(t + 1) * kstep;
            const char* a2 = last ? nA : cA + (size_t)(t + 2) * kstep; const char* b2 = last ? nB : cB + (size_t)(t + 2) * kstep;
            const char* a3 = a2 + kstep; const char* b3 = b2 + kstep;
            if (last && has_next) S.a_ready(nxt);
            PG8_LDB(B0, 0, 0); PG8_SCHED; PG8_LDA(At, 0, 0); PG8_STAGE(PG8_SA(1, 1), a1 + hstep, voffA);
            PG8_WAIT_L(8); PG8_BAR; PG8_WAIT_L(0); PG8_MMA(0, 0, At, B0); PG8_BAR; PG8_SCHED;
            PG8_LDB(B1, 0, 1); PG8_STAGE(PG8_SB(0, 0), b2, voffB);
            PG8_BAR; PG8_WAIT_L(0); PG8_MMA(0, 1, At, B1); PG8_BAR;
            PG8_LDA(At, 0, 1); PG8_STAGE(PG8_SA(0, 0), a2, voffA);
            PG8_BAR; PG8_WAIT_L(0); PG8_MMA(1, 0, At, B0); PG8_BAR; PG8_SCHED;
            PG8_STAGE(PG8_SB(0, 1), b2 + hstep, voffB);
            PG8_WAIT_V(6); PG8_BAR; PG8_MMA(1, 1, At, B1); PG8_BAR;
            PG8_LDB(B0, 1, 0); PG8_SCHED; PG8_LDA(At, 1, 0); PG8_STAGE(PG8_SA(0, 1), a2 + hstep, voffA);
            PG8_WAIT_L(8); PG8_BAR; PG8_WAIT_L(0); PG8_MMA(0, 0, At, B0); PG8_BAR; PG8_SCHED;
            PG8_LDB(B1, 1, 1); PG8_STAGE(PG8_SB(1, 0), b3, voffB);
            PG8_BAR; PG8_WAIT_L(0); PG8_MMA(0, 1, At, B1); PG8_BAR;
            PG8_LDA(At, 1, 1); PG8_STAGE(PG8_SA(1, 0), a3, voffA);
            PG8_BAR; PG8_WAIT_L(0); PG8_MMA(1, 0, At, B0); PG8_BAR; PG8_SCHED;
            PG8_STAGE(PG8_SB(1, 1), b3 + hstep, voffB);
            PG8_WAIT_V(6); PG8_BAR; PG8_MMA(1, 1, At, B1); PG8_BAR;
        }
        if constexpr (!Epi::AFTER_DRAIN) { E(acc, cur, wr, wc, fr, fq); S.done(cur); }
        if (!has_next) break;
#pragma unroll
        for (int a = 0; a < 2; ++a)
#pragma unroll
            for (int b = 0; b < 2; ++b)
#pragma unroll
                for (int m = 0; m < 4; ++m)
#pragma unroll
                    for (int n = 0; n < 2; ++n) acc[a][b][m][n] = (f32x4){0.f, 0.f, 0.f, 0.f};
        cur = nxt; cA = nA; cB = nB; ++ui;
    }
    PG8_WAIT_V(0);
    if (wr == 0) PG8_BAR;
    PG8_BAR;
    if constexpr (Epi::AFTER_DRAIN) { E.fused(acc, cur, wr, wc, fr, fq, lds, wid, lane); S.done(cur); }
#undef PG8_SA
#undef PG8_SB
#undef PG8_STAGE
#undef PG8_LDA
#undef PG8_LDB
#undef PG8_MMA
#undef PG8_WAIT_V
#undef PG8_WAIT_L
#undef PG8_BAR
#undef PG8_SCHED
}
}

template <int CTRL> DI float dpp_q(float x) { return __builtin_bit_cast(float, __builtin_amdgcn_mov_dpp(__builtin_bit_cast(int, x), CTRL, 0xf, 0xf, true)); }
DI void tstore4(bf16_t* dst, float v0, float v1, float v2, float v3, int q) {
  const bool o1_ = q & 1, o2_ = q & 2;
  const float sa = o1_ ? v0 : v1, sb = o1_ ? v2 : v3;
  const float ra = dpp_q<0xB1>(sa), rb = dpp_q<0xB1>(sb);
  const float w0 = o1_ ? ra : v0, w1 = o1_ ? v1 : ra, w2 = o1_ ? rb : v2, w3 = o1_ ? v3 : rb;
  const float sc = o2_ ? w0 : w2, sd = o2_ ? w1 : w3;
  const float rc = dpp_q<0x4E>(sc), rd = dpp_q<0x4E>(sd);
  const float x0 = o2_ ? rc : w0, x1 = o2_ ? rd : w1, x2 = o2_ ? w2 : rc, x3 = o2_ ? w3 : rd;
  *(uint2*)(dst + (size_t)q * SEQ - q) = pack4(x0, x1, x2, x3);
}
DI uint4 pack8u(const float (&a)[4], const float (&b)[4]) { uint4 v; v.x = cvt2(a[0], a[1]); v.y = cvt2(a[2], a[3]); v.z = cvt2(b[0], b[1]); v.w = cvt2(b[2], b[3]); return v; }
struct EpiProj8 {
  static constexpr bool PERM = true, AFTER_DRAIN = false;
  const Params& p;
  DI void operator()(const pg8::f32x4 (&acc)[2][2][4][2], const pg8::Unit& u, int wr, int wc, int fr, int fq) const {
    const int pn = u.pn, q4 = fr & 3;
    const bool rot128 = pn < 4, rot64 = (pn >= 8 && pn < 10) || pn == 10 || (pn == 11 && wc < 2), rot = rot128 || rot64;
    const int t00 = u.pm * 256 + wr * 64 + fr, s00 = t00 & 8191;
    const int cb0 = 8 * fq;
    const float* ct = rot128 ? p.c128 : p.c64; const float* st = rot128 ? p.s128 : p.s64;
    const int nrot = rot128 ? 64 : 32, ridx = (rot128 ? 32 * (wc & 1) : 0) + cb0;
    float cd_[2][4], sd_[2][4];
    if (rot) {
#pragma unroll
      for (int n = 0; n < 2; ++n) {
        const float4 c16 = *(const float4*)(ct + (size_t)16 * nrot + ridx + 4 * n), s16 = *(const float4*)(st + (size_t)16 * nrot + ridx + 4 * n);
        cd_[n][0] = c16.x; cd_[n][1] = c16.y; cd_[n][2] = c16.z; cd_[n][3] = c16.w; sd_[n][0] = s16.x; sd_[n][1] = s16.y; sd_[n][2] = s16.z; sd_[n][3] = s16.w;
      }
    }
#pragma unroll
    for (int ai = 0; ai < 2; ++ai) {
      float c_[2][4], s_[2][4];
      if (rot) {
#pragma unroll
        for (int n = 0; n < 2; ++n) {
          const float4 c4 = *(const float4*)(ct + (size_t)(s00 + 128 * ai) * nrot + ridx + 4 * n), s4 = *(const float4*)(st + (size_t)(s00 + 128 * ai) * nrot + ridx + 4 * n);
          c_[n][0] = c4.x; c_[n][1] = c4.y; c_[n][2] = c4.z; c_[n][3] = c4.w; s_[n][0] = s4.x; s_[n][1] = s4.y; s_[n][2] = s4.z; s_[n][3] = s4.w;
        }
      }
#pragma unroll
      for (int m = 0; m < 4; ++m) {
        const int t = t00 + ai * 128 + m * 16, b = t >> 13, s = t & 8191;
        float lo[2][4], hi[2][4];
#pragma unroll
        for (int n = 0; n < 2; ++n) {
          const pg8::f32x4 L = acc[ai][0][m][n], H = acc[ai][1][m][n];
#pragma unroll
          for (int i = 0; i < 4; ++i) {
            if (rot) {
              const float c = c_[n][i], sn = s_[n][i];
              lo[n][i] = L[i] * c - H[i] * sn; hi[n][i] = H[i] * c + L[i] * sn;
              c_[n][i] = c * cd_[n][i] - sn * sd_[n][i]; s_[n][i] = sn * cd_[n][i] + c * sd_[n][i];
            } else { lo[n][i] = L[i]; hi[n][i] = H[i]; }
          }
        }
        if (pn < 4) {
          const int hh = 2 * (pn & 1) + (wc >> 1), idx = 32 * (wc & 1) + cb0;
          if (pn < 2) {
            *(uint4*)(p.RQ + (size_t)t * 512 + hh * 128 + idx) = pack8u(lo[0], lo[1]);
            *(uint4*)(p.RQ + (size_t)t * 512 + hh * 128 + 64 + idx) = pack8u(hi[0], hi[1]);
          } else {
            const float sc = 0.08838834764831845f;
#pragma unroll
            for (int n = 0; n < 2; ++n)
#pragma unroll
              for (int i = 0; i < 4; ++i) { lo[n][i] *= sc; hi[n][i] *= sc; }
            *(uint4*)(p.RK + (size_t)t * 512 + hh * 128 + idx) = pack8u(lo[0], lo[1]);
            *(uint4*)(p.RK + (size_t)t * 512 + hh * 128 + 64 + idx) = pack8u(hi[0], hi[1]);
            const float zeta = __expf((float)(127 - (s & 127)) * logg_h(hh));
            bf16_t* kt = p.RKT + ((size_t)(b * 4 + hh) * 128 + idx) * SEQ + s;
#pragma unroll
            for (int n = 0; n < 2; ++n) {
              tstore4(kt + (size_t)(4 * n) * SEQ, lo[n][0] * zeta, lo[n][1] * zeta, lo[n][2] * zeta, lo[n][3] * zeta, q4);
              tstore4(kt + (size_t)(64 + 4 * n) * SEQ, hi[n][0] * zeta, hi[n][1] * zeta, hi[n][2] * zeta, hi[n][3] * zeta, q4);
            }
          }
        } else if (pn < 6) {
          bf16_t* v0 = p.RVT + ((size_t)(b * 4 + 2 * (pn - 4)) * 128 + 32 * wc + cb0) * SEQ + s;
#pragma unroll
          for (int n = 0; n < 2; ++n) {
            tstore4(v0 + (size_t)(4 * n) * SEQ, lo[n][0], lo[n][1], lo[n][2], lo[n][3], q4);
            tstore4(v0 + (size_t)(128 + 4 * n) * SEQ, hi[n][0], hi[n][1], hi[n][2], hi[n][3], q4);
          }
        } else if (pn < 8) {
          const int d = 32 * wc + cb0, h0 = 2 * (pn - 6);
#pragma unroll
          for (int n = 0; n < 2; ++n)
#pragma unroll
            for (int i = 0; i < 4; ++i) { lo[n][i] = siluf(lo[n][i]); hi[n][i] = siluf(hi[n][i]); }
          *(uint4*)(p.RGT + (size_t)t * 512 + h0 * 128 + d) = pack8u(lo[0], lo[1]);
          *(uint4*)(p.RGT + (size_t)t * 512 + (h0 + 1) * 128 + d) = pack8u(hi[0], hi[1]);
        } else if (pn < 10) {
          const int head = 4 * (pn - 8) + wc;
          const float qs = 0.125f * 1.4426950408889634f;
#pragma unroll
          for (int n = 0; n < 2; ++n)
#pragma unroll
            for (int i = 0; i < 4; ++i) { lo[n][i] *= qs; hi[n][i] *= qs; }
          *(uint4*)(p.NQ + (size_t)t * 512 + head * 64 + cb0) = pack8u(lo[0], lo[1]);
          *(uint4*)(p.NQ + (size_t)t * 512 + head * 64 + 32 + cb0) = pack8u(hi[0], hi[1]);
        } else if (pn == 10 || (pn == 11 && wc < 2)) {
          bf16_t* dst = (pn == 11) ? p.NKW : (wc < 2 ? p.NKC : p.NKS);
          const int g = wc & 1;
          *(uint4*)(dst + (size_t)t * 128 + g * 64 + cb0) = pack8u(lo[0], lo[1]);
          *(uint4*)(dst + (size_t)t * 128 + g * 64 + 32 + cb0) = pack8u(hi[0], hi[1]);
        } else if (pn == 11) {
          const int c0 = 32 * (wc - 2) + cb0;
          *(uint4*)(p.NVC + (size_t)t * 128 + c0) = pack8u(lo[0], lo[1]);
          *(uint4*)(p.NVC + (size_t)t * 128 + 64 + c0) = pack8u(hi[0], hi[1]);
        } else if (pn == 12) {
          const int col = 32 * wc + cb0, g = col >> 6, d = col & 63;
          bf16_t* v0 = p.NVST + ((size_t)(b * 2 + g) * 64 + d) * SEQ + s;
          bf16_t* v1 = p.NVWT + ((size_t)(b * 2 + g) * 64 + d) * SEQ + s;
#pragma unroll
          for (int n = 0; n < 2; ++n) {
            tstore4(v0 + (size_t)(4 * n) * SEQ, lo[n][0], lo[n][1], lo[n][2], lo[n][3], q4);
            tstore4(v1 + (size_t)(4 * n) * SEQ, hi[n][0], hi[n][1], hi[n][2], hi[n][3], q4);
          }
        } else {
          if (wc == 0) {
#pragma unroll
            for (int n = 0; n < 2; ++n)
#pragma unroll
              for (int i = 0; i < 4; ++i) if (cb0 + 4 * n + i < 24) p.GATE[(size_t)t * 24 + cb0 + 4 * n + i] = sigmoidf(lo[n][i]);
          }
        }
      }
    }
  }
};
struct EpiOut8 {
  static constexpr bool PERM = false, AFTER_DRAIN = false;
  const float* x; float* out; const float* mod;
  DI void operator()(const pg8::f32x4 (&acc)[2][2][4][2], const pg8::Unit& u, int wr, int wc, int fr, int fq) const {
    const int col0 = u.pn * 256 + wc * 32 + 4 * fq;
    const float* ga1 = mod + ((u.pm * 256) >> 13) * 6144 + 2048;
    float4 gv[2][2];
#pragma unroll
    for (int bj = 0; bj < 2; ++bj)
#pragma unroll
      for (int n = 0; n < 2; ++n) gv[bj][n] = *(const float4*)(ga1 + col0 + bj * 128 + n * 16);
#pragma unroll
    for (int ai = 0; ai < 2; ++ai)
#pragma unroll
      for (int m = 0; m < 4; ++m) {
        const size_t ro = (size_t)(u.pm * 256 + wr * 64 + fr + ai * 128 + m * 16) * DM + col0;
        float4 xv[2][2];
#pragma unroll
        for (int bj = 0; bj < 2; ++bj)
#pragma unroll
          for (int n = 0; n < 2; ++n) xv[bj][n] = *(const float4*)(x + ro + bj * 128 + n * 16);
#pragma unroll
        for (int bj = 0; bj < 2; ++bj)
#pragma unroll
          for (int n = 0; n < 2; ++n) {
            const pg8::f32x4 v = acc[ai][bj][m][n]; const float4 g4 = gv[bj][n], x4 = xv[bj][n];
            *(float4*)(out + ro + bj * 128 + n * 16) = make_float4(x4.x + g4.x * v[0], x4.y + g4.y * v[1], x4.z + g4.z * v[2], x4.w + g4.w * v[3]);
          }
      }
  }
};
struct EpiPQ8 {
  static constexpr bool PERM = true, AFTER_DRAIN = false;
  bf16_t* O;
  DI void operator()(const pg8::f32x4 (&acc)[2][2][4][2], const pg8::Unit& u, int wr, int wc, int fr, int fq) const {
#pragma unroll
    for (int ai = 0; ai < 2; ++ai)
#pragma unroll
      for (int m = 0; m < 4; ++m) {
        bf16_t* rowp = O + (size_t)(u.pm * 256 + wr * 64 + fr + ai * 128 + m * 16) * 2048 + u.pn * 256 + wc * 32 + 8 * fq;
#pragma unroll
        for (int bj = 0; bj < 2; ++bj) {
          const pg8::f32x4 v0 = acc[ai][bj][m][0], v1 = acc[ai][bj][m][1];
          uint4 o; o.x = cvt2(v0[0], v0[1]); o.y = cvt2(v0[2], v0[3]); o.z = cvt2(v1[0], v1[1]); o.w = cvt2(v1[2], v1[3]);
          *(uint4*)(rowp + bj * 128) = o;
        }
      }
  }
};
DI int crow(int reg, int h) { return (reg & 3) + 8 * (reg >> 2) + 4 * h; }
DI bf16x8 ld16(const bf16_t* ptr) { return *(const bf16x8*)ptr; }
DI bf16x8 ld8x2(const bf16_t* ptr) {
  uint2 a = *(const uint2*)ptr, b = *(const uint2*)(ptr + 8);
  uint4 v; v.x = a.x; v.y = a.y; v.z = b.x; v.w = b.y;
  return __builtin_bit_cast(bf16x8, v);
}
DI bf16x8 pack8(float x0, float x1, float x2, float x3, float x4, float x5, float x6, float x7) {
  uint4 v; v.x = cvt2(x0, x1); v.y = cvt2(x2, x3); v.z = cvt2(x4, x5); v.w = cvt2(x6, x7);
  return __builtin_bit_cast(bf16x8, v);
}

DI void retkv_mfma(const Params& p, int item) {
  const int lane = mytid() & 63, w = mytid() >> 6, r = lane & 31, h = lane >> 5;
  const int hh = item & 3, c = (item >> 2) & 63, b = item >> 8, bh = b * 4 + hh, s0 = c * 128;
  const int mi = w >> 1, nb = (w & 1) * 2;
  const bf16_t* vb_ = p.RVT + ((size_t)(bh * 128 + 32 * mi + r)) * SEQ + s0 + 8 * h;
  const bf16_t* k0 = p.RKT + ((size_t)(bh * 128 + 32 * nb + r)) * SEQ + s0 + 8 * h;
  const bf16_t* k1 = k0 + (size_t)32 * SEQ;
  f32x16 a0 = zero16(), a1 = zero16();
#pragma unroll
  for (int s = 0; s < 8; ++s) {
    bf16x8 a = ld16(vb_ + 16 * s), b0 = ld16(k0 + 16 * s), b1 = ld16(k1 + 16 * s);
    a0 = MFMA32(a, b0, a0); a1 = MFMA32(a, b1, a1);
  }
  float* dst = p.KV + (size_t)item * 16384;
#pragma unroll
  for (int e = 0; e < 16; ++e) {
    const int v = 32 * mi + crow(e, h);
    dst[v * 128 + 32 * nb + r] = a0[e];
    dst[v * 128 + 32 * nb + 32 + r] = a1[e];
  }
}
DI void scan_body(const Params& p, int idx) {
  const int e = idx & 16383, bh = idx >> 14, b = bh >> 2, h = bh & 3;
  const float cd = __expf(128.f * logg_h(h));
  float S = 0.f;
  for (int c0 = 0; c0 < 64; c0 += 32) {
    float kv[32];
#pragma unroll
    for (int u = 0; u < 32; ++u) kv[u] = p.KV[(size_t)((b * 64 + c0 + u) * 4 + h) * 16384 + e];
#pragma unroll
    for (int u = 0; u < 32; ++u) {
      p.SPREV[(size_t)((b * 64 + c0 + u) * 4 + h) * 16384 + e] = f2bf(S);
      S = cd * S + kv[u];
    }
  }
}
DI void retout_mfma(const Params& p, int task) {
  const int lane = mytid() & 63, r = lane & 31, h = lane >> 5;
  const int item = task >> 2, nt = task & 3;
  const int hh = item & 3, c = (item >> 2) & 63, b = item >> 8, bh = b * 4 + hh, s0 = c * 128, t0 = b * SEQ + s0;
  const float lg = logg_h(hh);
  const int n = 32 * nt + r;
  bf16x8 qf[8];
#pragma unroll
  for (int s = 0; s < 8; ++s) qf[s] = ld16(p.RQ + (size_t)(t0 + n) * 512 + hh * 128 + 16 * s + 8 * h);
  f32x16 acc[4];
#pragma unroll
  for (int vi = 0; vi < 4; ++vi) {
    acc[vi] = zero16();
    const bf16_t* sp = p.SPREV + (size_t)item * 16384 + (size_t)(32 * vi + r) * 128 + 8 * h;
#pragma unroll
    for (int s = 0; s < 8; ++s) acc[vi] = MFMA32(ld16(sp + 16 * s), qf[s], acc[vi]);
    __builtin_amdgcn_sched_barrier(0);
  }
  {
    const float xi = __expf((float)(n + 1) * lg);
#pragma unroll
    for (int vi = 0; vi < 4; ++vi)
#pragma unroll
      for (int e = 0; e < 16; ++e) acc[vi][e] *= xi;
  }
  for (int mt = 0; mt <= nt; ++mt) {
    f32x16 sa = zero16();
    const bf16_t* kp = p.RK + (size_t)(t0 + 32 * mt + r) * 512 + hh * 128 + 8 * h;
#pragma unroll
    for (int s = 0; s < 8; ++s) sa = MFMA32(ld16(kp + 16 * s), qf[s], sa);
    float pv[16];
#pragma unroll
    for (int e = 0; e < 16; ++e) {
      const int dm = n - (32 * mt + crow(e, h));
      pv[e] = (dm >= 0) ? sa[e] * __expf((float)dm * lg) : 0.f;
    }
#pragma unroll
    for (int s2 = 0; s2 < 2; ++s2) {
      bf16x8 bfr = pack8(pv[8 * s2], pv[8 * s2 + 1], pv[8 * s2 + 2], pv[8 * s2 + 3], pv[8 * s2 + 4], pv[8 * s2 + 5], pv[8 * s2 + 6], pv[8 * s2 + 7]);
#pragma unroll
      for (int vi = 0; vi < 4; ++vi) {
        bf16x8 afr = ld8x2(p.RVT + ((size_t)(bh * 128 + 32 * vi + r)) * SEQ + s0 + 32 * mt + 16 * s2 + 4 * h);
        acc[vi] = MFMA32(afr, bfr, acc[vi]);
      }
      __builtin_amdgcn_sched_barrier(0);
    }
  }
  float sum = 0.f;
#pragma unroll
  for (int vi = 0; vi < 4; ++vi)
#pragma unroll
    for (int e = 0; e < 16; ++e) sum += acc[vi][e];
  sum += __shfl_xor(sum, 32);
  const float mu = sum * (1.f / 128.f);
  float var = 0.f;
#pragma unroll
  for (int vi = 0; vi < 4; ++vi)
#pragma unroll
    for (int e = 0; e < 16; ++e) { float d = acc[vi][e] - mu; var += d * d; }
  var += __shfl_xor(var, 32);
  const float rs = rsqrtf(var * (1.f / 128.f) + 1e-6f);
#pragma unroll
  for (int vi = 0; vi < 4; ++vi)
#pragma unroll
    for (int g4 = 0; g4 < 4; ++g4) {
      const int v0 = 32 * vi + 8 * g4 + 4 * h;
      uint2 gt = *(const uint2*)(p.RGT + (size_t)(t0 + n) * 512 + hh * 128 + v0);
      float y0 = (acc[vi][4 * g4 + 0] - mu) * rs * __uint_as_float(gt.x << 16);
      float y1 = (acc[vi][4 * g4 + 1] - mu) * rs * __uint_as_float(gt.x & 0xffff0000u);
      float y2 = (acc[vi][4 * g4 + 2] - mu) * rs * __uint_as_float(gt.y << 16);
      float y3 = (acc[vi][4 * g4 + 3] - mu) * rs * __uint_as_float(gt.y & 0xffff0000u);
      *(uint2*)(p.RA + (size_t)(t0 + n) * DM + hh * 128 + v0) = pack4(y0, y1, y2, y3);
    }
}
#define HID_STRIDE 264
DI void compress_mfma(const Params& p, int item, char* smem) {
  float* PART = (float*)smem;
  bf16_t* HIDL = (bf16_t*)(smem + 4 * 16 * 256 * 4);
  const int tid = mytid(), lane = tid & 63, w = tid >> 6, r = lane & 31, h = lane >> 5;
  const int kv = item >> 7, bg = (item >> 5) & 3, rt = item & 31, n0 = rt * 16, b = bg >> 1, g = bg & 1;
  const bf16_t* src = kv ? p.NVC : p.NKC; const bf16_t* W1 = kv ? p.W1Tv : p.W1Tk; const bf16_t* W2 = kv ? p.W2Tv : p.W2Tk;
  const float* B1 = kv ? p.B1Pv : p.B1Pk;
  {
    const int kq = w >> 1, ch = w & 1;
    const int n = min(n0 + (r & 15), 510);
    const bf16_t* ab = src + ((size_t)(b * SEQ + 16 * n)) * 128 + g * 64 + 8 * h;
    const bf16_t* bb = W1 + (size_t)(128 * ch + r) * 2048 + 8 * h;
    f32x16 acc[4];
#pragma unroll
    for (int ct = 0; ct < 4; ++ct) acc[ct] = zero16();
#pragma unroll 4
    for (int s = 32 * kq; s < 32 * kq + 32; ++s) {
      const bf16x8 a = ld16(ab + (s >> 2) * 128 + (s & 3) * 16);
#pragma unroll
      for (int ct = 0; ct < 4; ++ct) acc[ct] = MFMA32(a, ld16(bb + (size_t)ct * 32 * 2048 + 16 * s), acc[ct]);
    }
#pragma unroll
    for (int ct = 0; ct < 4; ++ct)
#pragma unroll
      for (int e = 0; e < 8; ++e) PART[(kq * 16 + crow(e, h)) * 256 + 128 * ch + 32 * ct + r] = acc[ct][e];
  }
  __syncthreads();
#pragma unroll
  for (int i = 0; i < 8; ++i) {
    const int idx = tid + 512 * i, row = idx >> 8, col = idx & 255;
    const float v = PART[row * 256 + col] + PART[(16 + row) * 256 + col] + PART[(32 + row) * 256 + col] + PART[(48 + row) * 256 + col] + B1[col];
    HIDL[row * HID_STRIDE + col] = f2bf(gelu_tanh(v));
  }
  __syncthreads();
  if (w < 2) {
    f32x16 acc = zero16();
#pragma unroll
    for (int s = 0; s < 16; ++s) acc = MFMA32(ld16(HIDL + (r & 15) * HID_STRIDE + 16 * s + 8 * h), ld16(W2 + (size_t)(32 * w + r) * 256 + 16 * s + 8 * h), acc);
    const int e_ = 32 * w + r;
    if (kv == 0) {
#pragma unroll
      for (int e = 0; e < 8; ++e) { const int n = n0 + crow(e, h); p.KC[((size_t)bg * 512 + n) * 64 + e_] = (n < 511) ? f2bf(acc[e]) : (bf16_t)0; }
    } else {
#pragma unroll
      for (int g4 = 0; g4 < 2; ++g4) {
        const int n = n0 + 8 * g4 + 4 * h;
        float v3 = (n + 3 < 511) ? acc[4 * g4 + 3] : 0.f;
        *(uint2*)(p.VCT + ((size_t)bg * 64 + e_) * 512 + n) = pack4(acc[4 * g4], acc[4 * g4 + 1], acc[4 * g4 + 2], v3);
      }
    }
  }
  __syncthreads();
}
DI void kmax_body2(const Params& p, int vb) {
  const int tid = mytid(), g = tid & 1, t = vb * 256 + (tid >> 1), b = t >> 13;
  const bf16_t* k = p.NKS + (size_t)t * 128 + g * 64; const bf16_t* kw = p.NKW + (size_t)t * 128 + g * 64;
  float ss = 0.f, sw = 0.f;
  for (int d = 0; d < 64; d += 8) {
    uint4 a = *(const uint4*)(k + d), c = *(const uint4*)(kw + d);
    const unsigned aa[4] = {a.x, a.y, a.z, a.w}, cc[4] = {c.x, c.y, c.z, c.w};
#pragma unroll
    for (int q = 0; q < 4; ++q) {
      float x0 = __uint_as_float(aa[q] << 16), x1 = __uint_as_float(aa[q] & 0xffff0000u);
      float y0 = __uint_as_float(cc[q] << 16), y1 = __uint_as_float(cc[q] & 0xffff0000u);
      ss += x0 * x0 + x1 * x1; sw += y0 * y0 + y1 * y1;
    }
  }
  float m1 = sqrtf(ss), m2 = sqrtf(sw);
  for (int o = 2; o < 64; o <<= 1) { m1 = fmaxf(m1, __shfl_xor(m1, o)); m2 = fmaxf(m2, __shfl_xor(m2, o)); }
  if ((tid & 63) < 2) { atomicMax(&p.ksmax[b * 2 + g], __float_as_uint(m1)); atomicMax(&p.ksmax[4 + b * 2 + g], __float_as_uint(m2)); }
}
DI void kcmax_body(const Params& p, int idx) {
  const bf16_t* k = p.KC + (size_t)idx * 64;
  float ss = 0.f;
  for (int d = 0; d < 64; ++d) { float v = bf2f(k[d]); ss += v * v; }
  atomicMax(&p.ksmax[8 + (idx >> 9)], __float_as_uint(sqrtf(ss)));
}

#define NSA_IMP 0
#define NSA_SELM 65536
#define NSA_KV 66816
#define KV_ROW 144
#define KV_TILE (64 * KV_ROW)
template <int CTRL> DI float dpp_f2(float x) { return __builtin_bit_cast(float, __builtin_amdgcn_mov_dpp(__builtin_bit_cast(int, x), CTRL, 0xf, 0xf, true)); }
DI float quad_sum(float v) { v += dpp_f2<0xB1>(v); v += dpp_f2<0x4E>(v); return v; }
DI bf16x8 lds8x2(const char* ptr) {
  uint2 a = *(const uint2*)ptr, b = *(const uint2*)(ptr + 16);
  uint4 v; v.x = a.x; v.y = a.y; v.z = b.x; v.w = b.y;
  return __builtin_bit_cast(bf16x8, v);
}

DI void nsa_item(const Params& p, int item, char* smem) {
  const int tid = mytid(), lane = tid & 63, w = tid >> 6, r = lane & 31, h = lane >> 5;
  const int ti = item >> 2, bg = item & 3, b = bg >> 1, g = bg & 1;
  const int ts = ti * 64, tokg0 = b * SEQ + ts;
  const int tkl = 8 * w + (r >> 2), hl = r & 3, hd = g * 4 + hl, tpos = ts + tkl;
  float* IMPA = (float*)(smem + NSA_IMP); float* IMPB = IMPA + 64 * 128;
  unsigned* SELM = (unsigned*)(smem + NSA_SELM);
  char* KVB = smem + NSA_KV;
  const float ksm = __uint_as_float(p.ksmax[bg]), kwm = __uint_as_float(p.ksmax[4 + bg]), kcm = __uint_as_float(p.ksmax[8 + bg]);

  bf16x8 qf[4];
#pragma unroll
  for (int s = 0; s < 4; ++s) qf[s] = ld16(p.NQ + (size_t)(tokg0 + tkl) * 512 + hd * 64 + 16 * s + 8 * h);
  float qq = 0.f;
#pragma unroll
  for (int s = 0; s < 4; ++s) {
    uint4 u = __builtin_bit_cast(uint4, qf[s]);
    const unsigned uu[4] = {u.x, u.y, u.z, u.w};
#pragma unroll
    for (int q = 0; q < 4; ++q) { float x0 = __uint_as_float(uu[q] << 16), x1 = __uint_as_float(uu[q] & 0xffff0000u); qq += x0 * x0 + x1 * x1; }
  }
  qq += __shfl_xor(qq, 32);
  const float qn = sqrtf(qq);
  const int srow = tid >> 3, sch = tid & 7;
  const bf16_t* ksrc = p.NKS + ((size_t)(b * SEQ) + srow) * 128 + g * 64 + sch * 8;
  const bf16_t* vsrc = p.NVST + ((size_t)bg * 64 + srow) * SEQ + sch * 8;
  const bf16_t* kcs = p.KC + ((size_t)bg * 512 + srow) * 64 + sch * 8;
  const bf16_t* vcs = p.VCT + ((size_t)bg * 64 + srow) * 512 + sch * 8;
  char* sdst = KVB + srow * KV_ROW + sch * 16;
  {
    uint4 k0 = *(const uint4*)kcs, v0 = *(const uint4*)vcs;
    *(uint4*)sdst = k0; *(uint4*)(sdst + KV_TILE) = v0;
  }
  for (int q = tid; q < 64 * 128 * 2 / 4; q += NT) ((float4*)IMPA)[q] = make_float4(0.f, 0.f, 0.f, 0.f);
  __syncthreads();

#define RING_RUN(KS, KSTEP, VS, VSTEP, NTILES, NEED, COMPUTE)                                                                               \
  {                                                                                                                                         \
    for (int jj = 0; jj < (NTILES); ++jj) {                                                                                                 \
      uint4 ka_, va_;                                                                                                                       \
      ka_ = va_ = make_uint4(0u, 0u, 0u, 0u);                                                                                               \
      if (jj + 1 < (NTILES)) { ka_ = *(const uint4*)((KS) + (size_t)(jj + 1) * (KSTEP)); va_ = *(const uint4*)((VS) + (size_t)(jj + 1) * (VSTEP)); } \
      if (NEED(jj)) { const char* kb = KVB + (jj & 1) * 2 * KV_TILE; const char* vbuf = kb + KV_TILE; COMPUTE(jj, kb, vbuf) }               \
      if (jj + 1 < (NTILES)) { char* d2 = sdst + ((jj + 1) & 1) * 2 * KV_TILE; *(uint4*)d2 = ka_; *(uint4*)(d2 + KV_TILE) = va_; }          \
      __syncthreads();                                                                                                                      \
    }                                                                                                                                       \
  }
#define STAGE_PAIR0(KS, KSTEP, VS, VSTEP, NTILES) { uint4 k0_ = *(const uint4*)(KS), v0_ = *(const uint4*)(VS); *(uint4*)sdst = k0_; *(uint4*)(sdst + KV_TILE) = v0_; }
#define IMP_NONE(JJ, kh, pv)
#define ATT_TILE(kb, vbuf, INIT, FULL, MASKEXPR, SCALE, ACC, LACC, IMPHOOK, JJ)                                                             \
          {                                                                                                                                 \
            bf16x8 kf_[2][4], vf_[2][2][2];       \
            _Pragma("unroll") for (int kh = 0; kh < 2; ++kh)                                                                                \
              _Pragma("unroll") for (int s = 0; s < 4; ++s) kf_[kh][s] = *(const bf16x8*)(kb + (32 * kh + r) * KV_ROW + (16 * s + 8 * h) * 2); \
            _Pragma("unroll") for (int kh = 0; kh < 2; ++kh)                                                                                \
              _Pragma("unroll") for (int di = 0; di < 2; ++di)                                                                              \
                _Pragma("unroll") for (int s2 = 0; s2 < 2; ++s2) vf_[kh][di][s2] = lds8x2(vbuf + (32 * di + r) * KV_ROW + (32 * kh + 16 * s2 + 4 * h) * 2); \
            const bool full_ = (FULL);                                                                                                      \
            _Pragma("unroll") for (int kh = 0; kh < 2; ++kh) {                                                                              \
              f32x16 sa = fill16(INIT);                                                                                                     \
              _Pragma("unroll") for (int s = 0; s < 4; ++s) sa = MFMA32(kf_[kh][s], qf[s], sa);                                             \
              float pv[16];                                                                                                                 \
              _Pragma("unroll") for (int e = 0; e < 16; ++e) { const int key = 32 * kh + crow(e, h); pv[e] = (full_ || (MASKEXPR)) ? ex2(sa[e]) * (SCALE) : 0.f; } \
              LACC += ((pv[0] + pv[1]) + (pv[2] + pv[3])) + ((pv[4] + pv[5]) + (pv[6] + pv[7])) + ((pv[8] + pv[9]) + (pv[10] + pv[11])) + ((pv[12] + pv[13]) + (pv[14] + pv[15])); \
              IMPHOOK(JJ, kh, pv)                                                                                                           \
              const bf16x8 pk0 = pack8(pv[0], pv[1], pv[2], pv[3], pv[4], pv[5], pv[6], pv[7]);                                             \
              const bf16x8 pk1 = pack8(pv[8], pv[9], pv[10], pv[11], pv[12], pv[13], pv[14], pv[15]);                                       \
              _Pragma("unroll") for (int di = 0; di < 2; ++di) {                                                                            \
                ACC[di] = MFMA32(vf_[kh][di][0], pk0, ACC[di]);                                                                             \
                ACC[di] = MFMA32(vf_[kh][di][1], pk1, ACC[di]);                                                                             \
              }                                                                                                                             \
            }                                                                                                                               \
          }
  const float mbc = qn * kcm;
  int nvalid = (tpos >= 31) ? ((tpos - 31) >> 4) + 1 : 0;
  if (nvalid > 511) nvalid = 511;
  int nvw = (ts + 8 * w + 7 >= 31) ? ((ts + 8 * w + 7 - 31) >> 4) + 1 : 0;
  if (nvw > 511) nvw = 511;
  int nvmin = (ts + 8 * w >= 31) ? ((ts + 8 * w - 31) >> 4) + 1 : 0;
  if (nvmin > 511) nvmin = 511;
  int nvall = ((ts + 63 - 31) >> 4) + 1;
  if (nvall > 511) nvall = 511;
  const int nct = (nvall + 63) >> 6;
  float lsum = 0.f;
#define CMP_NEED(jj) (64 * (jj) < nvw)
#define CMPA_COMPUTE(jj, kb, vbuf)                                                                                                          \
          { _Pragma("unroll") for (int kh = 0; kh < 2; ++kh) {                                                                              \
              f32x16 sa = fill16(-mbc);                                                                                                     \
              _Pragma("unroll") for (int s = 0; s < 4; ++s) sa = MFMA32(*(const bf16x8*)(kb + (32 * kh + r) * KV_ROW + (16 * s + 8 * h) * 2), qf[s], sa); \
              const bool full_ = 64 * (jj) + 64 <= nvmin;                                                                                   \
              _Pragma("unroll") for (int e = 0; e < 16; ++e) lsum += (full_ || (64 * (jj) + 32 * kh + crow(e, h) < nvalid)) ? ex2(sa[e]) : 0.f; \
            } }
  RING_RUN(kcs, 64 * 64, vcs, 64, nct, CMP_NEED, CMPA_COMPUTE)
  lsum += __shfl_xor(lsum, 32);
  const float invl = (lsum > 0.f) ? 1.f / lsum : 0.f;
  f32x16 oc[2]; oc[0] = zero16(); oc[1] = zero16();
  {
    float ldummy = 0.f;
    STAGE_PAIR0(kcs, 64 * 64, vcs, 64, nct) __syncthreads();
#define CMP_IMP(JJ, kh, pv)                                                                                                                 \
              _Pragma("unroll") for (int q = 0; q < 4; ++q) {                                                                               \
                float A_ = 2.f * (pv[4 * q] + pv[4 * q + 1] + pv[4 * q + 2]) + pv[4 * q + 3], B_ = pv[4 * q + 3];                           \
                A_ = quad_sum(A_); B_ = quad_sum(B_);                                                                                       \
                if (hl == 0) { const int j_ = 16 * (JJ) + 8 * kh + 2 * q + h; IMPA[tkl * 128 + j_] = A_; IMPB[tkl * 128 + j_] = B_; }        \
              }
#define CMPB_COMPUTE(jj, kb, vbuf) ATT_TILE(kb, vbuf, -mbc, 64 * (jj) + 64 <= nvmin, 64 * (jj) + key < nvalid, invl, oc, ldummy, CMP_IMP, jj)
    RING_RUN(kcs, 64 * 64, vcs, 64, nct, CMP_NEED, CMPB_COMPUTE)
  }
  for (int rep522 = 0; rep522 < (PROBE_DUP == 522 ? 2 : 1); ++rep522)
  {
    const int tl = 8 * w + (lane >> 3), sub = lane & 7;
    unsigned kv_[16], ki_[16];
#pragma unroll
    for (int c = 0; c < 16; ++c) {
      const int j = sub + 8 * c;
      float imp = IMPA[tl * 128 + j] + ((j > 0) ? IMPB[tl * 128 + j - 1] : 0.f);
      if (j == 0 || j == ti || j == ti - 1) imp = 1e9f;
      kv_[c] = (j <= ti) ? __float_as_uint(imp) : 0u;
      ki_[c] = (j <= ti) ? (unsigned)(128 - j) : 0u;
    }
    unsigned m0 = 0, m1 = 0, m2 = 0, m3 = 0;
    for (int it = 0; it < 16; ++it) {
      unsigned bv = kv_[0], bi = ki_[0];
#pragma unroll
      for (int c = 1; c < 16; ++c) { const bool gt = (kv_[c] > bv) || (kv_[c] == bv && ki_[c] > bi); bv = gt ? kv_[c] : bv; bi = gt ? ki_[c] : bi; }
#define TOPK_STEP(CTRL) { const unsigned ov = (unsigned)__builtin_amdgcn_mov_dpp((int)bv, CTRL, 0xf, 0xf, true), oi = (unsigned)__builtin_amdgcn_mov_dpp((int)bi, CTRL, 0xf, 0xf, true); \
        const bool gt = (ov > bv) || (ov == bv && oi > bi); bv = gt ? ov : bv; bi = gt ? oi : bi; }
      TOPK_STEP(0xB1) TOPK_STEP(0x4E) TOPK_STEP(0x141)
#undef TOPK_STEP
      if (bi != 0u) {
        const int js = 128 - (int)bi;
        const unsigned bit = 1u << (js & 31);
        if ((js >> 5) == 0) m0 |= bit; else if ((js >> 5) == 1) m1 |= bit; else if ((js >> 5) == 2) m2 |= bit; else m3 |= bit;
#pragma unroll
        for (int c = 0; c < 16; ++c) { const bool hit = (ki_[c] == bi); kv_[c] = hit ? 0u : kv_[c]; ki_[c] = hit ? 0u : ki_[c]; }
      }
    }
    if (sub == 0) { SELM[tl * 4 + 0] = m0; SELM[tl * 4 + 1] = m1; SELM[tl * 4 + 2] = m2; SELM[tl * 4 + 3] = m3; }
  }
  if (lane < 4) {
    unsigned u = 0;
#pragma unroll
    for (int t8 = 0; t8 < 8; ++t8) u |= SELM[(8 * w + t8) * 4 + lane];
    SELM[(64 + w) * 4 + lane] = u;
  }
  __syncthreads();
  const float* gt = p.GATE + (size_t)(tokg0 + tkl) * 24 + hd * 3;
  float* OUTL = IMPA;
  {
    const float g0 = gt[0];
#pragma unroll
    for (int e = 0; e < 16; ++e) { OUTL[e * 512 + tid] = g0 * oc[0][e]; OUTL[(16 + e) * 512 + tid] = g0 * oc[1][e]; }
  }
  STAGE_PAIR0(ksrc, 64 * 128, vsrc, 64, ti + 1) __syncthreads();
  const float mbs = qn * ksm;
  f32x16 osl[2]; osl[0] = zero16(); osl[1] = zero16();
  float lsel = 0.f;
#define SEL_NEED(jj) ((SELM[(64 + w) * 4 + ((jj) >> 5)] >> ((jj) & 31)) & 1u)
#define SEL_COMPUTE(jj, kb, vbuf) { const unsigned msel_ = SELM[tkl * 4 + ((jj) >> 5)]; \
      const float init_ = ((msel_ >> ((jj) & 31)) & 1u) ? -mbs : NEG_INF; ATT_TILE(kb, vbuf, init_, (jj) < ti, key <= tkl, 1.f, osl, lsel, IMP_NONE, jj) }
  RING_RUN(ksrc, 64 * 128, vsrc, 64, ti + 1, SEL_NEED, SEL_COMPUTE)
  lsel += __shfl_xor(lsel, 32);
  {
    const float g1 = gt[1] / lsel;
#pragma unroll
    for (int e = 0; e < 16; ++e) { OUTL[e * 512 + tid] += g1 * osl[0][e]; OUTL[(16 + e) * 512 + tid] += g1 * osl[1][e]; }
  }
  f32x16 ow[2]; ow[0] = zero16(); ow[1] = zero16();
  float lw = 0.f;
  const float mbw = qn * kwm;
  {
    const int j0w = (ti >= 8) ? ti - 8 : 0, nwt = ti - j0w + 1;
    const bf16_t* kws = p.NKW + ((size_t)(b * SEQ + 64 * j0w) + srow) * 128 + g * 64 + sch * 8;
    const bf16_t* vws = p.NVWT + ((size_t)bg * 64 + srow) * SEQ + 64 * j0w + sch * 8;
    STAGE_PAIR0(kws, 64 * 128, vws, 64, nwt) __syncthreads();
#define WIN_NEED(jj) true
#define WIN_COMPUTE(jj, kb, vbuf) { const int jw_ = j0w + (jj); const bool last_ = (jw_ == ti), first_ = (ti >= 8) && ((jj) == 0); \
      ATT_TILE(kb, vbuf, -mbw, !(last_ || first_), last_ ? (key <= tkl) : (key > tkl), 1.f, ow, lw, IMP_NONE, jj) }
    RING_RUN(kws, 64 * 128, vws, 64, nwt, WIN_NEED, WIN_COMPUTE)
  }
  lw += __shfl_xor(lw, 32);
  {
    const float g2 = gt[2] / lw;
#pragma unroll
    for (int di = 0; di < 2; ++di)
#pragma unroll
      for (int g4 = 0; g4 < 4; ++g4) {
        const int d0 = 32 * di + 8 * g4 + 4 * h;
        float y[4];
#pragma unroll
        for (int e = 0; e < 4; ++e) y[e] = OUTL[(16 * di + 4 * g4 + e) * 512 + tid] + g2 * ow[di][4 * g4 + e];
        *(uint2*)(p.RA + (size_t)(tokg0 + tkl) * DM + 512 + hd * 64 + d0) = pack4(y[0], y[1], y[2], y[3]);
      }
  }
  __syncthreads();
}

typedef float f32x4 __attribute__((ext_vector_type(4)));
#define MFMA16(a, b, c) __builtin_amdgcn_mfma_f32_16x16x32_bf16((a), (b), (c), 0, 0, 0)
constexpr int pk_clen(int i) { return 16 / (i + 1); }
constexpr int pk_coff(int i) { int s = 0; for (int q = 0; q < i; ++q) s += pk_clen(q); return s; }
constexpr int pk_cand(int c) {
  int i = 0; while (i < 16 && c >= pk_clen(i)) { c -= pk_clen(i); ++i; }
  return (i < 16) ? i * 16 + c : 256;
}
#define SC_STRIDE 132

DI void convert_row(const Params& p, int row, int lane);
DI unsigned f2key(float x, unsigned tag, unsigned tagmask) {
  const unsigned bits = __float_as_uint(x), m = (unsigned)((int)bits >> 31) | 0x80000000u;
  return ((bits ^ m) & ~tagmask) | tag;
}
DI float key2f(unsigned k, unsigned tagmask) {
  const unsigned u = k & ~tagmask;
  return __uint_as_float((u & 0x80000000u) ? (u ^ 0x80000000u) : ~u);
}
DI void peer_topk_tile(const Params& p, int vb, char* smem) {
  unsigned* SC = (unsigned*)smem;
  unsigned* ELK = (unsigned*)(smem + 256 * SC_STRIDE * 4);
  float* ELW = (float*)(ELK + 16 * 128);
  int* CT = (int*)(ELW + 16 * 128);
  const int tid = mytid(), lane = tid & 63, w = tid >> 6;
  const int t0 = vb * 16;
  if (tid < 64) { int i = 0, c = tid; while (i < 16 && c >= 16 / (i + 1)) { c -= 16 / (i + 1); ++i; } CT[tid] = (i < 16) ? i * 16 + c : 0; }
  for (int rep91 = 0; rep91 < (PROBE_DUP == 91 ? 2 : 1); ++rep91) {
    const int tq = lane & 15, kq = lane >> 4;
#pragma unroll
    for (int pi = 0; pi < 2; ++pi) {
      const int ph = 2 * w + pi;
      bf16x8 bfr[4];
#pragma unroll
      for (int s = 0; s < 4; ++s) bfr[s] = *(const bf16x8*)(p.PQ + (size_t)(t0 + tq) * 2048 + ph * 128 + 32 * s + 8 * kq);
#pragma unroll
      for (int j = 0; j < 8; ++j) {
        f32x4 acc = {0.f, 0.f, 0.f, 0.f};
#pragma unroll
        for (int s = 0; s < 4; ++s) {
          bf16x8 afr = *(const bf16x8*)(p.SUBK + ((size_t)(ph * 128 + 16 * j + tq)) * 128 + 32 * s + 8 * kq);
          acc = MFMA16(afr, bfr[s], acc);
        }
        const int n0 = 16 * j + 4 * kq;
        uint4 kv4;
        kv4.x = f2key(acc[0], 127u - n0, 127u); kv4.y = f2key(acc[1], 126u - n0, 127u); kv4.z = f2key(acc[2], 125u - n0, 127u); kv4.w = f2key(acc[3], 124u - n0, 127u);
        *(uint4*)(SC + (ph * 16 + tq) * SC_STRIDE + n0) = kv4;
      }
    }
  }
  __syncthreads();
  if (tid < 256) {
    unsigned* row = SC + tid * SC_STRIDE;
    unsigned gmax[16];
#pragma unroll
    for (int g = 0; g < 16; ++g) {
      uint4 a = *(uint4*)(row + g * 8), b = *(uint4*)(row + g * 8 + 4);
      gmax[g] = max(max(max(a.x, a.y), max(a.z, a.w)), max(max(b.x, b.y), max(b.z, b.w)));
    }
    unsigned outk[16];
#pragma unroll
    for (int k = 0; k < 16; ++k) {
      unsigned m = max(max(max(max(gmax[0], gmax[1]), max(gmax[2], gmax[3])), max(max(gmax[4], gmax[5]), max(gmax[6], gmax[7]))),
                       max(max(max(gmax[8], gmax[9]), max(gmax[10], gmax[11])), max(max(gmax[12], gmax[13]), max(gmax[14], gmax[15]))));
      const int n = 127 - (int)(m & 127u), gi = n >> 3;
      unsigned* gp = row + gi * 8;
      uint4 a = *(uint4*)gp, b = *(uint4*)(gp + 4);
      const unsigned v[8] = {a.x, a.y, a.z, a.w, b.x, b.y, b.z, b.w};
      unsigned nm = 0u;
#pragma unroll
      for (int e = 0; e < 8; ++e) nm = max(nm, (v[e] == m) ? 0u : v[e]);
      row[n] = 0u;
#pragma unroll
      for (int g = 0; g < 16; ++g) gmax[g] = (g == gi) ? nm : gmax[g];
      outk[k] = m;
    }
#pragma unroll
    for (int k = 0; k < 16; ++k) row[k] = outk[k];
  } else {
#pragma unroll
    for (int i = 0; i < 8; ++i) convert_row(p, (vb * 4 + (w - 4)) * 8 + i, lane);
  }
  __syncthreads();
  for (int rep93 = 0; rep93 < (PROBE_DUP == 93 ? 2 : 1); ++rep93) {
    const int q = tid >> 2, sub = tid & 3, t = q >> 3, pp = q & 7;
    const unsigned* ra = SC + ((2 * pp) * 16 + t) * SC_STRIDE;
    const unsigned* rb = SC + ((2 * pp + 1) * 16 + t) * SC_STRIDE;
    unsigned ck[13];
#pragma unroll
    for (int k = 0; k < 13; ++k) {
      const int ij = (sub == 0) ? pk_cand(4 * k) : (sub == 1) ? pk_cand(4 * k + 1) : (sub == 2) ? pk_cand(4 * k + 2) : pk_cand(4 * k + 3);
      const int ord = 4 * k + sub;
      ck[k] = (ij < 256) ? f2key(key2f(ra[ij >> 4], 127u) + key2f(rb[ij & 15], 127u), (unsigned)(63 - ord), 63u) : 0u;
    }
    unsigned w16[16];
#pragma unroll
    for (int k = 0; k < 16; ++k) {
      unsigned bm = max(max(max(max(ck[0], ck[1]), max(ck[2], ck[3])), max(max(ck[4], ck[5]), max(ck[6], ck[7]))), max(max(max(ck[8], ck[9]), max(ck[10], ck[11])), ck[12]));
      bm = max(bm, (unsigned)__builtin_amdgcn_mov_dpp((int)bm, 0xB1, 0xf, 0xf, true));
      bm = max(bm, (unsigned)__builtin_amdgcn_mov_dpp((int)bm, 0x4E, 0xf, 0xf, true));
#pragma unroll
      for (int c = 0; c < 13; ++c) ck[c] = (ck[c] == bm) ? 0u : ck[c];
      w16[k] = bm;
    }
    float l = 0.f; const float vmax = key2f(w16[0], 63u);
    float ev[16];
#pragma unroll
    for (int k = 0; k < 16; ++k) { ev[k] = __expf(key2f(w16[k], 63u) - vmax); l += ev[k]; }
    const float inv = 1.f / l;
#pragma unroll
    for (int k = 0; k < 16; ++k)
      if ((k & 3) == sub) {
        const int ij = CT[63 - (int)(w16[k] & 63u)];
        const int code = (127 - (int)(ra[ij >> 4] & 127u)) * 128 + (127 - (int)(rb[ij & 15] & 127u));
        ELK[t * 128 + pp * 16 + k] = ((unsigned)code << 7) | (unsigned)(pp * 16 + k);
        ELW[t * 128 + pp * 16 + k] = ev[k] * inv;
      }
  }
  __syncthreads();
  for (int rep94 = 0; rep94 < (PROBE_DUP == 94 ? 2 : 1); ++rep94)
#pragma unroll
  for (int tt = 0; tt < 2; ++tt) {
    const int t = 2 * w + tt;
    const unsigned e0 = ELK[t * 128 + 2 * lane], e1 = ELK[t * 128 + 2 * lane + 1];
    int r0 = 0, r1 = 0;
#pragma unroll 8
    for (int c = 0; c < 32; ++c) {
      const uint4 kq = *(const uint4*)(ELK + t * 128 + 4 * c);
      r0 += (kq.x < e0) + (kq.y < e0) + (kq.z < e0) + (kq.w < e0);
      r1 += (kq.x < e1) + (kq.y < e1) + (kq.z < e1) + (kq.w < e1);
    }
    const size_t gb = (size_t)(t0 + t) * 128;
    p.EIDX[gb + r0] = (int)(e0 >> 7); p.EIDX[gb + r1] = (int)(e1 >> 7);
    p.EW[gb + r0] = ELW[t * 128 + (e0 & 127)]; p.EW[gb + r1] = ELW[t * 128 + (e1 & 127)];
  }
  __syncthreads();
}

DI float dot2bf(unsigned a, unsigned b, float acc) { return __builtin_amdgcn_fdot2_f32_bf16(__builtin_bit_cast(bf16x2_t, a), __builtin_bit_cast(bf16x2_t, b), acc, false); }
template <int CTRL> DI float dpp_f(float x) { return __builtin_bit_cast(float, __builtin_amdgcn_mov_dpp(__builtin_bit_cast(int, x), CTRL, 0xf, 0xf, true)); }
DI float row16_sum(float v) { v += dpp_f<0x128>(v); v += dpp_f<0x124>(v); v += dpp_f<0x122>(v); v += dpp_f<0x121>(v); return v; }
DI float dot_row(const uint4 (&u)[8], const uint4 (&h)[8]) {
  float d = 0.f;
#pragma unroll
  for (int j = 0; j < 8; ++j) { d = dot2bf(u[j].x, h[j].x, d); d = dot2bf(u[j].y, h[j].y, d); d = dot2bf(u[j].z, h[j].z, d); d = dot2bf(u[j].w, h[j].w, d); }
  return row16_sum(d);
}
DI void axpy_row(float (&acc)[64], const uint4 (&v)[8], float c) {
#pragma unroll
  for (int j = 0; j < 8; ++j) {
    const unsigned ww[4] = {v[j].x, v[j].y, v[j].z, v[j].w};
#pragma unroll
    for (int q = 0; q < 4; ++q) {
      acc[j * 8 + 2 * q] += c * __uint_as_float(ww[q] << 16);
      acc[j * 8 + 2 * q + 1] += c * __uint_as_float(ww[q] & 0xffff0000u);
    }
  }
}
DI void axpy_half(float (&acc)[32], const uint4 (&v)[4], float c) {
#pragma unroll
  for (int j = 0; j < 4; ++j) {
    const unsigned ww[4] = {v[j].x, v[j].y, v[j].z, v[j].w};
#pragma unroll
    for (int q = 0; q < 4; ++q) {
      acc[j * 8 + 2 * q] += c * __uint_as_float(ww[q] << 16);
      acc[j * 8 + 2 * q + 1] += c * __uint_as_float(ww[q] & 0xffff0000u);
    }
  }
}
#ifndef PEER_TILE_SHIFT
#define PEER_TILE_SHIFT 8
#endif
DI void fma16_fp8(float& d, const uint4& u, const float* hv) {
  const unsigned ww[4] = {u.x, u.y, u.z, u.w};
#pragma unroll
  for (int q = 0; q < 4; ++q) {
    f32x2_t a = __builtin_amdgcn_cvt_pk_f32_fp8((int)ww[q], false), b = __builtin_amdgcn_cvt_pk_f32_fp8((int)ww[q], true);
    d += a[0] * hv[4 * q] + a[1] * hv[4 * q + 1] + b[0] * hv[4 * q + 2] + b[1] * hv[4 * q + 3];
  }
}
DI float dot_row8(const uint4 (&u)[4], const float (&hv)[64]) {
  float d0 = 0.f, d1 = 0.f;
  fma16_fp8(d0, u[0], hv); fma16_fp8(d1, u[1], hv + 16); fma16_fp8(d0, u[2], hv + 32); fma16_fp8(d1, u[3], hv + 48);
  return row16_sum(d0 + d1);
}
DI void axpy_row8(float (&acc)[64], const uint4 (&v)[4], float c) {
#pragma unroll
  for (int j = 0; j < 4; ++j) {
    const unsigned ww[4] = {v[j].x, v[j].y, v[j].z, v[j].w};
#pragma unroll
    for (int q = 0; q < 4; ++q) {
      f32x2_t a = __builtin_amdgcn_cvt_pk_f32_fp8((int)ww[q], false), b = __builtin_amdgcn_cvt_pk_f32_fp8((int)ww[q], true);
      acc[j * 16 + 4 * q] += c * a[0]; acc[j * 16 + 4 * q + 1] += c * a[1]; acc[j * 16 + 4 * q + 2] += c * b[0]; acc[j * 16 + 4 * q + 3] += c * b[1];
    }
  }
}
DI void peer_gather_block(const Params& p, int vb, char* smem) {
  unsigned* ELK = (unsigned*)smem;
  float* ELC = (float*)(smem + 32768);
  const int tid = mytid(), lane = tid & 63, w = tid >> 6, grp = lane >> 4, i = lane & 15;
  const int tokbase = vb * 64;
  for (int q = tid; q < 64 * 128 / 4; q += NT) {
    ((uint4*)ELK)[q] = ((const uint4*)(p.EIDX + (size_t)tokbase * 128))[q];
    ((float4*)ELC)[q] = ((const float4*)(p.EW + (size_t)tokbase * 128))[q];
  }
  __syncthreads();
#pragma unroll 1
  for (int tt = 0; tt < 2; ++tt) {
    const int tl = w * 8 + grp * 2 + tt, tok = tokbase + tl;
    const unsigned* kk = ELK + tl * 128;
    float* cc = ELC + tl * 128;
    uint4 b0[4], b1[4], b2[4], b3[4];
#define ROW_LOAD(BUF, BASE, E) { const unsigned e_ = kk[E]; _Pragma("unroll") for (int j = 0; j < 4; ++j) BUF[j] = *(const uint4*)(BASE + (size_t)e_ * DM + j * 256); }
    {
      float hv[64];
#pragma unroll
      for (int j = 0; j < 4; ++j)
#pragma unroll
        for (int hf = 0; hf < 2; ++hf) {
          uint4 a = *(const uint4*)(p.RA + (size_t)tok * DM + j * 256 + i * 16 + hf * 8);
          const unsigned aa[4] = {a.x, a.y, a.z, a.w};
#pragma unroll
          for (int q = 0; q < 4; ++q) { hv[j * 16 + hf * 8 + 2 * q] = __uint_as_float(aa[q] << 16); hv[j * 16 + hf * 8 + 2 * q + 1] = __uint_as_float(aa[q] & 0xffff0000u); }
        }
      const unsigned char* ub_ = p.PDN8 + i * 16;
#define DN_COMP(BUF, E) { const unsigned e_ = kk[E]; float d_ = dot_row8(BUF, hv) * p.SDN[e_]; float c_ = cc[E] * gelu_tanh(d_) * p.SUP[e_]; if (i == 0) cc[E] = c_; }
      ROW_LOAD(b0, ub_, 0) ROW_LOAD(b1, ub_, 1) ROW_LOAD(b2, ub_, 2) ROW_LOAD(b3, ub_, 3)
      for (int e = 0; e < 128; e += 4) {
        DN_COMP(b0, e)     if (e + 4 < 128) ROW_LOAD(b0, ub_, e + 4)
        DN_COMP(b1, e + 1) if (e + 4 < 128) ROW_LOAD(b1, ub_, e + 5)
        DN_COMP(b2, e + 2) if (e + 4 < 128) ROW_LOAD(b2, ub_, e + 6)
        DN_COMP(b3, e + 3) if (e + 4 < 128) ROW_LOAD(b3, ub_, e + 7)
      }
#undef DN_COMP
    }
    {
      float acc[64];
#pragma unroll
      for (int e = 0; e < 64; ++e) acc[e] = 0.f;
      const unsigned char* vbase = p.PUP8 + i * 16;
      ROW_LOAD(b0, vbase, 0) ROW_LOAD(b1, vbase, 1) ROW_LOAD(b2, vbase, 2) ROW_LOAD(b3, vbase, 3)
      for (int e = 0; e < 128; e += 4) {
        axpy_row8(acc, b0, cc[e]);     if (e + 4 < 128) ROW_LOAD(b0, vbase, e + 4)
        axpy_row8(acc, b1, cc[e + 1]); if (e + 4 < 128) ROW_LOAD(b1, vbase, e + 5)
        axpy_row8(acc, b2, cc[e + 2]); if (e + 4 < 128) ROW_LOAD(b2, vbase, e + 6)
        axpy_row8(acc, b3, cc[e + 3]); if (e + 4 < 128) ROW_LOAD(b3, vbase, e + 7)
      }
      const int b = tok >> 13;
      const float* ga2 = p.mod + b * 6144 + 5120;
      const float* orow = p.out + (size_t)tok * DM; float* grow = p.gout + (size_t)tok * DM;
      float ss = 0.f;
#pragma unroll
      for (int j = 0; j < 4; ++j)
#pragma unroll
        for (int q4 = 0; q4 < 4; ++q4) {
          const int col = j * 256 + i * 16 + q4 * 4;
          float4 x1 = *(const float4*)(orow + col), gg = *(const float4*)(ga2 + col);
          float* q = acc + j * 16 + q4 * 4;
          q[0] = x1.x + gg.x * q[0]; q[1] = x1.y + gg.y * q[1]; q[2] = x1.z + gg.z * q[2]; q[3] = x1.w + gg.w * q[3];
          ss += q[0] * q[0] + q[1] * q[1] + q[2] * q[2] + q[3] * q[3];
        }
      ss = row16_sum(ss);
      const float rstd = rsqrtf(ss * (1.f / DM) + 1e-6f);
#pragma unroll
      for (int j = 0; j < 4; ++j)
#pragma unroll
        for (int q4 = 0; q4 < 4; ++q4) {
          const int col = j * 256 + i * 16 + q4 * 4;
          float4 gf = *(const float4*)(p.g_final + col);
          const float* q = acc + j * 16 + q4 * 4;
          *(float4*)(grow + col) = make_float4(q[0] * rstd * gf.x, q[1] * rstd * gf.y, q[2] * rstd * gf.z, q[3] * rstd * gf.w);
        }
    }
#undef ROW_LOAD
  }
  __syncthreads();
}
DI void convert_row(const Params& p, int row, int lane) {
  const int tb = row >> 14, rr = row & 16383;
  const float* src = (tb ? p.peer_up : p.peer_down) + (size_t)rr * DM;
  float4 x[4]; float am = 0.f;
#pragma unroll
  for (int q = 0; q < 4; ++q) {
    x[q] = *(const float4*)(src + q * 256 + lane * 4);
    am = fmaxf(am, fmaxf(fmaxf(fabsf(x[q].x), fabsf(x[q].y)), fmaxf(fabsf(x[q].z), fabsf(x[q].w))));
  }
  for (int o = 32; o; o >>= 1) am = fmaxf(am, __shfl_xor(am, o));
  const float sc = (am > 0.f) ? am * (1.f / 448.f) : 1.f, inv = (am > 0.f) ? 448.f / am : 1.f;
  unsigned* dst = (unsigned*)((tb ? p.PUP8 : p.PDN8) + (size_t)rr * DM);
#pragma unroll
  for (int q = 0; q < 4; ++q) {
    int wd = 0;
    wd = __builtin_amdgcn_cvt_pk_fp8_f32(x[q].x * inv, x[q].y * inv, wd, false);
    wd = __builtin_amdgcn_cvt_pk_fp8_f32(x[q].z * inv, x[q].w * inv, wd, true);
    dst[q * 64 + lane] = (unsigned)wd;
  }
  if (lane == 0) (tb ? p.SUP : p.SDN)[rr] = sc;
}

#define N_PHASES 11
template <int PH>
DI void run_phase(const Params& p, char* smem) {
  const int nb = gridDim.x, bid = blockIdx.x, tid = mytid();
  if (PH == 0) {
    for (int vb = bid; vb < PH0_MOD; vb += nb) ph0_body(p, vb, smem);
  } else if (PH == 1) {
    constexpr int kPrepA = (PH0_WIN - PH0_MOD) + (PH0_ROPE - PH0_SUBK);
    for (int vb = bid; vb < T_TOK / 8 + kPrepA; vb += nb) {
      if (vb < T_TOK / 8) rownorm_body(p.x, p.g_mix, p.mod, 0, 1024, p.RA, vb);
      else { const int j = vb - T_TOK / 8; ph0_body(p, (j < PH0_WIN - PH0_MOD) ? PH0_MOD + j : PH0_SUBK + (j - (PH0_WIN - PH0_MOD)), smem); }
    }
  } else if (PH == 2) {
    {
      pg8::StaticOrder S; S.init(T_TOK, NPROJ, nb, bid);
      const pg8::Gemm g{p.RA, p.WinT, T_TOK, NPROJ, 1024};
      pg8::gemm_phase((PG8_LAS unsigned char*)smem, g, S, EpiProj8{p});
    }
    {
      constexpr int kPrepB = (PH0_W2V - PH0_WQ) + (PH0_B1P - PH0_ROPE);
      const int rem = (64 * 14) % nb;
      if (rem == 0 || bid >= rem) {
        for (int j = (rem == 0) ? bid : bid - rem; j < kPrepB; j += (rem == 0) ? nb : nb - rem)
          ph0_body(p, (j < PH0_W2V - PH0_WQ) ? PH0_WQ + j : PH0_ROPE + (j - (PH0_W2V - PH0_WQ)), smem);
      }
    }
  } else if (PH == 3) {
    for (int vb = bid; vb < 256 + 512 + 64; vb += nb) {
      if (vb < 256) compress_mfma(p, vb, smem);
      else if (vb < 256 + 512) retkv_mfma(p, vb - 256);
      else kmax_body2(p, vb - 768);
    }
  } else if (PH == 4) {
    constexpr int kPrepC = (PH0_WQ - PH0_WIN) + (PH0_SUBK - PH0_W2V);
    for (int vb = bid; vb < 256 + 4 + kPrepC; vb += nb) {
      if (vb < 256) scan_body(p, vb * NT + tid);
      else if (vb < 260) kcmax_body(p, (vb - 256) * NT + tid);
      else { const int j = vb - 260; ph0_body(p, (j < PH0_WQ - PH0_WIN) ? PH0_WIN + j : PH0_W2V + (j - (PH0_WQ - PH0_WIN)), smem); }
    }
  } else if (PH == 5) {
    for (int rep = 0; rep < (PROBE_DUP == 51 ? 2 : 1); ++rep)
      for (int vb = bid; vb < 256; vb += nb) retout_mfma(p, vb * 8 + (tid >> 6));
    for (int rep = 0; rep < (PROBE_DUP == 52 ? 2 : 1); ++rep)
      for (int vb = bid; vb < 512; vb += nb) nsa_item(p, (vb < 256) ? vb : 767 - vb, smem);
  } else if (PH == 6) {
    pg8::StaticOrder S; S.init(T_TOK, 1024, nb, bid);
    const pg8::Gemm g{p.RA, p.WoutT, T_TOK, 1024, 1024};
    pg8::gemm_phase((PG8_LAS unsigned char*)smem, g, S, EpiOut8{p.x, p.out, p.mod});
  } else if (PH == 7) {
    for (int vb = bid; vb < T_TOK / 8; vb += nb) rownorm_body(p.out, p.g_ffn, p.mod, 3072, 4096, p.RA, vb);
  } else if (PH == 8) {
    pg8::StaticOrder S; S.init(T_TOK, 2048, nb, bid);
    const pg8::Gemm g{p.RA, p.WqT, T_TOK, 2048, 1024};
    pg8::gemm_phase((PG8_LAS unsigned char*)smem, g, S, EpiPQ8{p.PQ});
  } else if (PH == 9) {
    for (int vb = bid; vb < T_TOK / 16; vb += nb) peer_topk_tile(p, vb, smem);
  } else if (PH == 10) {
    for (int vb = bid; vb < T_TOK / 64; vb += nb) peer_gather_block(p, vb, smem);
  }
}


#define XB_TMO      128
#define XB_XCNT(j)  (256  + 64 * (j))
#define XB_XSUB(j)  (1280 + 64 * (j))
#define XB_XGEN(j)  (2304 + 64 * (j))
#define XB_TOP      3328
#define XB_TOPGEN   3392
#define XCD_BAR_WORDS 3456
#define XB_SPIN_CAP (1u << 22)
#define LAS __attribute__((address_space(3)))
DI unsigned xb_ld(unsigned* p) { return __hip_atomic_load(p, __ATOMIC_RELAXED, __HIP_MEMORY_SCOPE_AGENT); }
DI unsigned xb_add(unsigned* p, unsigned v) { return __hip_atomic_fetch_add(p, v, __ATOMIC_RELAXED, __HIP_MEMORY_SCOPE_AGENT); }
DI unsigned xb_xcc_id() { return (unsigned)__builtin_amdgcn_s_getreg((3 << 11) | 20) & 0xFu; }
#define XB_SPIN(cond, bar) do { unsigned _sp = 0; while (cond) { __builtin_amdgcn_s_sleep(1); \
    if ((++_sp & 255u) == 0u) { if (xb_ld(&(bar)[XB_TMO])) break; if (_sp > XB_SPIN_CAP) { atomicAdd(&(bar)[XB_TMO], 1u); break; } } } } while (0)
struct XcdBarrier { unsigned* bar; unsigned x; volatile LAS unsigned* st; };
DI XcdBarrier xcd_barrier_post(unsigned* bar, volatile LAS unsigned* st) {
  XcdBarrier b; b.bar = bar; b.x = xb_xcc_id(); b.st = st;
  if (threadIdx.x == 0) (void)xb_add(&bar[XB_XCNT(b.x)], 1u);
  return b;
}
DI void xcd_barrier_complete(unsigned* bar, unsigned x, unsigned& nloc, unsigned& nx) {
  const unsigned G = gridDim.x * gridDim.y * gridDim.z;
  unsigned sum, cnt, mine, sp = 0u;
  for (;;) {
    sum = 0u; cnt = 0u; mine = 0u;
#pragma unroll
    for (unsigned j = 0; j < 16; ++j) { const unsigned c = xb_ld(&bar[XB_XCNT(j)]); sum += c; cnt += (c > 0u) ? 1u : 0u; mine = (j == x) ? c : mine; }
    if (sum == G) break;
    __builtin_amdgcn_s_sleep(1);
    if ((++sp & 255u) == 0u) { if (xb_ld(&bar[XB_TMO])) break; if (sp > XB_SPIN_CAP) { atomicAdd(&bar[XB_TMO], 1u); break; } }
  }
  nloc = mine > 0u ? mine : 1u; nx = cnt > 0u ? cnt : 1u;
}
DI void xcd_barrier(const XcdBarrier& b) {
  asm volatile("s_waitcnt vmcnt(0)" ::: "memory");
  __syncthreads();
  if (threadIdx.x == 0) {
    unsigned* bar = b.bar;
    __builtin_amdgcn_s_waitcnt(0);
    unsigned nloc = b.st[0], nx = b.st[1];
    if (nloc == 0u) { xcd_barrier_complete(bar, b.x, nloc, nx); b.st[0] = nloc; b.st[1] = nx; }
    const unsigned old = xb_add(&bar[XB_XSUB(b.x)], 1u);
    const unsigned gen = old / nloc;
    if (old + 1u == (gen + 1u) * nloc) {
      __builtin_amdgcn_fence(__ATOMIC_RELEASE, "agent");
      asm volatile("s_waitcnt vmcnt(0)" ::: "memory");
      const unsigned og = xb_add(&bar[XB_TOP], 1u);
      const unsigned tg = og / nx;
      if (og + 1u == (tg + 1u) * nx) xb_add(&bar[XB_TOPGEN], 1u);
      else XB_SPIN(xb_ld(&bar[XB_TOPGEN]) == tg, bar);
      __builtin_amdgcn_fence(__ATOMIC_ACQUIRE, "agent");
      xb_add(&bar[XB_XGEN(b.x)], 1u);
      asm volatile("s_waitcnt vmcnt(0)" ::: "memory");
    } else {
      XB_SPIN(xb_ld(&bar[XB_XGEN(b.x)]) == gen, bar);
      __builtin_amdgcn_fence(__ATOMIC_ACQUIRE, "agent");
      asm volatile("s_waitcnt vmcnt(0)" ::: "memory");
    }
  }
  __syncthreads();
}

#define SMEM_BYTES 155648

template <int PH>
DI void phase_and_probe(const Params& p, char* smem, cg::grid_group& grid) {
  const int reps = (PROBE_DUP == PH) ? 2 : 1;
  for (int rep = 0; rep < reps; ++rep) {
    if (PH == 10 && rep + 1 < reps) { Params q = p; q.gout = (float*)p.PQ; run_phase<PH>(q, smem); }
    else run_phase<PH>(p, smem);
    if (rep + 1 < reps) grid.sync();
  }
}
__global__ void __launch_bounds__(NT) k_mega(Params p) {
  extern __shared__ __attribute__((aligned(16))) char smem[];
  __shared__ uint4 xb_words;
  cg::grid_group grid = cg::this_grid();
  if (threadIdx.x == 0) xb_words = make_uint4(0u, 0u, 0u, 0u);
  __syncthreads();
  XcdBarrier xb = xcd_barrier_post(p.xbar, (volatile LAS unsigned*)&xb_words);
  phase_and_probe<0>(p, smem, grid); grid.sync();
  phase_and_probe<1>(p, smem, grid); xcd_barrier(xb);
  phase_and_probe<2>(p, smem, grid); xcd_barrier(xb);
  phase_and_probe<3>(p, smem, grid); xcd_barrier(xb);
  phase_and_probe<4>(p, smem, grid); xcd_barrier(xb);
  phase_and_probe<5>(p, smem, grid); xcd_barrier(xb);
  phase_and_probe<6>(p, smem, grid); xcd_barrier(xb);
  phase_and_probe<7>(p, smem, grid); xcd_barrier(xb);
  phase_and_probe<8>(p, smem, grid); xcd_barrier(xb);
  phase_and_probe<9>(p, smem, grid); xcd_barrier(xb);
  phase_and_probe<10>(p, smem, grid);
}
#ifdef MK_MULTI
template <int PH>
__global__ void __launch_bounds__(NT) k_single(Params p) {
  extern __shared__ __attribute__((aligned(16))) char smem[];
  run_phase<PH>(p, smem);
}
#endif

static size_t carve(size_t& off, size_t bytes) { size_t o = off; off += (bytes + 255) & ~(size_t)255; return o; }

extern "C" void kernel_launch(void* const* d_in, const int* in_sizes, int n_in, void* d_out, int out_size, void* d_ws, size_t ws_size,
                              hipStream_t stream) {
  Params p{};
  p.x = (const float*)d_in[0]; p.c = (const float*)d_in[1]; p.w_ada = (const float*)d_in[2]; p.b_ada = (const float*)d_in[3];
  p.g_mix = (const float*)d_in[4]; p.w_in = (const float*)d_in[5]; p.pe_k = (const float*)d_in[6]; p.pe_v = (const float*)d_in[7];
  p.w_k1 = (const float*)d_in[8]; p.b_k1 = (const float*)d_in[9]; p.w_k2 = (const float*)d_in[10]; p.w_v1 = (const float*)d_in[11];
  p.b_v1 = (const float*)d_in[12]; p.w_v2 = (const float*)d_in[13]; p.w_out = (const float*)d_in[14]; p.g_ffn = (const float*)d_in[15];
  p.w_pq = (const float*)d_in[16]; p.subkeys = (const float*)d_in[17]; p.peer_down = (const float*)d_in[18]; p.peer_up = (const float*)d_in[19];
  p.g_final = (const float*)d_in[20];
  p.out = (float*)d_out; p.gout = p.out;
  char* ws = (char*)d_ws;
  size_t off = 0;
  p.mod = (float*)(ws + carve(off, 2 * 6144 * 4));
  p.ksmax = (unsigned*)(ws + carve(off, 256));
  p.xbar = (unsigned*)(ws + carve(off, XCD_BAR_WORDS * 4));
  p.c128 = (float*)(ws + carve(off, (size_t)SEQ * 64 * 4)); p.s128 = (float*)(ws + carve(off, (size_t)SEQ * 64 * 4));
  p.c64 = (float*)(ws + carve(off, (size_t)SEQ * 32 * 4)); p.s64 = (float*)(ws + carve(off, (size_t)SEQ * 32 * 4));
  p.WinT = (bf16_t*)(ws + carve(off, (size_t)NPROJ * 1024 * 2));
  p.WoutT = (bf16_t*)(ws + carve(off, (size_t)1024 * 1024 * 2));
  p.WqT = (bf16_t*)(ws + carve(off, (size_t)2048 * 1024 * 2));
  p.W1Tk = (bf16_t*)(ws + carve(off, (size_t)256 * 2048 * 2)); p.W1Tv = (bf16_t*)(ws + carve(off, (size_t)256 * 2048 * 2));
  p.W2Tk = (bf16_t*)(ws + carve(off, 64 * 256 * 2)); p.W2Tv = (bf16_t*)(ws + carve(off, 64 * 256 * 2));
  p.SUBK = (bf16_t*)(ws + carve(off, (size_t)16 * 128 * 128 * 2));
  p.B1Pk = (float*)(ws + carve(off, 1024)); p.B1Pv = (float*)(ws + carve(off, 1024));
  p.RA = (bf16_t*)(ws + carve(off, (size_t)T_TOK * 1024 * 2));
  size_t rb = off;
  p.RQ = (bf16_t*)(ws + carve(off, (size_t)T_TOK * 512 * 2)); p.RK = (bf16_t*)(ws + carve(off, (size_t)T_TOK * 512 * 2));
  p.RKT = (bf16_t*)(ws + carve(off, (size_t)T_TOK * 512 * 2)); p.RVT = (bf16_t*)(ws + carve(off, (size_t)T_TOK * 512 * 2));
  p.RGT = (bf16_t*)(ws + carve(off, (size_t)T_TOK * 512 * 2)); p.NQ = (bf16_t*)(ws + carve(off, (size_t)T_TOK * 512 * 2));
  p.NKC = (bf16_t*)(ws + carve(off, (size_t)T_TOK * 128 * 2)); p.NVC = (bf16_t*)(ws + carve(off, (size_t)T_TOK * 128 * 2));
  p.NKS = (bf16_t*)(ws + carve(off, (size_t)T_TOK * 128 * 2)); p.NKW = (bf16_t*)(ws + carve(off, (size_t)T_TOK * 128 * 2));
  p.NVST = (bf16_t*)(ws + carve(off, (size_t)T_TOK * 128 * 2)); p.NVWT = (bf16_t*)(ws + carve(off, (size_t)T_TOK * 128 * 2));
  p.GATE = (float*)(ws + carve(off, (size_t)T_TOK * 24 * 4));
  p.KV = (float*)(ws + carve(off, (size_t)512 * 16384 * 4));
  p.SPREV = (bf16_t*)(ws + carve(off, (size_t)512 * 16384 * 2));
  p.KC = (bf16_t*)(ws + carve(off, (size_t)4 * 512 * 64 * 2)); p.VCT = (bf16_t*)(ws + carve(off, (size_t)4 * 512 * 64 * 2));
  p.HID = (float*)(ws + carve(off, (size_t)2 * 2048 * 256 * 4));
  size_t off2 = rb;
  p.PQ = (bf16_t*)(ws + carve(off2, (size_t)T_TOK * 2048 * 2));
  p.EIDX = (int*)(ws + carve(off2, (size_t)T_TOK * 128 * 4));
  p.EW = (float*)(ws + carve(off2, (size_t)T_TOK * 128 * 4));
  p.PDN8 = (unsigned char*)(ws + carve(off2, (size_t)16384 * 1024));
  p.PUP8 = (unsigned char*)(ws + carve(off2, (size_t)16384 * 1024));
  p.SDN = (float*)(ws + carve(off2, 16384 * 4));
  p.SUP = (float*)(ws + carve(off2, 16384 * 4));
  (void)ws_size; (void)in_sizes; (void)n_in; (void)out_size;

#ifdef MK_MULTI
#define LAUNCH1(PH) { hipFuncSetAttribute((const void*)k_single<PH>, hipFuncAttributeMaxDynamicSharedMemorySize, SMEM_BYTES); k_single<PH><<<256, NT, SMEM_BYTES, stream>>>(p); }
  LAUNCH1(0) LAUNCH1(1) LAUNCH1(2) LAUNCH1(3) LAUNCH1(4) LAUNCH1(5) LAUNCH1(6) LAUNCH1(7) LAUNCH1(8) LAUNCH1(9) LAUNCH1(10)
#else
  static int grid_blocks = 0;
  if (!grid_blocks) {
    int dev = 0, cus = 0, per_cu = 0;
    (void)hipGetDevice(&dev);
    (void)hipDeviceGetAttribute(&cus, hipDeviceAttributeMultiprocessorCount, dev);
    (void)hipFuncSetAttribute((const void*)k_mega, hipFuncAttributeMaxDynamicSharedMemorySize, SMEM_BYTES);
    (void)hipOccupancyMaxActiveBlocksPerMultiprocessor(&per_cu, k_mega, NT, SMEM_BYTES);
    if (per_cu < 1) per_cu = 1;
    if (per_cu > 1) per_cu = 1;
    grid_blocks = cus * per_cu;
  }
  (void)hipMemsetAsync(p.xbar, 0, XCD_BAR_WORDS * 4, stream);
  void* args[] = {&p};
  hipError_t e = hipLaunchCooperativeKernel((void*)k_mega, dim3(grid_blocks), dim3(NT), args, SMEM_BYTES, stream);
  if (e != hipSuccess) fprintf(stderr, "cooperative launch failed: %s (grid %d)\n", hipGetErrorString(e), grid_blocks);
#endif
}
```

```cpp
#include <hip/hip_runtime.h>
#include <hip/hip_bf16.h>
#include <hip/hip_cooperative_groups.h>
#include <stdint.h>
#include <stdio.h>
namespace cg = cooperative_groups;

typedef unsigned short bf16_t;
#define DI __device__ __forceinline__

DI int mytid() { int t = threadIdx.x; asm volatile("" : "+v"(t)); return t; }
DI float bf2f(bf16_t v) { return __uint_as_float(((unsigned)v) << 16); }
DI bf16_t f2bf(float x) { unsigned u = __float_as_uint(x); u += 0x7fffu + ((u >> 16) & 1u); return (bf16_t)(u >> 16); }
DI float gelu_tanh(float x) { float u = 0.7978845608028654f * (x + 0.044715f * x * x * x); return 0.5f * x * (1.f + tanhf(u)); }
DI float siluf(float x) { return x / (1.f + __expf(-x)); }
DI float sigmoidf(float x) { return 1.f / (1.f + __expf(-x)); }

#define T_TOK 16384
#define SEQ 8192
#define DM 1024
#define NPROJ 3584
#define NEG_INF (-__builtin_inff())

struct Params {
  const float *x, *c, *w_ada, *b_ada, *g_mix, *w_in, *pe_k, *pe_v, *w_k1, *b_k1, *w_k2, *w_v1, *b_v1, *w_v2, *w_out, *g_ffn,
      *w_pq, *subkeys, *peer_down, *peer_up, *g_final;
  float* out;
  float* gout;
  float* mod;
  unsigned* ksmax;
  unsigned* xbar;
  float *c128, *s128, *c64, *s64;
  bf16_t *WinT, *WoutT, *WqT, *W1Tk, *W1Tv, *W2Tk, *W2Tv, *SUBK;
  float *B1Pk, *B1Pv;
  bf16_t* RA;
  bf16_t *RQ, *RK, *RKT, *RVT, *RGT, *NQ, *NKC, *NVC, *NKS, *NKW, *NVST, *NVWT;
  float* GATE;
  float* KV;
  bf16_t* SPREV;
  bf16_t *KC, *VCT;
  float* HID;
  bf16_t* PQ;
  int* EIDX;
  float* EW;
  unsigned char *PDN8, *PUP8;
  float *SDN, *SUP;
};

DI float logg_h(int h) { return log1pf(-exp2f(-5.f - (float)h)); }


typedef __bf16 bf16x2_t __attribute__((ext_vector_type(2)));
typedef float f32x2_t __attribute__((ext_vector_type(2)));
DI unsigned cvt2(float a, float b) { f32x2_t v = {a, b}; bf16x2_t r = __builtin_convertvector(v, bf16x2_t); return __builtin_bit_cast(unsigned, r); }
DI uint2 pack4(float a, float b, float c, float d) { uint2 r; r.x = cvt2(a, b); r.y = cvt2(c, d); return r; }
#define NT 512
#ifndef PROBE_DUP
#define PROBE_DUP -1
#endif
typedef short bf16x8 __attribute__((ext_vector_type(8)));
typedef float f32x16 __attribute__((ext_vector_type(16)));
#define MFMA32(a, b, c) __builtin_amdgcn_mfma_f32_32x32x16_bf16((a), (b), (c), 0, 0, 0)
DI f32x16 zero16() { f32x16 z; for (int e = 0; e < 16; ++e) z[e] = 0.f; return z; }
DI f32x16 fill16(float v) { f32x16 z; for (int e = 0; e < 16; ++e) z[e] = v; return z; }
DI float ex2(float x) { return __builtin_amdgcn_exp2f(x); }

DI int win_logical_col(int np) {
  const int tile = np >> 8, p = np & 255, half = p >> 7, q = p & 127;
  if (tile < 4) { const int head = 2 * (tile & 1) + (q >> 6), i = q & 63; return (tile >> 1) * 512 + head * 128 + (half ? 64 + i : i); }
  if (tile < 8) return 1024 + (tile - 4) * 256 + p;
  if (tile < 10) { const int head = 4 * (tile - 8) + (q >> 5), i = q & 31; return 2048 + head * 64 + (half ? 32 + i : i); }
  if (tile == 10) { const int blk = q >> 5, i = q & 31; return (blk < 2 ? 2560 + blk * 64 : 2816 + (blk - 2) * 64) + (half ? 32 + i : i); }
  if (tile == 11) { const int blk = q >> 5, i = q & 31; return (blk < 2) ? 3072 + blk * 64 + (half ? 32 + i : i) : 2688 + (half ? 64 : 0) + 32 * (blk - 2) + i; }
  if (tile == 12) return (half ? 3200 : 2944) + q;
  if (tile == 13) return (half == 0 && q < 24) ? 3328 + q : -1;
  return -1;
}

DI void tr_tile(const float* __restrict__ in, bf16_t* __restrict__ out, int K, int N_in, int k0, int n0, int mode, float* tile) {
  const int tid = mytid();
  {
    int nn = tid & 63, col = mode ? win_logical_col(n0 + nn) : (n0 + nn);
#pragma unroll
    for (int i = 0; i < 8; ++i) {
      int kk = (tid >> 6) + 8 * i;
      tile[kk * 65 + nn] = (col >= 0) ? in[(size_t)(k0 + kk) * N_in + col] : 0.f;
    }
  }
  __syncthreads();
  {
    int kk = tid & 63;
#pragma unroll
    for (int i = 0; i < 8; ++i) {
      int nn = (tid >> 6) + 8 * i;
      out[(size_t)(n0 + nn) * K + k0 + kk] = f2bf(tile[kk * 65 + nn]);
    }
  }
  __syncthreads();
}

#define PH0_MOD 96
#define PH0_WIN (PH0_MOD + 16 * 56)
#define PH0_WOUT (PH0_WIN + 256)
#define PH0_WQ (PH0_WOUT + 512)
#define PH0_W1K (PH0_WQ + 128)
#define PH0_W1V (PH0_W1K + 128)
#define PH0_W2K (PH0_W1V + 4)
#define PH0_W2V (PH0_W2K + 4)
#define PH0_SUBK (PH0_W2V + 512)
#define PH0_ROPE (PH0_SUBK + 1024)
#define PH0_B1P (PH0_ROPE + 8)
#define PH0_NVB PH0_B1P

DI void ph0_body(const Params& p, int vb, char* smem) {
  const int tid = mytid();
  float* fs = (float*)smem;
  if (vb < PH0_MOD) {
    int kg = tid >> 6, col = vb * 64 + (tid & 63);
    float a0 = 0.f, a1 = 0.f;
#pragma unroll 8
    for (int k = kg * 128; k < kg * 128 + 128; ++k) {
      float w = p.w_ada[(size_t)k * 6144 + col];
      a0 += siluf(p.c[k]) * w; a1 += siluf(p.c[DM + k]) * w;
    }
    fs[kg * 64 + (tid & 63)] = a0; fs[512 + kg * 64 + (tid & 63)] = a1;
    __syncthreads();
    if (tid < 128) {
      int b = tid >> 6, cc = tid & 63; float s = 0.f;
      for (int g = 0; g < 8; ++g) s += fs[b * 512 + g * 64 + cc];
      p.mod[b * 6144 + vb * 64 + cc] = s + p.b_ada[vb * 64 + cc];
    }
    __syncthreads();
    if (vb == 0 && tid < 12) p.ksmax[tid] = 0u;
  } else if (vb < PH0_WIN) { int t = vb - PH0_MOD; tr_tile(p.w_in, p.WinT, 1024, 3352, (t & 15) * 64, (t >> 4) * 64, 1, fs); }
  else if (vb < PH0_WOUT) { int t = vb - PH0_WIN; tr_tile(p.w_out, p.WoutT, 1024, 1024, (t & 15) * 64, (t >> 4) * 64, 0, fs); }
  else if (vb < PH0_WQ) { int t = vb - PH0_WOUT; tr_tile(p.w_pq, p.WqT, 1024, 2048, (t & 15) * 64, (t >> 4) * 64, 0, fs); }
  else if (vb < PH0_W1K) { int t = vb - PH0_WQ; tr_tile(p.w_k1, p.W1Tk, 2048, 256, (t & 31) * 64, (t >> 5) * 64, 0, fs); }
  else if (vb < PH0_W1V) { int t = vb - PH0_W1K; tr_tile(p.w_v1, p.W1Tv, 2048, 256, (t & 31) * 64, (t >> 5) * 64, 0, fs); }
  else if (vb < PH0_W2K) { int t = vb - PH0_W1V; tr_tile(p.w_k2, p.W2Tk, 256, 64, t * 64, 0, 0, fs); }
  else if (vb < PH0_W2V) { int t = vb - PH0_W2K; tr_tile(p.w_v2, p.W2Tv, 256, 64, t * 64, 0, 0, fs); }
  else if (vb < PH0_SUBK) { int i = (vb - PH0_W2V) * NT + tid; p.SUBK[i] = f2bf(p.subkeys[i]); }
  else if (vb < PH0_ROPE) {
    int idx = (vb - PH0_SUBK) * NT + tid;
    { int s = idx >> 6, i = idx & 63; float inv = powf(10000.f, -(float)(2 * i) / 128.f); float ang = (float)s * inv; p.c128[idx] = cosf(ang); p.s128[idx] = sinf(ang); }
    if (idx < SEQ * 32) { int s = idx >> 5, i = idx & 31; float inv = powf(10000.f, -(float)(2 * i) / 64.f); float ang = (float)s * inv; p.c64[idx] = cosf(ang); p.s64[idx] = sinf(ang); }
  } else {
    int t = vb - PH0_ROPE, kv = t >> 2, jb = t & 3;
    const float* w1 = kv ? p.w_v1 : p.w_k1; const float* pe = kv ? p.pe_v : p.pe_k; const float* b1 = kv ? p.b_v1 : p.b_k1;
    int fg = tid >> 6, j = jb * 64 + (tid & 63);
    float a = 0.f;
#pragma unroll 8
    for (int f = fg * 256; f < fg * 256 + 256; ++f) a += pe[f] * w1[(size_t)f * 256 + j];
    fs[fg * 64 + (tid & 63)] = a;
    __syncthreads();
    if (tid < 64) { float s = b1[j]; for (int g = 0; g < 8; ++g) s += fs[g * 64 + tid]; (kv ? p.B1Pv : p.B1Pk)[j] = s; }
    __syncthreads();
  }
}

DI void rownorm_body(const float* __restrict__ src, const float* __restrict__ g, const float* __restrict__ mod, int sh_off, int sc_off, bf16_t* __restrict__ dst, int vb) {
  int row = vb * 8 + (mytid() >> 6), lane = mytid() & 63;
  int b = row >> 13;
  const float* xr = src + (size_t)row * DM;
  float v[16]; float ss = 0.f;
#pragma unroll
  for (int i = 0; i < 4; ++i) {
    float4 t = *(const float4*)(xr + i * 256 + lane * 4);
    v[i * 4 + 0] = t.x; v[i * 4 + 1] = t.y; v[i * 4 + 2] = t.z; v[i * 4 + 3] = t.w;
    ss += t.x * t.x + t.y * t.y + t.z * t.z + t.w * t.w;
  }
  for (int o = 32; o; o >>= 1) ss += __shfl_xor(ss, o);
  float rstd = rsqrtf(ss * (1.f / DM) + 1e-6f);
  const float* sh = mod + b * 6144 + sh_off; const float* sc = mod + b * 6144 + sc_off;
#pragma unroll
  for (int i = 0; i < 4; ++i) {
    int col = i * 256 + lane * 4;
    float4 gg = *(const float4*)(g + col), s4 = *(const float4*)(sc + col), h4 = *(const float4*)(sh + col);
    float y0 = v[i * 4 + 0] * rstd * gg.x * (1.f + s4.x) + h4.x;
    float y1 = v[i * 4 + 1] * rstd * gg.y * (1.f + s4.y) + h4.y;
    float y2 = v[i * 4 + 2] * rstd * gg.z * (1.f + s4.z) + h4.z;
    float y3 = v[i * 4 + 3] * rstd * gg.w * (1.f + s4.w) + h4.w;
    *(uint2*)(dst + (size_t)row * DM + col) = pack4(y0, y1, y2, y3);
  }
}

#define G_A_BYTES (256 * 144)
#define G_B_BYTES (256 * 144)
#define G_BUF_BYTES (G_A_BYTES + G_B_BYTES)
template <class Epi>
DI void gemm_tile(const bf16_t* __restrict__ A, const bf16_t* __restrict__ Bt, int K, int m0, int n0, char* smem, const Epi& epi) {
  const int tid = mytid(), lane = tid & 63, w = tid >> 6, wm = w >> 2, wn = w & 3, r = lane & 31, h = lane >> 5;
  f32x16 acc[4][2];
#pragma unroll
  for (int i = 0; i < 4; ++i)
#pragma unroll
    for (int j = 0; j < 2; ++j) acc[i][j] = zero16();
  const int crow = tid >> 3, ckc = tid & 7;
  const bf16_t* ag = A + (size_t)(m0 + crow) * K + ckc * 8;
  const bf16_t* bg = Bt + (size_t)(n0 + crow) * K + ckc * 8;
  uint4 ra[4], rb[4];
#pragma unroll
  for (int i = 0; i < 4; ++i) { ra[i] = *(const uint4*)(ag + (size_t)i * 64 * K); rb[i] = *(const uint4*)(bg + (size_t)i * 64 * K); }
  char* lw = smem + crow * 144 + ckc * 16;
#pragma unroll
  for (int i = 0; i < 4; ++i) { *(uint4*)(lw + i * 64 * 144) = ra[i]; *(uint4*)(lw + G_A_BYTES + i * 64 * 144) = rb[i]; }
  __syncthreads();
  const int nk = K >> 6;
  for (int kt = 0; kt < nk; ++kt) {
    const int cur = kt & 1;
    if (kt + 1 < nk) {
      const int k0 = (kt + 1) * 64;
#pragma unroll
      for (int i = 0; i < 4; ++i) { ra[i] = *(const uint4*)(ag + (size_t)i * 64 * K + k0); rb[i] = *(const uint4*)(bg + (size_t)i * 64 * K + k0); }
    }
    const char* la = smem + cur * G_BUF_BYTES + (wm * 128 + r) * 144 + h * 16;
    const char* lb = smem + cur * G_BUF_BYTES + G_A_BYTES + (wn * 64 + r) * 144 + h * 16;
#pragma unroll
    for (int kk = 0; kk < 4; ++kk) {
      bf16x8 b0 = *(const bf16x8*)(lb + kk * 32), b1 = *(const bf16x8*)(lb + 32 * 144 + kk * 32);
#pragma unroll
      for (int i = 0; i < 4; ++i) {
        bf16x8 a = *(const bf16x8*)(la + i * 32 * 144 + kk * 32);
        acc[i][0] = MFMA32(a, b0, acc[i][0]); acc[i][1] = MFMA32(a, b1, acc[i][1]);
      }
    }
    if (kt + 1 < nk) {
      char* lw2 = lw + (cur ^ 1) * G_BUF_BYTES;
#pragma unroll
      for (int i = 0; i < 4; ++i) { *(uint4*)(lw2 + i * 64 * 144) = ra[i]; *(uint4*)(lw2 + G_A_BYTES + i * 64 * 144) = rb[i]; }
    }
    __syncthreads();
  }
  const int G = (n0 >> 6) + wn;
#pragma unroll
  for (int i = 0; i < 4; ++i) {
    float pre[4][8];
#pragma unroll
    for (int g = 0; g < 4; ++g) epi.prefetch(m0 + wm * 128 + i * 32 + 8 * g + 4 * h, G, r, pre[g]);
#pragma unroll
    for (int g = 0; g < 4; ++g) {
      float lo[4], hi[4];
#pragma unroll
      for (int e = 0; e < 4; ++e) { lo[e] = acc[i][0][4 * g + e]; hi[e] = acc[i][1][4 * g + e]; }
      epi(m0 + wm * 128 + i * 32 + 8 * g + 4 * h, G, r, lo, hi, pre[g]);
    }
  }
}

struct EpiProj {
  static constexpr bool kProbe = true;
  const Params& p;
  DI void prefetch(int t0, int G, int c, float (&pre)[8]) const {
    const int s0 = t0 & 8191;
    const bool r128 = G < 16, r64 = (G >= 32 && G < 40) || (G >= 40 && G < 52 && (((G - 40) >> 1) & 1) == 0);
    if (r128) {
      const int i = 32 * (G & 1) + c;
#pragma unroll
      for (int e = 0; e < 4; ++e) { pre[e] = p.c128[(s0 + e) * 64 + i]; pre[4 + e] = p.s128[(s0 + e) * 64 + i]; }
    } else if (r64) {
#pragma unroll
      for (int e = 0; e < 4; ++e) { pre[e] = p.c64[(s0 + e) * 32 + c]; pre[4 + e] = p.s64[(s0 + e) * 32 + c]; }
    } else {
#pragma unroll
      for (int e = 0; e < 8; ++e) pre[e] = 0.f;
    }
  }
  DI void operator()(int t0, int G, int c, const float (&lo)[4], const float (&hi)[4], const float (&pre)[8]) const {
    const int b = t0 >> 13, s0 = t0 & 8191;
    if (G < 16) {
      const int sec = G >> 3, hh = (G & 7) >> 1, j = G & 1, i = 32 * j + c;
      float o1[4], o2[4];
#pragma unroll
      for (int e = 0; e < 4; ++e) {
        float cs = pre[e], sn = pre[4 + e];
        o1[e] = lo[e] * cs - hi[e] * sn; o2[e] = hi[e] * cs + lo[e] * sn;
      }
      if (sec == 0) {
#pragma unroll
        for (int e = 0; e < 4; ++e) {
          p.RQ[(size_t)(t0 + e) * 512 + hh * 128 + i] = f2bf(o1[e]);
          p.RQ[(size_t)(t0 + e) * 512 + hh * 128 + 64 + i] = f2bf(o2[e]);
        }
      } else {
        const float sc = 0.08838834764831845f;
        const float lg = logg_h(hh);
#pragma unroll
        for (int e = 0; e < 4; ++e) {
          o1[e] *= sc; o2[e] *= sc;
          p.RK[(size_t)(t0 + e) * 512 + hh * 128 + i] = f2bf(o1[e]);
          p.RK[(size_t)(t0 + e) * 512 + hh * 128 + 64 + i] = f2bf(o2[e]);
          float zeta = __expf((float)(127 - ((s0 + e) & 127)) * lg);
          o1[e] *= zeta; o2[e] *= zeta;
        }
        *(uint2*)(p.RKT + ((size_t)(b * 4 + hh) * 128 + i) * SEQ + s0) = pack4(o1[0], o1[1], o1[2], o1[3]);
        *(uint2*)(p.RKT + ((size_t)(b * 4 + hh) * 128 + 64 + i) * SEQ + s0) = pack4(o2[0], o2[1], o2[2], o2[3]);
      }
    } else if (G < 24) {
      const int hh = (G - 16) >> 1, d = ((G - 16) & 1) * 64 + c;
      *(uint2*)(p.RVT + ((size_t)(b * 4 + hh) * 128 + d) * SEQ + s0) = pack4(lo[0], lo[1], lo[2], lo[3]);
      *(uint2*)(p.RVT + ((size_t)(b * 4 + hh) * 128 + d + 32) * SEQ + s0) = pack4(hi[0], hi[1], hi[2], hi[3]);
    } else if (G < 32) {
      const int hh = (G - 24) >> 1, d = ((G - 24) & 1) * 64 + c;
#pragma unroll
      for (int e = 0; e < 4; ++e) {
        p.RGT[(size_t)(t0 + e) * 512 + hh * 128 + d] = f2bf(siluf(lo[e]));
        p.RGT[(size_t)(t0 + e) * 512 + hh * 128 + d + 32] = f2bf(siluf(hi[e]));
      }
    } else if (G < 40) {
      const int head = G - 32;
#pragma unroll
      for (int e = 0; e < 4; ++e) {
        float cs = pre[e], sn = pre[4 + e];
        const float qs = 0.125f * 1.4426950408889634f;
        float o1 = (lo[e] * cs - hi[e] * sn) * qs, o2 = (hi[e] * cs + lo[e] * sn) * qs;
        p.NQ[(size_t)(t0 + e) * 512 + head * 64 + c] = f2bf(o1);
        p.NQ[(size_t)(t0 + e) * 512 + head * 64 + 32 + c] = f2bf(o2);
      }
    } else if (G < 52) {
      const int k = G - 40, kind = k >> 1, gg = k & 1;
      float o1[4], o2[4];
#pragma unroll
      for (int e = 0; e < 4; ++e) {
        o1[e] = lo[e]; o2[e] = hi[e];
        if ((kind & 1) == 0) {
          float cs = pre[e], sn = pre[4 + e];
          o1[e] = lo[e] * cs - hi[e] * sn; o2[e] = hi[e] * cs + lo[e] * sn;
        }
      }
      if (kind == 3 || kind == 5) {
        bf16_t* dst = (kind == 3 ? p.NVST : p.NVWT) + ((size_t)(b * 2 + gg) * 64 + c) * SEQ + s0;
        *(uint2*)dst = pack4(o1[0], o1[1], o1[2], o1[3]);
        *(uint2*)(dst + (size_t)32 * SEQ) = pack4(o2[0], o2[1], o2[2], o2[3]);
      } else {
        bf16_t* dst = (kind == 0 ? p.NKC : kind == 1 ? p.NVC : kind == 2 ? p.NKS : p.NKW);
#pragma unroll
        for (int e = 0; e < 4; ++e) {
          dst[(size_t)(t0 + e) * 128 + gg * 64 + c] = f2bf(o1[e]);
          dst[(size_t)(t0 + e) * 128 + gg * 64 + 32 + c] = f2bf(o2[e]);
        }
      }
    } else if (G == 52) {
      if (c < 24) {
#pragma unroll
        for (int e = 0; e < 4; ++e) p.GATE[(size_t)(t0 + e) * 24 + c] = sigmoidf(lo[e]);
      }
    }
  }
};
struct EpiOut {
  static constexpr bool kProbe = false;
  const Params& p;
  DI void prefetch(int t0, int G, int c, float (&pre)[8]) const {
    const int c0 = G * 64 + c;
#pragma unroll
    for (int e = 0; e < 4; ++e) { pre[e] = p.x[(size_t)(t0 + e) * DM + c0]; pre[4 + e] = p.x[(size_t)(t0 + e) * DM + c0 + 32]; }
  }
  DI void operator()(int t0, int G, int c, const float (&lo)[4], const float (&hi)[4], const float (&pre)[8]) const {
    const int b = t0 >> 13;
    const int c0 = G * 64 + c, c1 = c0 + 32;
    const float* ga1 = p.mod + b * 6144 + 2048;
    const float g0 = ga1[c0], g1 = ga1[c1];
#pragma unroll
    for (int e = 0; e < 4; ++e) {
      p.out[(size_t)(t0 + e) * DM + c0] = pre[e] + g0 * lo[e];
      p.out[(size_t)(t0 + e) * DM + c1] = pre[4 + e] + g1 * hi[e];
    }
  }
};
struct EpiPQ {
  static constexpr bool kProbe = false;
  const Params& p;
  DI void prefetch(int, int, int, float (&)[8]) const {}
  DI void operator()(int t0, int G, int c, const float (&lo)[4], const float (&hi)[4], const float (&)[8]) const {
#pragma unroll
    for (int e = 0; e < 4; ++e) {
      p.PQ[(size_t)(t0 + e) * 2048 + G * 64 + c] = f2bf(lo[e]);
      p.PQ[(size_t)(t0 + e) * 2048 + G * 64 + 32 + c] = f2bf(hi[e]);
    }
  }
};


namespace pg8 {
#define PG8_LAS __attribute__((address_space(3)))
typedef float f32x4 __attribute__((ext_vector_type(4)));
constexpr int BM = 256, BK = 64, HALF = 128, HTB = HALF * BK * 2, STAGE_BYTES = 8 * HTB, NXCD = 8, WGM = 8;
DI int lds_byte(int r, int c) { const int st = (r >> 4) * 2 + (c >> 5), rr = r & 15, cc = c & 31, ob = rr * 64 + cc * 2; return st * 1024 + (ob ^ (((ob >> 9) & 1) << 5)); }
DI void stage_rc(int b, int& R, int& C) { const int st = b / 1024, sb = b % 1024, swz = sb ^ (((sb >> 9) & 1) << 5); R = (st >> 1) * 16 + swz / 64; C = (st & 1) * 32 + (swz % 64) / 2; }
DI int perm32(int rho) { const int n = rho >> 4, i = rho & 15; return 8 * (i >> 2) + 4 * n + (i & 3); }
struct Unit { int pm, pn; };
struct Gemm { const bf16_t* A; const bf16_t* Bt; int M, N, K; };
struct StaticOrder {
  int nM, nN, nwg, G, c;
  DI void init(int M, int N, int G_, int c_) { nM = M / BM; nN = N / BM; nwg = nM * nN; G = G_; c = c_; }
  DI bool next(int i, Unit& u) const {
    const long L = (long)i * G + c; if (L >= nwg) return false;
    int wgid = (int)L; { const int q = nwg / NXCD, r = nwg % NXCD, xcd = wgid % NXCD, off = wgid / NXCD; wgid = (xcd < r ? xcd * (q + 1) : r * (q + 1) + (xcd - r) * q) + off; }
    const int nig = WGM * nN, gid = wgid / nig, fm = gid * WGM, gsz = (nM - fm) < WGM ? (nM - fm) : WGM;
    u.pm = fm + ((wgid % nig) % gsz); u.pn = (wgid % nig) / gsz; return true;
  }
  DI void a_ready(const Unit&) const {}
  DI void done(const Unit&) const {}
};
template <class Epi, class Sched>
__device__ __forceinline__ void gemm_phase(PG8_LAS unsigned char* lds, const Gemm g, const Sched& S, const Epi& E) {
    const int tid = mytid(), wid = __builtin_amdgcn_readfirstlane(tid >> 6), lane = tid & 63, wr = wid >> 2, wc = wid & 3, fr = lane & 15, fq = lane >> 4;
    const int K = g.K, nt = K / BK;
    unsigned voffA[2], voffB[2];
#pragma unroll
    for (int i = 0; i < 2; ++i) { int R, C; stage_rc(tid * 16 + i * 8192, R, C); const int Rb = Epi::PERM ? ((R & ~31) + perm32(R & 31)) : R;
        voffA[i] = (unsigned)(R * K + C) * 2u; voffB[i] = (unsigned)(Rb * K + C) * 2u; }
    const size_t kstep = (size_t)(BK * 2);
    const size_t hstep = (size_t)HALF * K * 2;
    const size_t tstep = 2 * hstep;
    const unsigned ldsw = (unsigned)wid * 1024u;
    const int aoff = lds_byte(wr * 64 + fr, fq * 8), boff = lds_byte(wc * 32 + fr, fq * 8);
#define PG8_SA(b, h) (((b) * 2 + (h)) * HTB)
#define PG8_SB(b, h) ((4 + (b) * 2 + (h)) * HTB)
#define PG8_STAGE(bufoff, gbase, voff) do { _Pragma("unroll") for (int _i = 0; _i < 2; ++_i) \
        __builtin_amdgcn_global_load_lds((const unsigned*)((const char*)(gbase) + (voff)[_i]), (PG8_LAS unsigned*)(lds + (bufoff) + ldsw + _i * 8192), 16, 0, 0); } while (0)
#define PG8_LDA(dst, b, h) do { _Pragma("unroll") for (int m = 0; m < 4; ++m) _Pragma("unroll") for (int k = 0; k < 2; ++k) dst[m][k] = *(const PG8_LAS bf16x8*)(lds + PG8_SA(b, h) + aoff + m * 2048 + k * 1024); } while (0)
#define PG8_LDB(dst, b, h) do { _Pragma("unroll") for (int n = 0; n < 2; ++n) _Pragma("unroll") for (int k = 0; k < 2; ++k) dst[n][k] = *(const PG8_LAS bf16x8*)(lds + PG8_SB(b, h) + boff + n * 2048 + k * 1024); } while (0)
#define PG8_MMA(ai, bj, At, Bt) do { __builtin_amdgcn_s_setprio(1); _Pragma("unroll") for (int m = 0; m < 4; ++m) _Pragma("unroll") for (int n = 0; n < 2; ++n) _Pragma("unroll") for (int k = 0; k < 2; ++k) \
        acc[ai][bj][m][n] = __builtin_amdgcn_mfma_f32_16x16x32_bf16(Bt[n][k], At[m][k], acc[ai][bj][m][n], 0, 0, 0); __builtin_amdgcn_s_setprio(0); } while (0)
#define PG8_WAIT_V(n) asm volatile("s_waitcnt vmcnt(" #n ")" ::: "memory")
#define PG8_WAIT_L(n) asm volatile("s_waitcnt lgkmcnt(" #n ")" ::: "memory")
#define PG8_BAR __builtin_amdgcn_s_barrier()
#define PG8_SCHED __builtin_amdgcn_sched_barrier(0)
    Unit cur, nxt; int ui = 0;
    if (!S.next(0, cur)) return;
    f32x4 acc[2][2][4][2];
#pragma unroll
    for (int a = 0; a < 2; ++a)
#pragma unroll
        for (int b = 0; b < 2; ++b)
#pragma unroll
            for (int m = 0; m < 4; ++m)
#pragma unroll
                for (int n = 0; n < 2; ++n) acc[a][b][m][n] = (f32x4){0.f, 0.f, 0.f, 0.f};
    bf16x8 At[4][2], B0[2][2], B1[2][2];
    const char* cA = (const char*)g.A + (size_t)cur.pm * tstep; const char* cB = (const char*)g.Bt + (size_t)cur.pn * tstep;
    S.a_ready(cur);
    PG8_STAGE(PG8_SB(0, 0), cB, voffB); PG8_STAGE(PG8_SA(0, 0), cA, voffA); PG8_STAGE(PG8_SB(0, 1), cB + hstep, voffB); PG8_STAGE(PG8_SA(0, 1), cA + hstep, voffA);
    if (wr == 1) PG8_BAR;
    PG8_WAIT_V(4); PG8_BAR;
    PG8_STAGE(PG8_SB(1, 0), cB + kstep, voffB); PG8_STAGE(PG8_SA(1, 0), cA + kstep, voffA); PG8_STAGE(PG8_SB(1, 1), cB + hstep + kstep, voffB);
    PG8_WAIT_V(6); PG8_BAR;
    for (;;) {
        const bool has_next = S.next(ui + 1, nxt);
        const char* nA = has_next ? (const char*)g.A + (size_t)nxt.pm * tstep : cA; const char* nB = has_next ? (const char*)g.Bt + (size_t)nxt.pn * tstep : cB;
        for (int t = 0; t < nt; t += 2) {
            const bool last = (t == nt - 2);
            const char* a1 = cA + (size_t)(t + 1) * kstep;
            const char* a2 = last ? nA : cA + (size_t)(t + 2) * kstep; const char* b2 = last ? nB : cB + (size_t)(t + 2) * kstep;
            const char* a3 = a2 + kstep; const char* b3 = b2 + kstep;
            if (last && has_next) S.a_ready(nxt);
            PG8_LDB(B0, 0, 0); PG8_SCHED; PG8_LDA(At, 0, 0); PG8_STAGE(PG8_SA(1, 1), a1 + hstep, voffA);
            PG8_WAIT_L(8); PG8_BAR; PG8_WAIT_L(0); PG8_MMA(0, 0, At, B0); PG8_BAR; PG8_SCHED;
            PG8_LDB(B1, 0, 1); PG8_STAGE(PG8_SB(0, 0), b2, voffB);
            PG8_BAR; PG8_WAIT_L(0); PG8_MMA(0, 1, At, B1); PG8_BAR;
            PG8_LDA(At, 0, 1); PG8_STAGE(PG8_SA(0, 0), a2, voffA);
            PG8_BAR; PG8_WAIT_L(0); PG8_MMA(1, 0, At, B0); PG8_BAR; PG8_SCHED;
            PG8_STAGE(PG8_SB(0, 1), b2 + hstep, voffB);
            PG8_WAIT_V(6); PG8_BAR; PG8_MMA(1, 1, At, B1); PG8_BAR;
            PG8_LDB(B0, 1, 0); PG8_SCHED; PG8_LDA(At, 1, 0); PG8_STAGE(PG8_SA(0, 1), a2 + hstep, voffA);
            PG8_WAIT_L(8); PG8_BAR; PG8_WAIT_L(0); PG8_MMA(0, 0, At, B0); PG8_BAR; PG8_SCHED;
            PG8_LDB(B1, 1, 1); PG8_STAGE(PG8_SB(1, 0), b3, voffB);
            PG8_BAR; PG8_WAIT_L(0); PG8_MMA(0, 1, At, B1); PG8_BAR;
            PG8_LDA(At, 1, 1); PG8_STAGE(PG8_SA(1, 0), a3, voffA);
            PG8_BAR; PG8_WAIT_L(0); PG8_MMA(1, 0, At, B0); PG8_BAR; PG8_SCHED;
            PG8_STAGE(PG8_SB(1, 1), b3 + hstep, voffB);
            PG8_WAIT_V(6); PG8_BAR; PG8_MMA(1, 1, At, B1); PG8_BAR;
        }
        if constexpr (!Epi::AFTER_DRAIN) { E(acc, cur, wr, wc, fr, fq); S.done(cur); }
        if (!has_next) break;
#pragma unroll
        for (int a = 0; a < 2; ++a)
#pragma unroll
            for (int b = 0; b < 2; ++b)
#pragma unroll
                for (int m = 0; m < 4; ++m)
#pragma unroll
                    for (int n = 0; n < 2; ++n) acc[a][b][m][n] = (f32x4){0.f, 0.f, 0.f, 0.f};
        cur = nxt; cA = nA; cB = nB; ++ui;
    }
    PG8_WAIT_V(0);
    if (wr == 0) PG8_BAR;
    PG8_BAR;
    if constexpr (Epi::AFTER_DRAIN) { E.fused(acc, cur, wr, wc, fr, fq, lds, wid, lane); S.done(cur); }
#undef PG8_SA
#undef PG8_SB
#undef PG8_STAGE
#undef PG8_LDA
#undef PG8_LDB
#undef PG8_MMA
#undef PG8_WAIT_V
#undef PG8_WAIT_L
#undef PG8_BAR
#undef PG8_SCHED
}
}

template <int CTRL> DI float dpp_q(float x) { return __builtin_bit_cast(float, __builtin_amdgcn_mov_dpp(__builtin_bit_cast(int, x), CTRL, 0xf, 0xf, true)); }
DI void tstore4(bf16_t* dst, float v0, float v1, float v2, float v3, int q) {
  const bool o1_ = q & 1, o2_ = q & 2;
  const float sa = o1_ ? v0 : v1, sb = o1_ ? v2 : v3;
  const float ra = dpp_q<0xB1>(sa), rb = dpp_q<0xB1>(sb);
  const float w0 = o1_ ? ra : v0, w1 = o1_ ? v1 : ra, w2 = o1_ ? rb : v2, w3 = o1_ ? v3 : rb;
  const float sc = o2_ ? w0 : w2, sd = o2_ ? w1 : w3;
  const float rc = dpp_q<0x4E>(sc), rd = dpp_q<0x4E>(sd);
  const float x0 = o2_ ? rc : w0, x1 = o2_ ? rd : w1, x2 = o2_ ? w2 : rc, x3 = o2_ ? w3 : rd;
  *(uint2*)(dst + (size_t)q * SEQ - q) = pack4(x0, x1, x2, x3);
}
DI uint4 pack8u(const float (&a)[4], const float (&b)[4]) { uint4 v; v.x = cvt2(a[0], a[1]); v.y = cvt2(a[2], a[3]); v.z = cvt2(b[0], b[1]); v.w = cvt2(b[2], b[3]); return v; }
struct EpiProj8 {
  static constexpr bool PERM = true, AFTER_DRAIN = false;
  const Params& p;
  DI void operator()(const pg8::f32x4 (&acc)[2][2][4][2], const pg8::Unit& u, int wr, int wc, int fr, int fq) const {
    const int pn = u.pn, q4 = fr & 3;
    const bool rot128 = pn < 4, rot64 = (pn >= 8 && pn < 10) || pn == 10 || (pn == 11 && wc < 2), rot = rot128 || rot64;
    const int t00 = u.pm * 256 + wr * 64 + fr, s00 = t00 & 8191;
    const int cb0 = 8 * fq;
    const float* ct = rot128 ? p.c128 : p.c64; const float* st = rot128 ? p.s128 : p.s64;
    const int nrot = rot128 ? 64 : 32, ridx = (rot128 ? 32 * (wc & 1) : 0) + cb0;
    float cd_[2][4], sd_[2][4];
    if (rot) {
#pragma unroll
      for (int n = 0; n < 2; ++n) {
        const float4 c16 = *(const float4*)(ct + (size_t)16 * nrot + ridx + 4 * n), s16 = *(const float4*)(st + (size_t)16 * nrot + ridx + 4 * n);
        cd_[n][0] = c16.x; cd_[n][1] = c16.y; cd_[n][2] = c16.z; cd_[n][3] = c16.w; sd_[n][0] = s16.x; sd_[n][1] = s16.y; sd_[n][2] = s16.z; sd_[n][3] = s16.w;
      }
    }
#pragma unroll
    for (int ai = 0; ai < 2; ++ai) {
      float c_[2][4], s_[2][4];
      if (rot) {
#pragma unroll
        for (int n = 0; n < 2; ++n) {
          const float4 c4 = *(const float4*)(ct + (size_t)(s00 + 128 * ai) * nrot + ridx + 4 * n), s4 = *(const float4*)(st + (size_t)(s00 + 128 * ai) * nrot + ridx + 4 * n);
          c_[n][0] = c4.x; c_[n][1] = c4.y; c_[n][2] = c4.z; c_[n][3] = c4.w; s_[n][0] = s4.x; s_[n][1] = s4.y; s_[n][2] = s4.z; s_[n][3] = s4.w;
        }
      }
#pragma unroll
      for (int m = 0; m < 4; ++m) {
        const int t = t00 + ai * 128 + m * 16, b = t >> 13, s = t & 8191;
        float lo[2][4], hi[2][4];
#pragma unroll
        for (int n = 0; n < 2; ++n) {
          const pg8::f32x4 L = acc[ai][0][m][n], H = acc[ai][1][m][n];
#pragma unroll
          for (int i = 0; i < 4; ++i) {
            if (rot) {
              const float c = c_[n][i], sn = s_[n][i];
              lo[n][i] = L[i] * c - H[i] * sn; hi[n][i] = H[i] * c + L[i] * sn;
              c_[n][i] = c * cd_[n][i] - sn * sd_[n][i]; s_[n][i] = sn * cd_[n][i] + c * sd_[n][i];
            } else { lo[n][i] = L[i]; hi[n][i] = H[i]; }
          }
        }
        if (pn < 4) {
          const int hh = 2 * (pn & 1) + (wc >> 1), idx = 32 * (wc & 1) + cb0;
          if (pn < 2) {
            *(uint4*)(p.RQ + (size_t)t * 512 + hh * 128 + idx) = pack8u(lo[0], lo[1]);
            *(uint4*)(p.RQ + (size_t)t * 512 + hh * 128 + 64 + idx) = pack8u(hi[0], hi[1]);
          } else {
            const float sc = 0.08838834764831845f;
#pragma unroll
            for (int n = 0; n < 2; ++n)
#pragma unroll
              for (int i = 0; i < 4; ++i) { lo[n][i] *= sc; hi[n][i] *= sc; }
            *(uint4*)(p.RK + (size_t)t * 512 + hh * 128 + idx) = pack8u(lo[0], lo[1]);
            *(uint4*)(p.RK + (size_t)t * 512 + hh * 128 + 64 + idx) = pack8u(hi[0], hi[1]);
            const float zeta = __expf((float)(127 - (s & 127)) * logg_h(hh));
            bf16_t* kt = p.RKT + ((size_t)(b * 4 + hh) * 128 + idx) * SEQ + s;
#pragma unroll
            for (int n = 0; n < 2; ++n) {
              tstore4(kt + (size_t)(4 * n) * SEQ, lo[n][0] * zeta, lo[n][1] * zeta, lo[n][2] * zeta, lo[n][3] * zeta, q4);
              tstore4(kt + (size_t)(64 + 4 * n) * SEQ, hi[n][0] * zeta, hi[n][1] * zeta, hi[n][2] * zeta, hi[n][3] * zeta, q4);
            }
          }
        } else if (pn < 6) {
          bf16_t* v0 = p.RVT + ((size_t)(b * 4 + 2 * (pn - 4)) * 128 + 32 * wc + cb0) * SEQ + s;
#pragma unroll
          for (int n = 0; n < 2; ++n) {
            tstore4(v0 + (size_t)(4 * n) * SEQ, lo[n][0], lo[n][1], lo[n][2], lo[n][3], q4);
            tstore4(v0 + (size_t)(128 + 4 * n) * SEQ, hi[n][0], hi[n][1], hi[n][2], hi[n][3], q4);
          }
        } else if (pn < 8) {
          const int d = 32 * wc + cb0, h0 = 2 * (pn - 6);
#pragma unroll
          for (int n = 0; n < 2; ++n)
#pragma unroll
            for (int i = 0; i < 4; ++i) { lo[n][i] = siluf(lo[n][i]); hi[n][i] = siluf(hi[n][i]); }
          *(uint4*)(p.RGT + (size_t)t * 512 + h0 * 128 + d) = pack8u(lo[0], lo[1]);
          *(uint4*)(p.RGT + (size_t)t * 512 + (h0 + 1) * 128 + d) = pack8u(hi[0], hi[1]);
        } else if (pn < 10) {
          const int head = 4 * (pn - 8) + wc;
          const float qs = 0.125f * 1.4426950408889634f;
#pragma unroll
          for (int n = 0; n < 2; ++n)
#pragma unroll
            for (int i = 0; i < 4; ++i) { lo[n][i] *= qs; hi[n][i] *= qs; }
          *(uint4*)(p.NQ + (size_t)t * 512 + head * 64 + cb0) = pack8u(lo[0], lo[1]);
          *(uint4*)(p.NQ + (size_t)t * 512 + head * 64 + 32 + cb0) = pack8u(hi[0], hi[1]);
        } else if (pn == 10 || (pn == 11 && wc < 2)) {
          bf16_t* dst = (pn == 11) ? p.NKW : (wc < 2 ? p.NKC : p.NKS);
          const int g = wc & 1;
          *(uint4*)(dst + (size_t)t * 128 + g * 64 + cb0) = pack8u(lo[0], lo[1]);
          *(uint4*)(dst + (size_t)t * 128 + g * 64 + 32 + cb0) = pack8u(hi[0], hi[1]);
        } else if (pn == 11) {
          const int c0 = 32 * (wc - 2) + cb0;
          *(uint4*)(p.NVC + (size_t)t * 128 + c0) = pack8u(lo[0], lo[1]);
          *(uint4*)(p.NVC + (size_t)t * 128 + 64 + c0) = pack8u(hi[0], hi[1]);
        } else if (pn == 12) {
          const int col = 32 * wc + cb0, g = col >> 6, d = col & 63;
          bf16_t* v0 = p.NVST + ((size_t)(b * 2 + g) * 64 + d) * SEQ + s;
          bf16_t* v1 = p.NVWT + ((size_t)(b * 2 + g) * 64 + d) * SEQ + s;
#pragma unroll
          for (int n = 0; n < 2; ++n) {
            tstore4(v0 + (size_t)(4 * n) * SEQ, lo[n][0], lo[n][1], lo[n][2], lo[n][3], q4);
            tstore4(v1 + (size_t)(4 * n) * SEQ, hi[n][0], hi[n][1], hi[n][2], hi[n][3], q4);
          }
        } else {
          if (wc == 0) {
#pragma unroll
            for (int n = 0; n < 2; ++n)
#pragma unroll
              for (int i = 0; i < 4; ++i) if (cb0 + 4 * n + i < 24) p.GATE[(size_t)t * 24 + cb0 + 4 * n + i] = sigmoidf(lo[n][i]);
          }
        }
      }
    }
  }
};
struct EpiOut8 {
  static constexpr bool PERM = false, AFTER_DRAIN = false;
  const float* x; float* out; const float* mod;
  DI void operator()(const pg8::f32x4 (&acc)[2][2][4][2], const pg8::Unit& u, int wr, int wc, int fr, int fq) const {
    const int col0 = u.pn * 256 + wc * 32 + 4 * fq;
    const float* ga1 = mod + ((u.pm * 256) >> 13) * 6144 + 2048;
    float4 gv[2][2];
#pragma unroll
    for (int bj = 0; bj < 2; ++bj)
#pragma unroll
      for (int n = 0; n < 2; ++n) gv[bj][n] = *(const float4*)(ga1 + col0 + bj * 128 + n * 16);
#pragma unroll
    for (int ai = 0; ai < 2; ++ai)
#pragma unroll
      for (int m = 0; m < 4; ++m) {
        const size_t ro = (size_t)(u.pm * 256 + wr * 64 + fr + ai * 128 + m * 16) * DM + col0;
        float4 xv[2][2];
#pragma unroll
        for (int bj = 0; bj < 2; ++bj)
#pragma unroll
          for (int n = 0; n < 2; ++n) xv[bj][n] = *(const float4*)(x + ro + bj * 128 + n * 16);
#pragma unroll
        for (int bj = 0; bj < 2; ++bj)
#pragma unroll
          for (int n = 0; n < 2; ++n) {
            const pg8::f32x4 v = acc[ai][bj][m][n]; const float4 g4 = gv[bj][n], x4 = xv[bj][n];
            *(float4*)(out + ro + bj * 128 + n * 16) = make_float4(x4.x + g4.x * v[0], x4.y + g4.y * v[1], x4.z + g4.z * v[2], x4.w + g4.w * v[3]);
          }
      }
  }
};
struct EpiPQ8 {
  static constexpr bool PERM = true, AFTER_DRAIN = false;
  bf16_t* O;
  DI void operator()(const pg8::f32x4 (&acc)[2][2][4][2], const pg8::Unit& u, int wr, int wc, int fr, int fq) const {
#pragma unroll
    for (int ai = 0; ai < 2; ++ai)
#pragma unroll
      for (int m = 0; m < 4; ++m) {
        bf16_t* rowp = O + (size_t)(u.pm * 256 + wr * 64 + fr + ai * 128 + m * 16) * 2048 + u.pn * 256 + wc * 32 + 8 * fq;
#pragma unroll
        for (int bj = 0; bj < 2; ++bj) {
          const pg8::f32x4 v0 = acc[ai][bj][m][0], v1 = acc[ai][bj][m][1];
          uint4 o; o.x = cvt2(v0[0], v0[1]); o.y = cvt2(v0[2], v0[3]); o.z = cvt2(v1[0], v1[1]); o.w = cvt2(v1[2], v1[3]);
          *(uint4*)(rowp + bj * 128) = o;
        }
      }
  }
};
DI int crow(int reg, int h) { return (reg & 3) + 8 * (reg >> 2) + 4 * h; }
DI bf16x8 ld16(const bf16_t* ptr) { return *(const bf16x8*)ptr; }
DI bf16x8 ld8x2(const bf16_t* ptr) {
  uint2 a = *(const uint2*)ptr, b = *(const uint2*)(ptr + 8);
  uint4 v; v.x = a.x; v.y = a.y; v.z = b.x; v.w = b.y;
  return __builtin_bit_cast(bf16x8, v);
}
DI bf16x8 pack8(float x0, float x1, float x2, float x3, float x4, float x5, float x6, float x7) {
  uint4 v; v.x = cvt2(x0, x1); v.y = cvt2(x2, x3); v.z = cvt2(x4, x5); v.w = cvt2(x6, x7);
  return __builtin_bit_cast(bf16x8, v);
}

DI void retkv_mfma(const Params& p, int item) {
  const int lane = mytid() & 63, w = mytid() >> 6, r = lane & 31, h = lane >> 5;
  const int hh = item & 3, c = (item >> 2) & 63, b = item >> 8, bh = b * 4 + hh, s0 = c * 128;
  const int mi = w >> 1, nb = (w & 1) * 2;
  const bf16_t* vb_ = p.RVT + ((size_t)(bh * 128 + 32 * mi + r)) * SEQ + s0 + 8 * h;
  const bf16_t* k0 = p.RKT + ((size_t)(bh * 128 + 32 * nb + r)) * SEQ + s0 + 8 * h;
  const bf16_t* k1 = k0 + (size_t)32 * SEQ;
  f32x16 a0 = zero16(), a1 = zero16();
#pragma unroll
  for (int s = 0; s < 8; ++s) {
    bf16x8 a = ld16(vb_ + 16 * s), b0 = ld16(k0 + 16 * s), b1 = ld16(k1 + 16 * s);
    a0 = MFMA32(a, b0, a0); a1 = MFMA32(a, b1, a1);
  }
  float* dst = p.KV + (size_t)item * 16384;
#pragma unroll
  for (int e = 0; e < 16; ++e) {
    const int v = 32 * mi + crow(e, h);
    dst[v * 128 + 32 * nb + r] = a0[e];
    dst[v * 128 + 32 * nb + 32 + r] = a1[e];
  }
}
DI void scan_body(const Params& p, int idx) {
  const int e = idx & 16383, bh = idx >> 14, b = bh >> 2, h = bh & 3;
  const float cd = __expf(128.f * logg_h(h));
  float S = 0.f;
  for (int c0 = 0; c0 < 64; c0 += 32) {
    float kv[32];
#pragma unroll
    for (int u = 0; u < 32; ++u) kv[u] = p.KV[(size_t)((b * 64 + c0 + u) * 4 + h) * 16384 + e];
#pragma unroll
    for (int u = 0; u < 32; ++u) {
      p.SPREV[(size_t)((b * 64 + c0 + u) * 4 + h) * 16384 + e] = f2bf(S);
      S = cd * S + kv[u];
    }
  }
}
DI void retout_mfma(const Params& p, int task) {
  const int lane = mytid() & 63, r = lane & 31, h = lane >> 5;
  const int item = task >> 2, nt = task & 3;
  const int hh = item & 3, c = (item >> 2) & 63, b = item >> 8, bh = b * 4 + hh, s0 = c * 128, t0 = b * SEQ + s0;
  const float lg = logg_h(hh);
  const int n = 32 * nt + r;
  bf16x8 qf[8];
#pragma unroll
  for (int s = 0; s < 8; ++s) qf[s] = ld16(p.RQ + (size_t)(t0 + n) * 512 + hh * 128 + 16 * s + 8 * h);
  f32x16 acc[4];
#pragma unroll
  for (int vi = 0; vi < 4; ++vi) {
    acc[vi] = zero16();
    const bf16_t* sp = p.SPREV + (size_t)item * 16384 + (size_t)(32 * vi + r) * 128 + 8 * h;
#pragma unroll
    for (int s = 0; s < 8; ++s) acc[vi] = MFMA32(ld16(sp + 16 * s), qf[s], acc[vi]);
    __builtin_amdgcn_sched_barrier(0);
  }
  {
    const float xi = __expf((float)(n + 1) * lg);
#pragma unroll
    for (int vi = 0; vi < 4; ++vi)
#pragma unroll
      for (int e = 0; e < 16; ++e) acc[vi][e] *= xi;
  }
  for (int mt = 0; mt <= nt; ++mt) {
    f32x16 sa = zero16();
    const bf16_t* kp = p.RK + (size_t)(t0 + 32 * mt + r) * 512 + hh * 128 + 8 * h;
#pragma unroll
    for (int s = 0; s < 8; ++s) sa = MFMA32(ld16(kp + 16 * s), qf[s], sa);
    float pv[16];
#pragma unroll
    for (int e = 0; e < 16; ++e) {
      const int dm = n - (32 * mt + crow(e, h));
      pv[e] = (dm >= 0) ? sa[e] * __expf((float)dm * lg) : 0.f;
    }
#pragma unroll
    for (int s2 = 0; s2 < 2; ++s2) {
      bf16x8 bfr = pack8(pv[8 * s2], pv[8 * s2 + 1], pv[8 * s2 + 2], pv[8 * s2 + 3], pv[8 * s2 + 4], pv[8 * s2 + 5], pv[8 * s2 + 6], pv[8 * s2 + 7]);
#pragma unroll
      for (int vi = 0; vi < 4; ++vi) {
        bf16x8 afr = ld8x2(p.RVT + ((size_t)(bh * 128 + 32 * vi + r)) * SEQ + s0 + 32 * mt + 16 * s2 + 4 * h);
        acc[vi] = MFMA32(afr, bfr, acc[vi]);
      }
      __builtin_amdgcn_sched_barrier(0);
    }
  }
  float sum = 0.f;
#pragma unroll
  for (int vi = 0; vi < 4; ++vi)
#pragma unroll
    for (int e = 0; e < 16; ++e) sum += acc[vi][e];
  sum += __shfl_xor(sum, 32);
  const float mu = sum * (1.f / 128.f);
  float var = 0.f;
#pragma unroll
  for (int vi = 0; vi < 4; ++vi)
#pragma unroll
    for (int e = 0; e < 16; ++e) { float d = acc[vi][e] - mu; var += d * d; }
  var += __shfl_xor(var, 32);
  const float rs = rsqrtf(var * (1.f / 128.f) + 1e-6f);
#pragma unroll
  for (int vi = 0; vi < 4; ++vi)
#pragma unroll
    for (int g4 = 0; g4 < 4; ++g4) {
      const int v0 = 32 * vi + 8 * g4 + 4 * h;
      uint2 gt = *(const uint2*)(p.RGT + (size_t)(t0 + n) * 512 + hh * 128 + v0);
      float y0 = (acc[vi][4 * g4 + 0] - mu) * rs * __uint_as_float(gt.x << 16);
      float y1 = (acc[vi][4 * g4 + 1] - mu) * rs * __uint_as_float(gt.x & 0xffff0000u);
      float y2 = (acc[vi][4 * g4 + 2] - mu) * rs * __uint_as_float(gt.y << 16);
      float y3 = (acc[vi][4 * g4 + 3] - mu) * rs * __uint_as_float(gt.y & 0xffff0000u);
      *(uint2*)(p.RA + (size_t)(t0 + n) * DM + hh * 128 + v0) = pack4(y0, y1, y2, y3);
    }
}
#define HID_STRIDE 264
DI void compress_mfma(const Params& p, int item, char* smem) {
  float* PART = (float*)smem;
  bf16_t* HIDL = (bf16_t*)(smem + 4 * 16 * 256 * 4);
  const int tid = mytid(), lane = tid & 63, w = tid >> 6, r = lane & 31, h = lane >> 5;
  const int kv = item >> 7, bg = (item >> 5) & 3, rt = item & 31, n0 = rt * 16, b = bg >> 1, g = bg & 1;
  const bf16_t* src = kv ? p.NVC : p.NKC; const bf16_t* W1 = kv ? p.W1Tv : p.W1Tk; const bf16_t* W2 = kv ? p.W2Tv : p.W2Tk;
  const float* B1 = kv ? p.B1Pv : p.B1Pk;
  {
    const int kq = w >> 1, ch = w & 1;
    const int n = min(n0 + (r & 15), 510);
    const bf16_t* ab = src + ((size_t)(b * SEQ + 16 * n)) * 128 + g * 64 + 8 * h;
    const bf16_t* bb = W1 + (size_t)(128 * ch + r) * 2048 + 8 * h;
    f32x16 acc[4];
#pragma unroll
    for (int ct = 0; ct < 4; ++ct) acc[ct] = zero16();
#pragma unroll 4
    for (int s = 32 * kq; s < 32 * kq + 32; ++s) {
      const bf16x8 a = ld16(ab + (s >> 2) * 128 + (s & 3) * 16);
#pragma unroll
      for (int ct = 0; ct < 4; ++ct) acc[ct] = MFMA32(a, ld16(bb + (size_t)ct * 32 * 2048 + 16 * s), acc[ct]);
    }
#pragma unroll
    for (int ct = 0; ct < 4; ++ct)
#pragma unroll
      for (int e = 0; e < 8; ++e) PART[(kq * 16 + crow(e, h)) * 256 + 128 * ch + 32 * ct + r] = acc[ct][e];
  }
  __syncthreads();
#pragma unroll
  for (int i = 0; i < 8; ++i) {
    const int idx = tid + 512 * i, row = idx >> 8, col = idx & 255;
    const float v = PART[row * 256 + col] + PART[(16 + row) * 256 + col] + PART[(32 + row) * 256 + col] + PART[(48 + row) * 256 + col] + B1[col];
    HIDL[row * HID_STRIDE + col] = f2bf(gelu_tanh(v));
  }
  __syncthreads();
  if (w < 2) {
    f32x16 acc = zero16();
#pragma unroll
    for (int s = 0; s < 16; ++s) acc = MFMA32(ld16(HIDL + (r & 15) * HID_STRIDE + 16 * s + 8 * h), ld16(W2 + (size_t)(32 * w + r) * 256 + 16 * s + 8 * h), acc);
    const int e_ = 32 * w + r;
    if (kv == 0) {
#pragma unroll
      for (int e = 0; e < 8; ++e) { const int n = n0 + crow(e, h); p.KC[((size_t)bg * 512 + n) * 64 + e_] = (n < 511) ? f2bf(acc[e]) : (bf16_t)0; }
    } else {
#pragma unroll
      for (int g4 = 0; g4 < 2; ++g4) {
        const int n = n0 + 8 * g4 + 4 * h;
        float v3 = (n + 3 < 511) ? acc[4 * g4 + 3] : 0.f;
        *(uint2*)(p.VCT + ((size_t)bg * 64 + e_) * 512 + n) = pack4(acc[4 * g4], acc[4 * g4 + 1], acc[4 * g4 + 2], v3);
      }
    }
  }
  __syncthreads();
}
DI void kmax_body2(const Params& p, int vb) {
  const int tid = mytid(), g = tid & 1, t = vb * 256 + (tid >> 1), b = t >> 13;
  const bf16_t* k = p.NKS + (size_t)t * 128 + g * 64; const bf16_t* kw = p.NKW + (size_t)t * 128 + g * 64;
  float ss = 0.f, sw = 0.f;
  for (int d = 0; d < 64; d += 8) {
    uint4 a = *(const uint4*)(k + d), c = *(const uint4*)(kw + d);
    const unsigned aa[4] = {a.x, a.y, a.z, a.w}, cc[4] = {c.x, c.y, c.z, c.w};
#pragma unroll
    for (int q = 0; q < 4; ++q) {
      float x0 = __uint_as_float(aa[q] << 16), x1 = __uint_as_float(aa[q] & 0xffff0000u);
      float y0 = __uint_as_float(cc[q] << 16), y1 = __uint_as_float(cc[q] & 0xffff0000u);
      ss += x0 * x0 + x1 * x1; sw += y0 * y0 + y1 * y1;
    }
  }
  float m1 = sqrtf(ss), m2 = sqrtf(sw);
  for (int o = 2; o < 64; o <<= 1) { m1 = fmaxf(m1, __shfl_xor(m1, o)); m2 = fmaxf(m2, __shfl_xor(m2, o)); }
  if ((tid & 63) < 2) { atomicMax(&p.ksmax[b * 2 + g], __float_as_uint(m1)); atomicMax(&p.ksmax[4 + b * 2 + g], __float_as_uint(m2)); }
}
DI void kcmax_body(const Params& p, int idx) {
  const bf16_t* k = p.KC + (size_t)idx * 64;
  float ss = 0.f;
  for (int d = 0; d < 64; ++d) { float v = bf2f(k[d]); ss += v * v; }
  atomicMax(&p.ksmax[8 + (idx >> 9)], __float_as_uint(sqrtf(ss)));
}

#define NSA_IMP 0
#define NSA_SELM 65536
#define NSA_KV 66816
#define KV_ROW 144
#define KV_TILE (64 * KV_ROW)
template <int CTRL> DI float dpp_f2(float x) { return __builtin_bit_cast(float, __builtin_amdgcn_mov_dpp(__builtin_bit_cast(int, x), CTRL, 0xf, 0xf, true)); }
DI float quad_sum(float v) { v += dpp_f2<0xB1>(v); v += dpp_f2<0x4E>(v); return v; }
DI bf16x8 lds8x2(const char* ptr) {
  uint2 a = *(const uint2*)ptr, b = *(const uint2*)(ptr + 16);
  uint4 v; v.x = a.x; v.y = a.y; v.z = b.x; v.w = b.y;
  return __builtin_bit_cast(bf16x8, v);
}

DI void nsa_item(const Params& p, int item, char* smem) {
  const int tid = mytid(), lane = tid & 63, w = tid >> 6, r = lane & 31, h = lane >> 5;
  const int ti = item >> 2, bg = item & 3, b = bg >> 1, g = bg & 1;
  const int ts = ti * 64, tokg0 = b * SEQ + ts;
  const int tkl = 8 * w + (r >> 2), hl = r & 3, hd = g * 4 + hl, tpos = ts + tkl;
  float* IMPA = (float*)(smem + NSA_IMP); float* IMPB = IMPA + 64 * 128;
  unsigned* SELM = (unsigned*)(smem + NSA_SELM);
  char* KVB = smem + NSA_KV;
  const float ksm = __uint_as_float(p.ksmax[bg]), kwm = __uint_as_float(p.ksmax[4 + bg]), kcm = __uint_as_float(p.ksmax[8 + bg]);

  bf16x8 qf[4];
#pragma unroll
  for (int s = 0; s < 4; ++s) qf[s] = ld16(p.NQ + (size_t)(tokg0 + tkl) * 512 + hd * 64 + 16 * s + 8 * h);
  float qq = 0.f;
#pragma unroll
  for (int s = 0; s < 4; ++s) {
    uint4 u = __builtin_bit_cast(uint4, qf[s]);
    const unsigned uu[4] = {u.x, u.y, u.z, u.w};
#pragma unroll
    for (int q = 0; q < 4; ++q) { float x0 = __uint_as_float(uu[q] << 16), x1 = __uint_as_float(uu[q] & 0xffff0000u); qq += x0 * x0 + x1 * x1; }
  }
  qq += __shfl_xor(qq, 32);
  const float qn = sqrtf(qq);
  const int srow = tid >> 3, sch = tid & 7;
  const bf16_t* ksrc = p.NKS + ((size_t)(b * SEQ) + srow) * 128 + g * 64 + sch * 8;
  const bf16_t* vsrc = p.NVST + ((size_t)bg * 64 + srow) * SEQ + sch * 8;
  const bf16_t* kcs = p.KC + ((size_t)bg * 512 + srow) * 64 + sch * 8;
  const bf16_t* vcs = p.VCT + ((size_t)bg * 64 + srow) * 512 + sch * 8;
  char* sdst = KVB + srow * KV_ROW + sch * 16;
  {
    uint4 k0 = *(const uint4*)kcs, v0 = *(const uint4*)vcs;
    *(uint4*)sdst = k0; *(uint4*)(sdst + KV_TILE) = v0;
  }
  for (int q = tid; q < 64 * 128 * 2 / 4; q += NT) ((float4*)IMPA)[q] = make_float4(0.f, 0.f, 0.f, 0.f);
  __syncthreads();

#define RING_RUN(KS, KSTEP, VS, VSTEP, NTILES, NEED, COMPUTE)                                                                               \
  {                                                                                                                                         \
    for (int jj = 0; jj < (NTILES); ++jj) {                                                                                                 \
      uint4 ka_, va_;                                                                                                                       \
      ka_ = va_ = make_uint4(0u, 0u, 0u, 0u);                                                                                               \
      if (jj + 1 < (NTILES)) { ka_ = *(const uint4*)((KS) + (size_t)(jj + 1) * (KSTEP)); va_ = *(const uint4*)((VS) + (size_t)(jj + 1) * (VSTEP)); } \
      if (NEED(jj)) { const char* kb = KVB + (jj & 1) * 2 * KV_TILE; const char* vbuf = kb + KV_TILE; COMPUTE(jj, kb, vbuf) }               \
      if (jj + 1 < (NTILES)) { char* d2 = sdst + ((jj + 1) & 1) * 2 * KV_TILE; *(uint4*)d2 = ka_; *(uint4*)(d2 + KV_TILE) = va_; }          \
      __syncthreads();                                                                                                                      \
    }                                                                                                                                       \
  }
#define STAGE_PAIR0(KS, KSTEP, VS, VSTEP, NTILES) { uint4 k0_ = *(const uint4*)(KS), v0_ = *(const uint4*)(VS); *(uint4*)sdst = k0_; *(uint4*)(sdst + KV_TILE) = v0_; }
#define IMP_NONE(JJ, kh, pv)
#define ATT_EXP(x) ex2(x)
#define ATT_LSUM(LACC, pv) LACC += ((pv[0] + pv[1]) + (pv[2] + pv[3])) + ((pv[4] + pv[5]) + (pv[6] + pv[7])) + ((pv[8] + pv[9]) + (pv[10] + pv[11])) + ((pv[12] + pv[13]) + (pv[14] + pv[15]));
#define ATT_TILE(kb, vbuf, INIT, FULL, MASKEXPR, SCALE, ACC, LACC, IMPHOOK, JJ)                                                             \
          {                                                                                                                                 \
            bf16x8 kf_[2][4], vf_[2][2][2];       \
            _Pragma("unroll") for (int kh = 0; kh < 2; ++kh)                                                                                \
              _Pragma("unroll") for (int s = 0; s < 4; ++s) kf_[kh][s] = *(const bf16x8*)(kb + (32 * kh + r) * KV_ROW + (16 * s + 8 * h) * 2); \
            _Pragma("unroll") for (int kh = 0; kh < 2; ++kh)                                                                                \
              _Pragma("unroll") for (int di = 0; di < 2; ++di)                                                                              \
                _Pragma("unroll") for (int s2 = 0; s2 < 2; ++s2) vf_[kh][di][s2] = lds8x2(vbuf + (32 * di + r) * KV_ROW + (32 * kh + 16 * s2 + 4 * h) * 2); \
            const bool full_ = (FULL);                                                                                                      \
            _Pragma("unroll") for (int kh = 0; kh < 2; ++kh) {                                                                              \
              f32x16 sa = fill16(INIT);                                                                                                     \
              _Pragma("unroll") for (int s = 0; s < 4; ++s) sa = MFMA32(kf_[kh][s], qf[s], sa);                                             \
              float pv[16];                                                                                                                 \
              _Pragma("unroll") for (int e = 0; e < 16; ++e) pv[e] = ATT_EXP(sa[e]) * (SCALE);                                              \
              if (!full_) { _Pragma("unroll") for (int e = 0; e < 16; ++e) { const int key = 32 * kh + crow(e, h); pv[e] = (MASKEXPR) ? pv[e] : 0.f; } }     \
              ATT_LSUM(LACC, pv)                                                                                                             \
              IMPHOOK(JJ, kh, pv)                                                                                                           \
              const bf16x8 pk0 = pack8(pv[0], pv[1], pv[2], pv[3], pv[4], pv[5], pv[6], pv[7]);                                             \
              const bf16x8 pk1 = pack8(pv[8], pv[9], pv[10], pv[11], pv[12], pv[13], pv[14], pv[15]);                                       \
              _Pragma("unroll") for (int di = 0; di < 2; ++di) {                                                                            \
                ACC[di] = MFMA32(vf_[kh][di][0], pk0, ACC[di]);                                                                             \
                ACC[di] = MFMA32(vf_[kh][di][1], pk1, ACC[di]);                                                                             \
              }                                                                                                                             \
            }                                                                                                                               \
          }
  const float mbc = qn * kcm;
  int nvalid = (tpos >= 31) ? ((tpos - 31) >> 4) + 1 : 0;
  if (nvalid > 511) nvalid = 511;
  int nvw = (ts + 8 * w + 7 >= 31) ? ((ts + 8 * w + 7 - 31) >> 4) + 1 : 0;
  if (nvw > 511) nvw = 511;
  int nvmin = (ts + 8 * w >= 31) ? ((ts + 8 * w - 31) >> 4) + 1 : 0;
  if (nvmin > 511) nvmin = 511;
  int nvall = ((ts + 63 - 31) >> 4) + 1;
  if (nvall > 511) nvall = 511;
  const int nct = (nvall + 63) >> 6;
  float lsum = 0.f;
#define CMP_NEED(jj) (64 * (jj) < nvw)
#define CMPA_COMPUTE(jj, kb, vbuf)                                                                                                          \
          { _Pragma("unroll") for (int kh = 0; kh < 2; ++kh) {                                                                              \
              f32x16 sa = fill16(-mbc);                                                                                                     \
              _Pragma("unroll") for (int s = 0; s < 4; ++s) sa = MFMA32(*(const bf16x8*)(kb + (32 * kh + r) * KV_ROW + (16 * s + 8 * h) * 2), qf[s], sa); \
              const bool full_ = 64 * (jj) + 64 <= nvmin;                                                                                   \
              if (full_) { _Pragma("unroll") for (int e = 0; e < 16; ++e) lsum += ex2(sa[e]); }                                             \
              else { _Pragma("unroll") for (int e = 0; e < 16; ++e) lsum += (64 * (jj) + 32 * kh + crow(e, h) < nvalid) ? ex2(sa[e]) : 0.f; } \
            } }
  RING_RUN(kcs, 64 * 64, vcs, 64, nct, CMP_NEED, CMPA_COMPUTE)
  lsum += __shfl_xor(lsum, 32);
  const float invl = (lsum > 0.f) ? 1.f / lsum : 0.f;
  f32x16 oc[2]; oc[0] = zero16(); oc[1] = zero16();
  {
    float ldummy = 0.f;
    STAGE_PAIR0(kcs, 64 * 64, vcs, 64, nct) __syncthreads();
#define CMP_IMP(JJ, kh, pv)                                                                                                                 \
              _Pragma("unroll") for (int q = 0; q < 4; ++q) {                                                                               \
                float A_ = 2.f * (pv[4 * q] + pv[4 * q + 1] + pv[4 * q + 2]) + pv[4 * q + 3], B_ = pv[4 * q + 3];                           \
                A_ = quad_sum(A_); B_ = quad_sum(B_);                                                                                       \
                if (hl == 0) { const int j_ = 16 * (JJ) + 8 * kh + 2 * q + h; IMPA[tkl * 128 + j_] = A_; IMPB[tkl * 128 + j_] = B_; }        \
              }
#define CMPB_COMPUTE(jj, kb, vbuf) ATT_TILE(kb, vbuf, -mbc, 64 * (jj) + 64 <= nvmin, 64 * (jj) + key < nvalid, invl, oc, ldummy, CMP_IMP, jj)
    RING_RUN(kcs, 64 * 64, vcs, 64, nct, CMP_NEED, CMPB_COMPUTE)
  }
  for (int rep522 = 0; rep522 < (PROBE_DUP == 522 ? 2 : 1); ++rep522)
  {
    const int tl = 8 * w + (lane >> 3), sub = lane & 7;
    unsigned kv_[16], ki_[16];
#pragma unroll
    for (int c = 0; c < 16; ++c) {
      const int j = sub + 8 * c;
      float imp = IMPA[tl * 128 + j] + ((j > 0) ? IMPB[tl * 128 + j - 1] : 0.f);
      if (j == 0 || j == ti || j == ti - 1) imp = 1e9f;
      kv_[c] = (j <= ti) ? __float_as_uint(imp) : 0u;
      ki_[c] = (j <= ti) ? (unsigned)(128 - j) : 0u;
    }
    unsigned m0 = 0, m1 = 0, m2 = 0, m3 = 0;
    for (int it = 0; it < 16; ++it) {
      unsigned bv = kv_[0], bi = ki_[0];
#pragma unroll
      for (int c = 1; c < 16; ++c) { const bool gt = (kv_[c] > bv) || (kv_[c] == bv && ki_[c] > bi); bv = gt ? kv_[c] : bv; bi = gt ? ki_[c] : bi; }
#define TOPK_STEP(CTRL) { const unsigned ov = (unsigned)__builtin_amdgcn_mov_dpp((int)bv, CTRL, 0xf, 0xf, true), oi = (unsigned)__builtin_amdgcn_mov_dpp((int)bi, CTRL, 0xf, 0xf, true); \
        const bool gt = (ov > bv) || (ov == bv && oi > bi); bv = gt ? ov : bv; bi = gt ? oi : bi; }
      TOPK_STEP(0xB1) TOPK_STEP(0x4E) TOPK_STEP(0x141)
#undef TOPK_STEP
      if (bi != 0u) {
        const int js = 128 - (int)bi;
        const unsigned bit = 1u << (js & 31);
        if ((js >> 5) == 0) m0 |= bit; else if ((js >> 5) == 1) m1 |= bit; else if ((js >> 5) == 2) m2 |= bit; else m3 |= bit;
#pragma unroll
        for (int c = 0; c < 16; ++c) { const bool hit = (ki_[c] == bi); kv_[c] = hit ? 0u : kv_[c]; ki_[c] = hit ? 0u : ki_[c]; }
      }
    }
    if (sub == 0) { SELM[tl * 4 + 0] = m0; SELM[tl * 4 + 1] = m1; SELM[tl * 4 + 2] = m2; SELM[tl * 4 + 3] = m3; }
  }
  if (lane < 4) {
    unsigned u = 0;
#pragma unroll
    for (int t8 = 0; t8 < 8; ++t8) u |= SELM[(8 * w + t8) * 4 + lane];
    SELM[(64 + w) * 4 + lane] = u;
  }
  __syncthreads();
  const float* gt = p.GATE + (size_t)(tokg0 + tkl) * 24 + hd * 3;
  float* OUTL = IMPA;
  {
    const float g0 = gt[0];
#pragma unroll
    for (int e = 0; e < 16; ++e) { OUTL[e * 512 + tid] = g0 * oc[0][e]; OUTL[(16 + e) * 512 + tid] = g0 * oc[1][e]; }
  }
  STAGE_PAIR0(ksrc, 64 * 128, vsrc, 64, ti + 1) __syncthreads();
  const float mbs = qn * ksm;
  f32x16 osl[2]; osl[0] = zero16(); osl[1] = zero16();
  float lsel = 0.f;
#define SEL_NEED(jj) ((SELM[(64 + w) * 4 + ((jj) >> 5)] >> ((jj) & 31)) & 1u)
#define SEL_COMPUTE(jj, kb, vbuf) { const unsigned msel_ = SELM[tkl * 4 + ((jj) >> 5)]; \
      const float init_ = ((msel_ >> ((jj) & 31)) & 1u) ? -mbs : NEG_INF; ATT_TILE(kb, vbuf, init_, (jj) < ti, key <= tkl, 1.f, osl, lsel, IMP_NONE, jj) }
  RING_RUN(ksrc, 64 * 128, vsrc, 64, ti + 1, SEL_NEED, SEL_COMPUTE)
  lsel += __shfl_xor(lsel, 32);
  {
    const float g1 = gt[1] / lsel;
#pragma unroll
    for (int e = 0; e < 16; ++e) { OUTL[e * 512 + tid] += g1 * osl[0][e]; OUTL[(16 + e) * 512 + tid] += g1 * osl[1][e]; }
  }
#if PROBE_DUP >= 530 && PROBE_DUP <= 539
  {
    osl[0] = zero16(); osl[1] = zero16(); lsel = 0.f;
    STAGE_PAIR0(ksrc, 64 * 128, vsrc, 64, ti + 1) __syncthreads();
#if PROBE_DUP == 530
    RING_RUN(ksrc, 64 * 128, vsrc, 64, ti + 1, SEL_NEED, SEL_COMPUTE)
#elif PROBE_DUP == 531
    for (int jj = 0; jj < ti + 1; ++jj) {
      if (SEL_NEED(jj)) { const char* kb = KVB + (jj & 1) * 2 * KV_TILE; const char* vbuf = kb + KV_TILE; SEL_COMPUTE(jj, kb, vbuf) }
      __syncthreads();
    }
#elif PROBE_DUP == 532
    for (int jj = 0; jj < ti + 1; ++jj) {
      uint4 ka_, va_;
      ka_ = va_ = make_uint4(0u, 0u, 0u, 0u);
      if (jj + 1 < ti + 1) { ka_ = *(const uint4*)(ksrc + (size_t)(jj + 1) * (64 * 128)); va_ = *(const uint4*)(vsrc + (size_t)(jj + 1) * 64); }
      if (jj + 1 < ti + 1) { char* d2 = sdst + ((jj + 1) & 1) * 2 * KV_TILE; *(uint4*)d2 = ka_; *(uint4*)(d2 + KV_TILE) = va_; }
      __syncthreads();
    }
#elif PROBE_DUP >= 533
#if PROBE_DUP == 534
#undef ATT_LSUM
#define ATT_LSUM(LACC, pv) LACC += pv[0];
#elif PROBE_DUP == 535
#undef ATT_EXP
#define ATT_EXP(x) (x)
#elif PROBE_DUP == 536
#undef ATT_EXP
#define ATT_EXP(x) (x)
#undef ATT_LSUM
#define ATT_LSUM(LACC, pv) LACC += pv[0];
#endif
    for (int jj = 0; jj < ti + 1; ++jj) {
      if (SEL_NEED(jj)) { const char* kb = KVB + (jj & 1) * 2 * KV_TILE; const char* vbuf = kb + KV_TILE; SEL_COMPUTE(jj, kb, vbuf) }
    }
    __syncthreads();
#endif
#undef ATT_EXP
#undef ATT_LSUM
#define ATT_EXP(x) ex2(x)
#define ATT_LSUM(LACC, pv) LACC += ((pv[0] + pv[1]) + (pv[2] + pv[3])) + ((pv[4] + pv[5]) + (pv[6] + pv[7])) + ((pv[8] + pv[9]) + (pv[10] + pv[11])) + ((pv[12] + pv[13]) + (pv[14] + pv[15]));
    float chk = lsel;
#pragma unroll
    for (int e = 0; e < 16; ++e) chk += osl[0][e] + osl[1][e];
    if (__float_as_uint(chk) == 0x7fc12345u) OUTL[tid] += 1.f;
  }
#endif
  f32x16 ow[2]; ow[0] = zero16(); ow[1] = zero16();
  float lw = 0.f;
  const float mbw = qn * kwm;
  {
    const int j0w = (ti >= 8) ? ti - 8 : 0, nwt = ti - j0w + 1;
    const bf16_t* kws = p.NKW + ((size_t)(b * SEQ + 64 * j0w) + srow) * 128 + g * 64 + sch * 8;
    const bf16_t* vws = p.NVWT + ((size_t)bg * 64 + srow) * SEQ + 64 * j0w + sch * 8;
    STAGE_PAIR0(kws, 64 * 128, vws, 64, nwt) __syncthreads();
#define WIN_NEED(jj) true
#define WIN_COMPUTE(jj, kb, vbuf) { const int jw_ = j0w + (jj); const bool last_ = (jw_ == ti), first_ = (ti >= 8) && ((jj) == 0); \
      ATT_TILE(kb, vbuf, -mbw, !(last_ || first_), last_ ? (key <= tkl) : (key > tkl), 1.f, ow, lw, IMP_NONE, jj) }
    RING_RUN(kws, 64 * 128, vws, 64, nwt, WIN_NEED, WIN_COMPUTE)
  }
  lw += __shfl_xor(lw, 32);
  {
    const float g2 = gt[2] / lw;
#pragma unroll
    for (int di = 0; di < 2; ++di)
#pragma unroll
      for (int g4 = 0; g4 < 4; ++g4) {
        const int d0 = 32 * di + 8 * g4 + 4 * h;
        float y[4];
#pragma unroll
        for (int e = 0; e < 4; ++e) y[e] = OUTL[(16 * di + 4 * g4 + e) * 512 + tid] + g2 * ow[di][4 * g4 + e];
        *(uint2*)(p.RA + (size_t)(tokg0 + tkl) * DM + 512 + hd * 64 + d0) = pack4(y[0], y[1], y[2], y[3]);
      }
  }
  __syncthreads();
}

typedef float f32x4 __attribute__((ext_vector_type(4)));
#define MFMA16(a, b, c) __builtin_amdgcn_mfma_f32_16x16x32_bf16((a), (b), (c), 0, 0, 0)
constexpr int pk_clen(int i) { return 16 / (i + 1); }
constexpr int pk_coff(int i) { int s = 0; for (int q = 0; q < i; ++q) s += pk_clen(q); return s; }
constexpr int pk_cand(int c) {
  int i = 0; while (i < 16 && c >= pk_clen(i)) { c -= pk_clen(i); ++i; }
  return (i < 16) ? i * 16 + c : 256;
}
#define SC_STRIDE 132

DI void convert_row(const Params& p, int row, int lane);
DI unsigned f2key(float x, unsigned tag, unsigned tagmask) {
  const unsigned bits = __float_as_uint(x), m = (unsigned)((int)bits >> 31) | 0x80000000u;
  return ((bits ^ m) & ~tagmask) | tag;
}
DI float key2f(unsigned k, unsigned tagmask) {
  const unsigned u = k & ~tagmask;
  return __uint_as_float((u & 0x80000000u) ? (u ^ 0x80000000u) : ~u);
}
DI void peer_topk_tile(const Params& p, int vb, char* smem) {
  unsigned* SC = (unsigned*)smem;
  unsigned* ELK = (unsigned*)(smem + 256 * SC_STRIDE * 4);
  float* ELW = (float*)(ELK + 16 * 128);
  int* CT = (int*)(ELW + 16 * 128);
  const int tid = mytid(), lane = tid & 63, w = tid >> 6;
  const int t0 = vb * 16;
  if (tid < 64) { int i = 0, c = tid; while (i < 16 && c >= 16 / (i + 1)) { c -= 16 / (i + 1); ++i; } CT[tid] = (i < 16) ? i * 16 + c : 0; }
  for (int rep91 = 0; rep91 < (PROBE_DUP == 91 ? 2 : 1); ++rep91) {
    const int tq = lane & 15, kq = lane >> 4;
#pragma unroll
    for (int pi = 0; pi < 2; ++pi) {
      const int ph = 2 * w + pi;
      bf16x8 bfr[4];
#pragma unroll
      for (int s = 0; s < 4; ++s) bfr[s] = *(const bf16x8*)(p.PQ + (size_t)(t0 + tq) * 2048 + ph * 128 + 32 * s + 8 * kq);
#pragma unroll
      for (int j = 0; j < 8; ++j) {
        f32x4 acc = {0.f, 0.f, 0.f, 0.f};
#pragma unroll
        for (int s = 0; s < 4; ++s) {
          bf16x8 afr = *(const bf16x8*)(p.SUBK + ((size_t)(ph * 128 + 16 * j + tq)) * 128 + 32 * s + 8 * kq);
          acc = MFMA16(afr, bfr[s], acc);
        }
        const int n0 = 16 * j + 4 * kq;
        uint4 kv4;
        kv4.x = f2key(acc[0], 127u - n0, 127u); kv4.y = f2key(acc[1], 126u - n0, 127u); kv4.z = f2key(acc[2], 125u - n0, 127u); kv4.w = f2key(acc[3], 124u - n0, 127u);
        *(uint4*)(SC + (ph * 16 + tq) * SC_STRIDE + n0) = kv4;
      }
    }
  }
  __syncthreads();
  if (tid < 256) {
    unsigned* row = SC + tid * SC_STRIDE;
    unsigned gmax[16];
#pragma unroll
    for (int g = 0; g < 16; ++g) {
      uint4 a = *(uint4*)(row + g * 8), b = *(uint4*)(row + g * 8 + 4);
      gmax[g] = max(max(max(a.x, a.y), max(a.z, a.w)), max(max(b.x, b.y), max(b.z, b.w)));
    }
    unsigned outk[16];
#pragma unroll
    for (int k = 0; k < 16; ++k) {
      unsigned m = max(max(max(max(gmax[0], gmax[1]), max(gmax[2], gmax[3])), max(max(gmax[4], gmax[5]), max(gmax[6], gmax[7]))),
                       max(max(max(gmax[8], gmax[9]), max(gmax[10], gmax[11])), max(max(gmax[12], gmax[13]), max(gmax[14], gmax[15]))));
      const int n = 127 - (int)(m & 127u), gi = n >> 3;
      unsigned* gp = row + gi * 8;
      uint4 a = *(uint4*)gp, b = *(uint4*)(gp + 4);
      const unsigned v[8] = {a.x, a.y, a.z, a.w, b.x, b.y, b.z, b.w};
      unsigned nm = 0u;
#pragma unroll
      for (int e = 0; e < 8; ++e) nm = max(nm, (v[e] == m) ? 0u : v[e]);
      row[n] = 0u;
#pragma unroll
      for (int g = 0; g < 16; ++g) gmax[g] = (g == gi) ? nm : gmax[g];
      outk[k] = m;
    }
#pragma unroll
    for (int k = 0; k < 16; ++k) row[k] = outk[k];
  } else {
#pragma unroll
    for (int i = 0; i < 4; ++i) convert_row(p, (vb * 4 + (w - 4)) * 8 + 2 * i, lane);
  }
  __syncthreads();
  for (int rep93 = 0; rep93 < (PROBE_DUP == 93 ? 2 : 1); ++rep93) {
    const int q = tid >> 2, sub = tid & 3, t = q >> 3, pp = q & 7;
    const unsigned* ra = SC + ((2 * pp) * 16 + t) * SC_STRIDE;
    const unsigned* rb = SC + ((2 * pp + 1) * 16 + t) * SC_STRIDE;
    unsigned ck[13];
#pragma unroll
    for (int k = 0; k < 13; ++k) {
      const int ij = (sub == 0) ? pk_cand(4 * k) : (sub == 1) ? pk_cand(4 * k + 1) : (sub == 2) ? pk_cand(4 * k + 2) : pk_cand(4 * k + 3);
      const int ord = 4 * k + sub;
      ck[k] = (ij < 256) ? f2key(key2f(ra[ij >> 4], 127u) + key2f(rb[ij & 15], 127u), (unsigned)(63 - ord), 63u) : 0u;
    }
    unsigned w16[16];
#pragma unroll
    for (int k = 0; k < 16; ++k) {
      unsigned bm = max(max(max(max(ck[0], ck[1]), max(ck[2], ck[3])), max(max(ck[4], ck[5]), max(ck[6], ck[7]))), max(max(max(ck[8], ck[9]), max(ck[10], ck[11])), ck[12]));
      bm = max(bm, (unsigned)__builtin_amdgcn_mov_dpp((int)bm, 0xB1, 0xf, 0xf, true));
      bm = max(bm, (unsigned)__builtin_amdgcn_mov_dpp((int)bm, 0x4E, 0xf, 0xf, true));
#pragma unroll
      for (int c = 0; c < 13; ++c) ck[c] = (ck[c] == bm) ? 0u : ck[c];
      w16[k] = bm;
    }
    float l = 0.f; const float vmax = key2f(w16[0], 63u);
    float ev[16];
#pragma unroll
    for (int k = 0; k < 16; ++k) { ev[k] = __expf(key2f(w16[k], 63u) - vmax); l += ev[k]; }
    const float inv = 1.f / l;
#pragma unroll
    for (int k = 0; k < 16; ++k)
      if ((k & 3) == sub) {
        const int ij = CT[63 - (int)(w16[k] & 63u)];
        const int code = (127 - (int)(ra[ij >> 4] & 127u)) * 128 + (127 - (int)(rb[ij & 15] & 127u));
        ELK[t * 128 + pp * 16 + k] = ((unsigned)code << 7) | (unsigned)(pp * 16 + k);
        ELW[t * 128 + pp * 16 + k] = ev[k] * inv;
      }
  }
  __syncthreads();
  for (int rep94 = 0; rep94 < (PROBE_DUP == 94 ? 2 : 1); ++rep94)
#pragma unroll
  for (int tt = 0; tt < 2; ++tt) {
    const int t = 2 * w + tt;
    const unsigned e0 = ELK[t * 128 + 2 * lane], e1 = ELK[t * 128 + 2 * lane + 1];
    int r0 = 0, r1 = 0;
#pragma unroll 8
    for (int c = 0; c < 32; ++c) {
      const uint4 kq = *(const uint4*)(ELK + t * 128 + 4 * c);
      r0 += (kq.x < e0) + (kq.y < e0) + (kq.z < e0) + (kq.w < e0);
      r1 += (kq.x < e1) + (kq.y < e1) + (kq.z < e1) + (kq.w < e1);
    }
    const size_t gb = (size_t)(t0 + t) * 128;
    p.EIDX[gb + r0] = (int)(e0 >> 7); p.EIDX[gb + r1] = (int)(e1 >> 7);
    p.EW[gb + r0] = ELW[t * 128 + (e0 & 127)]; p.EW[gb + r1] = ELW[t * 128 + (e1 & 127)];
  }
  __syncthreads();
}

DI float dot2bf(unsigned a, unsigned b, float acc) { return __builtin_amdgcn_fdot2_f32_bf16(__builtin_bit_cast(bf16x2_t, a), __builtin_bit_cast(bf16x2_t, b), acc, false); }
template <int CTRL> DI float dpp_f(float x) { return __builtin_bit_cast(float, __builtin_amdgcn_mov_dpp(__builtin_bit_cast(int, x), CTRL, 0xf, 0xf, true)); }
DI float row16_sum(float v) { v += dpp_f<0x128>(v); v += dpp_f<0x124>(v); v += dpp_f<0x122>(v); v += dpp_f<0x121>(v); return v; }
DI float dot_row(const uint4 (&u)[8], const uint4 (&h)[8]) {
  float d = 0.f;
#pragma unroll
  for (int j = 0; j < 8; ++j) { d = dot2bf(u[j].x, h[j].x, d); d = dot2bf(u[j].y, h[j].y, d); d = dot2bf(u[j].z, h[j].z, d); d = dot2bf(u[j].w, h[j].w, d); }
  return row16_sum(d);
}
DI void axpy_row(float (&acc)[64], const uint4 (&v)[8], float c) {
#pragma unroll
  for (int j = 0; j < 8; ++j) {
    const unsigned ww[4] = {v[j].x, v[j].y, v[j].z, v[j].w};
#pragma unroll
    for (int q = 0; q < 4; ++q) {
      acc[j * 8 + 2 * q] += c * __uint_as_float(ww[q] << 16);
      acc[j * 8 + 2 * q + 1] += c * __uint_as_float(ww[q] & 0xffff0000u);
    }
  }
}
DI void axpy_half(float (&acc)[32], const uint4 (&v)[4], float c) {
#pragma unroll
  for (int j = 0; j < 4; ++j) {
    const unsigned ww[4] = {v[j].x, v[j].y, v[j].z, v[j].w};
#pragma unroll
    for (int q = 0; q < 4; ++q) {
      acc[j * 8 + 2 * q] += c * __uint_as_float(ww[q] << 16);
      acc[j * 8 + 2 * q + 1] += c * __uint_as_float(ww[q] & 0xffff0000u);
    }
  }
}
#ifndef PEER_TILE_SHIFT
#define PEER_TILE_SHIFT 8
#endif
DI void fma16_fp8(float& d, const uint4& u, const float* hv) {
  const unsigned ww[4] = {u.x, u.y, u.z, u.w};
#pragma unroll
  for (int q = 0; q < 4; ++q) {
    f32x2_t a = __builtin_amdgcn_cvt_pk_f32_fp8((int)ww[q], false), b = __builtin_amdgcn_cvt_pk_f32_fp8((int)ww[q], true);
    d += a[0] * hv[4 * q] + a[1] * hv[4 * q + 1] + b[0] * hv[4 * q + 2] + b[1] * hv[4 * q + 3];
  }
}
DI float dot_row8(const uint4 (&u)[4], const float (&hv)[64]) {
  float d0 = 0.f, d1 = 0.f;
  fma16_fp8(d0, u[0], hv); fma16_fp8(d1, u[1], hv + 16); fma16_fp8(d0, u[2], hv + 32); fma16_fp8(d1, u[3], hv + 48);
  return row16_sum(d0 + d1);
}
DI void axpy_row8(float (&acc)[64], const uint4 (&v)[4], float c) {
#pragma unroll
  for (int j = 0; j < 4; ++j) {
    const unsigned ww[4] = {v[j].x, v[j].y, v[j].z, v[j].w};
#pragma unroll
    for (int q = 0; q < 4; ++q) {
      f32x2_t a = __builtin_amdgcn_cvt_pk_f32_fp8((int)ww[q], false), b = __builtin_amdgcn_cvt_pk_f32_fp8((int)ww[q], true);
      acc[j * 16 + 4 * q] += c * a[0]; acc[j * 16 + 4 * q + 1] += c * a[1]; acc[j * 16 + 4 * q + 2] += c * b[0]; acc[j * 16 + 4 * q + 3] += c * b[1];
    }
  }
}
typedef float f32x32_t __attribute__((ext_vector_type(32)));
typedef float f32x16_t __attribute__((ext_vector_type(16)));
typedef unsigned u32x6_t __attribute__((ext_vector_type(6)));
#define ROW6_BYTES 768
DI float dot_row6(const uint4 (&u)[3], const float (&hv)[64]) {
  u32x6_t pa, pb;
  pa[0] = u[0].x; pa[1] = u[0].y; pa[2] = u[0].z; pa[3] = u[0].w; pa[4] = u[1].x; pa[5] = u[1].y;
  pb[0] = u[1].z; pb[1] = u[1].w; pb[2] = u[2].x; pb[3] = u[2].y; pb[4] = u[2].z; pb[5] = u[2].w;
  float d0 = 0.f, d1 = 0.f;
  {
    const f32x32_t fa = __builtin_amdgcn_cvt_scalef32_pk32_f32_fp6(pa, 1.0f);
#pragma unroll
    for (int k = 0; k < 32; k += 2) { d0 += fa[k] * hv[k]; d1 += fa[k + 1] * hv[k + 1]; }
  }
  {
    const f32x32_t fb = __builtin_amdgcn_cvt_scalef32_pk32_f32_fp6(pb, 1.0f);
#pragma unroll
    for (int k = 0; k < 32; k += 2) { d0 += fb[k] * hv[32 + k]; d1 += fb[k + 1] * hv[32 + k + 1]; }
  }
  return row16_sum(d0 + d1);
}
DI void axpy_row6(float (&acc)[64], const uint4 (&v)[3], float c) {
  u32x6_t pa, pb;
  pa[0] = v[0].x; pa[1] = v[0].y; pa[2] = v[0].z; pa[3] = v[0].w; pa[4] = v[1].x; pa[5] = v[1].y;
  pb[0] = v[1].z; pb[1] = v[1].w; pb[2] = v[2].x; pb[3] = v[2].y; pb[4] = v[2].z; pb[5] = v[2].w;
  {
    const f32x32_t fa = __builtin_amdgcn_cvt_scalef32_pk32_f32_fp6(pa, 1.0f);
#pragma unroll
    for (int k = 0; k < 32; ++k) acc[k] += c * fa[k];
  }
  {
    const f32x32_t fb = __builtin_amdgcn_cvt_scalef32_pk32_f32_fp6(pb, 1.0f);
#pragma unroll
    for (int k = 0; k < 32; ++k) acc[32 + k] += c * fb[k];
  }
}
DI void peer_gather_block(const Params& p, int vb, char* smem) {
  unsigned* ELK = (unsigned*)smem;
  float* ELC = (float*)(smem + 32768);
  const int tid = mytid(), lane = tid & 63, w = tid >> 6, grp = lane >> 4, i = lane & 15;
  const int tokbase = vb * 64;
  for (int q = tid; q < 64 * 128 / 4; q += NT) {
    ((uint4*)ELK)[q] = ((const uint4*)(p.EIDX + (size_t)tokbase * 128))[q];
    ((float4*)ELC)[q] = ((const float4*)(p.EW + (size_t)tokbase * 128))[q];
  }
  __syncthreads();
#pragma unroll 1
  for (int tt = 0; tt < 2; ++tt) {
    const int tl = w * 8 + grp * 2 + tt, tok = tokbase + tl;
    const unsigned* kk = ELK + tl * 128;
    float* cc = ELC + tl * 128;
    uint4 b0[3], b1[3], b2[3], b3[3];
#define ROW_LOAD(BUF, BASE, E) { const unsigned e_ = kk[E]; _Pragma("unroll") for (int j = 0; j < 3; ++j) BUF[j] = *(const uint4*)(BASE + (size_t)e_ * ROW6_BYTES + j * 256); }
    {
      float hv[64];
#pragma unroll
      for (int j = 0; j < 4; ++j)
#pragma unroll
        for (int hf = 0; hf < 2; ++hf) {
          uint4 a = *(const uint4*)(p.RA + (size_t)tok * DM + j * 256 + i * 16 + hf * 8);
          const unsigned aa[4] = {a.x, a.y, a.z, a.w};
#pragma unroll
          for (int q = 0; q < 4; ++q) { hv[j * 16 + hf * 8 + 2 * q] = __uint_as_float(aa[q] << 16); hv[j * 16 + hf * 8 + 2 * q + 1] = __uint_as_float(aa[q] & 0xffff0000u); }
        }
      const unsigned char* ub_ = p.PDN8 + i * 16;
#define DN_COMP(BUF, E) { const unsigned e_ = kk[E]; float d_ = dot_row6(BUF, hv) * p.SDN[e_]; float c_ = cc[E] * gelu_tanh(d_) * p.SUP[e_]; if (i == 0) cc[E] = c_; }
      ROW_LOAD(b0, ub_, 0) ROW_LOAD(b1, ub_, 1) ROW_LOAD(b2, ub_, 2) ROW_LOAD(b3, ub_, 3)
      for (int e = 0; e < 128; e += 4) {
        DN_COMP(b0, e)     if (e + 4 < 128) ROW_LOAD(b0, ub_, e + 4)
        DN_COMP(b1, e + 1) if (e + 4 < 128) ROW_LOAD(b1, ub_, e + 5)
        DN_COMP(b2, e + 2) if (e + 4 < 128) ROW_LOAD(b2, ub_, e + 6)
        DN_COMP(b3, e + 3) if (e + 4 < 128) ROW_LOAD(b3, ub_, e + 7)
      }
#undef DN_COMP
    }
    {
      float acc[64];
#pragma unroll
      for (int e = 0; e < 64; ++e) acc[e] = 0.f;
      const unsigned char* vbase = p.PUP8 + i * 16;
      ROW_LOAD(b0, vbase, 0) ROW_LOAD(b1, vbase, 1) ROW_LOAD(b2, vbase, 2) ROW_LOAD(b3, vbase, 3)
      for (int e = 0; e < 128; e += 4) {
        axpy_row6(acc, b0, cc[e]);     if (e + 4 < 128) ROW_LOAD(b0, vbase, e + 4)
        axpy_row6(acc, b1, cc[e + 1]); if (e + 4 < 128) ROW_LOAD(b1, vbase, e + 5)
        axpy_row6(acc, b2, cc[e + 2]); if (e + 4 < 128) ROW_LOAD(b2, vbase, e + 6)
        axpy_row6(acc, b3, cc[e + 3]); if (e + 4 < 128) ROW_LOAD(b3, vbase, e + 7)
      }
      const int b = tok >> 13;
      const float* ga2 = p.mod + b * 6144 + 5120;
      const float* orow = p.out + (size_t)tok * DM; float* grow = p.gout + (size_t)tok * DM;
      float ss = 0.f;
#pragma unroll
      for (int j = 0; j < 4; ++j)
#pragma unroll
        for (int q4 = 0; q4 < 4; ++q4) {
          const int col = j * 256 + i * 16 + q4 * 4;
          float4 x1 = *(const float4*)(orow + col), gg = *(const float4*)(ga2 + col);
          float* q = acc + j * 16 + q4 * 4;
          q[0] = x1.x + gg.x * q[0]; q[1] = x1.y + gg.y * q[1]; q[2] = x1.z + gg.z * q[2]; q[3] = x1.w + gg.w * q[3];
          ss += q[0] * q[0] + q[1] * q[1] + q[2] * q[2] + q[3] * q[3];
        }
      ss = row16_sum(ss);
      const float rstd = rsqrtf(ss * (1.f / DM) + 1e-6f);
#pragma unroll
      for (int j = 0; j < 4; ++j)
#pragma unroll
        for (int q4 = 0; q4 < 4; ++q4) {
          const int col = j * 256 + i * 16 + q4 * 4;
          float4 gf = *(const float4*)(p.g_final + col);
          const float* q = acc + j * 16 + q4 * 4;
          *(float4*)(grow + col) = make_float4(q[0] * rstd * gf.x, q[1] * rstd * gf.y, q[2] * rstd * gf.z, q[3] * rstd * gf.w);
        }
    }
#undef ROW_LOAD
  }
  __syncthreads();
}
DI void convert_row(const Params& p, int row2, int lane) {
  const int row = row2 + (lane >> 5), L = lane & 31, i = L >> 1, gsel = L & 1;
  const int tb = row >> 14, rr = row & 16383;
  const float* src = (tb ? p.peer_up : p.peer_down) + (size_t)rr * DM + gsel * 512 + i * 16;
  float4 xa[4], xb[4]; float am = 0.f;
#pragma unroll
  for (int q = 0; q < 4; ++q) {
    xa[q] = *(const float4*)(src + q * 4); xb[q] = *(const float4*)(src + 256 + q * 4);
    am = fmaxf(am, fmaxf(fmaxf(fabsf(xa[q].x), fabsf(xa[q].y)), fmaxf(fabsf(xa[q].z), fabsf(xa[q].w))));
    am = fmaxf(am, fmaxf(fmaxf(fabsf(xb[q].x), fabsf(xb[q].y)), fmaxf(fabsf(xb[q].z), fabsf(xb[q].w))));
  }
  for (int o = 16; o; o >>= 1) am = fmaxf(am, __shfl_xor(am, o));
  const float sc = (am > 0.f) ? am * (1.f / 7.5f) : 1.f, inv = (am > 0.f) ? 7.5f / am : 1.f;
  f32x16_t va, vb;
  {
    float X[32];
#pragma unroll
    for (int q = 0; q < 4; ++q) {
      X[4 * q] = xa[q].x * inv; X[4 * q + 1] = xa[q].y * inv; X[4 * q + 2] = xa[q].z * inv; X[4 * q + 3] = xa[q].w * inv;
      X[16 + 4 * q] = xb[q].x * inv; X[16 + 4 * q + 1] = xb[q].y * inv; X[16 + 4 * q + 2] = xb[q].z * inv; X[16 + 4 * q + 3] = xb[q].w * inv;
    }
#pragma unroll
    for (int k = 0; k < 16; ++k) { va[k] = X[2 * k]; vb[k] = X[2 * k + 1]; }
  }
  const u32x6_t pk = __builtin_amdgcn_cvt_scalef32_2xpk16_fp6_f32(va, vb, 1.0f);
  unsigned char* dst = (tb ? p.PUP8 : p.PDN8) + (size_t)rr * ROW6_BYTES + i * 16;
#pragma unroll
  for (int d = 0; d < 6; ++d) { const int dd = 6 * gsel + d; *(unsigned*)(dst + (dd >> 2) * 256 + (dd & 3) * 4) = pk[d]; }
  if (L == 0) (tb ? p.SUP : p.SDN)[rr] = sc;
}

#define N_PHASES 11
template <int PH>
DI void run_phase(const Params& p, char* smem) {
  const int nb = gridDim.x, bid = blockIdx.x, tid = mytid();
  if (PH == 0) {
    for (int vb = bid; vb < PH0_MOD; vb += nb) ph0_body(p, vb, smem);
  } else if (PH == 1) {
    constexpr int kPrepA = (PH0_WIN - PH0_MOD) + (PH0_ROPE - PH0_SUBK);
    for (int vb = bid; vb < T_TOK / 8 + kPrepA; vb += nb) {
      if (vb < T_TOK / 8) rownorm_body(p.x, p.g_mix, p.mod, 0, 1024, p.RA, vb);
      else { const int j = vb - T_TOK / 8; ph0_body(p, (j < PH0_WIN - PH0_MOD) ? PH0_MOD + j : PH0_SUBK + (j - (PH0_WIN - PH0_MOD)), smem); }
    }
  } else if (PH == 2) {
    {
      pg8::StaticOrder S; S.init(T_TOK, NPROJ, nb, bid);
      const pg8::Gemm g{p.RA, p.WinT, T_TOK, NPROJ, 1024};
      pg8::gemm_phase((PG8_LAS unsigned char*)smem, g, S, EpiProj8{p});
    }
    {
      constexpr int kPrepB = (PH0_W2V - PH0_WQ) + (PH0_B1P - PH0_ROPE);
      const int rem = (64 * 14) % nb;
      if (rem == 0 || bid >= rem) {
        for (int j = (rem == 0) ? bid : bid - rem; j < kPrepB; j += (rem == 0) ? nb : nb - rem)
          ph0_body(p, (j < PH0_W2V - PH0_WQ) ? PH0_WQ + j : PH0_ROPE + (j - (PH0_W2V - PH0_WQ)), smem);
      }
    }
  } else if (PH == 3) {
    for (int vb = bid; vb < 256 + 512 + 64; vb += nb) {
      if (vb < 256) compress_mfma(p, vb, smem);
      else if (vb < 256 + 512) retkv_mfma(p, vb - 256);
      else kmax_body2(p, vb - 768);
    }
  } else if (PH == 4) {
    constexpr int kPrepC = (PH0_WQ - PH0_WIN) + (PH0_SUBK - PH0_W2V);
    for (int vb = bid; vb < 256 + 4 + kPrepC; vb += nb) {
      if (vb < 256) scan_body(p, vb * NT + tid);
      else if (vb < 260) kcmax_body(p, (vb - 256) * NT + tid);
      else { const int j = vb - 260; ph0_body(p, (j < PH0_WQ - PH0_WIN) ? PH0_WIN + j : PH0_W2V + (j - (PH0_WQ - PH0_WIN)), smem); }
    }
  } else if (PH == 5) {
    for (int rep = 0; rep < (PROBE_DUP == 51 ? 2 : 1); ++rep)
      for (int vb = bid; vb < 256; vb += nb) retout_mfma(p, vb * 8 + (tid >> 6));
    for (int rep = 0; rep < (PROBE_DUP == 52 ? 2 : 1); ++rep)
      for (int vb = bid; vb < 512; vb += nb) nsa_item(p, (vb < 256) ? vb : 767 - vb, smem);
  } else if (PH == 6) {
    pg8::StaticOrder S; S.init(T_TOK, 1024, nb, bid);
    const pg8::Gemm g{p.RA, p.WoutT, T_TOK, 1024, 1024};
    pg8::gemm_phase((PG8_LAS unsigned char*)smem, g, S, EpiOut8{p.x, p.out, p.mod});
  } else if (PH == 7) {
    for (int vb = bid; vb < T_TOK / 8; vb += nb) rownorm_body(p.out, p.g_ffn, p.mod, 3072, 4096, p.RA, vb);
  } else if (PH == 8) {
    pg8::StaticOrder S; S.init(T_TOK, 2048, nb, bid);
    const pg8::Gemm g{p.RA, p.WqT, T_TOK, 2048, 1024};
    pg8::gemm_phase((PG8_LAS unsigned char*)smem, g, S, EpiPQ8{p.PQ});
  } else if (PH == 9) {
    for (int vb = bid; vb < T_TOK / 16; vb += nb) peer_topk_tile(p, vb, smem);
  } else if (PH == 10) {
    for (int vb = bid; vb < T_TOK / 64; vb += nb) peer_gather_block(p, vb, smem);
  }
}


#define XB_TMO      128
#define XB_XCNT(j)  (256  + 64 * (j))
#define XB_XSUB(j)  (1280 + 64 * (j))
#define XB_XGEN(j)  (2304 + 64 * (j))
#define XB_TOP      3328
#define XB_TOPGEN   3392
#define XCD_BAR_WORDS 3456
#define XB_SPIN_CAP (1u << 22)
#define LAS __attribute__((address_space(3)))
DI unsigned xb_ld(unsigned* p) { return __hip_atomic_load(p, __ATOMIC_RELAXED, __HIP_MEMORY_SCOPE_AGENT); }
DI unsigned xb_add(unsigned* p, unsigned v) { return __hip_atomic_fetch_add(p, v, __ATOMIC_RELAXED, __HIP_MEMORY_SCOPE_AGENT); }
DI unsigned xb_xcc_id() { return (unsigned)__builtin_amdgcn_s_getreg((3 << 11) | 20) & 0xFu; }
#define XB_SPIN(cond, bar) do { unsigned _sp = 0; while (cond) { __builtin_amdgcn_s_sleep(1); \
    if ((++_sp & 255u) == 0u) { if (xb_ld(&(bar)[XB_TMO])) break; if (_sp > XB_SPIN_CAP) { atomicAdd(&(bar)[XB_TMO], 1u); break; } } } } while (0)
struct XcdBarrier { unsigned* bar; unsigned x; volatile LAS unsigned* st; };
DI XcdBarrier xcd_barrier_post(unsigned* bar, volatile LAS unsigned* st) {
  XcdBarrier b; b.bar = bar; b.x = xb_xcc_id(); b.st = st;
  if (threadIdx.x == 0) (void)xb_add(&bar[XB_XCNT(b.x)], 1u);
  return b;
}
DI void xcd_barrier_complete(unsigned* bar, unsigned x, unsigned& nloc, unsigned& nx) {
  const unsigned G = gridDim.x * gridDim.y * gridDim.z;
  unsigned sum, cnt, mine, sp = 0u;
  for (;;) {
    sum = 0u; cnt = 0u; mine = 0u;
#pragma unroll
    for (unsigned j = 0; j < 16; ++j) { const unsigned c = xb_ld(&bar[XB_XCNT(j)]); sum += c; cnt += (c > 0u) ? 1u : 0u; mine = (j == x) ? c : mine; }
    if (sum == G) break;
    __builtin_amdgcn_s_sleep(1);
    if ((++sp & 255u) == 0u) { if (xb_ld(&bar[XB_TMO])) break; if (sp > XB_SPIN_CAP) { atomicAdd(&bar[XB_TMO], 1u); break; } }
  }
  nloc = mine > 0u ? mine : 1u; nx = cnt > 0u ? cnt : 1u;
}
DI void xcd_barrier(const XcdBarrier& b) {
  asm volatile("s_waitcnt vmcnt(0)" ::: "memory");
  __syncthreads();
  if (threadIdx.x == 0) {
    unsigned* bar = b.bar;
    __builtin_amdgcn_s_waitcnt(0);
    unsigned nloc = b.st[0], nx = b.st[1];
    if (nloc == 0u) { xcd_barrier_complete(bar, b.x, nloc, nx); b.st[0] = nloc; b.st[1] = nx; }
    const unsigned old = xb_add(&bar[XB_XSUB(b.x)], 1u);
    const unsigned gen = old / nloc;
    if (old + 1u == (gen + 1u) * nloc) {
      __builtin_amdgcn_fence(__ATOMIC_RELEASE, "agent");
      asm volatile("s_waitcnt vmcnt(0)" ::: "memory");
      const unsigned og = xb_add(&bar[XB_TOP], 1u);
      const unsigned tg = og / nx;
      if (og + 1u == (tg + 1u) * nx) xb_add(&bar[XB_TOPGEN], 1u);
      else XB_SPIN(xb_ld(&bar[XB_TOPGEN]) == tg, bar);
      __builtin_amdgcn_fence(__ATOMIC_ACQUIRE, "agent");
      xb_add(&bar[XB_XGEN(b.x)], 1u);
      asm volatile("s_waitcnt vmcnt(0)" ::: "memory");
    } else {
      XB_SPIN(xb_ld(&bar[XB_XGEN(b.x)]) == gen, bar);
      __builtin_amdgcn_fence(__ATOMIC_ACQUIRE, "agent");
      asm volatile("s_waitcnt vmcnt(0)" ::: "memory");
    }
  }
  __syncthreads();
}

#define SMEM_BYTES 155648

template <int PH>
DI void phase_and_probe(const Params& p, char* smem, cg::grid_group& grid) {
  const int reps = (PROBE_DUP == PH) ? 2 : 1;
  for (int rep = 0; rep < reps; ++rep) {
    if (PH == 10 && rep + 1 < reps) { Params q = p; q.gout = (float*)p.PQ; run_phase<PH>(q, smem); }
    else run_phase<PH>(p, smem);
    if (rep + 1 < reps) grid.sync();
  }
}
__global__ void __launch_bounds__(NT) k_mega(Params p) {
  extern __shared__ __attribute__((aligned(16))) char smem[];
  __shared__ uint4 xb_words;
  cg::grid_group grid = cg::this_grid();
  if (threadIdx.x == 0) xb_words = make_uint4(0u, 0u, 0u, 0u);
  __syncthreads();
  XcdBarrier xb = xcd_barrier_post(p.xbar, (volatile LAS unsigned*)&xb_words);
  phase_and_probe<0>(p, smem, grid); grid.sync();
  phase_and_probe<1>(p, smem, grid); xcd_barrier(xb);
  phase_and_probe<2>(p, smem, grid); xcd_barrier(xb);
  phase_and_probe<3>(p, smem, grid); xcd_barrier(xb);
  phase_and_probe<4>(p, smem, grid); xcd_barrier(xb);
  phase_and_probe<5>(p, smem, grid); xcd_barrier(xb);
  phase_and_probe<6>(p, smem, grid); xcd_barrier(xb);
  phase_and_probe<7>(p, smem, grid); xcd_barrier(xb);
  phase_and_probe<8>(p, smem, grid); xcd_barrier(xb);
  phase_and_probe<9>(p, smem, grid); xcd_barrier(xb);
  phase_and_probe<10>(p, smem, grid);
}
#ifdef MK_MULTI
template <int PH>
__global__ void __launch_bounds__(NT) k_single(Params p) {
  extern __shared__ __attribute__((aligned(16))) char smem[];
  run_phase<PH>(p, smem);
}
#endif

static size_t carve(size_t& off, size_t bytes) { size_t o = off; off += (bytes + 255) & ~(size_t)255; return o; }

extern "C" void kernel_launch(void* const* d_in, const int* in_sizes, int n_in, void* d_out, int out_size, void* d_ws, size_t ws_size,
                              hipStream_t stream) {
  Params p{};
  p.x = (const float*)d_in[0]; p.c = (const float*)d_in[1]; p.w_ada = (const float*)d_in[2]; p.b_ada = (const float*)d_in[3];
  p.g_mix = (const float*)d_in[4]; p.w_in = (const float*)d_in[5]; p.pe_k = (const float*)d_in[6]; p.pe_v = (const float*)d_in[7];
  p.w_k1 = (const float*)d_in[8]; p.b_k1 = (const float*)d_in[9]; p.w_k2 = (const float*)d_in[10]; p.w_v1 = (const float*)d_in[11];
  p.b_v1 = (const float*)d_in[12]; p.w_v2 = (const float*)d_in[13]; p.w_out = (const float*)d_in[14]; p.g_ffn = (const float*)d_in[15];
  p.w_pq = (const float*)d_in[16]; p.subkeys = (const float*)d_in[17]; p.peer_down = (const float*)d_in[18]; p.peer_up = (const float*)d_in[19];
  p.g_final = (const float*)d_in[20];
  p.out = (float*)d_out; p.gout = p.out;
  char* ws = (char*)d_ws;
  size_t off = 0;
  p.mod = (float*)(ws + carve(off, 2 * 6144 * 4));
  p.ksmax = (unsigned*)(ws + carve(off, 256));
  p.xbar = (unsigned*)(ws + carve(off, XCD_BAR_WORDS * 4));
  p.c128 = (float*)(ws + carve(off, (size_t)SEQ * 64 * 4)); p.s128 = (float*)(ws + carve(off, (size_t)SEQ * 64 * 4));
  p.c64 = (float*)(ws + carve(off, (size_t)SEQ * 32 * 4)); p.s64 = (float*)(ws + carve(off, (size_t)SEQ * 32 * 4));
  p.WinT = (bf16_t*)(ws + carve(off, (size_t)NPROJ * 1024 * 2));
  p.WoutT = (bf16_t*)(ws + carve(off, (size_t)1024 * 1024 * 2));
  p.WqT = (bf16_t*)(ws + carve(off, (size_t)2048 * 1024 * 2));
  p.W1Tk = (bf16_t*)(ws + carve(off, (size_t)256 * 2048 * 2)); p.W1Tv = (bf16_t*)(ws + carve(off, (size_t)256 * 2048 * 2));
  p.W2Tk = (bf16_t*)(ws + carve(off, 64 * 256 * 2)); p.W2Tv = (bf16_t*)(ws + carve(off, 64 * 256 * 2));
  p.SUBK = (bf16_t*)(ws + carve(off, (size_t)16 * 128 * 128 * 2));
  p.B1Pk = (float*)(ws + carve(off, 1024)); p.B1Pv = (float*)(ws + carve(off, 1024));
  p.RA = (bf16_t*)(ws + carve(off, (size_t)T_TOK * 1024 * 2));
  size_t rb = off;
  p.RQ = (bf16_t*)(ws + carve(off, (size_t)T_TOK * 512 * 2)); p.RK = (bf16_t*)(ws + carve(off, (size_t)T_TOK * 512 * 2));
  p.RKT = (bf16_t*)(ws + carve(off, (size_t)T_TOK * 512 * 2)); p.RVT = (bf16_t*)(ws + carve(off, (size_t)T_TOK * 512 * 2));
  p.RGT = (bf16_t*)(ws + carve(off, (size_t)T_TOK * 512 * 2)); p.NQ = (bf16_t*)(ws + carve(off, (size_t)T_TOK * 512 * 2));
  p.NKC = (bf16_t*)(ws + carve(off, (size_t)T_TOK * 128 * 2)); p.NVC = (bf16_t*)(ws + carve(off, (size_t)T_TOK * 128 * 2));
  p.NKS = (bf16_t*)(ws + carve(off, (size_t)T_TOK * 128 * 2)); p.NKW = (bf16_t*)(ws + carve(off, (size_t)T_TOK * 128 * 2));
  p.NVST = (bf16_t*)(ws + carve(off, (size_t)T_TOK * 128 * 2)); p.NVWT = (bf16_t*)(ws + carve(off, (size_t)T_TOK * 128 * 2));
  p.GATE = (float*)(ws + carve(off, (size_t)T_TOK * 24 * 4));
  p.KV = (float*)(ws + carve(off, (size_t)512 * 16384 * 4));
  p.SPREV = (bf16_t*)(ws + carve(off, (size_t)512 * 16384 * 2));
  p.KC = (bf16_t*)(ws + carve(off, (size_t)4 * 512 * 64 * 2)); p.VCT = (bf16_t*)(ws + carve(off, (size_t)4 * 512 * 64 * 2));
  p.HID = (float*)(ws + carve(off, (size_t)2 * 2048 * 256 * 4));
  size_t off2 = rb;
  p.PQ = (bf16_t*)(ws + carve(off2, (size_t)T_TOK * 2048 * 2));
  p.EIDX = (int*)(ws + carve(off2, (size_t)T_TOK * 128 * 4));
  p.EW = (float*)(ws + carve(off2, (size_t)T_TOK * 128 * 4));
  p.PDN8 = (unsigned char*)(ws + carve(off2, (size_t)16384 * 1024));
  p.PUP8 = (unsigned char*)(ws + carve(off2, (size_t)16384 * 1024));
  p.SDN = (float*)(ws + carve(off2, 16384 * 4));
  p.SUP = (float*)(ws + carve(off2, 16384 * 4));
  (void)ws_size; (void)in_sizes; (void)n_in; (void)out_size;

#ifdef MK_MULTI
#define LAUNCH1(PH) { hipFuncSetAttribute((const void*)k_single<PH>, hipFuncAttributeMaxDynamicSharedMemorySize, SMEM_BYTES); k_single<PH><<<256, NT, SMEM_BYTES, stream>>>(p); }
  LAUNCH1(0) LAUNCH1(1) LAUNCH1(2) LAUNCH1(3) LAUNCH1(4) LAUNCH1(5) LAUNCH1(6) LAUNCH1(7) LAUNCH1(8) LAUNCH1(9) LAUNCH1(10)
#else
  static int grid_blocks = 0;
  if (!grid_blocks) {
    int dev = 0, cus = 0, per_cu = 0;
    (void)hipGetDevice(&dev);
    (void)hipDeviceGetAttribute(&cus, hipDeviceAttributeMultiprocessorCount, dev);
    (void)hipFuncSetAttribute((const void*)k_mega, hipFuncAttributeMaxDynamicSharedMemorySize, SMEM_BYTES);
    (void)hipOccupancyMaxActiveBlocksPerMultiprocessor(&per_cu, k_mega, NT, SMEM_BYTES);
    if (per_cu < 1) per_cu = 1;
    if (per_cu > 1) per_cu = 1;
    grid_blocks = cus * per_cu;
  }
  (void)hipMemsetAsync(p.xbar, 0, XCD_BAR_WORDS * 4, stream);
  void* args[] = {&p};
  hipError_t e = hipLaunchCooperativeKernel((void*)k_mega, dim3(grid_blocks), dim3(NT), args, SMEM_BYTES, stream);
  if (e != hipSuccess) fprintf(stderr, "cooperative launch failed: %s (grid %d)\n", hipGetErrorString(e), grid_blocks);
#endif
}
```

```cpp
#include <hip/hip_runtime.h>
#include <hip/hip_bf16.h>
#include <hip/hip_cooperative_groups.h>
#include <stdint.h>
#include <stdio.h>
namespace cg = cooperative_groups;

typedef unsigned short bf16_t;
#define DI __device__ __forceinline__

DI int mytid() { int t = threadIdx.x; asm volatile("" : "+v"(t)); return t; }
DI float bf2f(bf16_t v) { return __uint_as_float(((unsigned)v) << 16); }
DI bf16_t f2bf(float x) { unsigned u = __float_as_uint(x); u += 0x7fffu + ((u >> 16) & 1u); return (bf16_t)(u >> 16); }
DI float gelu_tanh(float x) { float u = 0.7978845608028654f * (x + 0.044715f * x * x * x); return 0.5f * x * (1.f + tanhf(u)); }
DI float siluf(float x) { return x / (1.f + __expf(-x)); }
DI float sigmoidf(float x) { return 1.f / (1.f + __expf(-x)); }

#define T_TOK 16384
#define SEQ 8192
#define DM 1024
#define NPROJ 3584
#define NEG_INF (-__builtin_inff())

struct Params {
  const float *x, *c, *w_ada, *b_ada, *g_mix, *w_in, *pe_k, *pe_v, *w_k1, *b_k1, *w_k2, *w_v1, *b_v1, *w_v2, *w_out, *g_ffn,
      *w_pq, *subkeys, *peer_down, *peer_up, *g_final;
  float* out;
  float* gout;
  float* mod;
  unsigned* ksmax;
  unsigned* xbar;
  float *c128, *s128, *c64, *s64;
  bf16_t *WinT, *WoutT, *WqT, *W1Tk, *W1Tv, *W2Tk, *W2Tv, *SUBK;
  float *B1Pk, *B1Pv;
  bf16_t* RA;
  bf16_t *RQ, *RK, *RKT, *RVT, *RGT, *NQ, *NKC, *NVC, *NKS, *NKW, *NVST, *NVWT;
  float* GATE;
  float* KV;
  bf16_t* SPREV;
  bf16_t *KC, *VCT;
  float* HID;
  bf16_t* PQ;
  int* EIDX;
  float* EW;
  unsigned char *PDN8, *PUP8;
  float *SDN, *SUP;
};

DI float logg_h(int h) { return log1pf(-exp2f(-5.f - (float)h)); }


typedef __bf16 bf16x2_t __attribute__((ext_vector_type(2)));
typedef float f32x2_t __attribute__((ext_vector_type(2)));
DI unsigned cvt2(float a, float b) { f32x2_t v = {a, b}; bf16x2_t r = __builtin_convertvector(v, bf16x2_t); return __builtin_bit_cast(unsigned, r); }
DI uint2 pack4(float a, float b, float c, float d) { uint2 r; r.x = cvt2(a, b); r.y = cvt2(c, d); return r; }
#define NT 512
#ifndef PROBE_DUP
#define PROBE_DUP -1
#endif
typedef short bf16x8 __attribute__((ext_vector_type(8)));
typedef float f32x16 __attribute__((ext_vector_type(16)));
#define MFMA32(a, b, c) __builtin_amdgcn_mfma_f32_32x32x16_bf16((a), (b), (c), 0, 0, 0)
DI f32x16 zero16() { f32x16 z; for (int e = 0; e < 16; ++e) z[e] = 0.f; return z; }
DI f32x16 fill16(float v) { f32x16 z; for (int e = 0; e < 16; ++e) z[e] = v; return z; }
DI float ex2(float x) { return __builtin_amdgcn_exp2f(x); }

DI int win_logical_col(int np) {
  const int tile = np >> 8, p = np & 255, half = p >> 7, q = p & 127;
  if (tile < 4) { const int head = 2 * (tile & 1) + (q >> 6), i = q & 63; return (tile >> 1) * 512 + head * 128 + (half ? 64 + i : i); }
  if (tile < 8) return 1024 + (tile - 4) * 256 + p;
  if (tile < 10) { const int head = 4 * (tile - 8) + (q >> 5), i = q & 31; return 2048 + head * 64 + (half ? 32 + i : i); }
  if (tile == 10) { const int blk = q >> 5, i = q & 31; return (blk < 2 ? 2560 + blk * 64 : 2816 + (blk - 2) * 64) + (half ? 32 + i : i); }
  if (tile == 11) { const int blk = q >> 5, i = q & 31; return (blk < 2) ? 3072 + blk * 64 + (half ? 32 + i : i) : 2688 + (half ? 64 : 0) + 32 * (blk - 2) + i; }
  if (tile == 12) return (half ? 3200 : 2944) + q;
  if (tile == 13) return (half == 0 && q < 24) ? 3328 + q : -1;
  return -1;
}

DI void tr_tile(const float* __restrict__ in, bf16_t* __restrict__ out, int K, int N_in, int k0, int n0, int mode, float* tile) {
  const int tid = mytid();
  {
    int nn = tid & 63, col = mode ? win_logical_col(n0 + nn) : (n0 + nn);
#pragma unroll
    for (int i = 0; i < 8; ++i) {
      int kk = (tid >> 6) + 8 * i;
      tile[kk * 65 + nn] = (col >= 0) ? in[(size_t)(k0 + kk) * N_in + col] : 0.f;
    }
  }
  __syncthreads();
  {
    int kk = tid & 63;
#pragma unroll
    for (int i = 0; i < 8; ++i) {
      int nn = (tid >> 6) + 8 * i;
      out[(size_t)(n0 + nn) * K + k0 + kk] = f2bf(tile[kk * 65 + nn]);
    }
  }
  __syncthreads();
}

#define PH0_MOD 96
#define PH0_WIN (PH0_MOD + 16 * 56)
#define PH0_WOUT (PH0_WIN + 256)
#define PH0_WQ (PH0_WOUT + 512)
#define PH0_W1K (PH0_WQ + 128)
#define PH0_W1V (PH0_W1K + 128)
#define PH0_W2K (PH0_W1V + 4)
#define PH0_W2V (PH0_W2K + 4)
#define PH0_SUBK (PH0_W2V + 512)
#define PH0_ROPE (PH0_SUBK + 1024)
#define PH0_B1P (PH0_ROPE + 8)
#define PH0_NVB PH0_B1P

DI void ph0_body(const Params& p, int vb, char* smem) {
  const int tid = mytid();
  float* fs = (float*)smem;
  if (vb < PH0_MOD) {
    int kg = tid >> 6, col = vb * 64 + (tid & 63);
    float a0 = 0.f, a1 = 0.f;
#pragma unroll 8
    for (int k = kg * 128; k < kg * 128 + 128; ++k) {
      float w = p.w_ada[(size_t)k * 6144 + col];
      a0 += siluf(p.c[k]) * w; a1 += siluf(p.c[DM + k]) * w;
    }
    fs[kg * 64 + (tid & 63)] = a0; fs[512 + kg * 64 + (tid & 63)] = a1;
    __syncthreads();
    if (tid < 128) {
      int b = tid >> 6, cc = tid & 63; float s = 0.f;
      for (int g = 0; g < 8; ++g) s += fs[b * 512 + g * 64 + cc];
      p.mod[b * 6144 + vb * 64 + cc] = s + p.b_ada[vb * 64 + cc];
    }
    __syncthreads();
    if (vb == 0 && tid < 12) p.ksmax[tid] = 0u;
  } else if (vb < PH0_WIN) { int t = vb - PH0_MOD; tr_tile(p.w_in, p.WinT, 1024, 3352, (t & 15) * 64, (t >> 4) * 64, 1, fs); }
  else if (vb < PH0_WOUT) { int t = vb - PH0_WIN; tr_tile(p.w_out, p.WoutT, 1024, 1024, (t & 15) * 64, (t >> 4) * 64, 0, fs); }
  else if (vb < PH0_WQ) { int t = vb - PH0_WOUT; tr_tile(p.w_pq, p.WqT, 1024, 2048, (t & 15) * 64, (t >> 4) * 64, 0, fs); }
  else if (vb < PH0_W1K) { int t = vb - PH0_WQ; tr_tile(p.w_k1, p.W1Tk, 2048, 256, (t & 31) * 64, (t >> 5) * 64, 0, fs); }
  else if (vb < PH0_W1V) { int t = vb - PH0_W1K; tr_tile(p.w_v1, p.W1Tv, 2048, 256, (t & 31) * 64, (t >> 5) * 64, 0, fs); }
  else if (vb < PH0_W2K) { int t = vb - PH0_W1V; tr_tile(p.w_k2, p.W2Tk, 256, 64, t * 64, 0, 0, fs); }
  else if (vb < PH0_W2V) { int t = vb - PH0_W2K; tr_tile(p.w_v2, p.W2Tv, 256, 64, t * 64, 0, 0, fs); }
  else if (vb < PH0_SUBK) { int i = (vb - PH0_W2V) * NT + tid; p.SUBK[i] = f2bf(p.subkeys[i]); }
  else if (vb < PH0_ROPE) {
    int idx = (vb - PH0_SUBK) * NT + tid;
    { int s = idx >> 6, i = idx & 63; float inv = powf(10000.f, -(float)(2 * i) / 128.f); float ang = (float)s * inv; p.c128[idx] = cosf(ang); p.s128[idx] = sinf(ang); }
    if (idx < SEQ * 32) { int s = idx >> 5, i = idx & 31; float inv = powf(10000.f, -(float)(2 * i) / 64.f); float ang = (float)s * inv; p.c64[idx] = cosf(ang); p.s64[idx] = sinf(ang); }
  } else {
    int t = vb - PH0_ROPE, kv = t >> 2, jb = t & 3;
    const float* w1 = kv ? p.w_v1 : p.w_k1; const float* pe = kv ? p.pe_v : p.pe_k; const float* b1 = kv ? p.b_v1 : p.b_k1;
    int fg = tid >> 6, j = jb * 64 + (tid & 63);
    float a = 0.f;
#pragma unroll 8
    for (int f = fg * 256; f < fg * 256 + 256; ++f) a += pe[f] * w1[(size_t)f * 256 + j];
    fs[fg * 64 + (tid & 63)] = a;
    __syncthreads();
    if (tid < 64) { float s = b1[j]; for (int g = 0; g < 8; ++g) s += fs[g * 64 + tid]; (kv ? p.B1Pv : p.B1Pk)[j] = s; }
    __syncthreads();
  }
}

DI void rownorm_body(const float* __restrict__ src, const float* __restrict__ g, const float* __restrict__ mod, int sh_off, int sc_off, bf16_t* __restrict__ dst, int vb) {
  int row = vb * 8 + (mytid() >> 6), lane = mytid() & 63;
  int b = row >> 13;
  const float* xr = src + (size_t)row * DM;
  float v[16]; float ss = 0.f;
#pragma unroll
  for (int i = 0; i < 4; ++i) {
    float4 t = *(const float4*)(xr + i * 256 + lane * 4);
    v[i * 4 + 0] = t.x; v[i * 4 + 1] = t.y; v[i * 4 + 2] = t.z; v[i * 4 + 3] = t.w;
    ss += t.x * t.x + t.y * t.y + t.z * t.z + t.w * t.w;
  }
  for (int o = 32; o; o >>= 1) ss += __shfl_xor(ss, o);
  float rstd = rsqrtf(ss * (1.f / DM) + 1e-6f);
  const float* sh = mod + b * 6144 + sh_off; const float* sc = mod + b * 6144 + sc_off;
#pragma unroll
  for (int i = 0; i < 4; ++i) {
    int col = i * 256 + lane * 4;
    float4 gg = *(const float4*)(g + col), s4 = *(const float4*)(sc + col), h4 = *(const float4*)(sh + col);
    float y0 = v[i * 4 + 0] * rstd * gg.x * (1.f + s4.x) + h4.x;
    float y1 = v[i * 4 + 1] * rstd * gg.y * (1.f + s4.y) + h4.y;
    float y2 = v[i * 4 + 2] * rstd * gg.z * (1.f + s4.z) + h4.z;
    float y3 = v[i * 4 + 3] * rstd * gg.w * (1.f + s4.w) + h4.w;
    *(uint2*)(dst + (size_t)row * DM + col) = pack4(y0, y1, y2, y3);
  }
}

#define G_A_BYTES (256 * 144)
#define G_B_BYTES (256 * 144)
#define G_BUF_BYTES (G_A_BYTES + G_B_BYTES)
template <class Epi>
DI void gemm_tile(const bf16_t* __restrict__ A, const bf16_t* __restrict__ Bt, int K, int m0, int n0, char* smem, const Epi& epi) {
  const int tid = mytid(), lane = tid & 63, w = tid >> 6, wm = w >> 2, wn = w & 3, r = lane & 31, h = lane >> 5;
  f32x16 acc[4][2];
#pragma unroll
  for (int i = 0; i < 4; ++i)
#pragma unroll
    for (int j = 0; j < 2; ++j) acc[i][j] = zero16();
  const int crow = tid >> 3, ckc = tid & 7;
  const bf16_t* ag = A + (size_t)(m0 + crow) * K + ckc * 8;
  const bf16_t* bg = Bt + (size_t)(n0 + crow) * K + ckc * 8;
  uint4 ra[4], rb[4];
#pragma unroll
  for (int i = 0; i < 4; ++i) { ra[i] = *(const uint4*)(ag + (size_t)i * 64 * K); rb[i] = *(const uint4*)(bg + (size_t)i * 64 * K); }
  char* lw = smem + crow * 144 + ckc * 16;
#pragma unroll
  for (int i = 0; i < 4; ++i) { *(uint4*)(lw + i * 64 * 144) = ra[i]; *(uint4*)(lw + G_A_BYTES + i * 64 * 144) = rb[i]; }
  __syncthreads();
  const int nk = K >> 6;
  for (int kt = 0; kt < nk; ++kt) {
    const int cur = kt & 1;
    if (kt + 1 < nk) {
      const int k0 = (kt + 1) * 64;
#pragma unroll
      for (int i = 0; i < 4; ++i) { ra[i] = *(const uint4*)(ag + (size_t)i * 64 * K + k0); rb[i] = *(const uint4*)(bg + (size_t)i * 64 * K + k0); }
    }
    const char* la = smem + cur * G_BUF_BYTES + (wm * 128 + r) * 144 + h * 16;
    const char* lb = smem + cur * G_BUF_BYTES + G_A_BYTES + (wn * 64 + r) * 144 + h * 16;
#pragma unroll
    for (int kk = 0; kk < 4; ++kk) {
      bf16x8 b0 = *(const bf16x8*)(lb + kk * 32), b1 = *(const bf16x8*)(lb + 32 * 144 + kk * 32);
#pragma unroll
      for (int i = 0; i < 4; ++i) {
        bf16x8 a = *(const bf16x8*)(la + i * 32 * 144 + kk * 32);
        acc[i][0] = MFMA32(a, b0, acc[i][0]); acc[i][1] = MFMA32(a, b1, acc[i][1]);
      }
    }
    if (kt + 1 < nk) {
      char* lw2 = lw + (cur ^ 1) * G_BUF_BYTES;
#pragma unroll
      for (int i = 0; i < 4; ++i) { *(uint4*)(lw2 + i * 64 * 144) = ra[i]; *(uint4*)(lw2 + G_A_BYTES + i * 64 * 144) = rb[i]; }
    }
    __syncthreads();
  }
  const int G = (n0 >> 6) + wn;
#pragma unroll
  for (int i = 0; i < 4; ++i) {
    float pre[4][8];
#pragma unroll
    for (int g = 0; g < 4; ++g) epi.prefetch(m0 + wm * 128 + i * 32 + 8 * g + 4 * h, G, r, pre[g]);
#pragma unroll
    for (int g = 0; g < 4; ++g) {
      float lo[4], hi[4];
#pragma unroll
      for (int e = 0; e < 4; ++e) { lo[e] = acc[i][0][4 * g + e]; hi[e] = acc[i][1][4 * g + e]; }
      epi(m0 + wm * 128 + i * 32 + 8 * g + 4 * h, G, r, lo, hi, pre[g]);
    }
  }
}

struct EpiProj {
  static constexpr bool kProbe = true;
  const Params& p;
  DI void prefetch(int t0, int G, int c, float (&pre)[8]) const {
    const int s0 = t0 & 8191;
    const bool r128 = G < 16, r64 = (G >= 32 && G < 40) || (G >= 40 && G < 52 && (((G - 40) >> 1) & 1) == 0);
    if (r128) {
      const int i = 32 * (G & 1) + c;
#pragma unroll
      for (int e = 0; e < 4; ++e) { pre[e] = p.c128[(s0 + e) * 64 + i]; pre[4 + e] = p.s128[(s0 + e) * 64 + i]; }
    } else if (r64) {
#pragma unroll
      for (int e = 0; e < 4; ++e) { pre[e] = p.c64[(s0 + e) * 32 + c]; pre[4 + e] = p.s64[(s0 + e) * 32 + c]; }
    } else {
#pragma unroll
      for (int e = 0; e < 8; ++e) pre[e] = 0.f;
    }
  }
  DI void operator()(int t0, int G, int c, const float (&lo)[4], const float (&hi)[4], const float (&pre)[8]) const {
    const int b = t0 >> 13, s0 = t0 & 8191;
    if (G < 16) {
      const int sec = G >> 3, hh = (G & 7) >> 1, j = G & 1, i = 32 * j + c;
      float o1[4], o2[4];
#pragma unroll
      for (int e = 0; e < 4; ++e) {
        float cs = pre[e], sn = pre[4 + e];
        o1[e] = lo[e] * cs - hi[e] * sn; o2[e] = hi[e] * cs + lo[e] * sn;
      }
      if (sec == 0) {
#pragma unroll
        for (int e = 0; e < 4; ++e) {
          p.RQ[(size_t)(t0 + e) * 512 + hh * 128 + i] = f2bf(o1[e]);
          p.RQ[(size_t)(t0 + e) * 512 + hh * 128 + 64 + i] = f2bf(o2[e]);
        }
      } else {
        const float sc = 0.08838834764831845f;
        const float lg = logg_h(hh);
#pragma unroll
        for (int e = 0; e < 4; ++e) {
          o1[e] *= sc; o2[e] *= sc;
          p.RK[(size_t)(t0 + e) * 512 + hh * 128 + i] = f2bf(o1[e]);
          p.RK[(size_t)(t0 + e) * 512 + hh * 128 + 64 + i] = f2bf(o2[e]);
          float zeta = __expf((float)(127 - ((s0 + e) & 127)) * lg);
          o1[e] *= zeta; o2[e] *= zeta;
        }
        *(uint2*)(p.RKT + ((size_t)(b * 4 + hh) * 128 + i) * SEQ + s0) = pack4(o1[0], o1[1], o1[2], o1[3]);
        *(uint2*)(p.RKT + ((size_t)(b * 4 + hh) * 128 + 64 + i) * SEQ + s0) = pack4(o2[0], o2[1], o2[2], o2[3]);
      }
    } else if (G < 24) {
      const int hh = (G - 16) >> 1, d = ((G - 16) & 1) * 64 + c;
      *(uint2*)(p.RVT + ((size_t)(b * 4 + hh) * 128 + d) * SEQ + s0) = pack4(lo[0], lo[1], lo[2], lo[3]);
      *(uint2*)(p.RVT + ((size_t)(b * 4 + hh) * 128 + d + 32) * SEQ + s0) = pack4(hi[0], hi[1], hi[2], hi[3]);
    } else if (G < 32) {
      const int hh = (G - 24) >> 1, d = ((G - 24) & 1) * 64 + c;
#pragma unroll
      for (int e = 0; e < 4; ++e) {
        p.RGT[(size_t)(t0 + e) * 512 + hh * 128 + d] = f2bf(siluf(lo[e]));
        p.RGT[(size_t)(t0 + e) * 512 + hh * 128 + d + 32] = f2bf(siluf(hi[e]));
      }
    } else if (G < 40) {
      const int head = G - 32;
#pragma unroll
      for (int e = 0; e < 4; ++e) {
        float cs = pre[e], sn = pre[4 + e];
        const float qs = 0.125f * 1.4426950408889634f;
        float o1 = (lo[e] * cs - hi[e] * sn) * qs, o2 = (hi[e] * cs + lo[e] * sn) * qs;
        p.NQ[(size_t)(t0 + e) * 512 + head * 64 + c] = f2bf(o1);
        p.NQ[(size_t)(t0 + e) * 512 + head * 64 + 32 + c] = f2bf(o2);
      }
    } else if (G < 52) {
      const int k = G - 40, kind = k >> 1, gg = k & 1;
      float o1[4], o2[4];
#pragma unroll
      for (int e = 0; e < 4; ++e) {
        o1[e] = lo[e]; o2[e] = hi[e];
        if ((kind & 1) == 0) {
          float cs = pre[e], sn = pre[4 + e];
          o1[e] = lo[e] * cs - hi[e] * sn; o2[e] = hi[e] * cs + lo[e] * sn;
        }
      }
      if (kind == 3 || kind == 5) {
        bf16_t* dst = (kind == 3 ? p.NVST : p.NVWT) + ((size_t)(b * 2 + gg) * 64 + c) * SEQ + s0;
        *(uint2*)dst = pack4(o1[0], o1[1], o1[2], o1[3]);
        *(uint2*)(dst + (size_t)32 * SEQ) = pack4(o2[0], o2[1], o2[2], o2[3]);
      } else {
        bf16_t* dst = (kind == 0 ? p.NKC : kind == 1 ? p.NVC : kind == 2 ? p.NKS : p.NKW);
#pragma unroll
        for (int e = 0; e < 4; ++e) {
          dst[(size_t)(t0 + e) * 128 + gg * 64 + c] = f2bf(o1[e]);
          dst[(size_t)(t0 + e) * 128 + gg * 64 + 32 + c] = f2bf(o2[e]);
        }
      }
    } else if (G == 52) {
      if (c < 24) {
#pragma unroll
        for (int e = 0; e < 4; ++e) p.GATE[(size_t)(t0 + e) * 24 + c] = sigmoidf(lo[e]);
      }
    }
  }
};
struct EpiOut {
  static constexpr bool kProbe = false;
  const Params& p;
  DI void prefetch(int t0, int G, int c, float (&pre)[8]) const {
    const int c0 = G * 64 + c;
#pragma unroll
    for (int e = 0; e < 4; ++e) { pre[e] = p.x[(size_t)(t0 + e) * DM + c0]; pre[4 + e] = p.x[(size_t)(t0 + e) * DM + c0 + 32]; }
  }
  DI void operator()(int t0, int G, int c, const float (&lo)[4], const float (&hi)[4], const float (&pre)[8]) const {
    const int b = t0 >> 13;
    const int c0 = G * 64 + c, c1 = c0 + 32;
    const float* ga1 = p.mod + b * 6144 + 2048;
    const float g0 = ga1[c0], g1 = ga1[c1];
#pragma unroll
    for (int e = 0; e < 4; ++e) {
      p.out[(size_t)(t0 + e) * DM + c0] = pre[e] + g0 * lo[e];
      p.out[(size_t)(t0 + e) * DM + c1] = pre[4 + e] + g1 * hi[e];
    }
  }
};
struct EpiPQ {
  static constexpr bool kProbe = false;
  const Params& p;
  DI void prefetch(int, int, int, float (&)[8]) const {}
  DI void operator()(int t0, int G, int c, const float (&lo)[4], const float (&hi)[4], const float (&)[8]) const {
#pragma unroll
    for (int e = 0; e < 4; ++e) {
      p.PQ[(size_t)(t0 + e) * 2048 + G * 64 + c] = f2bf(lo[e]);
      p.PQ[(size_t)(t0 + e) * 2048 + G * 64 + 32 + c] = f2bf(hi[e]);
    }
  }
};


namespace pg8 {
#define PG8_LAS __attribute__((address_space(3)))
typedef float f32x4 __attribute__((ext_vector_type(4)));
constexpr int BM = 256, BK = 64, HALF = 128, HTB = HALF * BK * 2, STAGE_BYTES = 8 * HTB, NXCD = 8, WGM = 8;
DI int lds_byte(int r, int c) { const int st = (r >> 4) * 2 + (c >> 5), rr = r & 15, cc = c & 31, ob = rr * 64 + cc * 2; return st * 1024 + (ob ^ (((ob >> 9) & 1) << 5)); }
DI void stage_rc(int b, int& R, int& C) { const int st = b / 1024, sb = b % 1024, swz = sb ^ (((sb >> 9) & 1) << 5); R = (st >> 1) * 16 + swz / 64; C = (st & 1) * 32 + (swz % 64) / 2; }
DI int perm32(int rho) { const int n = rho >> 4, i = rho & 15; return 8 * (i >> 2) + 4 * n + (i & 3); }
struct Unit { int pm, pn; };
struct Gemm { const bf16_t* A; const bf16_t* Bt; int M, N, K; };
struct StaticOrder {
  int nM, nN, nwg, G, c;
  DI void init(int M, int N, int G_, int c_) { nM = M / BM; nN = N / BM; nwg = nM * nN; G = G_; c = c_; }
  DI bool next(int i, Unit& u) const {
    const long L = (long)i * G + c; if (L >= nwg) return false;
    int wgid = (int)L; { const int q = nwg / NXCD, r = nwg % NXCD, xcd = wgid % NXCD, off = wgid / NXCD; wgid = (xcd < r ? xcd * (q + 1) : r * (q + 1) + (xcd - r) * q) + off; }
    const int nig = WGM * nN, gid = wgid / nig, fm = gid * WGM, gsz = (nM - fm) < WGM ? (nM - fm) : WGM;
    u.pm = fm + ((wgid % nig) % gsz); u.pn = (wgid % nig) / gsz; return true;
  }
  DI void a_ready(const Unit&) const {}
  DI void done(const Unit&) const {}
};
template <class Epi, class Sched>
__device__ __forceinline__ void gemm_phase(PG8_LAS unsigned char* lds, const Gemm g, const Sched& S, const Epi& E) {
    const int tid = mytid(), wid = __builtin_amdgcn_readfirstlane(tid >> 6), lane = tid & 63, wr = wid >> 2, wc = wid & 3, fr = lane & 15, fq = lane >> 4;
    const int K = g.K, nt = K / BK;
    unsigned voffA[2], voffB[2];
#pragma unroll
    for (int i = 0; i < 2; ++i) { int R, C; stage_rc(tid * 16 + i * 8192, R, C); const int Rb = Epi::PERM ? ((R & ~31) + perm32(R & 31)) : R;
        voffA[i] = (unsigned)(R * K + C) * 2u; voffB[i] = (unsigned)(Rb * K + C) * 2u; }
    const size_t kstep = (size_t)(BK * 2);
    const size_t hstep = (size_t)HALF * K * 2;
    const size_t tstep = 2 * hstep;
    const unsigned ldsw = (unsigned)wid * 1024u;
    const int aoff = lds_byte(wr * 64 + fr, fq * 8), boff = lds_byte(wc * 32 + fr, fq * 8);
#define PG8_SA(b, h) (((b) * 2 + (h)) * HTB)
#define PG8_SB(b, h) ((4 + (b) * 2 + (h)) * HTB)
#define PG8_STAGE(bufoff, gbase, voff) do { _Pragma("unroll") for (int _i = 0; _i < 2; ++_i) \
        __builtin_amdgcn_global_load_lds((const unsigned*)((const char*)(gbase) + (voff)[_i]), (PG8_LAS unsigned*)(lds + (bufoff) + ldsw + _i * 8192), 16, 0, 0); } while (0)
#define PG8_LDA(dst, b, h) do { _Pragma("unroll") for (int m = 0; m < 4; ++m) _Pragma("unroll") for (int k = 0; k < 2; ++k) dst[m][k] = *(const PG8_LAS bf16x8*)(lds + PG8_SA(b, h) + aoff + m * 2048 + k * 1024); } while (0)
#define PG8_LDB(dst, b, h) do { _Pragma("unroll") for (int n = 0; n < 2; ++n) _Pragma("unroll") for (int k = 0; k < 2; ++k) dst[n][k] = *(const PG8_LAS bf16x8*)(lds + PG8_SB(b, h) + boff + n * 2048 + k * 1024); } while (0)
#define PG8_MMA(ai, bj, At, Bt) do { __builtin_amdgcn_s_setprio(1); _Pragma("unroll") for (int m = 0; m < 4; ++m) _Pragma("unroll") for (int n = 0; n < 2; ++n) _Pragma("unroll") for (int k = 0; k < 2; ++k) \
        acc[ai][bj][m][n] = __builtin_amdgcn_mfma_f32_16x16x32_bf16(Bt[n][k], At[m][k], acc[ai][bj][m][n], 0, 0, 0); __builtin_amdgcn_s_setprio(0); } while (0)
#define PG8_WAIT_V(n) asm volatile("s_waitcnt vmcnt(" #n ")" ::: "memory")
#define PG8_WAIT_L(n) asm volatile("s_waitcnt lgkmcnt(" #n ")" ::: "memory")
#define PG8_BAR __builtin_amdgcn_s_barrier()
#define PG8_SCHED __builtin_amdgcn_sched_barrier(0)
    Unit cur, nxt; int ui = 0;
    if (!S.next(0, cur)) return;
    f32x4 acc[2][2][4][2];
#pragma unroll
    for (int a = 0; a < 2; ++a)
#pragma unroll
        for (int b = 0; b < 2; ++b)
#pragma unroll
            for (int m = 0; m < 4; ++m)
#pragma unroll
                for (int n = 0; n < 2; ++n) acc[a][b][m][n] = (f32x4){0.f, 0.f, 0.f, 0.f};
    bf16x8 At[4][2], B0[2][2], B1[2][2];
    const char* cA = (const char*)g.A + (size_t)cur.pm * tstep; const char* cB = (const char*)g.Bt + (size_t)cur.pn * tstep;
    S.a_ready(cur);
    PG8_STAGE(PG8_SB(0, 0), cB, voffB); PG8_STAGE(PG8_SA(0, 0), cA, voffA); PG8_STAGE(PG8_SB(0, 1), cB + hstep, voffB); PG8_STAGE(PG8_SA(0, 1), cA + hstep, voffA);
    if (wr == 1) PG8_BAR;
    PG8_WAIT_V(4); PG8_BAR;
    PG8_STAGE(PG8_SB(1, 0), cB + kstep, voffB); PG8_STAGE(PG8_SA(1, 0), cA + kstep, voffA); PG8_STAGE(PG8_SB(1, 1), cB + hstep + kstep, voffB);
    PG8_WAIT_V(6); PG8_BAR;
    for (;;) {
        const bool has_next = S.next(ui + 1, nxt);
        const char* nA = has_next ? (const char*)g.A + (size_t)nxt.pm * tstep : cA; const char* nB = has_next ? (const char*)g.Bt + (size_t)nxt.pn * tstep : cB;
        for (int t = 0; t < nt; t += 2) {
            const bool last = (t == nt - 2);
            const char* a1 = cA + (size_t)(t + 1) * kstep;
            const char* a2 = last ? nA : cA + (size_t)(t + 2) * kstep; const char* b2 = last ? nB : cB + (size_t)(t + 2) * kstep;
            const char* a3 = a2 + kstep; const char* b3 = b2 + kstep;
            if (last && has_next) S.a_ready(nxt);
            PG8_LDB(B0, 0, 0); PG8_SCHED; PG8_LDA(At, 0, 0); PG8_STAGE(PG8_SA(1, 1), a1 + hstep, voffA);
            PG8_WAIT_L(8); PG8_BAR; PG8_WAIT_L(0); PG8_MMA(0, 0, At, B0); PG8_BAR; PG8_SCHED;
            PG8_LDB(B1, 0, 1); PG8_STAGE(PG8_SB(0, 0), b2, voffB);
            PG8_BAR; PG8_WAIT_L(0); PG8_MMA(0, 1, At, B1); PG8_BAR;
            PG8_LDA(At, 0, 1); PG8_STAGE(PG8_SA(0, 0), a2, voffA);
            PG8_BAR; PG8_WAIT_L(0); PG8_MMA(1, 0, At, B0); PG8_BAR; PG8_SCHED;
            PG8_STAGE(PG8_SB(0, 1), b2 + hstep, voffB);
            PG8_WAIT_V(6); PG8_BAR; PG8_MMA(1, 1, At, B1); PG8_BAR;
            PG8_LDB(B0, 1, 0); PG8_SCHED; PG8_LDA(At, 1, 0); PG8_STAGE(PG8_SA(0, 1), a2 + hstep, voffA);
            PG8_WAIT_L(8); PG8_BAR; PG8_WAIT_L(0); PG8_MMA(0, 0, At, B0); PG8_BAR; PG8_SCHED;
            PG8_LDB(B1, 1, 1); PG8_STAGE(PG8_SB(1, 0), b3, voffB);
            PG8_BAR; PG8_WAIT_L(0); PG8_MMA(0, 1, At, B1); PG8_BAR;
            PG8_LDA(At, 1, 1); PG8_STAGE(PG8_SA(1, 0), a3, voffA);
            PG8_BAR; PG8_WAIT_L(0); PG8_MMA(1, 0, At, B0); PG8_BAR; PG8_SCHED;
            PG8_STAGE(PG8_SB(1, 1), b3 + hstep, voffB);
            PG8_WAIT_V(6); PG8_BAR; PG8_MMA(1, 1, At, B1); PG8_BAR;
        }
        if constexpr (!Epi::AFTER_DRAIN) { E(acc, cur, wr, wc, fr, fq); S.done(cur); }
        if (!has_next) break;
#pragma unroll
        for (int a = 0; a < 2; ++a)
#pragma unroll
            for (int b = 0; b < 2; ++b)
#pragma unroll
                for (int m = 0; m < 4; ++m)
#pragma unroll
                    for (int n = 0; n < 2; ++n) acc[a][b][m][n] = (f32x4){0.f, 0.f, 0.f, 0.f};
        cur = nxt; cA = nA; cB = nB; ++ui;
    }
    PG8_WAIT_V(0);
    if (wr == 0) PG8_BAR;
    PG8_BAR;
    if constexpr (Epi::AFTER_DRAIN) { E.fused(acc, cur, wr, wc, fr, fq, lds, wid, lane); S.done(cur); }
#undef PG8_SA
#undef PG8_SB
#undef PG8_STAGE
#undef PG8_LDA
#undef PG8_LDB
#undef PG8_MMA
#undef PG8_WAIT_V
#undef PG8_WAIT_L
#undef PG8_BAR
#undef PG8_SCHED
}
}

template <int CTRL> DI float dpp_q(float x) { return __builtin_bit_cast(float, __builtin_amdgcn_mov_dpp(__builtin_bit_cast(int, x), CTRL, 0xf, 0xf, true)); }
DI void tstore4(bf16_t* dst, float v0, float v1, float v2, float v3, int q) {
  const bool o1_ = q & 1, o2_ = q & 2;
  const float sa = o1_ ? v0 : v1, sb = o1_ ? v2 : v3;
  const float ra = dpp_q<0xB1>(sa), rb = dpp_q<0xB1>(sb);
  const float w0 = o1_ ? ra : v0, w1 = o1_ ? v1 : ra, w2 = o1_ ? rb : v2, w3 = o1_ ? v3 : rb;
  const float sc = o2_ ? w0 : w2, sd = o2_ ? w1 : w3;
  const float rc = dpp_q<0x4E>(sc), rd = dpp_q<0x4E>(sd);
  const float x0 = o2_ ? rc : w0, x1 = o2_ ? rd : w1, x2 = o2_ ? w2 : rc, x3 = o2_ ? w3 : rd;
  *(uint2*)(dst + (size_t)q * SEQ - q) = pack4(x0, x1, x2, x3);
}
DI uint4 pack8u(const float (&a)[4], const float (&b)[4]) { uint4 v; v.x = cvt2(a[0], a[1]); v.y = cvt2(a[2], a[3]); v.z = cvt2(b[0], b[1]); v.w = cvt2(b[2], b[3]); return v; }
struct EpiProj8 {
  static constexpr bool PERM = true, AFTER_DRAIN = false;
  const Params& p;
  DI void operator()(const pg8::f32x4 (&acc)[2][2][4][2], const pg8::Unit& u, int wr, int wc, int fr, int fq) const {
    const int pn = u.pn, q4 = fr & 3;
    const bool rot128 = pn < 4, rot64 = (pn >= 8 && pn < 10) || pn == 10 || (pn == 11 && wc < 2), rot = rot128 || rot64;
    const int t00 = u.pm * 256 + wr * 64 + fr, s00 = t00 & 8191;
    const int cb0 = 8 * fq;
    const float* ct = rot128 ? p.c128 : p.c64; const float* st = rot128 ? p.s128 : p.s64;
    const int nrot = rot128 ? 64 : 32, ridx = (rot128 ? 32 * (wc & 1) : 0) + cb0;
    float cd_[2][4], sd_[2][4];
    if (rot) {
#pragma unroll
      for (int n = 0; n < 2; ++n) {
        const float4 c16 = *(const float4*)(ct + (size_t)16 * nrot + ridx + 4 * n), s16 = *(const float4*)(st + (size_t)16 * nrot + ridx + 4 * n);
        cd_[n][0] = c16.x; cd_[n][1] = c16.y; cd_[n][2] = c16.z; cd_[n][3] = c16.w; sd_[n][0] = s16.x; sd_[n][1] = s16.y; sd_[n][2] = s16.z; sd_[n][3] = s16.w;
      }
    }
#pragma unroll
    for (int ai = 0; ai < 2; ++ai) {
      float c_[2][4], s_[2][4];
      if (rot) {
#pragma unroll
        for (int n = 0; n < 2; ++n) {
          const float4 c4 = *(const float4*)(ct + (size_t)(s00 + 128 * ai) * nrot + ridx + 4 * n), s4 = *(const float4*)(st + (size_t)(s00 + 128 * ai) * nrot + ridx + 4 * n);
          c_[n][0] = c4.x; c_[n][1] = c4.y; c_[n][2] = c4.z; c_[n][3] = c4.w; s_[n][0] = s4.x; s_[n][1] = s4.y; s_[n][2] = s4.z; s_[n][3] = s4.w;
        }
      }
#pragma unroll
      for (int m = 0; m < 4; ++m) {
        const int t = t00 + ai * 128 + m * 16, b = t >> 13, s = t & 8191;
        float lo[2][4], hi[2][4];
#pragma unroll
        for (int n = 0; n < 2; ++n) {
          const pg8::f32x4 L = acc[ai][0][m][n], H = acc[ai][1][m][n];
#pragma unroll
          for (int i = 0; i < 4; ++i) {
            if (rot) {
              const float c = c_[n][i], sn = s_[n][i];
              lo[n][i] = L[i] * c - H[i] * sn; hi[n][i] = H[i] * c + L[i] * sn;
              c_[n][i] = c * cd_[n][i] - sn * sd_[n][i]; s_[n][i] = sn * cd_[n][i] + c * sd_[n][i];
            } else { lo[n][i] = L[i]; hi[n][i] = H[i]; }
          }
        }
        if (pn < 4) {
          const int hh = 2 * (pn & 1) + (wc >> 1), idx = 32 * (wc & 1) + cb0;
          if (pn < 2) {
            *(uint4*)(p.RQ + (size_t)t * 512 + hh * 128 + idx) = pack8u(lo[0], lo[1]);
            *(uint4*)(p.RQ + (size_t)t * 512 + hh * 128 + 64 + idx) = pack8u(hi[0], hi[1]);
          } else {
            const float sc = 0.08838834764831845f;
#pragma unroll
            for (int n = 0; n < 2; ++n)
#pragma unroll
              for (int i = 0; i < 4; ++i) { lo[n][i] *= sc; hi[n][i] *= sc; }
            *(uint4*)(p.RK + (size_t)t * 512 + hh * 128 + idx) = pack8u(lo[0], lo[1]);
            *(uint4*)(p.RK + (size_t)t * 512 + hh * 128 + 64 + idx) = pack8u(hi[0], hi[1]);
            const float zeta = __expf((float)(127 - (s & 127)) * logg_h(hh));
            bf16_t* kt = p.RKT + ((size_t)(b * 4 + hh) * 128 + idx) * SEQ + s;
#pragma unroll
            for (int n = 0; n < 2; ++n) {
              tstore4(kt + (size_t)(4 * n) * SEQ, lo[n][0] * zeta, lo[n][1] * zeta, lo[n][2] * zeta, lo[n][3] * zeta, q4);
              tstore4(kt + (size_t)(64 + 4 * n) * SEQ, hi[n][0] * zeta, hi[n][1] * zeta, hi[n][2] * zeta, hi[n][3] * zeta, q4);
            }
          }
        } else if (pn < 6) {
          bf16_t* v0 = p.RVT + ((size_t)(b * 4 + 2 * (pn - 4)) * 128 + 32 * wc + cb0) * SEQ + s;
#pragma unroll
          for (int n = 0; n < 2; ++n) {
            tstore4(v0 + (size_t)(4 * n) * SEQ, lo[n][0], lo[n][1], lo[n][2], lo[n][3], q4);
            tstore4(v0 + (size_t)(128 + 4 * n) * SEQ, hi[n][0], hi[n][1], hi[n][2], hi[n][3], q4);
          }
        } else if (pn < 8) {
          const int d = 32 * wc + cb0, h0 = 2 * (pn - 6);
#pragma unroll
          for (int n = 0; n < 2; ++n)
#pragma unroll
            for (int i = 0; i < 4; ++i) { lo[n][i] = siluf(lo[n][i]); hi[n][i] = siluf(hi[n][i]); }
          *(uint4*)(p.RGT + (size_t)t * 512 + h0 * 128 + d) = pack8u(lo[0], lo[1]);
          *(uint4*)(p.RGT + (size_t)t * 512 + (h0 + 1) * 128 + d) = pack8u(hi[0], hi[1]);
        } else if (pn < 10) {
          const int head = 4 * (pn - 8) + wc;
          const float qs = 0.125f * 1.4426950408889634f;
#pragma unroll
          for (int n = 0; n < 2; ++n)
#pragma unroll
            for (int i = 0; i < 4; ++i) { lo[n][i] *= qs; hi[n][i] *= qs; }
          *(uint4*)(p.NQ + (size_t)t * 512 + head * 64 + cb0) = pack8u(lo[0], lo[1]);
          *(uint4*)(p.NQ + (size_t)t * 512 + head * 64 + 32 + cb0) = pack8u(hi[0], hi[1]);
        } else if (pn == 10 || (pn == 11 && wc < 2)) {
          bf16_t* dst = (pn == 11) ? p.NKW : (wc < 2 ? p.NKC : p.NKS);
          const int g = wc & 1;
          *(uint4*)(dst + (size_t)t * 128 + g * 64 + cb0) = pack8u(lo[0], lo[1]);
          *(uint4*)(dst + (size_t)t * 128 + g * 64 + 32 + cb0) = pack8u(hi[0], hi[1]);
        } else if (pn == 11) {
          const int c0 = 32 * (wc - 2) + cb0;
          *(uint4*)(p.NVC + (size_t)t * 128 + c0) = pack8u(lo[0], lo[1]);
          *(uint4*)(p.NVC + (size_t)t * 128 + 64 + c0) = pack8u(hi[0], hi[1]);
        } else if (pn == 12) {
          const int col = 32 * wc + cb0, g = col >> 6, d = col & 63;
          bf16_t* v0 = p.NVST + ((size_t)(b * 2 + g) * 64 + d) * SEQ + s;
          bf16_t* v1 = p.NVWT + ((size_t)(b * 2 + g) * 64 + d) * SEQ + s;
#pragma unroll
          for (int n = 0; n < 2; ++n) {
            tstore4(v0 + (size_t)(4 * n) * SEQ, lo[n][0], lo[n][1], lo[n][2], lo[n][3], q4);
            tstore4(v1 + (size_t)(4 * n) * SEQ, hi[n][0], hi[n][1], hi[n][2], hi[n][3], q4);
          }
        } else {
          if (wc == 0) {
#pragma unroll
            for (int n = 0; n < 2; ++n)
#pragma unroll
              for (int i = 0; i < 4; ++i) if (cb0 + 4 * n + i < 24) p.GATE[(size_t)t * 24 + cb0 + 4 * n + i] = sigmoidf(lo[n][i]);
          }
        }
      }
    }
  }
};
struct EpiOut8 {
  static constexpr bool PERM = false, AFTER_DRAIN = false;
  const float* x; float* out; const float* mod;
  DI void operator()(const pg8::f32x4 (&acc)[2][2][4][2], const pg8::Unit& u, int wr, int wc, int fr, int fq) const {
    const int col0 = u.pn * 256 + wc * 32 + 4 * fq;
    const float* ga1 = mod + ((u.pm * 256) >> 13) * 6144 + 2048;
    float4 gv[2][2];
#pragma unroll
    for (int bj = 0; bj < 2; ++bj)
#pragma unroll
      for (int n = 0; n < 2; ++n) gv[bj][n] = *(const float4*)(ga1 + col0 + bj * 128 + n * 16);
#pragma unroll
    for (int ai = 0; ai < 2; ++ai)
#pragma unroll
      for (int m = 0; m < 4; ++m) {
        const size_t ro = (size_t)(u.pm * 256 + wr * 64 + fr + ai * 128 + m * 16) * DM + col0;
        float4 xv[2][2];
#pragma unroll
        for (int bj = 0; bj < 2; ++bj)
#pragma unroll
          for (int n = 0; n < 2; ++n) xv[bj][n] = *(const float4*)(x + ro + bj * 128 + n * 16);
#pragma unroll
        for (int bj = 0; bj < 2; ++bj)
#pragma unroll
          for (int n = 0; n < 2; ++n) {
            const pg8::f32x4 v = acc[ai][bj][m][n]; const float4 g4 = gv[bj][n], x4 = xv[bj][n];
            *(float4*)(out + ro + bj * 128 + n * 16) = make_float4(x4.x + g4.x * v[0], x4.y + g4.y * v[1], x4.z + g4.z * v[2], x4.w + g4.w * v[3]);
          }
      }
  }
};
struct EpiPQ8 {
  static constexpr bool PERM = true, AFTER_DRAIN = false;
  bf16_t* O;
  DI void operator()(const pg8::f32x4 (&acc)[2][2][4][2], const pg8::Unit& u, int wr, int wc, int fr, int fq) const {
#pragma unroll
    for (int ai = 0; ai < 2; ++ai)
#pragma unroll
      for (int m = 0; m < 4; ++m) {
        bf16_t* rowp = O + (size_t)(u.pm * 256 + wr * 64 + fr + ai * 128 + m * 16) * 2048 + u.pn * 256 + wc * 32 + 8 * fq;
#pragma unroll
        for (int bj = 0; bj < 2; ++bj) {
          const pg8::f32x4 v0 = acc[ai][bj][m][0], v1 = acc[ai][bj][m][1];
          uint4 o; o.x = cvt2(v0[0], v0[1]); o.y = cvt2(v0[2], v0[3]); o.z = cvt2(v1[0], v1[1]); o.w = cvt2(v1[2], v1[3]);
          *(uint4*)(rowp + bj * 128) = o;
        }
      }
  }
};
DI int crow(int reg, int h) { return (reg & 3) + 8 * (reg >> 2) + 4 * h; }
DI bf16x8 ld16(const bf16_t* ptr) { return *(const bf16x8*)ptr; }
DI bf16x8 ld8x2(const bf16_t* ptr) {
  uint2 a = *(const uint2*)ptr, b = *(const uint2*)(ptr + 8);
  uint4 v; v.x = a.x; v.y = a.y; v.z = b.x; v.w = b.y;
  return __builtin_bit_cast(bf16x8, v);
}
DI bf16x8 pack8(float x0, float x1, float x2, float x3, float x4, float x5, float x6, float x7) {
  uint4 v; v.x = cvt2(x0, x1); v.y = cvt2(x2, x3); v.z = cvt2(x4, x5); v.w = cvt2(x6, x7);
  return __builtin_bit_cast(bf16x8, v);
}

DI void retkv_mfma(const Params& p, int item) {
  const int lane = mytid() & 63, w = mytid() >> 6, r = lane & 31, h = lane >> 5;
  const int hh = item & 3, c = (item >> 2) & 63, b = item >> 8, bh = b * 4 + hh, s0 = c * 128;
  const int mi = w >> 1, nb = (w & 1) * 2;
  const bf16_t* vb_ = p.RVT + ((size_t)(bh * 128 + 32 * mi + r)) * SEQ + s0 + 8 * h;
  const bf16_t* k0 = p.RKT + ((size_t)(bh * 128 + 32 * nb + r)) * SEQ + s0 + 8 * h;
  const bf16_t* k1 = k0 + (size_t)32 * SEQ;
  f32x16 a0 = zero16(), a1 = zero16();
#pragma unroll
  for (int s = 0; s < 8; ++s) {
    bf16x8 a = ld16(vb_ + 16 * s), b0 = ld16(k0 + 16 * s), b1 = ld16(k1 + 16 * s);
    a0 = MFMA32(a, b0, a0); a1 = MFMA32(a, b1, a1);
  }
  float* dst = p.KV + (size_t)item * 16384;
#pragma unroll
  for (int e = 0; e < 16; ++e) {
    const int v = 32 * mi + crow(e, h);
    dst[v * 128 + 32 * nb + r] = a0[e];
    dst[v * 128 + 32 * nb + 32 + r] = a1[e];
  }
}
DI void scan_body(const Params& p, int idx) {
  const int e = idx & 16383, bh = idx >> 14, b = bh >> 2, h = bh & 3;
  const float cd = __expf(128.f * logg_h(h));
  float S = 0.f;
  for (int c0 = 0; c0 < 64; c0 += 32) {
    float kv[32];
#pragma unroll
    for (int u = 0; u < 32; ++u) kv[u] = p.KV[(size_t)((b * 64 + c0 + u) * 4 + h) * 16384 + e];
#pragma unroll
    for (int u = 0; u < 32; ++u) {
      p.SPREV[(size_t)((b * 64 + c0 + u) * 4 + h) * 16384 + e] = f2bf(S);
      S = cd * S + kv[u];
    }
  }
}
DI void retout_mfma(const Params& p, int task) {
  const int lane = mytid() & 63, r = lane & 31, h = lane >> 5;
  const int item = task >> 2, nt = task & 3;
  const int hh = item & 3, c = (item >> 2) & 63, b = item >> 8, bh = b * 4 + hh, s0 = c * 128, t0 = b * SEQ + s0;
  const float lg = logg_h(hh);
  const int n = 32 * nt + r;
  bf16x8 qf[8];
#pragma unroll
  for (int s = 0; s < 8; ++s) qf[s] = ld16(p.RQ + (size_t)(t0 + n) * 512 + hh * 128 + 16 * s + 8 * h);
  f32x16 acc[4];
#pragma unroll
  for (int vi = 0; vi < 4; ++vi) {
    acc[vi] = zero16();
    const bf16_t* sp = p.SPREV + (size_t)item * 16384 + (size_t)(32 * vi + r) * 128 + 8 * h;
#pragma unroll
    for (int s = 0; s < 8; ++s) acc[vi] = MFMA32(ld16(sp + 16 * s), qf[s], acc[vi]);
    __builtin_amdgcn_sched_barrier(0);
  }
  {
    const float xi = __expf((float)(n + 1) * lg);
#pragma unroll
    for (int vi = 0; vi < 4; ++vi)
#pragma unroll
      for (int e = 0; e < 16; ++e) acc[vi][e] *= xi;
  }
  for (int mt = 0; mt <= nt; ++mt) {
    f32x16 sa = zero16();
    const bf16_t* kp = p.RK + (size_t)(t0 + 32 * mt + r) * 512 + hh * 128 + 8 * h;
#pragma unroll
    for (int s = 0; s < 8; ++s) sa = MFMA32(ld16(kp + 16 * s), qf[s], sa);
    float pv[16];
#pragma unroll
    for (int e = 0; e < 16; ++e) {
      const int dm = n - (32 * mt + crow(e, h));
      pv[e] = (dm >= 0) ? sa[e] * __expf((float)dm * lg) : 0.f;
    }
#pragma unroll
    for (int s2 = 0; s2 < 2; ++s2) {
      bf16x8 bfr = pack8(pv[8 * s2], pv[8 * s2 + 1], pv[8 * s2 + 2], pv[8 * s2 + 3], pv[8 * s2 + 4], pv[8 * s2 + 5], pv[8 * s2 + 6], pv[8 * s2 + 7]);
#pragma unroll
      for (int vi = 0; vi < 4; ++vi) {
        bf16x8 afr = ld8x2(p.RVT + ((size_t)(bh * 128 + 32 * vi + r)) * SEQ + s0 + 32 * mt + 16 * s2 + 4 * h);
        acc[vi] = MFMA32(afr, bfr, acc[vi]);
      }
      __builtin_amdgcn_sched_barrier(0);
    }
  }
  float sum = 0.f;
#pragma unroll
  for (int vi = 0; vi < 4; ++vi)
#pragma unroll
    for (int e = 0; e < 16; ++e) sum += acc[vi][e];
  sum += __shfl_xor(sum, 32);
  const float mu = sum * (1.f / 128.f);
  float var = 0.f;
#pragma unroll
  for (int vi = 0; vi < 4; ++vi)
#pragma unroll
    for (int e = 0; e < 16; ++e) { float d = acc[vi][e] - mu; var += d * d; }
  var += __shfl_xor(var, 32);
  const float rs = rsqrtf(var * (1.f / 128.f) + 1e-6f);
#pragma unroll
  for (int vi = 0; vi < 4; ++vi)
#pragma unroll
    for (int g4 = 0; g4 < 4; ++g4) {
      const int v0 = 32 * vi + 8 * g4 + 4 * h;
      uint2 gt = *(const uint2*)(p.RGT + (size_t)(t0 + n) * 512 + hh * 128 + v0);
      float y0 = (acc[vi][4 * g4 + 0] - mu) * rs * __uint_as_float(gt.x << 16);
      float y1 = (acc[vi][4 * g4 + 1] - mu) * rs * __uint_as_float(gt.x & 0xffff0000u);
      float y2 = (acc[vi][4 * g4 + 2] - mu) * rs * __uint_as_float(gt.y << 16);
      float y3 = (acc[vi][4 * g4 + 3] - mu) * rs * __uint_as_float(gt.y & 0xffff0000u);
      *(uint2*)(p.RA + (size_t)(t0 + n) * DM + hh * 128 + v0) = pack4(y0, y1, y2, y3);
    }
}
#define HID_STRIDE 264
DI void compress_mfma(const Params& p, int item, char* smem) {
  float* PART = (float*)smem;
  bf16_t* HIDL = (bf16_t*)(smem + 4 * 16 * 256 * 4);
  const int tid = mytid(), lane = tid & 63, w = tid >> 6, r = lane & 31, h = lane >> 5;
  const int kv = item >> 7, bg = (item >> 5) & 3, rt = item & 31, n0 = rt * 16, b = bg >> 1, g = bg & 1;
  const bf16_t* src = kv ? p.NVC : p.NKC; const bf16_t* W1 = kv ? p.W1Tv : p.W1Tk; const bf16_t* W2 = kv ? p.W2Tv : p.W2Tk;
  const float* B1 = kv ? p.B1Pv : p.B1Pk;
  {
    const int kq = w >> 1, ch = w & 1;
    const int n = min(n0 + (r & 15), 510);
    const bf16_t* ab = src + ((size_t)(b * SEQ + 16 * n)) * 128 + g * 64 + 8 * h;
    const bf16_t* bb = W1 + (size_t)(128 * ch + r) * 2048 + 8 * h;
    f32x16 acc[4];
#pragma unroll
    for (int ct = 0; ct < 4; ++ct) acc[ct] = zero16();
#pragma unroll 4
    for (int s = 32 * kq; s < 32 * kq + 32; ++s) {
      const bf16x8 a = ld16(ab + (s >> 2) * 128 + (s & 3) * 16);
#pragma unroll
      for (int ct = 0; ct < 4; ++ct) acc[ct] = MFMA32(a, ld16(bb + (size_t)ct * 32 * 2048 + 16 * s), acc[ct]);
    }
#pragma unroll
    for (int ct = 0; ct < 4; ++ct)
#pragma unroll
      for (int e = 0; e < 8; ++e) PART[(kq * 16 + crow(e, h)) * 256 + 128 * ch + 32 * ct + r] = acc[ct][e];
  }
  __syncthreads();
#pragma unroll
  for (int i = 0; i < 8; ++i) {
    const int idx = tid + 512 * i, row = idx >> 8, col = idx & 255;
    const float v = PART[row * 256 + col] + PART[(16 + row) * 256 + col] + PART[(32 + row) * 256 + col] + PART[(48 + row) * 256 + col] + B1[col];
    HIDL[row * HID_STRIDE + col] = f2bf(gelu_tanh(v));
  }
  __syncthreads();
  if (w < 2) {
    f32x16 acc = zero16();
#pragma unroll
    for (int s = 0; s < 16; ++s) acc = MFMA32(ld16(HIDL + (r & 15) * HID_STRIDE + 16 * s + 8 * h), ld16(W2 + (size_t)(32 * w + r) * 256 + 16 * s + 8 * h), acc);
    const int e_ = 32 * w + r;
    if (kv == 0) {
#pragma unroll
      for (int e = 0; e < 8; ++e) { const int n = n0 + crow(e, h); p.KC[((size_t)bg * 512 + n) * 64 + e_] = (n < 511) ? f2bf(acc[e]) : (bf16_t)0; }
    } else {
#pragma unroll
      for (int g4 = 0; g4 < 2; ++g4) {
        const int n = n0 + 8 * g4 + 4 * h;
        float v3 = (n + 3 < 511) ? acc[4 * g4 + 3] : 0.f;
        *(uint2*)(p.VCT + ((size_t)bg * 64 + e_) * 512 + n) = pack4(acc[4 * g4], acc[4 * g4 + 1], acc[4 * g4 + 2], v3);
      }
    }
  }
  __syncthreads();
}
DI void kmax_body2(const Params& p, int vb) {
  const int tid = mytid(), g = tid & 1, t = vb * 256 + (tid >> 1), b = t >> 13;
  const bf16_t* k = p.NKS + (size_t)t * 128 + g * 64; const bf16_t* kw = p.NKW + (size_t)t * 128 + g * 64;
  float ss = 0.f, sw = 0.f;
  for (int d = 0; d < 64; d += 8) {
    uint4 a = *(const uint4*)(k + d), c = *(const uint4*)(kw + d);
    const unsigned aa[4] = {a.x, a.y, a.z, a.w}, cc[4] = {c.x, c.y, c.z, c.w};
#pragma unroll
    for (int q = 0; q < 4; ++q) {
      float x0 = __uint_as_float(aa[q] << 16), x1 = __uint_as_float(aa[q] & 0xffff0000u);
      float y0 = __uint_as_float(cc[q] << 16), y1 = __uint_as_float(cc[q] & 0xffff0000u);
      ss += x0 * x0 + x1 * x1; sw += y0 * y0 + y1 * y1;
    }
  }
  float m1 = sqrtf(ss), m2 = sqrtf(sw);
  for (int o = 2; o < 64; o <<= 1) { m1 = fmaxf(m1, __shfl_xor(m1, o)); m2 = fmaxf(m2, __shfl_xor(m2, o)); }
  if ((tid & 63) < 2) { atomicMax(&p.ksmax[b * 2 + g], __float_as_uint(m1)); atomicMax(&p.ksmax[4 + b * 2 + g], __float_as_uint(m2)); }
}
DI void kcmax_body(const Params& p, int idx) {
  const bf16_t* k = p.KC + (size_t)idx * 64;
  float ss = 0.f;
  for (int d = 0; d < 64; ++d) { float v = bf2f(k[d]); ss += v * v; }
  atomicMax(&p.ksmax[8 + (idx >> 9)], __float_as_uint(sqrtf(ss)));
}

#define NSA_IMP 0
#define NSA_SELM 65536
#define NSA_KV 66816
#define KV_ROW 144
#define KV_TILE (64 * KV_ROW)
template <int CTRL> DI float dpp_f2(float x) { return __builtin_bit_cast(float, __builtin_amdgcn_mov_dpp(__builtin_bit_cast(int, x), CTRL, 0xf, 0xf, true)); }
DI float quad_sum(float v) { v += dpp_f2<0xB1>(v); v += dpp_f2<0x4E>(v); return v; }
DI bf16x8 lds8x2(const char* ptr) {
  uint2 a = *(const uint2*)ptr, b = *(const uint2*)(ptr + 16);
  uint4 v; v.x = a.x; v.y = a.y; v.z = b.x; v.w = b.y;
  return __builtin_bit_cast(bf16x8, v);
}

DI void nsa_item(const Params& p, int item, char* smem) {
  const int tid = mytid(), lane = tid & 63, w = tid >> 6, r = lane & 31, h = lane >> 5;
  const int ti = item >> 2, bg = item & 3, b = bg >> 1, g = bg & 1;
  const int ts = ti * 64, tokg0 = b * SEQ + ts;
  const int tkl = 8 * w + (r >> 2), hl = r & 3, hd = g * 4 + hl, tpos = ts + tkl;
  float* IMPA = (float*)(smem + NSA_IMP); float* IMPB = IMPA + 64 * 128;
  unsigned* SELM = (unsigned*)(smem + NSA_SELM);
  char* KVB = smem + NSA_KV;
  const float ksm = __uint_as_float(p.ksmax[bg]), kwm = __uint_as_float(p.ksmax[4 + bg]), kcm = __uint_as_float(p.ksmax[8 + bg]);

  bf16x8 qf[4];
#pragma unroll
  for (int s = 0; s < 4; ++s) qf[s] = ld16(p.NQ + (size_t)(tokg0 + tkl) * 512 + hd * 64 + 16 * s + 8 * h);
  float qq = 0.f;
#pragma unroll
  for (int s = 0; s < 4; ++s) {
    uint4 u = __builtin_bit_cast(uint4, qf[s]);
    const unsigned uu[4] = {u.x, u.y, u.z, u.w};
#pragma unroll
    for (int q = 0; q < 4; ++q) { float x0 = __uint_as_float(uu[q] << 16), x1 = __uint_as_float(uu[q] & 0xffff0000u); qq += x0 * x0 + x1 * x1; }
  }
  qq += __shfl_xor(qq, 32);
  const float qn = sqrtf(qq);
  const int srow = tid >> 3, sch = tid & 7;
  const bf16_t* ksrc = p.NKS + ((size_t)(b * SEQ) + srow) * 128 + g * 64 + sch * 8;
  const bf16_t* vsrc = p.NVST + ((size_t)bg * 64 + srow) * SEQ + sch * 8;
  const bf16_t* kcs = p.KC + ((size_t)bg * 512 + srow) * 64 + sch * 8;
  const bf16_t* vcs = p.VCT + ((size_t)bg * 64 + srow) * 512 + sch * 8;
  char* sdst = KVB + srow * KV_ROW + sch * 16;
  {
    uint4 k0 = *(const uint4*)kcs, v0 = *(const uint4*)vcs;
    *(uint4*)sdst = k0; *(uint4*)(sdst + KV_TILE) = v0;
  }
  for (int q = tid; q < 64 * 128 * 2 / 4; q += NT) ((float4*)IMPA)[q] = make_float4(0.f, 0.f, 0.f, 0.f);
  __syncthreads();

#define RING_RUN(KS, KSTEP, VS, VSTEP, NTILES, NEED, COMPUTE)                                                                               \
  {                                                                                                                                         \
    for (int jj = 0; jj < (NTILES); ++jj) {                                                                                                 \
      uint4 ka_, va_;                                                                                                                       \
      ka_ = va_ = make_uint4(0u, 0u, 0u, 0u);                                                                                               \
      if (jj + 1 < (NTILES)) { ka_ = *(const uint4*)((KS) + (size_t)(jj + 1) * (KSTEP)); va_ = *(const uint4*)((VS) + (size_t)(jj + 1) * (VSTEP)); } \
      if (NEED(jj)) { const char* kb = KVB + (jj & 1) * 2 * KV_TILE; const char* vbuf = kb + KV_TILE; COMPUTE(jj, kb, vbuf) }               \
      if (jj + 1 < (NTILES)) { char* d2 = sdst + ((jj + 1) & 1) * 2 * KV_TILE; *(uint4*)d2 = ka_; *(uint4*)(d2 + KV_TILE) = va_; }          \
      __syncthreads();                                                                                                                      \
    }                                                                                                                                       \
  }
#define STAGE_PAIR0(KS, KSTEP, VS, VSTEP, NTILES) { uint4 k0_ = *(const uint4*)(KS), v0_ = *(const uint4*)(VS); *(uint4*)sdst = k0_; *(uint4*)(sdst + KV_TILE) = v0_; }
#define IMP_NONE(JJ, kh, pv)
#define ATT_EXP(x) ex2(x)
#define ATT_LSUM(LACC, pv) LACC += ((pv[0] + pv[1]) + (pv[2] + pv[3])) + ((pv[4] + pv[5]) + (pv[6] + pv[7])) + ((pv[8] + pv[9]) + (pv[10] + pv[11])) + ((pv[12] + pv[13]) + (pv[14] + pv[15]));
#define ATT_TILE(kb, vbuf, INIT, FULL, MASKEXPR, SCALE, ACC, LACC, IMPHOOK, JJ)                                                             \
          {                                                                                                                                 \
            bf16x8 kf_[2][4], vf_[2][2][2];       \
            _Pragma("unroll") for (int kh = 0; kh < 2; ++kh)                                                                                \
              _Pragma("unroll") for (int s = 0; s < 4; ++s) kf_[kh][s] = *(const bf16x8*)(kb + (32 * kh + r) * KV_ROW + (16 * s + 8 * h) * 2); \
            _Pragma("unroll") for (int kh = 0; kh < 2; ++kh)                                                                                \
              _Pragma("unroll") for (int di = 0; di < 2; ++di)                                                                              \
                _Pragma("unroll") for (int s2 = 0; s2 < 2; ++s2) vf_[kh][di][s2] = lds8x2(vbuf + (32 * di + r) * KV_ROW + (32 * kh + 16 * s2 + 4 * h) * 2); \
            const bool full_ = (FULL);                                                                                                      \
            _Pragma("unroll") for (int kh = 0; kh < 2; ++kh) {                                                                              \
              f32x16 sa = fill16(INIT);                                                                                                     \
              _Pragma("unroll") for (int s = 0; s < 4; ++s) sa = MFMA32(kf_[kh][s], qf[s], sa);                                             \
              float pv[16];                                                                                                                 \
              _Pragma("unroll") for (int e = 0; e < 16; ++e) pv[e] = ATT_EXP(sa[e]) * (SCALE);                                              \
              if (!full_) { _Pragma("unroll") for (int e = 0; e < 16; ++e) { const int key = 32 * kh + crow(e, h); pv[e] = (MASKEXPR) ? pv[e] : 0.f; } }     \
              ATT_LSUM(LACC, pv)                                                                                                             \
              IMPHOOK(JJ, kh, pv)                                                                                                           \
              const bf16x8 pk0 = pack8(pv[0], pv[1], pv[2], pv[3], pv[4], pv[5], pv[6], pv[7]);                                             \
              const bf16x8 pk1 = pack8(pv[8], pv[9], pv[10], pv[11], pv[12], pv[13], pv[14], pv[15]);                                       \
              _Pragma("unroll") for (int di = 0; di < 2; ++di) {                                                                            \
                ACC[di] = MFMA32(vf_[kh][di][0], pk0, ACC[di]);                                                                             \
                ACC[di] = MFMA32(vf_[kh][di][1], pk1, ACC[di]);                                                                             \
              }                                                                                                                             \
            }                                                                                                                               \
          }
  const float mbc = qn * kcm;
  int nvalid = (tpos >= 31) ? ((tpos - 31) >> 4) + 1 : 0;
  if (nvalid > 511) nvalid = 511;
  int nvw = (ts + 8 * w + 7 >= 31) ? ((ts + 8 * w + 7 - 31) >> 4) + 1 : 0;
  if (nvw > 511) nvw = 511;
  int nvmin = (ts + 8 * w >= 31) ? ((ts + 8 * w - 31) >> 4) + 1 : 0;
  if (nvmin > 511) nvmin = 511;
  int nvall = ((ts + 63 - 31) >> 4) + 1;
  if (nvall > 511) nvall = 511;
  const int nct = (nvall + 63) >> 6;
  float lsum = 0.f;
#define CMP_NEED(jj) (64 * (jj) < nvw)
#define CMPA_COMPUTE(jj, kb, vbuf)                                                                                                          \
          { _Pragma("unroll") for (int kh = 0; kh < 2; ++kh) {                                                                              \
              f32x16 sa = fill16(-mbc);                                                                                                     \
              _Pragma("unroll") for (int s = 0; s < 4; ++s) sa = MFMA32(*(const bf16x8*)(kb + (32 * kh + r) * KV_ROW + (16 * s + 8 * h) * 2), qf[s], sa); \
              const bool full_ = 64 * (jj) + 64 <= nvmin;                                                                                   \
              if (full_) { _Pragma("unroll") for (int e = 0; e < 16; ++e) lsum += ex2(sa[e]); }                                             \
              else { _Pragma("unroll") for (int e = 0; e < 16; ++e) lsum += (64 * (jj) + 32 * kh + crow(e, h) < nvalid) ? ex2(sa[e]) : 0.f; } \
            } }
  RING_RUN(kcs, 64 * 64, vcs, 64, nct, CMP_NEED, CMPA_COMPUTE)
  lsum += __shfl_xor(lsum, 32);
  const float invl = (lsum > 0.f) ? 1.f / lsum : 0.f;
  f32x16 oc[2]; oc[0] = zero16(); oc[1] = zero16();
  {
    float ldummy = 0.f;
    STAGE_PAIR0(kcs, 64 * 64, vcs, 64, nct) __syncthreads();
#define CMP_IMP(JJ, kh, pv)                                                                                                                 \
              _Pragma("unroll") for (int q = 0; q < 4; ++q) {                                                                               \
                float A_ = 2.f * (pv[4 * q] + pv[4 * q + 1] + pv[4 * q + 2]) + pv[4 * q + 3], B_ = pv[4 * q + 3];                           \
                A_ = quad_sum(A_); B_ = quad_sum(B_);                                                                                       \
                if (hl == 0) { const int j_ = 16 * (JJ) + 8 * kh + 2 * q + h; IMPA[tkl * 128 + j_] = A_; IMPB[tkl * 128 + j_] = B_; }        \
              }
#define CMPB_COMPUTE(jj, kb, vbuf) ATT_TILE(kb, vbuf, -mbc, 64 * (jj) + 64 <= nvmin, 64 * (jj) + key < nvalid, invl, oc, ldummy, CMP_IMP, jj)
    RING_RUN(kcs, 64 * 64, vcs, 64, nct, CMP_NEED, CMPB_COMPUTE)
  }
  for (int rep522 = 0; rep522 < (PROBE_DUP == 522 ? 2 : 1); ++rep522)
  {
    const int tl = 8 * w + (lane >> 3), sub = lane & 7;
    unsigned kv_[16], ki_[16];
#pragma unroll
    for (int c = 0; c < 16; ++c) {
      const int j = sub + 8 * c;
      float imp = IMPA[tl * 128 + j] + ((j > 0) ? IMPB[tl * 128 + j - 1] : 0.f);
      if (j == 0 || j == ti || j == ti - 1) imp = 1e9f;
      kv_[c] = (j <= ti) ? __float_as_uint(imp) : 0u;
      ki_[c] = (j <= ti) ? (unsigned)(128 - j) : 0u;
    }
    unsigned m0 = 0, m1 = 0, m2 = 0, m3 = 0;
    for (int it = 0; it < 16; ++it) {
      unsigned bv = kv_[0], bi = ki_[0];
#pragma unroll
      for (int c = 1; c < 16; ++c) { const bool gt = (kv_[c] > bv) || (kv_[c] == bv && ki_[c] > bi); bv = gt ? kv_[c] : bv; bi = gt ? ki_[c] : bi; }
#define TOPK_STEP(CTRL) { const unsigned ov = (unsigned)__builtin_amdgcn_mov_dpp((int)bv, CTRL, 0xf, 0xf, true), oi = (unsigned)__builtin_amdgcn_mov_dpp((int)bi, CTRL, 0xf, 0xf, true); \
        const bool gt = (ov > bv) || (ov == bv && oi > bi); bv = gt ? ov : bv; bi = gt ? oi : bi; }
      TOPK_STEP(0xB1) TOPK_STEP(0x4E) TOPK_STEP(0x141)
#undef TOPK_STEP
      if (bi != 0u) {
        const int js = 128 - (int)bi;
        const unsigned bit = 1u << (js & 31);
        if ((js >> 5) == 0) m0 |= bit; else if ((js >> 5) == 1) m1 |= bit; else if ((js >> 5) == 2) m2 |= bit; else m3 |= bit;
#pragma unroll
        for (int c = 0; c < 16; ++c) { const bool hit = (ki_[c] == bi); kv_[c] = hit ? 0u : kv_[c]; ki_[c] = hit ? 0u : ki_[c]; }
      }
    }
    if (sub == 0) { SELM[tl * 4 + 0] = m0; SELM[tl * 4 + 1] = m1; SELM[tl * 4 + 2] = m2; SELM[tl * 4 + 3] = m3; }
  }
  if (lane < 4) {
    unsigned u = 0;
#pragma unroll
    for (int t8 = 0; t8 < 8; ++t8) u |= SELM[(8 * w + t8) * 4 + lane];
    SELM[(64 + w) * 4 + lane] = u;
  }
  __syncthreads();
  const float* gt = p.GATE + (size_t)(tokg0 + tkl) * 24 + hd * 3;
  float* OUTL = IMPA;
  {
    const float g0 = gt[0];
#pragma unroll
    for (int e = 0; e < 16; ++e) { OUTL[e * 512 + tid] = g0 * oc[0][e]; OUTL[(16 + e) * 512 + tid] = g0 * oc[1][e]; }
  }
  STAGE_PAIR0(ksrc, 64 * 128, vsrc, 64, ti + 1) __syncthreads();
  const float mbs = qn * ksm;
  f32x16 osl[2]; osl[0] = zero16(); osl[1] = zero16();
  float lsel = 0.f;
#define SEL_NEED(jj) ((SELM[(64 + w) * 4 + ((jj) >> 5)] >> ((jj) & 31)) & 1u)
#define SEL_COMPUTE(jj, kb, vbuf) { const unsigned msel_ = SELM[tkl * 4 + ((jj) >> 5)]; \
      const float init_ = ((msel_ >> ((jj) & 31)) & 1u) ? -mbs : NEG_INF; ATT_TILE(kb, vbuf, init_, (jj) < ti, key <= tkl, 1.f, osl, lsel, IMP_NONE, jj) }
  RING_RUN(ksrc, 64 * 128, vsrc, 64, ti + 1, SEL_NEED, SEL_COMPUTE)
  lsel += __shfl_xor(lsel, 32);
  {
    const float g1 = gt[1] / lsel;
#pragma unroll
    for (int e = 0; e < 16; ++e) { OUTL[e * 512 + tid] += g1 * osl[0][e]; OUTL[(16 + e) * 512 + tid] += g1 * osl[1][e]; }
  }
#if PROBE_DUP >= 530 && PROBE_DUP <= 539
  {
    osl[0] = zero16(); osl[1] = zero16(); lsel = 0.f;
    STAGE_PAIR0(ksrc, 64 * 128, vsrc, 64, ti + 1) __syncthreads();
#if PROBE_DUP == 530
    RING_RUN(ksrc, 64 * 128, vsrc, 64, ti + 1, SEL_NEED, SEL_COMPUTE)
#elif PROBE_DUP == 531
    for (int jj = 0; jj < ti + 1; ++jj) {
      if (SEL_NEED(jj)) { const char* kb = KVB + (jj & 1) * 2 * KV_TILE; const char* vbuf = kb + KV_TILE; SEL_COMPUTE(jj, kb, vbuf) }
      __syncthreads();
    }
#elif PROBE_DUP == 532
    for (int jj = 0; jj < ti + 1; ++jj) {
      uint4 ka_, va_;
      ka_ = va_ = make_uint4(0u, 0u, 0u, 0u);
      if (jj + 1 < ti + 1) { ka_ = *(const uint4*)(ksrc + (size_t)(jj + 1) * (64 * 128)); va_ = *(const uint4*)(vsrc + (size_t)(jj + 1) * 64); }
      if (jj + 1 < ti + 1) { char* d2 = sdst + ((jj + 1) & 1) * 2 * KV_TILE; *(uint4*)d2 = ka_; *(uint4*)(d2 + KV_TILE) = va_; }
      __syncthreads();
    }
#elif PROBE_DUP >= 533
#if PROBE_DUP == 534
#undef ATT_LSUM
#define ATT_LSUM(LACC, pv) LACC += pv[0];
#elif PROBE_DUP == 535
#undef ATT_EXP
#define ATT_EXP(x) (x)
#elif PROBE_DUP == 536
#undef ATT_EXP
#define ATT_EXP(x) (x)
#undef ATT_LSUM
#define ATT_LSUM(LACC, pv) LACC += pv[0];
#endif
    for (int jj = 0; jj < ti + 1; ++jj) {
      if (SEL_NEED(jj)) { const char* kb = KVB + (jj & 1) * 2 * KV_TILE; const char* vbuf = kb + KV_TILE; SEL_COMPUTE(jj, kb, vbuf) }
    }
    __syncthreads();
#endif
#undef ATT_EXP
#undef ATT_LSUM
#define ATT_EXP(x) ex2(x)
#define ATT_LSUM(LACC, pv) LACC += ((pv[0] + pv[1]) + (pv[2] + pv[3])) + ((pv[4] + pv[5]) + (pv[6] + pv[7])) + ((pv[8] + pv[9]) + (pv[10] + pv[11])) + ((pv[12] + pv[13]) + (pv[14] + pv[15]));
    float chk = lsel;
#pragma unroll
    for (int e = 0; e < 16; ++e) chk += osl[0][e] + osl[1][e];
    if (__float_as_uint(chk) == 0x7fc12345u) OUTL[tid] += 1.f;
  }
#endif
  f32x16 ow[2]; ow[0] = zero16(); ow[1] = zero16();
  float lw = 0.f;
  const float mbw = qn * kwm;
  {
    const int j0w = (ti >= 8) ? ti - 8 : 0, nwt = ti - j0w + 1;
    const bf16_t* kws = p.NKW + ((size_t)(b * SEQ + 64 * j0w) + srow) * 128 + g * 64 + sch * 8;
    const bf16_t* vws = p.NVWT + ((size_t)bg * 64 + srow) * SEQ + 64 * j0w + sch * 8;
    STAGE_PAIR0(kws, 64 * 128, vws, 64, nwt) __syncthreads();
#define WIN_NEED(jj) true
#define WIN_COMPUTE(jj, kb, vbuf) { const int jw_ = j0w + (jj); const bool last_ = (jw_ == ti), first_ = (ti >= 8) && ((jj) == 0); \
      ATT_TILE(kb, vbuf, -mbw, !(last_ || first_), last_ ? (key <= tkl) : (key > tkl), 1.f, ow, lw, IMP_NONE, jj) }
    RING_RUN(kws, 64 * 128, vws, 64, nwt, WIN_NEED, WIN_COMPUTE)
  }
  lw += __shfl_xor(lw, 32);
  {
    const float g2 = gt[2] / lw;
#pragma unroll
    for (int di = 0; di < 2; ++di)
#pragma unroll
      for (int g4 = 0; g4 < 4; ++g4) {
        const int d0 = 32 * di + 8 * g4 + 4 * h;
        float y[4];
#pragma unroll
        for (int e = 0; e < 4; ++e) y[e] = OUTL[(16 * di + 4 * g4 + e) * 512 + tid] + g2 * ow[di][4 * g4 + e];
        *(uint2*)(p.RA + (size_t)(tokg0 + tkl) * DM + 512 + hd * 64 + d0) = pack4(y[0], y[1], y[2], y[3]);
      }
  }
  __syncthreads();
}

typedef float f32x4 __attribute__((ext_vector_type(4)));
#define MFMA16(a, b, c) __builtin_amdgcn_mfma_f32_16x16x32_bf16((a), (b), (c), 0, 0, 0)
constexpr int pk_clen(int i) { return 16 / (i + 1); }
constexpr int pk_coff(int i) { int s = 0; for (int q = 0; q < i; ++q) s += pk_clen(q); return s; }
constexpr int pk_cand(int c) {
  int i = 0; while (i < 16 && c >= pk_clen(i)) { c -= pk_clen(i); ++i; }
  return (i < 16) ? i * 16 + c : 256;
}
#define SC_STRIDE 132

DI void convert_row(const Params& p, int row, int lane);
DI unsigned f2key(float x, unsigned tag, unsigned tagmask) {
  const unsigned bits = __float_as_uint(x), m = (unsigned)((int)bits >> 31) | 0x80000000u;
  return ((bits ^ m) & ~tagmask) | tag;
}
DI float key2f(unsigned k, unsigned tagmask) {
  const unsigned u = k & ~tagmask;
  return __uint_as_float((u & 0x80000000u) ? (u ^ 0x80000000u) : ~u);
}
DI void peer_topk_tile(const Params& p, int vb, char* smem) {
  unsigned* SC = (unsigned*)smem;
  unsigned* ELK = (unsigned*)(smem + 256 * SC_STRIDE * 4);
  float* ELW = (float*)(ELK + 16 * 128);
  int* CT = (int*)(ELW + 16 * 128);
  const int tid = mytid(), lane = tid & 63, w = tid >> 6;
  const int t0 = vb * 16;
  if (tid < 64) { int i = 0, c = tid; while (i < 16 && c >= 16 / (i + 1)) { c -= 16 / (i + 1); ++i; } CT[tid] = (i < 16) ? i * 16 + c : 0; }
  for (int rep91 = 0; rep91 < (PROBE_DUP == 91 ? 2 : 1); ++rep91) {
    const int tq = lane & 15, kq = lane >> 4;
#pragma unroll
    for (int pi = 0; pi < 2; ++pi) {
      const int ph = 2 * w + pi;
      bf16x8 bfr[4];
#pragma unroll
      for (int s = 0; s < 4; ++s) bfr[s] = *(const bf16x8*)(p.PQ + (size_t)(t0 + tq) * 2048 + ph * 128 + 32 * s + 8 * kq);
#pragma unroll
      for (int j = 0; j < 8; ++j) {
        f32x4 acc = {0.f, 0.f, 0.f, 0.f};
#pragma unroll
        for (int s = 0; s < 4; ++s) {
          bf16x8 afr = *(const bf16x8*)(p.SUBK + ((size_t)(ph * 128 + 16 * j + tq)) * 128 + 32 * s + 8 * kq);
          acc = MFMA16(afr, bfr[s], acc);
        }
        const int n0 = 16 * j + 4 * kq;
        uint4 kv4;
        kv4.x = f2key(acc[0], 127u - n0, 127u); kv4.y = f2key(acc[1], 126u - n0, 127u); kv4.z = f2key(acc[2], 125u - n0, 127u); kv4.w = f2key(acc[3], 124u - n0, 127u);
        *(uint4*)(SC + (ph * 16 + tq) * SC_STRIDE + n0) = kv4;
      }
    }
  }
  __syncthreads();
  if (tid < 256) {
    unsigned* row = SC + tid * SC_STRIDE;
    unsigned gmax[16];
#pragma unroll
    for (int g = 0; g < 16; ++g) {
      uint4 a = *(uint4*)(row + g * 8), b = *(uint4*)(row + g * 8 + 4);
      gmax[g] = max(max(max(a.x, a.y), max(a.z, a.w)), max(max(b.x, b.y), max(b.z, b.w)));
    }
    unsigned outk[16];
#pragma unroll
    for (int k = 0; k < 16; ++k) {
      unsigned m = max(max(max(max(gmax[0], gmax[1]), max(gmax[2], gmax[3])), max(max(gmax[4], gmax[5]), max(gmax[6], gmax[7]))),
                       max(max(max(gmax[8], gmax[9]), max(gmax[10], gmax[11])), max(max(gmax[12], gmax[13]), max(gmax[14], gmax[15]))));
      const int n = 127 - (int)(m & 127u), gi = n >> 3;
      unsigned* gp = row + gi * 8;
      uint4 a = *(uint4*)gp, b = *(uint4*)(gp + 4);
      const unsigned v[8] = {a.x, a.y, a.z, a.w, b.x, b.y, b.z, b.w};
      unsigned nm = 0u;
#pragma unroll
      for (int e = 0; e < 8; ++e) nm = max(nm, (v[e] == m) ? 0u : v[e]);
      row[n] = 0u;
#pragma unroll
      for (int g = 0; g < 16; ++g) gmax[g] = (g == gi) ? nm : gmax[g];
      outk[k] = m;
    }
#pragma unroll
    for (int k = 0; k < 16; ++k) row[k] = outk[k];
  } else {
#pragma unroll
    for (int i = 0; i < 4; ++i) convert_row(p, (vb * 4 + (w - 4)) * 8 + 2 * i, lane);
  }
  __syncthreads();
  for (int rep93 = 0; rep93 < (PROBE_DUP == 93 ? 2 : 1); ++rep93) {
    const int q = tid >> 2, sub = tid & 3, t = q >> 3, pp = q & 7;
    const unsigned* ra = SC + ((2 * pp) * 16 + t) * SC_STRIDE;
    const unsigned* rb = SC + ((2 * pp + 1) * 16 + t) * SC_STRIDE;
    unsigned ck[13];
#pragma unroll
    for (int k = 0; k < 13; ++k) {
      const int ij = (sub == 0) ? pk_cand(4 * k) : (sub == 1) ? pk_cand(4 * k + 1) : (sub == 2) ? pk_cand(4 * k + 2) : pk_cand(4 * k + 3);
      const int ord = 4 * k + sub;
      ck[k] = (ij < 256) ? f2key(key2f(ra[ij >> 4], 127u) + key2f(rb[ij & 15], 127u), (unsigned)(63 - ord), 63u) : 0u;
    }
    unsigned w16[16];
#pragma unroll
    for (int k = 0; k < 16; ++k) {
      unsigned bm = max(max(max(max(ck[0], ck[1]), max(ck[2], ck[3])), max(max(ck[4], ck[5]), max(ck[6], ck[7]))), max(max(max(ck[8], ck[9]), max(ck[10], ck[11])), ck[12]));
      bm = max(bm, (unsigned)__builtin_amdgcn_mov_dpp((int)bm, 0xB1, 0xf, 0xf, true));
      bm = max(bm, (unsigned)__builtin_amdgcn_mov_dpp((int)bm, 0x4E, 0xf, 0xf, true));
#pragma unroll
      for (int c = 0; c < 13; ++c) ck[c] = (ck[c] == bm) ? 0u : ck[c];
      w16[k] = bm;
    }
    float l = 0.f; const float vmax = key2f(w16[0], 63u);
    float ev[16];
#pragma unroll
    for (int k = 0; k < 16; ++k) { ev[k] = __expf(key2f(w16[k], 63u) - vmax); l += ev[k]; }
    const float inv = 1.f / l;
#pragma unroll
    for (int k = 0; k < 16; ++k)
      if ((k & 3) == sub) {
        const int ij = CT[63 - (int)(w16[k] & 63u)];
        const int code = (127 - (int)(ra[ij >> 4] & 127u)) * 128 + (127 - (int)(rb[ij & 15] & 127u));
        ELK[t * 128 + pp * 16 + k] = ((unsigned)code << 7) | (unsigned)(pp * 16 + k);
        ELW[t * 128 + pp * 16 + k] = ev[k] * inv;
      }
  }
  __syncthreads();
  for (int rep94 = 0; rep94 < (PROBE_DUP == 94 ? 2 : 1); ++rep94)
#pragma unroll
  for (int tt = 0; tt < 2; ++tt) {
    const int t = 2 * w + tt;
    const unsigned e0 = ELK[t * 128 + 2 * lane], e1 = ELK[t * 128 + 2 * lane + 1];
    int r0 = 0, r1 = 0;
#pragma unroll 8
    for (int c = 0; c < 32; ++c) {
      const uint4 kq = *(const uint4*)(ELK + t * 128 + 4 * c);
      r0 += (kq.x < e0) + (kq.y < e0) + (kq.z < e0) + (kq.w < e0);
      r1 += (kq.x < e1) + (kq.y < e1) + (kq.z < e1) + (kq.w < e1);
    }
    const size_t gb = (size_t)(t0 + t) * 128;
    p.EIDX[gb + r0] = (int)(e0 >> 7); p.EIDX[gb + r1] = (int)(e1 >> 7);
    p.EW[gb + r0] = ELW[t * 128 + (e0 & 127)]; p.EW[gb + r1] = ELW[t * 128 + (e1 & 127)];
  }
  __syncthreads();
}

DI float dot2bf(unsigned a, unsigned b, float acc) { return __builtin_amdgcn_fdot2_f32_bf16(__builtin_bit_cast(bf16x2_t, a), __builtin_bit_cast(bf16x2_t, b), acc, false); }
template <int CTRL> DI float dpp_f(float x) { return __builtin_bit_cast(float, __builtin_amdgcn_mov_dpp(__builtin_bit_cast(int, x), CTRL, 0xf, 0xf, true)); }
DI float row16_sum(float v) { v += dpp_f<0x128>(v); v += dpp_f<0x124>(v); v += dpp_f<0x122>(v); v += dpp_f<0x121>(v); return v; }
DI float dot_row(const uint4 (&u)[8], const uint4 (&h)[8]) {
  float d = 0.f;
#pragma unroll
  for (int j = 0; j < 8; ++j) { d = dot2bf(u[j].x, h[j].x, d); d = dot2bf(u[j].y, h[j].y, d); d = dot2bf(u[j].z, h[j].z, d); d = dot2bf(u[j].w, h[j].w, d); }
  return row16_sum(d);
}
DI void axpy_row(float (&acc)[64], const uint4 (&v)[8], float c) {
#pragma unroll
  for (int j = 0; j < 8; ++j) {
    const unsigned ww[4] = {v[j].x, v[j].y, v[j].z, v[j].w};
#pragma unroll
    for (int q = 0; q < 4; ++q) {
      acc[j * 8 + 2 * q] += c * __uint_as_float(ww[q] << 16);
      acc[j * 8 + 2 * q + 1] += c * __uint_as_float(ww[q] & 0xffff0000u);
    }
  }
}
DI void axpy_half(float (&acc)[32], const uint4 (&v)[4], float c) {
#pragma unroll
  for (int j = 0; j < 4; ++j) {
    const unsigned ww[4] = {v[j].x, v[j].y, v[j].z, v[j].w};
#pragma unroll
    for (int q = 0; q < 4; ++q) {
      acc[j * 8 + 2 * q] += c * __uint_as_float(ww[q] << 16);
      acc[j * 8 + 2 * q + 1] += c * __uint_as_float(ww[q] & 0xffff0000u);
    }
  }
}
#ifndef PEER_TILE_SHIFT
#define PEER_TILE_SHIFT 8
#endif
DI void fma16_fp8(float& d, const uint4& u, const float* hv) {
  const unsigned ww[4] = {u.x, u.y, u.z, u.w};
#pragma unroll
  for (int q = 0; q < 4; ++q) {
    f32x2_t a = __builtin_amdgcn_cvt_pk_f32_fp8((int)ww[q], false), b = __builtin_amdgcn_cvt_pk_f32_fp8((int)ww[q], true);
    d += a[0] * hv[4 * q] + a[1] * hv[4 * q + 1] + b[0] * hv[4 * q + 2] + b[1] * hv[4 * q + 3];
  }
}
DI float dot_row8(const uint4 (&u)[4], const float (&hv)[64]) {
  float d0 = 0.f, d1 = 0.f;
  fma16_fp8(d0, u[0], hv); fma16_fp8(d1, u[1], hv + 16); fma16_fp8(d0, u[2], hv + 32); fma16_fp8(d1, u[3], hv + 48);
  return row16_sum(d0 + d1);
}
DI void axpy_row8(float (&acc)[64], const uint4 (&v)[4], float c) {
#pragma unroll
  for (int j = 0; j < 4; ++j) {
    const unsigned ww[4] = {v[j].x, v[j].y, v[j].z, v[j].w};
#pragma unroll
    for (int q = 0; q < 4; ++q) {
      f32x2_t a = __builtin_amdgcn_cvt_pk_f32_fp8((int)ww[q], false), b = __builtin_amdgcn_cvt_pk_f32_fp8((int)ww[q], true);
      acc[j * 16 + 4 * q] += c * a[0]; acc[j * 16 + 4 * q + 1] += c * a[1]; acc[j * 16 + 4 * q + 2] += c * b[0]; acc[j * 16 + 4 * q + 3] += c * b[1];
    }
  }
}
typedef float f32x32_t __attribute__((ext_vector_type(32)));
typedef float f32x16_t __attribute__((ext_vector_type(16)));
typedef unsigned u32x6_t __attribute__((ext_vector_type(6)));
#define ROW6_BYTES 768
DI float dot_row6(const uint4 (&u)[3], const float (&hv)[64]) {
  u32x6_t pa, pb;
  pa[0] = u[0].x; pa[1] = u[0].y; pa[2] = u[0].z; pa[3] = u[0].w; pa[4] = u[1].x; pa[5] = u[1].y;
  pb[0] = u[1].z; pb[1] = u[1].w; pb[2] = u[2].x; pb[3] = u[2].y; pb[4] = u[2].z; pb[5] = u[2].w;
  float d0 = 0.f, d1 = 0.f;
  {
    const f32x32_t fa = __builtin_amdgcn_cvt_scalef32_pk32_f32_fp6(pa, 1.0f);
#pragma unroll
    for (int k = 0; k < 32; k += 2) { d0 += fa[k] * hv[k]; d1 += fa[k + 1] * hv[k + 1]; }
  }
  {
    const f32x32_t fb = __builtin_amdgcn_cvt_scalef32_pk32_f32_fp6(pb, 1.0f);
#pragma unroll
    for (int k = 0; k < 32; k += 2) { d0 += fb[k] * hv[32 + k]; d1 += fb[k + 1] * hv[32 + k + 1]; }
  }
  return row16_sum(d0 + d1);
}
DI void axpy_row6(float (&acc)[64], const uint4 (&v)[3], float c) {
  u32x6_t pa, pb;
  pa[0] = v[0].x; pa[1] = v[0].y; pa[2] = v[0].z; pa[3] = v[0].w; pa[4] = v[1].x; pa[5] = v[1].y;
  pb[0] = v[1].z; pb[1] = v[1].w; pb[2] = v[2].x; pb[3] = v[2].y; pb[4] = v[2].z; pb[5] = v[2].w;
  {
    const f32x32_t fa = __builtin_amdgcn_cvt_scalef32_pk32_f32_fp6(pa, 1.0f);
#pragma unroll
    for (int k = 0; k < 32; ++k) acc[k] += c * fa[k];
  }
  {
    const f32x32_t fb = __builtin_amdgcn_cvt_scalef32_pk32_f32_fp6(pb, 1.0f);
#pragma unroll
    for (int k = 0; k < 32; ++k) acc[32 + k] += c * fb[k];
  }
}
DI void peer_gather_block(const Params& p, int vb, char* smem) {
  unsigned* ELK = (unsigned*)smem;
  float* ELC = (float*)(smem + 32768);
  const int tid = mytid(), lane = tid & 63, w = tid >> 6, grp = lane >> 4, i = lane & 15;
  const int tokbase = vb * 64;
  float* ELS = (float*)(smem + 65536);
  for (int q = tid; q < 64 * 128 / 4; q += NT) {
    const uint4 k4 = ((const uint4*)(p.EIDX + (size_t)tokbase * 128))[q];
    float4 w4 = ((const float4*)(p.EW + (size_t)tokbase * 128))[q];
    ((uint4*)ELK)[q] = k4;
    w4.x *= p.SUP[k4.x]; w4.y *= p.SUP[k4.y]; w4.z *= p.SUP[k4.z]; w4.w *= p.SUP[k4.w];
    ((float4*)ELC)[q] = w4;
    ((float4*)ELS)[q] = make_float4(p.SDN[k4.x], p.SDN[k4.y], p.SDN[k4.z], p.SDN[k4.w]);
  }
  __syncthreads();
#pragma unroll 1
  for (int tt = 0; tt < 2; ++tt) {
    const int tl = w * 8 + grp * 2 + tt, tok = tokbase + tl;
    const unsigned* kk = ELK + tl * 128;
    float* cc = ELC + tl * 128;
    const float* sdn = ELS + tl * 128;
    uint4 b0[3], b1[3], b2[3], b3[3];
#define ROW_LOAD(BUF, BASE, E) { const unsigned e_ = kk[E]; _Pragma("unroll") for (int j = 0; j < 3; ++j) BUF[j] = *(const uint4*)(BASE + (size_t)e_ * ROW6_BYTES + j * 256); }
    {
      float hv[64];
#pragma unroll
      for (int j = 0; j < 4; ++j)
#pragma unroll
        for (int hf = 0; hf < 2; ++hf) {
          uint4 a = *(const uint4*)(p.RA + (size_t)tok * DM + j * 256 + i * 16 + hf * 8);
          const unsigned aa[4] = {a.x, a.y, a.z, a.w};
#pragma unroll
          for (int q = 0; q < 4; ++q) { hv[j * 16 + hf * 8 + 2 * q] = __uint_as_float(aa[q] << 16); hv[j * 16 + hf * 8 + 2 * q + 1] = __uint_as_float(aa[q] & 0xffff0000u); }
        }
      const unsigned char* ub_ = p.PDN8 + i * 16;
#define DN_COMP(BUF, E) { float d_ = dot_row6(BUF, hv) * sdn[E]; float c_ = cc[E] * gelu_tanh(d_); if (i == 0) cc[E] = c_; }
      ROW_LOAD(b0, ub_, 0) ROW_LOAD(b1, ub_, 1) ROW_LOAD(b2, ub_, 2) ROW_LOAD(b3, ub_, 3)
      for (int e = 0; e < 128; e += 4) {
        DN_COMP(b0, e)     if (e + 4 < 128) ROW_LOAD(b0, ub_, e + 4)
        DN_COMP(b1, e + 1) if (e + 4 < 128) ROW_LOAD(b1, ub_, e + 5)
        DN_COMP(b2, e + 2) if (e + 4 < 128) ROW_LOAD(b2, ub_, e + 6)
        DN_COMP(b3, e + 3) if (e + 4 < 128) ROW_LOAD(b3, ub_, e + 7)
      }
#undef DN_COMP
#if PROBE_DUP >= 101 && PROBE_DUP <= 103
      {
        float chk = 0.f; unsigned xk = 0u;
#define DN_PROBE(BUF, E) { float d_ = dot_row6(BUF, hv) * sdn[E]; chk += cc[E] * gelu_tanh(d_); }
#define DN_XOR(BUF, E) { xk ^= BUF[0].x ^ BUF[0].y ^ BUF[0].z ^ BUF[0].w ^ BUF[1].x ^ BUF[1].y ^ BUF[1].z ^ BUF[1].w ^ BUF[2].x ^ BUF[2].y ^ BUF[2].z ^ BUF[2].w; }
        ROW_LOAD(b0, ub_, 0) ROW_LOAD(b1, ub_, 1) ROW_LOAD(b2, ub_, 2) ROW_LOAD(b3, ub_, 3)
        for (int e = 0; e < 128; e += 4) {
#if PROBE_DUP == 101
          DN_PROBE(b0, e)     if (e + 4 < 128) ROW_LOAD(b0, ub_, e + 4)
          DN_PROBE(b1, e + 1) if (e + 4 < 128) ROW_LOAD(b1, ub_, e + 5)
          DN_PROBE(b2, e + 2) if (e + 4 < 128) ROW_LOAD(b2, ub_, e + 6)
          DN_PROBE(b3, e + 3) if (e + 4 < 128) ROW_LOAD(b3, ub_, e + 7)
#elif PROBE_DUP == 102
          DN_XOR(b0, e)     if (e + 4 < 128) ROW_LOAD(b0, ub_, e + 4)
          DN_XOR(b1, e + 1) if (e + 4 < 128) ROW_LOAD(b1, ub_, e + 5)
          DN_XOR(b2, e + 2) if (e + 4 < 128) ROW_LOAD(b2, ub_, e + 6)
          DN_XOR(b3, e + 3) if (e + 4 < 128) ROW_LOAD(b3, ub_, e + 7)
#else
          DN_PROBE(b0, e) DN_PROBE(b1, e + 1) DN_PROBE(b2, e + 2) DN_PROBE(b3, e + 3)
          b0[0].x ^= __float_as_uint(chk) & 1u;
#endif
        }
        if (__float_as_uint(chk) == 0x7fc12345u || xk == 0x9e3779b9u) cc[0] += 1.f;
#undef DN_PROBE
#undef DN_XOR
      }
#endif
    }
    {
      float acc[64];
#pragma unroll
      for (int e = 0; e < 64; ++e) acc[e] = 0.f;
      const unsigned char* vbase = p.PUP8 + i * 16;
      ROW_LOAD(b0, vbase, 0) ROW_LOAD(b1, vbase, 1) ROW_LOAD(b2, vbase, 2) ROW_LOAD(b3, vbase, 3)
      for (int e = 0; e < 128; e += 4) {
        axpy_row6(acc, b0, cc[e]);     if (e + 4 < 128) ROW_LOAD(b0, vbase, e + 4)
        axpy_row6(acc, b1, cc[e + 1]); if (e + 4 < 128) ROW_LOAD(b1, vbase, e + 5)
        axpy_row6(acc, b2, cc[e + 2]); if (e + 4 < 128) ROW_LOAD(b2, vbase, e + 6)
        axpy_row6(acc, b3, cc[e + 3]); if (e + 4 < 128) ROW_LOAD(b3, vbase, e + 7)
      }
      const int b = tok >> 13;
      const float* ga2 = p.mod + b * 6144 + 5120;
      const float* orow = p.out + (size_t)tok * DM; float* grow = p.gout + (size_t)tok * DM;
      float ss = 0.f;
#pragma unroll
      for (int j = 0; j < 4; ++j)
#pragma unroll
        for (int q4 = 0; q4 < 4; ++q4) {
          const int col = j * 256 + i * 16 + q4 * 4;
          float4 x1 = *(const float4*)(orow + col), gg = *(const float4*)(ga2 + col);
          float* q = acc + j * 16 + q4 * 4;
          q[0] = x1.x + gg.x * q[0]; q[1] = x1.y + gg.y * q[1]; q[2] = x1.z + gg.z * q[2]; q[3] = x1.w + gg.w * q[3];
          ss += q[0] * q[0] + q[1] * q[1] + q[2] * q[2] + q[3] * q[3];
        }
      ss = row16_sum(ss);
      const float rstd = rsqrtf(ss * (1.f / DM) + 1e-6f);
#pragma unroll
      for (int j = 0; j < 4; ++j)
#pragma unroll
        for (int q4 = 0; q4 < 4; ++q4) {
          const int col = j * 256 + i * 16 + q4 * 4;
          float4 gf = *(const float4*)(p.g_final + col);
          const float* q = acc + j * 16 + q4 * 4;
          *(float4*)(grow + col) = make_float4(q[0] * rstd * gf.x, q[1] * rstd * gf.y, q[2] * rstd * gf.z, q[3] * rstd * gf.w);
        }
    }
#undef ROW_LOAD
  }
  __syncthreads();
}
DI void convert_row(const Params& p, int row2, int lane) {
  const int row = row2 + (lane >> 5), L = lane & 31, i = L >> 1, gsel = L & 1;
  const int tb = row >> 14, rr = row & 16383;
  const float* src = (tb ? p.peer_up : p.peer_down) + (size_t)rr * DM + gsel * 512 + i * 16;
  float4 xa[4], xb[4]; float am = 0.f;
#pragma unroll
  for (int q = 0; q < 4; ++q) {
    xa[q] = *(const float4*)(src + q * 4); xb[q] = *(const float4*)(src + 256 + q * 4);
    am = fmaxf(am, fmaxf(fmaxf(fabsf(xa[q].x), fabsf(xa[q].y)), fmaxf(fabsf(xa[q].z), fabsf(xa[q].w))));
    am = fmaxf(am, fmaxf(fmaxf(fabsf(xb[q].x), fabsf(xb[q].y)), fmaxf(fabsf(xb[q].z), fabsf(xb[q].w))));
  }
  for (int o = 16; o; o >>= 1) am = fmaxf(am, __shfl_xor(am, o));
  const float sc = (am > 0.f) ? am * (1.f / 7.5f) : 1.f, inv = (am > 0.f) ? 7.5f / am : 1.f;
  f32x16_t va, vb;
  {
    float X[32];
#pragma unroll
    for (int q = 0; q < 4; ++q) {
      X[4 * q] = xa[q].x * inv; X[4 * q + 1] = xa[q].y * inv; X[4 * q + 2] = xa[q].z * inv; X[4 * q + 3] = xa[q].w * inv;
      X[16 + 4 * q] = xb[q].x * inv; X[16 + 4 * q + 1] = xb[q].y * inv; X[16 + 4 * q + 2] = xb[q].z * inv; X[16 + 4 * q + 3] = xb[q].w * inv;
    }
#pragma unroll
    for (int k = 0; k < 16; ++k) { va[k] = X[2 * k]; vb[k] = X[2 * k + 1]; }
  }
  const u32x6_t pk = __builtin_amdgcn_cvt_scalef32_2xpk16_fp6_f32(va, vb, 1.0f);
  unsigned char* dst = (tb ? p.PUP8 : p.PDN8) + (size_t)rr * ROW6_BYTES + i * 16;
#pragma unroll
  for (int d = 0; d < 6; ++d) { const int dd = 6 * gsel + d; *(unsigned*)(dst + (dd >> 2) * 256 + (dd & 3) * 4) = pk[d]; }
  if (L == 0) (tb ? p.SUP : p.SDN)[rr] = sc;
}

#define N_PHASES 11
template <int PH>
DI void run_phase(const Params& p, char* smem) {
  const int nb = gridDim.x, bid = blockIdx.x, tid = mytid();
  if (PH == 0) {
    for (int vb = bid; vb < PH0_MOD; vb += nb) ph0_body(p, vb, smem);
  } else if (PH == 1) {
    constexpr int kPrepA = (PH0_WIN - PH0_MOD) + (PH0_ROPE - PH0_SUBK);
    for (int vb = bid; vb < T_TOK / 8 + kPrepA; vb += nb) {
      if (vb < T_TOK / 8) rownorm_body(p.x, p.g_mix, p.mod, 0, 1024, p.RA, vb);
      else { const int j = vb - T_TOK / 8; ph0_body(p, (j < PH0_WIN - PH0_MOD) ? PH0_MOD + j : PH0_SUBK + (j - (PH0_WIN - PH0_MOD)), smem); }
    }
  } else if (PH == 2) {
    {
      pg8::StaticOrder S; S.init(T_TOK, NPROJ, nb, bid);
      const pg8::Gemm g{p.RA, p.WinT, T_TOK, NPROJ, 1024};
      pg8::gemm_phase((PG8_LAS unsigned char*)smem, g, S, EpiProj8{p});
    }
    {
      constexpr int kPrepB = (PH0_W2V - PH0_WQ) + (PH0_B1P - PH0_ROPE);
      const int rem = (64 * 14) % nb;
      if (rem == 0 || bid >= rem) {
        for (int j = (rem == 0) ? bid : bid - rem; j < kPrepB; j += (rem == 0) ? nb : nb - rem)
          ph0_body(p, (j < PH0_W2V - PH0_WQ) ? PH0_WQ + j : PH0_ROPE + (j - (PH0_W2V - PH0_WQ)), smem);
      }
    }
  } else if (PH == 3) {
    for (int vb = bid; vb < 256 + 512 + 64; vb += nb) {
      if (vb < 256) compress_mfma(p, vb, smem);
      else if (vb < 256 + 512) retkv_mfma(p, vb - 256);
      else kmax_body2(p, vb - 768);
    }
  } else if (PH == 4) {
    constexpr int kPrepC = (PH0_WQ - PH0_WIN) + (PH0_SUBK - PH0_W2V);
    for (int vb = bid; vb < 256 + 4 + kPrepC; vb += nb) {
      if (vb < 256) scan_body(p, vb * NT + tid);
      else if (vb < 260) kcmax_body(p, (vb - 256) * NT + tid);
      else { const int j = vb - 260; ph0_body(p, (j < PH0_WQ - PH0_WIN) ? PH0_WIN + j : PH0_W2V + (j - (PH0_WQ - PH0_WIN)), smem); }
    }
  } else if (PH == 5) {
    for (int rep = 0; rep < (PROBE_DUP == 51 ? 2 : 1); ++rep)
      for (int vb = bid; vb < 256; vb += nb) retout_mfma(p, vb * 8 + (tid >> 6));
    for (int rep = 0; rep < (PROBE_DUP == 52 ? 2 : 1); ++rep)
      for (int vb = bid; vb < 512; vb += nb) nsa_item(p, (vb < 256) ? vb : 767 - vb, smem);
  } else if (PH == 6) {
    pg8::StaticOrder S; S.init(T_TOK, 1024, nb, bid);
    const pg8::Gemm g{p.RA, p.WoutT, T_TOK, 1024, 1024};
    pg8::gemm_phase((PG8_LAS unsigned char*)smem, g, S, EpiOut8{p.x, p.out, p.mod});
  } else if (PH == 7) {
    for (int vb = bid; vb < T_TOK / 8; vb += nb) rownorm_body(p.out, p.g_ffn, p.mod, 3072, 4096, p.RA, vb);
  } else if (PH == 8) {
    pg8::StaticOrder S; S.init(T_TOK, 2048, nb, bid);
    const pg8::Gemm g{p.RA, p.WqT, T_TOK, 2048, 1024};
    pg8::gemm_phase((PG8_LAS unsigned char*)smem, g, S, EpiPQ8{p.PQ});
  } else if (PH == 9) {
    for (int vb = bid; vb < T_TOK / 16; vb += nb) peer_topk_tile(p, vb, smem);
  } else if (PH == 10) {
    for (int vb = bid; vb < T_TOK / 64; vb += nb) peer_gather_block(p, vb, smem);
  }
}


#define XB_TMO      128
#define XB_XCNT(j)  (256  + 64 * (j))
#define XB_XSUB(j)  (1280 + 64 * (j))
#define XB_XGEN(j)  (2304 + 64 * (j))
#define XB_TOP      3328
#define XB_TOPGEN   3392
#define XCD_BAR_WORDS 3456
#define XB_SPIN_CAP (1u << 22)
#define LAS __attribute__((address_space(3)))
DI unsigned xb_ld(unsigned* p) { return __hip_atomic_load(p, __ATOMIC_RELAXED, __HIP_MEMORY_SCOPE_AGENT); }
DI unsigned xb_add(unsigned* p, unsigned v) { return __hip_atomic_fetch_add(p, v, __ATOMIC_RELAXED, __HIP_MEMORY_SCOPE_AGENT); }
DI unsigned xb_xcc_id() { return (unsigned)__builtin_amdgcn_s_getreg((3 << 11) | 20) & 0xFu; }
#define XB_SPIN(cond, bar) do { unsigned _sp = 0; while (cond) { __builtin_amdgcn_s_sleep(1); \
    if ((++_sp & 255u) == 0u) { if (xb_ld(&(bar)[XB_TMO])) break; if (_sp > XB_SPIN_CAP) { atomicAdd(&(bar)[XB_TMO], 1u); break; } } } } while (0)
struct XcdBarrier { unsigned* bar; unsigned x; volatile LAS unsigned* st; };
DI XcdBarrier xcd_barrier_post(unsigned* bar, volatile LAS unsigned* st) {
  XcdBarrier b; b.bar = bar; b.x = xb_xcc_id(); b.st = st;
  if (threadIdx.x == 0) (void)xb_add(&bar[XB_XCNT(b.x)], 1u);
  return b;
}
DI void xcd_barrier_complete(unsigned* bar, unsigned x, unsigned& nloc, unsigned& nx) {
  const unsigned G = gridDim.x * gridDim.y * gridDim.z;
  unsigned sum, cnt, mine, sp = 0u;
  for (;;) {
    sum = 0u; cnt = 0u; mine = 0u;
#pragma unroll
    for (unsigned j = 0; j < 16; ++j) { const unsigned c = xb_ld(&bar[XB_XCNT(j)]); sum += c; cnt += (c > 0u) ? 1u : 0u; mine = (j == x) ? c : mine; }
    if (sum == G) break;
    __builtin_amdgcn_s_sleep(1);
    if ((++sp & 255u) == 0u) { if (xb_ld(&bar[XB_TMO])) break; if (sp > XB_SPIN_CAP) { atomicAdd(&bar[XB_TMO], 1u); break; } }
  }
  nloc = mine > 0u ? mine : 1u; nx = cnt > 0u ? cnt : 1u;
}
DI void xcd_barrier(const XcdBarrier& b) {
  asm volatile("s_waitcnt vmcnt(0)" ::: "memory");
  __syncthreads();
  if (threadIdx.x == 0) {
    unsigned* bar = b.bar;
    __builtin_amdgcn_s_waitcnt(0);
    unsigned nloc = b.st[0], nx = b.st[1];
    if (nloc == 0u) { xcd_barrier_complete(bar, b.x, nloc, nx); b.st[0] = nloc; b.st[1] = nx; }
    const unsigned old = xb_add(&bar[XB_XSUB(b.x)], 1u);
    const unsigned gen = old / nloc;
    if (old + 1u == (gen + 1u) * nloc) {
      __builtin_amdgcn_fence(__ATOMIC_RELEASE, "agent");
      asm volatile("s_waitcnt vmcnt(0)" ::: "memory");
      const unsigned og = xb_add(&bar[XB_TOP], 1u);
      const unsigned tg = og / nx;
      if (og + 1u == (tg + 1u) * nx) xb_add(&bar[XB_TOPGEN], 1u);
      else XB_SPIN(xb_ld(&bar[XB_TOPGEN]) == tg, bar);
      __builtin_amdgcn_fence(__ATOMIC_ACQUIRE, "agent");
      xb_add(&bar[XB_XGEN(b.x)], 1u);
      asm volatile("s_waitcnt vmcnt(0)" ::: "memory");
    } else {
      XB_SPIN(xb_ld(&bar[XB_XGEN(b.x)]) == gen, bar);
      __builtin_amdgcn_fence(__ATOMIC_ACQUIRE, "agent");
      asm volatile("s_waitcnt vmcnt(0)" ::: "memory");
    }
  }
  __syncthreads();
}

#define SMEM_BYTES 155648

template <int PH>
DI void phase_and_probe(const Params& p, char* smem, cg::grid_group& grid) {
  const int reps = (PROBE_DUP == PH) ? 2 : 1;
  for (int rep = 0; rep < reps; ++rep) {
    if (PH == 10 && rep + 1 < reps) { Params q = p; q.gout = (float*)p.PQ; run_phase<PH>(q, smem); }
    else run_phase<PH>(p, smem);
    if (rep + 1 < reps) grid.sync();
  }
}
__global__ void __launch_bounds__(NT) k_mega(Params p) {
  extern __shared__ __attribute__((aligned(16))) char smem[];
  __shared__ uint4 xb_words;
  cg::grid_group grid = cg::this_grid();
  if (threadIdx.x == 0) xb_words = make_uint4(0u, 0u, 0u, 0u);
  __syncthreads();
  XcdBarrier xb = xcd_barrier_post(p.xbar, (volatile LAS unsigned*)&xb_words);
  phase_and_probe<0>(p, smem, grid); grid.sync();
  phase_and_probe<1>(p, smem, grid); xcd_barrier(xb);
  phase_and_probe<2>(p, smem, grid); xcd_barrier(xb);
  phase_and_probe<3>(p, smem, grid); xcd_barrier(xb);
  phase_and_probe<4>(p, smem, grid); xcd_barrier(xb);
  phase_and_probe<5>(p, smem, grid); xcd_barrier(xb);
  phase_and_probe<6>(p, smem, grid); xcd_barrier(xb);
  phase_and_probe<7>(p, smem, grid); xcd_barrier(xb);
  phase_and_probe<8>(p, smem, grid); xcd_barrier(xb);
  phase_and_probe<9>(p, smem, grid); xcd_barrier(xb);
  phase_and_probe<10>(p, smem, grid);
}
#ifdef MK_MULTI
template <int PH>
__global__ void __launch_bounds__(NT) k_single(Params p) {
  extern __shared__ __attribute__((aligned(16))) char smem[];
  run_phase<PH>(p, smem);
}
#endif

static size_t carve(size_t& off, size_t bytes) { size_t o = off; off += (bytes + 255) & ~(size_t)255; return o; }

extern "C" void kernel_launch(void* const* d_in, const int* in_sizes, int n_in, void* d_out, int out_size, void* d_ws, size_t ws_size,
                              hipStream_t stream) {
  Params p{};
  p.x = (const float*)d_in[0]; p.c = (const float*)d_in[1]; p.w_ada = (const float*)d_in[2]; p.b_ada = (const float*)d_in[3];
  p.g_mix = (const float*)d_in[4]; p.w_in = (const float*)d_in[5]; p.pe_k = (const float*)d_in[6]; p.pe_v = (const float*)d_in[7];
  p.w_k1 = (const float*)d_in[8]; p.b_k1 = (const float*)d_in[9]; p.w_k2 = (const float*)d_in[10]; p.w_v1 = (const float*)d_in[11];
  p.b_v1 = (const float*)d_in[12]; p.w_v2 = (const float*)d_in[13]; p.w_out = (const float*)d_in[14]; p.g_ffn = (const float*)d_in[15];
  p.w_pq = (const float*)d_in[16]; p.subkeys = (const float*)d_in[17]; p.peer_down = (const float*)d_in[18]; p.peer_up = (const float*)d_in[19];
  p.g_final = (const float*)d_in[20];
  p.out = (float*)d_out; p.gout = p.out;
  char* ws = (char*)d_ws;
  size_t off = 0;
  p.mod = (float*)(ws + carve(off, 2 * 6144 * 4));
  p.ksmax = (unsigned*)(ws + carve(off, 256));
  p.xbar = (unsigned*)(ws + carve(off, XCD_BAR_WORDS * 4));
  p.c128 = (float*)(ws + carve(off, (size_t)SEQ * 64 * 4)); p.s128 = (float*)(ws + carve(off, (size_t)SEQ * 64 * 4));
  p.c64 = (float*)(ws + carve(off, (size_t)SEQ * 32 * 4)); p.s64 = (float*)(ws + carve(off, (size_t)SEQ * 32 * 4));
  p.WinT = (bf16_t*)(ws + carve(off, (size_t)NPROJ * 1024 * 2));
  p.WoutT = (bf16_t*)(ws + carve(off, (size_t)1024 * 1024 * 2));
  p.WqT = (bf16_t*)(ws + carve(off, (size_t)2048 * 1024 * 2));
  p.W1Tk = (bf16_t*)(ws + carve(off, (size_t)256 * 2048 * 2)); p.W1Tv = (bf16_t*)(ws + carve(off, (size_t)256 * 2048 * 2));
  p.W2Tk = (bf16_t*)(ws + carve(off, 64 * 256 * 2)); p.W2Tv = (bf16_t*)(ws + carve(off, 64 * 256 * 2));
  p.SUBK = (bf16_t*)(ws + carve(off, (size_t)16 * 128 * 128 * 2));
  p.B1Pk = (float*)(ws + carve(off, 1024)); p.B1Pv = (float*)(ws + carve(off, 1024));
  p.RA = (bf16_t*)(ws + carve(off, (size_t)T_TOK * 1024 * 2));
  size_t rb = off;
  p.RQ = (bf16_t*)(ws + carve(off, (size_t)T_TOK * 512 * 2)); p.RK = (bf16_t*)(ws + carve(off, (size_t)T_TOK * 512 * 2));
  p.RKT = (bf16_t*)(ws + carve(off, (size_t)T_TOK * 512 * 2)); p.RVT = (bf16_t*)(ws + carve(off, (size_t)T_TOK * 512 * 2));
  p.RGT = (bf16_t*)(ws + carve(off, (size_t)T_TOK * 512 * 2)); p.NQ = (bf16_t*)(ws + carve(off, (size_t)T_TOK * 512 * 2));
  p.NKC = (bf16_t*)(ws + carve(off, (size_t)T_TOK * 128 * 2)); p.NVC = (bf16_t*)(ws + carve(off, (size_t)T_TOK * 128 * 2));
  p.NKS = (bf16_t*)(ws + carve(off, (size_t)T_TOK * 128 * 2)); p.NKW = (bf16_t*)(ws + carve(off, (size_t)T_TOK * 128 * 2));
  p.NVST = (bf16_t*)(ws + carve(off, (size_t)T_TOK * 128 * 2)); p.NVWT = (bf16_t*)(ws + carve(off, (size_t)T_TOK * 128 * 2));
  p.GATE = (float*)(ws + carve(off, (size_t)T_TOK * 24 * 4));
  p.KV = (float*)(ws + carve(off, (size_t)512 * 16384 * 4));
  p.SPREV = (bf16_t*)(ws + carve(off, (size_t)512 * 16384 * 2));
  p.KC = (bf16_t*)(ws + carve(off, (size_t)4 * 512 * 64 * 2)); p.VCT = (bf16_t*)(ws + carve(off, (size_t)4 * 512 * 64 * 2));
  p.HID = (float*)(ws + carve(off, (size_t)2 * 2048 * 256 * 4));
  size_t off2 = rb;
  p.PQ = (bf16_t*)(ws + carve(off2, (size_t)T_TOK * 2048 * 2));
  p.EIDX = (int*)(ws + carve(off2, (size_t)T_TOK * 128 * 4));
  p.EW = (float*)(ws + carve(off2, (size_t)T_TOK * 128 * 4));
  p.PDN8 = (unsigned char*)(ws + carve(off2, (size_t)16384 * 1024));
  p.PUP8 = (unsigned char*)(ws + carve(off2, (size_t)16384 * 1024));
  p.SDN = (float*)(ws + carve(off2, 16384 * 4));
  p.SUP = (float*)(ws + carve(off2, 16384 * 4));
  (void)ws_size; (void)in_sizes; (void)n_in; (void)out_size;

#ifdef MK_MULTI
#define LAUNCH1(PH) { hipFuncSetAttribute((const void*)k_single<PH>, hipFuncAttributeMaxDynamicSharedMemorySize, SMEM_BYTES); k_single<PH><<<256, NT, SMEM_BYTES, stream>>>(p); }
  LAUNCH1(0) LAUNCH1(1) LAUNCH1(2) LAUNCH1(3) LAUNCH1(4) LAUNCH1(5) LAUNCH1(6) LAUNCH1(7) LAUNCH1(8) LAUNCH1(9) LAUNCH1(10)
#else
  static int grid_blocks = 0;
  if (!grid_blocks) {
    int dev = 0, cus = 0, per_cu = 0;
    (void)hipGetDevice(&dev);
    (void)hipDeviceGetAttribute(&cus, hipDeviceAttributeMultiprocessorCount, dev);
    (void)hipFuncSetAttribute((const void*)k_mega, hipFuncAttributeMaxDynamicSharedMemorySize, SMEM_BYTES);
    (void)hipOccupancyMaxActiveBlocksPerMultiprocessor(&per_cu, k_mega, NT, SMEM_BYTES);
    if (per_cu < 1) per_cu = 1;
    if (per_cu > 1) per_cu = 1;
    grid_blocks = cus * per_cu;
  }
  (void)hipMemsetAsync(p.xbar, 0, XCD_BAR_WORDS * 4, stream);
  void* args[] = {&p};
  hipError_t e = hipLaunchCooperativeKernel((void*)k_mega, dim3(grid_blocks), dim3(NT), args, SMEM_BYTES, stream);
  if (e != hipSuccess) fprintf(stderr, "cooperative launch failed: %s (grid %d)\n", hipGetErrorString(e), grid_blocks);
#endif
}
```

```cpp
#include <hip/hip_runtime.h>
#include <hip/hip_bf16.h>
#include <hip/hip_cooperative_groups.h>
#include <stdint.h>
#include <stdio.h>
namespace cg = cooperative_groups;

typedef unsigned short bf16_t;
#define DI __device__ __forceinline__

DI int mytid() { int t = threadIdx.x; asm volatile("" : "+v"(t)); return t; }
DI float bf2f(bf16_t v) { return __uint_as_float(((unsigned)v) << 16); }
DI bf16_t f2bf(float x) { unsigned u = __float_as_uint(x); u += 0x7fffu + ((u >> 16) & 1u); return (bf16_t)(u >> 16); }
DI float gelu_tanh(float x) { float u = 0.7978845608028654f * (x + 0.044715f * x * x * x); return 0.5f * x * (1.f + tanhf(u)); }
DI float siluf(float x) { return x / (1.f + __expf(-x)); }
DI float sigmoidf(float x) { return 1.f / (1.f + __expf(-x)); }

#define T_TOK 16384
#define SEQ 8192
#define DM 1024
#define NPROJ 3584
#define NEG_INF (-__builtin_inff())

struct Params {
  const float *x, *c, *w_ada, *b_ada, *g_mix, *w_in, *pe_k, *pe_v, *w_k1, *b_k1, *w_k2, *w_v1, *b_v1, *w_v2, *w_out, *g_ffn,
      *w_pq, *subkeys, *peer_down, *peer_up, *g_final;
  float* out;
  float* gout;
  float* mod;
  unsigned* ksmax;
  unsigned* xbar;
  float *c128, *s128, *c64, *s64;
  bf16_t *WinT, *WoutT, *WqT, *W1Tk, *W1Tv, *W2Tk, *W2Tv, *SUBK;
  float *B1Pk, *B1Pv;
  bf16_t* RA;
  bf16_t *RQ, *RK, *RKT, *RVT, *RGT, *NQ, *NKC, *NVC, *NKS, *NKW, *NVST, *NVWT;
  float* GATE;
  float* KV;
  bf16_t* SPREV;
  bf16_t *KC, *VCT;
  float* HID;
  bf16_t* PQ;
  int* EIDX;
  float* EW;
  unsigned char *PDN8, *PUP8;
  float *SDN, *SUP;
};

DI float logg_h(int h) { return log1pf(-exp2f(-5.f - (float)h)); }


typedef __bf16 bf16x2_t __attribute__((ext_vector_type(2)));
typedef float f32x2_t __attribute__((ext_vector_type(2)));
DI unsigned cvt2(float a, float b) { f32x2_t v = {a, b}; bf16x2_t r = __builtin_convertvector(v, bf16x2_t); return __builtin_bit_cast(unsigned, r); }
DI uint2 pack4(float a, float b, float c, float d) { uint2 r; r.x = cvt2(a, b); r.y = cvt2(c, d); return r; }
#define NT 512
#ifndef PROBE_DUP
#define PROBE_DUP -1
#endif
typedef short bf16x8 __attribute__((ext_vector_type(8)));
typedef float f32x16 __attribute__((ext_vector_type(16)));
#define MFMA32(a, b, c) __builtin_amdgcn_mfma_f32_32x32x16_bf16((a), (b), (c), 0, 0, 0)
DI f32x16 zero16() { f32x16 z; for (int e = 0; e < 16; ++e) z[e] = 0.f; return z; }
DI f32x16 fill16(float v) { f32x16 z; for (int e = 0; e < 16; ++e) z[e] = v; return z; }
DI float ex2(float x) { return __builtin_amdgcn_exp2f(x); }

DI int win_logical_col(int np) {
  const int tile = np >> 8, p = np & 255, half = p >> 7, q = p & 127;
  if (tile < 4) { const int head = 2 * (tile & 1) + (q >> 6), i = q & 63; return (tile >> 1) * 512 + head * 128 + (half ? 64 + i : i); }
  if (tile < 8) return 1024 + (tile - 4) * 256 + p;
  if (tile < 10) { const int head = 4 * (tile - 8) + (q >> 5), i = q & 31; return 2048 + head * 64 + (half ? 32 + i : i); }
  if (tile == 10) { const int blk = q >> 5, i = q & 31; return (blk < 2 ? 2560 + blk * 64 : 2816 + (blk - 2) * 64) + (half ? 32 + i : i); }
  if (tile == 11) { const int blk = q >> 5, i = q & 31; return (blk < 2) ? 3072 + blk * 64 + (half ? 32 + i : i) : 2688 + (half ? 64 : 0) + 32 * (blk - 2) + i; }
  if (tile == 12) return (half ? 3200 : 2944) + q;
  if (tile == 13) return (half == 0 && q < 24) ? 3328 + q : -1;
  return -1;
}

DI void tr_tile(const float* __restrict__ in, bf16_t* __restrict__ out, int K, int N_in, int k0, int n0, int mode, float* tile) {
  const int tid = mytid();
  {
    int nn = tid & 63, col = mode ? win_logical_col(n0 + nn) : (n0 + nn);
#pragma unroll
    for (int i = 0; i < 8; ++i) {
      int kk = (tid >> 6) + 8 * i;
      tile[kk * 65 + nn] = (col >= 0) ? in[(size_t)(k0 + kk) * N_in + col] : 0.f;
    }
  }
  __syncthreads();
  {
    int kk = tid & 63;
#pragma unroll
    for (int i = 0; i < 8; ++i) {
      int nn = (tid >> 6) + 8 * i;
      out[(size_t)(n0 + nn) * K + k0 + kk] = f2bf(tile[kk * 65 + nn]);
    }
  }
  __syncthreads();
}

#define PH0_MOD 96
#define PH0_WIN (PH0_MOD + 16 * 56)
#define PH0_WOUT (PH0_WIN + 256)
#define PH0_WQ (PH0_WOUT + 512)
#define PH0_W1K (PH0_WQ + 128)
#define PH0_W1V (PH0_W1K + 128)
#define PH0_W2K (PH0_W1V + 4)
#define PH0_W2V (PH0_W2K + 4)
#define PH0_SUBK (PH0_W2V + 512)
#define PH0_ROPE (PH0_SUBK + 1024)
#define PH0_B1P (PH0_ROPE + 8)
#define PH0_NVB PH0_B1P

DI void ph0_body(const Params& p, int vb, char* smem) {
  const int tid = mytid();
  float* fs = (float*)smem;
  if (vb < PH0_MOD) {
    int kg = tid >> 6, col = vb * 64 + (tid & 63);
    float a0 = 0.f, a1 = 0.f;
#pragma unroll 8
    for (int k = kg * 128; k < kg * 128 + 128; ++k) {
      float w = p.w_ada[(size_t)k * 6144 + col];
      a0 += siluf(p.c[k]) * w; a1 += siluf(p.c[DM + k]) * w;
    }
    fs[kg * 64 + (tid & 63)] = a0; fs[512 + kg * 64 + (tid & 63)] = a1;
    __syncthreads();
    if (tid < 128) {
      int b = tid >> 6, cc = tid & 63; float s = 0.f;
      for (int g = 0; g < 8; ++g) s += fs[b * 512 + g * 64 + cc];
      p.mod[b * 6144 + vb * 64 + cc] = s + p.b_ada[vb * 64 + cc];
    }
    __syncthreads();
    if (vb == 0 && tid < 12) p.ksmax[tid] = 0u;
  } else if (vb < PH0_WIN) { int t = vb - PH0_MOD; tr_tile(p.w_in, p.WinT, 1024, 3352, (t & 15) * 64, (t >> 4) * 64, 1, fs); }
  else if (vb < PH0_WOUT) { int t = vb - PH0_WIN; tr_tile(p.w_out, p.WoutT, 1024, 1024, (t & 15) * 64, (t >> 4) * 64, 0, fs); }
  else if (vb < PH0_WQ) { int t = vb - PH0_WOUT; tr_tile(p.w_pq, p.WqT, 1024, 2048, (t & 15) * 64, (t >> 4) * 64, 0, fs); }
  else if (vb < PH0_W1K) { int t = vb - PH0_WQ; tr_tile(p.w_k1, p.W1Tk, 2048, 256, (t & 31) * 64, (t >> 5) * 64, 0, fs); }
  else if (vb < PH0_W1V) { int t = vb - PH0_W1K; tr_tile(p.w_v1, p.W1Tv, 2048, 256, (t & 31) * 64, (t >> 5) * 64, 0, fs); }
  else if (vb < PH0_W2K) { int t = vb - PH0_W1V; tr_tile(p.w_k2, p.W2Tk, 256, 64, t * 64, 0, 0, fs); }
  else if (vb < PH0_W2V) { int t = vb - PH0_W2K; tr_tile(p.w_v2, p.W2Tv, 256, 64, t * 64, 0, 0, fs); }
  else if (vb < PH0_SUBK) { int i = (vb - PH0_W2V) * NT + tid; p.SUBK[i] = f2bf(p.subkeys[i]); }
  else if (vb < PH0_ROPE) {
    int idx = (vb - PH0_SUBK) * NT + tid;
    { int s = idx >> 6, i = idx & 63; float inv = powf(10000.f, -(float)(2 * i) / 128.f); float ang = (float)s * inv; p.c128[idx] = cosf(ang); p.s128[idx] = sinf(ang); }
    if (idx < SEQ * 32) { int s = idx >> 5, i = idx & 31; float inv = powf(10000.f, -(float)(2 * i) / 64.f); float ang = (float)s * inv; p.c64[idx] = cosf(ang); p.s64[idx] = sinf(ang); }
  } else {
    int t = vb - PH0_ROPE, kv = t >> 2, jb = t & 3;
    const float* w1 = kv ? p.w_v1 : p.w_k1; const float* pe = kv ? p.pe_v : p.pe_k; const float* b1 = kv ? p.b_v1 : p.b_k1;
    int fg = tid >> 6, j = jb * 64 + (tid & 63);
    float a = 0.f;
#pragma unroll 8
    for (int f = fg * 256; f < fg * 256 + 256; ++f) a += pe[f] * w1[(size_t)f * 256 + j];
    fs[fg * 64 + (tid & 63)] = a;
    __syncthreads();
    if (tid < 64) { float s = b1[j]; for (int g = 0; g < 8; ++g) s += fs[g * 64 + tid]; (kv ? p.B1Pv : p.B1Pk)[j] = s; }
    __syncthreads();
  }
}

DI void rownorm_body(const float* __restrict__ src, const float* __restrict__ g, const float* __restrict__ mod, int sh_off, int sc_off, bf16_t* __restrict__ dst, int vb) {
  int row = vb * 8 + (mytid() >> 6), lane = mytid() & 63;
  int b = row >> 13;
  const float* xr = src + (size_t)row * DM;
  float v[16]; float ss = 0.f;
#pragma unroll
  for (int i = 0; i < 4; ++i) {
    float4 t = *(const float4*)(xr + i * 256 + lane * 4);
    v[i * 4 + 0] = t.x; v[i * 4 + 1] = t.y; v[i * 4 + 2] = t.z; v[i * 4 + 3] = t.w;
    ss += t.x * t.x + t.y * t.y + t.z * t.z + t.w * t.w;
  }
  for (int o = 32; o; o >>= 1) ss += __shfl_xor(ss, o);
  float rstd = rsqrtf(ss * (1.f / DM) + 1e-6f);
  const float* sh = mod + b * 6144 + sh_off; const float* sc = mod + b * 6144 + sc_off;
#pragma unroll
  for (int i = 0; i < 4; ++i) {
    int col = i * 256 + lane * 4;
    float4 gg = *(const float4*)(g + col), s4 = *(const float4*)(sc + col), h4 = *(const float4*)(sh + col);
    float y0 = v[i * 4 + 0] * rstd * gg.x * (1.f + s4.x) + h4.x;
    float y1 = v[i * 4 + 1] * rstd * gg.y * (1.f + s4.y) + h4.y;
    float y2 = v[i * 4 + 2] * rstd * gg.z * (1.f + s4.z) + h4.z;
    float y3 = v[i * 4 + 3] * rstd * gg.w * (1.f + s4.w) + h4.w;
    *(uint2*)(dst + (size_t)row * DM + col) = pack4(y0, y1, y2, y3);
  }
}

#define G_A_BYTES (256 * 144)
#define G_B_BYTES (256 * 144)
#define G_BUF_BYTES (G_A_BYTES + G_B_BYTES)
template <class Epi>
DI void gemm_tile(const bf16_t* __restrict__ A, const bf16_t* __restrict__ Bt, int K, int m0, int n0, char* smem, const Epi& epi) {
  const int tid = mytid(), lane = tid & 63, w = tid >> 6, wm = w >> 2, wn = w & 3, r = lane & 31, h = lane >> 5;
  f32x16 acc[4][2];
#pragma unroll
  for (int i = 0; i < 4; ++i)
#pragma unroll
    for (int j = 0; j < 2; ++j) acc[i][j] = zero16();
  const int crow = tid >> 3, ckc = tid & 7;
  const bf16_t* ag = A + (size_t)(m0 + crow) * K + ckc * 8;
  const bf16_t* bg = Bt + (size_t)(n0 + crow) * K + ckc * 8;
  uint4 ra[4], rb[4];
#pragma unroll
  for (int i = 0; i < 4; ++i) { ra[i] = *(const uint4*)(ag + (size_t)i * 64 * K); rb[i] = *(const uint4*)(bg + (size_t)i * 64 * K); }
  char* lw = smem + crow * 144 + ckc * 16;
#pragma unroll
  for (int i = 0; i < 4; ++i) { *(uint4*)(lw + i * 64 * 144) = ra[i]; *(uint4*)(lw + G_A_BYTES + i * 64 * 144) = rb[i]; }
  __syncthreads();
  const int nk = K >> 6;
  for (int kt = 0; kt < nk; ++kt) {
    const int cur = kt & 1;
    if (kt + 1 < nk) {
      const int k0 = (kt + 1) * 64;
#pragma unroll
      for (int i = 0; i < 4; ++i) { ra[i] = *(const uint4*)(ag + (size_t)i * 64 * K + k0); rb[i] = *(const uint4*)(bg + (size_t)i * 64 * K + k0); }
    }
    const char* la = smem + cur * G_BUF_BYTES + (wm * 128 + r) * 144 + h * 16;
    const char* lb = smem + cur * G_BUF_BYTES + G_A_BYTES + (wn * 64 + r) * 144 + h * 16;
#pragma unroll
    for (int kk = 0; kk < 4; ++kk) {
      bf16x8 b0 = *(const bf16x8*)(lb + kk * 32), b1 = *(const bf16x8*)(lb + 32 * 144 + kk * 32);
#pragma unroll
      for (int i = 0; i < 4; ++i) {
        bf16x8 a = *(const bf16x8*)(la + i * 32 * 144 + kk * 32);
        acc[i][0] = MFMA32(a, b0, acc[i][0]); acc[i][1] = MFMA32(a, b1, acc[i][1]);
      }
    }
    if (kt + 1 < nk) {
      char* lw2 = lw + (cur ^ 1) * G_BUF_BYTES;
#pragma unroll
      for (int i = 0; i < 4; ++i) { *(uint4*)(lw2 + i * 64 * 144) = ra[i]; *(uint4*)(lw2 + G_A_BYTES + i * 64 * 144) = rb[i]; }
    }
    __syncthreads();
  }
  const int G = (n0 >> 6) + wn;
#pragma unroll
  for (int i = 0; i < 4; ++i) {
    float pre[4][8];
#pragma unroll
    for (int g = 0; g < 4; ++g) epi.prefetch(m0 + wm * 128 + i * 32 + 8 * g + 4 * h, G, r, pre[g]);
#pragma unroll
    for (int g = 0; g < 4; ++g) {
      float lo[4], hi[4];
#pragma unroll
      for (int e = 0; e < 4; ++e) { lo[e] = acc[i][0][4 * g + e]; hi[e] = acc[i][1][4 * g + e]; }
      epi(m0 + wm * 128 + i * 32 + 8 * g + 4 * h, G, r, lo, hi, pre[g]);
    }
  }
}

struct EpiProj {
  static constexpr bool kProbe = true;
  const Params& p;
  DI void prefetch(int t0, int G, int c, float (&pre)[8]) const {
    const int s0 = t0 & 8191;
    const bool r128 = G < 16, r64 = (G >= 32 && G < 40) || (G >= 40 && G < 52 && (((G - 40) >> 1) & 1) == 0);
    if (r128) {
      const int i = 32 * (G & 1) + c;
#pragma unroll
      for (int e = 0; e < 4; ++e) { pre[e] = p.c128[(s0 + e) * 64 + i]; pre[4 + e] = p.s128[(s0 + e) * 64 + i]; }
    } else if (r64) {
#pragma unroll
      for (int e = 0; e < 4; ++e) { pre[e] = p.c64[(s0 + e) * 32 + c]; pre[4 + e] = p.s64[(s0 + e) * 32 + c]; }
    } else {
#pragma unroll
      for (int e = 0; e < 8; ++e) pre[e] = 0.f;
    }
  }
  DI void operator()(int t0, int G, int c, const float (&lo)[4], const float (&hi)[4], const float (&pre)[8]) const {
    const int b = t0 >> 13, s0 = t0 & 8191;
    if (G < 16) {
      const int sec = G >> 3, hh = (G & 7) >> 1, j = G & 1, i = 32 * j + c;
      float o1[4], o2[4];
#pragma unroll
      for (int e = 0; e < 4; ++e) {
        float cs = pre[e], sn = pre[4 + e];
        o1[e] = lo[e] * cs - hi[e] * sn; o2[e] = hi[e] * cs + lo[e] * sn;
      }
      if (sec == 0) {
#pragma unroll
        for (int e = 0; e < 4; ++e) {
          p.RQ[(size_t)(t0 + e) * 512 + hh * 128 + i] = f2bf(o1[e]);
          p.RQ[(size_t)(t0 + e) * 512 + hh * 128 + 64 + i] = f2bf(o2[e]);
        }
      } else {
        const float sc = 0.08838834764831845f;
        const float lg = logg_h(hh);
#pragma unroll
        for (int e = 0; e < 4; ++e) {
          o1[e] *= sc; o2[e] *= sc;
          p.RK[(size_t)(t0 + e) * 512 + hh * 128 + i] = f2bf(o1[e]);
          p.RK[(size_t)(t0 + e) * 512 + hh * 128 + 64 + i] = f2bf(o2[e]);
          float zeta = __expf((float)(127 - ((s0 + e) & 127)) * lg);
          o1[e] *= zeta; o2[e] *= zeta;
        }
        *(uint2*)(p.RKT + ((size_t)(b * 4 + hh) * 128 + i) * SEQ + s0) = pack4(o1[0], o1[1], o1[2], o1[3]);
        *(uint2*)(p.RKT + ((size_t)(b * 4 + hh) * 128 + 64 + i) * SEQ + s0) = pack4(o2[0], o2[1], o2[2], o2[3]);
      }
    } else if (G < 24) {
      const int hh = (G - 16) >> 1, d = ((G - 16) & 1) * 64 + c;
      *(uint2*)(p.RVT + ((size_t)(b * 4 + hh) * 128 + d) * SEQ + s0) = pack4(lo[0], lo[1], lo[2], lo[3]);
      *(uint2*)(p.RVT + ((size_t)(b * 4 + hh) * 128 + d + 32) * SEQ + s0) = pack4(hi[0], hi[1], hi[2], hi[3]);
    } else if (G < 32) {
      const int hh = (G - 24) >> 1, d = ((G - 24) & 1) * 64 + c;
#pragma unroll
      for (int e = 0; e < 4; ++e) {
        p.RGT[(size_t)(t0 + e) * 512 + hh * 128 + d] = f2bf(siluf(lo[e]));
        p.RGT[(size_t)(t0 + e) * 512 + hh * 128 + d + 32] = f2bf(siluf(hi[e]));
      }
    } else if (G < 40) {
      const int head = G - 32;
#pragma unroll
      for (int e = 0; e < 4; ++e) {
        float cs = pre[e], sn = pre[4 + e];
        const float qs = 0.125f * 1.4426950408889634f;
        float o1 = (lo[e] * cs - hi[e] * sn) * qs, o2 = (hi[e] * cs + lo[e] * sn) * qs;
        p.NQ[(size_t)(t0 + e) * 512 + head * 64 + c] = f2bf(o1);
        p.NQ[(size_t)(t0 + e) * 512 + head * 64 + 32 + c] = f2bf(o2);
      }
    } else if (G < 52) {
      const int k = G - 40, kind = k >> 1, gg = k & 1;
      float o1[4], o2[4];
#pragma unroll
      for (int e = 0; e < 4; ++e) {
        o1[e] = lo[e]; o2[e] = hi[e];
        if ((kind & 1) == 0) {
          float cs = pre[e], sn = pre[4 + e];
          o1[e] = lo[e] * cs - hi[e] * sn; o2[e] = hi[e] * cs + lo[e] * sn;
        }
      }
      if (kind == 3 || kind == 5) {
        bf16_t* dst = (kind == 3 ? p.NVST : p.NVWT) + ((size_t)(b * 2 + gg) * 64 + c) * SEQ + s0;
        *(uint2*)dst = pack4(o1[0], o1[1], o1[2], o1[3]);
        *(uint2*)(dst + (size_t)32 * SEQ) = pack4(o2[0], o2[1], o2[2], o2[3]);
      } else {
        bf16_t* dst = (kind == 0 ? p.NKC : kind == 1 ? p.NVC : kind == 2 ? p.NKS : p.NKW);
#pragma unroll
        for (int e = 0; e < 4; ++e) {
          dst[(size_t)(t0 + e) * 128 + gg * 64 + c] = f2bf(o1[e]);
          dst[(size_t)(t0 + e) * 128 + gg * 64 + 32 + c] = f2bf(o2[e]);
        }
      }
    } else if (G == 52) {
      if (c < 24) {
#pragma unroll
        for (int e = 0; e < 4; ++e) p.GATE[(size_t)(t0 + e) * 24 + c] = sigmoidf(lo[e]);
      }
    }
  }
};
struct EpiOut {
  static constexpr bool kProbe = false;
  const Params& p;
  DI void prefetch(int t0, int G, int c, float (&pre)[8]) const {
    const int c0 = G * 64 + c;
#pragma unroll
    for (int e = 0; e < 4; ++e) { pre[e] = p.x[(size_t)(t0 + e) * DM + c0]; pre[4 + e] = p.x[(size_t)(t0 + e) * DM + c0 + 32]; }
  }
  DI void operator()(int t0, int G, int c, const float (&lo)[4], const float (&hi)[4], const float (&pre)[8]) const {
    const int b = t0 >> 13;
    const int c0 = G * 64 + c, c1 = c0 + 32;
    const float* ga1 = p.mod + b * 6144 + 2048;
    const float g0 = ga1[c0], g1 = ga1[c1];
#pragma unroll
    for (int e = 0; e < 4; ++e) {
      p.out[(size_t)(t0 + e) * DM + c0] = pre[e] + g0 * lo[e];
      p.out[(size_t)(t0 + e) * DM + c1] = pre[4 + e] + g1 * hi[e];
    }
  }
};
struct EpiPQ {
  static constexpr bool kProbe = false;
  const Params& p;
  DI void prefetch(int, int, int, float (&)[8]) const {}
  DI void operator()(int t0, int G, int c, const float (&lo)[4], const float (&hi)[4], const float (&)[8]) const {
#pragma unroll
    for (int e = 0; e < 4; ++e) {
      p.PQ[(size_t)(t0 + e) * 2048 + G * 64 + c] = f2bf(lo[e]);
      p.PQ[(size_t)(t0 + e) * 2048 + G * 64 + 32 + c] = f2bf(hi[e]);
    }
  }
};


namespace pg8 {
#define PG8_LAS __attribute__((address_space(3)))
typedef float f32x4 __attribute__((ext_vector_type(4)));
constexpr int BM = 256, BK = 64, HALF = 128, HTB = HALF * BK * 2, STAGE_BYTES = 8 * HTB, NXCD = 8, WGM = 8;
DI int lds_byte(int r, int c) { const int st = (r >> 4) * 2 + (c >> 5), rr = r & 15, cc = c & 31, ob = rr * 64 + cc * 2; return st * 1024 + (ob ^ (((ob >> 9) & 1) << 5)); }
DI void stage_rc(int b, int& R, int& C) { const int st = b / 1024, sb = b % 1024, swz = sb ^ (((sb >> 9) & 1) << 5); R = (st >> 1) * 16 + swz / 64; C = (st & 1) * 32 + (swz % 64) / 2; }
DI int perm32(int rho) { const int n = rho >> 4, i = rho & 15; return 8 * (i >> 2) + 4 * n + (i & 3); }
struct Unit { int pm, pn; };
struct Gemm { const bf16_t* A; const bf16_t* Bt; int M, N, K; };
struct StaticOrder {
  int nM, nN, nwg, G, c;
  DI void init(int M, int N, int G_, int c_) { nM = M / BM; nN = N / BM; nwg = nM * nN; G = G_; c = c_; }
  DI bool next(int i, Unit& u) const {
    const long L = (long)i * G + c; if (L >= nwg) return false;
    int wgid = (int)L; { const int q = nwg / NXCD, r = nwg % NXCD, xcd = wgid % NXCD, off = wgid / NXCD; wgid = (xcd < r ? xcd * (q + 1) : r * (q + 1) + (xcd - r) * q) + off; }
    const int nig = WGM * nN, gid = wgid / nig, fm = gid * WGM, gsz = (nM - fm) < WGM ? (nM - fm) : WGM;
    u.pm = fm + ((wgid % nig) % gsz); u.pn = (wgid % nig) / gsz; return true;
  }
  DI void a_ready(const Unit&) const {}
  DI void done(const Unit&) const {}
};
template <class Epi, class Sched>
__device__ __forceinline__ void gemm_phase(PG8_LAS unsigned char* lds, const Gemm g, const Sched& S, const Epi& E) {
    const int tid = mytid(), wid = __builtin_amdgcn_readfirstlane(tid >> 6), lane = tid & 63, wr = wid >> 2, wc = wid & 3, fr = lane & 15, fq = lane >> 4;
    const int K = g.K, nt = K / BK;
    unsigned voffA[2], voffB[2];
#pragma unroll
    for (int i = 0; i < 2; ++i) { int R, C; stage_rc(tid * 16 + i * 8192, R, C); const int Rb = Epi::PERM ? ((R & ~31) + perm32(R & 31)) : R;
        voffA[i] = (unsigned)(R * K + C) * 2u; voffB[i] = (unsigned)(Rb * K + C) * 2u; }
    const size_t kstep = (size_t)(BK * 2);
    const size_t hstep = (size_t)HALF * K * 2;
    const size_t tstep = 2 * hstep;
    const unsigned ldsw = (unsigned)wid * 1024u;
    const int aoff = lds_byte(wr * 64 + fr, fq * 8), boff = lds_byte(wc * 32 + fr, fq * 8);
#define PG8_SA(b, h) (((b) * 2 + (h)) * HTB)
#define PG8_SB(b, h) ((4 + (b) * 2 + (h)) * HTB)
#define PG8_STAGE(bufoff, gbase, voff) do { _Pragma("unroll") for (int _i = 0; _i < 2; ++_i) \
        __builtin_amdgcn_global_load_lds((const unsigned*)((const char*)(gbase) + (voff)[_i]), (PG8_LAS unsigned*)(lds + (bufoff) + ldsw + _i * 8192), 16, 0, 0); } while (0)
#define PG8_LDA(dst, b, h) do { _Pragma("unroll") for (int m = 0; m < 4; ++m) _Pragma("unroll") for (int k = 0; k < 2; ++k) dst[m][k] = *(const PG8_LAS bf16x8*)(lds + PG8_SA(b, h) + aoff + m * 2048 + k * 1024); } while (0)
#define PG8_LDB(dst, b, h) do { _Pragma("unroll") for (int n = 0; n < 2; ++n) _Pragma("unroll") for (int k = 0; k < 2; ++k) dst[n][k] = *(const PG8_LAS bf16x8*)(lds + PG8_SB(b, h) + boff + n * 2048 + k * 1024); } while (0)
#define PG8_MMA(ai, bj, At, Bt) do { __builtin_amdgcn_s_setprio(1); _Pragma("unroll") for (int m = 0; m < 4; ++m) _Pragma("unroll") for (int n = 0; n < 2; ++n) _Pragma("unroll") for (int k = 0; k < 2; ++k) \
        acc[ai][bj][m][n] = __builtin_amdgcn_mfma_f32_16x16x32_bf16(Bt[n][k], At[m][k], acc[ai][bj][m][n], 0, 0, 0); __builtin_amdgcn_s_setprio(0); } while (0)
#define PG8_WAIT_V(n) asm volatile("s_waitcnt vmcnt(" #n ")" ::: "memory")
#define PG8_WAIT_L(n) asm volatile("s_waitcnt lgkmcnt(" #n ")" ::: "memory")
#define PG8_BAR __builtin_amdgcn_s_barrier()
#define PG8_SCHED __builtin_amdgcn_sched_barrier(0)
    Unit cur, nxt; int ui = 0;
    if (!S.next(0, cur)) return;
    f32x4 acc[2][2][4][2];
#pragma unroll
    for (int a = 0; a < 2; ++a)
#pragma unroll
        for (int b = 0; b < 2; ++b)
#pragma unroll
            for (int m = 0; m < 4; ++m)
#pragma unroll
                for (int n = 0; n < 2; ++n) acc[a][b][m][n] = (f32x4){0.f, 0.f, 0.f, 0.f};
    bf16x8 At[4][2], B0[2][2], B1[2][2];
    const char* cA = (const char*)g.A + (size_t)cur.pm * tstep; const char* cB = (const char*)g.Bt + (size_t)cur.pn * tstep;
    S.a_ready(cur);
    PG8_STAGE(PG8_SB(0, 0), cB, voffB); PG8_STAGE(PG8_SA(0, 0), cA, voffA); PG8_STAGE(PG8_SB(0, 1), cB + hstep, voffB); PG8_STAGE(PG8_SA(0, 1), cA + hstep, voffA);
    if (wr == 1) PG8_BAR;
    PG8_WAIT_V(4); PG8_BAR;
    PG8_STAGE(PG8_SB(1, 0), cB + kstep, voffB); PG8_STAGE(PG8_SA(1, 0), cA + kstep, voffA); PG8_STAGE(PG8_SB(1, 1), cB + hstep + kstep, voffB);
    PG8_WAIT_V(6); PG8_BAR;
    for (;;) {
        const bool has_next = S.next(ui + 1, nxt);
        const char* nA = has_next ? (const char*)g.A + (size_t)nxt.pm * tstep : cA; const char* nB = has_next ? (const char*)g.Bt + (size_t)nxt.pn * tstep : cB;
        for (int t = 0; t < nt; t += 2) {
            const bool last = (t == nt - 2);
            const char* a1 = cA + (size_t)(t + 1) * kstep;
            const char* a2 = last ? nA : cA + (size_t)(t + 2) * kstep; const char* b2 = last ? nB : cB + (size_t)(t + 2) * kstep;
            const char* a3 = a2 + kstep; const char* b3 = b2 + kstep;
            if (last && has_next) S.a_ready(nxt);
            PG8_LDB(B0, 0, 0); PG8_SCHED; PG8_LDA(At, 0, 0); PG8_STAGE(PG8_SA(1, 1), a1 + hstep, voffA);
            PG8_WAIT_L(8); PG8_BAR; PG8_WAIT_L(0); PG8_MMA(0, 0, At, B0); PG8_BAR; PG8_SCHED;
            PG8_LDB(B1, 0, 1); PG8_STAGE(PG8_SB(0, 0), b2, voffB);
            PG8_BAR; PG8_WAIT_L(0); PG8_MMA(0, 1, At, B1); PG8_BAR;
            PG8_LDA(At, 0, 1); PG8_STAGE(PG8_SA(0, 0), a2, voffA);
            PG8_BAR; PG8_WAIT_L(0); PG8_MMA(1, 0, At, B0); PG8_BAR; PG8_SCHED;
            PG8_STAGE(PG8_SB(0, 1), b2 + hstep, voffB);
            PG8_WAIT_V(6); PG8_BAR; PG8_MMA(1, 1, At, B1); PG8_BAR;
            PG8_LDB(B0, 1, 0); PG8_SCHED; PG8_LDA(At, 1, 0); PG8_STAGE(PG8_SA(0, 1), a2 + hstep, voffA);
            PG8_WAIT_L(8); PG8_BAR; PG8_WAIT_L(0); PG8_MMA(0, 0, At, B0); PG8_BAR; PG8_SCHED;
            PG8_LDB(B1, 1, 1); PG8_STAGE(PG8_SB(1, 0), b3, voffB);
            PG8_BAR; PG8_WAIT_L(0); PG8_MMA(0, 1, At, B1); PG8_BAR;
            PG8_LDA(At, 1, 1); PG8_STAGE(PG8_SA(1, 0), a3, voffA);
            PG8_BAR; PG8_WAIT_L(0); PG8_MMA(1, 0, At, B0); PG8_BAR; PG8_SCHED;
            PG8_STAGE(PG8_SB(1, 1), b3 + hstep, voffB);
            PG8_WAIT_V(6); PG8_BAR; PG8_MMA(1, 1, At, B1); PG8_BAR;
        }
        if constexpr (!Epi::AFTER_DRAIN) { E(acc, cur, wr, wc, fr, fq); S.done(cur); }
        if (!has_next) break;
#pragma unroll
        for (int a = 0; a < 2; ++a)
#pragma unroll
            for (int b = 0; b < 2; ++b)
#pragma unroll
                for (int m = 0; m < 4; ++m)
#pragma unroll
                    for (int n = 0; n < 2; ++n) acc[a][b][m][n] = (f32x4){0.f, 0.f, 0.f, 0.f};
        cur = nxt; cA = nA; cB = nB; ++ui;
    }
    PG8_WAIT_V(0);
    if (wr == 0) PG8_BAR;
    PG8_BAR;
    if constexpr (Epi::AFTER_DRAIN) { E.fused(acc, cur, wr, wc, fr, fq, lds, wid, lane); S.done(cur); }
#undef PG8_SA
#undef PG8_SB
#undef PG8_STAGE
#undef PG8_LDA
#undef PG8_LDB
#undef PG8_MMA
#undef PG8_WAIT_V
#undef PG8_WAIT_L
#undef PG8_BAR
#undef PG8_SCHED
}
}

template <int CTRL> DI float dpp_q(float x) { return __builtin_bit_cast(float, __builtin_amdgcn_mov_dpp(__builtin_bit_cast(int, x), CTRL, 0xf, 0xf, true)); }
DI void tstore4(bf16_t* dst, float v0, float v1, float v2, float v3, int q) {
  const bool o1_ = q & 1, o2_ = q & 2;
  const float sa = o1_ ? v0 : v1, sb = o1_ ? v2 : v3;
  const float ra = dpp_q<0xB1>(sa), rb = dpp_q<0xB1>(sb);
  const float w0 = o1_ ? ra : v0, w1 = o1_ ? v1 : ra, w2 = o1_ ? rb : v2, w3 = o1_ ? v3 : rb;
  const float sc = o2_ ? w0 : w2, sd = o2_ ? w1 : w3;
  const float rc = dpp_q<0x4E>(sc), rd = dpp_q<0x4E>(sd);
  const float x0 = o2_ ? rc : w0, x1 = o2_ ? rd : w1, x2 = o2_ ? w2 : rc, x3 = o2_ ? w3 : rd;
  *(uint2*)(dst + (size_t)q * SEQ - q) = pack4(x0, x1, x2, x3);
}
DI uint4 pack8u(const float (&a)[4], const float (&b)[4]) { uint4 v; v.x = cvt2(a[0], a[1]); v.y = cvt2(a[2], a[3]); v.z = cvt2(b[0], b[1]); v.w = cvt2(b[2], b[3]); return v; }
struct EpiProj8 {
  static constexpr bool PERM = true, AFTER_DRAIN = false;
  const Params& p;
  DI void operator()(const pg8::f32x4 (&acc)[2][2][4][2], const pg8::Unit& u, int wr, int wc, int fr, int fq) const {
    const int pn = u.pn, q4 = fr & 3;
    const bool rot128 = pn < 4, rot64 = (pn >= 8 && pn < 10) || pn == 10 || (pn == 11 && wc < 2), rot = rot128 || rot64;
    const int t00 = u.pm * 256 + wr * 64 + fr, s00 = t00 & 8191;
    const int cb0 = 8 * fq;
    const float* ct = rot128 ? p.c128 : p.c64; const float* st = rot128 ? p.s128 : p.s64;
    const int nrot = rot128 ? 64 : 32, ridx = (rot128 ? 32 * (wc & 1) : 0) + cb0;
    float cd_[2][4], sd_[2][4];
    if (rot) {
#pragma unroll
      for (int n = 0; n < 2; ++n) {
        const float4 c16 = *(const float4*)(ct + (size_t)16 * nrot + ridx + 4 * n), s16 = *(const float4*)(st + (size_t)16 * nrot + ridx + 4 * n);
        cd_[n][0] = c16.x; cd_[n][1] = c16.y; cd_[n][2] = c16.z; cd_[n][3] = c16.w; sd_[n][0] = s16.x; sd_[n][1] = s16.y; sd_[n][2] = s16.z; sd_[n][3] = s16.w;
      }
    }
#pragma unroll
    for (int ai = 0; ai < 2; ++ai) {
      float c_[2][4], s_[2][4];
      if (rot) {
#pragma unroll
        for (int n = 0; n < 2; ++n) {
          const float4 c4 = *(const float4*)(ct + (size_t)(s00 + 128 * ai) * nrot + ridx + 4 * n), s4 = *(const float4*)(st + (size_t)(s00 + 128 * ai) * nrot + ridx + 4 * n);
          c_[n][0] = c4.x; c_[n][1] = c4.y; c_[n][2] = c4.z; c_[n][3] = c4.w; s_[n][0] = s4.x; s_[n][1] = s4.y; s_[n][2] = s4.z; s_[n][3] = s4.w;
        }
      }
#pragma unroll
      for (int m = 0; m < 4; ++m) {
        const int t = t00 + ai * 128 + m * 16, b = t >> 13, s = t & 8191;
        float lo[2][4], hi[2][4];
#pragma unroll
        for (int n = 0; n < 2; ++n) {
          const pg8::f32x4 L = acc[ai][0][m][n], H = acc[ai][1][m][n];
#pragma unroll
          for (int i = 0; i < 4; ++i) {
            if (rot) {
              const float c = c_[n][i], sn = s_[n][i];
              lo[n][i] = L[i] * c - H[i] * sn; hi[n][i] = H[i] * c + L[i] * sn;
              c_[n][i] = c * cd_[n][i] - sn * sd_[n][i]; s_[n][i] = sn * cd_[n][i] + c * sd_[n][i];
            } else { lo[n][i] = L[i]; hi[n][i] = H[i]; }
          }
        }
        if (pn < 4) {
          const int hh = 2 * (pn & 1) + (wc >> 1), idx = 32 * (wc & 1) + cb0;
          if (pn < 2) {
            *(uint4*)(p.RQ + (size_t)t * 512 + hh * 128 + idx) = pack8u(lo[0], lo[1]);
            *(uint4*)(p.RQ + (size_t)t * 512 + hh * 128 + 64 + idx) = pack8u(hi[0], hi[1]);
          } else {
            const float sc = 0.08838834764831845f;
#pragma unroll
            for (int n = 0; n < 2; ++n)
#pragma unroll
              for (int i = 0; i < 4; ++i) { lo[n][i] *= sc; hi[n][i] *= sc; }
            *(uint4*)(p.RK + (size_t)t * 512 + hh * 128 + idx) = pack8u(lo[0], lo[1]);
            *(uint4*)(p.RK + (size_t)t * 512 + hh * 128 + 64 + idx) = pack8u(hi[0], hi[1]);
            const float zeta = __expf((float)(127 - (s & 127)) * logg_h(hh));
            bf16_t* kt = p.RKT + ((size_t)(b * 4 + hh) * 128 + idx) * SEQ + s;
#pragma unroll
            for (int n = 0; n < 2; ++n) {
              tstore4(kt + (size_t)(4 * n) * SEQ, lo[n][0] * zeta, lo[n][1] * zeta, lo[n][2] * zeta, lo[n][3] * zeta, q4);
              tstore4(kt + (size_t)(64 + 4 * n) * SEQ, hi[n][0] * zeta, hi[n][1] * zeta, hi[n][2] * zeta, hi[n][3] * zeta, q4);
            }
          }
        } else if (pn < 6) {
          bf16_t* v0 = p.RVT + ((size_t)(b * 4 + 2 * (pn - 4)) * 128 + 32 * wc + cb0) * SEQ + s;
#pragma unroll
          for (int n = 0; n < 2; ++n) {
            tstore4(v0 + (size_t)(4 * n) * SEQ, lo[n][0], lo[n][1], lo[n][2], lo[n][3], q4);
            tstore4(v0 + (size_t)(128 + 4 * n) * SEQ, hi[n][0], hi[n][1], hi[n][2], hi[n][3], q4);
          }
        } else if (pn < 8) {
          const int d = 32 * wc + cb0, h0 = 2 * (pn - 6);
#pragma unroll
          for (int n = 0; n < 2; ++n)
#pragma unroll
            for (int i = 0; i < 4; ++i) { lo[n][i] = siluf(lo[n][i]); hi[n][i] = siluf(hi[n][i]); }
          *(uint4*)(p.RGT + (size_t)t * 512 + h0 * 128 + d) = pack8u(lo[0], lo[1]);
          *(uint4*)(p.RGT + (size_t)t * 512 + (h0 + 1) * 128 + d) = pack8u(hi[0], hi[1]);
        } else if (pn < 10) {
          const int head = 4 * (pn - 8) + wc;
          const float qs = 0.125f * 1.4426950408889634f;
#pragma unroll
          for (int n = 0; n < 2; ++n)
#pragma unroll
            for (int i = 0; i < 4; ++i) { lo[n][i] *= qs; hi[n][i] *= qs; }
          *(uint4*)(p.NQ + (size_t)t * 512 + head * 64 + cb0) = pack8u(lo[0], lo[1]);
          *(uint4*)(p.NQ + (size_t)t * 512 + head * 64 + 32 + cb0) = pack8u(hi[0], hi[1]);
        } else if (pn == 10 || (pn == 11 && wc < 2)) {
          bf16_t* dst = (pn == 11) ? p.NKW : (wc < 2 ? p.NKC : p.NKS);
          const int g = wc & 1;
          *(uint4*)(dst + (size_t)t * 128 + g * 64 + cb0) = pack8u(lo[0], lo[1]);
          *(uint4*)(dst + (size_t)t * 128 + g * 64 + 32 + cb0) = pack8u(hi[0], hi[1]);
        } else if (pn == 11) {
          const int c0 = 32 * (wc - 2) + cb0;
          *(uint4*)(p.NVC + (size_t)t * 128 + c0) = pack8u(lo[0], lo[1]);
          *(uint4*)(p.NVC + (size_t)t * 128 + 64 + c0) = pack8u(hi[0], hi[1]);
        } else if (pn == 12) {
          const int col = 32 * wc + cb0, g = col >> 6, d = col & 63;
          bf16_t* v0 = p.NVST + ((size_t)(b * 2 + g) * 64 + d) * SEQ + s;
          bf16_t* v1 = p.NVWT + ((size_t)(b * 2 + g) * 64 + d) * SEQ + s;
#pragma unroll
          for (int n = 0; n < 2; ++n) {
            tstore4(v0 + (size_t)(4 * n) * SEQ, lo[n][0], lo[n][1], lo[n][2], lo[n][3], q4);
            tstore4(v1 + (size_t)(4 * n) * SEQ, hi[n][0], hi[n][1], hi[n][2], hi[n][3], q4);
          }
        } else {
          if (wc == 0) {
#pragma unroll
            for (int n = 0; n < 2; ++n)
#pragma unroll
              for (int i = 0; i < 4; ++i) if (cb0 + 4 * n + i < 24) p.GATE[(size_t)t * 24 + cb0 + 4 * n + i] = sigmoidf(lo[n][i]);
          }
        }
      }
    }
  }
};
struct EpiOut8 {
  static constexpr bool PERM = false, AFTER_DRAIN = false;
  const float* x; float* out; const float* mod;
  DI void operator()(const pg8::f32x4 (&acc)[2][2][4][2], const pg8::Unit& u, int wr, int wc, int fr, int fq) const {
    const int col0 = u.pn * 256 + wc * 32 + 4 * fq;
    const float* ga1 = mod + ((u.pm * 256) >> 13) * 6144 + 2048;
    float4 gv[2][2];
#pragma unroll
    for (int bj = 0; bj < 2; ++bj)
#pragma unroll
      for (int n = 0; n < 2; ++n) gv[bj][n] = *(const float4*)(ga1 + col0 + bj * 128 + n * 16);
#pragma unroll
    for (int ai = 0; ai < 2; ++ai)
#pragma unroll
      for (int m = 0; m < 4; ++m) {
        const size_t ro = (size_t)(u.pm * 256 + wr * 64 + fr + ai * 128 + m * 16) * DM + col0;
        float4 xv[2][2];
#pragma unroll
        for (int bj = 0; bj < 2; ++bj)
#pragma unroll
          for (int n = 0; n < 2; ++n) xv[bj][n] = *(const float4*)(x + ro + bj * 128 + n * 16);
#pragma unroll
        for (int bj = 0; bj < 2; ++bj)
#pragma unroll
          for (int n = 0; n < 2; ++n) {
            const pg8::f32x4 v = acc[ai][bj][m][n]; const float4 g4 = gv[bj][n], x4 = xv[bj][n];
            *(float4*)(out + ro + bj * 128 + n * 16) = make_float4(x4.x + g4.x * v[0], x4.y + g4.y * v[1], x4.z + g4.z * v[2], x4.w + g4.w * v[3]);
          }
      }
  }
};
struct EpiPQ8 {
  static constexpr bool PERM = true, AFTER_DRAIN = false;
  bf16_t* O;
  DI void operator()(const pg8::f32x4 (&acc)[2][2][4][2], const pg8::Unit& u, int wr, int wc, int fr, int fq) const {
#pragma unroll
    for (int ai = 0; ai < 2; ++ai)
#pragma unroll
      for (int m = 0; m < 4; ++m) {
        bf16_t* rowp = O + (size_t)(u.pm * 256 + wr * 64 + fr + ai * 128 + m * 16) * 2048 + u.pn * 256 + wc * 32 + 8 * fq;
#pragma unroll
        for (int bj = 0; bj < 2; ++bj) {
          const pg8::f32x4 v0 = acc[ai][bj][m][0], v1 = acc[ai][bj][m][1];
          uint4 o; o.x = cvt2(v0[0], v0[1]); o.y = cvt2(v0[2], v0[3]); o.z = cvt2(v1[0], v1[1]); o.w = cvt2(v1[2], v1[3]);
          *(uint4*)(rowp + bj * 128) = o;
        }
      }
  }
};
DI int crow(int reg, int h) { return (reg & 3) + 8 * (reg >> 2) + 4 * h; }
DI bf16x8 ld16(const bf16_t* ptr) { return *(const bf16x8*)ptr; }
DI bf16x8 ld8x2(const bf16_t* ptr) {
  uint2 a = *(const uint2*)ptr, b = *(const uint2*)(ptr + 8);
  uint4 v; v.x = a.x; v.y = a.y; v.z = b.x; v.w = b.y;
  return __builtin_bit_cast(bf16x8, v);
}
DI bf16x8 pack8(float x0, float x1, float x2, float x3, float x4, float x5, float x6, float x7) {
  uint4 v; v.x = cvt2(x0, x1); v.y = cvt2(x2, x3); v.z = cvt2(x4, x5); v.w = cvt2(x6, x7);
  return __builtin_bit_cast(bf16x8, v);
}

DI void retkv_mfma(const Params& p, int item) {
  const int lane = mytid() & 63, w = mytid() >> 6, r = lane & 31, h = lane >> 5;
  const int hh = item & 3, c = (item >> 2) & 63, b = item >> 8, bh = b * 4 + hh, s0 = c * 128;
  const int mi = w >> 1, nb = (w & 1) * 2;
  const bf16_t* vb_ = p.RVT + ((size_t)(bh * 128 + 32 * mi + r)) * SEQ + s0 + 8 * h;
  const bf16_t* k0 = p.RKT + ((size_t)(bh * 128 + 32 * nb + r)) * SEQ + s0 + 8 * h;
  const bf16_t* k1 = k0 + (size_t)32 * SEQ;
  f32x16 a0 = zero16(), a1 = zero16();
#pragma unroll
  for (int s = 0; s < 8; ++s) {
    bf16x8 a = ld16(vb_ + 16 * s), b0 = ld16(k0 + 16 * s), b1 = ld16(k1 + 16 * s);
    a0 = MFMA32(a, b0, a0); a1 = MFMA32(a, b1, a1);
  }
  float* dst = p.KV + (size_t)item * 16384;
#pragma unroll
  for (int e = 0; e < 16; ++e) {
    const int v = 32 * mi + crow(e, h);
    dst[v * 128 + 32 * nb + r] = a0[e];
    dst[v * 128 + 32 * nb + 32 + r] = a1[e];
  }
}
DI void scan_body(const Params& p, int idx) {
  const int e = idx & 16383, bh = idx >> 14, b = bh >> 2, h = bh & 3;
  const float cd = __expf(128.f * logg_h(h));
  float S = 0.f;
  for (int c0 = 0; c0 < 64; c0 += 32) {
    float kv[32];
#pragma unroll
    for (int u = 0; u < 32; ++u) kv[u] = p.KV[(size_t)((b * 64 + c0 + u) * 4 + h) * 16384 + e];
#pragma unroll
    for (int u = 0; u < 32; ++u) {
      p.SPREV[(size_t)((b * 64 + c0 + u) * 4 + h) * 16384 + e] = f2bf(S);
      S = cd * S + kv[u];
    }
  }
}
DI void retout_mfma(const Params& p, int task) {
  const int lane = mytid() & 63, r = lane & 31, h = lane >> 5;
  const int item = task >> 2, nt = task & 3;
  const int hh = item & 3, c = (item >> 2) & 63, b = item >> 8, bh = b * 4 + hh, s0 = c * 128, t0 = b * SEQ + s0;
  const float lg = logg_h(hh);
  const int n = 32 * nt + r;
  bf16x8 qf[8];
#pragma unroll
  for (int s = 0; s < 8; ++s) qf[s] = ld16(p.RQ + (size_t)(t0 + n) * 512 + hh * 128 + 16 * s + 8 * h);
  f32x16 acc[4];
#pragma unroll
  for (int vi = 0; vi < 4; ++vi) {
    acc[vi] = zero16();
    const bf16_t* sp = p.SPREV + (size_t)item * 16384 + (size_t)(32 * vi + r) * 128 + 8 * h;
#pragma unroll
    for (int s = 0; s < 8; ++s) acc[vi] = MFMA32(ld16(sp + 16 * s), qf[s], acc[vi]);
    __builtin_amdgcn_sched_barrier(0);
  }
  {
    const float xi = __expf((float)(n + 1) * lg);
#pragma unroll
    for (int vi = 0; vi < 4; ++vi)
#pragma unroll
      for (int e = 0; e < 16; ++e) acc[vi][e] *= xi;
  }
  for (int mt = 0; mt <= nt; ++mt) {
    f32x16 sa = zero16();
    const bf16_t* kp = p.RK + (size_t)(t0 + 32 * mt + r) * 512 + hh * 128 + 8 * h;
#pragma unroll
    for (int s = 0; s < 8; ++s) sa = MFMA32(ld16(kp + 16 * s), qf[s], sa);
    float pv[16];
#pragma unroll
    for (int e = 0; e < 16; ++e) {
      const int dm = n - (32 * mt + crow(e, h));
      pv[e] = (dm >= 0) ? sa[e] * __expf((float)dm * lg) : 0.f;
    }
#pragma unroll
    for (int s2 = 0; s2 < 2; ++s2) {
      bf16x8 bfr = pack8(pv[8 * s2], pv[8 * s2 + 1], pv[8 * s2 + 2], pv[8 * s2 + 3], pv[8 * s2 + 4], pv[8 * s2 + 5], pv[8 * s2 + 6], pv[8 * s2 + 7]);
#pragma unroll
      for (int vi = 0; vi < 4; ++vi) {
        bf16x8 afr = ld8x2(p.RVT + ((size_t)(bh * 128 + 32 * vi + r)) * SEQ + s0 + 32 * mt + 16 * s2 + 4 * h);
        acc[vi] = MFMA32(afr, bfr, acc[vi]);
      }
      __builtin_amdgcn_sched_barrier(0);
    }
  }
  float sum = 0.f;
#pragma unroll
  for (int vi = 0; vi < 4; ++vi)
#pragma unroll
    for (int e = 0; e < 16; ++e) sum += acc[vi][e];
  sum += __shfl_xor(sum, 32);
  const float mu = sum * (1.f / 128.f);
  float var = 0.f;
#pragma unroll
  for (int vi = 0; vi < 4; ++vi)
#pragma unroll
    for (int e = 0; e < 16; ++e) { float d = acc[vi][e] - mu; var += d * d; }
  var += __shfl_xor(var, 32);
  const float rs = rsqrtf(var * (1.f / 128.f) + 1e-6f);
#pragma unroll
  for (int vi = 0; vi < 4; ++vi)
#pragma unroll
    for (int g4 = 0; g4 < 4; ++g4) {
      const int v0 = 32 * vi + 8 * g4 + 4 * h;
      uint2 gt = *(const uint2*)(p.RGT + (size_t)(t0 + n) * 512 + hh * 128 + v0);
      float y0 = (acc[vi][4 * g4 + 0] - mu) * rs * __uint_as_float(gt.x << 16);
      float y1 = (acc[vi][4 * g4 + 1] - mu) * rs * __uint_as_float(gt.x & 0xffff0000u);
      float y2 = (acc[vi][4 * g4 + 2] - mu) * rs * __uint_as_float(gt.y << 16);
      float y3 = (acc[vi][4 * g4 + 3] - mu) * rs * __uint_as_float(gt.y & 0xffff0000u);
      *(uint2*)(p.RA + (size_t)(t0 + n) * DM + hh * 128 + v0) = pack4(y0, y1, y2, y3);
    }
}
#define HID_STRIDE 264
DI void compress_mfma(const Params& p, int item, char* smem) {
  float* PART = (float*)smem;
  bf16_t* HIDL = (bf16_t*)(smem + 4 * 16 * 256 * 4);
  const int tid = mytid(), lane = tid & 63, w = tid >> 6, r = lane & 31, h = lane >> 5;
  const int kv = item >> 7, bg = (item >> 5) & 3, rt = item & 31, n0 = rt * 16, b = bg >> 1, g = bg & 1;
  const bf16_t* src = kv ? p.NVC : p.NKC; const bf16_t* W1 = kv ? p.W1Tv : p.W1Tk; const bf16_t* W2 = kv ? p.W2Tv : p.W2Tk;
  const float* B1 = kv ? p.B1Pv : p.B1Pk;
  {
    const int kq = w >> 1, ch = w & 1;
    const int n = min(n0 + (r & 15), 510);
    const bf16_t* ab = src + ((size_t)(b * SEQ + 16 * n)) * 128 + g * 64 + 8 * h;
    const bf16_t* bb = W1 + (size_t)(128 * ch + r) * 2048 + 8 * h;
    f32x16 acc[4];
#pragma unroll
    for (int ct = 0; ct < 4; ++ct) acc[ct] = zero16();
#pragma unroll 4
    for (int s = 32 * kq; s < 32 * kq + 32; ++s) {
      const bf16x8 a = ld16(ab + (s >> 2) * 128 + (s & 3) * 16);
#pragma unroll
      for (int ct = 0; ct < 4; ++ct) acc[ct] = MFMA32(a, ld16(bb + (size_t)ct * 32 * 2048 + 16 * s), acc[ct]);
    }
#pragma unroll
    for (int ct = 0; ct < 4; ++ct)
#pragma unroll
      for (int e = 0; e < 8; ++e) PART[(kq * 16 + crow(e, h)) * 256 + 128 * ch + 32 * ct + r] = acc[ct][e];
  }
  __syncthreads();
#pragma unroll
  for (int i = 0; i < 8; ++i) {
    const int idx = tid + 512 * i, row = idx >> 8, col = idx & 255;
    const float v = PART[row * 256 + col] + PART[(16 + row) * 256 + col] + PART[(32 + row) * 256 + col] + PART[(48 + row) * 256 + col] + B1[col];
    HIDL[row * HID_STRIDE + col] = f2bf(gelu_tanh(v));
  }
  __syncthreads();
  if (w < 2) {
    f32x16 acc = zero16();
#pragma unroll
    for (int s = 0; s < 16; ++s) acc = MFMA32(ld16(HIDL + (r & 15) * HID_STRIDE + 16 * s + 8 * h), ld16(W2 + (size_t)(32 * w + r) * 256 + 16 * s + 8 * h), acc);
    const int e_ = 32 * w + r;
    if (kv == 0) {
#pragma unroll
      for (int e = 0; e < 8; ++e) { const int n = n0 + crow(e, h); p.KC[((size_t)bg * 512 + n) * 64 + e_] = (n < 511) ? f2bf(acc[e]) : (bf16_t)0; }
    } else {
#pragma unroll
      for (int g4 = 0; g4 < 2; ++g4) {
        const int n = n0 + 8 * g4 + 4 * h;
        float v3 = (n + 3 < 511) ? acc[4 * g4 + 3] : 0.f;
        *(uint2*)(p.VCT + ((size_t)bg * 64 + e_) * 512 + n) = pack4(acc[4 * g4], acc[4 * g4 + 1], acc[4 * g4 + 2], v3);
      }
    }
  }
  __syncthreads();
}
DI void kmax_body2(const Params& p, int vb) {
  const int tid = mytid(), g = tid & 1, t = vb * 256 + (tid >> 1), b = t >> 13;
  const bf16_t* k = p.NKS + (size_t)t * 128 + g * 64; const bf16_t* kw = p.NKW + (size_t)t * 128 + g * 64;
  float ss = 0.f, sw = 0.f;
  for (int d = 0; d < 64; d += 8) {
    uint4 a = *(const uint4*)(k + d), c = *(const uint4*)(kw + d);
    const unsigned aa[4] = {a.x, a.y, a.z, a.w}, cc[4] = {c.x, c.y, c.z, c.w};
#pragma unroll
    for (int q = 0; q < 4; ++q) {
      float x0 = __uint_as_float(aa[q] << 16), x1 = __uint_as_float(aa[q] & 0xffff0000u);
      float y0 = __uint_as_float(cc[q] << 16), y1 = __uint_as_float(cc[q] & 0xffff0000u);
      ss += x0 * x0 + x1 * x1; sw += y0 * y0 + y1 * y1;
    }
  }
  float m1 = sqrtf(ss), m2 = sqrtf(sw);
  for (int o = 2; o < 64; o <<= 1) { m1 = fmaxf(m1, __shfl_xor(m1, o)); m2 = fmaxf(m2, __shfl_xor(m2, o)); }
  if ((tid & 63) < 2) { atomicMax(&p.ksmax[b * 2 + g], __float_as_uint(m1)); atomicMax(&p.ksmax[4 + b * 2 + g], __float_as_uint(m2)); }
}
DI void kcmax_body(const Params& p, int idx) {
  const bf16_t* k = p.KC + (size_t)idx * 64;
  float ss = 0.f;
  for (int d = 0; d < 64; ++d) { float v = bf2f(k[d]); ss += v * v; }
  atomicMax(&p.ksmax[8 + (idx >> 9)], __float_as_uint(sqrtf(ss)));
}

#define NSA_IMP 0
#define NSA_SELM 65536
#define NSA_KV 66816
#define KV_ROW 144
#define KV_TILE (64 * KV_ROW)
template <int CTRL> DI float dpp_f2(float x) { return __builtin_bit_cast(float, __builtin_amdgcn_mov_dpp(__builtin_bit_cast(int, x), CTRL, 0xf, 0xf, true)); }
DI float quad_sum(float v) { v += dpp_f2<0xB1>(v); v += dpp_f2<0x4E>(v); return v; }
DI bf16x8 lds8x2(const char* ptr) {
  uint2 a = *(const uint2*)ptr, b = *(const uint2*)(ptr + 16);
  uint4 v; v.x = a.x; v.y = a.y; v.z = b.x; v.w = b.y;
  return __builtin_bit_cast(bf16x8, v);
}

DI void nsa_item(const Params& p, int item, char* smem) {
  const int tid = mytid(), lane = tid & 63, w = tid >> 6, r = lane & 31, h = lane >> 5;
  const int ti = item >> 2, bg = item & 3, b = bg >> 1, g = bg & 1;
  const int ts = ti * 64, tokg0 = b * SEQ + ts;
  const int tkl = 8 * w + (r >> 2), hl = r & 3, hd = g * 4 + hl, tpos = ts + tkl;
  float* IMPA = (float*)(smem + NSA_IMP); float* IMPB = IMPA + 64 * 128;
  unsigned* SELM = (unsigned*)(smem + NSA_SELM);
  char* KVB = smem + NSA_KV;
  const float ksm = __uint_as_float(p.ksmax[bg]), kwm = __uint_as_float(p.ksmax[4 + bg]), kcm = __uint_as_float(p.ksmax[8 + bg]);

  bf16x8 qf[4];
#pragma unroll
  for (int s = 0; s < 4; ++s) qf[s] = ld16(p.NQ + (size_t)(tokg0 + tkl) * 512 + hd * 64 + 16 * s + 8 * h);
  float qq = 0.f;
#pragma unroll
  for (int s = 0; s < 4; ++s) {
    uint4 u = __builtin_bit_cast(uint4, qf[s]);
    const unsigned uu[4] = {u.x, u.y, u.z, u.w};
#pragma unroll
    for (int q = 0; q < 4; ++q) { float x0 = __uint_as_float(uu[q] << 16), x1 = __uint_as_float(uu[q] & 0xffff0000u); qq += x0 * x0 + x1 * x1; }
  }
  qq += __shfl_xor(qq, 32);
  const float qn = sqrtf(qq);
  const int srow = tid >> 3, sch = tid & 7;
  const bf16_t* ksrc = p.NKS + ((size_t)(b * SEQ) + srow) * 128 + g * 64 + sch * 8;
  const bf16_t* vsrc = p.NVST + ((size_t)bg * 64 + srow) * SEQ + sch * 8;
  const bf16_t* kcs = p.KC + ((size_t)bg * 512 + srow) * 64 + sch * 8;
  const bf16_t* vcs = p.VCT + ((size_t)bg * 64 + srow) * 512 + sch * 8;
  char* sdst = KVB + srow * KV_ROW + sch * 16;
  {
    uint4 k0 = *(const uint4*)kcs, v0 = *(const uint4*)vcs;
    *(uint4*)sdst = k0; *(uint4*)(sdst + KV_TILE) = v0;
  }
  for (int q = tid; q < 64 * 128 * 2 / 4; q += NT) ((float4*)IMPA)[q] = make_float4(0.f, 0.f, 0.f, 0.f);
  __syncthreads();

#define RING_RUN(KS, KSTEP, VS, VSTEP, NTILES, NEED, COMPUTE)                                                                               \
  {                                                                                                                                         \
    for (int jj = 0; jj < (NTILES); ++jj) {                                                                                                 \
      uint4 ka_, va_;                                                                                                                       \
      ka_ = va_ = make_uint4(0u, 0u, 0u, 0u);                                                                                               \
      if (jj + 1 < (NTILES)) { ka_ = *(const uint4*)((KS) + (size_t)(jj + 1) * (KSTEP)); va_ = *(const uint4*)((VS) + (size_t)(jj + 1) * (VSTEP)); } \
      if (NEED(jj)) { const char* kb = KVB + (jj & 1) * 2 * KV_TILE; const char* vbuf = kb + KV_TILE; COMPUTE(jj, kb, vbuf) }               \
      if (jj + 1 < (NTILES)) { char* d2 = sdst + ((jj + 1) & 1) * 2 * KV_TILE; *(uint4*)d2 = ka_; *(uint4*)(d2 + KV_TILE) = va_; }          \
      __syncthreads();                                                                                                                      \
    }                                                                                                                                       \
  }
#define STAGE_PAIR0(KS, KSTEP, VS, VSTEP, NTILES) { uint4 k0_ = *(const uint4*)(KS), v0_ = *(const uint4*)(VS); *(uint4*)sdst = k0_; *(uint4*)(sdst + KV_TILE) = v0_; }
#define IMP_NONE(JJ, kh, pv)
#define ATT_EXP(x) ex2(x)
#define ATT_LSUM(LACC, pv) LACC += ((pv[0] + pv[1]) + (pv[2] + pv[3])) + ((pv[4] + pv[5]) + (pv[6] + pv[7])) + ((pv[8] + pv[9]) + (pv[10] + pv[11])) + ((pv[12] + pv[13]) + (pv[14] + pv[15]));
#define ATT_TILE(kb, vbuf, INIT, FULL, MASKEXPR, SCALE, ACC, LACC, IMPHOOK, JJ)                                                             \
          {                                                                                                                                 \
            bf16x8 kf_[2][4], vf_[2][2][2];       \
            _Pragma("unroll") for (int kh = 0; kh < 2; ++kh)                                                                                \
              _Pragma("unroll") for (int s = 0; s < 4; ++s) kf_[kh][s] = *(const bf16x8*)(kb + (32 * kh + r) * KV_ROW + (16 * s + 8 * h) * 2); \
            _Pragma("unroll") for (int kh = 0; kh < 2; ++kh)                                                                                \
              _Pragma("unroll") for (int di = 0; di < 2; ++di)                                                                              \
                _Pragma("unroll") for (int s2 = 0; s2 < 2; ++s2) vf_[kh][di][s2] = lds8x2(vbuf + (32 * di + r) * KV_ROW + (32 * kh + 16 * s2 + 4 * h) * 2); \
            const bool full_ = (FULL);                                                                                                      \
            _Pragma("unroll") for (int kh = 0; kh < 2; ++kh) {                                                                              \
              f32x16 sa = fill16(INIT);                                                                                                     \
              _Pragma("unroll") for (int s = 0; s < 4; ++s) sa = MFMA32(kf_[kh][s], qf[s], sa);                                             \
              float pv[16];                                                                                                                 \
              _Pragma("unroll") for (int e = 0; e < 16; ++e) pv[e] = ATT_EXP(sa[e]) * (SCALE);                                              \
              if (!full_) { _Pragma("unroll") for (int e = 0; e < 16; ++e) { const int key = 32 * kh + crow(e, h); pv[e] = (MASKEXPR) ? pv[e] : 0.f; } }     \
              ATT_LSUM(LACC, pv)                                                                                                             \
              IMPHOOK(JJ, kh, pv)                                                                                                           \
              const bf16x8 pk0 = pack8(pv[0], pv[1], pv[2], pv[3], pv[4], pv[5], pv[6], pv[7]);                                             \
              const bf16x8 pk1 = pack8(pv[8], pv[9], pv[10], pv[11], pv[12], pv[13], pv[14], pv[15]);                                       \
              _Pragma("unroll") for (int di = 0; di < 2; ++di) {                                                                            \
                ACC[di] = MFMA32(vf_[kh][di][0], pk0, ACC[di]);                                                                             \
                ACC[di] = MFMA32(vf_[kh][di][1], pk1, ACC[di]);                                                                             \
              }                                                                                                                             \
            }                                                                                                                               \
          }
  const float mbc = qn * kcm;
  int nvalid = (tpos >= 31) ? ((tpos - 31) >> 4) + 1 : 0;
  if (nvalid > 511) nvalid = 511;
  int nvw = (ts + 8 * w + 7 >= 31) ? ((ts + 8 * w + 7 - 31) >> 4) + 1 : 0;
  if (nvw > 511) nvw = 511;
  int nvmin = (ts + 8 * w >= 31) ? ((ts + 8 * w - 31) >> 4) + 1 : 0;
  if (nvmin > 511) nvmin = 511;
  int nvall = ((ts + 63 - 31) >> 4) + 1;
  if (nvall > 511) nvall = 511;
  const int nct = (nvall + 63) >> 6;
  float lsum = 0.f;
#define CMP_NEED(jj) (64 * (jj) < nvw)
#define CMPA_COMPUTE(jj, kb, vbuf)                                                                                                          \
          { _Pragma("unroll") for (int kh = 0; kh < 2; ++kh) {                                                                              \
              f32x16 sa = fill16(-mbc);                                                                                                     \
              _Pragma("unroll") for (int s = 0; s < 4; ++s) sa = MFMA32(*(const bf16x8*)(kb + (32 * kh + r) * KV_ROW + (16 * s + 8 * h) * 2), qf[s], sa); \
              const bool full_ = 64 * (jj) + 64 <= nvmin;                                                                                   \
              if (full_) { _Pragma("unroll") for (int e = 0; e < 16; ++e) lsum += ex2(sa[e]); }                                             \
              else { _Pragma("unroll") for (int e = 0; e < 16; ++e) lsum += (64 * (jj) + 32 * kh + crow(e, h) < nvalid) ? ex2(sa[e]) : 0.f; } \
            } }
  RING_RUN(kcs, 64 * 64, vcs, 64, nct, CMP_NEED, CMPA_COMPUTE)
  lsum += __shfl_xor(lsum, 32);
  const float invl = (lsum > 0.f) ? 1.f / lsum : 0.f;
  f32x16 oc[2]; oc[0] = zero16(); oc[1] = zero16();
  {
    float ldummy = 0.f;
    STAGE_PAIR0(kcs, 64 * 64, vcs, 64, nct) __syncthreads();
#define CMP_IMP(JJ, kh, pv)                                                                                                                 \
              _Pragma("unroll") for (int q = 0; q < 4; ++q) {                                                                               \
                float A_ = 2.f * (pv[4 * q] + pv[4 * q + 1] + pv[4 * q + 2]) + pv[4 * q + 3], B_ = pv[4 * q + 3];                           \
                A_ = quad_sum(A_); B_ = quad_sum(B_);                                                                                       \
                if (hl == 0) { const int j_ = 16 * (JJ) + 8 * kh + 2 * q + h; IMPA[tkl * 128 + j_] = A_; IMPB[tkl * 128 + j_] = B_; }        \
              }
#define CMPB_COMPUTE(jj, kb, vbuf) ATT_TILE(kb, vbuf, -mbc, 64 * (jj) + 64 <= nvmin, 64 * (jj) + key < nvalid, invl, oc, ldummy, CMP_IMP, jj)
    RING_RUN(kcs, 64 * 64, vcs, 64, nct, CMP_NEED, CMPB_COMPUTE)
  }
  for (int rep522 = 0; rep522 < (PROBE_DUP == 522 ? 2 : 1); ++rep522)
  {
    const int tl = 8 * w + (lane >> 3), sub = lane & 7;
    unsigned kv_[16], ki_[16];
#pragma unroll
    for (int c = 0; c < 16; ++c) {
      const int j = sub + 8 * c;
      float imp = IMPA[tl * 128 + j] + ((j > 0) ? IMPB[tl * 128 + j - 1] : 0.f);
      if (j == 0 || j == ti || j == ti - 1) imp = 1e9f;
      kv_[c] = (j <= ti) ? __float_as_uint(imp) : 0u;
      ki_[c] = (j <= ti) ? (unsigned)(128 - j) : 0u;
    }
    unsigned m0 = 0, m1 = 0, m2 = 0, m3 = 0;
    for (int it = 0; it < 16; ++it) {
      unsigned bv = kv_[0], bi = ki_[0];
#pragma unroll
      for (int c = 1; c < 16; ++c) { const bool gt = (kv_[c] > bv) || (kv_[c] == bv && ki_[c] > bi); bv = gt ? kv_[c] : bv; bi = gt ? ki_[c] : bi; }
#define TOPK_STEP(CTRL) { const unsigned ov = (unsigned)__builtin_amdgcn_mov_dpp((int)bv, CTRL, 0xf, 0xf, true), oi = (unsigned)__builtin_amdgcn_mov_dpp((int)bi, CTRL, 0xf, 0xf, true); \
        const bool gt = (ov > bv) || (ov == bv && oi > bi); bv = gt ? ov : bv; bi = gt ? oi : bi; }
      TOPK_STEP(0xB1) TOPK_STEP(0x4E) TOPK_STEP(0x141)
#undef TOPK_STEP
      if (bi != 0u) {
        const int js = 128 - (int)bi;
        const unsigned bit = 1u << (js & 31);
        if ((js >> 5) == 0) m0 |= bit; else if ((js >> 5) == 1) m1 |= bit; else if ((js >> 5) == 2) m2 |= bit; else m3 |= bit;
#pragma unroll
        for (int c = 0; c < 16; ++c) { const bool hit = (ki_[c] == bi); kv_[c] = hit ? 0u : kv_[c]; ki_[c] = hit ? 0u : ki_[c]; }
      }
    }
    if (sub == 0) { SELM[tl * 4 + 0] = m0; SELM[tl * 4 + 1] = m1; SELM[tl * 4 + 2] = m2; SELM[tl * 4 + 3] = m3; }
  }
  if (lane < 4) {
    unsigned u = 0;
#pragma unroll
    for (int t8 = 0; t8 < 8; ++t8) u |= SELM[(8 * w + t8) * 4 + lane];
    SELM[(64 + w) * 4 + lane] = u;
  }
  __syncthreads();
  const float* gt = p.GATE + (size_t)(tokg0 + tkl) * 24 + hd * 3;
  float* OUTL = IMPA;
  {
    const float g0 = gt[0];
#pragma unroll
    for (int e = 0; e < 16; ++e) { OUTL[e * 512 + tid] = g0 * oc[0][e]; OUTL[(16 + e) * 512 + tid] = g0 * oc[1][e]; }
  }
  STAGE_PAIR0(ksrc, 64 * 128, vsrc, 64, ti + 1) __syncthreads();
  const float mbs = qn * ksm;
  f32x16 osl[2]; osl[0] = zero16(); osl[1] = zero16();
  float lsel = 0.f;
#define SEL_NEED(jj) ((SELM[(64 + w) * 4 + ((jj) >> 5)] >> ((jj) & 31)) & 1u)
#define SEL_COMPUTE(jj, kb, vbuf) { const unsigned msel_ = SELM[tkl * 4 + ((jj) >> 5)]; \
      const float init_ = ((msel_ >> ((jj) & 31)) & 1u) ? -mbs : NEG_INF; ATT_TILE(kb, vbuf, init_, (jj) < ti, key <= tkl, 1.f, osl, lsel, IMP_NONE, jj) }
  RING_RUN(ksrc, 64 * 128, vsrc, 64, ti + 1, SEL_NEED, SEL_COMPUTE)
  lsel += __shfl_xor(lsel, 32);
  {
    const float g1 = gt[1] / lsel;
#pragma unroll
    for (int e = 0; e < 16; ++e) { OUTL[e * 512 + tid] += g1 * osl[0][e]; OUTL[(16 + e) * 512 + tid] += g1 * osl[1][e]; }
  }
#if PROBE_DUP >= 530 && PROBE_DUP <= 539
  {
    osl[0] = zero16(); osl[1] = zero16(); lsel = 0.f;
    STAGE_PAIR0(ksrc, 64 * 128, vsrc, 64, ti + 1) __syncthreads();
#if PROBE_DUP == 530
    RING_RUN(ksrc, 64 * 128, vsrc, 64, ti + 1, SEL_NEED, SEL_COMPUTE)
#elif PROBE_DUP == 531
    for (int jj = 0; jj < ti + 1; ++jj) {
      if (SEL_NEED(jj)) { const char* kb = KVB + (jj & 1) * 2 * KV_TILE; const char* vbuf = kb + KV_TILE; SEL_COMPUTE(jj, kb, vbuf) }
      __syncthreads();
    }
#elif PROBE_DUP == 532
    for (int jj = 0; jj < ti + 1; ++jj) {
      uint4 ka_, va_;
      ka_ = va_ = make_uint4(0u, 0u, 0u, 0u);
      if (jj + 1 < ti + 1) { ka_ = *(const uint4*)(ksrc + (size_t)(jj + 1) * (64 * 128)); va_ = *(const uint4*)(vsrc + (size_t)(jj + 1) * 64); }
      if (jj + 1 < ti + 1) { char* d2 = sdst + ((jj + 1) & 1) * 2 * KV_TILE; *(uint4*)d2 = ka_; *(uint4*)(d2 + KV_TILE) = va_; }
      __syncthreads();
    }
#elif PROBE_DUP >= 533
#if PROBE_DUP == 534
#undef ATT_LSUM
#define ATT_LSUM(LACC, pv) LACC += pv[0];
#elif PROBE_DUP == 535
#undef ATT_EXP
#define ATT_EXP(x) (x)
#elif PROBE_DUP == 536
#undef ATT_EXP
#define ATT_EXP(x) (x)
#undef ATT_LSUM
#define ATT_LSUM(LACC, pv) LACC += pv[0];
#endif
    for (int jj = 0; jj < ti + 1; ++jj) {
      if (SEL_NEED(jj)) { const char* kb = KVB + (jj & 1) * 2 * KV_TILE; const char* vbuf = kb + KV_TILE; SEL_COMPUTE(jj, kb, vbuf) }
    }
    __syncthreads();
#endif
#undef ATT_EXP
#undef ATT_LSUM
#define ATT_EXP(x) ex2(x)
#define ATT_LSUM(LACC, pv) LACC += ((pv[0] + pv[1]) + (pv[2] + pv[3])) + ((pv[4] + pv[5]) + (pv[6] + pv[7])) + ((pv[8] + pv[9]) + (pv[10] + pv[11])) + ((pv[12] + pv[13]) + (pv[14] + pv[15]));
    float chk = lsel;
#pragma unroll
    for (int e = 0; e < 16; ++e) chk += osl[0][e] + osl[1][e];
    if (__float_as_uint(chk) == 0x7fc12345u) OUTL[tid] += 1.f;
  }
#endif
  f32x16 ow[2]; ow[0] = zero16(); ow[1] = zero16();
  float lw = 0.f;
  const float mbw = qn * kwm;
  {
    const int j0w = (ti >= 8) ? ti - 8 : 0, nwt = ti - j0w + 1;
    const bf16_t* kws = p.NKW + ((size_t)(b * SEQ + 64 * j0w) + srow) * 128 + g * 64 + sch * 8;
    const bf16_t* vws = p.NVWT + ((size_t)bg * 64 + srow) * SEQ + 64 * j0w + sch * 8;
    STAGE_PAIR0(kws, 64 * 128, vws, 64, nwt) __syncthreads();
#define WIN_NEED(jj) true
#define WIN_COMPUTE(jj, kb, vbuf) { const int jw_ = j0w + (jj); const bool last_ = (jw_ == ti), first_ = (ti >= 8) && ((jj) == 0); \
      ATT_TILE(kb, vbuf, -mbw, !(last_ || first_), last_ ? (key <= tkl) : (key > tkl), 1.f, ow, lw, IMP_NONE, jj) }
    RING_RUN(kws, 64 * 128, vws, 64, nwt, WIN_NEED, WIN_COMPUTE)
  }
  lw += __shfl_xor(lw, 32);
  {
    const float g2 = gt[2] / lw;
#pragma unroll
    for (int di = 0; di < 2; ++di)
#pragma unroll
      for (int g4 = 0; g4 < 4; ++g4) {
        const int d0 = 32 * di + 8 * g4 + 4 * h;
        float y[4];
#pragma unroll
        for (int e = 0; e < 4; ++e) y[e] = OUTL[(16 * di + 4 * g4 + e) * 512 + tid] + g2 * ow[di][4 * g4 + e];
        *(uint2*)(p.RA + (size_t)(tokg0 + tkl) * DM + 512 + hd * 64 + d0) = pack4(y[0], y[1], y[2], y[3]);
      }
  }
  __syncthreads();
}

typedef float f32x4 __attribute__((ext_vector_type(4)));
#define MFMA16(a, b, c) __builtin_amdgcn_mfma_f32_16x16x32_bf16((a), (b), (c), 0, 0, 0)
constexpr int pk_clen(int i) { return 16 / (i + 1); }
constexpr int pk_coff(int i) { int s = 0; for (int q = 0; q < i; ++q) s += pk_clen(q); return s; }
constexpr int pk_cand(int c) {
  int i = 0; while (i < 16 && c >= pk_clen(i)) { c -= pk_clen(i); ++i; }
  return (i < 16) ? i * 16 + c : 256;
}
#define SC_STRIDE 132

DI void convert_row(const Params& p, int row, int lane);
DI unsigned f2key(float x, unsigned tag, unsigned tagmask) {
  const unsigned bits = __float_as_uint(x), m = (unsigned)((int)bits >> 31) | 0x80000000u;
  return ((bits ^ m) & ~tagmask) | tag;
}
DI float key2f(unsigned k, unsigned tagmask) {
  const unsigned u = k & ~tagmask;
  return __uint_as_float((u & 0x80000000u) ? (u ^ 0x80000000u) : ~u);
}
DI void peer_topk_tile(const Params& p, int vb, char* smem) {
  unsigned* SC = (unsigned*)smem;
  unsigned* ELK = (unsigned*)(smem + 256 * SC_STRIDE * 4);
  float* ELW = (float*)(ELK + 16 * 128);
  int* CT = (int*)(ELW + 16 * 128);
  const int tid = mytid(), lane = tid & 63, w = tid >> 6;
  const int t0 = vb * 16;
  if (tid < 64) { int i = 0, c = tid; while (i < 16 && c >= 16 / (i + 1)) { c -= 16 / (i + 1); ++i; } CT[tid] = (i < 16) ? i * 16 + c : 0; }
  for (int rep91 = 0; rep91 < (PROBE_DUP == 91 ? 2 : 1); ++rep91) {
    const int tq = lane & 15, kq = lane >> 4;
#pragma unroll
    for (int pi = 0; pi < 2; ++pi) {
      const int ph = 2 * w + pi;
      bf16x8 bfr[4];
#pragma unroll
      for (int s = 0; s < 4; ++s) bfr[s] = *(const bf16x8*)(p.PQ + (size_t)(t0 + tq) * 2048 + ph * 128 + 32 * s + 8 * kq);
#pragma unroll
      for (int j = 0; j < 8; ++j) {
        f32x4 acc = {0.f, 0.f, 0.f, 0.f};
#pragma unroll
        for (int s = 0; s < 4; ++s) {
          bf16x8 afr = *(const bf16x8*)(p.SUBK + ((size_t)(ph * 128 + 16 * j + tq)) * 128 + 32 * s + 8 * kq);
          acc = MFMA16(afr, bfr[s], acc);
        }
        const int n0 = 16 * j + 4 * kq;
        uint4 kv4;
        kv4.x = f2key(acc[0], 127u - n0, 127u); kv4.y = f2key(acc[1], 126u - n0, 127u); kv4.z = f2key(acc[2], 125u - n0, 127u); kv4.w = f2key(acc[3], 124u - n0, 127u);
        *(uint4*)(SC + (ph * 16 + tq) * SC_STRIDE + n0) = kv4;
      }
    }
  }
  __syncthreads();
  if (tid < 256) {
    unsigned* row = SC + tid * SC_STRIDE;
    unsigned gmax[16];
#pragma unroll
    for (int g = 0; g < 16; ++g) {
      uint4 a = *(uint4*)(row + g * 8), b = *(uint4*)(row + g * 8 + 4);
      gmax[g] = max(max(max(a.x, a.y), max(a.z, a.w)), max(max(b.x, b.y), max(b.z, b.w)));
    }
    unsigned outk[16];
#pragma unroll
    for (int k = 0; k < 16; ++k) {
      unsigned m = max(max(max(max(gmax[0], gmax[1]), max(gmax[2], gmax[3])), max(max(gmax[4], gmax[5]), max(gmax[6], gmax[7]))),
                       max(max(max(gmax[8], gmax[9]), max(gmax[10], gmax[11])), max(max(gmax[12], gmax[13]), max(gmax[14], gmax[15]))));
      const int n = 127 - (int)(m & 127u), gi = n >> 3;
      unsigned* gp = row + gi * 8;
      uint4 a = *(uint4*)gp, b = *(uint4*)(gp + 4);
      const unsigned v[8] = {a.x, a.y, a.z, a.w, b.x, b.y, b.z, b.w};
      unsigned nm = 0u;
#pragma unroll
      for (int e = 0; e < 8; ++e) nm = max(nm, (v[e] == m) ? 0u : v[e]);
      row[n] = 0u;
#pragma unroll
      for (int g = 0; g < 16; ++g) gmax[g] = (g == gi) ? nm : gmax[g];
      outk[k] = m;
    }
#pragma unroll
    for (int k = 0; k < 16; ++k) row[k] = outk[k];
  } else {
#pragma unroll
    for (int i = 0; i < 4; ++i) convert_row(p, (vb * 4 + (w - 4)) * 8 + 2 * i, lane);
  }
  __syncthreads();
  for (int rep93 = 0; rep93 < (PROBE_DUP == 93 ? 2 : 1); ++rep93) {
    const int q = tid >> 2, sub = tid & 3, t = q >> 3, pp = q & 7;
    const unsigned* ra = SC + ((2 * pp) * 16 + t) * SC_STRIDE;
    const unsigned* rb = SC + ((2 * pp + 1) * 16 + t) * SC_STRIDE;
    unsigned ck[13];
#pragma unroll
    for (int k = 0; k < 13; ++k) {
      const int ij = (sub == 0) ? pk_cand(4 * k) : (sub == 1) ? pk_cand(4 * k + 1) : (sub == 2) ? pk_cand(4 * k + 2) : pk_cand(4 * k + 3);
      const int ord = 4 * k + sub;
      ck[k] = (ij < 256) ? f2key(key2f(ra[ij >> 4], 127u) + key2f(rb[ij & 15], 127u), (unsigned)(63 - ord), 63u) : 0u;
    }
    unsigned w16[16];
#pragma unroll
    for (int k = 0; k < 16; ++k) {
      unsigned bm = max(max(max(max(ck[0], ck[1]), max(ck[2], ck[3])), max(max(ck[4], ck[5]), max(ck[6], ck[7]))), max(max(max(ck[8], ck[9]), max(ck[10], ck[11])), ck[12]));
      bm = max(bm, (unsigned)__builtin_amdgcn_mov_dpp((int)bm, 0xB1, 0xf, 0xf, true));
      bm = max(bm, (unsigned)__builtin_amdgcn_mov_dpp((int)bm, 0x4E, 0xf, 0xf, true));
#pragma unroll
      for (int c = 0; c < 13; ++c) ck[c] = (ck[c] == bm) ? 0u : ck[c];
      w16[k] = bm;
    }
    float l = 0.f; const float vmax = key2f(w16[0], 63u);
    float ev[16];
#pragma unroll
    for (int k = 0; k < 16; ++k) { ev[k] = __expf(key2f(w16[k], 63u) - vmax); l += ev[k]; }
    const float inv = 1.f / l;
#pragma unroll
    for (int k = 0; k < 16; ++k)
      if ((k & 3) == sub) {
        const int ij = CT[63 - (int)(w16[k] & 63u)];
        const int code = (127 - (int)(ra[ij >> 4] & 127u)) * 128 + (127 - (int)(rb[ij & 15] & 127u));
        ELK[t * 128 + pp * 16 + k] = ((unsigned)code << 7) | (unsigned)(pp * 16 + k);
        ELW[t * 128 + pp * 16 + k] = ev[k] * inv;
      }
  }
  __syncthreads();
  for (int rep94 = 0; rep94 < (PROBE_DUP == 94 ? 2 : 1); ++rep94)
#pragma unroll
  for (int tt = 0; tt < 2; ++tt) {
    const int t = 2 * w + tt;
    const unsigned e0 = ELK[t * 128 + 2 * lane], e1 = ELK[t * 128 + 2 * lane + 1];
    int r0 = 0, r1 = 0;
#pragma unroll 8
    for (int c = 0; c < 32; ++c) {
      const uint4 kq = *(const uint4*)(ELK + t * 128 + 4 * c);
      r0 += (kq.x < e0) + (kq.y < e0) + (kq.z < e0) + (kq.w < e0);
      r1 += (kq.x < e1) + (kq.y < e1) + (kq.z < e1) + (kq.w < e1);
    }
    const size_t gb = (size_t)(t0 + t) * 128;
    p.EIDX[gb + r0] = (int)(e0 >> 7); p.EIDX[gb + r1] = (int)(e1 >> 7);
    p.EW[gb + r0] = ELW[t * 128 + (e0 & 127)]; p.EW[gb + r1] = ELW[t * 128 + (e1 & 127)];
  }
  __syncthreads();
}

DI float dot2bf(unsigned a, unsigned b, float acc) { return __builtin_amdgcn_fdot2_f32_bf16(__builtin_bit_cast(bf16x2_t, a), __builtin_bit_cast(bf16x2_t, b), acc, false); }
template <int CTRL> DI float dpp_f(float x) { return __builtin_bit_cast(float, __builtin_amdgcn_mov_dpp(__builtin_bit_cast(int, x), CTRL, 0xf, 0xf, true)); }
DI float row16_sum(float v) { v += dpp_f<0x128>(v); v += dpp_f<0x124>(v); v += dpp_f<0x122>(v); v += dpp_f<0x121>(v); return v; }
DI float dot_row(const uint4 (&u)[8], const uint4 (&h)[8]) {
  float d = 0.f;
#pragma unroll
  for (int j = 0; j < 8; ++j) { d = dot2bf(u[j].x, h[j].x, d); d = dot2bf(u[j].y, h[j].y, d); d = dot2bf(u[j].z, h[j].z, d); d = dot2bf(u[j].w, h[j].w, d); }
  return row16_sum(d);
}
DI void axpy_row(float (&acc)[64], const uint4 (&v)[8], float c) {
#pragma unroll
  for (int j = 0; j < 8; ++j) {
    const unsigned ww[4] = {v[j].x, v[j].y, v[j].z, v[j].w};
#pragma unroll
    for (int q = 0; q < 4; ++q) {
      acc[j * 8 + 2 * q] += c * __uint_as_float(ww[q] << 16);
      acc[j * 8 + 2 * q + 1] += c * __uint_as_float(ww[q] & 0xffff0000u);
    }
  }
}
DI void axpy_half(float (&acc)[32], const uint4 (&v)[4], float c) {
#pragma unroll
  for (int j = 0; j < 4; ++j) {
    const unsigned ww[4] = {v[j].x, v[j].y, v[j].z, v[j].w};
#pragma unroll
    for (int q = 0; q < 4; ++q) {
      acc[j * 8 + 2 * q] += c * __uint_as_float(ww[q] << 16);
      acc[j * 8 + 2 * q + 1] += c * __uint_as_float(ww[q] & 0xffff0000u);
    }
  }
}
#ifndef PEER_TILE_SHIFT
#define PEER_TILE_SHIFT 8
#endif
DI void fma16_fp8(float& d, const uint4& u, const float* hv) {
  const unsigned ww[4] = {u.x, u.y, u.z, u.w};
#pragma unroll
  for (int q = 0; q < 4; ++q) {
    f32x2_t a = __builtin_amdgcn_cvt_pk_f32_fp8((int)ww[q], false), b = __builtin_amdgcn_cvt_pk_f32_fp8((int)ww[q], true);
    d += a[0] * hv[4 * q] + a[1] * hv[4 * q + 1] + b[0] * hv[4 * q + 2] + b[1] * hv[4 * q + 3];
  }
}
DI float dot_row8(const uint4 (&u)[4], const float (&hv)[64]) {
  float d0 = 0.f, d1 = 0.f;
  fma16_fp8(d0, u[0], hv); fma16_fp8(d1, u[1], hv + 16); fma16_fp8(d0, u[2], hv + 32); fma16_fp8(d1, u[3], hv + 48);
  return row16_sum(d0 + d1);
}
DI void axpy_row8(float (&acc)[64], const uint4 (&v)[4], float c) {
#pragma unroll
  for (int j = 0; j < 4; ++j) {
    const unsigned ww[4] = {v[j].x, v[j].y, v[j].z, v[j].w};
#pragma unroll
    for (int q = 0; q < 4; ++q) {
      f32x2_t a = __builtin_amdgcn_cvt_pk_f32_fp8((int)ww[q], false), b = __builtin_amdgcn_cvt_pk_f32_fp8((int)ww[q], true);
      acc[j * 16 + 4 * q] += c * a[0]; acc[j * 16 + 4 * q + 1] += c * a[1]; acc[j * 16 + 4 * q + 2] += c * b[0]; acc[j * 16 + 4 * q + 3] += c * b[1];
    }
  }
}
typedef float f32x32_t __attribute__((ext_vector_type(32)));
typedef float f32x16_t __attribute__((ext_vector_type(16)));
typedef unsigned u32x6_t __attribute__((ext_vector_type(6)));
#define ROW6_BYTES 768
#define PIN(one, x) asm volatile("" : "+v"(one), "+v"(x))
DI float dot_row6(const uint4 (&X)[2], const uint2 (&Y)[2], const float (&hv)[64], float& one, float& d0, float& d1) {
  u32x6_t pa, pb;
  pa[0] = X[0].x; pa[1] = X[0].y; pa[2] = X[0].z; pa[3] = X[0].w; pa[4] = Y[0].x; pa[5] = Y[0].y;
  pb[0] = X[1].x; pb[1] = X[1].y; pb[2] = X[1].z; pb[3] = X[1].w; pb[4] = Y[1].x; pb[5] = Y[1].y;
  PIN(one, d0);
  d0 = 0.f; d1 = 0.f;
  {
    const f32x32_t fa = __builtin_amdgcn_cvt_scalef32_pk32_f32_fp6(pa, one);
#pragma unroll
    for (int k = 0; k < 32; k += 2) { d0 += fa[k] * hv[k]; d1 += fa[k + 1] * hv[k + 1]; }
  }
  PIN(one, d0);
  {
    const f32x32_t fb = __builtin_amdgcn_cvt_scalef32_pk32_f32_fp6(pb, one);
#pragma unroll
    for (int k = 0; k < 32; k += 2) { d0 += fb[k] * hv[32 + k]; d1 += fb[k + 1] * hv[32 + k + 1]; }
  }
  return row16_sum(d0 + d1);
}
DI void axpy_row6(float (&acc)[64], const uint4 (&X)[2], const uint2 (&Y)[2], float c, float& one) {
  u32x6_t pa, pb;
  pa[0] = X[0].x; pa[1] = X[0].y; pa[2] = X[0].z; pa[3] = X[0].w; pa[4] = Y[0].x; pa[5] = Y[0].y;
  pb[0] = X[1].x; pb[1] = X[1].y; pb[2] = X[1].z; pb[3] = X[1].w; pb[4] = Y[1].x; pb[5] = Y[1].y;
  PIN(one, acc[63]);
  {
    const f32x32_t fa = __builtin_amdgcn_cvt_scalef32_pk32_f32_fp6(pa, one);
#pragma unroll
    for (int k = 0; k < 32; ++k) acc[k] += c * fa[k];
  }
  PIN(one, acc[31]);
  {
    const f32x32_t fb = __builtin_amdgcn_cvt_scalef32_pk32_f32_fp6(pb, one);
#pragma unroll
    for (int k = 0; k < 32; ++k) acc[32 + k] += c * fb[k];
  }
}
DI void peer_gather_block(const Params& p, int vb, char* smem) {
  unsigned* ELK = (unsigned*)smem;
  float* ELC = (float*)(smem + 32768);
  const int tid = mytid(), lane = tid & 63, w = tid >> 6, grp = lane >> 4, i = lane & 15;
  const int tokbase = vb * 64;
  float* ELS = (float*)(smem + 65536);
  for (int q = tid; q < 64 * 128 / 4; q += NT) {
    const uint4 k4 = ((const uint4*)(p.EIDX + (size_t)tokbase * 128))[q];
    float4 w4 = ((const float4*)(p.EW + (size_t)tokbase * 128))[q];
    ((uint4*)ELK)[q] = k4;
    w4.x *= p.SUP[k4.x]; w4.y *= p.SUP[k4.y]; w4.z *= p.SUP[k4.z]; w4.w *= p.SUP[k4.w];
    ((float4*)ELC)[q] = w4;
    ((float4*)ELS)[q] = make_float4(p.SDN[k4.x], p.SDN[k4.y], p.SDN[k4.z], p.SDN[k4.w]);
  }
  __syncthreads();
#pragma unroll 1
  for (int tt = 0; tt < 2; ++tt) {
    const int tid_ = mytid(), i = tid_ & 15;
    const int tl = (tid_ >> 6) * 8 + ((tid_ & 63) >> 4) * 2 + tt, tok = tokbase + tl;
    const unsigned* kk = ELK + tl * 128;
    float* cc = ELC + tl * 128;
    const float* sdn = ELS + tl * 128;
    uint4 b0[2], b1[2], b2[2], b3[2]; uint2 c0[2], c1[2], c2[2], c3[2];
    float one = 1.0f, dd0 = 0.f, dd1 = 0.f;
#define ROW_LOAD(BUF, CUF, BASE, E) { const unsigned char* r_ = (BASE) + (size_t)kk[E] * ROW6_BYTES; \
      BUF[0] = *(const uint4*)(r_ + i * 16); CUF[0] = *(const uint2*)(r_ + 256 + i * 8); BUF[1] = *(const uint4*)(r_ + 384 + i * 16); CUF[1] = *(const uint2*)(r_ + 640 + i * 8); }
    {
      float hv[64];
#pragma unroll
      for (int j = 0; j < 4; ++j)
#pragma unroll
        for (int hf = 0; hf < 2; ++hf) {
          uint4 a = *(const uint4*)(p.RA + (size_t)tok * DM + j * 256 + i * 16 + hf * 8);
          const unsigned aa[4] = {a.x, a.y, a.z, a.w};
#pragma unroll
          for (int q = 0; q < 4; ++q) { hv[j * 16 + hf * 8 + 2 * q] = __uint_as_float(aa[q] << 16); hv[j * 16 + hf * 8 + 2 * q + 1] = __uint_as_float(aa[q] & 0xffff0000u); }
        }
      const unsigned char* ub_ = p.PDN8;
#define DN_COMP(BUF, CUF, E) { float d_ = dot_row6(BUF, CUF, hv, one, dd0, dd1) * sdn[E]; float c_ = cc[E] * gelu_tanh(d_); if (i == 0) cc[E] = c_; }
      ROW_LOAD(b0, c0, ub_, 0) ROW_LOAD(b1, c1, ub_, 1) ROW_LOAD(b2, c2, ub_, 2) ROW_LOAD(b3, c3, ub_, 3)
      for (int e = 0; e < 128; e += 4) {
        DN_COMP(b0, c0, e)     ROW_LOAD(b0, c0, ub_, (e + 4) & 127)
        DN_COMP(b1, c1, e + 1) ROW_LOAD(b1, c1, ub_, (e + 5) & 127)
        DN_COMP(b2, c2, e + 2) ROW_LOAD(b2, c2, ub_, (e + 6) & 127)
        DN_COMP(b3, c3, e + 3) ROW_LOAD(b3, c3, ub_, (e + 7) & 127)
      }
#undef DN_COMP
#if PROBE_DUP >= 101 && PROBE_DUP <= 103
      {
        float chk = 0.f; unsigned xk = 0u;
#define DN_PROBE(BUF, CUF, E) { float d_ = dot_row6(BUF, CUF, hv, one, dd0, dd1) * sdn[E]; chk += cc[E] * gelu_tanh(d_); }
#define DN_XOR(BUF, CUF, E) { xk ^= BUF[0].x ^ BUF[0].y ^ BUF[0].z ^ BUF[0].w ^ BUF[1].x ^ BUF[1].y ^ BUF[1].z ^ BUF[1].w ^ CUF[0].x ^ CUF[0].y ^ CUF[1].x ^ CUF[1].y; }
        ROW_LOAD(b0, c0, ub_, 0) ROW_LOAD(b1, c1, ub_, 1) ROW_LOAD(b2, c2, ub_, 2) ROW_LOAD(b3, c3, ub_, 3)
        for (int e = 0; e < 128; e += 4) {
#if PROBE_DUP == 101
          DN_PROBE(b0, c0, e)     if (e + 4 < 128) ROW_LOAD(b0, c0, ub_, e + 4)
          DN_PROBE(b1, c1, e + 1) if (e + 4 < 128) ROW_LOAD(b1, c1, ub_, e + 5)
          DN_PROBE(b2, c2, e + 2) if (e + 4 < 128) ROW_LOAD(b2, c2, ub_, e + 6)
          DN_PROBE(b3, c3, e + 3) if (e + 4 < 128) ROW_LOAD(b3, c3, ub_, e + 7)
#elif PROBE_DUP == 102
          DN_XOR(b0, c0, e)     if (e + 4 < 128) ROW_LOAD(b0, c0, ub_, e + 4)
          DN_XOR(b1, c1, e + 1) if (e + 4 < 128) ROW_LOAD(b1, c1, ub_, e + 5)
          DN_XOR(b2, c2, e + 2) if (e + 4 < 128) ROW_LOAD(b2, c2, ub_, e + 6)
          DN_XOR(b3, c3, e + 3) if (e + 4 < 128) ROW_LOAD(b3, c3, ub_, e + 7)
#else
          DN_PROBE(b0, c0, e) DN_PROBE(b1, c1, e + 1) DN_PROBE(b2, c2, e + 2) DN_PROBE(b3, c3, e + 3)
          b0[0].x ^= __float_as_uint(chk) & 1u;
#endif
        }
        if (__float_as_uint(chk) == 0x7fc12345u || xk == 0x9e3779b9u) cc[0] += 1.f;
#undef DN_PROBE
#undef DN_XOR
      }
#endif
    }
    {
      float acc[64];
#pragma unroll
      for (int e = 0; e < 64; ++e) acc[e] = 0.f;
      const unsigned char* vbase = p.PUP8;
      ROW_LOAD(b0, c0, vbase, 0) ROW_LOAD(b1, c1, vbase, 1) ROW_LOAD(b2, c2, vbase, 2) ROW_LOAD(b3, c3, vbase, 3)
      for (int e = 0; e < 128; e += 4) {
        axpy_row6(acc, b0, c0, cc[e], one);     ROW_LOAD(b0, c0, vbase, (e + 4) & 127)
        axpy_row6(acc, b1, c1, cc[e + 1], one); ROW_LOAD(b1, c1, vbase, (e + 5) & 127)
        axpy_row6(acc, b2, c2, cc[e + 2], one); ROW_LOAD(b2, c2, vbase, (e + 6) & 127)
        axpy_row6(acc, b3, c3, cc[e + 3], one); ROW_LOAD(b3, c3, vbase, (e + 7) & 127)
      }
      int tokl = tok; asm volatile("" : "+v"(tokl));
      const int b = tokl >> 13;
      const float* ga2 = p.mod + b * 6144 + 5120;
      const float* orow = p.out + (size_t)tokl * DM; float* grow = p.gout + (size_t)tokl * DM;
      float ss = 0.f;
#pragma unroll
      for (int j = 0; j < 4; ++j)
#pragma unroll
        for (int q4 = 0; q4 < 4; ++q4) {
          const int col = j * 256 + i * 16 + q4 * 4;
          float4 x1 = *(const float4*)(orow + col), gg = *(const float4*)(ga2 + col);
          float* q = acc + j * 16 + q4 * 4;
          q[0] = x1.x + gg.x * q[0]; q[1] = x1.y + gg.y * q[1]; q[2] = x1.z + gg.z * q[2]; q[3] = x1.w + gg.w * q[3];
          ss += q[0] * q[0] + q[1] * q[1] + q[2] * q[2] + q[3] * q[3];
        }
      float4 gf[16];
#pragma unroll
      for (int j = 0; j < 4; ++j)
#pragma unroll
        for (int q4 = 0; q4 < 4; ++q4) gf[j * 4 + q4] = *(const float4*)(p.g_final + j * 256 + i * 16 + q4 * 4);
      ss = row16_sum(ss);
      const float rstd = rsqrtf(ss * (1.f / DM) + 1e-6f);
#pragma unroll
      for (int j = 0; j < 4; ++j)
#pragma unroll
        for (int q4 = 0; q4 < 4; ++q4) {
          const int col = j * 256 + i * 16 + q4 * 4;
          const float4 g4 = gf[j * 4 + q4];
          const float* q = acc + j * 16 + q4 * 4;
          *(float4*)(grow + col) = make_float4(q[0] * rstd * g4.x, q[1] * rstd * g4.y, q[2] * rstd * g4.z, q[3] * rstd * g4.w);
        }
    }
#undef ROW_LOAD
  }
  __syncthreads();
}
DI void convert_row(const Params& p, int row2, int lane) {
  const int row = row2 + (lane >> 5), L = lane & 31, i = L >> 1, gsel = L & 1;
  const int tb = row >> 14, rr = row & 16383;
  const float* src = (tb ? p.peer_up : p.peer_down) + (size_t)rr * DM + gsel * 512 + i * 16;
  float4 xa[4], xb[4]; float am = 0.f;
#pragma unroll
  for (int q = 0; q < 4; ++q) {
    xa[q] = *(const float4*)(src + q * 4); xb[q] = *(const float4*)(src + 256 + q * 4);
    am = fmaxf(am, fmaxf(fmaxf(fabsf(xa[q].x), fabsf(xa[q].y)), fmaxf(fabsf(xa[q].z), fabsf(xa[q].w))));
    am = fmaxf(am, fmaxf(fmaxf(fabsf(xb[q].x), fabsf(xb[q].y)), fmaxf(fabsf(xb[q].z), fabsf(xb[q].w))));
  }
  for (int o = 16; o; o >>= 1) am = fmaxf(am, __shfl_xor(am, o));
  const float sc = (am > 0.f) ? am * (1.f / 7.5f) : 1.f, inv = (am > 0.f) ? 7.5f / am : 1.f;
  f32x16_t va, vb;
  {
    float X[32];
#pragma unroll
    for (int q = 0; q < 4; ++q) {
      X[4 * q] = xa[q].x * inv; X[4 * q + 1] = xa[q].y * inv; X[4 * q + 2] = xa[q].z * inv; X[4 * q + 3] = xa[q].w * inv;
      X[16 + 4 * q] = xb[q].x * inv; X[16 + 4 * q + 1] = xb[q].y * inv; X[16 + 4 * q + 2] = xb[q].z * inv; X[16 + 4 * q + 3] = xb[q].w * inv;
    }
#pragma unroll
    for (int k = 0; k < 16; ++k) { va[k] = X[2 * k]; vb[k] = X[2 * k + 1]; }
  }
  const u32x6_t pk = __builtin_amdgcn_cvt_scalef32_2xpk16_fp6_f32(va, vb, 1.0f);
  unsigned char* dst = (tb ? p.PUP8 : p.PDN8) + (size_t)rr * ROW6_BYTES + gsel * 384;
  *(uint4*)(dst + i * 16) = make_uint4(pk[0], pk[1], pk[2], pk[3]);
  *(uint2*)(dst + 256 + i * 8) = make_uint2(pk[4], pk[5]);
  if (L == 0) (tb ? p.SUP : p.SDN)[rr] = sc;
}

#define N_PHASES 11
template <int PH>
DI void run_phase(const Params& p, char* smem) {
  const int nb = gridDim.x, bid = blockIdx.x, tid = mytid();
  if (PH == 0) {
    for (int vb = bid; vb < PH0_MOD; vb += nb) ph0_body(p, vb, smem);
  } else if (PH == 1) {
    constexpr int kPrepA = (PH0_WIN - PH0_MOD) + (PH0_ROPE - PH0_SUBK);
    for (int vb = bid; vb < T_TOK / 8 + kPrepA; vb += nb) {
      if (vb < T_TOK / 8) rownorm_body(p.x, p.g_mix, p.mod, 0, 1024, p.RA, vb);
      else { const int j = vb - T_TOK / 8; ph0_body(p, (j < PH0_WIN - PH0_MOD) ? PH0_MOD + j : PH0_SUBK + (j - (PH0_WIN - PH0_MOD)), smem); }
    }
  } else if (PH == 2) {
    {
      pg8::StaticOrder S; S.init(T_TOK, NPROJ, nb, bid);
      const pg8::Gemm g{p.RA, p.WinT, T_TOK, NPROJ, 1024};
      pg8::gemm_phase((PG8_LAS unsigned char*)smem, g, S, EpiProj8{p});
    }
    {
      constexpr int kPrepB = (PH0_W2V - PH0_WQ) + (PH0_B1P - PH0_ROPE);
      const int rem = (64 * 14) % nb;
      if (rem == 0 || bid >= rem) {
        for (int j = (rem == 0) ? bid : bid - rem; j < kPrepB; j += (rem == 0) ? nb : nb - rem)
          ph0_body(p, (j < PH0_W2V - PH0_WQ) ? PH0_WQ + j : PH0_ROPE + (j - (PH0_W2V - PH0_WQ)), smem);
      }
    }
  } else if (PH == 3) {
    for (int vb = bid; vb < 256 + 512 + 64; vb += nb) {
      if (vb < 256) compress_mfma(p, vb, smem);
      else if (vb < 256 + 512) retkv_mfma(p, vb - 256);
      else kmax_body2(p, vb - 768);
    }
  } else if (PH == 4) {
    constexpr int kPrepC = (PH0_WQ - PH0_WIN) + (PH0_SUBK - PH0_W2V);
    for (int vb = bid; vb < 256 + 4 + kPrepC; vb += nb) {
      if (vb < 256) scan_body(p, vb * NT + tid);
      else if (vb < 260) kcmax_body(p, (vb - 256) * NT + tid);
      else { const int j = vb - 260; ph0_body(p, (j < PH0_WQ - PH0_WIN) ? PH0_WIN + j : PH0_W2V + (j - (PH0_WQ - PH0_WIN)), smem); }
    }
  } else if (PH == 5) {
    for (int rep = 0; rep < (PROBE_DUP == 51 ? 2 : 1); ++rep)
      for (int vb = bid; vb < 256; vb += nb) retout_mfma(p, vb * 8 + (tid >> 6));
    for (int rep = 0; rep < (PROBE_DUP == 52 ? 2 : 1); ++rep)
      for (int vb = bid; vb < 512; vb += nb) nsa_item(p, (vb < 256) ? vb : 767 - vb, smem);
  } else if (PH == 6) {
    pg8::StaticOrder S; S.init(T_TOK, 1024, nb, bid);
    const pg8::Gemm g{p.RA, p.WoutT, T_TOK, 1024, 1024};
    pg8::gemm_phase((PG8_LAS unsigned char*)smem, g, S, EpiOut8{p.x, p.out, p.mod});
  } else if (PH == 7) {
    for (int vb = bid; vb < T_TOK / 8; vb += nb) rownorm_body(p.out, p.g_ffn, p.mod, 3072, 4096, p.RA, vb);
  } else if (PH == 8) {
    pg8::StaticOrder S; S.init(T_TOK, 2048, nb, bid);
    const pg8::Gemm g{p.RA, p.WqT, T_TOK, 2048, 1024};
    pg8::gemm_phase((PG8_LAS unsigned char*)smem, g, S, EpiPQ8{p.PQ});
  } else if (PH == 9) {
    for (int vb = bid; vb < T_TOK / 16; vb += nb) peer_topk_tile(p, vb, smem);
  } else if (PH == 10) {
    for (int vb = bid; vb < T_TOK / 64; vb += nb) peer_gather_block(p, vb, smem);
  }
}


#define XB_TMO      128
#define XB_XCNT(j)  (256  + 64 * (j))
#define XB_XSUB(j)  (1280 + 64 * (j))
#define XB_XGEN(j)  (2304 + 64 * (j))
#define XB_TOP      3328
#define XB_TOPGEN   3392
#define XCD_BAR_WORDS 3456
#define XB_SPIN_CAP (1u << 22)
#define LAS __attribute__((address_space(3)))
DI unsigned xb_ld(unsigned* p) { return __hip_atomic_load(p, __ATOMIC_RELAXED, __HIP_MEMORY_SCOPE_AGENT); }
DI unsigned xb_add(unsigned* p, unsigned v) { return __hip_atomic_fetch_add(p, v, __ATOMIC_RELAXED, __HIP_MEMORY_SCOPE_AGENT); }
DI unsigned xb_xcc_id() { return (unsigned)__builtin_amdgcn_s_getreg((3 << 11) | 20) & 0xFu; }
#define XB_SPIN(cond, bar) do { unsigned _sp = 0; while (cond) { __builtin_amdgcn_s_sleep(1); \
    if ((++_sp & 255u) == 0u) { if (xb_ld(&(bar)[XB_TMO])) break; if (_sp > XB_SPIN_CAP) { atomicAdd(&(bar)[XB_TMO], 1u); break; } } } } while (0)
struct XcdBarrier { unsigned* bar; unsigned x; volatile LAS unsigned* st; };
DI XcdBarrier xcd_barrier_post(unsigned* bar, volatile LAS unsigned* st) {
  XcdBarrier b; b.bar = bar; b.x = xb_xcc_id(); b.st = st;
  if (threadIdx.x == 0) (void)xb_add(&bar[XB_XCNT(b.x)], 1u);
  return b;
}
DI void xcd_barrier_complete(unsigned* bar, unsigned x, unsigned& nloc, unsigned& nx) {
  const unsigned G = gridDim.x * gridDim.y * gridDim.z;
  unsigned sum, cnt, mine, sp = 0u;
  for (;;) {
    sum = 0u; cnt = 0u; mine = 0u;
#pragma unroll
    for (unsigned j = 0; j < 16; ++j) { const unsigned c = xb_ld(&bar[XB_XCNT(j)]); sum += c; cnt += (c > 0u) ? 1u : 0u; mine = (j == x) ? c : mine; }
    if (sum == G) break;
    __builtin_amdgcn_s_sleep(1);
    if ((++sp & 255u) == 0u) { if (xb_ld(&bar[XB_TMO])) break; if (sp > XB_SPIN_CAP) { atomicAdd(&bar[XB_TMO], 1u); break; } }
  }
  nloc = mine > 0u ? mine : 1u; nx = cnt > 0u ? cnt : 1u;
}
DI void xcd_barrier(const XcdBarrier& b) {
  asm volatile("s_waitcnt vmcnt(0)" ::: "memory");
  __syncthreads();
  if (threadIdx.x == 0) {
    unsigned* bar = b.bar;
    __builtin_amdgcn_s_waitcnt(0);
    unsigned nloc = b.st[0], nx = b.st[1];
    if (nloc == 0u) { xcd_barrier_complete(bar, b.x, nloc, nx); b.st[0] = nloc; b.st[1] = nx; }
    const unsigned old = xb_add(&bar[XB_XSUB(b.x)], 1u);
    const unsigned gen = old / nloc;
    if (old + 1u == (gen + 1u) * nloc) {
      __builtin_amdgcn_fence(__ATOMIC_RELEASE, "agent");
      asm volatile("s_waitcnt vmcnt(0)" ::: "memory");
      const unsigned og = xb_add(&bar[XB_TOP], 1u);
      const unsigned tg = og / nx;
      if (og + 1u == (tg + 1u) * nx) xb_add(&bar[XB_TOPGEN], 1u);
      else XB_SPIN(xb_ld(&bar[XB_TOPGEN]) == tg, bar);
      __builtin_amdgcn_fence(__ATOMIC_ACQUIRE, "agent");
      xb_add(&bar[XB_XGEN(b.x)], 1u);
      asm volatile("s_waitcnt vmcnt(0)" ::: "memory");
    } else {
      XB_SPIN(xb_ld(&bar[XB_XGEN(b.x)]) == gen, bar);
      __builtin_amdgcn_fence(__ATOMIC_ACQUIRE, "agent");
      asm volatile("s_waitcnt vmcnt(0)" ::: "memory");
    }
  }
  __syncthreads();
}

#define SMEM_BYTES 155648

template <int PH>
DI void phase_and_probe(const Params& p, char* smem, cg::grid_group& grid) {
  const int reps = (PROBE_DUP == PH) ? 2 : 1;
  for (int rep = 0; rep < reps; ++rep) {
    if (PH == 10 && rep + 1 < reps) { Params q = p; q.gout = (float*)p.PQ; run_phase<PH>(q, smem); }
    else run_phase<PH>(p, smem);
    if (rep + 1 < reps) grid.sync();
  }
}
__global__ void __launch_bounds__(NT) k_mega(Params p) {
  extern __shared__ __attribute__((aligned(16))) char smem[];
  __shared__ uint4 xb_words;
  cg::grid_group grid = cg::this_grid();
  if (threadIdx.x == 0) xb_words = make_uint4(0u, 0u, 0u, 0u);
  __syncthreads();
  XcdBarrier xb = xcd_barrier_post(p.xbar, (volatile LAS unsigned*)&xb_words);
  phase_and_probe<0>(p, smem, grid); grid.sync();
  phase_and_probe<1>(p, smem, grid); xcd_barrier(xb);
  phase_and_probe<2>(p, smem, grid); xcd_barrier(xb);
  phase_and_probe<3>(p, smem, grid); xcd_barrier(xb);
  phase_and_probe<4>(p, smem, grid); xcd_barrier(xb);
  phase_and_probe<5>(p, smem, grid); xcd_barrier(xb);
  phase_and_probe<6>(p, smem, grid); xcd_barrier(xb);
  phase_and_probe<7>(p, smem, grid); xcd_barrier(xb);
  phase_and_probe<8>(p, smem, grid); xcd_barrier(xb);
  phase_and_probe<9>(p, smem, grid); xcd_barrier(xb);
  phase_and_probe<10>(p, smem, grid);
}
#ifdef MK_MULTI
template <int PH>
__global__ void __launch_bounds__(NT) k_single(Params p) {
  extern __shared__ __attribute__((aligned(16))) char smem[];
  run_phase<PH>(p, smem);
}
#endif

static size_t carve(size_t& off, size_t bytes) { size_t o = off; off += (bytes + 255) & ~(size_t)255; return o; }

extern "C" void kernel_launch(void* const* d_in, const int* in_sizes, int n_in, void* d_out, int out_size, void* d_ws, size_t ws_size,
                              hipStream_t stream) {
  Params p{};
  p.x = (const float*)d_in[0]; p.c = (const float*)d_in[1]; p.w_ada = (const float*)d_in[2]; p.b_ada = (const float*)d_in[3];
  p.g_mix = (const float*)d_in[4]; p.w_in = (const float*)d_in[5]; p.pe_k = (const float*)d_in[6]; p.pe_v = (const float*)d_in[7];
  p.w_k1 = (const float*)d_in[8]; p.b_k1 = (const float*)d_in[9]; p.w_k2 = (const float*)d_in[10]; p.w_v1 = (const float*)d_in[11];
  p.b_v1 = (const float*)d_in[12]; p.w_v2 = (const float*)d_in[13]; p.w_out = (const float*)d_in[14]; p.g_ffn = (const float*)d_in[15];
  p.w_pq = (const float*)d_in[16]; p.subkeys = (const float*)d_in[17]; p.peer_down = (const float*)d_in[18]; p.peer_up = (const float*)d_in[19];
  p.g_final = (const float*)d_in[20];
  p.out = (float*)d_out; p.gout = p.out;
  char* ws = (char*)d_ws;
  size_t off = 0;
  p.mod = (float*)(ws + carve(off, 2 * 6144 * 4));
  p.ksmax = (unsigned*)(ws + carve(off, 256));
  p.xbar = (unsigned*)(ws + carve(off, XCD_BAR_WORDS * 4));
  p.c128 = (float*)(ws + carve(off, (size_t)SEQ * 64 * 4)); p.s128 = (float*)(ws + carve(off, (size_t)SEQ * 64 * 4));
  p.c64 = (float*)(ws + carve(off, (size_t)SEQ * 32 * 4)); p.s64 = (float*)(ws + carve(off, (size_t)SEQ * 32 * 4));
  p.WinT = (bf16_t*)(ws + carve(off, (size_t)NPROJ * 1024 * 2));
  p.WoutT = (bf16_t*)(ws + carve(off, (size_t)1024 * 1024 * 2));
  p.WqT = (bf16_t*)(ws + carve(off, (size_t)2048 * 1024 * 2));
  p.W1Tk = (bf16_t*)(ws + carve(off, (size_t)256 * 2048 * 2)); p.W1Tv = (bf16_t*)(ws + carve(off, (size_t)256 * 2048 * 2));
  p.W2Tk = (bf16_t*)(ws + carve(off, 64 * 256 * 2)); p.W2Tv = (bf16_t*)(ws + carve(off, 64 * 256 * 2));
  p.SUBK = (bf16_t*)(ws + carve(off, (size_t)16 * 128 * 128 * 2));
  p.B1Pk = (float*)(ws + carve(off, 1024)); p.B1Pv = (float*)(ws + carve(off, 1024));
  p.RA = (bf16_t*)(ws + carve(off, (size_t)T_TOK * 1024 * 2));
  size_t rb = off;
  p.RQ = (bf16_t*)(ws + carve(off, (size_t)T_TOK * 512 * 2)); p.RK = (bf16_t*)(ws + carve(off, (size_t)T_TOK * 512 * 2));
  p.RKT = (bf16_t*)(ws + carve(off, (size_t)T_TOK * 512 * 2)); p.RVT = (bf16_t*)(ws + carve(off, (size_t)T_TOK * 512 * 2));
  p.RGT = (bf16_t*)(ws + carve(off, (size_t)T_TOK * 512 * 2)); p.NQ = (bf16_t*)(ws + carve(off, (size_t)T_TOK * 512 * 2));
  p.NKC = (bf16_t*)(ws + carve(off, (size_t)T_TOK * 128 * 2)); p.NVC = (bf16_t*)(ws + carve(off, (size_t)T_TOK * 128 * 2));
  p.NKS = (bf16_t*)(ws + carve(off, (size_t)T_TOK * 128 * 2)); p.NKW = (bf16_t*)(ws + carve(off, (size_t)T_TOK * 128 * 2));
  p.NVST = (bf16_t*)(ws + carve(off, (size_t)T_TOK * 128 * 2)); p.NVWT = (bf16_t*)(ws + carve(off, (size_t)T_TOK * 128 * 2));
  p.GATE = (float*)(ws + carve(off, (size_t)T_TOK * 24 * 4));
  p.KV = (float*)(ws + carve(off, (size_t)512 * 16384 * 4));
  p.SPREV = (bf16_t*)(ws + carve(off, (size_t)512 * 16384 * 2));
  p.KC = (bf16_t*)(ws + carve(off, (size_t)4 * 512 * 64 * 2)); p.VCT = (bf16_t*)(ws + carve(off, (size_t)4 * 512 * 64 * 2));
  p.HID = (float*)(ws + carve(off, (size_t)2 * 2048 * 256 * 4));
  size_t off2 = rb;
  p.PQ = (bf16_t*)(ws + carve(off2, (size_t)T_TOK * 2048 * 2));
  p.EIDX = (int*)(ws + carve(off2, (size_t)T_TOK * 128 * 4));
  p.EW = (float*)(ws + carve(off2, (size_t)T_TOK * 128 * 4));
  p.PDN8 = (unsigned char*)(ws + carve(off2, (size_t)16384 * 1024));
  p.PUP8 = (unsigned char*)(ws + carve(off2, (size_t)16384 * 1024));
  p.SDN = (float*)(ws + carve(off2, 16384 * 4));
  p.SUP = (float*)(ws + carve(off2, 16384 * 4));
  (void)ws_size; (void)in_sizes; (void)n_in; (void)out_size;

#ifdef MK_MULTI
#define LAUNCH1(PH) { hipFuncSetAttribute((const void*)k_single<PH>, hipFuncAttributeMaxDynamicSharedMemorySize, SMEM_BYTES); k_single<PH><<<256, NT, SMEM_BYTES, stream>>>(p); }
  LAUNCH1(0) LAUNCH1(1) LAUNCH1(2) LAUNCH1(3) LAUNCH1(4) LAUNCH1(5) LAUNCH1(6) LAUNCH1(7) LAUNCH1(8) LAUNCH1(9) LAUNCH1(10)
#else
  static int grid_blocks = 0;
  if (!grid_blocks) {
    int dev = 0, cus = 0, per_cu = 0;
    (void)hipGetDevice(&dev);
    (void)hipDeviceGetAttribute(&cus, hipDeviceAttributeMultiprocessorCount, dev);
    (void)hipFuncSetAttribute((const void*)k_mega, hipFuncAttributeMaxDynamicSharedMemorySize, SMEM_BYTES);
    (void)hipOccupancyMaxActiveBlocksPerMultiprocessor(&per_cu, k_mega, NT, SMEM_BYTES);
    if (per_cu < 1) per_cu = 1;
    if (per_cu > 1) per_cu = 1;
    grid_blocks = cus * per_cu;
  }
  (void)hipMemsetAsync(p.xbar, 0, XCD_BAR_WORDS * 4, stream);
  void* args[] = {&p};
  hipError_t e = hipLaunchCooperativeKernel((void*)k_mega, dim3(grid_blocks), dim3(NT), args, SMEM_BYTES, stream);
  if (e != hipSuccess) fprintf(stderr, "cooperative launch failed: %s (grid %d)\n", hipGetErrorString(e), grid_blocks);
#endif
}
```

```cpp
#include <hip/hip_runtime.h>
#include <hip/hip_bf16.h>
#include <hip/hip_cooperative_groups.h>
#include <stdint.h>
#include <stdio.h>
namespace cg = cooperative_groups;

typedef unsigned short bf16_t;
#define DI __device__ __forceinline__

DI int mytid() { int t = threadIdx.x; asm volatile("" : "+v"(t)); return t; }
DI float bf2f(bf16_t v) { return __uint_as_float(((unsigned)v) << 16); }
DI bf16_t f2bf(float x) { unsigned u = __float_as_uint(x); u += 0x7fffu + ((u >> 16) & 1u); return (bf16_t)(u >> 16); }
DI float gelu_tanh(float x) { float u = 0.7978845608028654f * (x + 0.044715f * x * x * x); return 0.5f * x * (1.f + tanhf(u)); }
DI float siluf(float x) { return x / (1.f + __expf(-x)); }
DI float sigmoidf(float x) { return 1.f / (1.f + __expf(-x)); }

#define T_TOK 16384
#define SEQ 8192
#define DM 1024
#define NPROJ 3584
#define NEG_INF (-__builtin_inff())

struct Params {
  const float *x, *c, *w_ada, *b_ada, *g_mix, *w_in, *pe_k, *pe_v, *w_k1, *b_k1, *w_k2, *w_v1, *b_v1, *w_v2, *w_out, *g_ffn,
      *w_pq, *subkeys, *peer_down, *peer_up, *g_final;
  float* out;
  float* gout;
  float* mod;
  unsigned* ksmax;
  unsigned* xbar;
  float *c128, *s128, *c64, *s64;
  bf16_t *WinT, *WoutT, *WqT, *W1Tk, *W1Tv, *W2Tk, *W2Tv, *SUBK;
  float *B1Pk, *B1Pv;
  bf16_t* RA;
  bf16_t *RQ, *RK, *RKT, *RVT, *RGT, *NQ, *NKC, *NVC, *NKS, *NKW, *NVST, *NVWT;
  float* GATE;
  float* KV;
  bf16_t* SPREV;
  bf16_t *KC, *VCT;
  float* HID;
  bf16_t* PQ;
  int* EIDX;
  float* EW;
  unsigned char *PDN8, *PUP8;
  float *SDN, *SUP;
};

DI float logg_h(int h) { return log1pf(-exp2f(-5.f - (float)h)); }


typedef __bf16 bf16x2_t __attribute__((ext_vector_type(2)));
typedef float f32x2_t __attribute__((ext_vector_type(2)));
DI unsigned cvt2(float a, float b) { f32x2_t v = {a, b}; bf16x2_t r = __builtin_convertvector(v, bf16x2_t); return __builtin_bit_cast(unsigned, r); }
DI uint2 pack4(float a, float b, float c, float d) { uint2 r; r.x = cvt2(a, b); r.y = cvt2(c, d); return r; }
#define NT 512
#ifndef PROBE_DUP
#define PROBE_DUP -1
#endif
typedef short bf16x8 __attribute__((ext_vector_type(8)));
typedef float f32x16 __attribute__((ext_vector_type(16)));
#define MFMA32(a, b, c) __builtin_amdgcn_mfma_f32_32x32x16_bf16((a), (b), (c), 0, 0, 0)
DI f32x16 zero16() { f32x16 z; for (int e = 0; e < 16; ++e) z[e] = 0.f; return z; }
DI f32x16 fill16(float v) { f32x16 z; for (int e = 0; e < 16; ++e) z[e] = v; return z; }
DI float ex2(float x) { return __builtin_amdgcn_exp2f(x); }

DI int win_logical_col(int np) {
  const int tile = np >> 8, p = np & 255, half = p >> 7, q = p & 127;
  if (tile < 4) { const int head = 2 * (tile & 1) + (q >> 6), i = q & 63; return (tile >> 1) * 512 + head * 128 + (half ? 64 + i : i); }
  if (tile < 8) return 1024 + (tile - 4) * 256 + p;
  if (tile < 10) { const int head = 4 * (tile - 8) + (q >> 5), i = q & 31; return 2048 + head * 64 + (half ? 32 + i : i); }
  if (tile == 10) { const int blk = q >> 5, i = q & 31; return (blk < 2 ? 2560 + blk * 64 : 2816 + (blk - 2) * 64) + (half ? 32 + i : i); }
  if (tile == 11) { const int blk = q >> 5, i = q & 31; return (blk < 2) ? 3072 + blk * 64 + (half ? 32 + i : i) : 2688 + (half ? 64 : 0) + 32 * (blk - 2) + i; }
  if (tile == 12) return (half ? 3200 : 2944) + q;
  if (tile == 13) return (half == 0 && q < 24) ? 3328 + q : -1;
  return -1;
}

DI void tr_tile(const float* __restrict__ in, bf16_t* __restrict__ out, int K, int N_in, int k0, int n0, int mode, float* tile) {
  const int tid = mytid();
  {
    int nn = tid & 63, col = mode ? win_logical_col(n0 + nn) : (n0 + nn);
#pragma unroll
    for (int i = 0; i < 8; ++i) {
      int kk = (tid >> 6) + 8 * i;
      tile[kk * 65 + nn] = (col >= 0) ? in[(size_t)(k0 + kk) * N_in + col] : 0.f;
    }
  }
  __syncthreads();
  {
    int kk = tid & 63;
#pragma unroll
    for (int i = 0; i < 8; ++i) {
      int nn = (tid >> 6) + 8 * i;
      out[(size_t)(n0 + nn) * K + k0 + kk] = f2bf(tile[kk * 65 + nn]);
    }
  }
  __syncthreads();
}

#define PH0_MOD 96
#define PH0_WIN (PH0_MOD + 16 * 56)
#define PH0_WOUT (PH0_WIN + 256)
#define PH0_WQ (PH0_WOUT + 512)
#define PH0_W1K (PH0_WQ + 128)
#define PH0_W1V (PH0_W1K + 128)
#define PH0_W2K (PH0_W1V + 4)
#define PH0_W2V (PH0_W2K + 4)
#define PH0_SUBK (PH0_W2V + 512)
#define PH0_ROPE (PH0_SUBK + 1024)
#define PH0_B1P (PH0_ROPE + 8)
#define PH0_NVB PH0_B1P

DI void ph0_body(const Params& p, int vb, char* smem) {
  const int tid = mytid();
  float* fs = (float*)smem;
  if (vb < PH0_MOD) {
    int kg = tid >> 6, col = vb * 64 + (tid & 63);
    float a0 = 0.f, a1 = 0.f;
#pragma unroll 8
    for (int k = kg * 128; k < kg * 128 + 128; ++k) {
      float w = p.w_ada[(size_t)k * 6144 + col];
      a0 += siluf(p.c[k]) * w; a1 += siluf(p.c[DM + k]) * w;
    }
    fs[kg * 64 + (tid & 63)] = a0; fs[512 + kg * 64 + (tid & 63)] = a1;
    __syncthreads();
    if (tid < 128) {
      int b = tid >> 6, cc = tid & 63; float s = 0.f;
      for (int g = 0; g < 8; ++g) s += fs[b * 512 + g * 64 + cc];
      p.mod[b * 6144 + vb * 64 + cc] = s + p.b_ada[vb * 64 + cc];
    }
    __syncthreads();
    if (vb == 0 && tid < 12) p.ksmax[tid] = 0u;
  } else if (vb < PH0_WIN) { int t = vb - PH0_MOD; tr_tile(p.w_in, p.WinT, 1024, 3352, (t & 15) * 64, (t >> 4) * 64, 1, fs); }
  else if (vb < PH0_WOUT) { int t = vb - PH0_WIN; tr_tile(p.w_out, p.WoutT, 1024, 1024, (t & 15) * 64, (t >> 4) * 64, 0, fs); }
  else if (vb < PH0_WQ) { int t = vb - PH0_WOUT; tr_tile(p.w_pq, p.WqT, 1024, 2048, (t & 15) * 64, (t >> 4) * 64, 0, fs); }
  else if (vb < PH0_W1K) { int t = vb - PH0_WQ; tr_tile(p.w_k1, p.W1Tk, 2048, 256, (t & 31) * 64, (t >> 5) * 64, 0, fs); }
  else if (vb < PH0_W1V) { int t = vb - PH0_W1K; tr_tile(p.w_v1, p.W1Tv, 2048, 256, (t & 31) * 64, (t >> 5) * 64, 0, fs); }
  else if (vb < PH0_W2K) { int t = vb - PH0_W1V; tr_tile(p.w_k2, p.W2Tk, 256, 64, t * 64, 0, 0, fs); }
  else if (vb < PH0_W2V) { int t = vb - PH0_W2K; tr_tile(p.w_v2, p.W2Tv, 256, 64, t * 64, 0, 0, fs); }
  else if (vb < PH0_SUBK) { int i = (vb - PH0_W2V) * NT + tid; p.SUBK[i] = f2bf(p.subkeys[i]); }
  else if (vb < PH0_ROPE) {
    int idx = (vb - PH0_SUBK) * NT + tid;
    { int s = idx >> 6, i = idx & 63; float inv = powf(10000.f, -(float)(2 * i) / 128.f); float ang = (float)s * inv; p.c128[idx] = cosf(ang); p.s128[idx] = sinf(ang); }
    if (idx < SEQ * 32) { int s = idx >> 5, i = idx & 31; float inv = powf(10000.f, -(float)(2 * i) / 64.f); float ang = (float)s * inv; p.c64[idx] = cosf(ang); p.s64[idx] = sinf(ang); }
  } else {
    int t = vb - PH0_ROPE, kv = t >> 2, jb = t & 3;
    const float* w1 = kv ? p.w_v1 : p.w_k1; const float* pe = kv ? p.pe_v : p.pe_k; const float* b1 = kv ? p.b_v1 : p.b_k1;
    int fg = tid >> 6, j = jb * 64 + (tid & 63);
    float a = 0.f;
#pragma unroll 8
    for (int f = fg * 256; f < fg * 256 + 256; ++f) a += pe[f] * w1[(size_t)f * 256 + j];
    fs[fg * 64 + (tid & 63)] = a;
    __syncthreads();
    if (tid < 64) { float s = b1[j]; for (int g = 0; g < 8; ++g) s += fs[g * 64 + tid]; (kv ? p.B1Pv : p.B1Pk)[j] = s; }
    __syncthreads();
  }
}

DI void rownorm_body(const float* __restrict__ src, const float* __restrict__ g, const float* __restrict__ mod, int sh_off, int sc_off, bf16_t* __restrict__ dst, int vb) {
  int row = vb * 8 + (mytid() >> 6), lane = mytid() & 63;
  int b = row >> 13;
  const float* xr = src + (size_t)row * DM;
  float v[16]; float ss = 0.f;
#pragma unroll
  for (int i = 0; i < 4; ++i) {
    float4 t = *(const float4*)(xr + i * 256 + lane * 4);
    v[i * 4 + 0] = t.x; v[i * 4 + 1] = t.y; v[i * 4 + 2] = t.z; v[i * 4 + 3] = t.w;
    ss += t.x * t.x + t.y * t.y + t.z * t.z + t.w * t.w;
  }
  for (int o = 32; o; o >>= 1) ss += __shfl_xor(ss, o);
  float rstd = rsqrtf(ss * (1.f / DM) + 1e-6f);
  const float* sh = mod + b * 6144 + sh_off; const float* sc = mod + b * 6144 + sc_off;
#pragma unroll
  for (int i = 0; i < 4; ++i) {
    int col = i * 256 + lane * 4;
    float4 gg = *(const float4*)(g + col), s4 = *(const float4*)(sc + col), h4 = *(const float4*)(sh + col);
    float y0 = v[i * 4 + 0] * rstd * gg.x * (1.f + s4.x) + h4.x;
    float y1 = v[i * 4 + 1] * rstd * gg.y * (1.f + s4.y) + h4.y;
    float y2 = v[i * 4 + 2] * rstd * gg.z * (1.f + s4.z) + h4.z;
    float y3 = v[i * 4 + 3] * rstd * gg.w * (1.f + s4.w) + h4.w;
    *(uint2*)(dst + (size_t)row * DM + col) = pack4(y0, y1, y2, y3);
  }
}

#define G_A_BYTES (256 * 144)
#define G_B_BYTES (256 * 144)
#define G_BUF_BYTES (G_A_BYTES + G_B_BYTES)
template <class Epi>
DI void gemm_tile(const bf16_t* __restrict__ A, const bf16_t* __restrict__ Bt, int K, int m0, int n0, char* smem, const Epi& epi) {
  const int tid = mytid(), lane = tid & 63, w = tid >> 6, wm = w >> 2, wn = w & 3, r = lane & 31, h = lane >> 5;
  f32x16 acc[4][2];
#pragma unroll
  for (int i = 0; i < 4; ++i)
#pragma unroll
    for (int j = 0; j < 2; ++j) acc[i][j] = zero16();
  const int crow = tid >> 3, ckc = tid & 7;
  const bf16_t* ag = A + (size_t)(m0 + crow) * K + ckc * 8;
  const bf16_t* bg = Bt + (size_t)(n0 + crow) * K + ckc * 8;
  uint4 ra[4], rb[4];
#pragma unroll
  for (int i = 0; i < 4; ++i) { ra[i] = *(const uint4*)(ag + (size_t)i * 64 * K); rb[i] = *(const uint4*)(bg + (size_t)i * 64 * K); }
  char* lw = smem + crow * 144 + ckc * 16;
#pragma unroll
  for (int i = 0; i < 4; ++i) { *(uint4*)(lw + i * 64 * 144) = ra[i]; *(uint4*)(lw + G_A_BYTES + i * 64 * 144) = rb[i]; }
  __syncthreads();
  const int nk = K >> 6;
  for (int kt = 0; kt < nk; ++kt) {
    const int cur = kt & 1;
    if (kt + 1 < nk) {
      const int k0 = (kt + 1) * 64;
#pragma unroll
      for (int i = 0; i < 4; ++i) { ra[i] = *(const uint4*)(ag + (size_t)i * 64 * K + k0); rb[i] = *(const uint4*)(bg + (size_t)i * 64 * K + k0); }
    }
    const char* la = smem + cur * G_BUF_BYTES + (wm * 128 + r) * 144 + h * 16;
    const char* lb = smem + cur * G_BUF_BYTES + G_A_BYTES + (wn * 64 + r) * 144 + h * 16;
#pragma unroll
    for (int kk = 0; kk < 4; ++kk) {
      bf16x8 b0 = *(const bf16x8*)(lb + kk * 32), b1 = *(const bf16x8*)(lb + 32 * 144 + kk * 32);
#pragma unroll
      for (int i = 0; i < 4; ++i) {
        bf16x8 a = *(const bf16x8*)(la + i * 32 * 144 + kk * 32);
        acc[i][0] = MFMA32(a, b0, acc[i][0]); acc[i][1] = MFMA32(a, b1, acc[i][1]);
      }
    }
    if (kt + 1 < nk) {
      char* lw2 = lw + (cur ^ 1) * G_BUF_BYTES;
#pragma unroll
      for (int i = 0; i < 4; ++i) { *(uint4*)(lw2 + i * 64 * 144) = ra[i]; *(uint4*)(lw2 + G_A_BYTES + i * 64 * 144) = rb[i]; }
    }
    __syncthreads();
  }
  const int G = (n0 >> 6) + wn;
#pragma unroll
  for (int i = 0; i < 4; ++i) {
    float pre[4][8];
#pragma unroll
    for (int g = 0; g < 4; ++g) epi.prefetch(m0 + wm * 128 + i * 32 + 8 * g + 4 * h, G, r, pre[g]);
#pragma unroll
    for (int g = 0; g < 4; ++g) {
      float lo[4], hi[4];
#pragma unroll
      for (int e = 0; e < 4; ++e) { lo[e] = acc[i][0][4 * g + e]; hi[e] = acc[i][1][4 * g + e]; }
      epi(m0 + wm * 128 + i * 32 + 8 * g + 4 * h, G, r, lo, hi, pre[g]);
    }
  }
}

struct EpiProj {
  static constexpr bool kProbe = true;
  const Params& p;
  DI void prefetch(int t0, int G, int c, float (&pre)[8]) const {
    const int s0 = t0 & 8191;
    const bool r128 = G < 16, r64 = (G >= 32 && G < 40) || (G >= 40 && G < 52 && (((G - 40) >> 1) & 1) == 0);
    if (r128) {
      const int i = 32 * (G & 1) + c;
#pragma unroll
      for (int e = 0; e < 4; ++e) { pre[e] = p.c128[(s0 + e) * 64 + i]; pre[4 + e] = p.s128[(s0 + e) * 64 + i]; }
    } else if (r64) {
#pragma unroll
      for (int e = 0; e < 4; ++e) { pre[e] = p.c64[(s0 + e) * 32 + c]; pre[4 + e] = p.s64[(s0 + e) * 32 + c]; }
    } else {
#pragma unroll
      for (int e = 0; e < 8; ++e) pre[e] = 0.f;
    }
  }
  DI void operator()(int t0, int G, int c, const float (&lo)[4], const float (&hi)[4], const float (&pre)[8]) const {
    const int b = t0 >> 13, s0 = t0 & 8191;
    if (G < 16) {
      const int sec = G >> 3, hh = (G & 7) >> 1, j = G & 1, i = 32 * j + c;
      float o1[4], o2[4];
#pragma unroll
      for (int e = 0; e < 4; ++e) {
        float cs = pre[e], sn = pre[4 + e];
        o1[e] = lo[e] * cs - hi[e] * sn; o2[e] = hi[e] * cs + lo[e] * sn;
      }
      if (sec == 0) {
#pragma unroll
        for (int e = 0; e < 4; ++e) {
          p.RQ[(size_t)(t0 + e) * 512 + hh * 128 + i] = f2bf(o1[e]);
          p.RQ[(size_t)(t0 + e) * 512 + hh * 128 + 64 + i] = f2bf(o2[e]);
        }
      } else {
        const float sc = 0.08838834764831845f;
        const float lg = logg_h(hh);
#pragma unroll
        for (int e = 0; e < 4; ++e) {
          o1[e] *= sc; o2[e] *= sc;
          p.RK[(size_t)(t0 + e) * 512 + hh * 128 + i] = f2bf(o1[e]);
          p.RK[(size_t)(t0 + e) * 512 + hh * 128 + 64 + i] = f2bf(o2[e]);
          float zeta = __expf((float)(127 - ((s0 + e) & 127)) * lg);
          o1[e] *= zeta; o2[e] *= zeta;
        }
        *(uint2*)(p.RKT + ((size_t)(b * 4 + hh) * 128 + i) * SEQ + s0) = pack4(o1[0], o1[1], o1[2], o1[3]);
        *(uint2*)(p.RKT + ((size_t)(b * 4 + hh) * 128 + 64 + i) * SEQ + s0) = pack4(o2[0], o2[1], o2[2], o2[3]);
      }
    } else if (G < 24) {
      const int hh = (G - 16) >> 1, d = ((G - 16) & 1) * 64 + c;
      *(uint2*)(p.RVT + ((size_t)(b * 4 + hh) * 128 + d) * SEQ + s0) = pack4(lo[0], lo[1], lo[2], lo[3]);
      *(uint2*)(p.RVT + ((size_t)(b * 4 + hh) * 128 + d + 32) * SEQ + s0) = pack4(hi[0], hi[1], hi[2], hi[3]);
    } else if (G < 32) {
      const int hh = (G - 24) >> 1, d = ((G - 24) & 1) * 64 + c;
#pragma unroll
      for (int e = 0; e < 4; ++e) {
        p.RGT[(size_t)(t0 + e) * 512 + hh * 128 + d] = f2bf(siluf(lo[e]));
        p.RGT[(size_t)(t0 + e) * 512 + hh * 128 + d + 32] = f2bf(siluf(hi[e]));
      }
    } else if (G < 40) {
      const int head = G - 32;
#pragma unroll
      for (int e = 0; e < 4; ++e) {
        float cs = pre[e], sn = pre[4 + e];
        const float qs = 0.125f * 1.4426950408889634f;
        float o1 = (lo[e] * cs - hi[e] * sn) * qs, o2 = (hi[e] * cs + lo[e] * sn) * qs;
        p.NQ[(size_t)(t0 + e) * 512 + head * 64 + c] = f2bf(o1);
        p.NQ[(size_t)(t0 + e) * 512 + head * 64 + 32 + c] = f2bf(o2);
      }
    } else if (G < 52) {
      const int k = G - 40, kind = k >> 1, gg = k & 1;
      float o1[4], o2[4];
#pragma unroll
      for (int e = 0; e < 4; ++e) {
        o1[e] = lo[e]; o2[e] = hi[e];
        if ((kind & 1) == 0) {
          float cs = pre[e], sn = pre[4 + e];
          o1[e] = lo[e] * cs - hi[e] * sn; o2[e] = hi[e] * cs + lo[e] * sn;
        }
      }
      if (kind == 3 || kind == 5) {
        bf16_t* dst = (kind == 3 ? p.NVST : p.NVWT) + ((size_t)(b * 2 + gg) * 64 + c) * SEQ + s0;
        *(uint2*)dst = pack4(o1[0], o1[1], o1[2], o1[3]);
        *(uint2*)(dst + (size_t)32 * SEQ) = pack4(o2[0], o2[1], o2[2], o2[3]);
      } else {
        bf16_t* dst = (kind == 0 ? p.NKC : kind == 1 ? p.NVC : kind == 2 ? p.NKS : p.NKW);
#pragma unroll
        for (int e = 0; e < 4; ++e) {
          dst[(size_t)(t0 + e) * 128 + gg * 64 + c] = f2bf(o1[e]);
          dst[(size_t)(t0 + e) * 128 + gg * 64 + 32 + c] = f2bf(o2[e]);
        }
      }
    } else if (G == 52) {
      if (c < 24) {
#pragma unroll
        for (int e = 0; e < 4; ++e) p.GATE[(size_t)(t0 + e) * 24 + c] = sigmoidf(lo[e]);
      }
    }
  }
};
struct EpiOut {
  static constexpr bool kProbe = false;
  const Params& p;
  DI void prefetch(int t0, int G, int c, float (&pre)[8]) const {
    const int c0 = G * 64 + c;
#pragma unroll
    for (int e = 0; e < 4; ++e) { pre[e] = p.x[(size_t)(t0 + e) * DM + c0]; pre[4 + e] = p.x[(size_t)(t0 + e) * DM + c0 + 32]; }
  }
  DI void operator()(int t0, int G, int c, const float (&lo)[4], const float (&hi)[4], const float (&pre)[8]) const {
    const int b = t0 >> 13;
    const int c0 = G * 64 + c, c1 = c0 + 32;
    const float* ga1 = p.mod + b * 6144 + 2048;
    const float g0 = ga1[c0], g1 = ga1[c1];
#pragma unroll
    for (int e = 0; e < 4; ++e) {
      p.out[(size_t)(t0 + e) * DM + c0] = pre[e] + g0 * lo[e];
      p.out[(size_t)(t0 + e) * DM + c1] = pre[4 + e] + g1 * hi[e];
    }
  }
};
struct EpiPQ {
  static constexpr bool kProbe = false;
  const Params& p;
  DI void prefetch(int, int, int, float (&)[8]) const {}
  DI void operator()(int t0, int G, int c, const float (&lo)[4], const float (&hi)[4], const float (&)[8]) const {
#pragma unroll
    for (int e = 0; e < 4; ++e) {
      p.PQ[(size_t)(t0 + e) * 2048 + G * 64 + c] = f2bf(lo[e]);
      p.PQ[(size_t)(t0 + e) * 2048 + G * 64 + 32 + c] = f2bf(hi[e]);
    }
  }
};


namespace pg8 {
#define PG8_LAS __attribute__((address_space(3)))
typedef float f32x4 __attribute__((ext_vector_type(4)));
constexpr int BM = 256, BK = 64, HALF = 128, HTB = HALF * BK * 2, STAGE_BYTES = 8 * HTB, NXCD = 8, WGM = 8;
DI int lds_byte(int r, int c) { const int st = (r >> 4) * 2 + (c >> 5), rr = r & 15, cc = c & 31, ob = rr * 64 + cc * 2; return st * 1024 + (ob ^ (((ob >> 9) & 1) << 5)); }
DI void stage_rc(int b, int& R, int& C) { const int st = b / 1024, sb = b % 1024, swz = sb ^ (((sb >> 9) & 1) << 5); R = (st >> 1) * 16 + swz / 64; C = (st & 1) * 32 + (swz % 64) / 2; }
DI int perm32(int rho) { const int n = rho >> 4, i = rho & 15; return 8 * (i >> 2) + 4 * n + (i & 3); }
struct Unit { int pm, pn; };
struct Gemm { const bf16_t* A; const bf16_t* Bt; int M, N, K; };
struct StaticOrder {
  int nM, nN, nwg, G, c;
  DI void init(int M, int N, int G_, int c_) { nM = M / BM; nN = N / BM; nwg = nM * nN; G = G_; c = c_; }
  DI bool next(int i, Unit& u) const {
    const long L = (long)i * G + c; if (L >= nwg) return false;
    int wgid = (int)L; { const int q = nwg / NXCD, r = nwg % NXCD, xcd = wgid % NXCD, off = wgid / NXCD; wgid = (xcd < r ? xcd * (q + 1) : r * (q + 1) + (xcd - r) * q) + off; }
    const int nig = WGM * nN, gid = wgid / nig, fm = gid * WGM, gsz = (nM - fm) < WGM ? (nM - fm) : WGM;
    u.pm = fm + ((wgid % nig) % gsz); u.pn = (wgid % nig) / gsz; return true;
  }
  DI void a_ready(const Unit&) const {}
  DI void done(const Unit&) const {}
};
template <class Epi, class Sched>
__device__ __forceinline__ void gemm_phase(PG8_LAS unsigned char* lds, const Gemm g, const Sched& S, const Epi& E) {
    const int tid = mytid(), wid = __builtin_amdgcn_readfirstlane(tid >> 6), lane = tid & 63, wr = wid >> 2, wc = wid & 3, fr = lane & 15, fq = lane >> 4;
    const int K = g.K, nt = K / BK;
    unsigned voffA[2], voffB[2];
#pragma unroll
    for (int i = 0; i < 2; ++i) { int R, C; stage_rc(tid * 16 + i * 8192, R, C); const int Rb = Epi::PERM ? ((R & ~31) + perm32(R & 31)) : R;
        voffA[i] = (unsigned)(R * K + C) * 2u; voffB[i] = (unsigned)(Rb * K + C) * 2u; }
    const size_t kstep = (size_t)(BK * 2);
    const size_t hstep = (size_t)HALF * K * 2;
    const size_t tstep = 2 * hstep;
    const unsigned ldsw = (unsigned)wid * 1024u;
    const int aoff = lds_byte(wr * 64 + fr, fq * 8), boff = lds_byte(wc * 32 + fr, fq * 8);
#define PG8_SA(b, h) (((b) * 2 + (h)) * HTB)
#define PG8_SB(b, h) ((4 + (b) * 2 + (h)) * HTB)
#define PG8_STAGE(bufoff, gbase, voff) do { _Pragma("unroll") for (int _i = 0; _i < 2; ++_i) \
        __builtin_amdgcn_global_load_lds((const unsigned*)((const char*)(gbase) + (voff)[_i]), (PG8_LAS unsigned*)(lds + (bufoff) + ldsw + _i * 8192), 16, 0, 0); } while (0)
#define PG8_LDA(dst, b, h) do { _Pragma("unroll") for (int m = 0; m < 4; ++m) _Pragma("unroll") for (int k = 0; k < 2; ++k) dst[m][k] = *(const PG8_LAS bf16x8*)(lds + PG8_SA(b, h) + aoff + m * 2048 + k * 1024); } while (0)
#define PG8_LDB(dst, b, h) do { _Pragma("unroll") for (int n = 0; n < 2; ++n) _Pragma("unroll") for (int k = 0; k < 2; ++k) dst[n][k] = *(const PG8_LAS bf16x8*)(lds + PG8_SB(b, h) + boff + n * 2048 + k * 1024); } while (0)
#define PG8_MMA(ai, bj, At, Bt) do { __builtin_amdgcn_s_setprio(1); _Pragma("unroll") for (int m = 0; m < 4; ++m) _Pragma("unroll") for (int n = 0; n < 2; ++n) _Pragma("unroll") for (int k = 0; k < 2; ++k) \
        acc[ai][bj][m][n] = __builtin_amdgcn_mfma_f32_16x16x32_bf16(Bt[n][k], At[m][k], acc[ai][bj][m][n], 0, 0, 0); __builtin_amdgcn_s_setprio(0); } while (0)
#define PG8_WAIT_V(n) asm volatile("s_waitcnt vmcnt(" #n ")" ::: "memory")
#define PG8_WAIT_L(n) asm volatile("s_waitcnt lgkmcnt(" #n ")" ::: "memory")
#define PG8_BAR __builtin_amdgcn_s_barrier()
#define PG8_SCHED __builtin_amdgcn_sched_barrier(0)
    Unit cur, nxt; int ui = 0;
    if (!S.next(0, cur)) return;
    f32x4 acc[2][2][4][2];
#pragma unroll
    for (int a = 0; a < 2; ++a)
#pragma unroll
        for (int b = 0; b < 2; ++b)
#pragma unroll
            for (int m = 0; m < 4; ++m)
#pragma unroll
                for (int n = 0; n < 2; ++n) acc[a][b][m][n] = (f32x4){0.f, 0.f, 0.f, 0.f};
    bf16x8 At[4][2], B0[2][2], B1[2][2];
    const char* cA = (const char*)g.A + (size_t)cur.pm * tstep; const char* cB = (const char*)g.Bt + (size_t)cur.pn * tstep;
    S.a_ready(cur);
    PG8_STAGE(PG8_SB(0, 0), cB, voffB); PG8_STAGE(PG8_SA(0, 0), cA, voffA); PG8_STAGE(PG8_SB(0, 1), cB + hstep, voffB); PG8_STAGE(PG8_SA(0, 1), cA + hstep, voffA);
    if (wr == 1) PG8_BAR;
    PG8_WAIT_V(4); PG8_BAR;
    PG8_STAGE(PG8_SB(1, 0), cB + kstep, voffB); PG8_STAGE(PG8_SA(1, 0), cA + kstep, voffA); PG8_STAGE(PG8_SB(1, 1), cB + hstep + kstep, voffB);
    PG8_WAIT_V(6); PG8_BAR;
    for (;;) {
        const bool has_next = S.next(ui + 1, nxt);
        const char* nA = has_next ? (const char*)g.A + (size_t)nxt.pm * tstep : cA; const char* nB = has_next ? (const char*)g.Bt + (size_t)nxt.pn * tstep : cB;
        for (int t = 0; t < nt; t += 2) {
            const bool last = (t == nt - 2);
            const char* a1 = cA + (size_t)(t + 1) * kstep;
            const char* a2 = last ? nA : cA + (size_t)(t + 2) * kstep; const char* b2 = last ? nB : cB + (size_t)(t + 2) * kstep;
            const char* a3 = a2 + kstep; const char* b3 = b2 + kstep;
            if (last && has_next) S.a_ready(nxt);
            PG8_LDB(B0, 0, 0); PG8_SCHED; PG8_LDA(At, 0, 0); PG8_STAGE(PG8_SA(1, 1), a1 + hstep, voffA);
            PG8_WAIT_L(8); PG8_BAR; PG8_WAIT_L(0); PG8_MMA(0, 0, At, B0); PG8_BAR; PG8_SCHED;
            PG8_LDB(B1, 0, 1); PG8_STAGE(PG8_SB(0, 0), b2, voffB);
            PG8_BAR; PG8_WAIT_L(0); PG8_MMA(0, 1, At, B1); PG8_BAR;
            PG8_LDA(At, 0, 1); PG8_STAGE(PG8_SA(0, 0), a2, voffA);
            PG8_BAR; PG8_WAIT_L(0); PG8_MMA(1, 0, At, B0); PG8_BAR; PG8_SCHED;
            PG8_STAGE(PG8_SB(0, 1), b2 + hstep, voffB);
            PG8_WAIT_V(6); PG8_BAR; PG8_MMA(1, 1, At, B1); PG8_BAR;
            PG8_LDB(B0, 1, 0); PG8_SCHED; PG8_LDA(At, 1, 0); PG8_STAGE(PG8_SA(0, 1), a2 + hstep, voffA);
            PG8_WAIT_L(8); PG8_BAR; PG8_WAIT_L(0); PG8_MMA(0, 0, At, B0); PG8_BAR; PG8_SCHED;
            PG8_LDB(B1, 1, 1); PG8_STAGE(PG8_SB(1, 0), b3, voffB);
            PG8_BAR; PG8_WAIT_L(0); PG8_MMA(0, 1, At, B1); PG8_BAR;
            PG8_LDA(At, 1, 1); PG8_STAGE(PG8_SA(1, 0), a3, voffA);
            PG8_BAR; PG8_WAIT_L(0); PG8_MMA(1, 0, At, B0); PG8_BAR; PG8_SCHED;
            PG8_STAGE(PG8_SB(1, 1), b3 + hstep, voffB);
            PG8_WAIT_V(6); PG8_BAR; PG8_MMA(1, 1, At, B1); PG8_BAR;
        }
        if constexpr (!Epi::AFTER_DRAIN) { E(acc, cur, wr, wc, fr, fq); S.done(cur); }
        if (!has_next) break;
#pragma unroll
        for (int a = 0; a < 2; ++a)
#pragma unroll
            for (int b = 0; b < 2; ++b)
#pragma unroll
                for (int m = 0; m < 4; ++m)
#pragma unroll
                    for (int n = 0; n < 2; ++n) acc[a][b][m][n] = (f32x4){0.f, 0.f, 0.f, 0.f};
        cur = nxt; cA = nA; cB = nB; ++ui;
    }
    PG8_WAIT_V(0);
    if (wr == 0) PG8_BAR;
    PG8_BAR;
    if constexpr (Epi::AFTER_DRAIN) { E.fused(acc, cur, wr, wc, fr, fq, lds, wid, lane); S.done(cur); }
#undef PG8_SA
#undef PG8_SB
#undef PG8_STAGE
#undef PG8_LDA
#undef PG8_LDB
#undef PG8_MMA
#undef PG8_WAIT_V
#undef PG8_WAIT_L
#undef PG8_BAR
#undef PG8_SCHED
}
}

template <int CTRL> DI float dpp_q(float x) { return __builtin_bit_cast(float, __builtin_amdgcn_mov_dpp(__builtin_bit_cast(int, x), CTRL, 0xf, 0xf, true)); }
DI void tstore4(bf16_t* dst, float v0, float v1, float v2, float v3, int q) {
  const bool o1_ = q & 1, o2_ = q & 2;
  const float sa = o1_ ? v0 : v1, sb = o1_ ? v2 : v3;
  const float ra = dpp_q<0xB1>(sa), rb = dpp_q<0xB1>(sb);
  const float w0 = o1_ ? ra : v0, w1 = o1_ ? v1 : ra, w2 = o1_ ? rb : v2, w3 = o1_ ? v3 : rb;
  const float sc = o2_ ? w0 : w2, sd = o2_ ? w1 : w3;
  const float rc = dpp_q<0x4E>(sc), rd = dpp_q<0x4E>(sd);
  const float x0 = o2_ ? rc : w0, x1 = o2_ ? rd : w1, x2 = o2_ ? w2 : rc, x3 = o2_ ? w3 : rd;
  *(uint2*)(dst + (size_t)q * SEQ - q) = pack4(x0, x1, x2, x3);
}
DI uint4 pack8u(const float (&a)[4], const float (&b)[4]) { uint4 v; v.x = cvt2(a[0], a[1]); v.y = cvt2(a[2], a[3]); v.z = cvt2(b[0], b[1]); v.w = cvt2(b[2], b[3]); return v; }
struct EpiProj8 {
  static constexpr bool PERM = true, AFTER_DRAIN = false;
  const Params& p;
  DI void operator()(const pg8::f32x4 (&acc)[2][2][4][2], const pg8::Unit& u, int wr, int wc, int fr, int fq) const {
    const int pn = u.pn, q4 = fr & 3;
    const bool rot128 = pn < 4, rot64 = (pn >= 8 && pn < 10) || pn == 10 || (pn == 11 && wc < 2), rot = rot128 || rot64;
    const int t00 = u.pm * 256 + wr * 64 + fr, s00 = t00 & 8191;
    const int cb0 = 8 * fq;
    const float* ct = rot128 ? p.c128 : p.c64; const float* st = rot128 ? p.s128 : p.s64;
    const int nrot = rot128 ? 64 : 32, ridx = (rot128 ? 32 * (wc & 1) : 0) + cb0;
    float cd_[2][4], sd_[2][4];
    if (rot) {
#pragma unroll
      for (int n = 0; n < 2; ++n) {
        const float4 c16 = *(const float4*)(ct + (size_t)16 * nrot + ridx + 4 * n), s16 = *(const float4*)(st + (size_t)16 * nrot + ridx + 4 * n);
        cd_[n][0] = c16.x; cd_[n][1] = c16.y; cd_[n][2] = c16.z; cd_[n][3] = c16.w; sd_[n][0] = s16.x; sd_[n][1] = s16.y; sd_[n][2] = s16.z; sd_[n][3] = s16.w;
      }
    }
#pragma unroll
    for (int ai = 0; ai < 2; ++ai) {
      float c_[2][4], s_[2][4];
      if (rot) {
#pragma unroll
        for (int n = 0; n < 2; ++n) {
          const float4 c4 = *(const float4*)(ct + (size_t)(s00 + 128 * ai) * nrot + ridx + 4 * n), s4 = *(const float4*)(st + (size_t)(s00 + 128 * ai) * nrot + ridx + 4 * n);
          c_[n][0] = c4.x; c_[n][1] = c4.y; c_[n][2] = c4.z; c_[n][3] = c4.w; s_[n][0] = s4.x; s_[n][1] = s4.y; s_[n][2] = s4.z; s_[n][3] = s4.w;
        }
      }
#pragma unroll
      for (int m = 0; m < 4; ++m) {
        const int t = t00 + ai * 128 + m * 16, b = t >> 13, s = t & 8191;
        float lo[2][4], hi[2][4];
#pragma unroll
        for (int n = 0; n < 2; ++n) {
          const pg8::f32x4 L = acc[ai][0][m][n], H = acc[ai][1][m][n];
#pragma unroll
          for (int i = 0; i < 4; ++i) {
            if (rot) {
              const float c = c_[n][i], sn = s_[n][i];
              lo[n][i] = L[i] * c - H[i] * sn; hi[n][i] = H[i] * c + L[i] * sn;
              c_[n][i] = c * cd_[n][i] - sn * sd_[n][i]; s_[n][i] = sn * cd_[n][i] + c * sd_[n][i];
            } else { lo[n][i] = L[i]; hi[n][i] = H[i]; }
          }
        }
        if (pn < 4) {
          const int hh = 2 * (pn & 1) + (wc >> 1), idx = 32 * (wc & 1) + cb0;
          if (pn < 2) {
            *(uint4*)(p.RQ + (size_t)t * 512 + hh * 128 + idx) = pack8u(lo[0], lo[1]);
            *(uint4*)(p.RQ + (size_t)t * 512 + hh * 128 + 64 + idx) = pack8u(hi[0], hi[1]);
          } else {
            const float sc = 0.08838834764831845f;
#pragma unroll
            for (int n = 0; n < 2; ++n)
#pragma unroll
              for (int i = 0; i < 4; ++i) { lo[n][i] *= sc; hi[n][i] *= sc; }
            *(uint4*)(p.RK + (size_t)t * 512 + hh * 128 + idx) = pack8u(lo[0], lo[1]);
            *(uint4*)(p.RK + (size_t)t * 512 + hh * 128 + 64 + idx) = pack8u(hi[0], hi[1]);
            const float zeta = __expf((float)(127 - (s & 127)) * logg_h(hh));
            bf16_t* kt = p.RKT + ((size_t)(b * 4 + hh) * 128 + idx) * SEQ + s;
#pragma unroll
            for (int n = 0; n < 2; ++n) {
              tstore4(kt + (size_t)(4 * n) * SEQ, lo[n][0] * zeta, lo[n][1] * zeta, lo[n][2] * zeta, lo[n][3] * zeta, q4);
              tstore4(kt + (size_t)(64 + 4 * n) * SEQ, hi[n][0] * zeta, hi[n][1] * zeta, hi[n][2] * zeta, hi[n][3] * zeta, q4);
            }
          }
        } else if (pn < 6) {
          bf16_t* v0 = p.RVT + ((size_t)(b * 4 + 2 * (pn - 4)) * 128 + 32 * wc + cb0) * SEQ + s;
#pragma unroll
          for (int n = 0; n < 2; ++n) {
            tstore4(v0 + (size_t)(4 * n) * SEQ, lo[n][0], lo[n][1], lo[n][2], lo[n][3], q4);
            tstore4(v0 + (size_t)(128 + 4 * n) * SEQ, hi[n][0], hi[n][1], hi[n][2], hi[n][3], q4);
          }
        } else if (pn < 8) {
          const int d = 32 * wc + cb0, h0 = 2 * (pn - 6);
#pragma unroll
          for (int n = 0; n < 2; ++n)
#pragma unroll
            for (int i = 0; i < 4; ++i) { lo[n][i] = siluf(lo[n][i]); hi[n][i] = siluf(hi[n][i]); }
          *(uint4*)(p.RGT + (size_t)t * 512 + h0 * 128 + d) = pack8u(lo[0], lo[1]);
          *(uint4*)(p.RGT + (size_t)t * 512 + (h0 + 1) * 128 + d) = pack8u(hi[0], hi[1]);
        } else if (pn < 10) {
          const int head = 4 * (pn - 8) + wc;
          const float qs = 0.125f * 1.4426950408889634f;
#pragma unroll
          for (int n = 0; n < 2; ++n)
#pragma unroll
            for (int i = 0; i < 4; ++i) { lo[n][i] *= qs; hi[n][i] *= qs; }
          *(uint4*)(p.NQ + (size_t)t * 512 + head * 64 + cb0) = pack8u(lo[0], lo[1]);
          *(uint4*)(p.NQ + (size_t)t * 512 + head * 64 + 32 + cb0) = pack8u(hi[0], hi[1]);
        } else if (pn == 10 || (pn == 11 && wc < 2)) {
          bf16_t* dst = (pn == 11) ? p.NKW : (wc < 2 ? p.NKC : p.NKS);
          const int g = wc & 1;
          *(uint4*)(dst + (size_t)t * 128 + g * 64 + cb0) = pack8u(lo[0], lo[1]);
          *(uint4*)(dst + (size_t)t * 128 + g * 64 + 32 + cb0) = pack8u(hi[0], hi[1]);
        } else if (pn == 11) {
          const int c0 = 32 * (wc - 2) + cb0;
          *(uint4*)(p.NVC + (size_t)t * 128 + c0) = pack8u(lo[0], lo[1]);
          *(uint4*)(p.NVC + (size_t)t * 128 + 64 + c0) = pack8u(hi[0], hi[1]);
        } else if (pn == 12) {
          const int col = 32 * wc + cb0, g = col >> 6, d = col & 63;
          bf16_t* v0 = p.NVST + ((size_t)(b * 2 + g) * 64 + d) * SEQ + s;
          bf16_t* v1 = p.NVWT + ((size_t)(b * 2 + g) * 64 + d) * SEQ + s;
#pragma unroll
          for (int n = 0; n < 2; ++n) {
            tstore4(v0 + (size_t)(4 * n) * SEQ, lo[n][0], lo[n][1], lo[n][2], lo[n][3], q4);
            tstore4(v1 + (size_t)(4 * n) * SEQ, hi[n][0], hi[n][1], hi[n][2], hi[n][3], q4);
          }
        } else {
          if (wc == 0) {
#pragma unroll
            for (int n = 0; n < 2; ++n)
#pragma unroll
              for (int i = 0; i < 4; ++i) if (cb0 + 4 * n + i < 24) p.GATE[(size_t)t * 24 + cb0 + 4 * n + i] = sigmoidf(lo[n][i]);
          }
        }
      }
    }
  }
};
struct EpiOut8 {
  static constexpr bool PERM = false, AFTER_DRAIN = false;
  const float* x; float* out; const float* mod;
  DI void operator()(const pg8::f32x4 (&acc)[2][2][4][2], const pg8::Unit& u, int wr, int wc, int fr, int fq) const {
    const int col0 = u.pn * 256 + wc * 32 + 4 * fq;
    const float* ga1 = mod + ((u.pm * 256) >> 13) * 6144 + 2048;
    float4 gv[2][2];
#pragma unroll
    for (int bj = 0; bj < 2; ++bj)
#pragma unroll
      for (int n = 0; n < 2; ++n) gv[bj][n] = *(const float4*)(ga1 + col0 + bj * 128 + n * 16);
#pragma unroll
    for (int ai = 0; ai < 2; ++ai)
#pragma unroll
      for (int m = 0; m < 4; ++m) {
        const size_t ro = (size_t)(u.pm * 256 + wr * 64 + fr + ai * 128 + m * 16) * DM + col0;
        float4 xv[2][2];
#pragma unroll
        for (int bj = 0; bj < 2; ++bj)
#pragma unroll
          for (int n = 0; n < 2; ++n) xv[bj][n] = *(const float4*)(x + ro + bj * 128 + n * 16);
#pragma unroll
        for (int bj = 0; bj < 2; ++bj)
#pragma unroll
          for (int n = 0; n < 2; ++n) {
            const pg8::f32x4 v = acc[ai][bj][m][n]; const float4 g4 = gv[bj][n], x4 = xv[bj][n];
            *(float4*)(out + ro + bj * 128 + n * 16) = make_float4(x4.x + g4.x * v[0], x4.y + g4.y * v[1], x4.z + g4.z * v[2], x4.w + g4.w * v[3]);
          }
      }
  }
};
struct EpiPQ8 {
  static constexpr bool PERM = true, AFTER_DRAIN = false;
  bf16_t* O;
  DI void operator()(const pg8::f32x4 (&acc)[2][2][4][2], const pg8::Unit& u, int wr, int wc, int fr, int fq) const {
#pragma unroll
    for (int ai = 0; ai < 2; ++ai)
#pragma unroll
      for (int m = 0; m < 4; ++m) {
        bf16_t* rowp = O + (size_t)(u.pm * 256 + wr * 64 + fr + ai * 128 + m * 16) * 2048 + u.pn * 256 + wc * 32 + 8 * fq;
#pragma unroll
        for (int bj = 0; bj < 2; ++bj) {
          const pg8::f32x4 v0 = acc[ai][bj][m][0], v1 = acc[ai][bj][m][1];
          uint4 o; o.x = cvt2(v0[0], v0[1]); o.y = cvt2(v0[2], v0[3]); o.z = cvt2(v1[0], v1[1]); o.w = cvt2(v1[2], v1[3]);
          *(uint4*)(rowp + bj * 128) = o;
        }
      }
  }
};
DI int crow(int reg, int h) { return (reg & 3) + 8 * (reg >> 2) + 4 * h; }
DI bf16x8 ld16(const bf16_t* ptr) { return *(const bf16x8*)ptr; }
DI bf16x8 ld8x2(const bf16_t* ptr) {
  uint2 a = *(const uint2*)ptr, b = *(const uint2*)(ptr + 8);
  uint4 v; v.x = a.x; v.y = a.y; v.z = b.x; v.w = b.y;
  return __builtin_bit_cast(bf16x8, v);
}
DI bf16x8 pack8(float x0, float x1, float x2, float x3, float x4, float x5, float x6, float x7) {
  uint4 v; v.x = cvt2(x0, x1); v.y = cvt2(x2, x3); v.z = cvt2(x4, x5); v.w = cvt2(x6, x7);
  return __builtin_bit_cast(bf16x8, v);
}

DI void retkv_mfma(const Params& p, int item) {
  const int lane = mytid() & 63, w = mytid() >> 6, r = lane & 31, h = lane >> 5;
  const int hh = item & 3, c = (item >> 2) & 63, b = item >> 8, bh = b * 4 + hh, s0 = c * 128;
  const int mi = w >> 1, nb = (w & 1) * 2;
  const bf16_t* vb_ = p.RVT + ((size_t)(bh * 128 + 32 * mi + r)) * SEQ + s0 + 8 * h;
  const bf16_t* k0 = p.RKT + ((size_t)(bh * 128 + 32 * nb + r)) * SEQ + s0 + 8 * h;
  const bf16_t* k1 = k0 + (size_t)32 * SEQ;
  f32x16 a0 = zero16(), a1 = zero16();
#pragma unroll
  for (int s = 0; s < 8; ++s) {
    bf16x8 a = ld16(vb_ + 16 * s), b0 = ld16(k0 + 16 * s), b1 = ld16(k1 + 16 * s);
    a0 = MFMA32(a, b0, a0); a1 = MFMA32(a, b1, a1);
  }
  float* dst = p.KV + (size_t)item * 16384;
#pragma unroll
  for (int e = 0; e < 16; ++e) {
    const int v = 32 * mi + crow(e, h);
    dst[v * 128 + 32 * nb + r] = a0[e];
    dst[v * 128 + 32 * nb + 32 + r] = a1[e];
  }
}
DI void scan_body(const Params& p, int idx) {
  const int e = idx & 16383, bh = idx >> 14, b = bh >> 2, h = bh & 3;
  const float cd = __expf(128.f * logg_h(h));
  float S = 0.f;
  for (int c0 = 0; c0 < 64; c0 += 32) {
    float kv[32];
#pragma unroll
    for (int u = 0; u < 32; ++u) kv[u] = p.KV[(size_t)((b * 64 + c0 + u) * 4 + h) * 16384 + e];
#pragma unroll
    for (int u = 0; u < 32; ++u) {
      p.SPREV[(size_t)((b * 64 + c0 + u) * 4 + h) * 16384 + e] = f2bf(S);
      S = cd * S + kv[u];
    }
  }
}
DI void retout_mfma(const Params& p, int task) {
  const int lane = mytid() & 63, r = lane & 31, h = lane >> 5;
  const int item = task >> 2, nt = task & 3;
  const int hh = item & 3, c = (item >> 2) & 63, b = item >> 8, bh = b * 4 + hh, s0 = c * 128, t0 = b * SEQ + s0;
  const float lg = logg_h(hh);
  const int n = 32 * nt + r;
  bf16x8 qf[8];
#pragma unroll
  for (int s = 0; s < 8; ++s) qf[s] = ld16(p.RQ + (size_t)(t0 + n) * 512 + hh * 128 + 16 * s + 8 * h);
  f32x16 acc[4];
#pragma unroll
  for (int vi = 0; vi < 4; ++vi) {
    acc[vi] = zero16();
    const bf16_t* sp = p.SPREV + (size_t)item * 16384 + (size_t)(32 * vi + r) * 128 + 8 * h;
#pragma unroll
    for (int s = 0; s < 8; ++s) acc[vi] = MFMA32(ld16(sp + 16 * s), qf[s], acc[vi]);
    __builtin_amdgcn_sched_barrier(0);
  }
  {
    const float xi = __expf((float)(n + 1) * lg);
#pragma unroll
    for (int vi = 0; vi < 4; ++vi)
#pragma unroll
      for (int e = 0; e < 16; ++e) acc[vi][e] *= xi;
  }
  for (int mt = 0; mt <= nt; ++mt) {
    f32x16 sa = zero16();
    const bf16_t* kp = p.RK + (size_t)(t0 + 32 * mt + r) * 512 + hh * 128 + 8 * h;
#pragma unroll
    for (int s = 0; s < 8; ++s) sa = MFMA32(ld16(kp + 16 * s), qf[s], sa);
    float pv[16];
#pragma unroll
    for (int e = 0; e < 16; ++e) {
      const int dm = n - (32 * mt + crow(e, h));
      pv[e] = (dm >= 0) ? sa[e] * __expf((float)dm * lg) : 0.f;
    }
#pragma unroll
    for (int s2 = 0; s2 < 2; ++s2) {
      bf16x8 bfr = pack8(pv[8 * s2], pv[8 * s2 + 1], pv[8 * s2 + 2], pv[8 * s2 + 3], pv[8 * s2 + 4], pv[8 * s2 + 5], pv[8 * s2 + 6], pv[8 * s2 + 7]);
#pragma unroll
      for (int vi = 0; vi < 4; ++vi) {
        bf16x8 afr = ld8x2(p.RVT + ((size_t)(bh * 128 + 32 * vi + r)) * SEQ + s0 + 32 * mt + 16 * s2 + 4 * h);
        acc[vi] = MFMA32(afr, bfr, acc[vi]);
      }
      __builtin_amdgcn_sched_barrier(0);
    }
  }
  float sum = 0.f;
#pragma unroll
  for (int vi = 0; vi < 4; ++vi)
#pragma unroll
    for (int e = 0; e < 16; ++e) sum += acc[vi][e];
  sum += __shfl_xor(sum, 32);
  const float mu = sum * (1.f / 128.f);
  float var = 0.f;
#pragma unroll
  for (int vi = 0; vi < 4; ++vi)
#pragma unroll
    for (int e = 0; e < 16; ++e) { float d = acc[vi][e] - mu; var += d * d; }
  var += __shfl_xor(var, 32);
  const float rs = rsqrtf(var * (1.f / 128.f) + 1e-6f);
#pragma unroll
  for (int vi = 0; vi < 4; ++vi)
#pragma unroll
    for (int g4 = 0; g4 < 4; ++g4) {
      const int v0 = 32 * vi + 8 * g4 + 4 * h;
      uint2 gt = *(const uint2*)(p.RGT + (size_t)(t0 + n) * 512 + hh * 128 + v0);
      float y0 = (acc[vi][4 * g4 + 0] - mu) * rs * __uint_as_float(gt.x << 16);
      float y1 = (acc[vi][4 * g4 + 1] - mu) * rs * __uint_as_float(gt.x & 0xffff0000u);
      float y2 = (acc[vi][4 * g4 + 2] - mu) * rs * __uint_as_float(gt.y << 16);
      float y3 = (acc[vi][4 * g4 + 3] - mu) * rs * __uint_as_float(gt.y & 0xffff0000u);
      *(uint2*)(p.RA + (size_t)(t0 + n) * DM + hh * 128 + v0) = pack4(y0, y1, y2, y3);
    }
}
#define HID_STRIDE 264
DI void compress_mfma(const Params& p, int item, char* smem) {
  float* PART = (float*)smem;
  bf16_t* HIDL = (bf16_t*)(smem + 4 * 16 * 256 * 4);
  const int tid = mytid(), lane = tid & 63, w = tid >> 6, r = lane & 31, h = lane >> 5;
  const int kv = item >> 7, bg = (item >> 5) & 3, rt = item & 31, n0 = rt * 16, b = bg >> 1, g = bg & 1;
  const bf16_t* src = kv ? p.NVC : p.NKC; const bf16_t* W1 = kv ? p.W1Tv : p.W1Tk; const bf16_t* W2 = kv ? p.W2Tv : p.W2Tk;
  const float* B1 = kv ? p.B1Pv : p.B1Pk;
  {
    const int kq = w >> 1, ch = w & 1;
    const int n = min(n0 + (r & 15), 510);
    const bf16_t* ab = src + ((size_t)(b * SEQ + 16 * n)) * 128 + g * 64 + 8 * h;
    const bf16_t* bb = W1 + (size_t)(128 * ch + r) * 2048 + 8 * h;
    f32x16 acc[4];
#pragma unroll
    for (int ct = 0; ct < 4; ++ct) acc[ct] = zero16();
#pragma unroll 4
    for (int s = 32 * kq; s < 32 * kq + 32; ++s) {
      const bf16x8 a = ld16(ab + (s >> 2) * 128 + (s & 3) * 16);
#pragma unroll
      for (int ct = 0; ct < 4; ++ct) acc[ct] = MFMA32(a, ld16(bb + (size_t)ct * 32 * 2048 + 16 * s), acc[ct]);
    }
#pragma unroll
    for (int ct = 0; ct < 4; ++ct)
#pragma unroll
      for (int e = 0; e < 8; ++e) PART[(kq * 16 + crow(e, h)) * 256 + 128 * ch + 32 * ct + r] = acc[ct][e];
  }
  __syncthreads();
#pragma unroll
  for (int i = 0; i < 8; ++i) {
    const int idx = tid + 512 * i, row = idx >> 8, col = idx & 255;
    const float v = PART[row * 256 + col] + PART[(16 + row) * 256 + col] + PART[(32 + row) * 256 + col] + PART[(48 + row) * 256 + col] + B1[col];
    HIDL[row * HID_STRIDE + col] = f2bf(gelu_tanh(v));
  }
  __syncthreads();
  if (w < 2) {
    f32x16 acc = zero16();
#pragma unroll
    for (int s = 0; s < 16; ++s) acc = MFMA32(ld16(HIDL + (r & 15) * HID_STRIDE + 16 * s + 8 * h), ld16(W2 + (size_t)(32 * w + r) * 256 + 16 * s + 8 * h), acc);
    const int e_ = 32 * w + r;
    if (kv == 0) {
#pragma unroll
      for (int e = 0; e < 8; ++e) { const int n = n0 + crow(e, h); p.KC[((size_t)bg * 512 + n) * 64 + e_] = (n < 511) ? f2bf(acc[e]) : (bf16_t)0; }
    } else {
#pragma unroll
      for (int g4 = 0; g4 < 2; ++g4) {
        const int n = n0 + 8 * g4 + 4 * h;
        float v3 = (n + 3 < 511) ? acc[4 * g4 + 3] : 0.f;
        *(uint2*)(p.VCT + ((size_t)bg * 64 + e_) * 512 + n) = pack4(acc[4 * g4], acc[4 * g4 + 1], acc[4 * g4 + 2], v3);
      }
    }
  }
  __syncthreads();
}
DI void kmax_body2(const Params& p, int vb) {
  const int tid = mytid(), g = tid & 1, t = vb * 256 + (tid >> 1), b = t >> 13;
  const bf16_t* k = p.NKS + (size_t)t * 128 + g * 64; const bf16_t* kw = p.NKW + (size_t)t * 128 + g * 64;
  float ss = 0.f, sw = 0.f;
  for (int d = 0; d < 64; d += 8) {
    uint4 a = *(const uint4*)(k + d), c = *(const uint4*)(kw + d);
    const unsigned aa[4] = {a.x, a.y, a.z, a.w}, cc[4] = {c.x, c.y, c.z, c.w};
#pragma unroll
    for (int q = 0; q < 4; ++q) {
      float x0 = __uint_as_float(aa[q] << 16), x1 = __uint_as_float(aa[q] & 0xffff0000u);
      float y0 = __uint_as_float(cc[q] << 16), y1 = __uint_as_float(cc[q] & 0xffff0000u);
      ss += x0 * x0 + x1 * x1; sw += y0 * y0 + y1 * y1;
    }
  }
  float m1 = sqrtf(ss), m2 = sqrtf(sw);
  for (int o = 2; o < 64; o <<= 1) { m1 = fmaxf(m1, __shfl_xor(m1, o)); m2 = fmaxf(m2, __shfl_xor(m2, o)); }
  if ((tid & 63) < 2) { atomicMax(&p.ksmax[b * 2 + g], __float_as_uint(m1)); atomicMax(&p.ksmax[4 + b * 2 + g], __float_as_uint(m2)); }
}
DI void kcmax_body(const Params& p, int idx) {
  const bf16_t* k = p.KC + (size_t)idx * 64;
  float ss = 0.f;
  for (int d = 0; d < 64; ++d) { float v = bf2f(k[d]); ss += v * v; }
  atomicMax(&p.ksmax[8 + (idx >> 9)], __float_as_uint(sqrtf(ss)));
}

#define NSA_IMP 0
#define NSA_SELM 65536
#define NSA_KV 66816
#define KV_ROW 144
#define KV_TILE (64 * KV_ROW)
template <int CTRL> DI float dpp_f2(float x) { return __builtin_bit_cast(float, __builtin_amdgcn_mov_dpp(__builtin_bit_cast(int, x), CTRL, 0xf, 0xf, true)); }
DI float quad_sum(float v) { v += dpp_f2<0xB1>(v); v += dpp_f2<0x4E>(v); return v; }
DI bf16x8 lds8x2(const char* ptr) {
  uint2 a = *(const uint2*)ptr, b = *(const uint2*)(ptr + 16);
  uint4 v; v.x = a.x; v.y = a.y; v.z = b.x; v.w = b.y;
  return __builtin_bit_cast(bf16x8, v);
}

DI void nsa_item(const Params& p, int item, char* smem) {
  const int tid = mytid(), lane = tid & 63, w = tid >> 6, r = lane & 31, h = lane >> 5;
  const int ti = item >> 2, bg = item & 3, b = bg >> 1, g = bg & 1;
  const int ts = ti * 64, tokg0 = b * SEQ + ts;
  const int tkl = 8 * w + (r >> 2), hl = r & 3, hd = g * 4 + hl, tpos = ts + tkl;
  float* IMPA = (float*)(smem + NSA_IMP); float* IMPB = IMPA + 64 * 128;
  unsigned* SELM = (unsigned*)(smem + NSA_SELM);
  char* KVB = smem + NSA_KV;
  const float ksm = __uint_as_float(p.ksmax[bg]), kwm = __uint_as_float(p.ksmax[4 + bg]), kcm = __uint_as_float(p.ksmax[8 + bg]);

  bf16x8 qf[4];
#pragma unroll
  for (int s = 0; s < 4; ++s) qf[s] = ld16(p.NQ + (size_t)(tokg0 + tkl) * 512 + hd * 64 + 16 * s + 8 * h);
  float qq = 0.f;
#pragma unroll
  for (int s = 0; s < 4; ++s) {
    uint4 u = __builtin_bit_cast(uint4, qf[s]);
    const unsigned uu[4] = {u.x, u.y, u.z, u.w};
#pragma unroll
    for (int q = 0; q < 4; ++q) { float x0 = __uint_as_float(uu[q] << 16), x1 = __uint_as_float(uu[q] & 0xffff0000u); qq += x0 * x0 + x1 * x1; }
  }
  qq += __shfl_xor(qq, 32);
  const float qn = sqrtf(qq);
  const int srow = tid >> 3, sch = tid & 7;
  const bf16_t* ksrc = p.NKS + ((size_t)(b * SEQ) + srow) * 128 + g * 64 + sch * 8;
  const bf16_t* vsrc = p.NVST + ((size_t)bg * 64 + srow) * SEQ + sch * 8;
  const bf16_t* kcs = p.KC + ((size_t)bg * 512 + srow) * 64 + sch * 8;
  const bf16_t* vcs = p.VCT + ((size_t)bg * 64 + srow) * 512 + sch * 8;
  char* sdst = KVB + srow * KV_ROW + sch * 16;
  {
    uint4 k0 = *(const uint4*)kcs, v0 = *(const uint4*)vcs;
    *(uint4*)sdst = k0; *(uint4*)(sdst + KV_TILE) = v0;
  }
  for (int q = tid; q < 64 * 128 * 2 / 4; q += NT) ((float4*)IMPA)[q] = make_float4(0.f, 0.f, 0.f, 0.f);
  __syncthreads();

#define RING_RUN(KS, KSTEP, VS, VSTEP, NTILES, NEED, COMPUTE)                                                                               \
  {                                                                                                                                         \
    for (int jj = 0; jj < (NTILES); ++jj) {                                                                                                 \
      uint4 ka_, va_;                                                                                                                       \
      ka_ = va_ = make_uint4(0u, 0u, 0u, 0u);                                                                                               \
      if (jj + 1 < (NTILES)) { ka_ = *(const uint4*)((KS) + (size_t)(jj + 1) * (KSTEP)); va_ = *(const uint4*)((VS) + (size_t)(jj + 1) * (VSTEP)); } \
      if (NEED(jj)) { const char* kb = KVB + (jj & 1) * 2 * KV_TILE; const char* vbuf = kb + KV_TILE; COMPUTE(jj, kb, vbuf) }               \
      if (jj + 1 < (NTILES)) { char* d2 = sdst + ((jj + 1) & 1) * 2 * KV_TILE; *(uint4*)d2 = ka_; *(uint4*)(d2 + KV_TILE) = va_; }          \
      __syncthreads();                                                                                                                      \
    }                                                                                                                                       \
  }
#define STAGE_PAIR0(KS, KSTEP, VS, VSTEP, NTILES) { uint4 k0_ = *(const uint4*)(KS), v0_ = *(const uint4*)(VS); *(uint4*)sdst = k0_; *(uint4*)(sdst + KV_TILE) = v0_; }
#define IMP_NONE(JJ, kh, pv)
#define ATT_EXP(x) ex2(x)
#define ATT_LSUM(LACC, pv) LACC += ((pv[0] + pv[1]) + (pv[2] + pv[3])) + ((pv[4] + pv[5]) + (pv[6] + pv[7])) + ((pv[8] + pv[9]) + (pv[10] + pv[11])) + ((pv[12] + pv[13]) + (pv[14] + pv[15]));
#define ATT_TILE(kb, vbuf, INIT, FULL, MASKEXPR, SCALE, ACC, LACC, IMPHOOK, JJ)                                                             \
          {                                                                                                                                 \
            bf16x8 kf_[2][4], vf_[2][2][2];       \
            _Pragma("unroll") for (int kh = 0; kh < 2; ++kh)                                                                                \
              _Pragma("unroll") for (int s = 0; s < 4; ++s) kf_[kh][s] = *(const bf16x8*)(kb + (32 * kh + r) * KV_ROW + (16 * s + 8 * h) * 2); \
            _Pragma("unroll") for (int kh = 0; kh < 2; ++kh)                                                                                \
              _Pragma("unroll") for (int di = 0; di < 2; ++di)                                                                              \
                _Pragma("unroll") for (int s2 = 0; s2 < 2; ++s2) vf_[kh][di][s2] = lds8x2(vbuf + (32 * di + r) * KV_ROW + (32 * kh + 16 * s2 + 4 * h) * 2); \
            const bool full_ = (FULL);                                                                                                      \
            _Pragma("unroll") for (int kh = 0; kh < 2; ++kh) {                                                                              \
              f32x16 sa = fill16(INIT);                                                                                                     \
              _Pragma("unroll") for (int s = 0; s < 4; ++s) sa = MFMA32(kf_[kh][s], qf[s], sa);                                             \
              float pv[16];                                                                                                                 \
              _Pragma("unroll") for (int e = 0; e < 16; ++e) pv[e] = ATT_EXP(sa[e]) * (SCALE);                                              \
              if (!full_) { _Pragma("unroll") for (int e = 0; e < 16; ++e) { const int key = 32 * kh + crow(e, h); pv[e] = (MASKEXPR) ? pv[e] : 0.f; } }     \
              ATT_LSUM(LACC, pv)                                                                                                             \
              IMPHOOK(JJ, kh, pv)                                                                                                           \
              const bf16x8 pk0 = pack8(pv[0], pv[1], pv[2], pv[3], pv[4], pv[5], pv[6], pv[7]);                                             \
              const bf16x8 pk1 = pack8(pv[8], pv[9], pv[10], pv[11], pv[12], pv[13], pv[14], pv[15]);                                       \
              _Pragma("unroll") for (int di = 0; di < 2; ++di) {                                                                            \
                ACC[di] = MFMA32(vf_[kh][di][0], pk0, ACC[di]);                                                                             \
                ACC[di] = MFMA32(vf_[kh][di][1], pk1, ACC[di]);                                                                             \
              }                                                                                                                             \
            }                                                                                                                               \
          }
  const float mbc = qn * kcm;
  int nvalid = (tpos >= 31) ? ((tpos - 31) >> 4) + 1 : 0;
  if (nvalid > 511) nvalid = 511;
  int nvw = (ts + 8 * w + 7 >= 31) ? ((ts + 8 * w + 7 - 31) >> 4) + 1 : 0;
  if (nvw > 511) nvw = 511;
  int nvmin = (ts + 8 * w >= 31) ? ((ts + 8 * w - 31) >> 4) + 1 : 0;
  if (nvmin > 511) nvmin = 511;
  int nvall = ((ts + 63 - 31) >> 4) + 1;
  if (nvall > 511) nvall = 511;
  const int nct = (nvall + 63) >> 6;
  float lsum = 0.f;
#define CMP_NEED(jj) (64 * (jj) < nvw)
#define CMPA_COMPUTE(jj, kb, vbuf)                                                                                                          \
          { _Pragma("unroll") for (int kh = 0; kh < 2; ++kh) {                                                                              \
              f32x16 sa = fill16(-mbc);                                                                                                     \
              _Pragma("unroll") for (int s = 0; s < 4; ++s) sa = MFMA32(*(const bf16x8*)(kb + (32 * kh + r) * KV_ROW + (16 * s + 8 * h) * 2), qf[s], sa); \
              const bool full_ = 64 * (jj) + 64 <= nvmin;                                                                                   \
              if (full_) { _Pragma("unroll") for (int e = 0; e < 16; ++e) lsum += ex2(sa[e]); }                                             \
              else { _Pragma("unroll") for (int e = 0; e < 16; ++e) lsum += (64 * (jj) + 32 * kh + crow(e, h) < nvalid) ? ex2(sa[e]) : 0.f; } \
            } }
  RING_RUN(kcs, 64 * 64, vcs, 64, nct, CMP_NEED, CMPA_COMPUTE)
  lsum += __shfl_xor(lsum, 32);
  const float invl = (lsum > 0.f) ? 1.f / lsum : 0.f;
  f32x16 oc[2]; oc[0] = zero16(); oc[1] = zero16();
  {
    float ldummy = 0.f;
    STAGE_PAIR0(kcs, 64 * 64, vcs, 64, nct) __syncthreads();
#define CMP_IMP(JJ, kh, pv)                                                                                                                 \
              _Pragma("unroll") for (int q = 0; q < 4; ++q) {                                                                               \
                float A_ = 2.f * (pv[4 * q] + pv[4 * q + 1] + pv[4 * q + 2]) + pv[4 * q + 3], B_ = pv[4 * q + 3];                           \
                A_ = quad_sum(A_); B_ = quad_sum(B_);                                                                                       \
                if (hl == 0) { const int j_ = 16 * (JJ) + 8 * kh + 2 * q + h; IMPA[tkl * 128 + j_] = A_; IMPB[tkl * 128 + j_] = B_; }        \
              }
#define CMPB_COMPUTE(jj, kb, vbuf) ATT_TILE(kb, vbuf, -mbc, 64 * (jj) + 64 <= nvmin, 64 * (jj) + key < nvalid, invl, oc, ldummy, CMP_IMP, jj)
    RING_RUN(kcs, 64 * 64, vcs, 64, nct, CMP_NEED, CMPB_COMPUTE)
  }
  for (int rep522 = 0; rep522 < (PROBE_DUP == 522 ? 2 : 1); ++rep522)
  {
    const int tl = 8 * w + (lane >> 3), sub = lane & 7;
    unsigned kv_[16], ki_[16];
#pragma unroll
    for (int c = 0; c < 16; ++c) {
      const int j = sub + 8 * c;
      float imp = IMPA[tl * 128 + j] + ((j > 0) ? IMPB[tl * 128 + j - 1] : 0.f);
      if (j == 0 || j == ti || j == ti - 1) imp = 1e9f;
      kv_[c] = (j <= ti) ? __float_as_uint(imp) : 0u;
      ki_[c] = (j <= ti) ? (unsigned)(128 - j) : 0u;
    }
    unsigned m0 = 0, m1 = 0, m2 = 0, m3 = 0;
    for (int it = 0; it < 16; ++it) {
      unsigned bv = kv_[0], bi = ki_[0];
#pragma unroll
      for (int c = 1; c < 16; ++c) { const bool gt = (kv_[c] > bv) || (kv_[c] == bv && ki_[c] > bi); bv = gt ? kv_[c] : bv; bi = gt ? ki_[c] : bi; }
#define TOPK_STEP(CTRL) { const unsigned ov = (unsigned)__builtin_amdgcn_mov_dpp((int)bv, CTRL, 0xf, 0xf, true), oi = (unsigned)__builtin_amdgcn_mov_dpp((int)bi, CTRL, 0xf, 0xf, true); \
        const bool gt = (ov > bv) || (ov == bv && oi > bi); bv = gt ? ov : bv; bi = gt ? oi : bi; }
      TOPK_STEP(0xB1) TOPK_STEP(0x4E) TOPK_STEP(0x141)
#undef TOPK_STEP
      if (bi != 0u) {
        const int js = 128 - (int)bi;
        const unsigned bit = 1u << (js & 31);
        if ((js >> 5) == 0) m0 |= bit; else if ((js >> 5) == 1) m1 |= bit; else if ((js >> 5) == 2) m2 |= bit; else m3 |= bit;
#pragma unroll
        for (int c = 0; c < 16; ++c) { const bool hit = (ki_[c] == bi); kv_[c] = hit ? 0u : kv_[c]; ki_[c] = hit ? 0u : ki_[c]; }
      }
    }
    if (sub == 0) { SELM[tl * 4 + 0] = m0; SELM[tl * 4 + 1] = m1; SELM[tl * 4 + 2] = m2; SELM[tl * 4 + 3] = m3; }
  }
  if (lane < 4) {
    unsigned u = 0;
#pragma unroll
    for (int t8 = 0; t8 < 8; ++t8) u |= SELM[(8 * w + t8) * 4 + lane];
    SELM[(64 + w) * 4 + lane] = u;
  }
  __syncthreads();
  const float* gt = p.GATE + (size_t)(tokg0 + tkl) * 24 + hd * 3;
  float* OUTL = IMPA;
  {
    const float g0 = gt[0];
#pragma unroll
    for (int e = 0; e < 16; ++e) { OUTL[e * 512 + tid] = g0 * oc[0][e]; OUTL[(16 + e) * 512 + tid] = g0 * oc[1][e]; }
  }
  STAGE_PAIR0(ksrc, 64 * 128, vsrc, 64, ti + 1) __syncthreads();
  const float mbs = qn * ksm;
  f32x16 osl[2]; osl[0] = zero16(); osl[1] = zero16();
  float lsel = 0.f;
#define SEL_NEED(jj) ((SELM[(64 + w) * 4 + ((jj) >> 5)] >> ((jj) & 31)) & 1u)
#define SEL_COMPUTE(jj, kb, vbuf) { const unsigned msel_ = SELM[tkl * 4 + ((jj) >> 5)]; \
      const float init_ = ((msel_ >> ((jj) & 31)) & 1u) ? -mbs : NEG_INF; ATT_TILE(kb, vbuf, init_, (jj) < ti, key <= tkl, 1.f, osl, lsel, IMP_NONE, jj) }
  RING_RUN(ksrc, 64 * 128, vsrc, 64, ti + 1, SEL_NEED, SEL_COMPUTE)
  lsel += __shfl_xor(lsel, 32);
  {
    const float g1 = gt[1] / lsel;
#pragma unroll
    for (int e = 0; e < 16; ++e) { OUTL[e * 512 + tid] += g1 * osl[0][e]; OUTL[(16 + e) * 512 + tid] += g1 * osl[1][e]; }
  }
#if PROBE_DUP >= 530 && PROBE_DUP <= 539
  {
    osl[0] = zero16(); osl[1] = zero16(); lsel = 0.f;
    STAGE_PAIR0(ksrc, 64 * 128, vsrc, 64, ti + 1) __syncthreads();
#if PROBE_DUP == 530
    RING_RUN(ksrc, 64 * 128, vsrc, 64, ti + 1, SEL_NEED, SEL_COMPUTE)
#elif PROBE_DUP == 531
    for (int jj = 0; jj < ti + 1; ++jj) {
      if (SEL_NEED(jj)) { const char* kb = KVB + (jj & 1) * 2 * KV_TILE; const char* vbuf = kb + KV_TILE; SEL_COMPUTE(jj, kb, vbuf) }
      __syncthreads();
    }
#elif PROBE_DUP == 532
    for (int jj = 0; jj < ti + 1; ++jj) {
      uint4 ka_, va_;
      ka_ = va_ = make_uint4(0u, 0u, 0u, 0u);
      if (jj + 1 < ti + 1) { ka_ = *(const uint4*)(ksrc + (size_t)(jj + 1) * (64 * 128)); va_ = *(const uint4*)(vsrc + (size_t)(jj + 1) * 64); }
      if (jj + 1 < ti + 1) { char* d2 = sdst + ((jj + 1) & 1) * 2 * KV_TILE; *(uint4*)d2 = ka_; *(uint4*)(d2 + KV_TILE) = va_; }
      __syncthreads();
    }
#elif PROBE_DUP >= 533
#if PROBE_DUP == 534
#undef ATT_LSUM
#define ATT_LSUM(LACC, pv) LACC += pv[0];
#elif PROBE_DUP == 535
#undef ATT_EXP
#define ATT_EXP(x) (x)
#elif PROBE_DUP == 536
#undef ATT_EXP
#define ATT_EXP(x) (x)
#undef ATT_LSUM
#define ATT_LSUM(LACC, pv) LACC += pv[0];
#endif
    for (int jj = 0; jj < ti + 1; ++jj) {
      if (SEL_NEED(jj)) { const char* kb = KVB + (jj & 1) * 2 * KV_TILE; const char* vbuf = kb + KV_TILE; SEL_COMPUTE(jj, kb, vbuf) }
    }
    __syncthreads();
#endif
#undef ATT_EXP
#undef ATT_LSUM
#define ATT_EXP(x) ex2(x)
#define ATT_LSUM(LACC, pv) LACC += ((pv[0] + pv[1]) + (pv[2] + pv[3])) + ((pv[4] + pv[5]) + (pv[6] + pv[7])) + ((pv[8] + pv[9]) + (pv[10] + pv[11])) + ((pv[12] + pv[13]) + (pv[14] + pv[15]));
    float chk = lsel;
#pragma unroll
    for (int e = 0; e < 16; ++e) chk += osl[0][e] + osl[1][e];
    if (__float_as_uint(chk) == 0x7fc12345u) OUTL[tid] += 1.f;
  }
#endif
  f32x16 ow[2]; ow[0] = zero16(); ow[1] = zero16();
  float lw = 0.f;
  const float mbw = qn * kwm;
  {
    const int j0w = (ti >= 8) ? ti - 8 : 0, nwt = ti - j0w + 1;
    const bf16_t* kws = p.NKW + ((size_t)(b * SEQ + 64 * j0w) + srow) * 128 + g * 64 + sch * 8;
    const bf16_t* vws = p.NVWT + ((size_t)bg * 64 + srow) * SEQ + 64 * j0w + sch * 8;
    STAGE_PAIR0(kws, 64 * 128, vws, 64, nwt) __syncthreads();
#define WIN_NEED(jj) true
#define WIN_COMPUTE(jj, kb, vbuf) { const int jw_ = j0w + (jj); const bool last_ = (jw_ == ti), first_ = (ti >= 8) && ((jj) == 0); \
      ATT_TILE(kb, vbuf, -mbw, !(last_ || first_), last_ ? (key <= tkl) : (key > tkl), 1.f, ow, lw, IMP_NONE, jj) }
    RING_RUN(kws, 64 * 128, vws, 64, nwt, WIN_NEED, WIN_COMPUTE)
  }
  lw += __shfl_xor(lw, 32);
  {
    const float g2 = gt[2] / lw;
#pragma unroll
    for (int di = 0; di < 2; ++di)
#pragma unroll
      for (int g4 = 0; g4 < 4; ++g4) {
        const int d0 = 32 * di + 8 * g4 + 4 * h;
        float y[4];
#pragma unroll
        for (int e = 0; e < 4; ++e) y[e] = OUTL[(16 * di + 4 * g4 + e) * 512 + tid] + g2 * ow[di][4 * g4 + e];
        *(uint2*)(p.RA + (size_t)(tokg0 + tkl) * DM + 512 + hd * 64 + d0) = pack4(y[0], y[1], y[2], y[3]);
      }
  }
  __syncthreads();
}

typedef float f32x4 __attribute__((ext_vector_type(4)));
#define MFMA16(a, b, c) __builtin_amdgcn_mfma_f32_16x16x32_bf16((a), (b), (c), 0, 0, 0)
constexpr int pk_clen(int i) { return 16 / (i + 1); }
constexpr int pk_coff(int i) { int s = 0; for (int q = 0; q < i; ++q) s += pk_clen(q); return s; }
constexpr int pk_cand(int c) {
  int i = 0; while (i < 16 && c >= pk_clen(i)) { c -= pk_clen(i); ++i; }
  return (i < 16) ? i * 16 + c : 256;
}
#define SC_STRIDE 132

DI void convert_row(const Params& p, int row, int lane);
DI unsigned f2key(float x, unsigned tag, unsigned tagmask) {
  const unsigned bits = __float_as_uint(x), m = (unsigned)((int)bits >> 31) | 0x80000000u;
  return ((bits ^ m) & ~tagmask) | tag;
}
DI float key2f(unsigned k, unsigned tagmask) {
  const unsigned u = k & ~tagmask;
  return __uint_as_float((u & 0x80000000u) ? (u ^ 0x80000000u) : ~u);
}
DI void peer_topk_tile(const Params& p, int vb, char* smem) {
  unsigned* SC = (unsigned*)smem;
  unsigned* ELK = (unsigned*)(smem + 256 * SC_STRIDE * 4);
  float* ELW = (float*)(ELK + 16 * 128);
  int* CT = (int*)(ELW + 16 * 128);
  const int tid = mytid(), lane = tid & 63, w = tid >> 6;
  const int t0 = vb * 16;
  if (tid < 64) { int i = 0, c = tid; while (i < 16 && c >= 16 / (i + 1)) { c -= 16 / (i + 1); ++i; } CT[tid] = (i < 16) ? i * 16 + c : 0; }
  for (int rep91 = 0; rep91 < (PROBE_DUP == 91 ? 2 : 1); ++rep91) {
    const int tq = lane & 15, kq = lane >> 4;
#pragma unroll
    for (int pi = 0; pi < 2; ++pi) {
      const int ph = 2 * w + pi;
      bf16x8 bfr[4];
#pragma unroll
      for (int s = 0; s < 4; ++s) bfr[s] = *(const bf16x8*)(p.PQ + (size_t)(t0 + tq) * 2048 + ph * 128 + 32 * s + 8 * kq);
#pragma unroll
      for (int j = 0; j < 8; ++j) {
        f32x4 acc = {0.f, 0.f, 0.f, 0.f};
#pragma unroll
        for (int s = 0; s < 4; ++s) {
          bf16x8 afr = *(const bf16x8*)(p.SUBK + ((size_t)(ph * 128 + 16 * j + tq)) * 128 + 32 * s + 8 * kq);
          acc = MFMA16(afr, bfr[s], acc);
        }
        const int n0 = 16 * j + 4 * kq;
        uint4 kv4;
        kv4.x = f2key(acc[0], 127u - n0, 127u); kv4.y = f2key(acc[1], 126u - n0, 127u); kv4.z = f2key(acc[2], 125u - n0, 127u); kv4.w = f2key(acc[3], 124u - n0, 127u);
        *(uint4*)(SC + (ph * 16 + tq) * SC_STRIDE + n0) = kv4;
      }
    }
  }
  __syncthreads();
  if (tid < 256) {
    unsigned* row = SC + tid * SC_STRIDE;
    unsigned gmax[16];
#pragma unroll
    for (int g = 0; g < 16; ++g) {
      uint4 a = *(uint4*)(row + g * 8), b = *(uint4*)(row + g * 8 + 4);
      gmax[g] = max(max(max(a.x, a.y), max(a.z, a.w)), max(max(b.x, b.y), max(b.z, b.w)));
    }
    unsigned outk[16];
#pragma unroll
    for (int k = 0; k < 16; ++k) {
      unsigned m = max(max(max(max(gmax[0], gmax[1]), max(gmax[2], gmax[3])), max(max(gmax[4], gmax[5]), max(gmax[6], gmax[7]))),
                       max(max(max(gmax[8], gmax[9]), max(gmax[10], gmax[11])), max(max(gmax[12], gmax[13]), max(gmax[14], gmax[15]))));
      const int n = 127 - (int)(m & 127u), gi = n >> 3;
      unsigned* gp = row + gi * 8;
      uint4 a = *(uint4*)gp, b = *(uint4*)(gp + 4);
      const unsigned v[8] = {a.x, a.y, a.z, a.w, b.x, b.y, b.z, b.w};
      unsigned nm = 0u;
#pragma unroll
      for (int e = 0; e < 8; ++e) nm = max(nm, (v[e] == m) ? 0u : v[e]);
      row[n] = 0u;
#pragma unroll
      for (int g = 0; g < 16; ++g) gmax[g] = (g == gi) ? nm : gmax[g];
      outk[k] = m;
    }
#pragma unroll
    for (int k = 0; k < 16; ++k) row[k] = outk[k];
  } else {
#pragma unroll
    for (int i = 0; i < 4; ++i) convert_row(p, (vb * 4 + (w - 4)) * 8 + 2 * i, lane);
  }
  __syncthreads();
  for (int rep93 = 0; rep93 < (PROBE_DUP == 93 ? 2 : 1); ++rep93) {
    const int q = tid >> 2, sub = tid & 3, t = q >> 3, pp = q & 7;
    const unsigned* ra = SC + ((2 * pp) * 16 + t) * SC_STRIDE;
    const unsigned* rb = SC + ((2 * pp + 1) * 16 + t) * SC_STRIDE;
    unsigned ck[13];
#pragma unroll
    for (int k = 0; k < 13; ++k) {
      const int ij = (sub == 0) ? pk_cand(4 * k) : (sub == 1) ? pk_cand(4 * k + 1) : (sub == 2) ? pk_cand(4 * k + 2) : pk_cand(4 * k + 3);
      const int ord = 4 * k + sub;
      ck[k] = (ij < 256) ? f2key(key2f(ra[ij >> 4], 127u) + key2f(rb[ij & 15], 127u), (unsigned)(63 - ord), 63u) : 0u;
    }
    unsigned w16[16];
#pragma unroll
    for (int k = 0; k < 16; ++k) {
      unsigned bm = max(max(max(max(ck[0], ck[1]), max(ck[2], ck[3])), max(max(ck[4], ck[5]), max(ck[6], ck[7]))), max(max(max(ck[8], ck[9]), max(ck[10], ck[11])), ck[12]));
      bm = max(bm, (unsigned)__builtin_amdgcn_mov_dpp((int)bm, 0xB1, 0xf, 0xf, true));
      bm = max(bm, (unsigned)__builtin_amdgcn_mov_dpp((int)bm, 0x4E, 0xf, 0xf, true));
#pragma unroll
      for (int c = 0; c < 13; ++c) ck[c] = (ck[c] == bm) ? 0u : ck[c];
      w16[k] = bm;
    }
    float l = 0.f; const float vmax = key2f(w16[0], 63u);
    float ev[16];
#pragma unroll
    for (int k = 0; k < 16; ++k) { ev[k] = __expf(key2f(w16[k], 63u) - vmax); l += ev[k]; }
    const float inv = 1.f / l;
#pragma unroll
    for (int k = 0; k < 16; ++k)
      if ((k & 3) == sub) {
        const int ij = CT[63 - (int)(w16[k] & 63u)];
        const int code = (127 - (int)(ra[ij >> 4] & 127u)) * 128 + (127 - (int)(rb[ij & 15] & 127u));
        ELK[t * 128 + pp * 16 + k] = ((unsigned)code << 7) | (unsigned)(pp * 16 + k);
        ELW[t * 128 + pp * 16 + k] = ev[k] * inv;
      }
  }
  __syncthreads();
  for (int rep94 = 0; rep94 < (PROBE_DUP == 94 ? 2 : 1); ++rep94)
#pragma unroll
  for (int tt = 0; tt < 2; ++tt) {
    const int t = 2 * w + tt;
    const unsigned e0 = ELK[t * 128 + 2 * lane], e1 = ELK[t * 128 + 2 * lane + 1];
    int r0 = 0, r1 = 0;
#pragma unroll 8
    for (int c = 0; c < 32; ++c) {
      const uint4 kq = *(const uint4*)(ELK + t * 128 + 4 * c);
      r0 += (kq.x < e0) + (kq.y < e0) + (kq.z < e0) + (kq.w < e0);
      r1 += (kq.x < e1) + (kq.y < e1) + (kq.z < e1) + (kq.w < e1);
    }
    const size_t gb = (size_t)(t0 + t) * 128;
    p.EIDX[gb + r0] = (int)(e0 >> 7); p.EIDX[gb + r1] = (int)(e1 >> 7);
    p.EW[gb + r0] = ELW[t * 128 + (e0 & 127)]; p.EW[gb + r1] = ELW[t * 128 + (e1 & 127)];
  }
  __syncthreads();
}

DI float dot2bf(unsigned a, unsigned b, float acc) { return __builtin_amdgcn_fdot2_f32_bf16(__builtin_bit_cast(bf16x2_t, a), __builtin_bit_cast(bf16x2_t, b), acc, false); }
template <int CTRL> DI float dpp_f(float x) { return __builtin_bit_cast(float, __builtin_amdgcn_mov_dpp(__builtin_bit_cast(int, x), CTRL, 0xf, 0xf, true)); }
DI float row16_sum(float v) { v += dpp_f<0x128>(v); v += dpp_f<0x124>(v); v += dpp_f<0x122>(v); v += dpp_f<0x121>(v); return v; }
DI float dot_row(const uint4 (&u)[8], const uint4 (&h)[8]) {
  float d = 0.f;
#pragma unroll
  for (int j = 0; j < 8; ++j) { d = dot2bf(u[j].x, h[j].x, d); d = dot2bf(u[j].y, h[j].y, d); d = dot2bf(u[j].z, h[j].z, d); d = dot2bf(u[j].w, h[j].w, d); }
  return row16_sum(d);
}
DI void axpy_row(float (&acc)[64], const uint4 (&v)[8], float c) {
#pragma unroll
  for (int j = 0; j < 8; ++j) {
    const unsigned ww[4] = {v[j].x, v[j].y, v[j].z, v[j].w};
#pragma unroll
    for (int q = 0; q < 4; ++q) {
      acc[j * 8 + 2 * q] += c * __uint_as_float(ww[q] << 16);
      acc[j * 8 + 2 * q + 1] += c * __uint_as_float(ww[q] & 0xffff0000u);
    }
  }
}
DI void axpy_half(float (&acc)[32], const uint4 (&v)[4], float c) {
#pragma unroll
  for (int j = 0; j < 4; ++j) {
    const unsigned ww[4] = {v[j].x, v[j].y, v[j].z, v[j].w};
#pragma unroll
    for (int q = 0; q < 4; ++q) {
      acc[j * 8 + 2 * q] += c * __uint_as_float(ww[q] << 16);
      acc[j * 8 + 2 * q + 1] += c * __uint_as_float(ww[q] & 0xffff0000u);
    }
  }
}
#ifndef PEER_TILE_SHIFT
#define PEER_TILE_SHIFT 8
#endif
DI void fma16_fp8(float& d, const uint4& u, const float* hv) {
  const unsigned ww[4] = {u.x, u.y, u.z, u.w};
#pragma unroll
  for (int q = 0; q < 4; ++q) {
    f32x2_t a = __builtin_amdgcn_cvt_pk_f32_fp8((int)ww[q], false), b = __builtin_amdgcn_cvt_pk_f32_fp8((int)ww[q], true);
    d += a[0] * hv[4 * q] + a[1] * hv[4 * q + 1] + b[0] * hv[4 * q + 2] + b[1] * hv[4 * q + 3];
  }
}
DI float dot_row8(const uint4 (&u)[4], const float (&hv)[64]) {
  float d0 = 0.f, d1 = 0.f;
  fma16_fp8(d0, u[0], hv); fma16_fp8(d1, u[1], hv + 16); fma16_fp8(d0, u[2], hv + 32); fma16_fp8(d1, u[3], hv + 48);
  return row16_sum(d0 + d1);
}
DI void axpy_row8(float (&acc)[64], const uint4 (&v)[4], float c) {
#pragma unroll
  for (int j = 0; j < 4; ++j) {
    const unsigned ww[4] = {v[j].x, v[j].y, v[j].z, v[j].w};
#pragma unroll
    for (int q = 0; q < 4; ++q) {
      f32x2_t a = __builtin_amdgcn_cvt_pk_f32_fp8((int)ww[q], false), b = __builtin_amdgcn_cvt_pk_f32_fp8((int)ww[q], true);
      acc[j * 16 + 4 * q] += c * a[0]; acc[j * 16 + 4 * q + 1] += c * a[1]; acc[j * 16 + 4 * q + 2] += c * b[0]; acc[j * 16 + 4 * q + 3] += c * b[1];
    }
  }
}
typedef float f32x32_t __attribute__((ext_vector_type(32)));
typedef float f32x16_t __attribute__((ext_vector_type(16)));
typedef unsigned u32x6_t __attribute__((ext_vector_type(6)));
#define ROW6_BYTES 768
#define PIN(one, x) asm volatile("" : "+v"(one), "+v"(x))
DI float dot_row6(const uint4 (&X)[2], const uint2 (&Y)[2], const float (&hv)[64], float& one, float& d0, float& d1) {
  u32x6_t pa, pb;
  pa[0] = X[0].x; pa[1] = X[0].y; pa[2] = X[0].z; pa[3] = X[0].w; pa[4] = Y[0].x; pa[5] = Y[0].y;
  pb[0] = X[1].x; pb[1] = X[1].y; pb[2] = X[1].z; pb[3] = X[1].w; pb[4] = Y[1].x; pb[5] = Y[1].y;
  d0 = 0.f; d1 = 0.f;
  {
    const f32x32_t fa = __builtin_amdgcn_cvt_scalef32_pk32_f32_fp6(pa, one);
#pragma unroll
    for (int k = 0; k < 32; k += 2) { d0 += fa[k] * hv[k]; d1 += fa[k + 1] * hv[k + 1]; }
  }
  {
    const f32x32_t fb = __builtin_amdgcn_cvt_scalef32_pk32_f32_fp6(pb, one);
#pragma unroll
    for (int k = 0; k < 32; k += 2) { d0 += fb[k] * hv[32 + k]; d1 += fb[k + 1] * hv[32 + k + 1]; }
  }
  return row16_sum(d0 + d1);
}
DI void axpy_row6(float (&acc)[64], const uint4 (&X)[2], const uint2 (&Y)[2], float c, float& one) {
  u32x6_t pa, pb;
  pa[0] = X[0].x; pa[1] = X[0].y; pa[2] = X[0].z; pa[3] = X[0].w; pa[4] = Y[0].x; pa[5] = Y[0].y;
  pb[0] = X[1].x; pb[1] = X[1].y; pb[2] = X[1].z; pb[3] = X[1].w; pb[4] = Y[1].x; pb[5] = Y[1].y;
  {
    const f32x32_t fa = __builtin_amdgcn_cvt_scalef32_pk32_f32_fp6(pa, one);
#pragma unroll
    for (int k = 0; k < 32; ++k) acc[k] += c * fa[k];
  }
  PIN(one, acc[31]);
  {
    const f32x32_t fb = __builtin_amdgcn_cvt_scalef32_pk32_f32_fp6(pb, one);
#pragma unroll
    for (int k = 0; k < 32; ++k) acc[32 + k] += c * fb[k];
  }
}
DI void peer_gather_block(const Params& p, int vb, char* smem) {
  unsigned* ELK = (unsigned*)smem;
  float* ELC = (float*)(smem + 32768);
  const int tid = mytid(), lane = tid & 63, w = tid >> 6, grp = lane >> 4, i = lane & 15;
  const int tokbase = vb * 64;
  float* ELS = (float*)(smem + 65536);
  for (int q = tid; q < 64 * 128 / 4; q += NT) {
    const uint4 k4 = ((const uint4*)(p.EIDX + (size_t)tokbase * 128))[q];
    float4 w4 = ((const float4*)(p.EW + (size_t)tokbase * 128))[q];
    ((uint4*)ELK)[q] = k4;
    w4.x *= p.SUP[k4.x]; w4.y *= p.SUP[k4.y]; w4.z *= p.SUP[k4.z]; w4.w *= p.SUP[k4.w];
    ((float4*)ELC)[q] = w4;
    ((float4*)ELS)[q] = make_float4(p.SDN[k4.x], p.SDN[k4.y], p.SDN[k4.z], p.SDN[k4.w]);
  }
  __syncthreads();
#pragma unroll 1
  for (int tt = 0; tt < 2; ++tt) {
    const int tid_ = mytid(), i = tid_ & 15;
    const int tl = (tid_ >> 6) * 8 + ((tid_ & 63) >> 4) * 2 + tt, tok = tokbase + tl;
    const unsigned* kk = ELK + tl * 128;
    float* cc = ELC + tl * 128;
    const float* sdn = ELS + tl * 128;
    uint4 b0[2], b1[2], b2[2], b3[2]; uint2 c0[2], c1[2], c2[2], c3[2];
    float one = 1.0f, dd0 = 0.f, dd1 = 0.f;
#define ROW_LOAD(BUF, CUF, BASE, E) { const unsigned char* r_ = (BASE) + (size_t)kk[E] * ROW6_BYTES; \
      BUF[0] = *(const uint4*)(r_ + i * 16); CUF[0] = *(const uint2*)(r_ + 256 + i * 8); BUF[1] = *(const uint4*)(r_ + 384 + i * 16); CUF[1] = *(const uint2*)(r_ + 640 + i * 8); }
    {
      float hv[64];
#pragma unroll
      for (int j = 0; j < 4; ++j)
#pragma unroll
        for (int hf = 0; hf < 2; ++hf) {
          uint4 a = *(const uint4*)(p.RA + (size_t)tok * DM + j * 256 + i * 16 + hf * 8);
          const unsigned aa[4] = {a.x, a.y, a.z, a.w};
#pragma unroll
          for (int q = 0; q < 4; ++q) { hv[j * 16 + hf * 8 + 2 * q] = __uint_as_float(aa[q] << 16); hv[j * 16 + hf * 8 + 2 * q + 1] = __uint_as_float(aa[q] & 0xffff0000u); }
        }
      const unsigned char* ub_ = p.PDN8;
#define DN_COMP(BUF, CUF, E) { float d_ = dot_row6(BUF, CUF, hv, one, dd0, dd1) * sdn[E]; float c_ = cc[E] * gelu_tanh(d_); if (i == 0) cc[E] = c_; }
      ROW_LOAD(b0, c0, ub_, 0) ROW_LOAD(b1, c1, ub_, 1) ROW_LOAD(b2, c2, ub_, 2) ROW_LOAD(b3, c3, ub_, 3)
      for (int e = 0; e < 128; e += 4) {
        DN_COMP(b0, c0, e)     ROW_LOAD(b0, c0, ub_, (e + 4) & 127)
        DN_COMP(b1, c1, e + 1) ROW_LOAD(b1, c1, ub_, (e + 5) & 127)
        DN_COMP(b2, c2, e + 2) ROW_LOAD(b2, c2, ub_, (e + 6) & 127)
        DN_COMP(b3, c3, e + 3) ROW_LOAD(b3, c3, ub_, (e + 7) & 127)
      }
#undef DN_COMP
#if PROBE_DUP >= 101 && PROBE_DUP <= 103
      {
        float chk = 0.f; unsigned xk = 0u;
#define DN_PROBE(BUF, CUF, E) { float d_ = dot_row6(BUF, CUF, hv, one, dd0, dd1) * sdn[E]; chk += cc[E] * gelu_tanh(d_); }
#define DN_XOR(BUF, CUF, E) { xk ^= BUF[0].x ^ BUF[0].y ^ BUF[0].z ^ BUF[0].w ^ BUF[1].x ^ BUF[1].y ^ BUF[1].z ^ BUF[1].w ^ CUF[0].x ^ CUF[0].y ^ CUF[1].x ^ CUF[1].y; }
        ROW_LOAD(b0, c0, ub_, 0) ROW_LOAD(b1, c1, ub_, 1) ROW_LOAD(b2, c2, ub_, 2) ROW_LOAD(b3, c3, ub_, 3)
        for (int e = 0; e < 128; e += 4) {
#if PROBE_DUP == 101
          DN_PROBE(b0, c0, e)     if (e + 4 < 128) ROW_LOAD(b0, c0, ub_, e + 4)
          DN_PROBE(b1, c1, e + 1) if (e + 4 < 128) ROW_LOAD(b1, c1, ub_, e + 5)
          DN_PROBE(b2, c2, e + 2) if (e + 4 < 128) ROW_LOAD(b2, c2, ub_, e + 6)
          DN_PROBE(b3, c3, e + 3) if (e + 4 < 128) ROW_LOAD(b3, c3, ub_, e + 7)
#elif PROBE_DUP == 102
          DN_XOR(b0, c0, e)     if (e + 4 < 128) ROW_LOAD(b0, c0, ub_, e + 4)
          DN_XOR(b1, c1, e + 1) if (e + 4 < 128) ROW_LOAD(b1, c1, ub_, e + 5)
          DN_XOR(b2, c2, e + 2) if (e + 4 < 128) ROW_LOAD(b2, c2, ub_, e + 6)
          DN_XOR(b3, c3, e + 3) if (e + 4 < 128) ROW_LOAD(b3, c3, ub_, e + 7)
#else
          DN_PROBE(b0, c0, e) DN_PROBE(b1, c1, e + 1) DN_PROBE(b2, c2, e + 2) DN_PROBE(b3, c3, e + 3)
          b0[0].x ^= __float_as_uint(chk) & 1u;
#endif
        }
        if (__float_as_uint(chk) == 0x7fc12345u || xk == 0x9e3779b9u) cc[0] += 1.f;
#undef DN_PROBE
#undef DN_XOR
      }
#endif
    }
    {
      float acc[64];
#pragma unroll
      for (int e = 0; e < 64; ++e) acc[e] = 0.f;
      const unsigned char* vbase = p.PUP8;
      ROW_LOAD(b0, c0, vbase, 0) ROW_LOAD(b1, c1, vbase, 1) ROW_LOAD(b2, c2, vbase, 2) ROW_LOAD(b3, c3, vbase, 3)
      for (int e = 0; e < 128; e += 4) {
        axpy_row6(acc, b0, c0, cc[e], one);     ROW_LOAD(b0, c0, vbase, (e + 4) & 127)
        axpy_row6(acc, b1, c1, cc[e + 1], one); ROW_LOAD(b1, c1, vbase, (e + 5) & 127)
        axpy_row6(acc, b2, c2, cc[e + 2], one); ROW_LOAD(b2, c2, vbase, (e + 6) & 127)
        axpy_row6(acc, b3, c3, cc[e + 3], one); ROW_LOAD(b3, c3, vbase, (e + 7) & 127)
      }
      int tokl = tok; asm volatile("" : "+v"(tokl));
      const int b = tokl >> 13;
      const float* ga2 = p.mod + b * 6144 + 5120;
      const float* orow = p.out + (size_t)tokl * DM; float* grow = p.gout + (size_t)tokl * DM;
      float ss = 0.f;
#pragma unroll
      for (int j = 0; j < 4; ++j)
#pragma unroll
        for (int q4 = 0; q4 < 4; ++q4) {
          const int col = j * 256 + i * 16 + q4 * 4;
          float4 x1 = *(const float4*)(orow + col), gg = *(const float4*)(ga2 + col);
          float* q = acc + j * 16 + q4 * 4;
          q[0] = x1.x + gg.x * q[0]; q[1] = x1.y + gg.y * q[1]; q[2] = x1.z + gg.z * q[2]; q[3] = x1.w + gg.w * q[3];
          ss += q[0] * q[0] + q[1] * q[1] + q[2] * q[2] + q[3] * q[3];
        }
      float4 gf[16];
#pragma unroll
      for (int j = 0; j < 4; ++j)
#pragma unroll
        for (int q4 = 0; q4 < 4; ++q4) gf[j * 4 + q4] = *(const float4*)(p.g_final + j * 256 + i * 16 + q4 * 4);
      ss = row16_sum(ss);
      const float rstd = rsqrtf(ss * (1.f / DM) + 1e-6f);
#pragma unroll
      for (int j = 0; j < 4; ++j)
#pragma unroll
        for (int q4 = 0; q4 < 4; ++q4) {
          const int col = j * 256 + i * 16 + q4 * 4;
          const float4 g4 = gf[j * 4 + q4];
          const float* q = acc + j * 16 + q4 * 4;
          *(float4*)(grow + col) = make_float4(q[0] * rstd * g4.x, q[1] * rstd * g4.y, q[2] * rstd * g4.z, q[3] * rstd * g4.w);
        }
    }
#undef ROW_LOAD
  }
  __syncthreads();
}
DI void convert_row(const Params& p, int row2, int lane) {
  const int row = row2 + (lane >> 5), L = lane & 31, i = L >> 1, gsel = L & 1;
  const int tb = row >> 14, rr = row & 16383;
  const float* src = (tb ? p.peer_up : p.peer_down) + (size_t)rr * DM + gsel * 512 + i * 16;
  float4 xa[4], xb[4]; float am = 0.f;
#pragma unroll
  for (int q = 0; q < 4; ++q) {
    xa[q] = *(const float4*)(src + q * 4); xb[q] = *(const float4*)(src + 256 + q * 4);
    am = fmaxf(am, fmaxf(fmaxf(fabsf(xa[q].x), fabsf(xa[q].y)), fmaxf(fabsf(xa[q].z), fabsf(xa[q].w))));
    am = fmaxf(am, fmaxf(fmaxf(fabsf(xb[q].x), fabsf(xb[q].y)), fmaxf(fabsf(xb[q].z), fabsf(xb[q].w))));
  }
  for (int o = 16; o; o >>= 1) am = fmaxf(am, __shfl_xor(am, o));
  const float sc = (am > 0.f) ? am * (1.f / 7.5f) : 1.f, inv = (am > 0.f) ? 7.5f / am : 1.f;
  f32x16_t va, vb;
  {
    float X[32];
#pragma unroll
    for (int q = 0; q < 4; ++q) {
      X[4 * q] = xa[q].x * inv; X[4 * q + 1] = xa[q].y * inv; X[4 * q + 2] = xa[q].z * inv; X[4 * q + 3] = xa[q].w * inv;
      X[16 + 4 * q] = xb[q].x * inv; X[16 + 4 * q + 1] = xb[q].y * inv; X[16 + 4 * q + 2] = xb[q].z * inv; X[16 + 4 * q + 3] = xb[q].w * inv;
    }
#pragma unroll
    for (int k = 0; k < 16; ++k) { va[k] = X[2 * k]; vb[k] = X[2 * k + 1]; }
  }
  const u32x6_t pk = __builtin_amdgcn_cvt_scalef32_2xpk16_fp6_f32(va, vb, 1.0f);
  unsigned char* dst = (tb ? p.PUP8 : p.PDN8) + (size_t)rr * ROW6_BYTES + gsel * 384;
  *(uint4*)(dst + i * 16) = make_uint4(pk[0], pk[1], pk[2], pk[3]);
  *(uint2*)(dst + 256 + i * 8) = make_uint2(pk[4], pk[5]);
  if (L == 0) (tb ? p.SUP : p.SDN)[rr] = sc;
}

#define N_PHASES 11
template <int PH>
DI void run_phase(const Params& p, char* smem) {
  const int nb = gridDim.x, bid = blockIdx.x, tid = mytid();
  if (PH == 0) {
    for (int vb = bid; vb < PH0_MOD; vb += nb) ph0_body(p, vb, smem);
  } else if (PH == 1) {
    constexpr int kPrepA = (PH0_WIN - PH0_MOD) + (PH0_ROPE - PH0_SUBK);
    for (int vb = bid; vb < T_TOK / 8 + kPrepA; vb += nb) {
      if (vb < T_TOK / 8) rownorm_body(p.x, p.g_mix, p.mod, 0, 1024, p.RA, vb);
      else { const int j = vb - T_TOK / 8; ph0_body(p, (j < PH0_WIN - PH0_MOD) ? PH0_MOD + j : PH0_SUBK + (j - (PH0_WIN - PH0_MOD)), smem); }
    }
  } else if (PH == 2) {
    {
      pg8::StaticOrder S; S.init(T_TOK, NPROJ, nb, bid);
      const pg8::Gemm g{p.RA, p.WinT, T_TOK, NPROJ, 1024};
      pg8::gemm_phase((PG8_LAS unsigned char*)smem, g, S, EpiProj8{p});
    }
    {
      constexpr int kPrepB = (PH0_W2V - PH0_WQ) + (PH0_B1P - PH0_ROPE);
      const int rem = (64 * 14) % nb;
      if (rem == 0 || bid >= rem) {
        for (int j = (rem == 0) ? bid : bid - rem; j < kPrepB; j += (rem == 0) ? nb : nb - rem)
          ph0_body(p, (j < PH0_W2V - PH0_WQ) ? PH0_WQ + j : PH0_ROPE + (j - (PH0_W2V - PH0_WQ)), smem);
      }
    }
  } else if (PH == 3) {
    for (int vb = bid; vb < 256 + 512 + 64; vb += nb) {
      if (vb < 256) compress_mfma(p, vb, smem);
      else if (vb < 256 + 512) retkv_mfma(p, vb - 256);
      else kmax_body2(p, vb - 768);
    }
  } else if (PH == 4) {
    constexpr int kPrepC = (PH0_WQ - PH0_WIN) + (PH0_SUBK - PH0_W2V);
    for (int vb = bid; vb < 256 + 4 + kPrepC; vb += nb) {
      if (vb < 256) scan_body(p, vb * NT + tid);
      else if (vb < 260) kcmax_body(p, (vb - 256) * NT + tid);
      else { const int j = vb - 260; ph0_body(p, (j < PH0_WQ - PH0_WIN) ? PH0_WIN + j : PH0_W2V + (j - (PH0_WQ - PH0_WIN)), smem); }
    }
  } else if (PH == 5) {
    for (int rep = 0; rep < (PROBE_DUP == 51 ? 2 : 1); ++rep)
      for (int vb = bid; vb < 256; vb += nb) retout_mfma(p, vb * 8 + (tid >> 6));
    for (int rep = 0; rep < (PROBE_DUP == 52 ? 2 : 1); ++rep)
      for (int vb = bid; vb < 512; vb += nb) nsa_item(p, (vb < 256) ? vb : 767 - vb, smem);
  } else if (PH == 6) {
    pg8::StaticOrder S; S.init(T_TOK, 1024, nb, bid);
    const pg8::Gemm g{p.RA, p.WoutT, T_TOK, 1024, 1024};
    pg8::gemm_phase((PG8_LAS unsigned char*)smem, g, S, EpiOut8{p.x, p.out, p.mod});
  } else if (PH == 7) {
    for (int vb = bid; vb < T_TOK / 8; vb += nb) rownorm_body(p.out, p.g_ffn, p.mod, 3072, 4096, p.RA, vb);
  } else if (PH == 8) {
    pg8::StaticOrder S; S.init(T_TOK, 2048, nb, bid);
    const pg8::Gemm g{p.RA, p.WqT, T_TOK, 2048, 1024};
    pg8::gemm_phase((PG8_LAS unsigned char*)smem, g, S, EpiPQ8{p.PQ});
  } else if (PH == 9) {
    for (int vb = bid; vb < T_TOK / 16; vb += nb) peer_topk_tile(p, vb, smem);
  } else if (PH == 10) {
    for (int vb = bid; vb < T_TOK / 64; vb += nb) peer_gather_block(p, vb, smem);
  }
}


#define XB_TMO      128
#define XB_XCNT(j)  (256  + 64 * (j))
#define XB_XSUB(j)  (1280 + 64 * (j))
#define XB_XGEN(j)  (2304 + 64 * (j))
#define XB_TOP      3328
#define XB_TOPGEN   3392
#define XCD_BAR_WORDS 3456
#define XB_SPIN_CAP (1u << 22)
#define LAS __attribute__((address_space(3)))
DI unsigned xb_ld(unsigned* p) { return __hip_atomic_load(p, __ATOMIC_RELAXED, __HIP_MEMORY_SCOPE_AGENT); }
DI unsigned xb_add(unsigned* p, unsigned v) { return __hip_atomic_fetch_add(p, v, __ATOMIC_RELAXED, __HIP_MEMORY_SCOPE_AGENT); }
DI unsigned xb_xcc_id() { return (unsigned)__builtin_amdgcn_s_getreg((3 << 11) | 20) & 0xFu; }
#define XB_SPIN(cond, bar) do { unsigned _sp = 0; while (cond) { __builtin_amdgcn_s_sleep(1); \
    if ((++_sp & 255u) == 0u) { if (xb_ld(&(bar)[XB_TMO])) break; if (_sp > XB_SPIN_CAP) { atomicAdd(&(bar)[XB_TMO], 1u); break; } } } } while (0)
struct XcdBarrier { unsigned* bar; unsigned x; volatile LAS unsigned* st; };
DI XcdBarrier xcd_barrier_post(unsigned* bar, volatile LAS unsigned* st) {
  XcdBarrier b; b.bar = bar; b.x = xb_xcc_id(); b.st = st;
  if (threadIdx.x == 0) (void)xb_add(&bar[XB_XCNT(b.x)], 1u);
  return b;
}
DI void xcd_barrier_complete(unsigned* bar, unsigned x, unsigned& nloc, unsigned& nx) {
  const unsigned G = gridDim.x * gridDim.y * gridDim.z;
  unsigned sum, cnt, mine, sp = 0u;
  for (;;) {
    sum = 0u; cnt = 0u; mine = 0u;
#pragma unroll
    for (unsigned j = 0; j < 16; ++j) { const unsigned c = xb_ld(&bar[XB_XCNT(j)]); sum += c; cnt += (c > 0u) ? 1u : 0u; mine = (j == x) ? c : mine; }
    if (sum == G) break;
    __builtin_amdgcn_s_sleep(1);
    if ((++sp & 255u) == 0u) { if (xb_ld(&bar[XB_TMO])) break; if (sp > XB_SPIN_CAP) { atomicAdd(&bar[XB_TMO], 1u); break; } }
  }
  nloc = mine > 0u ? mine : 1u; nx = cnt > 0u ? cnt : 1u;
}
DI void xcd_barrier(const XcdBarrier& b) {
  asm volatile("s_waitcnt vmcnt(0)" ::: "memory");
  __syncthreads();
  if (threadIdx.x == 0) {
    unsigned* bar = b.bar;
    __builtin_amdgcn_s_waitcnt(0);
    unsigned nloc = b.st[0], nx = b.st[1];
    if (nloc == 0u) { xcd_barrier_complete(bar, b.x, nloc, nx); b.st[0] = nloc; b.st[1] = nx; }
    const unsigned old = xb_add(&bar[XB_XSUB(b.x)], 1u);
    const unsigned gen = old / nloc;
    if (old + 1u == (gen + 1u) * nloc) {
      __builtin_amdgcn_fence(__ATOMIC_RELEASE, "agent");
      asm volatile("s_waitcnt vmcnt(0)" ::: "memory");
      const unsigned og = xb_add(&bar[XB_TOP], 1u);
      const unsigned tg = og / nx;
      if (og + 1u == (tg + 1u) * nx) xb_add(&bar[XB_TOPGEN], 1u);
      else XB_SPIN(xb_ld(&bar[XB_TOPGEN]) == tg, bar);
      __builtin_amdgcn_fence(__ATOMIC_ACQUIRE, "agent");
      xb_add(&bar[XB_XGEN(b.x)], 1u);
      asm volatile("s_waitcnt vmcnt(0)" ::: "memory");
    } else {
      XB_SPIN(xb_ld(&bar[XB_XGEN(b.x)]) == gen, bar);
      __builtin_amdgcn_fence(__ATOMIC_ACQUIRE, "agent");
      asm volatile("s_waitcnt vmcnt(0)" ::: "memory");
    }
  }
  __syncthreads();
}

#define SMEM_BYTES 155648

template <int PH>
DI void phase_and_probe(const Params& p, char* smem, cg::grid_group& grid) {
  const int reps = (PROBE_DUP == PH) ? 2 : 1;
  for (int rep = 0; rep < reps; ++rep) {
    if (PH == 10 && rep + 1 < reps) { Params q = p; q.gout = (float*)p.PQ; run_phase<PH>(q, smem); }
    else run_phase<PH>(p, smem);
    if (rep + 1 < reps) grid.sync();
  }
}
__global__ void __launch_bounds__(NT) k_mega(Params p) {
  extern __shared__ __attribute__((aligned(16))) char smem[];
  __shared__ uint4 xb_words;
  cg::grid_group grid = cg::this_grid();
  if (threadIdx.x == 0) xb_words = make_uint4(0u, 0u, 0u, 0u);
  __syncthreads();
  XcdBarrier xb = xcd_barrier_post(p.xbar, (volatile LAS unsigned*)&xb_words);
  phase_and_probe<0>(p, smem, grid); grid.sync();
  phase_and_probe<1>(p, smem, grid); xcd_barrier(xb);
  phase_and_probe<2>(p, smem, grid); xcd_barrier(xb);
  phase_and_probe<3>(p, smem, grid); xcd_barrier(xb);
  phase_and_probe<4>(p, smem, grid); xcd_barrier(xb);
  phase_and_probe<5>(p, smem, grid); xcd_barrier(xb);
  phase_and_probe<6>(p, smem, grid); xcd_barrier(xb);
  phase_and_probe<7>(p, smem, grid); xcd_barrier(xb);
  phase_and_probe<8>(p, smem, grid); xcd_barrier(xb);
  phase_and_probe<9>(p, smem, grid); xcd_barrier(xb);
  phase_and_probe<10>(p, smem, grid);
}
#ifdef MK_MULTI
template <int PH>
__global__ void __launch_bounds__(NT) k_single(Params p) {
  extern __shared__ __attribute__((aligned(16))) char smem[];
  run_phase<PH>(p, smem);
}
#endif

static size_t carve(size_t& off, size_t bytes) { size_t o = off; off += (bytes + 255) & ~(size_t)255; return o; }

extern "C" void kernel_launch(void* const* d_in, const int* in_sizes, int n_in, void* d_out, int out_size, void* d_ws, size_t ws_size,
                              hipStream_t stream) {
  Params p{};
  p.x = (const float*)d_in[0]; p.c = (const float*)d_in[1]; p.w_ada = (const float*)d_in[2]; p.b_ada = (const float*)d_in[3];
  p.g_mix = (const float*)d_in[4]; p.w_in = (const float*)d_in[5]; p.pe_k = (const float*)d_in[6]; p.pe_v = (const float*)d_in[7];
  p.w_k1 = (const float*)d_in[8]; p.b_k1 = (const float*)d_in[9]; p.w_k2 = (const float*)d_in[10]; p.w_v1 = (const float*)d_in[11];
  p.b_v1 = (const float*)d_in[12]; p.w_v2 = (const float*)d_in[13]; p.w_out = (const float*)d_in[14]; p.g_ffn = (const float*)d_in[15];
  p.w_pq = (const float*)d_in[16]; p.subkeys = (const float*)d_in[17]; p.peer_down = (const float*)d_in[18]; p.peer_up = (const float*)d_in[19];
  p.g_final = (const float*)d_in[20];
  p.out = (float*)d_out; p.gout = p.out;
  char* ws = (char*)d_ws;
  size_t off = 0;
  p.mod = (float*)(ws + carve(off, 2 * 6144 * 4));
  p.ksmax = (unsigned*)(ws + carve(off, 256));
  p.xbar = (unsigned*)(ws + carve(off, XCD_BAR_WORDS * 4));
  p.c128 = (float*)(ws + carve(off, (size_t)SEQ * 64 * 4)); p.s128 = (float*)(ws + carve(off, (size_t)SEQ * 64 * 4));
  p.c64 = (float*)(ws + carve(off, (size_t)SEQ * 32 * 4)); p.s64 = (float*)(ws + carve(off, (size_t)SEQ * 32 * 4));
  p.WinT = (bf16_t*)(ws + carve(off, (size_t)NPROJ * 1024 * 2));
  p.WoutT = (bf16_t*)(ws + carve(off, (size_t)1024 * 1024 * 2));
  p.WqT = (bf16_t*)(ws + carve(off, (size_t)2048 * 1024 * 2));
  p.W1Tk = (bf16_t*)(ws + carve(off, (size_t)256 * 2048 * 2)); p.W1Tv = (bf16_t*)(ws + carve(off, (size_t)256 * 2048 * 2));
  p.W2Tk = (bf16_t*)(ws + carve(off, 64 * 256 * 2)); p.W2Tv = (bf16_t*)(ws + carve(off, 64 * 256 * 2));
  p.SUBK = (bf16_t*)(ws + carve(off, (size_t)16 * 128 * 128 * 2));
  p.B1Pk = (float*)(ws + carve(off, 1024)); p.B1Pv = (float*)(ws + carve(off, 1024));
  p.RA = (bf16_t*)(ws + carve(off, (size_t)T_TOK * 1024 * 2));
  size_t rb = off;
  p.RQ = (bf16_t*)(ws + carve(off, (size_t)T_TOK * 512 * 2)); p.RK = (bf16_t*)(ws + carve(off, (size_t)T_TOK * 512 * 2));
  p.RKT = (bf16_t*)(ws + carve(off, (size_t)T_TOK * 512 * 2)); p.RVT = (bf16_t*)(ws + carve(off, (size_t)T_TOK * 512 * 2));
  p.RGT = (bf16_t*)(ws + carve(off, (size_t)T_TOK * 512 * 2)); p.NQ = (bf16_t*)(ws + carve(off, (size_t)T_TOK * 512 * 2));
  p.NKC = (bf16_t*)(ws + carve(off, (size_t)T_TOK * 128 * 2)); p.NVC = (bf16_t*)(ws + carve(off, (size_t)T_TOK * 128 * 2));
  p.NKS = (bf16_t*)(ws + carve(off, (size_t)T_TOK * 128 * 2)); p.NKW = (bf16_t*)(ws + carve(off, (size_t)T_TOK * 128 * 2));
  p.NVST = (bf16_t*)(ws + carve(off, (size_t)T_TOK * 128 * 2)); p.NVWT = (bf16_t*)(ws + carve(off, (size_t)T_TOK * 128 * 2));
  p.GATE = (float*)(ws + carve(off, (size_t)T_TOK * 24 * 4));
  p.KV = (float*)(ws + carve(off, (size_t)512 * 16384 * 4));
  p.SPREV = (bf16_t*)(ws + carve(off, (size_t)512 * 16384 * 2));
  p.KC = (bf16_t*)(ws + carve(off, (size_t)4 * 512 * 64 * 2)); p.VCT = (bf16_t*)(ws + carve(off, (size_t)4 * 512 * 64 * 2));
  p.HID = (float*)(ws + carve(off, (size_t)2 * 2048 * 256 * 4));
  size_t off2 = rb;
  p.PQ = (bf16_t*)(ws + carve(off2, (size_t)T_TOK * 2048 * 2));
  p.EIDX = (int*)(ws + carve(off2, (size_t)T_TOK * 128 * 4));
  p.EW = (float*)(ws + carve(off2, (size_t)T_TOK * 128 * 4));
  p.PDN8 = (unsigned char*)(ws + carve(off2, (size_t)16384 * 1024));
  p.PUP8 = (unsigned char*)(ws + carve(off2, (size_t)16384 * 1024));
  p.SDN = (float*)(ws + carve(off2, 16384 * 4));
  p.SUP = (float*)(ws + carve(off2, 16384 * 4));
  (void)ws_size; (void)in_sizes; (void)n_in; (void)out_size;

#ifdef MK_MULTI
#define LAUNCH1(PH) { hipFuncSetAttribute((const void*)k_single<PH>, hipFuncAttributeMaxDynamicSharedMemorySize, SMEM_BYTES); k_single<PH><<<256, NT, SMEM_BYTES, stream>>>(p); }
  LAUNCH1(0) LAUNCH1(1) LAUNCH1(2) LAUNCH1(3) LAUNCH1(4) LAUNCH1(5) LAUNCH1(6) LAUNCH1(7) LAUNCH1(8) LAUNCH1(9) LAUNCH1(10)
#else
  static int grid_blocks = 0;
  if (!grid_blocks) {
    int dev = 0, cus = 0, per_cu = 0;
    (void)hipGetDevice(&dev);
    (void)hipDeviceGetAttribute(&cus, hipDeviceAttributeMultiprocessorCount, dev);
    (void)hipFuncSetAttribute((const void*)k_mega, hipFuncAttributeMaxDynamicSharedMemorySize, SMEM_BYTES);
    (void)hipOccupancyMaxActiveBlocksPerMultiprocessor(&per_cu, k_mega, NT, SMEM_BYTES);
    if (per_cu < 1) per_cu = 1;
    if (per_cu > 1) per_cu = 1;
    grid_blocks = cus * per_cu;
  }
  (void)hipMemsetAsync(p.xbar, 0, XCD_BAR_WORDS * 4, stream);
  void* args[] = {&p};
  hipError_t e = hipLaunchCooperativeKernel((void*)k_mega, dim3(grid_blocks), dim3(NT), args, SMEM_BYTES, stream);
  if (e != hipSuccess) fprintf(stderr, "cooperative launch failed: %s (grid %d)\n", hipGetErrorString(e), grid_blocks);
#endif
}
```

```cpp
#include <hip/hip_runtime.h>
#include <hip/hip_bf16.h>
#include <hip/hip_cooperative_groups.h>
#include <stdint.h>
#include <stdio.h>
namespace cg = cooperative_groups;

typedef unsigned short bf16_t;
#define DI __device__ __forceinline__

DI int mytid() { int t = threadIdx.x; asm volatile("" : "+v"(t)); return t; }
DI void lds_barrier() { asm volatile("s_waitcnt lgkmcnt(0)\n\ts_barrier" ::: "memory"); }
DI float bf2f(bf16_t v) { return __uint_as_float(((unsigned)v) << 16); }
DI bf16_t f2bf(float x) { unsigned u = __float_as_uint(x); u += 0x7fffu + ((u >> 16) & 1u); return (bf16_t)(u >> 16); }
DI float gelu_tanh(float x) { float u = 0.7978845608028654f * (x + 0.044715f * x * x * x); return 0.5f * x * (1.f + tanhf(u)); }
DI float siluf(float x) { return x / (1.f + __expf(-x)); }
DI float gelu_fast(float x) {
  const float u2 = -2.302208198f * (x + 0.044715f * x * x * x);
  return x * __builtin_amdgcn_rcpf(1.f + __builtin_amdgcn_exp2f(u2));
}
DI float sigmoidf(float x) { return 1.f / (1.f + __expf(-x)); }

#define T_TOK 16384
#define SEQ 8192
#define DM 1024
#define NPROJ 3584
#define NEG_INF (-__builtin_inff())

struct Params {
  const float *x, *c, *w_ada, *b_ada, *g_mix, *w_in, *pe_k, *pe_v, *w_k1, *b_k1, *w_k2, *w_v1, *b_v1, *w_v2, *w_out, *g_ffn,
      *w_pq, *subkeys, *peer_down, *peer_up, *g_final;
  float* out;
  float* gout;
  float* mod;
  unsigned* ksmax;
  unsigned* xbar;
  long long* tprobe;
  float *c128, *s128, *c64, *s64;
  bf16_t *WinT, *WoutT, *WqT, *W1Tk, *W1Tv, *W2Tk, *W2Tv, *SUBK;
  float *B1Pk, *B1Pv;
  bf16_t* RA;
  bf16_t *RQ, *RK, *RKT, *RVT, *RGT, *NQ, *NKC, *NVC, *NKS, *NKW, *NVST, *NVWT;
  float* GATE;
  float* KV;
  bf16_t* SPREV;
  bf16_t *KC, *VCT;
  float* HID;
  bf16_t* PQ;
  int* EIDX;
  float* EW;
  unsigned char *PDN8, *PUP8;
  float *SDN, *SUP;
};

DI float logg_h(int h) { return log1pf(-exp2f(-5.f - (float)h)); }


typedef __bf16 bf16x2_t __attribute__((ext_vector_type(2)));
typedef float f32x2_t __attribute__((ext_vector_type(2)));
DI unsigned cvt2(float a, float b) { f32x2_t v = {a, b}; bf16x2_t r = __builtin_convertvector(v, bf16x2_t); return __builtin_bit_cast(unsigned, r); }
DI uint2 pack4(float a, float b, float c, float d) { uint2 r; r.x = cvt2(a, b); r.y = cvt2(c, d); return r; }
#define NT 512
#ifndef PROBE_BLK
#define PROBE_BLK 0
#endif
#ifndef PROBE_DUP
#define PROBE_DUP -1
#endif
typedef short bf16x8 __attribute__((ext_vector_type(8)));
typedef float f32x16 __attribute__((ext_vector_type(16)));
#define MFMA32(a, b, c) __builtin_amdgcn_mfma_f32_32x32x16_bf16((a), (b), (c), 0, 0, 0)
DI f32x16 zero16() { f32x16 z; for (int e = 0; e < 16; ++e) z[e] = 0.f; return z; }
DI f32x16 fill16(float v) { f32x16 z; for (int e = 0; e < 16; ++e) z[e] = v; return z; }
DI float ex2(float x) { return __builtin_amdgcn_exp2f(x); }

DI int win_logical_col(int np) {
  const int tile = np >> 8, p = np & 255, half = p >> 7, q = p & 127;
  if (tile < 4) { const int head = 2 * (tile & 1) + (q >> 6), i = q & 63; return (tile >> 1) * 512 + head * 128 + (half ? 64 + i : i); }
  if (tile < 8) return 1024 + (tile - 4) * 256 + p;
  if (tile < 10) { const int head = 4 * (tile - 8) + (q >> 5), i = q & 31; return 2048 + head * 64 + (half ? 32 + i : i); }
  if (tile == 10) { const int blk = q >> 5, i = q & 31; return (blk < 2 ? 2560 + blk * 64 : 2816 + (blk - 2) * 64) + (half ? 32 + i : i); }
  if (tile == 11) { const int blk = q >> 5, i = q & 31; return (blk < 2) ? 3072 + blk * 64 + (half ? 32 + i : i) : 2688 + (half ? 64 : 0) + 32 * (blk - 2) + i; }
  if (tile == 12) return (half ? 3200 : 2944) + q;
  if (tile == 13) return (half == 0 && q < 24) ? 3328 + q : -1;
  return -1;
}

DI float rope_inv(int i, int d) { return exp2f(-(float)(2 * i) / (float)d * 13.287712379549449f); }
DI void rope_sincos(float x, float& sn, float& cs) {
  const float k = rintf(x * 0.15915494309189535f);
  float r = fmaf(-k, 6.28125f, x);
  r = fmaf(-k, 1.9353071795864769e-3f, r);
  const float rev = r * 0.15915494309189535f;
  sn = __builtin_amdgcn_sinf(rev); cs = __builtin_amdgcn_cosf(rev);
}
DI void tr_tile(const float* __restrict__ in, bf16_t* __restrict__ out, int K, int N_in, int k0, int n0, int mode, float* tile) {
  const int tid = mytid();
  {
    int nn = tid & 63, col = (mode == 1) ? win_logical_col(n0 + nn) : (n0 + nn);
#pragma unroll
    for (int i = 0; i < 8; ++i) {
      int kk = (tid >> 6) + 8 * i;
      tile[kk * 65 + nn] = (col >= 0) ? in[(size_t)(k0 + kk) * N_in + col] : 0.f;
    }
  }
  __syncthreads();
  {
    int kk = tid & 63;
#pragma unroll
    for (int i = 0; i < 8; ++i) {
      int nn = (tid >> 6) + 8 * i;
      const int n = n0 + nn, k = k0 + kk;
      const size_t o = (mode == 2) ? ((size_t)(((n >> 5) * (K >> 4) + (k >> 4)) * 64 + ((k >> 3) & 1) * 32 + (n & 31))) * 8 + (k & 7) : (size_t)n * K + k;
      out[o] = f2bf(tile[kk * 65 + nn]);
    }
  }
  __syncthreads();
}

#define PH0_MOD 96
#define PH0_WIN (PH0_MOD + 16 * 56)
#define PH0_WOUT (PH0_WIN + 256)
#define PH0_WQ (PH0_WOUT + 512)
#define PH0_W1K (PH0_WQ + 128)
#define PH0_W1V (PH0_W1K + 128)
#define PH0_W2K (PH0_W1V + 4)
#define PH0_W2V (PH0_W2K + 4)
#define PH0_SUBK (PH0_W2V + 512)
#define PH0_ROPE (PH0_SUBK + 1024)
#define PH0_B1P (PH0_ROPE + 8)
#define PH0_NVB PH0_B1P

DI void ph0_body(const Params& p, int vb, char* smem) {
  const int tid = mytid();
  float* fs = (float*)smem;
  if (vb < PH0_MOD) {
    int kg = tid >> 6, col = vb * 64 + (tid & 63);
    float a0 = 0.f, a1 = 0.f;
#pragma unroll 8
    for (int k = kg * 128; k < kg * 128 + 128; ++k) {
      float w = p.w_ada[(size_t)k * 6144 + col];
      a0 += siluf(p.c[k]) * w; a1 += siluf(p.c[DM + k]) * w;
    }
    fs[kg * 64 + (tid & 63)] = a0; fs[512 + kg * 64 + (tid & 63)] = a1;
    __syncthreads();
    if (tid < 128) {
      int b = tid >> 6, cc = tid & 63; float s = 0.f;
      for (int g = 0; g < 8; ++g) s += fs[b * 512 + g * 64 + cc];
      p.mod[b * 6144 + vb * 64 + cc] = s + p.b_ada[vb * 64 + cc];
    }
    __syncthreads();
    if (vb == 0 && tid < 12) p.ksmax[tid] = 0u;
  } else if (vb < PH0_WIN) { int t = vb - PH0_MOD; tr_tile(p.w_in, p.WinT, 1024, 3352, (t & 15) * 64, (t >> 4) * 64, 1, fs); }
  else if (vb < PH0_WOUT) { int t = vb - PH0_WIN; tr_tile(p.w_out, p.WoutT, 1024, 1024, (t & 15) * 64, (t >> 4) * 64, 0, fs); }
  else if (vb < PH0_WQ) { int t = vb - PH0_WOUT; tr_tile(p.w_pq, p.WqT, 1024, 2048, (t & 15) * 64, (t >> 4) * 64, 0, fs); }
  else if (vb < PH0_W1K) { int t = vb - PH0_WQ; tr_tile(p.w_k1, p.W1Tk, 2048, 256, (t & 31) * 64, (t >> 5) * 64, 2, fs); }
  else if (vb < PH0_W1V) { int t = vb - PH0_W1K; tr_tile(p.w_v1, p.W1Tv, 2048, 256, (t & 31) * 64, (t >> 5) * 64, 2, fs); }
  else if (vb < PH0_W2K) { int t = vb - PH0_W1V; tr_tile(p.w_k2, p.W2Tk, 256, 64, t * 64, 0, 0, fs); }
  else if (vb < PH0_W2V) { int t = vb - PH0_W2K; tr_tile(p.w_v2, p.W2Tv, 256, 64, t * 64, 0, 0, fs); }
  else if (vb < PH0_SUBK) {
    const int d = (vb - PH0_W2V) * NT + tid;
    const int e = d & 7, ln = (d >> 3) & 63, s4 = (d >> 9) & 3, j = (d >> 11) & 7, ph = d >> 14;
    p.SUBK[d] = f2bf(p.subkeys[((size_t)(ph * 128 + 16 * j + (ln & 15))) * 128 + 32 * s4 + 8 * (ln >> 4) + e]);
  }
  else if (vb < PH0_ROPE) {
    int idx = (vb - PH0_SUBK) * NT + tid;
    { int s = idx >> 6, i = idx & 63; float sn, cs; rope_sincos((float)s * rope_inv(i, 128), sn, cs); p.c128[idx] = cs; p.s128[idx] = sn; }
    if (idx < SEQ * 32) { int s = idx >> 5, i = idx & 31; float sn, cs; rope_sincos((float)s * rope_inv(i, 64), sn, cs); p.c64[idx] = cs; p.s64[idx] = sn; }
  } else {
    int t = vb - PH0_ROPE, kv = t >> 2, jb = t & 3;
    const float* w1 = kv ? p.w_v1 : p.w_k1; const float* pe = kv ? p.pe_v : p.pe_k; const float* b1 = kv ? p.b_v1 : p.b_k1;
    int fg = tid >> 6, j = jb * 64 + (tid & 63);
    float a = 0.f;
    for (int f0 = fg * 256; f0 < fg * 256 + 256; f0 += 32) {
      float wv[32], pv[32];
#pragma unroll
      for (int u = 0; u < 32; ++u) { wv[u] = w1[(size_t)(f0 + u) * 256 + j]; pv[u] = pe[f0 + u]; }
#pragma unroll
      for (int u = 0; u < 32; ++u) a += pv[u] * wv[u];
    }
    fs[fg * 64 + (tid & 63)] = a;
    __syncthreads();
    if (tid < 64) { float s = b1[j]; for (int g = 0; g < 8; ++g) s += fs[g * 64 + tid]; (kv ? p.B1Pv : p.B1Pk)[j] = s; }
    __syncthreads();
  }
}

DI void rownorm_body(const float* __restrict__ src, const float* __restrict__ g, const float* __restrict__ mod, int sh_off, int sc_off, bf16_t* __restrict__ dst, int vb) {
  int row = vb * 8 + (mytid() >> 6), lane = mytid() & 63;
  int b = row >> 13;
  const float* xr = src + (size_t)row * DM;
  float v[16]; float ss = 0.f;
#pragma unroll
  for (int i = 0; i < 4; ++i) {
    float4 t = *(const float4*)(xr + i * 256 + lane * 4);
    v[i * 4 + 0] = t.x; v[i * 4 + 1] = t.y; v[i * 4 + 2] = t.z; v[i * 4 + 3] = t.w;
    ss += t.x * t.x + t.y * t.y + t.z * t.z + t.w * t.w;
  }
  for (int o = 32; o; o >>= 1) ss += __shfl_xor(ss, o);
  float rstd = rsqrtf(ss * (1.f / DM) + 1e-6f);
  const float* sh = mod + b * 6144 + sh_off; const float* sc = mod + b * 6144 + sc_off;
#pragma unroll
  for (int i = 0; i < 4; ++i) {
    int col = i * 256 + lane * 4;
    float4 gg = *(const float4*)(g + col), s4 = *(const float4*)(sc + col), h4 = *(const float4*)(sh + col);
    float y0 = v[i * 4 + 0] * rstd * gg.x * (1.f + s4.x) + h4.x;
    float y1 = v[i * 4 + 1] * rstd * gg.y * (1.f + s4.y) + h4.y;
    float y2 = v[i * 4 + 2] * rstd * gg.z * (1.f + s4.z) + h4.z;
    float y3 = v[i * 4 + 3] * rstd * gg.w * (1.f + s4.w) + h4.w;
    *(uint2*)(dst + (size_t)row * DM + col) = pack4(y0, y1, y2, y3);
  }
}

#define G_A_BYTES (256 * 144)
#define G_B_BYTES (256 * 144)
#define G_BUF_BYTES (G_A_BYTES + G_B_BYTES)
template <class Epi>
DI void gemm_tile(const bf16_t* __restrict__ A, const bf16_t* __restrict__ Bt, int K, int m0, int n0, char* smem, const Epi& epi) {
  const int tid = mytid(), lane = tid & 63, w = tid >> 6, wm = w >> 2, wn = w & 3, r = lane & 31, h = lane >> 5;
  f32x16 acc[4][2];
#pragma unroll
  for (int i = 0; i < 4; ++i)
#pragma unroll
    for (int j = 0; j < 2; ++j) acc[i][j] = zero16();
  const int crow = tid >> 3, ckc = tid & 7;
  const bf16_t* ag = A + (size_t)(m0 + crow) * K + ckc * 8;
  const bf16_t* bg = Bt + (size_t)(n0 + crow) * K + ckc * 8;
  uint4 ra[4], rb[4];
#pragma unroll
  for (int i = 0; i < 4; ++i) { ra[i] = *(const uint4*)(ag + (size_t)i * 64 * K); rb[i] = *(const uint4*)(bg + (size_t)i * 64 * K); }
  char* lw = smem + crow * 144 + ckc * 16;
#pragma unroll
  for (int i = 0; i < 4; ++i) { *(uint4*)(lw + i * 64 * 144) = ra[i]; *(uint4*)(lw + G_A_BYTES + i * 64 * 144) = rb[i]; }
  __syncthreads();
  const int nk = K >> 6;
  for (int kt = 0; kt < nk; ++kt) {
    const int cur = kt & 1;
    if (kt + 1 < nk) {
      const int k0 = (kt + 1) * 64;
#pragma unroll
      for (int i = 0; i < 4; ++i) { ra[i] = *(const uint4*)(ag + (size_t)i * 64 * K + k0); rb[i] = *(const uint4*)(bg + (size_t)i * 64 * K + k0); }
    }
    const char* la = smem + cur * G_BUF_BYTES + (wm * 128 + r) * 144 + h * 16;
    const char* lb = smem + cur * G_BUF_BYTES + G_A_BYTES + (wn * 64 + r) * 144 + h * 16;
#pragma unroll
    for (int kk = 0; kk < 4; ++kk) {
      bf16x8 b0 = *(const bf16x8*)(lb + kk * 32), b1 = *(const bf16x8*)(lb + 32 * 144 + kk * 32);
#pragma unroll
      for (int i = 0; i < 4; ++i) {
        bf16x8 a = *(const bf16x8*)(la + i * 32 * 144 + kk * 32);
        acc[i][0] = MFMA32(a, b0, acc[i][0]); acc[i][1] = MFMA32(a, b1, acc[i][1]);
      }
    }
    if (kt + 1 < nk) {
      char* lw2 = lw + (cur ^ 1) * G_BUF_BYTES;
#pragma unroll
      for (int i = 0; i < 4; ++i) { *(uint4*)(lw2 + i * 64 * 144) = ra[i]; *(uint4*)(lw2 + G_A_BYTES + i * 64 * 144) = rb[i]; }
    }
    __syncthreads();
  }
  const int G = (n0 >> 6) + wn;
#pragma unroll
  for (int i = 0; i < 4; ++i) {
    float pre[4][8];
#pragma unroll
    for (int g = 0; g < 4; ++g) epi.prefetch(m0 + wm * 128 + i * 32 + 8 * g + 4 * h, G, r, pre[g]);
#pragma unroll
    for (int g = 0; g < 4; ++g) {
      float lo[4], hi[4];
#pragma unroll
      for (int e = 0; e < 4; ++e) { lo[e] = acc[i][0][4 * g + e]; hi[e] = acc[i][1][4 * g + e]; }
      epi(m0 + wm * 128 + i * 32 + 8 * g + 4 * h, G, r, lo, hi, pre[g]);
    }
  }
}

struct EpiProj {
  static constexpr bool kProbe = true;
  const Params& p;
  DI void prefetch(int t0, int G, int c, float (&pre)[8]) const {
    const int s0 = t0 & 8191;
    const bool r128 = G < 16, r64 = (G >= 32 && G < 40) || (G >= 40 && G < 52 && (((G - 40) >> 1) & 1) == 0);
    if (r128) {
      const int i = 32 * (G & 1) + c;
#pragma unroll
      for (int e = 0; e < 4; ++e) { pre[e] = p.c128[(s0 + e) * 64 + i]; pre[4 + e] = p.s128[(s0 + e) * 64 + i]; }
    } else if (r64) {
#pragma unroll
      for (int e = 0; e < 4; ++e) { pre[e] = p.c64[(s0 + e) * 32 + c]; pre[4 + e] = p.s64[(s0 + e) * 32 + c]; }
    } else {
#pragma unroll
      for (int e = 0; e < 8; ++e) pre[e] = 0.f;
    }
  }
  DI void operator()(int t0, int G, int c, const float (&lo)[4], const float (&hi)[4], const float (&pre)[8]) const {
    const int b = t0 >> 13, s0 = t0 & 8191;
    if (G < 16) {
      const int sec = G >> 3, hh = (G & 7) >> 1, j = G & 1, i = 32 * j + c;
      float o1[4], o2[4];
#pragma unroll
      for (int e = 0; e < 4; ++e) {
        float cs = pre[e], sn = pre[4 + e];
        o1[e] = lo[e] * cs - hi[e] * sn; o2[e] = hi[e] * cs + lo[e] * sn;
      }
      if (sec == 0) {
#pragma unroll
        for (int e = 0; e < 4; ++e) {
          p.RQ[(size_t)(t0 + e) * 512 + hh * 128 + i] = f2bf(o1[e]);
          p.RQ[(size_t)(t0 + e) * 512 + hh * 128 + 64 + i] = f2bf(o2[e]);
        }
      } else {
        const float sc = 0.08838834764831845f;
        const float lg = logg_h(hh);
#pragma unroll
        for (int e = 0; e < 4; ++e) {
          o1[e] *= sc; o2[e] *= sc;
          p.RK[(size_t)(t0 + e) * 512 + hh * 128 + i] = f2bf(o1[e]);
          p.RK[(size_t)(t0 + e) * 512 + hh * 128 + 64 + i] = f2bf(o2[e]);
          float zeta = __expf((float)(127 - ((s0 + e) & 127)) * lg);
          o1[e] *= zeta; o2[e] *= zeta;
        }
        *(uint2*)(p.RKT + ((size_t)(b * 4 + hh) * 128 + i) * SEQ + s0) = pack4(o1[0], o1[1], o1[2], o1[3]);
        *(uint2*)(p.RKT + ((size_t)(b * 4 + hh) * 128 + 64 + i) * SEQ + s0) = pack4(o2[0], o2[1], o2[2], o2[3]);
      }
    } else if (G < 24) {
      const int hh = (G - 16) >> 1, d = ((G - 16) & 1) * 64 + c;
      *(uint2*)(p.RVT + ((size_t)(b * 4 + hh) * 128 + d) * SEQ + s0) = pack4(lo[0], lo[1], lo[2], lo[3]);
      *(uint2*)(p.RVT + ((size_t)(b * 4 + hh) * 128 + d + 32) * SEQ + s0) = pack4(hi[0], hi[1], hi[2], hi[3]);
    } else if (G < 32) {
      const int hh = (G - 24) >> 1, d = ((G - 24) & 1) * 64 + c;
#pragma unroll
      for (int e = 0; e < 4; ++e) {
        p.RGT[(size_t)(t0 + e) * 512 + hh * 128 + d] = f2bf(siluf(lo[e]));
        p.RGT[(size_t)(t0 + e) * 512 + hh * 128 + d + 32] = f2bf(siluf(hi[e]));
      }
    } else if (G < 40) {
      const int head = G - 32;
#pragma unroll
      for (int e = 0; e < 4; ++e) {
        float cs = pre[e], sn = pre[4 + e];
        const float qs = 0.125f * 1.4426950408889634f;
        float o1 = (lo[e] * cs - hi[e] * sn) * qs, o2 = (hi[e] * cs + lo[e] * sn) * qs;
        p.NQ[(size_t)(t0 + e) * 512 + head * 64 + c] = f2bf(o1);
        p.NQ[(size_t)(t0 + e) * 512 + head * 64 + 32 + c] = f2bf(o2);
      }
    } else if (G < 52) {
      const int k = G - 40, kind = k >> 1, gg = k & 1;
      float o1[4], o2[4];
#pragma unroll
      for (int e = 0; e < 4; ++e) {
        o1[e] = lo[e]; o2[e] = hi[e];
        if ((kind & 1) == 0) {
          float cs = pre[e], sn = pre[4 + e];
          o1[e] = lo[e] * cs - hi[e] * sn; o2[e] = hi[e] * cs + lo[e] * sn;
        }
      }
      if (kind == 3 || kind == 5) {
        bf16_t* dst = (kind == 3 ? p.NVST : p.NVWT) + ((size_t)(b * 2 + gg) * 64 + c) * SEQ + s0;
        *(uint2*)dst = pack4(o1[0], o1[1], o1[2], o1[3]);
        *(uint2*)(dst + (size_t)32 * SEQ) = pack4(o2[0], o2[1], o2[2], o2[3]);
      } else {
        bf16_t* dst = (kind == 0 ? p.NKC : kind == 1 ? p.NVC : kind == 2 ? p.NKS : p.NKW);
#pragma unroll
        for (int e = 0; e < 4; ++e) {
          dst[(size_t)(t0 + e) * 128 + gg * 64 + c] = f2bf(o1[e]);
          dst[(size_t)(t0 + e) * 128 + gg * 64 + 32 + c] = f2bf(o2[e]);
        }
      }
    } else if (G == 52) {
      if (c < 24) {
#pragma unroll
        for (int e = 0; e < 4; ++e) p.GATE[(size_t)(t0 + e) * 24 + c] = sigmoidf(lo[e]);
      }
    }
  }
};
struct EpiOut {
  static constexpr bool kProbe = false;
  const Params& p;
  DI void prefetch(int t0, int G, int c, float (&pre)[8]) const {
    const int c0 = G * 64 + c;
#pragma unroll
    for (int e = 0; e < 4; ++e) { pre[e] = p.x[(size_t)(t0 + e) * DM + c0]; pre[4 + e] = p.x[(size_t)(t0 + e) * DM + c0 + 32]; }
  }
  DI void operator()(int t0, int G, int c, const float (&lo)[4], const float (&hi)[4], const float (&pre)[8]) const {
    const int b = t0 >> 13;
    const int c0 = G * 64 + c, c1 = c0 + 32;
    const float* ga1 = p.mod + b * 6144 + 2048;
    const float g0 = ga1[c0], g1 = ga1[c1];
#pragma unroll
    for (int e = 0; e < 4; ++e) {
      p.out[(size_t)(t0 + e) * DM + c0] = pre[e] + g0 * lo[e];
      p.out[(size_t)(t0 + e) * DM + c1] = pre[4 + e] + g1 * hi[e];
    }
  }
};
struct EpiPQ {
  static constexpr bool kProbe = false;
  const Params& p;
  DI void prefetch(int, int, int, float (&)[8]) const {}
  DI void operator()(int t0, int G, int c, const float (&lo)[4], const float (&hi)[4], const float (&)[8]) const {
#pragma unroll
    for (int e = 0; e < 4; ++e) {
      p.PQ[(size_t)(t0 + e) * 2048 + G * 64 + c] = f2bf(lo[e]);
      p.PQ[(size_t)(t0 + e) * 2048 + G * 64 + 32 + c] = f2bf(hi[e]);
    }
  }
};


namespace pg8 {
#define PG8_LAS __attribute__((address_space(3)))
typedef float f32x4 __attribute__((ext_vector_type(4)));
constexpr int BM = 256, BK = 64, HALF = 128, HTB = HALF * BK * 2, STAGE_BYTES = 8 * HTB, NXCD = 8, WGM = 8;
DI int lds_byte(int r, int c) { const int st = (r >> 4) * 2 + (c >> 5), rr = r & 15, cc = c & 31, ob = rr * 64 + cc * 2; return st * 1024 + (ob ^ (((ob >> 9) & 1) << 5)); }
DI void stage_rc(int b, int& R, int& C) { const int st = b / 1024, sb = b % 1024, swz = sb ^ (((sb >> 9) & 1) << 5); R = (st >> 1) * 16 + swz / 64; C = (st & 1) * 32 + (swz % 64) / 2; }
DI int perm32(int rho) { const int n = rho >> 4, i = rho & 15; return 8 * (i >> 2) + 4 * n + (i & 3); }
struct Unit { int pm, pn; };
struct Gemm { const bf16_t* A; const bf16_t* Bt; int M, N, K; };
struct StaticOrder {
  int nM, nN, nwg, G, c;
  DI void init(int M, int N, int G_, int c_) { nM = M / BM; nN = N / BM; nwg = nM * nN; G = G_; c = c_; }
  DI bool next(int i, Unit& u) const {
    const long L = (long)i * G + c; if (L >= nwg) return false;
    int wgid = (int)L; { const int q = nwg / NXCD, r = nwg % NXCD, xcd = wgid % NXCD, off = wgid / NXCD; wgid = (xcd < r ? xcd * (q + 1) : r * (q + 1) + (xcd - r) * q) + off; }
    const int nig = WGM * nN, gid = wgid / nig, fm = gid * WGM, gsz = (nM - fm) < WGM ? (nM - fm) : WGM;
    u.pm = fm + ((wgid % nig) % gsz); u.pn = (wgid % nig) / gsz; return true;
  }
  DI void a_ready(const Unit&) const {}
  DI void done(const Unit&) const {}
};
template <class Epi, class Sched>
__device__ __forceinline__ void gemm_phase(PG8_LAS unsigned char* lds, const Gemm g, const Sched& S, const Epi& E) {
    const int tid = mytid(), wid = __builtin_amdgcn_readfirstlane(tid >> 6), lane = tid & 63, wr = wid >> 2, wc = wid & 3, fr = lane & 15, fq = lane >> 4;
    const int K = g.K, nt = K / BK;
    unsigned voffA[2], voffB[2];
#pragma unroll
    for (int i = 0; i < 2; ++i) { int R, C; stage_rc(tid * 16 + i * 8192, R, C); const int Rb = Epi::PERM ? ((R & ~31) + perm32(R & 31)) : R;
        voffA[i] = (unsigned)(R * K + C) * 2u; voffB[i] = (unsigned)(Rb * K + C) * 2u; }
    const size_t kstep = (size_t)(BK * 2);
    const size_t hstep = (size_t)HALF * K * 2;
    const size_t tstep = 2 * hstep;
    const unsigned ldsw = (unsigned)wid * 1024u;
    const int aoff = lds_byte(wr * 64 + fr, fq * 8), boff = lds_byte(wc * 32 + fr, fq * 8);
#define PG8_SA(b, h) (((b) * 2 + (h)) * HTB)
#define PG8_SB(b, h) ((4 + (b) * 2 + (h)) * HTB)
#define PG8_STAGE(bufoff, gbase, voff) do { _Pragma("unroll") for (int _i = 0; _i < 2; ++_i) \
        __builtin_amdgcn_global_load_lds((const unsigned*)((const char*)(gbase) + (voff)[_i]), (PG8_LAS unsigned*)(lds + (bufoff) + ldsw + _i * 8192), 16, 0, 0); } while (0)
#define PG8_LDA(dst, b, h) do { _Pragma("unroll") for (int m = 0; m < 4; ++m) _Pragma("unroll") for (int k = 0; k < 2; ++k) dst[m][k] = *(const PG8_LAS bf16x8*)(lds + PG8_SA(b, h) + aoff + m * 2048 + k * 1024); } while (0)
#define PG8_LDB(dst, b, h) do { _Pragma("unroll") for (int n = 0; n < 2; ++n) _Pragma("unroll") for (int k = 0; k < 2; ++k) dst[n][k] = *(const PG8_LAS bf16x8*)(lds + PG8_SB(b, h) + boff + n * 2048 + k * 1024); } while (0)
#define PG8_MMA(ai, bj, At, Bt) do { __builtin_amdgcn_s_setprio(1); _Pragma("unroll") for (int m = 0; m < 4; ++m) _Pragma("unroll") for (int n = 0; n < 2; ++n) _Pragma("unroll") for (int k = 0; k < 2; ++k) \
        acc[ai][bj][m][n] = __builtin_amdgcn_mfma_f32_16x16x32_bf16(Bt[n][k], At[m][k], acc[ai][bj][m][n], 0, 0, 0); __builtin_amdgcn_s_setprio(0); } while (0)
#define PG8_WAIT_V(n) asm volatile("s_waitcnt vmcnt(" #n ")" ::: "memory")
#define PG8_WAIT_L(n) asm volatile("s_waitcnt lgkmcnt(" #n ")" ::: "memory")
#define PG8_BAR __builtin_amdgcn_s_barrier()
#define PG8_SCHED __builtin_amdgcn_sched_barrier(0)
    Unit cur, nxt; int ui = 0;
    if (!S.next(0, cur)) return;
    f32x4 acc[2][2][4][2];
#pragma unroll
    for (int a = 0; a < 2; ++a)
#pragma unroll
        for (int b = 0; b < 2; ++b)
#pragma unroll
            for (int m = 0; m < 4; ++m)
#pragma unroll
                for (int n = 0; n < 2; ++n) acc[a][b][m][n] = (f32x4){0.f, 0.f, 0.f, 0.f};
    bf16x8 At[4][2], B0[2][2], B1[2][2];
    const char* cA = (const char*)g.A + (size_t)cur.pm * tstep; const char* cB = (const char*)g.Bt + (size_t)cur.pn * tstep;
    S.a_ready(cur);
    PG8_STAGE(PG8_SB(0, 0), cB, voffB); PG8_STAGE(PG8_SA(0, 0), cA, voffA); PG8_STAGE(PG8_SB(0, 1), cB + hstep, voffB); PG8_STAGE(PG8_SA(0, 1), cA + hstep, voffA);
    if (wr == 1) PG8_BAR;
    PG8_WAIT_V(4); PG8_BAR;
    PG8_STAGE(PG8_SB(1, 0), cB + kstep, voffB); PG8_STAGE(PG8_SA(1, 0), cA + kstep, voffA); PG8_STAGE(PG8_SB(1, 1), cB + hstep + kstep, voffB);
    PG8_WAIT_V(6); PG8_BAR;
    for (;;) {
        const bool has_next = S.next(ui + 1, nxt);
        const char* nA = has_next ? (const char*)g.A + (size_t)nxt.pm * tstep : cA; const char* nB = has_next ? (const char*)g.Bt + (size_t)nxt.pn * tstep : cB;
        for (int t = 0; t < nt; t += 2) {
            const bool last = (t == nt - 2);
            const char* a1 = cA + (size_t)(t + 1) * kstep;
            const char* a2 = last ? nA : cA + (size_t)(t + 2) * kstep; const char* b2 = last ? nB : cB + (size_t)(t + 2) * kstep;
            const char* a3 = a2 + kstep; const char* b3 = b2 + kstep;
            if (last && has_next) S.a_ready(nxt);
            PG8_LDB(B0, 0, 0); PG8_SCHED; PG8_LDA(At, 0, 0); PG8_STAGE(PG8_SA(1, 1), a1 + hstep, voffA);
            PG8_WAIT_L(8); PG8_BAR; PG8_WAIT_L(0); PG8_MMA(0, 0, At, B0); PG8_BAR; PG8_SCHED;
            PG8_LDB(B1, 0, 1); PG8_STAGE(PG8_SB(0, 0), b2, voffB);
            PG8_BAR; PG8_WAIT_L(0); PG8_MMA(0, 1, At, B1); PG8_BAR;
            PG8_LDA(At, 0, 1); PG8_STAGE(PG8_SA(0, 0), a2, voffA);
            PG8_BAR; PG8_WAIT_L(0); PG8_MMA(1, 0, At, B0); PG8_BAR; PG8_SCHED;
            PG8_STAGE(PG8_SB(0, 1), b2 + hstep, voffB);
            PG8_WAIT_V(6); PG8_BAR; PG8_MMA(1, 1, At, B1); PG8_BAR;
            PG8_LDB(B0, 1, 0); PG8_SCHED; PG8_LDA(At, 1, 0); PG8_STAGE(PG8_SA(0, 1), a2 + hstep, voffA);
            PG8_WAIT_L(8); PG8_BAR; PG8_WAIT_L(0); PG8_MMA(0, 0, At, B0); PG8_BAR; PG8_SCHED;
            PG8_LDB(B1, 1, 1); PG8_STAGE(PG8_SB(1, 0), b3, voffB);
            PG8_BAR; PG8_WAIT_L(0); PG8_MMA(0, 1, At, B1); PG8_BAR;
            PG8_LDA(At, 1, 1); PG8_STAGE(PG8_SA(1, 0), a3, voffA);
            PG8_BAR; PG8_WAIT_L(0); PG8_MMA(1, 0, At, B0); PG8_BAR; PG8_SCHED;
            PG8_STAGE(PG8_SB(1, 1), b3 + hstep, voffB);
            PG8_WAIT_V(6); PG8_BAR; PG8_MMA(1, 1, At, B1); PG8_BAR;
        }
        if constexpr (!Epi::AFTER_DRAIN) { E(acc, cur, wr, wc, fr, fq); S.done(cur); }
        if (!has_next) break;
#pragma unroll
        for (int a = 0; a < 2; ++a)
#pragma unroll
            for (int b = 0; b < 2; ++b)
#pragma unroll
                for (int m = 0; m < 4; ++m)
#pragma unroll
                    for (int n = 0; n < 2; ++n) acc[a][b][m][n] = (f32x4){0.f, 0.f, 0.f, 0.f};
        cur = nxt; cA = nA; cB = nB; ++ui;
    }
    PG8_WAIT_V(0);
    if (wr == 0) PG8_BAR;
    PG8_BAR;
    if constexpr (Epi::AFTER_DRAIN) { E.fused(acc, cur, wr, wc, fr, fq, lds, wid, lane); S.done(cur); }
#undef PG8_SA
#undef PG8_SB
#undef PG8_STAGE
#undef PG8_LDA
#undef PG8_LDB
#undef PG8_MMA
#undef PG8_WAIT_V
#undef PG8_WAIT_L
#undef PG8_BAR
#undef PG8_SCHED
}
}

template <int CTRL> DI float dpp_q(float x) { return __builtin_bit_cast(float, __builtin_amdgcn_mov_dpp(__builtin_bit_cast(int, x), CTRL, 0xf, 0xf, true)); }
DI void tstore4(bf16_t* dst, float v0, float v1, float v2, float v3, int q) {
  const bool o1_ = q & 1, o2_ = q & 2;
  const float sa = o1_ ? v0 : v1, sb = o1_ ? v2 : v3;
  const float ra = dpp_q<0xB1>(sa), rb = dpp_q<0xB1>(sb);
  const float w0 = o1_ ? ra : v0, w1 = o1_ ? v1 : ra, w2 = o1_ ? rb : v2, w3 = o1_ ? v3 : rb;
  const float sc = o2_ ? w0 : w2, sd = o2_ ? w1 : w3;
  const float rc = dpp_q<0x4E>(sc), rd = dpp_q<0x4E>(sd);
  const float x0 = o2_ ? rc : w0, x1 = o2_ ? rd : w1, x2 = o2_ ? w2 : rc, x3 = o2_ ? w3 : rd;
  *(uint2*)(dst + (size_t)q * SEQ - q) = pack4(x0, x1, x2, x3);
}
DI uint4 pack8u(const float (&a)[4], const float (&b)[4]) { uint4 v; v.x = cvt2(a[0], a[1]); v.y = cvt2(a[2], a[3]); v.z = cvt2(b[0], b[1]); v.w = cvt2(b[2], b[3]); return v; }
struct EpiProj8 {
  static constexpr bool PERM = true, AFTER_DRAIN = false;
  const Params& p;
  DI void operator()(const pg8::f32x4 (&acc)[2][2][4][2], const pg8::Unit& u, int wr, int wc, int fr, int fq) const {
    const long long te0_ = (PROBE_DUP == 235) ? (long long)wall_clock64() : 0;
    body(acc, u, wr, wc, fr, fq);
    if (PROBE_DUP == 235 && blockIdx.x == 0 && threadIdx.x == 0) *p.tprobe += (long long)wall_clock64() - te0_;
  }
  DI void body(const pg8::f32x4 (&acc)[2][2][4][2], const pg8::Unit& u, int wr, int wc, int fr, int fq) const {
    const int pn = u.pn, q4 = fr & 3;
    const bool rot128 = pn < 4, rot64 = (pn >= 8 && pn < 10) || pn == 10 || (pn == 11 && wc < 2), rot = rot128 || rot64;
    const int t00 = u.pm * 256 + wr * 64 + fr, s00 = t00 & 8191;
    const int cb0 = 8 * fq;
    const float* ct = rot128 ? p.c128 : p.c64; const float* st = rot128 ? p.s128 : p.s64;
    const int nrot = rot128 ? 64 : 32, ridx = (rot128 ? 32 * (wc & 1) : 0) + cb0;
    float cd_[2][4], sd_[2][4];
    if (rot) {
#pragma unroll
      for (int n = 0; n < 2; ++n) {
        const float4 c16 = *(const float4*)(ct + (size_t)16 * nrot + ridx + 4 * n), s16 = *(const float4*)(st + (size_t)16 * nrot + ridx + 4 * n);
        cd_[n][0] = c16.x; cd_[n][1] = c16.y; cd_[n][2] = c16.z; cd_[n][3] = c16.w; sd_[n][0] = s16.x; sd_[n][1] = s16.y; sd_[n][2] = s16.z; sd_[n][3] = s16.w;
      }
    }
#pragma unroll
    for (int ai = 0; ai < 2; ++ai) {
      float c_[2][4], s_[2][4];
      if (rot) {
#pragma unroll
        for (int n = 0; n < 2; ++n) {
          const float4 c4 = *(const float4*)(ct + (size_t)(s00 + 128 * ai) * nrot + ridx + 4 * n), s4 = *(const float4*)(st + (size_t)(s00 + 128 * ai) * nrot + ridx + 4 * n);
          c_[n][0] = c4.x; c_[n][1] = c4.y; c_[n][2] = c4.z; c_[n][3] = c4.w; s_[n][0] = s4.x; s_[n][1] = s4.y; s_[n][2] = s4.z; s_[n][3] = s4.w;
        }
      }
#pragma unroll
      for (int m = 0; m < 4; ++m) {
        const int t = t00 + ai * 128 + m * 16, b = t >> 13, s = t & 8191;
        float lo[2][4], hi[2][4];
#pragma unroll
        for (int n = 0; n < 2; ++n) {
          const pg8::f32x4 L = acc[ai][0][m][n], H = acc[ai][1][m][n];
#pragma unroll
          for (int i = 0; i < 4; ++i) {
            if (rot) {
              const float c = c_[n][i], sn = s_[n][i];
              lo[n][i] = L[i] * c - H[i] * sn; hi[n][i] = H[i] * c + L[i] * sn;
              c_[n][i] = c * cd_[n][i] - sn * sd_[n][i]; s_[n][i] = sn * cd_[n][i] + c * sd_[n][i];
            } else { lo[n][i] = L[i]; hi[n][i] = H[i]; }
          }
        }
        if (pn < 4) {
          const int hh = 2 * (pn & 1) + (wc >> 1), idx = 32 * (wc & 1) + cb0;
          if (pn < 2) {
            *(uint4*)(p.RQ + (size_t)t * 512 + hh * 128 + idx) = pack8u(lo[0], lo[1]);
            *(uint4*)(p.RQ + (size_t)t * 512 + hh * 128 + 64 + idx) = pack8u(hi[0], hi[1]);
          } else {
            const float sc = 0.08838834764831845f;
#pragma unroll
            for (int n = 0; n < 2; ++n)
#pragma unroll
              for (int i = 0; i < 4; ++i) { lo[n][i] *= sc; hi[n][i] *= sc; }
            *(uint4*)(p.RK + (size_t)t * 512 + hh * 128 + idx) = pack8u(lo[0], lo[1]);
            *(uint4*)(p.RK + (size_t)t * 512 + hh * 128 + 64 + idx) = pack8u(hi[0], hi[1]);
            const float zeta = __expf((float)(127 - (s & 127)) * logg_h(hh));
            bf16_t* kt = p.RKT + ((size_t)(b * 4 + hh) * 128 + idx) * SEQ + s;
#pragma unroll
            for (int n = 0; n < 2; ++n) {
              tstore4(kt + (size_t)(4 * n) * SEQ, lo[n][0] * zeta, lo[n][1] * zeta, lo[n][2] * zeta, lo[n][3] * zeta, q4);
              tstore4(kt + (size_t)(64 + 4 * n) * SEQ, hi[n][0] * zeta, hi[n][1] * zeta, hi[n][2] * zeta, hi[n][3] * zeta, q4);
            }
          }
        } else if (pn < 6) {
          bf16_t* v0 = p.RVT + ((size_t)(b * 4 + 2 * (pn - 4)) * 128 + 32 * wc + cb0) * SEQ + s;
#pragma unroll
          for (int n = 0; n < 2; ++n) {
            tstore4(v0 + (size_t)(4 * n) * SEQ, lo[n][0], lo[n][1], lo[n][2], lo[n][3], q4);
            tstore4(v0 + (size_t)(128 + 4 * n) * SEQ, hi[n][0], hi[n][1], hi[n][2], hi[n][3], q4);
          }
        } else if (pn < 8) {
          const int d = 32 * wc + cb0, h0 = 2 * (pn - 6);
#pragma unroll
          for (int n = 0; n < 2; ++n)
#pragma unroll
            for (int i = 0; i < 4; ++i) { lo[n][i] = siluf(lo[n][i]); hi[n][i] = siluf(hi[n][i]); }
          *(uint4*)(p.RGT + (size_t)t * 512 + h0 * 128 + d) = pack8u(lo[0], lo[1]);
          *(uint4*)(p.RGT + (size_t)t * 512 + (h0 + 1) * 128 + d) = pack8u(hi[0], hi[1]);
        } else if (pn < 10) {
          const int head = 4 * (pn - 8) + wc;
          const float qs = 0.125f * 1.4426950408889634f;
#pragma unroll
          for (int n = 0; n < 2; ++n)
#pragma unroll
            for (int i = 0; i < 4; ++i) { lo[n][i] *= qs; hi[n][i] *= qs; }
          *(uint4*)(p.NQ + (size_t)t * 512 + head * 64 + cb0) = pack8u(lo[0], lo[1]);
          *(uint4*)(p.NQ + (size_t)t * 512 + head * 64 + 32 + cb0) = pack8u(hi[0], hi[1]);
        } else if (pn == 10 || (pn == 11 && wc < 2)) {
          bf16_t* dst = (pn == 11) ? p.NKW : (wc < 2 ? p.NKC : p.NKS);
          const int g = wc & 1;
          *(uint4*)(dst + (size_t)t * 128 + g * 64 + cb0) = pack8u(lo[0], lo[1]);
          *(uint4*)(dst + (size_t)t * 128 + g * 64 + 32 + cb0) = pack8u(hi[0], hi[1]);
        } else if (pn == 11) {
          const int c0 = 32 * (wc - 2) + cb0;
          *(uint4*)(p.NVC + (size_t)t * 128 + c0) = pack8u(lo[0], lo[1]);
          *(uint4*)(p.NVC + (size_t)t * 128 + 64 + c0) = pack8u(hi[0], hi[1]);
        } else if (pn == 12) {
          const int col = 32 * wc + cb0, g = col >> 6, d = col & 63;
          bf16_t* v0 = p.NVST + ((size_t)(b * 2 + g) * 64 + d) * SEQ + s;
          bf16_t* v1 = p.NVWT + ((size_t)(b * 2 + g) * 64 + d) * SEQ + s;
#pragma unroll
          for (int n = 0; n < 2; ++n) {
            tstore4(v0 + (size_t)(4 * n) * SEQ, lo[n][0], lo[n][1], lo[n][2], lo[n][3], q4);
            tstore4(v1 + (size_t)(4 * n) * SEQ, hi[n][0], hi[n][1], hi[n][2], hi[n][3], q4);
          }
        } else {
          if (wc == 0) {
#pragma unroll
            for (int n = 0; n < 2; ++n)
#pragma unroll
              for (int i = 0; i < 4; ++i) if (cb0 + 4 * n + i < 24) p.GATE[(size_t)t * 24 + cb0 + 4 * n + i] = sigmoidf(lo[n][i]);
          }
        }
      }
    }
  }
};
struct EpiOut8 {
  static constexpr bool PERM = false, AFTER_DRAIN = false;
  const float* x; float* out; const float* mod;
  DI void operator()(const pg8::f32x4 (&acc)[2][2][4][2], const pg8::Unit& u, int wr, int wc, int fr_, int fq_) const {
    const int ln = fr_ + 16 * fq_, fr = ln >> 2, fq = ln & 3, src4 = (fr + 16 * fq) * 4;
    const int col0 = u.pn * 256 + wc * 32 + 4 * fq;
    const float* ga1 = mod + ((u.pm * 256) >> 13) * 6144 + 2048;
    float4 gv[2][2];
#pragma unroll
    for (int bj = 0; bj < 2; ++bj)
#pragma unroll
      for (int n = 0; n < 2; ++n) gv[bj][n] = *(const float4*)(ga1 + col0 + bj * 128 + n * 16);
#pragma unroll
    for (int ai = 0; ai < 2; ++ai)
#pragma unroll
      for (int m = 0; m < 4; ++m) {
        const size_t ro = (size_t)(u.pm * 256 + wr * 64 + fr + ai * 128 + m * 16) * DM + col0;
        float4 xv[2][2];
#pragma unroll
        for (int bj = 0; bj < 2; ++bj)
#pragma unroll
          for (int n = 0; n < 2; ++n) xv[bj][n] = *(const float4*)(x + ro + bj * 128 + n * 16);
#pragma unroll
        for (int bj = 0; bj < 2; ++bj)
#pragma unroll
          for (int n = 0; n < 2; ++n) {
            pg8::f32x4 v = acc[ai][bj][m][n]; const float4 g4 = gv[bj][n], x4 = xv[bj][n];
#pragma unroll
            for (int q = 0; q < 4; ++q) { const float t_ = v[q]; v[q] = __int_as_float(__builtin_amdgcn_ds_bpermute(src4, __float_as_int(t_))); }
            *(float4*)(out + ro + bj * 128 + n * 16) = make_float4(x4.x + g4.x * v[0], x4.y + g4.y * v[1], x4.z + g4.z * v[2], x4.w + g4.w * v[3]);
          }
      }
  }
};
struct EpiPQ8 {
  static constexpr bool PERM = true, AFTER_DRAIN = false;
  bf16_t* O;
  DI void operator()(const pg8::f32x4 (&acc)[2][2][4][2], const pg8::Unit& u, int wr, int wc, int fr, int fq) const {
#pragma unroll
    for (int ai = 0; ai < 2; ++ai)
#pragma unroll
      for (int m = 0; m < 4; ++m) {
        const int tt = u.pm * 16 + wr * 4 + ai * 8 + m;
#pragma unroll
        for (int bj = 0; bj < 2; ++bj) {
          const pg8::f32x4 v0 = acc[ai][bj][m][0], v1 = acc[ai][bj][m][1];
          uint4 o; o.x = cvt2(v0[0], v0[1]); o.y = cvt2(v0[2], v0[3]); o.z = cvt2(v1[0], v1[1]); o.w = cvt2(v1[2], v1[3]);
          *(uint4*)(O + ((size_t)(((tt * 16 + u.pn * 2 + bj) * 4 + wc) * 64 + fq * 16 + fr)) * 8) = o;
        }
      }
  }
};
DI int crow(int reg, int h) { return (reg & 3) + 8 * (reg >> 2) + 4 * h; }
DI bf16x8 ld16(const bf16_t* ptr) { return *(const bf16x8*)ptr; }
DI bf16x8 ld8x2(const bf16_t* ptr) {
  uint2 a = *(const uint2*)ptr, b = *(const uint2*)(ptr + 8);
  uint4 v; v.x = a.x; v.y = a.y; v.z = b.x; v.w = b.y;
  return __builtin_bit_cast(bf16x8, v);
}
DI bf16x8 pack8(float x0, float x1, float x2, float x3, float x4, float x5, float x6, float x7) {
  uint4 v; v.x = cvt2(x0, x1); v.y = cvt2(x2, x3); v.z = cvt2(x4, x5); v.w = cvt2(x6, x7);
  return __builtin_bit_cast(bf16x8, v);
}

DI void retkv_mfma(const Params& p, int item) {
  const int lane = mytid() & 63, w = mytid() >> 6, r = lane & 31, h = lane >> 5;
  const int hh = item & 3, c = (item >> 2) & 63, b = item >> 8, bh = b * 4 + hh, s0 = c * 128;
  const int mi = w >> 1, nb = (w & 1) * 2;
  const bf16_t* vb_ = p.RVT + ((size_t)(bh * 128 + 32 * mi + r)) * SEQ + s0 + 8 * h;
  const bf16_t* k0 = p.RKT + ((size_t)(bh * 128 + 32 * nb + r)) * SEQ + s0 + 8 * h;
  const bf16_t* k1 = k0 + (size_t)32 * SEQ;
  f32x16 a0 = zero16(), a1 = zero16();
#pragma unroll
  for (int s = 0; s < 8; ++s) {
    bf16x8 a = ld16(vb_ + 16 * s), b0 = ld16(k0 + 16 * s), b1 = ld16(k1 + 16 * s);
    a0 = MFMA32(a, b0, a0); a1 = MFMA32(a, b1, a1);
  }
  float* dst = p.KV + (size_t)item * 16384;
#pragma unroll
  for (int e = 0; e < 16; ++e) {
    const int v = 32 * mi + crow(e, h);
    dst[v * 128 + 32 * nb + r] = a0[e];
    dst[v * 128 + 32 * nb + 32 + r] = a1[e];
  }
}
DI void scan_body(const Params& p, int idx) {
  const int e = idx & 16383, bh = idx >> 14, b = bh >> 2, h = bh & 3;
  const float cd = __expf(128.f * logg_h(h));
  const int v_ = e >> 7, k_ = e & 127, ef = ((((v_ >> 5) * 8 + (k_ >> 4)) * 64) + ((k_ >> 3) & 1) * 32 + (v_ & 31)) * 8 + (k_ & 7);
  float S = 0.f;
  for (int c0 = 0; c0 < 64; c0 += 32) {
    float kv[32];
#pragma unroll
    for (int u = 0; u < 32; ++u) kv[u] = p.KV[(size_t)((b * 64 + c0 + u) * 4 + h) * 16384 + e];
#pragma unroll
    for (int u = 0; u < 32; ++u) {
      p.SPREV[(size_t)((b * 64 + c0 + u) * 4 + h) * 16384 + e] = f2bf(S);
      S = cd * S + kv[u];
    }
  }
}
DI void retout_mfma(const Params& p, int task) {
  const int lane = mytid() & 63, r = lane & 31, h = lane >> 5;
  const int item = task >> 2, nt = task & 3;
  const int hh = item & 3, c = (item >> 2) & 63, b = item >> 8, bh = b * 4 + hh, s0 = c * 128, t0 = b * SEQ + s0;
  const float lg = logg_h(hh);
  const int n = 32 * nt + r;
  bf16x8 qf[8];
#pragma unroll
  for (int s = 0; s < 8; ++s) qf[s] = ld16(p.RQ + (size_t)(t0 + n) * 512 + hh * 128 + 16 * s + 8 * h);
  f32x16 acc[4];
#pragma unroll
  for (int vi = 0; vi < 4; ++vi) {
    acc[vi] = zero16();
    const bf16_t* sp = p.SPREV + (size_t)item * 16384 + (size_t)(32 * vi + r) * 128 + 8 * h;
#pragma unroll
    for (int s = 0; s < 8; ++s) acc[vi] = MFMA32(ld16(sp + 16 * s), qf[s], acc[vi]);
    if (vi & 1) __builtin_amdgcn_sched_barrier(0);
  }
  {
    const float xi = __expf((float)(n + 1) * lg);
#pragma unroll
    for (int vi = 0; vi < 4; ++vi)
#pragma unroll
      for (int e = 0; e < 16; ++e) acc[vi][e] *= xi;
  }
  for (int mt = 0; mt <= nt; ++mt) {
    f32x16 sa = zero16();
    const bf16_t* kp = p.RK + (size_t)(t0 + 32 * mt + r) * 512 + hh * 128 + 8 * h;
#pragma unroll
    for (int s = 0; s < 8; ++s) sa = MFMA32(ld16(kp + 16 * s), qf[s], sa);
    float pv[16];
#pragma unroll
    for (int e = 0; e < 16; ++e) {
      const int dm = n - (32 * mt + crow(e, h));
      pv[e] = (dm >= 0) ? sa[e] * __expf((float)dm * lg) : 0.f;
    }
#pragma unroll
    for (int s2 = 0; s2 < 2; ++s2) {
      bf16x8 bfr = pack8(pv[8 * s2], pv[8 * s2 + 1], pv[8 * s2 + 2], pv[8 * s2 + 3], pv[8 * s2 + 4], pv[8 * s2 + 5], pv[8 * s2 + 6], pv[8 * s2 + 7]);
#pragma unroll
      for (int vi = 0; vi < 4; ++vi) {
        bf16x8 afr = ld8x2(p.RVT + ((size_t)(bh * 128 + 32 * vi + r)) * SEQ + s0 + 32 * mt + 16 * s2 + 4 * h);
        acc[vi] = MFMA32(afr, bfr, acc[vi]);
      }
      __builtin_amdgcn_sched_barrier(0);
    }
  }
  float sum = 0.f;
#pragma unroll
  for (int vi = 0; vi < 4; ++vi)
#pragma unroll
    for (int e = 0; e < 16; ++e) sum += acc[vi][e];
  sum += __shfl_xor(sum, 32);
  const float mu = sum * (1.f / 128.f);
  float var = 0.f;
#pragma unroll
  for (int vi = 0; vi < 4; ++vi)
#pragma unroll
    for (int e = 0; e < 16; ++e) { float d = acc[vi][e] - mu; var += d * d; }
  var += __shfl_xor(var, 32);
  const float rs = rsqrtf(var * (1.f / 128.f) + 1e-6f);
#pragma unroll
  for (int vi = 0; vi < 4; ++vi)
#pragma unroll
    for (int g4 = 0; g4 < 4; ++g4) {
      const int v0 = 32 * vi + 8 * g4 + 4 * h;
      uint2 gt = *(const uint2*)(p.RGT + (size_t)(t0 + n) * 512 + hh * 128 + v0);
      float y0 = (acc[vi][4 * g4 + 0] - mu) * rs * __uint_as_float(gt.x << 16);
      float y1 = (acc[vi][4 * g4 + 1] - mu) * rs * __uint_as_float(gt.x & 0xffff0000u);
      float y2 = (acc[vi][4 * g4 + 2] - mu) * rs * __uint_as_float(gt.y << 16);
      float y3 = (acc[vi][4 * g4 + 3] - mu) * rs * __uint_as_float(gt.y & 0xffff0000u);
      *(uint2*)(p.RA + (size_t)(t0 + n) * DM + hh * 128 + v0) = pack4(y0, y1, y2, y3);
    }
}
#define HID_STRIDE 264
DI void compress_mfma(const Params& p, int item, char* smem) {
  float* PART = (float*)smem;
  bf16_t* HIDL = (bf16_t*)(smem + 4 * 16 * 256 * 4);
  const int tid = mytid(), lane = tid & 63, w = tid >> 6, r = lane & 31, h = lane >> 5;
  const int kv = item >> 7, bg = (item >> 5) & 3, rt = item & 31, n0 = rt * 16, b = bg >> 1, g = bg & 1;
  const bf16_t* src = kv ? p.NVC : p.NKC; const bf16_t* W1 = kv ? p.W1Tv : p.W1Tk; const bf16_t* W2 = kv ? p.W2Tv : p.W2Tk;
  const float* B1 = kv ? p.B1Pv : p.B1Pk;
  {
    const int kq = w >> 1, ch = w & 1;
    const int n = min(n0 + (r & 15), 510);
    const bf16_t* ab = src + ((size_t)(b * SEQ + 16 * n)) * 128 + g * 64 + 8 * h;
    const bf16_t* bb = W1 + (size_t)lane * 8;
    f32x16 acc[4];
#pragma unroll
    for (int ct = 0; ct < 4; ++ct) acc[ct] = zero16();
#pragma unroll 4
    for (int s = 32 * kq; s < 32 * kq + 32; ++s) {
      const bf16x8 a = ld16(ab + (s >> 2) * 128 + (s & 3) * 16);
#pragma unroll
      for (int ct = 0; ct < 4; ++ct) acc[ct] = MFMA32(a, ld16(bb + ((size_t)((4 * ch + ct) * 128 + s)) * 512), acc[ct]);
    }
#pragma unroll
    for (int ct = 0; ct < 4; ++ct)
#pragma unroll
      for (int e = 0; e < 8; ++e) PART[(kq * 16 + crow(e, h)) * 256 + 128 * ch + 32 * ct + r] = acc[ct][e];
  }
  __syncthreads();
#pragma unroll
  for (int i = 0; i < 8; ++i) {
    const int idx = tid + 512 * i, row = idx >> 8, col = idx & 255;
    const float v = PART[row * 256 + col] + PART[(16 + row) * 256 + col] + PART[(32 + row) * 256 + col] + PART[(48 + row) * 256 + col] + B1[col];
    HIDL[row * HID_STRIDE + col] = f2bf(gelu_tanh(v));
  }
  __syncthreads();
  if (w < 2) {
    f32x16 acc = zero16();
#pragma unroll
    for (int s = 0; s < 16; ++s) acc = MFMA32(ld16(HIDL + (r & 15) * HID_STRIDE + 16 * s + 8 * h), ld16(W2 + (size_t)(32 * w + r) * 256 + 16 * s + 8 * h), acc);
    const int e_ = 32 * w + r;
    if (kv == 0) {
#pragma unroll
      for (int e = 0; e < 8; ++e) { const int n = n0 + crow(e, h); p.KC[((size_t)bg * 512 + n) * 64 + e_] = (n < 511) ? f2bf(acc[e]) : (bf16_t)0; }
    } else {
#pragma unroll
      for (int g4 = 0; g4 < 2; ++g4) {
        const int n = n0 + 8 * g4 + 4 * h;
        float v3 = (n + 3 < 511) ? acc[4 * g4 + 3] : 0.f;
        *(uint2*)(p.VCT + ((size_t)bg * 64 + e_) * 512 + n) = pack4(acc[4 * g4], acc[4 * g4 + 1], acc[4 * g4 + 2], v3);
      }
    }
  }
  __syncthreads();
}
DI void kmax_body2(const Params& p, int vb) {
  const int tid = mytid(), g = tid & 1, t = vb * 256 + (tid >> 1), b = t >> 13;
  const bf16_t* k = p.NKS + (size_t)t * 128 + g * 64; const bf16_t* kw = p.NKW + (size_t)t * 128 + g * 64;
  float ss = 0.f, sw = 0.f;
#pragma unroll
  for (int d = 0; d < 64; d += 8) {
    uint4 a = *(const uint4*)(k + d), c = *(const uint4*)(kw + d);
    const unsigned aa[4] = {a.x, a.y, a.z, a.w}, cc[4] = {c.x, c.y, c.z, c.w};
#pragma unroll
    for (int q = 0; q < 4; ++q) {
      float x0 = __uint_as_float(aa[q] << 16), x1 = __uint_as_float(aa[q] & 0xffff0000u);
      float y0 = __uint_as_float(cc[q] << 16), y1 = __uint_as_float(cc[q] & 0xffff0000u);
      ss += x0 * x0 + x1 * x1; sw += y0 * y0 + y1 * y1;
    }
  }
  float m1 = sqrtf(ss), m2 = sqrtf(sw);
  for (int o = 2; o < 64; o <<= 1) { m1 = fmaxf(m1, __shfl_xor(m1, o)); m2 = fmaxf(m2, __shfl_xor(m2, o)); }
  if ((tid & 63) < 2) { atomicMax(&p.ksmax[b * 2 + g], __float_as_uint(m1)); atomicMax(&p.ksmax[4 + b * 2 + g], __float_as_uint(m2)); }
}
DI void kcmax_body(const Params& p, int idx) {
  const bf16_t* k = p.KC + (size_t)idx * 64;
  float ss = 0.f;
  uint4 kq[8];
#pragma unroll
  for (int d = 0; d < 8; ++d) kq[d] = *(const uint4*)(k + 8 * d);
#pragma unroll
  for (int d = 0; d < 8; ++d) {
    const unsigned uu[4] = {kq[d].x, kq[d].y, kq[d].z, kq[d].w};
#pragma unroll
    for (int q = 0; q < 4; ++q) { const float x0 = __uint_as_float(uu[q] << 16), x1 = __uint_as_float(uu[q] & 0xffff0000u); ss += x0 * x0 + x1 * x1; }
  }
  atomicMax(&p.ksmax[8 + (idx >> 9)], __float_as_uint(sqrtf(ss)));
}

#define NSA_IMP 0
#define NSA_SELM 65536
#define NSA_KV 66816
#define KV_ROW 144
#define KV_TILE (64 * KV_ROW)
#define V_ROW 144
#define VSTORE(BUFOFF, v) { *(uint2*)(sdv + (BUFOFF)) = make_uint2((v).x, (v).y); *(uint2*)(sdv + (BUFOFF) + 16) = make_uint2((v).z, (v).w); }
template <int CTRL> DI float dpp_f2(float x) { return __builtin_bit_cast(float, __builtin_amdgcn_mov_dpp(__builtin_bit_cast(int, x), CTRL, 0xf, 0xf, true)); }
DI float quad_sum(float v) { v += dpp_f2<0xB1>(v); v += dpp_f2<0x4E>(v); return v; }
DI bf16x8 lds8x2(const char* ptr) {
  uint2 a = *(const uint2*)ptr, b = *(const uint2*)(ptr + 16);
  uint4 v; v.x = a.x; v.y = a.y; v.z = b.x; v.w = b.y;
  return __builtin_bit_cast(bf16x8, v);
}

DI void nsa_item(const Params& p, int item, char* smem) {
  const int tid = mytid(), lane = tid & 63, w = tid >> 6, r = lane & 31, h = lane >> 5;
  const int ti = item >> 2, bg = item & 3, b = bg >> 1, g = bg & 1;
  const int ts = ti * 64, tokg0 = b * SEQ + ts;
  const int tkl = 8 * w + (r >> 2), hl = r & 3, hd = g * 4 + hl, tpos = ts + tkl;
  float* IMPA = (float*)(smem + NSA_IMP); float* IMPB = IMPA + 64 * 128;
  unsigned* SELM = (unsigned*)(smem + NSA_SELM);
  char* KVB = smem + NSA_KV;
  const float ksm = __uint_as_float(p.ksmax[bg]), kwm = __uint_as_float(p.ksmax[4 + bg]), kcm = __uint_as_float(p.ksmax[8 + bg]);

  bf16x8 qf[4];
#pragma unroll
  for (int s = 0; s < 4; ++s) qf[s] = ld16(p.NQ + (size_t)(tokg0 + tkl) * 512 + hd * 64 + 16 * s + 8 * h);
  float qq = 0.f;
#pragma unroll
  for (int s = 0; s < 4; ++s) {
    uint4 u = __builtin_bit_cast(uint4, qf[s]);
    const unsigned uu[4] = {u.x, u.y, u.z, u.w};
#pragma unroll
    for (int q = 0; q < 4; ++q) { float x0 = __uint_as_float(uu[q] << 16), x1 = __uint_as_float(uu[q] & 0xffff0000u); qq += x0 * x0 + x1 * x1; }
  }
  qq += __shfl_xor(qq, 32);
  const float qn = sqrtf(qq);
  const int srow = tid >> 3, sch = tid & 7;
  const bf16_t* ksrc = p.NKS + ((size_t)(b * SEQ) + srow) * 128 + g * 64 + sch * 8;
  const bf16_t* vsrc = p.NVST + ((size_t)bg * 64 + srow) * SEQ + sch * 8;
  const bf16_t* kcs = p.KC + ((size_t)bg * 512 + srow) * 64 + sch * 8;
  const bf16_t* vcs = p.VCT + ((size_t)bg * 64 + srow) * 512 + sch * 8;
  char* sdst = KVB + srow * KV_ROW + sch * 16;
  char* sdv = KVB + KV_TILE + srow * V_ROW + (sch >> 1) * 32 + (sch & 1) * 8;
  const uint4 k0c = *(const uint4*)kcs, v0c = *(const uint4*)vcs;
  *(uint4*)sdst = k0c; VSTORE(0, v0c)
  for (int q = tid; q < 64 * 128 * 2 / 4; q += NT) ((float4*)IMPA)[q] = make_float4(0.f, 0.f, 0.f, 0.f);
  __syncthreads();

#define RING_RUN(KS, KSTEP, VS, VSTEP, NTILES, NEED, COMPUTE)                                                                               \
  {     \
    uint4 ka_ = make_uint4(0u, 0u, 0u, 0u), va_ = ka_;                                                                                      \
    if (1 < (NTILES)) { ka_ = *(const uint4*)((KS) + (size_t)(KSTEP)); va_ = *(const uint4*)((VS) + (size_t)(VSTEP)); }                     \
    for (int jj = 0; jj < (NTILES); ++jj) {                                                                                                 \
      const int j2_ = (jj + 2 < (NTILES)) ? jj + 2 : jj;                             \
      const uint4 kb_ = *(const uint4*)((KS) + (size_t)j2_ * (KSTEP)), vb_ = *(const uint4*)((VS) + (size_t)j2_ * (VSTEP));                 \
      if (NEED(jj)) { const char* kb = KVB + (jj & 1) * 2 * KV_TILE; const char* vbuf = kb + KV_TILE; COMPUTE(jj, kb, vbuf) }               \
      if (jj + 1 < (NTILES)) { char* d2 = sdst + ((jj + 1) & 1) * 2 * KV_TILE; *(uint4*)d2 = ka_; VSTORE(((jj + 1) & 1) * 2 * KV_TILE, va_) }          \
      ka_ = kb_; va_ = vb_;                                                                                                                 \
      lds_barrier();                                            \
    }                                                                                                                                       \
  }
#define STAGE_PAIR0(KS, KSTEP, VS, VSTEP, NTILES) { uint4 k0_ = *(const uint4*)(KS), v0_ = *(const uint4*)(VS); *(uint4*)sdst = k0_; VSTORE(0, v0_) }
#define IMP_NONE(JJ, kh, pv)
#define ATT_EXP(x) ex2(x)
#define ATT_LSUM(LACC, pv) LACC += ((pv[0] + pv[1]) + (pv[2] + pv[3])) + ((pv[4] + pv[5]) + (pv[6] + pv[7])) + ((pv[8] + pv[9]) + (pv[10] + pv[11])) + ((pv[12] + pv[13]) + (pv[14] + pv[15]));
#define ATT_TILE(kb, vbuf, INIT, FULL, MASKEXPR, SCALE, ACC, LACC, IMPHOOK, JJ)                                                             \
          {                                                                                                                                 \
            bf16x8 kf_[2][4], vf_[2][2][2];       \
            _Pragma("unroll") for (int kh = 0; kh < 2; ++kh)                                                                                \
              _Pragma("unroll") for (int s = 0; s < 4; ++s) kf_[kh][s] = *(const bf16x8*)(kb + (32 * kh + r) * KV_ROW + (16 * s + 8 * h) * 2); \
            _Pragma("unroll") for (int kh = 0; kh < 2; ++kh)                                                                                \
              _Pragma("unroll") for (int di = 0; di < 2; ++di)                                                                              \
                _Pragma("unroll") for (int s2 = 0; s2 < 2; ++s2) vf_[kh][di][s2] = *(const bf16x8*)(vbuf + (32 * di + r) * V_ROW + (32 * kh + 16 * s2 + 8 * h) * 2); \
            const bool full_ = (FULL);                                                                                                      \
            _Pragma("unroll") for (int kh = 0; kh < 2; ++kh) {                                                                              \
              f32x16 sa = fill16(INIT);                                                                                                     \
              _Pragma("unroll") for (int s = 0; s < 4; ++s) sa = MFMA32(kf_[kh][s], qf[s], sa);                                             \
              float pv[16];                                                                                                                 \
              _Pragma("unroll") for (int e = 0; e < 16; ++e) pv[e] = ATT_EXP(sa[e]) * (SCALE);                                              \
              if (!full_) { _Pragma("unroll") for (int e = 0; e < 16; ++e) { const int key = 32 * kh + crow(e, h); pv[e] = (MASKEXPR) ? pv[e] : 0.f; } }     \
              ATT_LSUM(LACC, pv)                                                                                                             \
              IMPHOOK(JJ, kh, pv)                                                                                                           \
              const bf16x8 pk0 = pack8(pv[0], pv[1], pv[2], pv[3], pv[4], pv[5], pv[6], pv[7]);                                             \
              const bf16x8 pk1 = pack8(pv[8], pv[9], pv[10], pv[11], pv[12], pv[13], pv[14], pv[15]);                                       \
              _Pragma("unroll") for (int di = 0; di < 2; ++di) {                                                                            \
                ACC[di] = MFMA32(vf_[kh][di][0], pk0, ACC[di]);                                                                             \
                ACC[di] = MFMA32(vf_[kh][di][1], pk1, ACC[di]);                                                                             \
              }                                                                                                                             \
            }                                                                                                                               \
          }
  const float mbc = qn * kcm;
  int nvalid = (tpos >= 31) ? ((tpos - 31) >> 4) + 1 : 0;
  if (nvalid > 511) nvalid = 511;
  int nvw = (ts + 8 * w + 7 >= 31) ? ((ts + 8 * w + 7 - 31) >> 4) + 1 : 0;
  if (nvw > 511) nvw = 511;
  int nvmin = (ts + 8 * w >= 31) ? ((ts + 8 * w - 31) >> 4) + 1 : 0;
  if (nvmin > 511) nvmin = 511;
  int nvall = ((ts + 63 - 31) >> 4) + 1;
  if (nvall > 511) nvall = 511;
  const int nct = (nvall + 63) >> 6;
  float lsum = 0.f;
#define CMP_NEED(jj) (64 * (jj) < nvw)
#define CMPA_COMPUTE(jj, kb, vbuf)                                                                                                          \
          { _Pragma("unroll") for (int kh = 0; kh < 2; ++kh) {                                                                              \
              f32x16 sa = fill16(-mbc);                                                                                                     \
              _Pragma("unroll") for (int s = 0; s < 4; ++s) sa = MFMA32(*(const bf16x8*)(kb + (32 * kh + r) * KV_ROW + (16 * s + 8 * h) * 2), qf[s], sa); \
              const bool full_ = 64 * (jj) + 64 <= nvmin;                                                                                   \
              if (full_) { _Pragma("unroll") for (int e = 0; e < 16; ++e) lsum += ex2(sa[e]); }                                             \
              else { _Pragma("unroll") for (int e = 0; e < 16; ++e) lsum += (64 * (jj) + 32 * kh + crow(e, h) < nvalid) ? ex2(sa[e]) : 0.f; } \
            } }
  RING_RUN(kcs, 64 * 64, vcs, 64, nct, CMP_NEED, CMPA_COMPUTE)
  lsum += __shfl_xor(lsum, 32);
  const float invl = (lsum > 0.f) ? 1.f / lsum : 0.f;
  f32x16 oc[2]; oc[0] = zero16(); oc[1] = zero16();
  {
    float ldummy = 0.f;
    *(uint4*)sdst = k0c; VSTORE(0, v0c) __syncthreads();
#define CMP_IMP(JJ, kh, pv)                                                                                                                 \
              _Pragma("unroll") for (int q = 0; q < 4; ++q) {                                                                               \
                float A_ = 2.f * (pv[4 * q] + pv[4 * q + 1] + pv[4 * q + 2]) + pv[4 * q + 3], B_ = pv[4 * q + 3];                           \
                A_ = quad_sum(A_); B_ = quad_sum(B_);                                                                                       \
                if (hl == 0) { const int j_ = 16 * (JJ) + 8 * kh + 2 * q + h; IMPA[tkl * 128 + j_] = A_; IMPB[tkl * 128 + j_] = B_; }        \
              }
#define CMPB_COMPUTE(jj, kb, vbuf) ATT_TILE(kb, vbuf, -mbc, 64 * (jj) + 64 <= nvmin, 64 * (jj) + key < nvalid, invl, oc, ldummy, CMP_IMP, jj)
    RING_RUN(kcs, 64 * 64, vcs, 64, nct, CMP_NEED, CMPB_COMPUTE)
  }
  const uint4 ks0 = *(const uint4*)ksrc, vs0 = *(const uint4*)vsrc;
  for (int rep522 = 0; rep522 < (PROBE_DUP == 522 ? 2 : 1); ++rep522)
  {
    const int tl = 8 * w + (lane >> 3), sub = lane & 7;
    unsigned long long ks[16];
#pragma unroll
    for (int c = 0; c < 16; ++c) {
      const int j = sub + 8 * c;
      float imp = IMPA[tl * 128 + j] + ((j > 0) ? IMPB[tl * 128 + j - 1] : 0.f);
      if (j == 0 || j == ti || j == ti - 1) imp = 1e9f;
      ks[c] = (j <= ti) ? (((unsigned long long)__float_as_uint(imp) << 32) | (unsigned long long)(unsigned)(128 - j)) : 0ull;
    }
#pragma unroll
    for (int k = 2; k <= 16; k <<= 1)
#pragma unroll
      for (int j = k >> 1; j >= 1; j >>= 1)
#pragma unroll
        for (int c = 0; c < 16; ++c) {
          const int l = c ^ j;
          if (l > c) {
            const bool desc = ((c & k) == 0) || (k == 16);
            const unsigned long long x = ks[c], y = ks[l];
            const bool sw = desc ? (y > x) : (x > y);
            ks[c] = sw ? y : x; ks[l] = sw ? x : y;
          }
        }
    unsigned m0 = 0, m1 = 0, m2 = 0, m3 = 0;
    for (int it = 0; it < 16; ++it) {
      unsigned long long best = ks[0];
#define TOPK_STEP(CTRL) { const unsigned olo = (unsigned)__builtin_amdgcn_mov_dpp((int)(unsigned)best, CTRL, 0xf, 0xf, true), ohi = (unsigned)__builtin_amdgcn_mov_dpp((int)(unsigned)(best >> 32), CTRL, 0xf, 0xf, true); \
        const unsigned long long o = ((unsigned long long)ohi << 32) | olo; best = (o > best) ? o : best; }
      TOPK_STEP(0xB1) TOPK_STEP(0x4E) TOPK_STEP(0x141)
#undef TOPK_STEP
      const bool won = (ks[0] == best);
      const unsigned bi = (unsigned)best;
      if (bi != 0u) {
        const int js = 128 - (int)bi;
        const unsigned bit = 1u << (js & 31);
        if ((js >> 5) == 0) m0 |= bit; else if ((js >> 5) == 1) m1 |= bit; else if ((js >> 5) == 2) m2 |= bit; else m3 |= bit;
      }
#pragma unroll
      for (int c = 0; c < 15; ++c) ks[c] = won ? ks[c + 1] : ks[c];
      ks[15] = won ? 0ull : ks[15];
    }
    if (sub == 0) { SELM[tl * 4 + 0] = m0; SELM[tl * 4 + 1] = m1; SELM[tl * 4 + 2] = m2; SELM[tl * 4 + 3] = m3; }
  }
  if (lane < 4) {
    unsigned u = 0;
#pragma unroll
    for (int t8 = 0; t8 < 8; ++t8) u |= SELM[(8 * w + t8) * 4 + lane];
    SELM[(64 + w) * 4 + lane] = u;
  }
  __syncthreads();
  const float* gt = p.GATE + (size_t)(tokg0 + tkl) * 24 + hd * 3;
  float* OUTL = IMPA;
  {
    const float g0 = gt[0];
#pragma unroll
    for (int e = 0; e < 16; ++e) { OUTL[e * 512 + tid] = g0 * oc[0][e]; OUTL[(16 + e) * 512 + tid] = g0 * oc[1][e]; }
  }
  *(uint4*)sdst = ks0; VSTORE(0, vs0) __syncthreads();
  const float mbs = qn * ksm;
  f32x16 osl[2]; osl[0] = zero16(); osl[1] = zero16();
  float lsel = 0.f;
#define SEL_NEED(jj) ((SELM[(64 + w) * 4 + ((jj) >> 5)] >> ((jj) & 31)) & 1u)
#define SEL_COMPUTE(jj, kb, vbuf) { const unsigned msel_ = SELM[tkl * 4 + ((jj) >> 5)]; \
      const float init_ = ((msel_ >> ((jj) & 31)) & 1u) ? -mbs : NEG_INF; ATT_TILE(kb, vbuf, init_, (jj) < ti, key <= tkl, 1.f, osl, lsel, IMP_NONE, jj) }
  RING_RUN(ksrc, 64 * 128, vsrc, 64, ti + 1, SEL_NEED, SEL_COMPUTE)
  const int j0w = (ti >= 8) ? ti - 8 : 0, nwt = ti - j0w + 1;
  const bf16_t* kws = p.NKW + ((size_t)(b * SEQ + 64 * j0w) + srow) * 128 + g * 64 + sch * 8;
  const bf16_t* vws = p.NVWT + ((size_t)bg * 64 + srow) * SEQ + 64 * j0w + sch * 8;
  const uint4 kw0 = *(const uint4*)kws, vw0 = *(const uint4*)vws;
  lsel += __shfl_xor(lsel, 32);
  {
    const float g1 = gt[1] / lsel;
#pragma unroll
    for (int e = 0; e < 16; ++e) { OUTL[e * 512 + tid] += g1 * osl[0][e]; OUTL[(16 + e) * 512 + tid] += g1 * osl[1][e]; }
  }
#if PROBE_DUP >= 530 && PROBE_DUP <= 539
  {
    osl[0] = zero16(); osl[1] = zero16(); lsel = 0.f;
    STAGE_PAIR0(ksrc, 64 * 128, vsrc, 64, ti + 1) __syncthreads();
#if PROBE_DUP == 530
    RING_RUN(ksrc, 64 * 128, vsrc, 64, ti + 1, SEL_NEED, SEL_COMPUTE)
#elif PROBE_DUP == 531
    for (int jj = 0; jj < ti + 1; ++jj) {
      if (SEL_NEED(jj)) { const char* kb = KVB + (jj & 1) * 2 * KV_TILE; const char* vbuf = kb + KV_TILE; SEL_COMPUTE(jj, kb, vbuf) }
      __syncthreads();
    }
#elif PROBE_DUP == 532
    for (int jj = 0; jj < ti + 1; ++jj) {
      uint4 ka_, va_;
      ka_ = va_ = make_uint4(0u, 0u, 0u, 0u);
      if (jj + 1 < ti + 1) { ka_ = *(const uint4*)(ksrc + (size_t)(jj + 1) * (64 * 128)); va_ = *(const uint4*)(vsrc + (size_t)(jj + 1) * 64); }
      if (jj + 1 < ti + 1) { char* d2 = sdst + ((jj + 1) & 1) * 2 * KV_TILE; *(uint4*)d2 = ka_; VSTORE(((jj + 1) & 1) * 2 * KV_TILE, va_) }
      __syncthreads();
    }
#elif PROBE_DUP >= 533
#if PROBE_DUP == 534
#undef ATT_LSUM
#define ATT_LSUM(LACC, pv) LACC += pv[0];
#elif PROBE_DUP == 535
#undef ATT_EXP
#define ATT_EXP(x) (x)
#elif PROBE_DUP == 536
#undef ATT_EXP
#define ATT_EXP(x) (x)
#undef ATT_LSUM
#define ATT_LSUM(LACC, pv) LACC += pv[0];
#endif
    for (int jj = 0; jj < ti + 1; ++jj) {
      if (SEL_NEED(jj)) { const char* kb = KVB + (jj & 1) * 2 * KV_TILE; const char* vbuf = kb + KV_TILE; SEL_COMPUTE(jj, kb, vbuf) }
    }
    __syncthreads();
#endif
#undef ATT_EXP
#undef ATT_LSUM
#define ATT_EXP(x) ex2(x)
#define ATT_LSUM(LACC, pv) LACC += ((pv[0] + pv[1]) + (pv[2] + pv[3])) + ((pv[4] + pv[5]) + (pv[6] + pv[7])) + ((pv[8] + pv[9]) + (pv[10] + pv[11])) + ((pv[12] + pv[13]) + (pv[14] + pv[15]));
    float chk = lsel;
#pragma unroll
    for (int e = 0; e < 16; ++e) chk += osl[0][e] + osl[1][e];
    if (__float_as_uint(chk) == 0x7fc12345u) OUTL[tid] += 1.f;
  }
#endif
  f32x16 ow[2]; ow[0] = zero16(); ow[1] = zero16();
  float lw = 0.f;
  const float mbw = qn * kwm;
  {
    *(uint4*)sdst = kw0; VSTORE(0, vw0) __syncthreads();
#define WIN_NEED(jj) true
#define WIN_COMPUTE(jj, kb, vbuf) { const int jw_ = j0w + (jj); const bool last_ = (jw_ == ti), first_ = (ti >= 8) && ((jj) == 0); \
      ATT_TILE(kb, vbuf, -mbw, !(last_ || first_), last_ ? (key <= tkl) : (key > tkl), 1.f, ow, lw, IMP_NONE, jj) }
    RING_RUN(kws, 64 * 128, vws, 64, nwt, WIN_NEED, WIN_COMPUTE)
  }
  lw += __shfl_xor(lw, 32);
  {
    const float g2 = gt[2] / lw;
#pragma unroll
    for (int di = 0; di < 2; ++di)
#pragma unroll
      for (int g4 = 0; g4 < 4; ++g4) {
        const int d0 = 32 * di + 8 * g4 + 4 * h;
        float y[4];
#pragma unroll
        for (int e = 0; e < 4; ++e) y[e] = OUTL[(16 * di + 4 * g4 + e) * 512 + tid] + g2 * ow[di][4 * g4 + e];
        *(uint2*)(p.RA + (size_t)(tokg0 + tkl) * DM + 512 + hd * 64 + d0) = pack4(y[0], y[1], y[2], y[3]);
      }
  }
  __syncthreads();
}

typedef float f32x4 __attribute__((ext_vector_type(4)));
#define MFMA16(a, b, c) __builtin_amdgcn_mfma_f32_16x16x32_bf16((a), (b), (c), 0, 0, 0)
constexpr int pk_clen(int i) { return 16 / (i + 1); }
constexpr int pk_coff(int i) { int s = 0; for (int q = 0; q < i; ++q) s += pk_clen(q); return s; }
constexpr int pk_cand(int c) {
  int i = 0; while (i < 16 && c >= pk_clen(i)) { c -= pk_clen(i); ++i; }
  return (i < 16) ? i * 16 + c : 256;
}
#define SC_STRIDE 132

DI void convert_row(const Params& p, int row, int lane);
DI unsigned f2key(float x, unsigned tag, unsigned tagmask) {
  const unsigned bits = __float_as_uint(x), m = (unsigned)((int)bits >> 31) | 0x80000000u;
  return ((bits ^ m) & ~tagmask) | tag;
}
DI float key2f(unsigned k, unsigned tagmask) {
  const unsigned u = k & ~tagmask;
  return __uint_as_float((u & 0x80000000u) ? (u ^ 0x80000000u) : ~u);
}
DI void peer_topk_tile(const Params& p, int vb, int vb_next, char* smem, long long& tacc, f32x4 (&nxt)[2][8], bool& have_nxt) {
  unsigned* SC = (unsigned*)smem;
  unsigned* ELK = (unsigned*)(smem + 256 * SC_STRIDE * 4);
  float* ELW = (float*)(ELK + 16 * 128);
  int* CT = (int*)(ELW + 16 * 128);
  const int tid = mytid(), lane = tid & 63, w = tid >> 6;
  const int t0 = vb * 16;
  if (tid < 64) { int i = 0, c = tid; while (i < 16 && c >= 16 / (i + 1)) { c -= 16 / (i + 1); ++i; } CT[tid] = (i < 16) ? i * 16 + c : 0; }
#define TPROBE(K) if (PROBE_DUP == (K)) { tacc -= (long long)wall_clock64(); }
#define TPROBE_END(K) if (PROBE_DUP == (K)) { tacc += (long long)wall_clock64(); }
  TPROBE(96)
  {
    const int tq = lane & 15, kq = lane >> 4;
    if (!have_nxt) {
      const bool two = vb_next < T_TOK / 16;
#pragma unroll
      for (int pi = 0; pi < 2; ++pi) {
        const int ph = 2 * w + pi;
        bf16x8 bfr[4], bfn[4];
#pragma unroll
        for (int s = 0; s < 4; ++s) {
          bfr[s] = *(const bf16x8*)(p.PQ + ((size_t)(((vb * 16 + ph) * 4 + s) * 64 + lane)) * 8);
          bfn[s] = *(const bf16x8*)(p.PQ + ((size_t)((((two ? vb_next : vb) * 16 + ph) * 4 + s) * 64 + lane)) * 8);
        }
#pragma unroll
        for (int j = 0; j < 8; ++j) {
          f32x4 acc = {0.f, 0.f, 0.f, 0.f}, acn = {0.f, 0.f, 0.f, 0.f};
#pragma unroll
          for (int s = 0; s < 4; ++s) {
            bf16x8 afr = *(const bf16x8*)(p.SUBK + ((size_t)(((ph * 8 + j) * 4 + s) * 64 + lane)) * 8);
            acc = MFMA16(afr, bfr[s], acc); acn = MFMA16(afr, bfn[s], acn);
          }
          nxt[pi][j] = acn;
          const int n0 = 16 * j + 4 * kq;
          uint4 kv4;
          kv4.x = f2key(acc[0], 127u - n0, 127u); kv4.y = f2key(acc[1], 126u - n0, 127u); kv4.z = f2key(acc[2], 125u - n0, 127u); kv4.w = f2key(acc[3], 124u - n0, 127u);
          *(uint4*)(SC + (ph * 16 + tq) * SC_STRIDE + n0) = kv4;
        }
      }
      have_nxt = two;
    } else {
#pragma unroll
      for (int pi = 0; pi < 2; ++pi)
#pragma unroll
        for (int j = 0; j < 8; ++j) {
          const int ph = 2 * w + pi, n0 = 16 * j + 4 * kq;
          const f32x4 acc = nxt[pi][j];
          uint4 kv4;
          kv4.x = f2key(acc[0], 127u - n0, 127u); kv4.y = f2key(acc[1], 126u - n0, 127u); kv4.z = f2key(acc[2], 125u - n0, 127u); kv4.w = f2key(acc[3], 124u - n0, 127u);
          *(uint4*)(SC + (ph * 16 + tq) * SC_STRIDE + n0) = kv4;
        }
      have_nxt = false;
    }
  }
  lds_barrier();
  TPROBE_END(96) TPROBE(97)
  if (tid < 256) {
    unsigned* row = SC + tid * SC_STRIDE;
    unsigned gmax[16];
#pragma unroll
    for (int g = 0; g < 16; ++g) {
      uint4 a = *(uint4*)(row + g * 8), b = *(uint4*)(row + g * 8 + 4);
      gmax[g] = max(max(max(a.x, a.y), max(a.z, a.w)), max(max(b.x, b.y), max(b.z, b.w)));
    }
    unsigned outk[16];
#pragma unroll
    for (int k = 0; k < 16; ++k) {
      unsigned m = max(max(max(max(gmax[0], gmax[1]), max(gmax[2], gmax[3])), max(max(gmax[4], gmax[5]), max(gmax[6], gmax[7]))),
                       max(max(max(gmax[8], gmax[9]), max(gmax[10], gmax[11])), max(max(gmax[12], gmax[13]), max(gmax[14], gmax[15]))));
      const int n = 127 - (int)(m & 127u), gi = n >> 3;
      unsigned* gp = row + gi * 8;
      uint4 a = *(uint4*)gp, b = *(uint4*)(gp + 4);
      const unsigned v[8] = {a.x, a.y, a.z, a.w, b.x, b.y, b.z, b.w};
      unsigned nm = 0u;
#pragma unroll
      for (int e = 0; e < 8; ++e) nm = max(nm, (v[e] == m) ? 0u : v[e]);
      row[n] = 0u;
#pragma unroll
      for (int g = 0; g < 16; ++g) gmax[g] = (g == gi) ? nm : gmax[g];
      outk[k] = m;
    }
#pragma unroll
    for (int k = 0; k < 16; ++k) row[k] = outk[k];
  } else {
#pragma unroll
    for (int i = 0; i < 4; ++i) convert_row(p, (vb * 4 + (w - 4)) * 8 + 2 * i, lane);
#if PROBE_DUP == 95
    asm volatile("" ::: "memory");
#pragma unroll
    for (int i = 0; i < 4; ++i) convert_row(p, (vb * 4 + (w - 4)) * 8 + 2 * i, lane);
#endif
  }
  lds_barrier();
  TPROBE_END(97) TPROBE(98)
  for (int rep93 = 0; rep93 < (PROBE_DUP == 93 ? 2 : 1); ++rep93) {
    const int q = tid >> 2, sub = tid & 3, t = q >> 3, pp = q & 7;
    const unsigned* ra = SC + ((2 * pp) * 16 + t) * SC_STRIDE;
    const unsigned* rb = SC + ((2 * pp + 1) * 16 + t) * SC_STRIDE;
    unsigned ck[13];
#pragma unroll
    for (int k = 0; k < 13; ++k) {
      const int ij = (sub == 0) ? pk_cand(4 * k) : (sub == 1) ? pk_cand(4 * k + 1) : (sub == 2) ? pk_cand(4 * k + 2) : pk_cand(4 * k + 3);
      const int ord = 4 * k + sub;
      ck[k] = (ij < 256) ? f2key(key2f(ra[ij >> 4], 127u) + key2f(rb[ij & 15], 127u), (unsigned)(63 - ord), 63u) : 0u;
    }
#pragma unroll
    for (int r_ = 0; r_ < 13; ++r_)
#pragma unroll
      for (int c = (r_ & 1); c + 1 < 13; c += 2) { const unsigned hi_ = max(ck[c], ck[c + 1]), lo_ = min(ck[c], ck[c + 1]); ck[c] = hi_; ck[c + 1] = lo_; }
    unsigned w16[16];
#pragma unroll
    for (int k = 0; k < 16; ++k) {
      unsigned bm = ck[0];
      bm = max(bm, (unsigned)__builtin_amdgcn_mov_dpp((int)bm, 0xB1, 0xf, 0xf, true));
      bm = max(bm, (unsigned)__builtin_amdgcn_mov_dpp((int)bm, 0x4E, 0xf, 0xf, true));
      const bool won = (ck[0] == bm);
#pragma unroll
      for (int c = 0; c < 12; ++c) ck[c] = won ? ck[c + 1] : ck[c];
      ck[12] = won ? 0u : ck[12];
      w16[k] = bm;
    }
    float l = 0.f; const float vmax = key2f(w16[0], 63u);
    float ev[16];
#pragma unroll
    for (int k = 0; k < 16; ++k) { ev[k] = __expf(key2f(w16[k], 63u) - vmax); l += ev[k]; }
    const float inv = 1.f / l;
#pragma unroll
    for (int k = 0; k < 16; ++k)
      if ((k & 3) == sub) {
        const int ij = CT[63 - (int)(w16[k] & 63u)];
        const int code = (127 - (int)(ra[ij >> 4] & 127u)) * 128 + (127 - (int)(rb[ij & 15] & 127u));
        ELK[t * 128 + pp * 16 + k] = ((unsigned)code << 7) | (unsigned)(pp * 16 + k);
        ELW[t * 128 + pp * 16 + k] = ev[k] * inv;
      }
  }
  lds_barrier();
  TPROBE_END(98) TPROBE(99)
  {
    unsigned a0, b0, a1, b1;
    { const uint2 u0 = *(const uint2*)(ELK + (2 * w) * 128 + 2 * lane), u1 = *(const uint2*)(ELK + (2 * w + 1) * 128 + 2 * lane); a0 = u0.x; b0 = u0.y; a1 = u1.x; b1 = u1.y; }
#define BX_STEP(LJ, XCHG)                                                                                                   \
        { const unsigned pa0 = XCHG(a0), pb0 = XCHG(b0), pa1 = XCHG(a1), pb1 = XCHG(b1);                                    \
          const bool takemin = (((lane & (LJ)) == 0) == asc);                                                               \
          a0 = takemin ? min(a0, pa0) : max(a0, pa0); b0 = takemin ? min(b0, pb0) : max(b0, pb0);                           \
          a1 = takemin ? min(a1, pa1) : max(a1, pa1); b1 = takemin ? min(b1, pb1) : max(b1, pb1); }
#define BX_DPP1(v) ((unsigned)__builtin_amdgcn_mov_dpp((int)(v), 0xB1, 0xf, 0xf, true))
#define BX_DPP2(v) ((unsigned)__builtin_amdgcn_mov_dpp((int)(v), 0x4E, 0xf, 0xf, true))
#define BX_SW4(v) ((unsigned)__builtin_amdgcn_ds_swizzle((int)(v), (4 << 10) | 0x1F))
#define BX_SW8(v) ((unsigned)__builtin_amdgcn_ds_swizzle((int)(v), (8 << 10) | 0x1F))
#define BX_SW16(v) ((unsigned)__builtin_amdgcn_ds_swizzle((int)(v), (16 << 10) | 0x1F))
#define BX_BP32(v) ((unsigned)__builtin_amdgcn_ds_bpermute((lane ^ 32) * 4, (int)(v)))
#pragma unroll
    for (int k = 2; k <= 128; k <<= 1) {
      const bool asc = (k == 128) ? true : (((2 * lane) & k) == 0);
#pragma unroll
      for (int j = k >> 1; j >= 1; j >>= 1) {
        if (j == 1) {
          const unsigned l0 = min(a0, b0), h0 = max(a0, b0), l1 = min(a1, b1), h1 = max(a1, b1);
          a0 = asc ? l0 : h0; b0 = asc ? h0 : l0; a1 = asc ? l1 : h1; b1 = asc ? h1 : l1;
        } else if (j == 2) BX_STEP(1, BX_DPP1)
        else if (j == 4) BX_STEP(2, BX_DPP2)
        else if (j == 8) BX_STEP(4, BX_SW4)
        else if (j == 16) BX_STEP(8, BX_SW8)
        else if (j == 32) BX_STEP(16, BX_SW16)
        else BX_STEP(32, BX_BP32)
      }
    }
#undef BX_STEP
#undef BX_DPP1
#undef BX_DPP2
#undef BX_SW4
#undef BX_SW8
#undef BX_SW16
#undef BX_BP32
    {
      const size_t g0 = (size_t)(t0 + 2 * w) * 128 + 2 * lane, g1 = g0 + 128;
      *(uint2*)(p.EIDX + g0) = make_uint2(a0 >> 7, b0 >> 7); *(uint2*)(p.EIDX + g1) = make_uint2(a1 >> 7, b1 >> 7);
      *(float2*)(p.EW + g0) = make_float2(ELW[(2 * w) * 128 + (a0 & 127)], ELW[(2 * w) * 128 + (b0 & 127)]);
      *(float2*)(p.EW + g1) = make_float2(ELW[(2 * w + 1) * 128 + (a1 & 127)], ELW[(2 * w + 1) * 128 + (b1 & 127)]);
    }
  }
  lds_barrier();
  TPROBE_END(99)
}

DI float dot2bf(unsigned a, unsigned b, float acc) { return __builtin_amdgcn_fdot2_f32_bf16(__builtin_bit_cast(bf16x2_t, a), __builtin_bit_cast(bf16x2_t, b), acc, false); }
template <int CTRL> DI float dpp_f(float x) { return __builtin_bit_cast(float, __builtin_amdgcn_mov_dpp(__builtin_bit_cast(int, x), CTRL, 0xf, 0xf, true)); }
DI float row16_sum(float v) { v += dpp_f<0x128>(v); v += dpp_f<0x124>(v); v += dpp_f<0x122>(v); v += dpp_f<0x121>(v); return v; }
DI float dot_row(const uint4 (&u)[8], const uint4 (&h)[8]) {
  float d = 0.f;
#pragma unroll
  for (int j = 0; j < 8; ++j) { d = dot2bf(u[j].x, h[j].x, d); d = dot2bf(u[j].y, h[j].y, d); d = dot2bf(u[j].z, h[j].z, d); d = dot2bf(u[j].w, h[j].w, d); }
  return row16_sum(d);
}
DI void axpy_row(float (&acc)[64], const uint4 (&v)[8], float c) {
#pragma unroll
  for (int j = 0; j < 8; ++j) {
    const unsigned ww[4] = {v[j].x, v[j].y, v[j].z, v[j].w};
#pragma unroll
    for (int q = 0; q < 4; ++q) {
      acc[j * 8 + 2 * q] += c * __uint_as_float(ww[q] << 16);
      acc[j * 8 + 2 * q + 1] += c * __uint_as_float(ww[q] & 0xffff0000u);
    }
  }
}
DI void axpy_half(float (&acc)[32], const uint4 (&v)[4], float c) {
#pragma unroll
  for (int j = 0; j < 4; ++j) {
    const unsigned ww[4] = {v[j].x, v[j].y, v[j].z, v[j].w};
#pragma unroll
    for (int q = 0; q < 4; ++q) {
      acc[j * 8 + 2 * q] += c * __uint_as_float(ww[q] << 16);
      acc[j * 8 + 2 * q + 1] += c * __uint_as_float(ww[q] & 0xffff0000u);
    }
  }
}
#ifndef PEER_TILE_SHIFT
#define PEER_TILE_SHIFT 8
#endif
DI void fma16_fp8(float& d, const uint4& u, const float* hv) {
  const unsigned ww[4] = {u.x, u.y, u.z, u.w};
#pragma unroll
  for (int q = 0; q < 4; ++q) {
    f32x2_t a = __builtin_amdgcn_cvt_pk_f32_fp8((int)ww[q], false), b = __builtin_amdgcn_cvt_pk_f32_fp8((int)ww[q], true);
    d += a[0] * hv[4 * q] + a[1] * hv[4 * q + 1] + b[0] * hv[4 * q + 2] + b[1] * hv[4 * q + 3];
  }
}
DI float dot_row8(const uint4 (&u)[4], const float (&hv)[64]) {
  float d0 = 0.f, d1 = 0.f;
  fma16_fp8(d0, u[0], hv); fma16_fp8(d1, u[1], hv + 16); fma16_fp8(d0, u[2], hv + 32); fma16_fp8(d1, u[3], hv + 48);
  return row16_sum(d0 + d1);
}
DI void axpy_row8(float (&acc)[64], const uint4 (&v)[4], float c) {
#pragma unroll
  for (int j = 0; j < 4; ++j) {
    const unsigned ww[4] = {v[j].x, v[j].y, v[j].z, v[j].w};
#pragma unroll
    for (int q = 0; q < 4; ++q) {
      f32x2_t a = __builtin_amdgcn_cvt_pk_f32_fp8((int)ww[q], false), b = __builtin_amdgcn_cvt_pk_f32_fp8((int)ww[q], true);
      acc[j * 16 + 4 * q] += c * a[0]; acc[j * 16 + 4 * q + 1] += c * a[1]; acc[j * 16 + 4 * q + 2] += c * b[0]; acc[j * 16 + 4 * q + 3] += c * b[1];
    }
  }
}
typedef float f32x32_t __attribute__((ext_vector_type(32)));
typedef float f32x16_t __attribute__((ext_vector_type(16)));
typedef unsigned u32x6_t __attribute__((ext_vector_type(6)));
#define ROW6_BYTES 768
#define PIN(one, x) asm volatile("" : "+v"(one), "+v"(x))
DI float dot_row6(const uint4 (&X)[2], const uint2 (&Y)[2], const f32x2_t (&hv2)[32], float& one, float& d0, float& d1) {
  u32x6_t pa, pb;
  pa[0] = X[0].x; pa[1] = X[0].y; pa[2] = X[0].z; pa[3] = X[0].w; pa[4] = Y[0].x; pa[5] = Y[0].y;
  pb[0] = X[1].x; pb[1] = X[1].y; pb[2] = X[1].z; pb[3] = X[1].w; pb[4] = Y[1].x; pb[5] = Y[1].y;
  f32x2_t p0 = {0.f, 0.f}, p1 = {0.f, 0.f}, p2 = {0.f, 0.f}, p3 = {0.f, 0.f};
  {
    const f32x32_t fa = __builtin_amdgcn_cvt_scalef32_pk32_f32_fp6(pa, one);
#define PR(v, k) __builtin_shufflevector(v, v, (k), (k) + 1)
    p0 += PR(fa, 0) * hv2[0];  p1 += PR(fa, 2) * hv2[1];  p2 += PR(fa, 4) * hv2[2];  p3 += PR(fa, 6) * hv2[3];
    p0 += PR(fa, 8) * hv2[4];  p1 += PR(fa, 10) * hv2[5]; p2 += PR(fa, 12) * hv2[6]; p3 += PR(fa, 14) * hv2[7];
    p0 += PR(fa, 16) * hv2[8]; p1 += PR(fa, 18) * hv2[9]; p2 += PR(fa, 20) * hv2[10]; p3 += PR(fa, 22) * hv2[11];
    p0 += PR(fa, 24) * hv2[12]; p1 += PR(fa, 26) * hv2[13]; p2 += PR(fa, 28) * hv2[14]; p3 += PR(fa, 30) * hv2[15];
  }
  {
    const f32x32_t fb = __builtin_amdgcn_cvt_scalef32_pk32_f32_fp6(pb, one);
    p0 += PR(fb, 0) * hv2[16];  p1 += PR(fb, 2) * hv2[17];  p2 += PR(fb, 4) * hv2[18];  p3 += PR(fb, 6) * hv2[19];
    p0 += PR(fb, 8) * hv2[20];  p1 += PR(fb, 10) * hv2[21]; p2 += PR(fb, 12) * hv2[22]; p3 += PR(fb, 14) * hv2[23];
    p0 += PR(fb, 16) * hv2[24]; p1 += PR(fb, 18) * hv2[25]; p2 += PR(fb, 20) * hv2[26]; p3 += PR(fb, 22) * hv2[27];
    p0 += PR(fb, 24) * hv2[28]; p1 += PR(fb, 26) * hv2[29]; p2 += PR(fb, 28) * hv2[30]; p3 += PR(fb, 30) * hv2[31];
#undef PR
  }
  const f32x2_t t = (p0 + p1) + (p2 + p3);
  d0 = t[0]; d1 = t[1];
  return d0 + d1;
}
DI void axpy_row6(float (&acc)[64], const uint4 (&X)[2], const uint2 (&Y)[2], float c, float& one) {
  u32x6_t pa, pb;
  pa[0] = X[0].x; pa[1] = X[0].y; pa[2] = X[0].z; pa[3] = X[0].w; pa[4] = Y[0].x; pa[5] = Y[0].y;
  pb[0] = X[1].x; pb[1] = X[1].y; pb[2] = X[1].z; pb[3] = X[1].w; pb[4] = Y[1].x; pb[5] = Y[1].y;
  {
    const f32x32_t fa = __builtin_amdgcn_cvt_scalef32_pk32_f32_fp6(pa, one);
#pragma unroll
    for (int k = 0; k < 32; ++k) acc[k] += c * fa[k];
  }
  PIN(one, acc[31]);
  {
    const f32x32_t fb = __builtin_amdgcn_cvt_scalef32_pk32_f32_fp6(pb, one);
#pragma unroll
    for (int k = 0; k < 32; ++k) acc[32 + k] += c * fb[k];
  }
}
#define GPROBE(K) if (PROBE_DUP == (K) && blockIdx.x == 0 && threadIdx.x == 0) { *p.tprobe -= (long long)wall_clock64(); }
#define GPROBE_END(K) if (PROBE_DUP == (K) && blockIdx.x == 0 && threadIdx.x == 0) { *p.tprobe += (long long)wall_clock64(); }
DI void peer_gather_block(const Params& p, int vb, char* smem) {
  unsigned* ELK = (unsigned*)smem;
  float* ELC = (float*)(smem + 32768);
  const int tid = mytid(), lane = tid & 63, w = tid >> 6, grp = lane >> 4, i = lane & 15;
  const int tokbase = vb * 64;
  unsigned short* SDNL = (unsigned short*)(smem + 65536);
  unsigned short* SUPL = (unsigned short*)(smem + 98304);
  GPROBE(240)
  for (int q = tid; q < 64 * 128 / 4; q += NT) {
    ((uint4*)ELK)[q] = ((const uint4*)(p.EIDX + (size_t)tokbase * 128))[q];
    ((float4*)ELC)[q] = ((const float4*)(p.EW + (size_t)tokbase * 128))[q];
  }
#pragma unroll
  for (int r8 = 0; r8 < 8; ++r8) {
    const int q = tid + NT * r8;
    const float4 a = ((const float4*)p.SDN)[q], b = ((const float4*)p.SUP)[q];
    ((uint2*)SDNL)[q] = make_uint2((__float_as_uint(a.x) >> 16) | (__float_as_uint(a.y) & 0xffff0000u), (__float_as_uint(a.z) >> 16) | (__float_as_uint(a.w) & 0xffff0000u));
    ((uint2*)SUPL)[q] = make_uint2((__float_as_uint(b.x) >> 16) | (__float_as_uint(b.y) & 0xffff0000u), (__float_as_uint(b.z) >> 16) | (__float_as_uint(b.w) & 0xffff0000u));
  }
  __syncthreads();
  GPROBE_END(240)
#pragma unroll 1
  for (int tt = 0; tt < 2; ++tt) {
    const int tid_ = mytid(), i = tid_ & 15;
    const int tl = (tid_ >> 6) * 8 + ((tid_ & 63) >> 4) * 2 + tt, tok = tokbase + tl;
    const unsigned* kk = ELK + tl * 128;
    float* cc = ELC + tl * 128;
    uint4 b0[2], b1[2], b2[2], b3[2]; uint2 c0[2], c1[2], c2[2], c3[2];
    float one = 1.0f, dd0 = 0.f, dd1 = 0.f;
#define ROW_LOAD(BUF, CUF, BASE, E) { const unsigned o4_ = kk[E] * (unsigned)ROW6_BYTES + (unsigned)i * 16u, o2_ = kk[E] * (unsigned)ROW6_BYTES + 256u + (unsigned)i * 8u;     \
      BUF[0] = *(const uint4*)((BASE) + o4_); CUF[0] = *(const uint2*)((BASE) + o2_); BUF[1] = *(const uint4*)((BASE) + o4_ + 384u); CUF[1] = *(const uint2*)((BASE) + o2_ + 384u); }
    GPROBE(241)
    {
      f32x2_t hv[32];
#pragma unroll
      for (int j = 0; j < 4; ++j)
#pragma unroll
        for (int q4 = 0; q4 < 4; ++q4) {
          const uint2 a = *(const uint2*)(p.RA + (size_t)tok * DM + j * 256 + q4 * 64 + i * 4);
          hv[j * 8 + q4 * 2][0] = __uint_as_float(a.x << 16); hv[j * 8 + q4 * 2][1] = __uint_as_float(a.x & 0xffff0000u);
          hv[j * 8 + q4 * 2 + 1][0] = __uint_as_float(a.y << 16); hv[j * 8 + q4 * 2 + 1][1] = __uint_as_float(a.y & 0xffff0000u);
        }
      const unsigned char* ub_ = p.PDN8;
      ROW_LOAD(b0, c0, ub_, 0) ROW_LOAD(b1, c1, ub_, 1) ROW_LOAD(b2, c2, ub_, 2) ROW_LOAD(b3, c3, ub_, 3)
      for (int e = 0; e < 128; e += 4) {
        float q0 = dot_row6(b0, c0, hv, one, dd0, dd1); ROW_LOAD(b0, c0, ub_, (e + 4) & 127)
        float q1 = dot_row6(b1, c1, hv, one, dd0, dd1); ROW_LOAD(b1, c1, ub_, (e + 5) & 127)
        float q2 = dot_row6(b2, c2, hv, one, dd0, dd1); ROW_LOAD(b2, c2, ub_, (e + 6) & 127)
        float q3 = dot_row6(b3, c3, hv, one, dd0, dd1); ROW_LOAD(b3, c3, ub_, (e + 7) & 127)
        const uint4 k4 = *(const uint4*)(kk + e); const float4 w4 = *(const float4*)(cc + e);
        const float4 s4 = make_float4(__uint_as_float((unsigned)SDNL[k4.x] << 16), __uint_as_float((unsigned)SDNL[k4.y] << 16), __uint_as_float((unsigned)SDNL[k4.z] << 16), __uint_as_float((unsigned)SDNL[k4.w] << 16));
        const float4 u4 = make_float4(__uint_as_float((unsigned)SUPL[k4.x] << 16), __uint_as_float((unsigned)SUPL[k4.y] << 16), __uint_as_float((unsigned)SUPL[k4.z] << 16), __uint_as_float((unsigned)SUPL[k4.w] << 16));
        q0 = row16_sum(q0); q1 = row16_sum(q1); q2 = row16_sum(q2); q3 = row16_sum(q3);
        const float4 o4 = make_float4(w4.x * u4.x * gelu_fast(q0 * s4.x), w4.y * u4.y * gelu_fast(q1 * s4.y), w4.z * u4.z * gelu_fast(q2 * s4.z), w4.w * u4.w * gelu_fast(q3 * s4.w));
        if (i == 0) *(float4*)(cc + e) = o4;
      }
    }
    GPROBE_END(241)
    GPROBE(242)
    {
      float acc[64];
#pragma unroll
      for (int e = 0; e < 64; ++e) acc[e] = 0.f;
      const unsigned char* vbase = p.PUP8;
      ROW_LOAD(b0, c0, vbase, 0) ROW_LOAD(b1, c1, vbase, 1) ROW_LOAD(b2, c2, vbase, 2) ROW_LOAD(b3, c3, vbase, 3)
      for (int e = 0; e < 128; e += 4) {
        axpy_row6(acc, b0, c0, cc[e], one);     ROW_LOAD(b0, c0, vbase, (e + 4) & 127)
        axpy_row6(acc, b1, c1, cc[e + 1], one); ROW_LOAD(b1, c1, vbase, (e + 5) & 127)
        axpy_row6(acc, b2, c2, cc[e + 2], one); ROW_LOAD(b2, c2, vbase, (e + 6) & 127)
        axpy_row6(acc, b3, c3, cc[e + 3], one); ROW_LOAD(b3, c3, vbase, (e + 7) & 127)
      }
      GPROBE_END(242) GPROBE(243)
      int tokl = tok; asm volatile("" : "+v"(tokl));
      const int b = tokl >> 13;
      const float* ga2 = p.mod + b * 6144 + 5120;
      const float* orow = p.out + (size_t)tokl * DM; float* grow = p.gout + (size_t)tokl * DM;
      float ss = 0.f;
#pragma unroll
      for (int j = 0; j < 4; ++j)
#pragma unroll
        for (int q4 = 0; q4 < 4; ++q4) {
          const int col = j * 256 + q4 * 64 + i * 4;
          float4 x1 = *(const float4*)(orow + col), gg = *(const float4*)(ga2 + col);
          float* q = acc + j * 16 + q4 * 4;
          q[0] = x1.x + gg.x * q[0]; q[1] = x1.y + gg.y * q[1]; q[2] = x1.z + gg.z * q[2]; q[3] = x1.w + gg.w * q[3];
          ss += q[0] * q[0] + q[1] * q[1] + q[2] * q[2] + q[3] * q[3];
        }
      float4 gf[16];
#pragma unroll
      for (int j = 0; j < 4; ++j)
#pragma unroll
        for (int q4 = 0; q4 < 4; ++q4) gf[j * 4 + q4] = *(const float4*)(p.g_final + j * 256 + q4 * 64 + i * 4);
      ss = row16_sum(ss);
      const float rstd = rsqrtf(ss * (1.f / DM) + 1e-6f);
#pragma unroll
      for (int j = 0; j < 4; ++j)
#pragma unroll
        for (int q4 = 0; q4 < 4; ++q4) {
          const int col = j * 256 + q4 * 64 + i * 4;
          const float4 g4 = gf[j * 4 + q4];
          const float* q = acc + j * 16 + q4 * 4;
          *(float4*)(grow + col) = make_float4(q[0] * rstd * g4.x, q[1] * rstd * g4.y, q[2] * rstd * g4.z, q[3] * rstd * g4.w);
        }
    }
    GPROBE_END(243)
#undef ROW_LOAD
  }
  __syncthreads();
}
DI void convert_row(const Params& p, int row2, int lane) {
  const int row = row2 + (lane >> 5), L = lane & 31, i = L >> 1, gsel = L & 1;
  const int tb = row >> 14, rr = row & 16383;
  const float* src = (tb ? p.peer_up : p.peer_down) + (size_t)rr * DM + gsel * 512 + i * 4;
  float4 xa[4], xb[4]; float am = 0.f;
#pragma unroll
  for (int q = 0; q < 4; ++q) {
    xa[q] = *(const float4*)(src + q * 64); xb[q] = *(const float4*)(src + 256 + q * 64);
    am = fmaxf(am, fmaxf(fmaxf(fabsf(xa[q].x), fabsf(xa[q].y)), fmaxf(fabsf(xa[q].z), fabsf(xa[q].w))));
    am = fmaxf(am, fmaxf(fmaxf(fabsf(xb[q].x), fabsf(xb[q].y)), fmaxf(fabsf(xb[q].z), fabsf(xb[q].w))));
  }
  for (int o = 16; o; o >>= 1) am = fmaxf(am, __shfl_xor(am, o));
  const float sc = (am > 0.f) ? __uint_as_float((__float_as_uint(am * (1.f / 7.5f)) + 0xffffu) & 0xffff0000u) : 1.f, inv = 1.f / sc;
  f32x16_t va, vb;
  {
    float X[32];
#pragma unroll
    for (int q = 0; q < 4; ++q) {
      X[4 * q] = xa[q].x * inv; X[4 * q + 1] = xa[q].y * inv; X[4 * q + 2] = xa[q].z * inv; X[4 * q + 3] = xa[q].w * inv;
      X[16 + 4 * q] = xb[q].x * inv; X[16 + 4 * q + 1] = xb[q].y * inv; X[16 + 4 * q + 2] = xb[q].z * inv; X[16 + 4 * q + 3] = xb[q].w * inv;
    }
#pragma unroll
    for (int k = 0; k < 16; ++k) { va[k] = X[2 * k]; vb[k] = X[2 * k + 1]; }
  }
  const u32x6_t pk = __builtin_amdgcn_cvt_scalef32_2xpk16_fp6_f32(va, vb, 1.0f);
  unsigned char* dst = (tb ? p.PUP8 : p.PDN8) + (size_t)rr * ROW6_BYTES + gsel * 384;
  *(uint4*)(dst + i * 16) = make_uint4(pk[0], pk[1], pk[2], pk[3]);
  *(uint2*)(dst + 256 + i * 8) = make_uint2(pk[4], pk[5]);
  if (L == 0) (tb ? p.SUP : p.SDN)[rr] = sc;
}

#define N_PHASES 11
template <int PH>
DI void run_phase(const Params& p, char* smem) {
  const int nb = gridDim.x, bid = blockIdx.x, tid = mytid();
  if (PH == 0) {
    constexpr int kW = PH0_W2V - PH0_WQ, kB = PH0_B1P - PH0_ROPE, kPrepB = kW + kB;
    if (nb <= PH0_MOD) {
      for (int vb = bid; vb < PH0_MOD + kPrepB; vb += nb) ph0_body(p, (vb < PH0_MOD) ? vb : (vb - PH0_MOD < kB) ? PH0_ROPE + (vb - PH0_MOD) : PH0_WQ + (vb - PH0_MOD - kB), smem);
    } else if (bid < PH0_MOD) ph0_body(p, bid, smem);
    else for (int j = bid - PH0_MOD; j < kPrepB; j += nb - PH0_MOD) ph0_body(p, (j < kB) ? PH0_ROPE + j : PH0_WQ + (j - kB), smem);
  } else if (PH == 1) {
    constexpr int kPrepA = (PH0_WIN - PH0_MOD) + (PH0_ROPE - PH0_SUBK);
    for (int vb = bid; vb < T_TOK / 8 + kPrepA; vb += nb) {
      if (vb < T_TOK / 8) rownorm_body(p.x, p.g_mix, p.mod, 0, 1024, p.RA, vb);
      else { const int j = vb - T_TOK / 8; ph0_body(p, (j < PH0_WIN - PH0_MOD) ? PH0_MOD + j : PH0_SUBK + (j - (PH0_WIN - PH0_MOD)), smem); }
    }
  } else if (PH == 2) {
    {
      pg8::StaticOrder S; S.init(T_TOK, NPROJ, nb, bid);
      const pg8::Gemm g{p.RA, p.WinT, T_TOK, NPROJ, 1024};
      pg8::gemm_phase((PG8_LAS unsigned char*)smem, g, S, EpiProj8{p});
    }
    {
      constexpr int kPrepC = (PH0_WQ - PH0_WIN) + (PH0_SUBK - PH0_W2V);
      const int rem = (64 * 14) % nb;
      if (rem == 0 || bid >= rem) {
        for (int j = (rem == 0) ? bid : bid - rem; j < kPrepC; j += (rem == 0) ? nb : nb - rem)
          ph0_body(p, (j < PH0_WQ - PH0_WIN) ? PH0_WIN + j : PH0_W2V + (j - (PH0_WQ - PH0_WIN)), smem);
      }
    }
  } else if (PH == 3) {
    for (int vb = bid; vb < 256 + 512 + 64; vb += nb) {
      if (vb < 256) compress_mfma(p, vb, smem);
      else if (vb < 256 + 512) retkv_mfma(p, vb - 256);
      else kmax_body2(p, vb - 768);
    }
  } else if (PH == 4) {
    for (int vb = bid; vb < 256 + 4; vb += nb) {
      if (vb < 256) scan_body(p, vb * NT + tid);
      else kcmax_body(p, (vb - 256) * NT + tid);
    }
  } else if (PH == 5) {
    for (int rep = 0; rep < (PROBE_DUP == 51 ? 2 : 1); ++rep)
      for (int vb = bid; vb < 256; vb += nb) retout_mfma(p, vb * 8 + (tid >> 6));
    for (int rep = 0; rep < (PROBE_DUP == 52 ? 2 : 1); ++rep)
      for (int vb = bid; vb < 512; vb += nb) nsa_item(p, (vb < 256) ? vb : 767 - vb, smem);
  } else if (PH == 6) {
    pg8::StaticOrder S; S.init(T_TOK, 1024, nb, bid);
    const pg8::Gemm g{p.RA, p.WoutT, T_TOK, 1024, 1024};
    pg8::gemm_phase((PG8_LAS unsigned char*)smem, g, S, EpiOut8{p.x, p.out, p.mod});
  } else if (PH == 7) {
    for (int vb = bid; vb < T_TOK / 8; vb += nb) rownorm_body(p.out, p.g_ffn, p.mod, 3072, 4096, p.RA, vb);
  } else if (PH == 8) {
    pg8::StaticOrder S; S.init(T_TOK, 2048, nb, bid);
    const pg8::Gemm g{p.RA, p.WqT, T_TOK, 2048, 1024};
    pg8::gemm_phase((PG8_LAS unsigned char*)smem, g, S, EpiPQ8{p.PQ});
  } else if (PH == 9) {
    long long tacc = 0;
    f32x4 nxt[2][8]; bool have_nxt = false;
#pragma unroll
    for (int pi = 0; pi < 2; ++pi)
#pragma unroll
      for (int j = 0; j < 8; ++j) nxt[pi][j] = (f32x4){0.f, 0.f, 0.f, 0.f};
    for (int vb = bid; vb < T_TOK / 16; vb += nb) peer_topk_tile(p, vb, vb + nb, smem, tacc, nxt, have_nxt);
    if (PROBE_DUP >= 96 && PROBE_DUP <= 99 && bid == 0) {
      const long long t0 = (long long)wall_clock64();
      while ((long long)wall_clock64() - t0 < 10 * tacc) __builtin_amdgcn_s_sleep(8);
    }
  } else if (PH == 10) {
    for (int vb = bid; vb < T_TOK / 64; vb += nb) peer_gather_block(p, vb, smem);
  }
}


#define XB_TMO      128
#define XB_XCNT(j)  (256  + 64 * (j))
#define XB_XSUB(j)  (1280 + 64 * (j))
#define XB_XGEN(j)  (2304 + 64 * (j))
#define XB_TOP      3328
#define XB_TOPGEN   3392
#define XCD_BAR_WORDS 3456
#define XB_SPIN_CAP (1u << 22)
#define LAS __attribute__((address_space(3)))
DI unsigned xb_ld(unsigned* p) { return __hip_atomic_load(p, __ATOMIC_RELAXED, __HIP_MEMORY_SCOPE_AGENT); }
DI unsigned xb_add(unsigned* p, unsigned v) { return __hip_atomic_fetch_add(p, v, __ATOMIC_RELAXED, __HIP_MEMORY_SCOPE_AGENT); }
DI unsigned xb_xcc_id() { return (unsigned)__builtin_amdgcn_s_getreg((3 << 11) | 20) & 0xFu; }
#define XB_SPIN(cond, bar) do { unsigned _sp = 0; while (cond) { __builtin_amdgcn_s_sleep(1); \
    if ((++_sp & 255u) == 0u) { if (xb_ld(&(bar)[XB_TMO])) break; if (_sp > XB_SPIN_CAP) { atomicAdd(&(bar)[XB_TMO], 1u); break; } } } } while (0)
struct XcdBarrier { unsigned* bar; unsigned x; volatile LAS unsigned* st; };
DI XcdBarrier xcd_barrier_post(unsigned* bar, volatile LAS unsigned* st) {
  XcdBarrier b; b.bar = bar; b.x = xb_xcc_id(); b.st = st;
  if (threadIdx.x == 0) (void)xb_add(&bar[XB_XCNT(b.x)], 1u);
  return b;
}
DI void xcd_barrier_complete(unsigned* bar, unsigned x, unsigned& nloc, unsigned& nx) {
  const unsigned G = gridDim.x * gridDim.y * gridDim.z;
  unsigned sum, cnt, mine, sp = 0u;
  for (;;) {
    sum = 0u; cnt = 0u; mine = 0u;
#pragma unroll
    for (unsigned j = 0; j < 16; ++j) { const unsigned c = xb_ld(&bar[XB_XCNT(j)]); sum += c; cnt += (c > 0u) ? 1u : 0u; mine = (j == x) ? c : mine; }
    if (sum == G) break;
    __builtin_amdgcn_s_sleep(1);
    if ((++sp & 255u) == 0u) { if (xb_ld(&bar[XB_TMO])) break; if (sp > XB_SPIN_CAP) { atomicAdd(&bar[XB_TMO], 1u); break; } }
  }
  nloc = mine > 0u ? mine : 1u; nx = cnt > 0u ? cnt : 1u;
}
DI void xcd_barrier(const XcdBarrier& b) {
  asm volatile("s_waitcnt vmcnt(0)" ::: "memory");
  __syncthreads();
  if (threadIdx.x == 0) {
    unsigned* bar = b.bar;
    __builtin_amdgcn_s_waitcnt(0);
    unsigned nloc = b.st[0], nx = b.st[1];
    if (nloc == 0u) { xcd_barrier_complete(bar, b.x, nloc, nx); b.st[0] = nloc; b.st[1] = nx; }
    const unsigned old = xb_add(&bar[XB_XSUB(b.x)], 1u);
    const unsigned gen = old / nloc;
    if (old + 1u == (gen + 1u) * nloc) {
      __builtin_amdgcn_fence(__ATOMIC_RELEASE, "agent");
      asm volatile("s_waitcnt vmcnt(0)" ::: "memory");
      const unsigned og = xb_add(&bar[XB_TOP], 1u);
      const unsigned tg = og / nx;
      if (og + 1u == (tg + 1u) * nx) xb_add(&bar[XB_TOPGEN], 1u);
      else XB_SPIN(xb_ld(&bar[XB_TOPGEN]) == tg, bar);
      __builtin_amdgcn_fence(__ATOMIC_ACQUIRE, "agent");
      xb_add(&bar[XB_XGEN(b.x)], 1u);
      asm volatile("s_waitcnt vmcnt(0)" ::: "memory");
    } else {
      XB_SPIN(xb_ld(&bar[XB_XGEN(b.x)]) == gen, bar);
      __builtin_amdgcn_fence(__ATOMIC_ACQUIRE, "agent");
      asm volatile("s_waitcnt vmcnt(0)" ::: "memory");
    }
  }
  __syncthreads();
}

#define SMEM_BYTES 155648

template <int PH>
DI void phase_and_probe(const Params& p, char* smem, cg::grid_group& grid) {
  const int reps = (PROBE_DUP == PH) ? 2 : 1;
  for (int rep = 0; rep < reps; ++rep) {
    if (PH == 10 && rep + 1 < reps) { Params q = p; q.gout = (float*)p.PQ; run_phase<PH>(q, smem); }
    else run_phase<PH>(p, smem);
    if (rep + 1 < reps) grid.sync();
  }
}
__global__ void __launch_bounds__(NT) k_mega(Params p) {
  extern __shared__ __attribute__((aligned(16))) char smem[];
  __shared__ uint4 xb_words;
  cg::grid_group grid = cg::this_grid();
  if (threadIdx.x == 0) xb_words = make_uint4(0u, 0u, 0u, 0u);
  __syncthreads();
  XcdBarrier xb = xcd_barrier_post(p.xbar, (volatile LAS unsigned*)&xb_words);
#if PROBE_DUP >= 200 && PROBE_DUP < 260
  long long tprev_ = (long long)wall_clock64(), tsel_ = 0;
#define TMARK(K) { const long long now_ = (long long)wall_clock64(); if (PROBE_DUP == 200 + (K)) tsel_ = now_ - tprev_; tprev_ = now_; }
#define TWORK(K) { if (PROBE_DUP == 220 + (K)) tsel_ = (long long)wall_clock64() - tprev_; }
#else
#define TMARK(K)
#define TWORK(K)
#endif
  phase_and_probe<0>(p, smem, grid); TWORK(0) grid.sync(); TMARK(0)
  phase_and_probe<1>(p, smem, grid); TWORK(1) xcd_barrier(xb); TMARK(1)
  phase_and_probe<2>(p, smem, grid); TWORK(2) xcd_barrier(xb); TMARK(2)
  phase_and_probe<3>(p, smem, grid); TWORK(3) xcd_barrier(xb); TMARK(3)
  phase_and_probe<4>(p, smem, grid); TWORK(4) xcd_barrier(xb); TMARK(4)
  phase_and_probe<5>(p, smem, grid); TWORK(5) xcd_barrier(xb); TMARK(5)
  phase_and_probe<6>(p, smem, grid); TWORK(6) xcd_barrier(xb); TMARK(6)
  phase_and_probe<7>(p, smem, grid); TWORK(7) xcd_barrier(xb); TMARK(7)
  phase_and_probe<8>(p, smem, grid); TWORK(8) xcd_barrier(xb); TMARK(8)
  phase_and_probe<9>(p, smem, grid); TWORK(9) xcd_barrier(xb); TMARK(9)
  phase_and_probe<10>(p, smem, grid); TWORK(10) TMARK(10)
#if PROBE_DUP >= 200 && PROBE_DUP < 260
  if (PROBE_DUP == 235 || (PROBE_DUP >= 240 && PROBE_DUP < 260)) tsel_ = *p.tprobe;
  if (PROBE_BLK < 0 || blockIdx.x == PROBE_BLK) { const long long t0_ = (long long)wall_clock64(); while ((long long)wall_clock64() - t0_ < 10 * tsel_) __builtin_amdgcn_s_sleep(8); }
#endif
}
#ifdef MK_MULTI
template <int PH>
__global__ void __launch_bounds__(NT) k_single(Params p) {
  extern __shared__ __attribute__((aligned(16))) char smem[];
  run_phase<PH>(p, smem);
}
#endif

static size_t carve(size_t& off, size_t bytes) { size_t o = off; off += (bytes + 255) & ~(size_t)255; return o; }

extern "C" void kernel_launch(void* const* d_in, const int* in_sizes, int n_in, void* d_out, int out_size, void* d_ws, size_t ws_size,
                              hipStream_t stream) {
  Params p{};
  p.x = (const float*)d_in[0]; p.c = (const float*)d_in[1]; p.w_ada = (const float*)d_in[2]; p.b_ada = (const float*)d_in[3];
  p.g_mix = (const float*)d_in[4]; p.w_in = (const float*)d_in[5]; p.pe_k = (const float*)d_in[6]; p.pe_v = (const float*)d_in[7];
  p.w_k1 = (const float*)d_in[8]; p.b_k1 = (const float*)d_in[9]; p.w_k2 = (const float*)d_in[10]; p.w_v1 = (const float*)d_in[11];
  p.b_v1 = (const float*)d_in[12]; p.w_v2 = (const float*)d_in[13]; p.w_out = (const float*)d_in[14]; p.g_ffn = (const float*)d_in[15];
  p.w_pq = (const float*)d_in[16]; p.subkeys = (const float*)d_in[17]; p.peer_down = (const float*)d_in[18]; p.peer_up = (const float*)d_in[19];
  p.g_final = (const float*)d_in[20];
  p.out = (float*)d_out; p.gout = p.out;
  char* ws = (char*)d_ws;
  size_t off = 0;
  p.mod = (float*)(ws + carve(off, 2 * 6144 * 4));
  p.ksmax = (unsigned*)(ws + carve(off, 256));
  p.xbar = (unsigned*)(ws + carve(off, XCD_BAR_WORDS * 4 + 64)); p.tprobe = (long long*)(p.xbar + XCD_BAR_WORDS);
  p.c128 = (float*)(ws + carve(off, (size_t)SEQ * 64 * 4)); p.s128 = (float*)(ws + carve(off, (size_t)SEQ * 64 * 4));
  p.c64 = (float*)(ws + carve(off, (size_t)SEQ * 32 * 4)); p.s64 = (float*)(ws + carve(off, (size_t)SEQ * 32 * 4));
  p.WinT = (bf16_t*)(ws + carve(off, (size_t)NPROJ * 1024 * 2));
  p.WoutT = (bf16_t*)(ws + carve(off, (size_t)1024 * 1024 * 2));
  p.WqT = (bf16_t*)(ws + carve(off, (size_t)2048 * 1024 * 2));
  p.W1Tk = (bf16_t*)(ws + carve(off, (size_t)256 * 2048 * 2)); p.W1Tv = (bf16_t*)(ws + carve(off, (size_t)256 * 2048 * 2));
  p.W2Tk = (bf16_t*)(ws + carve(off, 64 * 256 * 2)); p.W2Tv = (bf16_t*)(ws + carve(off, 64 * 256 * 2));
  p.SUBK = (bf16_t*)(ws + carve(off, (size_t)16 * 128 * 128 * 2));
  p.B1Pk = (float*)(ws + carve(off, 1024)); p.B1Pv = (float*)(ws + carve(off, 1024));
  p.RA = (bf16_t*)(ws + carve(off, (size_t)T_TOK * 1024 * 2));
  size_t rb = off;
  p.RQ = (bf16_t*)(ws + carve(off, (size_t)T_TOK * 512 * 2)); p.RK = (bf16_t*)(ws + carve(off, (size_t)T_TOK * 512 * 2));
  p.RKT = (bf16_t*)(ws + carve(off, (size_t)T_TOK * 512 * 2)); p.RVT = (bf16_t*)(ws + carve(off, (size_t)T_TOK * 512 * 2));
  p.RGT = (bf16_t*)(ws + carve(off, (size_t)T_TOK * 512 * 2)); p.NQ = (bf16_t*)(ws + carve(off, (size_t)T_TOK * 512 * 2));
  p.NKC = (bf16_t*)(ws + carve(off, (size_t)T_TOK * 128 * 2)); p.NVC = (bf16_t*)(ws + carve(off, (size_t)T_TOK * 128 * 2));
  p.NKS = (bf16_t*)(ws + carve(off, (size_t)T_TOK * 128 * 2)); p.NKW = (bf16_t*)(ws + carve(off, (size_t)T_TOK * 128 * 2));
  p.NVST = (bf16_t*)(ws + carve(off, (size_t)T_TOK * 128 * 2)); p.NVWT = (bf16_t*)(ws + carve(off, (size_t)T_TOK * 128 * 2));
  p.GATE = (float*)(ws + carve(off, (size_t)T_TOK * 24 * 4));
  p.KV = (float*)(ws + carve(off, (size_t)512 * 16384 * 4));
  p.SPREV = (bf16_t*)(ws + carve(off, (size_t)512 * 16384 * 2));
  p.KC = (bf16_t*)(ws + carve(off, (size_t)4 * 512 * 64 * 2)); p.VCT = (bf16_t*)(ws + carve(off, (size_t)4 * 512 * 64 * 2));
  p.HID = (float*)(ws + carve(off, (size_t)2 * 2048 * 256 * 4));
  size_t off2 = rb;
  p.PQ = (bf16_t*)(ws + carve(off2, (size_t)T_TOK * 2048 * 2));
  p.EIDX = (int*)(ws + carve(off2, (size_t)T_TOK * 128 * 4));
  p.EW = (float*)(ws + carve(off2, (size_t)T_TOK * 128 * 4));
  p.PDN8 = (unsigned char*)(ws + carve(off2, (size_t)16384 * 1024));
  p.PUP8 = (unsigned char*)(ws + carve(off2, (size_t)16384 * 1024));
  p.SDN = (float*)(ws + carve(off2, 16384 * 4));
  p.SUP = (float*)(ws + carve(off2, 16384 * 4));
  (void)ws_size; (void)in_sizes; (void)n_in; (void)out_size;

#ifdef MK_MULTI
#define LAUNCH1(PH) { hipFuncSetAttribute((const void*)k_single<PH>, hipFuncAttributeMaxDynamicSharedMemorySize, SMEM_BYTES); k_single<PH><<<256, NT, SMEM_BYTES, stream>>>(p); }
  LAUNCH1(0) LAUNCH1(1) LAUNCH1(2) LAUNCH1(3) LAUNCH1(4) LAUNCH1(5) LAUNCH1(6) LAUNCH1(7) LAUNCH1(8) LAUNCH1(9) LAUNCH1(10)
#else
  static int grid_blocks = 0;
  if (!grid_blocks) {
    int dev = 0, cus = 0, per_cu = 0;
    (void)hipGetDevice(&dev);
    (void)hipDeviceGetAttribute(&cus, hipDeviceAttributeMultiprocessorCount, dev);
    (void)hipFuncSetAttribute((const void*)k_mega, hipFuncAttributeMaxDynamicSharedMemorySize, SMEM_BYTES);
    (void)hipOccupancyMaxActiveBlocksPerMultiprocessor(&per_cu, k_mega, NT, SMEM_BYTES);
    if (per_cu < 1) per_cu = 1;
    if (per_cu > 1) per_cu = 1;
    grid_blocks = cus * per_cu;
  }
  (void)hipMemsetAsync(p.xbar, 0, XCD_BAR_WORDS * 4 + 64, stream);
  void* args[] = {&p};
  hipError_t e = hipLaunchCooperativeKernel((void*)k_mega, dim3(grid_blocks), dim3(NT), args, SMEM_BYTES, stream);
  if (e != hipSuccess) fprintf(stderr, "cooperative launch failed: %s (grid %d)\n", hipGetErrorString(e), grid_blocks);
#endif
}
```
